# Optimizing an MI355X kernel written in HIP

```python
import math
import jax, jax.numpy as jnp
from jax import lax
import numpy as np


D_MODEL = 1024
BATCH = 8
SEQ = 2048
DEPTH = 2
DEC_BATCH = 8
DEC_SEQ = 32
PAST_LEN = 4096

CHUNK = 64
QBLK = 128
D_MIX = D_MODEL
A_WIDTH = D_MIX // 2
A_HEAD_DIM = 64
A_HEADS = A_WIDTH // (2 * A_HEAD_DIM)
A_VDIM = 2 * A_HEAD_DIM
ATTN_SCALE = A_HEAD_DIM ** -0.5
B_WIDTH = D_MIX // 4
POOL_WINDOWS = (2, 4, 8, 16)
N_POOL_GROUPS = len(POOL_WINDOWS)
POOL_GROUP = B_WIDTH // N_POOL_GROUPS
POOL_HIST = max(POOL_WINDOWS) - 1
C_WIDTH = D_MIX // 4
CONV_W = 3
D_FF = 2816
ROPE_THETA = 10000.0
EPS = 1e-6
NEG_INF = -1e30
D_IN = 3 * A_WIDTH + B_WIDTH + 3 * C_WIDTH
SPLITS = [A_WIDTH, 2 * A_WIDTH, 3 * A_WIDTH, 3 * A_WIDTH + B_WIDTH,
          3 * A_WIDTH + B_WIDTH + C_WIDTH, 3 * A_WIDTH + B_WIDTH + 2 * C_WIDTH]

kernel_name = 'hybrid_stream_diffattn_pool_conv_step'

F32 = jnp.float32


def rmsnorm(x, g):
    xf = x.astype(F32)
    y = xf * lax.rsqrt(jnp.mean(xf * xf, axis=-1, keepdims=True) + EPS)
    return (y * g.astype(F32)).astype(x.dtype)


def swiglu(x, wg, wu, wd):
    return (jax.nn.silu(x @ wg) * (x @ wu)) @ wd


def rope(x, pos):
    half = A_HEAD_DIM // 2
    inv = jnp.power(ROPE_THETA, -jnp.arange(half, dtype=F32) / half)
    ang = pos.astype(F32)[:, None] * inv[None, :]
    cos = jnp.cos(ang)[None, :, None, None, :]
    sin = jnp.sin(ang)[None, :, None, None, :]
    xf = x.astype(F32)
    x1, x2 = xf[..., :half], xf[..., half:]
    return jnp.concatenate([x1 * cos - x2 * sin, x2 * cos + x1 * sin], axis=-1).astype(x.dtype)


def diff_attend(q, k, v, mask, lam):
    s = jnp.einsum('bqhcd,bkhcd->bhcqk', q.astype(F32), k) * ATTN_SCALE
    if mask is not None:
        s = jnp.where(mask, s, NEG_INF)
    p = jax.nn.softmax(s, axis=-1)
    a = p[:, :, 0] - lam * p[:, :, 1]
    return jnp.einsum('bhqk,bkhe->bqhe', a, v)


def pool_mix(u_ext, pos, w_pool, scale):
    bsz, tot, _ = u_ext.shape
    t = tot - POOL_HIST
    uf = u_ext.astype(F32)
    cs = jnp.concatenate([jnp.zeros((bsz, 1, B_WIDTH), F32), jnp.cumsum(uf, axis=1)], axis=1)
    cur = uf[:, POOL_HIST:]
    outs = []
    for gi, w in enumerate(POOL_WINDOWS):
        lo, hi = gi * POOL_GROUP, (gi + 1) * POOL_GROUP
        wsum = cs[:, POOL_HIST + 1:, lo:hi] - cs[:, POOL_HIST + 1 - w:POOL_HIST + 1 - w + t, lo:hi]
        cnt = jnp.minimum(pos + 1, w).astype(F32)[None, :, None]
        outs.append(wsum / cnt - cur[..., lo:hi])
    d = jnp.stack(outs, axis=2)
    y = jnp.einsum('btgc,gce->btge', d, w_pool.astype(F32)).reshape(bsz, t, B_WIDTH)
    return (y * scale.astype(F32)).astype(u_ext.dtype)


def short_conv(v_ext, w):
    t = v_ext.shape[1] - (CONV_W - 1)
    y = w[0] * v_ext[:, 0:t]
    for j in range(1, CONV_W):
        y = y + w[j] * v_ext[:, j:j + t]
    return y


def run_trunk(x, pos, cache_k, cache_v, state_pool, state_conv, p):
    bsz, t, _ = x.shape
    new_k, new_v, new_pool, new_conv = [], [], [], []
    for l in range(DEPTH):
        h = rmsnorm(x, p['norm_ffn1'][l])
        x = x + 0.5 * swiglu(h, p['ffn1_gate'][l], p['ffn1_up'][l], p['ffn1_down'][l])
        h = rmsnorm(x, p['norm_mix'][l])
        z = h @ p['w_in'][l]
        q, k, v, u, hc, bg, cg = jnp.split(z, SPLITS, axis=-1)
        q = rope(q.reshape(bsz, t, A_HEADS, 2, A_HEAD_DIM), pos)
        k = rope(k.reshape(bsz, t, A_HEADS, 2, A_HEAD_DIM), pos)
        v = v.reshape(bsz, t, A_HEADS, A_VDIM)
        lam_init = 0.8 - 0.6 * math.exp(-0.3 * l)
        lq1, lk1 = p['lambda_q1'][l].astype(F32), p['lambda_k1'][l].astype(F32)
        lq2, lk2 = p['lambda_q2'][l].astype(F32), p['lambda_k2'][l].astype(F32)
        lam = jnp.exp(jnp.sum(lq1 * lk1)) - jnp.exp(jnp.sum(lq2 * lk2)) + lam_init
        cv = cg * hc
        if cache_k is None:
            kf, vf = k.astype(F32), v.astype(F32)
            nblk = t // QBLK
            qb = q.reshape(bsz, nblk, QBLK, A_HEADS, 2, A_HEAD_DIM).swapaxes(0, 1)
            key_chunk = jnp.arange(t) // CHUNK

            def blk(args):
                qi, bi = args
                q_chunk = (bi * QBLK + jnp.arange(QBLK)) // CHUNK
                mask = key_chunk[None, :] <= q_chunk[:, None]
                return diff_attend(qi, kf, vf, mask, lam)

            o = lax.map(blk, (qb, jnp.arange(nblk)))
            o = o.swapaxes(0, 1).reshape(bsz, t, A_HEADS, A_VDIM)
            pool_ext = jnp.concatenate([jnp.zeros((bsz, POOL_HIST, B_WIDTH), u.dtype), u], axis=1)
            conv_ext = jnp.concatenate([jnp.zeros((bsz, CONV_W - 1, C_WIDTH), cv.dtype), cv], axis=1)
        else:
            past = cache_k.shape[2]
            ck = cache_k[l].reshape(bsz, past, A_HEADS, 2, A_HEAD_DIM)
            k_all = jnp.concatenate([ck.astype(F32), k.astype(F32)], axis=1)
            v_all = jnp.concatenate([cache_v[l].astype(F32), v.astype(F32)], axis=1)
            o = diff_attend(q, k_all, v_all, None, lam)
            pool_ext = jnp.concatenate([state_pool[l].astype(u.dtype), u], axis=1)
            conv_ext = jnp.concatenate([state_conv[l].astype(cv.dtype), cv], axis=1)
        o = rmsnorm(o, p['subln'][l]) * (1.0 - lam_init)
        y_attn = o.reshape(bsz, t, A_WIDTH).astype(x.dtype)
        y_pool = pool_mix(pool_ext, pos, p['pool_w'][l], p['pool_scale'][l])
        y_conv = bg * short_conv(conv_ext, p['conv_w'][l])
        mix = jnp.concatenate([y_attn, y_pool, y_conv], axis=-1) @ p['w_out'][l]
        x = x + mix
        h = rmsnorm(x, p['norm_ffn2'][l])
        x = x + 0.5 * swiglu(h, p['ffn2_gate'][l], p['ffn2_up'][l], p['ffn2_down'][l])
        new_k.append(k.reshape(bsz, t, A_HEADS, 2 * A_HEAD_DIM))
        new_v.append(v)
        new_pool.append(pool_ext[:, -POOL_HIST:])
        new_conv.append(conv_ext[:, -(CONV_W - 1):])
    x = rmsnorm(x, p['final_norm'])
    return x, jnp.stack(new_k), jnp.stack(new_v), jnp.stack(new_pool), jnp.stack(new_conv)


def setup_inputs(seed: int = 0) -> dict:
    key = jax.random.key(seed)
    ks = jax.random.split(key, 32)

    def nrm(k, shape, s):
        return jax.random.normal(k, shape, F32) * s

    def gain(k, shape):
        return 1.0 + 0.1 * jax.random.normal(k, shape, F32)

    return {
        'x_prompt': nrm(ks[0], (BATCH, SEQ, D_MODEL), 1.0),
        'x_sample': nrm(ks[1], (DEC_BATCH, DEC_SEQ, D_MODEL), 1.0),
        'cache_k': nrm(ks[2], (DEPTH, DEC_BATCH, PAST_LEN, A_HEADS, 2 * A_HEAD_DIM), 1.0),
        'cache_v': nrm(ks[3], (DEPTH, DEC_BATCH, PAST_LEN, A_HEADS, A_VDIM), 1.0),
        'state_pool': nrm(ks[4], (DEPTH, DEC_BATCH, POOL_HIST, B_WIDTH), 1.0),
        'state_conv': nrm(ks[5], (DEPTH, DEC_BATCH, CONV_W - 1, C_WIDTH), 1.0),
        'norm_ffn1': gain(ks[6], (DEPTH, D_MODEL)),
        'ffn1_gate': nrm(ks[7], (DEPTH, D_MODEL, D_FF), D_MODEL ** -0.5),
        'ffn1_up': nrm(ks[8], (DEPTH, D_MODEL, D_FF), D_MODEL ** -0.5),
        'ffn1_down': nrm(ks[9], (DEPTH, D_FF, D_MODEL), D_FF ** -0.5),
        'norm_mix': gain(ks[10], (DEPTH, D_MODEL)),
        'w_in': nrm(ks[11], (DEPTH, D_MODEL, D_IN), D_MODEL ** -0.5),
        'lambda_q1': nrm(ks[12], (DEPTH, A_HEAD_DIM), 0.1),
        'lambda_k1': nrm(ks[13], (DEPTH, A_HEAD_DIM), 0.1),
        'lambda_q2': nrm(ks[14], (DEPTH, A_HEAD_DIM), 0.1),
        'lambda_k2': nrm(ks[15], (DEPTH, A_HEAD_DIM), 0.1),
        'subln': gain(ks[16], (DEPTH, A_VDIM)),
        'pool_w': nrm(ks[17], (DEPTH, N_POOL_GROUPS, POOL_GROUP, POOL_GROUP), POOL_GROUP ** -0.5),
        'pool_scale': gain(ks[18], (DEPTH, B_WIDTH)),
        'conv_w': nrm(ks[19], (DEPTH, CONV_W, C_WIDTH), CONV_W ** -0.5),
        'w_out': nrm(ks[20], (DEPTH, D_MIX, D_MODEL), D_MIX ** -0.5),
        'norm_ffn2': gain(ks[21], (DEPTH, D_MODEL)),
        'ffn2_gate': nrm(ks[22], (DEPTH, D_MODEL, D_FF), D_MODEL ** -0.5),
        'ffn2_up': nrm(ks[23], (DEPTH, D_MODEL, D_FF), D_MODEL ** -0.5),
        'ffn2_down': nrm(ks[24], (DEPTH, D_FF, D_MODEL), D_FF ** -0.5),
        'final_norm': gain(ks[25], (D_MODEL,)),
    }


def reference(x_prompt, x_sample, cache_k, cache_v, state_pool, state_conv,
              norm_ffn1, ffn1_gate, ffn1_up, ffn1_down, norm_mix, w_in,
              lambda_q1, lambda_k1, lambda_q2, lambda_k2, subln, pool_w, pool_scale, conv_w,
              w_out, norm_ffn2, ffn2_gate, ffn2_up, ffn2_down, final_norm):
    p = {
        'norm_ffn1': norm_ffn1, 'ffn1_gate': ffn1_gate, 'ffn1_up': ffn1_up, 'ffn1_down': ffn1_down,
        'norm_mix': norm_mix, 'w_in': w_in,
        'lambda_q1': lambda_q1, 'lambda_k1': lambda_k1, 'lambda_q2': lambda_q2, 'lambda_k2': lambda_k2,
        'subln': subln, 'pool_w': pool_w, 'pool_scale': pool_scale, 'conv_w': conv_w, 'w_out': w_out,
        'norm_ffn2': norm_ffn2, 'ffn2_gate': ffn2_gate, 'ffn2_up': ffn2_up, 'ffn2_down': ffn2_down,
        'final_norm': final_norm,
    }
    pos_prompt = jnp.arange(x_prompt.shape[1], dtype=jnp.int32)
    pos_sample = PAST_LEN + jnp.arange(x_sample.shape[1], dtype=jnp.int32)
    y_prompt, k_prompt, v_prompt, pool_prompt, conv_prompt = run_trunk(
        x_prompt, pos_prompt, None, None, None, None, p)
    y_sample, k_sample, v_sample, pool_sample, conv_sample = run_trunk(
        x_sample, pos_sample, cache_k, cache_v, state_pool, state_conv, p)
    return (y_prompt, y_sample, k_prompt, v_prompt, pool_prompt, conv_prompt,
            k_sample, v_sample, pool_sample, conv_sample)
```

```cpp
#include <hip/hip_runtime.h>
#include <hip/hip_cooperative_groups.h>
#include <cstdio>
#include <cstdint>
namespace pg8 {
#define PG8_LAS __attribute__((address_space(3)))
typedef unsigned short bf16_t;
typedef short bf16x8 __attribute__((ext_vector_type(8)));
typedef float f32x4 __attribute__((ext_vector_type(4)));
typedef unsigned u32x4 __attribute__((ext_vector_type(4)));
constexpr int BM = 256, BK = 64, HALF = 128, HTB = HALF * BK * 2  , STAGE_BYTES = 8 * HTB, NXCD = 8, WGM = 8;

__host__ __device__ __forceinline__ int lds_byte(int r, int c) { const int st = (r >> 4) * 2 + (c >> 5), rr = r & 15, cc = c & 31, ob = rr * 64 + cc * 2; return st * 1024 + (ob ^ (((ob >> 9) & 1) << 5)); }
__host__ __device__ __forceinline__ void stage_rc(int b, int& R, int& C) { const int st = b / 1024, sb = b % 1024, swz = sb ^ (((sb >> 9) & 1) << 5); R = (st >> 1) * 16 + swz / 64; C = (st & 1) * 32 + (swz % 64) / 2; }
__host__ __device__ __forceinline__ int perm32(int rho) { const int n = rho >> 4, i = rho & 15; return 8 * (i >> 2) + 4 * n + (i & 3); }

struct Unit { int pm, pn; };
struct Gemm { const bf16_t* A; const bf16_t* Bt; int M, N, K; };

struct StaticOrder {
    int nM, nN, nwg, G, c;
    __host__ __device__ void init(int M, int N, int G_, int c_) { nM = M / BM; nN = N / BM; nwg = nM * nN; G = G_; c = c_; }
    __host__ __device__ bool next(int i, Unit& u) const {
        const long L = (long)i * G + c; if (L >= nwg) return false;
        int wgid = (int)L; { const int q = nwg / NXCD, r = nwg % NXCD, xcd = wgid % NXCD, off = wgid / NXCD; wgid = (xcd < r ? xcd * (q + 1) : r * (q + 1) + (xcd - r) * q) + off; }
        const int nig = WGM * nN, gid = wgid / nig, fm = gid * WGM, gsz = (nM - fm) < WGM ? (nM - fm) : WGM;
        u.pm = fm + ((wgid % nig) % gsz); u.pn = (wgid % nig) / gsz; return true;
    }
    __device__ __forceinline__ void a_ready(const Unit&) const {}
    __device__ __forceinline__ void done(const Unit&) const {}
};

__device__ __forceinline__ unsigned cvt_pk_bf16(float lo, float hi) { unsigned r; asm volatile("v_cvt_pk_bf16_f32 %0, %1, %2" : "=v"(r) : "v"(lo), "v"(hi)); return r; }
typedef float f32x2 __attribute__((ext_vector_type(2)));
typedef unsigned u32x2 __attribute__((ext_vector_type(2)));
constexpr size_t WOFF_ROPE = (size_t)1 << 20, WOFF_QB = (size_t)215 << 20, WOFF_KB = (size_t)232 << 20, WOFF_VB = (size_t)249 << 20, WOFF_ZB = (size_t)266 << 20;
constexpr size_t OOFF_KP = 17039360, OOFF_VP = 33816576, OOFF_PP = 50593792, OOFF_KS = 50663424, OOFF_VS = 50925568, OOFF_PS = 51187712;
__device__ __forceinline__ float silu_mul(float g, float u) { const float e = __builtin_amdgcn_exp2f(-1.4426950408889634f * g); return g * u * __builtin_amdgcn_rcpf(1.0f + e); }
struct EpiSwiGLU {
    static constexpr bool PERM = true, AFTER_DRAIN = false;
    bf16_t* O; int ldc;
    __device__ __forceinline__ void operator()(const f32x4 (&acc)[2][2][4][2], const Unit& u, int wr, int wc, int fr, int fq) const {
        const int row0 = u.pm * BM + wr * 64 + fr; const int col0 = u.pn * 128 + wc * 32 + 8 * fq;
#pragma unroll
        for (int ai = 0; ai < 2; ++ai)
#pragma unroll
            for (int m = 0; m < 4; ++m) {
                bf16_t* p = O + (size_t)(row0 + ai * HALF + m * 16) * ldc + col0;
                const f32x4 g0 = acc[ai][0][m][0], g1 = acc[ai][0][m][1], u0 = acc[ai][1][m][0], u1 = acc[ai][1][m][1];
                u32x4 w;
                w.x = cvt_pk_bf16(silu_mul(g0[0], u0[0]), silu_mul(g0[1], u0[1])); w.y = cvt_pk_bf16(silu_mul(g0[2], u0[2]), silu_mul(g0[3], u0[3]));
                w.z = cvt_pk_bf16(silu_mul(g1[0], u1[0]), silu_mul(g1[1], u1[1])); w.w = cvt_pk_bf16(silu_mul(g1[2], u1[2]), silu_mul(g1[3], u1[3]));
                *(u32x4*)p = w;
                asm volatile("" ::: "memory");
            }
    }
};
struct EpiResid {
    static constexpr bool PERM = false, AFTER_DRAIN = false;
    const float* baseP; const float* baseS; float* out; float scale;
    __device__ __forceinline__ void operator()(const f32x4 (&acc)[2][2][4][2], const Unit& u, int wr, int wc, int fr, int fq) const {
        const int col0 = u.pn * BM + wc * 32 + 4 * fq;
#pragma unroll
        for (int ai = 0; ai < 2; ++ai)
#pragma unroll
            for (int m = 0; m < 4; ++m) {
                const int row = u.pm * BM + ai * HALF + wr * 64 + m * 16 + fr;
                const float* bp = (row < 16384) ? baseP + (size_t)row * 1024 : baseS + (size_t)(row - 16384) * 1024;
                float* op = out + (size_t)row * 1024;
#pragma unroll
                for (int bj = 0; bj < 2; ++bj)
#pragma unroll
                    for (int n = 0; n < 2; ++n) { const int c = col0 + bj * HALF + n * 16; const f32x4 b = *(const f32x4*)(bp + c); *(f32x4*)(op + c) = b + acc[ai][bj][m][n] * scale; }
                asm volatile("" ::: "memory");
            }
    }
};
struct EpiWin {
    static constexpr bool PERM = false, AFTER_DRAIN = false;
    unsigned char* ws; float* outp; int l; float qscale;
    __device__ __forceinline__ void operator()(const f32x4 (&acc)[2][2][4][2], const Unit& u, int wr, int wc, int fr, int fq) const {
        const int pn = u.pn;
        bf16_t* const Qb = (bf16_t*)(ws + WOFF_QB); bf16_t* const Kb = (bf16_t*)(ws + WOFF_KB); bf16_t* const Vb = (bf16_t*)(ws + WOFF_VB); bf16_t* const Zb = (bf16_t*)(ws + WOFF_ZB);
        const float* const rope = (const float*)(ws + WOFF_ROPE);
        float* const kP = outp + OOFF_KP + (size_t)l * 16384 * 512; float* const vP = outp + OOFF_VP + (size_t)l * 16384 * 512;
        float* const kS = outp + OOFF_KS + (size_t)l * 256 * 512; float* const vS = outp + OOFF_VS + (size_t)l * 256 * 512;
        float* const poolP = outp + OOFF_PP + (size_t)l * 8 * 15 * 256; float* const poolS = outp + OOFF_PS + (size_t)l * 8 * 15 * 256;
#pragma unroll
        for (int ai = 0; ai < 2; ++ai)
#pragma unroll
            for (int m = 0; m < 4; ++m) {
                const int row = u.pm * BM + ai * HALF + wr * 64 + m * 16 + fr;
                const bool smp = row >= 16384; const int rs = row - 16384;
                const int prow = smp ? 2048 + (rs & 31) : (row & 2047);
#pragma unroll
                for (int bj = 0; bj < 2; ++bj) {
                    const int dlo = 16 * (wc & 1) + 4 * fq, lc0 = 64 * (2 * bj + (wc >> 1)) + dlo;
                    const f32x4 a0 = acc[ai][bj][m][0], a1 = acc[ai][bj][m][1];
                    if (pn < 4) {
                        const f32x4 cs = *(const f32x4*)(rope + (size_t)prow * 64 + dlo), sn = *(const f32x4*)(rope + (size_t)prow * 64 + 32 + dlo);
                        const f32x4 r0 = a0 * cs - a1 * sn, r1 = a1 * cs + a0 * sn;
                        if (pn < 2) {
                            const int col = 256 * pn + lc0; bf16_t* q = Qb + (size_t)row * 512 + col;
                            u32x2 w0, w1; w0.x = cvt_pk_bf16(r0[0] * qscale, r0[1] * qscale); w0.y = cvt_pk_bf16(r0[2] * qscale, r0[3] * qscale);
                            w1.x = cvt_pk_bf16(r1[0] * qscale, r1[1] * qscale); w1.y = cvt_pk_bf16(r1[2] * qscale, r1[3] * qscale);
                            *(u32x2*)q = w0; *(u32x2*)(q + 32) = w1;
                        } else {
                            const int col = 256 * (pn - 2) + lc0; bf16_t* k = Kb + (size_t)row * 512 + col;
                            float* ko = smp ? kS + (size_t)rs * 512 + col : kP + (size_t)row * 512 + col;
                            *(f32x4*)ko = r0; *(f32x4*)(ko + 32) = r1;
                            u32x2 w0, w1; w0.x = cvt_pk_bf16(r0[0], r0[1]); w0.y = cvt_pk_bf16(r0[2], r0[3]); w1.x = cvt_pk_bf16(r1[0], r1[1]); w1.y = cvt_pk_bf16(r1[2], r1[3]);
                            *(u32x2*)k = w0; *(u32x2*)(k + 32) = w1;
                        }
                    } else if (pn < 6) {
                        const int col = 256 * (pn - 4) + lc0; bf16_t* v = Vb + (size_t)row * 512 + col;
                        float* vo = smp ? vS + (size_t)rs * 512 + col : vP + (size_t)row * 512 + col;
                        *(f32x4*)vo = a0; *(f32x4*)(vo + 32) = a1;
                        u32x2 w0, w1; w0.x = cvt_pk_bf16(a0[0], a0[1]); w0.y = cvt_pk_bf16(a0[2], a0[3]); w1.x = cvt_pk_bf16(a1[0], a1[1]); w1.y = cvt_pk_bf16(a1[2], a1[3]);
                        *(u32x2*)v = w0; *(u32x2*)(v + 32) = w1;
                    } else {
                        const int col = 256 * (pn - 6) + lc0; bf16_t* z = Zb + (size_t)row * 1024 + col;
                        u32x2 w0, w1; w0.x = cvt_pk_bf16(a0[0], a0[1]); w0.y = cvt_pk_bf16(a0[2], a0[3]); w1.x = cvt_pk_bf16(a1[0], a1[1]); w1.y = cvt_pk_bf16(a1[2], a1[3]);
                        *(u32x2*)z = w0; *(u32x2*)(z + 32) = w1;
                        if (pn == 6) {
                            if (smp) { const int b = rs >> 5, t = rs & 31; if (t >= 17) { float* po = poolS + (size_t)(b * 15 + t - 17) * 256 + lc0; *(f32x4*)po = a0; *(f32x4*)(po + 32) = a1; } }
                            else { const int b = row >> 11, t = row & 2047; if (t >= 2033) { float* po = poolP + (size_t)(b * 15 + t - 2033) * 256 + lc0; *(f32x4*)po = a0; *(f32x4*)(po + 32) = a1; } }
                        }
                    }
                }
                asm volatile("" ::: "memory");
            }
    }
};
template <class Epi, class Sched, bool ALIGN_EPI = false, bool SP2 = false>
__device__ __forceinline__ void gemm_phase(PG8_LAS unsigned char* lds, const Gemm g, const Sched& S, const Epi& E) {
    int tid_l = threadIdx.x; asm volatile("" : "+v"(tid_l)); const int tid = tid_l, wid = __builtin_amdgcn_readfirstlane(tid >> 6), lane = tid & 63, wr = wid >> 2, wc = wid & 3, fr = lane & 15, fq = lane >> 4;
    const int K = g.K, nt = K / BK;
    unsigned voffA[2], voffB[2];
#pragma unroll
    for (int i = 0; i < 2; ++i) { int R, C; stage_rc(tid * 16 + i * 8192, R, C); const int Rb = Epi::PERM ? ((R & ~31) + perm32(R & 31)) : R;
        voffA[i] = (unsigned)(R * K + C) * 2u; voffB[i] = (unsigned)(Rb * K + C) * 2u; }
    const size_t kstep = (size_t)(BK * 2);
    const size_t hstep = (size_t)HALF * K * 2;
    const size_t tstep = 2 * hstep;
    const unsigned ldsw = (unsigned)wid * 1024u;
    const int aoff = lds_byte(wr * 64 + fr, fq * 8), boff = lds_byte(wc * 32 + fr, fq * 8);
#define PG8_SA(b, h) (((b) * 2 + (h)) * HTB)
#define PG8_SB(b, h) ((4 + (b) * 2 + (h)) * HTB)
#define PG8_STAGE(bufoff, gbase, voff) do { _Pragma("unroll") for (int _i = 0; _i < 2; ++_i) \
        __builtin_amdgcn_global_load_lds((const unsigned*)((const char*)(gbase) + (voff)[_i]), (PG8_LAS unsigned*)(lds + (bufoff) + ldsw + _i * 8192), 16, 0, 0); } while (0)
#define PG8_LDA(dst, b, h) do { _Pragma("unroll") for (int m = 0; m < 4; ++m) _Pragma("unroll") for (int k = 0; k < 2; ++k) dst[m][k] = *(const PG8_LAS bf16x8*)(lds + PG8_SA(b, h) + aoff + m * 2048 + k * 1024); } while (0)
#define PG8_LDB(dst, b, h) do { _Pragma("unroll") for (int n = 0; n < 2; ++n) _Pragma("unroll") for (int k = 0; k < 2; ++k) dst[n][k] = *(const PG8_LAS bf16x8*)(lds + PG8_SB(b, h) + boff + n * 2048 + k * 1024); } while (0)
#define PG8_MMA(ai, bj, At, Bt) do { __builtin_amdgcn_s_setprio(1); _Pragma("unroll") for (int m = 0; m < 4; ++m) _Pragma("unroll") for (int n = 0; n < 2; ++n) _Pragma("unroll") for (int k = 0; k < 2; ++k) \
        acc[ai][bj][m][n] = __builtin_amdgcn_mfma_f32_16x16x32_bf16(Bt[n][k], At[m][k], acc[ai][bj][m][n], 0, 0, 0); __builtin_amdgcn_s_setprio(0); } while (0)
#define PG8_WAIT_V(n) asm volatile("s_waitcnt vmcnt(" #n ")" ::: "memory")
#define PG8_WAIT_L(n) asm volatile("s_waitcnt lgkmcnt(" #n ")" ::: "memory")
#define PG8_BAR __builtin_amdgcn_s_barrier()
#define PG8_SCHED __builtin_amdgcn_sched_barrier(0)
    Unit cur, nxt; int ui = 0;
    if (!S.next(0, cur)) return;
    f32x4 acc[2][2][4][2];
#pragma unroll
    for (int a = 0; a < 2; ++a)
#pragma unroll
        for (int b = 0; b < 2; ++b)
#pragma unroll
            for (int m = 0; m < 4; ++m)
#pragma unroll
                for (int n = 0; n < 2; ++n) acc[a][b][m][n] = (f32x4){0.f, 0.f, 0.f, 0.f};
    bf16x8 At[4][2], B0[2][2], B1[2][2];
    const char* cA = (const char*)g.A + (size_t)cur.pm * tstep; const char* cB = (const char*)g.Bt + (size_t)cur.pn * tstep;
    S.a_ready(cur);
    if constexpr (SP2) {
        PG8_STAGE(PG8_SB(0, 0), cB, voffB); PG8_STAGE(PG8_SB(0, 1), cB + hstep, voffB); PG8_STAGE(PG8_SA(0, 0), cA, voffA); PG8_STAGE(PG8_SA(0, 1), cA + hstep, voffA);
        if (wr == 1) PG8_BAR;
        PG8_WAIT_V(2); PG8_BAR;
        PG8_STAGE(PG8_SB(1, 0), cB + kstep, voffB); PG8_STAGE(PG8_SA(1, 0), cA + kstep, voffA); PG8_STAGE(PG8_SB(1, 1), cB + hstep + kstep, voffB);
        PG8_WAIT_V(6); PG8_BAR;
    } else {
        PG8_STAGE(PG8_SB(0, 0), cB, voffB); PG8_STAGE(PG8_SA(0, 0), cA, voffA); PG8_STAGE(PG8_SB(0, 1), cB + hstep, voffB); PG8_STAGE(PG8_SA(0, 1), cA + hstep, voffA);
        if (wr == 1) PG8_BAR;
        PG8_WAIT_V(4); PG8_BAR;
        PG8_STAGE(PG8_SB(1, 0), cB + kstep, voffB); PG8_STAGE(PG8_SA(1, 0), cA + kstep, voffA); PG8_STAGE(PG8_SB(1, 1), cB + hstep + kstep, voffB);
        PG8_WAIT_V(6); PG8_BAR;
    }
    for (;;) {
        const bool has_next = S.next(ui + 1, nxt);
        const char* nA = has_next ? (const char*)g.A + (size_t)nxt.pm * tstep : cA; const char* nB = has_next ? (const char*)g.Bt + (size_t)nxt.pn * tstep : cB;
        for (int t = 0; t < nt; t += 2) {
            const bool last = (t == nt - 2);
            const char* a1 = cA + (size_t)(t + 1) * kstep;
            const char* a2 = last ? nA : cA + (size_t)(t + 2) * kstep; const char* b2 = last ? nB : cB + (size_t)(t + 2) * kstep;
            const char* a3 = a2 + kstep; const char* b3 = b2 + kstep;
            if (last && has_next) S.a_ready(nxt);
            if constexpr (SP2) {
            PG8_LDB(B0, 0, 0); PG8_LDB(B1, 0, 1); PG8_SCHED; PG8_LDA(At, 0, 0); PG8_STAGE(PG8_SA(1, 1), a1 + hstep, voffA);
            PG8_WAIT_V(8); PG8_WAIT_L(0); PG8_BAR; PG8_MMA(0, 0, At, B0); PG8_MMA(0, 1, At, B1); PG8_BAR; PG8_SCHED;
            PG8_LDA(At, 0, 1); PG8_STAGE(PG8_SB(0, 0), b2, voffB); PG8_STAGE(PG8_SB(0, 1), b2 + hstep, voffB); PG8_STAGE(PG8_SA(0, 0), a2, voffA);
            PG8_WAIT_V(8); PG8_WAIT_L(0); PG8_BAR; PG8_MMA(1, 0, At, B0); PG8_MMA(1, 1, At, B1); PG8_BAR; PG8_SCHED;
            PG8_LDB(B0, 1, 0); PG8_LDB(B1, 1, 1); PG8_SCHED; PG8_LDA(At, 1, 0); PG8_STAGE(PG8_SA(0, 1), a2 + hstep, voffA);
            PG8_WAIT_V(8); PG8_WAIT_L(0); PG8_BAR; PG8_MMA(0, 0, At, B0); PG8_MMA(0, 1, At, B1); PG8_BAR; PG8_SCHED;
            PG8_LDA(At, 1, 1); PG8_STAGE(PG8_SB(1, 0), b3, voffB); PG8_STAGE(PG8_SB(1, 1), b3 + hstep, voffB); PG8_STAGE(PG8_SA(1, 0), a3, voffA);
            PG8_WAIT_V(8); PG8_WAIT_L(0); PG8_BAR; PG8_MMA(1, 0, At, B0); PG8_MMA(1, 1, At, B1); PG8_BAR; PG8_SCHED;
            } else {
            PG8_LDB(B0, 0, 0); PG8_SCHED; PG8_LDA(At, 0, 0); PG8_STAGE(PG8_SA(1, 1), a1 + hstep, voffA);
            PG8_WAIT_L(8); PG8_BAR; PG8_WAIT_L(0); PG8_MMA(0, 0, At, B0); PG8_BAR; PG8_SCHED;
            PG8_LDB(B1, 0, 1); PG8_STAGE(PG8_SB(0, 0), b2, voffB);
            PG8_BAR; PG8_WAIT_L(0); PG8_MMA(0, 1, At, B1); PG8_BAR;
            PG8_LDA(At, 0, 1); PG8_STAGE(PG8_SA(0, 0), a2, voffA);
            PG8_BAR; PG8_WAIT_L(0); PG8_MMA(1, 0, At, B0); PG8_BAR; PG8_SCHED;
            PG8_STAGE(PG8_SB(0, 1), b2 + hstep, voffB);
            PG8_WAIT_V(6); PG8_BAR; PG8_MMA(1, 1, At, B1); PG8_BAR;
            PG8_LDB(B0, 1, 0); PG8_SCHED; PG8_LDA(At, 1, 0); PG8_STAGE(PG8_SA(0, 1), a2 + hstep, voffA);
            PG8_WAIT_L(8); PG8_BAR; PG8_WAIT_L(0); PG8_MMA(0, 0, At, B0); PG8_BAR; PG8_SCHED;
            PG8_LDB(B1, 1, 1); PG8_STAGE(PG8_SB(1, 0), b3, voffB);
            PG8_BAR; PG8_WAIT_L(0); PG8_MMA(0, 1, At, B1); PG8_BAR;
            PG8_LDA(At, 1, 1); PG8_STAGE(PG8_SA(1, 0), a3, voffA);
            PG8_BAR; PG8_WAIT_L(0); PG8_MMA(1, 0, At, B0); PG8_BAR; PG8_SCHED;
            PG8_STAGE(PG8_SB(1, 1), b3 + hstep, voffB);
            PG8_WAIT_V(6); PG8_BAR; PG8_MMA(1, 1, At, B1); PG8_BAR;
            }
        }
        if constexpr (ALIGN_EPI) { if (wr == 0) PG8_BAR; }
        if constexpr (!Epi::AFTER_DRAIN) { E(acc, cur, wr, wc, fr, fq); S.done(cur); }
        if (!has_next) break;
#pragma unroll
        for (int a = 0; a < 2; ++a)
#pragma unroll
            for (int b = 0; b < 2; ++b)
#pragma unroll
                for (int m = 0; m < 4; ++m)
#pragma unroll
                    for (int n = 0; n < 2; ++n) acc[a][b][m][n] = (f32x4){0.f, 0.f, 0.f, 0.f};
        cur = nxt; cA = nA; cB = nB; ++ui;
        if constexpr (ALIGN_EPI) { if (wr == 1) PG8_BAR; }
    }
    PG8_WAIT_V(0);
    if constexpr (!ALIGN_EPI) { if (wr == 0) PG8_BAR; }
    PG8_BAR;
    if constexpr (Epi::AFTER_DRAIN) { E.fused(acc, cur, wr, wc, fr, fq, lds, wid, lane); S.done(cur); }
#undef PG8_SA
#undef PG8_SB
#undef PG8_STAGE
#undef PG8_LDA
#undef PG8_LDB
#undef PG8_MMA
#undef PG8_WAIT_V
#undef PG8_WAIT_L
#undef PG8_BAR
#undef PG8_SCHED
}
}
#include <hip/hip_bf16.h>
#include <cmath>
namespace attn_body {
using bf16=__hip_bfloat16;
using bf16x8=__attribute__((ext_vector_type(8)))short;
using s16x4=__attribute__((ext_vector_type(4)))short;
using f32x16=__attribute__((ext_vector_type(16)))float;
using u32x4=__attribute__((ext_vector_type(4)))unsigned;
constexpr int BATCH=8,NHEAD=16,SEQ=2048,D=64,PQK=512,PO=1024;
constexpr int NW=8,QBLK=32,QB=QBLK*NW,KVBLK=64,NQB=SEQ/QB;
constexpr int ATTN_UNIT_ROWS=QB;
__device__ __forceinline__ int crow(int r,int hi){return (r&3)+8*(r>>2)+4*hi;}
#define SBAR() __builtin_amdgcn_sched_barrier(0)
__device__ __forceinline__ void cmask(f32x16&p0,f32x16&p1,int jb,int qrel,int hi){
  const float NEG=-INFINITY; (void)hi;
  if(jb>(qrel>>6)){
  #pragma unroll
  for(int r=0;r<16;++r){p0[r]=NEG;p1[r]=NEG;}}
}

constexpr int NSLOT=3, SLOTB=8192;
constexpr int LDS_K=0, LDS_V=NSLOT*SLOTB, LDS_WS=2*NSLOT*SLOTB, LDS_OST=LDS_WS+NW*64*4, LDS_BYTES=LDS_OST+NW*4096;
constexpr float C2=0.125f*1.4426950408889634f;
__device__ __forceinline__ void glds16(const void*gsrc,unsigned lds_dst){unsigned keep;
  asm volatile("s_mov_b32 %0, m0\n\ts_mov_b32 m0, %2\n\ts_nop 0\n\tglobal_load_lds_dwordx4 %1, off\n\ts_mov_b32 m0, %0":"=&s"(keep):"v"(gsrc),"s"(lds_dst):"memory");}
__device__ __forceinline__ float max3f(float a,float b,float c){float r;asm("v_max3_f32 %0, %1, %2, %3":"=v"(r):"v"(a),"v"(b),"v"(c));return r;}
__device__ __forceinline__ float max2f(float a,float b){float r;asm("v_max_f32_e32 %0, %1, %2":"=v"(r):"v"(a),"v"(b));return r;}
__device__ __forceinline__ float fadd_s(float a,float b){float r;asm("v_add_f32_e32 %0, %1, %2":"=v"(r):"v"(a),"v"(b));return r;}
__device__ __forceinline__ float fsub_s(float a,float b){float r;asm("v_sub_f32_e32 %0, %1, %2":"=v"(r):"v"(a),"v"(b));return r;}
typedef float f32x2_t __attribute__((ext_vector_type(2))); typedef __bf16 bf16x2_t __attribute__((ext_vector_type(2)));
__device__ __forceinline__ unsigned cvtpk_s(float lo,float hi){f32x2_t v={lo,hi};bf16x2_t b=__builtin_convertvector(v,bf16x2_t);return __builtin_bit_cast(unsigned,b);}
#define WAIT_BAR(N) asm volatile("s_waitcnt vmcnt(" #N ") lgkmcnt(0)\n\ts_barrier":::"memory")

__device__ __forceinline__ void qkt(f32x16&p0,f32x16&p1,const char*Kslot,const bf16x8*qr,const f32x16&negm,int r32,int hi){
  const char*kb=Kslot+hi*1024+r32*16;
  #pragma unroll
  for(int d0=0;d0<4;++d0){
    const bf16x8 b0=*reinterpret_cast<const bf16x8*>(kb+d0*2048);
    const bf16x8 b1=*reinterpret_cast<const bf16x8*>(kb+d0*2048+512);
    if(d0==0){p0=__builtin_amdgcn_mfma_f32_32x32x16_bf16(b0,qr[0],negm,0,0,0);p1=__builtin_amdgcn_mfma_f32_32x32x16_bf16(b1,qr[0],negm,0,0,0);}
    else{p0=__builtin_amdgcn_mfma_f32_32x32x16_bf16(b0,qr[d0],p0,0,0,0);p1=__builtin_amdgcn_mfma_f32_32x32x16_bf16(b1,qr[d0],p1,0,0,0);}}
}
typedef __attribute__((address_space(3))) const char* lds_cptr;
typedef short v4i16_t __attribute__((ext_vector_type(4)));
__device__ __forceinline__ void kload8(bf16x8*kf,lds_cptr kp){
  kf[0]=*(const __attribute__((address_space(3))) bf16x8*)(kp);      kf[1]=*(const __attribute__((address_space(3))) bf16x8*)(kp+512);
  kf[2]=*(const __attribute__((address_space(3))) bf16x8*)(kp+2048); kf[3]=*(const __attribute__((address_space(3))) bf16x8*)(kp+2560);
  kf[4]=*(const __attribute__((address_space(3))) bf16x8*)(kp+4096); kf[5]=*(const __attribute__((address_space(3))) bf16x8*)(kp+4608);
  kf[6]=*(const __attribute__((address_space(3))) bf16x8*)(kp+6144); kf[7]=*(const __attribute__((address_space(3))) bf16x8*)(kp+6656);
}
__device__ __forceinline__ void kload2(bf16x8*kf,lds_cptr kp,int j){ kf[2*j]=*(const __attribute__((address_space(3))) bf16x8*)(kp+j*2048); kf[2*j+1]=*(const __attribute__((address_space(3))) bf16x8*)(kp+j*2048+512); }
__device__ __forceinline__ s16x4 vtr(lds_cptr p){ return __builtin_bit_cast(s16x4,__builtin_amdgcn_ds_read_tr16_b64_v4i16((__attribute__((address_space(3))) v4i16_t*)p)); }
__device__ __forceinline__ float rowmax(const f32x16&p0,const f32x16&p1){
  float a=max3f(p0[0],p0[1],p1[0]),b=max3f(p0[2],p0[3],p1[1]);a=max3f(a,p1[2],p1[3]);
  #pragma unroll
  for(int r=4;r<16;r+=4){a=max3f(a,p0[r],p0[r+1]);b=max3f(b,p0[r+2],p0[r+3]);a=max3f(a,p1[r],p1[r+1]);b=max3f(b,p1[r+2],p1[r+3]);}
  const float m=max2f(a,b);
  auto rr=__builtin_amdgcn_permlane32_swap(__float_as_uint(m),__float_as_uint(m),false,false);
  return max2f(__uint_as_float(rr[0]),__uint_as_float(rr[1]));
}
__device__ __forceinline__ void pv(f32x16*o,int vb,bf16x8 pa0,bf16x8 pa1,bf16x8 pa2,bf16x8 pa3){
  #pragma unroll
  for(int d0=0;d0<2;++d0){s16x4 lo[4],hi[4];
    #pragma unroll
    for(int ks=0;ks<4;++ks){
      asm volatile("ds_read_b64_tr_b16 %0,%1 offset:%c2":"=&v"(lo[ks]):"v"(vb),"i"(d0*4096+ks*1024):"memory");
      asm volatile("ds_read_b64_tr_b16 %0,%1 offset:%c2":"=&v"(hi[ks]):"v"(vb),"i"(d0*4096+ks*1024+512):"memory");}
    asm volatile("s_waitcnt lgkmcnt(0)":::"memory");SBAR();
    #define PK(k) (bf16x8){lo[k][0],lo[k][1],lo[k][2],lo[k][3],hi[k][0],hi[k][1],hi[k][2],hi[k][3]}
    o[d0]=__builtin_amdgcn_mfma_f32_32x32x16_bf16(pa0,PK(0),o[d0],0,0,0);
    o[d0]=__builtin_amdgcn_mfma_f32_32x32x16_bf16(pa1,PK(1),o[d0],0,0,0);
    o[d0]=__builtin_amdgcn_mfma_f32_32x32x16_bf16(pa2,PK(2),o[d0],0,0,0);
    o[d0]=__builtin_amdgcn_mfma_f32_32x32x16_bf16(pa3,PK(3),o[d0],0,0,0);
    #undef PK
  }
}

#ifndef ATTN_STORE16
#define ATTN_STORE16(p,v) (*(u32x4*)(p)=(v))
#endif
template<int THRL> __device__ __forceinline__ void attn_unit(int b,int qb,const bf16*Q,const bf16*__restrict__ K,const bf16*__restrict__ V,bf16*O,char*shm){
  int tid_l=threadIdx.x; asm volatile("":"+v"(tid_l)); const int tid=tid_l,lane=tid&63,r32=lane&31,hi=lane>>5; const int wid=__builtin_amdgcn_readfirstlane(tid>>6);
  const long rowbase=(long)b*SEQ; const int q0=qb*QB;
  const bf16*Qw=Q+(rowbase+q0+wid*QBLK)*PQK;
  const bf16*Kh=K+rowbase*PQK,*Vh=V+rowbase*PQK;
  const unsigned lds0=(unsigned)(uintptr_t)shm;
  float*wsf=(float*)(shm+LDS_WS)+wid*64;
  const bf16*ksrc=Kh+(long)lane*PQK+wid*8;
  const bf16*vsrc=Vh+(long)(16*(wid&3)+(lane>>2))*PQK+(wid>>2)*32+(lane&3)*8;
  const unsigned kdst=lds0+LDS_K+wid*1024, vdst=lds0+LDS_V+wid*1024;
  #define DMA_K(t,slot) glds16(ksrc+(long)(t)*KVBLK*PQK,(unsigned)__builtin_amdgcn_readfirstlane(kdst+(slot)))
  #define DMA_V(t,slot) glds16(vsrc+(long)(t)*KVBLK*PQK,(unsigned)__builtin_amdgcn_readfirstlane(vdst+(slot)))
  const int vb0=(int)(lds0+LDS_V)+((lane>>4)&1)*32+(lane&3)*8+(4*hi+((lane&15)>>2))*64;
  const char*Kbase=shm+LDS_K; bf16x8 kf[8];
  const lds_cptr shm3=(lds_cptr)shm; const lds_cptr kp0=shm3+LDS_K+hi*1024+r32*16; const lds_cptr vp0=shm3+LDS_V+((lane>>4)&1)*32+(lane&3)*8+(4*hi+((lane&15)>>2))*64;
  const int NT=(q0+QB)/KVBLK;
  DMA_K(0,0);DMA_V(0,0);DMA_K(1,SLOTB);
  bf16x8 qr[4];
  #pragma unroll
  for(int d0=0;d0<4;++d0)qr[d0]=*reinterpret_cast<const bf16x8*>(&Qw[(long)r32*PQK+d0*16+hi*8]);
  float mhat=0.f,l_reg=0.f;f32x16 o[2];o[0]=f32x16{};o[1]=f32x16{};f32x16 negm=f32x16{};asm volatile("":"+v"(negm));
  const int qrel=wid*QBLK+r32;
  #define CMASK(P0,P1,t) do{int jb_=(t)-(NT-4); if(jb_>=0)cmask(P0,P1,jb_,qrel,hi);}while(0)
  bool resc=false;
  #define START(P0,P1) do{ const float rm=rowmax(P0,P1); resc=false; \
    { const float dl=rm; mhat=fadd_s(mhat,dl); \
      _Pragma("unroll") for(int r=0;r<16;++r){P0[r]=fsub_s(P0[r],dl);P1[r]=fsub_s(P1[r],dl);} \
      _Pragma("unroll") for(int r=0;r<16;++r)negm[r]=-mhat; asm volatile("":"+v"(negm)); } \
    _Pragma("unroll") for(int r=0;r<16;++r)P0[r]=__builtin_amdgcn_exp2f(P0[r]); }while(0)
  #define RESC() do{ if(resc){ asm volatile("s_waitcnt lgkmcnt(0)":::"memory"); \
      _Pragma("unroll") for(int d_=0;d_<2;++d_) _Pragma("unroll") for(int r=0;r<16;++r)o[d_][r]*=wsf[crow(r,hi)]; } }while(0)
  f32x16 pA0,pA1,pB0,pB1;
  int sl_prev=0,sl_cur=0,sl_next=SLOTB;
  #define ROT() do{sl_prev=sl_cur;sl_cur=sl_next;sl_next=(sl_next==(NSLOT-1)*SLOTB)?0:sl_next+SLOTB;}while(0)
  DMA_K(2,2*SLOTB);
  WAIT_BAR(3);
  qkt(pA0,pA1,Kbase,qr,negm,r32,hi);asm volatile("s_nop 15\n\ts_nop 7":"+v"(pA0),"+v"(pA1));CMASK(pA0,pA1,0);
  START(pA0,pA1);
  _Pragma("unroll") for(int r=0;r<16;++r)pA1[r]=__builtin_amdgcn_exp2f(pA1[r]);
  WAIT_BAR(0);
  DMA_K(3,0);DMA_V(1,SLOTB);
  ROT();
  kload8(kf,kp0+sl_cur);
  WAIT_BAR(2);
  s16x4 vlo[8],vhi[8]; u32x4 pw0,pw1,pw2,pw3;
  #define PKW(P,B) cvtpk_s(P[B],P[B+1])
  #define PAF(k) __builtin_bit_cast(bf16x8,pw##k)
  #define VFR(i) (bf16x8){vlo[i][0],vlo[i][1],vlo[i][2],vlo[i][3],vhi[i][0],vhi[i][1],vhi[i][2],vhi[i][3]}
  #define PIN(x) asm volatile("":"+v"(x))
  #define MX3(a,b,c) __builtin_fmaxf(__builtin_fmaxf((a),(b)),(c))
  #define GAPA(MF,A0,A1,A2,A3,W0,W1,PW) do{ MF; sacc+=A0; sacc+=A1; sacc+=A2; sacc+=A3; PIN(sacc); W0; W1; PIN(PW); SBAR(); }while(0)
  #define EX(v) __builtin_amdgcn_exp2f(v)
  #define GAPB(MF,X,B) do{ MF; X[B]=EX(X[B]); X[B+1]=EX(X[B+1]); X[B+2]=EX(X[B+2]); X[B+3]=EX(X[B+3]); PIN(X); SBAR(); }while(0)
  #define VRD(i) do{ vlo[i]=vtr(vp_+(((i)>>2)*4096+((i)&3)*1024)); vhi[i]=vtr(vp_+(((i)>>2)*4096+((i)&3)*1024+512)); }while(0)
  #define KRD(G,j) do{ if(G){ kload2(kf,kp0+sl_next,j); SBAR(); } }while(0)
  #define STEP(C0,C1,P0,P1,t,GK,GV,GL) do{ SBAR(); \
    const lds_cptr vp_=vp0+sl_prev; \
    VRD(0); SBAR(); float sacc=(P0[0]+P0[1]); \
    GAPA(C0=__builtin_amdgcn_mfma_f32_32x32x16_bf16(kf[0],qr[0],negm,0,0,0), P0[2],P0[3],P0[4],P0[5],     pw0[0]=PKW(P0,0), pw0[1]=PKW(P0,2), pw0); \
    VRD(4); SBAR(); GAPA(C1=__builtin_amdgcn_mfma_f32_32x32x16_bf16(kf[1],qr[0],negm,0,0,0), P0[6],P0[7],P0[8],P0[9],     pw0[2]=PKW(P0,4), pw0[3]=PKW(P0,6), pw0); \
    VRD(1); SBAR(); GAPA(C0=__builtin_amdgcn_mfma_f32_32x32x16_bf16(kf[2],qr[1],C0,0,0,0),   P0[10],P0[11],P0[12],P0[13], pw1[0]=PKW(P0,8), pw1[1]=PKW(P0,10), pw1); \
    VRD(5); SBAR(); GAPA(C1=__builtin_amdgcn_mfma_f32_32x32x16_bf16(kf[3],qr[1],C1,0,0,0),   P0[14],P0[15],P1[0],P1[1],   pw1[2]=PKW(P0,12),pw1[3]=PKW(P0,14), pw1); \
    VRD(2); SBAR(); GAPA(C0=__builtin_amdgcn_mfma_f32_32x32x16_bf16(kf[4],qr[2],C0,0,0,0),   P1[2],P1[3],P1[4],P1[5],     pw2[0]=PKW(P1,0), pw2[1]=PKW(P1,2), pw2); \
    VRD(6); SBAR(); GAPA(C1=__builtin_amdgcn_mfma_f32_32x32x16_bf16(kf[5],qr[2],C1,0,0,0),   P1[6],P1[7],P1[8],P1[9],     pw2[2]=PKW(P1,4), pw2[3]=PKW(P1,6), pw2); \
    VRD(3); SBAR(); GAPA(C0=__builtin_amdgcn_mfma_f32_32x32x16_bf16(kf[6],qr[3],C0,0,0,0),   P1[10],P1[11],P1[12],P1[13], pw3[0]=PKW(P1,8), pw3[1]=PKW(P1,10), pw3); \
    VRD(7); SBAR(); GAPA(C1=__builtin_amdgcn_mfma_f32_32x32x16_bf16(kf[7],qr[3],C1,0,0,0),   P1[14],P1[15],0.f,0.f,       pw3[2]=PKW(P1,12),pw3[3]=PKW(P1,14), pw3); \
    l_reg+=sacc; \
    if(GK){DMA_K((t)+3,sl_cur);} if(GV){DMA_V((t)+1,sl_next);} \
    CMASK(C0,C1,t); \
    { float a=MX3(C0[0],C0[1],C1[0]),b=MX3(C0[2],C0[3],C1[1]); a=MX3(a,C1[2],C1[3]); \
      _Pragma("unroll") for(int r=4;r<16;r+=4){a=MX3(a,C0[r],C0[r+1]);b=MX3(b,C0[r+2],C0[r+3]);a=MX3(a,C1[r],C1[r+1]);b=MX3(b,C1[r+2],C1[r+3]);} \
      float rm=__builtin_fmaxf(a,b); { auto rr=__builtin_amdgcn_permlane32_swap(__float_as_uint(rm),__float_as_uint(rm),false,false); rm=__builtin_fmaxf(__uint_as_float(rr[0]),__uint_as_float(rr[1])); } \
      resc=false; \
      if(__builtin_expect(__any(rm>(float)THRL),0)){ const float dl=__builtin_fmaxf(rm,0.f); mhat+=dl; \
        _Pragma("unroll") for(int r=0;r<16;++r){C0[r]-=dl;C1[r]-=dl;} \
        _Pragma("unroll") for(int r=0;r<16;++r)negm[r]=-mhat; asm volatile("":"+v"(negm)); \
        const float f=__builtin_amdgcn_exp2f(-dl); l_reg*=f; if(hi==0)wsf[r32]=f; resc=true; } } \
    SBAR(); \
    GAPB(o[0]=__builtin_amdgcn_mfma_f32_32x32x16_bf16(PAF(0),VFR(0),o[0],0,0,0), C0,0); \
    GAPB(o[1]=__builtin_amdgcn_mfma_f32_32x32x16_bf16(PAF(0),VFR(4),o[1],0,0,0), C0,4); \
    KRD(GL,0); GAPB(o[0]=__builtin_amdgcn_mfma_f32_32x32x16_bf16(PAF(1),VFR(1),o[0],0,0,0), C0,8); \
    KRD(GL,1); GAPB(o[1]=__builtin_amdgcn_mfma_f32_32x32x16_bf16(PAF(1),VFR(5),o[1],0,0,0), C0,12); \
    KRD(GL,2); GAPB(o[0]=__builtin_amdgcn_mfma_f32_32x32x16_bf16(PAF(2),VFR(2),o[0],0,0,0), C1,0); \
    KRD(GL,3); GAPB(o[1]=__builtin_amdgcn_mfma_f32_32x32x16_bf16(PAF(2),VFR(6),o[1],0,0,0), C1,4); \
    GAPB(o[0]=__builtin_amdgcn_mfma_f32_32x32x16_bf16(PAF(3),VFR(3),o[0],0,0,0), C1,8); \
    GAPB(o[1]=__builtin_amdgcn_mfma_f32_32x32x16_bf16(PAF(3),VFR(7),o[1],0,0,0), C1,12); \
    }while(0)
  int t=1;
  #undef CMASK
  #define CMASK(P0,P1,t) do{}while(0)
  for(;t+5<NT;t+=2){
    STEP(pB0,pB1,pA0,pA1,t,true,true,true);     WAIT_BAR(2); RESC(); ROT();
    STEP(pA0,pA1,pB0,pB1,t+1,true,true,true);   WAIT_BAR(2); RESC(); ROT();
  }
  #undef CMASK
  #define CMASK(P0,P1,t) do{int jb_=(t)-(NT-4); if(jb_>=0)cmask(P0,P1,jb_,qrel,hi);}while(0)
  #define ENDW(tt) do{ if((tt)+3<NT){WAIT_BAR(2);} else if((tt)+2<NT){WAIT_BAR(1);} else {WAIT_BAR(0);} }while(0)
  for(;t+1<NT;t+=2){
    STEP(pB0,pB1,pA0,pA1,t,(t+3<NT),(t+1<NT),(t+1<NT));       ENDW(t);   RESC(); ROT();
    STEP(pA0,pA1,pB0,pB1,t+1,(t+4<NT),(t+2<NT),(t+2<NT));     ENDW(t+1); RESC(); ROT();
  }
  STEP(pB0,pB1,pA0,pA1,NT-1,false,false,false); RESC();
  { float sacc=pB0[0]+pB0[1]; _Pragma("unroll") for(int r=2;r<16;++r)sacc+=pB0[r]; _Pragma("unroll") for(int r=0;r<16;++r)sacc+=pB1[r]; l_reg+=sacc;
    pw0=(u32x4){PKW(pB0,0),PKW(pB0,2),PKW(pB0,4),PKW(pB0,6)};pw1=(u32x4){PKW(pB0,8),PKW(pB0,10),PKW(pB0,12),PKW(pB0,14)};pw2=(u32x4){PKW(pB1,0),PKW(pB1,2),PKW(pB1,4),PKW(pB1,6)};pw3=(u32x4){PKW(pB1,8),PKW(pB1,10),PKW(pB1,12),PKW(pB1,14)};
    SBAR(); pv(o,vb0+sl_cur,PAF(0),PAF(1),PAF(2),PAF(3)); }
  #undef PKW
  #undef PAF
  #undef VFR
  #undef PIN
  #undef MX3
  #undef GAPA
  #undef GAPB
  #undef EX
  #undef VRD
  #undef KRD
  #undef STEP
  #undef ENDW
  {auto rr=__builtin_amdgcn_permlane32_swap(__float_as_uint(l_reg),__float_as_uint(l_reg),false,false);l_reg=__uint_as_float(rr[0])+__uint_as_float(rr[1]);}
  if(hi==0)wsf[32+r32]=l_reg;asm volatile("s_waitcnt lgkmcnt(0)":::"memory");
  float rli[16];
  #pragma unroll
  for(int r=0;r<16;++r)rli[r]=__builtin_amdgcn_rcpf(wsf[32+crow(r,hi)]);
  bf16*Ow=O+(rowbase+q0+wid*QBLK)*PO;
  { bf16*stg=(bf16*)(shm+LDS_OST)+wid*2048;
    #pragma unroll
    for(int r=0;r<16;++r){const int orow=crow(r,hi);
      #pragma unroll
      for(int d0=0;d0<2;++d0)stg[orow*64+d0*32+r32]=__float2bfloat16(o[d0][r]*rli[r]);}
    asm volatile("s_waitcnt lgkmcnt(0)":::"memory");
    #pragma unroll
    for(int i=0;i<4;++i){const int row=i*8+(lane>>3),ch=lane&7; const u32x4 v=*(const u32x4*)(stg+row*64+ch*8); ATTN_STORE16(Ow+(long)row*PO+ch*8,v);} }
  asm volatile("s_waitcnt lgkmcnt(0)\n\ts_barrier":::"memory");
  #undef DMA_K
  #undef DMA_V
  #undef CMASK
  #undef START
  #undef RESC
  #undef ROT
}
#undef SBAR
#undef WAIT_BAR
}
namespace cg = cooperative_groups;
#define LAS __attribute__((address_space(3)))
typedef unsigned short bf16;
typedef unsigned v4u __attribute__((ext_vector_type(4)));
typedef unsigned v2u __attribute__((ext_vector_type(2)));
typedef float f32x4 __attribute__((ext_vector_type(4)));
typedef float f32x2 __attribute__((ext_vector_type(2)));
typedef float f32x16 __attribute__((ext_vector_type(16)));
typedef short bf16x8 __attribute__((ext_vector_type(8)));

constexpr int NWAVES = 8;
constexpr int D = 1024, MP = 16384, MS = 256, M = MP + MS, FF = 2816, DIN = 2560;
constexpr float EPS = 1e-6f;
constexpr float C2 = 0.125f * 1.4426950408889634f;
constexpr size_t OFF_Y = 0, OFF_KP = 17039360, OFF_VP = 33816576, OFF_PP = 50593792, OFF_CP = 50655232, OFF_KS = 50663424, OFF_VS = 50925568, OFF_PS = 51187712, OFF_CS = 51249152, OUT_TOTAL = 51257344;
constexpr size_t MiB = 1u << 20;
constexpr size_t WS_ROPE = 1 * MiB, WS_POOLWT = 2 * MiB, WS_W = 4 * MiB, WL = 40 * MiB;
constexpr size_t W_GU1 = 0, W_D1 = 11 * MiB, W_IN = 16 * MiB + MiB / 2, W_OUT = 21 * MiB + MiB / 2, W_GU2 = 23 * MiB + MiB / 2, W_D2 = 34 * MiB + MiB / 2;
constexpr size_t WS_X = 84 * MiB, WS_H = 149 * MiB, WS_MIX = 182 * MiB, WS_ACT = 215 * MiB;
constexpr size_t WS_QB = 215 * MiB, WS_KB = 232 * MiB, WS_VB = 249 * MiB, WS_ZB = 266 * MiB;
constexpr size_t WS_OB = 305 * MiB, WS_OPART = 338 * MiB, WS_ML = 347 * MiB, WS_END = 348 * MiB;
static_assert(WS_ROPE == pg8::WOFF_ROPE && WS_QB == pg8::WOFF_QB && WS_KB == pg8::WOFF_KB && WS_VB == pg8::WOFF_VB && WS_ZB == pg8::WOFF_ZB && OFF_KP == pg8::OOFF_KP && OFF_VP == pg8::OOFF_VP && OFF_PP == pg8::OOFF_PP && OFF_KS == pg8::OOFF_KS && OFF_VS == pg8::OOFF_VS && OFF_PS == pg8::OOFF_PS, "offsets");
static_assert(WS_ACT + (size_t)M * FF * 2 <= WS_OB && WS_ZB + (size_t)M * 1024 * 2 <= WS_OB && WS_X + (size_t)M * D * 4 <= WS_H && WS_H + (size_t)M * D * 2 <= WS_MIX && WS_MIX + (size_t)M * D * 2 <= WS_ACT, "ws map");
static_assert(WS_OB + (size_t)M * 1024 * 2 <= WS_OPART && WS_OPART + (size_t)32 * 2 * 9 * 32 * 128 * 4 <= WS_ML && WS_ML + (size_t)32 * 2 * 9 * 32 * 2 * 4 <= WS_END, "ws map 2");
constexpr int LDS_BYTES = 147456;

__device__ __forceinline__ unsigned pk2(float lo, float hi) { f32x2 v = {lo, hi}; typedef __bf16 b2 __attribute__((ext_vector_type(2))); b2 b = __builtin_convertvector(v, b2); return __builtin_bit_cast(unsigned, b); }
__device__ __forceinline__ float bf2f(unsigned short b) { return __builtin_bit_cast(float, (unsigned)b << 16); }
__device__ __forceinline__ bf16x8 pack8(f32x4 a, f32x4 b) { v4u w; w.x = pk2(a.x, a.y); w.y = pk2(a.z, a.w); w.z = pk2(b.x, b.y); w.w = pk2(b.z, b.w); return __builtin_bit_cast(bf16x8, w); }
__device__ __forceinline__ int crow(int r, int hi) { return (r & 3) + 8 * (r >> 2) + 4 * hi; }
__device__ __forceinline__ void xhalf_pair(float m, float& a, float& b) { a = m; b = m; asm volatile("s_nop 1\n\tv_permlane32_swap_b32 %0, %1\n\ts_nop 1" : "+v"(a), "+v"(b)); }
__device__ __forceinline__ float xhalf_max(float m) { float a, b; xhalf_pair(m, a, b); return fmaxf(a, b); }
__device__ __forceinline__ float xhalf_sum(float m) { float a, b; xhalf_pair(m, a, b); return a + b; }
template <int O> __device__ __forceinline__ float swz_xor(float v) { return __builtin_bit_cast(float, __builtin_amdgcn_ds_swizzle(__builtin_bit_cast(int, v), (O << 10) | 0x1f)); }
__device__ __forceinline__ float wave_sum(float v) {
    v += swz_xor<1>(v); v += swz_xor<2>(v); v += swz_xor<4>(v); v += swz_xor<8>(v); v += swz_xor<16>(v);
    return xhalf_sum(v);
}
#define LDS_WAIT() asm volatile("s_waitcnt lgkmcnt(0)" ::: "memory")

struct Params { const float* in[26]; float* out; unsigned char* ws; };
typedef const __attribute__((address_space(4))) unsigned char* karg_ptr;
__device__ __forceinline__ karg_ptr kargs() { karg_ptr k = (karg_ptr)__builtin_amdgcn_kernarg_segment_ptr(); asm volatile("" : "+s"(k)); return k; }
__device__ __forceinline__ const float* KIN(int i) { return *(const float* const __attribute__((address_space(4)))*)(kargs() + 8 * i); }
__device__ __forceinline__ float* KOUT() { return *(float* const __attribute__((address_space(4)))*)(kargs() + 8 * 26); }
__device__ __forceinline__ unsigned char* KWS() { return *(unsigned char* const __attribute__((address_space(4)))*)(kargs() + 8 * 27); }

template <int MODE> __device__ __forceinline__ int wmap(int nl, int row_off) {
    if (MODE == 0) return row_off + nl;
    if (MODE == 1) return (nl >> 7) * 256 + (nl & 127) + row_off;
    const int u = nl >> 8, lc = nl & 255, A = lc >> 6, n = (lc >> 5) & 1, B = (lc >> 4) & 1, f = lc & 15;
    return u * 256 + 128 * (A >> 1) + 32 * (2 * (A & 1) + B) + 16 * n + f;
}
template <int MODE> __device__ __forceinline__ void transpose_item(const float* W, int K, int N, bf16* WT, int row_off, LAS float* scr, int item, int lane) {
    const int nblk = N / 32, kb = item / nblk, nb = item % nblk, k0 = 64 * kb, n0 = 32 * nb;
#pragma unroll 8
    for (int i = 0; i < 32; ++i) { const int kk = 2 * i + (lane >> 5); scr[kk * 33 + (lane & 31)] = W[(size_t)(k0 + kk) * N + n0 + (lane & 31)]; }
    LDS_WAIT(); asm volatile("" ::: "memory");
    const int c = lane & 7;
#pragma unroll
    for (int j = 0; j < 4; ++j) { const int n = (lane >> 3) + 8 * j; const LAS float* s = scr + (8 * c) * 33 + n;
        v4u o; o.x = pk2(s[0 * 33], s[1 * 33]); o.y = pk2(s[2 * 33], s[3 * 33]); o.z = pk2(s[4 * 33], s[5 * 33]); o.w = pk2(s[6 * 33], s[7 * 33]);
        *(v4u*)(WT + (size_t)wmap<MODE>(n0 + n, row_off) * K + k0 + 8 * c) = o; }
    LDS_WAIT(); asm volatile("" ::: "memory");
}
__device__ __forceinline__ void prologue(LAS unsigned char* lds, int gw, int NGW, int wave, int lane) {
    LAS float* scr = (LAS float*)(lds + wave * 16384);
    constexpr int I_F = 16 * 88, I_IN = 16 * 80, I_OUT = 16 * 32, I_L = 6 * I_F + I_IN + I_OUT;
    for (int it = gw; it < 2 * I_L; it += NGW) {
        const int l = it / I_L; int r = it % I_L;
        unsigned char* wl = KWS() + WS_W + (size_t)l * WL;
        if (r < I_F) { transpose_item<1>(KIN(7) + (size_t)l * D * FF, D, FF, (bf16*)(wl + W_GU1), 0, scr, r, lane); continue; } r -= I_F;
        if (r < I_F) { transpose_item<1>(KIN(8) + (size_t)l * D * FF, D, FF, (bf16*)(wl + W_GU1), 128, scr, r, lane); continue; } r -= I_F;
        if (r < I_F) { transpose_item<0>(KIN(9) + (size_t)l * D * FF, FF, D, (bf16*)(wl + W_D1), 0, scr, r, lane); continue; } r -= I_F;
        if (r < I_IN) { transpose_item<2>(KIN(11) + (size_t)l * D * DIN, D, DIN, (bf16*)(wl + W_IN), 0, scr, r, lane); continue; } r -= I_IN;
        if (r < I_OUT) { transpose_item<0>(KIN(20) + (size_t)l * D * D, D, D, (bf16*)(wl + W_OUT), 0, scr, r, lane); continue; } r -= I_OUT;
        if (r < I_F) { transpose_item<1>(KIN(22) + (size_t)l * D * FF, D, FF, (bf16*)(wl + W_GU2), 0, scr, r, lane); continue; } r -= I_F;
        if (r < I_F) { transpose_item<1>(KIN(23) + (size_t)l * D * FF, D, FF, (bf16*)(wl + W_GU2), 128, scr, r, lane); continue; } r -= I_F;
        transpose_item<0>(KIN(24) + (size_t)l * D * FF, FF, D, (bf16*)(wl + W_D2), 0, scr, r, lane);
    }
    float* rope = (float*)(KWS() + WS_ROPE);
    for (int i = gw * 64 + lane; i < 2080 * 32; i += NGW * 64) {
        const int pr = i >> 5, d = i & 31; const int pos = pr < 2048 ? pr : 4096 + (pr - 2048);
        const float inv = exp2f(-(float)d * (13.287712379549449f / 32.0f));
        const float ang = (float)pos * inv;
        const double rev = (double)ang * 0.15915494309189535; const float fr = (float)(rev - __builtin_rint(rev));
        rope[pr * 64 + d] = __builtin_amdgcn_cosf(fr); rope[pr * 64 + 32 + d] = __builtin_amdgcn_sinf(fr);
    }
    bf16* pwt_ = (bf16*)(KWS() + WS_POOLWT);
    for (int i = gw * 64 + lane; i < 2 * 4 * 64 * 64; i += NGW * 64) {
        const int c = i & 63, e = (i >> 6) & 63, lg = i >> 12;
        pwt_[i] = (bf16)(pk2(KIN(17)[(size_t)lg * 4096 + c * 64 + e], 0.f) & 0xffffu);
    }
}
template <bool FINAL> __device__ __forceinline__ void norm_rows(const float* srcP, const float* srcS, const float* g, bf16* H, float* outf, int gw, int NGW, int lane) {
    const f32x4* g4 = (const f32x4*)g + lane;
    f32x4 gv[4];
#pragma unroll
    for (int j = 0; j < 4; ++j) gv[j] = g4[64 * j];
    for (int m = gw; m < M; m += NGW) {
        const float* xr = (m < MP) ? srcP + (size_t)m * D : srcS + (size_t)(m - MP) * D;
        const f32x4* x4 = (const f32x4*)xr + lane;
        f32x4 v[4]; float s = 0.f;
#pragma unroll
        for (int j = 0; j < 4; ++j) { v[j] = x4[64 * j]; s += (v[j].x * v[j].x + v[j].y * v[j].y) + (v[j].z * v[j].z + v[j].w * v[j].w); }
        const float rstd = 1.0f / sqrtf(wave_sum(s) * (1.0f / D) + EPS);
        if (FINAL) {
            f32x4* o4 = (f32x4*)(outf + (size_t)m * D) + lane;
#pragma unroll
            for (int j = 0; j < 4; ++j) o4[64 * j] = v[j] * rstd * gv[j];
        } else {
            v2u* o2 = (v2u*)(H + (size_t)m * D) + lane;
#pragma unroll
            for (int j = 0; j < 4; ++j) { const f32x4 y = v[j] * rstd * gv[j]; v2u w; w.x = pk2(y.x, y.y); w.y = pk2(y.z, y.w); o2[64 * j] = w; }
        }
    }
}
__device__ __forceinline__ f32x16 mfma32(bf16x8 a, bf16x8 b, f32x16 c) { return __builtin_amdgcn_mfma_f32_32x32x16_bf16(a, b, c, 0, 0, 0); }

__device__ __forceinline__ void sample_piece(LAS unsigned char* lds, int pc, int l, const bf16* Qb, const float* cache_k, const float* cache_v, const float* knew, const float* vnew, float* OPART, float* MLP, int tid) {
    const int lane = tid & 63, r32 = lane & 31, hi = lane >> 5, wid = __builtin_amdgcn_readfirstlane(tid >> 6);
    const int b = pc >> 5, h = (pc >> 3) & 3, s = pc & 7;
    const bf16* qrow = Qb + (size_t)(MP + b * 32 + r32) * 512 + h * 128 + hi * 8;
    LAS float* ML = (LAS float*)lds;
    LAS float* FAC = (LAS float*)(lds + 4096);
    LAS float* OX = (LAS float*)(lds + 8192);
    const int nrounds = (s == 7) ? 2 : 1;
    for (int rd = 0; rd < nrounds; ++rd) {
        const float *Kt, *Vt; int nvalid;
        if (rd == 0) { const size_t off = ((size_t)((l * 8 + b) * 4096 + (s * 8 + wid) * 64)) * 512 + h * 128; Kt = cache_k + off; Vt = cache_v + off; nvalid = 64; }
        else { const size_t off = ((size_t)(l * 8 + b) * 32) * 512 + h * 128; Kt = knew + off; Vt = vnew + off; nvalid = (wid == 0) ? 32 : 0; }
        float mrow[2], lrow[2]; bf16x8 pw[2][4];
#pragma unroll
        for (int c = 0; c < 2; ++c) { mrow[c] = -1e30f; lrow[c] = 0.f;
#pragma unroll
            for (int k = 0; k < 4; ++k) pw[c][k] = (bf16x8){0, 0, 0, 0, 0, 0, 0, 0}; }
        if (nvalid > 0) {
#pragma unroll
            for (int c = 0; c < 2; ++c) {
                bf16x8 qf[4];
#pragma unroll
                for (int d0 = 0; d0 < 4; ++d0) qf[d0] = *(const bf16x8*)(qrow + c * 64 + d0 * 16);
                f32x16 sc[2];
#pragma unroll
                for (int kvb = 0; kvb < 2; ++kvb) {
                    if (kvb * 32 < nvalid) {
                        f32x16 a;
#pragma unroll
                        for (int r = 0; r < 16; ++r) a[r] = 0.f;
                        const float* kp = Kt + (size_t)(kvb * 32 + r32) * 512 + c * 64 + hi * 8;
#pragma unroll
                        for (int d0 = 0; d0 < 4; ++d0) { const f32x4 x0 = *(const f32x4*)(kp + d0 * 16), x1 = *(const f32x4*)(kp + d0 * 16 + 4); a = mfma32(pack8(x0, x1), qf[d0], a); }
                        sc[kvb] = a;
                    } else {
#pragma unroll
                        for (int r = 0; r < 16; ++r) sc[kvb][r] = -1e30f;
                    }
                }
                float mx = -1e30f;
#pragma unroll
                for (int r = 0; r < 16; ++r) mx = fmaxf(mx, fmaxf(sc[0][r], sc[1][r]));
                mx = xhalf_max(mx);
                float sum = 0.f;
#pragma unroll
                for (int kvb = 0; kvb < 2; ++kvb)
#pragma unroll
                    for (int r = 0; r < 16; ++r) { const float pv = __builtin_amdgcn_exp2f(sc[kvb][r] - mx); sc[kvb][r] = pv; sum += pv; }
                sum = xhalf_sum(sum);
                mrow[c] = mx; lrow[c] = sum;
#pragma unroll
                for (int kvb = 0; kvb < 2; ++kvb)
#pragma unroll
                    for (int hf = 0; hf < 2; ++hf) { v4u w; w.x = pk2(sc[kvb][8 * hf + 0], sc[kvb][8 * hf + 1]); w.y = pk2(sc[kvb][8 * hf + 2], sc[kvb][8 * hf + 3]);
                        w.z = pk2(sc[kvb][8 * hf + 4], sc[kvb][8 * hf + 5]); w.w = pk2(sc[kvb][8 * hf + 6], sc[kvb][8 * hf + 7]); pw[c][2 * kvb + hf] = __builtin_bit_cast(bf16x8, w); }
            }
        }
        asm volatile("" ::: "memory");
        f32x16 o[2][4];
#pragma unroll
        for (int c = 0; c < 2; ++c)
#pragma unroll
            for (int eb = 0; eb < 4; ++eb)
#pragma unroll
                for (int r = 0; r < 16; ++r) o[c][eb][r] = 0.f;
        if (nvalid > 0) {
#pragma unroll
            for (int ks = 0; ks < 4; ++ks) {
                if (ks * 16 < nvalid) {
#pragma unroll
                    for (int eb = 0; eb < 4; ++eb) {
                        const float* vp = Vt + (size_t)(ks * 16 + 4 * hi) * 512 + eb * 32 + r32;
                        f32x4 x0, x1;
                        x0.x = vp[0 * 512]; x0.y = vp[1 * 512]; x0.z = vp[2 * 512]; x0.w = vp[3 * 512];
                        x1.x = vp[8 * 512]; x1.y = vp[9 * 512]; x1.z = vp[10 * 512]; x1.w = vp[11 * 512];
                        const bf16x8 vf = pack8(x0, x1);
                        o[0][eb] = mfma32(pw[0][ks], vf, o[0][eb]); o[1][eb] = mfma32(pw[1][ks], vf, o[1][eb]);
                    }
                }
            }
        }
        if (hi == 0) {
#pragma unroll
            for (int c = 0; c < 2; ++c) { ML[((wid * 2 + c) * 32 + r32) * 2 + 0] = mrow[c]; ML[((wid * 2 + c) * 32 + r32) * 2 + 1] = lrow[c]; }
        }
        __syncthreads();
        const int pidx = (rd == 0) ? s : 8;
        if (tid < 64) {
            const int c = tid >> 5, q = tid & 31; float mw[8], lw[8]; float Mx = -1e30f;
#pragma unroll
            for (int w = 0; w < 8; ++w) { mw[w] = ML[((w * 2 + c) * 32 + q) * 2 + 0]; lw[w] = ML[((w * 2 + c) * 32 + q) * 2 + 1]; Mx = fmaxf(Mx, mw[w]); }
            float L = 0.f;
#pragma unroll
            for (int w = 0; w < 8; ++w) { const float f = __builtin_amdgcn_exp2f(mw[w] - Mx); FAC[(w * 2 + c) * 32 + q] = f; L += lw[w] * f; }
            float* mp = MLP + ((size_t)((((b * 4 + h) * 2 + c) * 9 + pidx) * 32 + q)) * 2; mp[0] = Mx; mp[1] = L;
        }
        __syncthreads();
#pragma unroll
        for (int c = 0; c < 2; ++c) {
#pragma unroll
            for (int eb = 0; eb < 4; ++eb)
#pragma unroll
                for (int r = 0; r < 16; ++r) { const int q = crow(r, hi); OX[(wid * 32 + q) * 128 + eb * 32 + r32] = o[c][eb][r] * FAC[(wid * 2 + c) * 32 + q]; }
            __syncthreads();
            { const int idx = tid * 8, q = idx >> 7, e = idx & 127; f32x4 s0 = {0.f, 0.f, 0.f, 0.f}, s1 = {0.f, 0.f, 0.f, 0.f};
#pragma unroll
              for (int w = 0; w < 8; ++w) { s0 += *(const LAS f32x4*)(OX + (w * 32 + q) * 128 + e); s1 += *(const LAS f32x4*)(OX + (w * 32 + q) * 128 + e + 4); }
              float* dst = OPART + ((size_t)((((b * 4 + h) * 2 + c) * 9 + pidx) * 32 + q)) * 128 + e; *(f32x4*)dst = s0; *(f32x4*)(dst + 4) = s1; }
            __syncthreads();
        }
    }
}

__device__ __forceinline__ void poolconv_tile(LAS unsigned char* lds, int tl, int l, const bf16* Zb, bf16* MIX, const float* state_pool, const float* state_conv, const bf16* pwt, const float* pool_scale,
                                              const float* conv_w, float* out_cp, float* out_cs, int tid) {
    const int lane = tid & 63, r32 = lane & 31, hi = lane >> 5, wid = __builtin_amdgcn_readfirstlane(tid >> 6);
    int b, t0, TT, rowbase; bool smp;
    if (tl < 256) { b = tl >> 5; t0 = (tl & 31) * 64; TT = 64; rowbase = b * 2048 + t0; smp = false; }
    else { b = tl - 256; t0 = 0; TT = 32; rowbase = MP + b * 32; smp = true; }
    LAS float* U = (LAS float*)lds;
    LAS bf16* Dd = (LAS bf16*)(lds + 81920);
    for (int idx = tid; idx < (15 + TT) * 64; idx += 512) {
        const int i = idx >> 6, c4 = (idx & 63) * 4; f32x4 v = {0.f, 0.f, 0.f, 0.f};
        bool fromz = true; int zr = rowbase + i - 15;
        if (i < 15) { if (smp) { v = *(const f32x4*)(state_pool + (size_t)((l * 8 + b) * 15 + i) * 256 + c4); fromz = false; } else if (t0 - 15 + i < 0) fromz = false; }
        if (fromz) { const v2u w = *(const v2u*)(Zb + (size_t)zr * 1024 + c4); v.x = bf2f(w.x & 0xffff); v.y = bf2f(w.x >> 16); v.z = bf2f(w.y & 0xffff); v.w = bf2f(w.y >> 16); }
        *(LAS f32x4*)(U + i * 256 + c4) = v;
    }
    __syncthreads();
    {
        const int ch = tid & 255, th = tid >> 8, gi = ch >> 6, w = 2 << gi;
        if (th * 32 < TT) {
            for (int tt = th * 32; tt < th * 32 + 32; ++tt) {
                float s = 0.f;
                for (int i = 0; i < w; ++i) s += U[(15 + tt - i) * 256 + ch];
                const int pos = smp ? 4096 + tt : t0 + tt; const int cnt = (pos + 1 < w) ? pos + 1 : w;
                const float d = s / (float)cnt - U[(15 + tt) * 256 + ch];
                Dd[tt * 264 + ch] = (bf16)(pk2(d, 0.f) & 0xffffu);
            }
        }
    }
    __syncthreads();
    {
        const int gi = wid >> 1, th = wid & 1;
        if (th * 32 < TT) {
            f32x16 acc0, acc1;
#pragma unroll
            for (int r = 0; r < 16; ++r) { acc0[r] = 0.f; acc1[r] = 0.f; }
#pragma unroll
            for (int ks = 0; ks < 4; ++ks) {
                const bf16x8 a = *(const LAS bf16x8*)(Dd + (th * 32 + r32) * 264 + gi * 64 + ks * 16 + hi * 8);
                const bf16x8 b0 = *(const bf16x8*)(pwt + (size_t)((l * 4 + gi) * 64 + r32) * 64 + ks * 16 + hi * 8);
                const bf16x8 b1 = *(const bf16x8*)(pwt + (size_t)((l * 4 + gi) * 64 + 32 + r32) * 64 + ks * 16 + hi * 8);
                acc0 = mfma32(a, b0, acc0); acc1 = mfma32(a, b1, acc1);
            }
            const float sc0 = pool_scale[l * 256 + gi * 64 + r32], sc1 = pool_scale[l * 256 + gi * 64 + 32 + r32];
#pragma unroll
            for (int r = 0; r < 16; ++r) { const int tok = th * 32 + crow(r, hi); bf16* mp = MIX + (size_t)(rowbase + tok) * 1024 + 512 + gi * 64 + r32;
                mp[0] = (bf16)(pk2(acc0[r] * sc0, 0.f) & 0xffffu); mp[32] = (bf16)(pk2(acc1[r] * sc1, 0.f) & 0xffffu); }
        }
    }
    {
        const int ch = tid & 255, th = tid >> 8, ts = th * 32;
        if (ts < TT) {
            const float w0 = conv_w[l * 768 + ch], w1 = conv_w[l * 768 + 256 + ch], w2 = conv_w[l * 768 + 512 + ch];
            float cm[2];
#pragma unroll
            for (int k = 0; k < 2; ++k) {
                const int tt = ts - 2 + k; float v = 0.f;
                if (tt < 0 && smp) v = state_conv[(size_t)((l * 8 + b) * 2 + (2 + tt)) * 256 + ch];
                else if (t0 + tt >= 0) { const bf16* zr = Zb + (size_t)(rowbase + tt) * 1024; v = bf2f(zr[768 + ch]) * bf2f(zr[256 + ch]); }
                cm[k] = v;
            }
            float cm2 = cm[0], cm1 = cm[1];
            for (int tt = ts; tt < ts + 32; ++tt) {
                const bf16* zr = Zb + (size_t)(rowbase + tt) * 1024;
                const float cv = bf2f(zr[768 + ch]) * bf2f(zr[256 + ch]), bg = bf2f(zr[512 + ch]);
                const float y = bg * (w0 * cm2 + w1 * cm1 + w2 * cv);
                MIX[(size_t)(rowbase + tt) * 1024 + 768 + ch] = (bf16)(pk2(y, 0.f) & 0xffffu);
                if (smp) { if (tt >= 30) out_cs[(size_t)((l * 8 + b) * 2 + tt - 30) * 256 + ch] = cv; }
                else if (t0 + tt >= 2046) out_cp[(size_t)((l * 8 + b) * 2 + t0 + tt - 2046) * 256 + ch] = cv;
                cm2 = cm1; cm1 = cv;
            }
        }
    }
    __syncthreads();
}

__device__ __forceinline__ void combine_phase(int l, const bf16* Ob_, const float* OPART_, const float* MLP_, bf16* MIX_, int gw, int NGW, int lane) {
    const float lam_init = (l == 0) ? 0.2f : 0.35550934f;
    float lam;
    { const float a = KIN(12)[l * 64 + lane] * KIN(13)[l * 64 + lane], c = KIN(14)[l * 64 + lane] * KIN(15)[l * 64 + lane];
      lam = __expf(wave_sum(a)) - __expf(wave_sum(c)) + lam_init; }
    const float g0 = KIN(16)[l * 128 + 2 * lane], g1 = KIN(16)[l * 128 + 2 * lane + 1];
    for (int wt = gw; wt < M * 4; wt += NGW) {
        const int row = wt >> 2, h = wt & 3; float a0, a1;
        if (row < MP) {
            const unsigned w1 = *(const unsigned*)(Ob_ + (size_t)row * 1024 + h * 128 + 2 * lane), w2 = *(const unsigned*)(Ob_ + (size_t)row * 1024 + 512 + h * 128 + 2 * lane);
            a0 = bf2f(w1 & 0xffff) - lam * bf2f(w2 & 0xffff); a1 = bf2f(w1 >> 16) - lam * bf2f(w2 >> 16);
        } else {
            const int rs = row - MP, b = rs >> 5, q = rs & 31; float oc[2][2];
#pragma unroll
            for (int c = 0; c < 2; ++c) {
                const size_t base = (size_t)(((b * 4 + h) * 2 + c) * 9);
                float mw[9], lw[9]; float Mx = -1e30f;
#pragma unroll
                for (int pi = 0; pi < 9; ++pi) { const f32x2 ml = *(const f32x2*)(MLP_ + ((base + pi) * 32 + q) * 2); mw[pi] = ml.x; lw[pi] = ml.y; Mx = fmaxf(Mx, ml.x); }
                float L = 0.f, s0 = 0.f, s1 = 0.f;
#pragma unroll
                for (int pi = 0; pi < 9; ++pi) { const float f = __builtin_amdgcn_exp2f(mw[pi] - Mx); L += lw[pi] * f; const f32x2 ov = *(const f32x2*)(OPART_ + ((base + pi) * 32 + q) * 128 + 2 * lane); s0 += ov.x * f; s1 += ov.y * f; }
                const float il = 1.0f / L; oc[c][0] = s0 * il; oc[c][1] = s1 * il;
            }
            a0 = oc[0][0] - lam * oc[1][0]; a1 = oc[0][1] - lam * oc[1][1];
        }
        const float ss = wave_sum(a0 * a0 + a1 * a1);
        const float r = (1.0f / sqrtf(ss * (1.0f / 128.0f) + EPS)) * (1.0f - lam_init);
        *(unsigned*)(MIX_ + (size_t)row * 1024 + h * 128 + 2 * lane) = pk2(a0 * r * g0, a1 * r * g1);
    }
}


#ifndef PROBE_SLOW_ATTN
#define PROBE_SLOW_ATTN 0
#endif
#if PROBE_SLOW_ATTN
__device__ __forceinline__ void slow_attn_phase(int l, const bf16* Qb_, float* outp, const float* cache_k, const float* cache_v, bf16* MIX_, int gw, int NGW, int lane) {
    const float lam_init = (l == 0) ? 0.2f : 0.35550934f;
    float lam;
    { const float a = KIN(12)[l * 64 + lane] * KIN(13)[l * 64 + lane], c = KIN(14)[l * 64 + lane] * KIN(15)[l * 64 + lane];
      lam = __expf(wave_sum(a)) - __expf(wave_sum(c)) + lam_init; }
    const float g0 = KIN(16)[l * 128 + 2 * lane], g1 = KIN(16)[l * 128 + 2 * lane + 1];
    for (int wt = gw; wt < M * 4; wt += NGW) {
        const int row = wt >> 2, h = wt & 3;
        const float *K0, *V0, *K1, *V1; int n0, n1;
        if (row < MP) { const int b = row >> 11, t = row & 2047; K0 = outp + OFF_KP + ((size_t)l * MP + (size_t)b * 2048) * 512 + h * 128; V0 = outp + OFF_VP + ((size_t)l * MP + (size_t)b * 2048) * 512 + h * 128; n0 = ((t >> 6) + 1) * 64; K1 = K0; V1 = V0; n1 = 0; }
        else { const int rs = row - MP, b = rs >> 5; K0 = cache_k + ((size_t)(l * 8 + b) * 4096) * 512 + h * 128; V0 = cache_v + ((size_t)(l * 8 + b) * 4096) * 512 + h * 128; n0 = 4096;
               K1 = outp + OFF_KS + ((size_t)(l * 8 + b) * 32) * 512 + h * 128; V1 = outp + OFF_VS + ((size_t)(l * 8 + b) * 32) * 512 + h * 128; n1 = 32; }
        float oc[2][2];
#pragma unroll 1
        for (int c = 0; c < 2; ++c) {
            float q[64];
#pragma unroll
            for (int d = 0; d < 64; ++d) q[d] = bf2f(Qb_[(size_t)row * 512 + h * 128 + c * 64 + d]);
            float mx = -1e30f;
            for (int seg = 0; seg < 2; ++seg) { const float* Kp = seg ? K1 : K0; const int n = seg ? n1 : n0;
                for (int j0 = 0; j0 < n; j0 += 64) { const int j = j0 + lane; float s = -1e30f;
                    if (j < n) { const float* kr = Kp + (size_t)j * 512 + c * 64; s = 0.f;
#pragma unroll
                        for (int d = 0; d < 64; ++d) s += q[d] * kr[d]; }
                    mx = fmaxf(mx, s); } }
            mx = fmaxf(mx, swz_xor<1>(mx)); mx = fmaxf(mx, swz_xor<2>(mx)); mx = fmaxf(mx, swz_xor<4>(mx)); mx = fmaxf(mx, swz_xor<8>(mx)); mx = fmaxf(mx, swz_xor<16>(mx)); mx = xhalf_max(mx);
            float L = 0.f, o0 = 0.f, o1 = 0.f;
            for (int seg = 0; seg < 2; ++seg) { const float* Kp = seg ? K1 : K0; const float* Vp = seg ? V1 : V0; const int n = seg ? n1 : n0;
                for (int j0 = 0; j0 < n; j0 += 64) { const int j = j0 + lane; float pj = 0.f;
                    if (j < n) { const float* kr = Kp + (size_t)j * 512 + c * 64; float s = 0.f;
#pragma unroll
                        for (int d = 0; d < 64; ++d) s += q[d] * kr[d];
                        pj = __builtin_amdgcn_exp2f(s - mx); }
                    L += pj;
                    const int nn = (n - j0 < 64) ? n - j0 : 64;
                    for (int jj = 0; jj < nn; ++jj) { const float pb = __builtin_bit_cast(float, __builtin_amdgcn_readlane(__builtin_bit_cast(int, pj), jj));
                        const f32x2 vv = *(const f32x2*)(Vp + (size_t)(j0 + jj) * 512 + 2 * lane); o0 += pb * vv.x; o1 += pb * vv.y; } } }
            L = wave_sum(L);
            oc[c][0] = o0 / L; oc[c][1] = o1 / L;
        }
        const float a0 = oc[0][0] - lam * oc[1][0], a1 = oc[0][1] - lam * oc[1][1];
        const float ss = wave_sum(a0 * a0 + a1 * a1);
        const float r = (1.0f / sqrtf(ss * (1.0f / 128.0f) + EPS)) * (1.0f - lam_init);
        *(unsigned*)(MIX_ + (size_t)row * 1024 + h * 128 + 2 * lane) = pk2(a0 * r * g0, a1 * r * g1);
    }
}
#endif

#ifndef PROBE_SLOW_PC
#define PROBE_SLOW_PC 0
#endif
#if PROBE_SLOW_PC
__device__ __forceinline__ float zval(const bf16* Zb_, const float* st, int l, int b, bool smp, int rowbase, int t, int col, int hist) {
    if (t >= 0) return bf2f(Zb_[(size_t)(rowbase + t) * 1024 + col]);
    if (!smp) return 0.f;
    return st[(size_t)((l * 8 + b) * hist + (hist + t)) * 256 + (col & 255)];
}
__device__ __forceinline__ void slow_pc_phase(int l, const bf16* Zb_, bf16* MIX_, int gw, int NGW, int lane) {
    const float* sp = KIN(4); const float* scv = KIN(5); const float* pw = KIN(17); const float* psc = KIN(18); const float* cw = KIN(19);
    for (int wt = gw; wt < M * 4; wt += NGW) {
        const int row = wt >> 2, g = wt & 3; const bool smp = row >= MP;
        int b, t, rowbase; if (smp) { const int rs = row - MP; b = rs >> 5; t = rs & 31; rowbase = MP + b * 32; } else { b = row >> 11; t = row & 2047; rowbase = b * 2048; }
        const int w = 2 << g, ch = g * 64 + lane;
        float s = 0.f;
        for (int i = 0; i < w; ++i) { const int tt = t - i; s += zval(Zb_, sp, l, b, smp, rowbase, tt, ch, 15); }
        const int pos = smp ? 4096 + t : t; const int cnt = (pos + 1 < w) ? pos + 1 : w;
        const float d = s / (float)cnt - zval(Zb_, sp, l, b, smp, rowbase, t, ch, 15);
        float mine = 0.f;
        for (int e = 0; e < 64; ++e) { const float v = wave_sum(d * pw[(size_t)((l * 4 + g) * 64 + lane) * 64 + e]); if (e == lane) mine = v; }
        MIX_[(size_t)row * 1024 + 512 + ch] = (bf16)(pk2(mine * psc[l * 256 + ch], 0.f) & 0xffffu);
        float cvv[3];
#pragma unroll
        for (int k = 0; k < 3; ++k) { const int tt = t - 2 + k;
            if (tt >= 0) cvv[k] = bf2f(Zb_[(size_t)(rowbase + tt) * 1024 + 768 + ch]) * bf2f(Zb_[(size_t)(rowbase + tt) * 1024 + 256 + ch]);
            else cvv[k] = smp ? scv[(size_t)((l * 8 + b) * 2 + (2 + tt)) * 256 + ch] : 0.f; }
        const float bgv = bf2f(Zb_[(size_t)row * 1024 + 512 + ch]);
        const float y = bgv * (cw[l * 768 + ch] * cvv[0] + cw[l * 768 + 256 + ch] * cvv[1] + cw[l * 768 + 512 + ch] * cvv[2]);
        MIX_[(size_t)row * 1024 + 768 + ch] = (bf16)(pk2(y, 0.f) & 0xffffu);
    }
}
#endif
#define GRID_SYNC() do { asm volatile("s_waitcnt vmcnt(0) lgkmcnt(0)" ::: "memory"); grid.sync(); asm volatile("" ::: "memory"); } while (0)
__global__ void __launch_bounds__(NWAVES * 64, 2) mega_fwd(Params p) {
    extern __shared__ __attribute__((aligned(16))) unsigned char lds_raw[];
    LAS unsigned char* lds = (LAS unsigned char*)lds_raw;
    cg::grid_group grid = cg::this_grid();
    const int tid = threadIdx.x, lane = tid & 63, wave = __builtin_amdgcn_readfirstlane(tid >> 6);
    const int G = gridDim.x; const int bx = blockIdx.x; const int vcu0 = (G % 8 == 0) ? (bx % 8) * (G / 8) + bx / 8 : bx;
    const int NGW = G * NWAVES;
#define X ((float*)(ws + WS_X))
#define H ((bf16*)(ws + WS_H))
#define MIX ((bf16*)(ws + WS_MIX))
#define ACT ((bf16*)(ws + WS_ACT))
#define Qb ((bf16*)(ws + WS_QB))
#define Kb ((bf16*)(ws + WS_KB))
#define Vb ((bf16*)(ws + WS_VB))
#define Zb ((bf16*)(ws + WS_ZB))
#define Ob ((bf16*)(ws + WS_OB))
#define OPART ((float*)(ws + WS_OPART))
#define MLP ((float*)(ws + WS_ML))
#define pwt ((const bf16*)(ws + WS_POOLWT))
    { const int gw = vcu0 * NWAVES + wave; prologue(lds, gw, NGW, wave, lane); }
    GRID_SYNC();
#define FRESH_IDS() int tid = threadIdx.x; asm volatile("" : "+v"(tid)); const int lane = tid & 63, wave = __builtin_amdgcn_readfirstlane(tid >> 6); int vcu = vcu0; asm volatile("" : "+s"(vcu)); const int gw = vcu * NWAVES + wave; (void)lane; (void)gw; (void)wave
#pragma unroll 1
    for (int step = 0; step < 4; ++step) {
        const int l = step >> 1, f = step & 1;
        const bool first = (step == 0);
        { FRESH_IDS(); unsigned char* const ws = KWS();
          norm_rows<false>(first ? KIN(0) : X, first ? KIN(1) : X + (size_t)MP * D, (f ? KIN(21) : KIN(6)) + l * D, H, nullptr, gw, NGW, lane); }
        GRID_SYNC();
        { FRESH_IDS(); unsigned char* const ws = KWS(); unsigned char* const wl = ws + WS_W + (size_t)l * WL;
          pg8::Gemm g{H, (const bf16*)(wl + (f ? W_GU2 : W_GU1)), M, 2 * FF, D}; pg8::StaticOrder S; S.init(M, 2 * FF, G, bx);
          pg8::EpiSwiGLU E{ACT, FF};
          pg8::gemm_phase<pg8::EpiSwiGLU, pg8::StaticOrder, true, true>(lds, g, S, E); }
        GRID_SYNC();
        { FRESH_IDS(); unsigned char* const ws = KWS(); unsigned char* const wl = ws + WS_W + (size_t)l * WL;
          pg8::Gemm g{ACT, (const bf16*)(wl + (f ? W_D2 : W_D1)), M, D, FF}; pg8::StaticOrder S; S.init(M, D, G, bx);
          pg8::EpiResid E{first ? KIN(0) : X, first ? KIN(1) : X + (size_t)MP * D, X, 0.5f};
          pg8::gemm_phase<pg8::EpiResid, pg8::StaticOrder, true, true>(lds, g, S, E); }
        GRID_SYNC();
        if (f == 0) {
            { FRESH_IDS(); unsigned char* const ws = KWS();
              norm_rows<false>(X, X + (size_t)MP * D, KIN(10) + l * D, H, nullptr, gw, NGW, lane); }
            GRID_SYNC();
            { FRESH_IDS(); unsigned char* const ws = KWS(); unsigned char* const wl = ws + WS_W + (size_t)l * WL;
              pg8::Gemm g{H, (const bf16*)(wl + W_IN), M, DIN, D}; pg8::StaticOrder S; S.init(M, DIN, G, bx);
              pg8::EpiWin E{ws, KOUT(), l, C2};
              pg8::gemm_phase<pg8::EpiWin, pg8::StaticOrder, true, true>(lds, g, S, E); }
            GRID_SYNC();
#if !PROBE_SLOW_ATTN
            { FRESH_IDS(); unsigned char* const ws = KWS();
              for (int i = 0; i < 4; ++i) {
                const int L = i * G + vcu; if (L >= 1024) break;
                const int bh = (L & 255) >> 1, sI = L & 1, ii = L >> 8;
                const int qb = sI == 0 ? (ii == 0 ? 7 : ii == 1 ? 0 : ii == 2 ? 4 : 3) : (ii == 0 ? 6 : ii == 1 ? 1 : ii == 2 ? 5 : 2);
                const int b = bh >> 4, vh = bh & 15, hh = vh >> 2, c = (vh >> 1) & 1, hf = vh & 1;
                attn_body::attn_unit<8>(b, qb, (const attn_body::bf16*)(Qb + (hh * 2 + c) * 64), (const attn_body::bf16*)(Kb + (hh * 2 + c) * 64), (const attn_body::bf16*)(Vb + hh * 128 + hf * 64),
                                        (attn_body::bf16*)(Ob + c * 512 + hh * 128 + hf * 64), (char*)lds_raw);
              } }
            __syncthreads();
            { FRESH_IDS(); unsigned char* const ws = KWS(); float* const outp = KOUT();
              for (int pc = vcu; pc < 256; pc += G)
                sample_piece(lds, pc, l, Qb, KIN(2), KIN(3), outp + OFF_KS, outp + OFF_VS, OPART, MLP, tid); }
            __syncthreads();
#endif
            { FRESH_IDS(); unsigned char* const ws = KWS(); float* const outp = KOUT();
              for (int tl = vcu; tl < 264; tl += G)
                poolconv_tile(lds, tl, l, Zb, MIX, KIN(4), KIN(5), pwt, KIN(18), KIN(19), outp + OFF_CP, outp + OFF_CS, tid); }
            GRID_SYNC();
#if PROBE_SLOW_PC
            { FRESH_IDS(); unsigned char* const ws = KWS();
              slow_pc_phase(l, Zb, MIX, gw, NGW, lane); }
#endif
#if PROBE_SLOW_ATTN
            { FRESH_IDS(); unsigned char* const ws = KWS();
              slow_attn_phase(l, Qb, KOUT(), KIN(2), KIN(3), MIX, gw, NGW, lane); }
#else
            { FRESH_IDS(); unsigned char* const ws = KWS();
              combine_phase(l, Ob, OPART, MLP, MIX, gw, NGW, lane); }
#endif
            GRID_SYNC();
            { FRESH_IDS(); unsigned char* const ws = KWS(); unsigned char* const wl = ws + WS_W + (size_t)l * WL;
              pg8::Gemm g{MIX, (const bf16*)(wl + W_OUT), M, D, D}; pg8::StaticOrder S; S.init(M, D, G, bx);
              pg8::EpiResid E{X, X + (size_t)MP * D, X, 1.0f};
              pg8::gemm_phase<pg8::EpiResid, pg8::StaticOrder, true, true>(lds, g, S, E); }
            GRID_SYNC();
        }
    }
    { FRESH_IDS(); unsigned char* const ws = KWS();
      norm_rows<true>(X, X + (size_t)MP * D, KIN(25), nullptr, KOUT() + OFF_Y, gw, NGW, lane); }
}

extern "C" void kernel_launch(void* const* d_in, const int* in_sizes, int n_in, void* d_out, int out_size, void* d_ws, size_t ws_size, hipStream_t stream) {
    static int grid = 0;
    if (grid == 0) {
        if (n_in != 26 || (size_t)out_size != OUT_TOTAL || ws_size < WS_END) { fprintf(stderr, "kernel_launch: unexpected problem shape: n_in %d out %d ws %zu\n", n_in, out_size, ws_size); grid = -1; return; }
        int dev = 0, cus = 0, per_cu = 0;
        if (hipGetDevice(&dev) != hipSuccess || hipDeviceGetAttribute(&cus, hipDeviceAttributeMultiprocessorCount, dev) != hipSuccess) { grid = -1; return; }
        if (hipFuncSetAttribute((const void*)mega_fwd, hipFuncAttributeMaxDynamicSharedMemorySize, LDS_BYTES) != hipSuccess) { fprintf(stderr, "kernel_launch: hipFuncSetAttribute failed\n"); grid = -1; return; }
        if (hipOccupancyMaxActiveBlocksPerMultiprocessor(&per_cu, (const void*)mega_fwd, NWAVES * 64, LDS_BYTES) != hipSuccess || per_cu < 1) { fprintf(stderr, "kernel_launch: occupancy query says %d\n", per_cu); per_cu = 1; }
        (void)hipGetLastError();
        grid = cus * per_cu;
    }
    if (grid < 0) return;
    Params p{};
    for (int i = 0; i < 26; ++i) p.in[i] = (const float*)d_in[i];
    p.out = (float*)d_out; p.ws = (unsigned char*)d_ws;
    void* args[] = {&p};
    const hipError_t e = hipLaunchCooperativeKernel((const void*)mega_fwd, dim3(grid), dim3(NWAVES * 64), args, LDS_BYTES, stream);
    if (e != hipSuccess) fprintf(stderr, "kernel_launch: cooperative launch failed: %s (grid %d)\n", hipGetErrorString(e), grid);
}
```

```cpp
#include <hip/hip_runtime.h>
#include <hip/hip_cooperative_groups.h>
#include <cstdio>
#include <cstdint>
namespace pg8 {
#define PG8_LAS __attribute__((address_space(3)))
typedef unsigned short bf16_t;
typedef short bf16x8 __attribute__((ext_vector_type(8)));
typedef float f32x4 __attribute__((ext_vector_type(4)));
typedef unsigned u32x4 __attribute__((ext_vector_type(4)));
constexpr int BM = 256, BK = 64, HALF = 128, HTB = HALF * BK * 2  , STAGE_BYTES = 8 * HTB, NXCD = 8, WGM = 8;

__host__ __device__ __forceinline__ int lds_byte(int r, int c) { const int st = (r >> 4) * 2 + (c >> 5), rr = r & 15, cc = c & 31, ob = rr * 64 + cc * 2; return st * 1024 + (ob ^ (((ob >> 9) & 1) << 5)); }
__host__ __device__ __forceinline__ void stage_rc(int b, int& R, int& C) { const int st = b / 1024, sb = b % 1024, swz = sb ^ (((sb >> 9) & 1) << 5); R = (st >> 1) * 16 + swz / 64; C = (st & 1) * 32 + (swz % 64) / 2; }
__host__ __device__ __forceinline__ int perm32(int rho) { const int n = rho >> 4, i = rho & 15; return 8 * (i >> 2) + 4 * n + (i & 3); }

struct Unit { int pm, pn; };
struct Gemm { const bf16_t* A; const bf16_t* Bt; int M, N, K; };

struct StaticOrder {
    int nM, nN, nwg, G, c;
    __host__ __device__ void init(int M, int N, int G_, int c_) { nM = M / BM; nN = N / BM; nwg = nM * nN; G = G_; c = c_; }
    __host__ __device__ bool next(int i, Unit& u) const {
        const long L = (long)i * G + c; if (L >= nwg) return false;
        int wgid = (int)L; { const int q = nwg / NXCD, r = nwg % NXCD, xcd = wgid % NXCD, off = wgid / NXCD; wgid = (xcd < r ? xcd * (q + 1) : r * (q + 1) + (xcd - r) * q) + off; }
        const int nig = WGM * nN, gid = wgid / nig, fm = gid * WGM, gsz = (nM - fm) < WGM ? (nM - fm) : WGM;
        u.pm = fm + ((wgid % nig) % gsz); u.pn = (wgid % nig) / gsz; return true;
    }
    __device__ __forceinline__ void a_ready(const Unit&) const {}
    __device__ __forceinline__ void done(const Unit&) const {}
};

__device__ __forceinline__ unsigned cvt_pk_bf16(float lo, float hi) { unsigned r; asm volatile("v_cvt_pk_bf16_f32 %0, %1, %2" : "=v"(r) : "v"(lo), "v"(hi)); return r; }
typedef float f32x2 __attribute__((ext_vector_type(2)));
typedef unsigned u32x2 __attribute__((ext_vector_type(2)));
constexpr size_t WOFF_ROPE = (size_t)1 << 20, WOFF_QB = (size_t)215 << 20, WOFF_KB = (size_t)232 << 20, WOFF_VB = (size_t)249 << 20, WOFF_ZB = (size_t)266 << 20;
constexpr size_t OOFF_KP = 17039360, OOFF_VP = 33816576, OOFF_PP = 50593792, OOFF_KS = 50663424, OOFF_VS = 50925568, OOFF_PS = 51187712;
__device__ __forceinline__ float silu_mul(float g, float u) { const float e = __builtin_amdgcn_exp2f(-1.4426950408889634f * g); return g * u * __builtin_amdgcn_rcpf(1.0f + e); }
struct EpiSwiGLU {
    static constexpr bool PERM = true, AFTER_DRAIN = false;
    bf16_t* O; int ldc;
    __device__ __forceinline__ void operator()(const f32x4 (&acc)[2][2][4][2], const Unit& u, int wr, int wc, int fr, int fq) const {
        const int row0 = u.pm * BM + wr * 64 + fr; const int col0 = u.pn * 128 + wc * 32 + 8 * fq;
#pragma unroll
        for (int ai = 0; ai < 2; ++ai)
#pragma unroll
            for (int m = 0; m < 4; ++m) {
                bf16_t* p = O + (size_t)(row0 + ai * HALF + m * 16) * ldc + col0;
                const f32x4 g0 = acc[ai][0][m][0], g1 = acc[ai][0][m][1], u0 = acc[ai][1][m][0], u1 = acc[ai][1][m][1];
                u32x4 w;
                w.x = cvt_pk_bf16(silu_mul(g0[0], u0[0]), silu_mul(g0[1], u0[1])); w.y = cvt_pk_bf16(silu_mul(g0[2], u0[2]), silu_mul(g0[3], u0[3]));
                w.z = cvt_pk_bf16(silu_mul(g1[0], u1[0]), silu_mul(g1[1], u1[1])); w.w = cvt_pk_bf16(silu_mul(g1[2], u1[2]), silu_mul(g1[3], u1[3]));
                *(u32x4*)p = w;
                asm volatile("" ::: "memory");
            }
    }
};
struct EpiResid {
    static constexpr bool PERM = false, AFTER_DRAIN = false;
    const float* baseP; const float* baseS; float* out; float scale;
    __device__ __forceinline__ void operator()(const f32x4 (&acc)[2][2][4][2], const Unit& u, int wr, int wc, int fr, int fq) const {
        const int col0 = u.pn * BM + wc * 32 + 4 * fq;
#pragma unroll
        for (int ai = 0; ai < 2; ++ai)
#pragma unroll
            for (int m = 0; m < 4; ++m) {
                const int row = u.pm * BM + ai * HALF + wr * 64 + m * 16 + fr;
                const float* bp = (row < 16384) ? baseP + (size_t)row * 1024 : baseS + (size_t)(row - 16384) * 1024;
                float* op = out + (size_t)row * 1024;
#pragma unroll
                for (int bj = 0; bj < 2; ++bj)
#pragma unroll
                    for (int n = 0; n < 2; ++n) { const int c = col0 + bj * HALF + n * 16; const f32x4 b = *(const f32x4*)(bp + c); *(f32x4*)(op + c) = b + acc[ai][bj][m][n] * scale; }
                asm volatile("" ::: "memory");
            }
    }
};
struct EpiWin {
    static constexpr bool PERM = false, AFTER_DRAIN = false;
    unsigned char* ws; float* outp; int l; float qscale;
    __device__ __forceinline__ void operator()(const f32x4 (&acc)[2][2][4][2], const Unit& u, int wr, int wc, int fr, int fq) const {
        const int pn = u.pn;
        bf16_t* const Qb = (bf16_t*)(ws + WOFF_QB); bf16_t* const Kb = (bf16_t*)(ws + WOFF_KB); bf16_t* const Vb = (bf16_t*)(ws + WOFF_VB); bf16_t* const Zb = (bf16_t*)(ws + WOFF_ZB);
        const float* const rope = (const float*)(ws + WOFF_ROPE);
        float* const kP = outp + OOFF_KP + (size_t)l * 16384 * 512; float* const vP = outp + OOFF_VP + (size_t)l * 16384 * 512;
        float* const kS = outp + OOFF_KS + (size_t)l * 256 * 512; float* const vS = outp + OOFF_VS + (size_t)l * 256 * 512;
        float* const poolP = outp + OOFF_PP + (size_t)l * 8 * 15 * 256; float* const poolS = outp + OOFF_PS + (size_t)l * 8 * 15 * 256;
#pragma unroll
        for (int ai = 0; ai < 2; ++ai)
#pragma unroll
            for (int m = 0; m < 4; ++m) {
                const int row = u.pm * BM + ai * HALF + wr * 64 + m * 16 + fr;
                const bool smp = row >= 16384; const int rs = row - 16384;
                const int prow = smp ? 2048 + (rs & 31) : (row & 2047);
#pragma unroll
                for (int bj = 0; bj < 2; ++bj) {
                    const int dlo = 16 * (wc & 1) + 4 * fq, lc0 = 64 * (2 * bj + (wc >> 1)) + dlo;
                    const f32x4 a0 = acc[ai][bj][m][0], a1 = acc[ai][bj][m][1];
                    if (pn < 4) {
                        const f32x4 cs = *(const f32x4*)(rope + (size_t)prow * 64 + dlo), sn = *(const f32x4*)(rope + (size_t)prow * 64 + 32 + dlo);
                        const f32x4 r0 = a0 * cs - a1 * sn, r1 = a1 * cs + a0 * sn;
                        if (pn < 2) {
                            const int col = 256 * pn + lc0; bf16_t* q = Qb + (size_t)row * 512 + col;
                            u32x2 w0, w1; w0.x = cvt_pk_bf16(r0[0] * qscale, r0[1] * qscale); w0.y = cvt_pk_bf16(r0[2] * qscale, r0[3] * qscale);
                            w1.x = cvt_pk_bf16(r1[0] * qscale, r1[1] * qscale); w1.y = cvt_pk_bf16(r1[2] * qscale, r1[3] * qscale);
                            *(u32x2*)q = w0; *(u32x2*)(q + 32) = w1;
                        } else {
                            const int col = 256 * (pn - 2) + lc0; bf16_t* k = Kb + (size_t)row * 512 + col;
                            float* ko = smp ? kS + (size_t)rs * 512 + col : kP + (size_t)row * 512 + col;
                            *(f32x4*)ko = r0; *(f32x4*)(ko + 32) = r1;
                            u32x2 w0, w1; w0.x = cvt_pk_bf16(r0[0], r0[1]); w0.y = cvt_pk_bf16(r0[2], r0[3]); w1.x = cvt_pk_bf16(r1[0], r1[1]); w1.y = cvt_pk_bf16(r1[2], r1[3]);
                            *(u32x2*)k = w0; *(u32x2*)(k + 32) = w1;
                        }
                    } else if (pn < 6) {
                        const int col = 256 * (pn - 4) + lc0; bf16_t* v = Vb + (size_t)row * 512 + col;
                        float* vo = smp ? vS + (size_t)rs * 512 + col : vP + (size_t)row * 512 + col;
                        *(f32x4*)vo = a0; *(f32x4*)(vo + 32) = a1;
                        u32x2 w0, w1; w0.x = cvt_pk_bf16(a0[0], a0[1]); w0.y = cvt_pk_bf16(a0[2], a0[3]); w1.x = cvt_pk_bf16(a1[0], a1[1]); w1.y = cvt_pk_bf16(a1[2], a1[3]);
                        *(u32x2*)v = w0; *(u32x2*)(v + 32) = w1;
                    } else {
                        const int col = 256 * (pn - 6) + lc0; bf16_t* z = Zb + (size_t)row * 1024 + col;
                        u32x2 w0, w1; w0.x = cvt_pk_bf16(a0[0], a0[1]); w0.y = cvt_pk_bf16(a0[2], a0[3]); w1.x = cvt_pk_bf16(a1[0], a1[1]); w1.y = cvt_pk_bf16(a1[2], a1[3]);
                        *(u32x2*)z = w0; *(u32x2*)(z + 32) = w1;
                        if (pn == 6) {
                            if (smp) { const int b = rs >> 5, t = rs & 31; if (t >= 17) { float* po = poolS + (size_t)(b * 15 + t - 17) * 256 + lc0; *(f32x4*)po = a0; *(f32x4*)(po + 32) = a1; } }
                            else { const int b = row >> 11, t = row & 2047; if (t >= 2033) { float* po = poolP + (size_t)(b * 15 + t - 2033) * 256 + lc0; *(f32x4*)po = a0; *(f32x4*)(po + 32) = a1; } }
                        }
                    }
                }
                asm volatile("" ::: "memory");
            }
    }
};
template <class Epi, class Sched, bool ALIGN_EPI = false, bool SP2 = false>
__device__ __forceinline__ void gemm_phase(PG8_LAS unsigned char* lds, const Gemm g, const Sched& S, const Epi& E) {
    int tid_l = threadIdx.x; asm volatile("" : "+v"(tid_l)); const int tid = tid_l, wid = __builtin_amdgcn_readfirstlane(tid >> 6), lane = tid & 63, wr = wid >> 2, wc = wid & 3, fr = lane & 15, fq = lane >> 4;
    const int K = g.K, nt = K / BK;
    unsigned voffA[2], voffB[2];
#pragma unroll
    for (int i = 0; i < 2; ++i) { int R, C; stage_rc(tid * 16 + i * 8192, R, C); const int Rb = Epi::PERM ? ((R & ~31) + perm32(R & 31)) : R;
        voffA[i] = (unsigned)(R * K + C) * 2u; voffB[i] = (unsigned)(Rb * K + C) * 2u; }
    const size_t kstep = (size_t)(BK * 2);
    const size_t hstep = (size_t)HALF * K * 2;
    const size_t tstep = 2 * hstep;
    const unsigned ldsw = (unsigned)wid * 1024u;
    const int aoff = lds_byte(wr * 64 + fr, fq * 8), boff = lds_byte(wc * 32 + fr, fq * 8);
#define PG8_SA(b, h) (((b) * 2 + (h)) * HTB)
#define PG8_SB(b, h) ((4 + (b) * 2 + (h)) * HTB)
#define PG8_STAGE(bufoff, gbase, voff) do { _Pragma("unroll") for (int _i = 0; _i < 2; ++_i) \
        __builtin_amdgcn_global_load_lds((const unsigned*)((const char*)(gbase) + (voff)[_i]), (PG8_LAS unsigned*)(lds + (bufoff) + ldsw + _i * 8192), 16, 0, 0); } while (0)
#define PG8_LDA(dst, b, h) do { _Pragma("unroll") for (int m = 0; m < 4; ++m) _Pragma("unroll") for (int k = 0; k < 2; ++k) dst[m][k] = *(const PG8_LAS bf16x8*)(lds + PG8_SA(b, h) + aoff + m * 2048 + k * 1024); } while (0)
#define PG8_LDB(dst, b, h) do { _Pragma("unroll") for (int n = 0; n < 2; ++n) _Pragma("unroll") for (int k = 0; k < 2; ++k) dst[n][k] = *(const PG8_LAS bf16x8*)(lds + PG8_SB(b, h) + boff + n * 2048 + k * 1024); } while (0)
#define PG8_MMA(ai, bj, At, Bt) do { __builtin_amdgcn_s_setprio(1); _Pragma("unroll") for (int m = 0; m < 4; ++m) _Pragma("unroll") for (int n = 0; n < 2; ++n) _Pragma("unroll") for (int k = 0; k < 2; ++k) \
        acc[ai][bj][m][n] = __builtin_amdgcn_mfma_f32_16x16x32_bf16(Bt[n][k], At[m][k], acc[ai][bj][m][n], 0, 0, 0); __builtin_amdgcn_s_setprio(0); } while (0)
#define PG8_WAIT_V(n) asm volatile("s_waitcnt vmcnt(" #n ")" ::: "memory")
#define PG8_WAIT_L(n) asm volatile("s_waitcnt lgkmcnt(" #n ")" ::: "memory")
#define PG8_BAR __builtin_amdgcn_s_barrier()
#define PG8_SCHED __builtin_amdgcn_sched_barrier(0)
    Unit cur, nxt; int ui = 0;
    if (!S.next(0, cur)) return;
    f32x4 acc[2][2][4][2];
#pragma unroll
    for (int a = 0; a < 2; ++a)
#pragma unroll
        for (int b = 0; b < 2; ++b)
#pragma unroll
            for (int m = 0; m < 4; ++m)
#pragma unroll
                for (int n = 0; n < 2; ++n) acc[a][b][m][n] = (f32x4){0.f, 0.f, 0.f, 0.f};
    bf16x8 At[4][2], B0[2][2], B1[2][2];
    const char* cA = (const char*)g.A + (size_t)cur.pm * tstep; const char* cB = (const char*)g.Bt + (size_t)cur.pn * tstep;
    S.a_ready(cur);
    if constexpr (SP2) {
        PG8_STAGE(PG8_SB(0, 0), cB, voffB); PG8_STAGE(PG8_SB(0, 1), cB + hstep, voffB); PG8_STAGE(PG8_SA(0, 0), cA, voffA); PG8_STAGE(PG8_SA(0, 1), cA + hstep, voffA);
        if (wr == 1) PG8_BAR;
        PG8_WAIT_V(2); PG8_BAR;
        PG8_STAGE(PG8_SB(1, 0), cB + kstep, voffB); PG8_STAGE(PG8_SA(1, 0), cA + kstep, voffA); PG8_STAGE(PG8_SB(1, 1), cB + hstep + kstep, voffB);
        PG8_WAIT_V(6); PG8_BAR;
    } else {
        PG8_STAGE(PG8_SB(0, 0), cB, voffB); PG8_STAGE(PG8_SA(0, 0), cA, voffA); PG8_STAGE(PG8_SB(0, 1), cB + hstep, voffB); PG8_STAGE(PG8_SA(0, 1), cA + hstep, voffA);
        if (wr == 1) PG8_BAR;
        PG8_WAIT_V(4); PG8_BAR;
        PG8_STAGE(PG8_SB(1, 0), cB + kstep, voffB); PG8_STAGE(PG8_SA(1, 0), cA + kstep, voffA); PG8_STAGE(PG8_SB(1, 1), cB + hstep + kstep, voffB);
        PG8_WAIT_V(6); PG8_BAR;
    }
    for (;;) {
        const bool has_next = S.next(ui + 1, nxt);
        const char* nA = has_next ? (const char*)g.A + (size_t)nxt.pm * tstep : cA; const char* nB = has_next ? (const char*)g.Bt + (size_t)nxt.pn * tstep : cB;
        for (int t = 0; t < nt; t += 2) {
            const bool last = (t == nt - 2);
            const char* a1 = cA + (size_t)(t + 1) * kstep;
            const char* a2 = last ? nA : cA + (size_t)(t + 2) * kstep; const char* b2 = last ? nB : cB + (size_t)(t + 2) * kstep;
            const char* a3 = a2 + kstep; const char* b3 = b2 + kstep;
            if (last && has_next) S.a_ready(nxt);
            if constexpr (SP2) {
            PG8_LDB(B0, 0, 0); PG8_LDB(B1, 0, 1); PG8_SCHED; PG8_LDA(At, 0, 0); PG8_STAGE(PG8_SA(1, 1), a1 + hstep, voffA);
            PG8_WAIT_V(8); PG8_WAIT_L(0); PG8_BAR; PG8_MMA(0, 0, At, B0); PG8_MMA(0, 1, At, B1); PG8_BAR; PG8_SCHED;
            PG8_LDA(At, 0, 1); PG8_STAGE(PG8_SB(0, 0), b2, voffB); PG8_STAGE(PG8_SB(0, 1), b2 + hstep, voffB); PG8_STAGE(PG8_SA(0, 0), a2, voffA);
            PG8_WAIT_V(8); PG8_WAIT_L(0); PG8_BAR; PG8_MMA(1, 0, At, B0); PG8_MMA(1, 1, At, B1); PG8_BAR; PG8_SCHED;
            PG8_LDB(B0, 1, 0); PG8_LDB(B1, 1, 1); PG8_SCHED; PG8_LDA(At, 1, 0); PG8_STAGE(PG8_SA(0, 1), a2 + hstep, voffA);
            PG8_WAIT_V(8); PG8_WAIT_L(0); PG8_BAR; PG8_MMA(0, 0, At, B0); PG8_MMA(0, 1, At, B1); PG8_BAR; PG8_SCHED;
            PG8_LDA(At, 1, 1); PG8_STAGE(PG8_SB(1, 0), b3, voffB); PG8_STAGE(PG8_SB(1, 1), b3 + hstep, voffB); PG8_STAGE(PG8_SA(1, 0), a3, voffA);
            PG8_WAIT_V(8); PG8_WAIT_L(0); PG8_BAR; PG8_MMA(1, 0, At, B0); PG8_MMA(1, 1, At, B1); PG8_BAR; PG8_SCHED;
            } else {
            PG8_LDB(B0, 0, 0); PG8_SCHED; PG8_LDA(At, 0, 0); PG8_STAGE(PG8_SA(1, 1), a1 + hstep, voffA);
            PG8_WAIT_L(8); PG8_BAR; PG8_WAIT_L(0); PG8_MMA(0, 0, At, B0); PG8_BAR; PG8_SCHED;
            PG8_LDB(B1, 0, 1); PG8_STAGE(PG8_SB(0, 0), b2, voffB);
            PG8_BAR; PG8_WAIT_L(0); PG8_MMA(0, 1, At, B1); PG8_BAR;
            PG8_LDA(At, 0, 1); PG8_STAGE(PG8_SA(0, 0), a2, voffA);
            PG8_BAR; PG8_WAIT_L(0); PG8_MMA(1, 0, At, B0); PG8_BAR; PG8_SCHED;
            PG8_STAGE(PG8_SB(0, 1), b2 + hstep, voffB);
            PG8_WAIT_V(6); PG8_BAR; PG8_MMA(1, 1, At, B1); PG8_BAR;
            PG8_LDB(B0, 1, 0); PG8_SCHED; PG8_LDA(At, 1, 0); PG8_STAGE(PG8_SA(0, 1), a2 + hstep, voffA);
            PG8_WAIT_L(8); PG8_BAR; PG8_WAIT_L(0); PG8_MMA(0, 0, At, B0); PG8_BAR; PG8_SCHED;
            PG8_LDB(B1, 1, 1); PG8_STAGE(PG8_SB(1, 0), b3, voffB);
            PG8_BAR; PG8_WAIT_L(0); PG8_MMA(0, 1, At, B1); PG8_BAR;
            PG8_LDA(At, 1, 1); PG8_STAGE(PG8_SA(1, 0), a3, voffA);
            PG8_BAR; PG8_WAIT_L(0); PG8_MMA(1, 0, At, B0); PG8_BAR; PG8_SCHED;
            PG8_STAGE(PG8_SB(1, 1), b3 + hstep, voffB);
            PG8_WAIT_V(6); PG8_BAR; PG8_MMA(1, 1, At, B1); PG8_BAR;
            }
        }
        if constexpr (ALIGN_EPI) { if (wr == 0) PG8_BAR; }
        if constexpr (!Epi::AFTER_DRAIN) { E(acc, cur, wr, wc, fr, fq); S.done(cur); }
        if (!has_next) break;
#pragma unroll
        for (int a = 0; a < 2; ++a)
#pragma unroll
            for (int b = 0; b < 2; ++b)
#pragma unroll
                for (int m = 0; m < 4; ++m)
#pragma unroll
                    for (int n = 0; n < 2; ++n) acc[a][b][m][n] = (f32x4){0.f, 0.f, 0.f, 0.f};
        cur = nxt; cA = nA; cB = nB; ++ui;
        if constexpr (ALIGN_EPI) { if (wr == 1) PG8_BAR; }
    }
    PG8_WAIT_V(0);
    if constexpr (!ALIGN_EPI) { if (wr == 0) PG8_BAR; }
    PG8_BAR;
    if constexpr (Epi::AFTER_DRAIN) { E.fused(acc, cur, wr, wc, fr, fq, lds, wid, lane); S.done(cur); }
#undef PG8_SA
#undef PG8_SB
#undef PG8_STAGE
#undef PG8_LDA
#undef PG8_LDB
#undef PG8_MMA
#undef PG8_WAIT_V
#undef PG8_WAIT_L
#undef PG8_BAR
#undef PG8_SCHED
}
}
#include <hip/hip_bf16.h>
#include <cmath>
namespace attn_body {
using bf16=__hip_bfloat16;
using bf16x8=__attribute__((ext_vector_type(8)))short;
using s16x4=__attribute__((ext_vector_type(4)))short;
using f32x16=__attribute__((ext_vector_type(16)))float;
using u32x4=__attribute__((ext_vector_type(4)))unsigned;
constexpr int BATCH=8,NHEAD=16,SEQ=2048,D=64,PQK=512,PO=1024;
constexpr int NW=8,QBLK=32,QB=QBLK*NW,KVBLK=64,NQB=SEQ/QB;
constexpr int ATTN_UNIT_ROWS=QB;
__device__ __forceinline__ int crow(int r,int hi){return (r&3)+8*(r>>2)+4*hi;}
#define SBAR() __builtin_amdgcn_sched_barrier(0)
__device__ __forceinline__ void cmask(f32x16&p0,f32x16&p1,int jb,int qrel,int hi){
  const float NEG=-INFINITY; (void)hi;
  if(jb>(qrel>>6)){
  #pragma unroll
  for(int r=0;r<16;++r){p0[r]=NEG;p1[r]=NEG;}}
}

constexpr int NSLOT=3, SLOTB=8192;
constexpr int LDS_K=0, LDS_V=NSLOT*SLOTB, LDS_WS=2*NSLOT*SLOTB, LDS_OST=LDS_WS+NW*64*4, LDS_BYTES=LDS_OST+NW*4096;
constexpr float C2=0.125f*1.4426950408889634f;
__device__ __forceinline__ void glds16(const void*gsrc,unsigned lds_dst){unsigned keep;
  asm volatile("s_mov_b32 %0, m0\n\ts_mov_b32 m0, %2\n\ts_nop 0\n\tglobal_load_lds_dwordx4 %1, off\n\ts_mov_b32 m0, %0":"=&s"(keep):"v"(gsrc),"s"(lds_dst):"memory");}
__device__ __forceinline__ float max3f(float a,float b,float c){float r;asm("v_max3_f32 %0, %1, %2, %3":"=v"(r):"v"(a),"v"(b),"v"(c));return r;}
__device__ __forceinline__ float max2f(float a,float b){float r;asm("v_max_f32_e32 %0, %1, %2":"=v"(r):"v"(a),"v"(b));return r;}
__device__ __forceinline__ float fadd_s(float a,float b){float r;asm("v_add_f32_e32 %0, %1, %2":"=v"(r):"v"(a),"v"(b));return r;}
__device__ __forceinline__ float fsub_s(float a,float b){float r;asm("v_sub_f32_e32 %0, %1, %2":"=v"(r):"v"(a),"v"(b));return r;}
typedef float f32x2_t __attribute__((ext_vector_type(2))); typedef __bf16 bf16x2_t __attribute__((ext_vector_type(2)));
__device__ __forceinline__ unsigned cvtpk_s(float lo,float hi){f32x2_t v={lo,hi};bf16x2_t b=__builtin_convertvector(v,bf16x2_t);return __builtin_bit_cast(unsigned,b);}
#define WAIT_BAR(N) asm volatile("s_waitcnt vmcnt(" #N ") lgkmcnt(0)\n\ts_barrier":::"memory")

__device__ __forceinline__ void qkt(f32x16&p0,f32x16&p1,const char*Kslot,const bf16x8*qr,const f32x16&negm,int r32,int hi){
  const char*kb=Kslot+hi*1024+r32*16;
  #pragma unroll
  for(int d0=0;d0<4;++d0){
    const bf16x8 b0=*reinterpret_cast<const bf16x8*>(kb+d0*2048);
    const bf16x8 b1=*reinterpret_cast<const bf16x8*>(kb+d0*2048+512);
    if(d0==0){p0=__builtin_amdgcn_mfma_f32_32x32x16_bf16(b0,qr[0],negm,0,0,0);p1=__builtin_amdgcn_mfma_f32_32x32x16_bf16(b1,qr[0],negm,0,0,0);}
    else{p0=__builtin_amdgcn_mfma_f32_32x32x16_bf16(b0,qr[d0],p0,0,0,0);p1=__builtin_amdgcn_mfma_f32_32x32x16_bf16(b1,qr[d0],p1,0,0,0);}}
}
typedef __attribute__((address_space(3))) const char* lds_cptr;
typedef short v4i16_t __attribute__((ext_vector_type(4)));
__device__ __forceinline__ void kload8(bf16x8*kf,lds_cptr kp){
  kf[0]=*(const __attribute__((address_space(3))) bf16x8*)(kp);      kf[1]=*(const __attribute__((address_space(3))) bf16x8*)(kp+512);
  kf[2]=*(const __attribute__((address_space(3))) bf16x8*)(kp+2048); kf[3]=*(const __attribute__((address_space(3))) bf16x8*)(kp+2560);
  kf[4]=*(const __attribute__((address_space(3))) bf16x8*)(kp+4096); kf[5]=*(const __attribute__((address_space(3))) bf16x8*)(kp+4608);
  kf[6]=*(const __attribute__((address_space(3))) bf16x8*)(kp+6144); kf[7]=*(const __attribute__((address_space(3))) bf16x8*)(kp+6656);
}
__device__ __forceinline__ void kload2(bf16x8*kf,lds_cptr kp,int j){ kf[2*j]=*(const __attribute__((address_space(3))) bf16x8*)(kp+j*2048); kf[2*j+1]=*(const __attribute__((address_space(3))) bf16x8*)(kp+j*2048+512); }
__device__ __forceinline__ s16x4 vtr(lds_cptr p){ return __builtin_bit_cast(s16x4,__builtin_amdgcn_ds_read_tr16_b64_v4i16((__attribute__((address_space(3))) v4i16_t*)p)); }
__device__ __forceinline__ float rowmax(const f32x16&p0,const f32x16&p1){
  float a=max3f(p0[0],p0[1],p1[0]),b=max3f(p0[2],p0[3],p1[1]);a=max3f(a,p1[2],p1[3]);
  #pragma unroll
  for(int r=4;r<16;r+=4){a=max3f(a,p0[r],p0[r+1]);b=max3f(b,p0[r+2],p0[r+3]);a=max3f(a,p1[r],p1[r+1]);b=max3f(b,p1[r+2],p1[r+3]);}
  const float m=max2f(a,b);
  auto rr=__builtin_amdgcn_permlane32_swap(__float_as_uint(m),__float_as_uint(m),false,false);
  return max2f(__uint_as_float(rr[0]),__uint_as_float(rr[1]));
}
__device__ __forceinline__ void pv(f32x16*o,int vb,bf16x8 pa0,bf16x8 pa1,bf16x8 pa2,bf16x8 pa3){
  #pragma unroll
  for(int d0=0;d0<2;++d0){s16x4 lo[4],hi[4];
    #pragma unroll
    for(int ks=0;ks<4;++ks){
      asm volatile("ds_read_b64_tr_b16 %0,%1 offset:%c2":"=&v"(lo[ks]):"v"(vb),"i"(d0*4096+ks*1024):"memory");
      asm volatile("ds_read_b64_tr_b16 %0,%1 offset:%c2":"=&v"(hi[ks]):"v"(vb),"i"(d0*4096+ks*1024+512):"memory");}
    asm volatile("s_waitcnt lgkmcnt(0)":::"memory");SBAR();
    #define PK(k) (bf16x8){lo[k][0],lo[k][1],lo[k][2],lo[k][3],hi[k][0],hi[k][1],hi[k][2],hi[k][3]}
    o[d0]=__builtin_amdgcn_mfma_f32_32x32x16_bf16(pa0,PK(0),o[d0],0,0,0);
    o[d0]=__builtin_amdgcn_mfma_f32_32x32x16_bf16(pa1,PK(1),o[d0],0,0,0);
    o[d0]=__builtin_amdgcn_mfma_f32_32x32x16_bf16(pa2,PK(2),o[d0],0,0,0);
    o[d0]=__builtin_amdgcn_mfma_f32_32x32x16_bf16(pa3,PK(3),o[d0],0,0,0);
    #undef PK
  }
}

#ifndef ATTN_STORE16
#define ATTN_STORE16(p,v) (*(u32x4*)(p)=(v))
#endif
template<int THRL> __device__ __forceinline__ void attn_unit(int b,int qb,const bf16*Q,const bf16*__restrict__ K,const bf16*__restrict__ V,bf16*O,char*shm){
  int tid_l=threadIdx.x; asm volatile("":"+v"(tid_l)); const int tid=tid_l,lane=tid&63,r32=lane&31,hi=lane>>5; const int wid=__builtin_amdgcn_readfirstlane(tid>>6);
  const long rowbase=(long)b*SEQ; const int q0=qb*QB;
  const bf16*Qw=Q+(rowbase+q0+wid*QBLK)*PQK;
  const bf16*Kh=K+rowbase*PQK,*Vh=V+rowbase*PQK;
  const unsigned lds0=(unsigned)(uintptr_t)shm;
  float*wsf=(float*)(shm+LDS_WS)+wid*64;
  const bf16*ksrc=Kh+(long)lane*PQK+wid*8;
  const bf16*vsrc=Vh+(long)(16*(wid&3)+(lane>>2))*PQK+(wid>>2)*32+(lane&3)*8;
  const unsigned kdst=lds0+LDS_K+wid*1024, vdst=lds0+LDS_V+wid*1024;
  #define DMA_K(t,slot) glds16(ksrc+(long)(t)*KVBLK*PQK,(unsigned)__builtin_amdgcn_readfirstlane(kdst+(slot)))
  #define DMA_V(t,slot) glds16(vsrc+(long)(t)*KVBLK*PQK,(unsigned)__builtin_amdgcn_readfirstlane(vdst+(slot)))
  const int vb0=(int)(lds0+LDS_V)+((lane>>4)&1)*32+(lane&3)*8+(4*hi+((lane&15)>>2))*64;
  const char*Kbase=shm+LDS_K; bf16x8 kf[8];
  const lds_cptr shm3=(lds_cptr)shm; const lds_cptr kp0=shm3+LDS_K+hi*1024+r32*16; const lds_cptr vp0=shm3+LDS_V+((lane>>4)&1)*32+(lane&3)*8+(4*hi+((lane&15)>>2))*64;
  const int NT=(q0+QB)/KVBLK;
  DMA_K(0,0);DMA_V(0,0);DMA_K(1,SLOTB);
  bf16x8 qr[4];
  #pragma unroll
  for(int d0=0;d0<4;++d0)qr[d0]=*reinterpret_cast<const bf16x8*>(&Qw[(long)r32*PQK+d0*16+hi*8]);
  float mhat=0.f,l_reg=0.f;f32x16 o[2];o[0]=f32x16{};o[1]=f32x16{};f32x16 negm=f32x16{};asm volatile("":"+v"(negm));
  const int qrel=wid*QBLK+r32;
  #define CMASK(P0,P1,t) do{int jb_=(t)-(NT-4); if(jb_>=0)cmask(P0,P1,jb_,qrel,hi);}while(0)
  bool resc=false;
  #define START(P0,P1) do{ const float rm=rowmax(P0,P1); resc=false; \
    { const float dl=rm; mhat=fadd_s(mhat,dl); \
      _Pragma("unroll") for(int r=0;r<16;++r){P0[r]=fsub_s(P0[r],dl);P1[r]=fsub_s(P1[r],dl);} \
      _Pragma("unroll") for(int r=0;r<16;++r)negm[r]=-mhat; asm volatile("":"+v"(negm)); } \
    _Pragma("unroll") for(int r=0;r<16;++r)P0[r]=__builtin_amdgcn_exp2f(P0[r]); }while(0)
  #define RESC() do{ if(resc){ asm volatile("s_waitcnt lgkmcnt(0)":::"memory"); \
      _Pragma("unroll") for(int d_=0;d_<2;++d_) _Pragma("unroll") for(int r=0;r<16;++r)o[d_][r]*=wsf[crow(r,hi)]; } }while(0)
  f32x16 pA0,pA1,pB0,pB1;
  int sl_prev=0,sl_cur=0,sl_next=SLOTB;
  #define ROT() do{sl_prev=sl_cur;sl_cur=sl_next;sl_next=(sl_next==(NSLOT-1)*SLOTB)?0:sl_next+SLOTB;}while(0)
  DMA_K(2,2*SLOTB);
  WAIT_BAR(3);
  qkt(pA0,pA1,Kbase,qr,negm,r32,hi);asm volatile("s_nop 15\n\ts_nop 7":"+v"(pA0),"+v"(pA1));CMASK(pA0,pA1,0);
  START(pA0,pA1);
  _Pragma("unroll") for(int r=0;r<16;++r)pA1[r]=__builtin_amdgcn_exp2f(pA1[r]);
  WAIT_BAR(0);
  DMA_K(3,0);DMA_V(1,SLOTB);
  ROT();
  kload8(kf,kp0+sl_cur);
  WAIT_BAR(2);
  s16x4 vlo[8],vhi[8]; u32x4 pw0,pw1,pw2,pw3;
  #define PKW(P,B) cvtpk_s(P[B],P[B+1])
  #define PAF(k) __builtin_bit_cast(bf16x8,pw##k)
  #define VFR(i) (bf16x8){vlo[i][0],vlo[i][1],vlo[i][2],vlo[i][3],vhi[i][0],vhi[i][1],vhi[i][2],vhi[i][3]}
  #define PIN(x) asm volatile("":"+v"(x))
  #define MX3(a,b,c) __builtin_fmaxf(__builtin_fmaxf((a),(b)),(c))
  #define GAPA(MF,A0,A1,A2,A3,W0,W1,PW) do{ MF; sacc+=A0; sacc+=A1; sacc+=A2; sacc+=A3; PIN(sacc); W0; W1; PIN(PW); SBAR(); }while(0)
  #define EX(v) __builtin_amdgcn_exp2f(v)
  #define GAPB(MF,X,B) do{ MF; X[B]=EX(X[B]); X[B+1]=EX(X[B+1]); X[B+2]=EX(X[B+2]); X[B+3]=EX(X[B+3]); PIN(X); SBAR(); }while(0)
  #define VRD(i) do{ vlo[i]=vtr(vp_+(((i)>>2)*4096+((i)&3)*1024)); vhi[i]=vtr(vp_+(((i)>>2)*4096+((i)&3)*1024+512)); }while(0)
  #define KRD(G,j) do{ if(G){ kload2(kf,kp0+sl_next,j); SBAR(); } }while(0)
  #define STEP(C0,C1,P0,P1,t,GK,GV,GL) do{ SBAR(); \
    const lds_cptr vp_=vp0+sl_prev; \
    VRD(0); SBAR(); float sacc=(P0[0]+P0[1]); \
    GAPA(C0=__builtin_amdgcn_mfma_f32_32x32x16_bf16(kf[0],qr[0],negm,0,0,0), P0[2],P0[3],P0[4],P0[5],     pw0[0]=PKW(P0,0), pw0[1]=PKW(P0,2), pw0); \
    VRD(4); SBAR(); GAPA(C1=__builtin_amdgcn_mfma_f32_32x32x16_bf16(kf[1],qr[0],negm,0,0,0), P0[6],P0[7],P0[8],P0[9],     pw0[2]=PKW(P0,4), pw0[3]=PKW(P0,6), pw0); \
    VRD(1); SBAR(); GAPA(C0=__builtin_amdgcn_mfma_f32_32x32x16_bf16(kf[2],qr[1],C0,0,0,0),   P0[10],P0[11],P0[12],P0[13], pw1[0]=PKW(P0,8), pw1[1]=PKW(P0,10), pw1); \
    VRD(5); SBAR(); GAPA(C1=__builtin_amdgcn_mfma_f32_32x32x16_bf16(kf[3],qr[1],C1,0,0,0),   P0[14],P0[15],P1[0],P1[1],   pw1[2]=PKW(P0,12),pw1[3]=PKW(P0,14), pw1); \
    VRD(2); SBAR(); GAPA(C0=__builtin_amdgcn_mfma_f32_32x32x16_bf16(kf[4],qr[2],C0,0,0,0),   P1[2],P1[3],P1[4],P1[5],     pw2[0]=PKW(P1,0), pw2[1]=PKW(P1,2), pw2); \
    VRD(6); SBAR(); GAPA(C1=__builtin_amdgcn_mfma_f32_32x32x16_bf16(kf[5],qr[2],C1,0,0,0),   P1[6],P1[7],P1[8],P1[9],     pw2[2]=PKW(P1,4), pw2[3]=PKW(P1,6), pw2); \
    VRD(3); SBAR(); GAPA(C0=__builtin_amdgcn_mfma_f32_32x32x16_bf16(kf[6],qr[3],C0,0,0,0),   P1[10],P1[11],P1[12],P1[13], pw3[0]=PKW(P1,8), pw3[1]=PKW(P1,10), pw3); \
    VRD(7); SBAR(); GAPA(C1=__builtin_amdgcn_mfma_f32_32x32x16_bf16(kf[7],qr[3],C1,0,0,0),   P1[14],P1[15],0.f,0.f,       pw3[2]=PKW(P1,12),pw3[3]=PKW(P1,14), pw3); \
    l_reg+=sacc; \
    if(GK){DMA_K((t)+3,sl_cur);} if(GV){DMA_V((t)+1,sl_next);} \
    CMASK(C0,C1,t); \
    { float a=MX3(C0[0],C0[1],C1[0]),b=MX3(C0[2],C0[3],C1[1]); a=MX3(a,C1[2],C1[3]); \
      _Pragma("unroll") for(int r=4;r<16;r+=4){a=MX3(a,C0[r],C0[r+1]);b=MX3(b,C0[r+2],C0[r+3]);a=MX3(a,C1[r],C1[r+1]);b=MX3(b,C1[r+2],C1[r+3]);} \
      float rm=__builtin_fmaxf(a,b); { auto rr=__builtin_amdgcn_permlane32_swap(__float_as_uint(rm),__float_as_uint(rm),false,false); rm=__builtin_fmaxf(__uint_as_float(rr[0]),__uint_as_float(rr[1])); } \
      resc=false; \
      if(__builtin_expect(__any(rm>(float)THRL),0)){ const float dl=__builtin_fmaxf(rm,0.f); mhat+=dl; \
        _Pragma("unroll") for(int r=0;r<16;++r){C0[r]-=dl;C1[r]-=dl;} \
        _Pragma("unroll") for(int r=0;r<16;++r)negm[r]=-mhat; asm volatile("":"+v"(negm)); \
        const float f=__builtin_amdgcn_exp2f(-dl); l_reg*=f; if(hi==0)wsf[r32]=f; resc=true; } } \
    SBAR(); \
    GAPB(o[0]=__builtin_amdgcn_mfma_f32_32x32x16_bf16(PAF(0),VFR(0),o[0],0,0,0), C0,0); \
    GAPB(o[1]=__builtin_amdgcn_mfma_f32_32x32x16_bf16(PAF(0),VFR(4),o[1],0,0,0), C0,4); \
    KRD(GL,0); GAPB(o[0]=__builtin_amdgcn_mfma_f32_32x32x16_bf16(PAF(1),VFR(1),o[0],0,0,0), C0,8); \
    KRD(GL,1); GAPB(o[1]=__builtin_amdgcn_mfma_f32_32x32x16_bf16(PAF(1),VFR(5),o[1],0,0,0), C0,12); \
    KRD(GL,2); GAPB(o[0]=__builtin_amdgcn_mfma_f32_32x32x16_bf16(PAF(2),VFR(2),o[0],0,0,0), C1,0); \
    KRD(GL,3); GAPB(o[1]=__builtin_amdgcn_mfma_f32_32x32x16_bf16(PAF(2),VFR(6),o[1],0,0,0), C1,4); \
    GAPB(o[0]=__builtin_amdgcn_mfma_f32_32x32x16_bf16(PAF(3),VFR(3),o[0],0,0,0), C1,8); \
    GAPB(o[1]=__builtin_amdgcn_mfma_f32_32x32x16_bf16(PAF(3),VFR(7),o[1],0,0,0), C1,12); \
    }while(0)
  int t=1;
  #undef CMASK
  #define CMASK(P0,P1,t) do{}while(0)
  for(;t+5<NT;t+=2){
    STEP(pB0,pB1,pA0,pA1,t,true,true,true);     WAIT_BAR(2); RESC(); ROT();
    STEP(pA0,pA1,pB0,pB1,t+1,true,true,true);   WAIT_BAR(2); RESC(); ROT();
  }
  #undef CMASK
  #define CMASK(P0,P1,t) do{int jb_=(t)-(NT-4); if(jb_>=0)cmask(P0,P1,jb_,qrel,hi);}while(0)
  #define ENDW(tt) do{ if((tt)+3<NT){WAIT_BAR(2);} else if((tt)+2<NT){WAIT_BAR(1);} else {WAIT_BAR(0);} }while(0)
  for(;t+1<NT;t+=2){
    STEP(pB0,pB1,pA0,pA1,t,(t+3<NT),(t+1<NT),(t+1<NT));       ENDW(t);   RESC(); ROT();
    STEP(pA0,pA1,pB0,pB1,t+1,(t+4<NT),(t+2<NT),(t+2<NT));     ENDW(t+1); RESC(); ROT();
  }
  STEP(pB0,pB1,pA0,pA1,NT-1,false,false,false); RESC();
  { float sacc=pB0[0]+pB0[1]; _Pragma("unroll") for(int r=2;r<16;++r)sacc+=pB0[r]; _Pragma("unroll") for(int r=0;r<16;++r)sacc+=pB1[r]; l_reg+=sacc;
    pw0=(u32x4){PKW(pB0,0),PKW(pB0,2),PKW(pB0,4),PKW(pB0,6)};pw1=(u32x4){PKW(pB0,8),PKW(pB0,10),PKW(pB0,12),PKW(pB0,14)};pw2=(u32x4){PKW(pB1,0),PKW(pB1,2),PKW(pB1,4),PKW(pB1,6)};pw3=(u32x4){PKW(pB1,8),PKW(pB1,10),PKW(pB1,12),PKW(pB1,14)};
    SBAR(); pv(o,vb0+sl_cur,PAF(0),PAF(1),PAF(2),PAF(3)); }
  #undef PKW
  #undef PAF
  #undef VFR
  #undef PIN
  #undef MX3
  #undef GAPA
  #undef GAPB
  #undef EX
  #undef VRD
  #undef KRD
  #undef STEP
  #undef ENDW
  {auto rr=__builtin_amdgcn_permlane32_swap(__float_as_uint(l_reg),__float_as_uint(l_reg),false,false);l_reg=__uint_as_float(rr[0])+__uint_as_float(rr[1]);}
  if(hi==0)wsf[32+r32]=l_reg;asm volatile("s_waitcnt lgkmcnt(0)":::"memory");
  float rli[16];
  #pragma unroll
  for(int r=0;r<16;++r)rli[r]=__builtin_amdgcn_rcpf(wsf[32+crow(r,hi)]);
  bf16*Ow=O+(rowbase+q0+wid*QBLK)*PO;
  { bf16*stg=(bf16*)(shm+LDS_OST)+wid*2048;
    #pragma unroll
    for(int r=0;r<16;++r){const int orow=crow(r,hi);
      #pragma unroll
      for(int d0=0;d0<2;++d0)stg[orow*64+d0*32+r32]=__float2bfloat16(o[d0][r]*rli[r]);}
    asm volatile("s_waitcnt lgkmcnt(0)":::"memory");
    #pragma unroll
    for(int i=0;i<4;++i){const int row=i*8+(lane>>3),ch=lane&7; const u32x4 v=*(const u32x4*)(stg+row*64+ch*8); ATTN_STORE16(Ow+(long)row*PO+ch*8,v);} }
  asm volatile("s_waitcnt lgkmcnt(0)\n\ts_barrier":::"memory");
  #undef DMA_K
  #undef DMA_V
  #undef CMASK
  #undef START
  #undef RESC
  #undef ROT
}
#undef SBAR
#undef WAIT_BAR
}
namespace cg = cooperative_groups;
#define LAS __attribute__((address_space(3)))
typedef unsigned short bf16;
typedef unsigned v4u __attribute__((ext_vector_type(4)));
typedef unsigned v2u __attribute__((ext_vector_type(2)));
typedef float f32x4 __attribute__((ext_vector_type(4)));
typedef float f32x2 __attribute__((ext_vector_type(2)));
typedef float f32x16 __attribute__((ext_vector_type(16)));
typedef short bf16x8 __attribute__((ext_vector_type(8)));

constexpr int NWAVES = 8;
constexpr int D = 1024, MP = 16384, MS = 256, M = MP + MS, FF = 2816, DIN = 2560;
constexpr float EPS = 1e-6f;
constexpr float C2 = 0.125f * 1.4426950408889634f;
constexpr size_t OFF_Y = 0, OFF_KP = 17039360, OFF_VP = 33816576, OFF_PP = 50593792, OFF_CP = 50655232, OFF_KS = 50663424, OFF_VS = 50925568, OFF_PS = 51187712, OFF_CS = 51249152, OUT_TOTAL = 51257344;
constexpr size_t MiB = 1u << 20;
constexpr size_t WS_ROPE = 1 * MiB, WS_POOLWT = 2 * MiB, WS_W = 4 * MiB, WL = 40 * MiB;
constexpr size_t W_GU1 = 0, W_D1 = 11 * MiB, W_IN = 16 * MiB + MiB / 2, W_OUT = 21 * MiB + MiB / 2, W_GU2 = 23 * MiB + MiB / 2, W_D2 = 34 * MiB + MiB / 2;
constexpr size_t WS_X = 84 * MiB, WS_H = 149 * MiB, WS_MIX = 182 * MiB, WS_ACT = 215 * MiB;
constexpr size_t WS_QB = 215 * MiB, WS_KB = 232 * MiB, WS_VB = 249 * MiB, WS_ZB = 266 * MiB;
constexpr size_t WS_OB = 305 * MiB, WS_OPART = 338 * MiB, WS_ML = 347 * MiB, WS_END = 348 * MiB;
static_assert(WS_ROPE == pg8::WOFF_ROPE && WS_QB == pg8::WOFF_QB && WS_KB == pg8::WOFF_KB && WS_VB == pg8::WOFF_VB && WS_ZB == pg8::WOFF_ZB && OFF_KP == pg8::OOFF_KP && OFF_VP == pg8::OOFF_VP && OFF_PP == pg8::OOFF_PP && OFF_KS == pg8::OOFF_KS && OFF_VS == pg8::OOFF_VS && OFF_PS == pg8::OOFF_PS, "offsets");
static_assert(WS_ACT + (size_t)M * FF * 2 <= WS_OB && WS_ZB + (size_t)M * 1024 * 2 <= WS_OB && WS_X + (size_t)M * D * 4 <= WS_H && WS_H + (size_t)M * D * 2 <= WS_MIX && WS_MIX + (size_t)M * D * 2 <= WS_ACT, "ws map");
static_assert(WS_OB + (size_t)M * 1024 * 2 <= WS_OPART && WS_OPART + (size_t)32 * 2 * 9 * 32 * 128 * 4 <= WS_ML && WS_ML + (size_t)32 * 2 * 9 * 32 * 2 * 4 <= WS_END, "ws map 2");
constexpr int LDS_BYTES = 147456;

__device__ __forceinline__ unsigned pk2(float lo, float hi) { f32x2 v = {lo, hi}; typedef __bf16 b2 __attribute__((ext_vector_type(2))); b2 b = __builtin_convertvector(v, b2); return __builtin_bit_cast(unsigned, b); }
__device__ __forceinline__ float bf2f(unsigned short b) { return __builtin_bit_cast(float, (unsigned)b << 16); }
__device__ __forceinline__ bf16x8 pack8(f32x4 a, f32x4 b) { v4u w; w.x = pk2(a.x, a.y); w.y = pk2(a.z, a.w); w.z = pk2(b.x, b.y); w.w = pk2(b.z, b.w); return __builtin_bit_cast(bf16x8, w); }
__device__ __forceinline__ int crow(int r, int hi) { return (r & 3) + 8 * (r >> 2) + 4 * hi; }
__device__ __forceinline__ void xhalf_pair(float m, float& a, float& b) { a = m; b = m; asm volatile("s_nop 1\n\tv_permlane32_swap_b32 %0, %1\n\ts_nop 1" : "+v"(a), "+v"(b)); }
__device__ __forceinline__ float xhalf_max(float m) { float a, b; xhalf_pair(m, a, b); return fmaxf(a, b); }
__device__ __forceinline__ float xhalf_sum(float m) { float a, b; xhalf_pair(m, a, b); return a + b; }
template <int O> __device__ __forceinline__ float swz_xor(float v) { return __builtin_bit_cast(float, __builtin_amdgcn_ds_swizzle(__builtin_bit_cast(int, v), (O << 10) | 0x1f)); }
__device__ __forceinline__ float wave_sum(float v) {
    v += swz_xor<1>(v); v += swz_xor<2>(v); v += swz_xor<4>(v); v += swz_xor<8>(v); v += swz_xor<16>(v);
    return xhalf_sum(v);
}
#define LDS_WAIT() asm volatile("s_waitcnt lgkmcnt(0)" ::: "memory")

struct Params { const float* in[26]; float* out; unsigned char* ws; };
typedef const __attribute__((address_space(4))) unsigned char* karg_ptr;
__device__ __forceinline__ karg_ptr kargs() { karg_ptr k = (karg_ptr)__builtin_amdgcn_kernarg_segment_ptr(); asm volatile("" : "+s"(k)); return k; }
__device__ __forceinline__ const float* KIN(int i) { return *(const float* const __attribute__((address_space(4)))*)(kargs() + 8 * i); }
__device__ __forceinline__ float* KOUT() { return *(float* const __attribute__((address_space(4)))*)(kargs() + 8 * 26); }
__device__ __forceinline__ unsigned char* KWS() { return *(unsigned char* const __attribute__((address_space(4)))*)(kargs() + 8 * 27); }

template <int MODE> __device__ __forceinline__ int wmap(int nl, int row_off) {
    if (MODE == 0) return row_off + nl;
    if (MODE == 1) return (nl >> 7) * 256 + (nl & 127) + row_off;
    const int u = nl >> 8, lc = nl & 255, A = lc >> 6, n = (lc >> 5) & 1, B = (lc >> 4) & 1, f = lc & 15;
    return u * 256 + 128 * (A >> 1) + 32 * (2 * (A & 1) + B) + 16 * n + f;
}
template <int MODE> __device__ __forceinline__ void transpose_item(const float* W, int K, int N, bf16* WT, int row_off, LAS float* scr, int item, int lane) {
    const int nblk = N / 32, kb = item / nblk, nb = item % nblk, k0 = 64 * kb, n0 = 32 * nb;
#pragma unroll 8
    for (int i = 0; i < 32; ++i) { const int kk = 2 * i + (lane >> 5); scr[kk * 33 + (lane & 31)] = W[(size_t)(k0 + kk) * N + n0 + (lane & 31)]; }
    LDS_WAIT(); asm volatile("" ::: "memory");
    const int c = lane & 7;
#pragma unroll
    for (int j = 0; j < 4; ++j) { const int n = (lane >> 3) + 8 * j; const LAS float* s = scr + (8 * c) * 33 + n;
        v4u o; o.x = pk2(s[0 * 33], s[1 * 33]); o.y = pk2(s[2 * 33], s[3 * 33]); o.z = pk2(s[4 * 33], s[5 * 33]); o.w = pk2(s[6 * 33], s[7 * 33]);
        *(v4u*)(WT + (size_t)wmap<MODE>(n0 + n, row_off) * K + k0 + 8 * c) = o; }
    LDS_WAIT(); asm volatile("" ::: "memory");
}
__device__ __forceinline__ void prologue(LAS unsigned char* lds, int gw, int NGW, int wave, int lane) {
    LAS float* scr = (LAS float*)(lds + wave * 16384);
    constexpr int I_F = 16 * 88, I_IN = 16 * 80, I_OUT = 16 * 32, I_L = 6 * I_F + I_IN + I_OUT;
    for (int it = gw; it < 2 * I_L; it += NGW) {
        const int l = it / I_L; int r = it % I_L;
        unsigned char* wl = KWS() + WS_W + (size_t)l * WL;
        if (r < I_F) { transpose_item<1>(KIN(7) + (size_t)l * D * FF, D, FF, (bf16*)(wl + W_GU1), 0, scr, r, lane); continue; } r -= I_F;
        if (r < I_F) { transpose_item<1>(KIN(8) + (size_t)l * D * FF, D, FF, (bf16*)(wl + W_GU1), 128, scr, r, lane); continue; } r -= I_F;
        if (r < I_F) { transpose_item<0>(KIN(9) + (size_t)l * D * FF, FF, D, (bf16*)(wl + W_D1), 0, scr, r, lane); continue; } r -= I_F;
        if (r < I_IN) { transpose_item<2>(KIN(11) + (size_t)l * D * DIN, D, DIN, (bf16*)(wl + W_IN), 0, scr, r, lane); continue; } r -= I_IN;
        if (r < I_OUT) { transpose_item<0>(KIN(20) + (size_t)l * D * D, D, D, (bf16*)(wl + W_OUT), 0, scr, r, lane); continue; } r -= I_OUT;
        if (r < I_F) { transpose_item<1>(KIN(22) + (size_t)l * D * FF, D, FF, (bf16*)(wl + W_GU2), 0, scr, r, lane); continue; } r -= I_F;
        if (r < I_F) { transpose_item<1>(KIN(23) + (size_t)l * D * FF, D, FF, (bf16*)(wl + W_GU2), 128, scr, r, lane); continue; } r -= I_F;
        transpose_item<0>(KIN(24) + (size_t)l * D * FF, FF, D, (bf16*)(wl + W_D2), 0, scr, r, lane);
    }
    float* rope = (float*)(KWS() + WS_ROPE);
    for (int i = gw * 64 + lane; i < 2080 * 32; i += NGW * 64) {
        const int pr = i >> 5, d = i & 31; const int pos = pr < 2048 ? pr : 4096 + (pr - 2048);
        const float inv = exp2f(-(float)d * (13.287712379549449f / 32.0f));
        const float ang = (float)pos * inv;
        const double rev = (double)ang * 0.15915494309189535; const float fr = (float)(rev - __builtin_rint(rev));
        rope[pr * 64 + d] = __builtin_amdgcn_cosf(fr); rope[pr * 64 + 32 + d] = __builtin_amdgcn_sinf(fr);
    }
    bf16* pwt_ = (bf16*)(KWS() + WS_POOLWT);
    for (int i = gw * 64 + lane; i < 2 * 4 * 64 * 64; i += NGW * 64) {
        const int c = i & 63, e = (i >> 6) & 63, lg = i >> 12;
        pwt_[i] = (bf16)(pk2(KIN(17)[(size_t)lg * 4096 + c * 64 + e], 0.f) & 0xffffu);
    }
}
template <bool FINAL> __device__ __forceinline__ void norm_rows(const float* srcP, const float* srcS, const float* g, bf16* H, float* outf, int gw, int NGW, int lane) {
    const f32x4* g4 = (const f32x4*)g + lane;
    f32x4 gv[4];
#pragma unroll
    for (int j = 0; j < 4; ++j) gv[j] = g4[64 * j];
    for (int m = gw; m < M; m += NGW) {
        const float* xr = (m < MP) ? srcP + (size_t)m * D : srcS + (size_t)(m - MP) * D;
        const f32x4* x4 = (const f32x4*)xr + lane;
        f32x4 v[4]; float s = 0.f;
#pragma unroll
        for (int j = 0; j < 4; ++j) { v[j] = x4[64 * j]; s += (v[j].x * v[j].x + v[j].y * v[j].y) + (v[j].z * v[j].z + v[j].w * v[j].w); }
        const float rstd = 1.0f / sqrtf(wave_sum(s) * (1.0f / D) + EPS);
        if (FINAL) {
            f32x4* o4 = (f32x4*)(outf + (size_t)m * D) + lane;
#pragma unroll
            for (int j = 0; j < 4; ++j) o4[64 * j] = v[j] * rstd * gv[j];
        } else {
            v2u* o2 = (v2u*)(H + (size_t)m * D) + lane;
#pragma unroll
            for (int j = 0; j < 4; ++j) { const f32x4 y = v[j] * rstd * gv[j]; v2u w; w.x = pk2(y.x, y.y); w.y = pk2(y.z, y.w); o2[64 * j] = w; }
        }
    }
}
__device__ __forceinline__ f32x16 mfma32(bf16x8 a, bf16x8 b, f32x16 c) { return __builtin_amdgcn_mfma_f32_32x32x16_bf16(a, b, c, 0, 0, 0); }


__device__ __forceinline__ void skinny_gemm(LAS unsigned char* lds, const bf16* A, const bf16* Bt, int K, const float* base, float* out, float scale, int vcu, int G, int tid) {
    const int lane = tid & 63, r32 = lane & 31, hi = lane >> 5, wid = __builtin_amdgcn_readfirstlane(tid >> 6);
    LAS float* R = (LAS float*)lds;
    for (int tile = vcu; tile < 256; tile += G) {
        const int rt = tile >> 5, ct = tile & 31, kw = K >> 3, k0 = wid * kw;
        const bf16* ap = A + (size_t)(rt * 32 + r32) * K + k0 + hi * 8; const bf16* bp = Bt + (size_t)(ct * 32 + r32) * K + k0 + hi * 8;
        f32x16 acc;
#pragma unroll
        for (int r = 0; r < 16; ++r) acc[r] = 0.f;
#pragma unroll 4
        for (int ks = 0; ks < kw; ks += 16) { const bf16x8 a = *(const bf16x8*)(ap + ks), b = *(const bf16x8*)(bp + ks); acc = mfma32(a, b, acc); }
#pragma unroll
        for (int r = 0; r < 16; ++r) R[(wid * 32 + crow(r, hi)) * 32 + r32] = acc[r];
        __syncthreads();
        { const int e = tid * 2, row = e >> 5, col = e & 31; f32x2 s = {0.f, 0.f};
#pragma unroll
          for (int w = 0; w < 8; ++w) s += *(const LAS f32x2*)(R + (w * 32 + row) * 32 + col);
          const size_t o = (size_t)(rt * 32 + row) * 1024 + ct * 32 + col; const f32x2 bv = *(const f32x2*)(base + o); *(f32x2*)(out + o) = bv + s * scale; }
        __syncthreads();
    }
}

__device__ __forceinline__ void sample_piece(LAS unsigned char* lds, int pc, int l, const bf16* Qb, const float* cache_k, const float* cache_v, const float* knew, const float* vnew, float* OPART, float* MLP, int tid) {
    const int lane = tid & 63, r32 = lane & 31, hi = lane >> 5, wid = __builtin_amdgcn_readfirstlane(tid >> 6);
    const int b = pc >> 5, h = (pc >> 3) & 3, s = pc & 7;
    const bf16* qrow = Qb + (size_t)(MP + b * 32 + r32) * 512 + h * 128 + hi * 8;
    LAS float* ML = (LAS float*)lds;
    LAS float* FAC = (LAS float*)(lds + 4096);
    LAS float* OX = (LAS float*)(lds + 8192);
    const int nrounds = (s == 7) ? 2 : 1;
    for (int rd = 0; rd < nrounds; ++rd) {
        const float *Kt, *Vt; int nvalid;
        if (rd == 0) { const size_t off = ((size_t)((l * 8 + b) * 4096 + (s * 8 + wid) * 64)) * 512 + h * 128; Kt = cache_k + off; Vt = cache_v + off; nvalid = 64; }
        else { const size_t off = ((size_t)(l * 8 + b) * 32) * 512 + h * 128; Kt = knew + off; Vt = vnew + off; nvalid = (wid == 0) ? 32 : 0; }
        float mrow[2], lrow[2]; bf16x8 pw[2][4];
#pragma unroll
        for (int c = 0; c < 2; ++c) { mrow[c] = -1e30f; lrow[c] = 0.f;
#pragma unroll
            for (int k = 0; k < 4; ++k) pw[c][k] = (bf16x8){0, 0, 0, 0, 0, 0, 0, 0}; }
        if (nvalid > 0) {
#pragma unroll
            for (int c = 0; c < 2; ++c) {
                bf16x8 qf[4];
#pragma unroll
                for (int d0 = 0; d0 < 4; ++d0) qf[d0] = *(const bf16x8*)(qrow + c * 64 + d0 * 16);
                f32x16 sc[2];
#pragma unroll
                for (int kvb = 0; kvb < 2; ++kvb) {
                    if (kvb * 32 < nvalid) {
                        f32x16 a;
#pragma unroll
                        for (int r = 0; r < 16; ++r) a[r] = 0.f;
                        const float* kp = Kt + (size_t)(kvb * 32 + r32) * 512 + c * 64 + hi * 8;
#pragma unroll
                        for (int d0 = 0; d0 < 4; ++d0) { const f32x4 x0 = *(const f32x4*)(kp + d0 * 16), x1 = *(const f32x4*)(kp + d0 * 16 + 4); a = mfma32(pack8(x0, x1), qf[d0], a); }
                        sc[kvb] = a;
                    } else {
#pragma unroll
                        for (int r = 0; r < 16; ++r) sc[kvb][r] = -1e30f;
                    }
                }
                float mx = -1e30f;
#pragma unroll
                for (int r = 0; r < 16; ++r) mx = fmaxf(mx, fmaxf(sc[0][r], sc[1][r]));
                mx = xhalf_max(mx);
                float sum = 0.f;
#pragma unroll
                for (int kvb = 0; kvb < 2; ++kvb)
#pragma unroll
                    for (int r = 0; r < 16; ++r) { const float pv = __builtin_amdgcn_exp2f(sc[kvb][r] - mx); sc[kvb][r] = pv; sum += pv; }
                sum = xhalf_sum(sum);
                mrow[c] = mx; lrow[c] = sum;
#pragma unroll
                for (int kvb = 0; kvb < 2; ++kvb)
#pragma unroll
                    for (int hf = 0; hf < 2; ++hf) { v4u w; w.x = pk2(sc[kvb][8 * hf + 0], sc[kvb][8 * hf + 1]); w.y = pk2(sc[kvb][8 * hf + 2], sc[kvb][8 * hf + 3]);
                        w.z = pk2(sc[kvb][8 * hf + 4], sc[kvb][8 * hf + 5]); w.w = pk2(sc[kvb][8 * hf + 6], sc[kvb][8 * hf + 7]); pw[c][2 * kvb + hf] = __builtin_bit_cast(bf16x8, w); }
            }
        }
        asm volatile("" ::: "memory");
        f32x16 o[2][4];
#pragma unroll
        for (int c = 0; c < 2; ++c)
#pragma unroll
            for (int eb = 0; eb < 4; ++eb)
#pragma unroll
                for (int r = 0; r < 16; ++r) o[c][eb][r] = 0.f;
        if (nvalid > 0) {
#pragma unroll
            for (int ks = 0; ks < 4; ++ks) {
                if (ks * 16 < nvalid) {
#pragma unroll
                    for (int eb = 0; eb < 4; ++eb) {
                        const float* vp = Vt + (size_t)(ks * 16 + 4 * hi) * 512 + eb * 32 + r32;
                        f32x4 x0, x1;
                        x0.x = vp[0 * 512]; x0.y = vp[1 * 512]; x0.z = vp[2 * 512]; x0.w = vp[3 * 512];
                        x1.x = vp[8 * 512]; x1.y = vp[9 * 512]; x1.z = vp[10 * 512]; x1.w = vp[11 * 512];
                        const bf16x8 vf = pack8(x0, x1);
                        o[0][eb] = mfma32(pw[0][ks], vf, o[0][eb]); o[1][eb] = mfma32(pw[1][ks], vf, o[1][eb]);
                    }
                }
            }
        }
        if (hi == 0) {
#pragma unroll
            for (int c = 0; c < 2; ++c) { ML[((wid * 2 + c) * 32 + r32) * 2 + 0] = mrow[c]; ML[((wid * 2 + c) * 32 + r32) * 2 + 1] = lrow[c]; }
        }
        __syncthreads();
        const int pidx = (rd == 0) ? s : 8;
        if (tid < 64) {
            const int c = tid >> 5, q = tid & 31; float mw[8], lw[8]; float Mx = -1e30f;
#pragma unroll
            for (int w = 0; w < 8; ++w) { mw[w] = ML[((w * 2 + c) * 32 + q) * 2 + 0]; lw[w] = ML[((w * 2 + c) * 32 + q) * 2 + 1]; Mx = fmaxf(Mx, mw[w]); }
            float L = 0.f;
#pragma unroll
            for (int w = 0; w < 8; ++w) { const float f = __builtin_amdgcn_exp2f(mw[w] - Mx); FAC[(w * 2 + c) * 32 + q] = f; L += lw[w] * f; }
            float* mp = MLP + ((size_t)((((b * 4 + h) * 2 + c) * 9 + pidx) * 32 + q)) * 2; mp[0] = Mx; mp[1] = L;
        }
        __syncthreads();
#pragma unroll
        for (int c = 0; c < 2; ++c) {
#pragma unroll
            for (int eb = 0; eb < 4; ++eb)
#pragma unroll
                for (int r = 0; r < 16; ++r) { const int q = crow(r, hi); OX[(wid * 32 + q) * 128 + eb * 32 + r32] = o[c][eb][r] * FAC[(wid * 2 + c) * 32 + q]; }
            __syncthreads();
            { const int idx = tid * 8, q = idx >> 7, e = idx & 127; f32x4 s0 = {0.f, 0.f, 0.f, 0.f}, s1 = {0.f, 0.f, 0.f, 0.f};
#pragma unroll
              for (int w = 0; w < 8; ++w) { s0 += *(const LAS f32x4*)(OX + (w * 32 + q) * 128 + e); s1 += *(const LAS f32x4*)(OX + (w * 32 + q) * 128 + e + 4); }
              float* dst = OPART + ((size_t)((((b * 4 + h) * 2 + c) * 9 + pidx) * 32 + q)) * 128 + e; *(f32x4*)dst = s0; *(f32x4*)(dst + 4) = s1; }
            __syncthreads();
        }
    }
}

__device__ __forceinline__ void poolconv_tile(LAS unsigned char* lds, int tl, int l, const bf16* Zb, bf16* MIX, const float* state_pool, const float* state_conv, const bf16* pwt, const float* pool_scale,
                                              const float* conv_w, float* out_cp, float* out_cs, int tid) {
    const int lane = tid & 63, r32 = lane & 31, hi = lane >> 5, wid = __builtin_amdgcn_readfirstlane(tid >> 6);
    int b, t0, TT, rowbase; bool smp;
    if (tl < 256) { b = tl >> 5; t0 = (tl & 31) * 64; TT = 64; rowbase = b * 2048 + t0; smp = false; }
    else { b = tl - 256; t0 = 0; TT = 32; rowbase = MP + b * 32; smp = true; }
    LAS float* U = (LAS float*)lds;
    LAS bf16* Dd = (LAS bf16*)(lds + 81920);
    for (int idx = tid; idx < (15 + TT) * 64; idx += 512) {
        const int i = idx >> 6, c4 = (idx & 63) * 4; f32x4 v = {0.f, 0.f, 0.f, 0.f};
        bool fromz = true; int zr = rowbase + i - 15;
        if (i < 15) { if (smp) { v = *(const f32x4*)(state_pool + (size_t)((l * 8 + b) * 15 + i) * 256 + c4); fromz = false; } else if (t0 - 15 + i < 0) fromz = false; }
        if (fromz) { const v2u w = *(const v2u*)(Zb + (size_t)zr * 1024 + c4); v.x = bf2f(w.x & 0xffff); v.y = bf2f(w.x >> 16); v.z = bf2f(w.y & 0xffff); v.w = bf2f(w.y >> 16); }
        *(LAS f32x4*)(U + i * 256 + c4) = v;
    }
    __syncthreads();
    {
        const int ch = tid & 255, th = tid >> 8, gi = ch >> 6, w = 2 << gi;
        if (th * 32 < TT) {
            for (int tt = th * 32; tt < th * 32 + 32; ++tt) {
                float s = 0.f;
                for (int i = 0; i < w; ++i) s += U[(15 + tt - i) * 256 + ch];
                const int pos = smp ? 4096 + tt : t0 + tt; const int cnt = (pos + 1 < w) ? pos + 1 : w;
                const float d = s / (float)cnt - U[(15 + tt) * 256 + ch];
                Dd[tt * 264 + ch] = (bf16)(pk2(d, 0.f) & 0xffffu);
            }
        }
    }
    __syncthreads();
    {
        const int gi = wid >> 1, th = wid & 1;
        if (th * 32 < TT) {
            f32x16 acc0, acc1;
#pragma unroll
            for (int r = 0; r < 16; ++r) { acc0[r] = 0.f; acc1[r] = 0.f; }
#pragma unroll
            for (int ks = 0; ks < 4; ++ks) {
                const bf16x8 a = *(const LAS bf16x8*)(Dd + (th * 32 + r32) * 264 + gi * 64 + ks * 16 + hi * 8);
                const bf16x8 b0 = *(const bf16x8*)(pwt + (size_t)((l * 4 + gi) * 64 + r32) * 64 + ks * 16 + hi * 8);
                const bf16x8 b1 = *(const bf16x8*)(pwt + (size_t)((l * 4 + gi) * 64 + 32 + r32) * 64 + ks * 16 + hi * 8);
                acc0 = mfma32(a, b0, acc0); acc1 = mfma32(a, b1, acc1);
            }
            const float sc0 = pool_scale[l * 256 + gi * 64 + r32], sc1 = pool_scale[l * 256 + gi * 64 + 32 + r32];
#pragma unroll
            for (int r = 0; r < 16; ++r) { const int tok = th * 32 + crow(r, hi); bf16* mp = MIX + (size_t)(rowbase + tok) * 1024 + 512 + gi * 64 + r32;
                mp[0] = (bf16)(pk2(acc0[r] * sc0, 0.f) & 0xffffu); mp[32] = (bf16)(pk2(acc1[r] * sc1, 0.f) & 0xffffu); }
        }
    }
    {
        const int ch = tid & 255, th = tid >> 8, ts = th * 32;
        if (ts < TT) {
            const float w0 = conv_w[l * 768 + ch], w1 = conv_w[l * 768 + 256 + ch], w2 = conv_w[l * 768 + 512 + ch];
            float cm[2];
#pragma unroll
            for (int k = 0; k < 2; ++k) {
                const int tt = ts - 2 + k; float v = 0.f;
                if (tt < 0 && smp) v = state_conv[(size_t)((l * 8 + b) * 2 + (2 + tt)) * 256 + ch];
                else if (t0 + tt >= 0) { const bf16* zr = Zb + (size_t)(rowbase + tt) * 1024; v = bf2f(zr[768 + ch]) * bf2f(zr[256 + ch]); }
                cm[k] = v;
            }
            float cm2 = cm[0], cm1 = cm[1];
            for (int tt = ts; tt < ts + 32; ++tt) {
                const bf16* zr = Zb + (size_t)(rowbase + tt) * 1024;
                const float cv = bf2f(zr[768 + ch]) * bf2f(zr[256 + ch]), bg = bf2f(zr[512 + ch]);
                const float y = bg * (w0 * cm2 + w1 * cm1 + w2 * cv);
                MIX[(size_t)(rowbase + tt) * 1024 + 768 + ch] = (bf16)(pk2(y, 0.f) & 0xffffu);
                if (smp) { if (tt >= 30) out_cs[(size_t)((l * 8 + b) * 2 + tt - 30) * 256 + ch] = cv; }
                else if (t0 + tt >= 2046) out_cp[(size_t)((l * 8 + b) * 2 + t0 + tt - 2046) * 256 + ch] = cv;
                cm2 = cm1; cm1 = cv;
            }
        }
    }
    __syncthreads();
}

__device__ __forceinline__ void combine_phase(int l, const bf16* Ob_, const float* OPART_, const float* MLP_, bf16* MIX_, int gw, int NGW, int lane) {
    const float lam_init = (l == 0) ? 0.2f : 0.35550934f;
    float lam;
    { const float a = KIN(12)[l * 64 + lane] * KIN(13)[l * 64 + lane], c = KIN(14)[l * 64 + lane] * KIN(15)[l * 64 + lane];
      lam = __expf(wave_sum(a)) - __expf(wave_sum(c)) + lam_init; }
    const float g0 = KIN(16)[l * 128 + 2 * lane], g1 = KIN(16)[l * 128 + 2 * lane + 1];
    for (int wt = gw; wt < M * 4; wt += NGW) {
        const int row = wt >> 2, h = wt & 3; float a0, a1;
        if (row < MP) {
            const unsigned w1 = *(const unsigned*)(Ob_ + (size_t)row * 1024 + h * 128 + 2 * lane), w2 = *(const unsigned*)(Ob_ + (size_t)row * 1024 + 512 + h * 128 + 2 * lane);
            a0 = bf2f(w1 & 0xffff) - lam * bf2f(w2 & 0xffff); a1 = bf2f(w1 >> 16) - lam * bf2f(w2 >> 16);
        } else {
            const int rs = row - MP, b = rs >> 5, q = rs & 31; float oc[2][2];
#pragma unroll
            for (int c = 0; c < 2; ++c) {
                const size_t base = (size_t)(((b * 4 + h) * 2 + c) * 9);
                float mw[9], lw[9]; float Mx = -1e30f;
#pragma unroll
                for (int pi = 0; pi < 9; ++pi) { const f32x2 ml = *(const f32x2*)(MLP_ + ((base + pi) * 32 + q) * 2); mw[pi] = ml.x; lw[pi] = ml.y; Mx = fmaxf(Mx, ml.x); }
                float L = 0.f, s0 = 0.f, s1 = 0.f;
#pragma unroll
                for (int pi = 0; pi < 9; ++pi) { const float f = __builtin_amdgcn_exp2f(mw[pi] - Mx); L += lw[pi] * f; const f32x2 ov = *(const f32x2*)(OPART_ + ((base + pi) * 32 + q) * 128 + 2 * lane); s0 += ov.x * f; s1 += ov.y * f; }
                const float il = 1.0f / L; oc[c][0] = s0 * il; oc[c][1] = s1 * il;
            }
            a0 = oc[0][0] - lam * oc[1][0]; a1 = oc[0][1] - lam * oc[1][1];
        }
        const float ss = wave_sum(a0 * a0 + a1 * a1);
        const float r = (1.0f / sqrtf(ss * (1.0f / 128.0f) + EPS)) * (1.0f - lam_init);
        *(unsigned*)(MIX_ + (size_t)row * 1024 + h * 128 + 2 * lane) = pk2(a0 * r * g0, a1 * r * g1);
    }
}


#ifndef PROBE_SLOW_ATTN
#define PROBE_SLOW_ATTN 0
#endif
#if PROBE_SLOW_ATTN
__device__ __forceinline__ void slow_attn_phase(int l, const bf16* Qb_, float* outp, const float* cache_k, const float* cache_v, bf16* MIX_, int gw, int NGW, int lane) {
    const float lam_init = (l == 0) ? 0.2f : 0.35550934f;
    float lam;
    { const float a = KIN(12)[l * 64 + lane] * KIN(13)[l * 64 + lane], c = KIN(14)[l * 64 + lane] * KIN(15)[l * 64 + lane];
      lam = __expf(wave_sum(a)) - __expf(wave_sum(c)) + lam_init; }
    const float g0 = KIN(16)[l * 128 + 2 * lane], g1 = KIN(16)[l * 128 + 2 * lane + 1];
    for (int wt = gw; wt < M * 4; wt += NGW) {
        const int row = wt >> 2, h = wt & 3;
        const float *K0, *V0, *K1, *V1; int n0, n1;
        if (row < MP) { const int b = row >> 11, t = row & 2047; K0 = outp + OFF_KP + ((size_t)l * MP + (size_t)b * 2048) * 512 + h * 128; V0 = outp + OFF_VP + ((size_t)l * MP + (size_t)b * 2048) * 512 + h * 128; n0 = ((t >> 6) + 1) * 64; K1 = K0; V1 = V0; n1 = 0; }
        else { const int rs = row - MP, b = rs >> 5; K0 = cache_k + ((size_t)(l * 8 + b) * 4096) * 512 + h * 128; V0 = cache_v + ((size_t)(l * 8 + b) * 4096) * 512 + h * 128; n0 = 4096;
               K1 = outp + OFF_KS + ((size_t)(l * 8 + b) * 32) * 512 + h * 128; V1 = outp + OFF_VS + ((size_t)(l * 8 + b) * 32) * 512 + h * 128; n1 = 32; }
        float oc[2][2];
#pragma unroll 1
        for (int c = 0; c < 2; ++c) {
            float q[64];
#pragma unroll
            for (int d = 0; d < 64; ++d) q[d] = bf2f(Qb_[(size_t)row * 512 + h * 128 + c * 64 + d]);
            float mx = -1e30f;
            for (int seg = 0; seg < 2; ++seg) { const float* Kp = seg ? K1 : K0; const int n = seg ? n1 : n0;
                for (int j0 = 0; j0 < n; j0 += 64) { const int j = j0 + lane; float s = -1e30f;
                    if (j < n) { const float* kr = Kp + (size_t)j * 512 + c * 64; s = 0.f;
#pragma unroll
                        for (int d = 0; d < 64; ++d) s += q[d] * kr[d]; }
                    mx = fmaxf(mx, s); } }
            mx = fmaxf(mx, swz_xor<1>(mx)); mx = fmaxf(mx, swz_xor<2>(mx)); mx = fmaxf(mx, swz_xor<4>(mx)); mx = fmaxf(mx, swz_xor<8>(mx)); mx = fmaxf(mx, swz_xor<16>(mx)); mx = xhalf_max(mx);
            float L = 0.f, o0 = 0.f, o1 = 0.f;
            for (int seg = 0; seg < 2; ++seg) { const float* Kp = seg ? K1 : K0; const float* Vp = seg ? V1 : V0; const int n = seg ? n1 : n0;
                for (int j0 = 0; j0 < n; j0 += 64) { const int j = j0 + lane; float pj = 0.f;
                    if (j < n) { const float* kr = Kp + (size_t)j * 512 + c * 64; float s = 0.f;
#pragma unroll
                        for (int d = 0; d < 64; ++d) s += q[d] * kr[d];
                        pj = __builtin_amdgcn_exp2f(s - mx); }
                    L += pj;
                    const int nn = (n - j0 < 64) ? n - j0 : 64;
                    for (int jj = 0; jj < nn; ++jj) { const float pb = __builtin_bit_cast(float, __builtin_amdgcn_readlane(__builtin_bit_cast(int, pj), jj));
                        const f32x2 vv = *(const f32x2*)(Vp + (size_t)(j0 + jj) * 512 + 2 * lane); o0 += pb * vv.x; o1 += pb * vv.y; } } }
            L = wave_sum(L);
            oc[c][0] = o0 / L; oc[c][1] = o1 / L;
        }
        const float a0 = oc[0][0] - lam * oc[1][0], a1 = oc[0][1] - lam * oc[1][1];
        const float ss = wave_sum(a0 * a0 + a1 * a1);
        const float r = (1.0f / sqrtf(ss * (1.0f / 128.0f) + EPS)) * (1.0f - lam_init);
        *(unsigned*)(MIX_ + (size_t)row * 1024 + h * 128 + 2 * lane) = pk2(a0 * r * g0, a1 * r * g1);
    }
}
#endif

#ifndef PROBE_SLOW_PC
#define PROBE_SLOW_PC 0
#endif
#if PROBE_SLOW_PC
__device__ __forceinline__ float zval(const bf16* Zb_, const float* st, int l, int b, bool smp, int rowbase, int t, int col, int hist) {
    if (t >= 0) return bf2f(Zb_[(size_t)(rowbase + t) * 1024 + col]);
    if (!smp) return 0.f;
    return st[(size_t)((l * 8 + b) * hist + (hist + t)) * 256 + (col & 255)];
}
__device__ __forceinline__ void slow_pc_phase(int l, const bf16* Zb_, bf16* MIX_, int gw, int NGW, int lane) {
    const float* sp = KIN(4); const float* scv = KIN(5); const float* pw = KIN(17); const float* psc = KIN(18); const float* cw = KIN(19);
    for (int wt = gw; wt < M * 4; wt += NGW) {
        const int row = wt >> 2, g = wt & 3; const bool smp = row >= MP;
        int b, t, rowbase; if (smp) { const int rs = row - MP; b = rs >> 5; t = rs & 31; rowbase = MP + b * 32; } else { b = row >> 11; t = row & 2047; rowbase = b * 2048; }
        const int w = 2 << g, ch = g * 64 + lane;
        float s = 0.f;
        for (int i = 0; i < w; ++i) { const int tt = t - i; s += zval(Zb_, sp, l, b, smp, rowbase, tt, ch, 15); }
        const int pos = smp ? 4096 + t : t; const int cnt = (pos + 1 < w) ? pos + 1 : w;
        const float d = s / (float)cnt - zval(Zb_, sp, l, b, smp, rowbase, t, ch, 15);
        float mine = 0.f;
        for (int e = 0; e < 64; ++e) { const float v = wave_sum(d * pw[(size_t)((l * 4 + g) * 64 + lane) * 64 + e]); if (e == lane) mine = v; }
        MIX_[(size_t)row * 1024 + 512 + ch] = (bf16)(pk2(mine * psc[l * 256 + ch], 0.f) & 0xffffu);
        float cvv[3];
#pragma unroll
        for (int k = 0; k < 3; ++k) { const int tt = t - 2 + k;
            if (tt >= 0) cvv[k] = bf2f(Zb_[(size_t)(rowbase + tt) * 1024 + 768 + ch]) * bf2f(Zb_[(size_t)(rowbase + tt) * 1024 + 256 + ch]);
            else cvv[k] = smp ? scv[(size_t)((l * 8 + b) * 2 + (2 + tt)) * 256 + ch] : 0.f; }
        const float bgv = bf2f(Zb_[(size_t)row * 1024 + 512 + ch]);
        const float y = bgv * (cw[l * 768 + ch] * cvv[0] + cw[l * 768 + 256 + ch] * cvv[1] + cw[l * 768 + 512 + ch] * cvv[2]);
        MIX_[(size_t)row * 1024 + 768 + ch] = (bf16)(pk2(y, 0.f) & 0xffffu);
    }
}
#endif

#define XB_TMO      128
#define XB_XCNT(j)  (256  + 64 * (j))
#define XB_XSUB(j)  (1280 + 64 * (j))
#define XB_XGEN(j)  (2304 + 64 * (j))
#define XB_TOP      3328
#define XB_TOPGEN   3392
#define XCD_BAR_WORDS 3456
#define XB_SPIN_CAP (1u << 18)
__device__ __forceinline__ unsigned xb_ld(unsigned* p)              { return __hip_atomic_load(p, __ATOMIC_RELAXED, __HIP_MEMORY_SCOPE_AGENT); }
__device__ __forceinline__ unsigned xb_add(unsigned* p, unsigned v) { return __hip_atomic_fetch_add(p, v, __ATOMIC_RELAXED, __HIP_MEMORY_SCOPE_AGENT); }
__device__ __forceinline__ unsigned xb_xcc_id() { return (unsigned)__builtin_amdgcn_s_getreg((3 << 11) | 20) & 0xFu; }
#define XB_SPIN(cond, bar) do { unsigned _sp = 0; while (cond) { __builtin_amdgcn_s_sleep(1); \
    if ((++_sp & 255u) == 0u) { if (xb_ld(&(bar)[XB_TMO])) break; if (_sp > XB_SPIN_CAP) { atomicAdd(&(bar)[XB_TMO], 1u); break; } } } } while (0)
__device__ __forceinline__ void xcd_barrier_complete(unsigned* bar, unsigned x, unsigned& nloc, unsigned& nx) {
    const unsigned G = gridDim.x * gridDim.y * gridDim.z;
    unsigned sum, cnt, mine, sp = 0u;
    for (;;) {
        sum = 0u; cnt = 0u; mine = 0u;
#pragma unroll
        for (unsigned j = 0; j < 16; ++j) { const unsigned c = xb_ld(&bar[XB_XCNT(j)]); sum += c; cnt += (c > 0u) ? 1u : 0u; mine = (j == x) ? c : mine; }
        if (sum == G) break;
        __builtin_amdgcn_s_sleep(1);
        if ((++sp & 255u) == 0u) { if (xb_ld(&bar[XB_TMO])) break; if (sp > XB_SPIN_CAP) { atomicAdd(&bar[XB_TMO], 1u); break; } }
    }
    nloc = mine > 0u ? mine : 1u; nx = cnt > 0u ? cnt : 1u;
}
__device__ __forceinline__ void xcd_barrier(unsigned* bar, unsigned x, volatile LAS unsigned* st) {
    asm volatile("s_waitcnt vmcnt(0)" ::: "memory");
    __syncthreads();
    if (threadIdx.x == 0) {
        __builtin_amdgcn_s_waitcnt(0);
        unsigned nloc = st[0], nx = st[1];
        if (nloc == 0u) { xcd_barrier_complete(bar, x, nloc, nx); st[0] = nloc; st[1] = nx; }
        const unsigned old = xb_add(&bar[XB_XSUB(x)], 1u);
        const unsigned gen = old / nloc;
        if (old + 1u == (gen + 1u) * nloc) {
            __builtin_amdgcn_fence(__ATOMIC_RELEASE, "agent");
            asm volatile("s_waitcnt vmcnt(0)" ::: "memory");
            const unsigned og = xb_add(&bar[XB_TOP], 1u);
            const unsigned tg = og / nx;
            if (og + 1u == (tg + 1u) * nx) xb_add(&bar[XB_TOPGEN], 1u);
            else XB_SPIN(xb_ld(&bar[XB_TOPGEN]) == tg, bar);
            __builtin_amdgcn_fence(__ATOMIC_ACQUIRE, "agent");
            xb_add(&bar[XB_XGEN(x)], 1u);
            asm volatile("s_waitcnt vmcnt(0)" ::: "memory");
        } else {
            XB_SPIN(xb_ld(&bar[XB_XGEN(x)]) == gen, bar);
            __builtin_amdgcn_fence(__ATOMIC_ACQUIRE, "agent");
            asm volatile("s_waitcnt vmcnt(0)" ::: "memory");
        }
    }
    __syncthreads();
}
#define CG_SYNC() do { asm volatile("s_waitcnt vmcnt(0) lgkmcnt(0)" ::: "memory"); grid.sync(); asm volatile("" ::: "memory"); } while (0)
#define GRID_SYNC() xcd_barrier((unsigned*)KWS() + 4096, xcc, (volatile LAS unsigned*)(lds + LDS_BYTES - 64))
__global__ void __launch_bounds__(NWAVES * 64, 2) mega_fwd(Params p) {
    extern __shared__ __attribute__((aligned(16))) unsigned char lds_raw[];
    LAS unsigned char* lds = (LAS unsigned char*)lds_raw;
    cg::grid_group grid = cg::this_grid();
    const int tid = threadIdx.x, lane = tid & 63, wave = __builtin_amdgcn_readfirstlane(tid >> 6);
    const int G = gridDim.x; const int bx = blockIdx.x; const int vcu0 = (G % 8 == 0) ? (bx % 8) * (G / 8) + bx / 8 : bx;
    const int NGW = G * NWAVES;
#define X ((float*)(ws + WS_X))
#define H ((bf16*)(ws + WS_H))
#define MIX ((bf16*)(ws + WS_MIX))
#define ACT ((bf16*)(ws + WS_ACT))
#define Qb ((bf16*)(ws + WS_QB))
#define Kb ((bf16*)(ws + WS_KB))
#define Vb ((bf16*)(ws + WS_VB))
#define Zb ((bf16*)(ws + WS_ZB))
#define Ob ((bf16*)(ws + WS_OB))
#define OPART ((float*)(ws + WS_OPART))
#define MLP ((float*)(ws + WS_ML))
#define pwt ((const bf16*)(ws + WS_POOLWT))
    if (tid < 16) ((LAS unsigned*)(lds + LDS_BYTES - 64))[tid] = 0u;
    const unsigned xcc = xb_xcc_id();
    if (tid == 0) (void)xb_add((unsigned*)KWS() + 4096 + XB_XCNT(xcc), 1u);
    __syncthreads();
    { const int gw = vcu0 * NWAVES + wave; prologue(lds, gw, NGW, wave, lane); }
    CG_SYNC();
#define FRESH_IDS() int tid = threadIdx.x; asm volatile("" : "+v"(tid)); const int lane = tid & 63, wave = __builtin_amdgcn_readfirstlane(tid >> 6); int vcu = vcu0; asm volatile("" : "+s"(vcu)); const int gw = vcu * NWAVES + wave; (void)lane; (void)gw; (void)wave
#pragma unroll 1
    for (int step = 0; step < 4; ++step) {
        const int l = step >> 1, f = step & 1;
        const bool first = (step == 0);
        { FRESH_IDS(); unsigned char* const ws = KWS();
          norm_rows<false>(first ? KIN(0) : X, first ? KIN(1) : X + (size_t)MP * D, (f ? KIN(21) : KIN(6)) + l * D, H, nullptr, gw, NGW, lane); }
        GRID_SYNC();
        { FRESH_IDS(); unsigned char* const ws = KWS(); unsigned char* const wl = ws + WS_W + (size_t)l * WL;
          pg8::Gemm g{H, (const bf16*)(wl + (f ? W_GU2 : W_GU1)), M, 2 * FF, D}; pg8::StaticOrder S; S.init(M, 2 * FF, G, bx);
          pg8::EpiSwiGLU E{ACT, FF};
          pg8::gemm_phase<pg8::EpiSwiGLU, pg8::StaticOrder, true, true>(lds, g, S, E); }
        GRID_SYNC();
        { FRESH_IDS(); unsigned char* const ws = KWS(); unsigned char* const wl = ws + WS_W + (size_t)l * WL;
          pg8::Gemm g{ACT, (const bf16*)(wl + (f ? W_D2 : W_D1)), MP, D, FF}; pg8::StaticOrder S; S.init(MP, D, G, bx);
          pg8::EpiResid E{first ? KIN(0) : X, first ? KIN(1) : X + (size_t)MP * D, X, 0.5f};
          pg8::gemm_phase<pg8::EpiResid, pg8::StaticOrder, true, true>(lds, g, S, E);
          skinny_gemm(lds, ACT + (size_t)MP * FF, (const bf16*)(wl + (f ? W_D2 : W_D1)), FF, first ? KIN(1) : X + (size_t)MP * D, X + (size_t)MP * D, 0.5f, vcu, G, tid); }
        GRID_SYNC();
        if (f == 0) {
            { FRESH_IDS(); unsigned char* const ws = KWS();
              norm_rows<false>(X, X + (size_t)MP * D, KIN(10) + l * D, H, nullptr, gw, NGW, lane); }
            GRID_SYNC();
            { FRESH_IDS(); unsigned char* const ws = KWS(); unsigned char* const wl = ws + WS_W + (size_t)l * WL;
              pg8::Gemm g{H, (const bf16*)(wl + W_IN), M, DIN, D}; pg8::StaticOrder S; S.init(M, DIN, G, bx);
              pg8::EpiWin E{ws, KOUT(), l, C2};
              pg8::gemm_phase<pg8::EpiWin, pg8::StaticOrder, true, true>(lds, g, S, E); }
            GRID_SYNC();
#if !PROBE_SLOW_ATTN
            { FRESH_IDS(); unsigned char* const ws = KWS();
              for (int i = 0; i < 4; ++i) {
                const int L = i * G + vcu; if (L >= 1024) break;
                const int bh = (L & 255) >> 1, sI = L & 1, ii = L >> 8;
                const int qb = sI == 0 ? (ii == 0 ? 7 : ii == 1 ? 0 : ii == 2 ? 4 : 3) : (ii == 0 ? 6 : ii == 1 ? 1 : ii == 2 ? 5 : 2);
                const int b = bh >> 4, vh = bh & 15, hh = vh >> 2, c = (vh >> 1) & 1, hf = vh & 1;
                attn_body::attn_unit<8>(b, qb, (const attn_body::bf16*)(Qb + (hh * 2 + c) * 64), (const attn_body::bf16*)(Kb + (hh * 2 + c) * 64), (const attn_body::bf16*)(Vb + hh * 128 + hf * 64),
                                        (attn_body::bf16*)(Ob + c * 512 + hh * 128 + hf * 64), (char*)lds_raw);
              } }
            __syncthreads();
            { FRESH_IDS(); unsigned char* const ws = KWS(); float* const outp = KOUT();
              for (int pc = vcu; pc < 256; pc += G)
                sample_piece(lds, pc, l, Qb, KIN(2), KIN(3), outp + OFF_KS, outp + OFF_VS, OPART, MLP, tid); }
            __syncthreads();
#endif
            { FRESH_IDS(); unsigned char* const ws = KWS(); float* const outp = KOUT();
              for (int tl = vcu; tl < 264; tl += G)
                poolconv_tile(lds, tl, l, Zb, MIX, KIN(4), KIN(5), pwt, KIN(18), KIN(19), outp + OFF_CP, outp + OFF_CS, tid); }
            GRID_SYNC();
#if PROBE_SLOW_PC
            { FRESH_IDS(); unsigned char* const ws = KWS();
              slow_pc_phase(l, Zb, MIX, gw, NGW, lane); }
#endif
#if PROBE_SLOW_ATTN
            { FRESH_IDS(); unsigned char* const ws = KWS();
              slow_attn_phase(l, Qb, KOUT(), KIN(2), KIN(3), MIX, gw, NGW, lane); }
#else
            { FRESH_IDS(); unsigned char* const ws = KWS();
              combine_phase(l, Ob, OPART, MLP, MIX, gw, NGW, lane); }
#endif
            GRID_SYNC();
            { FRESH_IDS(); unsigned char* const ws = KWS(); unsigned char* const wl = ws + WS_W + (size_t)l * WL;
              pg8::Gemm g{MIX, (const bf16*)(wl + W_OUT), MP, D, D}; pg8::StaticOrder S; S.init(MP, D, G, bx);
              pg8::EpiResid E{X, X + (size_t)MP * D, X, 1.0f};
              pg8::gemm_phase<pg8::EpiResid, pg8::StaticOrder, true, true>(lds, g, S, E);
              skinny_gemm(lds, MIX + (size_t)MP * D, (const bf16*)(wl + W_OUT), D, X + (size_t)MP * D, X + (size_t)MP * D, 1.0f, vcu, G, tid); }
            GRID_SYNC();
        }
    }
    { FRESH_IDS(); unsigned char* const ws = KWS();
      norm_rows<true>(X, X + (size_t)MP * D, KIN(25), nullptr, KOUT() + OFF_Y, gw, NGW, lane); }
}

extern "C" void kernel_launch(void* const* d_in, const int* in_sizes, int n_in, void* d_out, int out_size, void* d_ws, size_t ws_size, hipStream_t stream) {
    static int grid = 0;
    if (grid == 0) {
        if (n_in != 26 || (size_t)out_size != OUT_TOTAL || ws_size < WS_END) { fprintf(stderr, "kernel_launch: unexpected problem shape: n_in %d out %d ws %zu\n", n_in, out_size, ws_size); grid = -1; return; }
        int dev = 0, cus = 0, per_cu = 0;
        if (hipGetDevice(&dev) != hipSuccess || hipDeviceGetAttribute(&cus, hipDeviceAttributeMultiprocessorCount, dev) != hipSuccess) { grid = -1; return; }
        if (hipFuncSetAttribute((const void*)mega_fwd, hipFuncAttributeMaxDynamicSharedMemorySize, LDS_BYTES) != hipSuccess) { fprintf(stderr, "kernel_launch: hipFuncSetAttribute failed\n"); grid = -1; return; }
        if (hipOccupancyMaxActiveBlocksPerMultiprocessor(&per_cu, (const void*)mega_fwd, NWAVES * 64, LDS_BYTES) != hipSuccess || per_cu < 1) { fprintf(stderr, "kernel_launch: occupancy query says %d\n", per_cu); per_cu = 1; }
        (void)hipGetLastError();
        grid = cus * per_cu;
    }
    if (grid < 0) return;
    if (hipMemsetAsync(d_ws, 0, 65536, stream) != hipSuccess) { fprintf(stderr, "kernel_launch: memset failed\n"); return; }
    Params p{};
    for (int i = 0; i < 26; ++i) p.in[i] = (const float*)d_in[i];
    p.out = (float*)d_out; p.ws = (unsigned char*)d_ws;
    void* args[] = {&p};
    const hipError_t e = hipLaunchCooperativeKernel((const void*)mega_fwd, dim3(grid), dim3(NWAVES * 64), args, LDS_BYTES, stream);
    if (e != hipSuccess) fprintf(stderr, "kernel_launch: cooperative launch failed: %s (grid %d)\n", hipGetErrorString(e), grid);
}
```

```cpp
#include <hip/hip_runtime.h>
#include <hip/hip_cooperative_groups.h>
#include <cstdio>
#include <cstdint>
namespace pg8 {
#define PG8_LAS __attribute__((address_space(3)))
typedef unsigned short bf16_t;
typedef short bf16x8 __attribute__((ext_vector_type(8)));
typedef float f32x4 __attribute__((ext_vector_type(4)));
typedef unsigned u32x4 __attribute__((ext_vector_type(4)));
constexpr int BM = 256, BK = 64, HALF = 128, HTB = HALF * BK * 2  , STAGE_BYTES = 8 * HTB, NXCD = 8, WGM = 8;

__host__ __device__ __forceinline__ int lds_byte(int r, int c) { const int st = (r >> 4) * 2 + (c >> 5), rr = r & 15, cc = c & 31, ob = rr * 64 + cc * 2; return st * 1024 + (ob ^ (((ob >> 9) & 1) << 5)); }
__host__ __device__ __forceinline__ void stage_rc(int b, int& R, int& C) { const int st = b / 1024, sb = b % 1024, swz = sb ^ (((sb >> 9) & 1) << 5); R = (st >> 1) * 16 + swz / 64; C = (st & 1) * 32 + (swz % 64) / 2; }
__host__ __device__ __forceinline__ int perm32(int rho) { const int n = rho >> 4, i = rho & 15; return 8 * (i >> 2) + 4 * n + (i & 3); }

struct Unit { int pm, pn; };
struct Gemm { const bf16_t* A; const bf16_t* Bt; int M, N, K; };

struct StaticOrder {
    int nM, nN, nwg, G, c;
    __host__ __device__ void init(int M, int N, int G_, int c_) { nM = M / BM; nN = N / BM; nwg = nM * nN; G = G_; c = c_; }
    __host__ __device__ bool next(int i, Unit& u) const {
        const long L = (long)i * G + c; if (L >= nwg) return false;
        int wgid = (int)L; { const int q = nwg / NXCD, r = nwg % NXCD, xcd = wgid % NXCD, off = wgid / NXCD; wgid = (xcd < r ? xcd * (q + 1) : r * (q + 1) + (xcd - r) * q) + off; }
        const int nig = WGM * nN, gid = wgid / nig, fm = gid * WGM, gsz = (nM - fm) < WGM ? (nM - fm) : WGM;
        u.pm = fm + ((wgid % nig) % gsz); u.pn = (wgid % nig) / gsz; return true;
    }
    __device__ __forceinline__ void a_ready(const Unit&) const {}
    __device__ __forceinline__ void done(const Unit&) const {}
};

__device__ __forceinline__ unsigned cvt_pk_bf16(float lo, float hi) { unsigned r; asm volatile("v_cvt_pk_bf16_f32 %0, %1, %2" : "=v"(r) : "v"(lo), "v"(hi)); return r; }
typedef float f32x2 __attribute__((ext_vector_type(2)));
typedef unsigned u32x2 __attribute__((ext_vector_type(2)));
constexpr size_t WOFF_ROPE = (size_t)1 << 20, WOFF_QB = (size_t)215 << 20, WOFF_KB = (size_t)232 << 20, WOFF_VB = (size_t)249 << 20, WOFF_ZB = (size_t)266 << 20;
constexpr size_t OOFF_KP = 17039360, OOFF_VP = 33816576, OOFF_PP = 50593792, OOFF_KS = 50663424, OOFF_VS = 50925568, OOFF_PS = 51187712;
__device__ __forceinline__ float silu_mul(float g, float u) { const float e = __builtin_amdgcn_exp2f(-1.4426950408889634f * g); return g * u * __builtin_amdgcn_rcpf(1.0f + e); }
struct EpiSwiGLU {
    static constexpr bool PERM = true, AFTER_DRAIN = false;
    bf16_t* O; int ldc;
    __device__ __forceinline__ void operator()(const f32x4 (&acc)[2][2][4][2], const Unit& u, int wr, int wc, int fr, int fq) const {
        const int row0 = u.pm * BM + wr * 64 + fr; const int col0 = u.pn * 128 + wc * 32 + 8 * fq;
#pragma unroll
        for (int ai = 0; ai < 2; ++ai)
#pragma unroll
            for (int m = 0; m < 4; ++m) {
                bf16_t* p = O + (size_t)(row0 + ai * HALF + m * 16) * ldc + col0;
                const f32x4 g0 = acc[ai][0][m][0], g1 = acc[ai][0][m][1], u0 = acc[ai][1][m][0], u1 = acc[ai][1][m][1];
                u32x4 w;
                w.x = cvt_pk_bf16(silu_mul(g0[0], u0[0]), silu_mul(g0[1], u0[1])); w.y = cvt_pk_bf16(silu_mul(g0[2], u0[2]), silu_mul(g0[3], u0[3]));
                w.z = cvt_pk_bf16(silu_mul(g1[0], u1[0]), silu_mul(g1[1], u1[1])); w.w = cvt_pk_bf16(silu_mul(g1[2], u1[2]), silu_mul(g1[3], u1[3]));
                *(u32x4*)p = w;
                asm volatile("" ::: "memory");
            }
    }
};
struct EpiResid {
    static constexpr bool PERM = false, AFTER_DRAIN = false;
    const float* baseP; const float* baseS; float* out; float scale;
    __device__ __forceinline__ void operator()(const f32x4 (&acc)[2][2][4][2], const Unit& u, int wr, int wc, int fr, int fq) const {
        const int col0 = u.pn * BM + wc * 32 + 4 * fq;
#pragma unroll
        for (int ai = 0; ai < 2; ++ai)
#pragma unroll
            for (int m = 0; m < 4; ++m) {
                const int row = u.pm * BM + ai * HALF + wr * 64 + m * 16 + fr;
                const float* bp = (row < 16384) ? baseP + (size_t)row * 1024 : baseS + (size_t)(row - 16384) * 1024;
                float* op = out + (size_t)row * 1024;
#pragma unroll
                for (int bj = 0; bj < 2; ++bj)
#pragma unroll
                    for (int n = 0; n < 2; ++n) { const int c = col0 + bj * HALF + n * 16; const f32x4 b = *(const f32x4*)(bp + c); *(f32x4*)(op + c) = b + acc[ai][bj][m][n] * scale; }
                asm volatile("" ::: "memory");
            }
    }
};
struct EpiWin {
    static constexpr bool PERM = false, AFTER_DRAIN = false;
    unsigned char* ws; float* outp; int l; float qscale;
    __device__ __forceinline__ void operator()(const f32x4 (&acc)[2][2][4][2], const Unit& u, int wr, int wc, int fr, int fq) const {
        const int pn = u.pn;
        bf16_t* const Qb = (bf16_t*)(ws + WOFF_QB); bf16_t* const Kb = (bf16_t*)(ws + WOFF_KB); bf16_t* const Vb = (bf16_t*)(ws + WOFF_VB); bf16_t* const Zb = (bf16_t*)(ws + WOFF_ZB);
        const float* const rope = (const float*)(ws + WOFF_ROPE);
        float* const kP = outp + OOFF_KP + (size_t)l * 16384 * 512; float* const vP = outp + OOFF_VP + (size_t)l * 16384 * 512;
        float* const kS = outp + OOFF_KS + (size_t)l * 256 * 512; float* const vS = outp + OOFF_VS + (size_t)l * 256 * 512;
        float* const poolP = outp + OOFF_PP + (size_t)l * 8 * 15 * 256; float* const poolS = outp + OOFF_PS + (size_t)l * 8 * 15 * 256;
#pragma unroll
        for (int ai = 0; ai < 2; ++ai)
#pragma unroll
            for (int m = 0; m < 4; ++m) {
                const int row = u.pm * BM + ai * HALF + wr * 64 + m * 16 + fr;
                const bool smp = row >= 16384; const int rs = row - 16384;
                const int prow = smp ? 2048 + (rs & 31) : (row & 2047);
#pragma unroll
                for (int bj = 0; bj < 2; ++bj) {
                    const int dlo = 16 * (wc & 1) + 4 * fq, lc0 = 64 * (2 * bj + (wc >> 1)) + dlo;
                    const f32x4 a0 = acc[ai][bj][m][0], a1 = acc[ai][bj][m][1];
                    if (pn < 4) {
                        const f32x4 cs = *(const f32x4*)(rope + (size_t)prow * 64 + dlo), sn = *(const f32x4*)(rope + (size_t)prow * 64 + 32 + dlo);
                        const f32x4 r0 = a0 * cs - a1 * sn, r1 = a1 * cs + a0 * sn;
                        if (pn < 2) {
                            const int col = 256 * pn + lc0; bf16_t* q = Qb + (size_t)row * 512 + col;
                            u32x2 w0, w1; w0.x = cvt_pk_bf16(r0[0] * qscale, r0[1] * qscale); w0.y = cvt_pk_bf16(r0[2] * qscale, r0[3] * qscale);
                            w1.x = cvt_pk_bf16(r1[0] * qscale, r1[1] * qscale); w1.y = cvt_pk_bf16(r1[2] * qscale, r1[3] * qscale);
                            *(u32x2*)q = w0; *(u32x2*)(q + 32) = w1;
                        } else {
                            const int col = 256 * (pn - 2) + lc0; bf16_t* k = Kb + (size_t)row * 512 + col;
                            float* ko = smp ? kS + (size_t)rs * 512 + col : kP + (size_t)row * 512 + col;
                            *(f32x4*)ko = r0; *(f32x4*)(ko + 32) = r1;
                            u32x2 w0, w1; w0.x = cvt_pk_bf16(r0[0], r0[1]); w0.y = cvt_pk_bf16(r0[2], r0[3]); w1.x = cvt_pk_bf16(r1[0], r1[1]); w1.y = cvt_pk_bf16(r1[2], r1[3]);
                            *(u32x2*)k = w0; *(u32x2*)(k + 32) = w1;
                        }
                    } else if (pn < 6) {
                        const int col = 256 * (pn - 4) + lc0; bf16_t* v = Vb + (size_t)row * 512 + col;
                        float* vo = smp ? vS + (size_t)rs * 512 + col : vP + (size_t)row * 512 + col;
                        *(f32x4*)vo = a0; *(f32x4*)(vo + 32) = a1;
                        u32x2 w0, w1; w0.x = cvt_pk_bf16(a0[0], a0[1]); w0.y = cvt_pk_bf16(a0[2], a0[3]); w1.x = cvt_pk_bf16(a1[0], a1[1]); w1.y = cvt_pk_bf16(a1[2], a1[3]);
                        *(u32x2*)v = w0; *(u32x2*)(v + 32) = w1;
                    } else {
                        const int col = 256 * (pn - 6) + lc0; bf16_t* z = Zb + (size_t)row * 1024 + col;
                        u32x2 w0, w1; w0.x = cvt_pk_bf16(a0[0], a0[1]); w0.y = cvt_pk_bf16(a0[2], a0[3]); w1.x = cvt_pk_bf16(a1[0], a1[1]); w1.y = cvt_pk_bf16(a1[2], a1[3]);
                        *(u32x2*)z = w0; *(u32x2*)(z + 32) = w1;
                        if (pn == 6) {
                            if (smp) { const int b = rs >> 5, t = rs & 31; if (t >= 17) { float* po = poolS + (size_t)(b * 15 + t - 17) * 256 + lc0; *(f32x4*)po = a0; *(f32x4*)(po + 32) = a1; } }
                            else { const int b = row >> 11, t = row & 2047; if (t >= 2033) { float* po = poolP + (size_t)(b * 15 + t - 2033) * 256 + lc0; *(f32x4*)po = a0; *(f32x4*)(po + 32) = a1; } }
                        }
                    }
                }
                asm volatile("" ::: "memory");
            }
    }
};
template <class Epi, class Sched, bool ALIGN_EPI = false, bool SP2 = false>
__device__ __forceinline__ void gemm_phase(PG8_LAS unsigned char* lds, const Gemm g, const Sched& S, const Epi& E) {
    int tid_l = threadIdx.x; asm volatile("" : "+v"(tid_l)); const int tid = tid_l, wid = __builtin_amdgcn_readfirstlane(tid >> 6), lane = tid & 63, wr = wid >> 2, wc = wid & 3, fr = lane & 15, fq = lane >> 4;
    const int K = g.K, nt = K / BK;
    unsigned voffA[2], voffB[2];
#pragma unroll
    for (int i = 0; i < 2; ++i) { int R, C; stage_rc(tid * 16 + i * 8192, R, C); const int Rb = Epi::PERM ? ((R & ~31) + perm32(R & 31)) : R;
        voffA[i] = (unsigned)(R * K + C) * 2u; voffB[i] = (unsigned)(Rb * K + C) * 2u; }
    const size_t kstep = (size_t)(BK * 2);
    const size_t hstep = (size_t)HALF * K * 2;
    const size_t tstep = 2 * hstep;
    const unsigned ldsw = (unsigned)wid * 1024u;
    const int aoff = lds_byte(wr * 64 + fr, fq * 8), boff = lds_byte(wc * 32 + fr, fq * 8);
#define PG8_SA(b, h) (((b) * 2 + (h)) * HTB)
#define PG8_SB(b, h) ((4 + (b) * 2 + (h)) * HTB)
#define PG8_STAGE(bufoff, gbase, voff) do { _Pragma("unroll") for (int _i = 0; _i < 2; ++_i) \
        __builtin_amdgcn_global_load_lds((const unsigned*)((const char*)(gbase) + (voff)[_i]), (PG8_LAS unsigned*)(lds + (bufoff) + ldsw + _i * 8192), 16, 0, 0); } while (0)
#define PG8_LDA(dst, b, h) do { _Pragma("unroll") for (int m = 0; m < 4; ++m) _Pragma("unroll") for (int k = 0; k < 2; ++k) dst[m][k] = *(const PG8_LAS bf16x8*)(lds + PG8_SA(b, h) + aoff + m * 2048 + k * 1024); } while (0)
#define PG8_LDB(dst, b, h) do { _Pragma("unroll") for (int n = 0; n < 2; ++n) _Pragma("unroll") for (int k = 0; k < 2; ++k) dst[n][k] = *(const PG8_LAS bf16x8*)(lds + PG8_SB(b, h) + boff + n * 2048 + k * 1024); } while (0)
#define PG8_MMA(ai, bj, At, Bt) do { __builtin_amdgcn_s_setprio(1); _Pragma("unroll") for (int m = 0; m < 4; ++m) _Pragma("unroll") for (int n = 0; n < 2; ++n) _Pragma("unroll") for (int k = 0; k < 2; ++k) \
        acc[ai][bj][m][n] = __builtin_amdgcn_mfma_f32_16x16x32_bf16(Bt[n][k], At[m][k], acc[ai][bj][m][n], 0, 0, 0); __builtin_amdgcn_s_setprio(0); } while (0)
#define PG8_WAIT_V(n) asm volatile("s_waitcnt vmcnt(" #n ")" ::: "memory")
#define PG8_WAIT_L(n) asm volatile("s_waitcnt lgkmcnt(" #n ")" ::: "memory")
#define PG8_BAR __builtin_amdgcn_s_barrier()
#define PG8_SCHED __builtin_amdgcn_sched_barrier(0)
    Unit cur, nxt; int ui = 0;
    if (!S.next(0, cur)) return;
    f32x4 acc[2][2][4][2];
#pragma unroll
    for (int a = 0; a < 2; ++a)
#pragma unroll
        for (int b = 0; b < 2; ++b)
#pragma unroll
            for (int m = 0; m < 4; ++m)
#pragma unroll
                for (int n = 0; n < 2; ++n) acc[a][b][m][n] = (f32x4){0.f, 0.f, 0.f, 0.f};
    bf16x8 At[4][2], B0[2][2], B1[2][2];
    const char* cA = (const char*)g.A + (size_t)cur.pm * tstep; const char* cB = (const char*)g.Bt + (size_t)cur.pn * tstep;
    S.a_ready(cur);
    if constexpr (SP2) {
        PG8_STAGE(PG8_SB(0, 0), cB, voffB); PG8_STAGE(PG8_SB(0, 1), cB + hstep, voffB); PG8_STAGE(PG8_SA(0, 0), cA, voffA); PG8_STAGE(PG8_SA(0, 1), cA + hstep, voffA);
        if (wr == 1) PG8_BAR;
        PG8_WAIT_V(2); PG8_BAR;
        PG8_STAGE(PG8_SB(1, 0), cB + kstep, voffB); PG8_STAGE(PG8_SA(1, 0), cA + kstep, voffA); PG8_STAGE(PG8_SB(1, 1), cB + hstep + kstep, voffB);
        PG8_WAIT_V(6); PG8_BAR;
    } else {
        PG8_STAGE(PG8_SB(0, 0), cB, voffB); PG8_STAGE(PG8_SA(0, 0), cA, voffA); PG8_STAGE(PG8_SB(0, 1), cB + hstep, voffB); PG8_STAGE(PG8_SA(0, 1), cA + hstep, voffA);
        if (wr == 1) PG8_BAR;
        PG8_WAIT_V(4); PG8_BAR;
        PG8_STAGE(PG8_SB(1, 0), cB + kstep, voffB); PG8_STAGE(PG8_SA(1, 0), cA + kstep, voffA); PG8_STAGE(PG8_SB(1, 1), cB + hstep + kstep, voffB);
        PG8_WAIT_V(6); PG8_BAR;
    }
    for (;;) {
        const bool has_next = S.next(ui + 1, nxt);
        const char* nA = has_next ? (const char*)g.A + (size_t)nxt.pm * tstep : cA; const char* nB = has_next ? (const char*)g.Bt + (size_t)nxt.pn * tstep : cB;
        for (int t = 0; t < nt; t += 2) {
            const bool last = (t == nt - 2);
            const char* a1 = cA + (size_t)(t + 1) * kstep;
            const char* a2 = last ? nA : cA + (size_t)(t + 2) * kstep; const char* b2 = last ? nB : cB + (size_t)(t + 2) * kstep;
            const char* a3 = a2 + kstep; const char* b3 = b2 + kstep;
            if (last && has_next) S.a_ready(nxt);
            if constexpr (SP2) {
            PG8_LDB(B0, 0, 0); PG8_LDB(B1, 0, 1); PG8_SCHED; PG8_LDA(At, 0, 0); PG8_STAGE(PG8_SA(1, 1), a1 + hstep, voffA);
            PG8_WAIT_V(8); PG8_WAIT_L(0); PG8_BAR; PG8_MMA(0, 0, At, B0); PG8_MMA(0, 1, At, B1); PG8_BAR; PG8_SCHED;
            PG8_LDA(At, 0, 1); PG8_STAGE(PG8_SB(0, 0), b2, voffB); PG8_STAGE(PG8_SB(0, 1), b2 + hstep, voffB); PG8_STAGE(PG8_SA(0, 0), a2, voffA);
            PG8_WAIT_V(8); PG8_WAIT_L(0); PG8_BAR; PG8_MMA(1, 0, At, B0); PG8_MMA(1, 1, At, B1); PG8_BAR; PG8_SCHED;
            PG8_LDB(B0, 1, 0); PG8_LDB(B1, 1, 1); PG8_SCHED; PG8_LDA(At, 1, 0); PG8_STAGE(PG8_SA(0, 1), a2 + hstep, voffA);
            PG8_WAIT_V(8); PG8_WAIT_L(0); PG8_BAR; PG8_MMA(0, 0, At, B0); PG8_MMA(0, 1, At, B1); PG8_BAR; PG8_SCHED;
            PG8_LDA(At, 1, 1); PG8_STAGE(PG8_SB(1, 0), b3, voffB); PG8_STAGE(PG8_SB(1, 1), b3 + hstep, voffB); PG8_STAGE(PG8_SA(1, 0), a3, voffA);
            PG8_WAIT_V(8); PG8_WAIT_L(0); PG8_BAR; PG8_MMA(1, 0, At, B0); PG8_MMA(1, 1, At, B1); PG8_BAR; PG8_SCHED;
            } else {
            PG8_LDB(B0, 0, 0); PG8_SCHED; PG8_LDA(At, 0, 0); PG8_STAGE(PG8_SA(1, 1), a1 + hstep, voffA);
            PG8_WAIT_L(8); PG8_BAR; PG8_WAIT_L(0); PG8_MMA(0, 0, At, B0); PG8_BAR; PG8_SCHED;
            PG8_LDB(B1, 0, 1); PG8_STAGE(PG8_SB(0, 0), b2, voffB);
            PG8_BAR; PG8_WAIT_L(0); PG8_MMA(0, 1, At, B1); PG8_BAR;
            PG8_LDA(At, 0, 1); PG8_STAGE(PG8_SA(0, 0), a2, voffA);
            PG8_BAR; PG8_WAIT_L(0); PG8_MMA(1, 0, At, B0); PG8_BAR; PG8_SCHED;
            PG8_STAGE(PG8_SB(0, 1), b2 + hstep, voffB);
            PG8_WAIT_V(6); PG8_BAR; PG8_MMA(1, 1, At, B1); PG8_BAR;
            PG8_LDB(B0, 1, 0); PG8_SCHED; PG8_LDA(At, 1, 0); PG8_STAGE(PG8_SA(0, 1), a2 + hstep, voffA);
            PG8_WAIT_L(8); PG8_BAR; PG8_WAIT_L(0); PG8_MMA(0, 0, At, B0); PG8_BAR; PG8_SCHED;
            PG8_LDB(B1, 1, 1); PG8_STAGE(PG8_SB(1, 0), b3, voffB);
            PG8_BAR; PG8_WAIT_L(0); PG8_MMA(0, 1, At, B1); PG8_BAR;
            PG8_LDA(At, 1, 1); PG8_STAGE(PG8_SA(1, 0), a3, voffA);
            PG8_BAR; PG8_WAIT_L(0); PG8_MMA(1, 0, At, B0); PG8_BAR; PG8_SCHED;
            PG8_STAGE(PG8_SB(1, 1), b3 + hstep, voffB);
            PG8_WAIT_V(6); PG8_BAR; PG8_MMA(1, 1, At, B1); PG8_BAR;
            }
        }
        if constexpr (ALIGN_EPI) { if (wr == 0) PG8_BAR; }
        if constexpr (!Epi::AFTER_DRAIN) { E(acc, cur, wr, wc, fr, fq); S.done(cur); }
        if (!has_next) break;
#pragma unroll
        for (int a = 0; a < 2; ++a)
#pragma unroll
            for (int b = 0; b < 2; ++b)
#pragma unroll
                for (int m = 0; m < 4; ++m)
#pragma unroll
                    for (int n = 0; n < 2; ++n) acc[a][b][m][n] = (f32x4){0.f, 0.f, 0.f, 0.f};
        cur = nxt; cA = nA; cB = nB; ++ui;
        if constexpr (ALIGN_EPI) { if (wr == 1) PG8_BAR; }
    }
    PG8_WAIT_V(0);
    if constexpr (!ALIGN_EPI) { if (wr == 0) PG8_BAR; }
    PG8_BAR;
    if constexpr (Epi::AFTER_DRAIN) { E.fused(acc, cur, wr, wc, fr, fq, lds, wid, lane); S.done(cur); }
#undef PG8_SA
#undef PG8_SB
#undef PG8_STAGE
#undef PG8_LDA
#undef PG8_LDB
#undef PG8_MMA
#undef PG8_WAIT_V
#undef PG8_WAIT_L
#undef PG8_BAR
#undef PG8_SCHED
}
}
#include <hip/hip_bf16.h>
#include <cmath>
namespace attn_body {
using bf16=__hip_bfloat16;
using bf16x8=__attribute__((ext_vector_type(8)))short;
using s16x4=__attribute__((ext_vector_type(4)))short;
using f32x16=__attribute__((ext_vector_type(16)))float;
using u32x4=__attribute__((ext_vector_type(4)))unsigned;
constexpr int BATCH=8,NHEAD=16,SEQ=2048,D=64,PQK=512,PO=1024;
constexpr int NW=8,QBLK=32,QB=QBLK*NW,KVBLK=64,NQB=SEQ/QB;
constexpr int ATTN_UNIT_ROWS=QB;
__device__ __forceinline__ int crow(int r,int hi){return (r&3)+8*(r>>2)+4*hi;}
#define SBAR() __builtin_amdgcn_sched_barrier(0)
__device__ __forceinline__ void cmask(f32x16&p0,f32x16&p1,int jb,int qrel,int hi){
  const float NEG=-INFINITY; (void)hi;
  if(jb>(qrel>>6)){
  #pragma unroll
  for(int r=0;r<16;++r){p0[r]=NEG;p1[r]=NEG;}}
}

constexpr int NSLOT=3, SLOTB=8192;
constexpr int LDS_K=0, LDS_V=NSLOT*SLOTB, LDS_WS=2*NSLOT*SLOTB, LDS_OST=LDS_WS+NW*64*4, LDS_BYTES=LDS_OST+NW*4096;
constexpr float C2=0.125f*1.4426950408889634f;
__device__ __forceinline__ void glds16(const void*gsrc,unsigned lds_dst){unsigned keep;
  asm volatile("s_mov_b32 %0, m0\n\ts_mov_b32 m0, %2\n\ts_nop 0\n\tglobal_load_lds_dwordx4 %1, off\n\ts_mov_b32 m0, %0":"=&s"(keep):"v"(gsrc),"s"(lds_dst):"memory");}
__device__ __forceinline__ float max3f(float a,float b,float c){float r;asm("v_max3_f32 %0, %1, %2, %3":"=v"(r):"v"(a),"v"(b),"v"(c));return r;}
__device__ __forceinline__ float max2f(float a,float b){float r;asm("v_max_f32_e32 %0, %1, %2":"=v"(r):"v"(a),"v"(b));return r;}
__device__ __forceinline__ float fadd_s(float a,float b){float r;asm("v_add_f32_e32 %0, %1, %2":"=v"(r):"v"(a),"v"(b));return r;}
__device__ __forceinline__ float fsub_s(float a,float b){float r;asm("v_sub_f32_e32 %0, %1, %2":"=v"(r):"v"(a),"v"(b));return r;}
typedef float f32x2_t __attribute__((ext_vector_type(2))); typedef __bf16 bf16x2_t __attribute__((ext_vector_type(2)));
__device__ __forceinline__ unsigned cvtpk_s(float lo,float hi){f32x2_t v={lo,hi};bf16x2_t b=__builtin_convertvector(v,bf16x2_t);return __builtin_bit_cast(unsigned,b);}
#define WAIT_BAR(N) asm volatile("s_waitcnt vmcnt(" #N ") lgkmcnt(0)\n\ts_barrier":::"memory")

__device__ __forceinline__ void qkt(f32x16&p0,f32x16&p1,const char*Kslot,const bf16x8*qr,const f32x16&negm,int r32,int hi){
  const char*kb=Kslot+hi*1024+r32*16;
  #pragma unroll
  for(int d0=0;d0<4;++d0){
    const bf16x8 b0=*reinterpret_cast<const bf16x8*>(kb+d0*2048);
    const bf16x8 b1=*reinterpret_cast<const bf16x8*>(kb+d0*2048+512);
    if(d0==0){p0=__builtin_amdgcn_mfma_f32_32x32x16_bf16(b0,qr[0],negm,0,0,0);p1=__builtin_amdgcn_mfma_f32_32x32x16_bf16(b1,qr[0],negm,0,0,0);}
    else{p0=__builtin_amdgcn_mfma_f32_32x32x16_bf16(b0,qr[d0],p0,0,0,0);p1=__builtin_amdgcn_mfma_f32_32x32x16_bf16(b1,qr[d0],p1,0,0,0);}}
}
typedef __attribute__((address_space(3))) const char* lds_cptr;
typedef short v4i16_t __attribute__((ext_vector_type(4)));
__device__ __forceinline__ void kload8(bf16x8*kf,lds_cptr kp){
  kf[0]=*(const __attribute__((address_space(3))) bf16x8*)(kp);      kf[1]=*(const __attribute__((address_space(3))) bf16x8*)(kp+512);
  kf[2]=*(const __attribute__((address_space(3))) bf16x8*)(kp+2048); kf[3]=*(const __attribute__((address_space(3))) bf16x8*)(kp+2560);
  kf[4]=*(const __attribute__((address_space(3))) bf16x8*)(kp+4096); kf[5]=*(const __attribute__((address_space(3))) bf16x8*)(kp+4608);
  kf[6]=*(const __attribute__((address_space(3))) bf16x8*)(kp+6144); kf[7]=*(const __attribute__((address_space(3))) bf16x8*)(kp+6656);
}
__device__ __forceinline__ void kload2(bf16x8*kf,lds_cptr kp,int j){ kf[2*j]=*(const __attribute__((address_space(3))) bf16x8*)(kp+j*2048); kf[2*j+1]=*(const __attribute__((address_space(3))) bf16x8*)(kp+j*2048+512); }
__device__ __forceinline__ s16x4 vtr(lds_cptr p){ return __builtin_bit_cast(s16x4,__builtin_amdgcn_ds_read_tr16_b64_v4i16((__attribute__((address_space(3))) v4i16_t*)p)); }
__device__ __forceinline__ float rowmax(const f32x16&p0,const f32x16&p1){
  float a=max3f(p0[0],p0[1],p1[0]),b=max3f(p0[2],p0[3],p1[1]);a=max3f(a,p1[2],p1[3]);
  #pragma unroll
  for(int r=4;r<16;r+=4){a=max3f(a,p0[r],p0[r+1]);b=max3f(b,p0[r+2],p0[r+3]);a=max3f(a,p1[r],p1[r+1]);b=max3f(b,p1[r+2],p1[r+3]);}
  const float m=max2f(a,b);
  auto rr=__builtin_amdgcn_permlane32_swap(__float_as_uint(m),__float_as_uint(m),false,false);
  return max2f(__uint_as_float(rr[0]),__uint_as_float(rr[1]));
}
__device__ __forceinline__ void pv(f32x16*o,int vb,bf16x8 pa0,bf16x8 pa1,bf16x8 pa2,bf16x8 pa3){
  #pragma unroll
  for(int d0=0;d0<2;++d0){s16x4 lo[4],hi[4];
    #pragma unroll
    for(int ks=0;ks<4;++ks){
      asm volatile("ds_read_b64_tr_b16 %0,%1 offset:%c2":"=&v"(lo[ks]):"v"(vb),"i"(d0*4096+ks*1024):"memory");
      asm volatile("ds_read_b64_tr_b16 %0,%1 offset:%c2":"=&v"(hi[ks]):"v"(vb),"i"(d0*4096+ks*1024+512):"memory");}
    asm volatile("s_waitcnt lgkmcnt(0)":::"memory");SBAR();
    #define PK(k) (bf16x8){lo[k][0],lo[k][1],lo[k][2],lo[k][3],hi[k][0],hi[k][1],hi[k][2],hi[k][3]}
    o[d0]=__builtin_amdgcn_mfma_f32_32x32x16_bf16(pa0,PK(0),o[d0],0,0,0);
    o[d0]=__builtin_amdgcn_mfma_f32_32x32x16_bf16(pa1,PK(1),o[d0],0,0,0);
    o[d0]=__builtin_amdgcn_mfma_f32_32x32x16_bf16(pa2,PK(2),o[d0],0,0,0);
    o[d0]=__builtin_amdgcn_mfma_f32_32x32x16_bf16(pa3,PK(3),o[d0],0,0,0);
    #undef PK
  }
}

#ifndef ATTN_STORE16
#define ATTN_STORE16(p,v) (*(u32x4*)(p)=(v))
#endif
template<int THRL> __device__ __forceinline__ void attn_unit(int b,int qb,const bf16*Q,const bf16*__restrict__ K,const bf16*__restrict__ V,bf16*O,char*shm){
  int tid_l=threadIdx.x; asm volatile("":"+v"(tid_l)); const int tid=tid_l,lane=tid&63,r32=lane&31,hi=lane>>5; const int wid=__builtin_amdgcn_readfirstlane(tid>>6);
  const long rowbase=(long)b*SEQ; const int q0=qb*QB;
  const bf16*Qw=Q+(rowbase+q0+wid*QBLK)*PQK;
  const bf16*Kh=K+rowbase*PQK,*Vh=V+rowbase*PQK;
  const unsigned lds0=(unsigned)(uintptr_t)shm;
  float*wsf=(float*)(shm+LDS_WS)+wid*64;
  const bf16*ksrc=Kh+(long)lane*PQK+wid*8;
  const bf16*vsrc=Vh+(long)(16*(wid&3)+(lane>>2))*PQK+(wid>>2)*32+(lane&3)*8;
  const unsigned kdst=lds0+LDS_K+wid*1024, vdst=lds0+LDS_V+wid*1024;
  #define DMA_K(t,slot) glds16(ksrc+(long)(t)*KVBLK*PQK,(unsigned)__builtin_amdgcn_readfirstlane(kdst+(slot)))
  #define DMA_V(t,slot) glds16(vsrc+(long)(t)*KVBLK*PQK,(unsigned)__builtin_amdgcn_readfirstlane(vdst+(slot)))
  const int vb0=(int)(lds0+LDS_V)+((lane>>4)&1)*32+(lane&3)*8+(4*hi+((lane&15)>>2))*64;
  const char*Kbase=shm+LDS_K; bf16x8 kf[8];
  const lds_cptr shm3=(lds_cptr)shm; const lds_cptr kp0=shm3+LDS_K+hi*1024+r32*16; const lds_cptr vp0=shm3+LDS_V+((lane>>4)&1)*32+(lane&3)*8+(4*hi+((lane&15)>>2))*64;
  const int NT=(q0+QB)/KVBLK;
  DMA_K(0,0);DMA_V(0,0);DMA_K(1,SLOTB);
  bf16x8 qr[4];
  #pragma unroll
  for(int d0=0;d0<4;++d0)qr[d0]=*reinterpret_cast<const bf16x8*>(&Qw[(long)r32*PQK+d0*16+hi*8]);
  float mhat=0.f,l_reg=0.f;f32x16 o[2];o[0]=f32x16{};o[1]=f32x16{};f32x16 negm=f32x16{};asm volatile("":"+v"(negm));
  const int qrel=wid*QBLK+r32;
  #define CMASK(P0,P1,t) do{int jb_=(t)-(NT-4); if(jb_>=0)cmask(P0,P1,jb_,qrel,hi);}while(0)
  bool resc=false;
  #define START(P0,P1) do{ const float rm=rowmax(P0,P1); resc=false; \
    { const float dl=rm; mhat=fadd_s(mhat,dl); \
      _Pragma("unroll") for(int r=0;r<16;++r){P0[r]=fsub_s(P0[r],dl);P1[r]=fsub_s(P1[r],dl);} \
      _Pragma("unroll") for(int r=0;r<16;++r)negm[r]=-mhat; asm volatile("":"+v"(negm)); } \
    _Pragma("unroll") for(int r=0;r<16;++r)P0[r]=__builtin_amdgcn_exp2f(P0[r]); }while(0)
  #define RESC() do{ if(resc){ asm volatile("s_waitcnt lgkmcnt(0)":::"memory"); \
      _Pragma("unroll") for(int d_=0;d_<2;++d_) _Pragma("unroll") for(int r=0;r<16;++r)o[d_][r]*=wsf[crow(r,hi)]; } }while(0)
  f32x16 pA0,pA1,pB0,pB1;
  int sl_prev=0,sl_cur=0,sl_next=SLOTB;
  #define ROT() do{sl_prev=sl_cur;sl_cur=sl_next;sl_next=(sl_next==(NSLOT-1)*SLOTB)?0:sl_next+SLOTB;}while(0)
  DMA_K(2,2*SLOTB);
  WAIT_BAR(3);
  qkt(pA0,pA1,Kbase,qr,negm,r32,hi);asm volatile("s_nop 15\n\ts_nop 7":"+v"(pA0),"+v"(pA1));CMASK(pA0,pA1,0);
  START(pA0,pA1);
  _Pragma("unroll") for(int r=0;r<16;++r)pA1[r]=__builtin_amdgcn_exp2f(pA1[r]);
  WAIT_BAR(0);
  DMA_K(3,0);DMA_V(1,SLOTB);
  ROT();
  kload8(kf,kp0+sl_cur);
  WAIT_BAR(2);
  s16x4 vlo[8],vhi[8]; u32x4 pw0,pw1,pw2,pw3;
  #define PKW(P,B) cvtpk_s(P[B],P[B+1])
  #define PAF(k) __builtin_bit_cast(bf16x8,pw##k)
  #define VFR(i) (bf16x8){vlo[i][0],vlo[i][1],vlo[i][2],vlo[i][3],vhi[i][0],vhi[i][1],vhi[i][2],vhi[i][3]}
  #define PIN(x) asm volatile("":"+v"(x))
  #define MX3(a,b,c) __builtin_fmaxf(__builtin_fmaxf((a),(b)),(c))
  #define GAPA(MF,A0,A1,A2,A3,W0,W1,PW) do{ MF; sacc+=A0; sacc+=A1; sacc+=A2; sacc+=A3; PIN(sacc); W0; W1; PIN(PW); SBAR(); }while(0)
  #define EX(v) __builtin_amdgcn_exp2f(v)
  #define GAPB(MF,X,B) do{ MF; X[B]=EX(X[B]); X[B+1]=EX(X[B+1]); X[B+2]=EX(X[B+2]); X[B+3]=EX(X[B+3]); PIN(X); SBAR(); }while(0)
  #define VRD(i) do{ vlo[i]=vtr(vp_+(((i)>>2)*4096+((i)&3)*1024)); vhi[i]=vtr(vp_+(((i)>>2)*4096+((i)&3)*1024+512)); }while(0)
  #define KRD(G,j) do{ if(G){ kload2(kf,kp0+sl_next,j); SBAR(); } }while(0)
  #define STEP(C0,C1,P0,P1,t,GK,GV,GL) do{ SBAR(); \
    const lds_cptr vp_=vp0+sl_prev; \
    VRD(0); SBAR(); float sacc=(P0[0]+P0[1]); \
    GAPA(C0=__builtin_amdgcn_mfma_f32_32x32x16_bf16(kf[0],qr[0],negm,0,0,0), P0[2],P0[3],P0[4],P0[5],     pw0[0]=PKW(P0,0), pw0[1]=PKW(P0,2), pw0); \
    VRD(4); SBAR(); GAPA(C1=__builtin_amdgcn_mfma_f32_32x32x16_bf16(kf[1],qr[0],negm,0,0,0), P0[6],P0[7],P0[8],P0[9],     pw0[2]=PKW(P0,4), pw0[3]=PKW(P0,6), pw0); \
    VRD(1); SBAR(); GAPA(C0=__builtin_amdgcn_mfma_f32_32x32x16_bf16(kf[2],qr[1],C0,0,0,0),   P0[10],P0[11],P0[12],P0[13], pw1[0]=PKW(P0,8), pw1[1]=PKW(P0,10), pw1); \
    VRD(5); SBAR(); GAPA(C1=__builtin_amdgcn_mfma_f32_32x32x16_bf16(kf[3],qr[1],C1,0,0,0),   P0[14],P0[15],P1[0],P1[1],   pw1[2]=PKW(P0,12),pw1[3]=PKW(P0,14), pw1); \
    VRD(2); SBAR(); GAPA(C0=__builtin_amdgcn_mfma_f32_32x32x16_bf16(kf[4],qr[2],C0,0,0,0),   P1[2],P1[3],P1[4],P1[5],     pw2[0]=PKW(P1,0), pw2[1]=PKW(P1,2), pw2); \
    VRD(6); SBAR(); GAPA(C1=__builtin_amdgcn_mfma_f32_32x32x16_bf16(kf[5],qr[2],C1,0,0,0),   P1[6],P1[7],P1[8],P1[9],     pw2[2]=PKW(P1,4), pw2[3]=PKW(P1,6), pw2); \
    VRD(3); SBAR(); GAPA(C0=__builtin_amdgcn_mfma_f32_32x32x16_bf16(kf[6],qr[3],C0,0,0,0),   P1[10],P1[11],P1[12],P1[13], pw3[0]=PKW(P1,8), pw3[1]=PKW(P1,10), pw3); \
    VRD(7); SBAR(); GAPA(C1=__builtin_amdgcn_mfma_f32_32x32x16_bf16(kf[7],qr[3],C1,0,0,0),   P1[14],P1[15],0.f,0.f,       pw3[2]=PKW(P1,12),pw3[3]=PKW(P1,14), pw3); \
    l_reg+=sacc; \
    if(GK){DMA_K((t)+3,sl_cur);} if(GV){DMA_V((t)+1,sl_next);} \
    CMASK(C0,C1,t); \
    { float a=MX3(C0[0],C0[1],C1[0]),b=MX3(C0[2],C0[3],C1[1]); a=MX3(a,C1[2],C1[3]); \
      _Pragma("unroll") for(int r=4;r<16;r+=4){a=MX3(a,C0[r],C0[r+1]);b=MX3(b,C0[r+2],C0[r+3]);a=MX3(a,C1[r],C1[r+1]);b=MX3(b,C1[r+2],C1[r+3]);} \
      float rm=__builtin_fmaxf(a,b); { auto rr=__builtin_amdgcn_permlane32_swap(__float_as_uint(rm),__float_as_uint(rm),false,false); rm=__builtin_fmaxf(__uint_as_float(rr[0]),__uint_as_float(rr[1])); } \
      resc=false; \
      if(__builtin_expect(__any(rm>(float)THRL),0)){ const float dl=__builtin_fmaxf(rm,0.f); mhat+=dl; \
        _Pragma("unroll") for(int r=0;r<16;++r){C0[r]-=dl;C1[r]-=dl;} \
        _Pragma("unroll") for(int r=0;r<16;++r)negm[r]=-mhat; asm volatile("":"+v"(negm)); \
        const float f=__builtin_amdgcn_exp2f(-dl); l_reg*=f; if(hi==0)wsf[r32]=f; resc=true; } } \
    SBAR(); \
    GAPB(o[0]=__builtin_amdgcn_mfma_f32_32x32x16_bf16(PAF(0),VFR(0),o[0],0,0,0), C0,0); \
    GAPB(o[1]=__builtin_amdgcn_mfma_f32_32x32x16_bf16(PAF(0),VFR(4),o[1],0,0,0), C0,4); \
    KRD(GL,0); GAPB(o[0]=__builtin_amdgcn_mfma_f32_32x32x16_bf16(PAF(1),VFR(1),o[0],0,0,0), C0,8); \
    KRD(GL,1); GAPB(o[1]=__builtin_amdgcn_mfma_f32_32x32x16_bf16(PAF(1),VFR(5),o[1],0,0,0), C0,12); \
    KRD(GL,2); GAPB(o[0]=__builtin_amdgcn_mfma_f32_32x32x16_bf16(PAF(2),VFR(2),o[0],0,0,0), C1,0); \
    KRD(GL,3); GAPB(o[1]=__builtin_amdgcn_mfma_f32_32x32x16_bf16(PAF(2),VFR(6),o[1],0,0,0), C1,4); \
    GAPB(o[0]=__builtin_amdgcn_mfma_f32_32x32x16_bf16(PAF(3),VFR(3),o[0],0,0,0), C1,8); \
    GAPB(o[1]=__builtin_amdgcn_mfma_f32_32x32x16_bf16(PAF(3),VFR(7),o[1],0,0,0), C1,12); \
    }while(0)
  int t=1;
  #undef CMASK
  #define CMASK(P0,P1,t) do{}while(0)
  for(;t+5<NT;t+=2){
    STEP(pB0,pB1,pA0,pA1,t,true,true,true);     WAIT_BAR(2); RESC(); ROT();
    STEP(pA0,pA1,pB0,pB1,t+1,true,true,true);   WAIT_BAR(2); RESC(); ROT();
  }
  #undef CMASK
  #define CMASK(P0,P1,t) do{int jb_=(t)-(NT-4); if(jb_>=0)cmask(P0,P1,jb_,qrel,hi);}while(0)
  #define ENDW(tt) do{ if((tt)+3<NT){WAIT_BAR(2);} else if((tt)+2<NT){WAIT_BAR(1);} else {WAIT_BAR(0);} }while(0)
  for(;t+1<NT;t+=2){
    STEP(pB0,pB1,pA0,pA1,t,(t+3<NT),(t+1<NT),(t+1<NT));       ENDW(t);   RESC(); ROT();
    STEP(pA0,pA1,pB0,pB1,t+1,(t+4<NT),(t+2<NT),(t+2<NT));     ENDW(t+1); RESC(); ROT();
  }
  STEP(pB0,pB1,pA0,pA1,NT-1,false,false,false); RESC();
  { float sacc=pB0[0]+pB0[1]; _Pragma("unroll") for(int r=2;r<16;++r)sacc+=pB0[r]; _Pragma("unroll") for(int r=0;r<16;++r)sacc+=pB1[r]; l_reg+=sacc;
    pw0=(u32x4){PKW(pB0,0),PKW(pB0,2),PKW(pB0,4),PKW(pB0,6)};pw1=(u32x4){PKW(pB0,8),PKW(pB0,10),PKW(pB0,12),PKW(pB0,14)};pw2=(u32x4){PKW(pB1,0),PKW(pB1,2),PKW(pB1,4),PKW(pB1,6)};pw3=(u32x4){PKW(pB1,8),PKW(pB1,10),PKW(pB1,12),PKW(pB1,14)};
    SBAR(); pv(o,vb0+sl_cur,PAF(0),PAF(1),PAF(2),PAF(3)); }
  #undef PKW
  #undef PAF
  #undef VFR
  #undef PIN
  #undef MX3
  #undef GAPA
  #undef GAPB
  #undef EX
  #undef VRD
  #undef KRD
  #undef STEP
  #undef ENDW
  {auto rr=__builtin_amdgcn_permlane32_swap(__float_as_uint(l_reg),__float_as_uint(l_reg),false,false);l_reg=__uint_as_float(rr[0])+__uint_as_float(rr[1]);}
  if(hi==0)wsf[32+r32]=l_reg;asm volatile("s_waitcnt lgkmcnt(0)":::"memory");
  float rli[16];
  #pragma unroll
  for(int r=0;r<16;++r)rli[r]=__builtin_amdgcn_rcpf(wsf[32+crow(r,hi)]);
  bf16*Ow=O+(rowbase+q0+wid*QBLK)*PO;
  { bf16*stg=(bf16*)(shm+LDS_OST)+wid*2048;
    #pragma unroll
    for(int r=0;r<16;++r){const int orow=crow(r,hi);
      #pragma unroll
      for(int d0=0;d0<2;++d0)stg[orow*64+d0*32+r32]=__float2bfloat16(o[d0][r]*rli[r]);}
    asm volatile("s_waitcnt lgkmcnt(0)":::"memory");
    #pragma unroll
    for(int i=0;i<4;++i){const int row=i*8+(lane>>3),ch=lane&7; const u32x4 v=*(const u32x4*)(stg+row*64+ch*8); ATTN_STORE16(Ow+(long)row*PO+ch*8,v);} }
  asm volatile("s_waitcnt lgkmcnt(0)\n\ts_barrier":::"memory");
  #undef DMA_K
  #undef DMA_V
  #undef CMASK
  #undef START
  #undef RESC
  #undef ROT
}
#undef SBAR
#undef WAIT_BAR
}
namespace cg = cooperative_groups;
#define LAS __attribute__((address_space(3)))
typedef unsigned short bf16;
typedef unsigned v4u __attribute__((ext_vector_type(4)));
typedef unsigned v2u __attribute__((ext_vector_type(2)));
typedef float f32x4 __attribute__((ext_vector_type(4)));
typedef float f32x2 __attribute__((ext_vector_type(2)));
typedef float f32x16 __attribute__((ext_vector_type(16)));
typedef short bf16x8 __attribute__((ext_vector_type(8)));

constexpr int NWAVES = 8;
constexpr int D = 1024, MP = 16384, MS = 256, M = MP + MS, FF = 2816, DIN = 2560;
constexpr float EPS = 1e-6f;
constexpr float C2 = 0.125f * 1.4426950408889634f;
constexpr size_t OFF_Y = 0, OFF_KP = 17039360, OFF_VP = 33816576, OFF_PP = 50593792, OFF_CP = 50655232, OFF_KS = 50663424, OFF_VS = 50925568, OFF_PS = 51187712, OFF_CS = 51249152, OUT_TOTAL = 51257344;
constexpr size_t MiB = 1u << 20;
constexpr size_t WS_ROPE = 1 * MiB, WS_POOLWT = 2 * MiB, WS_W = 4 * MiB, WL = 40 * MiB;
constexpr size_t W_GU1 = 0, W_D1 = 11 * MiB, W_IN = 16 * MiB + MiB / 2, W_OUT = 21 * MiB + MiB / 2, W_GU2 = 23 * MiB + MiB / 2, W_D2 = 34 * MiB + MiB / 2;
constexpr size_t WS_X = 84 * MiB, WS_H = 149 * MiB, WS_MIX = 182 * MiB, WS_ACT = 215 * MiB;
constexpr size_t WS_QB = 215 * MiB, WS_KB = 232 * MiB, WS_VB = 249 * MiB, WS_ZB = 266 * MiB;
constexpr size_t WS_OB = 305 * MiB, WS_OPART = 338 * MiB, WS_ML = 347 * MiB, WS_END = 348 * MiB;
static_assert(WS_ROPE == pg8::WOFF_ROPE && WS_QB == pg8::WOFF_QB && WS_KB == pg8::WOFF_KB && WS_VB == pg8::WOFF_VB && WS_ZB == pg8::WOFF_ZB && OFF_KP == pg8::OOFF_KP && OFF_VP == pg8::OOFF_VP && OFF_PP == pg8::OOFF_PP && OFF_KS == pg8::OOFF_KS && OFF_VS == pg8::OOFF_VS && OFF_PS == pg8::OOFF_PS, "offsets");
static_assert(WS_ACT + (size_t)M * FF * 2 <= WS_OB && WS_ZB + (size_t)M * 1024 * 2 <= WS_OB && WS_X + (size_t)M * D * 4 <= WS_H && WS_H + (size_t)M * D * 2 <= WS_MIX && WS_MIX + (size_t)M * D * 2 <= WS_ACT, "ws map");
static_assert(WS_OB + (size_t)M * 1024 * 2 <= WS_OPART && WS_OPART + (size_t)32 * 2 * 9 * 32 * 128 * 4 <= WS_ML && WS_ML + (size_t)32 * 2 * 9 * 32 * 2 * 4 <= WS_END, "ws map 2");
constexpr int LDS_BYTES = 147456;

__device__ __forceinline__ unsigned pk2(float lo, float hi) { f32x2 v = {lo, hi}; typedef __bf16 b2 __attribute__((ext_vector_type(2))); b2 b = __builtin_convertvector(v, b2); return __builtin_bit_cast(unsigned, b); }
__device__ __forceinline__ float bf2f(unsigned short b) { return __builtin_bit_cast(float, (unsigned)b << 16); }
__device__ __forceinline__ bf16x8 pack8(f32x4 a, f32x4 b) { v4u w; w.x = pk2(a.x, a.y); w.y = pk2(a.z, a.w); w.z = pk2(b.x, b.y); w.w = pk2(b.z, b.w); return __builtin_bit_cast(bf16x8, w); }
__device__ __forceinline__ int crow(int r, int hi) { return (r & 3) + 8 * (r >> 2) + 4 * hi; }
__device__ __forceinline__ void xhalf_pair(float m, float& a, float& b) { a = m; b = m; asm volatile("s_nop 1\n\tv_permlane32_swap_b32 %0, %1\n\ts_nop 1" : "+v"(a), "+v"(b)); }
__device__ __forceinline__ float xhalf_max(float m) { float a, b; xhalf_pair(m, a, b); return fmaxf(a, b); }
__device__ __forceinline__ float xhalf_sum(float m) { float a, b; xhalf_pair(m, a, b); return a + b; }
template <int O> __device__ __forceinline__ float swz_xor(float v) { return __builtin_bit_cast(float, __builtin_amdgcn_ds_swizzle(__builtin_bit_cast(int, v), (O << 10) | 0x1f)); }
__device__ __forceinline__ float wave_sum(float v) {
    v += swz_xor<1>(v); v += swz_xor<2>(v); v += swz_xor<4>(v); v += swz_xor<8>(v); v += swz_xor<16>(v);
    return xhalf_sum(v);
}
#define LDS_WAIT() asm volatile("s_waitcnt lgkmcnt(0)" ::: "memory")

struct Params { const float* in[26]; float* out; unsigned char* ws; };
typedef const __attribute__((address_space(4))) unsigned char* karg_ptr;
__device__ __forceinline__ karg_ptr kargs() { karg_ptr k = (karg_ptr)__builtin_amdgcn_kernarg_segment_ptr(); asm volatile("" : "+s"(k)); return k; }
__device__ __forceinline__ const float* KIN(int i) { return *(const float* const __attribute__((address_space(4)))*)(kargs() + 8 * i); }
__device__ __forceinline__ float* KOUT() { return *(float* const __attribute__((address_space(4)))*)(kargs() + 8 * 26); }
__device__ __forceinline__ unsigned char* KWS() { return *(unsigned char* const __attribute__((address_space(4)))*)(kargs() + 8 * 27); }

template <int MODE> __device__ __forceinline__ int wmap(int nl, int row_off) {
    if (MODE == 0) return row_off + nl;
    if (MODE == 1) return (nl >> 7) * 256 + (nl & 127) + row_off;
    const int u = nl >> 8, lc = nl & 255, A = lc >> 6, n = (lc >> 5) & 1, B = (lc >> 4) & 1, f = lc & 15;
    return u * 256 + 128 * (A >> 1) + 32 * (2 * (A & 1) + B) + 16 * n + f;
}
template <int MODE> __device__ __forceinline__ void transpose_item(const float* W, int K, int N, bf16* WT, int row_off, LAS float* scr, int item, int lane) {
    const int nblk = N / 32, kb = item / nblk, nb = item % nblk, k0 = 64 * kb, n0 = 32 * nb;
#pragma unroll 8
    for (int i = 0; i < 32; ++i) { const int kk = 2 * i + (lane >> 5); scr[kk * 33 + (lane & 31)] = W[(size_t)(k0 + kk) * N + n0 + (lane & 31)]; }
    LDS_WAIT(); asm volatile("" ::: "memory");
    const int c = lane & 7;
#pragma unroll
    for (int j = 0; j < 4; ++j) { const int n = (lane >> 3) + 8 * j; const LAS float* s = scr + (8 * c) * 33 + n;
        v4u o; o.x = pk2(s[0 * 33], s[1 * 33]); o.y = pk2(s[2 * 33], s[3 * 33]); o.z = pk2(s[4 * 33], s[5 * 33]); o.w = pk2(s[6 * 33], s[7 * 33]);
        *(v4u*)(WT + (size_t)wmap<MODE>(n0 + n, row_off) * K + k0 + 8 * c) = o; }
    LDS_WAIT(); asm volatile("" ::: "memory");
}
__device__ __forceinline__ void prologue(LAS unsigned char* lds, int gw, int NGW, int wave, int lane) {
    LAS float* scr = (LAS float*)(lds + wave * 16384);
    constexpr int I_F = 16 * 88, I_IN = 16 * 80, I_OUT = 16 * 32, I_L = 6 * I_F + I_IN + I_OUT;
    for (int it = gw; it < 2 * I_L; it += NGW) {
        const int l = it / I_L; int r = it % I_L;
        unsigned char* wl = KWS() + WS_W + (size_t)l * WL;
        if (r < I_F) { transpose_item<1>(KIN(7) + (size_t)l * D * FF, D, FF, (bf16*)(wl + W_GU1), 0, scr, r, lane); continue; } r -= I_F;
        if (r < I_F) { transpose_item<1>(KIN(8) + (size_t)l * D * FF, D, FF, (bf16*)(wl + W_GU1), 128, scr, r, lane); continue; } r -= I_F;
        if (r < I_F) { transpose_item<0>(KIN(9) + (size_t)l * D * FF, FF, D, (bf16*)(wl + W_D1), 0, scr, r, lane); continue; } r -= I_F;
        if (r < I_IN) { transpose_item<2>(KIN(11) + (size_t)l * D * DIN, D, DIN, (bf16*)(wl + W_IN), 0, scr, r, lane); continue; } r -= I_IN;
        if (r < I_OUT) { transpose_item<0>(KIN(20) + (size_t)l * D * D, D, D, (bf16*)(wl + W_OUT), 0, scr, r, lane); continue; } r -= I_OUT;
        if (r < I_F) { transpose_item<1>(KIN(22) + (size_t)l * D * FF, D, FF, (bf16*)(wl + W_GU2), 0, scr, r, lane); continue; } r -= I_F;
        if (r < I_F) { transpose_item<1>(KIN(23) + (size_t)l * D * FF, D, FF, (bf16*)(wl + W_GU2), 128, scr, r, lane); continue; } r -= I_F;
        transpose_item<0>(KIN(24) + (size_t)l * D * FF, FF, D, (bf16*)(wl + W_D2), 0, scr, r, lane);
    }
    float* rope = (float*)(KWS() + WS_ROPE);
    for (int i = gw * 64 + lane; i < 2080 * 32; i += NGW * 64) {
        const int pr = i >> 5, d = i & 31; const int pos = pr < 2048 ? pr : 4096 + (pr - 2048);
        const float inv = exp2f(-(float)d * (13.287712379549449f / 32.0f));
        const float ang = (float)pos * inv;
        const double rev = (double)ang * 0.15915494309189535; const float fr = (float)(rev - __builtin_rint(rev));
        rope[pr * 64 + d] = __builtin_amdgcn_cosf(fr); rope[pr * 64 + 32 + d] = __builtin_amdgcn_sinf(fr);
    }
    bf16* pwt_ = (bf16*)(KWS() + WS_POOLWT);
    for (int i = gw * 64 + lane; i < 2 * 4 * 64 * 64; i += NGW * 64) {
        const int c = i & 63, e = (i >> 6) & 63, lg = i >> 12;
        pwt_[i] = (bf16)(pk2(KIN(17)[(size_t)lg * 4096 + c * 64 + e], 0.f) & 0xffffu);
    }
}
template <bool FINAL> __device__ __forceinline__ void norm_rows(const float* srcP, const float* srcS, const float* g, bf16* H, float* outf, int gw, int NGW, int lane) {
    const f32x4* g4 = (const f32x4*)g + lane;
    f32x4 gv[4];
#pragma unroll
    for (int j = 0; j < 4; ++j) gv[j] = g4[64 * j];
    for (int m = gw; m < M; m += NGW) {
        const float* xr = (m < MP) ? srcP + (size_t)m * D : srcS + (size_t)(m - MP) * D;
        const f32x4* x4 = (const f32x4*)xr + lane;
        f32x4 v[4]; float s = 0.f;
#pragma unroll
        for (int j = 0; j < 4; ++j) { v[j] = x4[64 * j]; s += (v[j].x * v[j].x + v[j].y * v[j].y) + (v[j].z * v[j].z + v[j].w * v[j].w); }
        const float rstd = 1.0f / sqrtf(wave_sum(s) * (1.0f / D) + EPS);
        if (FINAL) {
            f32x4* o4 = (f32x4*)(outf + (size_t)m * D) + lane;
#pragma unroll
            for (int j = 0; j < 4; ++j) o4[64 * j] = v[j] * rstd * gv[j];
        } else {
            v2u* o2 = (v2u*)(H + (size_t)m * D) + lane;
#pragma unroll
            for (int j = 0; j < 4; ++j) { const f32x4 y = v[j] * rstd * gv[j]; v2u w; w.x = pk2(y.x, y.y); w.y = pk2(y.z, y.w); o2[64 * j] = w; }
        }
    }
}
__device__ __forceinline__ f32x16 mfma32(bf16x8 a, bf16x8 b, f32x16 c) { return __builtin_amdgcn_mfma_f32_32x32x16_bf16(a, b, c, 0, 0, 0); }


__device__ __forceinline__ void skinny_gemm(LAS unsigned char* lds, const bf16* A, const bf16* Bt, int K, const float* base, float* out, float scale, int vcu, int G, int tid) {
    const int lane = tid & 63, r32 = lane & 31, hi = lane >> 5, wid = __builtin_amdgcn_readfirstlane(tid >> 6);
    LAS float* R = (LAS float*)lds;
    for (int tile = vcu; tile < 256; tile += G) {
        const int rt = tile >> 5, ct = tile & 31, kw = K >> 3, k0 = wid * kw;
        const bf16* ap = A + (size_t)(rt * 32 + r32) * K + k0 + hi * 8; const bf16* bp = Bt + (size_t)(ct * 32 + r32) * K + k0 + hi * 8;
        f32x16 acc;
#pragma unroll
        for (int r = 0; r < 16; ++r) acc[r] = 0.f;
#pragma unroll 4
        for (int ks = 0; ks < kw; ks += 16) { const bf16x8 a = *(const bf16x8*)(ap + ks), b = *(const bf16x8*)(bp + ks); acc = mfma32(a, b, acc); }
#pragma unroll
        for (int r = 0; r < 16; ++r) R[(wid * 32 + crow(r, hi)) * 32 + r32] = acc[r];
        __syncthreads();
        { const int e = tid * 2, row = e >> 5, col = e & 31; f32x2 s = {0.f, 0.f};
#pragma unroll
          for (int w = 0; w < 8; ++w) s += *(const LAS f32x2*)(R + (w * 32 + row) * 32 + col);
          const size_t o = (size_t)(rt * 32 + row) * 1024 + ct * 32 + col; const f32x2 bv = *(const f32x2*)(base + o); *(f32x2*)(out + o) = bv + s * scale; }
        __syncthreads();
    }
}

__device__ __forceinline__ void sample_piece(LAS unsigned char* lds, int pc, int l, const bf16* Qb, const float* cache_k, const float* cache_v, const float* knew, const float* vnew, float* OPART, float* MLP, int tid) {
    const int lane = tid & 63, r32 = lane & 31, hi = lane >> 5, wid = __builtin_amdgcn_readfirstlane(tid >> 6);
    const int b = pc >> 5, h = (pc >> 3) & 3, s = pc & 7;
    const bf16* qrow = Qb + (size_t)(MP + b * 32 + r32) * 512 + h * 128 + hi * 8;
    LAS float* ML = (LAS float*)lds;
    LAS float* FAC = (LAS float*)(lds + 4096);
    LAS float* OX = (LAS float*)(lds + 8192);
    const int nrounds = (s == 7) ? 2 : 1;
    for (int rd = 0; rd < nrounds; ++rd) {
        const float *Kt, *Vt; int nvalid;
        if (rd == 0) { const size_t off = ((size_t)((l * 8 + b) * 4096 + (s * 8 + wid) * 64)) * 512 + h * 128; Kt = cache_k + off; Vt = cache_v + off; nvalid = 64; }
        else { const size_t off = ((size_t)(l * 8 + b) * 32) * 512 + h * 128; Kt = knew + off; Vt = vnew + off; nvalid = (wid == 0) ? 32 : 0; }
        float mrow[2], lrow[2]; bf16x8 pw[2][4];
#pragma unroll
        for (int c = 0; c < 2; ++c) { mrow[c] = -1e30f; lrow[c] = 0.f;
#pragma unroll
            for (int k = 0; k < 4; ++k) pw[c][k] = (bf16x8){0, 0, 0, 0, 0, 0, 0, 0}; }
        if (nvalid > 0) {
#pragma unroll
            for (int c = 0; c < 2; ++c) {
                bf16x8 qf[4];
#pragma unroll
                for (int d0 = 0; d0 < 4; ++d0) qf[d0] = *(const bf16x8*)(qrow + c * 64 + d0 * 16);
                f32x16 sc[2];
#pragma unroll
                for (int kvb = 0; kvb < 2; ++kvb) {
                    if (kvb * 32 < nvalid) {
                        f32x16 a;
#pragma unroll
                        for (int r = 0; r < 16; ++r) a[r] = 0.f;
                        const float* kp = Kt + (size_t)(kvb * 32 + r32) * 512 + c * 64 + hi * 8;
#pragma unroll
                        for (int d0 = 0; d0 < 4; ++d0) { const f32x4 x0 = *(const f32x4*)(kp + d0 * 16), x1 = *(const f32x4*)(kp + d0 * 16 + 4); a = mfma32(pack8(x0, x1), qf[d0], a); }
                        sc[kvb] = a;
                    } else {
#pragma unroll
                        for (int r = 0; r < 16; ++r) sc[kvb][r] = -1e30f;
                    }
                }
                float mx = -1e30f;
#pragma unroll
                for (int r = 0; r < 16; ++r) mx = fmaxf(mx, fmaxf(sc[0][r], sc[1][r]));
                mx = xhalf_max(mx);
                float sum = 0.f;
#pragma unroll
                for (int kvb = 0; kvb < 2; ++kvb)
#pragma unroll
                    for (int r = 0; r < 16; ++r) { const float pv = __builtin_amdgcn_exp2f(sc[kvb][r] - mx); sc[kvb][r] = pv; sum += pv; }
                sum = xhalf_sum(sum);
                mrow[c] = mx; lrow[c] = sum;
#pragma unroll
                for (int kvb = 0; kvb < 2; ++kvb)
#pragma unroll
                    for (int hf = 0; hf < 2; ++hf) { v4u w; w.x = pk2(sc[kvb][8 * hf + 0], sc[kvb][8 * hf + 1]); w.y = pk2(sc[kvb][8 * hf + 2], sc[kvb][8 * hf + 3]);
                        w.z = pk2(sc[kvb][8 * hf + 4], sc[kvb][8 * hf + 5]); w.w = pk2(sc[kvb][8 * hf + 6], sc[kvb][8 * hf + 7]); pw[c][2 * kvb + hf] = __builtin_bit_cast(bf16x8, w); }
            }
        }
        asm volatile("" ::: "memory");
        f32x16 o[2][4];
#pragma unroll
        for (int c = 0; c < 2; ++c)
#pragma unroll
            for (int eb = 0; eb < 4; ++eb)
#pragma unroll
                for (int r = 0; r < 16; ++r) o[c][eb][r] = 0.f;
        if (nvalid > 0) {
#pragma unroll
            for (int ks = 0; ks < 4; ++ks) {
                if (ks * 16 < nvalid) {
#pragma unroll
                    for (int eb = 0; eb < 4; ++eb) {
                        const float* vp = Vt + (size_t)(ks * 16 + 4 * hi) * 512 + eb * 32 + r32;
                        f32x4 x0, x1;
                        x0.x = vp[0 * 512]; x0.y = vp[1 * 512]; x0.z = vp[2 * 512]; x0.w = vp[3 * 512];
                        x1.x = vp[8 * 512]; x1.y = vp[9 * 512]; x1.z = vp[10 * 512]; x1.w = vp[11 * 512];
                        const bf16x8 vf = pack8(x0, x1);
                        o[0][eb] = mfma32(pw[0][ks], vf, o[0][eb]); o[1][eb] = mfma32(pw[1][ks], vf, o[1][eb]);
                    }
                }
            }
        }
        if (hi == 0) {
#pragma unroll
            for (int c = 0; c < 2; ++c) { ML[((wid * 2 + c) * 32 + r32) * 2 + 0] = mrow[c]; ML[((wid * 2 + c) * 32 + r32) * 2 + 1] = lrow[c]; }
        }
        __syncthreads();
        const int pidx = (rd == 0) ? s : 8;
        if (tid < 64) {
            const int c = tid >> 5, q = tid & 31; float mw[8], lw[8]; float Mx = -1e30f;
#pragma unroll
            for (int w = 0; w < 8; ++w) { mw[w] = ML[((w * 2 + c) * 32 + q) * 2 + 0]; lw[w] = ML[((w * 2 + c) * 32 + q) * 2 + 1]; Mx = fmaxf(Mx, mw[w]); }
            float L = 0.f;
#pragma unroll
            for (int w = 0; w < 8; ++w) { const float f = __builtin_amdgcn_exp2f(mw[w] - Mx); FAC[(w * 2 + c) * 32 + q] = f; L += lw[w] * f; }
            float* mp = MLP + ((size_t)((((b * 4 + h) * 2 + c) * 9 + pidx) * 32 + q)) * 2; mp[0] = Mx; mp[1] = L;
        }
        __syncthreads();
#pragma unroll
        for (int c = 0; c < 2; ++c) {
#pragma unroll
            for (int eb = 0; eb < 4; ++eb)
#pragma unroll
                for (int r = 0; r < 16; ++r) { const int q = crow(r, hi); OX[(wid * 32 + q) * 128 + eb * 32 + r32] = o[c][eb][r] * FAC[(wid * 2 + c) * 32 + q]; }
            __syncthreads();
            { const int idx = tid * 8, q = idx >> 7, e = idx & 127; f32x4 s0 = {0.f, 0.f, 0.f, 0.f}, s1 = {0.f, 0.f, 0.f, 0.f};
#pragma unroll
              for (int w = 0; w < 8; ++w) { s0 += *(const LAS f32x4*)(OX + (w * 32 + q) * 128 + e); s1 += *(const LAS f32x4*)(OX + (w * 32 + q) * 128 + e + 4); }
              float* dst = OPART + ((size_t)((((b * 4 + h) * 2 + c) * 9 + pidx) * 32 + q)) * 128 + e; *(f32x4*)dst = s0; *(f32x4*)(dst + 4) = s1; }
            __syncthreads();
        }
    }
}

__device__ __forceinline__ f32x4 bf4_to_f32(v2u w) { f32x4 v; v.x = bf2f(w.x & 0xffff); v.y = bf2f(w.x >> 16); v.z = bf2f(w.y & 0xffff); v.w = bf2f(w.y >> 16); return v; }
__device__ __forceinline__ void poolconv_tile(LAS unsigned char* lds, int tl, int l, const bf16* Zb, bf16* MIX, const float* state_pool, const float* state_conv, const bf16* pwt, const float* pool_scale,
                                              const float* conv_w, float* out_cp, float* out_cs, int tid) {
    const int lane = tid & 63, r32 = lane & 31, hi = lane >> 5, wid = __builtin_amdgcn_readfirstlane(tid >> 6);
    int b, t0, TT, rowbase; bool smp;
    if (tl < 256) { b = tl >> 5; t0 = (tl & 31) * 64; TT = 64; rowbase = b * 2048 + t0; smp = false; }
    else { b = tl - 256; t0 = 0; TT = 32; rowbase = MP + b * 32; smp = true; }
    LAS float* U = (LAS float*)lds;
    LAS bf16* Dd = (LAS bf16*)(lds + 81920);
    {
        f32x4 uv[10];
#pragma unroll
        for (int k = 0; k < 10; ++k) {
            const int idx = tid + 512 * k, i = idx >> 6, c4 = (idx & 63) * 4; f32x4 v = {0.f, 0.f, 0.f, 0.f};
            if (i < 15 + TT) {
                if (i < 15 && smp) v = *(const f32x4*)(state_pool + (size_t)((l * 8 + b) * 15 + i) * 256 + c4);
                else if (i >= 15 || t0 - 15 + i >= 0) v = bf4_to_f32(*(const v2u*)(Zb + (size_t)(rowbase + i - 15) * 1024 + c4));
            }
            uv[k] = v;
        }
#pragma unroll
        for (int k = 0; k < 10; ++k) { const int idx = tid + 512 * k, i = idx >> 6, c4 = (idx & 63) * 4; if (i < 15 + TT) *(LAS f32x4*)(U + i * 256 + c4) = uv[k]; }
    }
    __syncthreads();
    {
        const int ch = tid & 255, th = tid >> 8, gi = ch >> 6, w = 2 << gi;
        if (th * 32 < TT) {
            for (int tt = th * 32; tt < th * 32 + 32; ++tt) {
                float s = 0.f;
                for (int i = 0; i < w; ++i) s += U[(15 + tt - i) * 256 + ch];
                const int pos = smp ? 4096 + tt : t0 + tt; const int cnt = (pos + 1 < w) ? pos + 1 : w;
                const float d = s / (float)cnt - U[(15 + tt) * 256 + ch];
                Dd[tt * 264 + ch] = (bf16)(pk2(d, 0.f) & 0xffffu);
            }
        }
    }
    __syncthreads();
    {
        const int gi = wid >> 1, th = wid & 1;
        if (th * 32 < TT) {
            f32x16 acc0, acc1;
#pragma unroll
            for (int r = 0; r < 16; ++r) { acc0[r] = 0.f; acc1[r] = 0.f; }
#pragma unroll
            for (int ks = 0; ks < 4; ++ks) {
                const bf16x8 a = *(const LAS bf16x8*)(Dd + (th * 32 + r32) * 264 + gi * 64 + ks * 16 + hi * 8);
                const bf16x8 b0 = *(const bf16x8*)(pwt + (size_t)((l * 4 + gi) * 64 + r32) * 64 + ks * 16 + hi * 8);
                const bf16x8 b1 = *(const bf16x8*)(pwt + (size_t)((l * 4 + gi) * 64 + 32 + r32) * 64 + ks * 16 + hi * 8);
                acc0 = mfma32(a, b0, acc0); acc1 = mfma32(a, b1, acc1);
            }
            const float sc0 = pool_scale[l * 256 + gi * 64 + r32], sc1 = pool_scale[l * 256 + gi * 64 + 32 + r32];
#pragma unroll
            for (int r = 0; r < 16; ++r) { const int tok = th * 32 + crow(r, hi); bf16* mp = MIX + (size_t)(rowbase + tok) * 1024 + 512 + gi * 64 + r32;
                mp[0] = (bf16)(pk2(acc0[r] * sc0, 0.f) & 0xffffu); mp[32] = (bf16)(pk2(acc1[r] * sc1, 0.f) & 0xffffu); }
        }
    }
    if (wid * 8 < TT) {
        const int cq = lane, tc = wid * 8;
        v2u hraw[10], graw[10], braw[8]; f32x4 hst[2];
        hst[0] = (f32x4){0.f, 0.f, 0.f, 0.f}; hst[1] = hst[0];
#pragma unroll
        for (int i = 0; i < 10; ++i) {
            const int ts = tc - 2 + i; hraw[i] = (v2u){0u, 0u}; graw[i] = (v2u){0u, 0u};
            if (ts >= 0 || (!smp && t0 + ts >= 0)) { const bf16* zr = Zb + (size_t)(rowbase + ts) * 1024 + 4 * cq; hraw[i] = *(const v2u*)(zr + 256); graw[i] = *(const v2u*)(zr + 768); }
        }
#pragma unroll
        for (int i = 0; i < 8; ++i) braw[i] = *(const v2u*)(Zb + (size_t)(rowbase + tc + i) * 1024 + 512 + 4 * cq);
        if (smp && tc == 0) { hst[0] = *(const f32x4*)(state_conv + (size_t)((l * 8 + b) * 2 + 0) * 256 + 4 * cq); hst[1] = *(const f32x4*)(state_conv + (size_t)((l * 8 + b) * 2 + 1) * 256 + 4 * cq); }
        const f32x4 cw0 = *(const f32x4*)(conv_w + l * 768 + 4 * cq), cw1 = *(const f32x4*)(conv_w + l * 768 + 256 + 4 * cq), cw2 = *(const f32x4*)(conv_w + l * 768 + 512 + 4 * cq);
        f32x4 cm2 = bf4_to_f32(graw[0]) * bf4_to_f32(hraw[0]), cm1 = bf4_to_f32(graw[1]) * bf4_to_f32(hraw[1]);
        if (smp && tc == 0) { cm2 = hst[0]; cm1 = hst[1]; }
#pragma unroll
        for (int i = 0; i < 8; ++i) {
            const int tt = tc + i;
            const f32x4 cv = bf4_to_f32(graw[i + 2]) * bf4_to_f32(hraw[i + 2]);
            const f32x4 y = bf4_to_f32(braw[i]) * (cw0 * cm2 + cw1 * cm1 + cw2 * cv);
            v2u w; w.x = pk2(y.x, y.y); w.y = pk2(y.z, y.w);
            *(v2u*)(MIX + (size_t)(rowbase + tt) * 1024 + 768 + 4 * cq) = w;
            if (smp) { if (tt >= 30) *(f32x4*)(out_cs + (size_t)((l * 8 + b) * 2 + tt - 30) * 256 + 4 * cq) = cv; }
            else if (t0 + tt >= 2046) *(f32x4*)(out_cp + (size_t)((l * 8 + b) * 2 + t0 + tt - 2046) * 256 + 4 * cq) = cv;
            cm2 = cm1; cm1 = cv;
        }
    }
    __syncthreads();
}

__device__ __forceinline__ void combine_phase(int l, const bf16* Ob_, const float* OPART_, const float* MLP_, bf16* MIX_, int gw, int NGW, int lane) {
    const float lam_init = (l == 0) ? 0.2f : 0.35550934f;
    float lam;
    { const float a = KIN(12)[l * 64 + lane] * KIN(13)[l * 64 + lane], c = KIN(14)[l * 64 + lane] * KIN(15)[l * 64 + lane];
      lam = __expf(wave_sum(a)) - __expf(wave_sum(c)) + lam_init; }
    const float g0 = KIN(16)[l * 128 + 2 * lane], g1 = KIN(16)[l * 128 + 2 * lane + 1];
    for (int base = gw * 8; base < MP * 4; base += NGW * 8) {
        float a0[8], a1[8];
        {
            unsigned w1[8], w2[8];
#pragma unroll
            for (int j = 0; j < 8; ++j) { const int wt = base + j, row = wt >> 2, h = wt & 3;
                w1[j] = *(const unsigned*)(Ob_ + (size_t)row * 1024 + h * 128 + 2 * lane); w2[j] = *(const unsigned*)(Ob_ + (size_t)row * 1024 + 512 + h * 128 + 2 * lane); }
#pragma unroll
            for (int j = 0; j < 8; ++j) { a0[j] = bf2f(w1[j] & 0xffff) - lam * bf2f(w2[j] & 0xffff); a1[j] = bf2f(w1[j] >> 16) - lam * bf2f(w2[j] >> 16); }
        }
        float ss[8];
#pragma unroll
        for (int j = 0; j < 8; ++j) ss[j] = a0[j] * a0[j] + a1[j] * a1[j];
#pragma unroll
        for (int j = 0; j < 8; ++j) ss[j] += swz_xor<1>(ss[j]);
#pragma unroll
        for (int j = 0; j < 8; ++j) ss[j] += swz_xor<2>(ss[j]);
#pragma unroll
        for (int j = 0; j < 8; ++j) ss[j] += swz_xor<4>(ss[j]);
#pragma unroll
        for (int j = 0; j < 8; ++j) ss[j] += swz_xor<8>(ss[j]);
#pragma unroll
        for (int j = 0; j < 8; ++j) ss[j] += swz_xor<16>(ss[j]);
#pragma unroll
        for (int j = 0; j < 8; ++j) { const int wt = base + j, row = wt >> 2, h = wt & 3;
            const float tot = xhalf_sum(ss[j]);
            const float r = (1.0f / sqrtf(tot * (1.0f / 128.0f) + EPS)) * (1.0f - lam_init);
            *(unsigned*)(MIX_ + (size_t)row * 1024 + h * 128 + 2 * lane) = pk2(a0[j] * r * g0, a1[j] * r * g1); }
    }
    for (int wt = MP * 4 + gw; wt < M * 4; wt += NGW) {
        const int row = wt >> 2, h = wt & 3, rs = row - MP, b = rs >> 5, q = rs & 31; float oc[2][2];
#pragma unroll
        for (int c = 0; c < 2; ++c) {
            const size_t pb = (size_t)(((b * 4 + h) * 2 + c) * 9);
            float mw[9], lw[9]; f32x2 ov[9]; float Mx = -1e30f;
#pragma unroll
            for (int pi = 0; pi < 9; ++pi) { const f32x2 ml = *(const f32x2*)(MLP_ + ((pb + pi) * 32 + q) * 2); mw[pi] = ml.x; lw[pi] = ml.y; ov[pi] = *(const f32x2*)(OPART_ + ((pb + pi) * 32 + q) * 128 + 2 * lane); }
#pragma unroll
            for (int pi = 0; pi < 9; ++pi) Mx = fmaxf(Mx, mw[pi]);
            float L = 0.f, s0 = 0.f, s1 = 0.f;
#pragma unroll
            for (int pi = 0; pi < 9; ++pi) { const float fz = __builtin_amdgcn_exp2f(mw[pi] - Mx); L += lw[pi] * fz; s0 += ov[pi].x * fz; s1 += ov[pi].y * fz; }
            const float il = 1.0f / L; oc[c][0] = s0 * il; oc[c][1] = s1 * il;
        }
        const float a0 = oc[0][0] - lam * oc[1][0], a1 = oc[0][1] - lam * oc[1][1];
        const float tot = wave_sum(a0 * a0 + a1 * a1);
        const float r = (1.0f / sqrtf(tot * (1.0f / 128.0f) + EPS)) * (1.0f - lam_init);
        *(unsigned*)(MIX_ + (size_t)row * 1024 + h * 128 + 2 * lane) = pk2(a0 * r * g0, a1 * r * g1);
    }
}

#ifndef PROBE_SLOW_ATTN
#define PROBE_SLOW_ATTN 0
#endif
#if PROBE_SLOW_ATTN
__device__ __forceinline__ void slow_attn_phase(int l, const bf16* Qb_, float* outp, const float* cache_k, const float* cache_v, bf16* MIX_, int gw, int NGW, int lane) {
    const float lam_init = (l == 0) ? 0.2f : 0.35550934f;
    float lam;
    { const float a = KIN(12)[l * 64 + lane] * KIN(13)[l * 64 + lane], c = KIN(14)[l * 64 + lane] * KIN(15)[l * 64 + lane];
      lam = __expf(wave_sum(a)) - __expf(wave_sum(c)) + lam_init; }
    const float g0 = KIN(16)[l * 128 + 2 * lane], g1 = KIN(16)[l * 128 + 2 * lane + 1];
    for (int wt = gw; wt < M * 4; wt += NGW) {
        const int row = wt >> 2, h = wt & 3;
        const float *K0, *V0, *K1, *V1; int n0, n1;
        if (row < MP) { const int b = row >> 11, t = row & 2047; K0 = outp + OFF_KP + ((size_t)l * MP + (size_t)b * 2048) * 512 + h * 128; V0 = outp + OFF_VP + ((size_t)l * MP + (size_t)b * 2048) * 512 + h * 128; n0 = ((t >> 6) + 1) * 64; K1 = K0; V1 = V0; n1 = 0; }
        else { const int rs = row - MP, b = rs >> 5; K0 = cache_k + ((size_t)(l * 8 + b) * 4096) * 512 + h * 128; V0 = cache_v + ((size_t)(l * 8 + b) * 4096) * 512 + h * 128; n0 = 4096;
               K1 = outp + OFF_KS + ((size_t)(l * 8 + b) * 32) * 512 + h * 128; V1 = outp + OFF_VS + ((size_t)(l * 8 + b) * 32) * 512 + h * 128; n1 = 32; }
        float oc[2][2];
#pragma unroll 1
        for (int c = 0; c < 2; ++c) {
            float q[64];
#pragma unroll
            for (int d = 0; d < 64; ++d) q[d] = bf2f(Qb_[(size_t)row * 512 + h * 128 + c * 64 + d]);
            float mx = -1e30f;
            for (int seg = 0; seg < 2; ++seg) { const float* Kp = seg ? K1 : K0; const int n = seg ? n1 : n0;
                for (int j0 = 0; j0 < n; j0 += 64) { const int j = j0 + lane; float s = -1e30f;
                    if (j < n) { const float* kr = Kp + (size_t)j * 512 + c * 64; s = 0.f;
#pragma unroll
                        for (int d = 0; d < 64; ++d) s += q[d] * kr[d]; }
                    mx = fmaxf(mx, s); } }
            mx = fmaxf(mx, swz_xor<1>(mx)); mx = fmaxf(mx, swz_xor<2>(mx)); mx = fmaxf(mx, swz_xor<4>(mx)); mx = fmaxf(mx, swz_xor<8>(mx)); mx = fmaxf(mx, swz_xor<16>(mx)); mx = xhalf_max(mx);
            float L = 0.f, o0 = 0.f, o1 = 0.f;
            for (int seg = 0; seg < 2; ++seg) { const float* Kp = seg ? K1 : K0; const float* Vp = seg ? V1 : V0; const int n = seg ? n1 : n0;
                for (int j0 = 0; j0 < n; j0 += 64) { const int j = j0 + lane; float pj = 0.f;
                    if (j < n) { const float* kr = Kp + (size_t)j * 512 + c * 64; float s = 0.f;
#pragma unroll
                        for (int d = 0; d < 64; ++d) s += q[d] * kr[d];
                        pj = __builtin_amdgcn_exp2f(s - mx); }
                    L += pj;
                    const int nn = (n - j0 < 64) ? n - j0 : 64;
                    for (int jj = 0; jj < nn; ++jj) { const float pb = __builtin_bit_cast(float, __builtin_amdgcn_readlane(__builtin_bit_cast(int, pj), jj));
                        const f32x2 vv = *(const f32x2*)(Vp + (size_t)(j0 + jj) * 512 + 2 * lane); o0 += pb * vv.x; o1 += pb * vv.y; } } }
            L = wave_sum(L);
            oc[c][0] = o0 / L; oc[c][1] = o1 / L;
        }
        const float a0 = oc[0][0] - lam * oc[1][0], a1 = oc[0][1] - lam * oc[1][1];
        const float ss = wave_sum(a0 * a0 + a1 * a1);
        const float r = (1.0f / sqrtf(ss * (1.0f / 128.0f) + EPS)) * (1.0f - lam_init);
        *(unsigned*)(MIX_ + (size_t)row * 1024 + h * 128 + 2 * lane) = pk2(a0 * r * g0, a1 * r * g1);
    }
}
#endif

#ifndef PROBE_SLOW_PC
#define PROBE_SLOW_PC 0
#endif
#if PROBE_SLOW_PC
__device__ __forceinline__ float zval(const bf16* Zb_, const float* st, int l, int b, bool smp, int rowbase, int t, int col, int hist) {
    if (t >= 0) return bf2f(Zb_[(size_t)(rowbase + t) * 1024 + col]);
    if (!smp) return 0.f;
    return st[(size_t)((l * 8 + b) * hist + (hist + t)) * 256 + (col & 255)];
}
__device__ __forceinline__ void slow_pc_phase(int l, const bf16* Zb_, bf16* MIX_, int gw, int NGW, int lane) {
    const float* sp = KIN(4); const float* scv = KIN(5); const float* pw = KIN(17); const float* psc = KIN(18); const float* cw = KIN(19);
    for (int wt = gw; wt < M * 4; wt += NGW) {
        const int row = wt >> 2, g = wt & 3; const bool smp = row >= MP;
        int b, t, rowbase; if (smp) { const int rs = row - MP; b = rs >> 5; t = rs & 31; rowbase = MP + b * 32; } else { b = row >> 11; t = row & 2047; rowbase = b * 2048; }
        const int w = 2 << g, ch = g * 64 + lane;
        float s = 0.f;
        for (int i = 0; i < w; ++i) { const int tt = t - i; s += zval(Zb_, sp, l, b, smp, rowbase, tt, ch, 15); }
        const int pos = smp ? 4096 + t : t; const int cnt = (pos + 1 < w) ? pos + 1 : w;
        const float d = s / (float)cnt - zval(Zb_, sp, l, b, smp, rowbase, t, ch, 15);
        float mine = 0.f;
        for (int e = 0; e < 64; ++e) { const float v = wave_sum(d * pw[(size_t)((l * 4 + g) * 64 + lane) * 64 + e]); if (e == lane) mine = v; }
        MIX_[(size_t)row * 1024 + 512 + ch] = (bf16)(pk2(mine * psc[l * 256 + ch], 0.f) & 0xffffu);
        float cvv[3];
#pragma unroll
        for (int k = 0; k < 3; ++k) { const int tt = t - 2 + k;
            if (tt >= 0) cvv[k] = bf2f(Zb_[(size_t)(rowbase + tt) * 1024 + 768 + ch]) * bf2f(Zb_[(size_t)(rowbase + tt) * 1024 + 256 + ch]);
            else cvv[k] = smp ? scv[(size_t)((l * 8 + b) * 2 + (2 + tt)) * 256 + ch] : 0.f; }
        const float bgv = bf2f(Zb_[(size_t)row * 1024 + 512 + ch]);
        const float y = bgv * (cw[l * 768 + ch] * cvv[0] + cw[l * 768 + 256 + ch] * cvv[1] + cw[l * 768 + 512 + ch] * cvv[2]);
        MIX_[(size_t)row * 1024 + 768 + ch] = (bf16)(pk2(y, 0.f) & 0xffffu);
    }
}
#endif

#define XB_TMO      128
#define XB_XCNT(j)  (256  + 64 * (j))
#define XB_XSUB(j)  (1280 + 64 * (j))
#define XB_XGEN(j)  (2304 + 64 * (j))
#define XB_TOP      3328
#define XB_TOPGEN   3392
#define XCD_BAR_WORDS 3456
#define XB_SPIN_CAP (1u << 18)
__device__ __forceinline__ unsigned xb_ld(unsigned* p)              { return __hip_atomic_load(p, __ATOMIC_RELAXED, __HIP_MEMORY_SCOPE_AGENT); }
__device__ __forceinline__ unsigned xb_add(unsigned* p, unsigned v) { return __hip_atomic_fetch_add(p, v, __ATOMIC_RELAXED, __HIP_MEMORY_SCOPE_AGENT); }
__device__ __forceinline__ unsigned xb_xcc_id() { return (unsigned)__builtin_amdgcn_s_getreg((3 << 11) | 20) & 0xFu; }
#define XB_SPIN(cond, bar) do { unsigned _sp = 0; while (cond) { __builtin_amdgcn_s_sleep(1); \
    if ((++_sp & 255u) == 0u) { if (xb_ld(&(bar)[XB_TMO])) break; if (_sp > XB_SPIN_CAP) { atomicAdd(&(bar)[XB_TMO], 1u); break; } } } } while (0)
__device__ __forceinline__ void xcd_barrier_complete(unsigned* bar, unsigned x, unsigned& nloc, unsigned& nx) {
    const unsigned G = gridDim.x * gridDim.y * gridDim.z;
    unsigned sum, cnt, mine, sp = 0u;
    for (;;) {
        sum = 0u; cnt = 0u; mine = 0u;
#pragma unroll
        for (unsigned j = 0; j < 16; ++j) { const unsigned c = xb_ld(&bar[XB_XCNT(j)]); sum += c; cnt += (c > 0u) ? 1u : 0u; mine = (j == x) ? c : mine; }
        if (sum == G) break;
        __builtin_amdgcn_s_sleep(1);
        if ((++sp & 255u) == 0u) { if (xb_ld(&bar[XB_TMO])) break; if (sp > XB_SPIN_CAP) { atomicAdd(&bar[XB_TMO], 1u); break; } }
    }
    nloc = mine > 0u ? mine : 1u; nx = cnt > 0u ? cnt : 1u;
}
__device__ __forceinline__ void xcd_barrier(unsigned* bar, unsigned x, volatile LAS unsigned* st) {
    asm volatile("s_waitcnt vmcnt(0)" ::: "memory");
    __syncthreads();
    if (threadIdx.x == 0) {
        __builtin_amdgcn_s_waitcnt(0);
        unsigned nloc = st[0], nx = st[1];
        if (nloc == 0u) { xcd_barrier_complete(bar, x, nloc, nx); st[0] = nloc; st[1] = nx; }
        const unsigned old = xb_add(&bar[XB_XSUB(x)], 1u);
        const unsigned gen = old / nloc;
        if (old + 1u == (gen + 1u) * nloc) {
            __builtin_amdgcn_fence(__ATOMIC_RELEASE, "agent");
            asm volatile("s_waitcnt vmcnt(0)" ::: "memory");
            const unsigned og = xb_add(&bar[XB_TOP], 1u);
            const unsigned tg = og / nx;
            if (og + 1u == (tg + 1u) * nx) xb_add(&bar[XB_TOPGEN], 1u);
            else XB_SPIN(xb_ld(&bar[XB_TOPGEN]) == tg, bar);
            __builtin_amdgcn_fence(__ATOMIC_ACQUIRE, "agent");
            xb_add(&bar[XB_XGEN(x)], 1u);
            asm volatile("s_waitcnt vmcnt(0)" ::: "memory");
        } else {
            XB_SPIN(xb_ld(&bar[XB_XGEN(x)]) == gen, bar);
            __builtin_amdgcn_fence(__ATOMIC_ACQUIRE, "agent");
            asm volatile("s_waitcnt vmcnt(0)" ::: "memory");
        }
    }
    __syncthreads();
}
#define CG_SYNC() do { asm volatile("s_waitcnt vmcnt(0) lgkmcnt(0)" ::: "memory"); grid.sync(); asm volatile("" ::: "memory"); } while (0)
#define GRID_SYNC() xcd_barrier((unsigned*)KWS() + 4096, xcc, (volatile LAS unsigned*)(lds + LDS_BYTES - 64))
__global__ void __launch_bounds__(NWAVES * 64, 2) mega_fwd(Params p) {
    extern __shared__ __attribute__((aligned(16))) unsigned char lds_raw[];
    LAS unsigned char* lds = (LAS unsigned char*)lds_raw;
    cg::grid_group grid = cg::this_grid();
    const int tid = threadIdx.x, lane = tid & 63, wave = __builtin_amdgcn_readfirstlane(tid >> 6);
    const int G = gridDim.x; const int bx = blockIdx.x; const int vcu0 = (G % 8 == 0) ? (bx % 8) * (G / 8) + bx / 8 : bx;
    const int NGW = G * NWAVES;
#define X ((float*)(ws + WS_X))
#define H ((bf16*)(ws + WS_H))
#define MIX ((bf16*)(ws + WS_MIX))
#define ACT ((bf16*)(ws + WS_ACT))
#define Qb ((bf16*)(ws + WS_QB))
#define Kb ((bf16*)(ws + WS_KB))
#define Vb ((bf16*)(ws + WS_VB))
#define Zb ((bf16*)(ws + WS_ZB))
#define Ob ((bf16*)(ws + WS_OB))
#define OPART ((float*)(ws + WS_OPART))
#define MLP ((float*)(ws + WS_ML))
#define pwt ((const bf16*)(ws + WS_POOLWT))
    if (tid < 16) ((LAS unsigned*)(lds + LDS_BYTES - 64))[tid] = 0u;
    const unsigned xcc = xb_xcc_id();
    if (tid == 0) (void)xb_add((unsigned*)KWS() + 4096 + XB_XCNT(xcc), 1u);
    __syncthreads();
    { const int gw = vcu0 * NWAVES + wave; prologue(lds, gw, NGW, wave, lane); }
    CG_SYNC();
#define FRESH_IDS() int tid = threadIdx.x; asm volatile("" : "+v"(tid)); const int lane = tid & 63, wave = __builtin_amdgcn_readfirstlane(tid >> 6); int vcu = vcu0; asm volatile("" : "+s"(vcu)); const int gw = vcu * NWAVES + wave; (void)lane; (void)gw; (void)wave
#pragma unroll 1
    for (int step = 0; step < 4; ++step) {
        const int l = step >> 1, f = step & 1;
        const bool first = (step == 0);
        { FRESH_IDS(); unsigned char* const ws = KWS();
          norm_rows<false>(first ? KIN(0) : X, first ? KIN(1) : X + (size_t)MP * D, (f ? KIN(21) : KIN(6)) + l * D, H, nullptr, gw, NGW, lane); }
        GRID_SYNC();
        { FRESH_IDS(); unsigned char* const ws = KWS(); unsigned char* const wl = ws + WS_W + (size_t)l * WL;
          pg8::Gemm g{H, (const bf16*)(wl + (f ? W_GU2 : W_GU1)), M, 2 * FF, D}; pg8::StaticOrder S; S.init(M, 2 * FF, G, bx);
          pg8::EpiSwiGLU E{ACT, FF};
          pg8::gemm_phase<pg8::EpiSwiGLU, pg8::StaticOrder, true, true>(lds, g, S, E); }
        GRID_SYNC();
        { FRESH_IDS(); unsigned char* const ws = KWS(); unsigned char* const wl = ws + WS_W + (size_t)l * WL;
          pg8::Gemm g{ACT, (const bf16*)(wl + (f ? W_D2 : W_D1)), MP, D, FF}; pg8::StaticOrder S; S.init(MP, D, G, bx);
          pg8::EpiResid E{first ? KIN(0) : X, first ? KIN(1) : X + (size_t)MP * D, X, 0.5f};
          pg8::gemm_phase<pg8::EpiResid, pg8::StaticOrder, true, true>(lds, g, S, E);
          skinny_gemm(lds, ACT + (size_t)MP * FF, (const bf16*)(wl + (f ? W_D2 : W_D1)), FF, first ? KIN(1) : X + (size_t)MP * D, X + (size_t)MP * D, 0.5f, vcu, G, tid); }
        GRID_SYNC();
        if (f == 0) {
            { FRESH_IDS(); unsigned char* const ws = KWS();
              norm_rows<false>(X, X + (size_t)MP * D, KIN(10) + l * D, H, nullptr, gw, NGW, lane); }
            GRID_SYNC();
            { FRESH_IDS(); unsigned char* const ws = KWS(); unsigned char* const wl = ws + WS_W + (size_t)l * WL;
              pg8::Gemm g{H, (const bf16*)(wl + W_IN), M, DIN, D}; pg8::StaticOrder S; S.init(M, DIN, G, bx);
              pg8::EpiWin E{ws, KOUT(), l, C2};
              pg8::gemm_phase<pg8::EpiWin, pg8::StaticOrder, true, true>(lds, g, S, E); }
            GRID_SYNC();
#if !PROBE_SLOW_ATTN
            { FRESH_IDS(); unsigned char* const ws = KWS();
              for (int i = 0; i < 4; ++i) {
                const int L = i * G + vcu; if (L >= 1024) break;
                const int bh = (L & 255) >> 1, sI = L & 1, ii = L >> 8;
                const int qb = sI == 0 ? (ii == 0 ? 7 : ii == 1 ? 0 : ii == 2 ? 4 : 3) : (ii == 0 ? 6 : ii == 1 ? 1 : ii == 2 ? 5 : 2);
                const int b = bh >> 4, vh = bh & 15, hh = vh >> 2, c = (vh >> 1) & 1, hf = vh & 1;
                attn_body::attn_unit<8>(b, qb, (const attn_body::bf16*)(Qb + (hh * 2 + c) * 64), (const attn_body::bf16*)(Kb + (hh * 2 + c) * 64), (const attn_body::bf16*)(Vb + hh * 128 + hf * 64),
                                        (attn_body::bf16*)(Ob + c * 512 + hh * 128 + hf * 64), (char*)lds_raw);
              } }
            __syncthreads();
            { FRESH_IDS(); unsigned char* const ws = KWS(); float* const outp = KOUT();
              for (int pc = vcu; pc < 256; pc += G)
                sample_piece(lds, pc, l, Qb, KIN(2), KIN(3), outp + OFF_KS, outp + OFF_VS, OPART, MLP, tid); }
            __syncthreads();
#endif
            { FRESH_IDS(); unsigned char* const ws = KWS(); float* const outp = KOUT();
              for (int tl = vcu; tl < 264; tl += G)
                poolconv_tile(lds, tl, l, Zb, MIX, KIN(4), KIN(5), pwt, KIN(18), KIN(19), outp + OFF_CP, outp + OFF_CS, tid); }
            GRID_SYNC();
#if PROBE_SLOW_PC
            { FRESH_IDS(); unsigned char* const ws = KWS();
              slow_pc_phase(l, Zb, MIX, gw, NGW, lane); }
#endif
#if PROBE_SLOW_ATTN
            { FRESH_IDS(); unsigned char* const ws = KWS();
              slow_attn_phase(l, Qb, KOUT(), KIN(2), KIN(3), MIX, gw, NGW, lane); }
#else
            { FRESH_IDS(); unsigned char* const ws = KWS();
              combine_phase(l, Ob, OPART, MLP, MIX, gw, NGW, lane); }
#endif
            GRID_SYNC();
            { FRESH_IDS(); unsigned char* const ws = KWS(); unsigned char* const wl = ws + WS_W + (size_t)l * WL;
              pg8::Gemm g{MIX, (const bf16*)(wl + W_OUT), MP, D, D}; pg8::StaticOrder S; S.init(MP, D, G, bx);
              pg8::EpiResid E{X, X + (size_t)MP * D, X, 1.0f};
              pg8::gemm_phase<pg8::EpiResid, pg8::StaticOrder, true, true>(lds, g, S, E);
              skinny_gemm(lds, MIX + (size_t)MP * D, (const bf16*)(wl + W_OUT), D, X + (size_t)MP * D, X + (size_t)MP * D, 1.0f, vcu, G, tid); }
            GRID_SYNC();
        }
    }
    { FRESH_IDS(); unsigned char* const ws = KWS();
      norm_rows<true>(X, X + (size_t)MP * D, KIN(25), nullptr, KOUT() + OFF_Y, gw, NGW, lane); }
}

extern "C" void kernel_launch(void* const* d_in, const int* in_sizes, int n_in, void* d_out, int out_size, void* d_ws, size_t ws_size, hipStream_t stream) {
    static int grid = 0;
    if (grid == 0) {
        if (n_in != 26 || (size_t)out_size != OUT_TOTAL || ws_size < WS_END) { fprintf(stderr, "kernel_launch: unexpected problem shape: n_in %d out %d ws %zu\n", n_in, out_size, ws_size); grid = -1; return; }
        int dev = 0, cus = 0, per_cu = 0;
        if (hipGetDevice(&dev) != hipSuccess || hipDeviceGetAttribute(&cus, hipDeviceAttributeMultiprocessorCount, dev) != hipSuccess) { grid = -1; return; }
        if (hipFuncSetAttribute((const void*)mega_fwd, hipFuncAttributeMaxDynamicSharedMemorySize, LDS_BYTES) != hipSuccess) { fprintf(stderr, "kernel_launch: hipFuncSetAttribute failed\n"); grid = -1; return; }
        if (hipOccupancyMaxActiveBlocksPerMultiprocessor(&per_cu, (const void*)mega_fwd, NWAVES * 64, LDS_BYTES) != hipSuccess || per_cu < 1) { fprintf(stderr, "kernel_launch: occupancy query says %d\n", per_cu); per_cu = 1; }
        (void)hipGetLastError();
        grid = cus * per_cu;
    }
    if (grid < 0) return;
    if (hipMemsetAsync(d_ws, 0, 65536, stream) != hipSuccess) { fprintf(stderr, "kernel_launch: memset failed\n"); return; }
    Params p{};
    for (int i = 0; i < 26; ++i) p.in[i] = (const float*)d_in[i];
    p.out = (float*)d_out; p.ws = (unsigned char*)d_ws;
    void* args[] = {&p};
    const hipError_t e = hipLaunchCooperativeKernel((const void*)mega_fwd, dim3(grid), dim3(NWAVES * 64), args, LDS_BYTES, stream);
    if (e != hipSuccess) fprintf(stderr, "kernel_launch: cooperative launch failed: %s (grid %d)\n", hipGetErrorString(e), grid);
}
```

```cpp
#include <hip/hip_runtime.h>
#include <hip/hip_cooperative_groups.h>
#include <cstdio>
#include <cstdint>
namespace pg8 {
#define PG8_LAS __attribute__((address_space(3)))
typedef unsigned short bf16_t;
typedef short bf16x8 __attribute__((ext_vector_type(8)));
typedef float f32x4 __attribute__((ext_vector_type(4)));
typedef unsigned u32x4 __attribute__((ext_vector_type(4)));
constexpr int BM = 256, BK = 64, HALF = 128, HTB = HALF * BK * 2  , STAGE_BYTES = 8 * HTB, NXCD = 8, WGM = 8;

__host__ __device__ __forceinline__ int lds_byte(int r, int c) { const int st = (r >> 4) * 2 + (c >> 5), rr = r & 15, cc = c & 31, ob = rr * 64 + cc * 2; return st * 1024 + (ob ^ (((ob >> 9) & 1) << 5)); }
__host__ __device__ __forceinline__ void stage_rc(int b, int& R, int& C) { const int st = b / 1024, sb = b % 1024, swz = sb ^ (((sb >> 9) & 1) << 5); R = (st >> 1) * 16 + swz / 64; C = (st & 1) * 32 + (swz % 64) / 2; }
__host__ __device__ __forceinline__ int perm32(int rho) { const int n = rho >> 4, i = rho & 15; return 8 * (i >> 2) + 4 * n + (i & 3); }

struct Unit { int pm, pn; };
struct Gemm { const bf16_t* A; const bf16_t* Bt; int M, N, K; };

struct StaticOrder {
    int nM, nN, nwg, G, c;
    __host__ __device__ __forceinline__ void init(int M, int N, int G_, int c_) { nM = M / BM; nN = N / BM; nwg = nM * nN; G = G_; c = c_; }
    __host__ __device__ __forceinline__ bool next(int i, Unit& u) const {
        const long L = (long)i * G + c; if (L >= nwg) return false;
        int wgid = (int)L; { const int q = nwg / NXCD, r = nwg % NXCD, xcd = wgid % NXCD, off = wgid / NXCD; wgid = (xcd < r ? xcd * (q + 1) : r * (q + 1) + (xcd - r) * q) + off; }
        const int nig = WGM * nN, gid = wgid / nig, fm = gid * WGM, gsz = (nM - fm) < WGM ? (nM - fm) : WGM;
        u.pm = fm + ((wgid % nig) % gsz); u.pn = (wgid % nig) / gsz; return true;
    }
    __device__ __forceinline__ void a_ready(const Unit&) const {}
    __device__ __forceinline__ void done(const Unit&) const {}
};

__device__ __forceinline__ unsigned cvt_pk_bf16(float lo, float hi) { unsigned r; asm volatile("v_cvt_pk_bf16_f32 %0, %1, %2" : "=v"(r) : "v"(lo), "v"(hi)); return r; }
typedef float f32x2 __attribute__((ext_vector_type(2)));
typedef unsigned u32x2 __attribute__((ext_vector_type(2)));
constexpr size_t WOFF_ROPE = (size_t)1 << 20, WOFF_QB = (size_t)215 << 20, WOFF_KB = (size_t)232 << 20, WOFF_VB = (size_t)249 << 20, WOFF_ZB = (size_t)266 << 20;
constexpr size_t OOFF_KP = 17039360, OOFF_VP = 33816576, OOFF_PP = 50593792, OOFF_KS = 50663424, OOFF_VS = 50925568, OOFF_PS = 51187712;
__device__ __forceinline__ float silu_mul(float g, float u) { const float e = __builtin_amdgcn_exp2f(-1.4426950408889634f * g); return g * u * __builtin_amdgcn_rcpf(1.0f + e); }
struct EpiSwiGLU {
    static constexpr bool PERM = true, AFTER_DRAIN = false;
    bf16_t* O; int ldc;
    __device__ __forceinline__ void operator()(const f32x4 (&acc)[2][2][4][2], const Unit& u, int wr, int wc, int fr, int fq) const {
        const int row0 = u.pm * BM + wr * 64 + fr; const int col0 = u.pn * 128 + wc * 32 + 8 * fq;
#pragma unroll
        for (int ai = 0; ai < 2; ++ai)
#pragma unroll
            for (int m = 0; m < 4; ++m) {
                bf16_t* p = O + (size_t)(row0 + ai * HALF + m * 16) * ldc + col0;
                const f32x4 g0 = acc[ai][0][m][0], g1 = acc[ai][0][m][1], u0 = acc[ai][1][m][0], u1 = acc[ai][1][m][1];
                u32x4 w;
                w.x = cvt_pk_bf16(silu_mul(g0[0], u0[0]), silu_mul(g0[1], u0[1])); w.y = cvt_pk_bf16(silu_mul(g0[2], u0[2]), silu_mul(g0[3], u0[3]));
                w.z = cvt_pk_bf16(silu_mul(g1[0], u1[0]), silu_mul(g1[1], u1[1])); w.w = cvt_pk_bf16(silu_mul(g1[2], u1[2]), silu_mul(g1[3], u1[3]));
                *(u32x4*)p = w;
                asm volatile("" ::: "memory");
            }
    }
};
struct EpiResid {
    static constexpr bool PERM = false, AFTER_DRAIN = false;
    const float* baseP; const float* baseS; float* out; float scale;
    __device__ __forceinline__ void operator()(const f32x4 (&acc)[2][2][4][2], const Unit& u, int wr, int wc, int fr, int fq) const {
        const int col0 = u.pn * BM + wc * 32 + 4 * fq;
#pragma unroll
        for (int ai = 0; ai < 2; ++ai)
#pragma unroll
            for (int m = 0; m < 4; ++m) {
                const int row = u.pm * BM + ai * HALF + wr * 64 + m * 16 + fr;
                const float* bp = (row < 16384) ? baseP + (size_t)row * 1024 : baseS + (size_t)(row - 16384) * 1024;
                float* op = out + (size_t)row * 1024;
#pragma unroll
                for (int bj = 0; bj < 2; ++bj)
#pragma unroll
                    for (int n = 0; n < 2; ++n) { const int c = col0 + bj * HALF + n * 16; const f32x4 b = *(const f32x4*)(bp + c); *(f32x4*)(op + c) = b + acc[ai][bj][m][n] * scale; }
                asm volatile("" ::: "memory");
            }
    }
};
constexpr float RMS_EPS = 1e-6f;
__device__ __forceinline__ float rstd_of(float ss) { return 1.0f / sqrtf(ss * (1.0f / 1024.0f) + RMS_EPS); }

#define PG8_RLX_AGENT __ATOMIC_RELAXED, __HIP_MEMORY_SCOPE_AGENT
template <bool BASE16> struct EpiResidNorm {
    static constexpr bool PERM = false, AFTER_DRAIN = true;
    const void* baseP; bf16_t* out; float scale; bf16_t* hb; float* yout; const float* gain; unsigned* slots; unsigned* cnt;
    __device__ __forceinline__ void fused(f32x4 (&acc)[2][2][4][2], const Unit& u, int wr, int wc, int fr, int fq, PG8_LAS unsigned char* lds, int wid, int lane) const {
        PG8_LAS float* P = (PG8_LAS float*)lds;
        PG8_LAS float* S = (PG8_LAS float*)(lds + 4096);
        const int col0 = u.pn * BM + wc * 32 + 4 * fq;
#pragma unroll
        for (int ai = 0; ai < 2; ++ai)
#pragma unroll
            for (int m = 0; m < 4; ++m) {
                const int rl = ai * HALF + wr * 64 + m * 16 + fr; const size_t ro = (size_t)(u.pm * BM + rl) * 1024;
                float ss = 0.f;
#pragma unroll
                for (int bj = 0; bj < 2; ++bj)
#pragma unroll
                    for (int n = 0; n < 2; ++n) { const int c = col0 + bj * HALF + n * 16; f32x4 bv;
                        if (BASE16) { const u32x2 bw = *(const u32x2*)((const bf16_t*)baseP + ro + c); bv[0] = __builtin_bit_cast(float, bw.x << 16); bv[1] = __builtin_bit_cast(float, bw.x & 0xffff0000u); bv[2] = __builtin_bit_cast(float, bw.y << 16); bv[3] = __builtin_bit_cast(float, bw.y & 0xffff0000u); }
                        else bv = *(const f32x4*)((const float*)baseP + ro + c);
                        const f32x4 v = bv + acc[ai][bj][m][n] * scale; acc[ai][bj][m][n] = v;
                        if (out) { u32x2 w; w.x = cvt_pk_bf16(v[0], v[1]); w.y = cvt_pk_bf16(v[2], v[3]); *(u32x2*)(out + ro + c) = w; }
                        ss += (v[0] * v[0] + v[1] * v[1]) + (v[2] * v[2] + v[3] * v[3]); }
                ss += __builtin_bit_cast(float, __builtin_amdgcn_ds_swizzle(__builtin_bit_cast(int, ss), (16 << 10) | 0x1f));
                { float a = ss, b2 = ss; asm volatile("s_nop 1\n\tv_permlane32_swap_b32 %0, %1\n\ts_nop 1" : "+v"(a), "+v"(b2)); ss = a + b2; }
                if (fq == 0) P[rl * 4 + wc] = ss;
                if (m & 1) asm volatile("" ::: "memory");
            }
        asm volatile("s_waitcnt lgkmcnt(0)\n\ts_barrier" ::: "memory");
        const int t = wid * 64 + lane;
        if (t < 256) { const float s = (P[t * 4] + P[t * 4 + 1]) + (P[t * 4 + 2] + P[t * 4 + 3]);
            __hip_atomic_store(slots + (size_t)(u.pm * BM + t) * 4 + u.pn, __builtin_bit_cast(unsigned, s), PG8_RLX_AGENT); }
        asm volatile("s_waitcnt vmcnt(0)" ::: "memory");
        if (wid < 4 && lane == 0) __hip_atomic_fetch_add(cnt, 1u, PG8_RLX_AGENT);
        if (wid == 0) {
            unsigned spins = 0;
            while ((unsigned)__builtin_amdgcn_readfirstlane(__hip_atomic_load(cnt, PG8_RLX_AGENT)) < 16u) { __builtin_amdgcn_s_sleep(2); if (++spins > (1u << 22)) break; }
            __builtin_amdgcn_fence(__ATOMIC_ACQUIRE, "agent");
        }
        asm volatile("s_waitcnt vmcnt(0) lgkmcnt(0)\n\ts_barrier" ::: "memory");
        if (t < 256) { const unsigned* sl = slots + (size_t)(u.pm * BM + t) * 4; float tot = 0.f;
#pragma unroll
            for (int k = 0; k < 4; ++k) tot += __builtin_bit_cast(float, __hip_atomic_load(sl + k, PG8_RLX_AGENT));
            S[t] = rstd_of(tot); }
        asm volatile("s_waitcnt lgkmcnt(0)\n\ts_barrier" ::: "memory");
        f32x4 g4[2][2];
#pragma unroll
        for (int bj = 0; bj < 2; ++bj)
#pragma unroll
            for (int n = 0; n < 2; ++n) g4[bj][n] = *(const f32x4*)(gain + col0 + bj * HALF + n * 16);
#pragma unroll
        for (int ai = 0; ai < 2; ++ai)
#pragma unroll
            for (int m = 0; m < 4; ++m) {
                const int rl = ai * HALF + wr * 64 + m * 16 + fr; const size_t ro = (size_t)(u.pm * BM + rl) * 1024; const float r = S[rl];
#pragma unroll
                for (int bj = 0; bj < 2; ++bj)
#pragma unroll
                    for (int n = 0; n < 2; ++n) { const int c = col0 + bj * HALF + n * 16; const f32x4 y = acc[ai][bj][m][n] * r * g4[bj][n];
                        if (hb) { u32x2 w; w.x = cvt_pk_bf16(y[0], y[1]); w.y = cvt_pk_bf16(y[2], y[3]); *(u32x2*)(hb + ro + c) = w; }
                        else *(f32x4*)(yout + ro + c) = y; }
            }
        asm volatile("s_waitcnt lgkmcnt(0)\n\ts_barrier" ::: "memory");
    }
};

struct EpiWin {
    static constexpr bool PERM = false, AFTER_DRAIN = false;
    unsigned char* ws; float* outp; int l; float qscale;
    __device__ __forceinline__ void operator()(const f32x4 (&acc)[2][2][4][2], const Unit& u, int wr, int wc, int fr, int fq) const {
        const int pn = u.pn;
        bf16_t* const Qb = (bf16_t*)(ws + WOFF_QB); bf16_t* const Kb = (bf16_t*)(ws + WOFF_KB); bf16_t* const Vb = (bf16_t*)(ws + WOFF_VB); bf16_t* const Zb = (bf16_t*)(ws + WOFF_ZB);
        const float* const rope = (const float*)(ws + WOFF_ROPE);
        float* const kP = outp + OOFF_KP + (size_t)l * 16384 * 512; float* const vP = outp + OOFF_VP + (size_t)l * 16384 * 512;
        float* const kS = outp + OOFF_KS + (size_t)l * 256 * 512; float* const vS = outp + OOFF_VS + (size_t)l * 256 * 512;
        float* const poolP = outp + OOFF_PP + (size_t)l * 8 * 15 * 256; float* const poolS = outp + OOFF_PS + (size_t)l * 8 * 15 * 256;
#pragma unroll
        for (int ai = 0; ai < 2; ++ai)
#pragma unroll
            for (int m = 0; m < 4; ++m) {
                const int row = u.pm * BM + ai * HALF + wr * 64 + m * 16 + fr;
                const bool smp = row >= 16384; const int rs = row - 16384;
                const int prow = smp ? 2048 + (rs & 31) : (row & 2047);
#pragma unroll
                for (int bj = 0; bj < 2; ++bj) {
                    const int dlo = 16 * (wc & 1) + 4 * fq, lc0 = 64 * (2 * bj + (wc >> 1)) + dlo;
                    const f32x4 a0 = acc[ai][bj][m][0], a1 = acc[ai][bj][m][1];
                    if (pn < 4) {
                        const f32x4 cs = *(const f32x4*)(rope + (size_t)prow * 64 + dlo), sn = *(const f32x4*)(rope + (size_t)prow * 64 + 32 + dlo);
                        const f32x4 r0 = a0 * cs - a1 * sn, r1 = a1 * cs + a0 * sn;
                        if (pn < 2) {
                            const int col = 256 * pn + lc0; bf16_t* q = Qb + (size_t)row * 512 + col;
                            u32x2 w0, w1; w0.x = cvt_pk_bf16(r0[0] * qscale, r0[1] * qscale); w0.y = cvt_pk_bf16(r0[2] * qscale, r0[3] * qscale);
                            w1.x = cvt_pk_bf16(r1[0] * qscale, r1[1] * qscale); w1.y = cvt_pk_bf16(r1[2] * qscale, r1[3] * qscale);
                            *(u32x2*)q = w0; *(u32x2*)(q + 32) = w1;
                        } else {
                            const int col = 256 * (pn - 2) + lc0; bf16_t* k = Kb + (size_t)row * 512 + col;
                            float* ko = smp ? kS + (size_t)rs * 512 + col : kP + (size_t)row * 512 + col;
                            *(f32x4*)ko = r0; *(f32x4*)(ko + 32) = r1;
                            u32x2 w0, w1; w0.x = cvt_pk_bf16(r0[0], r0[1]); w0.y = cvt_pk_bf16(r0[2], r0[3]); w1.x = cvt_pk_bf16(r1[0], r1[1]); w1.y = cvt_pk_bf16(r1[2], r1[3]);
                            *(u32x2*)k = w0; *(u32x2*)(k + 32) = w1;
                        }
                    } else if (pn < 6) {
                        const int col = 256 * (pn - 4) + lc0; bf16_t* v = Vb + (size_t)row * 512 + col;
                        float* vo = smp ? vS + (size_t)rs * 512 + col : vP + (size_t)row * 512 + col;
                        *(f32x4*)vo = a0; *(f32x4*)(vo + 32) = a1;
                        u32x2 w0, w1; w0.x = cvt_pk_bf16(a0[0], a0[1]); w0.y = cvt_pk_bf16(a0[2], a0[3]); w1.x = cvt_pk_bf16(a1[0], a1[1]); w1.y = cvt_pk_bf16(a1[2], a1[3]);
                        *(u32x2*)v = w0; *(u32x2*)(v + 32) = w1;
                    } else {
                        const int col = 256 * (pn - 6) + lc0; bf16_t* z = Zb + (size_t)row * 1024 + col;
                        u32x2 w0, w1; w0.x = cvt_pk_bf16(a0[0], a0[1]); w0.y = cvt_pk_bf16(a0[2], a0[3]); w1.x = cvt_pk_bf16(a1[0], a1[1]); w1.y = cvt_pk_bf16(a1[2], a1[3]);
                        *(u32x2*)z = w0; *(u32x2*)(z + 32) = w1;
                        if (pn == 6) {
                            if (smp) { const int b = rs >> 5, t = rs & 31; if (t >= 17) { float* po = poolS + (size_t)(b * 15 + t - 17) * 256 + lc0; *(f32x4*)po = a0; *(f32x4*)(po + 32) = a1; } }
                            else { const int b = row >> 11, t = row & 2047; if (t >= 2033) { float* po = poolP + (size_t)(b * 15 + t - 2033) * 256 + lc0; *(f32x4*)po = a0; *(f32x4*)(po + 32) = a1; } }
                        }
                    }
                }
                asm volatile("" ::: "memory");
            }
    }
};
template <class Epi, class Sched, bool ALIGN_EPI = false, bool SP2 = false>
__device__ __forceinline__ void gemm_phase(PG8_LAS unsigned char* lds, const Gemm g, const Sched& S, const Epi& E) {
    int tid_l = threadIdx.x; asm volatile("" : "+v"(tid_l)); const int tid = tid_l, wid = __builtin_amdgcn_readfirstlane(tid >> 6), lane = tid & 63, wr = wid >> 2, wc = wid & 3, fr = lane & 15, fq = lane >> 4;
    const int K = g.K, nt = K / BK;
    unsigned voffA[2], voffB[2];
#pragma unroll
    for (int i = 0; i < 2; ++i) { int R, C; stage_rc(tid * 16 + i * 8192, R, C); const int Rb = Epi::PERM ? ((R & ~31) + perm32(R & 31)) : R;
        voffA[i] = (unsigned)(R * K + C) * 2u; voffB[i] = (unsigned)(Rb * K + C) * 2u; }
    const size_t kstep = (size_t)(BK * 2);
    const size_t hstep = (size_t)HALF * K * 2;
    const size_t tstep = 2 * hstep;
    const unsigned ldsw = (unsigned)wid * 1024u;
    const int aoff = lds_byte(wr * 64 + fr, fq * 8), boff = lds_byte(wc * 32 + fr, fq * 8);
#define PG8_SA(b, h) (((b) * 2 + (h)) * HTB)
#define PG8_SB(b, h) ((4 + (b) * 2 + (h)) * HTB)
#define PG8_STAGE(bufoff, gbase, voff) do { _Pragma("unroll") for (int _i = 0; _i < 2; ++_i) \
        __builtin_amdgcn_global_load_lds((const unsigned*)((const char*)(gbase) + (voff)[_i]), (PG8_LAS unsigned*)(lds + (bufoff) + ldsw + _i * 8192), 16, 0, 0); } while (0)
#define PG8_LDA(dst, b, h) do { _Pragma("unroll") for (int m = 0; m < 4; ++m) _Pragma("unroll") for (int k = 0; k < 2; ++k) dst[m][k] = *(const PG8_LAS bf16x8*)(lds + PG8_SA(b, h) + aoff + m * 2048 + k * 1024); } while (0)
#define PG8_LDB(dst, b, h) do { _Pragma("unroll") for (int n = 0; n < 2; ++n) _Pragma("unroll") for (int k = 0; k < 2; ++k) dst[n][k] = *(const PG8_LAS bf16x8*)(lds + PG8_SB(b, h) + boff + n * 2048 + k * 1024); } while (0)
#define PG8_MMA(ai, bj, At, Bt) do { __builtin_amdgcn_s_setprio(1); _Pragma("unroll") for (int m = 0; m < 4; ++m) _Pragma("unroll") for (int n = 0; n < 2; ++n) _Pragma("unroll") for (int k = 0; k < 2; ++k) \
        acc[ai][bj][m][n] = __builtin_amdgcn_mfma_f32_16x16x32_bf16(Bt[n][k], At[m][k], acc[ai][bj][m][n], 0, 0, 0); __builtin_amdgcn_s_setprio(0); } while (0)
#define PG8_WAIT_V(n) asm volatile("s_waitcnt vmcnt(" #n ")" ::: "memory")
#define PG8_WAIT_L(n) asm volatile("s_waitcnt lgkmcnt(" #n ")" ::: "memory")
#define PG8_BAR __builtin_amdgcn_s_barrier()
#define PG8_SCHED __builtin_amdgcn_sched_barrier(0)
    Unit cur, nxt; int ui = 0;
    if (!S.next(0, cur)) return;
    f32x4 acc[2][2][4][2];
#pragma unroll
    for (int a = 0; a < 2; ++a)
#pragma unroll
        for (int b = 0; b < 2; ++b)
#pragma unroll
            for (int m = 0; m < 4; ++m)
#pragma unroll
                for (int n = 0; n < 2; ++n) acc[a][b][m][n] = (f32x4){0.f, 0.f, 0.f, 0.f};
    bf16x8 At[4][2], B0[2][2], B1[2][2];
    const char* cA = (const char*)g.A + (size_t)cur.pm * tstep; const char* cB = (const char*)g.Bt + (size_t)cur.pn * tstep;
    S.a_ready(cur);
    if constexpr (SP2) {
        PG8_STAGE(PG8_SB(0, 0), cB, voffB); PG8_STAGE(PG8_SB(0, 1), cB + hstep, voffB); PG8_STAGE(PG8_SA(0, 0), cA, voffA); PG8_STAGE(PG8_SA(0, 1), cA + hstep, voffA);
        if (wr == 1) PG8_BAR;
        PG8_WAIT_V(2); PG8_BAR;
        PG8_STAGE(PG8_SB(1, 0), cB + kstep, voffB); PG8_STAGE(PG8_SA(1, 0), cA + kstep, voffA); PG8_STAGE(PG8_SB(1, 1), cB + hstep + kstep, voffB);
        PG8_WAIT_V(6); PG8_BAR;
    } else {
        PG8_STAGE(PG8_SB(0, 0), cB, voffB); PG8_STAGE(PG8_SA(0, 0), cA, voffA); PG8_STAGE(PG8_SB(0, 1), cB + hstep, voffB); PG8_STAGE(PG8_SA(0, 1), cA + hstep, voffA);
        if (wr == 1) PG8_BAR;
        PG8_WAIT_V(4); PG8_BAR;
        PG8_STAGE(PG8_SB(1, 0), cB + kstep, voffB); PG8_STAGE(PG8_SA(1, 0), cA + kstep, voffA); PG8_STAGE(PG8_SB(1, 1), cB + hstep + kstep, voffB);
        PG8_WAIT_V(6); PG8_BAR;
    }
    for (;;) {
        const bool has_next = S.next(ui + 1, nxt);
        const char* nA = has_next ? (const char*)g.A + (size_t)nxt.pm * tstep : cA; const char* nB = has_next ? (const char*)g.Bt + (size_t)nxt.pn * tstep : cB;
        for (int t = 0; t < nt; t += 2) {
            const bool last = (t == nt - 2);
            const char* a1 = cA + (size_t)(t + 1) * kstep;
            const char* a2 = last ? nA : cA + (size_t)(t + 2) * kstep; const char* b2 = last ? nB : cB + (size_t)(t + 2) * kstep;
            const char* a3 = a2 + kstep; const char* b3 = b2 + kstep;
            if (last && has_next) S.a_ready(nxt);
            if constexpr (SP2) {
            PG8_LDB(B0, 0, 0); PG8_LDB(B1, 0, 1); PG8_SCHED; PG8_LDA(At, 0, 0); PG8_STAGE(PG8_SA(1, 1), a1 + hstep, voffA);
            PG8_WAIT_V(8); PG8_WAIT_L(0); PG8_BAR; PG8_MMA(0, 0, At, B0); PG8_MMA(0, 1, At, B1); PG8_BAR; PG8_SCHED;
            PG8_LDA(At, 0, 1); PG8_STAGE(PG8_SB(0, 0), b2, voffB); PG8_STAGE(PG8_SB(0, 1), b2 + hstep, voffB); PG8_STAGE(PG8_SA(0, 0), a2, voffA);
            PG8_WAIT_V(8); PG8_WAIT_L(0); PG8_BAR; PG8_MMA(1, 0, At, B0); PG8_MMA(1, 1, At, B1); PG8_BAR; PG8_SCHED;
            PG8_LDB(B0, 1, 0); PG8_LDB(B1, 1, 1); PG8_SCHED; PG8_LDA(At, 1, 0); PG8_STAGE(PG8_SA(0, 1), a2 + hstep, voffA);
            PG8_WAIT_V(8); PG8_WAIT_L(0); PG8_BAR; PG8_MMA(0, 0, At, B0); PG8_MMA(0, 1, At, B1); PG8_BAR; PG8_SCHED;
            PG8_LDA(At, 1, 1); PG8_STAGE(PG8_SB(1, 0), b3, voffB); PG8_STAGE(PG8_SB(1, 1), b3 + hstep, voffB); PG8_STAGE(PG8_SA(1, 0), a3, voffA);
            PG8_WAIT_V(8); PG8_WAIT_L(0); PG8_BAR; PG8_MMA(1, 0, At, B0); PG8_MMA(1, 1, At, B1); PG8_BAR; PG8_SCHED;
            } else {
            PG8_LDB(B0, 0, 0); PG8_SCHED; PG8_LDA(At, 0, 0); PG8_STAGE(PG8_SA(1, 1), a1 + hstep, voffA);
            PG8_WAIT_L(8); PG8_BAR; PG8_WAIT_L(0); PG8_MMA(0, 0, At, B0); PG8_BAR; PG8_SCHED;
            PG8_LDB(B1, 0, 1); PG8_STAGE(PG8_SB(0, 0), b2, voffB);
            PG8_BAR; PG8_WAIT_L(0); PG8_MMA(0, 1, At, B1); PG8_BAR;
            PG8_LDA(At, 0, 1); PG8_STAGE(PG8_SA(0, 0), a2, voffA);
            PG8_BAR; PG8_WAIT_L(0); PG8_MMA(1, 0, At, B0); PG8_BAR; PG8_SCHED;
            PG8_STAGE(PG8_SB(0, 1), b2 + hstep, voffB);
            PG8_WAIT_V(6); PG8_BAR; PG8_MMA(1, 1, At, B1); PG8_BAR;
            PG8_LDB(B0, 1, 0); PG8_SCHED; PG8_LDA(At, 1, 0); PG8_STAGE(PG8_SA(0, 1), a2 + hstep, voffA);
            PG8_WAIT_L(8); PG8_BAR; PG8_WAIT_L(0); PG8_MMA(0, 0, At, B0); PG8_BAR; PG8_SCHED;
            PG8_LDB(B1, 1, 1); PG8_STAGE(PG8_SB(1, 0), b3, voffB);
            PG8_BAR; PG8_WAIT_L(0); PG8_MMA(0, 1, At, B1); PG8_BAR;
            PG8_LDA(At, 1, 1); PG8_STAGE(PG8_SA(1, 0), a3, voffA);
            PG8_BAR; PG8_WAIT_L(0); PG8_MMA(1, 0, At, B0); PG8_BAR; PG8_SCHED;
            PG8_STAGE(PG8_SB(1, 1), b3 + hstep, voffB);
            PG8_WAIT_V(6); PG8_BAR; PG8_MMA(1, 1, At, B1); PG8_BAR;
            }
        }
        if constexpr (ALIGN_EPI) { if (wr == 0) PG8_BAR; }
        if constexpr (!Epi::AFTER_DRAIN) { E(acc, cur, wr, wc, fr, fq); S.done(cur); }
        if (!has_next) break;
#pragma unroll
        for (int a = 0; a < 2; ++a)
#pragma unroll
            for (int b = 0; b < 2; ++b)
#pragma unroll
                for (int m = 0; m < 4; ++m)
#pragma unroll
                    for (int n = 0; n < 2; ++n) acc[a][b][m][n] = (f32x4){0.f, 0.f, 0.f, 0.f};
        cur = nxt; cA = nA; cB = nB; ++ui;
        if constexpr (ALIGN_EPI) { if (wr == 1) PG8_BAR; }
    }
    PG8_WAIT_V(0);
    if constexpr (!ALIGN_EPI) { if (wr == 0) PG8_BAR; }
    PG8_BAR;
    if constexpr (Epi::AFTER_DRAIN) { E.fused(acc, cur, wr, wc, fr, fq, lds, wid, lane); S.done(cur); }
#undef PG8_SA
#undef PG8_SB
#undef PG8_STAGE
#undef PG8_LDA
#undef PG8_LDB
#undef PG8_MMA
#undef PG8_WAIT_V
#undef PG8_WAIT_L
#undef PG8_BAR
#undef PG8_SCHED
}
}
#include <hip/hip_bf16.h>
#include <cmath>
namespace attn_body {
using bf16=__hip_bfloat16;
using bf16x8=__attribute__((ext_vector_type(8)))short;
using s16x4=__attribute__((ext_vector_type(4)))short;
using f32x16=__attribute__((ext_vector_type(16)))float;
using u32x4=__attribute__((ext_vector_type(4)))unsigned;
constexpr int BATCH=8,NHEAD=16,SEQ=2048,D=64,PQK=512,PO=1024;
constexpr int NW=8,QBLK=32,QB=QBLK*NW,KVBLK=64,NQB=SEQ/QB;
constexpr int ATTN_UNIT_ROWS=QB;
__device__ __forceinline__ int crow(int r,int hi){return (r&3)+8*(r>>2)+4*hi;}
#define SBAR() __builtin_amdgcn_sched_barrier(0)
__device__ __forceinline__ void cmask(f32x16&p0,f32x16&p1,int jb,int qrel,int hi){
  const float NEG=-INFINITY; (void)hi;
  if(jb>(qrel>>6)){
  #pragma unroll
  for(int r=0;r<16;++r){p0[r]=NEG;p1[r]=NEG;}}
}

constexpr int NSLOT=3, SLOTB=8192;
constexpr int LDS_K=0, LDS_V=NSLOT*SLOTB, LDS_WS=2*NSLOT*SLOTB, LDS_OST=LDS_WS+NW*64*4, LDS_BYTES=LDS_OST+NW*4096;
constexpr float C2=0.125f*1.4426950408889634f;
__device__ __forceinline__ void glds16(const void*gsrc,unsigned lds_dst){unsigned keep;
  asm volatile("s_mov_b32 %0, m0\n\ts_mov_b32 m0, %2\n\ts_nop 0\n\tglobal_load_lds_dwordx4 %1, off\n\ts_mov_b32 m0, %0":"=&s"(keep):"v"(gsrc),"s"(lds_dst):"memory");}
__device__ __forceinline__ float max3f(float a,float b,float c){float r;asm("v_max3_f32 %0, %1, %2, %3":"=v"(r):"v"(a),"v"(b),"v"(c));return r;}
__device__ __forceinline__ float max2f(float a,float b){float r;asm("v_max_f32_e32 %0, %1, %2":"=v"(r):"v"(a),"v"(b));return r;}
__device__ __forceinline__ float fadd_s(float a,float b){float r;asm("v_add_f32_e32 %0, %1, %2":"=v"(r):"v"(a),"v"(b));return r;}
__device__ __forceinline__ float fsub_s(float a,float b){float r;asm("v_sub_f32_e32 %0, %1, %2":"=v"(r):"v"(a),"v"(b));return r;}
typedef float f32x2_t __attribute__((ext_vector_type(2))); typedef __bf16 bf16x2_t __attribute__((ext_vector_type(2)));
__device__ __forceinline__ unsigned cvtpk_s(float lo,float hi){f32x2_t v={lo,hi};bf16x2_t b=__builtin_convertvector(v,bf16x2_t);return __builtin_bit_cast(unsigned,b);}
#define WAIT_BAR(N) asm volatile("s_waitcnt vmcnt(" #N ") lgkmcnt(0)\n\ts_barrier":::"memory")

__device__ __forceinline__ void qkt(f32x16&p0,f32x16&p1,const char*Kslot,const bf16x8*qr,const f32x16&negm,int r32,int hi){
  const char*kb=Kslot+hi*1024+r32*16;
  #pragma unroll
  for(int d0=0;d0<4;++d0){
    const bf16x8 b0=*reinterpret_cast<const bf16x8*>(kb+d0*2048);
    const bf16x8 b1=*reinterpret_cast<const bf16x8*>(kb+d0*2048+512);
    if(d0==0){p0=__builtin_amdgcn_mfma_f32_32x32x16_bf16(b0,qr[0],negm,0,0,0);p1=__builtin_amdgcn_mfma_f32_32x32x16_bf16(b1,qr[0],negm,0,0,0);}
    else{p0=__builtin_amdgcn_mfma_f32_32x32x16_bf16(b0,qr[d0],p0,0,0,0);p1=__builtin_amdgcn_mfma_f32_32x32x16_bf16(b1,qr[d0],p1,0,0,0);}}
}
typedef __attribute__((address_space(3))) const char* lds_cptr;
typedef short v4i16_t __attribute__((ext_vector_type(4)));
__device__ __forceinline__ void kload8(bf16x8*kf,lds_cptr kp){
  kf[0]=*(const __attribute__((address_space(3))) bf16x8*)(kp);      kf[1]=*(const __attribute__((address_space(3))) bf16x8*)(kp+512);
  kf[2]=*(const __attribute__((address_space(3))) bf16x8*)(kp+2048); kf[3]=*(const __attribute__((address_space(3))) bf16x8*)(kp+2560);
  kf[4]=*(const __attribute__((address_space(3))) bf16x8*)(kp+4096); kf[5]=*(const __attribute__((address_space(3))) bf16x8*)(kp+4608);
  kf[6]=*(const __attribute__((address_space(3))) bf16x8*)(kp+6144); kf[7]=*(const __attribute__((address_space(3))) bf16x8*)(kp+6656);
}
__device__ __forceinline__ void kload2(bf16x8*kf,lds_cptr kp,int j){ kf[2*j]=*(const __attribute__((address_space(3))) bf16x8*)(kp+j*2048); kf[2*j+1]=*(const __attribute__((address_space(3))) bf16x8*)(kp+j*2048+512); }
__device__ __forceinline__ s16x4 vtr(lds_cptr p){ return __builtin_bit_cast(s16x4,__builtin_amdgcn_ds_read_tr16_b64_v4i16((__attribute__((address_space(3))) v4i16_t*)p)); }
__device__ __forceinline__ float rowmax(const f32x16&p0,const f32x16&p1){
  float a=max3f(p0[0],p0[1],p1[0]),b=max3f(p0[2],p0[3],p1[1]);a=max3f(a,p1[2],p1[3]);
  #pragma unroll
  for(int r=4;r<16;r+=4){a=max3f(a,p0[r],p0[r+1]);b=max3f(b,p0[r+2],p0[r+3]);a=max3f(a,p1[r],p1[r+1]);b=max3f(b,p1[r+2],p1[r+3]);}
  const float m=max2f(a,b);
  auto rr=__builtin_amdgcn_permlane32_swap(__float_as_uint(m),__float_as_uint(m),false,false);
  return max2f(__uint_as_float(rr[0]),__uint_as_float(rr[1]));
}
__device__ __forceinline__ void pv(f32x16*o,int vb,bf16x8 pa0,bf16x8 pa1,bf16x8 pa2,bf16x8 pa3){
  #pragma unroll
  for(int d0=0;d0<2;++d0){s16x4 lo[4],hi[4];
    #pragma unroll
    for(int ks=0;ks<4;++ks){
      asm volatile("ds_read_b64_tr_b16 %0,%1 offset:%c2":"=&v"(lo[ks]):"v"(vb),"i"(d0*4096+ks*1024):"memory");
      asm volatile("ds_read_b64_tr_b16 %0,%1 offset:%c2":"=&v"(hi[ks]):"v"(vb),"i"(d0*4096+ks*1024+512):"memory");}
    asm volatile("s_waitcnt lgkmcnt(0)":::"memory");SBAR();
    #define PK(k) (bf16x8){lo[k][0],lo[k][1],lo[k][2],lo[k][3],hi[k][0],hi[k][1],hi[k][2],hi[k][3]}
    o[d0]=__builtin_amdgcn_mfma_f32_32x32x16_bf16(pa0,PK(0),o[d0],0,0,0);
    o[d0]=__builtin_amdgcn_mfma_f32_32x32x16_bf16(pa1,PK(1),o[d0],0,0,0);
    o[d0]=__builtin_amdgcn_mfma_f32_32x32x16_bf16(pa2,PK(2),o[d0],0,0,0);
    o[d0]=__builtin_amdgcn_mfma_f32_32x32x16_bf16(pa3,PK(3),o[d0],0,0,0);
    #undef PK
  }
}

#ifndef ATTN_STORE16
#define ATTN_STORE16(p,v) (*(u32x4*)(p)=(v))
#endif
template<int THRL> __device__ __forceinline__ void attn_unit(int b,int qb,const bf16*Q,const bf16*__restrict__ K,const bf16*__restrict__ V,bf16*O,char*shm){
  int tid_l=threadIdx.x; asm volatile("":"+v"(tid_l)); const int tid=tid_l,lane=tid&63,r32=lane&31,hi=lane>>5; const int wid=__builtin_amdgcn_readfirstlane(tid>>6);
  const long rowbase=(long)b*SEQ; const int q0=qb*QB;
  const bf16*Qw=Q+(rowbase+q0+wid*QBLK)*PQK;
  const bf16*Kh=K+rowbase*PQK,*Vh=V+rowbase*PQK;
  const unsigned lds0=(unsigned)(uintptr_t)shm;
  float*wsf=(float*)(shm+LDS_WS)+wid*64;
  const bf16*ksrc=Kh+(long)lane*PQK+wid*8;
  const bf16*vsrc=Vh+(long)(16*(wid&3)+(lane>>2))*PQK+(wid>>2)*32+(lane&3)*8;
  const unsigned kdst=lds0+LDS_K+wid*1024, vdst=lds0+LDS_V+wid*1024;
  #define DMA_K(t,slot) glds16(ksrc+(long)(t)*KVBLK*PQK,(unsigned)__builtin_amdgcn_readfirstlane(kdst+(slot)))
  #define DMA_V(t,slot) glds16(vsrc+(long)(t)*KVBLK*PQK,(unsigned)__builtin_amdgcn_readfirstlane(vdst+(slot)))
  const int vb0=(int)(lds0+LDS_V)+((lane>>4)&1)*32+(lane&3)*8+(4*hi+((lane&15)>>2))*64;
  const char*Kbase=shm+LDS_K; bf16x8 kf[8];
  const lds_cptr shm3=(lds_cptr)shm; const lds_cptr kp0=shm3+LDS_K+hi*1024+r32*16; const lds_cptr vp0=shm3+LDS_V+((lane>>4)&1)*32+(lane&3)*8+(4*hi+((lane&15)>>2))*64;
  const int NT=(q0+QB)/KVBLK;
  DMA_K(0,0);DMA_V(0,0);DMA_K(1,SLOTB);
  bf16x8 qr[4];
  #pragma unroll
  for(int d0=0;d0<4;++d0)qr[d0]=*reinterpret_cast<const bf16x8*>(&Qw[(long)r32*PQK+d0*16+hi*8]);
  float mhat=0.f,l_reg=0.f;f32x16 o[2];o[0]=f32x16{};o[1]=f32x16{};f32x16 negm=f32x16{};asm volatile("":"+v"(negm));
  const int qrel=wid*QBLK+r32;
  #define CMASK(P0,P1,t) do{int jb_=(t)-(NT-4); if(jb_>=0)cmask(P0,P1,jb_,qrel,hi);}while(0)
  bool resc=false;
  #define START(P0,P1) do{ const float rm=rowmax(P0,P1); resc=false; \
    { const float dl=rm; mhat=fadd_s(mhat,dl); \
      _Pragma("unroll") for(int r=0;r<16;++r){P0[r]=fsub_s(P0[r],dl);P1[r]=fsub_s(P1[r],dl);} \
      _Pragma("unroll") for(int r=0;r<16;++r)negm[r]=-mhat; asm volatile("":"+v"(negm)); } \
    _Pragma("unroll") for(int r=0;r<16;++r)P0[r]=__builtin_amdgcn_exp2f(P0[r]); }while(0)
  #define RESC() do{ if(resc){ asm volatile("s_waitcnt lgkmcnt(0)":::"memory"); \
      _Pragma("unroll") for(int d_=0;d_<2;++d_) _Pragma("unroll") for(int r=0;r<16;++r)o[d_][r]*=wsf[crow(r,hi)]; } }while(0)
  f32x16 pA0,pA1,pB0,pB1;
  int sl_prev=0,sl_cur=0,sl_next=SLOTB;
  #define ROT() do{sl_prev=sl_cur;sl_cur=sl_next;sl_next=(sl_next==(NSLOT-1)*SLOTB)?0:sl_next+SLOTB;}while(0)
  DMA_K(2,2*SLOTB);
  WAIT_BAR(3);
  qkt(pA0,pA1,Kbase,qr,negm,r32,hi);asm volatile("s_nop 15\n\ts_nop 7":"+v"(pA0),"+v"(pA1));CMASK(pA0,pA1,0);
  START(pA0,pA1);
  _Pragma("unroll") for(int r=0;r<16;++r)pA1[r]=__builtin_amdgcn_exp2f(pA1[r]);
  WAIT_BAR(0);
  DMA_K(3,0);DMA_V(1,SLOTB);
  ROT();
  kload8(kf,kp0+sl_cur);
  WAIT_BAR(2);
  s16x4 vlo[8],vhi[8]; u32x4 pw0,pw1,pw2,pw3;
  #define PKW(P,B) cvtpk_s(P[B],P[B+1])
  #define PAF(k) __builtin_bit_cast(bf16x8,pw##k)
  #define VFR(i) (bf16x8){vlo[i][0],vlo[i][1],vlo[i][2],vlo[i][3],vhi[i][0],vhi[i][1],vhi[i][2],vhi[i][3]}
  #define PIN(x) asm volatile("":"+v"(x))
  #define MX3(a,b,c) __builtin_fmaxf(__builtin_fmaxf((a),(b)),(c))
  #define GAPA(MF,A0,A1,A2,A3,W0,W1,PW) do{ MF; sacc+=A0; sacc+=A1; sacc+=A2; sacc+=A3; PIN(sacc); W0; W1; PIN(PW); SBAR(); }while(0)
  #define EX(v) __builtin_amdgcn_exp2f(v)
  #define GAPB(MF,X,B) do{ MF; X[B]=EX(X[B]); X[B+1]=EX(X[B+1]); X[B+2]=EX(X[B+2]); X[B+3]=EX(X[B+3]); PIN(X); SBAR(); }while(0)
  #define VRD(i) do{ vlo[i]=vtr(vp_+(((i)>>2)*4096+((i)&3)*1024)); vhi[i]=vtr(vp_+(((i)>>2)*4096+((i)&3)*1024+512)); }while(0)
  #define KRD(G,j) do{ if(G){ kload2(kf,kp0+sl_next,j); SBAR(); } }while(0)
  #define STEP(C0,C1,P0,P1,t,GK,GV,GL) do{ SBAR(); \
    const lds_cptr vp_=vp0+sl_prev; \
    VRD(0); SBAR(); float sacc=(P0[0]+P0[1]); \
    GAPA(C0=__builtin_amdgcn_mfma_f32_32x32x16_bf16(kf[0],qr[0],negm,0,0,0), P0[2],P0[3],P0[4],P0[5],     pw0[0]=PKW(P0,0), pw0[1]=PKW(P0,2), pw0); \
    VRD(4); SBAR(); GAPA(C1=__builtin_amdgcn_mfma_f32_32x32x16_bf16(kf[1],qr[0],negm,0,0,0), P0[6],P0[7],P0[8],P0[9],     pw0[2]=PKW(P0,4), pw0[3]=PKW(P0,6), pw0); \
    VRD(1); SBAR(); GAPA(C0=__builtin_amdgcn_mfma_f32_32x32x16_bf16(kf[2],qr[1],C0,0,0,0),   P0[10],P0[11],P0[12],P0[13], pw1[0]=PKW(P0,8), pw1[1]=PKW(P0,10), pw1); \
    VRD(5); SBAR(); GAPA(C1=__builtin_amdgcn_mfma_f32_32x32x16_bf16(kf[3],qr[1],C1,0,0,0),   P0[14],P0[15],P1[0],P1[1],   pw1[2]=PKW(P0,12),pw1[3]=PKW(P0,14), pw1); \
    VRD(2); SBAR(); GAPA(C0=__builtin_amdgcn_mfma_f32_32x32x16_bf16(kf[4],qr[2],C0,0,0,0),   P1[2],P1[3],P1[4],P1[5],     pw2[0]=PKW(P1,0), pw2[1]=PKW(P1,2), pw2); \
    VRD(6); SBAR(); GAPA(C1=__builtin_amdgcn_mfma_f32_32x32x16_bf16(kf[5],qr[2],C1,0,0,0),   P1[6],P1[7],P1[8],P1[9],     pw2[2]=PKW(P1,4), pw2[3]=PKW(P1,6), pw2); \
    VRD(3); SBAR(); GAPA(C0=__builtin_amdgcn_mfma_f32_32x32x16_bf16(kf[6],qr[3],C0,0,0,0),   P1[10],P1[11],P1[12],P1[13], pw3[0]=PKW(P1,8), pw3[1]=PKW(P1,10), pw3); \
    VRD(7); SBAR(); GAPA(C1=__builtin_amdgcn_mfma_f32_32x32x16_bf16(kf[7],qr[3],C1,0,0,0),   P1[14],P1[15],0.f,0.f,       pw3[2]=PKW(P1,12),pw3[3]=PKW(P1,14), pw3); \
    l_reg+=sacc; \
    if(GK){DMA_K((t)+3,sl_cur);} if(GV){DMA_V((t)+1,sl_next);} \
    CMASK(C0,C1,t); \
    { float a=MX3(C0[0],C0[1],C1[0]),b=MX3(C0[2],C0[3],C1[1]); a=MX3(a,C1[2],C1[3]); \
      _Pragma("unroll") for(int r=4;r<16;r+=4){a=MX3(a,C0[r],C0[r+1]);b=MX3(b,C0[r+2],C0[r+3]);a=MX3(a,C1[r],C1[r+1]);b=MX3(b,C1[r+2],C1[r+3]);} \
      float rm=__builtin_fmaxf(a,b); { auto rr=__builtin_amdgcn_permlane32_swap(__float_as_uint(rm),__float_as_uint(rm),false,false); rm=__builtin_fmaxf(__uint_as_float(rr[0]),__uint_as_float(rr[1])); } \
      resc=false; \
      if(__builtin_expect(__any(rm>(float)THRL),0)){ const float dl=__builtin_fmaxf(rm,0.f); mhat+=dl; \
        _Pragma("unroll") for(int r=0;r<16;++r){C0[r]-=dl;C1[r]-=dl;} \
        _Pragma("unroll") for(int r=0;r<16;++r)negm[r]=-mhat; asm volatile("":"+v"(negm)); \
        const float f=__builtin_amdgcn_exp2f(-dl); l_reg*=f; if(hi==0)wsf[r32]=f; resc=true; } } \
    SBAR(); \
    GAPB(o[0]=__builtin_amdgcn_mfma_f32_32x32x16_bf16(PAF(0),VFR(0),o[0],0,0,0), C0,0); \
    GAPB(o[1]=__builtin_amdgcn_mfma_f32_32x32x16_bf16(PAF(0),VFR(4),o[1],0,0,0), C0,4); \
    KRD(GL,0); GAPB(o[0]=__builtin_amdgcn_mfma_f32_32x32x16_bf16(PAF(1),VFR(1),o[0],0,0,0), C0,8); \
    KRD(GL,1); GAPB(o[1]=__builtin_amdgcn_mfma_f32_32x32x16_bf16(PAF(1),VFR(5),o[1],0,0,0), C0,12); \
    KRD(GL,2); GAPB(o[0]=__builtin_amdgcn_mfma_f32_32x32x16_bf16(PAF(2),VFR(2),o[0],0,0,0), C1,0); \
    KRD(GL,3); GAPB(o[1]=__builtin_amdgcn_mfma_f32_32x32x16_bf16(PAF(2),VFR(6),o[1],0,0,0), C1,4); \
    GAPB(o[0]=__builtin_amdgcn_mfma_f32_32x32x16_bf16(PAF(3),VFR(3),o[0],0,0,0), C1,8); \
    GAPB(o[1]=__builtin_amdgcn_mfma_f32_32x32x16_bf16(PAF(3),VFR(7),o[1],0,0,0), C1,12); \
    }while(0)
  int t=1;
  #undef CMASK
  #define CMASK(P0,P1,t) do{}while(0)
  for(;t+5<NT;t+=2){
    STEP(pB0,pB1,pA0,pA1,t,true,true,true);     WAIT_BAR(2); RESC(); ROT();
    STEP(pA0,pA1,pB0,pB1,t+1,true,true,true);   WAIT_BAR(2); RESC(); ROT();
  }
  #undef CMASK
  #define CMASK(P0,P1,t) do{int jb_=(t)-(NT-4); if(jb_>=0)cmask(P0,P1,jb_,qrel,hi);}while(0)
  #define ENDW(tt) do{ if((tt)+3<NT){WAIT_BAR(2);} else if((tt)+2<NT){WAIT_BAR(1);} else {WAIT_BAR(0);} }while(0)
  for(;t+1<NT;t+=2){
    STEP(pB0,pB1,pA0,pA1,t,(t+3<NT),(t+1<NT),(t+1<NT));       ENDW(t);   RESC(); ROT();
    STEP(pA0,pA1,pB0,pB1,t+1,(t+4<NT),(t+2<NT),(t+2<NT));     ENDW(t+1); RESC(); ROT();
  }
  STEP(pB0,pB1,pA0,pA1,NT-1,false,false,false); RESC();
  { float sacc=pB0[0]+pB0[1]; _Pragma("unroll") for(int r=2;r<16;++r)sacc+=pB0[r]; _Pragma("unroll") for(int r=0;r<16;++r)sacc+=pB1[r]; l_reg+=sacc;
    pw0=(u32x4){PKW(pB0,0),PKW(pB0,2),PKW(pB0,4),PKW(pB0,6)};pw1=(u32x4){PKW(pB0,8),PKW(pB0,10),PKW(pB0,12),PKW(pB0,14)};pw2=(u32x4){PKW(pB1,0),PKW(pB1,2),PKW(pB1,4),PKW(pB1,6)};pw3=(u32x4){PKW(pB1,8),PKW(pB1,10),PKW(pB1,12),PKW(pB1,14)};
    SBAR(); pv(o,vb0+sl_cur,PAF(0),PAF(1),PAF(2),PAF(3)); }
  #undef PKW
  #undef PAF
  #undef VFR
  #undef PIN
  #undef MX3
  #undef GAPA
  #undef GAPB
  #undef EX
  #undef VRD
  #undef KRD
  #undef STEP
  #undef ENDW
  {auto rr=__builtin_amdgcn_permlane32_swap(__float_as_uint(l_reg),__float_as_uint(l_reg),false,false);l_reg=__uint_as_float(rr[0])+__uint_as_float(rr[1]);}
  if(hi==0)wsf[32+r32]=l_reg;asm volatile("s_waitcnt lgkmcnt(0)":::"memory");
  float rli[16];
  #pragma unroll
  for(int r=0;r<16;++r)rli[r]=__builtin_amdgcn_rcpf(wsf[32+crow(r,hi)]);
  bf16*Ow=O+(rowbase+q0+wid*QBLK)*PO;
  { bf16*stg=(bf16*)(shm+LDS_OST)+wid*2048;
    #pragma unroll
    for(int r=0;r<16;++r){const int orow=crow(r,hi);
      #pragma unroll
      for(int d0=0;d0<2;++d0)stg[orow*64+d0*32+r32]=__float2bfloat16(o[d0][r]*rli[r]);}
    asm volatile("s_waitcnt lgkmcnt(0)":::"memory");
    #pragma unroll
    for(int i=0;i<4;++i){const int row=i*8+(lane>>3),ch=lane&7; const u32x4 v=*(const u32x4*)(stg+row*64+ch*8); ATTN_STORE16(Ow+(long)row*PO+ch*8,v);} }
  asm volatile("s_waitcnt lgkmcnt(0)\n\ts_barrier":::"memory");
  #undef DMA_K
  #undef DMA_V
  #undef CMASK
  #undef START
  #undef RESC
  #undef ROT
}
#undef SBAR
#undef WAIT_BAR
}
namespace cg = cooperative_groups;
#define LAS __attribute__((address_space(3)))
typedef unsigned short bf16;
typedef unsigned v4u __attribute__((ext_vector_type(4)));
typedef unsigned v2u __attribute__((ext_vector_type(2)));
typedef float f32x4 __attribute__((ext_vector_type(4)));
typedef float f32x2 __attribute__((ext_vector_type(2)));
typedef float f32x16 __attribute__((ext_vector_type(16)));
typedef short bf16x8 __attribute__((ext_vector_type(8)));

constexpr int NWAVES = 8;
constexpr int D = 1024, MP = 16384, MS = 256, M = MP + MS, FF = 2816, DIN = 2560;
constexpr float EPS = 1e-6f;
constexpr float C2 = 0.125f * 1.4426950408889634f;
constexpr size_t OFF_Y = 0, OFF_KP = 17039360, OFF_VP = 33816576, OFF_PP = 50593792, OFF_CP = 50655232, OFF_KS = 50663424, OFF_VS = 50925568, OFF_PS = 51187712, OFF_CS = 51249152, OUT_TOTAL = 51257344;
constexpr size_t MiB = 1u << 20;
constexpr size_t WS_ROPE = 1 * MiB, WS_POOLWT = 2 * MiB, WS_W = 4 * MiB, WL = 40 * MiB;
constexpr size_t W_GU1 = 0, W_D1 = 11 * MiB, W_IN = 16 * MiB + MiB / 2, W_OUT = 21 * MiB + MiB / 2, W_GU2 = 23 * MiB + MiB / 2, W_D2 = 34 * MiB + MiB / 2;
constexpr size_t WS_X = 84 * MiB, WS_H = 149 * MiB, WS_MIX = 182 * MiB, WS_ACT = 215 * MiB;
constexpr size_t WS_QB = 215 * MiB, WS_KB = 232 * MiB, WS_VB = 249 * MiB, WS_ZB = 266 * MiB;
constexpr size_t WS_OB = 305 * MiB, WS_OPART = 338 * MiB, WS_ML = 347 * MiB, WS_END = 352 * MiB;
static_assert(WS_ROPE == pg8::WOFF_ROPE && WS_QB == pg8::WOFF_QB && WS_KB == pg8::WOFF_KB && WS_VB == pg8::WOFF_VB && WS_ZB == pg8::WOFF_ZB && OFF_KP == pg8::OOFF_KP && OFF_VP == pg8::OOFF_VP && OFF_PP == pg8::OOFF_PP && OFF_KS == pg8::OOFF_KS && OFF_VS == pg8::OOFF_VS && OFF_PS == pg8::OOFF_PS, "offsets");
static_assert(WS_ACT + (size_t)M * FF * 2 <= WS_OB && WS_ZB + (size_t)M * 1024 * 2 <= WS_OB && WS_X + (size_t)M * D * 4 <= WS_H && WS_H + (size_t)M * D * 2 <= WS_MIX && WS_MIX + (size_t)M * D * 2 <= WS_ACT, "ws map");
static_assert(WS_OB + (size_t)M * 1024 * 2 <= WS_OPART && WS_OPART + (size_t)32 * 2 * 9 * 32 * 128 * 4 <= WS_ML && WS_ML + (size_t)32 * 2 * 9 * 32 * 2 * 4 <= WS_END, "ws map 2");
constexpr int LDS_BYTES = 147456;
constexpr size_t CTL_BYTES = 262144, CTL_CNT = 65536;
constexpr size_t WS_SLOTP = 350 * MiB, WS_SLOTS = 351 * MiB;

__device__ __forceinline__ unsigned pk2(float lo, float hi) { f32x2 v = {lo, hi}; typedef __bf16 b2 __attribute__((ext_vector_type(2))); b2 b = __builtin_convertvector(v, b2); return __builtin_bit_cast(unsigned, b); }
__device__ __forceinline__ float bf2f(unsigned short b) { return __builtin_bit_cast(float, (unsigned)b << 16); }
__device__ __forceinline__ bf16x8 pack8(f32x4 a, f32x4 b) { v4u w; w.x = pk2(a.x, a.y); w.y = pk2(a.z, a.w); w.z = pk2(b.x, b.y); w.w = pk2(b.z, b.w); return __builtin_bit_cast(bf16x8, w); }
__device__ __forceinline__ int crow(int r, int hi) { return (r & 3) + 8 * (r >> 2) + 4 * hi; }
__device__ __forceinline__ void xhalf_pair(float m, float& a, float& b) { a = m; b = m; asm volatile("s_nop 1\n\tv_permlane32_swap_b32 %0, %1\n\ts_nop 1" : "+v"(a), "+v"(b)); }
__device__ __forceinline__ float xhalf_max(float m) { float a, b; xhalf_pair(m, a, b); return fmaxf(a, b); }
__device__ __forceinline__ float xhalf_sum(float m) { float a, b; xhalf_pair(m, a, b); return a + b; }
template <int O> __device__ __forceinline__ float swz_xor(float v) { return __builtin_bit_cast(float, __builtin_amdgcn_ds_swizzle(__builtin_bit_cast(int, v), (O << 10) | 0x1f)); }
__device__ __forceinline__ float wave_sum(float v) {
    v += swz_xor<1>(v); v += swz_xor<2>(v); v += swz_xor<4>(v); v += swz_xor<8>(v); v += swz_xor<16>(v);
    return xhalf_sum(v);
}
#define LDS_WAIT() asm volatile("s_waitcnt lgkmcnt(0)" ::: "memory")

struct Params { const float* in[26]; float* out; unsigned char* ws; };
typedef const __attribute__((address_space(4))) unsigned char* karg_ptr;
__device__ __forceinline__ karg_ptr kargs() { karg_ptr k = (karg_ptr)__builtin_amdgcn_kernarg_segment_ptr(); asm volatile("" : "+s"(k)); return k; }
__device__ __forceinline__ const float* KIN(int i) { return *(const float* const __attribute__((address_space(4)))*)(kargs() + 8 * i); }
__device__ __forceinline__ float* KOUT() { return *(float* const __attribute__((address_space(4)))*)(kargs() + 8 * 26); }
__device__ __forceinline__ unsigned char* KWS() { return *(unsigned char* const __attribute__((address_space(4)))*)(kargs() + 8 * 27); }

template <int MODE> __device__ __forceinline__ int wmap(int nl, int row_off) {
    if (MODE == 0) return row_off + nl;
    if (MODE == 1) return (nl >> 7) * 256 + (nl & 127) + row_off;
    const int u = nl >> 8, lc = nl & 255, A = lc >> 6, n = (lc >> 5) & 1, B = (lc >> 4) & 1, f = lc & 15;
    return u * 256 + 128 * (A >> 1) + 32 * (2 * (A & 1) + B) + 16 * n + f;
}
template <int MODE> __device__ __forceinline__ void transpose_item(const float* W, int K, int N, bf16* WT, int row_off, LAS float* scr, int item, int lane) {
    const int nblk = N / 32, kb = item / nblk, nb = item % nblk, k0 = 64 * kb, n0 = 32 * nb;
#pragma unroll 8
    for (int i = 0; i < 32; ++i) { const int kk = 2 * i + (lane >> 5); scr[kk * 33 + (lane & 31)] = W[(size_t)(k0 + kk) * N + n0 + (lane & 31)]; }
    LDS_WAIT(); asm volatile("" ::: "memory");
    const int c = lane & 7;
#pragma unroll
    for (int j = 0; j < 4; ++j) { const int n = (lane >> 3) + 8 * j; const LAS float* s = scr + (8 * c) * 33 + n;
        v4u o; o.x = pk2(s[0 * 33], s[1 * 33]); o.y = pk2(s[2 * 33], s[3 * 33]); o.z = pk2(s[4 * 33], s[5 * 33]); o.w = pk2(s[6 * 33], s[7 * 33]);
        *(v4u*)(WT + (size_t)wmap<MODE>(n0 + n, row_off) * K + k0 + 8 * c) = o; }
    LDS_WAIT(); asm volatile("" ::: "memory");
}
__device__ __forceinline__ void prologue(LAS unsigned char* lds, int gw, int NGW, int wave, int lane) {
    LAS float* scr = (LAS float*)(lds + wave * 16384);
    constexpr int I_F = 16 * 88, I_IN = 16 * 80, I_OUT = 16 * 32, I_L = 6 * I_F + I_IN + I_OUT;
    for (int it = gw; it < 2 * I_L; it += NGW) {
        const int l = it / I_L; int r = it % I_L;
        unsigned char* wl = KWS() + WS_W + (size_t)l * WL;
        if (r < I_F) { transpose_item<1>(KIN(7) + (size_t)l * D * FF, D, FF, (bf16*)(wl + W_GU1), 0, scr, r, lane); continue; } r -= I_F;
        if (r < I_F) { transpose_item<1>(KIN(8) + (size_t)l * D * FF, D, FF, (bf16*)(wl + W_GU1), 128, scr, r, lane); continue; } r -= I_F;
        if (r < I_F) { transpose_item<0>(KIN(9) + (size_t)l * D * FF, FF, D, (bf16*)(wl + W_D1), 0, scr, r, lane); continue; } r -= I_F;
        if (r < I_IN) { transpose_item<2>(KIN(11) + (size_t)l * D * DIN, D, DIN, (bf16*)(wl + W_IN), 0, scr, r, lane); continue; } r -= I_IN;
        if (r < I_OUT) { transpose_item<0>(KIN(20) + (size_t)l * D * D, D, D, (bf16*)(wl + W_OUT), 0, scr, r, lane); continue; } r -= I_OUT;
        if (r < I_F) { transpose_item<1>(KIN(22) + (size_t)l * D * FF, D, FF, (bf16*)(wl + W_GU2), 0, scr, r, lane); continue; } r -= I_F;
        if (r < I_F) { transpose_item<1>(KIN(23) + (size_t)l * D * FF, D, FF, (bf16*)(wl + W_GU2), 128, scr, r, lane); continue; } r -= I_F;
        transpose_item<0>(KIN(24) + (size_t)l * D * FF, FF, D, (bf16*)(wl + W_D2), 0, scr, r, lane);
    }
    float* rope = (float*)(KWS() + WS_ROPE);
    for (int i = gw * 64 + lane; i < 2080 * 32; i += NGW * 64) {
        const int pr = i >> 5, d = i & 31; const int pos = pr < 2048 ? pr : 4096 + (pr - 2048);
        const float inv = exp2f(-(float)d * (13.287712379549449f / 32.0f));
        const float ang = (float)pos * inv;
        const double rev = (double)ang * 0.15915494309189535; const float fr = (float)(rev - __builtin_rint(rev));
        rope[pr * 64 + d] = __builtin_amdgcn_cosf(fr); rope[pr * 64 + 32 + d] = __builtin_amdgcn_sinf(fr);
    }
    bf16* pwt_ = (bf16*)(KWS() + WS_POOLWT);
    for (int i = gw * 64 + lane; i < 2 * 4 * 64 * 64; i += NGW * 64) {
        const int c = i & 63, e = (i >> 6) & 63, lg = i >> 12;
        pwt_[i] = (bf16)(pk2(KIN(17)[(size_t)lg * 4096 + c * 64 + e], 0.f) & 0xffffu);
    }
}
template <bool FINAL> __device__ __forceinline__ void norm_rows(const float* srcP, const float* srcS, const float* g, bf16* H, float* outf, int gw, int NGW, int lane) {
    const f32x4* g4 = (const f32x4*)g + lane;
    f32x4 gv[4];
#pragma unroll
    for (int j = 0; j < 4; ++j) gv[j] = g4[64 * j];
    for (int m = gw; m < M; m += NGW) {
        const float* xr = (m < MP) ? srcP + (size_t)m * D : srcS + (size_t)(m - MP) * D;
        const f32x4* x4 = (const f32x4*)xr + lane;
        f32x4 v[4]; float s = 0.f;
#pragma unroll
        for (int j = 0; j < 4; ++j) { v[j] = x4[64 * j]; s += (v[j].x * v[j].x + v[j].y * v[j].y) + (v[j].z * v[j].z + v[j].w * v[j].w); }
        const float rstd = 1.0f / sqrtf(wave_sum(s) * (1.0f / D) + EPS);
        if (FINAL) {
            f32x4* o4 = (f32x4*)(outf + (size_t)m * D) + lane;
#pragma unroll
            for (int j = 0; j < 4; ++j) o4[64 * j] = v[j] * rstd * gv[j];
        } else {
            v2u* o2 = (v2u*)(H + (size_t)m * D) + lane;
#pragma unroll
            for (int j = 0; j < 4; ++j) { const f32x4 y = v[j] * rstd * gv[j]; v2u w; w.x = pk2(y.x, y.y); w.y = pk2(y.z, y.w); o2[64 * j] = w; }
        }
    }
}
__device__ __forceinline__ f32x16 mfma32(bf16x8 a, bf16x8 b, f32x16 c) { return __builtin_amdgcn_mfma_f32_32x32x16_bf16(a, b, c, 0, 0, 0); }


template <bool BASE16> __device__ __forceinline__ void skinny_gemm(LAS unsigned char* lds, const bf16* A, const bf16* Bt, int K, const void* base, bf16* out, float scale, bf16* hb, float* yout, const float* gain,
                                            unsigned* slots, unsigned* cnt8, int vcu, int G, int tid) {
    const int lane = tid & 63, r32 = lane & 31, hi = lane >> 5, wid = __builtin_amdgcn_readfirstlane(tid >> 6);
    LAS float* R = (LAS float*)lds;
    __syncthreads();
    for (int tile = vcu; tile < 256; tile += G) {
        const int rt = tile >> 5, ct = tile & 31, kw = K >> 3, k0 = wid * kw;
        const bf16* ap = A + (size_t)(rt * 32 + r32) * K + k0 + hi * 8; const bf16* bp = Bt + (size_t)(ct * 32 + r32) * K + k0 + hi * 8;
        f32x16 acc;
#pragma unroll
        for (int r = 0; r < 16; ++r) acc[r] = 0.f;
#pragma unroll 4
        for (int ks = 0; ks < kw; ks += 16) { const bf16x8 a = *(const bf16x8*)(ap + ks), b = *(const bf16x8*)(bp + ks); acc = mfma32(a, b, acc); }
#pragma unroll
        for (int r = 0; r < 16; ++r) R[(wid * 32 + crow(r, hi)) * 32 + r32] = acc[r];
        __syncthreads();
        const int e = tid * 2, row = e >> 5, col = e & 31; f32x2 s = {0.f, 0.f};
#pragma unroll
        for (int w = 0; w < 8; ++w) s += *(const LAS f32x2*)(R + (w * 32 + row) * 32 + col);
        const size_t o = (size_t)(rt * 32 + row) * 1024 + ct * 32 + col; f32x2 bv; if (BASE16) { const unsigned bw = *(const unsigned*)((const bf16*)base + o); bv.x = bf2f(bw & 0xffff); bv.y = bf2f(bw >> 16); } else bv = *(const f32x2*)((const float*)base + o);
        const f32x2 v = bv + s * scale;
        if (out) *(unsigned*)(out + o) = pk2(v.x, v.y);
        float ss = v.x * v.x + v.y * v.y; ss += swz_xor<1>(ss); ss += swz_xor<2>(ss); ss += swz_xor<4>(ss); ss += swz_xor<8>(ss);
        if ((tid & 15) == 0) __hip_atomic_store(slots + (size_t)(rt * 32 + row) * 32 + ct, __builtin_bit_cast(unsigned, ss), __ATOMIC_RELAXED, __HIP_MEMORY_SCOPE_AGENT);
        asm volatile("s_waitcnt vmcnt(0)" ::: "memory");
        __syncthreads();
        if (tid == 0) {
            __hip_atomic_fetch_add(cnt8 + 64 * rt, 1u, __ATOMIC_RELAXED, __HIP_MEMORY_SCOPE_AGENT);
            unsigned spins = 0;
            while (__hip_atomic_load(cnt8 + 64 * rt, __ATOMIC_RELAXED, __HIP_MEMORY_SCOPE_AGENT) < 32u) { __builtin_amdgcn_s_sleep(2); if (++spins > (1u << 22)) break; }
            __builtin_amdgcn_fence(__ATOMIC_ACQUIRE, "agent");
            asm volatile("s_waitcnt vmcnt(0)" ::: "memory");
        }
        __syncthreads();
        { const unsigned* sl = slots + (size_t)(rt * 32 + row) * 32 + (tid & 15) * 2;
          float tot = __builtin_bit_cast(float, __hip_atomic_load(sl, __ATOMIC_RELAXED, __HIP_MEMORY_SCOPE_AGENT)) + __builtin_bit_cast(float, __hip_atomic_load(sl + 1, __ATOMIC_RELAXED, __HIP_MEMORY_SCOPE_AGENT));
          tot += swz_xor<1>(tot); tot += swz_xor<2>(tot); tot += swz_xor<4>(tot); tot += swz_xor<8>(tot);
          const float r = 1.0f / sqrtf(tot * (1.0f / 1024.0f) + EPS);
          const f32x2 gv = *(const f32x2*)(gain + ct * 32 + col); const f32x2 y = v * r * gv;
          if (hb) *(unsigned*)(hb + o) = pk2(y.x, y.y); else *(f32x2*)(yout + o) = y; }
        __syncthreads();
    }
}

__device__ __forceinline__ void sample_piece(LAS unsigned char* lds, int pc, int l, const bf16* Qb, const float* cache_k, const float* cache_v, const float* knew, const float* vnew, float* OPART, float* MLP, int tid) {
    const int lane = tid & 63, r32 = lane & 31, hi = lane >> 5, wid = __builtin_amdgcn_readfirstlane(tid >> 6);
    const int b = pc >> 5, h = (pc >> 3) & 3, s = pc & 7;
    const bf16* qrow = Qb + (size_t)(MP + b * 32 + r32) * 512 + h * 128 + hi * 8;
    LAS float* ML = (LAS float*)lds;
    LAS float* FAC = (LAS float*)(lds + 4096);
    LAS float* OX = (LAS float*)(lds + 8192);
    const int nrounds = (s == 7) ? 2 : 1;
    for (int rd = 0; rd < nrounds; ++rd) {
        const float *Kt, *Vt; int nvalid;
        if (rd == 0) { const size_t off = ((size_t)((l * 8 + b) * 4096 + (s * 8 + wid) * 64)) * 512 + h * 128; Kt = cache_k + off; Vt = cache_v + off; nvalid = 64; }
        else { const size_t off = ((size_t)(l * 8 + b) * 32) * 512 + h * 128; Kt = knew + off; Vt = vnew + off; nvalid = (wid == 0) ? 32 : 0; }
        float mrow[2], lrow[2]; bf16x8 pw[2][4];
#pragma unroll
        for (int c = 0; c < 2; ++c) { mrow[c] = -1e30f; lrow[c] = 0.f;
#pragma unroll
            for (int k = 0; k < 4; ++k) pw[c][k] = (bf16x8){0, 0, 0, 0, 0, 0, 0, 0}; }
        if (nvalid > 0) {
#pragma unroll
            for (int c = 0; c < 2; ++c) {
                bf16x8 qf[4];
#pragma unroll
                for (int d0 = 0; d0 < 4; ++d0) qf[d0] = *(const bf16x8*)(qrow + c * 64 + d0 * 16);
                f32x16 sc[2];
#pragma unroll
                for (int kvb = 0; kvb < 2; ++kvb) {
                    if (kvb * 32 < nvalid) {
                        f32x16 a;
#pragma unroll
                        for (int r = 0; r < 16; ++r) a[r] = 0.f;
                        const float* kp = Kt + (size_t)(kvb * 32 + r32) * 512 + c * 64 + hi * 8;
#pragma unroll
                        for (int d0 = 0; d0 < 4; ++d0) { const f32x4 x0 = *(const f32x4*)(kp + d0 * 16), x1 = *(const f32x4*)(kp + d0 * 16 + 4); a = mfma32(pack8(x0, x1), qf[d0], a); }
                        sc[kvb] = a;
                    } else {
#pragma unroll
                        for (int r = 0; r < 16; ++r) sc[kvb][r] = -1e30f;
                    }
                }
                float mx = -1e30f;
#pragma unroll
                for (int r = 0; r < 16; ++r) mx = fmaxf(mx, fmaxf(sc[0][r], sc[1][r]));
                mx = xhalf_max(mx);
                float sum = 0.f;
#pragma unroll
                for (int kvb = 0; kvb < 2; ++kvb)
#pragma unroll
                    for (int r = 0; r < 16; ++r) { const float pv = __builtin_amdgcn_exp2f(sc[kvb][r] - mx); sc[kvb][r] = pv; sum += pv; }
                sum = xhalf_sum(sum);
                mrow[c] = mx; lrow[c] = sum;
#pragma unroll
                for (int kvb = 0; kvb < 2; ++kvb)
#pragma unroll
                    for (int hf = 0; hf < 2; ++hf) { v4u w; w.x = pk2(sc[kvb][8 * hf + 0], sc[kvb][8 * hf + 1]); w.y = pk2(sc[kvb][8 * hf + 2], sc[kvb][8 * hf + 3]);
                        w.z = pk2(sc[kvb][8 * hf + 4], sc[kvb][8 * hf + 5]); w.w = pk2(sc[kvb][8 * hf + 6], sc[kvb][8 * hf + 7]); pw[c][2 * kvb + hf] = __builtin_bit_cast(bf16x8, w); }
            }
        }
        asm volatile("" ::: "memory");
        f32x16 o[2][4];
#pragma unroll
        for (int c = 0; c < 2; ++c)
#pragma unroll
            for (int eb = 0; eb < 4; ++eb)
#pragma unroll
                for (int r = 0; r < 16; ++r) o[c][eb][r] = 0.f;
        if (nvalid > 0) {
#pragma unroll
            for (int ks = 0; ks < 4; ++ks) {
                if (ks * 16 < nvalid) {
#pragma unroll
                    for (int eb = 0; eb < 4; ++eb) {
                        const float* vp = Vt + (size_t)(ks * 16 + 4 * hi) * 512 + eb * 32 + r32;
                        f32x4 x0, x1;
                        x0.x = vp[0 * 512]; x0.y = vp[1 * 512]; x0.z = vp[2 * 512]; x0.w = vp[3 * 512];
                        x1.x = vp[8 * 512]; x1.y = vp[9 * 512]; x1.z = vp[10 * 512]; x1.w = vp[11 * 512];
                        const bf16x8 vf = pack8(x0, x1);
                        o[0][eb] = mfma32(pw[0][ks], vf, o[0][eb]); o[1][eb] = mfma32(pw[1][ks], vf, o[1][eb]);
                    }
                }
            }
        }
        if (hi == 0) {
#pragma unroll
            for (int c = 0; c < 2; ++c) { ML[((wid * 2 + c) * 32 + r32) * 2 + 0] = mrow[c]; ML[((wid * 2 + c) * 32 + r32) * 2 + 1] = lrow[c]; }
        }
        __syncthreads();
        const int pidx = (rd == 0) ? s : 8;
        if (tid < 64) {
            const int c = tid >> 5, q = tid & 31; float mw[8], lw[8]; float Mx = -1e30f;
#pragma unroll
            for (int w = 0; w < 8; ++w) { mw[w] = ML[((w * 2 + c) * 32 + q) * 2 + 0]; lw[w] = ML[((w * 2 + c) * 32 + q) * 2 + 1]; Mx = fmaxf(Mx, mw[w]); }
            float L = 0.f;
#pragma unroll
            for (int w = 0; w < 8; ++w) { const float f = __builtin_amdgcn_exp2f(mw[w] - Mx); FAC[(w * 2 + c) * 32 + q] = f; L += lw[w] * f; }
            float* mp = MLP + ((size_t)((((b * 4 + h) * 2 + c) * 9 + pidx) * 32 + q)) * 2; mp[0] = Mx; mp[1] = L;
        }
        __syncthreads();
#pragma unroll
        for (int c = 0; c < 2; ++c) {
#pragma unroll
            for (int eb = 0; eb < 4; ++eb)
#pragma unroll
                for (int r = 0; r < 16; ++r) { const int q = crow(r, hi); OX[(wid * 32 + q) * 128 + eb * 32 + r32] = o[c][eb][r] * FAC[(wid * 2 + c) * 32 + q]; }
            __syncthreads();
            { const int idx = tid * 8, q = idx >> 7, e = idx & 127; f32x4 s0 = {0.f, 0.f, 0.f, 0.f}, s1 = {0.f, 0.f, 0.f, 0.f};
#pragma unroll
              for (int w = 0; w < 8; ++w) { s0 += *(const LAS f32x4*)(OX + (w * 32 + q) * 128 + e); s1 += *(const LAS f32x4*)(OX + (w * 32 + q) * 128 + e + 4); }
              float* dst = OPART + ((size_t)((((b * 4 + h) * 2 + c) * 9 + pidx) * 32 + q)) * 128 + e; *(f32x4*)dst = s0; *(f32x4*)(dst + 4) = s1; }
            __syncthreads();
        }
    }
}

__device__ __forceinline__ f32x4 bf4_to_f32(v2u w) { f32x4 v; v.x = bf2f(w.x & 0xffff); v.y = bf2f(w.x >> 16); v.z = bf2f(w.y & 0xffff); v.w = bf2f(w.y >> 16); return v; }
__device__ __forceinline__ void poolconv_tile(LAS unsigned char* lds, int tl, int l, const bf16* Zb, bf16* MIX, const float* state_pool, const float* state_conv, const bf16* pwt, const float* pool_scale,
                                              const float* conv_w, float* out_cp, float* out_cs, int tid) {
    const int lane = tid & 63, r32 = lane & 31, hi = lane >> 5, wid = __builtin_amdgcn_readfirstlane(tid >> 6);
    int b, t0, TT, rowbase; bool smp;
    if (tl < 256) { b = tl >> 5; t0 = (tl & 31) * 64; TT = 64; rowbase = b * 2048 + t0; smp = false; }
    else { b = tl - 256; t0 = 0; TT = 32; rowbase = MP + b * 32; smp = true; }
    LAS float* U = (LAS float*)lds;
    LAS bf16* Dd = (LAS bf16*)(lds + 81920);
    {
        f32x4 uv[10];
#pragma unroll
        for (int k = 0; k < 10; ++k) {
            const int idx = tid + 512 * k, i = idx >> 6, c4 = (idx & 63) * 4; f32x4 v = {0.f, 0.f, 0.f, 0.f};
            if (i < 15 + TT) {
                if (i < 15 && smp) v = *(const f32x4*)(state_pool + (size_t)((l * 8 + b) * 15 + i) * 256 + c4);
                else if (i >= 15 || t0 - 15 + i >= 0) v = bf4_to_f32(*(const v2u*)(Zb + (size_t)(rowbase + i - 15) * 1024 + c4));
            }
            uv[k] = v;
        }
#pragma unroll
        for (int k = 0; k < 10; ++k) { const int idx = tid + 512 * k, i = idx >> 6, c4 = (idx & 63) * 4; if (i < 15 + TT) *(LAS f32x4*)(U + i * 256 + c4) = uv[k]; }
    }
    __syncthreads();
    {
        const int ch = tid & 255, th = tid >> 8, gi = ch >> 6, w = 2 << gi;
        if (th * 32 < TT) {
            for (int tt = th * 32; tt < th * 32 + 32; ++tt) {
                float s = 0.f;
                for (int i = 0; i < w; ++i) s += U[(15 + tt - i) * 256 + ch];
                const int pos = smp ? 4096 + tt : t0 + tt; const int cnt = (pos + 1 < w) ? pos + 1 : w;
                const float d = s / (float)cnt - U[(15 + tt) * 256 + ch];
                Dd[tt * 264 + ch] = (bf16)(pk2(d, 0.f) & 0xffffu);
            }
        }
    }
    __syncthreads();
    {
        const int gi = wid >> 1, th = wid & 1;
        if (th * 32 < TT) {
            f32x16 acc0, acc1;
#pragma unroll
            for (int r = 0; r < 16; ++r) { acc0[r] = 0.f; acc1[r] = 0.f; }
#pragma unroll
            for (int ks = 0; ks < 4; ++ks) {
                const bf16x8 a = *(const LAS bf16x8*)(Dd + (th * 32 + r32) * 264 + gi * 64 + ks * 16 + hi * 8);
                const bf16x8 b0 = *(const bf16x8*)(pwt + (size_t)((l * 4 + gi) * 64 + r32) * 64 + ks * 16 + hi * 8);
                const bf16x8 b1 = *(const bf16x8*)(pwt + (size_t)((l * 4 + gi) * 64 + 32 + r32) * 64 + ks * 16 + hi * 8);
                acc0 = mfma32(a, b0, acc0); acc1 = mfma32(a, b1, acc1);
            }
            const float sc0 = pool_scale[l * 256 + gi * 64 + r32], sc1 = pool_scale[l * 256 + gi * 64 + 32 + r32];
#pragma unroll
            for (int r = 0; r < 16; ++r) { const int tok = th * 32 + crow(r, hi); bf16* mp = MIX + (size_t)(rowbase + tok) * 1024 + 512 + gi * 64 + r32;
                mp[0] = (bf16)(pk2(acc0[r] * sc0, 0.f) & 0xffffu); mp[32] = (bf16)(pk2(acc1[r] * sc1, 0.f) & 0xffffu); }
        }
    }
    if (wid * 8 < TT) {
        const int cq = lane, tc = wid * 8;
        v2u hraw[10], graw[10], braw[8]; f32x4 hst[2];
        hst[0] = (f32x4){0.f, 0.f, 0.f, 0.f}; hst[1] = hst[0];
#pragma unroll
        for (int i = 0; i < 10; ++i) {
            const int ts = tc - 2 + i; hraw[i] = (v2u){0u, 0u}; graw[i] = (v2u){0u, 0u};
            if (ts >= 0 || (!smp && t0 + ts >= 0)) { const bf16* zr = Zb + (size_t)(rowbase + ts) * 1024 + 4 * cq; hraw[i] = *(const v2u*)(zr + 256); graw[i] = *(const v2u*)(zr + 768); }
        }
#pragma unroll
        for (int i = 0; i < 8; ++i) braw[i] = *(const v2u*)(Zb + (size_t)(rowbase + tc + i) * 1024 + 512 + 4 * cq);
        if (smp && tc == 0) { hst[0] = *(const f32x4*)(state_conv + (size_t)((l * 8 + b) * 2 + 0) * 256 + 4 * cq); hst[1] = *(const f32x4*)(state_conv + (size_t)((l * 8 + b) * 2 + 1) * 256 + 4 * cq); }
        const f32x4 cw0 = *(const f32x4*)(conv_w + l * 768 + 4 * cq), cw1 = *(const f32x4*)(conv_w + l * 768 + 256 + 4 * cq), cw2 = *(const f32x4*)(conv_w + l * 768 + 512 + 4 * cq);
        f32x4 cm2 = bf4_to_f32(graw[0]) * bf4_to_f32(hraw[0]), cm1 = bf4_to_f32(graw[1]) * bf4_to_f32(hraw[1]);
        if (smp && tc == 0) { cm2 = hst[0]; cm1 = hst[1]; }
#pragma unroll
        for (int i = 0; i < 8; ++i) {
            const int tt = tc + i;
            const f32x4 cv = bf4_to_f32(graw[i + 2]) * bf4_to_f32(hraw[i + 2]);
            const f32x4 y = bf4_to_f32(braw[i]) * (cw0 * cm2 + cw1 * cm1 + cw2 * cv);
            v2u w; w.x = pk2(y.x, y.y); w.y = pk2(y.z, y.w);
            *(v2u*)(MIX + (size_t)(rowbase + tt) * 1024 + 768 + 4 * cq) = w;
            if (smp) { if (tt >= 30) *(f32x4*)(out_cs + (size_t)((l * 8 + b) * 2 + tt - 30) * 256 + 4 * cq) = cv; }
            else if (t0 + tt >= 2046) *(f32x4*)(out_cp + (size_t)((l * 8 + b) * 2 + t0 + tt - 2046) * 256 + 4 * cq) = cv;
            cm2 = cm1; cm1 = cv;
        }
    }
    __syncthreads();
}

__device__ __forceinline__ void combine_phase(int l, const bf16* Ob_, const float* OPART_, const float* MLP_, bf16* MIX_, int gw, int NGW, int lane) {
    const float lam_init = (l == 0) ? 0.2f : 0.35550934f;
    float lam;
    { const float a = KIN(12)[l * 64 + lane] * KIN(13)[l * 64 + lane], c = KIN(14)[l * 64 + lane] * KIN(15)[l * 64 + lane];
      lam = __expf(wave_sum(a)) - __expf(wave_sum(c)) + lam_init; }
    const float g0 = KIN(16)[l * 128 + 2 * lane], g1 = KIN(16)[l * 128 + 2 * lane + 1];
    for (int base = gw * 8; base < MP * 4; base += NGW * 8) {
        float a0[8], a1[8];
        {
            unsigned w1[8], w2[8];
#pragma unroll
            for (int j = 0; j < 8; ++j) { const int wt = base + j, row = wt >> 2, h = wt & 3;
                w1[j] = *(const unsigned*)(Ob_ + (size_t)row * 1024 + h * 128 + 2 * lane); w2[j] = *(const unsigned*)(Ob_ + (size_t)row * 1024 + 512 + h * 128 + 2 * lane); }
#pragma unroll
            for (int j = 0; j < 8; ++j) { a0[j] = bf2f(w1[j] & 0xffff) - lam * bf2f(w2[j] & 0xffff); a1[j] = bf2f(w1[j] >> 16) - lam * bf2f(w2[j] >> 16); }
        }
        float ss[8];
#pragma unroll
        for (int j = 0; j < 8; ++j) ss[j] = a0[j] * a0[j] + a1[j] * a1[j];
#pragma unroll
        for (int j = 0; j < 8; ++j) ss[j] += swz_xor<1>(ss[j]);
#pragma unroll
        for (int j = 0; j < 8; ++j) ss[j] += swz_xor<2>(ss[j]);
#pragma unroll
        for (int j = 0; j < 8; ++j) ss[j] += swz_xor<4>(ss[j]);
#pragma unroll
        for (int j = 0; j < 8; ++j) ss[j] += swz_xor<8>(ss[j]);
#pragma unroll
        for (int j = 0; j < 8; ++j) ss[j] += swz_xor<16>(ss[j]);
#pragma unroll
        for (int j = 0; j < 8; ++j) { const int wt = base + j, row = wt >> 2, h = wt & 3;
            const float tot = xhalf_sum(ss[j]);
            const float r = (1.0f / sqrtf(tot * (1.0f / 128.0f) + EPS)) * (1.0f - lam_init);
            *(unsigned*)(MIX_ + (size_t)row * 1024 + h * 128 + 2 * lane) = pk2(a0[j] * r * g0, a1[j] * r * g1); }
    }
    for (int wt = MP * 4 + gw; wt < M * 4; wt += NGW) {
        const int row = wt >> 2, h = wt & 3, rs = row - MP, b = rs >> 5, q = rs & 31; float oc[2][2];
#pragma unroll
        for (int c = 0; c < 2; ++c) {
            const size_t pb = (size_t)(((b * 4 + h) * 2 + c) * 9);
            float mw[9], lw[9]; f32x2 ov[9]; float Mx = -1e30f;
#pragma unroll
            for (int pi = 0; pi < 9; ++pi) { const f32x2 ml = *(const f32x2*)(MLP_ + ((pb + pi) * 32 + q) * 2); mw[pi] = ml.x; lw[pi] = ml.y; ov[pi] = *(const f32x2*)(OPART_ + ((pb + pi) * 32 + q) * 128 + 2 * lane); }
#pragma unroll
            for (int pi = 0; pi < 9; ++pi) Mx = fmaxf(Mx, mw[pi]);
            float L = 0.f, s0 = 0.f, s1 = 0.f;
#pragma unroll
            for (int pi = 0; pi < 9; ++pi) { const float fz = __builtin_amdgcn_exp2f(mw[pi] - Mx); L += lw[pi] * fz; s0 += ov[pi].x * fz; s1 += ov[pi].y * fz; }
            const float il = 1.0f / L; oc[c][0] = s0 * il; oc[c][1] = s1 * il;
        }
        const float a0 = oc[0][0] - lam * oc[1][0], a1 = oc[0][1] - lam * oc[1][1];
        const float tot = wave_sum(a0 * a0 + a1 * a1);
        const float r = (1.0f / sqrtf(tot * (1.0f / 128.0f) + EPS)) * (1.0f - lam_init);
        *(unsigned*)(MIX_ + (size_t)row * 1024 + h * 128 + 2 * lane) = pk2(a0 * r * g0, a1 * r * g1);
    }
}

#ifndef PROBE_SLOW_ATTN
#define PROBE_SLOW_ATTN 0
#endif
#if PROBE_SLOW_ATTN
__device__ __forceinline__ void slow_attn_phase(int l, const bf16* Qb_, float* outp, const float* cache_k, const float* cache_v, bf16* MIX_, int gw, int NGW, int lane) {
    const float lam_init = (l == 0) ? 0.2f : 0.35550934f;
    float lam;
    { const float a = KIN(12)[l * 64 + lane] * KIN(13)[l * 64 + lane], c = KIN(14)[l * 64 + lane] * KIN(15)[l * 64 + lane];
      lam = __expf(wave_sum(a)) - __expf(wave_sum(c)) + lam_init; }
    const float g0 = KIN(16)[l * 128 + 2 * lane], g1 = KIN(16)[l * 128 + 2 * lane + 1];
    for (int wt = gw; wt < M * 4; wt += NGW) {
        const int row = wt >> 2, h = wt & 3;
        const float *K0, *V0, *K1, *V1; int n0, n1;
        if (row < MP) { const int b = row >> 11, t = row & 2047; K0 = outp + OFF_KP + ((size_t)l * MP + (size_t)b * 2048) * 512 + h * 128; V0 = outp + OFF_VP + ((size_t)l * MP + (size_t)b * 2048) * 512 + h * 128; n0 = ((t >> 6) + 1) * 64; K1 = K0; V1 = V0; n1 = 0; }
        else { const int rs = row - MP, b = rs >> 5; K0 = cache_k + ((size_t)(l * 8 + b) * 4096) * 512 + h * 128; V0 = cache_v + ((size_t)(l * 8 + b) * 4096) * 512 + h * 128; n0 = 4096;
               K1 = outp + OFF_KS + ((size_t)(l * 8 + b) * 32) * 512 + h * 128; V1 = outp + OFF_VS + ((size_t)(l * 8 + b) * 32) * 512 + h * 128; n1 = 32; }
        float oc[2][2];
#pragma unroll 1
        for (int c = 0; c < 2; ++c) {
            float q[64];
#pragma unroll
            for (int d = 0; d < 64; ++d) q[d] = bf2f(Qb_[(size_t)row * 512 + h * 128 + c * 64 + d]);
            float mx = -1e30f;
            for (int seg = 0; seg < 2; ++seg) { const float* Kp = seg ? K1 : K0; const int n = seg ? n1 : n0;
                for (int j0 = 0; j0 < n; j0 += 64) { const int j = j0 + lane; float s = -1e30f;
                    if (j < n) { const float* kr = Kp + (size_t)j * 512 + c * 64; s = 0.f;
#pragma unroll
                        for (int d = 0; d < 64; ++d) s += q[d] * kr[d]; }
                    mx = fmaxf(mx, s); } }
            mx = fmaxf(mx, swz_xor<1>(mx)); mx = fmaxf(mx, swz_xor<2>(mx)); mx = fmaxf(mx, swz_xor<4>(mx)); mx = fmaxf(mx, swz_xor<8>(mx)); mx = fmaxf(mx, swz_xor<16>(mx)); mx = xhalf_max(mx);
            float L = 0.f, o0 = 0.f, o1 = 0.f;
            for (int seg = 0; seg < 2; ++seg) { const float* Kp = seg ? K1 : K0; const float* Vp = seg ? V1 : V0; const int n = seg ? n1 : n0;
                for (int j0 = 0; j0 < n; j0 += 64) { const int j = j0 + lane; float pj = 0.f;
                    if (j < n) { const float* kr = Kp + (size_t)j * 512 + c * 64; float s = 0.f;
#pragma unroll
                        for (int d = 0; d < 64; ++d) s += q[d] * kr[d];
                        pj = __builtin_amdgcn_exp2f(s - mx); }
                    L += pj;
                    const int nn = (n - j0 < 64) ? n - j0 : 64;
                    for (int jj = 0; jj < nn; ++jj) { const float pb = __builtin_bit_cast(float, __builtin_amdgcn_readlane(__builtin_bit_cast(int, pj), jj));
                        const f32x2 vv = *(const f32x2*)(Vp + (size_t)(j0 + jj) * 512 + 2 * lane); o0 += pb * vv.x; o1 += pb * vv.y; } } }
            L = wave_sum(L);
            oc[c][0] = o0 / L; oc[c][1] = o1 / L;
        }
        const float a0 = oc[0][0] - lam * oc[1][0], a1 = oc[0][1] - lam * oc[1][1];
        const float ss = wave_sum(a0 * a0 + a1 * a1);
        const float r = (1.0f / sqrtf(ss * (1.0f / 128.0f) + EPS)) * (1.0f - lam_init);
        *(unsigned*)(MIX_ + (size_t)row * 1024 + h * 128 + 2 * lane) = pk2(a0 * r * g0, a1 * r * g1);
    }
}
#endif

#ifndef PROBE_SLOW_PC
#define PROBE_SLOW_PC 0
#endif
#if PROBE_SLOW_PC
__device__ __forceinline__ float zval(const bf16* Zb_, const float* st, int l, int b, bool smp, int rowbase, int t, int col, int hist) {
    if (t >= 0) return bf2f(Zb_[(size_t)(rowbase + t) * 1024 + col]);
    if (!smp) return 0.f;
    return st[(size_t)((l * 8 + b) * hist + (hist + t)) * 256 + (col & 255)];
}
__device__ __forceinline__ void slow_pc_phase(int l, const bf16* Zb_, bf16* MIX_, int gw, int NGW, int lane) {
    const float* sp = KIN(4); const float* scv = KIN(5); const float* pw = KIN(17); const float* psc = KIN(18); const float* cw = KIN(19);
    for (int wt = gw; wt < M * 4; wt += NGW) {
        const int row = wt >> 2, g = wt & 3; const bool smp = row >= MP;
        int b, t, rowbase; if (smp) { const int rs = row - MP; b = rs >> 5; t = rs & 31; rowbase = MP + b * 32; } else { b = row >> 11; t = row & 2047; rowbase = b * 2048; }
        const int w = 2 << g, ch = g * 64 + lane;
        float s = 0.f;
        for (int i = 0; i < w; ++i) { const int tt = t - i; s += zval(Zb_, sp, l, b, smp, rowbase, tt, ch, 15); }
        const int pos = smp ? 4096 + t : t; const int cnt = (pos + 1 < w) ? pos + 1 : w;
        const float d = s / (float)cnt - zval(Zb_, sp, l, b, smp, rowbase, t, ch, 15);
        float mine = 0.f;
        for (int e = 0; e < 64; ++e) { const float v = wave_sum(d * pw[(size_t)((l * 4 + g) * 64 + lane) * 64 + e]); if (e == lane) mine = v; }
        MIX_[(size_t)row * 1024 + 512 + ch] = (bf16)(pk2(mine * psc[l * 256 + ch], 0.f) & 0xffffu);
        float cvv[3];
#pragma unroll
        for (int k = 0; k < 3; ++k) { const int tt = t - 2 + k;
            if (tt >= 0) cvv[k] = bf2f(Zb_[(size_t)(rowbase + tt) * 1024 + 768 + ch]) * bf2f(Zb_[(size_t)(rowbase + tt) * 1024 + 256 + ch]);
            else cvv[k] = smp ? scv[(size_t)((l * 8 + b) * 2 + (2 + tt)) * 256 + ch] : 0.f; }
        const float bgv = bf2f(Zb_[(size_t)row * 1024 + 512 + ch]);
        const float y = bgv * (cw[l * 768 + ch] * cvv[0] + cw[l * 768 + 256 + ch] * cvv[1] + cw[l * 768 + 512 + ch] * cvv[2]);
        MIX_[(size_t)row * 1024 + 768 + ch] = (bf16)(pk2(y, 0.f) & 0xffffu);
    }
}
#endif

#define XB_TMO      128
#define XB_XCNT(j)  (256  + 64 * (j))
#define XB_XSUB(j)  (1280 + 64 * (j))
#define XB_XGEN(j)  (2304 + 64 * (j))
#define XB_TOP      3328
#define XB_TOPGEN   3392
#define XCD_BAR_WORDS 3456
#define XB_SPIN_CAP (1u << 18)
__device__ __forceinline__ unsigned xb_ld(unsigned* p)              { return __hip_atomic_load(p, __ATOMIC_RELAXED, __HIP_MEMORY_SCOPE_AGENT); }
__device__ __forceinline__ unsigned xb_add(unsigned* p, unsigned v) { return __hip_atomic_fetch_add(p, v, __ATOMIC_RELAXED, __HIP_MEMORY_SCOPE_AGENT); }
__device__ __forceinline__ unsigned xb_xcc_id() { return (unsigned)__builtin_amdgcn_s_getreg((3 << 11) | 20) & 0xFu; }
#define XB_SPIN(cond, bar) do { unsigned _sp = 0; while (cond) { __builtin_amdgcn_s_sleep(1); \
    if ((++_sp & 255u) == 0u) { if (xb_ld(&(bar)[XB_TMO])) break; if (_sp > XB_SPIN_CAP) { atomicAdd(&(bar)[XB_TMO], 1u); break; } } } } while (0)
__device__ __forceinline__ void xcd_barrier_complete(unsigned* bar, unsigned x, unsigned& nloc, unsigned& nx) {
    const unsigned G = gridDim.x * gridDim.y * gridDim.z;
    unsigned sum, cnt, mine, sp = 0u;
    for (;;) {
        sum = 0u; cnt = 0u; mine = 0u;
#pragma unroll
        for (unsigned j = 0; j < 16; ++j) { const unsigned c = xb_ld(&bar[XB_XCNT(j)]); sum += c; cnt += (c > 0u) ? 1u : 0u; mine = (j == x) ? c : mine; }
        if (sum == G) break;
        __builtin_amdgcn_s_sleep(1);
        if ((++sp & 255u) == 0u) { if (xb_ld(&bar[XB_TMO])) break; if (sp > XB_SPIN_CAP) { atomicAdd(&bar[XB_TMO], 1u); break; } }
    }
    nloc = mine > 0u ? mine : 1u; nx = cnt > 0u ? cnt : 1u;
}
__device__ __forceinline__ void xcd_barrier(unsigned* bar, unsigned x, volatile LAS unsigned* st) {
    asm volatile("s_waitcnt vmcnt(0)" ::: "memory");
    __syncthreads();
    if (threadIdx.x == 0) {
        __builtin_amdgcn_s_waitcnt(0);
        unsigned nloc = st[0], nx = st[1];
        if (nloc == 0u) { xcd_barrier_complete(bar, x, nloc, nx); st[0] = nloc; st[1] = nx; }
        const unsigned old = xb_add(&bar[XB_XSUB(x)], 1u);
        const unsigned gen = old / nloc;
        if (old + 1u == (gen + 1u) * nloc) {
            __builtin_amdgcn_fence(__ATOMIC_RELEASE, "agent");
            asm volatile("s_waitcnt vmcnt(0)" ::: "memory");
            const unsigned og = xb_add(&bar[XB_TOP], 1u);
            const unsigned tg = og / nx;
            if (og + 1u == (tg + 1u) * nx) xb_add(&bar[XB_TOPGEN], 1u);
            else XB_SPIN(xb_ld(&bar[XB_TOPGEN]) == tg, bar);
            __builtin_amdgcn_fence(__ATOMIC_ACQUIRE, "agent");
            xb_add(&bar[XB_XGEN(x)], 1u);
            asm volatile("s_waitcnt vmcnt(0)" ::: "memory");
        } else {
            XB_SPIN(xb_ld(&bar[XB_XGEN(x)]) == gen, bar);
            __builtin_amdgcn_fence(__ATOMIC_ACQUIRE, "agent");
            asm volatile("s_waitcnt vmcnt(0)" ::: "memory");
        }
    }
    __syncthreads();
}
#define CG_SYNC() do { asm volatile("s_waitcnt vmcnt(0) lgkmcnt(0)" ::: "memory"); grid.sync(); asm volatile("" ::: "memory"); } while (0)
#define GRID_SYNC() xcd_barrier((unsigned*)KWS() + 4096, xcc, (volatile LAS unsigned*)(lds + LDS_BYTES - 64))
__global__ void __launch_bounds__(NWAVES * 64, 2) mega_fwd(Params p) {
    extern __shared__ __attribute__((aligned(16))) unsigned char lds_raw[];
    LAS unsigned char* lds = (LAS unsigned char*)lds_raw;
    cg::grid_group grid = cg::this_grid();
    const int tid = threadIdx.x, lane = tid & 63, wave = __builtin_amdgcn_readfirstlane(tid >> 6);
    const int G = gridDim.x; const int bx = blockIdx.x; const int vcu0 = (G % 8 == 0) ? (bx % 8) * (G / 8) + bx / 8 : bx;
    const int NGW = G * NWAVES;
#define X ((bf16*)(ws + WS_X))
#define H ((bf16*)(ws + WS_H))
#define MIX ((bf16*)(ws + WS_MIX))
#define ACT ((bf16*)(ws + WS_ACT))
#define Qb ((bf16*)(ws + WS_QB))
#define Kb ((bf16*)(ws + WS_KB))
#define Vb ((bf16*)(ws + WS_VB))
#define Zb ((bf16*)(ws + WS_ZB))
#define Ob ((bf16*)(ws + WS_OB))
#define OPART ((float*)(ws + WS_OPART))
#define MLP ((float*)(ws + WS_ML))
#define pwt ((const bf16*)(ws + WS_POOLWT))
    if (tid < 16) ((LAS unsigned*)(lds + LDS_BYTES - 64))[tid] = 0u;
    const unsigned xcc = xb_xcc_id();
    if (tid == 0) (void)xb_add((unsigned*)KWS() + 4096 + XB_XCNT(xcc), 1u);
    __syncthreads();
    { const int gw = vcu0 * NWAVES + wave; prologue(lds, gw, NGW, wave, lane);
      norm_rows<false>(KIN(0), KIN(1), KIN(6), (bf16*)(KWS() + WS_H), nullptr, gw, NGW, lane); }
    CG_SYNC();
#define FRESH_IDS() int tid = threadIdx.x; asm volatile("" : "+v"(tid)); const int lane = tid & 63, wave = __builtin_amdgcn_readfirstlane(tid >> 6); int vcu = vcu0; asm volatile("" : "+s"(vcu)); const int gw = vcu * NWAVES + wave; (void)lane; (void)gw; (void)wave
#define CNT(nid, idx) ((unsigned*)(ws + CTL_CNT) + (size_t)((nid) * 80 + (idx)) * 64)
#pragma unroll 1
    for (int step = 0; step < 4; ++step) {
        const int l = step >> 1, f = step & 1;
        const bool first = (step == 0);
        { FRESH_IDS(); unsigned char* const ws = KWS(); unsigned char* const wl = ws + WS_W + (size_t)l * WL;
          pg8::Gemm g{H, (const bf16*)(wl + (f ? W_GU2 : W_GU1)), M, 2 * FF, D}; pg8::StaticOrder S; S.init(M, 2 * FF, G, bx);
          pg8::EpiSwiGLU E{ACT, FF};
          pg8::gemm_phase<pg8::EpiSwiGLU, pg8::StaticOrder, true, true>(lds, g, S, E); }
        GRID_SYNC();
        { FRESH_IDS(); unsigned char* const ws = KWS(); unsigned char* const wl = ws + WS_W + (size_t)l * WL;
          const bool last = (step == 3);
          const float* const gn = last ? KIN(25) : (f ? KIN(6) + (l + 1) * D : KIN(10) + l * D);
          const int nid = step * 2;
          float* const yo = KOUT() + OFF_Y;
          pg8::Gemm g{ACT, (const bf16*)(wl + (f ? W_D2 : W_D1)), MP, D, FF}; pg8::StaticOrder S; S.init(MP, D, G, bx);
          { pg8::Unit u0; const int pm0 = S.next(0, u0) ? u0.pm : 0;
            if (first) { pg8::EpiResidNorm<false> E{KIN(0), X, 0.5f, H, yo, gn, (unsigned*)(ws + WS_SLOTP), CNT(nid, pm0)};
                         pg8::gemm_phase<pg8::EpiResidNorm<false>, pg8::StaticOrder, false, true>(lds, g, S, E); }
            else { pg8::EpiResidNorm<true> E{X, last ? nullptr : X, 0.5f, last ? nullptr : H, yo, gn, (unsigned*)(ws + WS_SLOTP), CNT(nid, pm0)};
                   pg8::gemm_phase<pg8::EpiResidNorm<true>, pg8::StaticOrder, false, true>(lds, g, S, E); } }
          if (first) skinny_gemm<false>(lds, ACT + (size_t)MP * FF, (const bf16*)(wl + W_D1), FF, KIN(1), X + (size_t)MP * D, 0.5f, H + (size_t)MP * D, yo + (size_t)MP * D, gn, (unsigned*)(ws + WS_SLOTS), CNT(nid, 64), vcu, G, tid);
          else skinny_gemm<true>(lds, ACT + (size_t)MP * FF, (const bf16*)(wl + (f ? W_D2 : W_D1)), FF, X + (size_t)MP * D, last ? nullptr : X + (size_t)MP * D, 0.5f,
                      last ? nullptr : H + (size_t)MP * D, yo + (size_t)MP * D, gn, (unsigned*)(ws + WS_SLOTS), CNT(nid, 64), vcu, G, tid); }
        if (step == 3) break;
        GRID_SYNC();
        if (f == 0) {
            { FRESH_IDS(); unsigned char* const ws = KWS(); unsigned char* const wl = ws + WS_W + (size_t)l * WL;
              pg8::Gemm g{H, (const bf16*)(wl + W_IN), M, DIN, D}; pg8::StaticOrder S; S.init(M, DIN, G, bx);
              pg8::EpiWin E{ws, KOUT(), l, C2};
              pg8::gemm_phase<pg8::EpiWin, pg8::StaticOrder, true, true>(lds, g, S, E); }
            GRID_SYNC();
            { FRESH_IDS(); unsigned char* const ws = KWS();
              for (int i = 0; i < 4; ++i) {
                const int L = i * G + vcu; if (L >= 1024) break;
                const int bh = (L & 255) >> 1, sI = L & 1, ii = L >> 8;
                const int qb = sI == 0 ? (ii == 0 ? 7 : ii == 1 ? 0 : ii == 2 ? 4 : 3) : (ii == 0 ? 6 : ii == 1 ? 1 : ii == 2 ? 5 : 2);
                const int b = bh >> 4, vh = bh & 15, hh = vh >> 2, c = (vh >> 1) & 1, hf = vh & 1;
                attn_body::attn_unit<8>(b, qb, (const attn_body::bf16*)(Qb + (hh * 2 + c) * 64), (const attn_body::bf16*)(Kb + (hh * 2 + c) * 64), (const attn_body::bf16*)(Vb + hh * 128 + hf * 64),
                                        (attn_body::bf16*)(Ob + c * 512 + hh * 128 + hf * 64), (char*)lds_raw);
              } }
            __syncthreads();
            { FRESH_IDS(); unsigned char* const ws = KWS(); float* const outp = KOUT();
              for (int pc = vcu; pc < 256; pc += G)
                sample_piece(lds, pc, l, Qb, KIN(2), KIN(3), outp + OFF_KS, outp + OFF_VS, OPART, MLP, tid); }
            __syncthreads();
            { FRESH_IDS(); unsigned char* const ws = KWS(); float* const outp = KOUT();
              for (int tl = vcu; tl < 264; tl += G)
                poolconv_tile(lds, tl, l, Zb, MIX, KIN(4), KIN(5), pwt, KIN(18), KIN(19), outp + OFF_CP, outp + OFF_CS, tid); }
            GRID_SYNC();
            { FRESH_IDS(); unsigned char* const ws = KWS();
              combine_phase(l, Ob, OPART, MLP, MIX, gw, NGW, lane); }
            GRID_SYNC();
            { FRESH_IDS(); unsigned char* const ws = KWS(); unsigned char* const wl = ws + WS_W + (size_t)l * WL;
              const float* const gn = KIN(21) + l * D; const int nid = step * 2 + 1;
              pg8::Gemm g{MIX, (const bf16*)(wl + W_OUT), MP, D, D}; pg8::StaticOrder S; S.init(MP, D, G, bx);
              { pg8::Unit u0; const int pm0 = S.next(0, u0) ? u0.pm : 0;
                pg8::EpiResidNorm<true> E{X, X, 1.0f, H, nullptr, gn, (unsigned*)(ws + WS_SLOTP), CNT(nid, pm0)};
                pg8::gemm_phase<pg8::EpiResidNorm<true>, pg8::StaticOrder, false, true>(lds, g, S, E); }
              skinny_gemm<true>(lds, MIX + (size_t)MP * D, (const bf16*)(wl + W_OUT), D, X + (size_t)MP * D, X + (size_t)MP * D, 1.0f, H + (size_t)MP * D, nullptr, gn,
                          (unsigned*)(ws + WS_SLOTS), CNT(nid, 64), vcu, G, tid); }
            GRID_SYNC();
        }
    }
}

extern "C" void kernel_launch(void* const* d_in, const int* in_sizes, int n_in, void* d_out, int out_size, void* d_ws, size_t ws_size, hipStream_t stream) {
    static int grid = 0;
    if (grid == 0) {
        if (n_in != 26 || (size_t)out_size != OUT_TOTAL || ws_size < WS_END) { fprintf(stderr, "kernel_launch: unexpected problem shape: n_in %d out %d ws %zu\n", n_in, out_size, ws_size); grid = -1; return; }
        int dev = 0, cus = 0, per_cu = 0;
        if (hipGetDevice(&dev) != hipSuccess || hipDeviceGetAttribute(&cus, hipDeviceAttributeMultiprocessorCount, dev) != hipSuccess) { grid = -1; return; }
        if (hipFuncSetAttribute((const void*)mega_fwd, hipFuncAttributeMaxDynamicSharedMemorySize, LDS_BYTES) != hipSuccess) { fprintf(stderr, "kernel_launch: hipFuncSetAttribute failed\n"); grid = -1; return; }
        if (hipOccupancyMaxActiveBlocksPerMultiprocessor(&per_cu, (const void*)mega_fwd, NWAVES * 64, LDS_BYTES) != hipSuccess || per_cu < 1) { fprintf(stderr, "kernel_launch: occupancy query says %d\n", per_cu); per_cu = 1; }
        (void)hipGetLastError();
        grid = cus * per_cu;
    }
    if (grid < 0) return;
    if (hipMemsetAsync(d_ws, 0, CTL_BYTES, stream) != hipSuccess) { fprintf(stderr, "kernel_launch: memset failed\n"); return; }
    Params p{};
    for (int i = 0; i < 26; ++i) p.in[i] = (const float*)d_in[i];
    p.out = (float*)d_out; p.ws = (unsigned char*)d_ws;
    void* args[] = {&p};
    const hipError_t e = hipLaunchCooperativeKernel((const void*)mega_fwd, dim3(grid), dim3(NWAVES * 64), args, LDS_BYTES, stream);
    if (e != hipSuccess) fprintf(stderr, "kernel_launch: cooperative launch failed: %s (grid %d)\n", hipGetErrorString(e), grid);
}
```

```cpp
#include <hip/hip_runtime.h>
#include <hip/hip_cooperative_groups.h>
#include <cstdio>
#include <cstdint>
namespace pg8 {
#define PG8_LAS __attribute__((address_space(3)))
typedef unsigned short bf16_t;
typedef short bf16x8 __attribute__((ext_vector_type(8)));
typedef float f32x4 __attribute__((ext_vector_type(4)));
typedef unsigned u32x4 __attribute__((ext_vector_type(4)));
constexpr int BM = 256, BK = 64, HALF = 128, HTB = HALF * BK * 2  , STAGE_BYTES = 8 * HTB, NXCD = 8, WGM = 8;

__host__ __device__ __forceinline__ int lds_byte(int r, int c) { const int st = (r >> 4) * 2 + (c >> 5), rr = r & 15, cc = c & 31, ob = rr * 64 + cc * 2; return st * 1024 + (ob ^ (((ob >> 9) & 1) << 5)); }
__host__ __device__ __forceinline__ void stage_rc(int b, int& R, int& C) { const int st = b / 1024, sb = b % 1024, swz = sb ^ (((sb >> 9) & 1) << 5); R = (st >> 1) * 16 + swz / 64; C = (st & 1) * 32 + (swz % 64) / 2; }
__host__ __device__ __forceinline__ int perm32(int rho) { const int n = rho >> 4, i = rho & 15; return 8 * (i >> 2) + 4 * n + (i & 3); }

struct Unit { int pm, pn; };
struct Gemm { const bf16_t* A; const bf16_t* Bt; int M, N, K; };

struct StaticOrder {
    int nM, nN, nwg, G, c;
    __host__ __device__ __forceinline__ void init(int M, int N, int G_, int c_) { nM = M / BM; nN = N / BM; nwg = nM * nN; G = G_; c = c_; }
    __host__ __device__ __forceinline__ bool next(int i, Unit& u) const {
        const long L = (long)i * G + c; if (L >= nwg) return false;
        int wgid = (int)L; { const int q = nwg / NXCD, r = nwg % NXCD, xcd = wgid % NXCD, off = wgid / NXCD; wgid = (xcd < r ? xcd * (q + 1) : r * (q + 1) + (xcd - r) * q) + off; }
        const int nig = WGM * nN, gid = wgid / nig, fm = gid * WGM, gsz = (nM - fm) < WGM ? (nM - fm) : WGM;
        u.pm = fm + ((wgid % nig) % gsz); u.pn = (wgid % nig) / gsz; return true;
    }
    __device__ __forceinline__ void a_ready(const Unit&) const {}
    __device__ __forceinline__ void done(const Unit&) const {}
};

__device__ __forceinline__ unsigned cvt_pk_bf16(float lo, float hi) { unsigned r; asm volatile("v_cvt_pk_bf16_f32 %0, %1, %2" : "=v"(r) : "v"(lo), "v"(hi)); return r; }
typedef float f32x2 __attribute__((ext_vector_type(2)));
typedef unsigned u32x2 __attribute__((ext_vector_type(2)));
constexpr size_t WOFF_ROPE = (size_t)1 << 20, WOFF_QB = (size_t)215 << 20, WOFF_KB = (size_t)232 << 20, WOFF_VB = (size_t)249 << 20, WOFF_ZB = (size_t)266 << 20;
constexpr size_t OOFF_KP = 17039360, OOFF_VP = 33816576, OOFF_PP = 50593792, OOFF_KS = 50663424, OOFF_VS = 50925568, OOFF_PS = 51187712;
__device__ __forceinline__ float silu_mul(float g, float u) { const float e = __builtin_amdgcn_exp2f(-1.4426950408889634f * g); return g * u * __builtin_amdgcn_rcpf(1.0f + e); }
struct EpiSwiGLU {
    static constexpr bool PERM = true, AFTER_DRAIN = false;
    bf16_t* O; int ldc;
    __device__ __forceinline__ void operator()(const f32x4 (&acc)[2][2][4][2], const Unit& u, int wr, int wc, int fr, int fq) const {
        const int row0 = u.pm * BM + wr * 64 + fr; const int col0 = u.pn * 128 + wc * 32 + 8 * fq;
#pragma unroll
        for (int ai = 0; ai < 2; ++ai)
#pragma unroll
            for (int m = 0; m < 4; ++m) {
                bf16_t* p = O + (size_t)(row0 + ai * HALF + m * 16) * ldc + col0;
                const f32x4 g0 = acc[ai][0][m][0], g1 = acc[ai][0][m][1], u0 = acc[ai][1][m][0], u1 = acc[ai][1][m][1];
                u32x4 w;
                w.x = cvt_pk_bf16(silu_mul(g0[0], u0[0]), silu_mul(g0[1], u0[1])); w.y = cvt_pk_bf16(silu_mul(g0[2], u0[2]), silu_mul(g0[3], u0[3]));
                w.z = cvt_pk_bf16(silu_mul(g1[0], u1[0]), silu_mul(g1[1], u1[1])); w.w = cvt_pk_bf16(silu_mul(g1[2], u1[2]), silu_mul(g1[3], u1[3]));
                *(u32x4*)p = w;
                asm volatile("" ::: "memory");
            }
    }
};
struct EpiResid {
    static constexpr bool PERM = false, AFTER_DRAIN = false;
    const float* baseP; const float* baseS; float* out; float scale;
    __device__ __forceinline__ void operator()(const f32x4 (&acc)[2][2][4][2], const Unit& u, int wr, int wc, int fr, int fq) const {
        const int col0 = u.pn * BM + wc * 32 + 4 * fq;
#pragma unroll
        for (int ai = 0; ai < 2; ++ai)
#pragma unroll
            for (int m = 0; m < 4; ++m) {
                const int row = u.pm * BM + ai * HALF + wr * 64 + m * 16 + fr;
                const float* bp = (row < 16384) ? baseP + (size_t)row * 1024 : baseS + (size_t)(row - 16384) * 1024;
                float* op = out + (size_t)row * 1024;
#pragma unroll
                for (int bj = 0; bj < 2; ++bj)
#pragma unroll
                    for (int n = 0; n < 2; ++n) { const int c = col0 + bj * HALF + n * 16; const f32x4 b = *(const f32x4*)(bp + c); *(f32x4*)(op + c) = b + acc[ai][bj][m][n] * scale; }
                asm volatile("" ::: "memory");
            }
    }
};
constexpr float RMS_EPS = 1e-6f;
__device__ __forceinline__ float rstd_of(float ss) { return 1.0f / sqrtf(ss * (1.0f / 1024.0f) + RMS_EPS); }

#define PG8_RLX_AGENT __ATOMIC_RELAXED, __HIP_MEMORY_SCOPE_AGENT
template <bool BASE16> struct EpiResidNorm {
    static constexpr bool PERM = false, AFTER_DRAIN = true;
    const void* baseP; bf16_t* out; float scale; bf16_t* hb; float* yout; const float* gain; unsigned* slots; unsigned* cnt;
    __device__ __forceinline__ void fused(f32x4 (&acc)[2][2][4][2], const Unit& u, int wr, int wc, int fr, int fq, PG8_LAS unsigned char* lds, int wid, int lane) const {
        PG8_LAS float* P = (PG8_LAS float*)lds;
        PG8_LAS float* S = (PG8_LAS float*)(lds + 4096);
        const int col0 = u.pn * BM + wc * 32 + 4 * fq;
#pragma unroll
        for (int ai = 0; ai < 2; ++ai)
#pragma unroll
            for (int m = 0; m < 4; ++m) {
                const int rl = ai * HALF + wr * 64 + m * 16 + fr; const size_t ro = (size_t)(u.pm * BM + rl) * 1024;
                float ss = 0.f;
#pragma unroll
                for (int bj = 0; bj < 2; ++bj)
#pragma unroll
                    for (int n = 0; n < 2; ++n) { const int c = col0 + bj * HALF + n * 16; f32x4 bv;
                        if (BASE16) { const u32x2 bw = *(const u32x2*)((const bf16_t*)baseP + ro + c); bv[0] = __builtin_bit_cast(float, bw.x << 16); bv[1] = __builtin_bit_cast(float, bw.x & 0xffff0000u); bv[2] = __builtin_bit_cast(float, bw.y << 16); bv[3] = __builtin_bit_cast(float, bw.y & 0xffff0000u); }
                        else bv = *(const f32x4*)((const float*)baseP + ro + c);
                        const f32x4 v = bv + acc[ai][bj][m][n] * scale; acc[ai][bj][m][n] = v;
                        if (out) { u32x2 w; w.x = cvt_pk_bf16(v[0], v[1]); w.y = cvt_pk_bf16(v[2], v[3]); *(u32x2*)(out + ro + c) = w; }
                        ss += (v[0] * v[0] + v[1] * v[1]) + (v[2] * v[2] + v[3] * v[3]); }
                ss += __builtin_bit_cast(float, __builtin_amdgcn_ds_swizzle(__builtin_bit_cast(int, ss), (16 << 10) | 0x1f));
                { float a = ss, b2 = ss; asm volatile("s_nop 1\n\tv_permlane32_swap_b32 %0, %1\n\ts_nop 1" : "+v"(a), "+v"(b2)); ss = a + b2; }
                if (fq == 0) P[rl * 4 + wc] = ss;
                if (m & 1) asm volatile("" ::: "memory");
            }
        asm volatile("s_waitcnt lgkmcnt(0)\n\ts_barrier" ::: "memory");
        const int t = wid * 64 + lane;
        if (t < 256) { const float s = (P[t * 4] + P[t * 4 + 1]) + (P[t * 4 + 2] + P[t * 4 + 3]);
            __hip_atomic_store(slots + (size_t)(u.pm * BM + t) * 4 + u.pn, __builtin_bit_cast(unsigned, s), PG8_RLX_AGENT); }
        asm volatile("s_waitcnt vmcnt(0)" ::: "memory");
        if (wid < 4 && lane == 0) __hip_atomic_fetch_add(cnt, 1u, PG8_RLX_AGENT);
        if (wid == 0) {
            unsigned spins = 0;
            while ((unsigned)__builtin_amdgcn_readfirstlane(__hip_atomic_load(cnt, PG8_RLX_AGENT)) < 16u) { __builtin_amdgcn_s_sleep(2); if (++spins > (1u << 22)) break; }
            __builtin_amdgcn_fence(__ATOMIC_ACQUIRE, "agent");
        }
        asm volatile("s_waitcnt vmcnt(0) lgkmcnt(0)\n\ts_barrier" ::: "memory");
        if (t < 256) { const unsigned* sl = slots + (size_t)(u.pm * BM + t) * 4; float tot = 0.f;
#pragma unroll
            for (int k = 0; k < 4; ++k) tot += __builtin_bit_cast(float, __hip_atomic_load(sl + k, PG8_RLX_AGENT));
            S[t] = rstd_of(tot); }
        asm volatile("s_waitcnt lgkmcnt(0)\n\ts_barrier" ::: "memory");
        f32x4 g4[2][2];
#pragma unroll
        for (int bj = 0; bj < 2; ++bj)
#pragma unroll
            for (int n = 0; n < 2; ++n) g4[bj][n] = *(const f32x4*)(gain + col0 + bj * HALF + n * 16);
#pragma unroll
        for (int ai = 0; ai < 2; ++ai)
#pragma unroll
            for (int m = 0; m < 4; ++m) {
                const int rl = ai * HALF + wr * 64 + m * 16 + fr; const size_t ro = (size_t)(u.pm * BM + rl) * 1024; const float r = S[rl];
#pragma unroll
                for (int bj = 0; bj < 2; ++bj)
#pragma unroll
                    for (int n = 0; n < 2; ++n) { const int c = col0 + bj * HALF + n * 16; const f32x4 y = acc[ai][bj][m][n] * r * g4[bj][n];
                        if (hb) { u32x2 w; w.x = cvt_pk_bf16(y[0], y[1]); w.y = cvt_pk_bf16(y[2], y[3]); *(u32x2*)(hb + ro + c) = w; }
                        else *(f32x4*)(yout + ro + c) = y; }
            }
        asm volatile("s_waitcnt lgkmcnt(0)\n\ts_barrier" ::: "memory");
    }
};

struct EpiWin {
    static constexpr bool PERM = false, AFTER_DRAIN = false;
    unsigned char* ws; float* outp; int l; float qscale;
    __device__ __forceinline__ void operator()(const f32x4 (&acc)[2][2][4][2], const Unit& u, int wr, int wc, int fr, int fq) const {
        const int pn = u.pn;
        bf16_t* const Qb = (bf16_t*)(ws + WOFF_QB); bf16_t* const Kb = (bf16_t*)(ws + WOFF_KB); bf16_t* const Vb = (bf16_t*)(ws + WOFF_VB); bf16_t* const Zb = (bf16_t*)(ws + WOFF_ZB);
        const float* const rope = (const float*)(ws + WOFF_ROPE);
        float* const kP = outp + OOFF_KP + (size_t)l * 16384 * 512; float* const vP = outp + OOFF_VP + (size_t)l * 16384 * 512;
        float* const kS = outp + OOFF_KS + (size_t)l * 256 * 512; float* const vS = outp + OOFF_VS + (size_t)l * 256 * 512;
        float* const poolP = outp + OOFF_PP + (size_t)l * 8 * 15 * 256; float* const poolS = outp + OOFF_PS + (size_t)l * 8 * 15 * 256;
#pragma unroll
        for (int ai = 0; ai < 2; ++ai)
#pragma unroll
            for (int m = 0; m < 4; ++m) {
                const int row = u.pm * BM + ai * HALF + wr * 64 + m * 16 + fr;
                const bool smp = row >= 16384; const int rs = row - 16384;
                const int prow = smp ? 2048 + (rs & 31) : (row & 2047);
#pragma unroll
                for (int bj = 0; bj < 2; ++bj) {
                    const int dlo = 16 * (wc & 1) + 4 * fq, lc0 = 64 * (2 * bj + (wc >> 1)) + dlo;
                    const f32x4 a0 = acc[ai][bj][m][0], a1 = acc[ai][bj][m][1];
                    if (pn < 4) {
                        const f32x4 cs = *(const f32x4*)(rope + (size_t)prow * 64 + dlo), sn = *(const f32x4*)(rope + (size_t)prow * 64 + 32 + dlo);
                        const f32x4 r0 = a0 * cs - a1 * sn, r1 = a1 * cs + a0 * sn;
                        if (pn < 2) {
                            const int col = 256 * pn + lc0; bf16_t* q = Qb + (size_t)row * 512 + col;
                            u32x2 w0, w1; w0.x = cvt_pk_bf16(r0[0] * qscale, r0[1] * qscale); w0.y = cvt_pk_bf16(r0[2] * qscale, r0[3] * qscale);
                            w1.x = cvt_pk_bf16(r1[0] * qscale, r1[1] * qscale); w1.y = cvt_pk_bf16(r1[2] * qscale, r1[3] * qscale);
                            *(u32x2*)q = w0; *(u32x2*)(q + 32) = w1;
                        } else {
                            const int col = 256 * (pn - 2) + lc0; bf16_t* k = Kb + (size_t)row * 512 + col;
                            float* ko = smp ? kS + (size_t)rs * 512 + col : kP + (size_t)row * 512 + col;
                            *(f32x4*)ko = r0; *(f32x4*)(ko + 32) = r1;
                            u32x2 w0, w1; w0.x = cvt_pk_bf16(r0[0], r0[1]); w0.y = cvt_pk_bf16(r0[2], r0[3]); w1.x = cvt_pk_bf16(r1[0], r1[1]); w1.y = cvt_pk_bf16(r1[2], r1[3]);
                            *(u32x2*)k = w0; *(u32x2*)(k + 32) = w1;
                        }
                    } else if (pn < 6) {
                        const int col = 256 * (pn - 4) + lc0; bf16_t* v = Vb + (size_t)row * 512 + col;
                        float* vo = smp ? vS + (size_t)rs * 512 + col : vP + (size_t)row * 512 + col;
                        *(f32x4*)vo = a0; *(f32x4*)(vo + 32) = a1;
                        u32x2 w0, w1; w0.x = cvt_pk_bf16(a0[0], a0[1]); w0.y = cvt_pk_bf16(a0[2], a0[3]); w1.x = cvt_pk_bf16(a1[0], a1[1]); w1.y = cvt_pk_bf16(a1[2], a1[3]);
                        *(u32x2*)v = w0; *(u32x2*)(v + 32) = w1;
                    } else {
                        const int col = 256 * (pn - 6) + lc0; bf16_t* z = Zb + (size_t)row * 1024 + col;
                        u32x2 w0, w1; w0.x = cvt_pk_bf16(a0[0], a0[1]); w0.y = cvt_pk_bf16(a0[2], a0[3]); w1.x = cvt_pk_bf16(a1[0], a1[1]); w1.y = cvt_pk_bf16(a1[2], a1[3]);
                        *(u32x2*)z = w0; *(u32x2*)(z + 32) = w1;
                        if (pn == 6) {
                            if (smp) { const int b = rs >> 5, t = rs & 31; if (t >= 17) { float* po = poolS + (size_t)(b * 15 + t - 17) * 256 + lc0; *(f32x4*)po = a0; *(f32x4*)(po + 32) = a1; } }
                            else { const int b = row >> 11, t = row & 2047; if (t >= 2033) { float* po = poolP + (size_t)(b * 15 + t - 2033) * 256 + lc0; *(f32x4*)po = a0; *(f32x4*)(po + 32) = a1; } }
                        }
                    }
                }
                asm volatile("" ::: "memory");
            }
    }
};
template <class Epi, class Sched, bool ALIGN_EPI = false, bool SP2 = false>
__device__ __forceinline__ void gemm_phase(PG8_LAS unsigned char* lds, const Gemm g, const Sched& S, const Epi& E) {
    int tid_l = threadIdx.x; asm volatile("" : "+v"(tid_l)); const int tid = tid_l, wid = __builtin_amdgcn_readfirstlane(tid >> 6), lane = tid & 63, wr = wid >> 2, wc = wid & 3, fr = lane & 15, fq = lane >> 4;
    const int K = g.K, nt = K / BK;
    unsigned voffA[2], voffB[2];
#pragma unroll
    for (int i = 0; i < 2; ++i) { int R, C; stage_rc(tid * 16 + i * 8192, R, C); const int Rb = Epi::PERM ? ((R & ~31) + perm32(R & 31)) : R;
        voffA[i] = (unsigned)(R * K + C) * 2u; voffB[i] = (unsigned)(Rb * K + C) * 2u; }
    const size_t kstep = (size_t)(BK * 2);
    const size_t hstep = (size_t)HALF * K * 2;
    const size_t tstep = 2 * hstep;
    const unsigned ldsw = (unsigned)wid * 1024u;
    const int aoff = lds_byte(wr * 64 + fr, fq * 8), boff = lds_byte(wc * 32 + fr, fq * 8);
#define PG8_SA(b, h) (((b) * 2 + (h)) * HTB)
#define PG8_SB(b, h) ((4 + (b) * 2 + (h)) * HTB)
#define PG8_STAGE(bufoff, gbase, voff) do { _Pragma("unroll") for (int _i = 0; _i < 2; ++_i) \
        __builtin_amdgcn_global_load_lds((const unsigned*)((const char*)(gbase) + (voff)[_i]), (PG8_LAS unsigned*)(lds + (bufoff) + ldsw + _i * 8192), 16, 0, 0); } while (0)
#define PG8_LDA(dst, b, h) do { _Pragma("unroll") for (int m = 0; m < 4; ++m) _Pragma("unroll") for (int k = 0; k < 2; ++k) dst[m][k] = *(const PG8_LAS bf16x8*)(lds + PG8_SA(b, h) + aoff + m * 2048 + k * 1024); } while (0)
#define PG8_LDB(dst, b, h) do { _Pragma("unroll") for (int n = 0; n < 2; ++n) _Pragma("unroll") for (int k = 0; k < 2; ++k) dst[n][k] = *(const PG8_LAS bf16x8*)(lds + PG8_SB(b, h) + boff + n * 2048 + k * 1024); } while (0)
#define PG8_MMA(ai, bj, At, Bt) do { __builtin_amdgcn_s_setprio(1); _Pragma("unroll") for (int m = 0; m < 4; ++m) _Pragma("unroll") for (int n = 0; n < 2; ++n) _Pragma("unroll") for (int k = 0; k < 2; ++k) \
        acc[ai][bj][m][n] = __builtin_amdgcn_mfma_f32_16x16x32_bf16(Bt[n][k], At[m][k], acc[ai][bj][m][n], 0, 0, 0); __builtin_amdgcn_s_setprio(0); } while (0)
#define PG8_WAIT_V(n) asm volatile("s_waitcnt vmcnt(" #n ")" ::: "memory")
#define PG8_WAIT_L(n) asm volatile("s_waitcnt lgkmcnt(" #n ")" ::: "memory")
#define PG8_BAR __builtin_amdgcn_s_barrier()
#define PG8_SCHED __builtin_amdgcn_sched_barrier(0)
    Unit cur, nxt; int ui = 0;
    if (!S.next(0, cur)) return;
    f32x4 acc[2][2][4][2];
#pragma unroll
    for (int a = 0; a < 2; ++a)
#pragma unroll
        for (int b = 0; b < 2; ++b)
#pragma unroll
            for (int m = 0; m < 4; ++m)
#pragma unroll
                for (int n = 0; n < 2; ++n) acc[a][b][m][n] = (f32x4){0.f, 0.f, 0.f, 0.f};
    bf16x8 At[4][2], B0[2][2], B1[2][2];
    const char* cA = (const char*)g.A + (size_t)cur.pm * tstep; const char* cB = (const char*)g.Bt + (size_t)cur.pn * tstep;
    S.a_ready(cur);
    if constexpr (SP2) {
        PG8_STAGE(PG8_SB(0, 0), cB, voffB); PG8_STAGE(PG8_SB(0, 1), cB + hstep, voffB); PG8_STAGE(PG8_SA(0, 0), cA, voffA); PG8_STAGE(PG8_SA(0, 1), cA + hstep, voffA);
        if (wr == 1) PG8_BAR;
        PG8_WAIT_V(2); PG8_BAR;
        PG8_STAGE(PG8_SB(1, 0), cB + kstep, voffB); PG8_STAGE(PG8_SA(1, 0), cA + kstep, voffA); PG8_STAGE(PG8_SB(1, 1), cB + hstep + kstep, voffB);
        PG8_WAIT_V(6); PG8_BAR;
    } else {
        PG8_STAGE(PG8_SB(0, 0), cB, voffB); PG8_STAGE(PG8_SA(0, 0), cA, voffA); PG8_STAGE(PG8_SB(0, 1), cB + hstep, voffB); PG8_STAGE(PG8_SA(0, 1), cA + hstep, voffA);
        if (wr == 1) PG8_BAR;
        PG8_WAIT_V(4); PG8_BAR;
        PG8_STAGE(PG8_SB(1, 0), cB + kstep, voffB); PG8_STAGE(PG8_SA(1, 0), cA + kstep, voffA); PG8_STAGE(PG8_SB(1, 1), cB + hstep + kstep, voffB);
        PG8_WAIT_V(6); PG8_BAR;
    }
    for (;;) {
        const bool has_next = S.next(ui + 1, nxt);
        const char* nA = has_next ? (const char*)g.A + (size_t)nxt.pm * tstep : cA; const char* nB = has_next ? (const char*)g.Bt + (size_t)nxt.pn * tstep : cB;
        for (int t = 0; t < nt; t += 2) {
            const bool last = (t == nt - 2);
            const char* a1 = cA + (size_t)(t + 1) * kstep;
            const char* a2 = last ? nA : cA + (size_t)(t + 2) * kstep; const char* b2 = last ? nB : cB + (size_t)(t + 2) * kstep;
            const char* a3 = a2 + kstep; const char* b3 = b2 + kstep;
            if (last && has_next) S.a_ready(nxt);
            if constexpr (SP2) {
            PG8_LDB(B0, 0, 0); PG8_LDB(B1, 0, 1); PG8_SCHED; PG8_LDA(At, 0, 0); PG8_STAGE(PG8_SA(1, 1), a1 + hstep, voffA);
            PG8_WAIT_V(8); PG8_WAIT_L(0); PG8_BAR; PG8_MMA(0, 0, At, B0); PG8_MMA(0, 1, At, B1); PG8_BAR; PG8_SCHED;
            PG8_LDA(At, 0, 1); PG8_STAGE(PG8_SB(0, 0), b2, voffB); PG8_STAGE(PG8_SB(0, 1), b2 + hstep, voffB); PG8_STAGE(PG8_SA(0, 0), a2, voffA);
            PG8_WAIT_V(8); PG8_WAIT_L(0); PG8_BAR; PG8_MMA(1, 0, At, B0); PG8_MMA(1, 1, At, B1); PG8_BAR; PG8_SCHED;
            PG8_LDB(B0, 1, 0); PG8_LDB(B1, 1, 1); PG8_SCHED; PG8_LDA(At, 1, 0); PG8_STAGE(PG8_SA(0, 1), a2 + hstep, voffA);
            PG8_WAIT_V(8); PG8_WAIT_L(0); PG8_BAR; PG8_MMA(0, 0, At, B0); PG8_MMA(0, 1, At, B1); PG8_BAR; PG8_SCHED;
            PG8_LDA(At, 1, 1); PG8_STAGE(PG8_SB(1, 0), b3, voffB); PG8_STAGE(PG8_SB(1, 1), b3 + hstep, voffB); PG8_STAGE(PG8_SA(1, 0), a3, voffA);
            PG8_WAIT_V(8); PG8_WAIT_L(0); PG8_BAR; PG8_MMA(1, 0, At, B0); PG8_MMA(1, 1, At, B1); PG8_BAR; PG8_SCHED;
            } else {
            PG8_LDB(B0, 0, 0); PG8_SCHED; PG8_LDA(At, 0, 0); PG8_STAGE(PG8_SA(1, 1), a1 + hstep, voffA);
            PG8_WAIT_L(8); PG8_BAR; PG8_WAIT_L(0); PG8_MMA(0, 0, At, B0); PG8_BAR; PG8_SCHED;
            PG8_LDB(B1, 0, 1); PG8_STAGE(PG8_SB(0, 0), b2, voffB);
            PG8_BAR; PG8_WAIT_L(0); PG8_MMA(0, 1, At, B1); PG8_BAR;
            PG8_LDA(At, 0, 1); PG8_STAGE(PG8_SA(0, 0), a2, voffA);
            PG8_BAR; PG8_WAIT_L(0); PG8_MMA(1, 0, At, B0); PG8_BAR; PG8_SCHED;
            PG8_STAGE(PG8_SB(0, 1), b2 + hstep, voffB);
            PG8_WAIT_V(6); PG8_BAR; PG8_MMA(1, 1, At, B1); PG8_BAR;
            PG8_LDB(B0, 1, 0); PG8_SCHED; PG8_LDA(At, 1, 0); PG8_STAGE(PG8_SA(0, 1), a2 + hstep, voffA);
            PG8_WAIT_L(8); PG8_BAR; PG8_WAIT_L(0); PG8_MMA(0, 0, At, B0); PG8_BAR; PG8_SCHED;
            PG8_LDB(B1, 1, 1); PG8_STAGE(PG8_SB(1, 0), b3, voffB);
            PG8_BAR; PG8_WAIT_L(0); PG8_MMA(0, 1, At, B1); PG8_BAR;
            PG8_LDA(At, 1, 1); PG8_STAGE(PG8_SA(1, 0), a3, voffA);
            PG8_BAR; PG8_WAIT_L(0); PG8_MMA(1, 0, At, B0); PG8_BAR; PG8_SCHED;
            PG8_STAGE(PG8_SB(1, 1), b3 + hstep, voffB);
            PG8_WAIT_V(6); PG8_BAR; PG8_MMA(1, 1, At, B1); PG8_BAR;
            }
        }
        if constexpr (ALIGN_EPI) { if (wr == 0) PG8_BAR; }
        if constexpr (!Epi::AFTER_DRAIN) { E(acc, cur, wr, wc, fr, fq); S.done(cur); }
        if (!has_next) break;
#pragma unroll
        for (int a = 0; a < 2; ++a)
#pragma unroll
            for (int b = 0; b < 2; ++b)
#pragma unroll
                for (int m = 0; m < 4; ++m)
#pragma unroll
                    for (int n = 0; n < 2; ++n) acc[a][b][m][n] = (f32x4){0.f, 0.f, 0.f, 0.f};
        cur = nxt; cA = nA; cB = nB; ++ui;
        if constexpr (ALIGN_EPI) { if (wr == 1) PG8_BAR; }
    }
    PG8_WAIT_V(0);
    if constexpr (!ALIGN_EPI) { if (wr == 0) PG8_BAR; }
    PG8_BAR;
    if constexpr (Epi::AFTER_DRAIN) { E.fused(acc, cur, wr, wc, fr, fq, lds, wid, lane); S.done(cur); }
#undef PG8_SA
#undef PG8_SB
#undef PG8_STAGE
#undef PG8_LDA
#undef PG8_LDB
#undef PG8_MMA
#undef PG8_WAIT_V
#undef PG8_WAIT_L
#undef PG8_BAR
#undef PG8_SCHED
}
}
#include <hip/hip_bf16.h>
#include <cmath>
namespace attn_body {
using bf16=__hip_bfloat16;
using bf16x8=__attribute__((ext_vector_type(8)))short;
using s16x4=__attribute__((ext_vector_type(4)))short;
using f32x16=__attribute__((ext_vector_type(16)))float;
using u32x4=__attribute__((ext_vector_type(4)))unsigned;
constexpr int BATCH=8,NHEAD=16,SEQ=2048,D=64,PQK=512,PO=1024;
constexpr int NW=8,QBLK=32,QB=QBLK*NW,KVBLK=64,NQB=SEQ/QB;
constexpr int ATTN_UNIT_ROWS=QB;
__device__ __forceinline__ int crow(int r,int hi){return (r&3)+8*(r>>2)+4*hi;}
#define SBAR() __builtin_amdgcn_sched_barrier(0)
__device__ __forceinline__ void cmask(f32x16&p0,f32x16&p1,int jb,int qrel,int hi){
  const float NEG=-INFINITY; (void)hi;
  if(jb>(qrel>>6)){
  #pragma unroll
  for(int r=0;r<16;++r){p0[r]=NEG;p1[r]=NEG;}}
}

constexpr int NSLOT=3, SLOTB=8192;
constexpr int LDS_K=0, LDS_V=NSLOT*SLOTB, LDS_WS=2*NSLOT*SLOTB, LDS_OST=LDS_WS+NW*64*4, LDS_BYTES=LDS_OST+NW*4096;
constexpr float C2=0.125f*1.4426950408889634f;
__device__ __forceinline__ void glds16(const void*gsrc,unsigned lds_dst){unsigned keep;
  asm volatile("s_mov_b32 %0, m0\n\ts_mov_b32 m0, %2\n\ts_nop 0\n\tglobal_load_lds_dwordx4 %1, off\n\ts_mov_b32 m0, %0":"=&s"(keep):"v"(gsrc),"s"(lds_dst):"memory");}
__device__ __forceinline__ float max3f(float a,float b,float c){float r;asm("v_max3_f32 %0, %1, %2, %3":"=v"(r):"v"(a),"v"(b),"v"(c));return r;}
__device__ __forceinline__ float max2f(float a,float b){float r;asm("v_max_f32_e32 %0, %1, %2":"=v"(r):"v"(a),"v"(b));return r;}
__device__ __forceinline__ float fadd_s(float a,float b){float r;asm("v_add_f32_e32 %0, %1, %2":"=v"(r):"v"(a),"v"(b));return r;}
__device__ __forceinline__ float fsub_s(float a,float b){float r;asm("v_sub_f32_e32 %0, %1, %2":"=v"(r):"v"(a),"v"(b));return r;}
typedef float f32x2_t __attribute__((ext_vector_type(2))); typedef __bf16 bf16x2_t __attribute__((ext_vector_type(2)));
__device__ __forceinline__ unsigned cvtpk_s(float lo,float hi){f32x2_t v={lo,hi};bf16x2_t b=__builtin_convertvector(v,bf16x2_t);return __builtin_bit_cast(unsigned,b);}
#define WAIT_BAR(N) asm volatile("s_waitcnt vmcnt(" #N ") lgkmcnt(0)\n\ts_barrier":::"memory")

__device__ __forceinline__ void qkt(f32x16&p0,f32x16&p1,const char*Kslot,const bf16x8*qr,const f32x16&negm,int r32,int hi){
  const char*kb=Kslot+hi*1024+r32*16;
  #pragma unroll
  for(int d0=0;d0<4;++d0){
    const bf16x8 b0=*reinterpret_cast<const bf16x8*>(kb+d0*2048);
    const bf16x8 b1=*reinterpret_cast<const bf16x8*>(kb+d0*2048+512);
    if(d0==0){p0=__builtin_amdgcn_mfma_f32_32x32x16_bf16(b0,qr[0],negm,0,0,0);p1=__builtin_amdgcn_mfma_f32_32x32x16_bf16(b1,qr[0],negm,0,0,0);}
    else{p0=__builtin_amdgcn_mfma_f32_32x32x16_bf16(b0,qr[d0],p0,0,0,0);p1=__builtin_amdgcn_mfma_f32_32x32x16_bf16(b1,qr[d0],p1,0,0,0);}}
}
typedef __attribute__((address_space(3))) const char* lds_cptr;
typedef short v4i16_t __attribute__((ext_vector_type(4)));
__device__ __forceinline__ void kload8(bf16x8*kf,lds_cptr kp){
  kf[0]=*(const __attribute__((address_space(3))) bf16x8*)(kp);      kf[1]=*(const __attribute__((address_space(3))) bf16x8*)(kp+512);
  kf[2]=*(const __attribute__((address_space(3))) bf16x8*)(kp+2048); kf[3]=*(const __attribute__((address_space(3))) bf16x8*)(kp+2560);
  kf[4]=*(const __attribute__((address_space(3))) bf16x8*)(kp+4096); kf[5]=*(const __attribute__((address_space(3))) bf16x8*)(kp+4608);
  kf[6]=*(const __attribute__((address_space(3))) bf16x8*)(kp+6144); kf[7]=*(const __attribute__((address_space(3))) bf16x8*)(kp+6656);
}
__device__ __forceinline__ void kload2(bf16x8*kf,lds_cptr kp,int j){ kf[2*j]=*(const __attribute__((address_space(3))) bf16x8*)(kp+j*2048); kf[2*j+1]=*(const __attribute__((address_space(3))) bf16x8*)(kp+j*2048+512); }
__device__ __forceinline__ s16x4 vtr(lds_cptr p){ return __builtin_bit_cast(s16x4,__builtin_amdgcn_ds_read_tr16_b64_v4i16((__attribute__((address_space(3))) v4i16_t*)p)); }
__device__ __forceinline__ float rowmax(const f32x16&p0,const f32x16&p1){
  float a=max3f(p0[0],p0[1],p1[0]),b=max3f(p0[2],p0[3],p1[1]);a=max3f(a,p1[2],p1[3]);
  #pragma unroll
  for(int r=4;r<16;r+=4){a=max3f(a,p0[r],p0[r+1]);b=max3f(b,p0[r+2],p0[r+3]);a=max3f(a,p1[r],p1[r+1]);b=max3f(b,p1[r+2],p1[r+3]);}
  const float m=max2f(a,b);
  auto rr=__builtin_amdgcn_permlane32_swap(__float_as_uint(m),__float_as_uint(m),false,false);
  return max2f(__uint_as_float(rr[0]),__uint_as_float(rr[1]));
}
__device__ __forceinline__ void pv(f32x16*o,int vb,bf16x8 pa0,bf16x8 pa1,bf16x8 pa2,bf16x8 pa3){
  #pragma unroll
  for(int d0=0;d0<2;++d0){s16x4 lo[4],hi[4];
    #pragma unroll
    for(int ks=0;ks<4;++ks){
      asm volatile("ds_read_b64_tr_b16 %0,%1 offset:%c2":"=&v"(lo[ks]):"v"(vb),"i"(d0*4096+ks*1024):"memory");
      asm volatile("ds_read_b64_tr_b16 %0,%1 offset:%c2":"=&v"(hi[ks]):"v"(vb),"i"(d0*4096+ks*1024+512):"memory");}
    asm volatile("s_waitcnt lgkmcnt(0)":::"memory");SBAR();
    #define PK(k) (bf16x8){lo[k][0],lo[k][1],lo[k][2],lo[k][3],hi[k][0],hi[k][1],hi[k][2],hi[k][3]}
    o[d0]=__builtin_amdgcn_mfma_f32_32x32x16_bf16(pa0,PK(0),o[d0],0,0,0);
    o[d0]=__builtin_amdgcn_mfma_f32_32x32x16_bf16(pa1,PK(1),o[d0],0,0,0);
    o[d0]=__builtin_amdgcn_mfma_f32_32x32x16_bf16(pa2,PK(2),o[d0],0,0,0);
    o[d0]=__builtin_amdgcn_mfma_f32_32x32x16_bf16(pa3,PK(3),o[d0],0,0,0);
    #undef PK
  }
}

#ifndef ATTN_STORE16
#define ATTN_STORE16(p,v) (*(u32x4*)(p)=(v))
#endif
template<int THRL> __device__ __forceinline__ void attn_unit(int b,int qb,const bf16*Q,const bf16*__restrict__ K,const bf16*__restrict__ V,bf16*O,char*shm){
  int tid_l=threadIdx.x; asm volatile("":"+v"(tid_l)); const int tid=tid_l,lane=tid&63,r32=lane&31,hi=lane>>5; const int wid=__builtin_amdgcn_readfirstlane(tid>>6);
  const long rowbase=(long)b*SEQ; const int q0=qb*QB;
  const bf16*Qw=Q+(rowbase+q0+wid*QBLK)*PQK;
  const bf16*Kh=K+rowbase*PQK,*Vh=V+rowbase*PQK;
  const unsigned lds0=(unsigned)(uintptr_t)shm;
  float*wsf=(float*)(shm+LDS_WS)+wid*64;
  const bf16*ksrc=Kh+(long)lane*PQK+wid*8;
  const bf16*vsrc=Vh+(long)(16*(wid&3)+(lane>>2))*PQK+(wid>>2)*32+(lane&3)*8;
  const unsigned kdst=lds0+LDS_K+wid*1024, vdst=lds0+LDS_V+wid*1024;
  #define DMA_K(t,slot) glds16(ksrc+(long)(t)*KVBLK*PQK,(unsigned)__builtin_amdgcn_readfirstlane(kdst+(slot)))
  #define DMA_V(t,slot) glds16(vsrc+(long)(t)*KVBLK*PQK,(unsigned)__builtin_amdgcn_readfirstlane(vdst+(slot)))
  const int vb0=(int)(lds0+LDS_V)+((lane>>4)&1)*32+(lane&3)*8+(4*hi+((lane&15)>>2))*64;
  const char*Kbase=shm+LDS_K; bf16x8 kf[8];
  const lds_cptr shm3=(lds_cptr)shm; const lds_cptr kp0=shm3+LDS_K+hi*1024+r32*16; const lds_cptr vp0=shm3+LDS_V+((lane>>4)&1)*32+(lane&3)*8+(4*hi+((lane&15)>>2))*64;
  const int NT=(q0+QB)/KVBLK;
  DMA_K(0,0);DMA_V(0,0);DMA_K(1,SLOTB);
  bf16x8 qr[4];
  #pragma unroll
  for(int d0=0;d0<4;++d0)qr[d0]=*reinterpret_cast<const bf16x8*>(&Qw[(long)r32*PQK+d0*16+hi*8]);
  float mhat=0.f,l_reg=0.f;f32x16 o[2];o[0]=f32x16{};o[1]=f32x16{};f32x16 negm=f32x16{};asm volatile("":"+v"(negm));
  const int qrel=wid*QBLK+r32;
  #define CMASK(P0,P1,t) do{int jb_=(t)-(NT-4); if(jb_>=0)cmask(P0,P1,jb_,qrel,hi);}while(0)
  bool resc=false;
  #define START(P0,P1) do{ const float rm=rowmax(P0,P1); resc=false; \
    { const float dl=rm; mhat=fadd_s(mhat,dl); \
      _Pragma("unroll") for(int r=0;r<16;++r){P0[r]=fsub_s(P0[r],dl);P1[r]=fsub_s(P1[r],dl);} \
      _Pragma("unroll") for(int r=0;r<16;++r)negm[r]=-mhat; asm volatile("":"+v"(negm)); } \
    _Pragma("unroll") for(int r=0;r<16;++r)P0[r]=__builtin_amdgcn_exp2f(P0[r]); }while(0)
  #define RESC() do{ if(resc){ asm volatile("s_waitcnt lgkmcnt(0)":::"memory"); \
      _Pragma("unroll") for(int d_=0;d_<2;++d_) _Pragma("unroll") for(int r=0;r<16;++r)o[d_][r]*=wsf[crow(r,hi)]; } }while(0)
  f32x16 pA0,pA1,pB0,pB1;
  int sl_prev=0,sl_cur=0,sl_next=SLOTB;
  #define ROT() do{sl_prev=sl_cur;sl_cur=sl_next;sl_next=(sl_next==(NSLOT-1)*SLOTB)?0:sl_next+SLOTB;}while(0)
  DMA_K(2,2*SLOTB);
  WAIT_BAR(3);
  qkt(pA0,pA1,Kbase,qr,negm,r32,hi);asm volatile("s_nop 15\n\ts_nop 7":"+v"(pA0),"+v"(pA1));CMASK(pA0,pA1,0);
  START(pA0,pA1);
  _Pragma("unroll") for(int r=0;r<16;++r)pA1[r]=__builtin_amdgcn_exp2f(pA1[r]);
  WAIT_BAR(0);
  DMA_K(3,0);DMA_V(1,SLOTB);
  ROT();
  kload8(kf,kp0+sl_cur);
  WAIT_BAR(2);
  s16x4 vlo[8],vhi[8]; u32x4 pw0,pw1,pw2,pw3;
  #define PKW(P,B) cvtpk_s(P[B],P[B+1])
  #define PAF(k) __builtin_bit_cast(bf16x8,pw##k)
  #define VFR(i) (bf16x8){vlo[i][0],vlo[i][1],vlo[i][2],vlo[i][3],vhi[i][0],vhi[i][1],vhi[i][2],vhi[i][3]}
  #define PIN(x) asm volatile("":"+v"(x))
  #define MX3(a,b,c) __builtin_fmaxf(__builtin_fmaxf((a),(b)),(c))
  #define GAPA(MF,A0,A1,A2,A3,W0,W1,PW) do{ MF; sacc+=A0; sacc+=A1; sacc+=A2; sacc+=A3; PIN(sacc); W0; W1; PIN(PW); SBAR(); }while(0)
  #define EX(v) __builtin_amdgcn_exp2f(v)
  #define GAPB(MF,X,B) do{ MF; X[B]=EX(X[B]); X[B+1]=EX(X[B+1]); X[B+2]=EX(X[B+2]); X[B+3]=EX(X[B+3]); PIN(X); SBAR(); }while(0)
  #define VRD(i) do{ vlo[i]=vtr(vp_+(((i)>>2)*4096+((i)&3)*1024)); vhi[i]=vtr(vp_+(((i)>>2)*4096+((i)&3)*1024+512)); }while(0)
  #define KRD(G,j) do{ if(G){ kload2(kf,kp0+sl_next,j); SBAR(); } }while(0)
  #define STEP(C0,C1,P0,P1,t,GK,GV,GL) do{ SBAR(); \
    const lds_cptr vp_=vp0+sl_prev; \
    VRD(0); SBAR(); float sacc=(P0[0]+P0[1]); \
    GAPA(C0=__builtin_amdgcn_mfma_f32_32x32x16_bf16(kf[0],qr[0],negm,0,0,0), P0[2],P0[3],P0[4],P0[5],     pw0[0]=PKW(P0,0), pw0[1]=PKW(P0,2), pw0); \
    VRD(4); SBAR(); GAPA(C1=__builtin_amdgcn_mfma_f32_32x32x16_bf16(kf[1],qr[0],negm,0,0,0), P0[6],P0[7],P0[8],P0[9],     pw0[2]=PKW(P0,4), pw0[3]=PKW(P0,6), pw0); \
    VRD(1); SBAR(); GAPA(C0=__builtin_amdgcn_mfma_f32_32x32x16_bf16(kf[2],qr[1],C0,0,0,0),   P0[10],P0[11],P0[12],P0[13], pw1[0]=PKW(P0,8), pw1[1]=PKW(P0,10), pw1); \
    VRD(5); SBAR(); GAPA(C1=__builtin_amdgcn_mfma_f32_32x32x16_bf16(kf[3],qr[1],C1,0,0,0),   P0[14],P0[15],P1[0],P1[1],   pw1[2]=PKW(P0,12),pw1[3]=PKW(P0,14), pw1); \
    VRD(2); SBAR(); GAPA(C0=__builtin_amdgcn_mfma_f32_32x32x16_bf16(kf[4],qr[2],C0,0,0,0),   P1[2],P1[3],P1[4],P1[5],     pw2[0]=PKW(P1,0), pw2[1]=PKW(P1,2), pw2); \
    VRD(6); SBAR(); GAPA(C1=__builtin_amdgcn_mfma_f32_32x32x16_bf16(kf[5],qr[2],C1,0,0,0),   P1[6],P1[7],P1[8],P1[9],     pw2[2]=PKW(P1,4), pw2[3]=PKW(P1,6), pw2); \
    VRD(3); SBAR(); GAPA(C0=__builtin_amdgcn_mfma_f32_32x32x16_bf16(kf[6],qr[3],C0,0,0,0),   P1[10],P1[11],P1[12],P1[13], pw3[0]=PKW(P1,8), pw3[1]=PKW(P1,10), pw3); \
    VRD(7); SBAR(); GAPA(C1=__builtin_amdgcn_mfma_f32_32x32x16_bf16(kf[7],qr[3],C1,0,0,0),   P1[14],P1[15],0.f,0.f,       pw3[2]=PKW(P1,12),pw3[3]=PKW(P1,14), pw3); \
    l_reg+=sacc; \
    if(GK){DMA_K((t)+3,sl_cur);} if(GV){DMA_V((t)+1,sl_next);} \
    CMASK(C0,C1,t); \
    { float a=MX3(C0[0],C0[1],C1[0]),b=MX3(C0[2],C0[3],C1[1]); a=MX3(a,C1[2],C1[3]); \
      _Pragma("unroll") for(int r=4;r<16;r+=4){a=MX3(a,C0[r],C0[r+1]);b=MX3(b,C0[r+2],C0[r+3]);a=MX3(a,C1[r],C1[r+1]);b=MX3(b,C1[r+2],C1[r+3]);} \
      float rm=__builtin_fmaxf(a,b); { auto rr=__builtin_amdgcn_permlane32_swap(__float_as_uint(rm),__float_as_uint(rm),false,false); rm=__builtin_fmaxf(__uint_as_float(rr[0]),__uint_as_float(rr[1])); } \
      resc=false; \
      if(__builtin_expect(__any(rm>(float)THRL),0)){ const float dl=__builtin_fmaxf(rm,0.f); mhat+=dl; \
        _Pragma("unroll") for(int r=0;r<16;++r){C0[r]-=dl;C1[r]-=dl;} \
        _Pragma("unroll") for(int r=0;r<16;++r)negm[r]=-mhat; asm volatile("":"+v"(negm)); \
        const float f=__builtin_amdgcn_exp2f(-dl); l_reg*=f; if(hi==0)wsf[r32]=f; resc=true; } } \
    SBAR(); \
    GAPB(o[0]=__builtin_amdgcn_mfma_f32_32x32x16_bf16(PAF(0),VFR(0),o[0],0,0,0), C0,0); \
    GAPB(o[1]=__builtin_amdgcn_mfma_f32_32x32x16_bf16(PAF(0),VFR(4),o[1],0,0,0), C0,4); \
    KRD(GL,0); GAPB(o[0]=__builtin_amdgcn_mfma_f32_32x32x16_bf16(PAF(1),VFR(1),o[0],0,0,0), C0,8); \
    KRD(GL,1); GAPB(o[1]=__builtin_amdgcn_mfma_f32_32x32x16_bf16(PAF(1),VFR(5),o[1],0,0,0), C0,12); \
    KRD(GL,2); GAPB(o[0]=__builtin_amdgcn_mfma_f32_32x32x16_bf16(PAF(2),VFR(2),o[0],0,0,0), C1,0); \
    KRD(GL,3); GAPB(o[1]=__builtin_amdgcn_mfma_f32_32x32x16_bf16(PAF(2),VFR(6),o[1],0,0,0), C1,4); \
    GAPB(o[0]=__builtin_amdgcn_mfma_f32_32x32x16_bf16(PAF(3),VFR(3),o[0],0,0,0), C1,8); \
    GAPB(o[1]=__builtin_amdgcn_mfma_f32_32x32x16_bf16(PAF(3),VFR(7),o[1],0,0,0), C1,12); \
    }while(0)
  int t=1;
  #undef CMASK
  #define CMASK(P0,P1,t) do{}while(0)
  for(;t+5<NT;t+=2){
    STEP(pB0,pB1,pA0,pA1,t,true,true,true);     WAIT_BAR(2); RESC(); ROT();
    STEP(pA0,pA1,pB0,pB1,t+1,true,true,true);   WAIT_BAR(2); RESC(); ROT();
  }
  #undef CMASK
  #define CMASK(P0,P1,t) do{int jb_=(t)-(NT-4); if(jb_>=0)cmask(P0,P1,jb_,qrel,hi);}while(0)
  #define ENDW(tt) do{ if((tt)+3<NT){WAIT_BAR(2);} else if((tt)+2<NT){WAIT_BAR(1);} else {WAIT_BAR(0);} }while(0)
  for(;t+1<NT;t+=2){
    STEP(pB0,pB1,pA0,pA1,t,(t+3<NT),(t+1<NT),(t+1<NT));       ENDW(t);   RESC(); ROT();
    STEP(pA0,pA1,pB0,pB1,t+1,(t+4<NT),(t+2<NT),(t+2<NT));     ENDW(t+1); RESC(); ROT();
  }
  STEP(pB0,pB1,pA0,pA1,NT-1,false,false,false); RESC();
  { float sacc=pB0[0]+pB0[1]; _Pragma("unroll") for(int r=2;r<16;++r)sacc+=pB0[r]; _Pragma("unroll") for(int r=0;r<16;++r)sacc+=pB1[r]; l_reg+=sacc;
    pw0=(u32x4){PKW(pB0,0),PKW(pB0,2),PKW(pB0,4),PKW(pB0,6)};pw1=(u32x4){PKW(pB0,8),PKW(pB0,10),PKW(pB0,12),PKW(pB0,14)};pw2=(u32x4){PKW(pB1,0),PKW(pB1,2),PKW(pB1,4),PKW(pB1,6)};pw3=(u32x4){PKW(pB1,8),PKW(pB1,10),PKW(pB1,12),PKW(pB1,14)};
    SBAR(); pv(o,vb0+sl_cur,PAF(0),PAF(1),PAF(2),PAF(3)); }
  #undef PKW
  #undef PAF
  #undef VFR
  #undef PIN
  #undef MX3
  #undef GAPA
  #undef GAPB
  #undef EX
  #undef VRD
  #undef KRD
  #undef STEP
  #undef ENDW
  {auto rr=__builtin_amdgcn_permlane32_swap(__float_as_uint(l_reg),__float_as_uint(l_reg),false,false);l_reg=__uint_as_float(rr[0])+__uint_as_float(rr[1]);}
  if(hi==0)wsf[32+r32]=l_reg;asm volatile("s_waitcnt lgkmcnt(0)":::"memory");
  float rli[16];
  #pragma unroll
  for(int r=0;r<16;++r)rli[r]=__builtin_amdgcn_rcpf(wsf[32+crow(r,hi)]);
  bf16*Ow=O+(rowbase+q0+wid*QBLK)*PO;
  { bf16*stg=(bf16*)(shm+LDS_OST)+wid*2048;
    #pragma unroll
    for(int r=0;r<16;++r){const int orow=crow(r,hi);
      #pragma unroll
      for(int d0=0;d0<2;++d0)stg[orow*64+d0*32+r32]=__float2bfloat16(o[d0][r]*rli[r]);}
    asm volatile("s_waitcnt lgkmcnt(0)":::"memory");
    #pragma unroll
    for(int i=0;i<4;++i){const int row=i*8+(lane>>3),ch=lane&7; const u32x4 v=*(const u32x4*)(stg+row*64+ch*8); ATTN_STORE16(Ow+(long)row*PO+ch*8,v);} }
  asm volatile("s_waitcnt lgkmcnt(0)\n\ts_barrier":::"memory");
  #undef DMA_K
  #undef DMA_V
  #undef CMASK
  #undef START
  #undef RESC
  #undef ROT
}
#undef SBAR
#undef WAIT_BAR
}
namespace cg = cooperative_groups;
#define LAS __attribute__((address_space(3)))
typedef unsigned short bf16;
typedef unsigned v4u __attribute__((ext_vector_type(4)));
typedef unsigned v2u __attribute__((ext_vector_type(2)));
typedef float f32x4 __attribute__((ext_vector_type(4)));
typedef float f32x2 __attribute__((ext_vector_type(2)));
typedef float f32x16 __attribute__((ext_vector_type(16)));
typedef short bf16x8 __attribute__((ext_vector_type(8)));

constexpr int NWAVES = 8;
constexpr int D = 1024, MP = 16384, MS = 256, M = MP + MS, FF = 2816, DIN = 2560;
constexpr float EPS = 1e-6f;
constexpr float C2 = 0.125f * 1.4426950408889634f;
constexpr size_t OFF_Y = 0, OFF_KP = 17039360, OFF_VP = 33816576, OFF_PP = 50593792, OFF_CP = 50655232, OFF_KS = 50663424, OFF_VS = 50925568, OFF_PS = 51187712, OFF_CS = 51249152, OUT_TOTAL = 51257344;
constexpr size_t MiB = 1u << 20;
constexpr size_t WS_ROPE = 1 * MiB, WS_POOLWT = 2 * MiB, WS_W = 4 * MiB, WL = 40 * MiB;
constexpr size_t W_GU1 = 0, W_D1 = 11 * MiB, W_IN = 16 * MiB + MiB / 2, W_OUT = 21 * MiB + MiB / 2, W_GU2 = 23 * MiB + MiB / 2, W_D2 = 34 * MiB + MiB / 2;
constexpr size_t WS_X = 84 * MiB, WS_H = 149 * MiB, WS_MIX = 182 * MiB, WS_ACT = 215 * MiB;
constexpr size_t WS_QB = 215 * MiB, WS_KB = 232 * MiB, WS_VB = 249 * MiB, WS_ZB = 266 * MiB;
constexpr size_t WS_OB = 305 * MiB, WS_OPART = 338 * MiB, WS_ML = 347 * MiB, WS_END = 352 * MiB;
static_assert(WS_ROPE == pg8::WOFF_ROPE && WS_QB == pg8::WOFF_QB && WS_KB == pg8::WOFF_KB && WS_VB == pg8::WOFF_VB && WS_ZB == pg8::WOFF_ZB && OFF_KP == pg8::OOFF_KP && OFF_VP == pg8::OOFF_VP && OFF_PP == pg8::OOFF_PP && OFF_KS == pg8::OOFF_KS && OFF_VS == pg8::OOFF_VS && OFF_PS == pg8::OOFF_PS, "offsets");
static_assert(WS_ACT + (size_t)M * FF * 2 <= WS_OB && WS_ZB + (size_t)M * 1024 * 2 <= WS_OB && WS_X + (size_t)M * D * 4 <= WS_H && WS_H + (size_t)M * D * 2 <= WS_MIX && WS_MIX + (size_t)M * D * 2 <= WS_ACT, "ws map");
static_assert(WS_OB + (size_t)M * 1024 * 2 <= WS_OPART && WS_OPART + (size_t)32 * 2 * 9 * 32 * 128 * 4 <= WS_ML && WS_ML + (size_t)32 * 2 * 9 * 32 * 2 * 4 <= WS_END, "ws map 2");
constexpr int LDS_BYTES = 147456;
constexpr size_t CTL_BYTES = 262144, CTL_CNT = 65536;
constexpr size_t WS_SLOTP = 350 * MiB, WS_SLOTS = 351 * MiB;

__device__ __forceinline__ unsigned pk2(float lo, float hi) { f32x2 v = {lo, hi}; typedef __bf16 b2 __attribute__((ext_vector_type(2))); b2 b = __builtin_convertvector(v, b2); return __builtin_bit_cast(unsigned, b); }
__device__ __forceinline__ float bf2f(unsigned short b) { return __builtin_bit_cast(float, (unsigned)b << 16); }
__device__ __forceinline__ bf16x8 pack8(f32x4 a, f32x4 b) { v4u w; w.x = pk2(a.x, a.y); w.y = pk2(a.z, a.w); w.z = pk2(b.x, b.y); w.w = pk2(b.z, b.w); return __builtin_bit_cast(bf16x8, w); }
__device__ __forceinline__ int crow(int r, int hi) { return (r & 3) + 8 * (r >> 2) + 4 * hi; }
__device__ __forceinline__ void xhalf_pair(float m, float& a, float& b) { a = m; b = m; asm volatile("s_nop 1\n\tv_permlane32_swap_b32 %0, %1\n\ts_nop 1" : "+v"(a), "+v"(b)); }
__device__ __forceinline__ float xhalf_max(float m) { float a, b; xhalf_pair(m, a, b); return fmaxf(a, b); }
__device__ __forceinline__ float xhalf_sum(float m) { float a, b; xhalf_pair(m, a, b); return a + b; }
template <int O> __device__ __forceinline__ float swz_xor(float v) { return __builtin_bit_cast(float, __builtin_amdgcn_ds_swizzle(__builtin_bit_cast(int, v), (O << 10) | 0x1f)); }
__device__ __forceinline__ float wave_sum(float v) {
    v += swz_xor<1>(v); v += swz_xor<2>(v); v += swz_xor<4>(v); v += swz_xor<8>(v); v += swz_xor<16>(v);
    return xhalf_sum(v);
}
#define LDS_WAIT() asm volatile("s_waitcnt lgkmcnt(0)" ::: "memory")

struct Params { const float* in[26]; float* out; unsigned char* ws; };
typedef const __attribute__((address_space(4))) unsigned char* karg_ptr;
__device__ __forceinline__ karg_ptr kargs() { karg_ptr k = (karg_ptr)__builtin_amdgcn_kernarg_segment_ptr(); asm volatile("" : "+s"(k)); return k; }
__device__ __forceinline__ const float* KIN(int i) { return *(const float* const __attribute__((address_space(4)))*)(kargs() + 8 * i); }
__device__ __forceinline__ float* KOUT() { return *(float* const __attribute__((address_space(4)))*)(kargs() + 8 * 26); }
__device__ __forceinline__ unsigned char* KWS() { return *(unsigned char* const __attribute__((address_space(4)))*)(kargs() + 8 * 27); }

template <int MODE> __device__ __forceinline__ int wmap(int nl, int row_off) {
    if (MODE == 0) return row_off + nl;
    if (MODE == 1) return (nl >> 7) * 256 + (nl & 127) + row_off;
    const int u = nl >> 8, lc = nl & 255, A = lc >> 6, n = (lc >> 5) & 1, B = (lc >> 4) & 1, f = lc & 15;
    return u * 256 + 128 * (A >> 1) + 32 * (2 * (A & 1) + B) + 16 * n + f;
}
template <int MODE> __device__ __forceinline__ void transpose_item(const float* W, int K, int N, bf16* WT, int row_off, LAS float* scr, int item, int lane) {
    const int nblk = N / 32, kb = item / nblk, nb = item % nblk, k0 = 64 * kb, n0 = 32 * nb;
#pragma unroll 8
    for (int i = 0; i < 32; ++i) { const int kk = 2 * i + (lane >> 5); scr[kk * 33 + (lane & 31)] = W[(size_t)(k0 + kk) * N + n0 + (lane & 31)]; }
    LDS_WAIT(); asm volatile("" ::: "memory");
    const int c = lane & 7;
#pragma unroll
    for (int j = 0; j < 4; ++j) { const int n = (lane >> 3) + 8 * j; const LAS float* s = scr + (8 * c) * 33 + n;
        v4u o; o.x = pk2(s[0 * 33], s[1 * 33]); o.y = pk2(s[2 * 33], s[3 * 33]); o.z = pk2(s[4 * 33], s[5 * 33]); o.w = pk2(s[6 * 33], s[7 * 33]);
        *(v4u*)(WT + (size_t)wmap<MODE>(n0 + n, row_off) * K + k0 + 8 * c) = o; }
    LDS_WAIT(); asm volatile("" ::: "memory");
}
__device__ __forceinline__ void prologue(LAS unsigned char* lds, int gw, int NGW, int wave, int lane) {
    LAS float* scr = (LAS float*)(lds + wave * 16384);
    constexpr int I_F = 16 * 88, I_IN = 16 * 80, I_OUT = 16 * 32, I_L = 6 * I_F + I_IN + I_OUT;
    for (int it = gw; it < 2 * I_L; it += NGW) {
        const int l = it / I_L; int r = it % I_L;
        unsigned char* wl = KWS() + WS_W + (size_t)l * WL;
        if (r < I_F) { transpose_item<1>(KIN(7) + (size_t)l * D * FF, D, FF, (bf16*)(wl + W_GU1), 0, scr, r, lane); continue; } r -= I_F;
        if (r < I_F) { transpose_item<1>(KIN(8) + (size_t)l * D * FF, D, FF, (bf16*)(wl + W_GU1), 128, scr, r, lane); continue; } r -= I_F;
        if (r < I_F) { transpose_item<0>(KIN(9) + (size_t)l * D * FF, FF, D, (bf16*)(wl + W_D1), 0, scr, r, lane); continue; } r -= I_F;
        if (r < I_IN) { transpose_item<2>(KIN(11) + (size_t)l * D * DIN, D, DIN, (bf16*)(wl + W_IN), 0, scr, r, lane); continue; } r -= I_IN;
        if (r < I_OUT) { transpose_item<0>(KIN(20) + (size_t)l * D * D, D, D, (bf16*)(wl + W_OUT), 0, scr, r, lane); continue; } r -= I_OUT;
        if (r < I_F) { transpose_item<1>(KIN(22) + (size_t)l * D * FF, D, FF, (bf16*)(wl + W_GU2), 0, scr, r, lane); continue; } r -= I_F;
        if (r < I_F) { transpose_item<1>(KIN(23) + (size_t)l * D * FF, D, FF, (bf16*)(wl + W_GU2), 128, scr, r, lane); continue; } r -= I_F;
        transpose_item<0>(KIN(24) + (size_t)l * D * FF, FF, D, (bf16*)(wl + W_D2), 0, scr, r, lane);
    }
    float* rope = (float*)(KWS() + WS_ROPE);
    for (int i = gw * 64 + lane; i < 2080 * 32; i += NGW * 64) {
        const int pr = i >> 5, d = i & 31; const int pos = pr < 2048 ? pr : 4096 + (pr - 2048);
        const float inv = exp2f(-(float)d * (13.287712379549449f / 32.0f));
        const float ang = (float)pos * inv;
        const double rev = (double)ang * 0.15915494309189535; const float fr = (float)(rev - __builtin_rint(rev));
        rope[pr * 64 + d] = __builtin_amdgcn_cosf(fr); rope[pr * 64 + 32 + d] = __builtin_amdgcn_sinf(fr);
    }
    bf16* pwt_ = (bf16*)(KWS() + WS_POOLWT);
    for (int i = gw * 64 + lane; i < 2 * 4 * 64 * 64; i += NGW * 64) {
        const int c = i & 63, e = (i >> 6) & 63, lg = i >> 12;
        pwt_[i] = (bf16)(pk2(KIN(17)[(size_t)lg * 4096 + c * 64 + e], 0.f) & 0xffffu);
    }
}
template <bool FINAL> __device__ __forceinline__ void norm_rows(const float* srcP, const float* srcS, const float* g, bf16* H, float* outf, int gw, int NGW, int lane) {
    const f32x4* g4 = (const f32x4*)g + lane;
    f32x4 gv[4];
#pragma unroll
    for (int j = 0; j < 4; ++j) gv[j] = g4[64 * j];
    for (int m = gw; m < M; m += NGW) {
        const float* xr = (m < MP) ? srcP + (size_t)m * D : srcS + (size_t)(m - MP) * D;
        const f32x4* x4 = (const f32x4*)xr + lane;
        f32x4 v[4]; float s = 0.f;
#pragma unroll
        for (int j = 0; j < 4; ++j) { v[j] = x4[64 * j]; s += (v[j].x * v[j].x + v[j].y * v[j].y) + (v[j].z * v[j].z + v[j].w * v[j].w); }
        const float rstd = 1.0f / sqrtf(wave_sum(s) * (1.0f / D) + EPS);
        if (FINAL) {
            f32x4* o4 = (f32x4*)(outf + (size_t)m * D) + lane;
#pragma unroll
            for (int j = 0; j < 4; ++j) o4[64 * j] = v[j] * rstd * gv[j];
        } else {
            v2u* o2 = (v2u*)(H + (size_t)m * D) + lane;
#pragma unroll
            for (int j = 0; j < 4; ++j) { const f32x4 y = v[j] * rstd * gv[j]; v2u w; w.x = pk2(y.x, y.y); w.y = pk2(y.z, y.w); o2[64 * j] = w; }
        }
    }
}
__device__ __forceinline__ f32x16 mfma32(bf16x8 a, bf16x8 b, f32x16 c) { return __builtin_amdgcn_mfma_f32_32x32x16_bf16(a, b, c, 0, 0, 0); }


template <bool BASE16> __device__ __forceinline__ void skinny_gemm(LAS unsigned char* lds, const bf16* A, const bf16* Bt, int K, const void* base, bf16* out, float scale, bf16* hb, float* yout, const float* gain,
                                            unsigned* slots, unsigned* cnt8, int vcu, int G, int tid) {
    const int lane = tid & 63, r32 = lane & 31, hi = lane >> 5, wid = __builtin_amdgcn_readfirstlane(tid >> 6);
    LAS float* R = (LAS float*)lds;
    __syncthreads();
    for (int tile = vcu; tile < 256; tile += G) {
        const int rt = tile >> 5, ct = tile & 31, kw = K >> 3, k0 = wid * kw;
        const bf16* ap = A + (size_t)(rt * 32 + r32) * K + k0 + hi * 8; const bf16* bp = Bt + (size_t)(ct * 32 + r32) * K + k0 + hi * 8;
        f32x16 acc;
#pragma unroll
        for (int r = 0; r < 16; ++r) acc[r] = 0.f;
#pragma unroll 4
        for (int ks = 0; ks < kw; ks += 16) { const bf16x8 a = *(const bf16x8*)(ap + ks), b = *(const bf16x8*)(bp + ks); acc = mfma32(a, b, acc); }
#pragma unroll
        for (int r = 0; r < 16; ++r) R[(wid * 32 + crow(r, hi)) * 32 + r32] = acc[r];
        __syncthreads();
        const int e = tid * 2, row = e >> 5, col = e & 31; f32x2 s = {0.f, 0.f};
#pragma unroll
        for (int w = 0; w < 8; ++w) s += *(const LAS f32x2*)(R + (w * 32 + row) * 32 + col);
        const size_t o = (size_t)(rt * 32 + row) * 1024 + ct * 32 + col; f32x2 bv; if (BASE16) { const unsigned bw = *(const unsigned*)((const bf16*)base + o); bv.x = bf2f(bw & 0xffff); bv.y = bf2f(bw >> 16); } else bv = *(const f32x2*)((const float*)base + o);
        const f32x2 v = bv + s * scale;
        if (out) *(unsigned*)(out + o) = pk2(v.x, v.y);
        float ss = v.x * v.x + v.y * v.y; ss += swz_xor<1>(ss); ss += swz_xor<2>(ss); ss += swz_xor<4>(ss); ss += swz_xor<8>(ss);
        if ((tid & 15) == 0) __hip_atomic_store(slots + (size_t)(rt * 32 + row) * 32 + ct, __builtin_bit_cast(unsigned, ss), __ATOMIC_RELAXED, __HIP_MEMORY_SCOPE_AGENT);
        asm volatile("s_waitcnt vmcnt(0)" ::: "memory");
        __syncthreads();
        if (tid == 0) {
            __hip_atomic_fetch_add(cnt8 + 64 * rt, 1u, __ATOMIC_RELAXED, __HIP_MEMORY_SCOPE_AGENT);
            unsigned spins = 0;
            while (__hip_atomic_load(cnt8 + 64 * rt, __ATOMIC_RELAXED, __HIP_MEMORY_SCOPE_AGENT) < 32u) { __builtin_amdgcn_s_sleep(2); if (++spins > (1u << 22)) break; }
            __builtin_amdgcn_fence(__ATOMIC_ACQUIRE, "agent");
            asm volatile("s_waitcnt vmcnt(0)" ::: "memory");
        }
        __syncthreads();
        { const unsigned* sl = slots + (size_t)(rt * 32 + row) * 32 + (tid & 15) * 2;
          float tot = __builtin_bit_cast(float, __hip_atomic_load(sl, __ATOMIC_RELAXED, __HIP_MEMORY_SCOPE_AGENT)) + __builtin_bit_cast(float, __hip_atomic_load(sl + 1, __ATOMIC_RELAXED, __HIP_MEMORY_SCOPE_AGENT));
          tot += swz_xor<1>(tot); tot += swz_xor<2>(tot); tot += swz_xor<4>(tot); tot += swz_xor<8>(tot);
          const float r = 1.0f / sqrtf(tot * (1.0f / 1024.0f) + EPS);
          const f32x2 gv = *(const f32x2*)(gain + ct * 32 + col); const f32x2 y = v * r * gv;
          if (hb) *(unsigned*)(hb + o) = pk2(y.x, y.y); else *(f32x2*)(yout + o) = y; }
        __syncthreads();
    }
}

__device__ __forceinline__ void sample_piece(LAS unsigned char* lds, int pc, int l, const bf16* Qb, const float* cache_k, const float* cache_v, const float* knew, const float* vnew, float* OPART, float* MLP, int tid) {
    const int lane = tid & 63, r32 = lane & 31, hi = lane >> 5, wid = __builtin_amdgcn_readfirstlane(tid >> 6);
    const int b = pc >> 5, h = (pc >> 3) & 3, s = pc & 7;
    const bf16* qrow = Qb + (size_t)(MP + b * 32 + r32) * 512 + h * 128 + hi * 8;
    LAS float* ML = (LAS float*)lds;
    LAS float* FAC = (LAS float*)(lds + 4096);
    LAS float* OX = (LAS float*)(lds + 8192);
    const bool extra = (s == 7) && (wid == 7);
    const size_t off = ((size_t)((l * 8 + b) * 4096 + (s * 8 + wid) * 64)) * 512 + h * 128;
    const size_t offx = ((size_t)(l * 8 + b) * 32) * 512 + h * 128;
    const float* Kt = cache_k + off; const float* Vt = cache_v + off; const float* Kx = knew + offx; const float* Vx = vnew + offx;
    float mrow[2], lrow[2]; bf16x8 pw[2][6];
#pragma unroll
    for (int c = 0; c < 2; ++c) {
        bf16x8 qf[4];
#pragma unroll
        for (int d0 = 0; d0 < 4; ++d0) qf[d0] = *(const bf16x8*)(qrow + c * 64 + d0 * 16);
        f32x16 sc[3];
#pragma unroll
        for (int kvb = 0; kvb < 3; ++kvb) {
            if (kvb < 2 || extra) {
                f32x16 a;
#pragma unroll
                for (int r = 0; r < 16; ++r) a[r] = 0.f;
                const float* kp = (kvb < 2 ? Kt + (size_t)(kvb * 32 + r32) * 512 : Kx + (size_t)r32 * 512) + c * 64 + hi * 8;
#pragma unroll
                for (int d0 = 0; d0 < 4; ++d0) { const f32x4 x0 = *(const f32x4*)(kp + d0 * 16), x1 = *(const f32x4*)(kp + d0 * 16 + 4); a = mfma32(pack8(x0, x1), qf[d0], a); }
                sc[kvb] = a;
            } else {
#pragma unroll
                for (int r = 0; r < 16; ++r) sc[kvb][r] = -1e30f;
            }
        }
        float mx = -1e30f;
#pragma unroll
        for (int r = 0; r < 16; ++r) mx = fmaxf(mx, fmaxf(fmaxf(sc[0][r], sc[1][r]), sc[2][r]));
        mx = xhalf_max(mx);
        float sum = 0.f;
#pragma unroll
        for (int kvb = 0; kvb < 3; ++kvb)
#pragma unroll
            for (int r = 0; r < 16; ++r) { const float pv = __builtin_amdgcn_exp2f(sc[kvb][r] - mx); sc[kvb][r] = pv; sum += pv; }
        sum = xhalf_sum(sum);
        mrow[c] = mx; lrow[c] = sum;
#pragma unroll
        for (int kvb = 0; kvb < 3; ++kvb)
#pragma unroll
            for (int hf = 0; hf < 2; ++hf) { v4u w; w.x = pk2(sc[kvb][8 * hf + 0], sc[kvb][8 * hf + 1]); w.y = pk2(sc[kvb][8 * hf + 2], sc[kvb][8 * hf + 3]);
                w.z = pk2(sc[kvb][8 * hf + 4], sc[kvb][8 * hf + 5]); w.w = pk2(sc[kvb][8 * hf + 6], sc[kvb][8 * hf + 7]); pw[c][2 * kvb + hf] = __builtin_bit_cast(bf16x8, w); }
    }
    asm volatile("" ::: "memory");
    f32x16 o[2][4];
#pragma unroll
    for (int c = 0; c < 2; ++c)
#pragma unroll
        for (int eb = 0; eb < 4; ++eb)
#pragma unroll
            for (int r = 0; r < 16; ++r) o[c][eb][r] = 0.f;
#pragma unroll
    for (int ks = 0; ks < 6; ++ks) {
        if (ks < 4 || extra) {
#pragma unroll
            for (int eb = 0; eb < 4; ++eb) {
                const float* vp = (ks < 4 ? Vt + (size_t)(ks * 16 + 4 * hi) * 512 : Vx + (size_t)((ks - 4) * 16 + 4 * hi) * 512) + eb * 32 + r32;
                f32x4 x0, x1;
                x0.x = vp[0 * 512]; x0.y = vp[1 * 512]; x0.z = vp[2 * 512]; x0.w = vp[3 * 512];
                x1.x = vp[8 * 512]; x1.y = vp[9 * 512]; x1.z = vp[10 * 512]; x1.w = vp[11 * 512];
                const bf16x8 vf = pack8(x0, x1);
                o[0][eb] = mfma32(pw[0][ks], vf, o[0][eb]); o[1][eb] = mfma32(pw[1][ks], vf, o[1][eb]);
            }
        }
    }
    if (hi == 0) {
#pragma unroll
        for (int c = 0; c < 2; ++c) { ML[((wid * 2 + c) * 32 + r32) * 2 + 0] = mrow[c]; ML[((wid * 2 + c) * 32 + r32) * 2 + 1] = lrow[c]; }
    }
    __syncthreads();
    const int pidx = s;
    if (tid < 64) {
        const int c = tid >> 5, q = tid & 31; float mw[8], lw[8]; float Mx = -1e30f;
#pragma unroll
        for (int w = 0; w < 8; ++w) { mw[w] = ML[((w * 2 + c) * 32 + q) * 2 + 0]; lw[w] = ML[((w * 2 + c) * 32 + q) * 2 + 1]; Mx = fmaxf(Mx, mw[w]); }
        float L = 0.f;
#pragma unroll
        for (int w = 0; w < 8; ++w) { const float fz = __builtin_amdgcn_exp2f(mw[w] - Mx); FAC[(w * 2 + c) * 32 + q] = fz; L += lw[w] * fz; }
        float* mp = MLP + ((size_t)((((b * 4 + h) * 2 + c) * 9 + pidx) * 32 + q)) * 2; mp[0] = Mx; mp[1] = L;
    }
    __syncthreads();
#pragma unroll
    for (int c = 0; c < 2; ++c) {
#pragma unroll
        for (int eb = 0; eb < 4; ++eb)
#pragma unroll
            for (int r = 0; r < 16; ++r) { const int q = crow(r, hi); OX[(wid * 32 + q) * 128 + eb * 32 + r32] = o[c][eb][r] * FAC[(wid * 2 + c) * 32 + q]; }
        __syncthreads();
        { const int idx = tid * 8, q = idx >> 7, e = idx & 127; f32x4 s0 = {0.f, 0.f, 0.f, 0.f}, s1 = {0.f, 0.f, 0.f, 0.f};
#pragma unroll
          for (int w = 0; w < 8; ++w) { s0 += *(const LAS f32x4*)(OX + (w * 32 + q) * 128 + e); s1 += *(const LAS f32x4*)(OX + (w * 32 + q) * 128 + e + 4); }
          float* dst = OPART + ((size_t)((((b * 4 + h) * 2 + c) * 9 + pidx) * 32 + q)) * 128 + e; *(f32x4*)dst = s0; *(f32x4*)(dst + 4) = s1; }
        __syncthreads();
    }
}

template <int W> __device__ __forceinline__ void pool_d(const LAS float* U, LAS bf16* Dd, int ch, int tbeg, int t0, bool smp) {
    float s = 0.f;
#pragma unroll
    for (int i = 0; i < W; ++i) s += U[(15 + tbeg - i) * 256 + ch];
#pragma unroll 8
    for (int k = 0; k < 32; ++k) {
        const int tt = tbeg + k; const float cur = U[(15 + tt) * 256 + ch];
        if (k > 0) s += cur - U[(15 + tt - W) * 256 + ch];
        const int pos = smp ? 4096 + tt : t0 + tt; const int cnt = (pos + 1 < W) ? pos + 1 : W;
        const float d = s * __builtin_amdgcn_rcpf((float)cnt) - cur;
        Dd[tt * 264 + ch] = (bf16)(pk2(d, 0.f) & 0xffffu);
    }
}
__device__ __forceinline__ f32x4 bf4_to_f32(v2u w) { f32x4 v; v.x = bf2f(w.x & 0xffff); v.y = bf2f(w.x >> 16); v.z = bf2f(w.y & 0xffff); v.w = bf2f(w.y >> 16); return v; }
__device__ __forceinline__ void poolconv_tile(LAS unsigned char* lds, int tl, int l, const bf16* Zb, bf16* MIX, const float* state_pool, const float* state_conv, const bf16* pwt, const float* pool_scale,
                                              const float* conv_w, float* out_cp, float* out_cs, int tid) {
    const int lane = tid & 63, r32 = lane & 31, hi = lane >> 5, wid = __builtin_amdgcn_readfirstlane(tid >> 6);
    int b, t0, TT, rowbase; bool smp;
    if (tl < 256) { b = tl >> 5; t0 = (tl & 31) * 64; TT = 64; rowbase = b * 2048 + t0; smp = false; }
    else { b = tl - 256; t0 = 0; TT = 32; rowbase = MP + b * 32; smp = true; }
    LAS float* U = (LAS float*)lds;
    LAS bf16* Dd = (LAS bf16*)(lds + 81920);
    {
        f32x4 uv[10];
#pragma unroll
        for (int k = 0; k < 10; ++k) {
            const int idx = tid + 512 * k, i = idx >> 6, c4 = (idx & 63) * 4; f32x4 v = {0.f, 0.f, 0.f, 0.f};
            if (i < 15 + TT) {
                if (i < 15 && smp) v = *(const f32x4*)(state_pool + (size_t)((l * 8 + b) * 15 + i) * 256 + c4);
                else if (i >= 15 || t0 - 15 + i >= 0) v = bf4_to_f32(*(const v2u*)(Zb + (size_t)(rowbase + i - 15) * 1024 + c4));
            }
            uv[k] = v;
        }
#pragma unroll
        for (int k = 0; k < 10; ++k) { const int idx = tid + 512 * k, i = idx >> 6, c4 = (idx & 63) * 4; if (i < 15 + TT) *(LAS f32x4*)(U + i * 256 + c4) = uv[k]; }
    }
    __syncthreads();
    {
        const int ch = tid & 255, th = tid >> 8, gi = __builtin_amdgcn_readfirstlane(ch >> 6);
        if (th * 32 < TT) {
            if (gi == 0) pool_d<2>(U, Dd, ch, th * 32, t0, smp); else if (gi == 1) pool_d<4>(U, Dd, ch, th * 32, t0, smp);
            else if (gi == 2) pool_d<8>(U, Dd, ch, th * 32, t0, smp); else pool_d<16>(U, Dd, ch, th * 32, t0, smp);
        }
    }
    __syncthreads();
    {
        const int gi = wid >> 1, th = wid & 1;
        if (th * 32 < TT) {
            f32x16 acc0, acc1;
#pragma unroll
            for (int r = 0; r < 16; ++r) { acc0[r] = 0.f; acc1[r] = 0.f; }
#pragma unroll
            for (int ks = 0; ks < 4; ++ks) {
                const bf16x8 a = *(const LAS bf16x8*)(Dd + (th * 32 + r32) * 264 + gi * 64 + ks * 16 + hi * 8);
                const bf16x8 b0 = *(const bf16x8*)(pwt + (size_t)((l * 4 + gi) * 64 + r32) * 64 + ks * 16 + hi * 8);
                const bf16x8 b1 = *(const bf16x8*)(pwt + (size_t)((l * 4 + gi) * 64 + 32 + r32) * 64 + ks * 16 + hi * 8);
                acc0 = mfma32(a, b0, acc0); acc1 = mfma32(a, b1, acc1);
            }
            const float sc0 = pool_scale[l * 256 + gi * 64 + r32], sc1 = pool_scale[l * 256 + gi * 64 + 32 + r32];
#pragma unroll
            for (int r = 0; r < 16; ++r) { const int tok = th * 32 + crow(r, hi); bf16* mp = MIX + (size_t)(rowbase + tok) * 1024 + 512 + gi * 64 + r32;
                mp[0] = (bf16)(pk2(acc0[r] * sc0, 0.f) & 0xffffu); mp[32] = (bf16)(pk2(acc1[r] * sc1, 0.f) & 0xffffu); }
        }
    }
    if (wid * 8 < TT) {
        const int cq = lane, tc = wid * 8;
        v2u hraw[10], graw[10], braw[8]; f32x4 hst[2];
        hst[0] = (f32x4){0.f, 0.f, 0.f, 0.f}; hst[1] = hst[0];
#pragma unroll
        for (int i = 0; i < 10; ++i) {
            const int ts = tc - 2 + i; hraw[i] = (v2u){0u, 0u}; graw[i] = (v2u){0u, 0u};
            if (ts >= 0 || (!smp && t0 + ts >= 0)) { const bf16* zr = Zb + (size_t)(rowbase + ts) * 1024 + 4 * cq; hraw[i] = *(const v2u*)(zr + 256); graw[i] = *(const v2u*)(zr + 768); }
        }
#pragma unroll
        for (int i = 0; i < 8; ++i) braw[i] = *(const v2u*)(Zb + (size_t)(rowbase + tc + i) * 1024 + 512 + 4 * cq);
        if (smp && tc == 0) { hst[0] = *(const f32x4*)(state_conv + (size_t)((l * 8 + b) * 2 + 0) * 256 + 4 * cq); hst[1] = *(const f32x4*)(state_conv + (size_t)((l * 8 + b) * 2 + 1) * 256 + 4 * cq); }
        const f32x4 cw0 = *(const f32x4*)(conv_w + l * 768 + 4 * cq), cw1 = *(const f32x4*)(conv_w + l * 768 + 256 + 4 * cq), cw2 = *(const f32x4*)(conv_w + l * 768 + 512 + 4 * cq);
        f32x4 cm2 = bf4_to_f32(graw[0]) * bf4_to_f32(hraw[0]), cm1 = bf4_to_f32(graw[1]) * bf4_to_f32(hraw[1]);
        if (smp && tc == 0) { cm2 = hst[0]; cm1 = hst[1]; }
#pragma unroll
        for (int i = 0; i < 8; ++i) {
            const int tt = tc + i;
            const f32x4 cv = bf4_to_f32(graw[i + 2]) * bf4_to_f32(hraw[i + 2]);
            const f32x4 y = bf4_to_f32(braw[i]) * (cw0 * cm2 + cw1 * cm1 + cw2 * cv);
            v2u w; w.x = pk2(y.x, y.y); w.y = pk2(y.z, y.w);
            *(v2u*)(MIX + (size_t)(rowbase + tt) * 1024 + 768 + 4 * cq) = w;
            if (smp) { if (tt >= 30) *(f32x4*)(out_cs + (size_t)((l * 8 + b) * 2 + tt - 30) * 256 + 4 * cq) = cv; }
            else if (t0 + tt >= 2046) *(f32x4*)(out_cp + (size_t)((l * 8 + b) * 2 + t0 + tt - 2046) * 256 + 4 * cq) = cv;
            cm2 = cm1; cm1 = cv;
        }
    }
    __syncthreads();
}

__device__ __forceinline__ void combine_phase(int l, const bf16* Ob_, const float* OPART_, const float* MLP_, bf16* MIX_, int gw, int NGW, int lane) {
    const float lam_init = (l == 0) ? 0.2f : 0.35550934f;
    float lam;
    { const float a = KIN(12)[l * 64 + lane] * KIN(13)[l * 64 + lane], c = KIN(14)[l * 64 + lane] * KIN(15)[l * 64 + lane];
      lam = __expf(wave_sum(a)) - __expf(wave_sum(c)) + lam_init; }
    const float g0 = KIN(16)[l * 128 + 2 * lane], g1 = KIN(16)[l * 128 + 2 * lane + 1];
    for (int base = gw * 8; base < MP * 4; base += NGW * 8) {
        float a0[8], a1[8];
        {
            unsigned w1[8], w2[8];
#pragma unroll
            for (int j = 0; j < 8; ++j) { const int wt = base + j, row = wt >> 2, h = wt & 3;
                w1[j] = *(const unsigned*)(Ob_ + (size_t)row * 1024 + h * 128 + 2 * lane); w2[j] = *(const unsigned*)(Ob_ + (size_t)row * 1024 + 512 + h * 128 + 2 * lane); }
#pragma unroll
            for (int j = 0; j < 8; ++j) { a0[j] = bf2f(w1[j] & 0xffff) - lam * bf2f(w2[j] & 0xffff); a1[j] = bf2f(w1[j] >> 16) - lam * bf2f(w2[j] >> 16); }
        }
        float ss[8];
#pragma unroll
        for (int j = 0; j < 8; ++j) ss[j] = a0[j] * a0[j] + a1[j] * a1[j];
#pragma unroll
        for (int j = 0; j < 8; ++j) ss[j] += swz_xor<1>(ss[j]);
#pragma unroll
        for (int j = 0; j < 8; ++j) ss[j] += swz_xor<2>(ss[j]);
#pragma unroll
        for (int j = 0; j < 8; ++j) ss[j] += swz_xor<4>(ss[j]);
#pragma unroll
        for (int j = 0; j < 8; ++j) ss[j] += swz_xor<8>(ss[j]);
#pragma unroll
        for (int j = 0; j < 8; ++j) ss[j] += swz_xor<16>(ss[j]);
#pragma unroll
        for (int j = 0; j < 8; ++j) { const int wt = base + j, row = wt >> 2, h = wt & 3;
            const float tot = xhalf_sum(ss[j]);
            const float r = (1.0f / sqrtf(tot * (1.0f / 128.0f) + EPS)) * (1.0f - lam_init);
            *(unsigned*)(MIX_ + (size_t)row * 1024 + h * 128 + 2 * lane) = pk2(a0[j] * r * g0, a1[j] * r * g1); }
    }
    for (int wt = MP * 4 + gw; wt < M * 4; wt += NGW) {
        const int row = wt >> 2, h = wt & 3, rs = row - MP, b = rs >> 5, q = rs & 31; float oc[2][2];
#pragma unroll
        for (int c = 0; c < 2; ++c) {
            const size_t pb = (size_t)(((b * 4 + h) * 2 + c) * 9);
            float mw[8], lw[8]; f32x2 ov[8]; float Mx = -1e30f;
#pragma unroll
            for (int pi = 0; pi < 8; ++pi) { const f32x2 ml = *(const f32x2*)(MLP_ + ((pb + pi) * 32 + q) * 2); mw[pi] = ml.x; lw[pi] = ml.y; ov[pi] = *(const f32x2*)(OPART_ + ((pb + pi) * 32 + q) * 128 + 2 * lane); }
#pragma unroll
            for (int pi = 0; pi < 8; ++pi) Mx = fmaxf(Mx, mw[pi]);
            float L = 0.f, s0 = 0.f, s1 = 0.f;
#pragma unroll
            for (int pi = 0; pi < 8; ++pi) { const float fz = __builtin_amdgcn_exp2f(mw[pi] - Mx); L += lw[pi] * fz; s0 += ov[pi].x * fz; s1 += ov[pi].y * fz; }
            const float il = 1.0f / L; oc[c][0] = s0 * il; oc[c][1] = s1 * il;
        }
        const float a0 = oc[0][0] - lam * oc[1][0], a1 = oc[0][1] - lam * oc[1][1];
        const float tot = wave_sum(a0 * a0 + a1 * a1);
        const float r = (1.0f / sqrtf(tot * (1.0f / 128.0f) + EPS)) * (1.0f - lam_init);
        *(unsigned*)(MIX_ + (size_t)row * 1024 + h * 128 + 2 * lane) = pk2(a0 * r * g0, a1 * r * g1);
    }
}

#ifndef PROBE_SLOW_ATTN
#define PROBE_SLOW_ATTN 0
#endif
#if PROBE_SLOW_ATTN
__device__ __forceinline__ void slow_attn_phase(int l, const bf16* Qb_, float* outp, const float* cache_k, const float* cache_v, bf16* MIX_, int gw, int NGW, int lane) {
    const float lam_init = (l == 0) ? 0.2f : 0.35550934f;
    float lam;
    { const float a = KIN(12)[l * 64 + lane] * KIN(13)[l * 64 + lane], c = KIN(14)[l * 64 + lane] * KIN(15)[l * 64 + lane];
      lam = __expf(wave_sum(a)) - __expf(wave_sum(c)) + lam_init; }
    const float g0 = KIN(16)[l * 128 + 2 * lane], g1 = KIN(16)[l * 128 + 2 * lane + 1];
    for (int wt = gw; wt < M * 4; wt += NGW) {
        const int row = wt >> 2, h = wt & 3;
        const float *K0, *V0, *K1, *V1; int n0, n1;
        if (row < MP) { const int b = row >> 11, t = row & 2047; K0 = outp + OFF_KP + ((size_t)l * MP + (size_t)b * 2048) * 512 + h * 128; V0 = outp + OFF_VP + ((size_t)l * MP + (size_t)b * 2048) * 512 + h * 128; n0 = ((t >> 6) + 1) * 64; K1 = K0; V1 = V0; n1 = 0; }
        else { const int rs = row - MP, b = rs >> 5; K0 = cache_k + ((size_t)(l * 8 + b) * 4096) * 512 + h * 128; V0 = cache_v + ((size_t)(l * 8 + b) * 4096) * 512 + h * 128; n0 = 4096;
               K1 = outp + OFF_KS + ((size_t)(l * 8 + b) * 32) * 512 + h * 128; V1 = outp + OFF_VS + ((size_t)(l * 8 + b) * 32) * 512 + h * 128; n1 = 32; }
        float oc[2][2];
#pragma unroll 1
        for (int c = 0; c < 2; ++c) {
            float q[64];
#pragma unroll
            for (int d = 0; d < 64; ++d) q[d] = bf2f(Qb_[(size_t)row * 512 + h * 128 + c * 64 + d]);
            float mx = -1e30f;
            for (int seg = 0; seg < 2; ++seg) { const float* Kp = seg ? K1 : K0; const int n = seg ? n1 : n0;
                for (int j0 = 0; j0 < n; j0 += 64) { const int j = j0 + lane; float s = -1e30f;
                    if (j < n) { const float* kr = Kp + (size_t)j * 512 + c * 64; s = 0.f;
#pragma unroll
                        for (int d = 0; d < 64; ++d) s += q[d] * kr[d]; }
                    mx = fmaxf(mx, s); } }
            mx = fmaxf(mx, swz_xor<1>(mx)); mx = fmaxf(mx, swz_xor<2>(mx)); mx = fmaxf(mx, swz_xor<4>(mx)); mx = fmaxf(mx, swz_xor<8>(mx)); mx = fmaxf(mx, swz_xor<16>(mx)); mx = xhalf_max(mx);
            float L = 0.f, o0 = 0.f, o1 = 0.f;
            for (int seg = 0; seg < 2; ++seg) { const float* Kp = seg ? K1 : K0; const float* Vp = seg ? V1 : V0; const int n = seg ? n1 : n0;
                for (int j0 = 0; j0 < n; j0 += 64) { const int j = j0 + lane; float pj = 0.f;
                    if (j < n) { const float* kr = Kp + (size_t)j * 512 + c * 64; float s = 0.f;
#pragma unroll
                        for (int d = 0; d < 64; ++d) s += q[d] * kr[d];
                        pj = __builtin_amdgcn_exp2f(s - mx); }
                    L += pj;
                    const int nn = (n - j0 < 64) ? n - j0 : 64;
                    for (int jj = 0; jj < nn; ++jj) { const float pb = __builtin_bit_cast(float, __builtin_amdgcn_readlane(__builtin_bit_cast(int, pj), jj));
                        const f32x2 vv = *(const f32x2*)(Vp + (size_t)(j0 + jj) * 512 + 2 * lane); o0 += pb * vv.x; o1 += pb * vv.y; } } }
            L = wave_sum(L);
            oc[c][0] = o0 / L; oc[c][1] = o1 / L;
        }
        const float a0 = oc[0][0] - lam * oc[1][0], a1 = oc[0][1] - lam * oc[1][1];
        const float ss = wave_sum(a0 * a0 + a1 * a1);
        const float r = (1.0f / sqrtf(ss * (1.0f / 128.0f) + EPS)) * (1.0f - lam_init);
        *(unsigned*)(MIX_ + (size_t)row * 1024 + h * 128 + 2 * lane) = pk2(a0 * r * g0, a1 * r * g1);
    }
}
#endif

#ifndef PROBE_SLOW_PC
#define PROBE_SLOW_PC 0
#endif
#if PROBE_SLOW_PC
__device__ __forceinline__ float zval(const bf16* Zb_, const float* st, int l, int b, bool smp, int rowbase, int t, int col, int hist) {
    if (t >= 0) return bf2f(Zb_[(size_t)(rowbase + t) * 1024 + col]);
    if (!smp) return 0.f;
    return st[(size_t)((l * 8 + b) * hist + (hist + t)) * 256 + (col & 255)];
}
__device__ __forceinline__ void slow_pc_phase(int l, const bf16* Zb_, bf16* MIX_, int gw, int NGW, int lane) {
    const float* sp = KIN(4); const float* scv = KIN(5); const float* pw = KIN(17); const float* psc = KIN(18); const float* cw = KIN(19);
    for (int wt = gw; wt < M * 4; wt += NGW) {
        const int row = wt >> 2, g = wt & 3; const bool smp = row >= MP;
        int b, t, rowbase; if (smp) { const int rs = row - MP; b = rs >> 5; t = rs & 31; rowbase = MP + b * 32; } else { b = row >> 11; t = row & 2047; rowbase = b * 2048; }
        const int w = 2 << g, ch = g * 64 + lane;
        float s = 0.f;
        for (int i = 0; i < w; ++i) { const int tt = t - i; s += zval(Zb_, sp, l, b, smp, rowbase, tt, ch, 15); }
        const int pos = smp ? 4096 + t : t; const int cnt = (pos + 1 < w) ? pos + 1 : w;
        const float d = s / (float)cnt - zval(Zb_, sp, l, b, smp, rowbase, t, ch, 15);
        float mine = 0.f;
        for (int e = 0; e < 64; ++e) { const float v = wave_sum(d * pw[(size_t)((l * 4 + g) * 64 + lane) * 64 + e]); if (e == lane) mine = v; }
        MIX_[(size_t)row * 1024 + 512 + ch] = (bf16)(pk2(mine * psc[l * 256 + ch], 0.f) & 0xffffu);
        float cvv[3];
#pragma unroll
        for (int k = 0; k < 3; ++k) { const int tt = t - 2 + k;
            if (tt >= 0) cvv[k] = bf2f(Zb_[(size_t)(rowbase + tt) * 1024 + 768 + ch]) * bf2f(Zb_[(size_t)(rowbase + tt) * 1024 + 256 + ch]);
            else cvv[k] = smp ? scv[(size_t)((l * 8 + b) * 2 + (2 + tt)) * 256 + ch] : 0.f; }
        const float bgv = bf2f(Zb_[(size_t)row * 1024 + 512 + ch]);
        const float y = bgv * (cw[l * 768 + ch] * cvv[0] + cw[l * 768 + 256 + ch] * cvv[1] + cw[l * 768 + 512 + ch] * cvv[2]);
        MIX_[(size_t)row * 1024 + 768 + ch] = (bf16)(pk2(y, 0.f) & 0xffffu);
    }
}
#endif

#define XB_TMO      128
#define XB_XCNT(j)  (256  + 64 * (j))
#define XB_XSUB(j)  (1280 + 64 * (j))
#define XB_XGEN(j)  (2304 + 64 * (j))
#define XB_TOP      3328
#define XB_TOPGEN   3392
#define XCD_BAR_WORDS 3456
#define XB_SPIN_CAP (1u << 18)
__device__ __forceinline__ unsigned xb_ld(unsigned* p)              { return __hip_atomic_load(p, __ATOMIC_RELAXED, __HIP_MEMORY_SCOPE_AGENT); }
__device__ __forceinline__ unsigned xb_add(unsigned* p, unsigned v) { return __hip_atomic_fetch_add(p, v, __ATOMIC_RELAXED, __HIP_MEMORY_SCOPE_AGENT); }
__device__ __forceinline__ unsigned xb_xcc_id() { return (unsigned)__builtin_amdgcn_s_getreg((3 << 11) | 20) & 0xFu; }
#define XB_SPIN(cond, bar) do { unsigned _sp = 0; while (cond) { __builtin_amdgcn_s_sleep(1); \
    if ((++_sp & 255u) == 0u) { if (xb_ld(&(bar)[XB_TMO])) break; if (_sp > XB_SPIN_CAP) { atomicAdd(&(bar)[XB_TMO], 1u); break; } } } } while (0)
__device__ __forceinline__ void xcd_barrier_complete(unsigned* bar, unsigned x, unsigned& nloc, unsigned& nx) {
    const unsigned G = gridDim.x * gridDim.y * gridDim.z;
    unsigned sum, cnt, mine, sp = 0u;
    for (;;) {
        sum = 0u; cnt = 0u; mine = 0u;
#pragma unroll
        for (unsigned j = 0; j < 16; ++j) { const unsigned c = xb_ld(&bar[XB_XCNT(j)]); sum += c; cnt += (c > 0u) ? 1u : 0u; mine = (j == x) ? c : mine; }
        if (sum == G) break;
        __builtin_amdgcn_s_sleep(1);
        if ((++sp & 255u) == 0u) { if (xb_ld(&bar[XB_TMO])) break; if (sp > XB_SPIN_CAP) { atomicAdd(&bar[XB_TMO], 1u); break; } }
    }
    nloc = mine > 0u ? mine : 1u; nx = cnt > 0u ? cnt : 1u;
}
__device__ __forceinline__ void xcd_barrier(unsigned* bar, unsigned x, volatile LAS unsigned* st) {
    asm volatile("s_waitcnt vmcnt(0)" ::: "memory");
    __syncthreads();
    if (threadIdx.x == 0) {
        __builtin_amdgcn_s_waitcnt(0);
        unsigned nloc = st[0], nx = st[1];
        if (nloc == 0u) { xcd_barrier_complete(bar, x, nloc, nx); st[0] = nloc; st[1] = nx; }
        const unsigned old = xb_add(&bar[XB_XSUB(x)], 1u);
        const unsigned gen = old / nloc;
        if (old + 1u == (gen + 1u) * nloc) {
            __builtin_amdgcn_fence(__ATOMIC_RELEASE, "agent");
            asm volatile("s_waitcnt vmcnt(0)" ::: "memory");
            const unsigned og = xb_add(&bar[XB_TOP], 1u);
            const unsigned tg = og / nx;
            if (og + 1u == (tg + 1u) * nx) xb_add(&bar[XB_TOPGEN], 1u);
            else XB_SPIN(xb_ld(&bar[XB_TOPGEN]) == tg, bar);
            __builtin_amdgcn_fence(__ATOMIC_ACQUIRE, "agent");
            xb_add(&bar[XB_XGEN(x)], 1u);
            asm volatile("s_waitcnt vmcnt(0)" ::: "memory");
        } else {
            XB_SPIN(xb_ld(&bar[XB_XGEN(x)]) == gen, bar);
            __builtin_amdgcn_fence(__ATOMIC_ACQUIRE, "agent");
            asm volatile("s_waitcnt vmcnt(0)" ::: "memory");
        }
    }
    __syncthreads();
}
#define CG_SYNC() do { asm volatile("s_waitcnt vmcnt(0) lgkmcnt(0)" ::: "memory"); grid.sync(); asm volatile("" ::: "memory"); } while (0)
#define GRID_SYNC() xcd_barrier((unsigned*)KWS() + 4096, xcc, (volatile LAS unsigned*)(lds + LDS_BYTES - 64))
__global__ void __launch_bounds__(NWAVES * 64, 2) mega_fwd(Params p) {
    extern __shared__ __attribute__((aligned(16))) unsigned char lds_raw[];
    LAS unsigned char* lds = (LAS unsigned char*)lds_raw;
    cg::grid_group grid = cg::this_grid();
    const int tid = threadIdx.x, lane = tid & 63, wave = __builtin_amdgcn_readfirstlane(tid >> 6);
    const int G = gridDim.x; const int bx = blockIdx.x; const int vcu0 = (G % 8 == 0) ? (bx % 8) * (G / 8) + bx / 8 : bx;
    const int NGW = G * NWAVES;
#define X ((bf16*)(ws + WS_X))
#define H ((bf16*)(ws + WS_H))
#define MIX ((bf16*)(ws + WS_MIX))
#define ACT ((bf16*)(ws + WS_ACT))
#define Qb ((bf16*)(ws + WS_QB))
#define Kb ((bf16*)(ws + WS_KB))
#define Vb ((bf16*)(ws + WS_VB))
#define Zb ((bf16*)(ws + WS_ZB))
#define Ob ((bf16*)(ws + WS_OB))
#define OPART ((float*)(ws + WS_OPART))
#define MLP ((float*)(ws + WS_ML))
#define pwt ((const bf16*)(ws + WS_POOLWT))
    if (tid < 16) ((LAS unsigned*)(lds + LDS_BYTES - 64))[tid] = 0u;
    const unsigned xcc = xb_xcc_id();
    if (tid == 0) (void)xb_add((unsigned*)KWS() + 4096 + XB_XCNT(xcc), 1u);
    __syncthreads();
    { const int gw = vcu0 * NWAVES + wave; prologue(lds, gw, NGW, wave, lane);
      norm_rows<false>(KIN(0), KIN(1), KIN(6), (bf16*)(KWS() + WS_H), nullptr, gw, NGW, lane); }
    CG_SYNC();
#define FRESH_IDS() int tid = threadIdx.x; asm volatile("" : "+v"(tid)); const int lane = tid & 63, wave = __builtin_amdgcn_readfirstlane(tid >> 6); int vcu = vcu0; asm volatile("" : "+s"(vcu)); const int gw = vcu * NWAVES + wave; (void)lane; (void)gw; (void)wave
#define CNT(nid, idx) ((unsigned*)(ws + CTL_CNT) + (size_t)((nid) * 80 + (idx)) * 64)
#pragma unroll 1
    for (int step = 0; step < 4; ++step) {
        const int l = step >> 1, f = step & 1;
        const bool first = (step == 0);
        { FRESH_IDS(); unsigned char* const ws = KWS(); unsigned char* const wl = ws + WS_W + (size_t)l * WL;
          pg8::Gemm g{H, (const bf16*)(wl + (f ? W_GU2 : W_GU1)), M, 2 * FF, D}; pg8::StaticOrder S; S.init(M, 2 * FF, G, bx);
          pg8::EpiSwiGLU E{ACT, FF};
          pg8::gemm_phase<pg8::EpiSwiGLU, pg8::StaticOrder, true, true>(lds, g, S, E); }
        GRID_SYNC();
        { FRESH_IDS(); unsigned char* const ws = KWS(); unsigned char* const wl = ws + WS_W + (size_t)l * WL;
          const bool last = (step == 3);
          const float* const gn = last ? KIN(25) : (f ? KIN(6) + (l + 1) * D : KIN(10) + l * D);
          const int nid = step * 2;
          float* const yo = KOUT() + OFF_Y;
          pg8::Gemm g{ACT, (const bf16*)(wl + (f ? W_D2 : W_D1)), MP, D, FF}; pg8::StaticOrder S; S.init(MP, D, G, bx);
          { pg8::Unit u0; const int pm0 = S.next(0, u0) ? u0.pm : 0;
            if (first) { pg8::EpiResidNorm<false> E{KIN(0), X, 0.5f, H, yo, gn, (unsigned*)(ws + WS_SLOTP), CNT(nid, pm0)};
                         pg8::gemm_phase<pg8::EpiResidNorm<false>, pg8::StaticOrder, false, true>(lds, g, S, E); }
            else { pg8::EpiResidNorm<true> E{X, last ? nullptr : X, 0.5f, last ? nullptr : H, yo, gn, (unsigned*)(ws + WS_SLOTP), CNT(nid, pm0)};
                   pg8::gemm_phase<pg8::EpiResidNorm<true>, pg8::StaticOrder, false, true>(lds, g, S, E); } }
          if (first) skinny_gemm<false>(lds, ACT + (size_t)MP * FF, (const bf16*)(wl + W_D1), FF, KIN(1), X + (size_t)MP * D, 0.5f, H + (size_t)MP * D, yo + (size_t)MP * D, gn, (unsigned*)(ws + WS_SLOTS), CNT(nid, 64), vcu, G, tid);
          else skinny_gemm<true>(lds, ACT + (size_t)MP * FF, (const bf16*)(wl + (f ? W_D2 : W_D1)), FF, X + (size_t)MP * D, last ? nullptr : X + (size_t)MP * D, 0.5f,
                      last ? nullptr : H + (size_t)MP * D, yo + (size_t)MP * D, gn, (unsigned*)(ws + WS_SLOTS), CNT(nid, 64), vcu, G, tid); }
        if (step == 3) break;
        GRID_SYNC();
        if (f == 0) {
            { FRESH_IDS(); unsigned char* const ws = KWS(); unsigned char* const wl = ws + WS_W + (size_t)l * WL;
              pg8::Gemm g{H, (const bf16*)(wl + W_IN), M, DIN, D}; pg8::StaticOrder S; S.init(M, DIN, G, bx);
              pg8::EpiWin E{ws, KOUT(), l, C2};
              pg8::gemm_phase<pg8::EpiWin, pg8::StaticOrder, true, true>(lds, g, S, E); }
            GRID_SYNC();
            { FRESH_IDS(); unsigned char* const ws = KWS();
              for (int i = 0; i < 4; ++i) {
                const int L = i * G + vcu; if (L >= 1024) break;
                const int bh = (L & 255) >> 1, sI = L & 1, ii = L >> 8;
                const int qb = sI == 0 ? (ii == 0 ? 7 : ii == 1 ? 0 : ii == 2 ? 4 : 3) : (ii == 0 ? 6 : ii == 1 ? 1 : ii == 2 ? 5 : 2);
                const int b = bh >> 4, vh = bh & 15, hh = vh >> 2, c = (vh >> 1) & 1, hf = vh & 1;
                attn_body::attn_unit<8>(b, qb, (const attn_body::bf16*)(Qb + (hh * 2 + c) * 64), (const attn_body::bf16*)(Kb + (hh * 2 + c) * 64), (const attn_body::bf16*)(Vb + hh * 128 + hf * 64),
                                        (attn_body::bf16*)(Ob + c * 512 + hh * 128 + hf * 64), (char*)lds_raw);
              } }
            __syncthreads();
            { FRESH_IDS(); unsigned char* const ws = KWS(); float* const outp = KOUT();
              for (int pc = vcu; pc < 256; pc += G)
                sample_piece(lds, pc, l, Qb, KIN(2), KIN(3), outp + OFF_KS, outp + OFF_VS, OPART, MLP, tid); }
            __syncthreads();
            { FRESH_IDS(); unsigned char* const ws = KWS(); float* const outp = KOUT();
              for (int tl = vcu; tl < 264; tl += G)
                poolconv_tile(lds, tl, l, Zb, MIX, KIN(4), KIN(5), pwt, KIN(18), KIN(19), outp + OFF_CP, outp + OFF_CS, tid); }
            GRID_SYNC();
            { FRESH_IDS(); unsigned char* const ws = KWS();
              combine_phase(l, Ob, OPART, MLP, MIX, gw, NGW, lane); }
            GRID_SYNC();
            { FRESH_IDS(); unsigned char* const ws = KWS(); unsigned char* const wl = ws + WS_W + (size_t)l * WL;
              const float* const gn = KIN(21) + l * D; const int nid = step * 2 + 1;
              pg8::Gemm g{MIX, (const bf16*)(wl + W_OUT), MP, D, D}; pg8::StaticOrder S; S.init(MP, D, G, bx);
              { pg8::Unit u0; const int pm0 = S.next(0, u0) ? u0.pm : 0;
                pg8::EpiResidNorm<true> E{X, X, 1.0f, H, nullptr, gn, (unsigned*)(ws + WS_SLOTP), CNT(nid, pm0)};
                pg8::gemm_phase<pg8::EpiResidNorm<true>, pg8::StaticOrder, false, true>(lds, g, S, E); }
              skinny_gemm<true>(lds, MIX + (size_t)MP * D, (const bf16*)(wl + W_OUT), D, X + (size_t)MP * D, X + (size_t)MP * D, 1.0f, H + (size_t)MP * D, nullptr, gn,
                          (unsigned*)(ws + WS_SLOTS), CNT(nid, 64), vcu, G, tid); }
            GRID_SYNC();
        }
    }
}

extern "C" void kernel_launch(void* const* d_in, const int* in_sizes, int n_in, void* d_out, int out_size, void* d_ws, size_t ws_size, hipStream_t stream) {
    static int grid = 0;
    if (grid == 0) {
        if (n_in != 26 || (size_t)out_size != OUT_TOTAL || ws_size < WS_END) { fprintf(stderr, "kernel_launch: unexpected problem shape: n_in %d out %d ws %zu\n", n_in, out_size, ws_size); grid = -1; return; }
        int dev = 0, cus = 0, per_cu = 0;
        if (hipGetDevice(&dev) != hipSuccess || hipDeviceGetAttribute(&cus, hipDeviceAttributeMultiprocessorCount, dev) != hipSuccess) { grid = -1; return; }
        if (hipFuncSetAttribute((const void*)mega_fwd, hipFuncAttributeMaxDynamicSharedMemorySize, LDS_BYTES) != hipSuccess) { fprintf(stderr, "kernel_launch: hipFuncSetAttribute failed\n"); grid = -1; return; }
        if (hipOccupancyMaxActiveBlocksPerMultiprocessor(&per_cu, (const void*)mega_fwd, NWAVES * 64, LDS_BYTES) != hipSuccess || per_cu < 1) { fprintf(stderr, "kernel_launch: occupancy query says %d\n", per_cu); per_cu = 1; }
        (void)hipGetLastError();
        grid = cus * per_cu;
    }
    if (grid < 0) return;
    if (hipMemsetAsync(d_ws, 0, CTL_BYTES, stream) != hipSuccess) { fprintf(stderr, "kernel_launch: memset failed\n"); return; }
    Params p{};
    for (int i = 0; i < 26; ++i) p.in[i] = (const float*)d_in[i];
    p.out = (float*)d_out; p.ws = (unsigned char*)d_ws;
    void* args[] = {&p};
    const hipError_t e = hipLaunchCooperativeKernel((const void*)mega_fwd, dim3(grid), dim3(NWAVES * 64), args, LDS_BYTES, stream);
    if (e != hipSuccess) fprintf(stderr, "kernel_launch: cooperative launch failed: %s (grid %d)\n", hipGetErrorString(e), grid);
}
```

```cpp
#include <hip/hip_runtime.h>
#include <hip/hip_cooperative_groups.h>
#include <cstdio>
#include <cstdint>
namespace pg8 {
#define PG8_LAS __attribute__((address_space(3)))
typedef unsigned short bf16_t;
typedef short bf16x8 __attribute__((ext_vector_type(8)));
typedef float f32x4 __attribute__((ext_vector_type(4)));
typedef unsigned u32x4 __attribute__((ext_vector_type(4)));
constexpr int BM = 256, BK = 64, HALF = 128, HTB = HALF * BK * 2  , STAGE_BYTES = 8 * HTB, NXCD = 8, WGM = 8;

__host__ __device__ __forceinline__ int lds_byte(int r, int c) { const int st = (r >> 4) * 2 + (c >> 5), rr = r & 15, cc = c & 31, ob = rr * 64 + cc * 2; return st * 1024 + (ob ^ (((ob >> 9) & 1) << 5)); }
__host__ __device__ __forceinline__ void stage_rc(int b, int& R, int& C) { const int st = b / 1024, sb = b % 1024, swz = sb ^ (((sb >> 9) & 1) << 5); R = (st >> 1) * 16 + swz / 64; C = (st & 1) * 32 + (swz % 64) / 2; }
__host__ __device__ __forceinline__ int perm32(int rho) { const int n = rho >> 4, i = rho & 15; return 8 * (i >> 2) + 4 * n + (i & 3); }

struct Unit { int pm, pn; };
struct Gemm { const bf16_t* A; const bf16_t* Bt; int M, N, K; };

struct StaticOrder {
    int nM, nN, nwg, G, c;
    __host__ __device__ __forceinline__ void init(int M, int N, int G_, int c_) { nM = M / BM; nN = N / BM; nwg = nM * nN; G = G_; c = c_; }
    __host__ __device__ __forceinline__ bool next(int i, Unit& u) const {
        const long L = (long)i * G + c; if (L >= nwg) return false;
        int wgid = (int)L; { const int q = nwg / NXCD, r = nwg % NXCD, xcd = wgid % NXCD, off = wgid / NXCD; wgid = (xcd < r ? xcd * (q + 1) : r * (q + 1) + (xcd - r) * q) + off; }
        const int nig = WGM * nN, gid = wgid / nig, fm = gid * WGM, gsz = (nM - fm) < WGM ? (nM - fm) : WGM;
        u.pm = fm + ((wgid % nig) % gsz); u.pn = (wgid % nig) / gsz; return true;
    }
    __device__ __forceinline__ void a_ready(const Unit&) const {}
    __device__ __forceinline__ void done(const Unit&) const {}
};

__device__ __forceinline__ unsigned cvt_pk_bf16(float lo, float hi) { unsigned r; asm volatile("v_cvt_pk_bf16_f32 %0, %1, %2" : "=v"(r) : "v"(lo), "v"(hi)); return r; }
typedef float f32x2 __attribute__((ext_vector_type(2)));
typedef unsigned u32x2 __attribute__((ext_vector_type(2)));
constexpr size_t WOFF_ROPE = (size_t)1 << 20, WOFF_QB = (size_t)215 << 20, WOFF_KB = (size_t)232 << 20, WOFF_VB = (size_t)249 << 20, WOFF_ZB = (size_t)266 << 20;
constexpr size_t OOFF_KP = 17039360, OOFF_VP = 33816576, OOFF_PP = 50593792, OOFF_KS = 50663424, OOFF_VS = 50925568, OOFF_PS = 51187712;
__device__ __forceinline__ float silu_mul(float g, float u) { const float e = __builtin_amdgcn_exp2f(-1.4426950408889634f * g); return g * u * __builtin_amdgcn_rcpf(1.0f + e); }
struct EpiSwiGLU {
    static constexpr bool PERM = true, AFTER_DRAIN = false;
    bf16_t* O; int ldc;
    __device__ __forceinline__ void operator()(const f32x4 (&acc)[2][2][4][2], const Unit& u, int wr, int wc, int fr, int fq) const {
        const int row0 = u.pm * BM + wr * 64 + fr; const int col0 = u.pn * 128 + wc * 32 + 8 * fq;
#pragma unroll
        for (int ai = 0; ai < 2; ++ai)
#pragma unroll
            for (int m = 0; m < 4; ++m) {
                bf16_t* p = O + (size_t)(row0 + ai * HALF + m * 16) * ldc + col0;
                const f32x4 g0 = acc[ai][0][m][0], g1 = acc[ai][0][m][1], u0 = acc[ai][1][m][0], u1 = acc[ai][1][m][1];
                u32x4 w;
                w.x = cvt_pk_bf16(silu_mul(g0[0], u0[0]), silu_mul(g0[1], u0[1])); w.y = cvt_pk_bf16(silu_mul(g0[2], u0[2]), silu_mul(g0[3], u0[3]));
                w.z = cvt_pk_bf16(silu_mul(g1[0], u1[0]), silu_mul(g1[1], u1[1])); w.w = cvt_pk_bf16(silu_mul(g1[2], u1[2]), silu_mul(g1[3], u1[3]));
                *(u32x4*)p = w;
                asm volatile("" ::: "memory");
            }
    }
};
struct EpiResid {
    static constexpr bool PERM = false, AFTER_DRAIN = false;
    const float* baseP; const float* baseS; float* out; float scale;
    __device__ __forceinline__ void operator()(const f32x4 (&acc)[2][2][4][2], const Unit& u, int wr, int wc, int fr, int fq) const {
        const int col0 = u.pn * BM + wc * 32 + 4 * fq;
#pragma unroll
        for (int ai = 0; ai < 2; ++ai)
#pragma unroll
            for (int m = 0; m < 4; ++m) {
                const int row = u.pm * BM + ai * HALF + wr * 64 + m * 16 + fr;
                const float* bp = (row < 16384) ? baseP + (size_t)row * 1024 : baseS + (size_t)(row - 16384) * 1024;
                float* op = out + (size_t)row * 1024;
#pragma unroll
                for (int bj = 0; bj < 2; ++bj)
#pragma unroll
                    for (int n = 0; n < 2; ++n) { const int c = col0 + bj * HALF + n * 16; const f32x4 b = *(const f32x4*)(bp + c); *(f32x4*)(op + c) = b + acc[ai][bj][m][n] * scale; }
                asm volatile("" ::: "memory");
            }
    }
};
constexpr float RMS_EPS = 1e-6f;
__device__ __forceinline__ float rstd_of(float ss) { return 1.0f / sqrtf(ss * (1.0f / 1024.0f) + RMS_EPS); }

#define PG8_RLX_AGENT __ATOMIC_RELAXED, __HIP_MEMORY_SCOPE_AGENT
template <bool BASE16> struct EpiResidNorm {
    static constexpr bool PERM = false, AFTER_DRAIN = true;
    const void* baseP; bf16_t* out; float scale; bf16_t* hb; float* yout; const float* gain; unsigned* slots; unsigned* cnt;
    __device__ __forceinline__ void fused(f32x4 (&acc)[2][2][4][2], const Unit& u, int wr, int wc, int fr, int fq, PG8_LAS unsigned char* lds, int wid, int lane) const {
        PG8_LAS float* P = (PG8_LAS float*)lds;
        PG8_LAS float* S = (PG8_LAS float*)(lds + 4096);
        const int col0 = u.pn * BM + wc * 32 + 4 * fq;
        if (BASE16) {
            u32x2 braw[2][4][2][2];
#pragma unroll
            for (int ai = 0; ai < 2; ++ai)
#pragma unroll
                for (int m = 0; m < 4; ++m) { const size_t ro = (size_t)(u.pm * BM + ai * HALF + wr * 64 + m * 16 + fr) * 1024;
#pragma unroll
                    for (int bj = 0; bj < 2; ++bj)
#pragma unroll
                        for (int n = 0; n < 2; ++n) braw[ai][m][bj][n] = *(const u32x2*)((const bf16_t*)baseP + ro + col0 + bj * HALF + n * 16); }
#pragma unroll
            for (int ai = 0; ai < 2; ++ai)
#pragma unroll
                for (int m = 0; m < 4; ++m)
#pragma unroll
                    for (int bj = 0; bj < 2; ++bj)
#pragma unroll
                        for (int n = 0; n < 2; ++n) { const u32x2 bw = braw[ai][m][bj][n]; f32x4 bv; bv[0] = __builtin_bit_cast(float, bw.x << 16); bv[1] = __builtin_bit_cast(float, bw.x & 0xffff0000u); bv[2] = __builtin_bit_cast(float, bw.y << 16); bv[3] = __builtin_bit_cast(float, bw.y & 0xffff0000u);
                            acc[ai][bj][m][n] = bv + acc[ai][bj][m][n] * scale; }
        }
#pragma unroll
        for (int ai = 0; ai < 2; ++ai)
#pragma unroll
            for (int m = 0; m < 4; ++m) {
                const int rl = ai * HALF + wr * 64 + m * 16 + fr; const size_t ro = (size_t)(u.pm * BM + rl) * 1024;
                float ss = 0.f;
#pragma unroll
                for (int bj = 0; bj < 2; ++bj)
#pragma unroll
                    for (int n = 0; n < 2; ++n) { const int c = col0 + bj * HALF + n * 16; f32x4 v;
                        if (BASE16) v = acc[ai][bj][m][n];
                        else { v = *(const f32x4*)((const float*)baseP + ro + c) + acc[ai][bj][m][n] * scale; acc[ai][bj][m][n] = v; }
                        if (out) { u32x2 w; w.x = cvt_pk_bf16(v[0], v[1]); w.y = cvt_pk_bf16(v[2], v[3]); *(u32x2*)(out + ro + c) = w; }
                        ss += (v[0] * v[0] + v[1] * v[1]) + (v[2] * v[2] + v[3] * v[3]); }
                ss += __builtin_bit_cast(float, __builtin_amdgcn_ds_swizzle(__builtin_bit_cast(int, ss), (16 << 10) | 0x1f));
                { float a = ss, b2 = ss; asm volatile("s_nop 1\n\tv_permlane32_swap_b32 %0, %1\n\ts_nop 1" : "+v"(a), "+v"(b2)); ss = a + b2; }
                if (fq == 0) P[rl * 4 + wc] = ss;
                if (!BASE16 && (m & 1)) asm volatile("" ::: "memory");
            }
        asm volatile("s_waitcnt lgkmcnt(0)\n\ts_barrier" ::: "memory");
        const int t = wid * 64 + lane;
        if (t < 256) { const float s = (P[t * 4] + P[t * 4 + 1]) + (P[t * 4 + 2] + P[t * 4 + 3]);
            __hip_atomic_store(slots + (size_t)(u.pm * BM + t) * 4 + u.pn, __builtin_bit_cast(unsigned, s), PG8_RLX_AGENT); }
        asm volatile("s_waitcnt vmcnt(0)" ::: "memory");
        if (wid < 4 && lane == 0) __hip_atomic_fetch_add(cnt, 1u, PG8_RLX_AGENT);
        if (wid == 0) {
            unsigned spins = 0;
            while ((unsigned)__builtin_amdgcn_readfirstlane(__hip_atomic_load(cnt, PG8_RLX_AGENT)) < 16u) { __builtin_amdgcn_s_sleep(2); if (++spins > (1u << 22)) break; }
            __builtin_amdgcn_fence(__ATOMIC_ACQUIRE, "agent");
        }
        asm volatile("s_waitcnt vmcnt(0) lgkmcnt(0)\n\ts_barrier" ::: "memory");
        if (t < 256) { const unsigned* sl = slots + (size_t)(u.pm * BM + t) * 4; float tot = 0.f;
#pragma unroll
            for (int k = 0; k < 4; ++k) tot += __builtin_bit_cast(float, __hip_atomic_load(sl + k, PG8_RLX_AGENT));
            S[t] = rstd_of(tot); }
        asm volatile("s_waitcnt lgkmcnt(0)\n\ts_barrier" ::: "memory");
        f32x4 g4[2][2];
#pragma unroll
        for (int bj = 0; bj < 2; ++bj)
#pragma unroll
            for (int n = 0; n < 2; ++n) g4[bj][n] = *(const f32x4*)(gain + col0 + bj * HALF + n * 16);
#pragma unroll
        for (int ai = 0; ai < 2; ++ai)
#pragma unroll
            for (int m = 0; m < 4; ++m) {
                const int rl = ai * HALF + wr * 64 + m * 16 + fr; const size_t ro = (size_t)(u.pm * BM + rl) * 1024; const float r = S[rl];
#pragma unroll
                for (int bj = 0; bj < 2; ++bj)
#pragma unroll
                    for (int n = 0; n < 2; ++n) { const int c = col0 + bj * HALF + n * 16; const f32x4 y = acc[ai][bj][m][n] * r * g4[bj][n];
                        if (hb) { u32x2 w; w.x = cvt_pk_bf16(y[0], y[1]); w.y = cvt_pk_bf16(y[2], y[3]); *(u32x2*)(hb + ro + c) = w; }
                        else *(f32x4*)(yout + ro + c) = y; }
            }
        asm volatile("s_waitcnt lgkmcnt(0)\n\ts_barrier" ::: "memory");
    }
};

struct EpiWin {
    static constexpr bool PERM = false, AFTER_DRAIN = false;
    unsigned char* ws; float* outp; int l; float qscale;
    __device__ __forceinline__ void operator()(const f32x4 (&acc)[2][2][4][2], const Unit& u, int wr, int wc, int fr, int fq) const {
        const int pn = u.pn;
        bf16_t* const Qb = (bf16_t*)(ws + WOFF_QB); bf16_t* const Kb = (bf16_t*)(ws + WOFF_KB); bf16_t* const Vb = (bf16_t*)(ws + WOFF_VB); bf16_t* const Zb = (bf16_t*)(ws + WOFF_ZB);
        const float* const rope = (const float*)(ws + WOFF_ROPE);
        float* const kP = outp + OOFF_KP + (size_t)l * 16384 * 512; float* const vP = outp + OOFF_VP + (size_t)l * 16384 * 512;
        float* const kS = outp + OOFF_KS + (size_t)l * 256 * 512; float* const vS = outp + OOFF_VS + (size_t)l * 256 * 512;
        float* const poolP = outp + OOFF_PP + (size_t)l * 8 * 15 * 256; float* const poolS = outp + OOFF_PS + (size_t)l * 8 * 15 * 256;
#pragma unroll
        for (int ai = 0; ai < 2; ++ai)
#pragma unroll
            for (int m = 0; m < 4; ++m) {
                const int row = u.pm * BM + ai * HALF + wr * 64 + m * 16 + fr;
                const bool smp = row >= 16384; const int rs = row - 16384;
                const int prow = smp ? 2048 + (rs & 31) : (row & 2047);
#pragma unroll
                for (int bj = 0; bj < 2; ++bj) {
                    const int dlo = 16 * (wc & 1) + 4 * fq, lc0 = 64 * (2 * bj + (wc >> 1)) + dlo;
                    const f32x4 a0 = acc[ai][bj][m][0], a1 = acc[ai][bj][m][1];
                    if (pn < 4) {
                        const f32x4 cs = *(const f32x4*)(rope + (size_t)prow * 64 + dlo), sn = *(const f32x4*)(rope + (size_t)prow * 64 + 32 + dlo);
                        const f32x4 r0 = a0 * cs - a1 * sn, r1 = a1 * cs + a0 * sn;
                        if (pn < 2) {
                            const int col = 256 * pn + lc0; bf16_t* q = Qb + (size_t)row * 512 + col;
                            u32x2 w0, w1; w0.x = cvt_pk_bf16(r0[0] * qscale, r0[1] * qscale); w0.y = cvt_pk_bf16(r0[2] * qscale, r0[3] * qscale);
                            w1.x = cvt_pk_bf16(r1[0] * qscale, r1[1] * qscale); w1.y = cvt_pk_bf16(r1[2] * qscale, r1[3] * qscale);
                            *(u32x2*)q = w0; *(u32x2*)(q + 32) = w1;
                        } else {
                            const int col = 256 * (pn - 2) + lc0; bf16_t* k = Kb + (size_t)row * 512 + col;
                            float* ko = smp ? kS + (size_t)rs * 512 + col : kP + (size_t)row * 512 + col;
                            *(f32x4*)ko = r0; *(f32x4*)(ko + 32) = r1;
                            u32x2 w0, w1; w0.x = cvt_pk_bf16(r0[0], r0[1]); w0.y = cvt_pk_bf16(r0[2], r0[3]); w1.x = cvt_pk_bf16(r1[0], r1[1]); w1.y = cvt_pk_bf16(r1[2], r1[3]);
                            *(u32x2*)k = w0; *(u32x2*)(k + 32) = w1;
                        }
                    } else if (pn < 6) {
                        const int col = 256 * (pn - 4) + lc0; bf16_t* v = Vb + (size_t)row * 512 + col;
                        float* vo = smp ? vS + (size_t)rs * 512 + col : vP + (size_t)row * 512 + col;
                        *(f32x4*)vo = a0; *(f32x4*)(vo + 32) = a1;
                        u32x2 w0, w1; w0.x = cvt_pk_bf16(a0[0], a0[1]); w0.y = cvt_pk_bf16(a0[2], a0[3]); w1.x = cvt_pk_bf16(a1[0], a1[1]); w1.y = cvt_pk_bf16(a1[2], a1[3]);
                        *(u32x2*)v = w0; *(u32x2*)(v + 32) = w1;
                    } else {
                        const int col = 256 * (pn - 6) + lc0; bf16_t* z = Zb + (size_t)row * 1024 + col;
                        u32x2 w0, w1; w0.x = cvt_pk_bf16(a0[0], a0[1]); w0.y = cvt_pk_bf16(a0[2], a0[3]); w1.x = cvt_pk_bf16(a1[0], a1[1]); w1.y = cvt_pk_bf16(a1[2], a1[3]);
                        *(u32x2*)z = w0; *(u32x2*)(z + 32) = w1;
                        if (pn == 6) {
                            if (smp) { const int b = rs >> 5, t = rs & 31; if (t >= 17) { float* po = poolS + (size_t)(b * 15 + t - 17) * 256 + lc0; *(f32x4*)po = a0; *(f32x4*)(po + 32) = a1; } }
                            else { const int b = row >> 11, t = row & 2047; if (t >= 2033) { float* po = poolP + (size_t)(b * 15 + t - 2033) * 256 + lc0; *(f32x4*)po = a0; *(f32x4*)(po + 32) = a1; } }
                        }
                    }
                }
                asm volatile("" ::: "memory");
            }
    }
};
template <class Epi, class Sched, bool ALIGN_EPI = false, bool SP2 = false>
__device__ __forceinline__ void gemm_phase(PG8_LAS unsigned char* lds, const Gemm g, const Sched& S, const Epi& E) {
    int tid_l = threadIdx.x; asm volatile("" : "+v"(tid_l)); const int tid = tid_l, wid = __builtin_amdgcn_readfirstlane(tid >> 6), lane = tid & 63, wr = wid >> 2, wc = wid & 3, fr = lane & 15, fq = lane >> 4;
    const int K = g.K, nt = K / BK;
    unsigned voffA[2], voffB[2];
#pragma unroll
    for (int i = 0; i < 2; ++i) { int R, C; stage_rc(tid * 16 + i * 8192, R, C); const int Rb = Epi::PERM ? ((R & ~31) + perm32(R & 31)) : R;
        voffA[i] = (unsigned)(R * K + C) * 2u; voffB[i] = (unsigned)(Rb * K + C) * 2u; }
    const size_t kstep = (size_t)(BK * 2);
    const size_t hstep = (size_t)HALF * K * 2;
    const size_t tstep = 2 * hstep;
    const unsigned ldsw = (unsigned)wid * 1024u;
    const int aoff = lds_byte(wr * 64 + fr, fq * 8), boff = lds_byte(wc * 32 + fr, fq * 8);
#define PG8_SA(b, h) (((b) * 2 + (h)) * HTB)
#define PG8_SB(b, h) ((4 + (b) * 2 + (h)) * HTB)
#define PG8_STAGE(bufoff, gbase, voff) do { _Pragma("unroll") for (int _i = 0; _i < 2; ++_i) \
        __builtin_amdgcn_global_load_lds((const unsigned*)((const char*)(gbase) + (voff)[_i]), (PG8_LAS unsigned*)(lds + (bufoff) + ldsw + _i * 8192), 16, 0, 0); } while (0)
#define PG8_LDA(dst, b, h) do { _Pragma("unroll") for (int m = 0; m < 4; ++m) _Pragma("unroll") for (int k = 0; k < 2; ++k) dst[m][k] = *(const PG8_LAS bf16x8*)(lds + PG8_SA(b, h) + aoff + m * 2048 + k * 1024); } while (0)
#define PG8_LDB(dst, b, h) do { _Pragma("unroll") for (int n = 0; n < 2; ++n) _Pragma("unroll") for (int k = 0; k < 2; ++k) dst[n][k] = *(const PG8_LAS bf16x8*)(lds + PG8_SB(b, h) + boff + n * 2048 + k * 1024); } while (0)
#define PG8_MMA(ai, bj, At, Bt) do { __builtin_amdgcn_s_setprio(1); _Pragma("unroll") for (int m = 0; m < 4; ++m) _Pragma("unroll") for (int n = 0; n < 2; ++n) _Pragma("unroll") for (int k = 0; k < 2; ++k) \
        acc[ai][bj][m][n] = __builtin_amdgcn_mfma_f32_16x16x32_bf16(Bt[n][k], At[m][k], acc[ai][bj][m][n], 0, 0, 0); __builtin_amdgcn_s_setprio(0); } while (0)
#define PG8_WAIT_V(n) asm volatile("s_waitcnt vmcnt(" #n ")" ::: "memory")
#define PG8_WAIT_L(n) asm volatile("s_waitcnt lgkmcnt(" #n ")" ::: "memory")
#define PG8_BAR __builtin_amdgcn_s_barrier()
#define PG8_SCHED __builtin_amdgcn_sched_barrier(0)
    Unit cur, nxt; int ui = 0;
    if (!S.next(0, cur)) return;
    f32x4 acc[2][2][4][2];
#pragma unroll
    for (int a = 0; a < 2; ++a)
#pragma unroll
        for (int b = 0; b < 2; ++b)
#pragma unroll
            for (int m = 0; m < 4; ++m)
#pragma unroll
                for (int n = 0; n < 2; ++n) acc[a][b][m][n] = (f32x4){0.f, 0.f, 0.f, 0.f};
    bf16x8 At[4][2], B0[2][2], B1[2][2];
    const char* cA = (const char*)g.A + (size_t)cur.pm * tstep; const char* cB = (const char*)g.Bt + (size_t)cur.pn * tstep;
    S.a_ready(cur);
    if constexpr (SP2) {
        PG8_STAGE(PG8_SB(0, 0), cB, voffB); PG8_STAGE(PG8_SB(0, 1), cB + hstep, voffB); PG8_STAGE(PG8_SA(0, 0), cA, voffA); PG8_STAGE(PG8_SA(0, 1), cA + hstep, voffA);
        if (wr == 1) PG8_BAR;
        PG8_WAIT_V(2); PG8_BAR;
        PG8_STAGE(PG8_SB(1, 0), cB + kstep, voffB); PG8_STAGE(PG8_SA(1, 0), cA + kstep, voffA); PG8_STAGE(PG8_SB(1, 1), cB + hstep + kstep, voffB);
        PG8_WAIT_V(6); PG8_BAR;
    } else {
        PG8_STAGE(PG8_SB(0, 0), cB, voffB); PG8_STAGE(PG8_SA(0, 0), cA, voffA); PG8_STAGE(PG8_SB(0, 1), cB + hstep, voffB); PG8_STAGE(PG8_SA(0, 1), cA + hstep, voffA);
        if (wr == 1) PG8_BAR;
        PG8_WAIT_V(4); PG8_BAR;
        PG8_STAGE(PG8_SB(1, 0), cB + kstep, voffB); PG8_STAGE(PG8_SA(1, 0), cA + kstep, voffA); PG8_STAGE(PG8_SB(1, 1), cB + hstep + kstep, voffB);
        PG8_WAIT_V(6); PG8_BAR;
    }
    for (;;) {
        const bool has_next = S.next(ui + 1, nxt);
        const char* nA = has_next ? (const char*)g.A + (size_t)nxt.pm * tstep : cA; const char* nB = has_next ? (const char*)g.Bt + (size_t)nxt.pn * tstep : cB;
        for (int t = 0; t < nt; t += 2) {
            const bool last = (t == nt - 2);
            const char* a1 = cA + (size_t)(t + 1) * kstep;
            const char* a2 = last ? nA : cA + (size_t)(t + 2) * kstep; const char* b2 = last ? nB : cB + (size_t)(t + 2) * kstep;
            const char* a3 = a2 + kstep; const char* b3 = b2 + kstep;
            if (last && has_next) S.a_ready(nxt);
            if constexpr (SP2) {
            PG8_LDB(B0, 0, 0); PG8_LDB(B1, 0, 1); PG8_SCHED; PG8_LDA(At, 0, 0); PG8_STAGE(PG8_SA(1, 1), a1 + hstep, voffA);
            PG8_WAIT_V(8); PG8_WAIT_L(0); PG8_BAR; PG8_MMA(0, 0, At, B0); PG8_MMA(0, 1, At, B1); PG8_BAR; PG8_SCHED;
            PG8_LDA(At, 0, 1); PG8_STAGE(PG8_SB(0, 0), b2, voffB); PG8_STAGE(PG8_SB(0, 1), b2 + hstep, voffB); PG8_STAGE(PG8_SA(0, 0), a2, voffA);
            PG8_WAIT_V(8); PG8_WAIT_L(0); PG8_BAR; PG8_MMA(1, 0, At, B0); PG8_MMA(1, 1, At, B1); PG8_BAR; PG8_SCHED;
            PG8_LDB(B0, 1, 0); PG8_LDB(B1, 1, 1); PG8_SCHED; PG8_LDA(At, 1, 0); PG8_STAGE(PG8_SA(0, 1), a2 + hstep, voffA);
            PG8_WAIT_V(8); PG8_WAIT_L(0); PG8_BAR; PG8_MMA(0, 0, At, B0); PG8_MMA(0, 1, At, B1); PG8_BAR; PG8_SCHED;
            PG8_LDA(At, 1, 1); PG8_STAGE(PG8_SB(1, 0), b3, voffB); PG8_STAGE(PG8_SB(1, 1), b3 + hstep, voffB); PG8_STAGE(PG8_SA(1, 0), a3, voffA);
            PG8_WAIT_V(8); PG8_WAIT_L(0); PG8_BAR; PG8_MMA(1, 0, At, B0); PG8_MMA(1, 1, At, B1); PG8_BAR; PG8_SCHED;
            } else {
            PG8_LDB(B0, 0, 0); PG8_SCHED; PG8_LDA(At, 0, 0); PG8_STAGE(PG8_SA(1, 1), a1 + hstep, voffA);
            PG8_WAIT_L(8); PG8_BAR; PG8_WAIT_L(0); PG8_MMA(0, 0, At, B0); PG8_BAR; PG8_SCHED;
            PG8_LDB(B1, 0, 1); PG8_STAGE(PG8_SB(0, 0), b2, voffB);
            PG8_BAR; PG8_WAIT_L(0); PG8_MMA(0, 1, At, B1); PG8_BAR;
            PG8_LDA(At, 0, 1); PG8_STAGE(PG8_SA(0, 0), a2, voffA);
            PG8_BAR; PG8_WAIT_L(0); PG8_MMA(1, 0, At, B0); PG8_BAR; PG8_SCHED;
            PG8_STAGE(PG8_SB(0, 1), b2 + hstep, voffB);
            PG8_WAIT_V(6); PG8_BAR; PG8_MMA(1, 1, At, B1); PG8_BAR;
            PG8_LDB(B0, 1, 0); PG8_SCHED; PG8_LDA(At, 1, 0); PG8_STAGE(PG8_SA(0, 1), a2 + hstep, voffA);
            PG8_WAIT_L(8); PG8_BAR; PG8_WAIT_L(0); PG8_MMA(0, 0, At, B0); PG8_BAR; PG8_SCHED;
            PG8_LDB(B1, 1, 1); PG8_STAGE(PG8_SB(1, 0), b3, voffB);
            PG8_BAR; PG8_WAIT_L(0); PG8_MMA(0, 1, At, B1); PG8_BAR;
            PG8_LDA(At, 1, 1); PG8_STAGE(PG8_SA(1, 0), a3, voffA);
            PG8_BAR; PG8_WAIT_L(0); PG8_MMA(1, 0, At, B0); PG8_BAR; PG8_SCHED;
            PG8_STAGE(PG8_SB(1, 1), b3 + hstep, voffB);
            PG8_WAIT_V(6); PG8_BAR; PG8_MMA(1, 1, At, B1); PG8_BAR;
            }
        }
        if constexpr (ALIGN_EPI) { if (wr == 0) PG8_BAR; }
        if constexpr (!Epi::AFTER_DRAIN) { E(acc, cur, wr, wc, fr, fq); S.done(cur); }
        if (!has_next) break;
#pragma unroll
        for (int a = 0; a < 2; ++a)
#pragma unroll
            for (int b = 0; b < 2; ++b)
#pragma unroll
                for (int m = 0; m < 4; ++m)
#pragma unroll
                    for (int n = 0; n < 2; ++n) acc[a][b][m][n] = (f32x4){0.f, 0.f, 0.f, 0.f};
        cur = nxt; cA = nA; cB = nB; ++ui;
        if constexpr (ALIGN_EPI) { if (wr == 1) PG8_BAR; }
    }
    PG8_WAIT_V(0);
    if constexpr (!ALIGN_EPI) { if (wr == 0) PG8_BAR; }
    PG8_BAR;
    if constexpr (Epi::AFTER_DRAIN) { E.fused(acc, cur, wr, wc, fr, fq, lds, wid, lane); S.done(cur); }
#undef PG8_SA
#undef PG8_SB
#undef PG8_STAGE
#undef PG8_LDA
#undef PG8_LDB
#undef PG8_MMA
#undef PG8_WAIT_V
#undef PG8_WAIT_L
#undef PG8_BAR
#undef PG8_SCHED
}
}
#include <hip/hip_bf16.h>
#include <cmath>
namespace attn_body {
using bf16=__hip_bfloat16;
using bf16x8=__attribute__((ext_vector_type(8)))short;
using s16x4=__attribute__((ext_vector_type(4)))short;
using f32x16=__attribute__((ext_vector_type(16)))float;
using u32x4=__attribute__((ext_vector_type(4)))unsigned;
constexpr int BATCH=8,NHEAD=16,SEQ=2048,D=64,PQK=512,PO=1024;
constexpr int NW=8,QBLK=32,QB=QBLK*NW,KVBLK=64,NQB=SEQ/QB;
constexpr int ATTN_UNIT_ROWS=QB;
__device__ __forceinline__ int crow(int r,int hi){return (r&3)+8*(r>>2)+4*hi;}
#define SBAR() __builtin_amdgcn_sched_barrier(0)
__device__ __forceinline__ void cmask(f32x16&p0,f32x16&p1,int jb,int qrel,int hi){
  const float NEG=-INFINITY; (void)hi;
  if(jb>(qrel>>6)){
  #pragma unroll
  for(int r=0;r<16;++r){p0[r]=NEG;p1[r]=NEG;}}
}

constexpr int NSLOT=3, SLOTB=8192;
constexpr int LDS_K=0, LDS_V=NSLOT*SLOTB, LDS_WS=2*NSLOT*SLOTB, LDS_OST=LDS_WS+NW*64*4, LDS_BYTES=LDS_OST+NW*4096;
constexpr float C2=0.125f*1.4426950408889634f;
__device__ __forceinline__ void glds16(const void*gsrc,unsigned lds_dst){unsigned keep;
  asm volatile("s_mov_b32 %0, m0\n\ts_mov_b32 m0, %2\n\ts_nop 0\n\tglobal_load_lds_dwordx4 %1, off\n\ts_mov_b32 m0, %0":"=&s"(keep):"v"(gsrc),"s"(lds_dst):"memory");}
__device__ __forceinline__ float max3f(float a,float b,float c){float r;asm("v_max3_f32 %0, %1, %2, %3":"=v"(r):"v"(a),"v"(b),"v"(c));return r;}
__device__ __forceinline__ float max2f(float a,float b){float r;asm("v_max_f32_e32 %0, %1, %2":"=v"(r):"v"(a),"v"(b));return r;}
__device__ __forceinline__ float fadd_s(float a,float b){float r;asm("v_add_f32_e32 %0, %1, %2":"=v"(r):"v"(a),"v"(b));return r;}
__device__ __forceinline__ float fsub_s(float a,float b){float r;asm("v_sub_f32_e32 %0, %1, %2":"=v"(r):"v"(a),"v"(b));return r;}
typedef float f32x2_t __attribute__((ext_vector_type(2))); typedef __bf16 bf16x2_t __attribute__((ext_vector_type(2)));
__device__ __forceinline__ unsigned cvtpk_s(float lo,float hi){f32x2_t v={lo,hi};bf16x2_t b=__builtin_convertvector(v,bf16x2_t);return __builtin_bit_cast(unsigned,b);}
#define WAIT_BAR(N) asm volatile("s_waitcnt vmcnt(" #N ") lgkmcnt(0)\n\ts_barrier":::"memory")

__device__ __forceinline__ void qkt(f32x16&p0,f32x16&p1,const char*Kslot,const bf16x8*qr,const f32x16&negm,int r32,int hi){
  const char*kb=Kslot+hi*1024+r32*16;
  #pragma unroll
  for(int d0=0;d0<4;++d0){
    const bf16x8 b0=*reinterpret_cast<const bf16x8*>(kb+d0*2048);
    const bf16x8 b1=*reinterpret_cast<const bf16x8*>(kb+d0*2048+512);
    if(d0==0){p0=__builtin_amdgcn_mfma_f32_32x32x16_bf16(b0,qr[0],negm,0,0,0);p1=__builtin_amdgcn_mfma_f32_32x32x16_bf16(b1,qr[0],negm,0,0,0);}
    else{p0=__builtin_amdgcn_mfma_f32_32x32x16_bf16(b0,qr[d0],p0,0,0,0);p1=__builtin_amdgcn_mfma_f32_32x32x16_bf16(b1,qr[d0],p1,0,0,0);}}
}
typedef __attribute__((address_space(3))) const char* lds_cptr;
typedef short v4i16_t __attribute__((ext_vector_type(4)));
__device__ __forceinline__ void kload8(bf16x8*kf,lds_cptr kp){
  kf[0]=*(const __attribute__((address_space(3))) bf16x8*)(kp);      kf[1]=*(const __attribute__((address_space(3))) bf16x8*)(kp+512);
  kf[2]=*(const __attribute__((address_space(3))) bf16x8*)(kp+2048); kf[3]=*(const __attribute__((address_space(3))) bf16x8*)(kp+2560);
  kf[4]=*(const __attribute__((address_space(3))) bf16x8*)(kp+4096); kf[5]=*(const __attribute__((address_space(3))) bf16x8*)(kp+4608);
  kf[6]=*(const __attribute__((address_space(3))) bf16x8*)(kp+6144); kf[7]=*(const __attribute__((address_space(3))) bf16x8*)(kp+6656);
}
__device__ __forceinline__ void kload2(bf16x8*kf,lds_cptr kp,int j){ kf[2*j]=*(const __attribute__((address_space(3))) bf16x8*)(kp+j*2048); kf[2*j+1]=*(const __attribute__((address_space(3))) bf16x8*)(kp+j*2048+512); }
__device__ __forceinline__ s16x4 vtr(lds_cptr p){ return __builtin_bit_cast(s16x4,__builtin_amdgcn_ds_read_tr16_b64_v4i16((__attribute__((address_space(3))) v4i16_t*)p)); }
__device__ __forceinline__ float rowmax(const f32x16&p0,const f32x16&p1){
  float a=max3f(p0[0],p0[1],p1[0]),b=max3f(p0[2],p0[3],p1[1]);a=max3f(a,p1[2],p1[3]);
  #pragma unroll
  for(int r=4;r<16;r+=4){a=max3f(a,p0[r],p0[r+1]);b=max3f(b,p0[r+2],p0[r+3]);a=max3f(a,p1[r],p1[r+1]);b=max3f(b,p1[r+2],p1[r+3]);}
  const float m=max2f(a,b);
  auto rr=__builtin_amdgcn_permlane32_swap(__float_as_uint(m),__float_as_uint(m),false,false);
  return max2f(__uint_as_float(rr[0]),__uint_as_float(rr[1]));
}
__device__ __forceinline__ void pv(f32x16*o,int vb,bf16x8 pa0,bf16x8 pa1,bf16x8 pa2,bf16x8 pa3){
  #pragma unroll
  for(int d0=0;d0<2;++d0){s16x4 lo[4],hi[4];
    #pragma unroll
    for(int ks=0;ks<4;++ks){
      asm volatile("ds_read_b64_tr_b16 %0,%1 offset:%c2":"=&v"(lo[ks]):"v"(vb),"i"(d0*4096+ks*1024):"memory");
      asm volatile("ds_read_b64_tr_b16 %0,%1 offset:%c2":"=&v"(hi[ks]):"v"(vb),"i"(d0*4096+ks*1024+512):"memory");}
    asm volatile("s_waitcnt lgkmcnt(0)":::"memory");SBAR();
    #define PK(k) (bf16x8){lo[k][0],lo[k][1],lo[k][2],lo[k][3],hi[k][0],hi[k][1],hi[k][2],hi[k][3]}
    o[d0]=__builtin_amdgcn_mfma_f32_32x32x16_bf16(pa0,PK(0),o[d0],0,0,0);
    o[d0]=__builtin_amdgcn_mfma_f32_32x32x16_bf16(pa1,PK(1),o[d0],0,0,0);
    o[d0]=__builtin_amdgcn_mfma_f32_32x32x16_bf16(pa2,PK(2),o[d0],0,0,0);
    o[d0]=__builtin_amdgcn_mfma_f32_32x32x16_bf16(pa3,PK(3),o[d0],0,0,0);
    #undef PK
  }
}

#ifndef ATTN_STORE16
#define ATTN_STORE16(p,v) (*(u32x4*)(p)=(v))
#endif
template<int THRL> __device__ __forceinline__ void attn_unit(int b,int qb,const bf16*Q,const bf16*__restrict__ K,const bf16*__restrict__ V,bf16*O,char*shm){
  int tid_l=threadIdx.x; asm volatile("":"+v"(tid_l)); const int tid=tid_l,lane=tid&63,r32=lane&31,hi=lane>>5; const int wid=__builtin_amdgcn_readfirstlane(tid>>6);
  const long rowbase=(long)b*SEQ; const int q0=qb*QB;
  const bf16*Qw=Q+(rowbase+q0+wid*QBLK)*PQK;
  const bf16*Kh=K+rowbase*PQK,*Vh=V+rowbase*PQK;
  const unsigned lds0=(unsigned)(uintptr_t)shm;
  float*wsf=(float*)(shm+LDS_WS)+wid*64;
  const bf16*ksrc=Kh+(long)lane*PQK+wid*8;
  const bf16*vsrc=Vh+(long)(16*(wid&3)+(lane>>2))*PQK+(wid>>2)*32+(lane&3)*8;
  const unsigned kdst=lds0+LDS_K+wid*1024, vdst=lds0+LDS_V+wid*1024;
  #define DMA_K(t,slot) glds16(ksrc+(long)(t)*KVBLK*PQK,(unsigned)__builtin_amdgcn_readfirstlane(kdst+(slot)))
  #define DMA_V(t,slot) glds16(vsrc+(long)(t)*KVBLK*PQK,(unsigned)__builtin_amdgcn_readfirstlane(vdst+(slot)))
  const int vb0=(int)(lds0+LDS_V)+((lane>>4)&1)*32+(lane&3)*8+(4*hi+((lane&15)>>2))*64;
  const char*Kbase=shm+LDS_K; bf16x8 kf[8];
  const lds_cptr shm3=(lds_cptr)shm; const lds_cptr kp0=shm3+LDS_K+hi*1024+r32*16; const lds_cptr vp0=shm3+LDS_V+((lane>>4)&1)*32+(lane&3)*8+(4*hi+((lane&15)>>2))*64;
  const int NT=(q0+QB)/KVBLK;
  DMA_K(0,0);DMA_V(0,0);DMA_K(1,SLOTB);
  bf16x8 qr[4];
  #pragma unroll
  for(int d0=0;d0<4;++d0)qr[d0]=*reinterpret_cast<const bf16x8*>(&Qw[(long)r32*PQK+d0*16+hi*8]);
  float mhat=0.f,l_reg=0.f;f32x16 o[2];o[0]=f32x16{};o[1]=f32x16{};f32x16 negm=f32x16{};asm volatile("":"+v"(negm));
  const int qrel=wid*QBLK+r32;
  #define CMASK(P0,P1,t) do{int jb_=(t)-(NT-4); if(jb_>=0)cmask(P0,P1,jb_,qrel,hi);}while(0)
  bool resc=false;
  #define START(P0,P1) do{ const float rm=rowmax(P0,P1); resc=false; \
    { const float dl=rm; mhat=fadd_s(mhat,dl); \
      _Pragma("unroll") for(int r=0;r<16;++r){P0[r]=fsub_s(P0[r],dl);P1[r]=fsub_s(P1[r],dl);} \
      _Pragma("unroll") for(int r=0;r<16;++r)negm[r]=-mhat; asm volatile("":"+v"(negm)); } \
    _Pragma("unroll") for(int r=0;r<16;++r)P0[r]=__builtin_amdgcn_exp2f(P0[r]); }while(0)
  #define RESC() do{ if(resc){ asm volatile("s_waitcnt lgkmcnt(0)":::"memory"); \
      _Pragma("unroll") for(int d_=0;d_<2;++d_) _Pragma("unroll") for(int r=0;r<16;++r)o[d_][r]*=wsf[crow(r,hi)]; } }while(0)
  f32x16 pA0,pA1,pB0,pB1;
  int sl_prev=0,sl_cur=0,sl_next=SLOTB;
  #define ROT() do{sl_prev=sl_cur;sl_cur=sl_next;sl_next=(sl_next==(NSLOT-1)*SLOTB)?0:sl_next+SLOTB;}while(0)
  DMA_K(2,2*SLOTB);
  WAIT_BAR(3);
  qkt(pA0,pA1,Kbase,qr,negm,r32,hi);asm volatile("s_nop 15\n\ts_nop 7":"+v"(pA0),"+v"(pA1));CMASK(pA0,pA1,0);
  START(pA0,pA1);
  _Pragma("unroll") for(int r=0;r<16;++r)pA1[r]=__builtin_amdgcn_exp2f(pA1[r]);
  WAIT_BAR(0);
  DMA_K(3,0);DMA_V(1,SLOTB);
  ROT();
  kload8(kf,kp0+sl_cur);
  WAIT_BAR(2);
  s16x4 vlo[8],vhi[8]; u32x4 pw0,pw1,pw2,pw3;
  #define PKW(P,B) cvtpk_s(P[B],P[B+1])
  #define PAF(k) __builtin_bit_cast(bf16x8,pw##k)
  #define VFR(i) (bf16x8){vlo[i][0],vlo[i][1],vlo[i][2],vlo[i][3],vhi[i][0],vhi[i][1],vhi[i][2],vhi[i][3]}
  #define PIN(x) asm volatile("":"+v"(x))
  #define MX3(a,b,c) __builtin_fmaxf(__builtin_fmaxf((a),(b)),(c))
  #define GAPA(MF,A0,A1,A2,A3,W0,W1,PW) do{ MF; sacc+=A0; sacc+=A1; sacc+=A2; sacc+=A3; PIN(sacc); W0; W1; PIN(PW); SBAR(); }while(0)
  #define EX(v) __builtin_amdgcn_exp2f(v)
  #define GAPB(MF,X,B) do{ MF; X[B]=EX(X[B]); X[B+1]=EX(X[B+1]); X[B+2]=EX(X[B+2]); X[B+3]=EX(X[B+3]); PIN(X); SBAR(); }while(0)
  #define VRD(i) do{ vlo[i]=vtr(vp_+(((i)>>2)*4096+((i)&3)*1024)); vhi[i]=vtr(vp_+(((i)>>2)*4096+((i)&3)*1024+512)); }while(0)
  #define KRD(G,j) do{ if(G){ kload2(kf,kp0+sl_next,j); SBAR(); } }while(0)
  #define STEP(C0,C1,P0,P1,t,GK,GV,GL) do{ SBAR(); \
    const lds_cptr vp_=vp0+sl_prev; \
    VRD(0); SBAR(); float sacc=(P0[0]+P0[1]); \
    GAPA(C0=__builtin_amdgcn_mfma_f32_32x32x16_bf16(kf[0],qr[0],negm,0,0,0), P0[2],P0[3],P0[4],P0[5],     pw0[0]=PKW(P0,0), pw0[1]=PKW(P0,2), pw0); \
    VRD(4); SBAR(); GAPA(C1=__builtin_amdgcn_mfma_f32_32x32x16_bf16(kf[1],qr[0],negm,0,0,0), P0[6],P0[7],P0[8],P0[9],     pw0[2]=PKW(P0,4), pw0[3]=PKW(P0,6), pw0); \
    VRD(1); SBAR(); GAPA(C0=__builtin_amdgcn_mfma_f32_32x32x16_bf16(kf[2],qr[1],C0,0,0,0),   P0[10],P0[11],P0[12],P0[13], pw1[0]=PKW(P0,8), pw1[1]=PKW(P0,10), pw1); \
    VRD(5); SBAR(); GAPA(C1=__builtin_amdgcn_mfma_f32_32x32x16_bf16(kf[3],qr[1],C1,0,0,0),   P0[14],P0[15],P1[0],P1[1],   pw1[2]=PKW(P0,12),pw1[3]=PKW(P0,14), pw1); \
    VRD(2); SBAR(); GAPA(C0=__builtin_amdgcn_mfma_f32_32x32x16_bf16(kf[4],qr[2],C0,0,0,0),   P1[2],P1[3],P1[4],P1[5],     pw2[0]=PKW(P1,0), pw2[1]=PKW(P1,2), pw2); \
    VRD(6); SBAR(); GAPA(C1=__builtin_amdgcn_mfma_f32_32x32x16_bf16(kf[5],qr[2],C1,0,0,0),   P1[6],P1[7],P1[8],P1[9],     pw2[2]=PKW(P1,4), pw2[3]=PKW(P1,6), pw2); \
    VRD(3); SBAR(); GAPA(C0=__builtin_amdgcn_mfma_f32_32x32x16_bf16(kf[6],qr[3],C0,0,0,0),   P1[10],P1[11],P1[12],P1[13], pw3[0]=PKW(P1,8), pw3[1]=PKW(P1,10), pw3); \
    VRD(7); SBAR(); GAPA(C1=__builtin_amdgcn_mfma_f32_32x32x16_bf16(kf[7],qr[3],C1,0,0,0),   P1[14],P1[15],0.f,0.f,       pw3[2]=PKW(P1,12),pw3[3]=PKW(P1,14), pw3); \
    l_reg+=sacc; \
    if(GK){DMA_K((t)+3,sl_cur);} if(GV){DMA_V((t)+1,sl_next);} \
    CMASK(C0,C1,t); \
    { float a=MX3(C0[0],C0[1],C1[0]),b=MX3(C0[2],C0[3],C1[1]); a=MX3(a,C1[2],C1[3]); \
      _Pragma("unroll") for(int r=4;r<16;r+=4){a=MX3(a,C0[r],C0[r+1]);b=MX3(b,C0[r+2],C0[r+3]);a=MX3(a,C1[r],C1[r+1]);b=MX3(b,C1[r+2],C1[r+3]);} \
      float rm=__builtin_fmaxf(a,b); { auto rr=__builtin_amdgcn_permlane32_swap(__float_as_uint(rm),__float_as_uint(rm),false,false); rm=__builtin_fmaxf(__uint_as_float(rr[0]),__uint_as_float(rr[1])); } \
      resc=false; \
      if(__builtin_expect(__any(rm>(float)THRL),0)){ const float dl=__builtin_fmaxf(rm,0.f); mhat+=dl; \
        _Pragma("unroll") for(int r=0;r<16;++r){C0[r]-=dl;C1[r]-=dl;} \
        _Pragma("unroll") for(int r=0;r<16;++r)negm[r]=-mhat; asm volatile("":"+v"(negm)); \
        const float f=__builtin_amdgcn_exp2f(-dl); l_reg*=f; if(hi==0)wsf[r32]=f; resc=true; } } \
    SBAR(); \
    GAPB(o[0]=__builtin_amdgcn_mfma_f32_32x32x16_bf16(PAF(0),VFR(0),o[0],0,0,0), C0,0); \
    GAPB(o[1]=__builtin_amdgcn_mfma_f32_32x32x16_bf16(PAF(0),VFR(4),o[1],0,0,0), C0,4); \
    KRD(GL,0); GAPB(o[0]=__builtin_amdgcn_mfma_f32_32x32x16_bf16(PAF(1),VFR(1),o[0],0,0,0), C0,8); \
    KRD(GL,1); GAPB(o[1]=__builtin_amdgcn_mfma_f32_32x32x16_bf16(PAF(1),VFR(5),o[1],0,0,0), C0,12); \
    KRD(GL,2); GAPB(o[0]=__builtin_amdgcn_mfma_f32_32x32x16_bf16(PAF(2),VFR(2),o[0],0,0,0), C1,0); \
    KRD(GL,3); GAPB(o[1]=__builtin_amdgcn_mfma_f32_32x32x16_bf16(PAF(2),VFR(6),o[1],0,0,0), C1,4); \
    GAPB(o[0]=__builtin_amdgcn_mfma_f32_32x32x16_bf16(PAF(3),VFR(3),o[0],0,0,0), C1,8); \
    GAPB(o[1]=__builtin_amdgcn_mfma_f32_32x32x16_bf16(PAF(3),VFR(7),o[1],0,0,0), C1,12); \
    }while(0)
  int t=1;
  #undef CMASK
  #define CMASK(P0,P1,t) do{}while(0)
  for(;t+5<NT;t+=2){
    STEP(pB0,pB1,pA0,pA1,t,true,true,true);     WAIT_BAR(2); RESC(); ROT();
    STEP(pA0,pA1,pB0,pB1,t+1,true,true,true);   WAIT_BAR(2); RESC(); ROT();
  }
  #undef CMASK
  #define CMASK(P0,P1,t) do{int jb_=(t)-(NT-4); if(jb_>=0)cmask(P0,P1,jb_,qrel,hi);}while(0)
  #define ENDW(tt) do{ if((tt)+3<NT){WAIT_BAR(2);} else if((tt)+2<NT){WAIT_BAR(1);} else {WAIT_BAR(0);} }while(0)
  for(;t+1<NT;t+=2){
    STEP(pB0,pB1,pA0,pA1,t,(t+3<NT),(t+1<NT),(t+1<NT));       ENDW(t);   RESC(); ROT();
    STEP(pA0,pA1,pB0,pB1,t+1,(t+4<NT),(t+2<NT),(t+2<NT));     ENDW(t+1); RESC(); ROT();
  }
  STEP(pB0,pB1,pA0,pA1,NT-1,false,false,false); RESC();
  { float sacc=pB0[0]+pB0[1]; _Pragma("unroll") for(int r=2;r<16;++r)sacc+=pB0[r]; _Pragma("unroll") for(int r=0;r<16;++r)sacc+=pB1[r]; l_reg+=sacc;
    pw0=(u32x4){PKW(pB0,0),PKW(pB0,2),PKW(pB0,4),PKW(pB0,6)};pw1=(u32x4){PKW(pB0,8),PKW(pB0,10),PKW(pB0,12),PKW(pB0,14)};pw2=(u32x4){PKW(pB1,0),PKW(pB1,2),PKW(pB1,4),PKW(pB1,6)};pw3=(u32x4){PKW(pB1,8),PKW(pB1,10),PKW(pB1,12),PKW(pB1,14)};
    SBAR(); pv(o,vb0+sl_cur,PAF(0),PAF(1),PAF(2),PAF(3)); }
  #undef PKW
  #undef PAF
  #undef VFR
  #undef PIN
  #undef MX3
  #undef GAPA
  #undef GAPB
  #undef EX
  #undef VRD
  #undef KRD
  #undef STEP
  #undef ENDW
  {auto rr=__builtin_amdgcn_permlane32_swap(__float_as_uint(l_reg),__float_as_uint(l_reg),false,false);l_reg=__uint_as_float(rr[0])+__uint_as_float(rr[1]);}
  if(hi==0)wsf[32+r32]=l_reg;asm volatile("s_waitcnt lgkmcnt(0)":::"memory");
  float rli[16];
  #pragma unroll
  for(int r=0;r<16;++r)rli[r]=__builtin_amdgcn_rcpf(wsf[32+crow(r,hi)]);
  bf16*Ow=O+(rowbase+q0+wid*QBLK)*PO;
  { bf16*stg=(bf16*)(shm+LDS_OST)+wid*2048;
    #pragma unroll
    for(int r=0;r<16;++r){const int orow=crow(r,hi);
      #pragma unroll
      for(int d0=0;d0<2;++d0)stg[orow*64+d0*32+r32]=__float2bfloat16(o[d0][r]*rli[r]);}
    asm volatile("s_waitcnt lgkmcnt(0)":::"memory");
    #pragma unroll
    for(int i=0;i<4;++i){const int row=i*8+(lane>>3),ch=lane&7; const u32x4 v=*(const u32x4*)(stg+row*64+ch*8); ATTN_STORE16(Ow+(long)row*PO+ch*8,v);} }
  asm volatile("s_waitcnt lgkmcnt(0)\n\ts_barrier":::"memory");
  #undef DMA_K
  #undef DMA_V
  #undef CMASK
  #undef START
  #undef RESC
  #undef ROT
}
#undef SBAR
#undef WAIT_BAR
}
namespace cg = cooperative_groups;
#define LAS __attribute__((address_space(3)))
typedef unsigned short bf16;
typedef unsigned v4u __attribute__((ext_vector_type(4)));
typedef unsigned v2u __attribute__((ext_vector_type(2)));
typedef float f32x4 __attribute__((ext_vector_type(4)));
typedef float f32x2 __attribute__((ext_vector_type(2)));
typedef float f32x16 __attribute__((ext_vector_type(16)));
typedef short bf16x8 __attribute__((ext_vector_type(8)));

constexpr int NWAVES = 8;
constexpr int D = 1024, MP = 16384, MS = 256, M = MP + MS, FF = 2816, DIN = 2560;
constexpr float EPS = 1e-6f;
constexpr float C2 = 0.125f * 1.4426950408889634f;
constexpr size_t OFF_Y = 0, OFF_KP = 17039360, OFF_VP = 33816576, OFF_PP = 50593792, OFF_CP = 50655232, OFF_KS = 50663424, OFF_VS = 50925568, OFF_PS = 51187712, OFF_CS = 51249152, OUT_TOTAL = 51257344;
constexpr size_t MiB = 1u << 20;
constexpr size_t WS_ROPE = 1 * MiB, WS_POOLWT = 2 * MiB, WS_W = 4 * MiB, WL = 40 * MiB;
constexpr size_t W_GU1 = 0, W_D1 = 11 * MiB, W_IN = 16 * MiB + MiB / 2, W_OUT = 21 * MiB + MiB / 2, W_GU2 = 23 * MiB + MiB / 2, W_D2 = 34 * MiB + MiB / 2;
constexpr size_t WS_X = 84 * MiB, WS_H = 149 * MiB, WS_MIX = 182 * MiB, WS_ACT = 215 * MiB;
constexpr size_t WS_QB = 215 * MiB, WS_KB = 232 * MiB, WS_VB = 249 * MiB, WS_ZB = 266 * MiB;
constexpr size_t WS_OB = 305 * MiB, WS_OPART = 338 * MiB, WS_ML = 347 * MiB, WS_END = 352 * MiB;
static_assert(WS_ROPE == pg8::WOFF_ROPE && WS_QB == pg8::WOFF_QB && WS_KB == pg8::WOFF_KB && WS_VB == pg8::WOFF_VB && WS_ZB == pg8::WOFF_ZB && OFF_KP == pg8::OOFF_KP && OFF_VP == pg8::OOFF_VP && OFF_PP == pg8::OOFF_PP && OFF_KS == pg8::OOFF_KS && OFF_VS == pg8::OOFF_VS && OFF_PS == pg8::OOFF_PS, "offsets");
static_assert(WS_ACT + (size_t)M * FF * 2 <= WS_OB && WS_ZB + (size_t)M * 1024 * 2 <= WS_OB && WS_X + (size_t)M * D * 4 <= WS_H && WS_H + (size_t)M * D * 2 <= WS_MIX && WS_MIX + (size_t)M * D * 2 <= WS_ACT, "ws map");
static_assert(WS_OB + (size_t)M * 1024 * 2 <= WS_OPART && WS_OPART + (size_t)32 * 2 * 9 * 32 * 128 * 4 <= WS_ML && WS_ML + (size_t)32 * 2 * 9 * 32 * 2 * 4 <= WS_END, "ws map 2");
constexpr int LDS_BYTES = 147456;
constexpr size_t CTL_BYTES = 262144, CTL_CNT = 65536;
constexpr size_t WS_SLOTP = 350 * MiB, WS_SLOTS = 351 * MiB;

__device__ __forceinline__ unsigned pk2(float lo, float hi) { f32x2 v = {lo, hi}; typedef __bf16 b2 __attribute__((ext_vector_type(2))); b2 b = __builtin_convertvector(v, b2); return __builtin_bit_cast(unsigned, b); }
__device__ __forceinline__ float bf2f(unsigned short b) { return __builtin_bit_cast(float, (unsigned)b << 16); }
__device__ __forceinline__ bf16x8 pack8(f32x4 a, f32x4 b) { v4u w; w.x = pk2(a.x, a.y); w.y = pk2(a.z, a.w); w.z = pk2(b.x, b.y); w.w = pk2(b.z, b.w); return __builtin_bit_cast(bf16x8, w); }
__device__ __forceinline__ int crow(int r, int hi) { return (r & 3) + 8 * (r >> 2) + 4 * hi; }
__device__ __forceinline__ void xhalf_pair(float m, float& a, float& b) { a = m; b = m; asm volatile("s_nop 1\n\tv_permlane32_swap_b32 %0, %1\n\ts_nop 1" : "+v"(a), "+v"(b)); }
__device__ __forceinline__ float xhalf_max(float m) { float a, b; xhalf_pair(m, a, b); return fmaxf(a, b); }
__device__ __forceinline__ float xhalf_sum(float m) { float a, b; xhalf_pair(m, a, b); return a + b; }
template <int O> __device__ __forceinline__ float swz_xor(float v) { return __builtin_bit_cast(float, __builtin_amdgcn_ds_swizzle(__builtin_bit_cast(int, v), (O << 10) | 0x1f)); }
__device__ __forceinline__ float wave_sum(float v) {
    v += swz_xor<1>(v); v += swz_xor<2>(v); v += swz_xor<4>(v); v += swz_xor<8>(v); v += swz_xor<16>(v);
    return xhalf_sum(v);
}
#define LDS_WAIT() asm volatile("s_waitcnt lgkmcnt(0)" ::: "memory")

struct Params { const float* in[26]; float* out; unsigned char* ws; };
typedef const __attribute__((address_space(4))) unsigned char* karg_ptr;
__device__ __forceinline__ karg_ptr kargs() { karg_ptr k = (karg_ptr)__builtin_amdgcn_kernarg_segment_ptr(); asm volatile("" : "+s"(k)); return k; }
__device__ __forceinline__ const float* KIN(int i) { return *(const float* const __attribute__((address_space(4)))*)(kargs() + 8 * i); }
__device__ __forceinline__ float* KOUT() { return *(float* const __attribute__((address_space(4)))*)(kargs() + 8 * 26); }
__device__ __forceinline__ unsigned char* KWS() { return *(unsigned char* const __attribute__((address_space(4)))*)(kargs() + 8 * 27); }

template <int MODE> __device__ __forceinline__ int wmap(int nl, int row_off) {
    if (MODE == 0) return row_off + nl;
    if (MODE == 1) return (nl >> 7) * 256 + (nl & 127) + row_off;
    const int u = nl >> 8, lc = nl & 255, A = lc >> 6, n = (lc >> 5) & 1, B = (lc >> 4) & 1, f = lc & 15;
    return u * 256 + 128 * (A >> 1) + 32 * (2 * (A & 1) + B) + 16 * n + f;
}
template <int MODE> __device__ __forceinline__ void transpose_item(const float* W, int K, int N, bf16* WT, int row_off, LAS float* scr, int item, int lane) {
    const int nblk = N / 32, kb = item / nblk, nb = item % nblk, k0 = 64 * kb, n0 = 32 * nb;
#pragma unroll 8
    for (int i = 0; i < 32; ++i) { const int kk = 2 * i + (lane >> 5); scr[kk * 33 + (lane & 31)] = W[(size_t)(k0 + kk) * N + n0 + (lane & 31)]; }
    LDS_WAIT(); asm volatile("" ::: "memory");
    const int c = lane & 7;
#pragma unroll
    for (int j = 0; j < 4; ++j) { const int n = (lane >> 3) + 8 * j; const LAS float* s = scr + (8 * c) * 33 + n;
        v4u o; o.x = pk2(s[0 * 33], s[1 * 33]); o.y = pk2(s[2 * 33], s[3 * 33]); o.z = pk2(s[4 * 33], s[5 * 33]); o.w = pk2(s[6 * 33], s[7 * 33]);
        *(v4u*)(WT + (size_t)wmap<MODE>(n0 + n, row_off) * K + k0 + 8 * c) = o; }
    LDS_WAIT(); asm volatile("" ::: "memory");
}
__device__ __forceinline__ void prologue(LAS unsigned char* lds, int gw, int NGW, int wave, int lane) {
    LAS float* scr = (LAS float*)(lds + wave * 16384);
    constexpr int I_F = 16 * 88, I_IN = 16 * 80, I_OUT = 16 * 32, I_L = 6 * I_F + I_IN + I_OUT;
    for (int it = gw; it < 2 * I_L; it += NGW) {
        const int l = it / I_L; int r = it % I_L;
        unsigned char* wl = KWS() + WS_W + (size_t)l * WL;
        if (r < I_F) { transpose_item<1>(KIN(7) + (size_t)l * D * FF, D, FF, (bf16*)(wl + W_GU1), 0, scr, r, lane); continue; } r -= I_F;
        if (r < I_F) { transpose_item<1>(KIN(8) + (size_t)l * D * FF, D, FF, (bf16*)(wl + W_GU1), 128, scr, r, lane); continue; } r -= I_F;
        if (r < I_F) { transpose_item<0>(KIN(9) + (size_t)l * D * FF, FF, D, (bf16*)(wl + W_D1), 0, scr, r, lane); continue; } r -= I_F;
        if (r < I_IN) { transpose_item<2>(KIN(11) + (size_t)l * D * DIN, D, DIN, (bf16*)(wl + W_IN), 0, scr, r, lane); continue; } r -= I_IN;
        if (r < I_OUT) { transpose_item<0>(KIN(20) + (size_t)l * D * D, D, D, (bf16*)(wl + W_OUT), 0, scr, r, lane); continue; } r -= I_OUT;
        if (r < I_F) { transpose_item<1>(KIN(22) + (size_t)l * D * FF, D, FF, (bf16*)(wl + W_GU2), 0, scr, r, lane); continue; } r -= I_F;
        if (r < I_F) { transpose_item<1>(KIN(23) + (size_t)l * D * FF, D, FF, (bf16*)(wl + W_GU2), 128, scr, r, lane); continue; } r -= I_F;
        transpose_item<0>(KIN(24) + (size_t)l * D * FF, FF, D, (bf16*)(wl + W_D2), 0, scr, r, lane);
    }
    float* rope = (float*)(KWS() + WS_ROPE);
    for (int i = gw * 64 + lane; i < 2080 * 32; i += NGW * 64) {
        const int pr = i >> 5, d = i & 31; const int pos = pr < 2048 ? pr : 4096 + (pr - 2048);
        const float inv = exp2f(-(float)d * (13.287712379549449f / 32.0f));
        const float ang = (float)pos * inv;
        const double rev = (double)ang * 0.15915494309189535; const float fr = (float)(rev - __builtin_rint(rev));
        rope[pr * 64 + d] = __builtin_amdgcn_cosf(fr); rope[pr * 64 + 32 + d] = __builtin_amdgcn_sinf(fr);
    }
    bf16* pwt_ = (bf16*)(KWS() + WS_POOLWT);
    for (int i = gw * 64 + lane; i < 2 * 4 * 64 * 64; i += NGW * 64) {
        const int c = i & 63, e = (i >> 6) & 63, lg = i >> 12;
        pwt_[i] = (bf16)(pk2(KIN(17)[(size_t)lg * 4096 + c * 64 + e], 0.f) & 0xffffu);
    }
}
template <bool FINAL> __device__ __forceinline__ void norm_rows(const float* srcP, const float* srcS, const float* g, bf16* H, float* outf, int gw, int NGW, int lane) {
    const f32x4* g4 = (const f32x4*)g + lane;
    f32x4 gv[4];
#pragma unroll
    for (int j = 0; j < 4; ++j) gv[j] = g4[64 * j];
    for (int m = gw; m < M; m += NGW) {
        const float* xr = (m < MP) ? srcP + (size_t)m * D : srcS + (size_t)(m - MP) * D;
        const f32x4* x4 = (const f32x4*)xr + lane;
        f32x4 v[4]; float s = 0.f;
#pragma unroll
        for (int j = 0; j < 4; ++j) { v[j] = x4[64 * j]; s += (v[j].x * v[j].x + v[j].y * v[j].y) + (v[j].z * v[j].z + v[j].w * v[j].w); }
        const float rstd = 1.0f / sqrtf(wave_sum(s) * (1.0f / D) + EPS);
        if (FINAL) {
            f32x4* o4 = (f32x4*)(outf + (size_t)m * D) + lane;
#pragma unroll
            for (int j = 0; j < 4; ++j) o4[64 * j] = v[j] * rstd * gv[j];
        } else {
            v2u* o2 = (v2u*)(H + (size_t)m * D) + lane;
#pragma unroll
            for (int j = 0; j < 4; ++j) { const f32x4 y = v[j] * rstd * gv[j]; v2u w; w.x = pk2(y.x, y.y); w.y = pk2(y.z, y.w); o2[64 * j] = w; }
        }
    }
}
__device__ __forceinline__ f32x16 mfma32(bf16x8 a, bf16x8 b, f32x16 c) { return __builtin_amdgcn_mfma_f32_32x32x16_bf16(a, b, c, 0, 0, 0); }


template <bool BASE16, int K> __device__ __forceinline__ void skinny_gemm(LAS unsigned char* lds, const bf16* A, const bf16* Bt, const void* base, bf16* out, float scale, bf16* hb, float* yout, const float* gain,
                                            unsigned* slots, unsigned* cnt8, int vcu, int G, int tid) {
    const int lane = tid & 63, r32 = lane & 31, hi = lane >> 5, wid = __builtin_amdgcn_readfirstlane(tid >> 6);
    LAS float* R = (LAS float*)lds;
    __syncthreads();
    for (int tile = vcu; tile < 256; tile += G) {
        const int rt = tile >> 5, ct = tile & 31, kw = K >> 3, k0 = wid * kw;
        const bf16* ap = A + (size_t)(rt * 32 + r32) * K + k0 + hi * 8; const bf16* bp = Bt + (size_t)(ct * 32 + r32) * K + k0 + hi * 8;
        f32x16 acc;
#pragma unroll
        for (int r = 0; r < 16; ++r) acc[r] = 0.f;
        constexpr int NST = K / 128, UB = (NST % 11 == 0) ? 11 : 8;
#pragma unroll 1
        for (int s0 = 0; s0 < NST; s0 += UB) { bf16x8 av[UB], bw[UB];
#pragma unroll
            for (int j = 0; j < UB; ++j) { av[j] = *(const bf16x8*)(ap + (s0 + j) * 16); bw[j] = *(const bf16x8*)(bp + (s0 + j) * 16); }
#pragma unroll
            for (int j = 0; j < UB; ++j) acc = mfma32(av[j], bw[j], acc); }
#pragma unroll
        for (int r = 0; r < 16; ++r) R[(wid * 32 + crow(r, hi)) * 32 + r32] = acc[r];
        __syncthreads();
        const int e = tid * 2, row = e >> 5, col = e & 31; f32x2 s = {0.f, 0.f};
#pragma unroll
        for (int w = 0; w < 8; ++w) s += *(const LAS f32x2*)(R + (w * 32 + row) * 32 + col);
        const size_t o = (size_t)(rt * 32 + row) * 1024 + ct * 32 + col; f32x2 bv; if (BASE16) { const unsigned bw = *(const unsigned*)((const bf16*)base + o); bv.x = bf2f(bw & 0xffff); bv.y = bf2f(bw >> 16); } else bv = *(const f32x2*)((const float*)base + o);
        const f32x2 v = bv + s * scale;
        if (out) *(unsigned*)(out + o) = pk2(v.x, v.y);
        float ss = v.x * v.x + v.y * v.y; ss += swz_xor<1>(ss); ss += swz_xor<2>(ss); ss += swz_xor<4>(ss); ss += swz_xor<8>(ss);
        if ((tid & 15) == 0) __hip_atomic_store(slots + (size_t)(rt * 32 + row) * 32 + ct, __builtin_bit_cast(unsigned, ss), __ATOMIC_RELAXED, __HIP_MEMORY_SCOPE_AGENT);
        asm volatile("s_waitcnt vmcnt(0)" ::: "memory");
        __syncthreads();
        if (tid == 0) {
            __hip_atomic_fetch_add(cnt8 + 64 * rt, 1u, __ATOMIC_RELAXED, __HIP_MEMORY_SCOPE_AGENT);
            unsigned spins = 0;
            while (__hip_atomic_load(cnt8 + 64 * rt, __ATOMIC_RELAXED, __HIP_MEMORY_SCOPE_AGENT) < 32u) { __builtin_amdgcn_s_sleep(2); if (++spins > (1u << 22)) break; }
            __builtin_amdgcn_fence(__ATOMIC_ACQUIRE, "agent");
            asm volatile("s_waitcnt vmcnt(0)" ::: "memory");
        }
        __syncthreads();
        { const unsigned* sl = slots + (size_t)(rt * 32 + row) * 32 + (tid & 15) * 2;
          float tot = __builtin_bit_cast(float, __hip_atomic_load(sl, __ATOMIC_RELAXED, __HIP_MEMORY_SCOPE_AGENT)) + __builtin_bit_cast(float, __hip_atomic_load(sl + 1, __ATOMIC_RELAXED, __HIP_MEMORY_SCOPE_AGENT));
          tot += swz_xor<1>(tot); tot += swz_xor<2>(tot); tot += swz_xor<4>(tot); tot += swz_xor<8>(tot);
          const float r = 1.0f / sqrtf(tot * (1.0f / 1024.0f) + EPS);
          const f32x2 gv = *(const f32x2*)(gain + ct * 32 + col); const f32x2 y = v * r * gv;
          if (hb) *(unsigned*)(hb + o) = pk2(y.x, y.y); else *(f32x2*)(yout + o) = y; }
        __syncthreads();
    }
}

__device__ __forceinline__ void sample_piece(LAS unsigned char* lds, int pc, int l, const bf16* Qb, const float* cache_k, const float* cache_v, const float* knew, const float* vnew, float* OPART, float* MLP, int tid) {
    const int lane = tid & 63, r32 = lane & 31, hi = lane >> 5, wid = __builtin_amdgcn_readfirstlane(tid >> 6);
    const int b = pc >> 5, h = (pc >> 3) & 3, s = pc & 7;
    const bf16* qrow = Qb + (size_t)(MP + b * 32 + r32) * 512 + h * 128 + hi * 8;
    LAS float* ML = (LAS float*)lds;
    LAS float* FAC = (LAS float*)(lds + 4096);
    LAS float* OX = (LAS float*)(lds + 8192);
    const bool extra = (s == 7) && (wid == 7);
    const size_t off = ((size_t)((l * 8 + b) * 4096 + (s * 8 + wid) * 64)) * 512 + h * 128;
    const size_t offx = ((size_t)(l * 8 + b) * 32) * 512 + h * 128;
    const float* Kt = cache_k + off; const float* Vt = cache_v + off; const float* Kx = knew + offx; const float* Vx = vnew + offx;
    float mrow[2], lrow[2]; bf16x8 pw[2][6];
#pragma unroll
    for (int c = 0; c < 2; ++c) {
        bf16x8 qf[4];
#pragma unroll
        for (int d0 = 0; d0 < 4; ++d0) qf[d0] = *(const bf16x8*)(qrow + c * 64 + d0 * 16);
        f32x16 sc[3];
#pragma unroll
        for (int kvb = 0; kvb < 3; ++kvb) {
            if (kvb < 2 || extra) {
                f32x16 a;
#pragma unroll
                for (int r = 0; r < 16; ++r) a[r] = 0.f;
                const float* kp = (kvb < 2 ? Kt + (size_t)(kvb * 32 + r32) * 512 : Kx + (size_t)r32 * 512) + c * 64 + hi * 8;
#pragma unroll
                for (int d0 = 0; d0 < 4; ++d0) { const f32x4 x0 = *(const f32x4*)(kp + d0 * 16), x1 = *(const f32x4*)(kp + d0 * 16 + 4); a = mfma32(pack8(x0, x1), qf[d0], a); }
                sc[kvb] = a;
            } else {
#pragma unroll
                for (int r = 0; r < 16; ++r) sc[kvb][r] = -1e30f;
            }
        }
        float mx = -1e30f;
#pragma unroll
        for (int r = 0; r < 16; ++r) mx = fmaxf(mx, fmaxf(fmaxf(sc[0][r], sc[1][r]), sc[2][r]));
        mx = xhalf_max(mx);
        float sum = 0.f;
#pragma unroll
        for (int kvb = 0; kvb < 3; ++kvb)
#pragma unroll
            for (int r = 0; r < 16; ++r) { const float pv = __builtin_amdgcn_exp2f(sc[kvb][r] - mx); sc[kvb][r] = pv; sum += pv; }
        sum = xhalf_sum(sum);
        mrow[c] = mx; lrow[c] = sum;
#pragma unroll
        for (int kvb = 0; kvb < 3; ++kvb)
#pragma unroll
            for (int hf = 0; hf < 2; ++hf) { v4u w; w.x = pk2(sc[kvb][8 * hf + 0], sc[kvb][8 * hf + 1]); w.y = pk2(sc[kvb][8 * hf + 2], sc[kvb][8 * hf + 3]);
                w.z = pk2(sc[kvb][8 * hf + 4], sc[kvb][8 * hf + 5]); w.w = pk2(sc[kvb][8 * hf + 6], sc[kvb][8 * hf + 7]); pw[c][2 * kvb + hf] = __builtin_bit_cast(bf16x8, w); }
    }
    asm volatile("" ::: "memory");
    f32x16 o[2][4];
#pragma unroll
    for (int c = 0; c < 2; ++c)
#pragma unroll
        for (int eb = 0; eb < 4; ++eb)
#pragma unroll
            for (int r = 0; r < 16; ++r) o[c][eb][r] = 0.f;
#pragma unroll
    for (int ks = 0; ks < 6; ++ks) {
        if (ks < 4 || extra) {
#pragma unroll
            for (int eb = 0; eb < 4; ++eb) {
                const float* vp = (ks < 4 ? Vt + (size_t)(ks * 16 + 4 * hi) * 512 : Vx + (size_t)((ks - 4) * 16 + 4 * hi) * 512) + eb * 32 + r32;
                f32x4 x0, x1;
                x0.x = vp[0 * 512]; x0.y = vp[1 * 512]; x0.z = vp[2 * 512]; x0.w = vp[3 * 512];
                x1.x = vp[8 * 512]; x1.y = vp[9 * 512]; x1.z = vp[10 * 512]; x1.w = vp[11 * 512];
                const bf16x8 vf = pack8(x0, x1);
                o[0][eb] = mfma32(pw[0][ks], vf, o[0][eb]); o[1][eb] = mfma32(pw[1][ks], vf, o[1][eb]);
            }
        }
    }
    if (hi == 0) {
#pragma unroll
        for (int c = 0; c < 2; ++c) { ML[((wid * 2 + c) * 32 + r32) * 2 + 0] = mrow[c]; ML[((wid * 2 + c) * 32 + r32) * 2 + 1] = lrow[c]; }
    }
    __syncthreads();
    const int pidx = s;
    if (tid < 64) {
        const int c = tid >> 5, q = tid & 31; float mw[8], lw[8]; float Mx = -1e30f;
#pragma unroll
        for (int w = 0; w < 8; ++w) { mw[w] = ML[((w * 2 + c) * 32 + q) * 2 + 0]; lw[w] = ML[((w * 2 + c) * 32 + q) * 2 + 1]; Mx = fmaxf(Mx, mw[w]); }
        float L = 0.f;
#pragma unroll
        for (int w = 0; w < 8; ++w) { const float fz = __builtin_amdgcn_exp2f(mw[w] - Mx); FAC[(w * 2 + c) * 32 + q] = fz; L += lw[w] * fz; }
        float* mp = MLP + ((size_t)((((b * 4 + h) * 2 + c) * 9 + pidx) * 32 + q)) * 2; mp[0] = Mx; mp[1] = L;
    }
    __syncthreads();
#pragma unroll
    for (int c = 0; c < 2; ++c) {
#pragma unroll
        for (int eb = 0; eb < 4; ++eb)
#pragma unroll
            for (int r = 0; r < 16; ++r) { const int q = crow(r, hi); OX[(wid * 32 + q) * 128 + eb * 32 + r32] = o[c][eb][r] * FAC[(wid * 2 + c) * 32 + q]; }
        __syncthreads();
        { const int idx = tid * 8, q = idx >> 7, e = idx & 127; f32x4 s0 = {0.f, 0.f, 0.f, 0.f}, s1 = {0.f, 0.f, 0.f, 0.f};
#pragma unroll
          for (int w = 0; w < 8; ++w) { s0 += *(const LAS f32x4*)(OX + (w * 32 + q) * 128 + e); s1 += *(const LAS f32x4*)(OX + (w * 32 + q) * 128 + e + 4); }
          float* dst = OPART + ((size_t)((((b * 4 + h) * 2 + c) * 9 + pidx) * 32 + q)) * 128 + e; *(f32x4*)dst = s0; *(f32x4*)(dst + 4) = s1; }
        __syncthreads();
    }
}

template <int W> __device__ __forceinline__ void pool_d(const LAS float* U, LAS bf16* Dd, int ch, int tbeg, int t0, bool smp) {
    float s = 0.f;
#pragma unroll
    for (int i = 0; i < W; ++i) s += U[(15 + tbeg - i) * 256 + ch];
#pragma unroll 8
    for (int k = 0; k < 32; ++k) {
        const int tt = tbeg + k; const float cur = U[(15 + tt) * 256 + ch];
        if (k > 0) s += cur - U[(15 + tt - W) * 256 + ch];
        const int pos = smp ? 4096 + tt : t0 + tt; const int cnt = (pos + 1 < W) ? pos + 1 : W;
        const float d = s * __builtin_amdgcn_rcpf((float)cnt) - cur;
        Dd[tt * 264 + ch] = (bf16)(pk2(d, 0.f) & 0xffffu);
    }
}
__device__ __forceinline__ f32x4 bf4_to_f32(v2u w) { f32x4 v; v.x = bf2f(w.x & 0xffff); v.y = bf2f(w.x >> 16); v.z = bf2f(w.y & 0xffff); v.w = bf2f(w.y >> 16); return v; }
__device__ __forceinline__ void poolconv_tile(LAS unsigned char* lds, int tl, int l, const bf16* Zb, bf16* MIX, const float* state_pool, const float* state_conv, const bf16* pwt, const float* pool_scale,
                                              const float* conv_w, float* out_cp, float* out_cs, int tid) {
    const int lane = tid & 63, r32 = lane & 31, hi = lane >> 5, wid = __builtin_amdgcn_readfirstlane(tid >> 6);
    int b, t0, TT, rowbase; bool smp;
    if (tl < 256) { b = tl >> 5; t0 = (tl & 31) * 64; TT = 64; rowbase = b * 2048 + t0; smp = false; }
    else { b = tl - 256; t0 = 0; TT = 32; rowbase = MP + b * 32; smp = true; }
    LAS float* U = (LAS float*)lds;
    LAS bf16* Dd = (LAS bf16*)(lds + 81920);
    {
        f32x4 uv[10];
#pragma unroll
        for (int k = 0; k < 10; ++k) {
            const int idx = tid + 512 * k, i = idx >> 6, c4 = (idx & 63) * 4; f32x4 v = {0.f, 0.f, 0.f, 0.f};
            if (i < 15 + TT) {
                if (i < 15 && smp) v = *(const f32x4*)(state_pool + (size_t)((l * 8 + b) * 15 + i) * 256 + c4);
                else if (i >= 15 || t0 - 15 + i >= 0) v = bf4_to_f32(*(const v2u*)(Zb + (size_t)(rowbase + i - 15) * 1024 + c4));
            }
            uv[k] = v;
        }
#pragma unroll
        for (int k = 0; k < 10; ++k) { const int idx = tid + 512 * k, i = idx >> 6, c4 = (idx & 63) * 4; if (i < 15 + TT) *(LAS f32x4*)(U + i * 256 + c4) = uv[k]; }
    }
    __syncthreads();
    {
        const int ch = tid & 255, th = tid >> 8, gi = __builtin_amdgcn_readfirstlane(ch >> 6);
        if (th * 32 < TT) {
            if (gi == 0) pool_d<2>(U, Dd, ch, th * 32, t0, smp); else if (gi == 1) pool_d<4>(U, Dd, ch, th * 32, t0, smp);
            else if (gi == 2) pool_d<8>(U, Dd, ch, th * 32, t0, smp); else pool_d<16>(U, Dd, ch, th * 32, t0, smp);
        }
    }
    __syncthreads();
    {
        const int gi = wid >> 1, th = wid & 1;
        if (th * 32 < TT) {
            f32x16 acc0, acc1;
#pragma unroll
            for (int r = 0; r < 16; ++r) { acc0[r] = 0.f; acc1[r] = 0.f; }
#pragma unroll
            for (int ks = 0; ks < 4; ++ks) {
                const bf16x8 a = *(const LAS bf16x8*)(Dd + (th * 32 + r32) * 264 + gi * 64 + ks * 16 + hi * 8);
                const bf16x8 b0 = *(const bf16x8*)(pwt + (size_t)((l * 4 + gi) * 64 + r32) * 64 + ks * 16 + hi * 8);
                const bf16x8 b1 = *(const bf16x8*)(pwt + (size_t)((l * 4 + gi) * 64 + 32 + r32) * 64 + ks * 16 + hi * 8);
                acc0 = mfma32(a, b0, acc0); acc1 = mfma32(a, b1, acc1);
            }
            const float sc0 = pool_scale[l * 256 + gi * 64 + r32], sc1 = pool_scale[l * 256 + gi * 64 + 32 + r32];
#pragma unroll
            for (int r = 0; r < 16; ++r) { const int tok = th * 32 + crow(r, hi); bf16* mp = MIX + (size_t)(rowbase + tok) * 1024 + 512 + gi * 64 + r32;
                mp[0] = (bf16)(pk2(acc0[r] * sc0, 0.f) & 0xffffu); mp[32] = (bf16)(pk2(acc1[r] * sc1, 0.f) & 0xffffu); }
        }
    }
    if (wid * 8 < TT) {
        const int cq = lane, tc = wid * 8;
        v2u hraw[10], graw[10], braw[8]; f32x4 hst[2];
        hst[0] = (f32x4){0.f, 0.f, 0.f, 0.f}; hst[1] = hst[0];
#pragma unroll
        for (int i = 0; i < 10; ++i) {
            const int ts = tc - 2 + i; hraw[i] = (v2u){0u, 0u}; graw[i] = (v2u){0u, 0u};
            if (ts >= 0 || (!smp && t0 + ts >= 0)) { const bf16* zr = Zb + (size_t)(rowbase + ts) * 1024 + 4 * cq; hraw[i] = *(const v2u*)(zr + 256); graw[i] = *(const v2u*)(zr + 768); }
        }
#pragma unroll
        for (int i = 0; i < 8; ++i) braw[i] = *(const v2u*)(Zb + (size_t)(rowbase + tc + i) * 1024 + 512 + 4 * cq);
        if (smp && tc == 0) { hst[0] = *(const f32x4*)(state_conv + (size_t)((l * 8 + b) * 2 + 0) * 256 + 4 * cq); hst[1] = *(const f32x4*)(state_conv + (size_t)((l * 8 + b) * 2 + 1) * 256 + 4 * cq); }
        const f32x4 cw0 = *(const f32x4*)(conv_w + l * 768 + 4 * cq), cw1 = *(const f32x4*)(conv_w + l * 768 + 256 + 4 * cq), cw2 = *(const f32x4*)(conv_w + l * 768 + 512 + 4 * cq);
        f32x4 cm2 = bf4_to_f32(graw[0]) * bf4_to_f32(hraw[0]), cm1 = bf4_to_f32(graw[1]) * bf4_to_f32(hraw[1]);
        if (smp && tc == 0) { cm2 = hst[0]; cm1 = hst[1]; }
#pragma unroll
        for (int i = 0; i < 8; ++i) {
            const int tt = tc + i;
            const f32x4 cv = bf4_to_f32(graw[i + 2]) * bf4_to_f32(hraw[i + 2]);
            const f32x4 y = bf4_to_f32(braw[i]) * (cw0 * cm2 + cw1 * cm1 + cw2 * cv);
            v2u w; w.x = pk2(y.x, y.y); w.y = pk2(y.z, y.w);
            *(v2u*)(MIX + (size_t)(rowbase + tt) * 1024 + 768 + 4 * cq) = w;
            if (smp) { if (tt >= 30) *(f32x4*)(out_cs + (size_t)((l * 8 + b) * 2 + tt - 30) * 256 + 4 * cq) = cv; }
            else if (t0 + tt >= 2046) *(f32x4*)(out_cp + (size_t)((l * 8 + b) * 2 + t0 + tt - 2046) * 256 + 4 * cq) = cv;
            cm2 = cm1; cm1 = cv;
        }
    }
    __syncthreads();
}

__device__ __forceinline__ void combine_phase(int l, const bf16* Ob_, const float* OPART_, const float* MLP_, bf16* MIX_, int gw, int NGW, int lane) {
    const float lam_init = (l == 0) ? 0.2f : 0.35550934f;
    float lam;
    { const float a = KIN(12)[l * 64 + lane] * KIN(13)[l * 64 + lane], c = KIN(14)[l * 64 + lane] * KIN(15)[l * 64 + lane];
      lam = __expf(wave_sum(a)) - __expf(wave_sum(c)) + lam_init; }
    const float g0 = KIN(16)[l * 128 + 2 * lane], g1 = KIN(16)[l * 128 + 2 * lane + 1];
    for (int base = gw * 8; base < MP * 4; base += NGW * 8) {
        float a0[8], a1[8];
        {
            unsigned w1[8], w2[8];
#pragma unroll
            for (int j = 0; j < 8; ++j) { const int wt = base + j, row = wt >> 2, h = wt & 3;
                w1[j] = *(const unsigned*)(Ob_ + (size_t)row * 1024 + h * 128 + 2 * lane); w2[j] = *(const unsigned*)(Ob_ + (size_t)row * 1024 + 512 + h * 128 + 2 * lane); }
#pragma unroll
            for (int j = 0; j < 8; ++j) { a0[j] = bf2f(w1[j] & 0xffff) - lam * bf2f(w2[j] & 0xffff); a1[j] = bf2f(w1[j] >> 16) - lam * bf2f(w2[j] >> 16); }
        }
        float ss[8];
#pragma unroll
        for (int j = 0; j < 8; ++j) ss[j] = a0[j] * a0[j] + a1[j] * a1[j];
#pragma unroll
        for (int j = 0; j < 8; ++j) ss[j] += swz_xor<1>(ss[j]);
#pragma unroll
        for (int j = 0; j < 8; ++j) ss[j] += swz_xor<2>(ss[j]);
#pragma unroll
        for (int j = 0; j < 8; ++j) ss[j] += swz_xor<4>(ss[j]);
#pragma unroll
        for (int j = 0; j < 8; ++j) ss[j] += swz_xor<8>(ss[j]);
#pragma unroll
        for (int j = 0; j < 8; ++j) ss[j] += swz_xor<16>(ss[j]);
#pragma unroll
        for (int j = 0; j < 8; ++j) { const int wt = base + j, row = wt >> 2, h = wt & 3;
            const float tot = xhalf_sum(ss[j]);
            const float r = (1.0f / sqrtf(tot * (1.0f / 128.0f) + EPS)) * (1.0f - lam_init);
            *(unsigned*)(MIX_ + (size_t)row * 1024 + h * 128 + 2 * lane) = pk2(a0[j] * r * g0, a1[j] * r * g1); }
    }
    for (int wt = MP * 4 + gw; wt < M * 4; wt += NGW) {
        const int row = wt >> 2, h = wt & 3, rs = row - MP, b = rs >> 5, q = rs & 31; float oc[2][2];
#pragma unroll
        for (int c = 0; c < 2; ++c) {
            const size_t pb = (size_t)(((b * 4 + h) * 2 + c) * 9);
            float mw[8], lw[8]; f32x2 ov[8]; float Mx = -1e30f;
#pragma unroll
            for (int pi = 0; pi < 8; ++pi) { const f32x2 ml = *(const f32x2*)(MLP_ + ((pb + pi) * 32 + q) * 2); mw[pi] = ml.x; lw[pi] = ml.y; ov[pi] = *(const f32x2*)(OPART_ + ((pb + pi) * 32 + q) * 128 + 2 * lane); }
#pragma unroll
            for (int pi = 0; pi < 8; ++pi) Mx = fmaxf(Mx, mw[pi]);
            float L = 0.f, s0 = 0.f, s1 = 0.f;
#pragma unroll
            for (int pi = 0; pi < 8; ++pi) { const float fz = __builtin_amdgcn_exp2f(mw[pi] - Mx); L += lw[pi] * fz; s0 += ov[pi].x * fz; s1 += ov[pi].y * fz; }
            const float il = 1.0f / L; oc[c][0] = s0 * il; oc[c][1] = s1 * il;
        }
        const float a0 = oc[0][0] - lam * oc[1][0], a1 = oc[0][1] - lam * oc[1][1];
        const float tot = wave_sum(a0 * a0 + a1 * a1);
        const float r = (1.0f / sqrtf(tot * (1.0f / 128.0f) + EPS)) * (1.0f - lam_init);
        *(unsigned*)(MIX_ + (size_t)row * 1024 + h * 128 + 2 * lane) = pk2(a0 * r * g0, a1 * r * g1);
    }
}

#ifndef PROBE_SLOW_ATTN
#define PROBE_SLOW_ATTN 0
#endif
#if PROBE_SLOW_ATTN
__device__ __forceinline__ void slow_attn_phase(int l, const bf16* Qb_, float* outp, const float* cache_k, const float* cache_v, bf16* MIX_, int gw, int NGW, int lane) {
    const float lam_init = (l == 0) ? 0.2f : 0.35550934f;
    float lam;
    { const float a = KIN(12)[l * 64 + lane] * KIN(13)[l * 64 + lane], c = KIN(14)[l * 64 + lane] * KIN(15)[l * 64 + lane];
      lam = __expf(wave_sum(a)) - __expf(wave_sum(c)) + lam_init; }
    const float g0 = KIN(16)[l * 128 + 2 * lane], g1 = KIN(16)[l * 128 + 2 * lane + 1];
    for (int wt = gw; wt < M * 4; wt += NGW) {
        const int row = wt >> 2, h = wt & 3;
        const float *K0, *V0, *K1, *V1; int n0, n1;
        if (row < MP) { const int b = row >> 11, t = row & 2047; K0 = outp + OFF_KP + ((size_t)l * MP + (size_t)b * 2048) * 512 + h * 128; V0 = outp + OFF_VP + ((size_t)l * MP + (size_t)b * 2048) * 512 + h * 128; n0 = ((t >> 6) + 1) * 64; K1 = K0; V1 = V0; n1 = 0; }
        else { const int rs = row - MP, b = rs >> 5; K0 = cache_k + ((size_t)(l * 8 + b) * 4096) * 512 + h * 128; V0 = cache_v + ((size_t)(l * 8 + b) * 4096) * 512 + h * 128; n0 = 4096;
               K1 = outp + OFF_KS + ((size_t)(l * 8 + b) * 32) * 512 + h * 128; V1 = outp + OFF_VS + ((size_t)(l * 8 + b) * 32) * 512 + h * 128; n1 = 32; }
        float oc[2][2];
#pragma unroll 1
        for (int c = 0; c < 2; ++c) {
            float q[64];
#pragma unroll
            for (int d = 0; d < 64; ++d) q[d] = bf2f(Qb_[(size_t)row * 512 + h * 128 + c * 64 + d]);
            float mx = -1e30f;
            for (int seg = 0; seg < 2; ++seg) { const float* Kp = seg ? K1 : K0; const int n = seg ? n1 : n0;
                for (int j0 = 0; j0 < n; j0 += 64) { const int j = j0 + lane; float s = -1e30f;
                    if (j < n) { const float* kr = Kp + (size_t)j * 512 + c * 64; s = 0.f;
#pragma unroll
                        for (int d = 0; d < 64; ++d) s += q[d] * kr[d]; }
                    mx = fmaxf(mx, s); } }
            mx = fmaxf(mx, swz_xor<1>(mx)); mx = fmaxf(mx, swz_xor<2>(mx)); mx = fmaxf(mx, swz_xor<4>(mx)); mx = fmaxf(mx, swz_xor<8>(mx)); mx = fmaxf(mx, swz_xor<16>(mx)); mx = xhalf_max(mx);
            float L = 0.f, o0 = 0.f, o1 = 0.f;
            for (int seg = 0; seg < 2; ++seg) { const float* Kp = seg ? K1 : K0; const float* Vp = seg ? V1 : V0; const int n = seg ? n1 : n0;
                for (int j0 = 0; j0 < n; j0 += 64) { const int j = j0 + lane; float pj = 0.f;
                    if (j < n) { const float* kr = Kp + (size_t)j * 512 + c * 64; float s = 0.f;
#pragma unroll
                        for (int d = 0; d < 64; ++d) s += q[d] * kr[d];
                        pj = __builtin_amdgcn_exp2f(s - mx); }
                    L += pj;
                    const int nn = (n - j0 < 64) ? n - j0 : 64;
                    for (int jj = 0; jj < nn; ++jj) { const float pb = __builtin_bit_cast(float, __builtin_amdgcn_readlane(__builtin_bit_cast(int, pj), jj));
                        const f32x2 vv = *(const f32x2*)(Vp + (size_t)(j0 + jj) * 512 + 2 * lane); o0 += pb * vv.x; o1 += pb * vv.y; } } }
            L = wave_sum(L);
            oc[c][0] = o0 / L; oc[c][1] = o1 / L;
        }
        const float a0 = oc[0][0] - lam * oc[1][0], a1 = oc[0][1] - lam * oc[1][1];
        const float ss = wave_sum(a0 * a0 + a1 * a1);
        const float r = (1.0f / sqrtf(ss * (1.0f / 128.0f) + EPS)) * (1.0f - lam_init);
        *(unsigned*)(MIX_ + (size_t)row * 1024 + h * 128 + 2 * lane) = pk2(a0 * r * g0, a1 * r * g1);
    }
}
#endif

#ifndef PROBE_SLOW_PC
#define PROBE_SLOW_PC 0
#endif
#if PROBE_SLOW_PC
__device__ __forceinline__ float zval(const bf16* Zb_, const float* st, int l, int b, bool smp, int rowbase, int t, int col, int hist) {
    if (t >= 0) return bf2f(Zb_[(size_t)(rowbase + t) * 1024 + col]);
    if (!smp) return 0.f;
    return st[(size_t)((l * 8 + b) * hist + (hist + t)) * 256 + (col & 255)];
}
__device__ __forceinline__ void slow_pc_phase(int l, const bf16* Zb_, bf16* MIX_, int gw, int NGW, int lane) {
    const float* sp = KIN(4); const float* scv = KIN(5); const float* pw = KIN(17); const float* psc = KIN(18); const float* cw = KIN(19);
    for (int wt = gw; wt < M * 4; wt += NGW) {
        const int row = wt >> 2, g = wt & 3; const bool smp = row >= MP;
        int b, t, rowbase; if (smp) { const int rs = row - MP; b = rs >> 5; t = rs & 31; rowbase = MP + b * 32; } else { b = row >> 11; t = row & 2047; rowbase = b * 2048; }
        const int w = 2 << g, ch = g * 64 + lane;
        float s = 0.f;
        for (int i = 0; i < w; ++i) { const int tt = t - i; s += zval(Zb_, sp, l, b, smp, rowbase, tt, ch, 15); }
        const int pos = smp ? 4096 + t : t; const int cnt = (pos + 1 < w) ? pos + 1 : w;
        const float d = s / (float)cnt - zval(Zb_, sp, l, b, smp, rowbase, t, ch, 15);
        float mine = 0.f;
        for (int e = 0; e < 64; ++e) { const float v = wave_sum(d * pw[(size_t)((l * 4 + g) * 64 + lane) * 64 + e]); if (e == lane) mine = v; }
        MIX_[(size_t)row * 1024 + 512 + ch] = (bf16)(pk2(mine * psc[l * 256 + ch], 0.f) & 0xffffu);
        float cvv[3];
#pragma unroll
        for (int k = 0; k < 3; ++k) { const int tt = t - 2 + k;
            if (tt >= 0) cvv[k] = bf2f(Zb_[(size_t)(rowbase + tt) * 1024 + 768 + ch]) * bf2f(Zb_[(size_t)(rowbase + tt) * 1024 + 256 + ch]);
            else cvv[k] = smp ? scv[(size_t)((l * 8 + b) * 2 + (2 + tt)) * 256 + ch] : 0.f; }
        const float bgv = bf2f(Zb_[(size_t)row * 1024 + 512 + ch]);
        const float y = bgv * (cw[l * 768 + ch] * cvv[0] + cw[l * 768 + 256 + ch] * cvv[1] + cw[l * 768 + 512 + ch] * cvv[2]);
        MIX_[(size_t)row * 1024 + 768 + ch] = (bf16)(pk2(y, 0.f) & 0xffffu);
    }
}
#endif

#define XB_TMO      128
#define XB_XCNT(j)  (256  + 64 * (j))
#define XB_XSUB(j)  (1280 + 64 * (j))
#define XB_XGEN(j)  (2304 + 64 * (j))
#define XB_TOP      3328
#define XB_TOPGEN   3392
#define XCD_BAR_WORDS 3456
#define XB_SPIN_CAP (1u << 18)
__device__ __forceinline__ unsigned xb_ld(unsigned* p)              { return __hip_atomic_load(p, __ATOMIC_RELAXED, __HIP_MEMORY_SCOPE_AGENT); }
__device__ __forceinline__ unsigned xb_add(unsigned* p, unsigned v) { return __hip_atomic_fetch_add(p, v, __ATOMIC_RELAXED, __HIP_MEMORY_SCOPE_AGENT); }
__device__ __forceinline__ unsigned xb_xcc_id() { return (unsigned)__builtin_amdgcn_s_getreg((3 << 11) | 20) & 0xFu; }
#define XB_SPIN(cond, bar) do { unsigned _sp = 0; while (cond) { __builtin_amdgcn_s_sleep(1); \
    if ((++_sp & 255u) == 0u) { if (xb_ld(&(bar)[XB_TMO])) break; if (_sp > XB_SPIN_CAP) { atomicAdd(&(bar)[XB_TMO], 1u); break; } } } } while (0)
__device__ __forceinline__ void xcd_barrier_complete(unsigned* bar, unsigned x, unsigned& nloc, unsigned& nx) {
    const unsigned G = gridDim.x * gridDim.y * gridDim.z;
    unsigned sum, cnt, mine, sp = 0u;
    for (;;) {
        sum = 0u; cnt = 0u; mine = 0u;
#pragma unroll
        for (unsigned j = 0; j < 16; ++j) { const unsigned c = xb_ld(&bar[XB_XCNT(j)]); sum += c; cnt += (c > 0u) ? 1u : 0u; mine = (j == x) ? c : mine; }
        if (sum == G) break;
        __builtin_amdgcn_s_sleep(1);
        if ((++sp & 255u) == 0u) { if (xb_ld(&bar[XB_TMO])) break; if (sp > XB_SPIN_CAP) { atomicAdd(&bar[XB_TMO], 1u); break; } }
    }
    nloc = mine > 0u ? mine : 1u; nx = cnt > 0u ? cnt : 1u;
}
__device__ __forceinline__ void xcd_barrier(unsigned* bar, unsigned x, volatile LAS unsigned* st) {
    asm volatile("s_waitcnt vmcnt(0)" ::: "memory");
    __syncthreads();
    if (threadIdx.x == 0) {
        __builtin_amdgcn_s_waitcnt(0);
        unsigned nloc = st[0], nx = st[1];
        if (nloc == 0u) { xcd_barrier_complete(bar, x, nloc, nx); st[0] = nloc; st[1] = nx; }
        const unsigned old = xb_add(&bar[XB_XSUB(x)], 1u);
        const unsigned gen = old / nloc;
        if (old + 1u == (gen + 1u) * nloc) {
            __builtin_amdgcn_fence(__ATOMIC_RELEASE, "agent");
            asm volatile("s_waitcnt vmcnt(0)" ::: "memory");
            const unsigned og = xb_add(&bar[XB_TOP], 1u);
            const unsigned tg = og / nx;
            if (og + 1u == (tg + 1u) * nx) xb_add(&bar[XB_TOPGEN], 1u);
            else XB_SPIN(xb_ld(&bar[XB_TOPGEN]) == tg, bar);
            __builtin_amdgcn_fence(__ATOMIC_ACQUIRE, "agent");
            xb_add(&bar[XB_XGEN(x)], 1u);
            asm volatile("s_waitcnt vmcnt(0)" ::: "memory");
        } else {
            XB_SPIN(xb_ld(&bar[XB_XGEN(x)]) == gen, bar);
            __builtin_amdgcn_fence(__ATOMIC_ACQUIRE, "agent");
            asm volatile("s_waitcnt vmcnt(0)" ::: "memory");
        }
    }
    __syncthreads();
}
#define CG_SYNC() do { asm volatile("s_waitcnt vmcnt(0) lgkmcnt(0)" ::: "memory"); grid.sync(); asm volatile("" ::: "memory"); } while (0)
#define GRID_SYNC() xcd_barrier((unsigned*)KWS() + 4096, xcc, (volatile LAS unsigned*)(lds + LDS_BYTES - 64))
__global__ void __launch_bounds__(NWAVES * 64, 2) mega_fwd(Params p) {
    extern __shared__ __attribute__((aligned(16))) unsigned char lds_raw[];
    LAS unsigned char* lds = (LAS unsigned char*)lds_raw;
    cg::grid_group grid = cg::this_grid();
    const int tid = threadIdx.x, lane = tid & 63, wave = __builtin_amdgcn_readfirstlane(tid >> 6);
    const int G = gridDim.x; const int bx = blockIdx.x; const int vcu0 = (G % 8 == 0) ? (bx % 8) * (G / 8) + bx / 8 : bx;
    const int NGW = G * NWAVES;
#define X ((bf16*)(ws + WS_X))
#define H ((bf16*)(ws + WS_H))
#define MIX ((bf16*)(ws + WS_MIX))
#define ACT ((bf16*)(ws + WS_ACT))
#define Qb ((bf16*)(ws + WS_QB))
#define Kb ((bf16*)(ws + WS_KB))
#define Vb ((bf16*)(ws + WS_VB))
#define Zb ((bf16*)(ws + WS_ZB))
#define Ob ((bf16*)(ws + WS_OB))
#define OPART ((float*)(ws + WS_OPART))
#define MLP ((float*)(ws + WS_ML))
#define pwt ((const bf16*)(ws + WS_POOLWT))
    if (tid < 16) ((LAS unsigned*)(lds + LDS_BYTES - 64))[tid] = 0u;
    const unsigned xcc = xb_xcc_id();
    if (tid == 0) (void)xb_add((unsigned*)KWS() + 4096 + XB_XCNT(xcc), 1u);
    __syncthreads();
    { const int gw = vcu0 * NWAVES + wave; prologue(lds, gw, NGW, wave, lane);
      norm_rows<false>(KIN(0), KIN(1), KIN(6), (bf16*)(KWS() + WS_H), nullptr, gw, NGW, lane); }
    CG_SYNC();
#define FRESH_IDS() int tid = threadIdx.x; asm volatile("" : "+v"(tid)); const int lane = tid & 63, wave = __builtin_amdgcn_readfirstlane(tid >> 6); int vcu = vcu0; asm volatile("" : "+s"(vcu)); const int gw = vcu * NWAVES + wave; (void)lane; (void)gw; (void)wave
#define CNT(nid, idx) ((unsigned*)(ws + CTL_CNT) + (size_t)((nid) * 80 + (idx)) * 64)
#pragma unroll 1
    for (int step = 0; step < 4; ++step) {
        const int l = step >> 1, f = step & 1;
        const bool first = (step == 0);
        { FRESH_IDS(); unsigned char* const ws = KWS(); unsigned char* const wl = ws + WS_W + (size_t)l * WL;
          pg8::Gemm g{H, (const bf16*)(wl + (f ? W_GU2 : W_GU1)), M, 2 * FF, D}; pg8::StaticOrder S; S.init(M, 2 * FF, G, bx);
          pg8::EpiSwiGLU E{ACT, FF};
          pg8::gemm_phase<pg8::EpiSwiGLU, pg8::StaticOrder, true, true>(lds, g, S, E); }
        GRID_SYNC();
        { FRESH_IDS(); unsigned char* const ws = KWS(); unsigned char* const wl = ws + WS_W + (size_t)l * WL;
          const bool last = (step == 3);
          const float* const gn = last ? KIN(25) : (f ? KIN(6) + (l + 1) * D : KIN(10) + l * D);
          const int nid = step * 2;
          float* const yo = KOUT() + OFF_Y;
          pg8::Gemm g{ACT, (const bf16*)(wl + (f ? W_D2 : W_D1)), MP, D, FF}; pg8::StaticOrder S; S.init(MP, D, G, bx);
          { pg8::Unit u0; const int pm0 = S.next(0, u0) ? u0.pm : 0;
            if (first) { pg8::EpiResidNorm<false> E{KIN(0), X, 0.5f, H, yo, gn, (unsigned*)(ws + WS_SLOTP), CNT(nid, pm0)};
                         pg8::gemm_phase<pg8::EpiResidNorm<false>, pg8::StaticOrder, false, true>(lds, g, S, E); }
            else { pg8::EpiResidNorm<true> E{X, last ? nullptr : X, 0.5f, last ? nullptr : H, yo, gn, (unsigned*)(ws + WS_SLOTP), CNT(nid, pm0)};
                   pg8::gemm_phase<pg8::EpiResidNorm<true>, pg8::StaticOrder, false, true>(lds, g, S, E); } }
          if (first) skinny_gemm<false, FF>(lds, ACT + (size_t)MP * FF, (const bf16*)(wl + W_D1), KIN(1), X + (size_t)MP * D, 0.5f, H + (size_t)MP * D, yo + (size_t)MP * D, gn, (unsigned*)(ws + WS_SLOTS), CNT(nid, 64), vcu, G, tid);
          else skinny_gemm<true, FF>(lds, ACT + (size_t)MP * FF, (const bf16*)(wl + (f ? W_D2 : W_D1)), X + (size_t)MP * D, last ? nullptr : X + (size_t)MP * D, 0.5f,
                      last ? nullptr : H + (size_t)MP * D, yo + (size_t)MP * D, gn, (unsigned*)(ws + WS_SLOTS), CNT(nid, 64), vcu, G, tid); }
        if (step == 3) break;
        GRID_SYNC();
        if (f == 0) {
            { FRESH_IDS(); unsigned char* const ws = KWS(); unsigned char* const wl = ws + WS_W + (size_t)l * WL;
              pg8::Gemm g{H, (const bf16*)(wl + W_IN), M, DIN, D}; pg8::StaticOrder S; S.init(M, DIN, G, bx);
              pg8::EpiWin E{ws, KOUT(), l, C2};
              pg8::gemm_phase<pg8::EpiWin, pg8::StaticOrder, true, true>(lds, g, S, E); }
            GRID_SYNC();
            { FRESH_IDS(); unsigned char* const ws = KWS();
              for (int i = 0; i < 4; ++i) {
                const int L = i * G + vcu; if (L >= 1024) break;
                const int bh = (L & 255) >> 1, sI = L & 1, ii = L >> 8;
                const int qb = sI == 0 ? (ii == 0 ? 7 : ii == 1 ? 0 : ii == 2 ? 4 : 3) : (ii == 0 ? 6 : ii == 1 ? 1 : ii == 2 ? 5 : 2);
                const int b = bh >> 4, vh = bh & 15, hh = vh >> 2, c = (vh >> 1) & 1, hf = vh & 1;
                attn_body::attn_unit<8>(b, qb, (const attn_body::bf16*)(Qb + (hh * 2 + c) * 64), (const attn_body::bf16*)(Kb + (hh * 2 + c) * 64), (const attn_body::bf16*)(Vb + hh * 128 + hf * 64),
                                        (attn_body::bf16*)(Ob + c * 512 + hh * 128 + hf * 64), (char*)lds_raw);
              } }
            __syncthreads();
            { FRESH_IDS(); unsigned char* const ws = KWS(); float* const outp = KOUT();
              for (int pc = vcu; pc < 256; pc += G)
                sample_piece(lds, pc, l, Qb, KIN(2), KIN(3), outp + OFF_KS, outp + OFF_VS, OPART, MLP, tid); }
            __syncthreads();
            { FRESH_IDS(); unsigned char* const ws = KWS(); float* const outp = KOUT();
              for (int tl = vcu; tl < 264; tl += G)
                poolconv_tile(lds, tl, l, Zb, MIX, KIN(4), KIN(5), pwt, KIN(18), KIN(19), outp + OFF_CP, outp + OFF_CS, tid); }
            GRID_SYNC();
            { FRESH_IDS(); unsigned char* const ws = KWS();
              combine_phase(l, Ob, OPART, MLP, MIX, gw, NGW, lane); }
            GRID_SYNC();
            { FRESH_IDS(); unsigned char* const ws = KWS(); unsigned char* const wl = ws + WS_W + (size_t)l * WL;
              const float* const gn = KIN(21) + l * D; const int nid = step * 2 + 1;
              pg8::Gemm g{MIX, (const bf16*)(wl + W_OUT), MP, D, D}; pg8::StaticOrder S; S.init(MP, D, G, bx);
              { pg8::Unit u0; const int pm0 = S.next(0, u0) ? u0.pm : 0;
                pg8::EpiResidNorm<true> E{X, X, 1.0f, H, nullptr, gn, (unsigned*)(ws + WS_SLOTP), CNT(nid, pm0)};
                pg8::gemm_phase<pg8::EpiResidNorm<true>, pg8::StaticOrder, false, true>(lds, g, S, E); }
              skinny_gemm<true, D>(lds, MIX + (size_t)MP * D, (const bf16*)(wl + W_OUT), X + (size_t)MP * D, X + (size_t)MP * D, 1.0f, H + (size_t)MP * D, nullptr, gn,
                          (unsigned*)(ws + WS_SLOTS), CNT(nid, 64), vcu, G, tid); }
            GRID_SYNC();
        }
    }
}

extern "C" void kernel_launch(void* const* d_in, const int* in_sizes, int n_in, void* d_out, int out_size, void* d_ws, size_t ws_size, hipStream_t stream) {
    static int grid = 0;
    if (grid == 0) {
        if (n_in != 26 || (size_t)out_size != OUT_TOTAL || ws_size < WS_END) { fprintf(stderr, "kernel_launch: unexpected problem shape: n_in %d out %d ws %zu\n", n_in, out_size, ws_size); grid = -1; return; }
        int dev = 0, cus = 0, per_cu = 0;
        if (hipGetDevice(&dev) != hipSuccess || hipDeviceGetAttribute(&cus, hipDeviceAttributeMultiprocessorCount, dev) != hipSuccess) { grid = -1; return; }
        if (hipFuncSetAttribute((const void*)mega_fwd, hipFuncAttributeMaxDynamicSharedMemorySize, LDS_BYTES) != hipSuccess) { fprintf(stderr, "kernel_launch: hipFuncSetAttribute failed\n"); grid = -1; return; }
        if (hipOccupancyMaxActiveBlocksPerMultiprocessor(&per_cu, (const void*)mega_fwd, NWAVES * 64, LDS_BYTES) != hipSuccess || per_cu < 1) { fprintf(stderr, "kernel_launch: occupancy query says %d\n", per_cu); per_cu = 1; }
        (void)hipGetLastError();
        grid = cus * per_cu;
    }
    if (grid < 0) return;
    if (hipMemsetAsync(d_ws, 0, CTL_BYTES, stream) != hipSuccess) { fprintf(stderr, "kernel_launch: memset failed\n"); return; }
    Params p{};
    for (int i = 0; i < 26; ++i) p.in[i] = (const float*)d_in[i];
    p.out = (float*)d_out; p.ws = (unsigned char*)d_ws;
    void* args[] = {&p};
    const hipError_t e = hipLaunchCooperativeKernel((const void*)mega_fwd, dim3(grid), dim3(NWAVES * 64), args, LDS_BYTES, stream);
    if (e != hipSuccess) fprintf(stderr, "kernel_launch: cooperative launch failed: %s (grid %d)\n", hipGetErrorString(e), grid);
}
```

```cpp
#include <hip/hip_runtime.h>
#include <hip/hip_cooperative_groups.h>
#include <cstdio>
#include <cstdint>
namespace pg8 {
#define PG8_LAS __attribute__((address_space(3)))
typedef unsigned short bf16_t;
typedef short bf16x8 __attribute__((ext_vector_type(8)));
typedef float f32x4 __attribute__((ext_vector_type(4)));
typedef unsigned u32x4 __attribute__((ext_vector_type(4)));
constexpr int BM = 256, BK = 64, HALF = 128, HTB = HALF * BK * 2  , STAGE_BYTES = 8 * HTB, NXCD = 8, WGM = 8;

__host__ __device__ __forceinline__ int lds_byte(int r, int c) { const int st = (r >> 4) * 2 + (c >> 5), rr = r & 15, cc = c & 31, ob = rr * 64 + cc * 2; return st * 1024 + (ob ^ (((ob >> 9) & 1) << 5)); }
__host__ __device__ __forceinline__ void stage_rc(int b, int& R, int& C) { const int st = b / 1024, sb = b % 1024, swz = sb ^ (((sb >> 9) & 1) << 5); R = (st >> 1) * 16 + swz / 64; C = (st & 1) * 32 + (swz % 64) / 2; }
__host__ __device__ __forceinline__ int perm32(int rho) { const int n = rho >> 4, i = rho & 15; return 8 * (i >> 2) + 4 * n + (i & 3); }

struct Unit { int pm, pn; };
struct Gemm { const bf16_t* A; const bf16_t* Bt; int M, N, K; };

struct StaticOrder {
    int nM, nN, nwg, G, c;
    __host__ __device__ __forceinline__ void init(int M, int N, int G_, int c_) { nM = M / BM; nN = N / BM; nwg = nM * nN; G = G_; c = c_; }
    __host__ __device__ __forceinline__ bool next(int i, Unit& u) const {
        const long L = (long)i * G + c; if (L >= nwg) return false;
        int wgid = (int)L; { const int q = nwg / NXCD, r = nwg % NXCD, xcd = wgid % NXCD, off = wgid / NXCD; wgid = (xcd < r ? xcd * (q + 1) : r * (q + 1) + (xcd - r) * q) + off; }
        const int nig = WGM * nN, gid = wgid / nig, fm = gid * WGM, gsz = (nM - fm) < WGM ? (nM - fm) : WGM;
        u.pm = fm + ((wgid % nig) % gsz); u.pn = (wgid % nig) / gsz; return true;
    }
    __device__ __forceinline__ void a_ready(const Unit&) const {}
    __device__ __forceinline__ void done(const Unit&) const {}
};

__device__ __forceinline__ unsigned cvt_pk_bf16(float lo, float hi) { unsigned r; asm volatile("v_cvt_pk_bf16_f32 %0, %1, %2" : "=v"(r) : "v"(lo), "v"(hi)); return r; }
typedef float f32x2 __attribute__((ext_vector_type(2)));
typedef unsigned u32x2 __attribute__((ext_vector_type(2)));
constexpr size_t WOFF_ROPE = (size_t)1 << 20, WOFF_QB = (size_t)215 << 20, WOFF_KB = (size_t)232 << 20, WOFF_VB = (size_t)249 << 20, WOFF_ZB = (size_t)266 << 20;
constexpr size_t OOFF_KP = 17039360, OOFF_VP = 33816576, OOFF_PP = 50593792, OOFF_KS = 50663424, OOFF_VS = 50925568, OOFF_PS = 51187712;
__device__ __forceinline__ float silu_mul(float g, float u) { const float e = __builtin_amdgcn_exp2f(-1.4426950408889634f * g); return g * u * __builtin_amdgcn_rcpf(1.0f + e); }
struct EpiSwiGLU {
    static constexpr bool PERM = true, AFTER_DRAIN = false;
    bf16_t* O; int ldc;
    __device__ __forceinline__ void operator()(const f32x4 (&acc)[2][2][4][2], const Unit& u, int wr, int wc, int fr, int fq) const {
        const int row0 = u.pm * BM + wr * 64 + fr; const int col0 = u.pn * 128 + wc * 32 + 8 * fq;
#pragma unroll
        for (int ai = 0; ai < 2; ++ai)
#pragma unroll
            for (int m = 0; m < 4; ++m) {
                bf16_t* p = O + (size_t)(row0 + ai * HALF + m * 16) * ldc + col0;
                const f32x4 g0 = acc[ai][0][m][0], g1 = acc[ai][0][m][1], u0 = acc[ai][1][m][0], u1 = acc[ai][1][m][1];
                u32x4 w;
                w.x = cvt_pk_bf16(silu_mul(g0[0], u0[0]), silu_mul(g0[1], u0[1])); w.y = cvt_pk_bf16(silu_mul(g0[2], u0[2]), silu_mul(g0[3], u0[3]));
                w.z = cvt_pk_bf16(silu_mul(g1[0], u1[0]), silu_mul(g1[1], u1[1])); w.w = cvt_pk_bf16(silu_mul(g1[2], u1[2]), silu_mul(g1[3], u1[3]));
                *(u32x4*)p = w;
                asm volatile("" ::: "memory");
            }
    }
};
struct EpiResid {
    static constexpr bool PERM = false, AFTER_DRAIN = false;
    const float* baseP; const float* baseS; float* out; float scale;
    __device__ __forceinline__ void operator()(const f32x4 (&acc)[2][2][4][2], const Unit& u, int wr, int wc, int fr, int fq) const {
        const int col0 = u.pn * BM + wc * 32 + 4 * fq;
#pragma unroll
        for (int ai = 0; ai < 2; ++ai)
#pragma unroll
            for (int m = 0; m < 4; ++m) {
                const int row = u.pm * BM + ai * HALF + wr * 64 + m * 16 + fr;
                const float* bp = (row < 16384) ? baseP + (size_t)row * 1024 : baseS + (size_t)(row - 16384) * 1024;
                float* op = out + (size_t)row * 1024;
#pragma unroll
                for (int bj = 0; bj < 2; ++bj)
#pragma unroll
                    for (int n = 0; n < 2; ++n) { const int c = col0 + bj * HALF + n * 16; const f32x4 b = *(const f32x4*)(bp + c); *(f32x4*)(op + c) = b + acc[ai][bj][m][n] * scale; }
                asm volatile("" ::: "memory");
            }
    }
};
constexpr float RMS_EPS = 1e-6f;
__device__ __forceinline__ float rstd_of(float ss) { return 1.0f / sqrtf(ss * (1.0f / 1024.0f) + RMS_EPS); }

#define PG8_RLX_AGENT __ATOMIC_RELAXED, __HIP_MEMORY_SCOPE_AGENT
template <bool BASE16> struct EpiResidNorm {
    static constexpr bool PERM = false, AFTER_DRAIN = true;
    const void* baseP; bf16_t* out; float scale; bf16_t* hb; float* yout; const float* gain; unsigned* slots; unsigned* cnt;
    __device__ __forceinline__ void fused(f32x4 (&acc)[2][2][4][2], const Unit& u, int wr, int wc, int fr, int fq, PG8_LAS unsigned char* lds, int wid, int lane) const {
        PG8_LAS float* P = (PG8_LAS float*)lds;
        PG8_LAS float* S = (PG8_LAS float*)(lds + 4096);
        const int col0 = u.pn * BM + wc * 32 + 4 * fq;
        if (BASE16) {
            u32x2 braw[2][4][2][2];
#pragma unroll
            for (int ai = 0; ai < 2; ++ai)
#pragma unroll
                for (int m = 0; m < 4; ++m) { const size_t ro = (size_t)(u.pm * BM + ai * HALF + wr * 64 + m * 16 + fr) * 1024;
#pragma unroll
                    for (int bj = 0; bj < 2; ++bj)
#pragma unroll
                        for (int n = 0; n < 2; ++n) braw[ai][m][bj][n] = *(const u32x2*)((const bf16_t*)baseP + ro + col0 + bj * HALF + n * 16); }
#pragma unroll
            for (int ai = 0; ai < 2; ++ai)
#pragma unroll
                for (int m = 0; m < 4; ++m)
#pragma unroll
                    for (int bj = 0; bj < 2; ++bj)
#pragma unroll
                        for (int n = 0; n < 2; ++n) { const u32x2 bw = braw[ai][m][bj][n]; f32x4 bv; bv[0] = __builtin_bit_cast(float, bw.x << 16); bv[1] = __builtin_bit_cast(float, bw.x & 0xffff0000u); bv[2] = __builtin_bit_cast(float, bw.y << 16); bv[3] = __builtin_bit_cast(float, bw.y & 0xffff0000u);
                            acc[ai][bj][m][n] = bv + acc[ai][bj][m][n] * scale; }
        }
#pragma unroll
        for (int ai = 0; ai < 2; ++ai)
#pragma unroll
            for (int m = 0; m < 4; ++m) {
                const int rl = ai * HALF + wr * 64 + m * 16 + fr; const size_t ro = (size_t)(u.pm * BM + rl) * 1024;
                float ss = 0.f;
#pragma unroll
                for (int bj = 0; bj < 2; ++bj)
#pragma unroll
                    for (int n = 0; n < 2; ++n) { const int c = col0 + bj * HALF + n * 16; f32x4 v;
                        if (BASE16) v = acc[ai][bj][m][n];
                        else { v = *(const f32x4*)((const float*)baseP + ro + c) + acc[ai][bj][m][n] * scale; acc[ai][bj][m][n] = v; }
                        if (out) { u32x2 w; w.x = cvt_pk_bf16(v[0], v[1]); w.y = cvt_pk_bf16(v[2], v[3]); *(u32x2*)(out + ro + c) = w; }
                        ss += (v[0] * v[0] + v[1] * v[1]) + (v[2] * v[2] + v[3] * v[3]); }
                ss += __builtin_bit_cast(float, __builtin_amdgcn_ds_swizzle(__builtin_bit_cast(int, ss), (16 << 10) | 0x1f));
                { float a = ss, b2 = ss; asm volatile("s_nop 1\n\tv_permlane32_swap_b32 %0, %1\n\ts_nop 1" : "+v"(a), "+v"(b2)); ss = a + b2; }
                if (fq == 0) P[rl * 4 + wc] = ss;
                if (!BASE16 && (m & 1)) asm volatile("" ::: "memory");
            }
        asm volatile("s_waitcnt lgkmcnt(0)\n\ts_barrier" ::: "memory");
        const int t = wid * 64 + lane;
        if (t < 256) { const float s = (P[t * 4] + P[t * 4 + 1]) + (P[t * 4 + 2] + P[t * 4 + 3]);
            __hip_atomic_store(slots + (size_t)(u.pm * BM + t) * 4 + u.pn, __builtin_bit_cast(unsigned, s), PG8_RLX_AGENT); }
        asm volatile("s_waitcnt vmcnt(0)" ::: "memory");
        if (wid < 4 && lane == 0) __hip_atomic_fetch_add(cnt, 1u, PG8_RLX_AGENT);
        if (wid == 0) {
            unsigned spins = 0;
            while ((unsigned)__builtin_amdgcn_readfirstlane(__hip_atomic_load(cnt, PG8_RLX_AGENT)) < 16u) { __builtin_amdgcn_s_sleep(2); if (++spins > (1u << 22)) break; }
            __builtin_amdgcn_fence(__ATOMIC_ACQUIRE, "agent");
        }
        asm volatile("s_waitcnt vmcnt(0) lgkmcnt(0)\n\ts_barrier" ::: "memory");
        if (t < 256) { const unsigned* sl = slots + (size_t)(u.pm * BM + t) * 4; float tot = 0.f;
#pragma unroll
            for (int k = 0; k < 4; ++k) tot += __builtin_bit_cast(float, __hip_atomic_load(sl + k, PG8_RLX_AGENT));
            S[t] = rstd_of(tot); }
        asm volatile("s_waitcnt lgkmcnt(0)\n\ts_barrier" ::: "memory");
        f32x4 g4[2][2];
#pragma unroll
        for (int bj = 0; bj < 2; ++bj)
#pragma unroll
            for (int n = 0; n < 2; ++n) g4[bj][n] = *(const f32x4*)(gain + col0 + bj * HALF + n * 16);
#pragma unroll
        for (int ai = 0; ai < 2; ++ai)
#pragma unroll
            for (int m = 0; m < 4; ++m) {
                const int rl = ai * HALF + wr * 64 + m * 16 + fr; const size_t ro = (size_t)(u.pm * BM + rl) * 1024; const float r = S[rl];
#pragma unroll
                for (int bj = 0; bj < 2; ++bj)
#pragma unroll
                    for (int n = 0; n < 2; ++n) { const int c = col0 + bj * HALF + n * 16; const f32x4 y = acc[ai][bj][m][n] * r * g4[bj][n];
                        if (hb) { u32x2 w; w.x = cvt_pk_bf16(y[0], y[1]); w.y = cvt_pk_bf16(y[2], y[3]); *(u32x2*)(hb + ro + c) = w; }
                        else *(f32x4*)(yout + ro + c) = y; }
            }
        asm volatile("s_waitcnt lgkmcnt(0)\n\ts_barrier" ::: "memory");
    }
};

struct EpiWin {
    static constexpr bool PERM = false, AFTER_DRAIN = false;
    unsigned char* ws; float* outp; int l; float qscale;
    __device__ __forceinline__ void operator()(const f32x4 (&acc)[2][2][4][2], const Unit& u, int wr, int wc, int fr, int fq) const {
        const int pn = u.pn;
        bf16_t* const Qb = (bf16_t*)(ws + WOFF_QB); bf16_t* const Kb = (bf16_t*)(ws + WOFF_KB); bf16_t* const Vb = (bf16_t*)(ws + WOFF_VB); bf16_t* const Zb = (bf16_t*)(ws + WOFF_ZB);
        const float* const rope = (const float*)(ws + WOFF_ROPE);
        float* const kP = outp + OOFF_KP + (size_t)l * 16384 * 512; float* const vP = outp + OOFF_VP + (size_t)l * 16384 * 512;
        float* const kS = outp + OOFF_KS + (size_t)l * 256 * 512; float* const vS = outp + OOFF_VS + (size_t)l * 256 * 512;
        float* const poolP = outp + OOFF_PP + (size_t)l * 8 * 15 * 256; float* const poolS = outp + OOFF_PS + (size_t)l * 8 * 15 * 256;
#pragma unroll
        for (int ai = 0; ai < 2; ++ai)
#pragma unroll
            for (int m = 0; m < 4; ++m) {
                const int row = u.pm * BM + ai * HALF + wr * 64 + m * 16 + fr;
                const bool smp = row >= 16384; const int rs = row - 16384;
                const int prow = smp ? 2048 + (rs & 31) : (row & 2047);
#pragma unroll
                for (int bj = 0; bj < 2; ++bj) {
                    const int dlo = 16 * (wc & 1) + 4 * fq, lc0 = 64 * (2 * bj + (wc >> 1)) + dlo;
                    const f32x4 a0 = acc[ai][bj][m][0], a1 = acc[ai][bj][m][1];
                    if (pn < 4) {
                        const f32x4 cs = *(const f32x4*)(rope + (size_t)prow * 64 + dlo), sn = *(const f32x4*)(rope + (size_t)prow * 64 + 32 + dlo);
                        const f32x4 r0 = a0 * cs - a1 * sn, r1 = a1 * cs + a0 * sn;
                        if (pn < 2) {
                            const int col = 256 * pn + lc0; bf16_t* q = Qb + (size_t)row * 512 + col;
                            u32x2 w0, w1; w0.x = cvt_pk_bf16(r0[0] * qscale, r0[1] * qscale); w0.y = cvt_pk_bf16(r0[2] * qscale, r0[3] * qscale);
                            w1.x = cvt_pk_bf16(r1[0] * qscale, r1[1] * qscale); w1.y = cvt_pk_bf16(r1[2] * qscale, r1[3] * qscale);
                            *(u32x2*)q = w0; *(u32x2*)(q + 32) = w1;
                        } else {
                            const int col = 256 * (pn - 2) + lc0; bf16_t* k = Kb + (size_t)row * 512 + col;
                            float* ko = smp ? kS + (size_t)rs * 512 + col : kP + (size_t)row * 512 + col;
                            *(f32x4*)ko = r0; *(f32x4*)(ko + 32) = r1;
                            u32x2 w0, w1; w0.x = cvt_pk_bf16(r0[0], r0[1]); w0.y = cvt_pk_bf16(r0[2], r0[3]); w1.x = cvt_pk_bf16(r1[0], r1[1]); w1.y = cvt_pk_bf16(r1[2], r1[3]);
                            *(u32x2*)k = w0; *(u32x2*)(k + 32) = w1;
                        }
                    } else if (pn < 6) {
                        const int col = 256 * (pn - 4) + lc0; bf16_t* v = Vb + (size_t)row * 512 + col;
                        float* vo = smp ? vS + (size_t)rs * 512 + col : vP + (size_t)row * 512 + col;
                        *(f32x4*)vo = a0; *(f32x4*)(vo + 32) = a1;
                        u32x2 w0, w1; w0.x = cvt_pk_bf16(a0[0], a0[1]); w0.y = cvt_pk_bf16(a0[2], a0[3]); w1.x = cvt_pk_bf16(a1[0], a1[1]); w1.y = cvt_pk_bf16(a1[2], a1[3]);
                        *(u32x2*)v = w0; *(u32x2*)(v + 32) = w1;
                    } else {
                        const int col = 256 * (pn - 6) + lc0; bf16_t* z = Zb + (size_t)row * 1024 + col;
                        u32x2 w0, w1; w0.x = cvt_pk_bf16(a0[0], a0[1]); w0.y = cvt_pk_bf16(a0[2], a0[3]); w1.x = cvt_pk_bf16(a1[0], a1[1]); w1.y = cvt_pk_bf16(a1[2], a1[3]);
                        *(u32x2*)z = w0; *(u32x2*)(z + 32) = w1;
                        if (pn == 6) {
                            if (smp) { const int b = rs >> 5, t = rs & 31; if (t >= 17) { float* po = poolS + (size_t)(b * 15 + t - 17) * 256 + lc0; *(f32x4*)po = a0; *(f32x4*)(po + 32) = a1; } }
                            else { const int b = row >> 11, t = row & 2047; if (t >= 2033) { float* po = poolP + (size_t)(b * 15 + t - 2033) * 256 + lc0; *(f32x4*)po = a0; *(f32x4*)(po + 32) = a1; } }
                        }
                    }
                }
                asm volatile("" ::: "memory");
            }
    }
};
template <class Epi, class Sched, bool ALIGN_EPI = false, bool SP2 = false>
__device__ __forceinline__ void gemm_phase(PG8_LAS unsigned char* lds, const Gemm g, const Sched& S, const Epi& E) {
    int tid_l = threadIdx.x; asm volatile("" : "+v"(tid_l)); const int tid = tid_l, wid = __builtin_amdgcn_readfirstlane(tid >> 6), lane = tid & 63, wr = wid >> 2, wc = wid & 3, fr = lane & 15, fq = lane >> 4;
    const int K = g.K, nt = K / BK;
    unsigned voffA[2], voffB[2];
#pragma unroll
    for (int i = 0; i < 2; ++i) { int R, C; stage_rc(tid * 16 + i * 8192, R, C); const int Rb = Epi::PERM ? ((R & ~31) + perm32(R & 31)) : R;
        voffA[i] = (unsigned)(R * K + C) * 2u; voffB[i] = (unsigned)(Rb * K + C) * 2u; }
    const size_t kstep = (size_t)(BK * 2);
    const size_t hstep = (size_t)HALF * K * 2;
    const size_t tstep = 2 * hstep;
    const unsigned ldsw = (unsigned)wid * 1024u;
    const int aoff = lds_byte(wr * 64 + fr, fq * 8), boff = lds_byte(wc * 32 + fr, fq * 8);
#define PG8_SA(b, h) (((b) * 2 + (h)) * HTB)
#define PG8_SB(b, h) ((4 + (b) * 2 + (h)) * HTB)
#define PG8_STAGE(bufoff, gbase, voff) do { _Pragma("unroll") for (int _i = 0; _i < 2; ++_i) \
        __builtin_amdgcn_global_load_lds((const unsigned*)((const char*)(gbase) + (voff)[_i]), (PG8_LAS unsigned*)(lds + (bufoff) + ldsw + _i * 8192), 16, 0, 0); } while (0)
#define PG8_LDA(dst, b, h) do { _Pragma("unroll") for (int m = 0; m < 4; ++m) _Pragma("unroll") for (int k = 0; k < 2; ++k) dst[m][k] = *(const PG8_LAS bf16x8*)(lds + PG8_SA(b, h) + aoff + m * 2048 + k * 1024); } while (0)
#define PG8_LDB(dst, b, h) do { _Pragma("unroll") for (int n = 0; n < 2; ++n) _Pragma("unroll") for (int k = 0; k < 2; ++k) dst[n][k] = *(const PG8_LAS bf16x8*)(lds + PG8_SB(b, h) + boff + n * 2048 + k * 1024); } while (0)
#define PG8_MMA(ai, bj, At, Bt) do { __builtin_amdgcn_s_setprio(1); _Pragma("unroll") for (int m = 0; m < 4; ++m) _Pragma("unroll") for (int n = 0; n < 2; ++n) _Pragma("unroll") for (int k = 0; k < 2; ++k) \
        acc[ai][bj][m][n] = __builtin_amdgcn_mfma_f32_16x16x32_bf16(Bt[n][k], At[m][k], acc[ai][bj][m][n], 0, 0, 0); __builtin_amdgcn_s_setprio(0); } while (0)
#define PG8_WAIT_V(n) asm volatile("s_waitcnt vmcnt(" #n ")" ::: "memory")
#define PG8_WAIT_L(n) asm volatile("s_waitcnt lgkmcnt(" #n ")" ::: "memory")
#define PG8_BAR __builtin_amdgcn_s_barrier()
#define PG8_SCHED __builtin_amdgcn_sched_barrier(0)
    Unit cur, nxt; int ui = 0;
    if (!S.next(0, cur)) return;
    f32x4 acc[2][2][4][2];
#pragma unroll
    for (int a = 0; a < 2; ++a)
#pragma unroll
        for (int b = 0; b < 2; ++b)
#pragma unroll
            for (int m = 0; m < 4; ++m)
#pragma unroll
                for (int n = 0; n < 2; ++n) acc[a][b][m][n] = (f32x4){0.f, 0.f, 0.f, 0.f};
    bf16x8 At[4][2], B0[2][2], B1[2][2];
    const char* cA = (const char*)g.A + (size_t)cur.pm * tstep; const char* cB = (const char*)g.Bt + (size_t)cur.pn * tstep;
    S.a_ready(cur);
    if constexpr (SP2) {
        PG8_STAGE(PG8_SB(0, 0), cB, voffB); PG8_STAGE(PG8_SB(0, 1), cB + hstep, voffB); PG8_STAGE(PG8_SA(0, 0), cA, voffA); PG8_STAGE(PG8_SA(0, 1), cA + hstep, voffA);
        if (wr == 1) PG8_BAR;
        PG8_WAIT_V(2); PG8_BAR;
        PG8_STAGE(PG8_SB(1, 0), cB + kstep, voffB); PG8_STAGE(PG8_SA(1, 0), cA + kstep, voffA); PG8_STAGE(PG8_SB(1, 1), cB + hstep + kstep, voffB);
        PG8_WAIT_V(6); PG8_BAR;
    } else {
        PG8_STAGE(PG8_SB(0, 0), cB, voffB); PG8_STAGE(PG8_SA(0, 0), cA, voffA); PG8_STAGE(PG8_SB(0, 1), cB + hstep, voffB); PG8_STAGE(PG8_SA(0, 1), cA + hstep, voffA);
        if (wr == 1) PG8_BAR;
        PG8_WAIT_V(4); PG8_BAR;
        PG8_STAGE(PG8_SB(1, 0), cB + kstep, voffB); PG8_STAGE(PG8_SA(1, 0), cA + kstep, voffA); PG8_STAGE(PG8_SB(1, 1), cB + hstep + kstep, voffB);
        PG8_WAIT_V(6); PG8_BAR;
    }
    for (;;) {
        const bool has_next = S.next(ui + 1, nxt);
        const char* nA = has_next ? (const char*)g.A + (size_t)nxt.pm * tstep : cA; const char* nB = has_next ? (const char*)g.Bt + (size_t)nxt.pn * tstep : cB;
        for (int t = 0; t < nt; t += 2) {
            const bool last = (t == nt - 2);
            const char* a1 = cA + (size_t)(t + 1) * kstep;
            const char* a2 = last ? nA : cA + (size_t)(t + 2) * kstep; const char* b2 = last ? nB : cB + (size_t)(t + 2) * kstep;
            const char* a3 = a2 + kstep; const char* b3 = b2 + kstep;
            if (last && has_next) S.a_ready(nxt);
            if constexpr (SP2) {
            PG8_LDB(B0, 0, 0); PG8_LDB(B1, 0, 1); PG8_SCHED; PG8_LDA(At, 0, 0); PG8_STAGE(PG8_SA(1, 1), a1 + hstep, voffA);
            PG8_WAIT_V(8); PG8_WAIT_L(0); PG8_BAR; PG8_MMA(0, 0, At, B0); PG8_MMA(0, 1, At, B1); PG8_BAR; PG8_SCHED;
            PG8_LDA(At, 0, 1); PG8_STAGE(PG8_SB(0, 0), b2, voffB); PG8_STAGE(PG8_SB(0, 1), b2 + hstep, voffB); PG8_STAGE(PG8_SA(0, 0), a2, voffA);
            PG8_WAIT_V(8); PG8_WAIT_L(0); PG8_BAR; PG8_MMA(1, 0, At, B0); PG8_MMA(1, 1, At, B1); PG8_BAR; PG8_SCHED;
            PG8_LDB(B0, 1, 0); PG8_LDB(B1, 1, 1); PG8_SCHED; PG8_LDA(At, 1, 0); PG8_STAGE(PG8_SA(0, 1), a2 + hstep, voffA);
            PG8_WAIT_V(8); PG8_WAIT_L(0); PG8_BAR; PG8_MMA(0, 0, At, B0); PG8_MMA(0, 1, At, B1); PG8_BAR; PG8_SCHED;
            PG8_LDA(At, 1, 1); PG8_STAGE(PG8_SB(1, 0), b3, voffB); PG8_STAGE(PG8_SB(1, 1), b3 + hstep, voffB); PG8_STAGE(PG8_SA(1, 0), a3, voffA);
            PG8_WAIT_V(8); PG8_WAIT_L(0); PG8_BAR; PG8_MMA(1, 0, At, B0); PG8_MMA(1, 1, At, B1); PG8_BAR; PG8_SCHED;
            } else {
            PG8_LDB(B0, 0, 0); PG8_SCHED; PG8_LDA(At, 0, 0); PG8_STAGE(PG8_SA(1, 1), a1 + hstep, voffA);
            PG8_WAIT_L(8); PG8_BAR; PG8_WAIT_L(0); PG8_MMA(0, 0, At, B0); PG8_BAR; PG8_SCHED;
            PG8_LDB(B1, 0, 1); PG8_STAGE(PG8_SB(0, 0), b2, voffB);
            PG8_BAR; PG8_WAIT_L(0); PG8_MMA(0, 1, At, B1); PG8_BAR;
            PG8_LDA(At, 0, 1); PG8_STAGE(PG8_SA(0, 0), a2, voffA);
            PG8_BAR; PG8_WAIT_L(0); PG8_MMA(1, 0, At, B0); PG8_BAR; PG8_SCHED;
            PG8_STAGE(PG8_SB(0, 1), b2 + hstep, voffB);
            PG8_WAIT_V(6); PG8_BAR; PG8_MMA(1, 1, At, B1); PG8_BAR;
            PG8_LDB(B0, 1, 0); PG8_SCHED; PG8_LDA(At, 1, 0); PG8_STAGE(PG8_SA(0, 1), a2 + hstep, voffA);
            PG8_WAIT_L(8); PG8_BAR; PG8_WAIT_L(0); PG8_MMA(0, 0, At, B0); PG8_BAR; PG8_SCHED;
            PG8_LDB(B1, 1, 1); PG8_STAGE(PG8_SB(1, 0), b3, voffB);
            PG8_BAR; PG8_WAIT_L(0); PG8_MMA(0, 1, At, B1); PG8_BAR;
            PG8_LDA(At, 1, 1); PG8_STAGE(PG8_SA(1, 0), a3, voffA);
            PG8_BAR; PG8_WAIT_L(0); PG8_MMA(1, 0, At, B0); PG8_BAR; PG8_SCHED;
            PG8_STAGE(PG8_SB(1, 1), b3 + hstep, voffB);
            PG8_WAIT_V(6); PG8_BAR; PG8_MMA(1, 1, At, B1); PG8_BAR;
            }
        }
        if constexpr (ALIGN_EPI) { if (wr == 0) PG8_BAR; }
        if constexpr (!Epi::AFTER_DRAIN) { E(acc, cur, wr, wc, fr, fq); S.done(cur); }
        if (!has_next) break;
#pragma unroll
        for (int a = 0; a < 2; ++a)
#pragma unroll
            for (int b = 0; b < 2; ++b)
#pragma unroll
                for (int m = 0; m < 4; ++m)
#pragma unroll
                    for (int n = 0; n < 2; ++n) acc[a][b][m][n] = (f32x4){0.f, 0.f, 0.f, 0.f};
        cur = nxt; cA = nA; cB = nB; ++ui;
        if constexpr (ALIGN_EPI) { if (wr == 1) PG8_BAR; }
    }
    PG8_WAIT_V(0);
    if constexpr (!ALIGN_EPI) { if (wr == 0) PG8_BAR; }
    PG8_BAR;
    if constexpr (Epi::AFTER_DRAIN) { E.fused(acc, cur, wr, wc, fr, fq, lds, wid, lane); S.done(cur); }
#undef PG8_SA
#undef PG8_SB
#undef PG8_STAGE
#undef PG8_LDA
#undef PG8_LDB
#undef PG8_MMA
#undef PG8_WAIT_V
#undef PG8_WAIT_L
#undef PG8_BAR
#undef PG8_SCHED
}
}
#include <hip/hip_bf16.h>
#include <cmath>
namespace attn_body {
using bf16=__hip_bfloat16;
using bf16x8=__attribute__((ext_vector_type(8)))short;
using s16x4=__attribute__((ext_vector_type(4)))short;
using f32x16=__attribute__((ext_vector_type(16)))float;
using u32x4=__attribute__((ext_vector_type(4)))unsigned;
constexpr int BATCH=8,NHEAD=16,SEQ=2048,D=64,PQK=512,PO=1024;
constexpr int NW=8,QBLK=32,QB=QBLK*NW,KVBLK=64,NQB=SEQ/QB;
constexpr int ATTN_UNIT_ROWS=QB;
__device__ __forceinline__ int crow(int r,int hi){return (r&3)+8*(r>>2)+4*hi;}
#define SBAR() __builtin_amdgcn_sched_barrier(0)
__device__ __forceinline__ void cmask(f32x16&p0,f32x16&p1,int jb,int qrel,int hi){
  const float NEG=-INFINITY; (void)hi;
  if(jb>(qrel>>6)){
  #pragma unroll
  for(int r=0;r<16;++r){p0[r]=NEG;p1[r]=NEG;}}
}

constexpr int NSLOT=3, SLOTB=8192;
constexpr int LDS_K=0, LDS_V=NSLOT*SLOTB, LDS_WS=2*NSLOT*SLOTB, LDS_OST=LDS_WS+NW*64*4, LDS_BYTES=LDS_OST+NW*4096;
constexpr float C2=0.125f*1.4426950408889634f;
__device__ __forceinline__ void glds16(const void*gsrc,unsigned lds_dst){unsigned keep;
  asm volatile("s_mov_b32 %0, m0\n\ts_mov_b32 m0, %2\n\ts_nop 0\n\tglobal_load_lds_dwordx4 %1, off\n\ts_mov_b32 m0, %0":"=&s"(keep):"v"(gsrc),"s"(lds_dst):"memory");}
__device__ __forceinline__ float max3f(float a,float b,float c){float r;asm("v_max3_f32 %0, %1, %2, %3":"=v"(r):"v"(a),"v"(b),"v"(c));return r;}
__device__ __forceinline__ float max2f(float a,float b){float r;asm("v_max_f32_e32 %0, %1, %2":"=v"(r):"v"(a),"v"(b));return r;}
__device__ __forceinline__ float fadd_s(float a,float b){float r;asm("v_add_f32_e32 %0, %1, %2":"=v"(r):"v"(a),"v"(b));return r;}
__device__ __forceinline__ float fsub_s(float a,float b){float r;asm("v_sub_f32_e32 %0, %1, %2":"=v"(r):"v"(a),"v"(b));return r;}
typedef float f32x2_t __attribute__((ext_vector_type(2))); typedef __bf16 bf16x2_t __attribute__((ext_vector_type(2)));
__device__ __forceinline__ unsigned cvtpk_s(float lo,float hi){f32x2_t v={lo,hi};bf16x2_t b=__builtin_convertvector(v,bf16x2_t);return __builtin_bit_cast(unsigned,b);}
#define WAIT_BAR(N) asm volatile("s_waitcnt vmcnt(" #N ") lgkmcnt(0)\n\ts_barrier":::"memory")

__device__ __forceinline__ void qkt(f32x16&p0,f32x16&p1,const char*Kslot,const bf16x8*qr,const f32x16&negm,int r32,int hi){
  const char*kb=Kslot+hi*1024+r32*16;
  #pragma unroll
  for(int d0=0;d0<4;++d0){
    const bf16x8 b0=*reinterpret_cast<const bf16x8*>(kb+d0*2048);
    const bf16x8 b1=*reinterpret_cast<const bf16x8*>(kb+d0*2048+512);
    if(d0==0){p0=__builtin_amdgcn_mfma_f32_32x32x16_bf16(b0,qr[0],negm,0,0,0);p1=__builtin_amdgcn_mfma_f32_32x32x16_bf16(b1,qr[0],negm,0,0,0);}
    else{p0=__builtin_amdgcn_mfma_f32_32x32x16_bf16(b0,qr[d0],p0,0,0,0);p1=__builtin_amdgcn_mfma_f32_32x32x16_bf16(b1,qr[d0],p1,0,0,0);}}
}
typedef __attribute__((address_space(3))) const char* lds_cptr;
typedef short v4i16_t __attribute__((ext_vector_type(4)));
__device__ __forceinline__ void kload8(bf16x8*kf,lds_cptr kp){
  kf[0]=*(const __attribute__((address_space(3))) bf16x8*)(kp);      kf[1]=*(const __attribute__((address_space(3))) bf16x8*)(kp+512);
  kf[2]=*(const __attribute__((address_space(3))) bf16x8*)(kp+2048); kf[3]=*(const __attribute__((address_space(3))) bf16x8*)(kp+2560);
  kf[4]=*(const __attribute__((address_space(3))) bf16x8*)(kp+4096); kf[5]=*(const __attribute__((address_space(3))) bf16x8*)(kp+4608);
  kf[6]=*(const __attribute__((address_space(3))) bf16x8*)(kp+6144); kf[7]=*(const __attribute__((address_space(3))) bf16x8*)(kp+6656);
}
__device__ __forceinline__ void kload2(bf16x8*kf,lds_cptr kp,int j){ kf[2*j]=*(const __attribute__((address_space(3))) bf16x8*)(kp+j*2048); kf[2*j+1]=*(const __attribute__((address_space(3))) bf16x8*)(kp+j*2048+512); }
__device__ __forceinline__ s16x4 vtr(lds_cptr p){ return __builtin_bit_cast(s16x4,__builtin_amdgcn_ds_read_tr16_b64_v4i16((__attribute__((address_space(3))) v4i16_t*)p)); }
__device__ __forceinline__ float rowmax(const f32x16&p0,const f32x16&p1){
  float a=max3f(p0[0],p0[1],p1[0]),b=max3f(p0[2],p0[3],p1[1]);a=max3f(a,p1[2],p1[3]);
  #pragma unroll
  for(int r=4;r<16;r+=4){a=max3f(a,p0[r],p0[r+1]);b=max3f(b,p0[r+2],p0[r+3]);a=max3f(a,p1[r],p1[r+1]);b=max3f(b,p1[r+2],p1[r+3]);}
  const float m=max2f(a,b);
  auto rr=__builtin_amdgcn_permlane32_swap(__float_as_uint(m),__float_as_uint(m),false,false);
  return max2f(__uint_as_float(rr[0]),__uint_as_float(rr[1]));
}
__device__ __forceinline__ void pv(f32x16*o,int vb,bf16x8 pa0,bf16x8 pa1,bf16x8 pa2,bf16x8 pa3){
  #pragma unroll
  for(int d0=0;d0<2;++d0){s16x4 lo[4],hi[4];
    #pragma unroll
    for(int ks=0;ks<4;++ks){
      asm volatile("ds_read_b64_tr_b16 %0,%1 offset:%c2":"=&v"(lo[ks]):"v"(vb),"i"(d0*4096+ks*1024):"memory");
      asm volatile("ds_read_b64_tr_b16 %0,%1 offset:%c2":"=&v"(hi[ks]):"v"(vb),"i"(d0*4096+ks*1024+512):"memory");}
    asm volatile("s_waitcnt lgkmcnt(0)":::"memory");SBAR();
    #define PK(k) (bf16x8){lo[k][0],lo[k][1],lo[k][2],lo[k][3],hi[k][0],hi[k][1],hi[k][2],hi[k][3]}
    o[d0]=__builtin_amdgcn_mfma_f32_32x32x16_bf16(pa0,PK(0),o[d0],0,0,0);
    o[d0]=__builtin_amdgcn_mfma_f32_32x32x16_bf16(pa1,PK(1),o[d0],0,0,0);
    o[d0]=__builtin_amdgcn_mfma_f32_32x32x16_bf16(pa2,PK(2),o[d0],0,0,0);
    o[d0]=__builtin_amdgcn_mfma_f32_32x32x16_bf16(pa3,PK(3),o[d0],0,0,0);
    #undef PK
  }
}

#ifndef ATTN_STORE16
#define ATTN_STORE16(p,v) (*(u32x4*)(p)=(v))
#endif
template<int THRL> __device__ __forceinline__ void attn_unit(int b,int qb,const bf16*Q,const bf16*__restrict__ K,const bf16*__restrict__ V,bf16*O,char*shm){
  int tid_l=threadIdx.x; asm volatile("":"+v"(tid_l)); const int tid=tid_l,lane=tid&63,r32=lane&31,hi=lane>>5; const int wid=__builtin_amdgcn_readfirstlane(tid>>6);
  const long rowbase=(long)b*SEQ; const int q0=qb*QB;
  const bf16*Qw=Q+(rowbase+q0+wid*QBLK)*PQK;
  const bf16*Kh=K+rowbase*PQK,*Vh=V+rowbase*PQK;
  const unsigned lds0=(unsigned)(uintptr_t)shm;
  float*wsf=(float*)(shm+LDS_WS)+wid*64;
  const bf16*ksrc=Kh+(long)lane*PQK+wid*8;
  const bf16*vsrc=Vh+(long)(16*(wid&3)+(lane>>2))*PQK+(wid>>2)*32+(lane&3)*8;
  const unsigned kdst=lds0+LDS_K+wid*1024, vdst=lds0+LDS_V+wid*1024;
  #define DMA_K(t,slot) glds16(ksrc+(long)(t)*KVBLK*PQK,(unsigned)__builtin_amdgcn_readfirstlane(kdst+(slot)))
  #define DMA_V(t,slot) glds16(vsrc+(long)(t)*KVBLK*PQK,(unsigned)__builtin_amdgcn_readfirstlane(vdst+(slot)))
  const int vb0=(int)(lds0+LDS_V)+((lane>>4)&1)*32+(lane&3)*8+(4*hi+((lane&15)>>2))*64;
  const char*Kbase=shm+LDS_K; bf16x8 kf[8];
  const lds_cptr shm3=(lds_cptr)shm; const lds_cptr kp0=shm3+LDS_K+hi*1024+r32*16; const lds_cptr vp0=shm3+LDS_V+((lane>>4)&1)*32+(lane&3)*8+(4*hi+((lane&15)>>2))*64;
  const int NT=(q0+QB)/KVBLK;
  DMA_K(0,0);DMA_V(0,0);DMA_K(1,SLOTB);
  bf16x8 qr[4];
  #pragma unroll
  for(int d0=0;d0<4;++d0)qr[d0]=*reinterpret_cast<const bf16x8*>(&Qw[(long)r32*PQK+d0*16+hi*8]);
  float mhat=0.f,l_reg=0.f;f32x16 o[2];o[0]=f32x16{};o[1]=f32x16{};f32x16 negm=f32x16{};asm volatile("":"+v"(negm));
  const int qrel=wid*QBLK+r32;
  #define CMASK(P0,P1,t) do{int jb_=(t)-(NT-4); if(jb_>=0)cmask(P0,P1,jb_,qrel,hi);}while(0)
  bool resc=false;
  #define START(P0,P1) do{ const float rm=rowmax(P0,P1); resc=false; \
    { const float dl=rm; mhat=fadd_s(mhat,dl); \
      _Pragma("unroll") for(int r=0;r<16;++r){P0[r]=fsub_s(P0[r],dl);P1[r]=fsub_s(P1[r],dl);} \
      _Pragma("unroll") for(int r=0;r<16;++r)negm[r]=-mhat; asm volatile("":"+v"(negm)); } \
    _Pragma("unroll") for(int r=0;r<16;++r)P0[r]=__builtin_amdgcn_exp2f(P0[r]); }while(0)
  #define RESC() do{ if(resc){ asm volatile("s_waitcnt lgkmcnt(0)":::"memory"); \
      _Pragma("unroll") for(int d_=0;d_<2;++d_) _Pragma("unroll") for(int r=0;r<16;++r)o[d_][r]*=wsf[crow(r,hi)]; } }while(0)
  f32x16 pA0,pA1,pB0,pB1;
  int sl_prev=0,sl_cur=0,sl_next=SLOTB;
  #define ROT() do{sl_prev=sl_cur;sl_cur=sl_next;sl_next=(sl_next==(NSLOT-1)*SLOTB)?0:sl_next+SLOTB;}while(0)
  DMA_K(2,2*SLOTB);
  WAIT_BAR(3);
  qkt(pA0,pA1,Kbase,qr,negm,r32,hi);asm volatile("s_nop 15\n\ts_nop 7":"+v"(pA0),"+v"(pA1));CMASK(pA0,pA1,0);
  START(pA0,pA1);
  _Pragma("unroll") for(int r=0;r<16;++r)pA1[r]=__builtin_amdgcn_exp2f(pA1[r]);
  WAIT_BAR(0);
  DMA_K(3,0);DMA_V(1,SLOTB);
  ROT();
  kload8(kf,kp0+sl_cur);
  WAIT_BAR(2);
  s16x4 vlo[8],vhi[8]; u32x4 pw0,pw1,pw2,pw3;
  #define PKW(P,B) cvtpk_s(P[B],P[B+1])
  #define PAF(k) __builtin_bit_cast(bf16x8,pw##k)
  #define VFR(i) (bf16x8){vlo[i][0],vlo[i][1],vlo[i][2],vlo[i][3],vhi[i][0],vhi[i][1],vhi[i][2],vhi[i][3]}
  #define PIN(x) asm volatile("":"+v"(x))
  #define MX3(a,b,c) __builtin_fmaxf(__builtin_fmaxf((a),(b)),(c))
  #define GAPA(MF,A0,A1,A2,A3,W0,W1,PW) do{ MF; sacc+=A0; sacc+=A1; sacc+=A2; sacc+=A3; PIN(sacc); W0; W1; PIN(PW); SBAR(); }while(0)
  #define EX(v) __builtin_amdgcn_exp2f(v)
  #define GAPB(MF,X,B) do{ MF; X[B]=EX(X[B]); X[B+1]=EX(X[B+1]); X[B+2]=EX(X[B+2]); X[B+3]=EX(X[B+3]); PIN(X); SBAR(); }while(0)
  #define VRD(i) do{ vlo[i]=vtr(vp_+(((i)>>2)*4096+((i)&3)*1024)); vhi[i]=vtr(vp_+(((i)>>2)*4096+((i)&3)*1024+512)); }while(0)
  #define KRD(G,j) do{ if(G){ kload2(kf,kp0+sl_next,j); SBAR(); } }while(0)
  #define STEP(C0,C1,P0,P1,t,GK,GV,GL) do{ SBAR(); \
    const lds_cptr vp_=vp0+sl_prev; \
    VRD(0); SBAR(); float sacc=(P0[0]+P0[1]); \
    GAPA(C0=__builtin_amdgcn_mfma_f32_32x32x16_bf16(kf[0],qr[0],negm,0,0,0), P0[2],P0[3],P0[4],P0[5],     pw0[0]=PKW(P0,0), pw0[1]=PKW(P0,2), pw0); \
    VRD(4); SBAR(); GAPA(C1=__builtin_amdgcn_mfma_f32_32x32x16_bf16(kf[1],qr[0],negm,0,0,0), P0[6],P0[7],P0[8],P0[9],     pw0[2]=PKW(P0,4), pw0[3]=PKW(P0,6), pw0); \
    VRD(1); SBAR(); GAPA(C0=__builtin_amdgcn_mfma_f32_32x32x16_bf16(kf[2],qr[1],C0,0,0,0),   P0[10],P0[11],P0[12],P0[13], pw1[0]=PKW(P0,8), pw1[1]=PKW(P0,10), pw1); \
    VRD(5); SBAR(); GAPA(C1=__builtin_amdgcn_mfma_f32_32x32x16_bf16(kf[3],qr[1],C1,0,0,0),   P0[14],P0[15],P1[0],P1[1],   pw1[2]=PKW(P0,12),pw1[3]=PKW(P0,14), pw1); \
    VRD(2); SBAR(); GAPA(C0=__builtin_amdgcn_mfma_f32_32x32x16_bf16(kf[4],qr[2],C0,0,0,0),   P1[2],P1[3],P1[4],P1[5],     pw2[0]=PKW(P1,0), pw2[1]=PKW(P1,2), pw2); \
    VRD(6); SBAR(); GAPA(C1=__builtin_amdgcn_mfma_f32_32x32x16_bf16(kf[5],qr[2],C1,0,0,0),   P1[6],P1[7],P1[8],P1[9],     pw2[2]=PKW(P1,4), pw2[3]=PKW(P1,6), pw2); \
    VRD(3); SBAR(); GAPA(C0=__builtin_amdgcn_mfma_f32_32x32x16_bf16(kf[6],qr[3],C0,0,0,0),   P1[10],P1[11],P1[12],P1[13], pw3[0]=PKW(P1,8), pw3[1]=PKW(P1,10), pw3); \
    VRD(7); SBAR(); GAPA(C1=__builtin_amdgcn_mfma_f32_32x32x16_bf16(kf[7],qr[3],C1,0,0,0),   P1[14],P1[15],0.f,0.f,       pw3[2]=PKW(P1,12),pw3[3]=PKW(P1,14), pw3); \
    l_reg+=sacc; \
    if(GK){DMA_K((t)+3,sl_cur);} if(GV){DMA_V((t)+1,sl_next);} \
    CMASK(C0,C1,t); \
    { float a=MX3(C0[0],C0[1],C1[0]),b=MX3(C0[2],C0[3],C1[1]); a=MX3(a,C1[2],C1[3]); \
      _Pragma("unroll") for(int r=4;r<16;r+=4){a=MX3(a,C0[r],C0[r+1]);b=MX3(b,C0[r+2],C0[r+3]);a=MX3(a,C1[r],C1[r+1]);b=MX3(b,C1[r+2],C1[r+3]);} \
      float rm=__builtin_fmaxf(a,b); { auto rr=__builtin_amdgcn_permlane32_swap(__float_as_uint(rm),__float_as_uint(rm),false,false); rm=__builtin_fmaxf(__uint_as_float(rr[0]),__uint_as_float(rr[1])); } \
      resc=false; \
      if(__builtin_expect(__any(rm>(float)THRL),0)){ const float dl=__builtin_fmaxf(rm,0.f); mhat+=dl; \
        _Pragma("unroll") for(int r=0;r<16;++r){C0[r]-=dl;C1[r]-=dl;} \
        _Pragma("unroll") for(int r=0;r<16;++r)negm[r]=-mhat; asm volatile("":"+v"(negm)); \
        const float f=__builtin_amdgcn_exp2f(-dl); l_reg*=f; if(hi==0)wsf[r32]=f; resc=true; } } \
    SBAR(); \
    GAPB(o[0]=__builtin_amdgcn_mfma_f32_32x32x16_bf16(PAF(0),VFR(0),o[0],0,0,0), C0,0); \
    GAPB(o[1]=__builtin_amdgcn_mfma_f32_32x32x16_bf16(PAF(0),VFR(4),o[1],0,0,0), C0,4); \
    KRD(GL,0); GAPB(o[0]=__builtin_amdgcn_mfma_f32_32x32x16_bf16(PAF(1),VFR(1),o[0],0,0,0), C0,8); \
    KRD(GL,1); GAPB(o[1]=__builtin_amdgcn_mfma_f32_32x32x16_bf16(PAF(1),VFR(5),o[1],0,0,0), C0,12); \
    KRD(GL,2); GAPB(o[0]=__builtin_amdgcn_mfma_f32_32x32x16_bf16(PAF(2),VFR(2),o[0],0,0,0), C1,0); \
    KRD(GL,3); GAPB(o[1]=__builtin_amdgcn_mfma_f32_32x32x16_bf16(PAF(2),VFR(6),o[1],0,0,0), C1,4); \
    GAPB(o[0]=__builtin_amdgcn_mfma_f32_32x32x16_bf16(PAF(3),VFR(3),o[0],0,0,0), C1,8); \
    GAPB(o[1]=__builtin_amdgcn_mfma_f32_32x32x16_bf16(PAF(3),VFR(7),o[1],0,0,0), C1,12); \
    }while(0)
  int t=1;
  #undef CMASK
  #define CMASK(P0,P1,t) do{}while(0)
  for(;t+5<NT;t+=2){
    STEP(pB0,pB1,pA0,pA1,t,true,true,true);     WAIT_BAR(2); RESC(); ROT();
    STEP(pA0,pA1,pB0,pB1,t+1,true,true,true);   WAIT_BAR(2); RESC(); ROT();
  }
  #undef CMASK
  #define CMASK(P0,P1,t) do{int jb_=(t)-(NT-4); if(jb_>=0)cmask(P0,P1,jb_,qrel,hi);}while(0)
  #define ENDW(tt) do{ if((tt)+3<NT){WAIT_BAR(2);} else if((tt)+2<NT){WAIT_BAR(1);} else {WAIT_BAR(0);} }while(0)
  for(;t+1<NT;t+=2){
    STEP(pB0,pB1,pA0,pA1,t,(t+3<NT),(t+1<NT),(t+1<NT));       ENDW(t);   RESC(); ROT();
    STEP(pA0,pA1,pB0,pB1,t+1,(t+4<NT),(t+2<NT),(t+2<NT));     ENDW(t+1); RESC(); ROT();
  }
  STEP(pB0,pB1,pA0,pA1,NT-1,false,false,false); RESC();
  { float sacc=pB0[0]+pB0[1]; _Pragma("unroll") for(int r=2;r<16;++r)sacc+=pB0[r]; _Pragma("unroll") for(int r=0;r<16;++r)sacc+=pB1[r]; l_reg+=sacc;
    pw0=(u32x4){PKW(pB0,0),PKW(pB0,2),PKW(pB0,4),PKW(pB0,6)};pw1=(u32x4){PKW(pB0,8),PKW(pB0,10),PKW(pB0,12),PKW(pB0,14)};pw2=(u32x4){PKW(pB1,0),PKW(pB1,2),PKW(pB1,4),PKW(pB1,6)};pw3=(u32x4){PKW(pB1,8),PKW(pB1,10),PKW(pB1,12),PKW(pB1,14)};
    SBAR(); pv(o,vb0+sl_cur,PAF(0),PAF(1),PAF(2),PAF(3)); }
  #undef PKW
  #undef PAF
  #undef VFR
  #undef PIN
  #undef MX3
  #undef GAPA
  #undef GAPB
  #undef EX
  #undef VRD
  #undef KRD
  #undef STEP
  #undef ENDW
  {auto rr=__builtin_amdgcn_permlane32_swap(__float_as_uint(l_reg),__float_as_uint(l_reg),false,false);l_reg=__uint_as_float(rr[0])+__uint_as_float(rr[1]);}
  if(hi==0)wsf[32+r32]=l_reg;asm volatile("s_waitcnt lgkmcnt(0)":::"memory");
  float rli[16];
  #pragma unroll
  for(int r=0;r<16;++r)rli[r]=__builtin_amdgcn_rcpf(wsf[32+crow(r,hi)]);
  bf16*Ow=O+(rowbase+q0+wid*QBLK)*PO;
  { bf16*stg=(bf16*)(shm+LDS_OST)+wid*2048;
    #pragma unroll
    for(int r=0;r<16;++r){const int orow=crow(r,hi);
      #pragma unroll
      for(int d0=0;d0<2;++d0)stg[orow*64+d0*32+r32]=__float2bfloat16(o[d0][r]*rli[r]);}
    asm volatile("s_waitcnt lgkmcnt(0)":::"memory");
    #pragma unroll
    for(int i=0;i<4;++i){const int row=i*8+(lane>>3),ch=lane&7; const u32x4 v=*(const u32x4*)(stg+row*64+ch*8); ATTN_STORE16(Ow+(long)row*PO+ch*8,v);} }
  asm volatile("s_waitcnt lgkmcnt(0)\n\ts_barrier":::"memory");
  #undef DMA_K
  #undef DMA_V
  #undef CMASK
  #undef START
  #undef RESC
  #undef ROT
}
#undef SBAR
#undef WAIT_BAR
}
namespace cg = cooperative_groups;
#define LAS __attribute__((address_space(3)))
typedef unsigned short bf16;
typedef unsigned v4u __attribute__((ext_vector_type(4)));
typedef unsigned v2u __attribute__((ext_vector_type(2)));
typedef float f32x4 __attribute__((ext_vector_type(4)));
typedef float f32x2 __attribute__((ext_vector_type(2)));
typedef float f32x16 __attribute__((ext_vector_type(16)));
typedef short bf16x8 __attribute__((ext_vector_type(8)));

constexpr int NWAVES = 8;
constexpr int D = 1024, MP = 16384, MS = 256, M = MP + MS, FF = 2816, DIN = 2560;
constexpr float EPS = 1e-6f;
constexpr float C2 = 0.125f * 1.4426950408889634f;
constexpr size_t OFF_Y = 0, OFF_KP = 17039360, OFF_VP = 33816576, OFF_PP = 50593792, OFF_CP = 50655232, OFF_KS = 50663424, OFF_VS = 50925568, OFF_PS = 51187712, OFF_CS = 51249152, OUT_TOTAL = 51257344;
constexpr size_t MiB = 1u << 20;
constexpr size_t WS_ROPE = 1 * MiB, WS_POOLWT = 2 * MiB, WS_W = 4 * MiB, WL = 40 * MiB;
constexpr size_t W_GU1 = 0, W_D1 = 11 * MiB, W_IN = 16 * MiB + MiB / 2, W_OUT = 21 * MiB + MiB / 2, W_GU2 = 23 * MiB + MiB / 2, W_D2 = 34 * MiB + MiB / 2;
constexpr size_t WS_X = 84 * MiB, WS_H = 149 * MiB, WS_MIX = 182 * MiB, WS_ACT = 215 * MiB;
constexpr size_t WS_QB = 215 * MiB, WS_KB = 232 * MiB, WS_VB = 249 * MiB, WS_ZB = 266 * MiB;
constexpr size_t WS_OB = 305 * MiB, WS_OPART = 338 * MiB, WS_ML = 347 * MiB, WS_END = 352 * MiB;
static_assert(WS_ROPE == pg8::WOFF_ROPE && WS_QB == pg8::WOFF_QB && WS_KB == pg8::WOFF_KB && WS_VB == pg8::WOFF_VB && WS_ZB == pg8::WOFF_ZB && OFF_KP == pg8::OOFF_KP && OFF_VP == pg8::OOFF_VP && OFF_PP == pg8::OOFF_PP && OFF_KS == pg8::OOFF_KS && OFF_VS == pg8::OOFF_VS && OFF_PS == pg8::OOFF_PS, "offsets");
static_assert(WS_ACT + (size_t)M * FF * 2 <= WS_OB && WS_ZB + (size_t)M * 1024 * 2 <= WS_OB && WS_X + (size_t)M * D * 4 <= WS_H && WS_H + (size_t)M * D * 2 <= WS_MIX && WS_MIX + (size_t)M * D * 2 <= WS_ACT, "ws map");
static_assert(WS_OB + (size_t)M * 1024 * 2 <= WS_OPART && WS_OPART + (size_t)32 * 2 * 9 * 32 * 128 * 4 <= WS_ML && WS_ML + (size_t)32 * 2 * 9 * 32 * 2 * 4 <= WS_END, "ws map 2");
constexpr int LDS_BYTES = 147456;
constexpr size_t CTL_BYTES = 262144, CTL_CNT = 65536;
constexpr size_t WS_SLOTP = 350 * MiB, WS_SLOTS = 351 * MiB;

__device__ __forceinline__ unsigned pk2(float lo, float hi) { f32x2 v = {lo, hi}; typedef __bf16 b2 __attribute__((ext_vector_type(2))); b2 b = __builtin_convertvector(v, b2); return __builtin_bit_cast(unsigned, b); }
__device__ __forceinline__ float bf2f(unsigned short b) { return __builtin_bit_cast(float, (unsigned)b << 16); }
__device__ __forceinline__ bf16x8 pack8(f32x4 a, f32x4 b) { v4u w; w.x = pk2(a.x, a.y); w.y = pk2(a.z, a.w); w.z = pk2(b.x, b.y); w.w = pk2(b.z, b.w); return __builtin_bit_cast(bf16x8, w); }
__device__ __forceinline__ int crow(int r, int hi) { return (r & 3) + 8 * (r >> 2) + 4 * hi; }
__device__ __forceinline__ void xhalf_pair(float m, float& a, float& b) { a = m; b = m; asm volatile("s_nop 1\n\tv_permlane32_swap_b32 %0, %1\n\ts_nop 1" : "+v"(a), "+v"(b)); }
__device__ __forceinline__ float xhalf_max(float m) { float a, b; xhalf_pair(m, a, b); return fmaxf(a, b); }
__device__ __forceinline__ float xhalf_sum(float m) { float a, b; xhalf_pair(m, a, b); return a + b; }
template <int O> __device__ __forceinline__ float swz_xor(float v) { return __builtin_bit_cast(float, __builtin_amdgcn_ds_swizzle(__builtin_bit_cast(int, v), (O << 10) | 0x1f)); }
__device__ __forceinline__ float wave_sum(float v) {
    v += swz_xor<1>(v); v += swz_xor<2>(v); v += swz_xor<4>(v); v += swz_xor<8>(v); v += swz_xor<16>(v);
    return xhalf_sum(v);
}
#define LDS_WAIT() asm volatile("s_waitcnt lgkmcnt(0)" ::: "memory")

struct Params { const float* in[26]; float* out; unsigned char* ws; };
typedef const __attribute__((address_space(4))) unsigned char* karg_ptr;
__device__ __forceinline__ karg_ptr kargs() { karg_ptr k = (karg_ptr)__builtin_amdgcn_kernarg_segment_ptr(); asm volatile("" : "+s"(k)); return k; }
__device__ __forceinline__ const float* KIN(int i) { return *(const float* const __attribute__((address_space(4)))*)(kargs() + 8 * i); }
__device__ __forceinline__ float* KOUT() { return *(float* const __attribute__((address_space(4)))*)(kargs() + 8 * 26); }
__device__ __forceinline__ unsigned char* KWS() { return *(unsigned char* const __attribute__((address_space(4)))*)(kargs() + 8 * 27); }

template <int MODE> __device__ __forceinline__ int wmap(int nl, int row_off) {
    if (MODE == 0) return row_off + nl;
    if (MODE == 1) return (nl >> 7) * 256 + (nl & 127) + row_off;
    const int u = nl >> 8, lc = nl & 255, A = lc >> 6, n = (lc >> 5) & 1, B = (lc >> 4) & 1, f = lc & 15;
    return u * 256 + 128 * (A >> 1) + 32 * (2 * (A & 1) + B) + 16 * n + f;
}
template <int MODE> __device__ __forceinline__ void transpose_item(const float* W, int K, int N, bf16* WT, int row_off, LAS float* scr, int item, int lane) {
    const int nblk = N / 32, kb = item / nblk, nb = item % nblk, k0 = 64 * kb, n0 = 32 * nb;
#pragma unroll 8
    for (int i = 0; i < 32; ++i) { const int kk = 2 * i + (lane >> 5); scr[kk * 33 + (lane & 31)] = W[(size_t)(k0 + kk) * N + n0 + (lane & 31)]; }
    LDS_WAIT(); asm volatile("" ::: "memory");
    const int c = lane & 7;
#pragma unroll
    for (int j = 0; j < 4; ++j) { const int n = (lane >> 3) + 8 * j; const LAS float* s = scr + (8 * c) * 33 + n;
        v4u o; o.x = pk2(s[0 * 33], s[1 * 33]); o.y = pk2(s[2 * 33], s[3 * 33]); o.z = pk2(s[4 * 33], s[5 * 33]); o.w = pk2(s[6 * 33], s[7 * 33]);
        *(v4u*)(WT + (size_t)wmap<MODE>(n0 + n, row_off) * K + k0 + 8 * c) = o; }
    LDS_WAIT(); asm volatile("" ::: "memory");
}
__device__ __forceinline__ void prologue(LAS unsigned char* lds, int gw, int NGW, int wave, int lane) {
    LAS float* scr = (LAS float*)(lds + wave * 16384);
    constexpr int I_F = 16 * 88, I_IN = 16 * 80, I_OUT = 16 * 32, I_L = 6 * I_F + I_IN + I_OUT;
    for (int it = gw; it < 2 * I_L; it += NGW) {
        const int l = it / I_L; int r = it % I_L;
        unsigned char* wl = KWS() + WS_W + (size_t)l * WL;
        if (r < I_F) { transpose_item<1>(KIN(7) + (size_t)l * D * FF, D, FF, (bf16*)(wl + W_GU1), 0, scr, r, lane); continue; } r -= I_F;
        if (r < I_F) { transpose_item<1>(KIN(8) + (size_t)l * D * FF, D, FF, (bf16*)(wl + W_GU1), 128, scr, r, lane); continue; } r -= I_F;
        if (r < I_F) { transpose_item<0>(KIN(9) + (size_t)l * D * FF, FF, D, (bf16*)(wl + W_D1), 0, scr, r, lane); continue; } r -= I_F;
        if (r < I_IN) { transpose_item<2>(KIN(11) + (size_t)l * D * DIN, D, DIN, (bf16*)(wl + W_IN), 0, scr, r, lane); continue; } r -= I_IN;
        if (r < I_OUT) { transpose_item<0>(KIN(20) + (size_t)l * D * D, D, D, (bf16*)(wl + W_OUT), 0, scr, r, lane); continue; } r -= I_OUT;
        if (r < I_F) { transpose_item<1>(KIN(22) + (size_t)l * D * FF, D, FF, (bf16*)(wl + W_GU2), 0, scr, r, lane); continue; } r -= I_F;
        if (r < I_F) { transpose_item<1>(KIN(23) + (size_t)l * D * FF, D, FF, (bf16*)(wl + W_GU2), 128, scr, r, lane); continue; } r -= I_F;
        transpose_item<0>(KIN(24) + (size_t)l * D * FF, FF, D, (bf16*)(wl + W_D2), 0, scr, r, lane);
    }
    float* rope = (float*)(KWS() + WS_ROPE);
    for (int i = gw * 64 + lane; i < 2080 * 32; i += NGW * 64) {
        const int pr = i >> 5, d = i & 31; const int pos = pr < 2048 ? pr : 4096 + (pr - 2048);
        const float inv = exp2f(-(float)d * (13.287712379549449f / 32.0f));
        const float ang = (float)pos * inv;
        const double rev = (double)ang * 0.15915494309189535; const float fr = (float)(rev - __builtin_rint(rev));
        rope[pr * 64 + d] = __builtin_amdgcn_cosf(fr); rope[pr * 64 + 32 + d] = __builtin_amdgcn_sinf(fr);
    }
    bf16* pwt_ = (bf16*)(KWS() + WS_POOLWT);
    for (int i = gw * 64 + lane; i < 2 * 4 * 64 * 64; i += NGW * 64) {
        const int c = i & 63, e = (i >> 6) & 63, lg = i >> 12;
        pwt_[i] = (bf16)(pk2(KIN(17)[(size_t)lg * 4096 + c * 64 + e], 0.f) & 0xffffu);
    }
}
template <bool FINAL> __device__ __forceinline__ void norm_rows(const float* srcP, const float* srcS, const float* g, bf16* H, float* outf, int gw, int NGW, int lane) {
    const f32x4* g4 = (const f32x4*)g + lane;
    f32x4 gv[4];
#pragma unroll
    for (int j = 0; j < 4; ++j) gv[j] = g4[64 * j];
    for (int m = gw; m < M; m += NGW) {
        const float* xr = (m < MP) ? srcP + (size_t)m * D : srcS + (size_t)(m - MP) * D;
        const f32x4* x4 = (const f32x4*)xr + lane;
        f32x4 v[4]; float s = 0.f;
#pragma unroll
        for (int j = 0; j < 4; ++j) { v[j] = x4[64 * j]; s += (v[j].x * v[j].x + v[j].y * v[j].y) + (v[j].z * v[j].z + v[j].w * v[j].w); }
        const float rstd = 1.0f / sqrtf(wave_sum(s) * (1.0f / D) + EPS);
        if (FINAL) {
            f32x4* o4 = (f32x4*)(outf + (size_t)m * D) + lane;
#pragma unroll
            for (int j = 0; j < 4; ++j) o4[64 * j] = v[j] * rstd * gv[j];
        } else {
            v2u* o2 = (v2u*)(H + (size_t)m * D) + lane;
#pragma unroll
            for (int j = 0; j < 4; ++j) { const f32x4 y = v[j] * rstd * gv[j]; v2u w; w.x = pk2(y.x, y.y); w.y = pk2(y.z, y.w); o2[64 * j] = w; }
        }
    }
}
__device__ __forceinline__ f32x16 mfma32(bf16x8 a, bf16x8 b, f32x16 c) { return __builtin_amdgcn_mfma_f32_32x32x16_bf16(a, b, c, 0, 0, 0); }


template <bool BASE16, int K> __device__ __forceinline__ void skinny_gemm(LAS unsigned char* lds, const bf16* A, const bf16* Bt, const void* base, bf16* out, float scale, bf16* hb, float* yout, const float* gain,
                                            unsigned* slots, unsigned* cnt8, int vcu, int G, int tid) {
    const int lane = tid & 63, r32 = lane & 31, hi = lane >> 5, wid = __builtin_amdgcn_readfirstlane(tid >> 6);
    LAS float* R = (LAS float*)lds;
    __syncthreads();
    for (int tile = vcu; tile < 256; tile += G) {
        const int rt = tile >> 5, ct = tile & 31, kw = K >> 3, k0 = wid * kw;
        const bf16* ap = A + (size_t)(rt * 32 + r32) * K + k0 + hi * 8; const bf16* bp = Bt + (size_t)(ct * 32 + r32) * K + k0 + hi * 8;
        f32x16 acc;
#pragma unroll
        for (int r = 0; r < 16; ++r) acc[r] = 0.f;
        constexpr int NST = K / 128, UB = (NST % 11 == 0) ? 11 : 8;
#pragma unroll 1
        for (int s0 = 0; s0 < NST; s0 += UB) { bf16x8 av[UB], bw[UB];
#pragma unroll
            for (int j = 0; j < UB; ++j) { av[j] = *(const bf16x8*)(ap + (s0 + j) * 16); bw[j] = *(const bf16x8*)(bp + (s0 + j) * 16); }
#pragma unroll
            for (int j = 0; j < UB; ++j) acc = mfma32(av[j], bw[j], acc); }
#pragma unroll
        for (int r = 0; r < 16; ++r) R[(wid * 32 + crow(r, hi)) * 32 + r32] = acc[r];
        __syncthreads();
        const int e = tid * 2, row = e >> 5, col = e & 31; f32x2 s = {0.f, 0.f};
#pragma unroll
        for (int w = 0; w < 8; ++w) s += *(const LAS f32x2*)(R + (w * 32 + row) * 32 + col);
        const size_t o = (size_t)(rt * 32 + row) * 1024 + ct * 32 + col; f32x2 bv; if (BASE16) { const unsigned bw = *(const unsigned*)((const bf16*)base + o); bv.x = bf2f(bw & 0xffff); bv.y = bf2f(bw >> 16); } else bv = *(const f32x2*)((const float*)base + o);
        const f32x2 v = bv + s * scale;
        if (out) *(unsigned*)(out + o) = pk2(v.x, v.y);
        float ss = v.x * v.x + v.y * v.y; ss += swz_xor<1>(ss); ss += swz_xor<2>(ss); ss += swz_xor<4>(ss); ss += swz_xor<8>(ss);
        if ((tid & 15) == 0) __hip_atomic_store(slots + (size_t)(rt * 32 + row) * 32 + ct, __builtin_bit_cast(unsigned, ss), __ATOMIC_RELAXED, __HIP_MEMORY_SCOPE_AGENT);
        asm volatile("s_waitcnt vmcnt(0)" ::: "memory");
        __syncthreads();
        if (tid == 0) {
            __hip_atomic_fetch_add(cnt8 + 64 * rt, 1u, __ATOMIC_RELAXED, __HIP_MEMORY_SCOPE_AGENT);
            unsigned spins = 0;
            while (__hip_atomic_load(cnt8 + 64 * rt, __ATOMIC_RELAXED, __HIP_MEMORY_SCOPE_AGENT) < 32u) { __builtin_amdgcn_s_sleep(2); if (++spins > (1u << 22)) break; }
            __builtin_amdgcn_fence(__ATOMIC_ACQUIRE, "agent");
            asm volatile("s_waitcnt vmcnt(0)" ::: "memory");
        }
        __syncthreads();
        { const unsigned* sl = slots + (size_t)(rt * 32 + row) * 32 + (tid & 15) * 2;
          float tot = __builtin_bit_cast(float, __hip_atomic_load(sl, __ATOMIC_RELAXED, __HIP_MEMORY_SCOPE_AGENT)) + __builtin_bit_cast(float, __hip_atomic_load(sl + 1, __ATOMIC_RELAXED, __HIP_MEMORY_SCOPE_AGENT));
          tot += swz_xor<1>(tot); tot += swz_xor<2>(tot); tot += swz_xor<4>(tot); tot += swz_xor<8>(tot);
          const float r = 1.0f / sqrtf(tot * (1.0f / 1024.0f) + EPS);
          const f32x2 gv = *(const f32x2*)(gain + ct * 32 + col); const f32x2 y = v * r * gv;
          if (hb) *(unsigned*)(hb + o) = pk2(y.x, y.y); else *(f32x2*)(yout + o) = y; }
        __syncthreads();
    }
}

__device__ __forceinline__ void sample_piece(LAS unsigned char* lds, int pc, int l, const bf16* Qb, const float* cache_k, const float* cache_v, const float* knew, const float* vnew, float* OPART, float* MLP, int tid) {
    const int lane = tid & 63, r32 = lane & 31, hi = lane >> 5, wid = __builtin_amdgcn_readfirstlane(tid >> 6);
    const int b = pc >> 5, h = (pc >> 3) & 3, s = pc & 7;
    const bf16* qrow = Qb + (size_t)(MP + b * 32 + r32) * 512 + h * 128 + hi * 8;
    LAS float* ML = (LAS float*)lds;
    LAS float* FAC = (LAS float*)(lds + 4096);
    LAS float* OX = (LAS float*)(lds + 8192);
    const bool extra = (s == 7) && (wid == 7);
    const size_t off = ((size_t)((l * 8 + b) * 4096 + (s * 8 + wid) * 64)) * 512 + h * 128;
    const size_t offx = ((size_t)(l * 8 + b) * 32) * 512 + h * 128;
    const float* Kt = cache_k + off; const float* Vt = cache_v + off; const float* Kx = knew + offx; const float* Vx = vnew + offx;
    float mrow[2], lrow[2]; bf16x8 pw[2][6];
#pragma unroll
    for (int c = 0; c < 2; ++c) {
        bf16x8 qf[4];
#pragma unroll
        for (int d0 = 0; d0 < 4; ++d0) qf[d0] = *(const bf16x8*)(qrow + c * 64 + d0 * 16);
        f32x16 sc[3];
#pragma unroll
        for (int kvb = 0; kvb < 3; ++kvb) {
            if (kvb < 2 || extra) {
                f32x16 a;
#pragma unroll
                for (int r = 0; r < 16; ++r) a[r] = 0.f;
                const float* kp = (kvb < 2 ? Kt + (size_t)(kvb * 32 + r32) * 512 : Kx + (size_t)r32 * 512) + c * 64 + hi * 8;
#pragma unroll
                for (int d0 = 0; d0 < 4; ++d0) { const f32x4 x0 = *(const f32x4*)(kp + d0 * 16), x1 = *(const f32x4*)(kp + d0 * 16 + 4); a = mfma32(pack8(x0, x1), qf[d0], a); }
                sc[kvb] = a;
            } else {
#pragma unroll
                for (int r = 0; r < 16; ++r) sc[kvb][r] = -1e30f;
            }
        }
        float mx = -1e30f;
#pragma unroll
        for (int r = 0; r < 16; ++r) mx = fmaxf(mx, fmaxf(fmaxf(sc[0][r], sc[1][r]), sc[2][r]));
        mx = xhalf_max(mx);
        float sum = 0.f;
#pragma unroll
        for (int kvb = 0; kvb < 3; ++kvb)
#pragma unroll
            for (int r = 0; r < 16; ++r) { const float pv = __builtin_amdgcn_exp2f(sc[kvb][r] - mx); sc[kvb][r] = pv; sum += pv; }
        sum = xhalf_sum(sum);
        mrow[c] = mx; lrow[c] = sum;
#pragma unroll
        for (int kvb = 0; kvb < 3; ++kvb)
#pragma unroll
            for (int hf = 0; hf < 2; ++hf) { v4u w; w.x = pk2(sc[kvb][8 * hf + 0], sc[kvb][8 * hf + 1]); w.y = pk2(sc[kvb][8 * hf + 2], sc[kvb][8 * hf + 3]);
                w.z = pk2(sc[kvb][8 * hf + 4], sc[kvb][8 * hf + 5]); w.w = pk2(sc[kvb][8 * hf + 6], sc[kvb][8 * hf + 7]); pw[c][2 * kvb + hf] = __builtin_bit_cast(bf16x8, w); }
    }
    asm volatile("" ::: "memory");
    f32x16 o[2][4];
#pragma unroll
    for (int c = 0; c < 2; ++c)
#pragma unroll
        for (int eb = 0; eb < 4; ++eb)
#pragma unroll
            for (int r = 0; r < 16; ++r) o[c][eb][r] = 0.f;
#pragma unroll
    for (int ks = 0; ks < 6; ++ks) {
        if (ks < 4 || extra) {
#pragma unroll
            for (int eb = 0; eb < 4; ++eb) {
                const float* vp = (ks < 4 ? Vt + (size_t)(ks * 16 + 4 * hi) * 512 : Vx + (size_t)((ks - 4) * 16 + 4 * hi) * 512) + eb * 32 + r32;
                f32x4 x0, x1;
                x0.x = vp[0 * 512]; x0.y = vp[1 * 512]; x0.z = vp[2 * 512]; x0.w = vp[3 * 512];
                x1.x = vp[8 * 512]; x1.y = vp[9 * 512]; x1.z = vp[10 * 512]; x1.w = vp[11 * 512];
                const bf16x8 vf = pack8(x0, x1);
                o[0][eb] = mfma32(pw[0][ks], vf, o[0][eb]); o[1][eb] = mfma32(pw[1][ks], vf, o[1][eb]);
            }
        }
    }
    if (hi == 0) {
#pragma unroll
        for (int c = 0; c < 2; ++c) { ML[((wid * 2 + c) * 32 + r32) * 2 + 0] = mrow[c]; ML[((wid * 2 + c) * 32 + r32) * 2 + 1] = lrow[c]; }
    }
    __syncthreads();
    const int pidx = s;
    if (tid < 64) {
        const int c = tid >> 5, q = tid & 31; float mw[8], lw[8]; float Mx = -1e30f;
#pragma unroll
        for (int w = 0; w < 8; ++w) { mw[w] = ML[((w * 2 + c) * 32 + q) * 2 + 0]; lw[w] = ML[((w * 2 + c) * 32 + q) * 2 + 1]; Mx = fmaxf(Mx, mw[w]); }
        float L = 0.f;
#pragma unroll
        for (int w = 0; w < 8; ++w) { const float fz = __builtin_amdgcn_exp2f(mw[w] - Mx); FAC[(w * 2 + c) * 32 + q] = fz; L += lw[w] * fz; }
        float* mp = MLP + ((size_t)((((b * 4 + h) * 2 + c) * 9 + pidx) * 32 + q)) * 2; mp[0] = Mx; mp[1] = L;
    }
    __syncthreads();
#pragma unroll
    for (int c = 0; c < 2; ++c) {
#pragma unroll
        for (int eb = 0; eb < 4; ++eb)
#pragma unroll
            for (int r = 0; r < 16; ++r) { const int q = crow(r, hi); OX[(wid * 32 + q) * 128 + eb * 32 + r32] = o[c][eb][r] * FAC[(wid * 2 + c) * 32 + q]; }
        __syncthreads();
        { const int idx = tid * 8, q = idx >> 7, e = idx & 127; f32x4 s0 = {0.f, 0.f, 0.f, 0.f}, s1 = {0.f, 0.f, 0.f, 0.f};
#pragma unroll
          for (int w = 0; w < 8; ++w) { s0 += *(const LAS f32x4*)(OX + (w * 32 + q) * 128 + e); s1 += *(const LAS f32x4*)(OX + (w * 32 + q) * 128 + e + 4); }
          float* dst = OPART + ((size_t)((((b * 4 + h) * 2 + c) * 9 + pidx) * 32 + q)) * 128 + e; *(f32x4*)dst = s0; *(f32x4*)(dst + 4) = s1; }
        __syncthreads();
    }
}

template <int W> __device__ __forceinline__ void pool_d(const LAS float* U, LAS bf16* Dd, int ch, int tbeg, int t0, bool smp) {
    float s = 0.f;
#pragma unroll
    for (int i = 0; i < W; ++i) s += U[(15 + tbeg - i) * 256 + ch];
#pragma unroll 8
    for (int k = 0; k < 32; ++k) {
        const int tt = tbeg + k; const float cur = U[(15 + tt) * 256 + ch];
        if (k > 0) s += cur - U[(15 + tt - W) * 256 + ch];
        const int pos = smp ? 4096 + tt : t0 + tt; const int cnt = (pos + 1 < W) ? pos + 1 : W;
        const float d = s * __builtin_amdgcn_rcpf((float)cnt) - cur;
        Dd[tt * 264 + ch] = (bf16)(pk2(d, 0.f) & 0xffffu);
    }
}
__device__ __forceinline__ f32x4 bf4_to_f32(v2u w) { f32x4 v; v.x = bf2f(w.x & 0xffff); v.y = bf2f(w.x >> 16); v.z = bf2f(w.y & 0xffff); v.w = bf2f(w.y >> 16); return v; }
__device__ __forceinline__ void poolconv_tile(LAS unsigned char* lds, int tl, int l, const bf16* Zb, bf16* MIX, const float* state_pool, const float* state_conv, const bf16* pwt, const float* pool_scale,
                                              const float* conv_w, float* out_cp, float* out_cs, int tid) {
    const int lane = tid & 63, r32 = lane & 31, hi = lane >> 5, wid = __builtin_amdgcn_readfirstlane(tid >> 6);
    int b, t0, TT, rowbase; bool smp;
    if (tl < 256) { b = tl >> 5; t0 = (tl & 31) * 64; TT = 64; rowbase = b * 2048 + t0; smp = false; }
    else { b = tl - 256; t0 = 0; TT = 32; rowbase = MP + b * 32; smp = true; }
    LAS float* U = (LAS float*)lds;
    LAS bf16* Dd = (LAS bf16*)(lds + 81920);
    {
        f32x4 uv[10];
#pragma unroll
        for (int k = 0; k < 10; ++k) {
            const int idx = tid + 512 * k, i = idx >> 6, c4 = (idx & 63) * 4; f32x4 v = {0.f, 0.f, 0.f, 0.f};
            if (i < 15 + TT) {
                if (i < 15 && smp) v = *(const f32x4*)(state_pool + (size_t)((l * 8 + b) * 15 + i) * 256 + c4);
                else if (i >= 15 || t0 - 15 + i >= 0) v = bf4_to_f32(*(const v2u*)(Zb + (size_t)(rowbase + i - 15) * 1024 + c4));
            }
            uv[k] = v;
        }
#pragma unroll
        for (int k = 0; k < 10; ++k) { const int idx = tid + 512 * k, i = idx >> 6, c4 = (idx & 63) * 4; if (i < 15 + TT) *(LAS f32x4*)(U + i * 256 + c4) = uv[k]; }
    }
    __syncthreads();
    {
        const int ch = tid & 255, th = tid >> 8, gi = __builtin_amdgcn_readfirstlane(ch >> 6);
        if (th * 32 < TT) {
            if (gi == 0) pool_d<2>(U, Dd, ch, th * 32, t0, smp); else if (gi == 1) pool_d<4>(U, Dd, ch, th * 32, t0, smp);
            else if (gi == 2) pool_d<8>(U, Dd, ch, th * 32, t0, smp); else pool_d<16>(U, Dd, ch, th * 32, t0, smp);
        }
    }
    __syncthreads();
    {
        const int gi = wid >> 1, th = wid & 1;
        if (th * 32 < TT) {
            f32x16 acc0, acc1;
#pragma unroll
            for (int r = 0; r < 16; ++r) { acc0[r] = 0.f; acc1[r] = 0.f; }
#pragma unroll
            for (int ks = 0; ks < 4; ++ks) {
                const bf16x8 a = *(const LAS bf16x8*)(Dd + (th * 32 + r32) * 264 + gi * 64 + ks * 16 + hi * 8);
                const bf16x8 b0 = *(const bf16x8*)(pwt + (size_t)((l * 4 + gi) * 64 + r32) * 64 + ks * 16 + hi * 8);
                const bf16x8 b1 = *(const bf16x8*)(pwt + (size_t)((l * 4 + gi) * 64 + 32 + r32) * 64 + ks * 16 + hi * 8);
                acc0 = mfma32(a, b0, acc0); acc1 = mfma32(a, b1, acc1);
            }
            const float sc0 = pool_scale[l * 256 + gi * 64 + r32], sc1 = pool_scale[l * 256 + gi * 64 + 32 + r32];
#pragma unroll
            for (int r = 0; r < 16; ++r) { const int tok = th * 32 + crow(r, hi); bf16* mp = MIX + (size_t)(rowbase + tok) * 1024 + 512 + gi * 64 + r32;
                mp[0] = (bf16)(pk2(acc0[r] * sc0, 0.f) & 0xffffu); mp[32] = (bf16)(pk2(acc1[r] * sc1, 0.f) & 0xffffu); }
        }
    }
    if (wid * 8 < TT) {
        const int cq = lane, tc = wid * 8;
        v2u hraw[10], graw[10], braw[8]; f32x4 hst[2];
        hst[0] = (f32x4){0.f, 0.f, 0.f, 0.f}; hst[1] = hst[0];
#pragma unroll
        for (int i = 0; i < 10; ++i) {
            const int ts = tc - 2 + i; hraw[i] = (v2u){0u, 0u}; graw[i] = (v2u){0u, 0u};
            if (ts >= 0 || (!smp && t0 + ts >= 0)) { const bf16* zr = Zb + (size_t)(rowbase + ts) * 1024 + 4 * cq; hraw[i] = *(const v2u*)(zr + 256); graw[i] = *(const v2u*)(zr + 768); }
        }
#pragma unroll
        for (int i = 0; i < 8; ++i) braw[i] = *(const v2u*)(Zb + (size_t)(rowbase + tc + i) * 1024 + 512 + 4 * cq);
        if (smp && tc == 0) { hst[0] = *(const f32x4*)(state_conv + (size_t)((l * 8 + b) * 2 + 0) * 256 + 4 * cq); hst[1] = *(const f32x4*)(state_conv + (size_t)((l * 8 + b) * 2 + 1) * 256 + 4 * cq); }
        const f32x4 cw0 = *(const f32x4*)(conv_w + l * 768 + 4 * cq), cw1 = *(const f32x4*)(conv_w + l * 768 + 256 + 4 * cq), cw2 = *(const f32x4*)(conv_w + l * 768 + 512 + 4 * cq);
        f32x4 cm2 = bf4_to_f32(graw[0]) * bf4_to_f32(hraw[0]), cm1 = bf4_to_f32(graw[1]) * bf4_to_f32(hraw[1]);
        if (smp && tc == 0) { cm2 = hst[0]; cm1 = hst[1]; }
#pragma unroll
        for (int i = 0; i < 8; ++i) {
            const int tt = tc + i;
            const f32x4 cv = bf4_to_f32(graw[i + 2]) * bf4_to_f32(hraw[i + 2]);
            const f32x4 y = bf4_to_f32(braw[i]) * (cw0 * cm2 + cw1 * cm1 + cw2 * cv);
            v2u w; w.x = pk2(y.x, y.y); w.y = pk2(y.z, y.w);
            *(v2u*)(MIX + (size_t)(rowbase + tt) * 1024 + 768 + 4 * cq) = w;
            if (smp) { if (tt >= 30) *(f32x4*)(out_cs + (size_t)((l * 8 + b) * 2 + tt - 30) * 256 + 4 * cq) = cv; }
            else if (t0 + tt >= 2046) *(f32x4*)(out_cp + (size_t)((l * 8 + b) * 2 + t0 + tt - 2046) * 256 + 4 * cq) = cv;
            cm2 = cm1; cm1 = cv;
        }
    }
    __syncthreads();
}

__device__ __forceinline__ void combine_phase(int l, const bf16* Ob_, const float* OPART_, const float* MLP_, bf16* MIX_, int gw, int NGW, int lane) {
    const float lam_init = (l == 0) ? 0.2f : 0.35550934f;
    float lam;
    { const float a = KIN(12)[l * 64 + lane] * KIN(13)[l * 64 + lane], c = KIN(14)[l * 64 + lane] * KIN(15)[l * 64 + lane];
      lam = __expf(wave_sum(a)) - __expf(wave_sum(c)) + lam_init; }
    const float g0 = KIN(16)[l * 128 + 2 * lane], g1 = KIN(16)[l * 128 + 2 * lane + 1];
    for (int base = gw * 8; base < MP * 4; base += NGW * 8) {
        float a0[8], a1[8];
        {
            unsigned w1[8], w2[8];
#pragma unroll
            for (int j = 0; j < 8; ++j) { const int wt = base + j, row = wt >> 2, h = wt & 3;
                w1[j] = *(const unsigned*)(Ob_ + (size_t)row * 1024 + h * 128 + 2 * lane); w2[j] = *(const unsigned*)(Ob_ + (size_t)row * 1024 + 512 + h * 128 + 2 * lane); }
#pragma unroll
            for (int j = 0; j < 8; ++j) { a0[j] = bf2f(w1[j] & 0xffff) - lam * bf2f(w2[j] & 0xffff); a1[j] = bf2f(w1[j] >> 16) - lam * bf2f(w2[j] >> 16); }
        }
        float ss[8];
#pragma unroll
        for (int j = 0; j < 8; ++j) ss[j] = a0[j] * a0[j] + a1[j] * a1[j];
#pragma unroll
        for (int j = 0; j < 8; ++j) ss[j] += swz_xor<1>(ss[j]);
#pragma unroll
        for (int j = 0; j < 8; ++j) ss[j] += swz_xor<2>(ss[j]);
#pragma unroll
        for (int j = 0; j < 8; ++j) ss[j] += swz_xor<4>(ss[j]);
#pragma unroll
        for (int j = 0; j < 8; ++j) ss[j] += swz_xor<8>(ss[j]);
#pragma unroll
        for (int j = 0; j < 8; ++j) ss[j] += swz_xor<16>(ss[j]);
#pragma unroll
        for (int j = 0; j < 8; ++j) { const int wt = base + j, row = wt >> 2, h = wt & 3;
            const float tot = xhalf_sum(ss[j]);
            const float r = (1.0f / sqrtf(tot * (1.0f / 128.0f) + EPS)) * (1.0f - lam_init);
            *(unsigned*)(MIX_ + (size_t)row * 1024 + h * 128 + 2 * lane) = pk2(a0[j] * r * g0, a1[j] * r * g1); }
    }
    for (int wt = MP * 4 + gw; wt < M * 4; wt += NGW) {
        const int row = wt >> 2, h = wt & 3, rs = row - MP, b = rs >> 5, q = rs & 31; float oc[2][2];
#pragma unroll
        for (int c = 0; c < 2; ++c) {
            const size_t pb = (size_t)(((b * 4 + h) * 2 + c) * 9);
            float mw[8], lw[8]; f32x2 ov[8]; float Mx = -1e30f;
#pragma unroll
            for (int pi = 0; pi < 8; ++pi) { const f32x2 ml = *(const f32x2*)(MLP_ + ((pb + pi) * 32 + q) * 2); mw[pi] = ml.x; lw[pi] = ml.y; ov[pi] = *(const f32x2*)(OPART_ + ((pb + pi) * 32 + q) * 128 + 2 * lane); }
#pragma unroll
            for (int pi = 0; pi < 8; ++pi) Mx = fmaxf(Mx, mw[pi]);
            float L = 0.f, s0 = 0.f, s1 = 0.f;
#pragma unroll
            for (int pi = 0; pi < 8; ++pi) { const float fz = __builtin_amdgcn_exp2f(mw[pi] - Mx); L += lw[pi] * fz; s0 += ov[pi].x * fz; s1 += ov[pi].y * fz; }
            const float il = 1.0f / L; oc[c][0] = s0 * il; oc[c][1] = s1 * il;
        }
        const float a0 = oc[0][0] - lam * oc[1][0], a1 = oc[0][1] - lam * oc[1][1];
        const float tot = wave_sum(a0 * a0 + a1 * a1);
        const float r = (1.0f / sqrtf(tot * (1.0f / 128.0f) + EPS)) * (1.0f - lam_init);
        *(unsigned*)(MIX_ + (size_t)row * 1024 + h * 128 + 2 * lane) = pk2(a0 * r * g0, a1 * r * g1);
    }
}

#ifndef PROBE_SLOW_ATTN
#define PROBE_SLOW_ATTN 0
#endif
#if PROBE_SLOW_ATTN
__device__ __forceinline__ void slow_attn_phase(int l, const bf16* Qb_, float* outp, const float* cache_k, const float* cache_v, bf16* MIX_, int gw, int NGW, int lane) {
    const float lam_init = (l == 0) ? 0.2f : 0.35550934f;
    float lam;
    { const float a = KIN(12)[l * 64 + lane] * KIN(13)[l * 64 + lane], c = KIN(14)[l * 64 + lane] * KIN(15)[l * 64 + lane];
      lam = __expf(wave_sum(a)) - __expf(wave_sum(c)) + lam_init; }
    const float g0 = KIN(16)[l * 128 + 2 * lane], g1 = KIN(16)[l * 128 + 2 * lane + 1];
    for (int wt = gw; wt < M * 4; wt += NGW) {
        const int row = wt >> 2, h = wt & 3;
        const float *K0, *V0, *K1, *V1; int n0, n1;
        if (row < MP) { const int b = row >> 11, t = row & 2047; K0 = outp + OFF_KP + ((size_t)l * MP + (size_t)b * 2048) * 512 + h * 128; V0 = outp + OFF_VP + ((size_t)l * MP + (size_t)b * 2048) * 512 + h * 128; n0 = ((t >> 6) + 1) * 64; K1 = K0; V1 = V0; n1 = 0; }
        else { const int rs = row - MP, b = rs >> 5; K0 = cache_k + ((size_t)(l * 8 + b) * 4096) * 512 + h * 128; V0 = cache_v + ((size_t)(l * 8 + b) * 4096) * 512 + h * 128; n0 = 4096;
               K1 = outp + OFF_KS + ((size_t)(l * 8 + b) * 32) * 512 + h * 128; V1 = outp + OFF_VS + ((size_t)(l * 8 + b) * 32) * 512 + h * 128; n1 = 32; }
        float oc[2][2];
#pragma unroll 1
        for (int c = 0; c < 2; ++c) {
            float q[64];
#pragma unroll
            for (int d = 0; d < 64; ++d) q[d] = bf2f(Qb_[(size_t)row * 512 + h * 128 + c * 64 + d]);
            float mx = -1e30f;
            for (int seg = 0; seg < 2; ++seg) { const float* Kp = seg ? K1 : K0; const int n = seg ? n1 : n0;
                for (int j0 = 0; j0 < n; j0 += 64) { const int j = j0 + lane; float s = -1e30f;
                    if (j < n) { const float* kr = Kp + (size_t)j * 512 + c * 64; s = 0.f;
#pragma unroll
                        for (int d = 0; d < 64; ++d) s += q[d] * kr[d]; }
                    mx = fmaxf(mx, s); } }
            mx = fmaxf(mx, swz_xor<1>(mx)); mx = fmaxf(mx, swz_xor<2>(mx)); mx = fmaxf(mx, swz_xor<4>(mx)); mx = fmaxf(mx, swz_xor<8>(mx)); mx = fmaxf(mx, swz_xor<16>(mx)); mx = xhalf_max(mx);
            float L = 0.f, o0 = 0.f, o1 = 0.f;
            for (int seg = 0; seg < 2; ++seg) { const float* Kp = seg ? K1 : K0; const float* Vp = seg ? V1 : V0; const int n = seg ? n1 : n0;
                for (int j0 = 0; j0 < n; j0 += 64) { const int j = j0 + lane; float pj = 0.f;
                    if (j < n) { const float* kr = Kp + (size_t)j * 512 + c * 64; float s = 0.f;
#pragma unroll
                        for (int d = 0; d < 64; ++d) s += q[d] * kr[d];
                        pj = __builtin_amdgcn_exp2f(s - mx); }
                    L += pj;
                    const int nn = (n - j0 < 64) ? n - j0 : 64;
                    for (int jj = 0; jj < nn; ++jj) { const float pb = __builtin_bit_cast(float, __builtin_amdgcn_readlane(__builtin_bit_cast(int, pj), jj));
                        const f32x2 vv = *(const f32x2*)(Vp + (size_t)(j0 + jj) * 512 + 2 * lane); o0 += pb * vv.x; o1 += pb * vv.y; } } }
            L = wave_sum(L);
            oc[c][0] = o0 / L; oc[c][1] = o1 / L;
        }
        const float a0 = oc[0][0] - lam * oc[1][0], a1 = oc[0][1] - lam * oc[1][1];
        const float ss = wave_sum(a0 * a0 + a1 * a1);
        const float r = (1.0f / sqrtf(ss * (1.0f / 128.0f) + EPS)) * (1.0f - lam_init);
        *(unsigned*)(MIX_ + (size_t)row * 1024 + h * 128 + 2 * lane) = pk2(a0 * r * g0, a1 * r * g1);
    }
}
#endif

#ifndef PROBE_SLOW_PC
#define PROBE_SLOW_PC 0
#endif
#if PROBE_SLOW_PC
__device__ __forceinline__ float zval(const bf16* Zb_, const float* st, int l, int b, bool smp, int rowbase, int t, int col, int hist) {
    if (t >= 0) return bf2f(Zb_[(size_t)(rowbase + t) * 1024 + col]);
    if (!smp) return 0.f;
    return st[(size_t)((l * 8 + b) * hist + (hist + t)) * 256 + (col & 255)];
}
__device__ __forceinline__ void slow_pc_phase(int l, const bf16* Zb_, bf16* MIX_, int gw, int NGW, int lane) {
    const float* sp = KIN(4); const float* scv = KIN(5); const float* pw = KIN(17); const float* psc = KIN(18); const float* cw = KIN(19);
    for (int wt = gw; wt < M * 4; wt += NGW) {
        const int row = wt >> 2, g = wt & 3; const bool smp = row >= MP;
        int b, t, rowbase; if (smp) { const int rs = row - MP; b = rs >> 5; t = rs & 31; rowbase = MP + b * 32; } else { b = row >> 11; t = row & 2047; rowbase = b * 2048; }
        const int w = 2 << g, ch = g * 64 + lane;
        float s = 0.f;
        for (int i = 0; i < w; ++i) { const int tt = t - i; s += zval(Zb_, sp, l, b, smp, rowbase, tt, ch, 15); }
        const int pos = smp ? 4096 + t : t; const int cnt = (pos + 1 < w) ? pos + 1 : w;
        const float d = s / (float)cnt - zval(Zb_, sp, l, b, smp, rowbase, t, ch, 15);
        float mine = 0.f;
        for (int e = 0; e < 64; ++e) { const float v = wave_sum(d * pw[(size_t)((l * 4 + g) * 64 + lane) * 64 + e]); if (e == lane) mine = v; }
        MIX_[(size_t)row * 1024 + 512 + ch] = (bf16)(pk2(mine * psc[l * 256 + ch], 0.f) & 0xffffu);
        float cvv[3];
#pragma unroll
        for (int k = 0; k < 3; ++k) { const int tt = t - 2 + k;
            if (tt >= 0) cvv[k] = bf2f(Zb_[(size_t)(rowbase + tt) * 1024 + 768 + ch]) * bf2f(Zb_[(size_t)(rowbase + tt) * 1024 + 256 + ch]);
            else cvv[k] = smp ? scv[(size_t)((l * 8 + b) * 2 + (2 + tt)) * 256 + ch] : 0.f; }
        const float bgv = bf2f(Zb_[(size_t)row * 1024 + 512 + ch]);
        const float y = bgv * (cw[l * 768 + ch] * cvv[0] + cw[l * 768 + 256 + ch] * cvv[1] + cw[l * 768 + 512 + ch] * cvv[2]);
        MIX_[(size_t)row * 1024 + 768 + ch] = (bf16)(pk2(y, 0.f) & 0xffffu);
    }
}
#endif

#define XB_TMO      128
#define XB_XCNT(j)  (256  + 64 * (j))
#define XB_XSUB(j)  (1280 + 64 * (j))
#define XB_XGEN(j)  (2304 + 64 * (j))
#define XB_TOP      3328
#define XB_TOPGEN   3392
#define XCD_BAR_WORDS 3456
#define XB_SPIN_CAP (1u << 18)
__device__ __forceinline__ unsigned xb_ld(unsigned* p)              { return __hip_atomic_load(p, __ATOMIC_RELAXED, __HIP_MEMORY_SCOPE_AGENT); }
__device__ __forceinline__ unsigned xb_add(unsigned* p, unsigned v) { return __hip_atomic_fetch_add(p, v, __ATOMIC_RELAXED, __HIP_MEMORY_SCOPE_AGENT); }
__device__ __forceinline__ unsigned xb_xcc_id() { return (unsigned)__builtin_amdgcn_s_getreg((3 << 11) | 20) & 0xFu; }
#define XB_SPIN(cond, bar) do { unsigned _sp = 0; while (cond) { __builtin_amdgcn_s_sleep(1); \
    if ((++_sp & 255u) == 0u) { if (xb_ld(&(bar)[XB_TMO])) break; if (_sp > XB_SPIN_CAP) { atomicAdd(&(bar)[XB_TMO], 1u); break; } } } } while (0)
__device__ __forceinline__ void xcd_barrier_complete(unsigned* bar, unsigned x, unsigned& nloc, unsigned& nx) {
    const unsigned G = gridDim.x * gridDim.y * gridDim.z;
    unsigned sum, cnt, mine, sp = 0u;
    for (;;) {
        sum = 0u; cnt = 0u; mine = 0u;
#pragma unroll
        for (unsigned j = 0; j < 16; ++j) { const unsigned c = xb_ld(&bar[XB_XCNT(j)]); sum += c; cnt += (c > 0u) ? 1u : 0u; mine = (j == x) ? c : mine; }
        if (sum == G) break;
        __builtin_amdgcn_s_sleep(1);
        if ((++sp & 255u) == 0u) { if (xb_ld(&bar[XB_TMO])) break; if (sp > XB_SPIN_CAP) { atomicAdd(&bar[XB_TMO], 1u); break; } }
    }
    nloc = mine > 0u ? mine : 1u; nx = cnt > 0u ? cnt : 1u;
}
__device__ __forceinline__ void xcd_barrier(unsigned* bar, unsigned x, volatile LAS unsigned* st) {
    asm volatile("s_waitcnt vmcnt(0)" ::: "memory");
    __syncthreads();
    if (threadIdx.x == 0) {
        __builtin_amdgcn_s_waitcnt(0);
        unsigned nloc = st[0], nx = st[1];
        if (nloc == 0u) { xcd_barrier_complete(bar, x, nloc, nx); st[0] = nloc; st[1] = nx; }
        const unsigned old = xb_add(&bar[XB_XSUB(x)], 1u);
        const unsigned gen = old / nloc;
        if (old + 1u == (gen + 1u) * nloc) {
            __builtin_amdgcn_fence(__ATOMIC_RELEASE, "agent");
            asm volatile("s_waitcnt vmcnt(0)" ::: "memory");
            const unsigned og = xb_add(&bar[XB_TOP], 1u);
            const unsigned tg = og / nx;
            if (og + 1u == (tg + 1u) * nx) xb_add(&bar[XB_TOPGEN], 1u);
            else XB_SPIN(xb_ld(&bar[XB_TOPGEN]) == tg, bar);
            __builtin_amdgcn_fence(__ATOMIC_ACQUIRE, "agent");
            xb_add(&bar[XB_XGEN(x)], 1u);
            asm volatile("s_waitcnt vmcnt(0)" ::: "memory");
        } else {
            XB_SPIN(xb_ld(&bar[XB_XGEN(x)]) == gen, bar);
            __builtin_amdgcn_fence(__ATOMIC_ACQUIRE, "agent");
            asm volatile("s_waitcnt vmcnt(0)" ::: "memory");
        }
    }
    __syncthreads();
}
#define CG_SYNC() do { asm volatile("s_waitcnt vmcnt(0) lgkmcnt(0)" ::: "memory"); grid.sync(); asm volatile("" ::: "memory"); } while (0)
#define GRID_SYNC() xcd_barrier((unsigned*)KWS() + 4096, xcc, (volatile LAS unsigned*)(lds + LDS_BYTES - 64))
__global__ void __launch_bounds__(NWAVES * 64, 2) mega_fwd(Params p) {
    extern __shared__ __attribute__((aligned(16))) unsigned char lds_raw[];
    LAS unsigned char* lds = (LAS unsigned char*)lds_raw;
    cg::grid_group grid = cg::this_grid();
    const int tid = threadIdx.x, lane = tid & 63, wave = __builtin_amdgcn_readfirstlane(tid >> 6);
    const int G = gridDim.x; const int bx = blockIdx.x; const int vcu0 = (G % 8 == 0) ? (bx % 8) * (G / 8) + bx / 8 : bx;
    const int NGW = G * NWAVES;
#define X ((bf16*)(ws + WS_X))
#define H ((bf16*)(ws + WS_H))
#define MIX ((bf16*)(ws + WS_MIX))
#define ACT ((bf16*)(ws + WS_ACT))
#define Qb ((bf16*)(ws + WS_QB))
#define Kb ((bf16*)(ws + WS_KB))
#define Vb ((bf16*)(ws + WS_VB))
#define Zb ((bf16*)(ws + WS_ZB))
#define Ob ((bf16*)(ws + WS_OB))
#define OPART ((float*)(ws + WS_OPART))
#define MLP ((float*)(ws + WS_ML))
#define pwt ((const bf16*)(ws + WS_POOLWT))
    if (tid < 16) ((LAS unsigned*)(lds + LDS_BYTES - 64))[tid] = 0u;
    const unsigned xcc = xb_xcc_id();
    if (tid == 0) (void)xb_add((unsigned*)KWS() + 4096 + XB_XCNT(xcc), 1u);
    __syncthreads();
    { const int gw = vcu0 * NWAVES + wave; prologue(lds, gw, NGW, wave, lane);
      norm_rows<false>(KIN(0), KIN(1), KIN(6), (bf16*)(KWS() + WS_H), nullptr, gw, NGW, lane); }
    CG_SYNC();
#define FRESH_IDS() int tid = threadIdx.x; asm volatile("" : "+v"(tid)); const int lane = tid & 63, wave = __builtin_amdgcn_readfirstlane(tid >> 6); int vcu = vcu0; asm volatile("" : "+s"(vcu)); const int gw = vcu * NWAVES + wave; (void)lane; (void)gw; (void)wave
#define CNT(nid, idx) ((unsigned*)(ws + CTL_CNT) + (size_t)((nid) * 80 + (idx)) * 64)
#pragma unroll 1
    for (int step = 0; step < 4; ++step) {
        const int l = step >> 1, f = step & 1;
        const bool first = (step == 0);
        { FRESH_IDS(); unsigned char* const ws = KWS(); unsigned char* const wl = ws + WS_W + (size_t)l * WL;
          pg8::Gemm g{H, (const bf16*)(wl + (f ? W_GU2 : W_GU1)), M, 2 * FF, D}; pg8::StaticOrder S; S.init(M, 2 * FF, G, bx);
          pg8::EpiSwiGLU E{ACT, FF};
          pg8::gemm_phase<pg8::EpiSwiGLU, pg8::StaticOrder, true, true>(lds, g, S, E); }
        GRID_SYNC();
        { FRESH_IDS(); unsigned char* const ws = KWS(); unsigned char* const wl = ws + WS_W + (size_t)l * WL;
          const bool last = (step == 3);
          const float* const gn = last ? KIN(25) : (f ? KIN(6) + (l + 1) * D : KIN(10) + l * D);
          const int nid = step * 2;
          float* const yo = KOUT() + OFF_Y;
          pg8::Gemm g{ACT, (const bf16*)(wl + (f ? W_D2 : W_D1)), MP, D, FF}; pg8::StaticOrder S; S.init(MP, D, G, bx);
          { pg8::Unit u0; const int pm0 = S.next(0, u0) ? u0.pm : 0;
            if (first) { pg8::EpiResidNorm<false> E{KIN(0), X, 0.5f, H, yo, gn, (unsigned*)(ws + WS_SLOTP), CNT(nid, pm0)};
                         pg8::gemm_phase<pg8::EpiResidNorm<false>, pg8::StaticOrder, false, true>(lds, g, S, E); }
            else { pg8::EpiResidNorm<true> E{X, last ? nullptr : X, 0.5f, last ? nullptr : H, yo, gn, (unsigned*)(ws + WS_SLOTP), CNT(nid, pm0)};
                   pg8::gemm_phase<pg8::EpiResidNorm<true>, pg8::StaticOrder, false, true>(lds, g, S, E); } }
          if (first) skinny_gemm<false, FF>(lds, ACT + (size_t)MP * FF, (const bf16*)(wl + W_D1), KIN(1), X + (size_t)MP * D, 0.5f, H + (size_t)MP * D, yo + (size_t)MP * D, gn, (unsigned*)(ws + WS_SLOTS), CNT(nid, 64), vcu, G, tid);
          else skinny_gemm<true, FF>(lds, ACT + (size_t)MP * FF, (const bf16*)(wl + (f ? W_D2 : W_D1)), X + (size_t)MP * D, last ? nullptr : X + (size_t)MP * D, 0.5f,
                      last ? nullptr : H + (size_t)MP * D, yo + (size_t)MP * D, gn, (unsigned*)(ws + WS_SLOTS), CNT(nid, 64), vcu, G, tid); }
        if (step == 3) break;
        GRID_SYNC();
        if (f == 0) {
            { FRESH_IDS(); unsigned char* const ws = KWS(); unsigned char* const wl = ws + WS_W + (size_t)l * WL;
              pg8::Gemm g{H, (const bf16*)(wl + W_IN), M, DIN, D}; pg8::StaticOrder S; S.init(M, DIN, G, bx);
              pg8::EpiWin E{ws, KOUT(), l, C2};
              pg8::gemm_phase<pg8::EpiWin, pg8::StaticOrder, true, true>(lds, g, S, E); }
            GRID_SYNC();
#pragma unroll 1
            for (int slot = 0; slot < 2; ++slot) {
              if (((slot ^ vcu0) & 1) == 0) {
                FRESH_IDS(); unsigned char* const ws = KWS();
                for (int i = 0; i < 4; ++i) {
                  const int L = i * G + vcu; if (L >= 1024) break;
                  const int bh = (L & 255) >> 1, sI = L & 1, ii = L >> 8;
                  const int qb = sI == 0 ? (ii == 0 ? 7 : ii == 1 ? 0 : ii == 2 ? 4 : 3) : (ii == 0 ? 6 : ii == 1 ? 1 : ii == 2 ? 5 : 2);
                  const int b = bh >> 4, vh = bh & 15, hh = vh >> 2, c = (vh >> 1) & 1, hf = vh & 1;
                  attn_body::attn_unit<8>(b, qb, (const attn_body::bf16*)(Qb + (hh * 2 + c) * 64), (const attn_body::bf16*)(Kb + (hh * 2 + c) * 64), (const attn_body::bf16*)(Vb + hh * 128 + hf * 64),
                                          (attn_body::bf16*)(Ob + c * 512 + hh * 128 + hf * 64), (char*)lds_raw);
                }
              } else {
                FRESH_IDS(); unsigned char* const ws = KWS(); float* const outp = KOUT();
                for (int pc = vcu; pc < 256; pc += G)
                  sample_piece(lds, pc, l, Qb, KIN(2), KIN(3), outp + OFF_KS, outp + OFF_VS, OPART, MLP, tid);
              }
              __syncthreads();
            }
            { FRESH_IDS(); unsigned char* const ws = KWS(); float* const outp = KOUT();
              for (int tl = vcu; tl < 264; tl += G)
                poolconv_tile(lds, tl, l, Zb, MIX, KIN(4), KIN(5), pwt, KIN(18), KIN(19), outp + OFF_CP, outp + OFF_CS, tid); }
            GRID_SYNC();
            { FRESH_IDS(); unsigned char* const ws = KWS();
              combine_phase(l, Ob, OPART, MLP, MIX, gw, NGW, lane); }
            GRID_SYNC();
            { FRESH_IDS(); unsigned char* const ws = KWS(); unsigned char* const wl = ws + WS_W + (size_t)l * WL;
              const float* const gn = KIN(21) + l * D; const int nid = step * 2 + 1;
              pg8::Gemm g{MIX, (const bf16*)(wl + W_OUT), MP, D, D}; pg8::StaticOrder S; S.init(MP, D, G, bx);
              { pg8::Unit u0; const int pm0 = S.next(0, u0) ? u0.pm : 0;
                pg8::EpiResidNorm<true> E{X, X, 1.0f, H, nullptr, gn, (unsigned*)(ws + WS_SLOTP), CNT(nid, pm0)};
                pg8::gemm_phase<pg8::EpiResidNorm<true>, pg8::StaticOrder, false, true>(lds, g, S, E); }
              skinny_gemm<true, D>(lds, MIX + (size_t)MP * D, (const bf16*)(wl + W_OUT), X + (size_t)MP * D, X + (size_t)MP * D, 1.0f, H + (size_t)MP * D, nullptr, gn,
                          (unsigned*)(ws + WS_SLOTS), CNT(nid, 64), vcu, G, tid); }
            GRID_SYNC();
        }
    }
}

extern "C" void kernel_launch(void* const* d_in, const int* in_sizes, int n_in, void* d_out, int out_size, void* d_ws, size_t ws_size, hipStream_t stream) {
    static int grid = 0;
    if (grid == 0) {
        if (n_in != 26 || (size_t)out_size != OUT_TOTAL || ws_size < WS_END) { fprintf(stderr, "kernel_launch: unexpected problem shape: n_in %d out %d ws %zu\n", n_in, out_size, ws_size); grid = -1; return; }
        int dev = 0, cus = 0, per_cu = 0;
        if (hipGetDevice(&dev) != hipSuccess || hipDeviceGetAttribute(&cus, hipDeviceAttributeMultiprocessorCount, dev) != hipSuccess) { grid = -1; return; }
        if (hipFuncSetAttribute((const void*)mega_fwd, hipFuncAttributeMaxDynamicSharedMemorySize, LDS_BYTES) != hipSuccess) { fprintf(stderr, "kernel_launch: hipFuncSetAttribute failed\n"); grid = -1; return; }
        if (hipOccupancyMaxActiveBlocksPerMultiprocessor(&per_cu, (const void*)mega_fwd, NWAVES * 64, LDS_BYTES) != hipSuccess || per_cu < 1) { fprintf(stderr, "kernel_launch: occupancy query says %d\n", per_cu); per_cu = 1; }
        (void)hipGetLastError();
        grid = cus * per_cu;
    }
    if (grid < 0) return;
    if (hipMemsetAsync(d_ws, 0, CTL_BYTES, stream) != hipSuccess) { fprintf(stderr, "kernel_launch: memset failed\n"); return; }
    Params p{};
    for (int i = 0; i < 26; ++i) p.in[i] = (const float*)d_in[i];
    p.out = (float*)d_out; p.ws = (unsigned char*)d_ws;
    void* args[] = {&p};
    const hipError_t e = hipLaunchCooperativeKernel((const void*)mega_fwd, dim3(grid), dim3(NWAVES * 64), args, LDS_BYTES, stream);
    if (e != hipSuccess) fprintf(stderr, "kernel_launch: cooperative launch failed: %s (grid %d)\n", hipGetErrorString(e), grid);
}
```

```cpp
#include <hip/hip_runtime.h>
#include <hip/hip_cooperative_groups.h>
#include <cstdio>
#include <cstdint>
namespace pg8 {
#define PG8_LAS __attribute__((address_space(3)))
typedef unsigned short bf16_t;
typedef short bf16x8 __attribute__((ext_vector_type(8)));
typedef float f32x4 __attribute__((ext_vector_type(4)));
typedef unsigned u32x4 __attribute__((ext_vector_type(4)));
constexpr int BM = 256, BK = 64, HALF = 128, HTB = HALF * BK * 2  , STAGE_BYTES = 8 * HTB, NXCD = 8, WGM = 8;

__host__ __device__ __forceinline__ int lds_byte(int r, int c) { const int st = (r >> 4) * 2 + (c >> 5), rr = r & 15, cc = c & 31, ob = rr * 64 + cc * 2; return st * 1024 + (ob ^ (((ob >> 9) & 1) << 5)); }
__host__ __device__ __forceinline__ void stage_rc(int b, int& R, int& C) { const int st = b / 1024, sb = b % 1024, swz = sb ^ (((sb >> 9) & 1) << 5); R = (st >> 1) * 16 + swz / 64; C = (st & 1) * 32 + (swz % 64) / 2; }
__host__ __device__ __forceinline__ int perm32(int rho) { const int n = rho >> 4, i = rho & 15; return 8 * (i >> 2) + 4 * n + (i & 3); }

struct Unit { int pm, pn; };
struct Gemm { const bf16_t* A; const bf16_t* Bt; int M, N, K; };

struct StaticOrder {
    int nM, nN, nwg, G, c;
    __host__ __device__ __forceinline__ void init(int M, int N, int G_, int c_) { nM = M / BM; nN = N / BM; nwg = nM * nN; G = G_; c = c_; }
    __host__ __device__ __forceinline__ bool next(int i, Unit& u) const {
        const long L = (long)i * G + c; if (L >= nwg) return false;
        int wgid = (int)L; { const int q = nwg / NXCD, r = nwg % NXCD, xcd = wgid % NXCD, off = wgid / NXCD; wgid = (xcd < r ? xcd * (q + 1) : r * (q + 1) + (xcd - r) * q) + off; }
        const int nig = WGM * nN, gid = wgid / nig, fm = gid * WGM, gsz = (nM - fm) < WGM ? (nM - fm) : WGM;
        u.pm = fm + ((wgid % nig) % gsz); u.pn = (wgid % nig) / gsz; return true;
    }
    __device__ __forceinline__ void a_ready(const Unit&) const {}
    __device__ __forceinline__ void done(const Unit&) const {}
};

__device__ __forceinline__ unsigned cvt_pk_bf16(float lo, float hi) { unsigned r; asm volatile("v_cvt_pk_bf16_f32 %0, %1, %2" : "=v"(r) : "v"(lo), "v"(hi)); return r; }
typedef float f32x2 __attribute__((ext_vector_type(2)));
typedef unsigned u32x2 __attribute__((ext_vector_type(2)));
constexpr size_t WOFF_ROPE = (size_t)1 << 20, WOFF_QB = (size_t)215 << 20, WOFF_KB = (size_t)232 << 20, WOFF_VB = (size_t)249 << 20, WOFF_ZB = (size_t)266 << 20;
constexpr size_t OOFF_KP = 17039360, OOFF_VP = 33816576, OOFF_PP = 50593792, OOFF_KS = 50663424, OOFF_VS = 50925568, OOFF_PS = 51187712;
__device__ __forceinline__ float silu_mul(float g, float u) { const float e = __builtin_amdgcn_exp2f(-1.4426950408889634f * g); return g * u * __builtin_amdgcn_rcpf(1.0f + e); }
struct EpiSwiGLU {
    static constexpr bool PERM = true, AFTER_DRAIN = false;
    bf16_t* O; int ldc;
    __device__ __forceinline__ void operator()(const f32x4 (&acc)[2][2][4][2], const Unit& u, int wr, int wc, int fr, int fq) const {
        const int row0 = u.pm * BM + wr * 64 + fr; const int col0 = u.pn * 128 + wc * 32 + 8 * fq;
#pragma unroll
        for (int ai = 0; ai < 2; ++ai)
#pragma unroll
            for (int m = 0; m < 4; ++m) {
                bf16_t* p = O + (size_t)(row0 + ai * HALF + m * 16) * ldc + col0;
                const f32x4 g0 = acc[ai][0][m][0], g1 = acc[ai][0][m][1], u0 = acc[ai][1][m][0], u1 = acc[ai][1][m][1];
                u32x4 w;
                w.x = cvt_pk_bf16(silu_mul(g0[0], u0[0]), silu_mul(g0[1], u0[1])); w.y = cvt_pk_bf16(silu_mul(g0[2], u0[2]), silu_mul(g0[3], u0[3]));
                w.z = cvt_pk_bf16(silu_mul(g1[0], u1[0]), silu_mul(g1[1], u1[1])); w.w = cvt_pk_bf16(silu_mul(g1[2], u1[2]), silu_mul(g1[3], u1[3]));
                *(u32x4*)p = w;
                asm volatile("" ::: "memory");
            }
    }
};
struct EpiResid {
    static constexpr bool PERM = false, AFTER_DRAIN = false;
    const float* baseP; const float* baseS; float* out; float scale;
    __device__ __forceinline__ void operator()(const f32x4 (&acc)[2][2][4][2], const Unit& u, int wr, int wc, int fr, int fq) const {
        const int col0 = u.pn * BM + wc * 32 + 4 * fq;
#pragma unroll
        for (int ai = 0; ai < 2; ++ai)
#pragma unroll
            for (int m = 0; m < 4; ++m) {
                const int row = u.pm * BM + ai * HALF + wr * 64 + m * 16 + fr;
                const float* bp = (row < 16384) ? baseP + (size_t)row * 1024 : baseS + (size_t)(row - 16384) * 1024;
                float* op = out + (size_t)row * 1024;
#pragma unroll
                for (int bj = 0; bj < 2; ++bj)
#pragma unroll
                    for (int n = 0; n < 2; ++n) { const int c = col0 + bj * HALF + n * 16; const f32x4 b = *(const f32x4*)(bp + c); *(f32x4*)(op + c) = b + acc[ai][bj][m][n] * scale; }
                asm volatile("" ::: "memory");
            }
    }
};
constexpr float RMS_EPS = 1e-6f;
__device__ __forceinline__ float rstd_of(float ss) { return 1.0f / sqrtf(ss * (1.0f / 1024.0f) + RMS_EPS); }

#define PG8_RLX_AGENT __ATOMIC_RELAXED, __HIP_MEMORY_SCOPE_AGENT
template <bool BASE16> struct EpiResidNorm {
    static constexpr bool PERM = false, AFTER_DRAIN = true;
    const void* baseP; bf16_t* out; float scale; bf16_t* hb; float* yout; const float* gain; unsigned* slots; unsigned* cnt;
    __device__ __forceinline__ void fused(f32x4 (&acc)[2][2][4][2], const Unit& u, int wr, int wc, int fr, int fq, PG8_LAS unsigned char* lds, int wid, int lane) const {
        PG8_LAS float* P = (PG8_LAS float*)lds;
        PG8_LAS float* S = (PG8_LAS float*)(lds + 4096);
        const int col0 = u.pn * BM + wc * 32 + 4 * fq;
        if (BASE16) {
            u32x2 braw[2][4][2][2];
#pragma unroll
            for (int ai = 0; ai < 2; ++ai)
#pragma unroll
                for (int m = 0; m < 4; ++m) { const size_t ro = (size_t)(u.pm * BM + ai * HALF + wr * 64 + m * 16 + fr) * 1024;
#pragma unroll
                    for (int bj = 0; bj < 2; ++bj)
#pragma unroll
                        for (int n = 0; n < 2; ++n) braw[ai][m][bj][n] = *(const u32x2*)((const bf16_t*)baseP + ro + col0 + bj * HALF + n * 16); }
#pragma unroll
            for (int ai = 0; ai < 2; ++ai)
#pragma unroll
                for (int m = 0; m < 4; ++m)
#pragma unroll
                    for (int bj = 0; bj < 2; ++bj)
#pragma unroll
                        for (int n = 0; n < 2; ++n) { const u32x2 bw = braw[ai][m][bj][n]; f32x4 bv; bv[0] = __builtin_bit_cast(float, bw.x << 16); bv[1] = __builtin_bit_cast(float, bw.x & 0xffff0000u); bv[2] = __builtin_bit_cast(float, bw.y << 16); bv[3] = __builtin_bit_cast(float, bw.y & 0xffff0000u);
                            acc[ai][bj][m][n] = bv + acc[ai][bj][m][n] * scale; }
        }
#pragma unroll
        for (int ai = 0; ai < 2; ++ai)
#pragma unroll
            for (int m = 0; m < 4; ++m) {
                const int rl = ai * HALF + wr * 64 + m * 16 + fr; const size_t ro = (size_t)(u.pm * BM + rl) * 1024;
                float ss = 0.f;
#pragma unroll
                for (int bj = 0; bj < 2; ++bj)
#pragma unroll
                    for (int n = 0; n < 2; ++n) { const int c = col0 + bj * HALF + n * 16; f32x4 v;
                        if (BASE16) v = acc[ai][bj][m][n];
                        else { v = *(const f32x4*)((const float*)baseP + ro + c) + acc[ai][bj][m][n] * scale; acc[ai][bj][m][n] = v; }
                        if (out) { u32x2 w; w.x = cvt_pk_bf16(v[0], v[1]); w.y = cvt_pk_bf16(v[2], v[3]); *(u32x2*)(out + ro + c) = w; }
                        ss += (v[0] * v[0] + v[1] * v[1]) + (v[2] * v[2] + v[3] * v[3]); }
                ss += __builtin_bit_cast(float, __builtin_amdgcn_ds_swizzle(__builtin_bit_cast(int, ss), (16 << 10) | 0x1f));
                { float a = ss, b2 = ss; asm volatile("s_nop 1\n\tv_permlane32_swap_b32 %0, %1\n\ts_nop 1" : "+v"(a), "+v"(b2)); ss = a + b2; }
                if (fq == 0) P[rl * 4 + wc] = ss;
                if (!BASE16 && (m & 1)) asm volatile("" ::: "memory");
            }
        asm volatile("s_waitcnt lgkmcnt(0)\n\ts_barrier" ::: "memory");
        const int t = wid * 64 + lane;
        if (t < 256) { const float s = (P[t * 4] + P[t * 4 + 1]) + (P[t * 4 + 2] + P[t * 4 + 3]);
            __hip_atomic_store(slots + (size_t)(u.pm * BM + t) * 4 + u.pn, __builtin_bit_cast(unsigned, s), PG8_RLX_AGENT); }
        asm volatile("s_waitcnt vmcnt(0)" ::: "memory");
        if (wid < 4 && lane == 0) __hip_atomic_fetch_add(cnt, 1u, PG8_RLX_AGENT);
        if (wid == 0) {
            unsigned spins = 0;
            while ((unsigned)__builtin_amdgcn_readfirstlane(__hip_atomic_load(cnt, PG8_RLX_AGENT)) < 16u) { __builtin_amdgcn_s_sleep(2); if (++spins > (1u << 22)) break; }
            __builtin_amdgcn_fence(__ATOMIC_ACQUIRE, "agent");
        }
        asm volatile("s_waitcnt vmcnt(0) lgkmcnt(0)\n\ts_barrier" ::: "memory");
        if (t < 256) { const unsigned* sl = slots + (size_t)(u.pm * BM + t) * 4; float tot = 0.f;
#pragma unroll
            for (int k = 0; k < 4; ++k) tot += __builtin_bit_cast(float, __hip_atomic_load(sl + k, PG8_RLX_AGENT));
            S[t] = rstd_of(tot); }
        asm volatile("s_waitcnt lgkmcnt(0)\n\ts_barrier" ::: "memory");
        f32x4 g4[2][2];
#pragma unroll
        for (int bj = 0; bj < 2; ++bj)
#pragma unroll
            for (int n = 0; n < 2; ++n) g4[bj][n] = *(const f32x4*)(gain + col0 + bj * HALF + n * 16);
#pragma unroll
        for (int ai = 0; ai < 2; ++ai)
#pragma unroll
            for (int m = 0; m < 4; ++m) {
                const int rl = ai * HALF + wr * 64 + m * 16 + fr; const size_t ro = (size_t)(u.pm * BM + rl) * 1024; const float r = S[rl];
#pragma unroll
                for (int bj = 0; bj < 2; ++bj)
#pragma unroll
                    for (int n = 0; n < 2; ++n) { const int c = col0 + bj * HALF + n * 16; const f32x4 y = acc[ai][bj][m][n] * r * g4[bj][n];
                        if (hb) { u32x2 w; w.x = cvt_pk_bf16(y[0], y[1]); w.y = cvt_pk_bf16(y[2], y[3]); *(u32x2*)(hb + ro + c) = w; }
                        else *(f32x4*)(yout + ro + c) = y; }
            }
        asm volatile("s_waitcnt lgkmcnt(0)\n\ts_barrier" ::: "memory");
    }
};

struct EpiWin {
    static constexpr bool PERM = false, AFTER_DRAIN = false;
    unsigned char* ws; float* outp; int l; float qscale;
    __device__ __forceinline__ void operator()(const f32x4 (&acc)[2][2][4][2], const Unit& u, int wr, int wc, int fr, int fq) const {
        const int pn = u.pn;
        bf16_t* const Qb = (bf16_t*)(ws + WOFF_QB); bf16_t* const Kb = (bf16_t*)(ws + WOFF_KB); bf16_t* const Vb = (bf16_t*)(ws + WOFF_VB); bf16_t* const Zb = (bf16_t*)(ws + WOFF_ZB);
        const float* const rope = (const float*)(ws + WOFF_ROPE);
        float* const kP = outp + OOFF_KP + (size_t)l * 16384 * 512; float* const vP = outp + OOFF_VP + (size_t)l * 16384 * 512;
        float* const kS = outp + OOFF_KS + (size_t)l * 256 * 512; float* const vS = outp + OOFF_VS + (size_t)l * 256 * 512;
        float* const poolP = outp + OOFF_PP + (size_t)l * 8 * 15 * 256; float* const poolS = outp + OOFF_PS + (size_t)l * 8 * 15 * 256;
#pragma unroll
        for (int ai = 0; ai < 2; ++ai)
#pragma unroll
            for (int m = 0; m < 4; ++m) {
                const int row = u.pm * BM + ai * HALF + wr * 64 + m * 16 + fr;
                const bool smp = row >= 16384; const int rs = row - 16384;
                const int prow = smp ? 2048 + (rs & 31) : (row & 2047);
#pragma unroll
                for (int bj = 0; bj < 2; ++bj) {
                    const int dlo = 16 * (wc & 1) + 4 * fq, lc0 = 64 * (2 * bj + (wc >> 1)) + dlo;
                    const f32x4 a0 = acc[ai][bj][m][0], a1 = acc[ai][bj][m][1];
                    if (pn < 4) {
                        const f32x4 cs = *(const f32x4*)(rope + (size_t)prow * 64 + dlo), sn = *(const f32x4*)(rope + (size_t)prow * 64 + 32 + dlo);
                        const f32x4 r0 = a0 * cs - a1 * sn, r1 = a1 * cs + a0 * sn;
                        if (pn < 2) {
                            const int col = 256 * pn + lc0; bf16_t* q = Qb + (size_t)row * 512 + col;
                            u32x2 w0, w1; w0.x = cvt_pk_bf16(r0[0] * qscale, r0[1] * qscale); w0.y = cvt_pk_bf16(r0[2] * qscale, r0[3] * qscale);
                            w1.x = cvt_pk_bf16(r1[0] * qscale, r1[1] * qscale); w1.y = cvt_pk_bf16(r1[2] * qscale, r1[3] * qscale);
                            *(u32x2*)q = w0; *(u32x2*)(q + 32) = w1;
                        } else {
                            const int col = 256 * (pn - 2) + lc0; bf16_t* k = Kb + (size_t)row * 512 + col;
                            float* ko = smp ? kS + (size_t)rs * 512 + col : kP + (size_t)row * 512 + col;
                            *(f32x4*)ko = r0; *(f32x4*)(ko + 32) = r1;
                            u32x2 w0, w1; w0.x = cvt_pk_bf16(r0[0], r0[1]); w0.y = cvt_pk_bf16(r0[2], r0[3]); w1.x = cvt_pk_bf16(r1[0], r1[1]); w1.y = cvt_pk_bf16(r1[2], r1[3]);
                            *(u32x2*)k = w0; *(u32x2*)(k + 32) = w1;
                        }
                    } else if (pn < 6) {
                        const int col = 256 * (pn - 4) + lc0; bf16_t* v = Vb + (size_t)row * 512 + col;
                        float* vo = smp ? vS + (size_t)rs * 512 + col : vP + (size_t)row * 512 + col;
                        *(f32x4*)vo = a0; *(f32x4*)(vo + 32) = a1;
                        u32x2 w0, w1; w0.x = cvt_pk_bf16(a0[0], a0[1]); w0.y = cvt_pk_bf16(a0[2], a0[3]); w1.x = cvt_pk_bf16(a1[0], a1[1]); w1.y = cvt_pk_bf16(a1[2], a1[3]);
                        *(u32x2*)v = w0; *(u32x2*)(v + 32) = w1;
                    } else {
                        const int col = 256 * (pn - 6) + lc0; bf16_t* z = Zb + (size_t)row * 1024 + col;
                        u32x2 w0, w1; w0.x = cvt_pk_bf16(a0[0], a0[1]); w0.y = cvt_pk_bf16(a0[2], a0[3]); w1.x = cvt_pk_bf16(a1[0], a1[1]); w1.y = cvt_pk_bf16(a1[2], a1[3]);
                        *(u32x2*)z = w0; *(u32x2*)(z + 32) = w1;
                        if (pn == 6) {
                            if (smp) { const int b = rs >> 5, t = rs & 31; if (t >= 17) { float* po = poolS + (size_t)(b * 15 + t - 17) * 256 + lc0; *(f32x4*)po = a0; *(f32x4*)(po + 32) = a1; } }
                            else { const int b = row >> 11, t = row & 2047; if (t >= 2033) { float* po = poolP + (size_t)(b * 15 + t - 2033) * 256 + lc0; *(f32x4*)po = a0; *(f32x4*)(po + 32) = a1; } }
                        }
                    }
                }
                asm volatile("" ::: "memory");
            }
    }
};
template <class Epi, class Sched, bool ALIGN_EPI = false, bool SP2 = false>
__device__ __forceinline__ void gemm_phase(PG8_LAS unsigned char* lds, const Gemm g, const Sched& S, const Epi& E) {
    int tid_l = threadIdx.x; asm volatile("" : "+v"(tid_l)); const int tid = tid_l, wid = __builtin_amdgcn_readfirstlane(tid >> 6), lane = tid & 63, wr = wid >> 2, wc = wid & 3, fr = lane & 15, fq = lane >> 4;
    const int K = g.K, nt = K / BK;
    unsigned voffA[2], voffB[2];
#pragma unroll
    for (int i = 0; i < 2; ++i) { int R, C; stage_rc(tid * 16 + i * 8192, R, C); const int Rb = Epi::PERM ? ((R & ~31) + perm32(R & 31)) : R;
        voffA[i] = (unsigned)(R * K + C) * 2u; voffB[i] = (unsigned)(Rb * K + C) * 2u; }
    const size_t kstep = (size_t)(BK * 2);
    const size_t hstep = (size_t)HALF * K * 2;
    const size_t tstep = 2 * hstep;
    const unsigned ldsw = (unsigned)wid * 1024u;
    const int aoff = lds_byte(wr * 64 + fr, fq * 8), boff = lds_byte(wc * 32 + fr, fq * 8);
#define PG8_SA(b, h) (((b) * 2 + (h)) * HTB)
#define PG8_SB(b, h) ((4 + (b) * 2 + (h)) * HTB)
#define PG8_STAGE(bufoff, gbase, voff) do { _Pragma("unroll") for (int _i = 0; _i < 2; ++_i) \
        __builtin_amdgcn_global_load_lds((const unsigned*)((const char*)(gbase) + (voff)[_i]), (PG8_LAS unsigned*)(lds + (bufoff) + ldsw + _i * 8192), 16, 0, 0); } while (0)
#define PG8_LDA(dst, b, h) do { _Pragma("unroll") for (int m = 0; m < 4; ++m) _Pragma("unroll") for (int k = 0; k < 2; ++k) dst[m][k] = *(const PG8_LAS bf16x8*)(lds + PG8_SA(b, h) + aoff + m * 2048 + k * 1024); } while (0)
#define PG8_LDB(dst, b, h) do { _Pragma("unroll") for (int n = 0; n < 2; ++n) _Pragma("unroll") for (int k = 0; k < 2; ++k) dst[n][k] = *(const PG8_LAS bf16x8*)(lds + PG8_SB(b, h) + boff + n * 2048 + k * 1024); } while (0)
#define PG8_MMA(ai, bj, At, Bt) do { __builtin_amdgcn_s_setprio(1); _Pragma("unroll") for (int m = 0; m < 4; ++m) _Pragma("unroll") for (int n = 0; n < 2; ++n) _Pragma("unroll") for (int k = 0; k < 2; ++k) \
        acc[ai][bj][m][n] = __builtin_amdgcn_mfma_f32_16x16x32_bf16(Bt[n][k], At[m][k], acc[ai][bj][m][n], 0, 0, 0); __builtin_amdgcn_s_setprio(0); } while (0)
#define PG8_WAIT_V(n) asm volatile("s_waitcnt vmcnt(" #n ")" ::: "memory")
#define PG8_WAIT_L(n) asm volatile("s_waitcnt lgkmcnt(" #n ")" ::: "memory")
#define PG8_BAR __builtin_amdgcn_s_barrier()
#define PG8_SCHED __builtin_amdgcn_sched_barrier(0)
    Unit cur, nxt; int ui = 0;
    if (!S.next(0, cur)) return;
    f32x4 acc[2][2][4][2];
#pragma unroll
    for (int a = 0; a < 2; ++a)
#pragma unroll
        for (int b = 0; b < 2; ++b)
#pragma unroll
            for (int m = 0; m < 4; ++m)
#pragma unroll
                for (int n = 0; n < 2; ++n) acc[a][b][m][n] = (f32x4){0.f, 0.f, 0.f, 0.f};
    bf16x8 At[4][2], B0[2][2], B1[2][2];
    const char* cA = (const char*)g.A + (size_t)cur.pm * tstep; const char* cB = (const char*)g.Bt + (size_t)cur.pn * tstep;
    S.a_ready(cur);
    if constexpr (SP2) {
        PG8_STAGE(PG8_SB(0, 0), cB, voffB); PG8_STAGE(PG8_SB(0, 1), cB + hstep, voffB); PG8_STAGE(PG8_SA(0, 0), cA, voffA); PG8_STAGE(PG8_SA(0, 1), cA + hstep, voffA);
        if (wr == 1) PG8_BAR;
        PG8_WAIT_V(2); PG8_BAR;
        PG8_STAGE(PG8_SB(1, 0), cB + kstep, voffB); PG8_STAGE(PG8_SA(1, 0), cA + kstep, voffA); PG8_STAGE(PG8_SB(1, 1), cB + hstep + kstep, voffB);
        PG8_WAIT_V(6); PG8_BAR;
    } else {
        PG8_STAGE(PG8_SB(0, 0), cB, voffB); PG8_STAGE(PG8_SA(0, 0), cA, voffA); PG8_STAGE(PG8_SB(0, 1), cB + hstep, voffB); PG8_STAGE(PG8_SA(0, 1), cA + hstep, voffA);
        if (wr == 1) PG8_BAR;
        PG8_WAIT_V(4); PG8_BAR;
        PG8_STAGE(PG8_SB(1, 0), cB + kstep, voffB); PG8_STAGE(PG8_SA(1, 0), cA + kstep, voffA); PG8_STAGE(PG8_SB(1, 1), cB + hstep + kstep, voffB);
        PG8_WAIT_V(6); PG8_BAR;
    }
    for (;;) {
        const bool has_next = S.next(ui + 1, nxt);
        const char* nA = has_next ? (const char*)g.A + (size_t)nxt.pm * tstep : cA; const char* nB = has_next ? (const char*)g.Bt + (size_t)nxt.pn * tstep : cB;
        for (int t = 0; t < nt; t += 2) {
            const bool last = (t == nt - 2);
            const char* a1 = cA + (size_t)(t + 1) * kstep;
            const char* a2 = last ? nA : cA + (size_t)(t + 2) * kstep; const char* b2 = last ? nB : cB + (size_t)(t + 2) * kstep;
            const char* a3 = a2 + kstep; const char* b3 = b2 + kstep;
            if (last && has_next) S.a_ready(nxt);
            if constexpr (SP2) {
            PG8_LDB(B0, 0, 0); PG8_LDB(B1, 0, 1); PG8_SCHED; PG8_LDA(At, 0, 0); PG8_STAGE(PG8_SA(1, 1), a1 + hstep, voffA);
            PG8_WAIT_V(8); PG8_WAIT_L(0); PG8_BAR; PG8_MMA(0, 0, At, B0); PG8_MMA(0, 1, At, B1); PG8_BAR; PG8_SCHED;
            PG8_LDA(At, 0, 1); PG8_STAGE(PG8_SB(0, 0), b2, voffB); PG8_STAGE(PG8_SB(0, 1), b2 + hstep, voffB); PG8_STAGE(PG8_SA(0, 0), a2, voffA);
            PG8_WAIT_V(8); PG8_WAIT_L(0); PG8_BAR; PG8_MMA(1, 0, At, B0); PG8_MMA(1, 1, At, B1); PG8_BAR; PG8_SCHED;
            PG8_LDB(B0, 1, 0); PG8_LDB(B1, 1, 1); PG8_SCHED; PG8_LDA(At, 1, 0); PG8_STAGE(PG8_SA(0, 1), a2 + hstep, voffA);
            PG8_WAIT_V(8); PG8_WAIT_L(0); PG8_BAR; PG8_MMA(0, 0, At, B0); PG8_MMA(0, 1, At, B1); PG8_BAR; PG8_SCHED;
            PG8_LDA(At, 1, 1); PG8_STAGE(PG8_SB(1, 0), b3, voffB); PG8_STAGE(PG8_SB(1, 1), b3 + hstep, voffB); PG8_STAGE(PG8_SA(1, 0), a3, voffA);
            PG8_WAIT_V(8); PG8_WAIT_L(0); PG8_BAR; PG8_MMA(1, 0, At, B0); PG8_MMA(1, 1, At, B1); PG8_BAR; PG8_SCHED;
            } else {
            PG8_LDB(B0, 0, 0); PG8_SCHED; PG8_LDA(At, 0, 0); PG8_STAGE(PG8_SA(1, 1), a1 + hstep, voffA);
            PG8_WAIT_L(8); PG8_BAR; PG8_WAIT_L(0); PG8_MMA(0, 0, At, B0); PG8_BAR; PG8_SCHED;
            PG8_LDB(B1, 0, 1); PG8_STAGE(PG8_SB(0, 0), b2, voffB);
            PG8_BAR; PG8_WAIT_L(0); PG8_MMA(0, 1, At, B1); PG8_BAR;
            PG8_LDA(At, 0, 1); PG8_STAGE(PG8_SA(0, 0), a2, voffA);
            PG8_BAR; PG8_WAIT_L(0); PG8_MMA(1, 0, At, B0); PG8_BAR; PG8_SCHED;
            PG8_STAGE(PG8_SB(0, 1), b2 + hstep, voffB);
            PG8_WAIT_V(6); PG8_BAR; PG8_MMA(1, 1, At, B1); PG8_BAR;
            PG8_LDB(B0, 1, 0); PG8_SCHED; PG8_LDA(At, 1, 0); PG8_STAGE(PG8_SA(0, 1), a2 + hstep, voffA);
            PG8_WAIT_L(8); PG8_BAR; PG8_WAIT_L(0); PG8_MMA(0, 0, At, B0); PG8_BAR; PG8_SCHED;
            PG8_LDB(B1, 1, 1); PG8_STAGE(PG8_SB(1, 0), b3, voffB);
            PG8_BAR; PG8_WAIT_L(0); PG8_MMA(0, 1, At, B1); PG8_BAR;
            PG8_LDA(At, 1, 1); PG8_STAGE(PG8_SA(1, 0), a3, voffA);
            PG8_BAR; PG8_WAIT_L(0); PG8_MMA(1, 0, At, B0); PG8_BAR; PG8_SCHED;
            PG8_STAGE(PG8_SB(1, 1), b3 + hstep, voffB);
            PG8_WAIT_V(6); PG8_BAR; PG8_MMA(1, 1, At, B1); PG8_BAR;
            }
        }
        if constexpr (ALIGN_EPI) { if (wr == 0) PG8_BAR; }
        if constexpr (!Epi::AFTER_DRAIN) { E(acc, cur, wr, wc, fr, fq); S.done(cur); }
        if (!has_next) break;
#pragma unroll
        for (int a = 0; a < 2; ++a)
#pragma unroll
            for (int b = 0; b < 2; ++b)
#pragma unroll
                for (int m = 0; m < 4; ++m)
#pragma unroll
                    for (int n = 0; n < 2; ++n) acc[a][b][m][n] = (f32x4){0.f, 0.f, 0.f, 0.f};
        cur = nxt; cA = nA; cB = nB; ++ui;
        if constexpr (ALIGN_EPI) { if (wr == 1) PG8_BAR; }
    }
    PG8_WAIT_V(0);
    if constexpr (!ALIGN_EPI) { if (wr == 0) PG8_BAR; }
    PG8_BAR;
    if constexpr (Epi::AFTER_DRAIN) { E.fused(acc, cur, wr, wc, fr, fq, lds, wid, lane); S.done(cur); }
#undef PG8_SA
#undef PG8_SB
#undef PG8_STAGE
#undef PG8_LDA
#undef PG8_LDB
#undef PG8_MMA
#undef PG8_WAIT_V
#undef PG8_WAIT_L
#undef PG8_BAR
#undef PG8_SCHED
}
}
#include <hip/hip_bf16.h>
#include <cmath>
namespace attn_body {
using bf16=__hip_bfloat16;
using bf16x8=__attribute__((ext_vector_type(8)))short;
using s16x4=__attribute__((ext_vector_type(4)))short;
using f32x16=__attribute__((ext_vector_type(16)))float;
using u32x4=__attribute__((ext_vector_type(4)))unsigned;
constexpr int BATCH=8,NHEAD=16,SEQ=2048,D=64,PQK=512,PO=1024;
constexpr int NW=8,QBLK=32,QB=QBLK*NW,KVBLK=64,NQB=SEQ/QB;
constexpr int ATTN_UNIT_ROWS=QB;
__device__ __forceinline__ int crow(int r,int hi){return (r&3)+8*(r>>2)+4*hi;}
#define SBAR() __builtin_amdgcn_sched_barrier(0)
__device__ __forceinline__ void cmask(f32x16&p0,f32x16&p1,int jb,int qrel,int hi){
  const float NEG=-INFINITY; (void)hi;
  if(jb>(qrel>>6)){
  #pragma unroll
  for(int r=0;r<16;++r){p0[r]=NEG;p1[r]=NEG;}}
}

constexpr int NSLOT=3, SLOTB=8192;
constexpr int LDS_K=0, LDS_V=NSLOT*SLOTB, LDS_WS=2*NSLOT*SLOTB, LDS_OST=LDS_WS+NW*64*4, LDS_BYTES=LDS_OST+NW*4096;
constexpr float C2=0.125f*1.4426950408889634f;
__device__ __forceinline__ void glds16(const void*gsrc,unsigned lds_dst){unsigned keep;
  asm volatile("s_mov_b32 %0, m0\n\ts_mov_b32 m0, %2\n\ts_nop 0\n\tglobal_load_lds_dwordx4 %1, off\n\ts_mov_b32 m0, %0":"=&s"(keep):"v"(gsrc),"s"(lds_dst):"memory");}
__device__ __forceinline__ float max3f(float a,float b,float c){float r;asm("v_max3_f32 %0, %1, %2, %3":"=v"(r):"v"(a),"v"(b),"v"(c));return r;}
__device__ __forceinline__ float max2f(float a,float b){float r;asm("v_max_f32_e32 %0, %1, %2":"=v"(r):"v"(a),"v"(b));return r;}
__device__ __forceinline__ float fadd_s(float a,float b){float r;asm("v_add_f32_e32 %0, %1, %2":"=v"(r):"v"(a),"v"(b));return r;}
__device__ __forceinline__ float fsub_s(float a,float b){float r;asm("v_sub_f32_e32 %0, %1, %2":"=v"(r):"v"(a),"v"(b));return r;}
typedef float f32x2_t __attribute__((ext_vector_type(2))); typedef __bf16 bf16x2_t __attribute__((ext_vector_type(2)));
__device__ __forceinline__ unsigned cvtpk_s(float lo,float hi){f32x2_t v={lo,hi};bf16x2_t b=__builtin_convertvector(v,bf16x2_t);return __builtin_bit_cast(unsigned,b);}
#define WAIT_BAR(N) asm volatile("s_waitcnt vmcnt(" #N ") lgkmcnt(0)\n\ts_barrier":::"memory")

__device__ __forceinline__ void qkt(f32x16&p0,f32x16&p1,const char*Kslot,const bf16x8*qr,const f32x16&negm,int r32,int hi){
  const char*kb=Kslot+hi*1024+r32*16;
  #pragma unroll
  for(int d0=0;d0<4;++d0){
    const bf16x8 b0=*reinterpret_cast<const bf16x8*>(kb+d0*2048);
    const bf16x8 b1=*reinterpret_cast<const bf16x8*>(kb+d0*2048+512);
    if(d0==0){p0=__builtin_amdgcn_mfma_f32_32x32x16_bf16(b0,qr[0],negm,0,0,0);p1=__builtin_amdgcn_mfma_f32_32x32x16_bf16(b1,qr[0],negm,0,0,0);}
    else{p0=__builtin_amdgcn_mfma_f32_32x32x16_bf16(b0,qr[d0],p0,0,0,0);p1=__builtin_amdgcn_mfma_f32_32x32x16_bf16(b1,qr[d0],p1,0,0,0);}}
}
typedef __attribute__((address_space(3))) const char* lds_cptr;
typedef short v4i16_t __attribute__((ext_vector_type(4)));
__device__ __forceinline__ void kload8(bf16x8*kf,lds_cptr kp){
  kf[0]=*(const __attribute__((address_space(3))) bf16x8*)(kp);      kf[1]=*(const __attribute__((address_space(3))) bf16x8*)(kp+512);
  kf[2]=*(const __attribute__((address_space(3))) bf16x8*)(kp+2048); kf[3]=*(const __attribute__((address_space(3))) bf16x8*)(kp+2560);
  kf[4]=*(const __attribute__((address_space(3))) bf16x8*)(kp+4096); kf[5]=*(const __attribute__((address_space(3))) bf16x8*)(kp+4608);
  kf[6]=*(const __attribute__((address_space(3))) bf16x8*)(kp+6144); kf[7]=*(const __attribute__((address_space(3))) bf16x8*)(kp+6656);
}
__device__ __forceinline__ void kload2(bf16x8*kf,lds_cptr kp,int j){ kf[2*j]=*(const __attribute__((address_space(3))) bf16x8*)(kp+j*2048); kf[2*j+1]=*(const __attribute__((address_space(3))) bf16x8*)(kp+j*2048+512); }
__device__ __forceinline__ s16x4 vtr(lds_cptr p){ return __builtin_bit_cast(s16x4,__builtin_amdgcn_ds_read_tr16_b64_v4i16((__attribute__((address_space(3))) v4i16_t*)p)); }
__device__ __forceinline__ float rowmax(const f32x16&p0,const f32x16&p1){
  float a=max3f(p0[0],p0[1],p1[0]),b=max3f(p0[2],p0[3],p1[1]);a=max3f(a,p1[2],p1[3]);
  #pragma unroll
  for(int r=4;r<16;r+=4){a=max3f(a,p0[r],p0[r+1]);b=max3f(b,p0[r+2],p0[r+3]);a=max3f(a,p1[r],p1[r+1]);b=max3f(b,p1[r+2],p1[r+3]);}
  const float m=max2f(a,b);
  auto rr=__builtin_amdgcn_permlane32_swap(__float_as_uint(m),__float_as_uint(m),false,false);
  return max2f(__uint_as_float(rr[0]),__uint_as_float(rr[1]));
}
__device__ __forceinline__ void pv(f32x16*o,int vb,bf16x8 pa0,bf16x8 pa1,bf16x8 pa2,bf16x8 pa3){
  #pragma unroll
  for(int d0=0;d0<2;++d0){s16x4 lo[4],hi[4];
    #pragma unroll
    for(int ks=0;ks<4;++ks){
      asm volatile("ds_read_b64_tr_b16 %0,%1 offset:%c2":"=&v"(lo[ks]):"v"(vb),"i"(d0*4096+ks*1024):"memory");
      asm volatile("ds_read_b64_tr_b16 %0,%1 offset:%c2":"=&v"(hi[ks]):"v"(vb),"i"(d0*4096+ks*1024+512):"memory");}
    asm volatile("s_waitcnt lgkmcnt(0)":::"memory");SBAR();
    #define PK(k) (bf16x8){lo[k][0],lo[k][1],lo[k][2],lo[k][3],hi[k][0],hi[k][1],hi[k][2],hi[k][3]}
    o[d0]=__builtin_amdgcn_mfma_f32_32x32x16_bf16(pa0,PK(0),o[d0],0,0,0);
    o[d0]=__builtin_amdgcn_mfma_f32_32x32x16_bf16(pa1,PK(1),o[d0],0,0,0);
    o[d0]=__builtin_amdgcn_mfma_f32_32x32x16_bf16(pa2,PK(2),o[d0],0,0,0);
    o[d0]=__builtin_amdgcn_mfma_f32_32x32x16_bf16(pa3,PK(3),o[d0],0,0,0);
    #undef PK
  }
}

#ifndef ATTN_STORE16
#define ATTN_STORE16(p,v) (*(u32x4*)(p)=(v))
#endif
template<int THRL> __device__ __forceinline__ void attn_unit(int b,int qb,const bf16*Q,const bf16*__restrict__ K,const bf16*__restrict__ V,bf16*O,char*shm){
  int tid_l=threadIdx.x; asm volatile("":"+v"(tid_l)); const int tid=tid_l,lane=tid&63,r32=lane&31,hi=lane>>5; const int wid=__builtin_amdgcn_readfirstlane(tid>>6);
  const long rowbase=(long)b*SEQ; const int q0=qb*QB;
  const bf16*Qw=Q+(rowbase+q0+wid*QBLK)*PQK;
  const bf16*Kh=K+rowbase*PQK,*Vh=V+rowbase*PQK;
  const unsigned lds0=(unsigned)(uintptr_t)shm;
  float*wsf=(float*)(shm+LDS_WS)+wid*64;
  const bf16*ksrc=Kh+(long)lane*PQK+wid*8;
  const bf16*vsrc=Vh+(long)(16*(wid&3)+(lane>>2))*PQK+(wid>>2)*32+(lane&3)*8;
  const unsigned kdst=lds0+LDS_K+wid*1024, vdst=lds0+LDS_V+wid*1024;
  #define DMA_K(t,slot) glds16(ksrc+(long)(t)*KVBLK*PQK,(unsigned)__builtin_amdgcn_readfirstlane(kdst+(slot)))
  #define DMA_V(t,slot) glds16(vsrc+(long)(t)*KVBLK*PQK,(unsigned)__builtin_amdgcn_readfirstlane(vdst+(slot)))
  const int vb0=(int)(lds0+LDS_V)+((lane>>4)&1)*32+(lane&3)*8+(4*hi+((lane&15)>>2))*64;
  const char*Kbase=shm+LDS_K; bf16x8 kf[8];
  const lds_cptr shm3=(lds_cptr)shm; const lds_cptr kp0=shm3+LDS_K+hi*1024+r32*16; const lds_cptr vp0=shm3+LDS_V+((lane>>4)&1)*32+(lane&3)*8+(4*hi+((lane&15)>>2))*64;
  const int NT=(q0+QB)/KVBLK;
  DMA_K(0,0);DMA_V(0,0);DMA_K(1,SLOTB);
  bf16x8 qr[4];
  #pragma unroll
  for(int d0=0;d0<4;++d0)qr[d0]=*reinterpret_cast<const bf16x8*>(&Qw[(long)r32*PQK+d0*16+hi*8]);
  float mhat=0.f,l_reg=0.f;f32x16 o[2];o[0]=f32x16{};o[1]=f32x16{};f32x16 negm=f32x16{};asm volatile("":"+v"(negm));
  const int qrel=wid*QBLK+r32;
  #define CMASK(P0,P1,t) do{int jb_=(t)-(NT-4); if(jb_>=0)cmask(P0,P1,jb_,qrel,hi);}while(0)
  bool resc=false;
  #define START(P0,P1) do{ const float rm=rowmax(P0,P1); resc=false; \
    { const float dl=rm; mhat=fadd_s(mhat,dl); \
      _Pragma("unroll") for(int r=0;r<16;++r){P0[r]=fsub_s(P0[r],dl);P1[r]=fsub_s(P1[r],dl);} \
      _Pragma("unroll") for(int r=0;r<16;++r)negm[r]=-mhat; asm volatile("":"+v"(negm)); } \
    _Pragma("unroll") for(int r=0;r<16;++r)P0[r]=__builtin_amdgcn_exp2f(P0[r]); }while(0)
  #define RESC() do{ if(resc){ asm volatile("s_waitcnt lgkmcnt(0)":::"memory"); \
      _Pragma("unroll") for(int d_=0;d_<2;++d_) _Pragma("unroll") for(int r=0;r<16;++r)o[d_][r]*=wsf[crow(r,hi)]; } }while(0)
  f32x16 pA0,pA1,pB0,pB1;
  int sl_prev=0,sl_cur=0,sl_next=SLOTB;
  #define ROT() do{sl_prev=sl_cur;sl_cur=sl_next;sl_next=(sl_next==(NSLOT-1)*SLOTB)?0:sl_next+SLOTB;}while(0)
  DMA_K(2,2*SLOTB);
  WAIT_BAR(3);
  qkt(pA0,pA1,Kbase,qr,negm,r32,hi);asm volatile("s_nop 15\n\ts_nop 7":"+v"(pA0),"+v"(pA1));CMASK(pA0,pA1,0);
  START(pA0,pA1);
  _Pragma("unroll") for(int r=0;r<16;++r)pA1[r]=__builtin_amdgcn_exp2f(pA1[r]);
  WAIT_BAR(0);
  DMA_K(3,0);DMA_V(1,SLOTB);
  ROT();
  kload8(kf,kp0+sl_cur);
  WAIT_BAR(2);
  s16x4 vlo[8],vhi[8]; u32x4 pw0,pw1,pw2,pw3;
  #define PKW(P,B) cvtpk_s(P[B],P[B+1])
  #define PAF(k) __builtin_bit_cast(bf16x8,pw##k)
  #define VFR(i) (bf16x8){vlo[i][0],vlo[i][1],vlo[i][2],vlo[i][3],vhi[i][0],vhi[i][1],vhi[i][2],vhi[i][3]}
  #define PIN(x) asm volatile("":"+v"(x))
  #define MX3(a,b,c) __builtin_fmaxf(__builtin_fmaxf((a),(b)),(c))
  #define GAPA(MF,A0,A1,A2,A3,W0,W1,PW) do{ MF; sacc+=A0; sacc+=A1; sacc+=A2; sacc+=A3; PIN(sacc); W0; W1; PIN(PW); SBAR(); }while(0)
  #define EX(v) __builtin_amdgcn_exp2f(v)
  #define GAPB(MF,X,B) do{ MF; X[B]=EX(X[B]); X[B+1]=EX(X[B+1]); X[B+2]=EX(X[B+2]); X[B+3]=EX(X[B+3]); PIN(X); SBAR(); }while(0)
  #define VRD(i) do{ vlo[i]=vtr(vp_+(((i)>>2)*4096+((i)&3)*1024)); vhi[i]=vtr(vp_+(((i)>>2)*4096+((i)&3)*1024+512)); }while(0)
  #define KRD(G,j) do{ if(G){ kload2(kf,kp0+sl_next,j); SBAR(); } }while(0)
  #define STEP(C0,C1,P0,P1,t,GK,GV,GL) do{ SBAR(); \
    const lds_cptr vp_=vp0+sl_prev; \
    VRD(0); SBAR(); float sacc=(P0[0]+P0[1]); \
    GAPA(C0=__builtin_amdgcn_mfma_f32_32x32x16_bf16(kf[0],qr[0],negm,0,0,0), P0[2],P0[3],P0[4],P0[5],     pw0[0]=PKW(P0,0), pw0[1]=PKW(P0,2), pw0); \
    VRD(4); SBAR(); GAPA(C1=__builtin_amdgcn_mfma_f32_32x32x16_bf16(kf[1],qr[0],negm,0,0,0), P0[6],P0[7],P0[8],P0[9],     pw0[2]=PKW(P0,4), pw0[3]=PKW(P0,6), pw0); \
    VRD(1); SBAR(); GAPA(C0=__builtin_amdgcn_mfma_f32_32x32x16_bf16(kf[2],qr[1],C0,0,0,0),   P0[10],P0[11],P0[12],P0[13], pw1[0]=PKW(P0,8), pw1[1]=PKW(P0,10), pw1); \
    VRD(5); SBAR(); GAPA(C1=__builtin_amdgcn_mfma_f32_32x32x16_bf16(kf[3],qr[1],C1,0,0,0),   P0[14],P0[15],P1[0],P1[1],   pw1[2]=PKW(P0,12),pw1[3]=PKW(P0,14), pw1); \
    VRD(2); SBAR(); GAPA(C0=__builtin_amdgcn_mfma_f32_32x32x16_bf16(kf[4],qr[2],C0,0,0,0),   P1[2],P1[3],P1[4],P1[5],     pw2[0]=PKW(P1,0), pw2[1]=PKW(P1,2), pw2); \
    VRD(6); SBAR(); GAPA(C1=__builtin_amdgcn_mfma_f32_32x32x16_bf16(kf[5],qr[2],C1,0,0,0),   P1[6],P1[7],P1[8],P1[9],     pw2[2]=PKW(P1,4), pw2[3]=PKW(P1,6), pw2); \
    VRD(3); SBAR(); GAPA(C0=__builtin_amdgcn_mfma_f32_32x32x16_bf16(kf[6],qr[3],C0,0,0,0),   P1[10],P1[11],P1[12],P1[13], pw3[0]=PKW(P1,8), pw3[1]=PKW(P1,10), pw3); \
    VRD(7); SBAR(); GAPA(C1=__builtin_amdgcn_mfma_f32_32x32x16_bf16(kf[7],qr[3],C1,0,0,0),   P1[14],P1[15],0.f,0.f,       pw3[2]=PKW(P1,12),pw3[3]=PKW(P1,14), pw3); \
    l_reg+=sacc; \
    if(GK){DMA_K((t)+3,sl_cur);} if(GV){DMA_V((t)+1,sl_next);} \
    CMASK(C0,C1,t); \
    { float a=MX3(C0[0],C0[1],C1[0]),b=MX3(C0[2],C0[3],C1[1]); a=MX3(a,C1[2],C1[3]); \
      _Pragma("unroll") for(int r=4;r<16;r+=4){a=MX3(a,C0[r],C0[r+1]);b=MX3(b,C0[r+2],C0[r+3]);a=MX3(a,C1[r],C1[r+1]);b=MX3(b,C1[r+2],C1[r+3]);} \
      float rm=__builtin_fmaxf(a,b); { auto rr=__builtin_amdgcn_permlane32_swap(__float_as_uint(rm),__float_as_uint(rm),false,false); rm=__builtin_fmaxf(__uint_as_float(rr[0]),__uint_as_float(rr[1])); } \
      resc=false; \
      if(__builtin_expect(__any(rm>(float)THRL),0)){ const float dl=__builtin_fmaxf(rm,0.f); mhat+=dl; \
        _Pragma("unroll") for(int r=0;r<16;++r){C0[r]-=dl;C1[r]-=dl;} \
        _Pragma("unroll") for(int r=0;r<16;++r)negm[r]=-mhat; asm volatile("":"+v"(negm)); \
        const float f=__builtin_amdgcn_exp2f(-dl); l_reg*=f; if(hi==0)wsf[r32]=f; resc=true; } } \
    SBAR(); \
    GAPB(o[0]=__builtin_amdgcn_mfma_f32_32x32x16_bf16(PAF(0),VFR(0),o[0],0,0,0), C0,0); \
    GAPB(o[1]=__builtin_amdgcn_mfma_f32_32x32x16_bf16(PAF(0),VFR(4),o[1],0,0,0), C0,4); \
    KRD(GL,0); GAPB(o[0]=__builtin_amdgcn_mfma_f32_32x32x16_bf16(PAF(1),VFR(1),o[0],0,0,0), C0,8); \
    KRD(GL,1); GAPB(o[1]=__builtin_amdgcn_mfma_f32_32x32x16_bf16(PAF(1),VFR(5),o[1],0,0,0), C0,12); \
    KRD(GL,2); GAPB(o[0]=__builtin_amdgcn_mfma_f32_32x32x16_bf16(PAF(2),VFR(2),o[0],0,0,0), C1,0); \
    KRD(GL,3); GAPB(o[1]=__builtin_amdgcn_mfma_f32_32x32x16_bf16(PAF(2),VFR(6),o[1],0,0,0), C1,4); \
    GAPB(o[0]=__builtin_amdgcn_mfma_f32_32x32x16_bf16(PAF(3),VFR(3),o[0],0,0,0), C1,8); \
    GAPB(o[1]=__builtin_amdgcn_mfma_f32_32x32x16_bf16(PAF(3),VFR(7),o[1],0,0,0), C1,12); \
    }while(0)
  int t=1;
  #undef CMASK
  #define CMASK(P0,P1,t) do{}while(0)
  for(;t+5<NT;t+=2){
    STEP(pB0,pB1,pA0,pA1,t,true,true,true);     WAIT_BAR(2); RESC(); ROT();
    STEP(pA0,pA1,pB0,pB1,t+1,true,true,true);   WAIT_BAR(2); RESC(); ROT();
  }
  #undef CMASK
  #define CMASK(P0,P1,t) do{int jb_=(t)-(NT-4); if(jb_>=0)cmask(P0,P1,jb_,qrel,hi);}while(0)
  #define ENDW(tt) do{ if((tt)+3<NT){WAIT_BAR(2);} else if((tt)+2<NT){WAIT_BAR(1);} else {WAIT_BAR(0);} }while(0)
  for(;t+1<NT;t+=2){
    STEP(pB0,pB1,pA0,pA1,t,(t+3<NT),(t+1<NT),(t+1<NT));       ENDW(t);   RESC(); ROT();
    STEP(pA0,pA1,pB0,pB1,t+1,(t+4<NT),(t+2<NT),(t+2<NT));     ENDW(t+1); RESC(); ROT();
  }
  STEP(pB0,pB1,pA0,pA1,NT-1,false,false,false); RESC();
  { float sacc=pB0[0]+pB0[1]; _Pragma("unroll") for(int r=2;r<16;++r)sacc+=pB0[r]; _Pragma("unroll") for(int r=0;r<16;++r)sacc+=pB1[r]; l_reg+=sacc;
    pw0=(u32x4){PKW(pB0,0),PKW(pB0,2),PKW(pB0,4),PKW(pB0,6)};pw1=(u32x4){PKW(pB0,8),PKW(pB0,10),PKW(pB0,12),PKW(pB0,14)};pw2=(u32x4){PKW(pB1,0),PKW(pB1,2),PKW(pB1,4),PKW(pB1,6)};pw3=(u32x4){PKW(pB1,8),PKW(pB1,10),PKW(pB1,12),PKW(pB1,14)};
    SBAR(); pv(o,vb0+sl_cur,PAF(0),PAF(1),PAF(2),PAF(3)); }
  #undef PKW
  #undef PAF
  #undef VFR
  #undef PIN
  #undef MX3
  #undef GAPA
  #undef GAPB
  #undef EX
  #undef VRD
  #undef KRD
  #undef STEP
  #undef ENDW
  {auto rr=__builtin_amdgcn_permlane32_swap(__float_as_uint(l_reg),__float_as_uint(l_reg),false,false);l_reg=__uint_as_float(rr[0])+__uint_as_float(rr[1]);}
  if(hi==0)wsf[32+r32]=l_reg;asm volatile("s_waitcnt lgkmcnt(0)":::"memory");
  float rli[16];
  #pragma unroll
  for(int r=0;r<16;++r)rli[r]=__builtin_amdgcn_rcpf(wsf[32+crow(r,hi)]);
  bf16*Ow=O+(rowbase+q0+wid*QBLK)*PO;
  { bf16*stg=(bf16*)(shm+LDS_OST)+wid*2048;
    #pragma unroll
    for(int r=0;r<16;++r){const int orow=crow(r,hi);
      #pragma unroll
      for(int d0=0;d0<2;++d0)stg[orow*64+d0*32+r32]=__float2bfloat16(o[d0][r]*rli[r]);}
    asm volatile("s_waitcnt lgkmcnt(0)":::"memory");
    #pragma unroll
    for(int i=0;i<4;++i){const int row=i*8+(lane>>3),ch=lane&7; const u32x4 v=*(const u32x4*)(stg+row*64+ch*8); ATTN_STORE16(Ow+(long)row*PO+ch*8,v);} }
  asm volatile("s_waitcnt lgkmcnt(0)\n\ts_barrier":::"memory");
  #undef DMA_K
  #undef DMA_V
  #undef CMASK
  #undef START
  #undef RESC
  #undef ROT
}
#undef SBAR
#undef WAIT_BAR
}
namespace cg = cooperative_groups;
#define LAS __attribute__((address_space(3)))
typedef unsigned short bf16;
typedef unsigned v4u __attribute__((ext_vector_type(4)));
typedef unsigned v2u __attribute__((ext_vector_type(2)));
typedef float f32x4 __attribute__((ext_vector_type(4)));
typedef float f32x2 __attribute__((ext_vector_type(2)));
typedef float f32x16 __attribute__((ext_vector_type(16)));
typedef short bf16x8 __attribute__((ext_vector_type(8)));

constexpr int NWAVES = 8;
constexpr int D = 1024, MP = 16384, MS = 256, M = MP + MS, FF = 2816, DIN = 2560;
constexpr float EPS = 1e-6f;
constexpr float C2 = 0.125f * 1.4426950408889634f;
constexpr size_t OFF_Y = 0, OFF_KP = 17039360, OFF_VP = 33816576, OFF_PP = 50593792, OFF_CP = 50655232, OFF_KS = 50663424, OFF_VS = 50925568, OFF_PS = 51187712, OFF_CS = 51249152, OUT_TOTAL = 51257344;
constexpr size_t MiB = 1u << 20;
constexpr size_t WS_ROPE = 1 * MiB, WS_POOLWT = 2 * MiB, WS_W = 4 * MiB, WL = 40 * MiB;
constexpr size_t W_GU1 = 0, W_D1 = 11 * MiB, W_IN = 16 * MiB + MiB / 2, W_OUT = 21 * MiB + MiB / 2, W_GU2 = 23 * MiB + MiB / 2, W_D2 = 34 * MiB + MiB / 2;
constexpr size_t WS_X = 84 * MiB, WS_H = 149 * MiB, WS_MIX = 182 * MiB, WS_ACT = 215 * MiB;
constexpr size_t WS_QB = 215 * MiB, WS_KB = 232 * MiB, WS_VB = 249 * MiB, WS_ZB = 266 * MiB;
constexpr size_t WS_OB = 305 * MiB, WS_OPART = 338 * MiB, WS_ML = 347 * MiB, WS_END = 352 * MiB;
static_assert(WS_ROPE == pg8::WOFF_ROPE && WS_QB == pg8::WOFF_QB && WS_KB == pg8::WOFF_KB && WS_VB == pg8::WOFF_VB && WS_ZB == pg8::WOFF_ZB && OFF_KP == pg8::OOFF_KP && OFF_VP == pg8::OOFF_VP && OFF_PP == pg8::OOFF_PP && OFF_KS == pg8::OOFF_KS && OFF_VS == pg8::OOFF_VS && OFF_PS == pg8::OOFF_PS, "offsets");
static_assert(WS_ACT + (size_t)M * FF * 2 <= WS_OB && WS_ZB + (size_t)M * 1024 * 2 <= WS_OB && WS_X + (size_t)M * D * 4 <= WS_H && WS_H + (size_t)M * D * 2 <= WS_MIX && WS_MIX + (size_t)M * D * 2 <= WS_ACT, "ws map");
static_assert(WS_OB + (size_t)M * 1024 * 2 <= WS_OPART && WS_OPART + (size_t)32 * 2 * 9 * 32 * 128 * 4 <= WS_ML && WS_ML + (size_t)32 * 2 * 9 * 32 * 2 * 4 <= WS_END, "ws map 2");
constexpr int LDS_BYTES = 147456;
constexpr size_t CTL_BYTES = 262144, CTL_CNT = 65536;
constexpr size_t WS_SLOTP = 350 * MiB, WS_SLOTS = 351 * MiB;

__device__ __forceinline__ unsigned pk2(float lo, float hi) { f32x2 v = {lo, hi}; typedef __bf16 b2 __attribute__((ext_vector_type(2))); b2 b = __builtin_convertvector(v, b2); return __builtin_bit_cast(unsigned, b); }
__device__ __forceinline__ float bf2f(unsigned short b) { return __builtin_bit_cast(float, (unsigned)b << 16); }
__device__ __forceinline__ bf16x8 pack8(f32x4 a, f32x4 b) { v4u w; w.x = pk2(a.x, a.y); w.y = pk2(a.z, a.w); w.z = pk2(b.x, b.y); w.w = pk2(b.z, b.w); return __builtin_bit_cast(bf16x8, w); }
__device__ __forceinline__ int crow(int r, int hi) { return (r & 3) + 8 * (r >> 2) + 4 * hi; }
__device__ __forceinline__ void xhalf_pair(float m, float& a, float& b) { a = m; b = m; asm volatile("s_nop 1\n\tv_permlane32_swap_b32 %0, %1\n\ts_nop 1" : "+v"(a), "+v"(b)); }
__device__ __forceinline__ float xhalf_max(float m) { float a, b; xhalf_pair(m, a, b); return fmaxf(a, b); }
__device__ __forceinline__ float xhalf_sum(float m) { float a, b; xhalf_pair(m, a, b); return a + b; }
template <int O> __device__ __forceinline__ float swz_xor(float v) { return __builtin_bit_cast(float, __builtin_amdgcn_ds_swizzle(__builtin_bit_cast(int, v), (O << 10) | 0x1f)); }
__device__ __forceinline__ float wave_sum(float v) {
    v += swz_xor<1>(v); v += swz_xor<2>(v); v += swz_xor<4>(v); v += swz_xor<8>(v); v += swz_xor<16>(v);
    return xhalf_sum(v);
}
#define LDS_WAIT() asm volatile("s_waitcnt lgkmcnt(0)" ::: "memory")

struct Params { const float* in[26]; float* out; unsigned char* ws; };
typedef const __attribute__((address_space(4))) unsigned char* karg_ptr;
__device__ __forceinline__ karg_ptr kargs() { karg_ptr k = (karg_ptr)__builtin_amdgcn_kernarg_segment_ptr(); asm volatile("" : "+s"(k)); return k; }
__device__ __forceinline__ const float* KIN(int i) { return *(const float* const __attribute__((address_space(4)))*)(kargs() + 8 * i); }
__device__ __forceinline__ float* KOUT() { return *(float* const __attribute__((address_space(4)))*)(kargs() + 8 * 26); }
__device__ __forceinline__ unsigned char* KWS() { return *(unsigned char* const __attribute__((address_space(4)))*)(kargs() + 8 * 27); }

template <int MODE> __device__ __forceinline__ int wmap(int nl, int row_off) {
    if (MODE == 0) return row_off + nl;
    if (MODE == 1) return (nl >> 7) * 256 + (nl & 127) + row_off;
    const int u = nl >> 8, lc = nl & 255, A = lc >> 6, n = (lc >> 5) & 1, B = (lc >> 4) & 1, f = lc & 15;
    return u * 256 + 128 * (A >> 1) + 32 * (2 * (A & 1) + B) + 16 * n + f;
}
template <int MODE> __device__ __forceinline__ void transpose_item(const float* W, int K, int N, bf16* WT, int row_off, LAS float* scr, int item, int lane) {
    const int nblk = N / 32, kb = item / nblk, nb = item % nblk, k0 = 64 * kb, n0 = 32 * nb;
#pragma unroll 8
    for (int i = 0; i < 32; ++i) { const int kk = 2 * i + (lane >> 5); scr[kk * 33 + (lane & 31)] = W[(size_t)(k0 + kk) * N + n0 + (lane & 31)]; }
    LDS_WAIT(); asm volatile("" ::: "memory");
    const int c = lane & 7;
#pragma unroll
    for (int j = 0; j < 4; ++j) { const int n = (lane >> 3) + 8 * j; const LAS float* s = scr + (8 * c) * 33 + n;
        v4u o; o.x = pk2(s[0 * 33], s[1 * 33]); o.y = pk2(s[2 * 33], s[3 * 33]); o.z = pk2(s[4 * 33], s[5 * 33]); o.w = pk2(s[6 * 33], s[7 * 33]);
        *(v4u*)(WT + (size_t)wmap<MODE>(n0 + n, row_off) * K + k0 + 8 * c) = o; }
    LDS_WAIT(); asm volatile("" ::: "memory");
}
__device__ __forceinline__ void prologue(LAS unsigned char* lds, int gw, int NGW, int wave, int lane) {
    LAS float* scr = (LAS float*)(lds + wave * 16384);
    constexpr int I_F = 16 * 88, I_IN = 16 * 80, I_OUT = 16 * 32, I_L = 6 * I_F + I_IN + I_OUT;
    for (int it = gw; it < 2 * I_L; it += NGW) {
        const int l = it / I_L; int r = it % I_L;
        unsigned char* wl = KWS() + WS_W + (size_t)l * WL;
        if (r < I_F) { transpose_item<1>(KIN(7) + (size_t)l * D * FF, D, FF, (bf16*)(wl + W_GU1), 0, scr, r, lane); continue; } r -= I_F;
        if (r < I_F) { transpose_item<1>(KIN(8) + (size_t)l * D * FF, D, FF, (bf16*)(wl + W_GU1), 128, scr, r, lane); continue; } r -= I_F;
        if (r < I_F) { transpose_item<0>(KIN(9) + (size_t)l * D * FF, FF, D, (bf16*)(wl + W_D1), 0, scr, r, lane); continue; } r -= I_F;
        if (r < I_IN) { transpose_item<2>(KIN(11) + (size_t)l * D * DIN, D, DIN, (bf16*)(wl + W_IN), 0, scr, r, lane); continue; } r -= I_IN;
        if (r < I_OUT) { transpose_item<0>(KIN(20) + (size_t)l * D * D, D, D, (bf16*)(wl + W_OUT), 0, scr, r, lane); continue; } r -= I_OUT;
        if (r < I_F) { transpose_item<1>(KIN(22) + (size_t)l * D * FF, D, FF, (bf16*)(wl + W_GU2), 0, scr, r, lane); continue; } r -= I_F;
        if (r < I_F) { transpose_item<1>(KIN(23) + (size_t)l * D * FF, D, FF, (bf16*)(wl + W_GU2), 128, scr, r, lane); continue; } r -= I_F;
        transpose_item<0>(KIN(24) + (size_t)l * D * FF, FF, D, (bf16*)(wl + W_D2), 0, scr, r, lane);
    }
    float* rope = (float*)(KWS() + WS_ROPE);
    for (int i = gw * 64 + lane; i < 2080 * 32; i += NGW * 64) {
        const int pr = i >> 5, d = i & 31; const int pos = pr < 2048 ? pr : 4096 + (pr - 2048);
        const float inv = exp2f(-(float)d * (13.287712379549449f / 32.0f));
        const float ang = (float)pos * inv;
        const double rev = (double)ang * 0.15915494309189535; const float fr = (float)(rev - __builtin_rint(rev));
        rope[pr * 64 + d] = __builtin_amdgcn_cosf(fr); rope[pr * 64 + 32 + d] = __builtin_amdgcn_sinf(fr);
    }
    bf16* pwt_ = (bf16*)(KWS() + WS_POOLWT);
    for (int i = gw * 64 + lane; i < 2 * 4 * 64 * 64; i += NGW * 64) {
        const int c = i & 63, e = (i >> 6) & 63, lg = i >> 12;
        pwt_[i] = (bf16)(pk2(KIN(17)[(size_t)lg * 4096 + c * 64 + e], 0.f) & 0xffffu);
    }
}
template <bool FINAL> __device__ __forceinline__ void norm_rows(const float* srcP, const float* srcS, const float* g, bf16* H, float* outf, int gw, int NGW, int lane) {
    const f32x4* g4 = (const f32x4*)g + lane;
    f32x4 gv[4];
#pragma unroll
    for (int j = 0; j < 4; ++j) gv[j] = g4[64 * j];
    for (int m = gw; m < M; m += NGW) {
        const float* xr = (m < MP) ? srcP + (size_t)m * D : srcS + (size_t)(m - MP) * D;
        const f32x4* x4 = (const f32x4*)xr + lane;
        f32x4 v[4]; float s = 0.f;
#pragma unroll
        for (int j = 0; j < 4; ++j) { v[j] = x4[64 * j]; s += (v[j].x * v[j].x + v[j].y * v[j].y) + (v[j].z * v[j].z + v[j].w * v[j].w); }
        const float rstd = 1.0f / sqrtf(wave_sum(s) * (1.0f / D) + EPS);
        if (FINAL) {
            f32x4* o4 = (f32x4*)(outf + (size_t)m * D) + lane;
#pragma unroll
            for (int j = 0; j < 4; ++j) o4[64 * j] = v[j] * rstd * gv[j];
        } else {
            v2u* o2 = (v2u*)(H + (size_t)m * D) + lane;
#pragma unroll
            for (int j = 0; j < 4; ++j) { const f32x4 y = v[j] * rstd * gv[j]; v2u w; w.x = pk2(y.x, y.y); w.y = pk2(y.z, y.w); o2[64 * j] = w; }
        }
    }
}
__device__ __forceinline__ f32x16 mfma32(bf16x8 a, bf16x8 b, f32x16 c) { return __builtin_amdgcn_mfma_f32_32x32x16_bf16(a, b, c, 0, 0, 0); }


template <bool BASE16, int K> __device__ __forceinline__ void skinny_part1(LAS unsigned char* lds, const bf16* A, const bf16* Bt, const void* base, bf16* out, float scale,
                                            unsigned* slots, unsigned* cnt8, int tile, int tid) {
    const int lane = tid & 63, r32 = lane & 31, hi = lane >> 5, wid = __builtin_amdgcn_readfirstlane(tid >> 6);
    LAS float* R = (LAS float*)lds;
    LAS float* PARK = (LAS float*)(lds + 131072);
    const int rt = tile >> 5, ct = tile & 31, kw = K >> 3, k0 = wid * kw;
    const int e = tid * 2, row = e >> 5, col = e & 31;
    const size_t o = (size_t)(rt * 32 + row) * 1024 + ct * 32 + col;
    f32x2 bv; if (BASE16) { const unsigned bw = *(const unsigned*)((const bf16*)base + o); bv.x = bf2f(bw & 0xffff); bv.y = bf2f(bw >> 16); } else bv = *(const f32x2*)((const float*)base + o);
    const bf16* ap = A + (size_t)(rt * 32 + r32) * K + k0 + hi * 8; const bf16* bp = Bt + (size_t)(ct * 32 + r32) * K + k0 + hi * 8;
    f32x16 acc;
#pragma unroll
    for (int r = 0; r < 16; ++r) acc[r] = 0.f;
    constexpr int NST = K / 128, UB = (NST % 11 == 0) ? 11 : 8;
#pragma unroll 1
    for (int s0 = 0; s0 < NST; s0 += UB) { bf16x8 av[UB], bw[UB];
#pragma unroll
        for (int j = 0; j < UB; ++j) { av[j] = *(const bf16x8*)(ap + (s0 + j) * 16); bw[j] = *(const bf16x8*)(bp + (s0 + j) * 16); }
#pragma unroll
        for (int j = 0; j < UB; ++j) acc = mfma32(av[j], bw[j], acc); }
    __syncthreads();
#pragma unroll
    for (int r = 0; r < 16; ++r) R[(wid * 32 + crow(r, hi)) * 32 + r32] = acc[r];
    __syncthreads();
    f32x2 s = {0.f, 0.f};
#pragma unroll
    for (int w = 0; w < 8; ++w) s += *(const LAS f32x2*)(R + (w * 32 + row) * 32 + col);
    const f32x2 v = bv + s * scale;
    float ss = v.x * v.x + v.y * v.y; ss += swz_xor<1>(ss); ss += swz_xor<2>(ss); ss += swz_xor<4>(ss); ss += swz_xor<8>(ss);
    if ((tid & 15) == 0) __hip_atomic_store(slots + (size_t)(rt * 32 + row) * 32 + ct, __builtin_bit_cast(unsigned, ss), __ATOMIC_RELAXED, __HIP_MEMORY_SCOPE_AGENT);
    *(LAS f32x2*)(PARK + tid * 2) = v;
    asm volatile("s_waitcnt vmcnt(0)" ::: "memory");
    __syncthreads();
    if (tid == 0) __hip_atomic_fetch_add(cnt8 + 64 * rt, 1u, __ATOMIC_RELAXED, __HIP_MEMORY_SCOPE_AGENT);
    if (out) *(unsigned*)(out + o) = pk2(v.x, v.y);
    __syncthreads();
}
__device__ __forceinline__ void skinny_part2(LAS unsigned char* lds, bf16* hb, float* yout, const float* gain, unsigned* slots, unsigned* cnt8, int tile, int tid) {
    LAS float* PARK = (LAS float*)(lds + 131072);
    const int rt = tile >> 5, ct = tile & 31, e = tid * 2, row = e >> 5, col = e & 31;
    const size_t o = (size_t)(rt * 32 + row) * 1024 + ct * 32 + col;
    if (tid == 0) {
        unsigned spins = 0;
        while (__hip_atomic_load(cnt8 + 64 * rt, __ATOMIC_RELAXED, __HIP_MEMORY_SCOPE_AGENT) < 32u) { __builtin_amdgcn_s_sleep(2); if (++spins > (1u << 22)) break; }
        __builtin_amdgcn_fence(__ATOMIC_ACQUIRE, "agent");
        asm volatile("s_waitcnt vmcnt(0)" ::: "memory");
    }
    __syncthreads();
    const unsigned* sl = slots + (size_t)(rt * 32 + row) * 32 + (tid & 15) * 2;
    float tot = __builtin_bit_cast(float, __hip_atomic_load(sl, __ATOMIC_RELAXED, __HIP_MEMORY_SCOPE_AGENT)) + __builtin_bit_cast(float, __hip_atomic_load(sl + 1, __ATOMIC_RELAXED, __HIP_MEMORY_SCOPE_AGENT));
    tot += swz_xor<1>(tot); tot += swz_xor<2>(tot); tot += swz_xor<4>(tot); tot += swz_xor<8>(tot);
    const float r = 1.0f / sqrtf(tot * (1.0f / 1024.0f) + EPS);
    const f32x2 v = *(const LAS f32x2*)(PARK + tid * 2);
    const f32x2 gv = *(const f32x2*)(gain + ct * 32 + col); const f32x2 y = v * r * gv;
    if (hb) *(unsigned*)(hb + o) = pk2(y.x, y.y); else *(f32x2*)(yout + o) = y;
    __syncthreads();
}

__device__ __forceinline__ void sample_piece(LAS unsigned char* lds, int pc, int l, const bf16* Qb, const float* cache_k, const float* cache_v, const float* knew, const float* vnew, float* OPART, float* MLP, int tid) {
    const int lane = tid & 63, r32 = lane & 31, hi = lane >> 5, wid = __builtin_amdgcn_readfirstlane(tid >> 6);
    const int b = pc >> 5, h = (pc >> 3) & 3, s = pc & 7;
    const bf16* qrow = Qb + (size_t)(MP + b * 32 + r32) * 512 + h * 128 + hi * 8;
    LAS float* ML = (LAS float*)lds;
    LAS float* FAC = (LAS float*)(lds + 4096);
    LAS float* OX = (LAS float*)(lds + 8192);
    const bool extra = (s == 7) && (wid == 7);
    const size_t off = ((size_t)((l * 8 + b) * 4096 + (s * 8 + wid) * 64)) * 512 + h * 128;
    const size_t offx = ((size_t)(l * 8 + b) * 32) * 512 + h * 128;
    const float* Kt = cache_k + off; const float* Vt = cache_v + off; const float* Kx = knew + offx; const float* Vx = vnew + offx;
    float mrow[2], lrow[2]; bf16x8 pw[2][6];
#pragma unroll
    for (int c = 0; c < 2; ++c) {
        bf16x8 qf[4];
#pragma unroll
        for (int d0 = 0; d0 < 4; ++d0) qf[d0] = *(const bf16x8*)(qrow + c * 64 + d0 * 16);
        f32x16 sc[3];
#pragma unroll
        for (int kvb = 0; kvb < 3; ++kvb) {
            if (kvb < 2 || extra) {
                f32x16 a;
#pragma unroll
                for (int r = 0; r < 16; ++r) a[r] = 0.f;
                const float* kp = (kvb < 2 ? Kt + (size_t)(kvb * 32 + r32) * 512 : Kx + (size_t)r32 * 512) + c * 64 + hi * 8;
#pragma unroll
                for (int d0 = 0; d0 < 4; ++d0) { const f32x4 x0 = *(const f32x4*)(kp + d0 * 16), x1 = *(const f32x4*)(kp + d0 * 16 + 4); a = mfma32(pack8(x0, x1), qf[d0], a); }
                sc[kvb] = a;
            } else {
#pragma unroll
                for (int r = 0; r < 16; ++r) sc[kvb][r] = -1e30f;
            }
        }
        float mx = -1e30f;
#pragma unroll
        for (int r = 0; r < 16; ++r) mx = fmaxf(mx, fmaxf(fmaxf(sc[0][r], sc[1][r]), sc[2][r]));
        mx = xhalf_max(mx);
        float sum = 0.f;
#pragma unroll
        for (int kvb = 0; kvb < 3; ++kvb)
#pragma unroll
            for (int r = 0; r < 16; ++r) { const float pv = __builtin_amdgcn_exp2f(sc[kvb][r] - mx); sc[kvb][r] = pv; sum += pv; }
        sum = xhalf_sum(sum);
        mrow[c] = mx; lrow[c] = sum;
#pragma unroll
        for (int kvb = 0; kvb < 3; ++kvb)
#pragma unroll
            for (int hf = 0; hf < 2; ++hf) { v4u w; w.x = pk2(sc[kvb][8 * hf + 0], sc[kvb][8 * hf + 1]); w.y = pk2(sc[kvb][8 * hf + 2], sc[kvb][8 * hf + 3]);
                w.z = pk2(sc[kvb][8 * hf + 4], sc[kvb][8 * hf + 5]); w.w = pk2(sc[kvb][8 * hf + 6], sc[kvb][8 * hf + 7]); pw[c][2 * kvb + hf] = __builtin_bit_cast(bf16x8, w); }
    }
    asm volatile("" ::: "memory");
    f32x16 o[2][4];
#pragma unroll
    for (int c = 0; c < 2; ++c)
#pragma unroll
        for (int eb = 0; eb < 4; ++eb)
#pragma unroll
            for (int r = 0; r < 16; ++r) o[c][eb][r] = 0.f;
#pragma unroll
    for (int ks = 0; ks < 6; ++ks) {
        if (ks < 4 || extra) {
#pragma unroll
            for (int eb = 0; eb < 4; ++eb) {
                const float* vp = (ks < 4 ? Vt + (size_t)(ks * 16 + 4 * hi) * 512 : Vx + (size_t)((ks - 4) * 16 + 4 * hi) * 512) + eb * 32 + r32;
                f32x4 x0, x1;
                x0.x = vp[0 * 512]; x0.y = vp[1 * 512]; x0.z = vp[2 * 512]; x0.w = vp[3 * 512];
                x1.x = vp[8 * 512]; x1.y = vp[9 * 512]; x1.z = vp[10 * 512]; x1.w = vp[11 * 512];
                const bf16x8 vf = pack8(x0, x1);
                o[0][eb] = mfma32(pw[0][ks], vf, o[0][eb]); o[1][eb] = mfma32(pw[1][ks], vf, o[1][eb]);
            }
        }
    }
    if (hi == 0) {
#pragma unroll
        for (int c = 0; c < 2; ++c) { ML[((wid * 2 + c) * 32 + r32) * 2 + 0] = mrow[c]; ML[((wid * 2 + c) * 32 + r32) * 2 + 1] = lrow[c]; }
    }
    __syncthreads();
    const int pidx = s;
    if (tid < 64) {
        const int c = tid >> 5, q = tid & 31; float mw[8], lw[8]; float Mx = -1e30f;
#pragma unroll
        for (int w = 0; w < 8; ++w) { mw[w] = ML[((w * 2 + c) * 32 + q) * 2 + 0]; lw[w] = ML[((w * 2 + c) * 32 + q) * 2 + 1]; Mx = fmaxf(Mx, mw[w]); }
        float L = 0.f;
#pragma unroll
        for (int w = 0; w < 8; ++w) { const float fz = __builtin_amdgcn_exp2f(mw[w] - Mx); FAC[(w * 2 + c) * 32 + q] = fz; L += lw[w] * fz; }
        float* mp = MLP + ((size_t)((((b * 4 + h) * 2 + c) * 9 + pidx) * 32 + q)) * 2; mp[0] = Mx; mp[1] = L;
    }
    __syncthreads();
#pragma unroll
    for (int c = 0; c < 2; ++c) {
#pragma unroll
        for (int eb = 0; eb < 4; ++eb)
#pragma unroll
            for (int r = 0; r < 16; ++r) { const int q = crow(r, hi); OX[(wid * 32 + q) * 128 + eb * 32 + r32] = o[c][eb][r] * FAC[(wid * 2 + c) * 32 + q]; }
        __syncthreads();
        { const int idx = tid * 8, q = idx >> 7, e = idx & 127; f32x4 s0 = {0.f, 0.f, 0.f, 0.f}, s1 = {0.f, 0.f, 0.f, 0.f};
#pragma unroll
          for (int w = 0; w < 8; ++w) { s0 += *(const LAS f32x4*)(OX + (w * 32 + q) * 128 + e); s1 += *(const LAS f32x4*)(OX + (w * 32 + q) * 128 + e + 4); }
          float* dst = OPART + ((size_t)((((b * 4 + h) * 2 + c) * 9 + pidx) * 32 + q)) * 128 + e; *(f32x4*)dst = s0; *(f32x4*)(dst + 4) = s1; }
        __syncthreads();
    }
}

template <int W> __device__ __forceinline__ void pool_d(const LAS float* U, LAS bf16* Dd, int ch, int tbeg, int t0, bool smp) {
    float s = 0.f;
#pragma unroll
    for (int i = 0; i < W; ++i) s += U[(15 + tbeg - i) * 256 + ch];
#pragma unroll 8
    for (int k = 0; k < 32; ++k) {
        const int tt = tbeg + k; const float cur = U[(15 + tt) * 256 + ch];
        if (k > 0) s += cur - U[(15 + tt - W) * 256 + ch];
        const int pos = smp ? 4096 + tt : t0 + tt; const int cnt = (pos + 1 < W) ? pos + 1 : W;
        const float d = s * __builtin_amdgcn_rcpf((float)cnt) - cur;
        Dd[tt * 264 + ch] = (bf16)(pk2(d, 0.f) & 0xffffu);
    }
}
__device__ __forceinline__ f32x4 bf4_to_f32(v2u w) { f32x4 v; v.x = bf2f(w.x & 0xffff); v.y = bf2f(w.x >> 16); v.z = bf2f(w.y & 0xffff); v.w = bf2f(w.y >> 16); return v; }
__device__ __forceinline__ void poolconv_tile(LAS unsigned char* lds, int tl, int l, const bf16* Zb, bf16* MIX, const float* state_pool, const float* state_conv, const bf16* pwt, const float* pool_scale,
                                              const float* conv_w, float* out_cp, float* out_cs, int tid) {
    const int lane = tid & 63, r32 = lane & 31, hi = lane >> 5, wid = __builtin_amdgcn_readfirstlane(tid >> 6);
    int b, t0, TT, rowbase; bool smp;
    if (tl < 256) { b = tl >> 5; t0 = (tl & 31) * 64; TT = 64; rowbase = b * 2048 + t0; smp = false; }
    else { b = tl - 256; t0 = 0; TT = 32; rowbase = MP + b * 32; smp = true; }
    LAS float* U = (LAS float*)lds;
    LAS bf16* Dd = (LAS bf16*)(lds + 81920);
    {
        f32x4 uv[10];
#pragma unroll
        for (int k = 0; k < 10; ++k) {
            const int idx = tid + 512 * k, i = idx >> 6, c4 = (idx & 63) * 4; f32x4 v = {0.f, 0.f, 0.f, 0.f};
            if (i < 15 + TT) {
                if (i < 15 && smp) v = *(const f32x4*)(state_pool + (size_t)((l * 8 + b) * 15 + i) * 256 + c4);
                else if (i >= 15 || t0 - 15 + i >= 0) v = bf4_to_f32(*(const v2u*)(Zb + (size_t)(rowbase + i - 15) * 1024 + c4));
            }
            uv[k] = v;
        }
#pragma unroll
        for (int k = 0; k < 10; ++k) { const int idx = tid + 512 * k, i = idx >> 6, c4 = (idx & 63) * 4; if (i < 15 + TT) *(LAS f32x4*)(U + i * 256 + c4) = uv[k]; }
    }
    __syncthreads();
    {
        const int ch = tid & 255, th = tid >> 8, gi = __builtin_amdgcn_readfirstlane(ch >> 6);
        if (th * 32 < TT) {
            if (gi == 0) pool_d<2>(U, Dd, ch, th * 32, t0, smp); else if (gi == 1) pool_d<4>(U, Dd, ch, th * 32, t0, smp);
            else if (gi == 2) pool_d<8>(U, Dd, ch, th * 32, t0, smp); else pool_d<16>(U, Dd, ch, th * 32, t0, smp);
        }
    }
    __syncthreads();
    {
        const int gi = wid >> 1, th = wid & 1;
        if (th * 32 < TT) {
            f32x16 acc0, acc1;
#pragma unroll
            for (int r = 0; r < 16; ++r) { acc0[r] = 0.f; acc1[r] = 0.f; }
#pragma unroll
            for (int ks = 0; ks < 4; ++ks) {
                const bf16x8 a = *(const LAS bf16x8*)(Dd + (th * 32 + r32) * 264 + gi * 64 + ks * 16 + hi * 8);
                const bf16x8 b0 = *(const bf16x8*)(pwt + (size_t)((l * 4 + gi) * 64 + r32) * 64 + ks * 16 + hi * 8);
                const bf16x8 b1 = *(const bf16x8*)(pwt + (size_t)((l * 4 + gi) * 64 + 32 + r32) * 64 + ks * 16 + hi * 8);
                acc0 = mfma32(a, b0, acc0); acc1 = mfma32(a, b1, acc1);
            }
            const float sc0 = pool_scale[l * 256 + gi * 64 + r32], sc1 = pool_scale[l * 256 + gi * 64 + 32 + r32];
#pragma unroll
            for (int r = 0; r < 16; ++r) { const int tok = th * 32 + crow(r, hi); bf16* mp = MIX + (size_t)(rowbase + tok) * 1024 + 512 + gi * 64 + r32;
                mp[0] = (bf16)(pk2(acc0[r] * sc0, 0.f) & 0xffffu); mp[32] = (bf16)(pk2(acc1[r] * sc1, 0.f) & 0xffffu); }
        }
    }
    if (wid * 8 < TT) {
        const int cq = lane, tc = wid * 8;
        v2u hraw[10], graw[10], braw[8]; f32x4 hst[2];
        hst[0] = (f32x4){0.f, 0.f, 0.f, 0.f}; hst[1] = hst[0];
#pragma unroll
        for (int i = 0; i < 10; ++i) {
            const int ts = tc - 2 + i; hraw[i] = (v2u){0u, 0u}; graw[i] = (v2u){0u, 0u};
            if (ts >= 0 || (!smp && t0 + ts >= 0)) { const bf16* zr = Zb + (size_t)(rowbase + ts) * 1024 + 4 * cq; hraw[i] = *(const v2u*)(zr + 256); graw[i] = *(const v2u*)(zr + 768); }
        }
#pragma unroll
        for (int i = 0; i < 8; ++i) braw[i] = *(const v2u*)(Zb + (size_t)(rowbase + tc + i) * 1024 + 512 + 4 * cq);
        if (smp && tc == 0) { hst[0] = *(const f32x4*)(state_conv + (size_t)((l * 8 + b) * 2 + 0) * 256 + 4 * cq); hst[1] = *(const f32x4*)(state_conv + (size_t)((l * 8 + b) * 2 + 1) * 256 + 4 * cq); }
        const f32x4 cw0 = *(const f32x4*)(conv_w + l * 768 + 4 * cq), cw1 = *(const f32x4*)(conv_w + l * 768 + 256 + 4 * cq), cw2 = *(const f32x4*)(conv_w + l * 768 + 512 + 4 * cq);
        f32x4 cm2 = bf4_to_f32(graw[0]) * bf4_to_f32(hraw[0]), cm1 = bf4_to_f32(graw[1]) * bf4_to_f32(hraw[1]);
        if (smp && tc == 0) { cm2 = hst[0]; cm1 = hst[1]; }
#pragma unroll
        for (int i = 0; i < 8; ++i) {
            const int tt = tc + i;
            const f32x4 cv = bf4_to_f32(graw[i + 2]) * bf4_to_f32(hraw[i + 2]);
            const f32x4 y = bf4_to_f32(braw[i]) * (cw0 * cm2 + cw1 * cm1 + cw2 * cv);
            v2u w; w.x = pk2(y.x, y.y); w.y = pk2(y.z, y.w);
            *(v2u*)(MIX + (size_t)(rowbase + tt) * 1024 + 768 + 4 * cq) = w;
            if (smp) { if (tt >= 30) *(f32x4*)(out_cs + (size_t)((l * 8 + b) * 2 + tt - 30) * 256 + 4 * cq) = cv; }
            else if (t0 + tt >= 2046) *(f32x4*)(out_cp + (size_t)((l * 8 + b) * 2 + t0 + tt - 2046) * 256 + 4 * cq) = cv;
            cm2 = cm1; cm1 = cv;
        }
    }
    __syncthreads();
}

__device__ __forceinline__ void combine_phase(int l, const bf16* Ob_, const float* OPART_, const float* MLP_, bf16* MIX_, int gw, int NGW, int lane) {
    const float lam_init = (l == 0) ? 0.2f : 0.35550934f;
    float lam;
    { const float a = KIN(12)[l * 64 + lane] * KIN(13)[l * 64 + lane], c = KIN(14)[l * 64 + lane] * KIN(15)[l * 64 + lane];
      lam = __expf(wave_sum(a)) - __expf(wave_sum(c)) + lam_init; }
    const float g0 = KIN(16)[l * 128 + 2 * lane], g1 = KIN(16)[l * 128 + 2 * lane + 1];
    for (int base = gw * 8; base < MP * 4; base += NGW * 8) {
        float a0[8], a1[8];
        {
            unsigned w1[8], w2[8];
#pragma unroll
            for (int j = 0; j < 8; ++j) { const int wt = base + j, row = wt >> 2, h = wt & 3;
                w1[j] = *(const unsigned*)(Ob_ + (size_t)row * 1024 + h * 128 + 2 * lane); w2[j] = *(const unsigned*)(Ob_ + (size_t)row * 1024 + 512 + h * 128 + 2 * lane); }
#pragma unroll
            for (int j = 0; j < 8; ++j) { a0[j] = bf2f(w1[j] & 0xffff) - lam * bf2f(w2[j] & 0xffff); a1[j] = bf2f(w1[j] >> 16) - lam * bf2f(w2[j] >> 16); }
        }
        float ss[8];
#pragma unroll
        for (int j = 0; j < 8; ++j) ss[j] = a0[j] * a0[j] + a1[j] * a1[j];
#pragma unroll
        for (int j = 0; j < 8; ++j) ss[j] += swz_xor<1>(ss[j]);
#pragma unroll
        for (int j = 0; j < 8; ++j) ss[j] += swz_xor<2>(ss[j]);
#pragma unroll
        for (int j = 0; j < 8; ++j) ss[j] += swz_xor<4>(ss[j]);
#pragma unroll
        for (int j = 0; j < 8; ++j) ss[j] += swz_xor<8>(ss[j]);
#pragma unroll
        for (int j = 0; j < 8; ++j) ss[j] += swz_xor<16>(ss[j]);
#pragma unroll
        for (int j = 0; j < 8; ++j) { const int wt = base + j, row = wt >> 2, h = wt & 3;
            const float tot = xhalf_sum(ss[j]);
            const float r = (1.0f / sqrtf(tot * (1.0f / 128.0f) + EPS)) * (1.0f - lam_init);
            *(unsigned*)(MIX_ + (size_t)row * 1024 + h * 128 + 2 * lane) = pk2(a0[j] * r * g0, a1[j] * r * g1); }
    }
    for (int wt = MP * 4 + gw; wt < M * 4; wt += NGW) {
        const int row = wt >> 2, h = wt & 3, rs = row - MP, b = rs >> 5, q = rs & 31; float oc[2][2];
#pragma unroll
        for (int c = 0; c < 2; ++c) {
            const size_t pb = (size_t)(((b * 4 + h) * 2 + c) * 9);
            float mw[8], lw[8]; f32x2 ov[8]; float Mx = -1e30f;
#pragma unroll
            for (int pi = 0; pi < 8; ++pi) { const f32x2 ml = *(const f32x2*)(MLP_ + ((pb + pi) * 32 + q) * 2); mw[pi] = ml.x; lw[pi] = ml.y; ov[pi] = *(const f32x2*)(OPART_ + ((pb + pi) * 32 + q) * 128 + 2 * lane); }
#pragma unroll
            for (int pi = 0; pi < 8; ++pi) Mx = fmaxf(Mx, mw[pi]);
            float L = 0.f, s0 = 0.f, s1 = 0.f;
#pragma unroll
            for (int pi = 0; pi < 8; ++pi) { const float fz = __builtin_amdgcn_exp2f(mw[pi] - Mx); L += lw[pi] * fz; s0 += ov[pi].x * fz; s1 += ov[pi].y * fz; }
            const float il = 1.0f / L; oc[c][0] = s0 * il; oc[c][1] = s1 * il;
        }
        const float a0 = oc[0][0] - lam * oc[1][0], a1 = oc[0][1] - lam * oc[1][1];
        const float tot = wave_sum(a0 * a0 + a1 * a1);
        const float r = (1.0f / sqrtf(tot * (1.0f / 128.0f) + EPS)) * (1.0f - lam_init);
        *(unsigned*)(MIX_ + (size_t)row * 1024 + h * 128 + 2 * lane) = pk2(a0 * r * g0, a1 * r * g1);
    }
}

#ifndef PROBE_SLOW_ATTN
#define PROBE_SLOW_ATTN 0
#endif
#if PROBE_SLOW_ATTN
__device__ __forceinline__ void slow_attn_phase(int l, const bf16* Qb_, float* outp, const float* cache_k, const float* cache_v, bf16* MIX_, int gw, int NGW, int lane) {
    const float lam_init = (l == 0) ? 0.2f : 0.35550934f;
    float lam;
    { const float a = KIN(12)[l * 64 + lane] * KIN(13)[l * 64 + lane], c = KIN(14)[l * 64 + lane] * KIN(15)[l * 64 + lane];
      lam = __expf(wave_sum(a)) - __expf(wave_sum(c)) + lam_init; }
    const float g0 = KIN(16)[l * 128 + 2 * lane], g1 = KIN(16)[l * 128 + 2 * lane + 1];
    for (int wt = gw; wt < M * 4; wt += NGW) {
        const int row = wt >> 2, h = wt & 3;
        const float *K0, *V0, *K1, *V1; int n0, n1;
        if (row < MP) { const int b = row >> 11, t = row & 2047; K0 = outp + OFF_KP + ((size_t)l * MP + (size_t)b * 2048) * 512 + h * 128; V0 = outp + OFF_VP + ((size_t)l * MP + (size_t)b * 2048) * 512 + h * 128; n0 = ((t >> 6) + 1) * 64; K1 = K0; V1 = V0; n1 = 0; }
        else { const int rs = row - MP, b = rs >> 5; K0 = cache_k + ((size_t)(l * 8 + b) * 4096) * 512 + h * 128; V0 = cache_v + ((size_t)(l * 8 + b) * 4096) * 512 + h * 128; n0 = 4096;
               K1 = outp + OFF_KS + ((size_t)(l * 8 + b) * 32) * 512 + h * 128; V1 = outp + OFF_VS + ((size_t)(l * 8 + b) * 32) * 512 + h * 128; n1 = 32; }
        float oc[2][2];
#pragma unroll 1
        for (int c = 0; c < 2; ++c) {
            float q[64];
#pragma unroll
            for (int d = 0; d < 64; ++d) q[d] = bf2f(Qb_[(size_t)row * 512 + h * 128 + c * 64 + d]);
            float mx = -1e30f;
            for (int seg = 0; seg < 2; ++seg) { const float* Kp = seg ? K1 : K0; const int n = seg ? n1 : n0;
                for (int j0 = 0; j0 < n; j0 += 64) { const int j = j0 + lane; float s = -1e30f;
                    if (j < n) { const float* kr = Kp + (size_t)j * 512 + c * 64; s = 0.f;
#pragma unroll
                        for (int d = 0; d < 64; ++d) s += q[d] * kr[d]; }
                    mx = fmaxf(mx, s); } }
            mx = fmaxf(mx, swz_xor<1>(mx)); mx = fmaxf(mx, swz_xor<2>(mx)); mx = fmaxf(mx, swz_xor<4>(mx)); mx = fmaxf(mx, swz_xor<8>(mx)); mx = fmaxf(mx, swz_xor<16>(mx)); mx = xhalf_max(mx);
            float L = 0.f, o0 = 0.f, o1 = 0.f;
            for (int seg = 0; seg < 2; ++seg) { const float* Kp = seg ? K1 : K0; const float* Vp = seg ? V1 : V0; const int n = seg ? n1 : n0;
                for (int j0 = 0; j0 < n; j0 += 64) { const int j = j0 + lane; float pj = 0.f;
                    if (j < n) { const float* kr = Kp + (size_t)j * 512 + c * 64; float s = 0.f;
#pragma unroll
                        for (int d = 0; d < 64; ++d) s += q[d] * kr[d];
                        pj = __builtin_amdgcn_exp2f(s - mx); }
                    L += pj;
                    const int nn = (n - j0 < 64) ? n - j0 : 64;
                    for (int jj = 0; jj < nn; ++jj) { const float pb = __builtin_bit_cast(float, __builtin_amdgcn_readlane(__builtin_bit_cast(int, pj), jj));
                        const f32x2 vv = *(const f32x2*)(Vp + (size_t)(j0 + jj) * 512 + 2 * lane); o0 += pb * vv.x; o1 += pb * vv.y; } } }
            L = wave_sum(L);
            oc[c][0] = o0 / L; oc[c][1] = o1 / L;
        }
        const float a0 = oc[0][0] - lam * oc[1][0], a1 = oc[0][1] - lam * oc[1][1];
        const float ss = wave_sum(a0 * a0 + a1 * a1);
        const float r = (1.0f / sqrtf(ss * (1.0f / 128.0f) + EPS)) * (1.0f - lam_init);
        *(unsigned*)(MIX_ + (size_t)row * 1024 + h * 128 + 2 * lane) = pk2(a0 * r * g0, a1 * r * g1);
    }
}
#endif

#ifndef PROBE_SLOW_PC
#define PROBE_SLOW_PC 0
#endif
#if PROBE_SLOW_PC
__device__ __forceinline__ float zval(const bf16* Zb_, const float* st, int l, int b, bool smp, int rowbase, int t, int col, int hist) {
    if (t >= 0) return bf2f(Zb_[(size_t)(rowbase + t) * 1024 + col]);
    if (!smp) return 0.f;
    return st[(size_t)((l * 8 + b) * hist + (hist + t)) * 256 + (col & 255)];
}
__device__ __forceinline__ void slow_pc_phase(int l, const bf16* Zb_, bf16* MIX_, int gw, int NGW, int lane) {
    const float* sp = KIN(4); const float* scv = KIN(5); const float* pw = KIN(17); const float* psc = KIN(18); const float* cw = KIN(19);
    for (int wt = gw; wt < M * 4; wt += NGW) {
        const int row = wt >> 2, g = wt & 3; const bool smp = row >= MP;
        int b, t, rowbase; if (smp) { const int rs = row - MP; b = rs >> 5; t = rs & 31; rowbase = MP + b * 32; } else { b = row >> 11; t = row & 2047; rowbase = b * 2048; }
        const int w = 2 << g, ch = g * 64 + lane;
        float s = 0.f;
        for (int i = 0; i < w; ++i) { const int tt = t - i; s += zval(Zb_, sp, l, b, smp, rowbase, tt, ch, 15); }
        const int pos = smp ? 4096 + t : t; const int cnt = (pos + 1 < w) ? pos + 1 : w;
        const float d = s / (float)cnt - zval(Zb_, sp, l, b, smp, rowbase, t, ch, 15);
        float mine = 0.f;
        for (int e = 0; e < 64; ++e) { const float v = wave_sum(d * pw[(size_t)((l * 4 + g) * 64 + lane) * 64 + e]); if (e == lane) mine = v; }
        MIX_[(size_t)row * 1024 + 512 + ch] = (bf16)(pk2(mine * psc[l * 256 + ch], 0.f) & 0xffffu);
        float cvv[3];
#pragma unroll
        for (int k = 0; k < 3; ++k) { const int tt = t - 2 + k;
            if (tt >= 0) cvv[k] = bf2f(Zb_[(size_t)(rowbase + tt) * 1024 + 768 + ch]) * bf2f(Zb_[(size_t)(rowbase + tt) * 1024 + 256 + ch]);
            else cvv[k] = smp ? scv[(size_t)((l * 8 + b) * 2 + (2 + tt)) * 256 + ch] : 0.f; }
        const float bgv = bf2f(Zb_[(size_t)row * 1024 + 512 + ch]);
        const float y = bgv * (cw[l * 768 + ch] * cvv[0] + cw[l * 768 + 256 + ch] * cvv[1] + cw[l * 768 + 512 + ch] * cvv[2]);
        MIX_[(size_t)row * 1024 + 768 + ch] = (bf16)(pk2(y, 0.f) & 0xffffu);
    }
}
#endif

#define XB_TMO      128
#define XB_XCNT(j)  (256  + 64 * (j))
#define XB_XSUB(j)  (1280 + 64 * (j))
#define XB_XGEN(j)  (2304 + 64 * (j))
#define XB_TOP      3328
#define XB_TOPGEN   3392
#define XCD_BAR_WORDS 3456
#define XB_SPIN_CAP (1u << 18)
__device__ __forceinline__ unsigned xb_ld(unsigned* p)              { return __hip_atomic_load(p, __ATOMIC_RELAXED, __HIP_MEMORY_SCOPE_AGENT); }
__device__ __forceinline__ unsigned xb_add(unsigned* p, unsigned v) { return __hip_atomic_fetch_add(p, v, __ATOMIC_RELAXED, __HIP_MEMORY_SCOPE_AGENT); }
__device__ __forceinline__ unsigned xb_xcc_id() { return (unsigned)__builtin_amdgcn_s_getreg((3 << 11) | 20) & 0xFu; }
#define XB_SPIN(cond, bar) do { unsigned _sp = 0; while (cond) { __builtin_amdgcn_s_sleep(1); \
    if ((++_sp & 255u) == 0u) { if (xb_ld(&(bar)[XB_TMO])) break; if (_sp > XB_SPIN_CAP) { atomicAdd(&(bar)[XB_TMO], 1u); break; } } } } while (0)
__device__ __forceinline__ void xcd_barrier_complete(unsigned* bar, unsigned x, unsigned& nloc, unsigned& nx) {
    const unsigned G = gridDim.x * gridDim.y * gridDim.z;
    unsigned sum, cnt, mine, sp = 0u;
    for (;;) {
        sum = 0u; cnt = 0u; mine = 0u;
#pragma unroll
        for (unsigned j = 0; j < 16; ++j) { const unsigned c = xb_ld(&bar[XB_XCNT(j)]); sum += c; cnt += (c > 0u) ? 1u : 0u; mine = (j == x) ? c : mine; }
        if (sum == G) break;
        __builtin_amdgcn_s_sleep(1);
        if ((++sp & 255u) == 0u) { if (xb_ld(&bar[XB_TMO])) break; if (sp > XB_SPIN_CAP) { atomicAdd(&bar[XB_TMO], 1u); break; } }
    }
    nloc = mine > 0u ? mine : 1u; nx = cnt > 0u ? cnt : 1u;
}
__device__ __forceinline__ void xcd_barrier(unsigned* bar, unsigned x, volatile LAS unsigned* st) {
    asm volatile("s_waitcnt vmcnt(0)" ::: "memory");
    __syncthreads();
    if (threadIdx.x == 0) {
        __builtin_amdgcn_s_waitcnt(0);
        unsigned nloc = st[0], nx = st[1];
        if (nloc == 0u) { xcd_barrier_complete(bar, x, nloc, nx); st[0] = nloc; st[1] = nx; }
        const unsigned old = xb_add(&bar[XB_XSUB(x)], 1u);
        const unsigned gen = old / nloc;
        if (old + 1u == (gen + 1u) * nloc) {
            __builtin_amdgcn_fence(__ATOMIC_RELEASE, "agent");
            asm volatile("s_waitcnt vmcnt(0)" ::: "memory");
            const unsigned og = xb_add(&bar[XB_TOP], 1u);
            const unsigned tg = og / nx;
            if (og + 1u == (tg + 1u) * nx) xb_add(&bar[XB_TOPGEN], 1u);
            else XB_SPIN(xb_ld(&bar[XB_TOPGEN]) == tg, bar);
            __builtin_amdgcn_fence(__ATOMIC_ACQUIRE, "agent");
            xb_add(&bar[XB_XGEN(x)], 1u);
            asm volatile("s_waitcnt vmcnt(0)" ::: "memory");
        } else {
            XB_SPIN(xb_ld(&bar[XB_XGEN(x)]) == gen, bar);
            __builtin_amdgcn_fence(__ATOMIC_ACQUIRE, "agent");
            asm volatile("s_waitcnt vmcnt(0)" ::: "memory");
        }
    }
    __syncthreads();
}
#define CG_SYNC() do { asm volatile("s_waitcnt vmcnt(0) lgkmcnt(0)" ::: "memory"); grid.sync(); asm volatile("" ::: "memory"); } while (0)
#define GRID_SYNC() xcd_barrier((unsigned*)KWS() + 4096, xcc, (volatile LAS unsigned*)(lds + LDS_BYTES - 64))
__global__ void __launch_bounds__(NWAVES * 64, 2) mega_fwd(Params p) {
    extern __shared__ __attribute__((aligned(16))) unsigned char lds_raw[];
    LAS unsigned char* lds = (LAS unsigned char*)lds_raw;
    cg::grid_group grid = cg::this_grid();
    const int tid = threadIdx.x, lane = tid & 63, wave = __builtin_amdgcn_readfirstlane(tid >> 6);
    const int G = gridDim.x; const int bx = blockIdx.x; const int vcu0 = (G % 8 == 0) ? (bx % 8) * (G / 8) + bx / 8 : bx;
    const int NGW = G * NWAVES;
#define X ((bf16*)(ws + WS_X))
#define H ((bf16*)(ws + WS_H))
#define MIX ((bf16*)(ws + WS_MIX))
#define ACT ((bf16*)(ws + WS_ACT))
#define Qb ((bf16*)(ws + WS_QB))
#define Kb ((bf16*)(ws + WS_KB))
#define Vb ((bf16*)(ws + WS_VB))
#define Zb ((bf16*)(ws + WS_ZB))
#define Ob ((bf16*)(ws + WS_OB))
#define OPART ((float*)(ws + WS_OPART))
#define MLP ((float*)(ws + WS_ML))
#define pwt ((const bf16*)(ws + WS_POOLWT))
    if (tid < 16) ((LAS unsigned*)(lds + LDS_BYTES - 64))[tid] = 0u;
    const unsigned xcc = xb_xcc_id();
    if (tid == 0) (void)xb_add((unsigned*)KWS() + 4096 + XB_XCNT(xcc), 1u);
    __syncthreads();
    { const int gw = vcu0 * NWAVES + wave; prologue(lds, gw, NGW, wave, lane);
      norm_rows<false>(KIN(0), KIN(1), KIN(6), (bf16*)(KWS() + WS_H), nullptr, gw, NGW, lane); }
    CG_SYNC();
#define FRESH_IDS() int tid = threadIdx.x; asm volatile("" : "+v"(tid)); const int lane = tid & 63, wave = __builtin_amdgcn_readfirstlane(tid >> 6); int vcu = vcu0; asm volatile("" : "+s"(vcu)); const int gw = vcu * NWAVES + wave; (void)lane; (void)gw; (void)wave
#define CNT(nid, idx) ((unsigned*)(ws + CTL_CNT) + (size_t)((nid) * 80 + (idx)) * 64)
#pragma unroll 1
    for (int step = 0; step < 4; ++step) {
        const int l = step >> 1, f = step & 1;
        const bool first = (step == 0);
        { FRESH_IDS(); unsigned char* const ws = KWS(); unsigned char* const wl = ws + WS_W + (size_t)l * WL;
          pg8::Gemm g{H, (const bf16*)(wl + (f ? W_GU2 : W_GU1)), M, 2 * FF, D}; pg8::StaticOrder S; S.init(M, 2 * FF, G, bx);
          pg8::EpiSwiGLU E{ACT, FF};
          pg8::gemm_phase<pg8::EpiSwiGLU, pg8::StaticOrder, true, true>(lds, g, S, E); }
        GRID_SYNC();
        { FRESH_IDS(); unsigned char* const ws = KWS(); unsigned char* const wl = ws + WS_W + (size_t)l * WL;
          const bool last = (step == 3);
          const float* const gn = last ? KIN(25) : (f ? KIN(6) + (l + 1) * D : KIN(10) + l * D);
          const int nid = step * 2;
          float* const yo = KOUT() + OFF_Y;
          pg8::Gemm g{ACT, (const bf16*)(wl + (f ? W_D2 : W_D1)), MP, D, FF}; pg8::StaticOrder S; S.init(MP, D, G, bx);
          if (first) skinny_part1<false, FF>(lds, ACT + (size_t)MP * FF, (const bf16*)(wl + W_D1), KIN(1), X + (size_t)MP * D, 0.5f, (unsigned*)(ws + WS_SLOTS), CNT(nid, 64), vcu, tid);
          else skinny_part1<true, FF>(lds, ACT + (size_t)MP * FF, (const bf16*)(wl + (f ? W_D2 : W_D1)), X + (size_t)MP * D, last ? nullptr : X + (size_t)MP * D, 0.5f, (unsigned*)(ws + WS_SLOTS), CNT(nid, 64), vcu, tid);
          { pg8::Unit u0; const int pm0 = S.next(0, u0) ? u0.pm : 0;
            if (first) { pg8::EpiResidNorm<false> E{KIN(0), X, 0.5f, H, yo, gn, (unsigned*)(ws + WS_SLOTP), CNT(nid, pm0)};
                         pg8::gemm_phase<pg8::EpiResidNorm<false>, pg8::StaticOrder, false, true>(lds, g, S, E); }
            else { pg8::EpiResidNorm<true> E{X, last ? nullptr : X, 0.5f, last ? nullptr : H, yo, gn, (unsigned*)(ws + WS_SLOTP), CNT(nid, pm0)};
                   pg8::gemm_phase<pg8::EpiResidNorm<true>, pg8::StaticOrder, false, true>(lds, g, S, E); } }
          skinny_part2(lds, last ? nullptr : H + (size_t)MP * D, yo + (size_t)MP * D, gn, (unsigned*)(ws + WS_SLOTS), CNT(nid, 64), vcu, tid); }
        if (step == 3) break;
        GRID_SYNC();
        if (f == 0) {
            { FRESH_IDS(); unsigned char* const ws = KWS(); unsigned char* const wl = ws + WS_W + (size_t)l * WL;
              pg8::Gemm g{H, (const bf16*)(wl + W_IN), M, DIN, D}; pg8::StaticOrder S; S.init(M, DIN, G, bx);
              pg8::EpiWin E{ws, KOUT(), l, C2};
              pg8::gemm_phase<pg8::EpiWin, pg8::StaticOrder, true, true>(lds, g, S, E); }
            GRID_SYNC();
#pragma unroll 1
            for (int slot = 0; slot < 2; ++slot) {
              if (((slot ^ vcu0) & 1) == 0) {
                FRESH_IDS(); unsigned char* const ws = KWS();
                for (int i = 0; i < 4; ++i) {
                  const int L = i * G + vcu; if (L >= 1024) break;
                  const int bh = (L & 255) >> 1, sI = L & 1, ii = L >> 8;
                  const int qb = sI == 0 ? (ii == 0 ? 7 : ii == 1 ? 0 : ii == 2 ? 4 : 3) : (ii == 0 ? 6 : ii == 1 ? 1 : ii == 2 ? 5 : 2);
                  const int b = bh >> 4, vh = bh & 15, hh = vh >> 2, c = (vh >> 1) & 1, hf = vh & 1;
                  attn_body::attn_unit<8>(b, qb, (const attn_body::bf16*)(Qb + (hh * 2 + c) * 64), (const attn_body::bf16*)(Kb + (hh * 2 + c) * 64), (const attn_body::bf16*)(Vb + hh * 128 + hf * 64),
                                          (attn_body::bf16*)(Ob + c * 512 + hh * 128 + hf * 64), (char*)lds_raw);
                }
              } else {
                FRESH_IDS(); unsigned char* const ws = KWS(); float* const outp = KOUT();
                for (int pc = vcu; pc < 256; pc += G)
                  sample_piece(lds, pc, l, Qb, KIN(2), KIN(3), outp + OFF_KS, outp + OFF_VS, OPART, MLP, tid);
              }
              __syncthreads();
            }
            { FRESH_IDS(); unsigned char* const ws = KWS(); float* const outp = KOUT();
              for (int tl = vcu; tl < 264; tl += G)
                poolconv_tile(lds, tl, l, Zb, MIX, KIN(4), KIN(5), pwt, KIN(18), KIN(19), outp + OFF_CP, outp + OFF_CS, tid); }
            GRID_SYNC();
            { FRESH_IDS(); unsigned char* const ws = KWS();
              combine_phase(l, Ob, OPART, MLP, MIX, gw, NGW, lane); }
            GRID_SYNC();
            { FRESH_IDS(); unsigned char* const ws = KWS(); unsigned char* const wl = ws + WS_W + (size_t)l * WL;
              const float* const gn = KIN(21) + l * D; const int nid = step * 2 + 1;
              pg8::Gemm g{MIX, (const bf16*)(wl + W_OUT), MP, D, D}; pg8::StaticOrder S; S.init(MP, D, G, bx);
              skinny_part1<true, D>(lds, MIX + (size_t)MP * D, (const bf16*)(wl + W_OUT), X + (size_t)MP * D, X + (size_t)MP * D, 1.0f, (unsigned*)(ws + WS_SLOTS), CNT(nid, 64), vcu, tid);
              { pg8::Unit u0; const int pm0 = S.next(0, u0) ? u0.pm : 0;
                pg8::EpiResidNorm<true> E{X, X, 1.0f, H, nullptr, gn, (unsigned*)(ws + WS_SLOTP), CNT(nid, pm0)};
                pg8::gemm_phase<pg8::EpiResidNorm<true>, pg8::StaticOrder, false, true>(lds, g, S, E); }
              skinny_part2(lds, H + (size_t)MP * D, nullptr, gn, (unsigned*)(ws + WS_SLOTS), CNT(nid, 64), vcu, tid); }
            GRID_SYNC();
        }
    }
}

extern "C" void kernel_launch(void* const* d_in, const int* in_sizes, int n_in, void* d_out, int out_size, void* d_ws, size_t ws_size, hipStream_t stream) {
    static int grid = 0;
    if (grid == 0) {
        if (n_in != 26 || (size_t)out_size != OUT_TOTAL || ws_size < WS_END) { fprintf(stderr, "kernel_launch: unexpected problem shape: n_in %d out %d ws %zu\n", n_in, out_size, ws_size); grid = -1; return; }
        int dev = 0, cus = 0, per_cu = 0;
        if (hipGetDevice(&dev) != hipSuccess || hipDeviceGetAttribute(&cus, hipDeviceAttributeMultiprocessorCount, dev) != hipSuccess) { grid = -1; return; }
        if (hipFuncSetAttribute((const void*)mega_fwd, hipFuncAttributeMaxDynamicSharedMemorySize, LDS_BYTES) != hipSuccess) { fprintf(stderr, "kernel_launch: hipFuncSetAttribute failed\n"); grid = -1; return; }
        if (hipOccupancyMaxActiveBlocksPerMultiprocessor(&per_cu, (const void*)mega_fwd, NWAVES * 64, LDS_BYTES) != hipSuccess || per_cu < 1) { fprintf(stderr, "kernel_launch: occupancy query says %d\n", per_cu); per_cu = 1; }
        (void)hipGetLastError();
        grid = cus * per_cu;
    }
    if (grid < 0) return;
    if (hipMemsetAsync(d_ws, 0, CTL_BYTES, stream) != hipSuccess) { fprintf(stderr, "kernel_launch: memset failed\n"); return; }
    Params p{};
    for (int i = 0; i < 26; ++i) p.in[i] = (const float*)d_in[i];
    p.out = (float*)d_out; p.ws = (unsigned char*)d_ws;
    void* args[] = {&p};
    const hipError_t e = hipLaunchCooperativeKernel((const void*)mega_fwd, dim3(grid), dim3(NWAVES * 64), args, LDS_BYTES, stream);
    if (e != hipSuccess) fprintf(stderr, "kernel_launch: cooperative launch failed: %s (grid %d)\n", hipGetErrorString(e), grid);
}
```

```cpp
#include <hip/hip_runtime.h>
#include <hip/hip_cooperative_groups.h>
#include <cstdio>
#include <cstdint>
namespace pg8 {
#define PG8_LAS __attribute__((address_space(3)))
typedef unsigned short bf16_t;
typedef short bf16x8 __attribute__((ext_vector_type(8)));
typedef float f32x4 __attribute__((ext_vector_type(4)));
typedef unsigned u32x4 __attribute__((ext_vector_type(4)));
constexpr int BM = 256, BK = 64, HALF = 128, HTB = HALF * BK * 2  , STAGE_BYTES = 8 * HTB, NXCD = 8, WGM = 8;

__host__ __device__ __forceinline__ int lds_byte(int r, int c) { const int st = (r >> 4) * 2 + (c >> 5), rr = r & 15, cc = c & 31, ob = rr * 64 + cc * 2; return st * 1024 + (ob ^ (((ob >> 9) & 1) << 5)); }
__host__ __device__ __forceinline__ void stage_rc(int b, int& R, int& C) { const int st = b / 1024, sb = b % 1024, swz = sb ^ (((sb >> 9) & 1) << 5); R = (st >> 1) * 16 + swz / 64; C = (st & 1) * 32 + (swz % 64) / 2; }
__host__ __device__ __forceinline__ int perm32(int rho) { const int n = rho >> 4, i = rho & 15; return 8 * (i >> 2) + 4 * n + (i & 3); }

struct Unit { int pm, pn; };
struct Gemm { const bf16_t* A; const bf16_t* Bt; int M, N, K; };

struct StaticOrder {
    int nM, nN, nwg, G, c;
    __host__ __device__ __forceinline__ void init(int M, int N, int G_, int c_) { nM = M / BM; nN = N / BM; nwg = nM * nN; G = G_; c = c_; }
    __host__ __device__ __forceinline__ bool next(int i, Unit& u) const {
        const long L = (long)i * G + c; if (L >= nwg) return false;
        int wgid = (int)L; { const int q = nwg / NXCD, r = nwg % NXCD, xcd = wgid % NXCD, off = wgid / NXCD; wgid = (xcd < r ? xcd * (q + 1) : r * (q + 1) + (xcd - r) * q) + off; }
        const int nig = WGM * nN, gid = wgid / nig, fm = gid * WGM, gsz = (nM - fm) < WGM ? (nM - fm) : WGM;
        u.pm = fm + ((wgid % nig) % gsz); u.pn = (wgid % nig) / gsz; return true;
    }
    __device__ __forceinline__ void a_ready(const Unit&) const {}
    __device__ __forceinline__ void done(const Unit&) const {}
};

__device__ __forceinline__ unsigned cvt_pk_bf16(float lo, float hi) { unsigned r; asm volatile("v_cvt_pk_bf16_f32 %0, %1, %2" : "=v"(r) : "v"(lo), "v"(hi)); return r; }
typedef float f32x2 __attribute__((ext_vector_type(2)));
typedef unsigned u32x2 __attribute__((ext_vector_type(2)));
constexpr size_t WOFF_ROPE = (size_t)1 << 20, WOFF_QB = (size_t)215 << 20, WOFF_KB = (size_t)232 << 20, WOFF_VB = (size_t)249 << 20, WOFF_ZB = (size_t)266 << 20;
constexpr size_t OOFF_KP = 17039360, OOFF_VP = 33816576, OOFF_PP = 50593792, OOFF_KS = 50663424, OOFF_VS = 50925568, OOFF_PS = 51187712;
__device__ __forceinline__ float silu_mul(float g, float u) { const float e = __builtin_amdgcn_exp2f(-1.4426950408889634f * g); return g * u * __builtin_amdgcn_rcpf(1.0f + e); }
struct EpiSwiGLU {
    static constexpr bool PERM = true, AFTER_DRAIN = false;
    bf16_t* O; int ldc;
    __device__ __forceinline__ void operator()(const f32x4 (&acc)[2][2][4][2], const Unit& u, int wr, int wc, int fr, int fq) const {
        const int row0 = u.pm * BM + wr * 64 + fr; const int col0 = u.pn * 128 + wc * 32 + 8 * fq;
#pragma unroll
        for (int ai = 0; ai < 2; ++ai)
#pragma unroll
            for (int m = 0; m < 4; ++m) {
                bf16_t* p = O + (size_t)(row0 + ai * HALF + m * 16) * ldc + col0;
                const f32x4 g0 = acc[ai][0][m][0], g1 = acc[ai][0][m][1], u0 = acc[ai][1][m][0], u1 = acc[ai][1][m][1];
                u32x4 w;
                w.x = cvt_pk_bf16(silu_mul(g0[0], u0[0]), silu_mul(g0[1], u0[1])); w.y = cvt_pk_bf16(silu_mul(g0[2], u0[2]), silu_mul(g0[3], u0[3]));
                w.z = cvt_pk_bf16(silu_mul(g1[0], u1[0]), silu_mul(g1[1], u1[1])); w.w = cvt_pk_bf16(silu_mul(g1[2], u1[2]), silu_mul(g1[3], u1[3]));
                *(u32x4*)p = w;
                asm volatile("" ::: "memory");
            }
    }
};
struct EpiResid {
    static constexpr bool PERM = false, AFTER_DRAIN = false;
    const float* baseP; const float* baseS; float* out; float scale;
    __device__ __forceinline__ void operator()(const f32x4 (&acc)[2][2][4][2], const Unit& u, int wr, int wc, int fr, int fq) const {
        const int col0 = u.pn * BM + wc * 32 + 4 * fq;
#pragma unroll
        for (int ai = 0; ai < 2; ++ai)
#pragma unroll
            for (int m = 0; m < 4; ++m) {
                const int row = u.pm * BM + ai * HALF + wr * 64 + m * 16 + fr;
                const float* bp = (row < 16384) ? baseP + (size_t)row * 1024 : baseS + (size_t)(row - 16384) * 1024;
                float* op = out + (size_t)row * 1024;
#pragma unroll
                for (int bj = 0; bj < 2; ++bj)
#pragma unroll
                    for (int n = 0; n < 2; ++n) { const int c = col0 + bj * HALF + n * 16; const f32x4 b = *(const f32x4*)(bp + c); *(f32x4*)(op + c) = b + acc[ai][bj][m][n] * scale; }
                asm volatile("" ::: "memory");
            }
    }
};
constexpr float RMS_EPS = 1e-6f;
__device__ __forceinline__ float rstd_of(float ss) { return 1.0f / sqrtf(ss * (1.0f / 1024.0f) + RMS_EPS); }

#define PG8_RLX_AGENT __ATOMIC_RELAXED, __HIP_MEMORY_SCOPE_AGENT
template <bool BASE16> struct EpiResidNorm {
    static constexpr bool PERM = false, AFTER_DRAIN = true;
    const void* baseP; bf16_t* out; float scale; bf16_t* hb; float* yout; const float* gain; unsigned* slots; unsigned* cnt;
    __device__ __forceinline__ void fused(f32x4 (&acc)[2][2][4][2], const Unit& u, int wr, int wc, int fr, int fq, PG8_LAS unsigned char* lds, int wid, int lane) const {
        PG8_LAS float* P = (PG8_LAS float*)lds;
        PG8_LAS float* S = (PG8_LAS float*)(lds + 4096);
        const int col0 = u.pn * BM + wc * 32 + 4 * fq;
        if (BASE16) {
            u32x2 braw[2][4][2][2];
#pragma unroll
            for (int ai = 0; ai < 2; ++ai)
#pragma unroll
                for (int m = 0; m < 4; ++m) { const size_t ro = (size_t)(u.pm * BM + ai * HALF + wr * 64 + m * 16 + fr) * 1024;
#pragma unroll
                    for (int bj = 0; bj < 2; ++bj)
#pragma unroll
                        for (int n = 0; n < 2; ++n) braw[ai][m][bj][n] = *(const u32x2*)((const bf16_t*)baseP + ro + col0 + bj * HALF + n * 16); }
#pragma unroll
            for (int ai = 0; ai < 2; ++ai)
#pragma unroll
                for (int m = 0; m < 4; ++m)
#pragma unroll
                    for (int bj = 0; bj < 2; ++bj)
#pragma unroll
                        for (int n = 0; n < 2; ++n) { const u32x2 bw = braw[ai][m][bj][n]; f32x4 bv; bv[0] = __builtin_bit_cast(float, bw.x << 16); bv[1] = __builtin_bit_cast(float, bw.x & 0xffff0000u); bv[2] = __builtin_bit_cast(float, bw.y << 16); bv[3] = __builtin_bit_cast(float, bw.y & 0xffff0000u);
                            acc[ai][bj][m][n] = bv + acc[ai][bj][m][n] * scale; }
        }
#pragma unroll
        for (int ai = 0; ai < 2; ++ai)
#pragma unroll
            for (int m = 0; m < 4; ++m) {
                const int rl = ai * HALF + wr * 64 + m * 16 + fr; const size_t ro = (size_t)(u.pm * BM + rl) * 1024;
                float ss = 0.f;
#pragma unroll
                for (int bj = 0; bj < 2; ++bj)
#pragma unroll
                    for (int n = 0; n < 2; ++n) { const int c = col0 + bj * HALF + n * 16; f32x4 v;
                        if (BASE16) v = acc[ai][bj][m][n];
                        else { v = *(const f32x4*)((const float*)baseP + ro + c) + acc[ai][bj][m][n] * scale; acc[ai][bj][m][n] = v; }
                        if (out) { u32x2 w; w.x = cvt_pk_bf16(v[0], v[1]); w.y = cvt_pk_bf16(v[2], v[3]); *(u32x2*)(out + ro + c) = w; }
                        ss += (v[0] * v[0] + v[1] * v[1]) + (v[2] * v[2] + v[3] * v[3]); }
                ss += __builtin_bit_cast(float, __builtin_amdgcn_ds_swizzle(__builtin_bit_cast(int, ss), (16 << 10) | 0x1f));
                { float a = ss, b2 = ss; asm volatile("s_nop 1\n\tv_permlane32_swap_b32 %0, %1\n\ts_nop 1" : "+v"(a), "+v"(b2)); ss = a + b2; }
                if (fq == 0) P[rl * 4 + wc] = ss;
                if (!BASE16 && (m & 1)) asm volatile("" ::: "memory");
            }
        asm volatile("s_waitcnt lgkmcnt(0)\n\ts_barrier" ::: "memory");
        const int t = wid * 64 + lane;
        if (t < 256) { const float s = (P[t * 4] + P[t * 4 + 1]) + (P[t * 4 + 2] + P[t * 4 + 3]);
            __hip_atomic_store(slots + (size_t)(u.pm * BM + t) * 4 + u.pn, __builtin_bit_cast(unsigned, s), PG8_RLX_AGENT); }
        asm volatile("s_waitcnt vmcnt(0)" ::: "memory");
        if (wid < 4 && lane == 0) __hip_atomic_fetch_add(cnt, 1u, PG8_RLX_AGENT);
        if (wid == 0) {
            unsigned spins = 0;
            while ((unsigned)__builtin_amdgcn_readfirstlane(__hip_atomic_load(cnt, PG8_RLX_AGENT)) < 16u) { __builtin_amdgcn_s_sleep(2); if (++spins > (1u << 22)) break; }
            __builtin_amdgcn_fence(__ATOMIC_ACQUIRE, "agent");
        }
        asm volatile("s_waitcnt vmcnt(0) lgkmcnt(0)\n\ts_barrier" ::: "memory");
        if (t < 256) { const unsigned* sl = slots + (size_t)(u.pm * BM + t) * 4; float tot = 0.f;
#pragma unroll
            for (int k = 0; k < 4; ++k) tot += __builtin_bit_cast(float, __hip_atomic_load(sl + k, PG8_RLX_AGENT));
            S[t] = rstd_of(tot); }
        asm volatile("s_waitcnt lgkmcnt(0)\n\ts_barrier" ::: "memory");
        f32x4 g4[2][2];
#pragma unroll
        for (int bj = 0; bj < 2; ++bj)
#pragma unroll
            for (int n = 0; n < 2; ++n) g4[bj][n] = *(const f32x4*)(gain + col0 + bj * HALF + n * 16);
#pragma unroll
        for (int ai = 0; ai < 2; ++ai)
#pragma unroll
            for (int m = 0; m < 4; ++m) {
                const int rl = ai * HALF + wr * 64 + m * 16 + fr; const size_t ro = (size_t)(u.pm * BM + rl) * 1024; const float r = S[rl];
#pragma unroll
                for (int bj = 0; bj < 2; ++bj)
#pragma unroll
                    for (int n = 0; n < 2; ++n) { const int c = col0 + bj * HALF + n * 16; const f32x4 y = acc[ai][bj][m][n] * r * g4[bj][n];
                        if (hb) { u32x2 w; w.x = cvt_pk_bf16(y[0], y[1]); w.y = cvt_pk_bf16(y[2], y[3]); *(u32x2*)(hb + ro + c) = w; }
                        else *(f32x4*)(yout + ro + c) = y; }
            }
        asm volatile("s_waitcnt lgkmcnt(0)\n\ts_barrier" ::: "memory");
    }
};

struct EpiWin {
    static constexpr bool PERM = false, AFTER_DRAIN = false;
    unsigned char* ws; float* outp; int l; float qscale;
    __device__ __forceinline__ void operator()(const f32x4 (&acc)[2][2][4][2], const Unit& u, int wr, int wc, int fr, int fq) const {
        const int pn = u.pn;
        bf16_t* const Qb = (bf16_t*)(ws + WOFF_QB); bf16_t* const Kb = (bf16_t*)(ws + WOFF_KB); bf16_t* const Vb = (bf16_t*)(ws + WOFF_VB); bf16_t* const Zb = (bf16_t*)(ws + WOFF_ZB);
        const float* const rope = (const float*)(ws + WOFF_ROPE);
        float* const kP = outp + OOFF_KP + (size_t)l * 16384 * 512; float* const vP = outp + OOFF_VP + (size_t)l * 16384 * 512;
        float* const kS = outp + OOFF_KS + (size_t)l * 256 * 512; float* const vS = outp + OOFF_VS + (size_t)l * 256 * 512;
        float* const poolP = outp + OOFF_PP + (size_t)l * 8 * 15 * 256; float* const poolS = outp + OOFF_PS + (size_t)l * 8 * 15 * 256;
#pragma unroll
        for (int ai = 0; ai < 2; ++ai)
#pragma unroll
            for (int m = 0; m < 4; ++m) {
                const int row = u.pm * BM + ai * HALF + wr * 64 + m * 16 + fr;
                const bool smp = row >= 16384; const int rs = row - 16384;
                const int prow = smp ? 2048 + (rs & 31) : (row & 2047);
#pragma unroll
                for (int bj = 0; bj < 2; ++bj) {
                    const int dlo = 16 * (wc & 1) + 4 * fq, lc0 = 64 * (2 * bj + (wc >> 1)) + dlo;
                    const f32x4 a0 = acc[ai][bj][m][0], a1 = acc[ai][bj][m][1];
                    if (pn < 4) {
                        const f32x4 cs = *(const f32x4*)(rope + (size_t)prow * 64 + dlo), sn = *(const f32x4*)(rope + (size_t)prow * 64 + 32 + dlo);
                        const f32x4 r0 = a0 * cs - a1 * sn, r1 = a1 * cs + a0 * sn;
                        if (pn < 2) {
                            const int col = 256 * pn + lc0; bf16_t* q = Qb + (size_t)row * 512 + col;
                            u32x2 w0, w1; w0.x = cvt_pk_bf16(r0[0] * qscale, r0[1] * qscale); w0.y = cvt_pk_bf16(r0[2] * qscale, r0[3] * qscale);
                            w1.x = cvt_pk_bf16(r1[0] * qscale, r1[1] * qscale); w1.y = cvt_pk_bf16(r1[2] * qscale, r1[3] * qscale);
                            *(u32x2*)q = w0; *(u32x2*)(q + 32) = w1;
                        } else {
                            const int col = 256 * (pn - 2) + lc0; bf16_t* k = Kb + (size_t)row * 512 + col;
                            float* ko = smp ? kS + (size_t)rs * 512 + col : kP + (size_t)row * 512 + col;
                            *(f32x4*)ko = r0; *(f32x4*)(ko + 32) = r1;
                            u32x2 w0, w1; w0.x = cvt_pk_bf16(r0[0], r0[1]); w0.y = cvt_pk_bf16(r0[2], r0[3]); w1.x = cvt_pk_bf16(r1[0], r1[1]); w1.y = cvt_pk_bf16(r1[2], r1[3]);
                            *(u32x2*)k = w0; *(u32x2*)(k + 32) = w1;
                        }
                    } else if (pn < 6) {
                        const int col = 256 * (pn - 4) + lc0; bf16_t* v = Vb + (size_t)row * 512 + col;
                        float* vo = smp ? vS + (size_t)rs * 512 + col : vP + (size_t)row * 512 + col;
                        *(f32x4*)vo = a0; *(f32x4*)(vo + 32) = a1;
                        u32x2 w0, w1; w0.x = cvt_pk_bf16(a0[0], a0[1]); w0.y = cvt_pk_bf16(a0[2], a0[3]); w1.x = cvt_pk_bf16(a1[0], a1[1]); w1.y = cvt_pk_bf16(a1[2], a1[3]);
                        *(u32x2*)v = w0; *(u32x2*)(v + 32) = w1;
                    } else {
                        const int col = 256 * (pn - 6) + lc0; bf16_t* z = Zb + (size_t)row * 1024 + col;
                        u32x2 w0, w1; w0.x = cvt_pk_bf16(a0[0], a0[1]); w0.y = cvt_pk_bf16(a0[2], a0[3]); w1.x = cvt_pk_bf16(a1[0], a1[1]); w1.y = cvt_pk_bf16(a1[2], a1[3]);
                        *(u32x2*)z = w0; *(u32x2*)(z + 32) = w1;
                        if (pn == 6) {
                            if (smp) { const int b = rs >> 5, t = rs & 31; if (t >= 17) { float* po = poolS + (size_t)(b * 15 + t - 17) * 256 + lc0; *(f32x4*)po = a0; *(f32x4*)(po + 32) = a1; } }
                            else { const int b = row >> 11, t = row & 2047; if (t >= 2033) { float* po = poolP + (size_t)(b * 15 + t - 2033) * 256 + lc0; *(f32x4*)po = a0; *(f32x4*)(po + 32) = a1; } }
                        }
                    }
                }
                asm volatile("" ::: "memory");
            }
    }
};
template <class Epi, class Sched, bool ALIGN_EPI = false, bool SP2 = false>
__device__ __forceinline__ void gemm_phase(PG8_LAS unsigned char* lds, const Gemm g, const Sched& S, const Epi& E) {
    int tid_l = threadIdx.x; asm volatile("" : "+v"(tid_l)); const int tid = tid_l, wid = __builtin_amdgcn_readfirstlane(tid >> 6), lane = tid & 63, wr = wid >> 2, wc = wid & 3, fr = lane & 15, fq = lane >> 4;
    const int K = g.K, nt = K / BK;
    unsigned voffA[2], voffB[2];
#pragma unroll
    for (int i = 0; i < 2; ++i) { int R, C; stage_rc(tid * 16 + i * 8192, R, C); const int Rb = Epi::PERM ? ((R & ~31) + perm32(R & 31)) : R;
        voffA[i] = (unsigned)(R * K + C) * 2u; voffB[i] = (unsigned)(Rb * K + C) * 2u; }
    const size_t kstep = (size_t)(BK * 2);
    const size_t hstep = (size_t)HALF * K * 2;
    const size_t tstep = 2 * hstep;
    const unsigned ldsw = (unsigned)wid * 1024u;
    const int aoff = lds_byte(wr * 64 + fr, fq * 8), boff = lds_byte(wc * 32 + fr, fq * 8);
#define PG8_SA(b, h) (((b) * 2 + (h)) * HTB)
#define PG8_SB(b, h) ((4 + (b) * 2 + (h)) * HTB)
#define PG8_STAGE(bufoff, gbase, voff) do { _Pragma("unroll") for (int _i = 0; _i < 2; ++_i) \
        __builtin_amdgcn_global_load_lds((const unsigned*)((const char*)(gbase) + (voff)[_i]), (PG8_LAS unsigned*)(lds + (bufoff) + ldsw + _i * 8192), 16, 0, 0); } while (0)
#define PG8_LDA(dst, b, h) do { _Pragma("unroll") for (int m = 0; m < 4; ++m) _Pragma("unroll") for (int k = 0; k < 2; ++k) dst[m][k] = *(const PG8_LAS bf16x8*)(lds + PG8_SA(b, h) + aoff + m * 2048 + k * 1024); } while (0)
#define PG8_LDB(dst, b, h) do { _Pragma("unroll") for (int n = 0; n < 2; ++n) _Pragma("unroll") for (int k = 0; k < 2; ++k) dst[n][k] = *(const PG8_LAS bf16x8*)(lds + PG8_SB(b, h) + boff + n * 2048 + k * 1024); } while (0)
#define PG8_MMA(ai, bj, At, Bt) do { __builtin_amdgcn_s_setprio(1); _Pragma("unroll") for (int m = 0; m < 4; ++m) _Pragma("unroll") for (int n = 0; n < 2; ++n) _Pragma("unroll") for (int k = 0; k < 2; ++k) \
        acc[ai][bj][m][n] = __builtin_amdgcn_mfma_f32_16x16x32_bf16(Bt[n][k], At[m][k], acc[ai][bj][m][n], 0, 0, 0); __builtin_amdgcn_s_setprio(0); } while (0)
#define PG8_WAIT_V(n) asm volatile("s_waitcnt vmcnt(" #n ")" ::: "memory")
#define PG8_WAIT_L(n) asm volatile("s_waitcnt lgkmcnt(" #n ")" ::: "memory")
#define PG8_BAR __builtin_amdgcn_s_barrier()
#define PG8_SCHED __builtin_amdgcn_sched_barrier(0)
    Unit cur, nxt; int ui = 0;
    if (!S.next(0, cur)) return;
    f32x4 acc[2][2][4][2];
#pragma unroll
    for (int a = 0; a < 2; ++a)
#pragma unroll
        for (int b = 0; b < 2; ++b)
#pragma unroll
            for (int m = 0; m < 4; ++m)
#pragma unroll
                for (int n = 0; n < 2; ++n) acc[a][b][m][n] = (f32x4){0.f, 0.f, 0.f, 0.f};
    bf16x8 At[4][2], B0[2][2], B1[2][2];
    const char* cA = (const char*)g.A + (size_t)cur.pm * tstep; const char* cB = (const char*)g.Bt + (size_t)cur.pn * tstep;
    S.a_ready(cur);
    if constexpr (SP2) {
        PG8_STAGE(PG8_SB(0, 0), cB, voffB); PG8_STAGE(PG8_SB(0, 1), cB + hstep, voffB); PG8_STAGE(PG8_SA(0, 0), cA, voffA); PG8_STAGE(PG8_SA(0, 1), cA + hstep, voffA);
        if (wr == 1) PG8_BAR;
        PG8_WAIT_V(2); PG8_BAR;
        PG8_STAGE(PG8_SB(1, 0), cB + kstep, voffB); PG8_STAGE(PG8_SA(1, 0), cA + kstep, voffA); PG8_STAGE(PG8_SB(1, 1), cB + hstep + kstep, voffB);
        PG8_WAIT_V(6); PG8_BAR;
    } else {
        PG8_STAGE(PG8_SB(0, 0), cB, voffB); PG8_STAGE(PG8_SA(0, 0), cA, voffA); PG8_STAGE(PG8_SB(0, 1), cB + hstep, voffB); PG8_STAGE(PG8_SA(0, 1), cA + hstep, voffA);
        if (wr == 1) PG8_BAR;
        PG8_WAIT_V(4); PG8_BAR;
        PG8_STAGE(PG8_SB(1, 0), cB + kstep, voffB); PG8_STAGE(PG8_SA(1, 0), cA + kstep, voffA); PG8_STAGE(PG8_SB(1, 1), cB + hstep + kstep, voffB);
        PG8_WAIT_V(6); PG8_BAR;
    }
    for (;;) {
        const bool has_next = S.next(ui + 1, nxt);
        const char* nA = has_next ? (const char*)g.A + (size_t)nxt.pm * tstep : cA; const char* nB = has_next ? (const char*)g.Bt + (size_t)nxt.pn * tstep : cB;
        for (int t = 0; t < nt; t += 2) {
            const bool last = (t == nt - 2);
            const char* a1 = cA + (size_t)(t + 1) * kstep;
            const char* a2 = last ? nA : cA + (size_t)(t + 2) * kstep; const char* b2 = last ? nB : cB + (size_t)(t + 2) * kstep;
            const char* a3 = a2 + kstep; const char* b3 = b2 + kstep;
            if (last && has_next) S.a_ready(nxt);
            if constexpr (SP2) {
            PG8_LDB(B0, 0, 0); PG8_LDB(B1, 0, 1); PG8_SCHED; PG8_LDA(At, 0, 0); PG8_STAGE(PG8_SA(1, 1), a1 + hstep, voffA);
            PG8_WAIT_V(8); PG8_WAIT_L(0); PG8_BAR; PG8_MMA(0, 0, At, B0); PG8_MMA(0, 1, At, B1); PG8_BAR; PG8_SCHED;
            PG8_LDA(At, 0, 1); PG8_STAGE(PG8_SB(0, 0), b2, voffB); PG8_STAGE(PG8_SB(0, 1), b2 + hstep, voffB); PG8_STAGE(PG8_SA(0, 0), a2, voffA);
            PG8_WAIT_V(8); PG8_WAIT_L(0); PG8_BAR; PG8_MMA(1, 0, At, B0); PG8_MMA(1, 1, At, B1); PG8_BAR; PG8_SCHED;
            PG8_LDB(B0, 1, 0); PG8_LDB(B1, 1, 1); PG8_SCHED; PG8_LDA(At, 1, 0); PG8_STAGE(PG8_SA(0, 1), a2 + hstep, voffA);
            PG8_WAIT_V(8); PG8_WAIT_L(0); PG8_BAR; PG8_MMA(0, 0, At, B0); PG8_MMA(0, 1, At, B1); PG8_BAR; PG8_SCHED;
            PG8_LDA(At, 1, 1); PG8_STAGE(PG8_SB(1, 0), b3, voffB); PG8_STAGE(PG8_SB(1, 1), b3 + hstep, voffB); PG8_STAGE(PG8_SA(1, 0), a3, voffA);
            PG8_WAIT_V(8); PG8_WAIT_L(0); PG8_BAR; PG8_MMA(1, 0, At, B0); PG8_MMA(1, 1, At, B1); PG8_BAR; PG8_SCHED;
            } else {
            PG8_LDB(B0, 0, 0); PG8_SCHED; PG8_LDA(At, 0, 0); PG8_STAGE(PG8_SA(1, 1), a1 + hstep, voffA);
            PG8_WAIT_L(8); PG8_BAR; PG8_WAIT_L(0); PG8_MMA(0, 0, At, B0); PG8_BAR; PG8_SCHED;
            PG8_LDB(B1, 0, 1); PG8_STAGE(PG8_SB(0, 0), b2, voffB);
            PG8_BAR; PG8_WAIT_L(0); PG8_MMA(0, 1, At, B1); PG8_BAR;
            PG8_LDA(At, 0, 1); PG8_STAGE(PG8_SA(0, 0), a2, voffA);
            PG8_BAR; PG8_WAIT_L(0); PG8_MMA(1, 0, At, B0); PG8_BAR; PG8_SCHED;
            PG8_STAGE(PG8_SB(0, 1), b2 + hstep, voffB);
            PG8_WAIT_V(6); PG8_BAR; PG8_MMA(1, 1, At, B1); PG8_BAR;
            PG8_LDB(B0, 1, 0); PG8_SCHED; PG8_LDA(At, 1, 0); PG8_STAGE(PG8_SA(0, 1), a2 + hstep, voffA);
            PG8_WAIT_L(8); PG8_BAR; PG8_WAIT_L(0); PG8_MMA(0, 0, At, B0); PG8_BAR; PG8_SCHED;
            PG8_LDB(B1, 1, 1); PG8_STAGE(PG8_SB(1, 0), b3, voffB);
            PG8_BAR; PG8_WAIT_L(0); PG8_MMA(0, 1, At, B1); PG8_BAR;
            PG8_LDA(At, 1, 1); PG8_STAGE(PG8_SA(1, 0), a3, voffA);
            PG8_BAR; PG8_WAIT_L(0); PG8_MMA(1, 0, At, B0); PG8_BAR; PG8_SCHED;
            PG8_STAGE(PG8_SB(1, 1), b3 + hstep, voffB);
            PG8_WAIT_V(6); PG8_BAR; PG8_MMA(1, 1, At, B1); PG8_BAR;
            }
        }
        if constexpr (ALIGN_EPI) { if (wr == 0) PG8_BAR; }
        if constexpr (!Epi::AFTER_DRAIN) { E(acc, cur, wr, wc, fr, fq); S.done(cur); }
        if (!has_next) break;
#pragma unroll
        for (int a = 0; a < 2; ++a)
#pragma unroll
            for (int b = 0; b < 2; ++b)
#pragma unroll
                for (int m = 0; m < 4; ++m)
#pragma unroll
                    for (int n = 0; n < 2; ++n) acc[a][b][m][n] = (f32x4){0.f, 0.f, 0.f, 0.f};
        cur = nxt; cA = nA; cB = nB; ++ui;
        if constexpr (ALIGN_EPI) { if (wr == 1) PG8_BAR; }
    }
    PG8_WAIT_V(0);
    if constexpr (!ALIGN_EPI) { if (wr == 0) PG8_BAR; }
    PG8_BAR;
    if constexpr (Epi::AFTER_DRAIN) { E.fused(acc, cur, wr, wc, fr, fq, lds, wid, lane); S.done(cur); }
#undef PG8_SA
#undef PG8_SB
#undef PG8_STAGE
#undef PG8_LDA
#undef PG8_LDB
#undef PG8_MMA
#undef PG8_WAIT_V
#undef PG8_WAIT_L
#undef PG8_BAR
#undef PG8_SCHED
}
}
#include <hip/hip_bf16.h>
#include <cmath>
namespace attn_body {
using bf16=__hip_bfloat16;
using bf16x8=__attribute__((ext_vector_type(8)))short;
using s16x4=__attribute__((ext_vector_type(4)))short;
using f32x16=__attribute__((ext_vector_type(16)))float;
using u32x4=__attribute__((ext_vector_type(4)))unsigned;
constexpr int BATCH=8,NHEAD=16,SEQ=2048,D=64,PQK=512,PO=1024;
constexpr int NW=8,QBLK=32,QB=QBLK*NW,KVBLK=64,NQB=SEQ/QB;
constexpr int ATTN_UNIT_ROWS=QB;
__device__ __forceinline__ int crow(int r,int hi){return (r&3)+8*(r>>2)+4*hi;}
#define SBAR() __builtin_amdgcn_sched_barrier(0)
__device__ __forceinline__ void cmask(f32x16&p0,f32x16&p1,int jb,int qrel,int hi){
  const float NEG=-INFINITY; (void)hi;
  if(jb>(qrel>>6)){
  #pragma unroll
  for(int r=0;r<16;++r){p0[r]=NEG;p1[r]=NEG;}}
}

constexpr int NSLOT=3, SLOTB=8192;
constexpr int LDS_K=0, LDS_V=NSLOT*SLOTB, LDS_WS=2*NSLOT*SLOTB, LDS_OST=LDS_WS+NW*64*4, LDS_BYTES=LDS_OST+NW*4096;
constexpr float C2=0.125f*1.4426950408889634f;
__device__ __forceinline__ void glds16(const void*gsrc,unsigned lds_dst){unsigned keep;
  asm volatile("s_mov_b32 %0, m0\n\ts_mov_b32 m0, %2\n\ts_nop 0\n\tglobal_load_lds_dwordx4 %1, off\n\ts_mov_b32 m0, %0":"=&s"(keep):"v"(gsrc),"s"(lds_dst):"memory");}
__device__ __forceinline__ float max3f(float a,float b,float c){float r;asm("v_max3_f32 %0, %1, %2, %3":"=v"(r):"v"(a),"v"(b),"v"(c));return r;}
__device__ __forceinline__ float max2f(float a,float b){float r;asm("v_max_f32_e32 %0, %1, %2":"=v"(r):"v"(a),"v"(b));return r;}
__device__ __forceinline__ float fadd_s(float a,float b){float r;asm("v_add_f32_e32 %0, %1, %2":"=v"(r):"v"(a),"v"(b));return r;}
__device__ __forceinline__ float fsub_s(float a,float b){float r;asm("v_sub_f32_e32 %0, %1, %2":"=v"(r):"v"(a),"v"(b));return r;}
typedef float f32x2_t __attribute__((ext_vector_type(2))); typedef __bf16 bf16x2_t __attribute__((ext_vector_type(2)));
__device__ __forceinline__ unsigned cvtpk_s(float lo,float hi){f32x2_t v={lo,hi};bf16x2_t b=__builtin_convertvector(v,bf16x2_t);return __builtin_bit_cast(unsigned,b);}
#define WAIT_BAR(N) asm volatile("s_waitcnt vmcnt(" #N ") lgkmcnt(0)\n\ts_barrier":::"memory")

__device__ __forceinline__ void qkt(f32x16&p0,f32x16&p1,const char*Kslot,const bf16x8*qr,const f32x16&negm,int r32,int hi){
  const char*kb=Kslot+hi*1024+r32*16;
  #pragma unroll
  for(int d0=0;d0<4;++d0){
    const bf16x8 b0=*reinterpret_cast<const bf16x8*>(kb+d0*2048);
    const bf16x8 b1=*reinterpret_cast<const bf16x8*>(kb+d0*2048+512);
    if(d0==0){p0=__builtin_amdgcn_mfma_f32_32x32x16_bf16(b0,qr[0],negm,0,0,0);p1=__builtin_amdgcn_mfma_f32_32x32x16_bf16(b1,qr[0],negm,0,0,0);}
    else{p0=__builtin_amdgcn_mfma_f32_32x32x16_bf16(b0,qr[d0],p0,0,0,0);p1=__builtin_amdgcn_mfma_f32_32x32x16_bf16(b1,qr[d0],p1,0,0,0);}}
}
typedef __attribute__((address_space(3))) const char* lds_cptr;
typedef short v4i16_t __attribute__((ext_vector_type(4)));
__device__ __forceinline__ void kload8(bf16x8*kf,lds_cptr kp){
  kf[0]=*(const __attribute__((address_space(3))) bf16x8*)(kp);      kf[1]=*(const __attribute__((address_space(3))) bf16x8*)(kp+512);
  kf[2]=*(const __attribute__((address_space(3))) bf16x8*)(kp+2048); kf[3]=*(const __attribute__((address_space(3))) bf16x8*)(kp+2560);
  kf[4]=*(const __attribute__((address_space(3))) bf16x8*)(kp+4096); kf[5]=*(const __attribute__((address_space(3))) bf16x8*)(kp+4608);
  kf[6]=*(const __attribute__((address_space(3))) bf16x8*)(kp+6144); kf[7]=*(const __attribute__((address_space(3))) bf16x8*)(kp+6656);
}
__device__ __forceinline__ void kload2(bf16x8*kf,lds_cptr kp,int j){ kf[2*j]=*(const __attribute__((address_space(3))) bf16x8*)(kp+j*2048); kf[2*j+1]=*(const __attribute__((address_space(3))) bf16x8*)(kp+j*2048+512); }
__device__ __forceinline__ s16x4 vtr(lds_cptr p){ return __builtin_bit_cast(s16x4,__builtin_amdgcn_ds_read_tr16_b64_v4i16((__attribute__((address_space(3))) v4i16_t*)p)); }
__device__ __forceinline__ float rowmax(const f32x16&p0,const f32x16&p1){
  float a=max3f(p0[0],p0[1],p1[0]),b=max3f(p0[2],p0[3],p1[1]);a=max3f(a,p1[2],p1[3]);
  #pragma unroll
  for(int r=4;r<16;r+=4){a=max3f(a,p0[r],p0[r+1]);b=max3f(b,p0[r+2],p0[r+3]);a=max3f(a,p1[r],p1[r+1]);b=max3f(b,p1[r+2],p1[r+3]);}
  const float m=max2f(a,b);
  auto rr=__builtin_amdgcn_permlane32_swap(__float_as_uint(m),__float_as_uint(m),false,false);
  return max2f(__uint_as_float(rr[0]),__uint_as_float(rr[1]));
}
__device__ __forceinline__ void pv(f32x16*o,int vb,bf16x8 pa0,bf16x8 pa1,bf16x8 pa2,bf16x8 pa3){
  #pragma unroll
  for(int d0=0;d0<2;++d0){s16x4 lo[4],hi[4];
    #pragma unroll
    for(int ks=0;ks<4;++ks){
      asm volatile("ds_read_b64_tr_b16 %0,%1 offset:%c2":"=&v"(lo[ks]):"v"(vb),"i"(d0*4096+ks*1024):"memory");
      asm volatile("ds_read_b64_tr_b16 %0,%1 offset:%c2":"=&v"(hi[ks]):"v"(vb),"i"(d0*4096+ks*1024+512):"memory");}
    asm volatile("s_waitcnt lgkmcnt(0)":::"memory");SBAR();
    #define PK(k) (bf16x8){lo[k][0],lo[k][1],lo[k][2],lo[k][3],hi[k][0],hi[k][1],hi[k][2],hi[k][3]}
    o[d0]=__builtin_amdgcn_mfma_f32_32x32x16_bf16(pa0,PK(0),o[d0],0,0,0);
    o[d0]=__builtin_amdgcn_mfma_f32_32x32x16_bf16(pa1,PK(1),o[d0],0,0,0);
    o[d0]=__builtin_amdgcn_mfma_f32_32x32x16_bf16(pa2,PK(2),o[d0],0,0,0);
    o[d0]=__builtin_amdgcn_mfma_f32_32x32x16_bf16(pa3,PK(3),o[d0],0,0,0);
    #undef PK
  }
}

#ifndef ATTN_STORE16
#define ATTN_STORE16(p,v) (*(u32x4*)(p)=(v))
#endif
template<int THRL> __device__ __forceinline__ void attn_unit(int b,int qb,const bf16*Q,const bf16*__restrict__ K,const bf16*__restrict__ V,bf16*O,char*shm){
  int tid_l=threadIdx.x; asm volatile("":"+v"(tid_l)); const int tid=tid_l,lane=tid&63,r32=lane&31,hi=lane>>5; const int wid=__builtin_amdgcn_readfirstlane(tid>>6);
  const long rowbase=(long)b*SEQ; const int q0=qb*QB;
  const bf16*Qw=Q+(rowbase+q0+wid*QBLK)*PQK;
  const bf16*Kh=K+rowbase*PQK,*Vh=V+rowbase*PQK;
  const unsigned lds0=(unsigned)(uintptr_t)shm;
  float*wsf=(float*)(shm+LDS_WS)+wid*64;
  const bf16*ksrc=Kh+(long)lane*PQK+wid*8;
  const bf16*vsrc=Vh+(long)(16*(wid&3)+(lane>>2))*PQK+(wid>>2)*32+(lane&3)*8;
  const unsigned kdst=lds0+LDS_K+wid*1024, vdst=lds0+LDS_V+wid*1024;
  #define DMA_K(t,slot) glds16(ksrc+(long)(t)*KVBLK*PQK,(unsigned)__builtin_amdgcn_readfirstlane(kdst+(slot)))
  #define DMA_V(t,slot) glds16(vsrc+(long)(t)*KVBLK*PQK,(unsigned)__builtin_amdgcn_readfirstlane(vdst+(slot)))
  const int vb0=(int)(lds0+LDS_V)+((lane>>4)&1)*32+(lane&3)*8+(4*hi+((lane&15)>>2))*64;
  const char*Kbase=shm+LDS_K; bf16x8 kf[8];
  const lds_cptr shm3=(lds_cptr)shm; const lds_cptr kp0=shm3+LDS_K+hi*1024+r32*16; const lds_cptr vp0=shm3+LDS_V+((lane>>4)&1)*32+(lane&3)*8+(4*hi+((lane&15)>>2))*64;
  const int NT=(q0+QB)/KVBLK;
  DMA_K(0,0);DMA_V(0,0);DMA_K(1,SLOTB);
  bf16x8 qr[4];
  #pragma unroll
  for(int d0=0;d0<4;++d0)qr[d0]=*reinterpret_cast<const bf16x8*>(&Qw[(long)r32*PQK+d0*16+hi*8]);
  float mhat=0.f,l_reg=0.f;f32x16 o[2];o[0]=f32x16{};o[1]=f32x16{};f32x16 negm=f32x16{};asm volatile("":"+v"(negm));
  const int qrel=wid*QBLK+r32;
  #define CMASK(P0,P1,t) do{int jb_=(t)-(NT-4); if(jb_>=0)cmask(P0,P1,jb_,qrel,hi);}while(0)
  bool resc=false;
  #define START(P0,P1) do{ const float rm=rowmax(P0,P1); resc=false; \
    { const float dl=rm; mhat=fadd_s(mhat,dl); \
      _Pragma("unroll") for(int r=0;r<16;++r){P0[r]=fsub_s(P0[r],dl);P1[r]=fsub_s(P1[r],dl);} \
      _Pragma("unroll") for(int r=0;r<16;++r)negm[r]=-mhat; asm volatile("":"+v"(negm)); } \
    _Pragma("unroll") for(int r=0;r<16;++r)P0[r]=__builtin_amdgcn_exp2f(P0[r]); }while(0)
  #define RESC() do{ if(resc){ asm volatile("s_waitcnt lgkmcnt(0)":::"memory"); \
      _Pragma("unroll") for(int d_=0;d_<2;++d_) _Pragma("unroll") for(int r=0;r<16;++r)o[d_][r]*=wsf[crow(r,hi)]; } }while(0)
  f32x16 pA0,pA1,pB0,pB1;
  int sl_prev=0,sl_cur=0,sl_next=SLOTB;
  #define ROT() do{sl_prev=sl_cur;sl_cur=sl_next;sl_next=(sl_next==(NSLOT-1)*SLOTB)?0:sl_next+SLOTB;}while(0)
  DMA_K(2,2*SLOTB);
  WAIT_BAR(3);
  qkt(pA0,pA1,Kbase,qr,negm,r32,hi);asm volatile("s_nop 15\n\ts_nop 7":"+v"(pA0),"+v"(pA1));CMASK(pA0,pA1,0);
  START(pA0,pA1);
  _Pragma("unroll") for(int r=0;r<16;++r)pA1[r]=__builtin_amdgcn_exp2f(pA1[r]);
  WAIT_BAR(0);
  DMA_K(3,0);DMA_V(1,SLOTB);
  ROT();
  kload8(kf,kp0+sl_cur);
  WAIT_BAR(2);
  s16x4 vlo[8],vhi[8]; u32x4 pw0,pw1,pw2,pw3;
  #define PKW(P,B) cvtpk_s(P[B],P[B+1])
  #define PAF(k) __builtin_bit_cast(bf16x8,pw##k)
  #define VFR(i) (bf16x8){vlo[i][0],vlo[i][1],vlo[i][2],vlo[i][3],vhi[i][0],vhi[i][1],vhi[i][2],vhi[i][3]}
  #define PIN(x) asm volatile("":"+v"(x))
  #define MX3(a,b,c) __builtin_fmaxf(__builtin_fmaxf((a),(b)),(c))
  #define GAPA(MF,A0,A1,A2,A3,W0,W1,PW) do{ MF; sacc+=A0; sacc+=A1; sacc+=A2; sacc+=A3; PIN(sacc); W0; W1; PIN(PW); SBAR(); }while(0)
  #define EX(v) __builtin_amdgcn_exp2f(v)
  #define GAPB(MF,X,B) do{ MF; X[B]=EX(X[B]); X[B+1]=EX(X[B+1]); X[B+2]=EX(X[B+2]); X[B+3]=EX(X[B+3]); PIN(X); SBAR(); }while(0)
  #define VRD(i) do{ vlo[i]=vtr(vp_+(((i)>>2)*4096+((i)&3)*1024)); vhi[i]=vtr(vp_+(((i)>>2)*4096+((i)&3)*1024+512)); }while(0)
  #define KRD(G,j) do{ if(G){ kload2(kf,kp0+sl_next,j); SBAR(); } }while(0)
  #define STEP(C0,C1,P0,P1,t,GK,GV,GL) do{ SBAR(); \
    const lds_cptr vp_=vp0+sl_prev; \
    VRD(0); SBAR(); float sacc=(P0[0]+P0[1]); \
    GAPA(C0=__builtin_amdgcn_mfma_f32_32x32x16_bf16(kf[0],qr[0],negm,0,0,0), P0[2],P0[3],P0[4],P0[5],     pw0[0]=PKW(P0,0), pw0[1]=PKW(P0,2), pw0); \
    VRD(4); SBAR(); GAPA(C1=__builtin_amdgcn_mfma_f32_32x32x16_bf16(kf[1],qr[0],negm,0,0,0), P0[6],P0[7],P0[8],P0[9],     pw0[2]=PKW(P0,4), pw0[3]=PKW(P0,6), pw0); \
    VRD(1); SBAR(); GAPA(C0=__builtin_amdgcn_mfma_f32_32x32x16_bf16(kf[2],qr[1],C0,0,0,0),   P0[10],P0[11],P0[12],P0[13], pw1[0]=PKW(P0,8), pw1[1]=PKW(P0,10), pw1); \
    VRD(5); SBAR(); GAPA(C1=__builtin_amdgcn_mfma_f32_32x32x16_bf16(kf[3],qr[1],C1,0,0,0),   P0[14],P0[15],P1[0],P1[1],   pw1[2]=PKW(P0,12),pw1[3]=PKW(P0,14), pw1); \
    VRD(2); SBAR(); GAPA(C0=__builtin_amdgcn_mfma_f32_32x32x16_bf16(kf[4],qr[2],C0,0,0,0),   P1[2],P1[3],P1[4],P1[5],     pw2[0]=PKW(P1,0), pw2[1]=PKW(P1,2), pw2); \
    VRD(6); SBAR(); GAPA(C1=__builtin_amdgcn_mfma_f32_32x32x16_bf16(kf[5],qr[2],C1,0,0,0),   P1[6],P1[7],P1[8],P1[9],     pw2[2]=PKW(P1,4), pw2[3]=PKW(P1,6), pw2); \
    VRD(3); SBAR(); GAPA(C0=__builtin_amdgcn_mfma_f32_32x32x16_bf16(kf[6],qr[3],C0,0,0,0),   P1[10],P1[11],P1[12],P1[13], pw3[0]=PKW(P1,8), pw3[1]=PKW(P1,10), pw3); \
    VRD(7); SBAR(); GAPA(C1=__builtin_amdgcn_mfma_f32_32x32x16_bf16(kf[7],qr[3],C1,0,0,0),   P1[14],P1[15],0.f,0.f,       pw3[2]=PKW(P1,12),pw3[3]=PKW(P1,14), pw3); \
    l_reg+=sacc; \
    if(GK){DMA_K((t)+3,sl_cur);} if(GV){DMA_V((t)+1,sl_next);} \
    CMASK(C0,C1,t); \
    { float a=MX3(C0[0],C0[1],C1[0]),b=MX3(C0[2],C0[3],C1[1]); a=MX3(a,C1[2],C1[3]); \
      _Pragma("unroll") for(int r=4;r<16;r+=4){a=MX3(a,C0[r],C0[r+1]);b=MX3(b,C0[r+2],C0[r+3]);a=MX3(a,C1[r],C1[r+1]);b=MX3(b,C1[r+2],C1[r+3]);} \
      float rm=__builtin_fmaxf(a,b); { auto rr=__builtin_amdgcn_permlane32_swap(__float_as_uint(rm),__float_as_uint(rm),false,false); rm=__builtin_fmaxf(__uint_as_float(rr[0]),__uint_as_float(rr[1])); } \
      resc=false; \
      if(__builtin_expect(__any(rm>(float)THRL),0)){ const float dl=__builtin_fmaxf(rm,0.f); mhat+=dl; \
        _Pragma("unroll") for(int r=0;r<16;++r){C0[r]-=dl;C1[r]-=dl;} \
        _Pragma("unroll") for(int r=0;r<16;++r)negm[r]=-mhat; asm volatile("":"+v"(negm)); \
        const float f=__builtin_amdgcn_exp2f(-dl); l_reg*=f; if(hi==0)wsf[r32]=f; resc=true; } } \
    SBAR(); \
    GAPB(o[0]=__builtin_amdgcn_mfma_f32_32x32x16_bf16(PAF(0),VFR(0),o[0],0,0,0), C0,0); \
    GAPB(o[1]=__builtin_amdgcn_mfma_f32_32x32x16_bf16(PAF(0),VFR(4),o[1],0,0,0), C0,4); \
    KRD(GL,0); GAPB(o[0]=__builtin_amdgcn_mfma_f32_32x32x16_bf16(PAF(1),VFR(1),o[0],0,0,0), C0,8); \
    KRD(GL,1); GAPB(o[1]=__builtin_amdgcn_mfma_f32_32x32x16_bf16(PAF(1),VFR(5),o[1],0,0,0), C0,12); \
    KRD(GL,2); GAPB(o[0]=__builtin_amdgcn_mfma_f32_32x32x16_bf16(PAF(2),VFR(2),o[0],0,0,0), C1,0); \
    KRD(GL,3); GAPB(o[1]=__builtin_amdgcn_mfma_f32_32x32x16_bf16(PAF(2),VFR(6),o[1],0,0,0), C1,4); \
    GAPB(o[0]=__builtin_amdgcn_mfma_f32_32x32x16_bf16(PAF(3),VFR(3),o[0],0,0,0), C1,8); \
    GAPB(o[1]=__builtin_amdgcn_mfma_f32_32x32x16_bf16(PAF(3),VFR(7),o[1],0,0,0), C1,12); \
    }while(0)
  int t=1;
  #undef CMASK
  #define CMASK(P0,P1,t) do{}while(0)
  for(;t+5<NT;t+=2){
    STEP(pB0,pB1,pA0,pA1,t,true,true,true);     WAIT_BAR(2); RESC(); ROT();
    STEP(pA0,pA1,pB0,pB1,t+1,true,true,true);   WAIT_BAR(2); RESC(); ROT();
  }
  #undef CMASK
  #define CMASK(P0,P1,t) do{int jb_=(t)-(NT-4); if(jb_>=0)cmask(P0,P1,jb_,qrel,hi);}while(0)
  #define ENDW(tt) do{ if((tt)+3<NT){WAIT_BAR(2);} else if((tt)+2<NT){WAIT_BAR(1);} else {WAIT_BAR(0);} }while(0)
  for(;t+1<NT;t+=2){
    STEP(pB0,pB1,pA0,pA1,t,(t+3<NT),(t+1<NT),(t+1<NT));       ENDW(t);   RESC(); ROT();
    STEP(pA0,pA1,pB0,pB1,t+1,(t+4<NT),(t+2<NT),(t+2<NT));     ENDW(t+1); RESC(); ROT();
  }
  STEP(pB0,pB1,pA0,pA1,NT-1,false,false,false); RESC();
  { float sacc=pB0[0]+pB0[1]; _Pragma("unroll") for(int r=2;r<16;++r)sacc+=pB0[r]; _Pragma("unroll") for(int r=0;r<16;++r)sacc+=pB1[r]; l_reg+=sacc;
    pw0=(u32x4){PKW(pB0,0),PKW(pB0,2),PKW(pB0,4),PKW(pB0,6)};pw1=(u32x4){PKW(pB0,8),PKW(pB0,10),PKW(pB0,12),PKW(pB0,14)};pw2=(u32x4){PKW(pB1,0),PKW(pB1,2),PKW(pB1,4),PKW(pB1,6)};pw3=(u32x4){PKW(pB1,8),PKW(pB1,10),PKW(pB1,12),PKW(pB1,14)};
    SBAR(); pv(o,vb0+sl_cur,PAF(0),PAF(1),PAF(2),PAF(3)); }
  #undef PKW
  #undef PAF
  #undef VFR
  #undef PIN
  #undef MX3
  #undef GAPA
  #undef GAPB
  #undef EX
  #undef VRD
  #undef KRD
  #undef STEP
  #undef ENDW
  {auto rr=__builtin_amdgcn_permlane32_swap(__float_as_uint(l_reg),__float_as_uint(l_reg),false,false);l_reg=__uint_as_float(rr[0])+__uint_as_float(rr[1]);}
  if(hi==0)wsf[32+r32]=l_reg;asm volatile("s_waitcnt lgkmcnt(0)":::"memory");
  float rli[16];
  #pragma unroll
  for(int r=0;r<16;++r)rli[r]=__builtin_amdgcn_rcpf(wsf[32+crow(r,hi)]);
  bf16*Ow=O+(rowbase+q0+wid*QBLK)*PO;
  { bf16*stg=(bf16*)(shm+LDS_OST)+wid*2048;
    #pragma unroll
    for(int r=0;r<16;++r){const int orow=crow(r,hi);
      #pragma unroll
      for(int d0=0;d0<2;++d0)stg[orow*64+d0*32+r32]=__float2bfloat16(o[d0][r]*rli[r]);}
    asm volatile("s_waitcnt lgkmcnt(0)":::"memory");
    #pragma unroll
    for(int i=0;i<4;++i){const int row=i*8+(lane>>3),ch=lane&7; const u32x4 v=*(const u32x4*)(stg+row*64+ch*8); ATTN_STORE16(Ow+(long)row*PO+ch*8,v);} }
  asm volatile("s_waitcnt lgkmcnt(0)\n\ts_barrier":::"memory");
  #undef DMA_K
  #undef DMA_V
  #undef CMASK
  #undef START
  #undef RESC
  #undef ROT
}
#undef SBAR
#undef WAIT_BAR
}
namespace cg = cooperative_groups;
#define LAS __attribute__((address_space(3)))
typedef unsigned short bf16;
typedef unsigned v4u __attribute__((ext_vector_type(4)));
typedef unsigned v2u __attribute__((ext_vector_type(2)));
typedef float f32x4 __attribute__((ext_vector_type(4)));
typedef float f32x2 __attribute__((ext_vector_type(2)));
typedef float f32x16 __attribute__((ext_vector_type(16)));
typedef short bf16x8 __attribute__((ext_vector_type(8)));

constexpr int NWAVES = 8;
constexpr int D = 1024, MP = 16384, MS = 256, M = MP + MS, FF = 2816, DIN = 2560;
constexpr float EPS = 1e-6f;
constexpr float C2 = 0.125f * 1.4426950408889634f;
constexpr size_t OFF_Y = 0, OFF_KP = 17039360, OFF_VP = 33816576, OFF_PP = 50593792, OFF_CP = 50655232, OFF_KS = 50663424, OFF_VS = 50925568, OFF_PS = 51187712, OFF_CS = 51249152, OUT_TOTAL = 51257344;
constexpr size_t MiB = 1u << 20;
constexpr size_t WS_ROPE = 1 * MiB, WS_POOLWT = 2 * MiB, WS_W = 4 * MiB, WL = 40 * MiB;
constexpr size_t W_GU1 = 0, W_D1 = 11 * MiB, W_IN = 16 * MiB + MiB / 2, W_OUT = 21 * MiB + MiB / 2, W_GU2 = 23 * MiB + MiB / 2, W_D2 = 34 * MiB + MiB / 2;
constexpr size_t WS_X = 84 * MiB, WS_H = 149 * MiB, WS_MIX = 182 * MiB, WS_ACT = 215 * MiB;
constexpr size_t WS_QB = 215 * MiB, WS_KB = 232 * MiB, WS_VB = 249 * MiB, WS_ZB = 266 * MiB;
constexpr size_t WS_OB = 305 * MiB, WS_OPART = 338 * MiB, WS_ML = 347 * MiB, WS_END = 352 * MiB;
static_assert(WS_ROPE == pg8::WOFF_ROPE && WS_QB == pg8::WOFF_QB && WS_KB == pg8::WOFF_KB && WS_VB == pg8::WOFF_VB && WS_ZB == pg8::WOFF_ZB && OFF_KP == pg8::OOFF_KP && OFF_VP == pg8::OOFF_VP && OFF_PP == pg8::OOFF_PP && OFF_KS == pg8::OOFF_KS && OFF_VS == pg8::OOFF_VS && OFF_PS == pg8::OOFF_PS, "offsets");
static_assert(WS_ACT + (size_t)M * FF * 2 <= WS_OB && WS_ZB + (size_t)M * 1024 * 2 <= WS_OB && WS_X + (size_t)M * D * 4 <= WS_H && WS_H + (size_t)M * D * 2 <= WS_MIX && WS_MIX + (size_t)M * D * 2 <= WS_ACT, "ws map");
static_assert(WS_OB + (size_t)M * 1024 * 2 <= WS_OPART && WS_OPART + (size_t)32 * 2 * 9 * 32 * 128 * 4 <= WS_ML && WS_ML + (size_t)32 * 2 * 9 * 32 * 2 * 4 <= WS_END, "ws map 2");
constexpr int LDS_BYTES = 147456;
constexpr size_t CTL_BYTES = 262144, CTL_CNT = 65536;
constexpr size_t WS_SLOTP = 350 * MiB, WS_SLOTS = 351 * MiB;

__device__ __forceinline__ unsigned pk2(float lo, float hi) { f32x2 v = {lo, hi}; typedef __bf16 b2 __attribute__((ext_vector_type(2))); b2 b = __builtin_convertvector(v, b2); return __builtin_bit_cast(unsigned, b); }
__device__ __forceinline__ float bf2f(unsigned short b) { return __builtin_bit_cast(float, (unsigned)b << 16); }
__device__ __forceinline__ bf16x8 pack8(f32x4 a, f32x4 b) { v4u w; w.x = pk2(a.x, a.y); w.y = pk2(a.z, a.w); w.z = pk2(b.x, b.y); w.w = pk2(b.z, b.w); return __builtin_bit_cast(bf16x8, w); }
__device__ __forceinline__ int crow(int r, int hi) { return (r & 3) + 8 * (r >> 2) + 4 * hi; }
__device__ __forceinline__ void xhalf_pair(float m, float& a, float& b) { a = m; b = m; asm volatile("s_nop 1\n\tv_permlane32_swap_b32 %0, %1\n\ts_nop 1" : "+v"(a), "+v"(b)); }
__device__ __forceinline__ float xhalf_max(float m) { float a, b; xhalf_pair(m, a, b); return fmaxf(a, b); }
__device__ __forceinline__ float xhalf_sum(float m) { float a, b; xhalf_pair(m, a, b); return a + b; }
template <int O> __device__ __forceinline__ float swz_xor(float v) { return __builtin_bit_cast(float, __builtin_amdgcn_ds_swizzle(__builtin_bit_cast(int, v), (O << 10) | 0x1f)); }
__device__ __forceinline__ float wave_sum(float v) {
    v += swz_xor<1>(v); v += swz_xor<2>(v); v += swz_xor<4>(v); v += swz_xor<8>(v); v += swz_xor<16>(v);
    return xhalf_sum(v);
}
#define LDS_WAIT() asm volatile("s_waitcnt lgkmcnt(0)" ::: "memory")

struct Params { const float* in[26]; float* out; unsigned char* ws; };
typedef const __attribute__((address_space(4))) unsigned char* karg_ptr;
__device__ __forceinline__ karg_ptr kargs() { karg_ptr k = (karg_ptr)__builtin_amdgcn_kernarg_segment_ptr(); asm volatile("" : "+s"(k)); return k; }
__device__ __forceinline__ const float* KIN(int i) { return *(const float* const __attribute__((address_space(4)))*)(kargs() + 8 * i); }
__device__ __forceinline__ float* KOUT() { return *(float* const __attribute__((address_space(4)))*)(kargs() + 8 * 26); }
__device__ __forceinline__ unsigned char* KWS() { return *(unsigned char* const __attribute__((address_space(4)))*)(kargs() + 8 * 27); }

template <int MODE> __device__ __forceinline__ int wmap(int nl, int row_off) {
    if (MODE == 0) return row_off + nl;
    if (MODE == 1) return (nl >> 7) * 256 + (nl & 127) + row_off;
    const int u = nl >> 8, lc = nl & 255, A = lc >> 6, n = (lc >> 5) & 1, B = (lc >> 4) & 1, f = lc & 15;
    return u * 256 + 128 * (A >> 1) + 32 * (2 * (A & 1) + B) + 16 * n + f;
}
template <int MODE> __device__ __forceinline__ void transpose_item(const float* W, int K, int N, bf16* WT, int row_off, LAS float* scr, int item, int lane) {
    const int nblk = N / 32, kb = item / nblk, nb = item % nblk, k0 = 64 * kb, n0 = 32 * nb;
#pragma unroll 8
    for (int i = 0; i < 32; ++i) { const int kk = 2 * i + (lane >> 5); scr[kk * 33 + (lane & 31)] = W[(size_t)(k0 + kk) * N + n0 + (lane & 31)]; }
    LDS_WAIT(); asm volatile("" ::: "memory");
    const int c = lane & 7;
#pragma unroll
    for (int j = 0; j < 4; ++j) { const int n = (lane >> 3) + 8 * j; const LAS float* s = scr + (8 * c) * 33 + n;
        v4u o; o.x = pk2(s[0 * 33], s[1 * 33]); o.y = pk2(s[2 * 33], s[3 * 33]); o.z = pk2(s[4 * 33], s[5 * 33]); o.w = pk2(s[6 * 33], s[7 * 33]);
        *(v4u*)(WT + (size_t)wmap<MODE>(n0 + n, row_off) * K + k0 + 8 * c) = o; }
    LDS_WAIT(); asm volatile("" ::: "memory");
}
__device__ __forceinline__ void prologue(LAS unsigned char* lds, int gw, int NGW, int wave, int lane) {
    LAS float* scr = (LAS float*)(lds + wave * 16384);
    constexpr int I_F = 16 * 88, I_IN = 16 * 80, I_OUT = 16 * 32, I_L = 6 * I_F + I_IN + I_OUT;
    for (int it = gw; it < 2 * I_L; it += NGW) {
        const int l = it / I_L; int r = it % I_L;
        unsigned char* wl = KWS() + WS_W + (size_t)l * WL;
        if (r < I_F) { transpose_item<1>(KIN(7) + (size_t)l * D * FF, D, FF, (bf16*)(wl + W_GU1), 0, scr, r, lane); continue; } r -= I_F;
        if (r < I_F) { transpose_item<1>(KIN(8) + (size_t)l * D * FF, D, FF, (bf16*)(wl + W_GU1), 128, scr, r, lane); continue; } r -= I_F;
        if (r < I_F) { transpose_item<0>(KIN(9) + (size_t)l * D * FF, FF, D, (bf16*)(wl + W_D1), 0, scr, r, lane); continue; } r -= I_F;
        if (r < I_IN) { transpose_item<2>(KIN(11) + (size_t)l * D * DIN, D, DIN, (bf16*)(wl + W_IN), 0, scr, r, lane); continue; } r -= I_IN;
        if (r < I_OUT) { transpose_item<0>(KIN(20) + (size_t)l * D * D, D, D, (bf16*)(wl + W_OUT), 0, scr, r, lane); continue; } r -= I_OUT;
        if (r < I_F) { transpose_item<1>(KIN(22) + (size_t)l * D * FF, D, FF, (bf16*)(wl + W_GU2), 0, scr, r, lane); continue; } r -= I_F;
        if (r < I_F) { transpose_item<1>(KIN(23) + (size_t)l * D * FF, D, FF, (bf16*)(wl + W_GU2), 128, scr, r, lane); continue; } r -= I_F;
        transpose_item<0>(KIN(24) + (size_t)l * D * FF, FF, D, (bf16*)(wl + W_D2), 0, scr, r, lane);
    }
    float* rope = (float*)(KWS() + WS_ROPE);
    for (int i = gw * 64 + lane; i < 2080 * 32; i += NGW * 64) {
        const int pr = i >> 5, d = i & 31; const int pos = pr < 2048 ? pr : 4096 + (pr - 2048);
        const float inv = exp2f(-(float)d * (13.287712379549449f / 32.0f));
        const float ang = (float)pos * inv;
        const double rev = (double)ang * 0.15915494309189535; const float fr = (float)(rev - __builtin_rint(rev));
        rope[pr * 64 + d] = __builtin_amdgcn_cosf(fr); rope[pr * 64 + 32 + d] = __builtin_amdgcn_sinf(fr);
    }
    bf16* pwt_ = (bf16*)(KWS() + WS_POOLWT);
    for (int i = gw * 64 + lane; i < 2 * 4 * 64 * 64; i += NGW * 64) {
        const int c = i & 63, e = (i >> 6) & 63, lg = i >> 12;
        pwt_[i] = (bf16)(pk2(KIN(17)[(size_t)lg * 4096 + c * 64 + e], 0.f) & 0xffffu);
    }
}
template <bool FINAL> __device__ __forceinline__ void norm_rows(const float* srcP, const float* srcS, const float* g, bf16* H, float* outf, int gw, int NGW, int lane) {
    const f32x4* g4 = (const f32x4*)g + lane;
    f32x4 gv[4];
#pragma unroll
    for (int j = 0; j < 4; ++j) gv[j] = g4[64 * j];
    for (int m = gw; m < M; m += NGW) {
        const float* xr = (m < MP) ? srcP + (size_t)m * D : srcS + (size_t)(m - MP) * D;
        const f32x4* x4 = (const f32x4*)xr + lane;
        f32x4 v[4]; float s = 0.f;
#pragma unroll
        for (int j = 0; j < 4; ++j) { v[j] = x4[64 * j]; s += (v[j].x * v[j].x + v[j].y * v[j].y) + (v[j].z * v[j].z + v[j].w * v[j].w); }
        const float rstd = 1.0f / sqrtf(wave_sum(s) * (1.0f / D) + EPS);
        if (FINAL) {
            f32x4* o4 = (f32x4*)(outf + (size_t)m * D) + lane;
#pragma unroll
            for (int j = 0; j < 4; ++j) o4[64 * j] = v[j] * rstd * gv[j];
        } else {
            v2u* o2 = (v2u*)(H + (size_t)m * D) + lane;
#pragma unroll
            for (int j = 0; j < 4; ++j) { const f32x4 y = v[j] * rstd * gv[j]; v2u w; w.x = pk2(y.x, y.y); w.y = pk2(y.z, y.w); o2[64 * j] = w; }
        }
    }
}
__device__ __forceinline__ f32x16 mfma32(bf16x8 a, bf16x8 b, f32x16 c) { return __builtin_amdgcn_mfma_f32_32x32x16_bf16(a, b, c, 0, 0, 0); }


template <bool BASE16, int K> __device__ __forceinline__ void skinny_part1(LAS unsigned char* lds, const bf16* A, const bf16* Bt, const void* base, bf16* out, float scale,
                                            unsigned* slots, unsigned* cnt8, int tile, int tid) {
    const int lane = tid & 63, r32 = lane & 31, hi = lane >> 5, wid = __builtin_amdgcn_readfirstlane(tid >> 6);
    LAS float* R = (LAS float*)lds;
    LAS float* PARK = (LAS float*)(lds + 131072);
    const int rt = tile >> 5, ct = tile & 31, kw = K >> 3, k0 = wid * kw;
    const int e = tid * 2, row = e >> 5, col = e & 31;
    const size_t o = (size_t)(rt * 32 + row) * 1024 + ct * 32 + col;
    f32x2 bv; if (BASE16) { const unsigned bw = *(const unsigned*)((const bf16*)base + o); bv.x = bf2f(bw & 0xffff); bv.y = bf2f(bw >> 16); } else bv = *(const f32x2*)((const float*)base + o);
    const bf16* ap = A + (size_t)(rt * 32 + r32) * K + wid * 16 + hi * 8; const bf16* bp = Bt + (size_t)(ct * 32 + r32) * K + wid * 16 + hi * 8; (void)k0;
    f32x16 acc;
#pragma unroll
    for (int r = 0; r < 16; ++r) acc[r] = 0.f;
    constexpr int NST = K / 128, UB = (NST % 11 == 0) ? 11 : 8;
#pragma unroll 1
    for (int s0 = 0; s0 < NST; s0 += UB) { bf16x8 av[UB], bw[UB];
#pragma unroll
        for (int j = 0; j < UB; ++j) { av[j] = *(const bf16x8*)(ap + (s0 + j) * 128); bw[j] = *(const bf16x8*)(bp + (s0 + j) * 128); }
#pragma unroll
        for (int j = 0; j < UB; ++j) acc = mfma32(av[j], bw[j], acc); }
    __syncthreads();
#pragma unroll
    for (int r = 0; r < 16; ++r) R[(wid * 32 + crow(r, hi)) * 32 + r32] = acc[r];
    __syncthreads();
    f32x2 s = {0.f, 0.f};
#pragma unroll
    for (int w = 0; w < 8; ++w) s += *(const LAS f32x2*)(R + (w * 32 + row) * 32 + col);
    const f32x2 v = bv + s * scale;
    float ss = v.x * v.x + v.y * v.y; ss += swz_xor<1>(ss); ss += swz_xor<2>(ss); ss += swz_xor<4>(ss); ss += swz_xor<8>(ss);
    if ((tid & 15) == 0) __hip_atomic_store(slots + (size_t)(rt * 32 + row) * 32 + ct, __builtin_bit_cast(unsigned, ss), __ATOMIC_RELAXED, __HIP_MEMORY_SCOPE_AGENT);
    *(LAS f32x2*)(PARK + tid * 2) = v;
    asm volatile("s_waitcnt vmcnt(0)" ::: "memory");
    __syncthreads();
    if (tid == 0) __hip_atomic_fetch_add(cnt8 + 64 * rt, 1u, __ATOMIC_RELAXED, __HIP_MEMORY_SCOPE_AGENT);
    if (out) *(unsigned*)(out + o) = pk2(v.x, v.y);
    __syncthreads();
}
__device__ __forceinline__ void skinny_part2(LAS unsigned char* lds, bf16* hb, float* yout, const float* gain, unsigned* slots, unsigned* cnt8, int tile, int tid) {
    LAS float* PARK = (LAS float*)(lds + 131072);
    const int rt = tile >> 5, ct = tile & 31, e = tid * 2, row = e >> 5, col = e & 31;
    const size_t o = (size_t)(rt * 32 + row) * 1024 + ct * 32 + col;
    if (tid == 0) {
        unsigned spins = 0;
        while (__hip_atomic_load(cnt8 + 64 * rt, __ATOMIC_RELAXED, __HIP_MEMORY_SCOPE_AGENT) < 32u) { __builtin_amdgcn_s_sleep(2); if (++spins > (1u << 22)) break; }
        __builtin_amdgcn_fence(__ATOMIC_ACQUIRE, "agent");
        asm volatile("s_waitcnt vmcnt(0)" ::: "memory");
    }
    __syncthreads();
    const unsigned* sl = slots + (size_t)(rt * 32 + row) * 32 + (tid & 15) * 2;
    float tot = __builtin_bit_cast(float, __hip_atomic_load(sl, __ATOMIC_RELAXED, __HIP_MEMORY_SCOPE_AGENT)) + __builtin_bit_cast(float, __hip_atomic_load(sl + 1, __ATOMIC_RELAXED, __HIP_MEMORY_SCOPE_AGENT));
    tot += swz_xor<1>(tot); tot += swz_xor<2>(tot); tot += swz_xor<4>(tot); tot += swz_xor<8>(tot);
    const float r = 1.0f / sqrtf(tot * (1.0f / 1024.0f) + EPS);
    const f32x2 v = *(const LAS f32x2*)(PARK + tid * 2);
    const f32x2 gv = *(const f32x2*)(gain + ct * 32 + col); const f32x2 y = v * r * gv;
    if (hb) *(unsigned*)(hb + o) = pk2(y.x, y.y); else *(f32x2*)(yout + o) = y;
    __syncthreads();
}

__device__ __forceinline__ void sample_piece(LAS unsigned char* lds, int pc, int l, const bf16* Qb, const float* cache_k, const float* cache_v, const float* knew, const float* vnew, float* OPART, float* MLP, int tid) {
    const int lane = tid & 63, r32 = lane & 31, hi = lane >> 5, wid = __builtin_amdgcn_readfirstlane(tid >> 6);
    const int b = pc >> 5, h = (pc >> 3) & 3, s = pc & 7;
    const bf16* qrow = Qb + (size_t)(MP + b * 32 + r32) * 512 + h * 128 + hi * 8;
    LAS float* ML = (LAS float*)lds;
    LAS float* FAC = (LAS float*)(lds + 4096);
    LAS float* OX = (LAS float*)(lds + 8192);
    const bool extra = (s == 7) && (wid == 7);
    const size_t off = ((size_t)((l * 8 + b) * 4096 + (s * 8 + wid) * 64)) * 512 + h * 128;
    const size_t offx = ((size_t)(l * 8 + b) * 32) * 512 + h * 128;
    const float* Kt = cache_k + off; const float* Vt = cache_v + off; const float* Kx = knew + offx; const float* Vx = vnew + offx;
    float mrow[2], lrow[2]; bf16x8 pw[2][6];
#pragma unroll
    for (int c = 0; c < 2; ++c) {
        bf16x8 qf[4];
#pragma unroll
        for (int d0 = 0; d0 < 4; ++d0) qf[d0] = *(const bf16x8*)(qrow + c * 64 + d0 * 16);
        f32x16 sc[3];
#pragma unroll
        for (int kvb = 0; kvb < 3; ++kvb) {
            if (kvb < 2 || extra) {
                f32x16 a;
#pragma unroll
                for (int r = 0; r < 16; ++r) a[r] = 0.f;
                const float* kp = (kvb < 2 ? Kt + (size_t)(kvb * 32 + r32) * 512 : Kx + (size_t)r32 * 512) + c * 64 + hi * 8;
#pragma unroll
                for (int d0 = 0; d0 < 4; ++d0) { const f32x4 x0 = *(const f32x4*)(kp + d0 * 16), x1 = *(const f32x4*)(kp + d0 * 16 + 4); a = mfma32(pack8(x0, x1), qf[d0], a); }
                sc[kvb] = a;
            } else {
#pragma unroll
                for (int r = 0; r < 16; ++r) sc[kvb][r] = -1e30f;
            }
        }
        float mx = -1e30f;
#pragma unroll
        for (int r = 0; r < 16; ++r) mx = fmaxf(mx, fmaxf(fmaxf(sc[0][r], sc[1][r]), sc[2][r]));
        mx = xhalf_max(mx);
        float sum = 0.f;
#pragma unroll
        for (int kvb = 0; kvb < 3; ++kvb)
#pragma unroll
            for (int r = 0; r < 16; ++r) { const float pv = __builtin_amdgcn_exp2f(sc[kvb][r] - mx); sc[kvb][r] = pv; sum += pv; }
        sum = xhalf_sum(sum);
        mrow[c] = mx; lrow[c] = sum;
#pragma unroll
        for (int kvb = 0; kvb < 3; ++kvb)
#pragma unroll
            for (int hf = 0; hf < 2; ++hf) { v4u w; w.x = pk2(sc[kvb][8 * hf + 0], sc[kvb][8 * hf + 1]); w.y = pk2(sc[kvb][8 * hf + 2], sc[kvb][8 * hf + 3]);
                w.z = pk2(sc[kvb][8 * hf + 4], sc[kvb][8 * hf + 5]); w.w = pk2(sc[kvb][8 * hf + 6], sc[kvb][8 * hf + 7]); pw[c][2 * kvb + hf] = __builtin_bit_cast(bf16x8, w); }
    }
    asm volatile("" ::: "memory");
    f32x16 o[2][4];
#pragma unroll
    for (int c = 0; c < 2; ++c)
#pragma unroll
        for (int eb = 0; eb < 4; ++eb)
#pragma unroll
            for (int r = 0; r < 16; ++r) o[c][eb][r] = 0.f;
#pragma unroll
    for (int ks = 0; ks < 6; ++ks) {
        if (ks < 4 || extra) {
#pragma unroll
            for (int eb = 0; eb < 4; ++eb) {
                const float* vp = (ks < 4 ? Vt + (size_t)(ks * 16 + 4 * hi) * 512 : Vx + (size_t)((ks - 4) * 16 + 4 * hi) * 512) + eb * 32 + r32;
                f32x4 x0, x1;
                x0.x = vp[0 * 512]; x0.y = vp[1 * 512]; x0.z = vp[2 * 512]; x0.w = vp[3 * 512];
                x1.x = vp[8 * 512]; x1.y = vp[9 * 512]; x1.z = vp[10 * 512]; x1.w = vp[11 * 512];
                const bf16x8 vf = pack8(x0, x1);
                o[0][eb] = mfma32(pw[0][ks], vf, o[0][eb]); o[1][eb] = mfma32(pw[1][ks], vf, o[1][eb]);
            }
        }
    }
    if (hi == 0) {
#pragma unroll
        for (int c = 0; c < 2; ++c) { ML[((wid * 2 + c) * 32 + r32) * 2 + 0] = mrow[c]; ML[((wid * 2 + c) * 32 + r32) * 2 + 1] = lrow[c]; }
    }
    __syncthreads();
    const int pidx = s;
    if (tid < 64) {
        const int c = tid >> 5, q = tid & 31; float mw[8], lw[8]; float Mx = -1e30f;
#pragma unroll
        for (int w = 0; w < 8; ++w) { mw[w] = ML[((w * 2 + c) * 32 + q) * 2 + 0]; lw[w] = ML[((w * 2 + c) * 32 + q) * 2 + 1]; Mx = fmaxf(Mx, mw[w]); }
        float L = 0.f;
#pragma unroll
        for (int w = 0; w < 8; ++w) { const float fz = __builtin_amdgcn_exp2f(mw[w] - Mx); FAC[(w * 2 + c) * 32 + q] = fz; L += lw[w] * fz; }
        float* mp = MLP + ((size_t)((((b * 4 + h) * 2 + c) * 9 + pidx) * 32 + q)) * 2; mp[0] = Mx; mp[1] = L;
    }
    __syncthreads();
#pragma unroll
    for (int c = 0; c < 2; ++c) {
#pragma unroll
        for (int eb = 0; eb < 4; ++eb)
#pragma unroll
            for (int r = 0; r < 16; ++r) { const int q = crow(r, hi); OX[(wid * 32 + q) * 128 + eb * 32 + r32] = o[c][eb][r] * FAC[(wid * 2 + c) * 32 + q]; }
        __syncthreads();
        { const int idx = tid * 8, q = idx >> 7, e = idx & 127; f32x4 s0 = {0.f, 0.f, 0.f, 0.f}, s1 = {0.f, 0.f, 0.f, 0.f};
#pragma unroll
          for (int w = 0; w < 8; ++w) { s0 += *(const LAS f32x4*)(OX + (w * 32 + q) * 128 + e); s1 += *(const LAS f32x4*)(OX + (w * 32 + q) * 128 + e + 4); }
          float* dst = OPART + ((size_t)((((b * 4 + h) * 2 + c) * 9 + pidx) * 32 + q)) * 128 + e; *(f32x4*)dst = s0; *(f32x4*)(dst + 4) = s1; }
        __syncthreads();
    }
}

template <int W> __device__ __forceinline__ void pool_d(const LAS float* U, LAS bf16* Dd, int ch, int tbeg, int t0, bool smp) {
    float s = 0.f;
#pragma unroll
    for (int i = 0; i < W; ++i) s += U[(15 + tbeg - i) * 256 + ch];
#pragma unroll 8
    for (int k = 0; k < 32; ++k) {
        const int tt = tbeg + k; const float cur = U[(15 + tt) * 256 + ch];
        if (k > 0) s += cur - U[(15 + tt - W) * 256 + ch];
        const int pos = smp ? 4096 + tt : t0 + tt; const int cnt = (pos + 1 < W) ? pos + 1 : W;
        const float d = s * __builtin_amdgcn_rcpf((float)cnt) - cur;
        Dd[tt * 264 + ch] = (bf16)(pk2(d, 0.f) & 0xffffu);
    }
}
__device__ __forceinline__ f32x4 bf4_to_f32(v2u w) { f32x4 v; v.x = bf2f(w.x & 0xffff); v.y = bf2f(w.x >> 16); v.z = bf2f(w.y & 0xffff); v.w = bf2f(w.y >> 16); return v; }
__device__ __forceinline__ void poolconv_tile(LAS unsigned char* lds, int tl, int l, const bf16* Zb, bf16* MIX, const float* state_pool, const float* state_conv, const bf16* pwt, const float* pool_scale,
                                              const float* conv_w, float* out_cp, float* out_cs, int tid) {
    const int lane = tid & 63, r32 = lane & 31, hi = lane >> 5, wid = __builtin_amdgcn_readfirstlane(tid >> 6);
    int b, t0, TT, rowbase; bool smp;
    if (tl < 256) { b = tl >> 5; t0 = (tl & 31) * 64; TT = 64; rowbase = b * 2048 + t0; smp = false; }
    else { b = tl - 256; t0 = 0; TT = 32; rowbase = MP + b * 32; smp = true; }
    LAS float* U = (LAS float*)lds;
    LAS bf16* Dd = (LAS bf16*)(lds + 81920);
    {
        f32x4 uv[10];
#pragma unroll
        for (int k = 0; k < 10; ++k) {
            const int idx = tid + 512 * k, i = idx >> 6, c4 = (idx & 63) * 4; f32x4 v = {0.f, 0.f, 0.f, 0.f};
            if (i < 15 + TT) {
                if (i < 15 && smp) v = *(const f32x4*)(state_pool + (size_t)((l * 8 + b) * 15 + i) * 256 + c4);
                else if (i >= 15 || t0 - 15 + i >= 0) v = bf4_to_f32(*(const v2u*)(Zb + (size_t)(rowbase + i - 15) * 1024 + c4));
            }
            uv[k] = v;
        }
#pragma unroll
        for (int k = 0; k < 10; ++k) { const int idx = tid + 512 * k, i = idx >> 6, c4 = (idx & 63) * 4; if (i < 15 + TT) *(LAS f32x4*)(U + i * 256 + c4) = uv[k]; }
    }
    __syncthreads();
    {
        const int ch = tid & 255, th = tid >> 8, gi = __builtin_amdgcn_readfirstlane(ch >> 6);
        if (th * 32 < TT) {
            if (gi == 0) pool_d<2>(U, Dd, ch, th * 32, t0, smp); else if (gi == 1) pool_d<4>(U, Dd, ch, th * 32, t0, smp);
            else if (gi == 2) pool_d<8>(U, Dd, ch, th * 32, t0, smp); else pool_d<16>(U, Dd, ch, th * 32, t0, smp);
        }
    }
    __syncthreads();
    {
        const int gi = wid >> 1, th = wid & 1;
        if (th * 32 < TT) {
            f32x16 acc0, acc1;
#pragma unroll
            for (int r = 0; r < 16; ++r) { acc0[r] = 0.f; acc1[r] = 0.f; }
#pragma unroll
            for (int ks = 0; ks < 4; ++ks) {
                const bf16x8 a = *(const LAS bf16x8*)(Dd + (th * 32 + r32) * 264 + gi * 64 + ks * 16 + hi * 8);
                const bf16x8 b0 = *(const bf16x8*)(pwt + (size_t)((l * 4 + gi) * 64 + r32) * 64 + ks * 16 + hi * 8);
                const bf16x8 b1 = *(const bf16x8*)(pwt + (size_t)((l * 4 + gi) * 64 + 32 + r32) * 64 + ks * 16 + hi * 8);
                acc0 = mfma32(a, b0, acc0); acc1 = mfma32(a, b1, acc1);
            }
            const float sc0 = pool_scale[l * 256 + gi * 64 + r32], sc1 = pool_scale[l * 256 + gi * 64 + 32 + r32];
#pragma unroll
            for (int r = 0; r < 16; ++r) { const int tok = th * 32 + crow(r, hi); bf16* mp = MIX + (size_t)(rowbase + tok) * 1024 + 512 + gi * 64 + r32;
                mp[0] = (bf16)(pk2(acc0[r] * sc0, 0.f) & 0xffffu); mp[32] = (bf16)(pk2(acc1[r] * sc1, 0.f) & 0xffffu); }
        }
    }
    if (wid * 8 < TT) {
        const int cq = lane, tc = wid * 8;
        v2u hraw[10], graw[10], braw[8]; f32x4 hst[2];
        hst[0] = (f32x4){0.f, 0.f, 0.f, 0.f}; hst[1] = hst[0];
#pragma unroll
        for (int i = 0; i < 10; ++i) {
            const int ts = tc - 2 + i; hraw[i] = (v2u){0u, 0u}; graw[i] = (v2u){0u, 0u};
            if (ts >= 0 || (!smp && t0 + ts >= 0)) { const bf16* zr = Zb + (size_t)(rowbase + ts) * 1024 + 4 * cq; hraw[i] = *(const v2u*)(zr + 256); graw[i] = *(const v2u*)(zr + 768); }
        }
#pragma unroll
        for (int i = 0; i < 8; ++i) braw[i] = *(const v2u*)(Zb + (size_t)(rowbase + tc + i) * 1024 + 512 + 4 * cq);
        if (smp && tc == 0) { hst[0] = *(const f32x4*)(state_conv + (size_t)((l * 8 + b) * 2 + 0) * 256 + 4 * cq); hst[1] = *(const f32x4*)(state_conv + (size_t)((l * 8 + b) * 2 + 1) * 256 + 4 * cq); }
        const f32x4 cw0 = *(const f32x4*)(conv_w + l * 768 + 4 * cq), cw1 = *(const f32x4*)(conv_w + l * 768 + 256 + 4 * cq), cw2 = *(const f32x4*)(conv_w + l * 768 + 512 + 4 * cq);
        f32x4 cm2 = bf4_to_f32(graw[0]) * bf4_to_f32(hraw[0]), cm1 = bf4_to_f32(graw[1]) * bf4_to_f32(hraw[1]);
        if (smp && tc == 0) { cm2 = hst[0]; cm1 = hst[1]; }
#pragma unroll
        for (int i = 0; i < 8; ++i) {
            const int tt = tc + i;
            const f32x4 cv = bf4_to_f32(graw[i + 2]) * bf4_to_f32(hraw[i + 2]);
            const f32x4 y = bf4_to_f32(braw[i]) * (cw0 * cm2 + cw1 * cm1 + cw2 * cv);
            v2u w; w.x = pk2(y.x, y.y); w.y = pk2(y.z, y.w);
            *(v2u*)(MIX + (size_t)(rowbase + tt) * 1024 + 768 + 4 * cq) = w;
            if (smp) { if (tt >= 30) *(f32x4*)(out_cs + (size_t)((l * 8 + b) * 2 + tt - 30) * 256 + 4 * cq) = cv; }
            else if (t0 + tt >= 2046) *(f32x4*)(out_cp + (size_t)((l * 8 + b) * 2 + t0 + tt - 2046) * 256 + 4 * cq) = cv;
            cm2 = cm1; cm1 = cv;
        }
    }
    __syncthreads();
}

__device__ __forceinline__ void combine_phase(int l, const bf16* Ob_, const float* OPART_, const float* MLP_, bf16* MIX_, int gw, int NGW, int lane) {
    const float lam_init = (l == 0) ? 0.2f : 0.35550934f;
    float lam;
    { const float a = KIN(12)[l * 64 + lane] * KIN(13)[l * 64 + lane], c = KIN(14)[l * 64 + lane] * KIN(15)[l * 64 + lane];
      lam = __expf(wave_sum(a)) - __expf(wave_sum(c)) + lam_init; }
    const float g0 = KIN(16)[l * 128 + 2 * lane], g1 = KIN(16)[l * 128 + 2 * lane + 1];
    for (int base = gw * 8; base < MP * 4; base += NGW * 8) {
        float a0[8], a1[8];
        {
            unsigned w1[8], w2[8];
#pragma unroll
            for (int j = 0; j < 8; ++j) { const int wt = base + j, row = wt >> 2, h = wt & 3;
                w1[j] = *(const unsigned*)(Ob_ + (size_t)row * 1024 + h * 128 + 2 * lane); w2[j] = *(const unsigned*)(Ob_ + (size_t)row * 1024 + 512 + h * 128 + 2 * lane); }
#pragma unroll
            for (int j = 0; j < 8; ++j) { a0[j] = bf2f(w1[j] & 0xffff) - lam * bf2f(w2[j] & 0xffff); a1[j] = bf2f(w1[j] >> 16) - lam * bf2f(w2[j] >> 16); }
        }
        float ss[8];
#pragma unroll
        for (int j = 0; j < 8; ++j) ss[j] = a0[j] * a0[j] + a1[j] * a1[j];
#pragma unroll
        for (int j = 0; j < 8; ++j) ss[j] += swz_xor<1>(ss[j]);
#pragma unroll
        for (int j = 0; j < 8; ++j) ss[j] += swz_xor<2>(ss[j]);
#pragma unroll
        for (int j = 0; j < 8; ++j) ss[j] += swz_xor<4>(ss[j]);
#pragma unroll
        for (int j = 0; j < 8; ++j) ss[j] += swz_xor<8>(ss[j]);
#pragma unroll
        for (int j = 0; j < 8; ++j) ss[j] += swz_xor<16>(ss[j]);
#pragma unroll
        for (int j = 0; j < 8; ++j) { const int wt = base + j, row = wt >> 2, h = wt & 3;
            const float tot = xhalf_sum(ss[j]);
            const float r = (1.0f / sqrtf(tot * (1.0f / 128.0f) + EPS)) * (1.0f - lam_init);
            *(unsigned*)(MIX_ + (size_t)row * 1024 + h * 128 + 2 * lane) = pk2(a0[j] * r * g0, a1[j] * r * g1); }
    }
    for (int wt = MP * 4 + gw; wt < M * 4; wt += NGW) {
        const int row = wt >> 2, h = wt & 3, rs = row - MP, b = rs >> 5, q = rs & 31; float oc[2][2];
#pragma unroll
        for (int c = 0; c < 2; ++c) {
            const size_t pb = (size_t)(((b * 4 + h) * 2 + c) * 9);
            float mw[8], lw[8]; f32x2 ov[8]; float Mx = -1e30f;
#pragma unroll
            for (int pi = 0; pi < 8; ++pi) { const f32x2 ml = *(const f32x2*)(MLP_ + ((pb + pi) * 32 + q) * 2); mw[pi] = ml.x; lw[pi] = ml.y; ov[pi] = *(const f32x2*)(OPART_ + ((pb + pi) * 32 + q) * 128 + 2 * lane); }
#pragma unroll
            for (int pi = 0; pi < 8; ++pi) Mx = fmaxf(Mx, mw[pi]);
            float L = 0.f, s0 = 0.f, s1 = 0.f;
#pragma unroll
            for (int pi = 0; pi < 8; ++pi) { const float fz = __builtin_amdgcn_exp2f(mw[pi] - Mx); L += lw[pi] * fz; s0 += ov[pi].x * fz; s1 += ov[pi].y * fz; }
            const float il = 1.0f / L; oc[c][0] = s0 * il; oc[c][1] = s1 * il;
        }
        const float a0 = oc[0][0] - lam * oc[1][0], a1 = oc[0][1] - lam * oc[1][1];
        const float tot = wave_sum(a0 * a0 + a1 * a1);
        const float r = (1.0f / sqrtf(tot * (1.0f / 128.0f) + EPS)) * (1.0f - lam_init);
        *(unsigned*)(MIX_ + (size_t)row * 1024 + h * 128 + 2 * lane) = pk2(a0 * r * g0, a1 * r * g1);
    }
}

#ifndef PROBE_SLOW_ATTN
#define PROBE_SLOW_ATTN 0
#endif
#if PROBE_SLOW_ATTN
__device__ __forceinline__ void slow_attn_phase(int l, const bf16* Qb_, float* outp, const float* cache_k, const float* cache_v, bf16* MIX_, int gw, int NGW, int lane) {
    const float lam_init = (l == 0) ? 0.2f : 0.35550934f;
    float lam;
    { const float a = KIN(12)[l * 64 + lane] * KIN(13)[l * 64 + lane], c = KIN(14)[l * 64 + lane] * KIN(15)[l * 64 + lane];
      lam = __expf(wave_sum(a)) - __expf(wave_sum(c)) + lam_init; }
    const float g0 = KIN(16)[l * 128 + 2 * lane], g1 = KIN(16)[l * 128 + 2 * lane + 1];
    for (int wt = gw; wt < M * 4; wt += NGW) {
        const int row = wt >> 2, h = wt & 3;
        const float *K0, *V0, *K1, *V1; int n0, n1;
        if (row < MP) { const int b = row >> 11, t = row & 2047; K0 = outp + OFF_KP + ((size_t)l * MP + (size_t)b * 2048) * 512 + h * 128; V0 = outp + OFF_VP + ((size_t)l * MP + (size_t)b * 2048) * 512 + h * 128; n0 = ((t >> 6) + 1) * 64; K1 = K0; V1 = V0; n1 = 0; }
        else { const int rs = row - MP, b = rs >> 5; K0 = cache_k + ((size_t)(l * 8 + b) * 4096) * 512 + h * 128; V0 = cache_v + ((size_t)(l * 8 + b) * 4096) * 512 + h * 128; n0 = 4096;
               K1 = outp + OFF_KS + ((size_t)(l * 8 + b) * 32) * 512 + h * 128; V1 = outp + OFF_VS + ((size_t)(l * 8 + b) * 32) * 512 + h * 128; n1 = 32; }
        float oc[2][2];
#pragma unroll 1
        for (int c = 0; c < 2; ++c) {
            float q[64];
#pragma unroll
            for (int d = 0; d < 64; ++d) q[d] = bf2f(Qb_[(size_t)row * 512 + h * 128 + c * 64 + d]);
            float mx = -1e30f;
            for (int seg = 0; seg < 2; ++seg) { const float* Kp = seg ? K1 : K0; const int n = seg ? n1 : n0;
                for (int j0 = 0; j0 < n; j0 += 64) { const int j = j0 + lane; float s = -1e30f;
                    if (j < n) { const float* kr = Kp + (size_t)j * 512 + c * 64; s = 0.f;
#pragma unroll
                        for (int d = 0; d < 64; ++d) s += q[d] * kr[d]; }
                    mx = fmaxf(mx, s); } }
            mx = fmaxf(mx, swz_xor<1>(mx)); mx = fmaxf(mx, swz_xor<2>(mx)); mx = fmaxf(mx, swz_xor<4>(mx)); mx = fmaxf(mx, swz_xor<8>(mx)); mx = fmaxf(mx, swz_xor<16>(mx)); mx = xhalf_max(mx);
            float L = 0.f, o0 = 0.f, o1 = 0.f;
            for (int seg = 0; seg < 2; ++seg) { const float* Kp = seg ? K1 : K0; const float* Vp = seg ? V1 : V0; const int n = seg ? n1 : n0;
                for (int j0 = 0; j0 < n; j0 += 64) { const int j = j0 + lane; float pj = 0.f;
                    if (j < n) { const float* kr = Kp + (size_t)j * 512 + c * 64; float s = 0.f;
#pragma unroll
                        for (int d = 0; d < 64; ++d) s += q[d] * kr[d];
                        pj = __builtin_amdgcn_exp2f(s - mx); }
                    L += pj;
                    const int nn = (n - j0 < 64) ? n - j0 : 64;
                    for (int jj = 0; jj < nn; ++jj) { const float pb = __builtin_bit_cast(float, __builtin_amdgcn_readlane(__builtin_bit_cast(int, pj), jj));
                        const f32x2 vv = *(const f32x2*)(Vp + (size_t)(j0 + jj) * 512 + 2 * lane); o0 += pb * vv.x; o1 += pb * vv.y; } } }
            L = wave_sum(L);
            oc[c][0] = o0 / L; oc[c][1] = o1 / L;
        }
        const float a0 = oc[0][0] - lam * oc[1][0], a1 = oc[0][1] - lam * oc[1][1];
        const float ss = wave_sum(a0 * a0 + a1 * a1);
        const float r = (1.0f / sqrtf(ss * (1.0f / 128.0f) + EPS)) * (1.0f - lam_init);
        *(unsigned*)(MIX_ + (size_t)row * 1024 + h * 128 + 2 * lane) = pk2(a0 * r * g0, a1 * r * g1);
    }
}
#endif

#ifndef PROBE_SLOW_PC
#define PROBE_SLOW_PC 0
#endif
#if PROBE_SLOW_PC
__device__ __forceinline__ float zval(const bf16* Zb_, const float* st, int l, int b, bool smp, int rowbase, int t, int col, int hist) {
    if (t >= 0) return bf2f(Zb_[(size_t)(rowbase + t) * 1024 + col]);
    if (!smp) return 0.f;
    return st[(size_t)((l * 8 + b) * hist + (hist + t)) * 256 + (col & 255)];
}
__device__ __forceinline__ void slow_pc_phase(int l, const bf16* Zb_, bf16* MIX_, int gw, int NGW, int lane) {
    const float* sp = KIN(4); const float* scv = KIN(5); const float* pw = KIN(17); const float* psc = KIN(18); const float* cw = KIN(19);
    for (int wt = gw; wt < M * 4; wt += NGW) {
        const int row = wt >> 2, g = wt & 3; const bool smp = row >= MP;
        int b, t, rowbase; if (smp) { const int rs = row - MP; b = rs >> 5; t = rs & 31; rowbase = MP + b * 32; } else { b = row >> 11; t = row & 2047; rowbase = b * 2048; }
        const int w = 2 << g, ch = g * 64 + lane;
        float s = 0.f;
        for (int i = 0; i < w; ++i) { const int tt = t - i; s += zval(Zb_, sp, l, b, smp, rowbase, tt, ch, 15); }
        const int pos = smp ? 4096 + t : t; const int cnt = (pos + 1 < w) ? pos + 1 : w;
        const float d = s / (float)cnt - zval(Zb_, sp, l, b, smp, rowbase, t, ch, 15);
        float mine = 0.f;
        for (int e = 0; e < 64; ++e) { const float v = wave_sum(d * pw[(size_t)((l * 4 + g) * 64 + lane) * 64 + e]); if (e == lane) mine = v; }
        MIX_[(size_t)row * 1024 + 512 + ch] = (bf16)(pk2(mine * psc[l * 256 + ch], 0.f) & 0xffffu);
        float cvv[3];
#pragma unroll
        for (int k = 0; k < 3; ++k) { const int tt = t - 2 + k;
            if (tt >= 0) cvv[k] = bf2f(Zb_[(size_t)(rowbase + tt) * 1024 + 768 + ch]) * bf2f(Zb_[(size_t)(rowbase + tt) * 1024 + 256 + ch]);
            else cvv[k] = smp ? scv[(size_t)((l * 8 + b) * 2 + (2 + tt)) * 256 + ch] : 0.f; }
        const float bgv = bf2f(Zb_[(size_t)row * 1024 + 512 + ch]);
        const float y = bgv * (cw[l * 768 + ch] * cvv[0] + cw[l * 768 + 256 + ch] * cvv[1] + cw[l * 768 + 512 + ch] * cvv[2]);
        MIX_[(size_t)row * 1024 + 768 + ch] = (bf16)(pk2(y, 0.f) & 0xffffu);
    }
}
#endif

#define XB_TMO      128
#define XB_XCNT(j)  (256  + 64 * (j))
#define XB_XSUB(j)  (1280 + 64 * (j))
#define XB_XGEN(j)  (2304 + 64 * (j))
#define XB_TOP      3328
#define XB_TOPGEN   3392
#define XCD_BAR_WORDS 3456
#define XB_SPIN_CAP (1u << 18)
__device__ __forceinline__ unsigned xb_ld(unsigned* p)              { return __hip_atomic_load(p, __ATOMIC_RELAXED, __HIP_MEMORY_SCOPE_AGENT); }
__device__ __forceinline__ unsigned xb_add(unsigned* p, unsigned v) { return __hip_atomic_fetch_add(p, v, __ATOMIC_RELAXED, __HIP_MEMORY_SCOPE_AGENT); }
__device__ __forceinline__ unsigned xb_xcc_id() { return (unsigned)__builtin_amdgcn_s_getreg((3 << 11) | 20) & 0xFu; }
#define XB_SPIN(cond, bar) do { unsigned _sp = 0; while (cond) { __builtin_amdgcn_s_sleep(1); \
    if ((++_sp & 255u) == 0u) { if (xb_ld(&(bar)[XB_TMO])) break; if (_sp > XB_SPIN_CAP) { atomicAdd(&(bar)[XB_TMO], 1u); break; } } } } while (0)
__device__ __forceinline__ void xcd_barrier_complete(unsigned* bar, unsigned x, unsigned& nloc, unsigned& nx) {
    const unsigned G = gridDim.x * gridDim.y * gridDim.z;
    unsigned sum, cnt, mine, sp = 0u;
    for (;;) {
        sum = 0u; cnt = 0u; mine = 0u;
#pragma unroll
        for (unsigned j = 0; j < 16; ++j) { const unsigned c = xb_ld(&bar[XB_XCNT(j)]); sum += c; cnt += (c > 0u) ? 1u : 0u; mine = (j == x) ? c : mine; }
        if (sum == G) break;
        __builtin_amdgcn_s_sleep(1);
        if ((++sp & 255u) == 0u) { if (xb_ld(&bar[XB_TMO])) break; if (sp > XB_SPIN_CAP) { atomicAdd(&bar[XB_TMO], 1u); break; } }
    }
    nloc = mine > 0u ? mine : 1u; nx = cnt > 0u ? cnt : 1u;
}
__device__ __forceinline__ void xcd_barrier(unsigned* bar, unsigned x, volatile LAS unsigned* st) {
    asm volatile("s_waitcnt vmcnt(0)" ::: "memory");
    __syncthreads();
    if (threadIdx.x == 0) {
        __builtin_amdgcn_s_waitcnt(0);
        unsigned nloc = st[0], nx = st[1];
        if (nloc == 0u) { xcd_barrier_complete(bar, x, nloc, nx); st[0] = nloc; st[1] = nx; }
        const unsigned old = xb_add(&bar[XB_XSUB(x)], 1u);
        const unsigned gen = old / nloc;
        if (old + 1u == (gen + 1u) * nloc) {
            __builtin_amdgcn_fence(__ATOMIC_RELEASE, "agent");
            asm volatile("s_waitcnt vmcnt(0)" ::: "memory");
            const unsigned og = xb_add(&bar[XB_TOP], 1u);
            const unsigned tg = og / nx;
            if (og + 1u == (tg + 1u) * nx) xb_add(&bar[XB_TOPGEN], 1u);
            else XB_SPIN(xb_ld(&bar[XB_TOPGEN]) == tg, bar);
            __builtin_amdgcn_fence(__ATOMIC_ACQUIRE, "agent");
            xb_add(&bar[XB_XGEN(x)], 1u);
            asm volatile("s_waitcnt vmcnt(0)" ::: "memory");
        } else {
            XB_SPIN(xb_ld(&bar[XB_XGEN(x)]) == gen, bar);
            __builtin_amdgcn_fence(__ATOMIC_ACQUIRE, "agent");
            asm volatile("s_waitcnt vmcnt(0)" ::: "memory");
        }
    }
    __syncthreads();
}
#define CG_SYNC() do { asm volatile("s_waitcnt vmcnt(0) lgkmcnt(0)" ::: "memory"); grid.sync(); asm volatile("" ::: "memory"); } while (0)
#define GRID_SYNC() xcd_barrier((unsigned*)KWS() + 4096, xcc, (volatile LAS unsigned*)(lds + LDS_BYTES - 64))
__global__ void __launch_bounds__(NWAVES * 64, 2) mega_fwd(Params p) {
    extern __shared__ __attribute__((aligned(16))) unsigned char lds_raw[];
    LAS unsigned char* lds = (LAS unsigned char*)lds_raw;
    cg::grid_group grid = cg::this_grid();
    const int tid = threadIdx.x, lane = tid & 63, wave = __builtin_amdgcn_readfirstlane(tid >> 6);
    const int G = gridDim.x; const int bx = blockIdx.x; const int vcu0 = (G % 8 == 0) ? (bx % 8) * (G / 8) + bx / 8 : bx;
    const int NGW = G * NWAVES;
#define X ((bf16*)(ws + WS_X))
#define H ((bf16*)(ws + WS_H))
#define MIX ((bf16*)(ws + WS_MIX))
#define ACT ((bf16*)(ws + WS_ACT))
#define Qb ((bf16*)(ws + WS_QB))
#define Kb ((bf16*)(ws + WS_KB))
#define Vb ((bf16*)(ws + WS_VB))
#define Zb ((bf16*)(ws + WS_ZB))
#define Ob ((bf16*)(ws + WS_OB))
#define OPART ((float*)(ws + WS_OPART))
#define MLP ((float*)(ws + WS_ML))
#define pwt ((const bf16*)(ws + WS_POOLWT))
    if (tid < 16) ((LAS unsigned*)(lds + LDS_BYTES - 64))[tid] = 0u;
    const unsigned xcc = xb_xcc_id();
    if (tid == 0) (void)xb_add((unsigned*)KWS() + 4096 + XB_XCNT(xcc), 1u);
    __syncthreads();
    { const int gw = vcu0 * NWAVES + wave; prologue(lds, gw, NGW, wave, lane);
      norm_rows<false>(KIN(0), KIN(1), KIN(6), (bf16*)(KWS() + WS_H), nullptr, gw, NGW, lane); }
    CG_SYNC();
#define FRESH_IDS() int tid = threadIdx.x; asm volatile("" : "+v"(tid)); const int lane = tid & 63, wave = __builtin_amdgcn_readfirstlane(tid >> 6); int vcu = vcu0; asm volatile("" : "+s"(vcu)); const int gw = vcu * NWAVES + wave; (void)lane; (void)gw; (void)wave
#define CNT(nid, idx) ((unsigned*)(ws + CTL_CNT) + (size_t)((nid) * 80 + (idx)) * 64)
#pragma unroll 1
    for (int step = 0; step < 4; ++step) {
        const int l = step >> 1, f = step & 1;
        const bool first = (step == 0);
        { FRESH_IDS(); unsigned char* const ws = KWS(); unsigned char* const wl = ws + WS_W + (size_t)l * WL;
          pg8::Gemm g{H, (const bf16*)(wl + (f ? W_GU2 : W_GU1)), M, 2 * FF, D}; pg8::StaticOrder S; S.init(M, 2 * FF, G, bx);
          pg8::EpiSwiGLU E{ACT, FF};
          pg8::gemm_phase<pg8::EpiSwiGLU, pg8::StaticOrder, true, true>(lds, g, S, E); }
        GRID_SYNC();
        { FRESH_IDS(); unsigned char* const ws = KWS(); unsigned char* const wl = ws + WS_W + (size_t)l * WL;
          const bool last = (step == 3);
          const float* const gn = last ? KIN(25) : (f ? KIN(6) + (l + 1) * D : KIN(10) + l * D);
          const int nid = step * 2;
          float* const yo = KOUT() + OFF_Y;
          pg8::Gemm g{ACT, (const bf16*)(wl + (f ? W_D2 : W_D1)), MP, D, FF}; pg8::StaticOrder S; S.init(MP, D, G, bx);
          if (first) skinny_part1<false, FF>(lds, ACT + (size_t)MP * FF, (const bf16*)(wl + W_D1), KIN(1), X + (size_t)MP * D, 0.5f, (unsigned*)(ws + WS_SLOTS), CNT(nid, 64), vcu, tid);
          else skinny_part1<true, FF>(lds, ACT + (size_t)MP * FF, (const bf16*)(wl + (f ? W_D2 : W_D1)), X + (size_t)MP * D, last ? nullptr : X + (size_t)MP * D, 0.5f, (unsigned*)(ws + WS_SLOTS), CNT(nid, 64), vcu, tid);
          { pg8::Unit u0; const int pm0 = S.next(0, u0) ? u0.pm : 0;
            if (first) { pg8::EpiResidNorm<false> E{KIN(0), X, 0.5f, H, yo, gn, (unsigned*)(ws + WS_SLOTP), CNT(nid, pm0)};
                         pg8::gemm_phase<pg8::EpiResidNorm<false>, pg8::StaticOrder, false, true>(lds, g, S, E); }
            else { pg8::EpiResidNorm<true> E{X, last ? nullptr : X, 0.5f, last ? nullptr : H, yo, gn, (unsigned*)(ws + WS_SLOTP), CNT(nid, pm0)};
                   pg8::gemm_phase<pg8::EpiResidNorm<true>, pg8::StaticOrder, false, true>(lds, g, S, E); } }
          skinny_part2(lds, last ? nullptr : H + (size_t)MP * D, yo + (size_t)MP * D, gn, (unsigned*)(ws + WS_SLOTS), CNT(nid, 64), vcu, tid); }
        if (step == 3) break;
        GRID_SYNC();
        if (f == 0) {
            { FRESH_IDS(); unsigned char* const ws = KWS(); unsigned char* const wl = ws + WS_W + (size_t)l * WL;
              pg8::Gemm g{H, (const bf16*)(wl + W_IN), M, DIN, D}; pg8::StaticOrder S; S.init(M, DIN, G, bx);
              pg8::EpiWin E{ws, KOUT(), l, C2};
              pg8::gemm_phase<pg8::EpiWin, pg8::StaticOrder, true, true>(lds, g, S, E); }
            GRID_SYNC();
#pragma unroll 1
            for (int slot = 0; slot < 2; ++slot) {
              if (((slot ^ vcu0) & 1) == 0) {
                FRESH_IDS(); unsigned char* const ws = KWS();
                for (int i = 0; i < 4; ++i) {
                  const int L = i * G + vcu; if (L >= 1024) break;
                  const int bh = (L & 255) >> 1, sI = L & 1, ii = L >> 8;
                  const int qb = sI == 0 ? (ii == 0 ? 7 : ii == 1 ? 0 : ii == 2 ? 4 : 3) : (ii == 0 ? 6 : ii == 1 ? 1 : ii == 2 ? 5 : 2);
                  const int b = bh >> 4, vh = bh & 15, hh = vh >> 2, c = (vh >> 1) & 1, hf = vh & 1;
                  attn_body::attn_unit<8>(b, qb, (const attn_body::bf16*)(Qb + (hh * 2 + c) * 64), (const attn_body::bf16*)(Kb + (hh * 2 + c) * 64), (const attn_body::bf16*)(Vb + hh * 128 + hf * 64),
                                          (attn_body::bf16*)(Ob + c * 512 + hh * 128 + hf * 64), (char*)lds_raw);
                }
              } else {
                FRESH_IDS(); unsigned char* const ws = KWS(); float* const outp = KOUT();
                for (int pc = vcu; pc < 256; pc += G)
                  sample_piece(lds, pc, l, Qb, KIN(2), KIN(3), outp + OFF_KS, outp + OFF_VS, OPART, MLP, tid);
              }
              __syncthreads();
            }
            { FRESH_IDS(); unsigned char* const ws = KWS(); float* const outp = KOUT();
              for (int tl = vcu; tl < 264; tl += G)
                poolconv_tile(lds, tl, l, Zb, MIX, KIN(4), KIN(5), pwt, KIN(18), KIN(19), outp + OFF_CP, outp + OFF_CS, tid); }
            GRID_SYNC();
            { FRESH_IDS(); unsigned char* const ws = KWS();
              combine_phase(l, Ob, OPART, MLP, MIX, gw, NGW, lane); }
            GRID_SYNC();
            { FRESH_IDS(); unsigned char* const ws = KWS(); unsigned char* const wl = ws + WS_W + (size_t)l * WL;
              const float* const gn = KIN(21) + l * D; const int nid = step * 2 + 1;
              pg8::Gemm g{MIX, (const bf16*)(wl + W_OUT), MP, D, D}; pg8::StaticOrder S; S.init(MP, D, G, bx);
              skinny_part1<true, D>(lds, MIX + (size_t)MP * D, (const bf16*)(wl + W_OUT), X + (size_t)MP * D, X + (size_t)MP * D, 1.0f, (unsigned*)(ws + WS_SLOTS), CNT(nid, 64), vcu, tid);
              { pg8::Unit u0; const int pm0 = S.next(0, u0) ? u0.pm : 0;
                pg8::EpiResidNorm<true> E{X, X, 1.0f, H, nullptr, gn, (unsigned*)(ws + WS_SLOTP), CNT(nid, pm0)};
                pg8::gemm_phase<pg8::EpiResidNorm<true>, pg8::StaticOrder, false, true>(lds, g, S, E); }
              skinny_part2(lds, H + (size_t)MP * D, nullptr, gn, (unsigned*)(ws + WS_SLOTS), CNT(nid, 64), vcu, tid); }
            GRID_SYNC();
        }
    }
}

extern "C" void kernel_launch(void* const* d_in, const int* in_sizes, int n_in, void* d_out, int out_size, void* d_ws, size_t ws_size, hipStream_t stream) {
    static int grid = 0;
    if (grid == 0) {
        if (n_in != 26 || (size_t)out_size != OUT_TOTAL || ws_size < WS_END) { fprintf(stderr, "kernel_launch: unexpected problem shape: n_in %d out %d ws %zu\n", n_in, out_size, ws_size); grid = -1; return; }
        int dev = 0, cus = 0, per_cu = 0;
        if (hipGetDevice(&dev) != hipSuccess || hipDeviceGetAttribute(&cus, hipDeviceAttributeMultiprocessorCount, dev) != hipSuccess) { grid = -1; return; }
        if (hipFuncSetAttribute((const void*)mega_fwd, hipFuncAttributeMaxDynamicSharedMemorySize, LDS_BYTES) != hipSuccess) { fprintf(stderr, "kernel_launch: hipFuncSetAttribute failed\n"); grid = -1; return; }
        if (hipOccupancyMaxActiveBlocksPerMultiprocessor(&per_cu, (const void*)mega_fwd, NWAVES * 64, LDS_BYTES) != hipSuccess || per_cu < 1) { fprintf(stderr, "kernel_launch: occupancy query says %d\n", per_cu); per_cu = 1; }
        (void)hipGetLastError();
        grid = cus * per_cu;
    }
    if (grid < 0) return;
    if (hipMemsetAsync(d_ws, 0, CTL_BYTES, stream) != hipSuccess) { fprintf(stderr, "kernel_launch: memset failed\n"); return; }
    Params p{};
    for (int i = 0; i < 26; ++i) p.in[i] = (const float*)d_in[i];
    p.out = (float*)d_out; p.ws = (unsigned char*)d_ws;
    void* args[] = {&p};
    const hipError_t e = hipLaunchCooperativeKernel((const void*)mega_fwd, dim3(grid), dim3(NWAVES * 64), args, LDS_BYTES, stream);
    if (e != hipSuccess) fprintf(stderr, "kernel_launch: cooperative launch failed: %s (grid %d)\n", hipGetErrorString(e), grid);
}
```

```cpp
#include <hip/hip_runtime.h>
#include <hip/hip_cooperative_groups.h>
#include <cstdio>
#include <cstdint>
namespace pg8 {
#define PG8_LAS __attribute__((address_space(3)))
typedef unsigned short bf16_t;
typedef short bf16x8 __attribute__((ext_vector_type(8)));
typedef float f32x4 __attribute__((ext_vector_type(4)));
typedef unsigned u32x4 __attribute__((ext_vector_type(4)));
constexpr int BM = 256, BK = 64, HALF = 128, HTB = HALF * BK * 2  , STAGE_BYTES = 8 * HTB, NXCD = 8, WGM = 8;

__host__ __device__ __forceinline__ int lds_byte(int r, int c) { const int st = (r >> 4) * 2 + (c >> 5), rr = r & 15, cc = c & 31, ob = rr * 64 + cc * 2; return st * 1024 + (ob ^ (((ob >> 9) & 1) << 5)); }
__host__ __device__ __forceinline__ void stage_rc(int b, int& R, int& C) { const int st = b / 1024, sb = b % 1024, swz = sb ^ (((sb >> 9) & 1) << 5); R = (st >> 1) * 16 + swz / 64; C = (st & 1) * 32 + (swz % 64) / 2; }
__host__ __device__ __forceinline__ int perm32(int rho) { const int n = rho >> 4, i = rho & 15; return 8 * (i >> 2) + 4 * n + (i & 3); }

struct Unit { int pm, pn; };
struct Gemm { const bf16_t* A; const bf16_t* Bt; int M, N, K; };

struct StaticOrder {
    int nM, nN, nwg, G, c;
    __host__ __device__ __forceinline__ void init(int M, int N, int G_, int c_) { nM = M / BM; nN = N / BM; nwg = nM * nN; G = G_; c = c_; }
    __host__ __device__ __forceinline__ bool next(int i, Unit& u) const {
        const long L = (long)i * G + c; if (L >= nwg) return false;
        int wgid = (int)L; { const int q = nwg / NXCD, r = nwg % NXCD, xcd = wgid % NXCD, off = wgid / NXCD; wgid = (xcd < r ? xcd * (q + 1) : r * (q + 1) + (xcd - r) * q) + off; }
        const int nig = WGM * nN, gid = wgid / nig, fm = gid * WGM, gsz = (nM - fm) < WGM ? (nM - fm) : WGM;
        u.pm = fm + ((wgid % nig) % gsz); u.pn = (wgid % nig) / gsz; return true;
    }
    __device__ __forceinline__ void a_ready(const Unit&) const {}
    __device__ __forceinline__ void done(const Unit&) const {}
};

__device__ __forceinline__ unsigned cvt_pk_bf16(float lo, float hi) { unsigned r; asm volatile("v_cvt_pk_bf16_f32 %0, %1, %2" : "=v"(r) : "v"(lo), "v"(hi)); return r; }
typedef float f32x2 __attribute__((ext_vector_type(2)));
typedef unsigned u32x2 __attribute__((ext_vector_type(2)));
constexpr size_t WOFF_ROPE = (size_t)1 << 20, WOFF_QB = (size_t)215 << 20, WOFF_KB = (size_t)232 << 20, WOFF_VB = (size_t)249 << 20, WOFF_ZB = (size_t)266 << 20;
constexpr size_t OOFF_KP = 17039360, OOFF_VP = 33816576, OOFF_PP = 50593792, OOFF_KS = 50663424, OOFF_VS = 50925568, OOFF_PS = 51187712;
__device__ __forceinline__ float silu_mul(float g, float u) { const float e = __builtin_amdgcn_exp2f(-1.4426950408889634f * g); return g * u * __builtin_amdgcn_rcpf(1.0f + e); }
struct EpiSwiGLU {
    static constexpr bool PERM = true, AFTER_DRAIN = false;
    bf16_t* O; int ldc;
    __device__ __forceinline__ void operator()(const f32x4 (&acc)[2][2][4][2], const Unit& u, int wr, int wc, int fr, int fq) const {
        const int row0 = u.pm * BM + wr * 64 + fr; const int col0 = u.pn * 128 + wc * 32 + 8 * fq;
#pragma unroll
        for (int ai = 0; ai < 2; ++ai)
#pragma unroll
            for (int m = 0; m < 4; ++m) {
                bf16_t* p = O + (size_t)(row0 + ai * HALF + m * 16) * ldc + col0;
                const f32x4 g0 = acc[ai][0][m][0], g1 = acc[ai][0][m][1], u0 = acc[ai][1][m][0], u1 = acc[ai][1][m][1];
                u32x4 w;
                w.x = cvt_pk_bf16(silu_mul(g0[0], u0[0]), silu_mul(g0[1], u0[1])); w.y = cvt_pk_bf16(silu_mul(g0[2], u0[2]), silu_mul(g0[3], u0[3]));
                w.z = cvt_pk_bf16(silu_mul(g1[0], u1[0]), silu_mul(g1[1], u1[1])); w.w = cvt_pk_bf16(silu_mul(g1[2], u1[2]), silu_mul(g1[3], u1[3]));
                *(u32x4*)p = w;
                asm volatile("" ::: "memory");
            }
    }
};
struct EpiResid {
    static constexpr bool PERM = false, AFTER_DRAIN = false;
    const float* baseP; const float* baseS; float* out; float scale;
    __device__ __forceinline__ void operator()(const f32x4 (&acc)[2][2][4][2], const Unit& u, int wr, int wc, int fr, int fq) const {
        const int col0 = u.pn * BM + wc * 32 + 4 * fq;
#pragma unroll
        for (int ai = 0; ai < 2; ++ai)
#pragma unroll
            for (int m = 0; m < 4; ++m) {
                const int row = u.pm * BM + ai * HALF + wr * 64 + m * 16 + fr;
                const float* bp = (row < 16384) ? baseP + (size_t)row * 1024 : baseS + (size_t)(row - 16384) * 1024;
                float* op = out + (size_t)row * 1024;
#pragma unroll
                for (int bj = 0; bj < 2; ++bj)
#pragma unroll
                    for (int n = 0; n < 2; ++n) { const int c = col0 + bj * HALF + n * 16; const f32x4 b = *(const f32x4*)(bp + c); *(f32x4*)(op + c) = b + acc[ai][bj][m][n] * scale; }
                asm volatile("" ::: "memory");
            }
    }
};
constexpr float RMS_EPS = 1e-6f;
__device__ __forceinline__ float rstd_of(float ss) { return 1.0f / sqrtf(ss * (1.0f / 1024.0f) + RMS_EPS); }

#define PG8_RLX_AGENT __ATOMIC_RELAXED, __HIP_MEMORY_SCOPE_AGENT
template <bool BASE16> struct EpiResidNorm {
    static constexpr bool PERM = false, AFTER_DRAIN = true;
    const void* baseP; bf16_t* out; float scale; bf16_t* hb; float* yout; const float* gain; unsigned* slots; unsigned* cnt;
    __device__ __forceinline__ void fused(f32x4 (&acc)[2][2][4][2], const Unit& u, int wr, int wc, int fr, int fq, PG8_LAS unsigned char* lds, int wid, int lane) const {
        PG8_LAS float* P = (PG8_LAS float*)lds;
        PG8_LAS float* S = (PG8_LAS float*)(lds + 4096);
        const int col0 = u.pn * BM + wc * 32 + 4 * fq;
        if (BASE16) {
            u32x2 braw[2][4][2][2];
#pragma unroll
            for (int ai = 0; ai < 2; ++ai)
#pragma unroll
                for (int m = 0; m < 4; ++m) { const size_t ro = (size_t)(u.pm * BM + ai * HALF + wr * 64 + m * 16 + fr) * 1024;
#pragma unroll
                    for (int bj = 0; bj < 2; ++bj)
#pragma unroll
                        for (int n = 0; n < 2; ++n) braw[ai][m][bj][n] = *(const u32x2*)((const bf16_t*)baseP + ro + col0 + bj * HALF + n * 16); }
#pragma unroll
            for (int ai = 0; ai < 2; ++ai)
#pragma unroll
                for (int m = 0; m < 4; ++m)
#pragma unroll
                    for (int bj = 0; bj < 2; ++bj)
#pragma unroll
                        for (int n = 0; n < 2; ++n) { const u32x2 bw = braw[ai][m][bj][n]; f32x4 bv; bv[0] = __builtin_bit_cast(float, bw.x << 16); bv[1] = __builtin_bit_cast(float, bw.x & 0xffff0000u); bv[2] = __builtin_bit_cast(float, bw.y << 16); bv[3] = __builtin_bit_cast(float, bw.y & 0xffff0000u);
                            acc[ai][bj][m][n] = bv + acc[ai][bj][m][n] * scale; }
        }
#pragma unroll
        for (int ai = 0; ai < 2; ++ai)
#pragma unroll
            for (int m = 0; m < 4; ++m) {
                const int rl = ai * HALF + wr * 64 + m * 16 + fr; const size_t ro = (size_t)(u.pm * BM + rl) * 1024;
                float ss = 0.f;
#pragma unroll
                for (int bj = 0; bj < 2; ++bj)
#pragma unroll
                    for (int n = 0; n < 2; ++n) { const int c = col0 + bj * HALF + n * 16; f32x4 v;
                        if (BASE16) v = acc[ai][bj][m][n];
                        else { v = *(const f32x4*)((const float*)baseP + ro + c) + acc[ai][bj][m][n] * scale; acc[ai][bj][m][n] = v; }
                        if (out) { u32x2 w; w.x = cvt_pk_bf16(v[0], v[1]); w.y = cvt_pk_bf16(v[2], v[3]); *(u32x2*)(out + ro + c) = w; }
                        ss += (v[0] * v[0] + v[1] * v[1]) + (v[2] * v[2] + v[3] * v[3]); }
                ss += __builtin_bit_cast(float, __builtin_amdgcn_ds_swizzle(__builtin_bit_cast(int, ss), (16 << 10) | 0x1f));
                { float a = ss, b2 = ss; asm volatile("s_nop 1\n\tv_permlane32_swap_b32 %0, %1\n\ts_nop 1" : "+v"(a), "+v"(b2)); ss = a + b2; }
                if (fq == 0) P[rl * 4 + wc] = ss;
                if (!BASE16 && (m & 1)) asm volatile("" ::: "memory");
            }
        asm volatile("s_waitcnt lgkmcnt(0)\n\ts_barrier" ::: "memory");
        const int t = wid * 64 + lane;
        if (t < 256) { const float s = (P[t * 4] + P[t * 4 + 1]) + (P[t * 4 + 2] + P[t * 4 + 3]);
            __hip_atomic_store(slots + (size_t)(u.pm * BM + t) * 4 + u.pn, __builtin_bit_cast(unsigned, s), PG8_RLX_AGENT); }
        asm volatile("s_waitcnt vmcnt(0)" ::: "memory");
        if (wid < 4 && lane == 0) __hip_atomic_fetch_add(cnt, 1u, PG8_RLX_AGENT);
        if (wid == 0) {
            unsigned spins = 0;
            while ((unsigned)__builtin_amdgcn_readfirstlane(__hip_atomic_load(cnt, PG8_RLX_AGENT)) < 16u) { __builtin_amdgcn_s_sleep(2); if (++spins > (1u << 22)) break; }
            __builtin_amdgcn_fence(__ATOMIC_ACQUIRE, "agent");
        }
        asm volatile("s_waitcnt vmcnt(0) lgkmcnt(0)\n\ts_barrier" ::: "memory");
        if (t < 256) { const unsigned* sl = slots + (size_t)(u.pm * BM + t) * 4; float tot = 0.f;
#pragma unroll
            for (int k = 0; k < 4; ++k) tot += __builtin_bit_cast(float, __hip_atomic_load(sl + k, PG8_RLX_AGENT));
            S[t] = rstd_of(tot); }
        asm volatile("s_waitcnt lgkmcnt(0)\n\ts_barrier" ::: "memory");
        f32x4 g4[2][2];
#pragma unroll
        for (int bj = 0; bj < 2; ++bj)
#pragma unroll
            for (int n = 0; n < 2; ++n) g4[bj][n] = *(const f32x4*)(gain + col0 + bj * HALF + n * 16);
#pragma unroll
        for (int ai = 0; ai < 2; ++ai)
#pragma unroll
            for (int m = 0; m < 4; ++m) {
                const int rl = ai * HALF + wr * 64 + m * 16 + fr; const size_t ro = (size_t)(u.pm * BM + rl) * 1024; const float r = S[rl];
#pragma unroll
                for (int bj = 0; bj < 2; ++bj)
#pragma unroll
                    for (int n = 0; n < 2; ++n) { const int c = col0 + bj * HALF + n * 16; const f32x4 y = acc[ai][bj][m][n] * r * g4[bj][n];
                        if (hb) { u32x2 w; w.x = cvt_pk_bf16(y[0], y[1]); w.y = cvt_pk_bf16(y[2], y[3]); *(u32x2*)(hb + ro + c) = w; }
                        else *(f32x4*)(yout + ro + c) = y; }
            }
        asm volatile("s_waitcnt lgkmcnt(0)\n\ts_barrier" ::: "memory");
    }
};

struct EpiWin {
    static constexpr bool PERM = false, AFTER_DRAIN = false;
    unsigned char* ws; float* outp; int l; float qscale;
    __device__ __forceinline__ void operator()(const f32x4 (&acc)[2][2][4][2], const Unit& u, int wr, int wc, int fr, int fq) const {
        const int pn = u.pn;
        float invrev[4];
#pragma unroll
        for (int j = 0; j < 4; ++j) invrev[j] = exp2f(-(float)(16 * (wc & 1) + 4 * fq + j) * (13.287712379549449f / 32.0f)) * 0.15915494309189535f;
        bf16_t* const Qb = (bf16_t*)(ws + WOFF_QB); bf16_t* const Kb = (bf16_t*)(ws + WOFF_KB); bf16_t* const Vb = (bf16_t*)(ws + WOFF_VB); bf16_t* const Zb = (bf16_t*)(ws + WOFF_ZB);
        const float* const rope = (const float*)(ws + WOFF_ROPE);
        float* const kP = outp + OOFF_KP + (size_t)l * 16384 * 512; float* const vP = outp + OOFF_VP + (size_t)l * 16384 * 512;
        float* const kS = outp + OOFF_KS + (size_t)l * 256 * 512; float* const vS = outp + OOFF_VS + (size_t)l * 256 * 512;
        float* const poolP = outp + OOFF_PP + (size_t)l * 8 * 15 * 256; float* const poolS = outp + OOFF_PS + (size_t)l * 8 * 15 * 256;
#pragma unroll
        for (int ai = 0; ai < 2; ++ai)
#pragma unroll
            for (int m = 0; m < 4; ++m) {
                const int row = u.pm * BM + ai * HALF + wr * 64 + m * 16 + fr;
                const bool smp = row >= 16384; const int rs = row - 16384;
                const int prow = smp ? 2048 + (rs & 31) : (row & 2047);
#pragma unroll
                for (int bj = 0; bj < 2; ++bj) {
                    const int dlo = 16 * (wc & 1) + 4 * fq, lc0 = 64 * (2 * bj + (wc >> 1)) + dlo;
                    const f32x4 a0 = acc[ai][bj][m][0], a1 = acc[ai][bj][m][1];
                    if (pn < 4) {
                        f32x4 cs, sn; { const float posf = (float)(smp ? 4096 + (rs & 31) : (row & 2047));
#pragma unroll
                          for (int j = 0; j < 4; ++j) { const float rev = posf * invrev[j]; const float fr_ = rev - __builtin_rintf(rev); cs[j] = __builtin_amdgcn_cosf(fr_); sn[j] = __builtin_amdgcn_sinf(fr_); } }
                        const f32x4 r0 = a0 * cs - a1 * sn, r1 = a1 * cs + a0 * sn;
                        if (pn < 2) {
                            const int col = 256 * pn + lc0; bf16_t* q = Qb + (size_t)row * 512 + col;
                            u32x2 w0, w1; w0.x = cvt_pk_bf16(r0[0] * qscale, r0[1] * qscale); w0.y = cvt_pk_bf16(r0[2] * qscale, r0[3] * qscale);
                            w1.x = cvt_pk_bf16(r1[0] * qscale, r1[1] * qscale); w1.y = cvt_pk_bf16(r1[2] * qscale, r1[3] * qscale);
                            *(u32x2*)q = w0; *(u32x2*)(q + 32) = w1;
                        } else {
                            const int col = 256 * (pn - 2) + lc0; bf16_t* k = Kb + (size_t)row * 512 + col;
                            float* ko = smp ? kS + (size_t)rs * 512 + col : kP + (size_t)row * 512 + col;
                            *(f32x4*)ko = r0; *(f32x4*)(ko + 32) = r1;
                            u32x2 w0, w1; w0.x = cvt_pk_bf16(r0[0], r0[1]); w0.y = cvt_pk_bf16(r0[2], r0[3]); w1.x = cvt_pk_bf16(r1[0], r1[1]); w1.y = cvt_pk_bf16(r1[2], r1[3]);
                            *(u32x2*)k = w0; *(u32x2*)(k + 32) = w1;
                        }
                    } else if (pn < 6) {
                        const int col = 256 * (pn - 4) + lc0; bf16_t* v = Vb + (size_t)row * 512 + col;
                        float* vo = smp ? vS + (size_t)rs * 512 + col : vP + (size_t)row * 512 + col;
                        *(f32x4*)vo = a0; *(f32x4*)(vo + 32) = a1;
                        u32x2 w0, w1; w0.x = cvt_pk_bf16(a0[0], a0[1]); w0.y = cvt_pk_bf16(a0[2], a0[3]); w1.x = cvt_pk_bf16(a1[0], a1[1]); w1.y = cvt_pk_bf16(a1[2], a1[3]);
                        *(u32x2*)v = w0; *(u32x2*)(v + 32) = w1;
                    } else {
                        const int col = 256 * (pn - 6) + lc0; bf16_t* z = Zb + (size_t)row * 1024 + col;
                        u32x2 w0, w1; w0.x = cvt_pk_bf16(a0[0], a0[1]); w0.y = cvt_pk_bf16(a0[2], a0[3]); w1.x = cvt_pk_bf16(a1[0], a1[1]); w1.y = cvt_pk_bf16(a1[2], a1[3]);
                        *(u32x2*)z = w0; *(u32x2*)(z + 32) = w1;
                        if (pn == 6) {
                            if (smp) { const int b = rs >> 5, t = rs & 31; if (t >= 17) { float* po = poolS + (size_t)(b * 15 + t - 17) * 256 + lc0; *(f32x4*)po = a0; *(f32x4*)(po + 32) = a1; } }
                            else { const int b = row >> 11, t = row & 2047; if (t >= 2033) { float* po = poolP + (size_t)(b * 15 + t - 2033) * 256 + lc0; *(f32x4*)po = a0; *(f32x4*)(po + 32) = a1; } }
                        }
                    }
                }
                asm volatile("" ::: "memory");
            }
    }
};
template <class Epi, class Sched, bool ALIGN_EPI = false, bool SP2 = false>
__device__ __forceinline__ void gemm_phase(PG8_LAS unsigned char* lds, const Gemm g, const Sched& S, const Epi& E) {
    int tid_l = threadIdx.x; asm volatile("" : "+v"(tid_l)); const int tid = tid_l, wid = __builtin_amdgcn_readfirstlane(tid >> 6), lane = tid & 63, wr = wid >> 2, wc = wid & 3, fr = lane & 15, fq = lane >> 4;
    const int K = g.K, nt = K / BK;
    unsigned voffA[2], voffB[2];
#pragma unroll
    for (int i = 0; i < 2; ++i) { int R, C; stage_rc(tid * 16 + i * 8192, R, C); const int Rb = Epi::PERM ? ((R & ~31) + perm32(R & 31)) : R;
        voffA[i] = (unsigned)(R * K + C) * 2u; voffB[i] = (unsigned)(Rb * K + C) * 2u; }
    const size_t kstep = (size_t)(BK * 2);
    const size_t hstep = (size_t)HALF * K * 2;
    const size_t tstep = 2 * hstep;
    const unsigned ldsw = (unsigned)wid * 1024u;
    const int aoff = lds_byte(wr * 64 + fr, fq * 8), boff = lds_byte(wc * 32 + fr, fq * 8);
#define PG8_SA(b, h) (((b) * 2 + (h)) * HTB)
#define PG8_SB(b, h) ((4 + (b) * 2 + (h)) * HTB)
#define PG8_STAGE(bufoff, gbase, voff) do { _Pragma("unroll") for (int _i = 0; _i < 2; ++_i) \
        __builtin_amdgcn_global_load_lds((const unsigned*)((const char*)(gbase) + (voff)[_i]), (PG8_LAS unsigned*)(lds + (bufoff) + ldsw + _i * 8192), 16, 0, 0); } while (0)
#define PG8_LDA(dst, b, h) do { _Pragma("unroll") for (int m = 0; m < 4; ++m) _Pragma("unroll") for (int k = 0; k < 2; ++k) dst[m][k] = *(const PG8_LAS bf16x8*)(lds + PG8_SA(b, h) + aoff + m * 2048 + k * 1024); } while (0)
#define PG8_LDB(dst, b, h) do { _Pragma("unroll") for (int n = 0; n < 2; ++n) _Pragma("unroll") for (int k = 0; k < 2; ++k) dst[n][k] = *(const PG8_LAS bf16x8*)(lds + PG8_SB(b, h) + boff + n * 2048 + k * 1024); } while (0)
#define PG8_MMA(ai, bj, At, Bt) do { __builtin_amdgcn_s_setprio(1); _Pragma("unroll") for (int m = 0; m < 4; ++m) _Pragma("unroll") for (int n = 0; n < 2; ++n) _Pragma("unroll") for (int k = 0; k < 2; ++k) \
        acc[ai][bj][m][n] = __builtin_amdgcn_mfma_f32_16x16x32_bf16(Bt[n][k], At[m][k], acc[ai][bj][m][n], 0, 0, 0); __builtin_amdgcn_s_setprio(0); } while (0)
#define PG8_WAIT_V(n) asm volatile("s_waitcnt vmcnt(" #n ")" ::: "memory")
#define PG8_WAIT_L(n) asm volatile("s_waitcnt lgkmcnt(" #n ")" ::: "memory")
#define PG8_BAR __builtin_amdgcn_s_barrier()
#define PG8_SCHED __builtin_amdgcn_sched_barrier(0)
    Unit cur, nxt; int ui = 0;
    if (!S.next(0, cur)) return;
    f32x4 acc[2][2][4][2];
#pragma unroll
    for (int a = 0; a < 2; ++a)
#pragma unroll
        for (int b = 0; b < 2; ++b)
#pragma unroll
            for (int m = 0; m < 4; ++m)
#pragma unroll
                for (int n = 0; n < 2; ++n) acc[a][b][m][n] = (f32x4){0.f, 0.f, 0.f, 0.f};
    bf16x8 At[4][2], B0[2][2], B1[2][2];
    const char* cA = (const char*)g.A + (size_t)cur.pm * tstep; const char* cB = (const char*)g.Bt + (size_t)cur.pn * tstep;
    S.a_ready(cur);
    if constexpr (SP2) {
        PG8_STAGE(PG8_SB(0, 0), cB, voffB); PG8_STAGE(PG8_SB(0, 1), cB + hstep, voffB); PG8_STAGE(PG8_SA(0, 0), cA, voffA); PG8_STAGE(PG8_SA(0, 1), cA + hstep, voffA);
        if (wr == 1) PG8_BAR;
        PG8_WAIT_V(2); PG8_BAR;
        PG8_STAGE(PG8_SB(1, 0), cB + kstep, voffB); PG8_STAGE(PG8_SA(1, 0), cA + kstep, voffA); PG8_STAGE(PG8_SB(1, 1), cB + hstep + kstep, voffB);
        PG8_WAIT_V(6); PG8_BAR;
    } else {
        PG8_STAGE(PG8_SB(0, 0), cB, voffB); PG8_STAGE(PG8_SA(0, 0), cA, voffA); PG8_STAGE(PG8_SB(0, 1), cB + hstep, voffB); PG8_STAGE(PG8_SA(0, 1), cA + hstep, voffA);
        if (wr == 1) PG8_BAR;
        PG8_WAIT_V(4); PG8_BAR;
        PG8_STAGE(PG8_SB(1, 0), cB + kstep, voffB); PG8_STAGE(PG8_SA(1, 0), cA + kstep, voffA); PG8_STAGE(PG8_SB(1, 1), cB + hstep + kstep, voffB);
        PG8_WAIT_V(6); PG8_BAR;
    }
    for (;;) {
        const bool has_next = S.next(ui + 1, nxt);
        const char* nA = has_next ? (const char*)g.A + (size_t)nxt.pm * tstep : cA; const char* nB = has_next ? (const char*)g.Bt + (size_t)nxt.pn * tstep : cB;
        for (int t = 0; t < nt; t += 2) {
            const bool last = (t == nt - 2);
            const char* a1 = cA + (size_t)(t + 1) * kstep;
            const char* a2 = last ? nA : cA + (size_t)(t + 2) * kstep; const char* b2 = last ? nB : cB + (size_t)(t + 2) * kstep;
            const char* a3 = a2 + kstep; const char* b3 = b2 + kstep;
            if (last && has_next) S.a_ready(nxt);
            if constexpr (SP2) {
            PG8_LDB(B0, 0, 0); PG8_LDB(B1, 0, 1); PG8_SCHED; PG8_LDA(At, 0, 0); PG8_STAGE(PG8_SA(1, 1), a1 + hstep, voffA);
            PG8_WAIT_V(8); PG8_WAIT_L(0); PG8_BAR; PG8_MMA(0, 0, At, B0); PG8_MMA(0, 1, At, B1); PG8_BAR; PG8_SCHED;
            PG8_LDA(At, 0, 1); PG8_STAGE(PG8_SB(0, 0), b2, voffB); PG8_STAGE(PG8_SB(0, 1), b2 + hstep, voffB); PG8_STAGE(PG8_SA(0, 0), a2, voffA);
            PG8_WAIT_V(8); PG8_WAIT_L(0); PG8_BAR; PG8_MMA(1, 0, At, B0); PG8_MMA(1, 1, At, B1); PG8_BAR; PG8_SCHED;
            PG8_LDB(B0, 1, 0); PG8_LDB(B1, 1, 1); PG8_SCHED; PG8_LDA(At, 1, 0); PG8_STAGE(PG8_SA(0, 1), a2 + hstep, voffA);
            PG8_WAIT_V(8); PG8_WAIT_L(0); PG8_BAR; PG8_MMA(0, 0, At, B0); PG8_MMA(0, 1, At, B1); PG8_BAR; PG8_SCHED;
            PG8_LDA(At, 1, 1); PG8_STAGE(PG8_SB(1, 0), b3, voffB); PG8_STAGE(PG8_SB(1, 1), b3 + hstep, voffB); PG8_STAGE(PG8_SA(1, 0), a3, voffA);
            PG8_WAIT_V(8); PG8_WAIT_L(0); PG8_BAR; PG8_MMA(1, 0, At, B0); PG8_MMA(1, 1, At, B1); PG8_BAR; PG8_SCHED;
            } else {
            PG8_LDB(B0, 0, 0); PG8_SCHED; PG8_LDA(At, 0, 0); PG8_STAGE(PG8_SA(1, 1), a1 + hstep, voffA);
            PG8_WAIT_L(8); PG8_BAR; PG8_WAIT_L(0); PG8_MMA(0, 0, At, B0); PG8_BAR; PG8_SCHED;
            PG8_LDB(B1, 0, 1); PG8_STAGE(PG8_SB(0, 0), b2, voffB);
            PG8_BAR; PG8_WAIT_L(0); PG8_MMA(0, 1, At, B1); PG8_BAR;
            PG8_LDA(At, 0, 1); PG8_STAGE(PG8_SA(0, 0), a2, voffA);
            PG8_BAR; PG8_WAIT_L(0); PG8_MMA(1, 0, At, B0); PG8_BAR; PG8_SCHED;
            PG8_STAGE(PG8_SB(0, 1), b2 + hstep, voffB);
            PG8_WAIT_V(6); PG8_BAR; PG8_MMA(1, 1, At, B1); PG8_BAR;
            PG8_LDB(B0, 1, 0); PG8_SCHED; PG8_LDA(At, 1, 0); PG8_STAGE(PG8_SA(0, 1), a2 + hstep, voffA);
            PG8_WAIT_L(8); PG8_BAR; PG8_WAIT_L(0); PG8_MMA(0, 0, At, B0); PG8_BAR; PG8_SCHED;
            PG8_LDB(B1, 1, 1); PG8_STAGE(PG8_SB(1, 0), b3, voffB);
            PG8_BAR; PG8_WAIT_L(0); PG8_MMA(0, 1, At, B1); PG8_BAR;
            PG8_LDA(At, 1, 1); PG8_STAGE(PG8_SA(1, 0), a3, voffA);
            PG8_BAR; PG8_WAIT_L(0); PG8_MMA(1, 0, At, B0); PG8_BAR; PG8_SCHED;
            PG8_STAGE(PG8_SB(1, 1), b3 + hstep, voffB);
            PG8_WAIT_V(6); PG8_BAR; PG8_MMA(1, 1, At, B1); PG8_BAR;
            }
        }
        if constexpr (ALIGN_EPI) { if (wr == 0) PG8_BAR; }
        if constexpr (!Epi::AFTER_DRAIN) { E(acc, cur, wr, wc, fr, fq); S.done(cur); }
        if (!has_next) break;
#pragma unroll
        for (int a = 0; a < 2; ++a)
#pragma unroll
            for (int b = 0; b < 2; ++b)
#pragma unroll
                for (int m = 0; m < 4; ++m)
#pragma unroll
                    for (int n = 0; n < 2; ++n) acc[a][b][m][n] = (f32x4){0.f, 0.f, 0.f, 0.f};
        cur = nxt; cA = nA; cB = nB; ++ui;
        if constexpr (ALIGN_EPI) { if (wr == 1) PG8_BAR; }
    }
    PG8_WAIT_V(0);
    if constexpr (!ALIGN_EPI) { if (wr == 0) PG8_BAR; }
    PG8_BAR;
    if constexpr (Epi::AFTER_DRAIN) { E.fused(acc, cur, wr, wc, fr, fq, lds, wid, lane); S.done(cur); }
#undef PG8_SA
#undef PG8_SB
#undef PG8_STAGE
#undef PG8_LDA
#undef PG8_LDB
#undef PG8_MMA
#undef PG8_WAIT_V
#undef PG8_WAIT_L
#undef PG8_BAR
#undef PG8_SCHED
}
}
#include <hip/hip_bf16.h>
#include <cmath>
namespace attn_body {
using bf16=__hip_bfloat16;
using bf16x8=__attribute__((ext_vector_type(8)))short;
using s16x4=__attribute__((ext_vector_type(4)))short;
using f32x16=__attribute__((ext_vector_type(16)))float;
using u32x4=__attribute__((ext_vector_type(4)))unsigned;
constexpr int BATCH=8,NHEAD=16,SEQ=2048,D=64,PQK=512,PO=1024;
constexpr int NW=8,QBLK=32,QB=QBLK*NW,KVBLK=64,NQB=SEQ/QB;
constexpr int ATTN_UNIT_ROWS=QB;
__device__ __forceinline__ int crow(int r,int hi){return (r&3)+8*(r>>2)+4*hi;}
#define SBAR() __builtin_amdgcn_sched_barrier(0)
__device__ __forceinline__ void cmask(f32x16&p0,f32x16&p1,int jb,int qrel,int hi){
  const float NEG=-INFINITY; (void)hi;
  if(jb>(qrel>>6)){
  #pragma unroll
  for(int r=0;r<16;++r){p0[r]=NEG;p1[r]=NEG;}}
}

constexpr int NSLOT=3, SLOTB=8192;
constexpr int LDS_K=0, LDS_V=NSLOT*SLOTB, LDS_WS=2*NSLOT*SLOTB, LDS_OST=LDS_WS+NW*64*4, LDS_BYTES=LDS_OST+NW*4096;
constexpr float C2=0.125f*1.4426950408889634f;
__device__ __forceinline__ void glds16(const void*gsrc,unsigned lds_dst){unsigned keep;
  asm volatile("s_mov_b32 %0, m0\n\ts_mov_b32 m0, %2\n\ts_nop 0\n\tglobal_load_lds_dwordx4 %1, off\n\ts_mov_b32 m0, %0":"=&s"(keep):"v"(gsrc),"s"(lds_dst):"memory");}
__device__ __forceinline__ float max3f(float a,float b,float c){float r;asm("v_max3_f32 %0, %1, %2, %3":"=v"(r):"v"(a),"v"(b),"v"(c));return r;}
__device__ __forceinline__ float max2f(float a,float b){float r;asm("v_max_f32_e32 %0, %1, %2":"=v"(r):"v"(a),"v"(b));return r;}
__device__ __forceinline__ float fadd_s(float a,float b){float r;asm("v_add_f32_e32 %0, %1, %2":"=v"(r):"v"(a),"v"(b));return r;}
__device__ __forceinline__ float fsub_s(float a,float b){float r;asm("v_sub_f32_e32 %0, %1, %2":"=v"(r):"v"(a),"v"(b));return r;}
typedef float f32x2_t __attribute__((ext_vector_type(2))); typedef __bf16 bf16x2_t __attribute__((ext_vector_type(2)));
__device__ __forceinline__ unsigned cvtpk_s(float lo,float hi){f32x2_t v={lo,hi};bf16x2_t b=__builtin_convertvector(v,bf16x2_t);return __builtin_bit_cast(unsigned,b);}
#define WAIT_BAR(N) asm volatile("s_waitcnt vmcnt(" #N ") lgkmcnt(0)\n\ts_barrier":::"memory")

__device__ __forceinline__ void qkt(f32x16&p0,f32x16&p1,const char*Kslot,const bf16x8*qr,const f32x16&negm,int r32,int hi){
  const char*kb=Kslot+hi*1024+r32*16;
  #pragma unroll
  for(int d0=0;d0<4;++d0){
    const bf16x8 b0=*reinterpret_cast<const bf16x8*>(kb+d0*2048);
    const bf16x8 b1=*reinterpret_cast<const bf16x8*>(kb+d0*2048+512);
    if(d0==0){p0=__builtin_amdgcn_mfma_f32_32x32x16_bf16(b0,qr[0],negm,0,0,0);p1=__builtin_amdgcn_mfma_f32_32x32x16_bf16(b1,qr[0],negm,0,0,0);}
    else{p0=__builtin_amdgcn_mfma_f32_32x32x16_bf16(b0,qr[d0],p0,0,0,0);p1=__builtin_amdgcn_mfma_f32_32x32x16_bf16(b1,qr[d0],p1,0,0,0);}}
}
typedef __attribute__((address_space(3))) const char* lds_cptr;
typedef short v4i16_t __attribute__((ext_vector_type(4)));
__device__ __forceinline__ void kload8(bf16x8*kf,lds_cptr kp){
  kf[0]=*(const __attribute__((address_space(3))) bf16x8*)(kp);      kf[1]=*(const __attribute__((address_space(3))) bf16x8*)(kp+512);
  kf[2]=*(const __attribute__((address_space(3))) bf16x8*)(kp+2048); kf[3]=*(const __attribute__((address_space(3))) bf16x8*)(kp+2560);
  kf[4]=*(const __attribute__((address_space(3))) bf16x8*)(kp+4096); kf[5]=*(const __attribute__((address_space(3))) bf16x8*)(kp+4608);
  kf[6]=*(const __attribute__((address_space(3))) bf16x8*)(kp+6144); kf[7]=*(const __attribute__((address_space(3))) bf16x8*)(kp+6656);
}
__device__ __forceinline__ void kload2(bf16x8*kf,lds_cptr kp,int j){ kf[2*j]=*(const __attribute__((address_space(3))) bf16x8*)(kp+j*2048); kf[2*j+1]=*(const __attribute__((address_space(3))) bf16x8*)(kp+j*2048+512); }
__device__ __forceinline__ s16x4 vtr(lds_cptr p){ return __builtin_bit_cast(s16x4,__builtin_amdgcn_ds_read_tr16_b64_v4i16((__attribute__((address_space(3))) v4i16_t*)p)); }
__device__ __forceinline__ float rowmax(const f32x16&p0,const f32x16&p1){
  float a=max3f(p0[0],p0[1],p1[0]),b=max3f(p0[2],p0[3],p1[1]);a=max3f(a,p1[2],p1[3]);
  #pragma unroll
  for(int r=4;r<16;r+=4){a=max3f(a,p0[r],p0[r+1]);b=max3f(b,p0[r+2],p0[r+3]);a=max3f(a,p1[r],p1[r+1]);b=max3f(b,p1[r+2],p1[r+3]);}
  const float m=max2f(a,b);
  auto rr=__builtin_amdgcn_permlane32_swap(__float_as_uint(m),__float_as_uint(m),false,false);
  return max2f(__uint_as_float(rr[0]),__uint_as_float(rr[1]));
}
__device__ __forceinline__ void pv(f32x16*o,int vb,bf16x8 pa0,bf16x8 pa1,bf16x8 pa2,bf16x8 pa3){
  #pragma unroll
  for(int d0=0;d0<2;++d0){s16x4 lo[4],hi[4];
    #pragma unroll
    for(int ks=0;ks<4;++ks){
      asm volatile("ds_read_b64_tr_b16 %0,%1 offset:%c2":"=&v"(lo[ks]):"v"(vb),"i"(d0*4096+ks*1024):"memory");
      asm volatile("ds_read_b64_tr_b16 %0,%1 offset:%c2":"=&v"(hi[ks]):"v"(vb),"i"(d0*4096+ks*1024+512):"memory");}
    asm volatile("s_waitcnt lgkmcnt(0)":::"memory");SBAR();
    #define PK(k) (bf16x8){lo[k][0],lo[k][1],lo[k][2],lo[k][3],hi[k][0],hi[k][1],hi[k][2],hi[k][3]}
    o[d0]=__builtin_amdgcn_mfma_f32_32x32x16_bf16(pa0,PK(0),o[d0],0,0,0);
    o[d0]=__builtin_amdgcn_mfma_f32_32x32x16_bf16(pa1,PK(1),o[d0],0,0,0);
    o[d0]=__builtin_amdgcn_mfma_f32_32x32x16_bf16(pa2,PK(2),o[d0],0,0,0);
    o[d0]=__builtin_amdgcn_mfma_f32_32x32x16_bf16(pa3,PK(3),o[d0],0,0,0);
    #undef PK
  }
}

#ifndef ATTN_STORE16
#define ATTN_STORE16(p,v) (*(u32x4*)(p)=(v))
#endif
template<int THRL> __device__ __forceinline__ void attn_unit(int b,int qb,const bf16*Q,const bf16*__restrict__ K,const bf16*__restrict__ V,bf16*O,char*shm){
  int tid_l=threadIdx.x; asm volatile("":"+v"(tid_l)); const int tid=tid_l,lane=tid&63,r32=lane&31,hi=lane>>5; const int wid=__builtin_amdgcn_readfirstlane(tid>>6);
  const long rowbase=(long)b*SEQ; const int q0=qb*QB;
  const bf16*Qw=Q+(rowbase+q0+wid*QBLK)*PQK;
  const bf16*Kh=K+rowbase*PQK,*Vh=V+rowbase*PQK;
  const unsigned lds0=(unsigned)(uintptr_t)shm;
  float*wsf=(float*)(shm+LDS_WS)+wid*64;
  const bf16*ksrc=Kh+(long)lane*PQK+wid*8;
  const bf16*vsrc=Vh+(long)(16*(wid&3)+(lane>>2))*PQK+(wid>>2)*32+(lane&3)*8;
  const unsigned kdst=lds0+LDS_K+wid*1024, vdst=lds0+LDS_V+wid*1024;
  #define DMA_K(t,slot) glds16(ksrc+(long)(t)*KVBLK*PQK,(unsigned)__builtin_amdgcn_readfirstlane(kdst+(slot)))
  #define DMA_V(t,slot) glds16(vsrc+(long)(t)*KVBLK*PQK,(unsigned)__builtin_amdgcn_readfirstlane(vdst+(slot)))
  const int vb0=(int)(lds0+LDS_V)+((lane>>4)&1)*32+(lane&3)*8+(4*hi+((lane&15)>>2))*64;
  const char*Kbase=shm+LDS_K; bf16x8 kf[8];
  const lds_cptr shm3=(lds_cptr)shm; const lds_cptr kp0=shm3+LDS_K+hi*1024+r32*16; const lds_cptr vp0=shm3+LDS_V+((lane>>4)&1)*32+(lane&3)*8+(4*hi+((lane&15)>>2))*64;
  const int NT=(q0+QB)/KVBLK;
  DMA_K(0,0);DMA_V(0,0);DMA_K(1,SLOTB);
  bf16x8 qr[4];
  #pragma unroll
  for(int d0=0;d0<4;++d0)qr[d0]=*reinterpret_cast<const bf16x8*>(&Qw[(long)r32*PQK+d0*16+hi*8]);
  float mhat=0.f,l_reg=0.f;f32x16 o[2];o[0]=f32x16{};o[1]=f32x16{};f32x16 negm=f32x16{};asm volatile("":"+v"(negm));
  const int qrel=wid*QBLK+r32;
  #define CMASK(P0,P1,t) do{int jb_=(t)-(NT-4); if(jb_>=0)cmask(P0,P1,jb_,qrel,hi);}while(0)
  bool resc=false;
  #define START(P0,P1) do{ const float rm=rowmax(P0,P1); resc=false; \
    { const float dl=rm; mhat=fadd_s(mhat,dl); \
      _Pragma("unroll") for(int r=0;r<16;++r){P0[r]=fsub_s(P0[r],dl);P1[r]=fsub_s(P1[r],dl);} \
      _Pragma("unroll") for(int r=0;r<16;++r)negm[r]=-mhat; asm volatile("":"+v"(negm)); } \
    _Pragma("unroll") for(int r=0;r<16;++r)P0[r]=__builtin_amdgcn_exp2f(P0[r]); }while(0)
  #define RESC() do{ if(resc){ asm volatile("s_waitcnt lgkmcnt(0)":::"memory"); \
      _Pragma("unroll") for(int d_=0;d_<2;++d_) _Pragma("unroll") for(int r=0;r<16;++r)o[d_][r]*=wsf[crow(r,hi)]; } }while(0)
  f32x16 pA0,pA1,pB0,pB1;
  int sl_prev=0,sl_cur=0,sl_next=SLOTB;
  #define ROT() do{sl_prev=sl_cur;sl_cur=sl_next;sl_next=(sl_next==(NSLOT-1)*SLOTB)?0:sl_next+SLOTB;}while(0)
  DMA_K(2,2*SLOTB);
  WAIT_BAR(3);
  qkt(pA0,pA1,Kbase,qr,negm,r32,hi);asm volatile("s_nop 15\n\ts_nop 7":"+v"(pA0),"+v"(pA1));CMASK(pA0,pA1,0);
  START(pA0,pA1);
  _Pragma("unroll") for(int r=0;r<16;++r)pA1[r]=__builtin_amdgcn_exp2f(pA1[r]);
  WAIT_BAR(0);
  DMA_K(3,0);DMA_V(1,SLOTB);
  ROT();
  kload8(kf,kp0+sl_cur);
  WAIT_BAR(2);
  s16x4 vlo[8],vhi[8]; u32x4 pw0,pw1,pw2,pw3;
  #define PKW(P,B) cvtpk_s(P[B],P[B+1])
  #define PAF(k) __builtin_bit_cast(bf16x8,pw##k)
  #define VFR(i) (bf16x8){vlo[i][0],vlo[i][1],vlo[i][2],vlo[i][3],vhi[i][0],vhi[i][1],vhi[i][2],vhi[i][3]}
  #define PIN(x) asm volatile("":"+v"(x))
  #define MX3(a,b,c) __builtin_fmaxf(__builtin_fmaxf((a),(b)),(c))
  #define GAPA(MF,A0,A1,A2,A3,W0,W1,PW) do{ MF; sacc+=A0; sacc+=A1; sacc+=A2; sacc+=A3; PIN(sacc); W0; W1; PIN(PW); SBAR(); }while(0)
  #define EX(v) __builtin_amdgcn_exp2f(v)
  #define GAPB(MF,X,B) do{ MF; X[B]=EX(X[B]); X[B+1]=EX(X[B+1]); X[B+2]=EX(X[B+2]); X[B+3]=EX(X[B+3]); PIN(X); SBAR(); }while(0)
  #define VRD(i) do{ vlo[i]=vtr(vp_+(((i)>>2)*4096+((i)&3)*1024)); vhi[i]=vtr(vp_+(((i)>>2)*4096+((i)&3)*1024+512)); }while(0)
  #define KRD(G,j) do{ if(G){ kload2(kf,kp0+sl_next,j); SBAR(); } }while(0)
  #define STEP(C0,C1,P0,P1,t,GK,GV,GL) do{ SBAR(); \
    const lds_cptr vp_=vp0+sl_prev; \
    VRD(0); SBAR(); float sacc=(P0[0]+P0[1]); \
    GAPA(C0=__builtin_amdgcn_mfma_f32_32x32x16_bf16(kf[0],qr[0],negm,0,0,0), P0[2],P0[3],P0[4],P0[5],     pw0[0]=PKW(P0,0), pw0[1]=PKW(P0,2), pw0); \
    VRD(4); SBAR(); GAPA(C1=__builtin_amdgcn_mfma_f32_32x32x16_bf16(kf[1],qr[0],negm,0,0,0), P0[6],P0[7],P0[8],P0[9],     pw0[2]=PKW(P0,4), pw0[3]=PKW(P0,6), pw0); \
    VRD(1); SBAR(); GAPA(C0=__builtin_amdgcn_mfma_f32_32x32x16_bf16(kf[2],qr[1],C0,0,0,0),   P0[10],P0[11],P0[12],P0[13], pw1[0]=PKW(P0,8), pw1[1]=PKW(P0,10), pw1); \
    VRD(5); SBAR(); GAPA(C1=__builtin_amdgcn_mfma_f32_32x32x16_bf16(kf[3],qr[1],C1,0,0,0),   P0[14],P0[15],P1[0],P1[1],   pw1[2]=PKW(P0,12),pw1[3]=PKW(P0,14), pw1); \
    VRD(2); SBAR(); GAPA(C0=__builtin_amdgcn_mfma_f32_32x32x16_bf16(kf[4],qr[2],C0,0,0,0),   P1[2],P1[3],P1[4],P1[5],     pw2[0]=PKW(P1,0), pw2[1]=PKW(P1,2), pw2); \
    VRD(6); SBAR(); GAPA(C1=__builtin_amdgcn_mfma_f32_32x32x16_bf16(kf[5],qr[2],C1,0,0,0),   P1[6],P1[7],P1[8],P1[9],     pw2[2]=PKW(P1,4), pw2[3]=PKW(P1,6), pw2); \
    VRD(3); SBAR(); GAPA(C0=__builtin_amdgcn_mfma_f32_32x32x16_bf16(kf[6],qr[3],C0,0,0,0),   P1[10],P1[11],P1[12],P1[13], pw3[0]=PKW(P1,8), pw3[1]=PKW(P1,10), pw3); \
    VRD(7); SBAR(); GAPA(C1=__builtin_amdgcn_mfma_f32_32x32x16_bf16(kf[7],qr[3],C1,0,0,0),   P1[14],P1[15],0.f,0.f,       pw3[2]=PKW(P1,12),pw3[3]=PKW(P1,14), pw3); \
    l_reg+=sacc; \
    if(GK){DMA_K((t)+3,sl_cur);} if(GV){DMA_V((t)+1,sl_next);} \
    CMASK(C0,C1,t); \
    { float a=MX3(C0[0],C0[1],C1[0]),b=MX3(C0[2],C0[3],C1[1]); a=MX3(a,C1[2],C1[3]); \
      _Pragma("unroll") for(int r=4;r<16;r+=4){a=MX3(a,C0[r],C0[r+1]);b=MX3(b,C0[r+2],C0[r+3]);a=MX3(a,C1[r],C1[r+1]);b=MX3(b,C1[r+2],C1[r+3]);} \
      float rm=__builtin_fmaxf(a,b); { auto rr=__builtin_amdgcn_permlane32_swap(__float_as_uint(rm),__float_as_uint(rm),false,false); rm=__builtin_fmaxf(__uint_as_float(rr[0]),__uint_as_float(rr[1])); } \
      resc=false; \
      if(__builtin_expect(__any(rm>(float)THRL),0)){ const float dl=__builtin_fmaxf(rm,0.f); mhat+=dl; \
        _Pragma("unroll") for(int r=0;r<16;++r){C0[r]-=dl;C1[r]-=dl;} \
        _Pragma("unroll") for(int r=0;r<16;++r)negm[r]=-mhat; asm volatile("":"+v"(negm)); \
        const float f=__builtin_amdgcn_exp2f(-dl); l_reg*=f; if(hi==0)wsf[r32]=f; resc=true; } } \
    SBAR(); \
    GAPB(o[0]=__builtin_amdgcn_mfma_f32_32x32x16_bf16(PAF(0),VFR(0),o[0],0,0,0), C0,0); \
    GAPB(o[1]=__builtin_amdgcn_mfma_f32_32x32x16_bf16(PAF(0),VFR(4),o[1],0,0,0), C0,4); \
    KRD(GL,0); GAPB(o[0]=__builtin_amdgcn_mfma_f32_32x32x16_bf16(PAF(1),VFR(1),o[0],0,0,0), C0,8); \
    KRD(GL,1); GAPB(o[1]=__builtin_amdgcn_mfma_f32_32x32x16_bf16(PAF(1),VFR(5),o[1],0,0,0), C0,12); \
    KRD(GL,2); GAPB(o[0]=__builtin_amdgcn_mfma_f32_32x32x16_bf16(PAF(2),VFR(2),o[0],0,0,0), C1,0); \
    KRD(GL,3); GAPB(o[1]=__builtin_amdgcn_mfma_f32_32x32x16_bf16(PAF(2),VFR(6),o[1],0,0,0), C1,4); \
    GAPB(o[0]=__builtin_amdgcn_mfma_f32_32x32x16_bf16(PAF(3),VFR(3),o[0],0,0,0), C1,8); \
    GAPB(o[1]=__builtin_amdgcn_mfma_f32_32x32x16_bf16(PAF(3),VFR(7),o[1],0,0,0), C1,12); \
    }while(0)
  int t=1;
  #undef CMASK
  #define CMASK(P0,P1,t) do{}while(0)
  for(;t+5<NT;t+=2){
    STEP(pB0,pB1,pA0,pA1,t,true,true,true);     WAIT_BAR(2); RESC(); ROT();
    STEP(pA0,pA1,pB0,pB1,t+1,true,true,true);   WAIT_BAR(2); RESC(); ROT();
  }
  #undef CMASK
  #define CMASK(P0,P1,t) do{int jb_=(t)-(NT-4); if(jb_>=0)cmask(P0,P1,jb_,qrel,hi);}while(0)
  #define ENDW(tt) do{ if((tt)+3<NT){WAIT_BAR(2);} else if((tt)+2<NT){WAIT_BAR(1);} else {WAIT_BAR(0);} }while(0)
  for(;t+1<NT;t+=2){
    STEP(pB0,pB1,pA0,pA1,t,(t+3<NT),(t+1<NT),(t+1<NT));       ENDW(t);   RESC(); ROT();
    STEP(pA0,pA1,pB0,pB1,t+1,(t+4<NT),(t+2<NT),(t+2<NT));     ENDW(t+1); RESC(); ROT();
  }
  STEP(pB0,pB1,pA0,pA1,NT-1,false,false,false); RESC();
  { float sacc=pB0[0]+pB0[1]; _Pragma("unroll") for(int r=2;r<16;++r)sacc+=pB0[r]; _Pragma("unroll") for(int r=0;r<16;++r)sacc+=pB1[r]; l_reg+=sacc;
    pw0=(u32x4){PKW(pB0,0),PKW(pB0,2),PKW(pB0,4),PKW(pB0,6)};pw1=(u32x4){PKW(pB0,8),PKW(pB0,10),PKW(pB0,12),PKW(pB0,14)};pw2=(u32x4){PKW(pB1,0),PKW(pB1,2),PKW(pB1,4),PKW(pB1,6)};pw3=(u32x4){PKW(pB1,8),PKW(pB1,10),PKW(pB1,12),PKW(pB1,14)};
    SBAR(); pv(o,vb0+sl_cur,PAF(0),PAF(1),PAF(2),PAF(3)); }
  #undef PKW
  #undef PAF
  #undef VFR
  #undef PIN
  #undef MX3
  #undef GAPA
  #undef GAPB
  #undef EX
  #undef VRD
  #undef KRD
  #undef STEP
  #undef ENDW
  {auto rr=__builtin_amdgcn_permlane32_swap(__float_as_uint(l_reg),__float_as_uint(l_reg),false,false);l_reg=__uint_as_float(rr[0])+__uint_as_float(rr[1]);}
  if(hi==0)wsf[32+r32]=l_reg;asm volatile("s_waitcnt lgkmcnt(0)":::"memory");
  float rli[16];
  #pragma unroll
  for(int r=0;r<16;++r)rli[r]=__builtin_amdgcn_rcpf(wsf[32+crow(r,hi)]);
  bf16*Ow=O+(rowbase+q0+wid*QBLK)*PO;
  { bf16*stg=(bf16*)(shm+LDS_OST)+wid*2048;
    #pragma unroll
    for(int r=0;r<16;++r){const int orow=crow(r,hi);
      #pragma unroll
      for(int d0=0;d0<2;++d0)stg[orow*64+d0*32+r32]=__float2bfloat16(o[d0][r]*rli[r]);}
    asm volatile("s_waitcnt lgkmcnt(0)":::"memory");
    #pragma unroll
    for(int i=0;i<4;++i){const int row=i*8+(lane>>3),ch=lane&7; const u32x4 v=*(const u32x4*)(stg+row*64+ch*8); ATTN_STORE16(Ow+(long)row*PO+ch*8,v);} }
  asm volatile("s_waitcnt lgkmcnt(0)\n\ts_barrier":::"memory");
  #undef DMA_K
  #undef DMA_V
  #undef CMASK
  #undef START
  #undef RESC
  #undef ROT
}
#undef SBAR
#undef WAIT_BAR
}
namespace cg = cooperative_groups;
#define LAS __attribute__((address_space(3)))
typedef unsigned short bf16;
typedef unsigned v4u __attribute__((ext_vector_type(4)));
typedef unsigned v2u __attribute__((ext_vector_type(2)));
typedef float f32x4 __attribute__((ext_vector_type(4)));
typedef float f32x2 __attribute__((ext_vector_type(2)));
typedef float f32x16 __attribute__((ext_vector_type(16)));
typedef short bf16x8 __attribute__((ext_vector_type(8)));

constexpr int NWAVES = 8;
constexpr int D = 1024, MP = 16384, MS = 256, M = MP + MS, FF = 2816, DIN = 2560;
constexpr float EPS = 1e-6f;
constexpr float C2 = 0.125f * 1.4426950408889634f;
constexpr size_t OFF_Y = 0, OFF_KP = 17039360, OFF_VP = 33816576, OFF_PP = 50593792, OFF_CP = 50655232, OFF_KS = 50663424, OFF_VS = 50925568, OFF_PS = 51187712, OFF_CS = 51249152, OUT_TOTAL = 51257344;
constexpr size_t MiB = 1u << 20;
constexpr size_t WS_ROPE = 1 * MiB, WS_POOLWT = 2 * MiB, WS_W = 4 * MiB, WL = 40 * MiB;
constexpr size_t W_GU1 = 0, W_D1 = 11 * MiB, W_IN = 16 * MiB + MiB / 2, W_OUT = 21 * MiB + MiB / 2, W_GU2 = 23 * MiB + MiB / 2, W_D2 = 34 * MiB + MiB / 2;
constexpr size_t WS_X = 84 * MiB, WS_H = 149 * MiB, WS_MIX = 182 * MiB, WS_ACT = 215 * MiB;
constexpr size_t WS_QB = 215 * MiB, WS_KB = 232 * MiB, WS_VB = 249 * MiB, WS_ZB = 266 * MiB;
constexpr size_t WS_OB = 305 * MiB, WS_OPART = 338 * MiB, WS_ML = 347 * MiB, WS_END = 352 * MiB;
static_assert(WS_ROPE == pg8::WOFF_ROPE && WS_QB == pg8::WOFF_QB && WS_KB == pg8::WOFF_KB && WS_VB == pg8::WOFF_VB && WS_ZB == pg8::WOFF_ZB && OFF_KP == pg8::OOFF_KP && OFF_VP == pg8::OOFF_VP && OFF_PP == pg8::OOFF_PP && OFF_KS == pg8::OOFF_KS && OFF_VS == pg8::OOFF_VS && OFF_PS == pg8::OOFF_PS, "offsets");
static_assert(WS_ACT + (size_t)M * FF * 2 <= WS_OB && WS_ZB + (size_t)M * 1024 * 2 <= WS_OB && WS_X + (size_t)M * D * 4 <= WS_H && WS_H + (size_t)M * D * 2 <= WS_MIX && WS_MIX + (size_t)M * D * 2 <= WS_ACT, "ws map");
static_assert(WS_OB + (size_t)M * 1024 * 2 <= WS_OPART && WS_OPART + (size_t)32 * 2 * 9 * 32 * 128 * 4 <= WS_ML && WS_ML + (size_t)32 * 2 * 9 * 32 * 2 * 4 <= WS_END, "ws map 2");
constexpr int LDS_BYTES = 147456;
constexpr size_t CTL_BYTES = 262144, CTL_CNT = 65536;
constexpr size_t WS_SLOTP = 350 * MiB, WS_SLOTS = 351 * MiB;

__device__ __forceinline__ unsigned pk2(float lo, float hi) { f32x2 v = {lo, hi}; typedef __bf16 b2 __attribute__((ext_vector_type(2))); b2 b = __builtin_convertvector(v, b2); return __builtin_bit_cast(unsigned, b); }
__device__ __forceinline__ float bf2f(unsigned short b) { return __builtin_bit_cast(float, (unsigned)b << 16); }
__device__ __forceinline__ bf16x8 pack8(f32x4 a, f32x4 b) { v4u w; w.x = pk2(a.x, a.y); w.y = pk2(a.z, a.w); w.z = pk2(b.x, b.y); w.w = pk2(b.z, b.w); return __builtin_bit_cast(bf16x8, w); }
__device__ __forceinline__ int crow(int r, int hi) { return (r & 3) + 8 * (r >> 2) + 4 * hi; }
__device__ __forceinline__ void xhalf_pair(float m, float& a, float& b) { a = m; b = m; asm volatile("s_nop 1\n\tv_permlane32_swap_b32 %0, %1\n\ts_nop 1" : "+v"(a), "+v"(b)); }
__device__ __forceinline__ float xhalf_max(float m) { float a, b; xhalf_pair(m, a, b); return fmaxf(a, b); }
__device__ __forceinline__ float xhalf_sum(float m) { float a, b; xhalf_pair(m, a, b); return a + b; }
template <int O> __device__ __forceinline__ float swz_xor(float v) { return __builtin_bit_cast(float, __builtin_amdgcn_ds_swizzle(__builtin_bit_cast(int, v), (O << 10) | 0x1f)); }
__device__ __forceinline__ float wave_sum(float v) {
    v += swz_xor<1>(v); v += swz_xor<2>(v); v += swz_xor<4>(v); v += swz_xor<8>(v); v += swz_xor<16>(v);
    return xhalf_sum(v);
}
#define LDS_WAIT() asm volatile("s_waitcnt lgkmcnt(0)" ::: "memory")

struct Params { const float* in[26]; float* out; unsigned char* ws; };
typedef const __attribute__((address_space(4))) unsigned char* karg_ptr;
__device__ __forceinline__ karg_ptr kargs() { karg_ptr k = (karg_ptr)__builtin_amdgcn_kernarg_segment_ptr(); asm volatile("" : "+s"(k)); return k; }
__device__ __forceinline__ const float* KIN(int i) { return *(const float* const __attribute__((address_space(4)))*)(kargs() + 8 * i); }
__device__ __forceinline__ float* KOUT() { return *(float* const __attribute__((address_space(4)))*)(kargs() + 8 * 26); }
__device__ __forceinline__ unsigned char* KWS() { return *(unsigned char* const __attribute__((address_space(4)))*)(kargs() + 8 * 27); }

template <int MODE> __device__ __forceinline__ int wmap(int nl, int row_off) {
    if (MODE == 0) return row_off + nl;
    if (MODE == 1) return (nl >> 7) * 256 + (nl & 127) + row_off;
    const int u = nl >> 8, lc = nl & 255, A = lc >> 6, n = (lc >> 5) & 1, B = (lc >> 4) & 1, f = lc & 15;
    return u * 256 + 128 * (A >> 1) + 32 * (2 * (A & 1) + B) + 16 * n + f;
}
template <int MODE> __device__ __forceinline__ void transpose_item(const float* W, int K, int N, bf16* WT, int row_off, LAS float* scr, int item, int lane) {
    const int nblk = N / 32, kb = item / nblk, nb = item % nblk, k0 = 64 * kb, n0 = 32 * nb;
#pragma unroll 8
    for (int i = 0; i < 32; ++i) { const int kk = 2 * i + (lane >> 5); scr[kk * 33 + (lane & 31)] = W[(size_t)(k0 + kk) * N + n0 + (lane & 31)]; }
    LDS_WAIT(); asm volatile("" ::: "memory");
    const int c = lane & 7;
#pragma unroll
    for (int j = 0; j < 4; ++j) { const int n = (lane >> 3) + 8 * j; const LAS float* s = scr + (8 * c) * 33 + n;
        v4u o; o.x = pk2(s[0 * 33], s[1 * 33]); o.y = pk2(s[2 * 33], s[3 * 33]); o.z = pk2(s[4 * 33], s[5 * 33]); o.w = pk2(s[6 * 33], s[7 * 33]);
        *(v4u*)(WT + (size_t)wmap<MODE>(n0 + n, row_off) * K + k0 + 8 * c) = o; }
    LDS_WAIT(); asm volatile("" ::: "memory");
}
__device__ __forceinline__ void prologue(LAS unsigned char* lds, int gw, int NGW, int wave, int lane) {
    LAS float* scr = (LAS float*)(lds + wave * 16384);
    constexpr int I_F = 16 * 88, I_IN = 16 * 80, I_OUT = 16 * 32, I_L = 6 * I_F + I_IN + I_OUT;
    for (int it = gw; it < 2 * I_L; it += NGW) {
        const int l = it / I_L; int r = it % I_L;
        unsigned char* wl = KWS() + WS_W + (size_t)l * WL;
        if (r < I_F) { transpose_item<1>(KIN(7) + (size_t)l * D * FF, D, FF, (bf16*)(wl + W_GU1), 0, scr, r, lane); continue; } r -= I_F;
        if (r < I_F) { transpose_item<1>(KIN(8) + (size_t)l * D * FF, D, FF, (bf16*)(wl + W_GU1), 128, scr, r, lane); continue; } r -= I_F;
        if (r < I_F) { transpose_item<0>(KIN(9) + (size_t)l * D * FF, FF, D, (bf16*)(wl + W_D1), 0, scr, r, lane); continue; } r -= I_F;
        if (r < I_IN) { transpose_item<2>(KIN(11) + (size_t)l * D * DIN, D, DIN, (bf16*)(wl + W_IN), 0, scr, r, lane); continue; } r -= I_IN;
        if (r < I_OUT) { transpose_item<0>(KIN(20) + (size_t)l * D * D, D, D, (bf16*)(wl + W_OUT), 0, scr, r, lane); continue; } r -= I_OUT;
        if (r < I_F) { transpose_item<1>(KIN(22) + (size_t)l * D * FF, D, FF, (bf16*)(wl + W_GU2), 0, scr, r, lane); continue; } r -= I_F;
        if (r < I_F) { transpose_item<1>(KIN(23) + (size_t)l * D * FF, D, FF, (bf16*)(wl + W_GU2), 128, scr, r, lane); continue; } r -= I_F;
        transpose_item<0>(KIN(24) + (size_t)l * D * FF, FF, D, (bf16*)(wl + W_D2), 0, scr, r, lane);
    }
    float* rope = (float*)(KWS() + WS_ROPE);
    for (int i = gw * 64 + lane; i < 2080 * 32; i += NGW * 64) {
        const int pr = i >> 5, d = i & 31; const int pos = pr < 2048 ? pr : 4096 + (pr - 2048);
        const float inv = exp2f(-(float)d * (13.287712379549449f / 32.0f));
        const float ang = (float)pos * inv;
        const double rev = (double)ang * 0.15915494309189535; const float fr = (float)(rev - __builtin_rint(rev));
        rope[pr * 64 + d] = __builtin_amdgcn_cosf(fr); rope[pr * 64 + 32 + d] = __builtin_amdgcn_sinf(fr);
    }
    bf16* pwt_ = (bf16*)(KWS() + WS_POOLWT);
    for (int i = gw * 64 + lane; i < 2 * 4 * 64 * 64; i += NGW * 64) {
        const int c = i & 63, e = (i >> 6) & 63, lg = i >> 12;
        pwt_[i] = (bf16)(pk2(KIN(17)[(size_t)lg * 4096 + c * 64 + e], 0.f) & 0xffffu);
    }
}
template <bool FINAL> __device__ __forceinline__ void norm_rows(const float* srcP, const float* srcS, const float* g, bf16* H, float* outf, int gw, int NGW, int lane) {
    const f32x4* g4 = (const f32x4*)g + lane;
    f32x4 gv[4];
#pragma unroll
    for (int j = 0; j < 4; ++j) gv[j] = g4[64 * j];
    for (int m = gw; m < M; m += NGW) {
        const float* xr = (m < MP) ? srcP + (size_t)m * D : srcS + (size_t)(m - MP) * D;
        const f32x4* x4 = (const f32x4*)xr + lane;
        f32x4 v[4]; float s = 0.f;
#pragma unroll
        for (int j = 0; j < 4; ++j) { v[j] = x4[64 * j]; s += (v[j].x * v[j].x + v[j].y * v[j].y) + (v[j].z * v[j].z + v[j].w * v[j].w); }
        const float rstd = 1.0f / sqrtf(wave_sum(s) * (1.0f / D) + EPS);
        if (FINAL) {
            f32x4* o4 = (f32x4*)(outf + (size_t)m * D) + lane;
#pragma unroll
            for (int j = 0; j < 4; ++j) o4[64 * j] = v[j] * rstd * gv[j];
        } else {
            v2u* o2 = (v2u*)(H + (size_t)m * D) + lane;
#pragma unroll
            for (int j = 0; j < 4; ++j) { const f32x4 y = v[j] * rstd * gv[j]; v2u w; w.x = pk2(y.x, y.y); w.y = pk2(y.z, y.w); o2[64 * j] = w; }
        }
    }
}
__device__ __forceinline__ f32x16 mfma32(bf16x8 a, bf16x8 b, f32x16 c) { return __builtin_amdgcn_mfma_f32_32x32x16_bf16(a, b, c, 0, 0, 0); }


template <bool BASE16, int K> __device__ __forceinline__ void skinny_part1(LAS unsigned char* lds, const bf16* A, const bf16* Bt, const void* base, bf16* out, float scale,
                                            unsigned* slots, unsigned* cnt8, int tile, int tid) {
    const int lane = tid & 63, r32 = lane & 31, hi = lane >> 5, wid = __builtin_amdgcn_readfirstlane(tid >> 6);
    LAS float* R = (LAS float*)lds;
    LAS float* PARK = (LAS float*)(lds + 131072);
    const int rt = tile >> 5, ct = tile & 31, kw = K >> 3, k0 = wid * kw;
    const int e = tid * 2, row = e >> 5, col = e & 31;
    const size_t o = (size_t)(rt * 32 + row) * 1024 + ct * 32 + col;
    f32x2 bv; if (BASE16) { const unsigned bw = *(const unsigned*)((const bf16*)base + o); bv.x = bf2f(bw & 0xffff); bv.y = bf2f(bw >> 16); } else bv = *(const f32x2*)((const float*)base + o);
    const bf16* ap = A + (size_t)(rt * 32 + r32) * K + wid * 16 + hi * 8; const bf16* bp = Bt + (size_t)(ct * 32 + r32) * K + wid * 16 + hi * 8; (void)k0;
    f32x16 acc;
#pragma unroll
    for (int r = 0; r < 16; ++r) acc[r] = 0.f;
    constexpr int NST = K / 128, UB = (NST % 11 == 0) ? 11 : 8;
#pragma unroll 1
    for (int s0 = 0; s0 < NST; s0 += UB) { bf16x8 av[UB], bw[UB];
#pragma unroll
        for (int j = 0; j < UB; ++j) { av[j] = *(const bf16x8*)(ap + (s0 + j) * 128); bw[j] = *(const bf16x8*)(bp + (s0 + j) * 128); }
#pragma unroll
        for (int j = 0; j < UB; ++j) acc = mfma32(av[j], bw[j], acc); }
    __syncthreads();
#pragma unroll
    for (int r = 0; r < 16; ++r) R[(wid * 32 + crow(r, hi)) * 32 + r32] = acc[r];
    __syncthreads();
    f32x2 s = {0.f, 0.f};
#pragma unroll
    for (int w = 0; w < 8; ++w) s += *(const LAS f32x2*)(R + (w * 32 + row) * 32 + col);
    const f32x2 v = bv + s * scale;
    float ss = v.x * v.x + v.y * v.y; ss += swz_xor<1>(ss); ss += swz_xor<2>(ss); ss += swz_xor<4>(ss); ss += swz_xor<8>(ss);
    if ((tid & 15) == 0) __hip_atomic_store(slots + (size_t)(rt * 32 + row) * 32 + ct, __builtin_bit_cast(unsigned, ss), __ATOMIC_RELAXED, __HIP_MEMORY_SCOPE_AGENT);
    *(LAS f32x2*)(PARK + tid * 2) = v;
    asm volatile("s_waitcnt vmcnt(0)" ::: "memory");
    __syncthreads();
    if (tid == 0) __hip_atomic_fetch_add(cnt8 + 64 * rt, 1u, __ATOMIC_RELAXED, __HIP_MEMORY_SCOPE_AGENT);
    if (out) *(unsigned*)(out + o) = pk2(v.x, v.y);
    __syncthreads();
}
__device__ __forceinline__ void skinny_part2(LAS unsigned char* lds, bf16* hb, float* yout, const float* gain, unsigned* slots, unsigned* cnt8, int tile, int tid) {
    LAS float* PARK = (LAS float*)(lds + 131072);
    const int rt = tile >> 5, ct = tile & 31, e = tid * 2, row = e >> 5, col = e & 31;
    const size_t o = (size_t)(rt * 32 + row) * 1024 + ct * 32 + col;
    if (tid == 0) {
        unsigned spins = 0;
        while (__hip_atomic_load(cnt8 + 64 * rt, __ATOMIC_RELAXED, __HIP_MEMORY_SCOPE_AGENT) < 32u) { __builtin_amdgcn_s_sleep(2); if (++spins > (1u << 22)) break; }
        __builtin_amdgcn_fence(__ATOMIC_ACQUIRE, "agent");
        asm volatile("s_waitcnt vmcnt(0)" ::: "memory");
    }
    __syncthreads();
    const unsigned* sl = slots + (size_t)(rt * 32 + row) * 32 + (tid & 15) * 2;
    float tot = __builtin_bit_cast(float, __hip_atomic_load(sl, __ATOMIC_RELAXED, __HIP_MEMORY_SCOPE_AGENT)) + __builtin_bit_cast(float, __hip_atomic_load(sl + 1, __ATOMIC_RELAXED, __HIP_MEMORY_SCOPE_AGENT));
    tot += swz_xor<1>(tot); tot += swz_xor<2>(tot); tot += swz_xor<4>(tot); tot += swz_xor<8>(tot);
    const float r = 1.0f / sqrtf(tot * (1.0f / 1024.0f) + EPS);
    const f32x2 v = *(const LAS f32x2*)(PARK + tid * 2);
    const f32x2 gv = *(const f32x2*)(gain + ct * 32 + col); const f32x2 y = v * r * gv;
    if (hb) *(unsigned*)(hb + o) = pk2(y.x, y.y); else *(f32x2*)(yout + o) = y;
    __syncthreads();
}

__device__ __forceinline__ void sample_piece(LAS unsigned char* lds, int pc, int l, const bf16* Qb, const float* cache_k, const float* cache_v, const float* knew, const float* vnew, float* OPART, float* MLP, int tid) {
    const int lane = tid & 63, r32 = lane & 31, hi = lane >> 5, wid = __builtin_amdgcn_readfirstlane(tid >> 6);
    const int b = pc >> 5, h = (pc >> 3) & 3, s = pc & 7;
    const bf16* qrow = Qb + (size_t)(MP + b * 32 + r32) * 512 + h * 128 + hi * 8;
    LAS float* ML = (LAS float*)lds;
    LAS float* FAC = (LAS float*)(lds + 4096);
    LAS float* OX = (LAS float*)(lds + 8192);
    const bool extra = (s == 7) && (wid == 7);
    const size_t off = ((size_t)((l * 8 + b) * 4096 + (s * 8 + wid) * 64)) * 512 + h * 128;
    const size_t offx = ((size_t)(l * 8 + b) * 32) * 512 + h * 128;
    const float* Kt = cache_k + off; const float* Vt = cache_v + off; const float* Kx = knew + offx; const float* Vx = vnew + offx;
    float mrow[2], lrow[2]; bf16x8 pw[2][6];
#pragma unroll
    for (int c = 0; c < 2; ++c) {
        bf16x8 qf[4];
#pragma unroll
        for (int d0 = 0; d0 < 4; ++d0) qf[d0] = *(const bf16x8*)(qrow + c * 64 + d0 * 16);
        f32x16 sc[3];
#pragma unroll
        for (int kvb = 0; kvb < 3; ++kvb) {
            if (kvb < 2 || extra) {
                f32x16 a;
#pragma unroll
                for (int r = 0; r < 16; ++r) a[r] = 0.f;
                const float* kp = (kvb < 2 ? Kt + (size_t)(kvb * 32 + r32) * 512 : Kx + (size_t)r32 * 512) + c * 64 + hi * 8;
#pragma unroll
                for (int d0 = 0; d0 < 4; ++d0) { const f32x4 x0 = *(const f32x4*)(kp + d0 * 16), x1 = *(const f32x4*)(kp + d0 * 16 + 4); a = mfma32(pack8(x0, x1), qf[d0], a); }
                sc[kvb] = a;
            } else {
#pragma unroll
                for (int r = 0; r < 16; ++r) sc[kvb][r] = -1e30f;
            }
        }
        float mx = -1e30f;
#pragma unroll
        for (int r = 0; r < 16; ++r) mx = fmaxf(mx, fmaxf(fmaxf(sc[0][r], sc[1][r]), sc[2][r]));
        mx = xhalf_max(mx);
        float sum = 0.f;
#pragma unroll
        for (int kvb = 0; kvb < 3; ++kvb)
#pragma unroll
            for (int r = 0; r < 16; ++r) { const float pv = __builtin_amdgcn_exp2f(sc[kvb][r] - mx); sc[kvb][r] = pv; sum += pv; }
        sum = xhalf_sum(sum);
        mrow[c] = mx; lrow[c] = sum;
#pragma unroll
        for (int kvb = 0; kvb < 3; ++kvb)
#pragma unroll
            for (int hf = 0; hf < 2; ++hf) { v4u w; w.x = pk2(sc[kvb][8 * hf + 0], sc[kvb][8 * hf + 1]); w.y = pk2(sc[kvb][8 * hf + 2], sc[kvb][8 * hf + 3]);
                w.z = pk2(sc[kvb][8 * hf + 4], sc[kvb][8 * hf + 5]); w.w = pk2(sc[kvb][8 * hf + 6], sc[kvb][8 * hf + 7]); pw[c][2 * kvb + hf] = __builtin_bit_cast(bf16x8, w); }
    }
    asm volatile("" ::: "memory");
    f32x16 o[2][4];
#pragma unroll
    for (int c = 0; c < 2; ++c)
#pragma unroll
        for (int eb = 0; eb < 4; ++eb)
#pragma unroll
            for (int r = 0; r < 16; ++r) o[c][eb][r] = 0.f;
#pragma unroll
    for (int ks = 0; ks < 6; ++ks) {
        if (ks < 4 || extra) {
#pragma unroll
            for (int eb = 0; eb < 4; ++eb) {
                const float* vp = (ks < 4 ? Vt + (size_t)(ks * 16 + 4 * hi) * 512 : Vx + (size_t)((ks - 4) * 16 + 4 * hi) * 512) + eb * 32 + r32;
                f32x4 x0, x1;
                x0.x = vp[0 * 512]; x0.y = vp[1 * 512]; x0.z = vp[2 * 512]; x0.w = vp[3 * 512];
                x1.x = vp[8 * 512]; x1.y = vp[9 * 512]; x1.z = vp[10 * 512]; x1.w = vp[11 * 512];
                const bf16x8 vf = pack8(x0, x1);
                o[0][eb] = mfma32(pw[0][ks], vf, o[0][eb]); o[1][eb] = mfma32(pw[1][ks], vf, o[1][eb]);
            }
        }
    }
    if (hi == 0) {
#pragma unroll
        for (int c = 0; c < 2; ++c) { ML[((wid * 2 + c) * 32 + r32) * 2 + 0] = mrow[c]; ML[((wid * 2 + c) * 32 + r32) * 2 + 1] = lrow[c]; }
    }
    __syncthreads();
    const int pidx = s;
    if (tid < 64) {
        const int c = tid >> 5, q = tid & 31; float mw[8], lw[8]; float Mx = -1e30f;
#pragma unroll
        for (int w = 0; w < 8; ++w) { mw[w] = ML[((w * 2 + c) * 32 + q) * 2 + 0]; lw[w] = ML[((w * 2 + c) * 32 + q) * 2 + 1]; Mx = fmaxf(Mx, mw[w]); }
        float L = 0.f;
#pragma unroll
        for (int w = 0; w < 8; ++w) { const float fz = __builtin_amdgcn_exp2f(mw[w] - Mx); FAC[(w * 2 + c) * 32 + q] = fz; L += lw[w] * fz; }
        float* mp = MLP + ((size_t)((((b * 4 + h) * 2 + c) * 9 + pidx) * 32 + q)) * 2; mp[0] = Mx; mp[1] = L;
    }
    __syncthreads();
#pragma unroll
    for (int c = 0; c < 2; ++c) {
#pragma unroll
        for (int eb = 0; eb < 4; ++eb)
#pragma unroll
            for (int r = 0; r < 16; ++r) { const int q = crow(r, hi); OX[(wid * 32 + q) * 128 + eb * 32 + r32] = o[c][eb][r] * FAC[(wid * 2 + c) * 32 + q]; }
        __syncthreads();
        { const int idx = tid * 8, q = idx >> 7, e = idx & 127; f32x4 s0 = {0.f, 0.f, 0.f, 0.f}, s1 = {0.f, 0.f, 0.f, 0.f};
#pragma unroll
          for (int w = 0; w < 8; ++w) { s0 += *(const LAS f32x4*)(OX + (w * 32 + q) * 128 + e); s1 += *(const LAS f32x4*)(OX + (w * 32 + q) * 128 + e + 4); }
          float* dst = OPART + ((size_t)((((b * 4 + h) * 2 + c) * 9 + pidx) * 32 + q)) * 128 + e; *(f32x4*)dst = s0; *(f32x4*)(dst + 4) = s1; }
        __syncthreads();
    }
}

template <int W> __device__ __forceinline__ void pool_d(const LAS float* U, LAS bf16* Dd, int ch, int tbeg, int t0, bool smp) {
    float s = 0.f;
#pragma unroll
    for (int i = 0; i < W; ++i) s += U[(15 + tbeg - i) * 256 + ch];
#pragma unroll 8
    for (int k = 0; k < 32; ++k) {
        const int tt = tbeg + k; const float cur = U[(15 + tt) * 256 + ch];
        if (k > 0) s += cur - U[(15 + tt - W) * 256 + ch];
        const int pos = smp ? 4096 + tt : t0 + tt; const int cnt = (pos + 1 < W) ? pos + 1 : W;
        const float d = s * __builtin_amdgcn_rcpf((float)cnt) - cur;
        Dd[tt * 264 + ch] = (bf16)(pk2(d, 0.f) & 0xffffu);
    }
}
__device__ __forceinline__ f32x4 bf4_to_f32(v2u w) { f32x4 v; v.x = bf2f(w.x & 0xffff); v.y = bf2f(w.x >> 16); v.z = bf2f(w.y & 0xffff); v.w = bf2f(w.y >> 16); return v; }
__device__ __forceinline__ void poolconv_tile(LAS unsigned char* lds, int tl, int l, const bf16* Zb, bf16* MIX, const float* state_pool, const float* state_conv, const bf16* pwt, const float* pool_scale,
                                              const float* conv_w, float* out_cp, float* out_cs, int tid) {
    const int lane = tid & 63, r32 = lane & 31, hi = lane >> 5, wid = __builtin_amdgcn_readfirstlane(tid >> 6);
    int b, t0, TT, rowbase; bool smp;
    if (tl < 256) { b = tl >> 5; t0 = (tl & 31) * 64; TT = 64; rowbase = b * 2048 + t0; smp = false; }
    else { b = tl - 256; t0 = 0; TT = 32; rowbase = MP + b * 32; smp = true; }
    LAS float* U = (LAS float*)lds;
    LAS bf16* Dd = (LAS bf16*)(lds + 81920);
    {
        f32x4 uv[10];
#pragma unroll
        for (int k = 0; k < 10; ++k) {
            const int idx = tid + 512 * k, i = idx >> 6, c4 = (idx & 63) * 4; f32x4 v = {0.f, 0.f, 0.f, 0.f};
            if (i < 15 + TT) {
                if (i < 15 && smp) v = *(const f32x4*)(state_pool + (size_t)((l * 8 + b) * 15 + i) * 256 + c4);
                else if (i >= 15 || t0 - 15 + i >= 0) v = bf4_to_f32(*(const v2u*)(Zb + (size_t)(rowbase + i - 15) * 1024 + c4));
            }
            uv[k] = v;
        }
#pragma unroll
        for (int k = 0; k < 10; ++k) { const int idx = tid + 512 * k, i = idx >> 6, c4 = (idx & 63) * 4; if (i < 15 + TT) *(LAS f32x4*)(U + i * 256 + c4) = uv[k]; }
    }
    __syncthreads();
    {
        const int ch = tid & 255, th = tid >> 8, gi = __builtin_amdgcn_readfirstlane(ch >> 6);
        if (th * 32 < TT) {
            if (gi == 0) pool_d<2>(U, Dd, ch, th * 32, t0, smp); else if (gi == 1) pool_d<4>(U, Dd, ch, th * 32, t0, smp);
            else if (gi == 2) pool_d<8>(U, Dd, ch, th * 32, t0, smp); else pool_d<16>(U, Dd, ch, th * 32, t0, smp);
        }
    }
    __syncthreads();
    {
        const int gi = wid >> 1, th = wid & 1;
        if (th * 32 < TT) {
            f32x16 acc0, acc1;
#pragma unroll
            for (int r = 0; r < 16; ++r) { acc0[r] = 0.f; acc1[r] = 0.f; }
#pragma unroll
            for (int ks = 0; ks < 4; ++ks) {
                const bf16x8 a = *(const LAS bf16x8*)(Dd + (th * 32 + r32) * 264 + gi * 64 + ks * 16 + hi * 8);
                const bf16x8 b0 = *(const bf16x8*)(pwt + (size_t)((l * 4 + gi) * 64 + r32) * 64 + ks * 16 + hi * 8);
                const bf16x8 b1 = *(const bf16x8*)(pwt + (size_t)((l * 4 + gi) * 64 + 32 + r32) * 64 + ks * 16 + hi * 8);
                acc0 = mfma32(a, b0, acc0); acc1 = mfma32(a, b1, acc1);
            }
            const float sc0 = pool_scale[l * 256 + gi * 64 + r32], sc1 = pool_scale[l * 256 + gi * 64 + 32 + r32];
#pragma unroll
            for (int r = 0; r < 16; ++r) { const int tok = th * 32 + crow(r, hi); bf16* mp = MIX + (size_t)(rowbase + tok) * 1024 + 512 + gi * 64 + r32;
                mp[0] = (bf16)(pk2(acc0[r] * sc0, 0.f) & 0xffffu); mp[32] = (bf16)(pk2(acc1[r] * sc1, 0.f) & 0xffffu); }
        }
    }
    if (wid * 8 < TT) {
        const int cq = lane, tc = wid * 8;
        v2u hraw[10], graw[10], braw[8]; f32x4 hst[2];
        hst[0] = (f32x4){0.f, 0.f, 0.f, 0.f}; hst[1] = hst[0];
#pragma unroll
        for (int i = 0; i < 10; ++i) {
            const int ts = tc - 2 + i; hraw[i] = (v2u){0u, 0u}; graw[i] = (v2u){0u, 0u};
            if (ts >= 0 || (!smp && t0 + ts >= 0)) { const bf16* zr = Zb + (size_t)(rowbase + ts) * 1024 + 4 * cq; hraw[i] = *(const v2u*)(zr + 256); graw[i] = *(const v2u*)(zr + 768); }
        }
#pragma unroll
        for (int i = 0; i < 8; ++i) braw[i] = *(const v2u*)(Zb + (size_t)(rowbase + tc + i) * 1024 + 512 + 4 * cq);
        if (smp && tc == 0) { hst[0] = *(const f32x4*)(state_conv + (size_t)((l * 8 + b) * 2 + 0) * 256 + 4 * cq); hst[1] = *(const f32x4*)(state_conv + (size_t)((l * 8 + b) * 2 + 1) * 256 + 4 * cq); }
        const f32x4 cw0 = *(const f32x4*)(conv_w + l * 768 + 4 * cq), cw1 = *(const f32x4*)(conv_w + l * 768 + 256 + 4 * cq), cw2 = *(const f32x4*)(conv_w + l * 768 + 512 + 4 * cq);
        f32x4 cm2 = bf4_to_f32(graw[0]) * bf4_to_f32(hraw[0]), cm1 = bf4_to_f32(graw[1]) * bf4_to_f32(hraw[1]);
        if (smp && tc == 0) { cm2 = hst[0]; cm1 = hst[1]; }
#pragma unroll
        for (int i = 0; i < 8; ++i) {
            const int tt = tc + i;
            const f32x4 cv = bf4_to_f32(graw[i + 2]) * bf4_to_f32(hraw[i + 2]);
            const f32x4 y = bf4_to_f32(braw[i]) * (cw0 * cm2 + cw1 * cm1 + cw2 * cv);
            v2u w; w.x = pk2(y.x, y.y); w.y = pk2(y.z, y.w);
            *(v2u*)(MIX + (size_t)(rowbase + tt) * 1024 + 768 + 4 * cq) = w;
            if (smp) { if (tt >= 30) *(f32x4*)(out_cs + (size_t)((l * 8 + b) * 2 + tt - 30) * 256 + 4 * cq) = cv; }
            else if (t0 + tt >= 2046) *(f32x4*)(out_cp + (size_t)((l * 8 + b) * 2 + t0 + tt - 2046) * 256 + 4 * cq) = cv;
            cm2 = cm1; cm1 = cv;
        }
    }
    __syncthreads();
}

__device__ __forceinline__ void combine_phase(int l, const bf16* Ob_, const float* OPART_, const float* MLP_, bf16* MIX_, int gw, int NGW, int lane) {
    const float lam_init = (l == 0) ? 0.2f : 0.35550934f;
    float lam;
    { const float a = KIN(12)[l * 64 + lane] * KIN(13)[l * 64 + lane], c = KIN(14)[l * 64 + lane] * KIN(15)[l * 64 + lane];
      lam = __expf(wave_sum(a)) - __expf(wave_sum(c)) + lam_init; }
    const float g0 = KIN(16)[l * 128 + 2 * lane], g1 = KIN(16)[l * 128 + 2 * lane + 1];
    for (int base = gw * 8; base < MP * 4; base += NGW * 8) {
        float a0[8], a1[8];
        {
            unsigned w1[8], w2[8];
#pragma unroll
            for (int j = 0; j < 8; ++j) { const int wt = base + j, row = wt >> 2, h = wt & 3;
                w1[j] = *(const unsigned*)(Ob_ + (size_t)row * 1024 + h * 128 + 2 * lane); w2[j] = *(const unsigned*)(Ob_ + (size_t)row * 1024 + 512 + h * 128 + 2 * lane); }
#pragma unroll
            for (int j = 0; j < 8; ++j) { a0[j] = bf2f(w1[j] & 0xffff) - lam * bf2f(w2[j] & 0xffff); a1[j] = bf2f(w1[j] >> 16) - lam * bf2f(w2[j] >> 16); }
        }
        float ss[8];
#pragma unroll
        for (int j = 0; j < 8; ++j) ss[j] = a0[j] * a0[j] + a1[j] * a1[j];
#pragma unroll
        for (int j = 0; j < 8; ++j) ss[j] += swz_xor<1>(ss[j]);
#pragma unroll
        for (int j = 0; j < 8; ++j) ss[j] += swz_xor<2>(ss[j]);
#pragma unroll
        for (int j = 0; j < 8; ++j) ss[j] += swz_xor<4>(ss[j]);
#pragma unroll
        for (int j = 0; j < 8; ++j) ss[j] += swz_xor<8>(ss[j]);
#pragma unroll
        for (int j = 0; j < 8; ++j) ss[j] += swz_xor<16>(ss[j]);
#pragma unroll
        for (int j = 0; j < 8; ++j) { const int wt = base + j, row = wt >> 2, h = wt & 3;
            const float tot = xhalf_sum(ss[j]);
            const float r = (1.0f / sqrtf(tot * (1.0f / 128.0f) + EPS)) * (1.0f - lam_init);
            *(unsigned*)(MIX_ + (size_t)row * 1024 + h * 128 + 2 * lane) = pk2(a0[j] * r * g0, a1[j] * r * g1); }
    }
    for (int wt = MP * 4 + gw; wt < M * 4; wt += NGW) {
        const int row = wt >> 2, h = wt & 3, rs = row - MP, b = rs >> 5, q = rs & 31; float oc[2][2];
#pragma unroll
        for (int c = 0; c < 2; ++c) {
            const size_t pb = (size_t)(((b * 4 + h) * 2 + c) * 9);
            float mw[8], lw[8]; f32x2 ov[8]; float Mx = -1e30f;
#pragma unroll
            for (int pi = 0; pi < 8; ++pi) { const f32x2 ml = *(const f32x2*)(MLP_ + ((pb + pi) * 32 + q) * 2); mw[pi] = ml.x; lw[pi] = ml.y; ov[pi] = *(const f32x2*)(OPART_ + ((pb + pi) * 32 + q) * 128 + 2 * lane); }
#pragma unroll
            for (int pi = 0; pi < 8; ++pi) Mx = fmaxf(Mx, mw[pi]);
            float L = 0.f, s0 = 0.f, s1 = 0.f;
#pragma unroll
            for (int pi = 0; pi < 8; ++pi) { const float fz = __builtin_amdgcn_exp2f(mw[pi] - Mx); L += lw[pi] * fz; s0 += ov[pi].x * fz; s1 += ov[pi].y * fz; }
            const float il = 1.0f / L; oc[c][0] = s0 * il; oc[c][1] = s1 * il;
        }
        const float a0 = oc[0][0] - lam * oc[1][0], a1 = oc[0][1] - lam * oc[1][1];
        const float tot = wave_sum(a0 * a0 + a1 * a1);
        const float r = (1.0f / sqrtf(tot * (1.0f / 128.0f) + EPS)) * (1.0f - lam_init);
        *(unsigned*)(MIX_ + (size_t)row * 1024 + h * 128 + 2 * lane) = pk2(a0 * r * g0, a1 * r * g1);
    }
}

#ifndef PROBE_SLOW_ATTN
#define PROBE_SLOW_ATTN 0
#endif
#if PROBE_SLOW_ATTN
__device__ __forceinline__ void slow_attn_phase(int l, const bf16* Qb_, float* outp, const float* cache_k, const float* cache_v, bf16* MIX_, int gw, int NGW, int lane) {
    const float lam_init = (l == 0) ? 0.2f : 0.35550934f;
    float lam;
    { const float a = KIN(12)[l * 64 + lane] * KIN(13)[l * 64 + lane], c = KIN(14)[l * 64 + lane] * KIN(15)[l * 64 + lane];
      lam = __expf(wave_sum(a)) - __expf(wave_sum(c)) + lam_init; }
    const float g0 = KIN(16)[l * 128 + 2 * lane], g1 = KIN(16)[l * 128 + 2 * lane + 1];
    for (int wt = gw; wt < M * 4; wt += NGW) {
        const int row = wt >> 2, h = wt & 3;
        const float *K0, *V0, *K1, *V1; int n0, n1;
        if (row < MP) { const int b = row >> 11, t = row & 2047; K0 = outp + OFF_KP + ((size_t)l * MP + (size_t)b * 2048) * 512 + h * 128; V0 = outp + OFF_VP + ((size_t)l * MP + (size_t)b * 2048) * 512 + h * 128; n0 = ((t >> 6) + 1) * 64; K1 = K0; V1 = V0; n1 = 0; }
        else { const int rs = row - MP, b = rs >> 5; K0 = cache_k + ((size_t)(l * 8 + b) * 4096) * 512 + h * 128; V0 = cache_v + ((size_t)(l * 8 + b) * 4096) * 512 + h * 128; n0 = 4096;
               K1 = outp + OFF_KS + ((size_t)(l * 8 + b) * 32) * 512 + h * 128; V1 = outp + OFF_VS + ((size_t)(l * 8 + b) * 32) * 512 + h * 128; n1 = 32; }
        float oc[2][2];
#pragma unroll 1
        for (int c = 0; c < 2; ++c) {
            float q[64];
#pragma unroll
            for (int d = 0; d < 64; ++d) q[d] = bf2f(Qb_[(size_t)row * 512 + h * 128 + c * 64 + d]);
            float mx = -1e30f;
            for (int seg = 0; seg < 2; ++seg) { const float* Kp = seg ? K1 : K0; const int n = seg ? n1 : n0;
                for (int j0 = 0; j0 < n; j0 += 64) { const int j = j0 + lane; float s = -1e30f;
                    if (j < n) { const float* kr = Kp + (size_t)j * 512 + c * 64; s = 0.f;
#pragma unroll
                        for (int d = 0; d < 64; ++d) s += q[d] * kr[d]; }
                    mx = fmaxf(mx, s); } }
            mx = fmaxf(mx, swz_xor<1>(mx)); mx = fmaxf(mx, swz_xor<2>(mx)); mx = fmaxf(mx, swz_xor<4>(mx)); mx = fmaxf(mx, swz_xor<8>(mx)); mx = fmaxf(mx, swz_xor<16>(mx)); mx = xhalf_max(mx);
            float L = 0.f, o0 = 0.f, o1 = 0.f;
            for (int seg = 0; seg < 2; ++seg) { const float* Kp = seg ? K1 : K0; const float* Vp = seg ? V1 : V0; const int n = seg ? n1 : n0;
                for (int j0 = 0; j0 < n; j0 += 64) { const int j = j0 + lane; float pj = 0.f;
                    if (j < n) { const float* kr = Kp + (size_t)j * 512 + c * 64; float s = 0.f;
#pragma unroll
                        for (int d = 0; d < 64; ++d) s += q[d] * kr[d];
                        pj = __builtin_amdgcn_exp2f(s - mx); }
                    L += pj;
                    const int nn = (n - j0 < 64) ? n - j0 : 64;
                    for (int jj = 0; jj < nn; ++jj) { const float pb = __builtin_bit_cast(float, __builtin_amdgcn_readlane(__builtin_bit_cast(int, pj), jj));
                        const f32x2 vv = *(const f32x2*)(Vp + (size_t)(j0 + jj) * 512 + 2 * lane); o0 += pb * vv.x; o1 += pb * vv.y; } } }
            L = wave_sum(L);
            oc[c][0] = o0 / L; oc[c][1] = o1 / L;
        }
        const float a0 = oc[0][0] - lam * oc[1][0], a1 = oc[0][1] - lam * oc[1][1];
        const float ss = wave_sum(a0 * a0 + a1 * a1);
        const float r = (1.0f / sqrtf(ss * (1.0f / 128.0f) + EPS)) * (1.0f - lam_init);
        *(unsigned*)(MIX_ + (size_t)row * 1024 + h * 128 + 2 * lane) = pk2(a0 * r * g0, a1 * r * g1);
    }
}
#endif

#ifndef PROBE_SLOW_PC
#define PROBE_SLOW_PC 0
#endif
#if PROBE_SLOW_PC
__device__ __forceinline__ float zval(const bf16* Zb_, const float* st, int l, int b, bool smp, int rowbase, int t, int col, int hist) {
    if (t >= 0) return bf2f(Zb_[(size_t)(rowbase + t) * 1024 + col]);
    if (!smp) return 0.f;
    return st[(size_t)((l * 8 + b) * hist + (hist + t)) * 256 + (col & 255)];
}
__device__ __forceinline__ void slow_pc_phase(int l, const bf16* Zb_, bf16* MIX_, int gw, int NGW, int lane) {
    const float* sp = KIN(4); const float* scv = KIN(5); const float* pw = KIN(17); const float* psc = KIN(18); const float* cw = KIN(19);
    for (int wt = gw; wt < M * 4; wt += NGW) {
        const int row = wt >> 2, g = wt & 3; const bool smp = row >= MP;
        int b, t, rowbase; if (smp) { const int rs = row - MP; b = rs >> 5; t = rs & 31; rowbase = MP + b * 32; } else { b = row >> 11; t = row & 2047; rowbase = b * 2048; }
        const int w = 2 << g, ch = g * 64 + lane;
        float s = 0.f;
        for (int i = 0; i < w; ++i) { const int tt = t - i; s += zval(Zb_, sp, l, b, smp, rowbase, tt, ch, 15); }
        const int pos = smp ? 4096 + t : t; const int cnt = (pos + 1 < w) ? pos + 1 : w;
        const float d = s / (float)cnt - zval(Zb_, sp, l, b, smp, rowbase, t, ch, 15);
        float mine = 0.f;
        for (int e = 0; e < 64; ++e) { const float v = wave_sum(d * pw[(size_t)((l * 4 + g) * 64 + lane) * 64 + e]); if (e == lane) mine = v; }
        MIX_[(size_t)row * 1024 + 512 + ch] = (bf16)(pk2(mine * psc[l * 256 + ch], 0.f) & 0xffffu);
        float cvv[3];
#pragma unroll
        for (int k = 0; k < 3; ++k) { const int tt = t - 2 + k;
            if (tt >= 0) cvv[k] = bf2f(Zb_[(size_t)(rowbase + tt) * 1024 + 768 + ch]) * bf2f(Zb_[(size_t)(rowbase + tt) * 1024 + 256 + ch]);
            else cvv[k] = smp ? scv[(size_t)((l * 8 + b) * 2 + (2 + tt)) * 256 + ch] : 0.f; }
        const float bgv = bf2f(Zb_[(size_t)row * 1024 + 512 + ch]);
        const float y = bgv * (cw[l * 768 + ch] * cvv[0] + cw[l * 768 + 256 + ch] * cvv[1] + cw[l * 768 + 512 + ch] * cvv[2]);
        MIX_[(size_t)row * 1024 + 768 + ch] = (bf16)(pk2(y, 0.f) & 0xffffu);
    }
}
#endif

#define XB_TMO      128
#define XB_XCNT(j)  (256  + 64 * (j))
#define XB_XSUB(j)  (1280 + 64 * (j))
#define XB_XGEN(j)  (2304 + 64 * (j))
#define XB_TOP      3328
#define XB_TOPGEN   3392
#define XCD_BAR_WORDS 3456
#define XB_SPIN_CAP (1u << 18)
__device__ __forceinline__ unsigned xb_ld(unsigned* p)              { return __hip_atomic_load(p, __ATOMIC_RELAXED, __HIP_MEMORY_SCOPE_AGENT); }
__device__ __forceinline__ unsigned xb_add(unsigned* p, unsigned v) { return __hip_atomic_fetch_add(p, v, __ATOMIC_RELAXED, __HIP_MEMORY_SCOPE_AGENT); }
__device__ __forceinline__ unsigned xb_xcc_id() { return (unsigned)__builtin_amdgcn_s_getreg((3 << 11) | 20) & 0xFu; }
#define XB_SPIN(cond, bar) do { unsigned _sp = 0; while (cond) { __builtin_amdgcn_s_sleep(1); \
    if ((++_sp & 255u) == 0u) { if (xb_ld(&(bar)[XB_TMO])) break; if (_sp > XB_SPIN_CAP) { atomicAdd(&(bar)[XB_TMO], 1u); break; } } } } while (0)
__device__ __forceinline__ void xcd_barrier_complete(unsigned* bar, unsigned x, unsigned& nloc, unsigned& nx) {
    const unsigned G = gridDim.x * gridDim.y * gridDim.z;
    unsigned sum, cnt, mine, sp = 0u;
    for (;;) {
        sum = 0u; cnt = 0u; mine = 0u;
#pragma unroll
        for (unsigned j = 0; j < 16; ++j) { const unsigned c = xb_ld(&bar[XB_XCNT(j)]); sum += c; cnt += (c > 0u) ? 1u : 0u; mine = (j == x) ? c : mine; }
        if (sum == G) break;
        __builtin_amdgcn_s_sleep(1);
        if ((++sp & 255u) == 0u) { if (xb_ld(&bar[XB_TMO])) break; if (sp > XB_SPIN_CAP) { atomicAdd(&bar[XB_TMO], 1u); break; } }
    }
    nloc = mine > 0u ? mine : 1u; nx = cnt > 0u ? cnt : 1u;
}
__device__ __forceinline__ void xcd_barrier(unsigned* bar, unsigned x, volatile LAS unsigned* st) {
    asm volatile("s_waitcnt vmcnt(0)" ::: "memory");
    __syncthreads();
    if (threadIdx.x == 0) {
        __builtin_amdgcn_s_waitcnt(0);
        unsigned nloc = st[0], nx = st[1];
        if (nloc == 0u) { xcd_barrier_complete(bar, x, nloc, nx); st[0] = nloc; st[1] = nx; }
        const unsigned old = xb_add(&bar[XB_XSUB(x)], 1u);
        const unsigned gen = old / nloc;
        if (old + 1u == (gen + 1u) * nloc) {
            __builtin_amdgcn_fence(__ATOMIC_RELEASE, "agent");
            asm volatile("s_waitcnt vmcnt(0)" ::: "memory");
            const unsigned og = xb_add(&bar[XB_TOP], 1u);
            const unsigned tg = og / nx;
            if (og + 1u == (tg + 1u) * nx) xb_add(&bar[XB_TOPGEN], 1u);
            else XB_SPIN(xb_ld(&bar[XB_TOPGEN]) == tg, bar);
            __builtin_amdgcn_fence(__ATOMIC_ACQUIRE, "agent");
            xb_add(&bar[XB_XGEN(x)], 1u);
            asm volatile("s_waitcnt vmcnt(0)" ::: "memory");
        } else {
            XB_SPIN(xb_ld(&bar[XB_XGEN(x)]) == gen, bar);
            __builtin_amdgcn_fence(__ATOMIC_ACQUIRE, "agent");
            asm volatile("s_waitcnt vmcnt(0)" ::: "memory");
        }
    }
    __syncthreads();
}
#define CG_SYNC() do { asm volatile("s_waitcnt vmcnt(0) lgkmcnt(0)" ::: "memory"); grid.sync(); asm volatile("" ::: "memory"); } while (0)
#define GRID_SYNC() xcd_barrier((unsigned*)KWS() + 4096, xcc, (volatile LAS unsigned*)(lds + LDS_BYTES - 64))
__global__ void __launch_bounds__(NWAVES * 64, 2) mega_fwd(Params p) {
    extern __shared__ __attribute__((aligned(16))) unsigned char lds_raw[];
    LAS unsigned char* lds = (LAS unsigned char*)lds_raw;
    cg::grid_group grid = cg::this_grid();
    const int tid = threadIdx.x, lane = tid & 63, wave = __builtin_amdgcn_readfirstlane(tid >> 6);
    const int G = gridDim.x; const int bx = blockIdx.x; const int vcu0 = (G % 8 == 0) ? (bx % 8) * (G / 8) + bx / 8 : bx;
    const int NGW = G * NWAVES;
#define X ((bf16*)(ws + WS_X))
#define H ((bf16*)(ws + WS_H))
#define MIX ((bf16*)(ws + WS_MIX))
#define ACT ((bf16*)(ws + WS_ACT))
#define Qb ((bf16*)(ws + WS_QB))
#define Kb ((bf16*)(ws + WS_KB))
#define Vb ((bf16*)(ws + WS_VB))
#define Zb ((bf16*)(ws + WS_ZB))
#define Ob ((bf16*)(ws + WS_OB))
#define OPART ((float*)(ws + WS_OPART))
#define MLP ((float*)(ws + WS_ML))
#define pwt ((const bf16*)(ws + WS_POOLWT))
    if (tid < 16) ((LAS unsigned*)(lds + LDS_BYTES - 64))[tid] = 0u;
    const unsigned xcc = xb_xcc_id();
    if (tid == 0) (void)xb_add((unsigned*)KWS() + 4096 + XB_XCNT(xcc), 1u);
    __syncthreads();
    { const int gw = vcu0 * NWAVES + wave; prologue(lds, gw, NGW, wave, lane);
      norm_rows<false>(KIN(0), KIN(1), KIN(6), (bf16*)(KWS() + WS_H), nullptr, gw, NGW, lane); }
    CG_SYNC();
#define FRESH_IDS() int tid = threadIdx.x; asm volatile("" : "+v"(tid)); const int lane = tid & 63, wave = __builtin_amdgcn_readfirstlane(tid >> 6); int vcu = vcu0; asm volatile("" : "+s"(vcu)); const int gw = vcu * NWAVES + wave; (void)lane; (void)gw; (void)wave
#define CNT(nid, idx) ((unsigned*)(ws + CTL_CNT) + (size_t)((nid) * 80 + (idx)) * 64)
#pragma unroll 1
    for (int step = 0; step < 4; ++step) {
        const int l = step >> 1, f = step & 1;
        const bool first = (step == 0);
        { FRESH_IDS(); unsigned char* const ws = KWS(); unsigned char* const wl = ws + WS_W + (size_t)l * WL;
          pg8::Gemm g{H, (const bf16*)(wl + (f ? W_GU2 : W_GU1)), M, 2 * FF, D}; pg8::StaticOrder S; S.init(M, 2 * FF, G, bx);
          pg8::EpiSwiGLU E{ACT, FF};
          pg8::gemm_phase<pg8::EpiSwiGLU, pg8::StaticOrder, true, true>(lds, g, S, E); }
        GRID_SYNC();
        { FRESH_IDS(); unsigned char* const ws = KWS(); unsigned char* const wl = ws + WS_W + (size_t)l * WL;
          const bool last = (step == 3);
          const float* const gn = last ? KIN(25) : (f ? KIN(6) + (l + 1) * D : KIN(10) + l * D);
          const int nid = step * 2;
          float* const yo = KOUT() + OFF_Y;
          pg8::Gemm g{ACT, (const bf16*)(wl + (f ? W_D2 : W_D1)), MP, D, FF}; pg8::StaticOrder S; S.init(MP, D, G, bx);
          if (first) skinny_part1<false, FF>(lds, ACT + (size_t)MP * FF, (const bf16*)(wl + W_D1), KIN(1), X + (size_t)MP * D, 0.5f, (unsigned*)(ws + WS_SLOTS), CNT(nid, 64), vcu, tid);
          else skinny_part1<true, FF>(lds, ACT + (size_t)MP * FF, (const bf16*)(wl + (f ? W_D2 : W_D1)), X + (size_t)MP * D, last ? nullptr : X + (size_t)MP * D, 0.5f, (unsigned*)(ws + WS_SLOTS), CNT(nid, 64), vcu, tid);
          { pg8::Unit u0; const int pm0 = S.next(0, u0) ? u0.pm : 0;
            if (first) { pg8::EpiResidNorm<false> E{KIN(0), X, 0.5f, H, yo, gn, (unsigned*)(ws + WS_SLOTP), CNT(nid, pm0)};
                         pg8::gemm_phase<pg8::EpiResidNorm<false>, pg8::StaticOrder, false, true>(lds, g, S, E); }
            else { pg8::EpiResidNorm<true> E{X, last ? nullptr : X, 0.5f, last ? nullptr : H, yo, gn, (unsigned*)(ws + WS_SLOTP), CNT(nid, pm0)};
                   pg8::gemm_phase<pg8::EpiResidNorm<true>, pg8::StaticOrder, false, true>(lds, g, S, E); } }
          skinny_part2(lds, last ? nullptr : H + (size_t)MP * D, yo + (size_t)MP * D, gn, (unsigned*)(ws + WS_SLOTS), CNT(nid, 64), vcu, tid); }
        if (step == 3) break;
        GRID_SYNC();
        if (f == 0) {
            { FRESH_IDS(); unsigned char* const ws = KWS(); unsigned char* const wl = ws + WS_W + (size_t)l * WL;
              pg8::Gemm g{H, (const bf16*)(wl + W_IN), M, DIN, D}; pg8::StaticOrder S; S.init(M, DIN, G, bx);
              pg8::EpiWin E{ws, KOUT(), l, C2};
              pg8::gemm_phase<pg8::EpiWin, pg8::StaticOrder, true, true>(lds, g, S, E); }
            GRID_SYNC();
#pragma unroll 1
            for (int slot = 0; slot < 2; ++slot) {
              if (((slot ^ vcu0) & 1) == 0) {
                FRESH_IDS(); unsigned char* const ws = KWS();
                for (int i = 0; i < 4; ++i) {
                  const int L = i * G + vcu; if (L >= 1024) break;
                  const int bh = (L & 255) >> 1, sI = L & 1, ii = L >> 8;
                  const int qb = sI == 0 ? (ii == 0 ? 7 : ii == 1 ? 0 : ii == 2 ? 4 : 3) : (ii == 0 ? 6 : ii == 1 ? 1 : ii == 2 ? 5 : 2);
                  const int b = bh >> 4, vh = bh & 15, hh = vh >> 2, c = (vh >> 1) & 1, hf = vh & 1;
                  attn_body::attn_unit<8>(b, qb, (const attn_body::bf16*)(Qb + (hh * 2 + c) * 64), (const attn_body::bf16*)(Kb + (hh * 2 + c) * 64), (const attn_body::bf16*)(Vb + hh * 128 + hf * 64),
                                          (attn_body::bf16*)(Ob + c * 512 + hh * 128 + hf * 64), (char*)lds_raw);
                }
              } else {
                FRESH_IDS(); unsigned char* const ws = KWS(); float* const outp = KOUT();
                for (int pc = vcu; pc < 256; pc += G)
                  sample_piece(lds, pc, l, Qb, KIN(2), KIN(3), outp + OFF_KS, outp + OFF_VS, OPART, MLP, tid);
              }
              __syncthreads();
            }
            { FRESH_IDS(); unsigned char* const ws = KWS(); float* const outp = KOUT();
              for (int tl = vcu; tl < 264; tl += G)
                poolconv_tile(lds, tl, l, Zb, MIX, KIN(4), KIN(5), pwt, KIN(18), KIN(19), outp + OFF_CP, outp + OFF_CS, tid); }
            GRID_SYNC();
            { FRESH_IDS(); unsigned char* const ws = KWS();
              combine_phase(l, Ob, OPART, MLP, MIX, gw, NGW, lane); }
            GRID_SYNC();
            { FRESH_IDS(); unsigned char* const ws = KWS(); unsigned char* const wl = ws + WS_W + (size_t)l * WL;
              const float* const gn = KIN(21) + l * D; const int nid = step * 2 + 1;
              pg8::Gemm g{MIX, (const bf16*)(wl + W_OUT), MP, D, D}; pg8::StaticOrder S; S.init(MP, D, G, bx);
              skinny_part1<true, D>(lds, MIX + (size_t)MP * D, (const bf16*)(wl + W_OUT), X + (size_t)MP * D, X + (size_t)MP * D, 1.0f, (unsigned*)(ws + WS_SLOTS), CNT(nid, 64), vcu, tid);
              { pg8::Unit u0; const int pm0 = S.next(0, u0) ? u0.pm : 0;
                pg8::EpiResidNorm<true> E{X, X, 1.0f, H, nullptr, gn, (unsigned*)(ws + WS_SLOTP), CNT(nid, pm0)};
                pg8::gemm_phase<pg8::EpiResidNorm<true>, pg8::StaticOrder, false, true>(lds, g, S, E); }
              skinny_part2(lds, H + (size_t)MP * D, nullptr, gn, (unsigned*)(ws + WS_SLOTS), CNT(nid, 64), vcu, tid); }
            GRID_SYNC();
        }
    }
}

extern "C" void kernel_launch(void* const* d_in, const int* in_sizes, int n_in, void* d_out, int out_size, void* d_ws, size_t ws_size, hipStream_t stream) {
    static int grid = 0;
    if (grid == 0) {
        if (n_in != 26 || (size_t)out_size != OUT_TOTAL || ws_size < WS_END) { fprintf(stderr, "kernel_launch: unexpected problem shape: n_in %d out %d ws %zu\n", n_in, out_size, ws_size); grid = -1; return; }
        int dev = 0, cus = 0, per_cu = 0;
        if (hipGetDevice(&dev) != hipSuccess || hipDeviceGetAttribute(&cus, hipDeviceAttributeMultiprocessorCount, dev) != hipSuccess) { grid = -1; return; }
        if (hipFuncSetAttribute((const void*)mega_fwd, hipFuncAttributeMaxDynamicSharedMemorySize, LDS_BYTES) != hipSuccess) { fprintf(stderr, "kernel_launch: hipFuncSetAttribute failed\n"); grid = -1; return; }
        if (hipOccupancyMaxActiveBlocksPerMultiprocessor(&per_cu, (const void*)mega_fwd, NWAVES * 64, LDS_BYTES) != hipSuccess || per_cu < 1) { fprintf(stderr, "kernel_launch: occupancy query says %d\n", per_cu); per_cu = 1; }
        (void)hipGetLastError();
        grid = cus * per_cu;
    }
    if (grid < 0) return;
    if (hipMemsetAsync(d_ws, 0, CTL_BYTES, stream) != hipSuccess) { fprintf(stderr, "kernel_launch: memset failed\n"); return; }
    Params p{};
    for (int i = 0; i < 26; ++i) p.in[i] = (const float*)d_in[i];
    p.out = (float*)d_out; p.ws = (unsigned char*)d_ws;
    void* args[] = {&p};
    const hipError_t e = hipLaunchCooperativeKernel((const void*)mega_fwd, dim3(grid), dim3(NWAVES * 64), args, LDS_BYTES, stream);
    if (e != hipSuccess) fprintf(stderr, "kernel_launch: cooperative launch failed: %s (grid %d)\n", hipGetErrorString(e), grid);
}
```

```cpp
#include <hip/hip_runtime.h>
#include <hip/hip_cooperative_groups.h>
#include <cstdio>
#include <cstdint>
namespace pg8 {
#define PG8_LAS __attribute__((address_space(3)))
typedef unsigned short bf16_t;
typedef short bf16x8 __attribute__((ext_vector_type(8)));
typedef float f32x4 __attribute__((ext_vector_type(4)));
typedef unsigned u32x4 __attribute__((ext_vector_type(4)));
constexpr int BM = 256, BK = 64, HALF = 128, HTB = HALF * BK * 2  , STAGE_BYTES = 8 * HTB, NXCD = 8, WGM = 8;

__host__ __device__ __forceinline__ int lds_byte(int r, int c) { const int st = (r >> 4) * 2 + (c >> 5), rr = r & 15, cc = c & 31, ob = rr * 64 + cc * 2; return st * 1024 + (ob ^ (((ob >> 9) & 1) << 5)); }
__host__ __device__ __forceinline__ void stage_rc(int b, int& R, int& C) { const int st = b / 1024, sb = b % 1024, swz = sb ^ (((sb >> 9) & 1) << 5); R = (st >> 1) * 16 + swz / 64; C = (st & 1) * 32 + (swz % 64) / 2; }
__host__ __device__ __forceinline__ int perm32(int rho) { const int n = rho >> 4, i = rho & 15; return 8 * (i >> 2) + 4 * n + (i & 3); }

struct Unit { int pm, pn; };
struct Gemm { const bf16_t* A; const bf16_t* Bt; int M, N, K; };

struct StaticOrder {
    int nM, nN, nwg, G, c;
    __host__ __device__ __forceinline__ void init(int M, int N, int G_, int c_) { nM = M / BM; nN = N / BM; nwg = nM * nN; G = G_; c = c_; }
    __host__ __device__ __forceinline__ bool next(int i, Unit& u) const {
        const long L = (long)i * G + c; if (L >= nwg) return false;
        int wgid = (int)L; { const int q = nwg / NXCD, r = nwg % NXCD, xcd = wgid % NXCD, off = wgid / NXCD; wgid = (xcd < r ? xcd * (q + 1) : r * (q + 1) + (xcd - r) * q) + off; }
        const int nig = WGM * nN, gid = wgid / nig, fm = gid * WGM, gsz = (nM - fm) < WGM ? (nM - fm) : WGM;
        u.pm = fm + ((wgid % nig) % gsz); u.pn = (wgid % nig) / gsz; return true;
    }
    __device__ __forceinline__ void a_ready(const Unit&) const {}
    __device__ __forceinline__ void done(const Unit&) const {}
};

__device__ __forceinline__ unsigned cvt_pk_bf16(float lo, float hi) { unsigned r; asm volatile("v_cvt_pk_bf16_f32 %0, %1, %2" : "=v"(r) : "v"(lo), "v"(hi)); return r; }
typedef float f32x2 __attribute__((ext_vector_type(2)));
typedef unsigned u32x2 __attribute__((ext_vector_type(2)));
constexpr size_t WOFF_ROPE = (size_t)1 << 20, WOFF_QB = (size_t)215 << 20, WOFF_KB = (size_t)232 << 20, WOFF_VB = (size_t)249 << 20, WOFF_ZB = (size_t)266 << 20;
constexpr size_t OOFF_KP = 17039360, OOFF_VP = 33816576, OOFF_PP = 50593792, OOFF_KS = 50663424, OOFF_VS = 50925568, OOFF_PS = 51187712;
__device__ __forceinline__ float silu_mul(float g, float u) { const float e = __builtin_amdgcn_exp2f(-1.4426950408889634f * g); return g * u * __builtin_amdgcn_rcpf(1.0f + e); }
struct EpiSwiGLU {
    static constexpr bool PERM = true, AFTER_DRAIN = false;
    bf16_t* O; int ldc;
    __device__ __forceinline__ void operator()(const f32x4 (&acc)[2][2][4][2], const Unit& u, int wr, int wc, int fr, int fq) const {
        const int row0 = u.pm * BM + wr * 64 + fr; const int col0 = u.pn * 128 + wc * 32 + 8 * fq;
#pragma unroll
        for (int ai = 0; ai < 2; ++ai)
#pragma unroll
            for (int m = 0; m < 4; ++m) {
                bf16_t* p = O + (size_t)(row0 + ai * HALF + m * 16) * ldc + col0;
                const f32x4 g0 = acc[ai][0][m][0], g1 = acc[ai][0][m][1], u0 = acc[ai][1][m][0], u1 = acc[ai][1][m][1];
                u32x4 w;
                w.x = cvt_pk_bf16(silu_mul(g0[0], u0[0]), silu_mul(g0[1], u0[1])); w.y = cvt_pk_bf16(silu_mul(g0[2], u0[2]), silu_mul(g0[3], u0[3]));
                w.z = cvt_pk_bf16(silu_mul(g1[0], u1[0]), silu_mul(g1[1], u1[1])); w.w = cvt_pk_bf16(silu_mul(g1[2], u1[2]), silu_mul(g1[3], u1[3]));
                *(u32x4*)p = w;
                asm volatile("" ::: "memory");
            }
    }
};
struct EpiResid {
    static constexpr bool PERM = false, AFTER_DRAIN = false;
    const float* baseP; const float* baseS; float* out; float scale;
    __device__ __forceinline__ void operator()(const f32x4 (&acc)[2][2][4][2], const Unit& u, int wr, int wc, int fr, int fq) const {
        const int col0 = u.pn * BM + wc * 32 + 4 * fq;
#pragma unroll
        for (int ai = 0; ai < 2; ++ai)
#pragma unroll
            for (int m = 0; m < 4; ++m) {
                const int row = u.pm * BM + ai * HALF + wr * 64 + m * 16 + fr;
                const float* bp = (row < 16384) ? baseP + (size_t)row * 1024 : baseS + (size_t)(row - 16384) * 1024;
                float* op = out + (size_t)row * 1024;
#pragma unroll
                for (int bj = 0; bj < 2; ++bj)
#pragma unroll
                    for (int n = 0; n < 2; ++n) { const int c = col0 + bj * HALF + n * 16; const f32x4 b = *(const f32x4*)(bp + c); *(f32x4*)(op + c) = b + acc[ai][bj][m][n] * scale; }
                asm volatile("" ::: "memory");
            }
    }
};
constexpr float RMS_EPS = 1e-6f;
__device__ __forceinline__ float rstd_of(float ss) { return 1.0f / sqrtf(ss * (1.0f / 1024.0f) + RMS_EPS); }

#define PG8_RLX_AGENT __ATOMIC_RELAXED, __HIP_MEMORY_SCOPE_AGENT
template <bool BASE16> struct EpiResidNorm {
    static constexpr bool PERM = false, AFTER_DRAIN = true;
    const void* baseP; bf16_t* out; float scale; bf16_t* hb; float* yout; const float* gain; unsigned* slots; unsigned* cnt;
    __device__ __forceinline__ void fused(f32x4 (&acc)[2][2][4][2], const Unit& u, int wr, int wc, int fr, int fq, PG8_LAS unsigned char* lds, int wid, int lane) const {
        PG8_LAS float* P = (PG8_LAS float*)lds;
        PG8_LAS float* S = (PG8_LAS float*)(lds + 4096);
        const int col0 = u.pn * BM + wc * 32 + 4 * fq;
        if (BASE16) {
            u32x2 braw[2][4][2][2];
#pragma unroll
            for (int ai = 0; ai < 2; ++ai)
#pragma unroll
                for (int m = 0; m < 4; ++m) { const size_t ro = (size_t)(u.pm * BM + ai * HALF + wr * 64 + m * 16 + fr) * 1024;
#pragma unroll
                    for (int bj = 0; bj < 2; ++bj)
#pragma unroll
                        for (int n = 0; n < 2; ++n) braw[ai][m][bj][n] = *(const u32x2*)((const bf16_t*)baseP + ro + col0 + bj * HALF + n * 16); }
#pragma unroll
            for (int ai = 0; ai < 2; ++ai)
#pragma unroll
                for (int m = 0; m < 4; ++m)
#pragma unroll
                    for (int bj = 0; bj < 2; ++bj)
#pragma unroll
                        for (int n = 0; n < 2; ++n) { const u32x2 bw = braw[ai][m][bj][n]; f32x4 bv; bv[0] = __builtin_bit_cast(float, bw.x << 16); bv[1] = __builtin_bit_cast(float, bw.x & 0xffff0000u); bv[2] = __builtin_bit_cast(float, bw.y << 16); bv[3] = __builtin_bit_cast(float, bw.y & 0xffff0000u);
                            acc[ai][bj][m][n] = bv + acc[ai][bj][m][n] * scale; }
        }
#pragma unroll
        for (int ai = 0; ai < 2; ++ai)
#pragma unroll
            for (int m = 0; m < 4; ++m) {
                const int rl = ai * HALF + wr * 64 + m * 16 + fr; const size_t ro = (size_t)(u.pm * BM + rl) * 1024;
                float ss = 0.f;
#pragma unroll
                for (int bj = 0; bj < 2; ++bj)
#pragma unroll
                    for (int n = 0; n < 2; ++n) { const int c = col0 + bj * HALF + n * 16; f32x4 v;
                        if (BASE16) v = acc[ai][bj][m][n];
                        else { v = *(const f32x4*)((const float*)baseP + ro + c) + acc[ai][bj][m][n] * scale; acc[ai][bj][m][n] = v; }
                        if (out) { u32x2 w; w.x = cvt_pk_bf16(v[0], v[1]); w.y = cvt_pk_bf16(v[2], v[3]); *(u32x2*)(out + ro + c) = w; }
                        ss += (v[0] * v[0] + v[1] * v[1]) + (v[2] * v[2] + v[3] * v[3]); }
                ss += __builtin_bit_cast(float, __builtin_amdgcn_ds_swizzle(__builtin_bit_cast(int, ss), (16 << 10) | 0x1f));
                { float a = ss, b2 = ss; asm volatile("s_nop 1\n\tv_permlane32_swap_b32 %0, %1\n\ts_nop 1" : "+v"(a), "+v"(b2)); ss = a + b2; }
                if (fq == 0) P[rl * 4 + wc] = ss;
                if (!BASE16 && (m & 1)) asm volatile("" ::: "memory");
            }
        asm volatile("s_waitcnt lgkmcnt(0)\n\ts_barrier" ::: "memory");
        const int t = wid * 64 + lane;
        if (t < 256) { const float s = (P[t * 4] + P[t * 4 + 1]) + (P[t * 4 + 2] + P[t * 4 + 3]);
            __hip_atomic_store(slots + (size_t)(u.pm * BM + t) * 4 + u.pn, __builtin_bit_cast(unsigned, s), PG8_RLX_AGENT); }
        asm volatile("s_waitcnt vmcnt(0)" ::: "memory");
        if (wid < 4 && lane == 0) __hip_atomic_fetch_add(cnt, 1u, PG8_RLX_AGENT);
        if (wid == 0) {
            unsigned spins = 0;
            while ((unsigned)__builtin_amdgcn_readfirstlane(__hip_atomic_load(cnt, PG8_RLX_AGENT)) < 16u) { __builtin_amdgcn_s_sleep(2); if (++spins > (1u << 22)) break; }
            __builtin_amdgcn_fence(__ATOMIC_ACQUIRE, "agent");
        }
        asm volatile("s_waitcnt vmcnt(0) lgkmcnt(0)\n\ts_barrier" ::: "memory");
        if (t < 256) { const unsigned* sl = slots + (size_t)(u.pm * BM + t) * 4; float tot = 0.f;
#pragma unroll
            for (int k = 0; k < 4; ++k) tot += __builtin_bit_cast(float, __hip_atomic_load(sl + k, PG8_RLX_AGENT));
            S[t] = rstd_of(tot); }
        asm volatile("s_waitcnt lgkmcnt(0)\n\ts_barrier" ::: "memory");
        f32x4 g4[2][2];
#pragma unroll
        for (int bj = 0; bj < 2; ++bj)
#pragma unroll
            for (int n = 0; n < 2; ++n) g4[bj][n] = *(const f32x4*)(gain + col0 + bj * HALF + n * 16);
#pragma unroll
        for (int ai = 0; ai < 2; ++ai)
#pragma unroll
            for (int m = 0; m < 4; ++m) {
                const int rl = ai * HALF + wr * 64 + m * 16 + fr; const size_t ro = (size_t)(u.pm * BM + rl) * 1024; const float r = S[rl];
#pragma unroll
                for (int bj = 0; bj < 2; ++bj)
#pragma unroll
                    for (int n = 0; n < 2; ++n) { const int c = col0 + bj * HALF + n * 16; const f32x4 y = acc[ai][bj][m][n] * r * g4[bj][n];
                        if (hb) { u32x2 w; w.x = cvt_pk_bf16(y[0], y[1]); w.y = cvt_pk_bf16(y[2], y[3]); *(u32x2*)(hb + ro + c) = w; }
                        else *(f32x4*)(yout + ro + c) = y; }
            }
        asm volatile("s_waitcnt lgkmcnt(0)\n\ts_barrier" ::: "memory");
    }
};

struct EpiWin {
    static constexpr bool PERM = false, AFTER_DRAIN = false;
    unsigned char* ws; float* outp; int l; float qscale;
    __device__ __forceinline__ void operator()(const f32x4 (&acc)[2][2][4][2], const Unit& u, int wr, int wc, int fr, int fq) const {
        const int pn = u.pn;
        float invrev[2][4];
#pragma unroll
        for (int n = 0; n < 2; ++n)
#pragma unroll
            for (int j = 0; j < 4; ++j) invrev[n][j] = exp2f(-(float)(8 * fq + 4 * n + j) * (13.287712379549449f / 32.0f)) * 0.15915494309189535f;
        bf16_t* const Qb = (bf16_t*)(ws + WOFF_QB); bf16_t* const Kb = (bf16_t*)(ws + WOFF_KB); bf16_t* const Vb = (bf16_t*)(ws + WOFF_VB); bf16_t* const Zb = (bf16_t*)(ws + WOFF_ZB);
        float* const kP = outp + OOFF_KP + (size_t)l * 16384 * 512; float* const vP = outp + OOFF_VP + (size_t)l * 16384 * 512;
        float* const kS = outp + OOFF_KS + (size_t)l * 256 * 512; float* const vS = outp + OOFF_VS + (size_t)l * 256 * 512;
        float* const poolP = outp + OOFF_PP + (size_t)l * 8 * 15 * 256; float* const poolS = outp + OOFF_PS + (size_t)l * 8 * 15 * 256;
        const int c0 = 64 * wc + 8 * fq;
#pragma unroll
        for (int ai = 0; ai < 2; ++ai)
#pragma unroll
            for (int m = 0; m < 4; ++m) {
                const int row = u.pm * BM + ai * HALF + wr * 64 + m * 16 + fr;
                const bool smp = row >= 16384; const int rs = row - 16384;
                f32x4 v[2][2];
                if (pn < 4) {
                    const float posf = (float)(smp ? 4096 + (rs & 31) : (row & 2047));
#pragma unroll
                    for (int n = 0; n < 2; ++n) { f32x4 cs, sn;
#pragma unroll
                        for (int j = 0; j < 4; ++j) { const float rev = posf * invrev[n][j]; const float fr_ = rev - __builtin_rintf(rev); cs[j] = __builtin_amdgcn_cosf(fr_); sn[j] = __builtin_amdgcn_sinf(fr_); }
                        const f32x4 lo = acc[ai][0][m][n], hi = acc[ai][1][m][n];
                        v[0][n] = lo * cs - hi * sn; v[1][n] = hi * cs + lo * sn; }
                } else {
#pragma unroll
                    for (int bj = 0; bj < 2; ++bj)
#pragma unroll
                        for (int n = 0; n < 2; ++n) v[bj][n] = acc[ai][bj][m][n];
                }
#pragma unroll
                for (int bj = 0; bj < 2; ++bj) {
                    const int lc = c0 + 32 * bj; const f32x4 x0 = v[bj][0], x1 = v[bj][1];
                    if (pn < 2) {
                        bf16_t* q = Qb + (size_t)row * 512 + 256 * pn + lc;
                        u32x4 w; w.x = cvt_pk_bf16(x0[0] * qscale, x0[1] * qscale); w.y = cvt_pk_bf16(x0[2] * qscale, x0[3] * qscale); w.z = cvt_pk_bf16(x1[0] * qscale, x1[1] * qscale); w.w = cvt_pk_bf16(x1[2] * qscale, x1[3] * qscale);
                        *(u32x4*)q = w;
                    } else {
                        u32x4 w; w.x = cvt_pk_bf16(x0[0], x0[1]); w.y = cvt_pk_bf16(x0[2], x0[3]); w.z = cvt_pk_bf16(x1[0], x1[1]); w.w = cvt_pk_bf16(x1[2], x1[3]);
                        if (pn < 4) { const int col = 256 * (pn - 2) + lc; float* ko = smp ? kS + (size_t)rs * 512 + col : kP + (size_t)row * 512 + col;
                            *(f32x4*)ko = x0; *(f32x4*)(ko + 4) = x1; *(u32x4*)(Kb + (size_t)row * 512 + col) = w; }
                        else if (pn < 6) { const int col = 256 * (pn - 4) + lc; float* vo = smp ? vS + (size_t)rs * 512 + col : vP + (size_t)row * 512 + col;
                            *(f32x4*)vo = x0; *(f32x4*)(vo + 4) = x1; *(u32x4*)(Vb + (size_t)row * 512 + col) = w; }
                        else { *(u32x4*)(Zb + (size_t)row * 1024 + 256 * (pn - 6) + lc) = w;
                            if (pn == 6) {
                                if (smp) { const int b = rs >> 5, t = rs & 31; if (t >= 17) { float* po = poolS + (size_t)(b * 15 + t - 17) * 256 + lc; *(f32x4*)po = x0; *(f32x4*)(po + 4) = x1; } }
                                else { const int b = row >> 11, t = row & 2047; if (t >= 2033) { float* po = poolP + (size_t)(b * 15 + t - 2033) * 256 + lc; *(f32x4*)po = x0; *(f32x4*)(po + 4) = x1; } }
                            } }
                    }
                }
                asm volatile("" ::: "memory");
            }
    }
};
template <class Epi, class Sched, bool ALIGN_EPI = false, bool SP2 = false>
__device__ __forceinline__ void gemm_phase(PG8_LAS unsigned char* lds, const Gemm g, const Sched& S, const Epi& E) {
    int tid_l = threadIdx.x; asm volatile("" : "+v"(tid_l)); const int tid = tid_l, wid = __builtin_amdgcn_readfirstlane(tid >> 6), lane = tid & 63, wr = wid >> 2, wc = wid & 3, fr = lane & 15, fq = lane >> 4;
    const int K = g.K, nt = K / BK;
    unsigned voffA[2], voffB[2];
#pragma unroll
    for (int i = 0; i < 2; ++i) { int R, C; stage_rc(tid * 16 + i * 8192, R, C); const int Rb = Epi::PERM ? ((R & ~31) + perm32(R & 31)) : R;
        voffA[i] = (unsigned)(R * K + C) * 2u; voffB[i] = (unsigned)(Rb * K + C) * 2u; }
    const size_t kstep = (size_t)(BK * 2);
    const size_t hstep = (size_t)HALF * K * 2;
    const size_t tstep = 2 * hstep;
    const unsigned ldsw = (unsigned)wid * 1024u;
    const int aoff = lds_byte(wr * 64 + fr, fq * 8), boff = lds_byte(wc * 32 + fr, fq * 8);
#define PG8_SA(b, h) (((b) * 2 + (h)) * HTB)
#define PG8_SB(b, h) ((4 + (b) * 2 + (h)) * HTB)
#define PG8_STAGE(bufoff, gbase, voff) do { _Pragma("unroll") for (int _i = 0; _i < 2; ++_i) \
        __builtin_amdgcn_global_load_lds((const unsigned*)((const char*)(gbase) + (voff)[_i]), (PG8_LAS unsigned*)(lds + (bufoff) + ldsw + _i * 8192), 16, 0, 0); } while (0)
#define PG8_LDA(dst, b, h) do { _Pragma("unroll") for (int m = 0; m < 4; ++m) _Pragma("unroll") for (int k = 0; k < 2; ++k) dst[m][k] = *(const PG8_LAS bf16x8*)(lds + PG8_SA(b, h) + aoff + m * 2048 + k * 1024); } while (0)
#define PG8_LDB(dst, b, h) do { _Pragma("unroll") for (int n = 0; n < 2; ++n) _Pragma("unroll") for (int k = 0; k < 2; ++k) dst[n][k] = *(const PG8_LAS bf16x8*)(lds + PG8_SB(b, h) + boff + n * 2048 + k * 1024); } while (0)
#define PG8_MMA(ai, bj, At, Bt) do { __builtin_amdgcn_s_setprio(1); _Pragma("unroll") for (int m = 0; m < 4; ++m) _Pragma("unroll") for (int n = 0; n < 2; ++n) _Pragma("unroll") for (int k = 0; k < 2; ++k) \
        acc[ai][bj][m][n] = __builtin_amdgcn_mfma_f32_16x16x32_bf16(Bt[n][k], At[m][k], acc[ai][bj][m][n], 0, 0, 0); __builtin_amdgcn_s_setprio(0); } while (0)
#define PG8_WAIT_V(n) asm volatile("s_waitcnt vmcnt(" #n ")" ::: "memory")
#define PG8_WAIT_L(n) asm volatile("s_waitcnt lgkmcnt(" #n ")" ::: "memory")
#define PG8_BAR __builtin_amdgcn_s_barrier()
#define PG8_SCHED __builtin_amdgcn_sched_barrier(0)
    Unit cur, nxt; int ui = 0;
    if (!S.next(0, cur)) return;
    f32x4 acc[2][2][4][2];
#pragma unroll
    for (int a = 0; a < 2; ++a)
#pragma unroll
        for (int b = 0; b < 2; ++b)
#pragma unroll
            for (int m = 0; m < 4; ++m)
#pragma unroll
                for (int n = 0; n < 2; ++n) acc[a][b][m][n] = (f32x4){0.f, 0.f, 0.f, 0.f};
    bf16x8 At[4][2], B0[2][2], B1[2][2];
    const char* cA = (const char*)g.A + (size_t)cur.pm * tstep; const char* cB = (const char*)g.Bt + (size_t)cur.pn * tstep;
    S.a_ready(cur);
    if constexpr (SP2) {
        PG8_STAGE(PG8_SB(0, 0), cB, voffB); PG8_STAGE(PG8_SB(0, 1), cB + hstep, voffB); PG8_STAGE(PG8_SA(0, 0), cA, voffA); PG8_STAGE(PG8_SA(0, 1), cA + hstep, voffA);
        if (wr == 1) PG8_BAR;
        PG8_WAIT_V(2); PG8_BAR;
        PG8_STAGE(PG8_SB(1, 0), cB + kstep, voffB); PG8_STAGE(PG8_SA(1, 0), cA + kstep, voffA); PG8_STAGE(PG8_SB(1, 1), cB + hstep + kstep, voffB);
        PG8_WAIT_V(6); PG8_BAR;
    } else {
        PG8_STAGE(PG8_SB(0, 0), cB, voffB); PG8_STAGE(PG8_SA(0, 0), cA, voffA); PG8_STAGE(PG8_SB(0, 1), cB + hstep, voffB); PG8_STAGE(PG8_SA(0, 1), cA + hstep, voffA);
        if (wr == 1) PG8_BAR;
        PG8_WAIT_V(4); PG8_BAR;
        PG8_STAGE(PG8_SB(1, 0), cB + kstep, voffB); PG8_STAGE(PG8_SA(1, 0), cA + kstep, voffA); PG8_STAGE(PG8_SB(1, 1), cB + hstep + kstep, voffB);
        PG8_WAIT_V(6); PG8_BAR;
    }
    for (;;) {
        const bool has_next = S.next(ui + 1, nxt);
        const char* nA = has_next ? (const char*)g.A + (size_t)nxt.pm * tstep : cA; const char* nB = has_next ? (const char*)g.Bt + (size_t)nxt.pn * tstep : cB;
        for (int t = 0; t < nt; t += 2) {
            const bool last = (t == nt - 2);
            const char* a1 = cA + (size_t)(t + 1) * kstep;
            const char* a2 = last ? nA : cA + (size_t)(t + 2) * kstep; const char* b2 = last ? nB : cB + (size_t)(t + 2) * kstep;
            const char* a3 = a2 + kstep; const char* b3 = b2 + kstep;
            if (last && has_next) S.a_ready(nxt);
            if constexpr (SP2) {
            PG8_LDB(B0, 0, 0); PG8_LDB(B1, 0, 1); PG8_SCHED; PG8_LDA(At, 0, 0); PG8_STAGE(PG8_SA(1, 1), a1 + hstep, voffA);
            PG8_WAIT_V(8); PG8_WAIT_L(0); PG8_BAR; PG8_MMA(0, 0, At, B0); PG8_MMA(0, 1, At, B1); PG8_BAR; PG8_SCHED;
            PG8_LDA(At, 0, 1); PG8_STAGE(PG8_SB(0, 0), b2, voffB); PG8_STAGE(PG8_SB(0, 1), b2 + hstep, voffB); PG8_STAGE(PG8_SA(0, 0), a2, voffA);
            PG8_WAIT_V(8); PG8_WAIT_L(0); PG8_BAR; PG8_MMA(1, 0, At, B0); PG8_MMA(1, 1, At, B1); PG8_BAR; PG8_SCHED;
            PG8_LDB(B0, 1, 0); PG8_LDB(B1, 1, 1); PG8_SCHED; PG8_LDA(At, 1, 0); PG8_STAGE(PG8_SA(0, 1), a2 + hstep, voffA);
            PG8_WAIT_V(8); PG8_WAIT_L(0); PG8_BAR; PG8_MMA(0, 0, At, B0); PG8_MMA(0, 1, At, B1); PG8_BAR; PG8_SCHED;
            PG8_LDA(At, 1, 1); PG8_STAGE(PG8_SB(1, 0), b3, voffB); PG8_STAGE(PG8_SB(1, 1), b3 + hstep, voffB); PG8_STAGE(PG8_SA(1, 0), a3, voffA);
            PG8_WAIT_V(8); PG8_WAIT_L(0); PG8_BAR; PG8_MMA(1, 0, At, B0); PG8_MMA(1, 1, At, B1); PG8_BAR; PG8_SCHED;
            } else {
            PG8_LDB(B0, 0, 0); PG8_SCHED; PG8_LDA(At, 0, 0); PG8_STAGE(PG8_SA(1, 1), a1 + hstep, voffA);
            PG8_WAIT_L(8); PG8_BAR; PG8_WAIT_L(0); PG8_MMA(0, 0, At, B0); PG8_BAR; PG8_SCHED;
            PG8_LDB(B1, 0, 1); PG8_STAGE(PG8_SB(0, 0), b2, voffB);
            PG8_BAR; PG8_WAIT_L(0); PG8_MMA(0, 1, At, B1); PG8_BAR;
            PG8_LDA(At, 0, 1); PG8_STAGE(PG8_SA(0, 0), a2, voffA);
            PG8_BAR; PG8_WAIT_L(0); PG8_MMA(1, 0, At, B0); PG8_BAR; PG8_SCHED;
            PG8_STAGE(PG8_SB(0, 1), b2 + hstep, voffB);
            PG8_WAIT_V(6); PG8_BAR; PG8_MMA(1, 1, At, B1); PG8_BAR;
            PG8_LDB(B0, 1, 0); PG8_SCHED; PG8_LDA(At, 1, 0); PG8_STAGE(PG8_SA(0, 1), a2 + hstep, voffA);
            PG8_WAIT_L(8); PG8_BAR; PG8_WAIT_L(0); PG8_MMA(0, 0, At, B0); PG8_BAR; PG8_SCHED;
            PG8_LDB(B1, 1, 1); PG8_STAGE(PG8_SB(1, 0), b3, voffB);
            PG8_BAR; PG8_WAIT_L(0); PG8_MMA(0, 1, At, B1); PG8_BAR;
            PG8_LDA(At, 1, 1); PG8_STAGE(PG8_SA(1, 0), a3, voffA);
            PG8_BAR; PG8_WAIT_L(0); PG8_MMA(1, 0, At, B0); PG8_BAR; PG8_SCHED;
            PG8_STAGE(PG8_SB(1, 1), b3 + hstep, voffB);
            PG8_WAIT_V(6); PG8_BAR; PG8_MMA(1, 1, At, B1); PG8_BAR;
            }
        }
        if constexpr (ALIGN_EPI) { if (wr == 0) PG8_BAR; }
        if constexpr (!Epi::AFTER_DRAIN) { E(acc, cur, wr, wc, fr, fq); S.done(cur); }
        if (!has_next) break;
#pragma unroll
        for (int a = 0; a < 2; ++a)
#pragma unroll
            for (int b = 0; b < 2; ++b)
#pragma unroll
                for (int m = 0; m < 4; ++m)
#pragma unroll
                    for (int n = 0; n < 2; ++n) acc[a][b][m][n] = (f32x4){0.f, 0.f, 0.f, 0.f};
        cur = nxt; cA = nA; cB = nB; ++ui;
        if constexpr (ALIGN_EPI) { if (wr == 1) PG8_BAR; }
    }
    PG8_WAIT_V(0);
    if constexpr (!ALIGN_EPI) { if (wr == 0) PG8_BAR; }
    PG8_BAR;
    if constexpr (Epi::AFTER_DRAIN) { E.fused(acc, cur, wr, wc, fr, fq, lds, wid, lane); S.done(cur); }
#undef PG8_SA
#undef PG8_SB
#undef PG8_STAGE
#undef PG8_LDA
#undef PG8_LDB
#undef PG8_MMA
#undef PG8_WAIT_V
#undef PG8_WAIT_L
#undef PG8_BAR
#undef PG8_SCHED
}
}
#include <hip/hip_bf16.h>
#include <cmath>
namespace attn_body {
using bf16=__hip_bfloat16;
using bf16x8=__attribute__((ext_vector_type(8)))short;
using s16x4=__attribute__((ext_vector_type(4)))short;
using f32x16=__attribute__((ext_vector_type(16)))float;
using u32x4=__attribute__((ext_vector_type(4)))unsigned;
constexpr int BATCH=8,NHEAD=16,SEQ=2048,D=64,PQK=512,PO=1024;
constexpr int NW=8,QBLK=32,QB=QBLK*NW,KVBLK=64,NQB=SEQ/QB;
constexpr int ATTN_UNIT_ROWS=QB;
__device__ __forceinline__ int crow(int r,int hi){return (r&3)+8*(r>>2)+4*hi;}
#define SBAR() __builtin_amdgcn_sched_barrier(0)
__device__ __forceinline__ void cmask(f32x16&p0,f32x16&p1,int jb,int qrel,int hi){
  const float NEG=-INFINITY; (void)hi;
  if(jb>(qrel>>6)){
  #pragma unroll
  for(int r=0;r<16;++r){p0[r]=NEG;p1[r]=NEG;}}
}

constexpr int NSLOT=3, SLOTB=8192;
constexpr int LDS_K=0, LDS_V=NSLOT*SLOTB, LDS_WS=2*NSLOT*SLOTB, LDS_OST=LDS_WS+NW*64*4, LDS_BYTES=LDS_OST+NW*4096;
constexpr float C2=0.125f*1.4426950408889634f;
__device__ __forceinline__ void glds16(const void*gsrc,unsigned lds_dst){unsigned keep;
  asm volatile("s_mov_b32 %0, m0\n\ts_mov_b32 m0, %2\n\ts_nop 0\n\tglobal_load_lds_dwordx4 %1, off\n\ts_mov_b32 m0, %0":"=&s"(keep):"v"(gsrc),"s"(lds_dst):"memory");}
__device__ __forceinline__ float max3f(float a,float b,float c){float r;asm("v_max3_f32 %0, %1, %2, %3":"=v"(r):"v"(a),"v"(b),"v"(c));return r;}
__device__ __forceinline__ float max2f(float a,float b){float r;asm("v_max_f32_e32 %0, %1, %2":"=v"(r):"v"(a),"v"(b));return r;}
__device__ __forceinline__ float fadd_s(float a,float b){float r;asm("v_add_f32_e32 %0, %1, %2":"=v"(r):"v"(a),"v"(b));return r;}
__device__ __forceinline__ float fsub_s(float a,float b){float r;asm("v_sub_f32_e32 %0, %1, %2":"=v"(r):"v"(a),"v"(b));return r;}
typedef float f32x2_t __attribute__((ext_vector_type(2))); typedef __bf16 bf16x2_t __attribute__((ext_vector_type(2)));
__device__ __forceinline__ unsigned cvtpk_s(float lo,float hi){f32x2_t v={lo,hi};bf16x2_t b=__builtin_convertvector(v,bf16x2_t);return __builtin_bit_cast(unsigned,b);}
#define WAIT_BAR(N) asm volatile("s_waitcnt vmcnt(" #N ") lgkmcnt(0)\n\ts_barrier":::"memory")

__device__ __forceinline__ void qkt(f32x16&p0,f32x16&p1,const char*Kslot,const bf16x8*qr,const f32x16&negm,int r32,int hi){
  const char*kb=Kslot+hi*1024+r32*16;
  #pragma unroll
  for(int d0=0;d0<4;++d0){
    const bf16x8 b0=*reinterpret_cast<const bf16x8*>(kb+d0*2048);
    const bf16x8 b1=*reinterpret_cast<const bf16x8*>(kb+d0*2048+512);
    if(d0==0){p0=__builtin_amdgcn_mfma_f32_32x32x16_bf16(b0,qr[0],negm,0,0,0);p1=__builtin_amdgcn_mfma_f32_32x32x16_bf16(b1,qr[0],negm,0,0,0);}
    else{p0=__builtin_amdgcn_mfma_f32_32x32x16_bf16(b0,qr[d0],p0,0,0,0);p1=__builtin_amdgcn_mfma_f32_32x32x16_bf16(b1,qr[d0],p1,0,0,0);}}
}
typedef __attribute__((address_space(3))) const char* lds_cptr;
typedef short v4i16_t __attribute__((ext_vector_type(4)));
__device__ __forceinline__ void kload8(bf16x8*kf,lds_cptr kp){
  kf[0]=*(const __attribute__((address_space(3))) bf16x8*)(kp);      kf[1]=*(const __attribute__((address_space(3))) bf16x8*)(kp+512);
  kf[2]=*(const __attribute__((address_space(3))) bf16x8*)(kp+2048); kf[3]=*(const __attribute__((address_space(3))) bf16x8*)(kp+2560);
  kf[4]=*(const __attribute__((address_space(3))) bf16x8*)(kp+4096); kf[5]=*(const __attribute__((address_space(3))) bf16x8*)(kp+4608);
  kf[6]=*(const __attribute__((address_space(3))) bf16x8*)(kp+6144); kf[7]=*(const __attribute__((address_space(3))) bf16x8*)(kp+6656);
}
__device__ __forceinline__ void kload2(bf16x8*kf,lds_cptr kp,int j){ kf[2*j]=*(const __attribute__((address_space(3))) bf16x8*)(kp+j*2048); kf[2*j+1]=*(const __attribute__((address_space(3))) bf16x8*)(kp+j*2048+512); }
__device__ __forceinline__ s16x4 vtr(lds_cptr p){ return __builtin_bit_cast(s16x4,__builtin_amdgcn_ds_read_tr16_b64_v4i16((__attribute__((address_space(3))) v4i16_t*)p)); }
__device__ __forceinline__ float rowmax(const f32x16&p0,const f32x16&p1){
  float a=max3f(p0[0],p0[1],p1[0]),b=max3f(p0[2],p0[3],p1[1]);a=max3f(a,p1[2],p1[3]);
  #pragma unroll
  for(int r=4;r<16;r+=4){a=max3f(a,p0[r],p0[r+1]);b=max3f(b,p0[r+2],p0[r+3]);a=max3f(a,p1[r],p1[r+1]);b=max3f(b,p1[r+2],p1[r+3]);}
  const float m=max2f(a,b);
  auto rr=__builtin_amdgcn_permlane32_swap(__float_as_uint(m),__float_as_uint(m),false,false);
  return max2f(__uint_as_float(rr[0]),__uint_as_float(rr[1]));
}
__device__ __forceinline__ void pv(f32x16*o,int vb,bf16x8 pa0,bf16x8 pa1,bf16x8 pa2,bf16x8 pa3){
  #pragma unroll
  for(int d0=0;d0<2;++d0){s16x4 lo[4],hi[4];
    #pragma unroll
    for(int ks=0;ks<4;++ks){
      asm volatile("ds_read_b64_tr_b16 %0,%1 offset:%c2":"=&v"(lo[ks]):"v"(vb),"i"(d0*4096+ks*1024):"memory");
      asm volatile("ds_read_b64_tr_b16 %0,%1 offset:%c2":"=&v"(hi[ks]):"v"(vb),"i"(d0*4096+ks*1024+512):"memory");}
    asm volatile("s_waitcnt lgkmcnt(0)":::"memory");SBAR();
    #define PK(k) (bf16x8){lo[k][0],lo[k][1],lo[k][2],lo[k][3],hi[k][0],hi[k][1],hi[k][2],hi[k][3]}
    o[d0]=__builtin_amdgcn_mfma_f32_32x32x16_bf16(pa0,PK(0),o[d0],0,0,0);
    o[d0]=__builtin_amdgcn_mfma_f32_32x32x16_bf16(pa1,PK(1),o[d0],0,0,0);
    o[d0]=__builtin_amdgcn_mfma_f32_32x32x16_bf16(pa2,PK(2),o[d0],0,0,0);
    o[d0]=__builtin_amdgcn_mfma_f32_32x32x16_bf16(pa3,PK(3),o[d0],0,0,0);
    #undef PK
  }
}

#ifndef ATTN_STORE16
#define ATTN_STORE16(p,v) (*(u32x4*)(p)=(v))
#endif
template<int THRL> __device__ __forceinline__ void attn_unit(int b,int qb,const bf16*Q,const bf16*__restrict__ K,const bf16*__restrict__ V,bf16*O,char*shm){
  int tid_l=threadIdx.x; asm volatile("":"+v"(tid_l)); const int tid=tid_l,lane=tid&63,r32=lane&31,hi=lane>>5; const int wid=__builtin_amdgcn_readfirstlane(tid>>6);
  const long rowbase=(long)b*SEQ; const int q0=qb*QB;
  const bf16*Qw=Q+(rowbase+q0+wid*QBLK)*PQK;
  const bf16*Kh=K+rowbase*PQK,*Vh=V+rowbase*PQK;
  const unsigned lds0=(unsigned)(uintptr_t)shm;
  float*wsf=(float*)(shm+LDS_WS)+wid*64;
  const bf16*ksrc=Kh+(long)lane*PQK+wid*8;
  const bf16*vsrc=Vh+(long)(16*(wid&3)+(lane>>2))*PQK+(wid>>2)*32+(lane&3)*8;
  const unsigned kdst=lds0+LDS_K+wid*1024, vdst=lds0+LDS_V+wid*1024;
  #define DMA_K(t,slot) glds16(ksrc+(long)(t)*KVBLK*PQK,(unsigned)__builtin_amdgcn_readfirstlane(kdst+(slot)))
  #define DMA_V(t,slot) glds16(vsrc+(long)(t)*KVBLK*PQK,(unsigned)__builtin_amdgcn_readfirstlane(vdst+(slot)))
  const int vb0=(int)(lds0+LDS_V)+((lane>>4)&1)*32+(lane&3)*8+(4*hi+((lane&15)>>2))*64;
  const char*Kbase=shm+LDS_K; bf16x8 kf[8];
  const lds_cptr shm3=(lds_cptr)shm; const lds_cptr kp0=shm3+LDS_K+hi*1024+r32*16; const lds_cptr vp0=shm3+LDS_V+((lane>>4)&1)*32+(lane&3)*8+(4*hi+((lane&15)>>2))*64;
  const int NT=(q0+QB)/KVBLK;
  DMA_K(0,0);DMA_V(0,0);DMA_K(1,SLOTB);
  bf16x8 qr[4];
  #pragma unroll
  for(int d0=0;d0<4;++d0)qr[d0]=*reinterpret_cast<const bf16x8*>(&Qw[(long)r32*PQK+d0*16+hi*8]);
  float mhat=0.f,l_reg=0.f;f32x16 o[2];o[0]=f32x16{};o[1]=f32x16{};f32x16 negm=f32x16{};asm volatile("":"+v"(negm));
  const int qrel=wid*QBLK+r32;
  #define CMASK(P0,P1,t) do{int jb_=(t)-(NT-4); if(jb_>=0)cmask(P0,P1,jb_,qrel,hi);}while(0)
  bool resc=false;
  #define START(P0,P1) do{ const float rm=rowmax(P0,P1); resc=false; \
    { const float dl=rm; mhat=fadd_s(mhat,dl); \
      _Pragma("unroll") for(int r=0;r<16;++r){P0[r]=fsub_s(P0[r],dl);P1[r]=fsub_s(P1[r],dl);} \
      _Pragma("unroll") for(int r=0;r<16;++r)negm[r]=-mhat; asm volatile("":"+v"(negm)); } \
    _Pragma("unroll") for(int r=0;r<16;++r)P0[r]=__builtin_amdgcn_exp2f(P0[r]); }while(0)
  #define RESC() do{ if(resc){ asm volatile("s_waitcnt lgkmcnt(0)":::"memory"); \
      _Pragma("unroll") for(int d_=0;d_<2;++d_) _Pragma("unroll") for(int r=0;r<16;++r)o[d_][r]*=wsf[crow(r,hi)]; } }while(0)
  f32x16 pA0,pA1,pB0,pB1;
  int sl_prev=0,sl_cur=0,sl_next=SLOTB;
  #define ROT() do{sl_prev=sl_cur;sl_cur=sl_next;sl_next=(sl_next==(NSLOT-1)*SLOTB)?0:sl_next+SLOTB;}while(0)
  DMA_K(2,2*SLOTB);
  WAIT_BAR(3);
  qkt(pA0,pA1,Kbase,qr,negm,r32,hi);asm volatile("s_nop 15\n\ts_nop 7":"+v"(pA0),"+v"(pA1));CMASK(pA0,pA1,0);
  START(pA0,pA1);
  _Pragma("unroll") for(int r=0;r<16;++r)pA1[r]=__builtin_amdgcn_exp2f(pA1[r]);
  WAIT_BAR(0);
  DMA_K(3,0);DMA_V(1,SLOTB);
  ROT();
  kload8(kf,kp0+sl_cur);
  WAIT_BAR(2);
  s16x4 vlo[8],vhi[8]; u32x4 pw0,pw1,pw2,pw3;
  #define PKW(P,B) cvtpk_s(P[B],P[B+1])
  #define PAF(k) __builtin_bit_cast(bf16x8,pw##k)
  #define VFR(i) (bf16x8){vlo[i][0],vlo[i][1],vlo[i][2],vlo[i][3],vhi[i][0],vhi[i][1],vhi[i][2],vhi[i][3]}
  #define PIN(x) asm volatile("":"+v"(x))
  #define MX3(a,b,c) __builtin_fmaxf(__builtin_fmaxf((a),(b)),(c))
  #define GAPA(MF,A0,A1,A2,A3,W0,W1,PW) do{ MF; sacc+=A0; sacc+=A1; sacc+=A2; sacc+=A3; PIN(sacc); W0; W1; PIN(PW); SBAR(); }while(0)
  #define EX(v) __builtin_amdgcn_exp2f(v)
  #define GAPB(MF,X,B) do{ MF; X[B]=EX(X[B]); X[B+1]=EX(X[B+1]); X[B+2]=EX(X[B+2]); X[B+3]=EX(X[B+3]); PIN(X); SBAR(); }while(0)
  #define VRD(i) do{ vlo[i]=vtr(vp_+(((i)>>2)*4096+((i)&3)*1024)); vhi[i]=vtr(vp_+(((i)>>2)*4096+((i)&3)*1024+512)); }while(0)
  #define KRD(G,j) do{ if(G){ kload2(kf,kp0+sl_next,j); SBAR(); } }while(0)
  #define STEP(C0,C1,P0,P1,t,GK,GV,GL) do{ SBAR(); \
    const lds_cptr vp_=vp0+sl_prev; \
    VRD(0); SBAR(); float sacc=(P0[0]+P0[1]); \
    GAPA(C0=__builtin_amdgcn_mfma_f32_32x32x16_bf16(kf[0],qr[0],negm,0,0,0), P0[2],P0[3],P0[4],P0[5],     pw0[0]=PKW(P0,0), pw0[1]=PKW(P0,2), pw0); \
    VRD(4); SBAR(); GAPA(C1=__builtin_amdgcn_mfma_f32_32x32x16_bf16(kf[1],qr[0],negm,0,0,0), P0[6],P0[7],P0[8],P0[9],     pw0[2]=PKW(P0,4), pw0[3]=PKW(P0,6), pw0); \
    VRD(1); SBAR(); GAPA(C0=__builtin_amdgcn_mfma_f32_32x32x16_bf16(kf[2],qr[1],C0,0,0,0),   P0[10],P0[11],P0[12],P0[13], pw1[0]=PKW(P0,8), pw1[1]=PKW(P0,10), pw1); \
    VRD(5); SBAR(); GAPA(C1=__builtin_amdgcn_mfma_f32_32x32x16_bf16(kf[3],qr[1],C1,0,0,0),   P0[14],P0[15],P1[0],P1[1],   pw1[2]=PKW(P0,12),pw1[3]=PKW(P0,14), pw1); \
    VRD(2); SBAR(); GAPA(C0=__builtin_amdgcn_mfma_f32_32x32x16_bf16(kf[4],qr[2],C0,0,0,0),   P1[2],P1[3],P1[4],P1[5],     pw2[0]=PKW(P1,0), pw2[1]=PKW(P1,2), pw2); \
    VRD(6); SBAR(); GAPA(C1=__builtin_amdgcn_mfma_f32_32x32x16_bf16(kf[5],qr[2],C1,0,0,0),   P1[6],P1[7],P1[8],P1[9],     pw2[2]=PKW(P1,4), pw2[3]=PKW(P1,6), pw2); \
    VRD(3); SBAR(); GAPA(C0=__builtin_amdgcn_mfma_f32_32x32x16_bf16(kf[6],qr[3],C0,0,0,0),   P1[10],P1[11],P1[12],P1[13], pw3[0]=PKW(P1,8), pw3[1]=PKW(P1,10), pw3); \
    VRD(7); SBAR(); GAPA(C1=__builtin_amdgcn_mfma_f32_32x32x16_bf16(kf[7],qr[3],C1,0,0,0),   P1[14],P1[15],0.f,0.f,       pw3[2]=PKW(P1,12),pw3[3]=PKW(P1,14), pw3); \
    l_reg+=sacc; \
    if(GK){DMA_K((t)+3,sl_cur);} if(GV){DMA_V((t)+1,sl_next);} \
    CMASK(C0,C1,t); \
    { float a=MX3(C0[0],C0[1],C1[0]),b=MX3(C0[2],C0[3],C1[1]); a=MX3(a,C1[2],C1[3]); \
      _Pragma("unroll") for(int r=4;r<16;r+=4){a=MX3(a,C0[r],C0[r+1]);b=MX3(b,C0[r+2],C0[r+3]);a=MX3(a,C1[r],C1[r+1]);b=MX3(b,C1[r+2],C1[r+3]);} \
      float rm=__builtin_fmaxf(a,b); { auto rr=__builtin_amdgcn_permlane32_swap(__float_as_uint(rm),__float_as_uint(rm),false,false); rm=__builtin_fmaxf(__uint_as_float(rr[0]),__uint_as_float(rr[1])); } \
      resc=false; \
      if(__builtin_expect(__any(rm>(float)THRL),0)){ const float dl=__builtin_fmaxf(rm,0.f); mhat+=dl; \
        _Pragma("unroll") for(int r=0;r<16;++r){C0[r]-=dl;C1[r]-=dl;} \
        _Pragma("unroll") for(int r=0;r<16;++r)negm[r]=-mhat; asm volatile("":"+v"(negm)); \
        const float f=__builtin_amdgcn_exp2f(-dl); l_reg*=f; if(hi==0)wsf[r32]=f; resc=true; } } \
    SBAR(); \
    GAPB(o[0]=__builtin_amdgcn_mfma_f32_32x32x16_bf16(PAF(0),VFR(0),o[0],0,0,0), C0,0); \
    GAPB(o[1]=__builtin_amdgcn_mfma_f32_32x32x16_bf16(PAF(0),VFR(4),o[1],0,0,0), C0,4); \
    KRD(GL,0); GAPB(o[0]=__builtin_amdgcn_mfma_f32_32x32x16_bf16(PAF(1),VFR(1),o[0],0,0,0), C0,8); \
    KRD(GL,1); GAPB(o[1]=__builtin_amdgcn_mfma_f32_32x32x16_bf16(PAF(1),VFR(5),o[1],0,0,0), C0,12); \
    KRD(GL,2); GAPB(o[0]=__builtin_amdgcn_mfma_f32_32x32x16_bf16(PAF(2),VFR(2),o[0],0,0,0), C1,0); \
    KRD(GL,3); GAPB(o[1]=__builtin_amdgcn_mfma_f32_32x32x16_bf16(PAF(2),VFR(6),o[1],0,0,0), C1,4); \
    GAPB(o[0]=__builtin_amdgcn_mfma_f32_32x32x16_bf16(PAF(3),VFR(3),o[0],0,0,0), C1,8); \
    GAPB(o[1]=__builtin_amdgcn_mfma_f32_32x32x16_bf16(PAF(3),VFR(7),o[1],0,0,0), C1,12); \
    }while(0)
  int t=1;
  #undef CMASK
  #define CMASK(P0,P1,t) do{}while(0)
  for(;t+5<NT;t+=2){
    STEP(pB0,pB1,pA0,pA1,t,true,true,true);     WAIT_BAR(2); RESC(); ROT();
    STEP(pA0,pA1,pB0,pB1,t+1,true,true,true);   WAIT_BAR(2); RESC(); ROT();
  }
  #undef CMASK
  #define CMASK(P0,P1,t) do{int jb_=(t)-(NT-4); if(jb_>=0)cmask(P0,P1,jb_,qrel,hi);}while(0)
  #define ENDW(tt) do{ if((tt)+3<NT){WAIT_BAR(2);} else if((tt)+2<NT){WAIT_BAR(1);} else {WAIT_BAR(0);} }while(0)
  for(;t+1<NT;t+=2){
    STEP(pB0,pB1,pA0,pA1,t,(t+3<NT),(t+1<NT),(t+1<NT));       ENDW(t);   RESC(); ROT();
    STEP(pA0,pA1,pB0,pB1,t+1,(t+4<NT),(t+2<NT),(t+2<NT));     ENDW(t+1); RESC(); ROT();
  }
  STEP(pB0,pB1,pA0,pA1,NT-1,false,false,false); RESC();
  { float sacc=pB0[0]+pB0[1]; _Pragma("unroll") for(int r=2;r<16;++r)sacc+=pB0[r]; _Pragma("unroll") for(int r=0;r<16;++r)sacc+=pB1[r]; l_reg+=sacc;
    pw0=(u32x4){PKW(pB0,0),PKW(pB0,2),PKW(pB0,4),PKW(pB0,6)};pw1=(u32x4){PKW(pB0,8),PKW(pB0,10),PKW(pB0,12),PKW(pB0,14)};pw2=(u32x4){PKW(pB1,0),PKW(pB1,2),PKW(pB1,4),PKW(pB1,6)};pw3=(u32x4){PKW(pB1,8),PKW(pB1,10),PKW(pB1,12),PKW(pB1,14)};
    SBAR(); pv(o,vb0+sl_cur,PAF(0),PAF(1),PAF(2),PAF(3)); }
  #undef PKW
  #undef PAF
  #undef VFR
  #undef PIN
  #undef MX3
  #undef GAPA
  #undef GAPB
  #undef EX
  #undef VRD
  #undef KRD
  #undef STEP
  #undef ENDW
  {auto rr=__builtin_amdgcn_permlane32_swap(__float_as_uint(l_reg),__float_as_uint(l_reg),false,false);l_reg=__uint_as_float(rr[0])+__uint_as_float(rr[1]);}
  if(hi==0)wsf[32+r32]=l_reg;asm volatile("s_waitcnt lgkmcnt(0)":::"memory");
  float rli[16];
  #pragma unroll
  for(int r=0;r<16;++r)rli[r]=__builtin_amdgcn_rcpf(wsf[32+crow(r,hi)]);
  bf16*Ow=O+(rowbase+q0+wid*QBLK)*PO;
  { bf16*stg=(bf16*)(shm+LDS_OST)+wid*2048;
    #pragma unroll
    for(int r=0;r<16;++r){const int orow=crow(r,hi);
      #pragma unroll
      for(int d0=0;d0<2;++d0)stg[orow*64+d0*32+r32]=__float2bfloat16(o[d0][r]*rli[r]);}
    asm volatile("s_waitcnt lgkmcnt(0)":::"memory");
    #pragma unroll
    for(int i=0;i<4;++i){const int row=i*8+(lane>>3),ch=lane&7; const u32x4 v=*(const u32x4*)(stg+row*64+ch*8); ATTN_STORE16(Ow+(long)row*PO+ch*8,v);} }
  asm volatile("s_waitcnt lgkmcnt(0)\n\ts_barrier":::"memory");
  #undef DMA_K
  #undef DMA_V
  #undef CMASK
  #undef START
  #undef RESC
  #undef ROT
}
#undef SBAR
#undef WAIT_BAR
}
namespace cg = cooperative_groups;
#define LAS __attribute__((address_space(3)))
typedef unsigned short bf16;
typedef unsigned v4u __attribute__((ext_vector_type(4)));
typedef unsigned v2u __attribute__((ext_vector_type(2)));
typedef float f32x4 __attribute__((ext_vector_type(4)));
typedef float f32x2 __attribute__((ext_vector_type(2)));
typedef float f32x16 __attribute__((ext_vector_type(16)));
typedef short bf16x8 __attribute__((ext_vector_type(8)));

constexpr int NWAVES = 8;
constexpr int D = 1024, MP = 16384, MS = 256, M = MP + MS, FF = 2816, DIN = 2560;
constexpr float EPS = 1e-6f;
constexpr float C2 = 0.125f * 1.4426950408889634f;
constexpr size_t OFF_Y = 0, OFF_KP = 17039360, OFF_VP = 33816576, OFF_PP = 50593792, OFF_CP = 50655232, OFF_KS = 50663424, OFF_VS = 50925568, OFF_PS = 51187712, OFF_CS = 51249152, OUT_TOTAL = 51257344;
constexpr size_t MiB = 1u << 20;
constexpr size_t WS_ROPE = 1 * MiB, WS_POOLWT = 2 * MiB, WS_W = 4 * MiB, WL = 40 * MiB;
constexpr size_t W_GU1 = 0, W_D1 = 11 * MiB, W_IN = 16 * MiB + MiB / 2, W_OUT = 21 * MiB + MiB / 2, W_GU2 = 23 * MiB + MiB / 2, W_D2 = 34 * MiB + MiB / 2;
constexpr size_t WS_X = 84 * MiB, WS_H = 149 * MiB, WS_MIX = 182 * MiB, WS_ACT = 215 * MiB;
constexpr size_t WS_QB = 215 * MiB, WS_KB = 232 * MiB, WS_VB = 249 * MiB, WS_ZB = 266 * MiB;
constexpr size_t WS_OB = 305 * MiB, WS_OPART = 338 * MiB, WS_ML = 347 * MiB, WS_END = 352 * MiB;
static_assert(WS_ROPE == pg8::WOFF_ROPE && WS_QB == pg8::WOFF_QB && WS_KB == pg8::WOFF_KB && WS_VB == pg8::WOFF_VB && WS_ZB == pg8::WOFF_ZB && OFF_KP == pg8::OOFF_KP && OFF_VP == pg8::OOFF_VP && OFF_PP == pg8::OOFF_PP && OFF_KS == pg8::OOFF_KS && OFF_VS == pg8::OOFF_VS && OFF_PS == pg8::OOFF_PS, "offsets");
static_assert(WS_ACT + (size_t)M * FF * 2 <= WS_OB && WS_ZB + (size_t)M * 1024 * 2 <= WS_OB && WS_X + (size_t)M * D * 4 <= WS_H && WS_H + (size_t)M * D * 2 <= WS_MIX && WS_MIX + (size_t)M * D * 2 <= WS_ACT, "ws map");
static_assert(WS_OB + (size_t)M * 1024 * 2 <= WS_OPART && WS_OPART + (size_t)32 * 2 * 9 * 32 * 128 * 4 <= WS_ML && WS_ML + (size_t)32 * 2 * 9 * 32 * 2 * 4 <= WS_END, "ws map 2");
constexpr int LDS_BYTES = 147456;
constexpr size_t CTL_BYTES = 262144, CTL_CNT = 65536;
constexpr size_t WS_SLOTP = 350 * MiB, WS_SLOTS = 351 * MiB;

__device__ __forceinline__ unsigned pk2(float lo, float hi) { f32x2 v = {lo, hi}; typedef __bf16 b2 __attribute__((ext_vector_type(2))); b2 b = __builtin_convertvector(v, b2); return __builtin_bit_cast(unsigned, b); }
__device__ __forceinline__ float bf2f(unsigned short b) { return __builtin_bit_cast(float, (unsigned)b << 16); }
__device__ __forceinline__ bf16x8 pack8(f32x4 a, f32x4 b) { v4u w; w.x = pk2(a.x, a.y); w.y = pk2(a.z, a.w); w.z = pk2(b.x, b.y); w.w = pk2(b.z, b.w); return __builtin_bit_cast(bf16x8, w); }
__device__ __forceinline__ int crow(int r, int hi) { return (r & 3) + 8 * (r >> 2) + 4 * hi; }
__device__ __forceinline__ void xhalf_pair(float m, float& a, float& b) { a = m; b = m; asm volatile("s_nop 1\n\tv_permlane32_swap_b32 %0, %1\n\ts_nop 1" : "+v"(a), "+v"(b)); }
__device__ __forceinline__ float xhalf_max(float m) { float a, b; xhalf_pair(m, a, b); return fmaxf(a, b); }
__device__ __forceinline__ float xhalf_sum(float m) { float a, b; xhalf_pair(m, a, b); return a + b; }
template <int O> __device__ __forceinline__ float swz_xor(float v) { return __builtin_bit_cast(float, __builtin_amdgcn_ds_swizzle(__builtin_bit_cast(int, v), (O << 10) | 0x1f)); }
__device__ __forceinline__ float wave_sum(float v) {
    v += swz_xor<1>(v); v += swz_xor<2>(v); v += swz_xor<4>(v); v += swz_xor<8>(v); v += swz_xor<16>(v);
    return xhalf_sum(v);
}
#define LDS_WAIT() asm volatile("s_waitcnt lgkmcnt(0)" ::: "memory")

struct Params { const float* in[26]; float* out; unsigned char* ws; };
typedef const __attribute__((address_space(4))) unsigned char* karg_ptr;
__device__ __forceinline__ karg_ptr kargs() { karg_ptr k = (karg_ptr)__builtin_amdgcn_kernarg_segment_ptr(); asm volatile("" : "+s"(k)); return k; }
__device__ __forceinline__ const float* KIN(int i) { return *(const float* const __attribute__((address_space(4)))*)(kargs() + 8 * i); }
__device__ __forceinline__ float* KOUT() { return *(float* const __attribute__((address_space(4)))*)(kargs() + 8 * 26); }
__device__ __forceinline__ unsigned char* KWS() { return *(unsigned char* const __attribute__((address_space(4)))*)(kargs() + 8 * 27); }

template <int MODE> __device__ __forceinline__ int wmap(int nl, int row_off) {
    if (MODE == 0) return row_off + nl;
    if (MODE == 1) return (nl >> 7) * 256 + (nl & 127) + row_off;
    const int u = nl >> 8, lc = nl & 255, hc = lc >> 6, bjx = (lc >> 5) & 1, fqx = (lc >> 3) & 3, n = (lc >> 2) & 1, j = lc & 3;
    return u * 256 + 128 * bjx + 32 * hc + 16 * n + 4 * fqx + j;
}
template <int MODE> __device__ __forceinline__ void transpose_item(const float* W, int K, int N, bf16* WT, int row_off, LAS float* scr, int item, int lane) {
    const int nblk = N / 32, kb = item / nblk, nb = item % nblk, k0 = 64 * kb, n0 = 32 * nb;
#pragma unroll 8
    for (int i = 0; i < 32; ++i) { const int kk = 2 * i + (lane >> 5); scr[kk * 33 + (lane & 31)] = W[(size_t)(k0 + kk) * N + n0 + (lane & 31)]; }
    LDS_WAIT(); asm volatile("" ::: "memory");
    const int c = lane & 7;
#pragma unroll
    for (int j = 0; j < 4; ++j) { const int n = (lane >> 3) + 8 * j; const LAS float* s = scr + (8 * c) * 33 + n;
        v4u o; o.x = pk2(s[0 * 33], s[1 * 33]); o.y = pk2(s[2 * 33], s[3 * 33]); o.z = pk2(s[4 * 33], s[5 * 33]); o.w = pk2(s[6 * 33], s[7 * 33]);
        *(v4u*)(WT + (size_t)wmap<MODE>(n0 + n, row_off) * K + k0 + 8 * c) = o; }
    LDS_WAIT(); asm volatile("" ::: "memory");
}
__device__ __forceinline__ void prologue(LAS unsigned char* lds, int gw, int NGW, int wave, int lane) {
    LAS float* scr = (LAS float*)(lds + wave * 16384);
    constexpr int I_F = 16 * 88, I_IN = 16 * 80, I_OUT = 16 * 32, I_L = 6 * I_F + I_IN + I_OUT;
    for (int it = gw; it < 2 * I_L; it += NGW) {
        const int l = it / I_L; int r = it % I_L;
        unsigned char* wl = KWS() + WS_W + (size_t)l * WL;
        if (r < I_F) { transpose_item<1>(KIN(7) + (size_t)l * D * FF, D, FF, (bf16*)(wl + W_GU1), 0, scr, r, lane); continue; } r -= I_F;
        if (r < I_F) { transpose_item<1>(KIN(8) + (size_t)l * D * FF, D, FF, (bf16*)(wl + W_GU1), 128, scr, r, lane); continue; } r -= I_F;
        if (r < I_F) { transpose_item<0>(KIN(9) + (size_t)l * D * FF, FF, D, (bf16*)(wl + W_D1), 0, scr, r, lane); continue; } r -= I_F;
        if (r < I_IN) { transpose_item<2>(KIN(11) + (size_t)l * D * DIN, D, DIN, (bf16*)(wl + W_IN), 0, scr, r, lane); continue; } r -= I_IN;
        if (r < I_OUT) { transpose_item<0>(KIN(20) + (size_t)l * D * D, D, D, (bf16*)(wl + W_OUT), 0, scr, r, lane); continue; } r -= I_OUT;
        if (r < I_F) { transpose_item<1>(KIN(22) + (size_t)l * D * FF, D, FF, (bf16*)(wl + W_GU2), 0, scr, r, lane); continue; } r -= I_F;
        if (r < I_F) { transpose_item<1>(KIN(23) + (size_t)l * D * FF, D, FF, (bf16*)(wl + W_GU2), 128, scr, r, lane); continue; } r -= I_F;
        transpose_item<0>(KIN(24) + (size_t)l * D * FF, FF, D, (bf16*)(wl + W_D2), 0, scr, r, lane);
    }
    float* rope = (float*)(KWS() + WS_ROPE);
    for (int i = gw * 64 + lane; i < 2080 * 32; i += NGW * 64) {
        const int pr = i >> 5, d = i & 31; const int pos = pr < 2048 ? pr : 4096 + (pr - 2048);
        const float inv = exp2f(-(float)d * (13.287712379549449f / 32.0f));
        const float ang = (float)pos * inv;
        const double rev = (double)ang * 0.15915494309189535; const float fr = (float)(rev - __builtin_rint(rev));
        rope[pr * 64 + d] = __builtin_amdgcn_cosf(fr); rope[pr * 64 + 32 + d] = __builtin_amdgcn_sinf(fr);
    }
    bf16* pwt_ = (bf16*)(KWS() + WS_POOLWT);
    for (int i = gw * 64 + lane; i < 2 * 4 * 64 * 64; i += NGW * 64) {
        const int c = i & 63, e = (i >> 6) & 63, lg = i >> 12;
        pwt_[i] = (bf16)(pk2(KIN(17)[(size_t)lg * 4096 + c * 64 + e], 0.f) & 0xffffu);
    }
}
template <bool FINAL> __device__ __forceinline__ void norm_rows(const float* srcP, const float* srcS, const float* g, bf16* H, float* outf, int gw, int NGW, int lane) {
    const f32x4* g4 = (const f32x4*)g + lane;
    f32x4 gv[4];
#pragma unroll
    for (int j = 0; j < 4; ++j) gv[j] = g4[64 * j];
    for (int m = gw; m < M; m += NGW) {
        const float* xr = (m < MP) ? srcP + (size_t)m * D : srcS + (size_t)(m - MP) * D;
        const f32x4* x4 = (const f32x4*)xr + lane;
        f32x4 v[4]; float s = 0.f;
#pragma unroll
        for (int j = 0; j < 4; ++j) { v[j] = x4[64 * j]; s += (v[j].x * v[j].x + v[j].y * v[j].y) + (v[j].z * v[j].z + v[j].w * v[j].w); }
        const float rstd = 1.0f / sqrtf(wave_sum(s) * (1.0f / D) + EPS);
        if (FINAL) {
            f32x4* o4 = (f32x4*)(outf + (size_t)m * D) + lane;
#pragma unroll
            for (int j = 0; j < 4; ++j) o4[64 * j] = v[j] * rstd * gv[j];
        } else {
            v2u* o2 = (v2u*)(H + (size_t)m * D) + lane;
#pragma unroll
            for (int j = 0; j < 4; ++j) { const f32x4 y = v[j] * rstd * gv[j]; v2u w; w.x = pk2(y.x, y.y); w.y = pk2(y.z, y.w); o2[64 * j] = w; }
        }
    }
}
__device__ __forceinline__ f32x16 mfma32(bf16x8 a, bf16x8 b, f32x16 c) { return __builtin_amdgcn_mfma_f32_32x32x16_bf16(a, b, c, 0, 0, 0); }


template <bool BASE16, int K> __device__ __forceinline__ void skinny_part1(LAS unsigned char* lds, const bf16* A, const bf16* Bt, const void* base, bf16* out, float scale,
                                            unsigned* slots, unsigned* cnt8, int tile, int tid) {
    const int lane = tid & 63, r32 = lane & 31, hi = lane >> 5, wid = __builtin_amdgcn_readfirstlane(tid >> 6);
    LAS float* R = (LAS float*)lds;
    LAS float* PARK = (LAS float*)(lds + 131072);
    const int rt = tile >> 5, ct = tile & 31, kw = K >> 3, k0 = wid * kw;
    const int e = tid * 2, row = e >> 5, col = e & 31;
    const size_t o = (size_t)(rt * 32 + row) * 1024 + ct * 32 + col;
    f32x2 bv; if (BASE16) { const unsigned bw = *(const unsigned*)((const bf16*)base + o); bv.x = bf2f(bw & 0xffff); bv.y = bf2f(bw >> 16); } else bv = *(const f32x2*)((const float*)base + o);
    const bf16* ap = A + (size_t)(rt * 32 + r32) * K + wid * 16 + hi * 8; const bf16* bp = Bt + (size_t)(ct * 32 + r32) * K + wid * 16 + hi * 8; (void)k0;
    f32x16 acc;
#pragma unroll
    for (int r = 0; r < 16; ++r) acc[r] = 0.f;
    constexpr int NST = K / 128, UB = (NST % 11 == 0) ? 11 : 8;
#pragma unroll 1
    for (int s0 = 0; s0 < NST; s0 += UB) { bf16x8 av[UB], bw[UB];
#pragma unroll
        for (int j = 0; j < UB; ++j) { av[j] = *(const bf16x8*)(ap + (s0 + j) * 128); bw[j] = *(const bf16x8*)(bp + (s0 + j) * 128); }
#pragma unroll
        for (int j = 0; j < UB; ++j) acc = mfma32(av[j], bw[j], acc); }
    __syncthreads();
#pragma unroll
    for (int r = 0; r < 16; ++r) R[(wid * 32 + crow(r, hi)) * 32 + r32] = acc[r];
    __syncthreads();
    f32x2 s = {0.f, 0.f};
#pragma unroll
    for (int w = 0; w < 8; ++w) s += *(const LAS f32x2*)(R + (w * 32 + row) * 32 + col);
    const f32x2 v = bv + s * scale;
    float ss = v.x * v.x + v.y * v.y; ss += swz_xor<1>(ss); ss += swz_xor<2>(ss); ss += swz_xor<4>(ss); ss += swz_xor<8>(ss);
    if ((tid & 15) == 0) __hip_atomic_store(slots + (size_t)(rt * 32 + row) * 32 + ct, __builtin_bit_cast(unsigned, ss), __ATOMIC_RELAXED, __HIP_MEMORY_SCOPE_AGENT);
    *(LAS f32x2*)(PARK + tid * 2) = v;
    asm volatile("s_waitcnt vmcnt(0)" ::: "memory");
    __syncthreads();
    if (tid == 0) __hip_atomic_fetch_add(cnt8 + 64 * rt, 1u, __ATOMIC_RELAXED, __HIP_MEMORY_SCOPE_AGENT);
    if (out) *(unsigned*)(out + o) = pk2(v.x, v.y);
    __syncthreads();
}
__device__ __forceinline__ void skinny_part2(LAS unsigned char* lds, bf16* hb, float* yout, const float* gain, unsigned* slots, unsigned* cnt8, int tile, int tid) {
    LAS float* PARK = (LAS float*)(lds + 131072);
    const int rt = tile >> 5, ct = tile & 31, e = tid * 2, row = e >> 5, col = e & 31;
    const size_t o = (size_t)(rt * 32 + row) * 1024 + ct * 32 + col;
    if (tid == 0) {
        unsigned spins = 0;
        while (__hip_atomic_load(cnt8 + 64 * rt, __ATOMIC_RELAXED, __HIP_MEMORY_SCOPE_AGENT) < 32u) { __builtin_amdgcn_s_sleep(2); if (++spins > (1u << 22)) break; }
        __builtin_amdgcn_fence(__ATOMIC_ACQUIRE, "agent");
        asm volatile("s_waitcnt vmcnt(0)" ::: "memory");
    }
    __syncthreads();
    const unsigned* sl = slots + (size_t)(rt * 32 + row) * 32 + (tid & 15) * 2;
    float tot = __builtin_bit_cast(float, __hip_atomic_load(sl, __ATOMIC_RELAXED, __HIP_MEMORY_SCOPE_AGENT)) + __builtin_bit_cast(float, __hip_atomic_load(sl + 1, __ATOMIC_RELAXED, __HIP_MEMORY_SCOPE_AGENT));
    tot += swz_xor<1>(tot); tot += swz_xor<2>(tot); tot += swz_xor<4>(tot); tot += swz_xor<8>(tot);
    const float r = 1.0f / sqrtf(tot * (1.0f / 1024.0f) + EPS);
    const f32x2 v = *(const LAS f32x2*)(PARK + tid * 2);
    const f32x2 gv = *(const f32x2*)(gain + ct * 32 + col); const f32x2 y = v * r * gv;
    if (hb) *(unsigned*)(hb + o) = pk2(y.x, y.y); else *(f32x2*)(yout + o) = y;
    __syncthreads();
}

__device__ __forceinline__ void sample_piece(LAS unsigned char* lds, int pc, int l, const bf16* Qb, const float* cache_k, const float* cache_v, const float* knew, const float* vnew, float* OPART, float* MLP, int tid) {
    const int lane = tid & 63, r32 = lane & 31, hi = lane >> 5, wid = __builtin_amdgcn_readfirstlane(tid >> 6);
    const int b = pc >> 5, h = (pc >> 3) & 3, s = pc & 7;
    const bf16* qrow = Qb + (size_t)(MP + b * 32 + r32) * 512 + h * 128 + hi * 8;
    LAS float* ML = (LAS float*)lds;
    LAS float* FAC = (LAS float*)(lds + 4096);
    LAS float* OX = (LAS float*)(lds + 8192);
    const bool extra = (s == 7) && (wid == 7);
    const size_t off = ((size_t)((l * 8 + b) * 4096 + (s * 8 + wid) * 64)) * 512 + h * 128;
    const size_t offx = ((size_t)(l * 8 + b) * 32) * 512 + h * 128;
    const float* Kt = cache_k + off; const float* Vt = cache_v + off; const float* Kx = knew + offx; const float* Vx = vnew + offx;
    float mrow[2], lrow[2]; bf16x8 pw[2][6];
#pragma unroll
    for (int c = 0; c < 2; ++c) {
        bf16x8 qf[4];
#pragma unroll
        for (int d0 = 0; d0 < 4; ++d0) qf[d0] = *(const bf16x8*)(qrow + c * 64 + d0 * 16);
        f32x16 sc[3];
#pragma unroll
        for (int kvb = 0; kvb < 3; ++kvb) {
            if (kvb < 2 || extra) {
                f32x16 a;
#pragma unroll
                for (int r = 0; r < 16; ++r) a[r] = 0.f;
                const float* kp = (kvb < 2 ? Kt + (size_t)(kvb * 32 + r32) * 512 : Kx + (size_t)r32 * 512) + c * 64 + hi * 8;
#pragma unroll
                for (int d0 = 0; d0 < 4; ++d0) { const f32x4 x0 = *(const f32x4*)(kp + d0 * 16), x1 = *(const f32x4*)(kp + d0 * 16 + 4); a = mfma32(pack8(x0, x1), qf[d0], a); }
                sc[kvb] = a;
            } else {
#pragma unroll
                for (int r = 0; r < 16; ++r) sc[kvb][r] = -1e30f;
            }
        }
        float mx = -1e30f;
#pragma unroll
        for (int r = 0; r < 16; ++r) mx = fmaxf(mx, fmaxf(fmaxf(sc[0][r], sc[1][r]), sc[2][r]));
        mx = xhalf_max(mx);
        float sum = 0.f;
#pragma unroll
        for (int kvb = 0; kvb < 3; ++kvb)
#pragma unroll
            for (int r = 0; r < 16; ++r) { const float pv = __builtin_amdgcn_exp2f(sc[kvb][r] - mx); sc[kvb][r] = pv; sum += pv; }
        sum = xhalf_sum(sum);
        mrow[c] = mx; lrow[c] = sum;
#pragma unroll
        for (int kvb = 0; kvb < 3; ++kvb)
#pragma unroll
            for (int hf = 0; hf < 2; ++hf) { v4u w; w.x = pk2(sc[kvb][8 * hf + 0], sc[kvb][8 * hf + 1]); w.y = pk2(sc[kvb][8 * hf + 2], sc[kvb][8 * hf + 3]);
                w.z = pk2(sc[kvb][8 * hf + 4], sc[kvb][8 * hf + 5]); w.w = pk2(sc[kvb][8 * hf + 6], sc[kvb][8 * hf + 7]); pw[c][2 * kvb + hf] = __builtin_bit_cast(bf16x8, w); }
    }
    asm volatile("" ::: "memory");
    f32x16 o[2][4];
#pragma unroll
    for (int c = 0; c < 2; ++c)
#pragma unroll
        for (int eb = 0; eb < 4; ++eb)
#pragma unroll
            for (int r = 0; r < 16; ++r) o[c][eb][r] = 0.f;
#pragma unroll
    for (int ks = 0; ks < 6; ++ks) {
        if (ks < 4 || extra) {
#pragma unroll
            for (int eb = 0; eb < 4; ++eb) {
                const float* vp = (ks < 4 ? Vt + (size_t)(ks * 16 + 4 * hi) * 512 : Vx + (size_t)((ks - 4) * 16 + 4 * hi) * 512) + eb * 32 + r32;
                f32x4 x0, x1;
                x0.x = vp[0 * 512]; x0.y = vp[1 * 512]; x0.z = vp[2 * 512]; x0.w = vp[3 * 512];
                x1.x = vp[8 * 512]; x1.y = vp[9 * 512]; x1.z = vp[10 * 512]; x1.w = vp[11 * 512];
                const bf16x8 vf = pack8(x0, x1);
                o[0][eb] = mfma32(pw[0][ks], vf, o[0][eb]); o[1][eb] = mfma32(pw[1][ks], vf, o[1][eb]);
            }
        }
    }
    if (hi == 0) {
#pragma unroll
        for (int c = 0; c < 2; ++c) { ML[((wid * 2 + c) * 32 + r32) * 2 + 0] = mrow[c]; ML[((wid * 2 + c) * 32 + r32) * 2 + 1] = lrow[c]; }
    }
    __syncthreads();
    const int pidx = s;
    if (tid < 64) {
        const int c = tid >> 5, q = tid & 31; float mw[8], lw[8]; float Mx = -1e30f;
#pragma unroll
        for (int w = 0; w < 8; ++w) { mw[w] = ML[((w * 2 + c) * 32 + q) * 2 + 0]; lw[w] = ML[((w * 2 + c) * 32 + q) * 2 + 1]; Mx = fmaxf(Mx, mw[w]); }
        float L = 0.f;
#pragma unroll
        for (int w = 0; w < 8; ++w) { const float fz = __builtin_amdgcn_exp2f(mw[w] - Mx); FAC[(w * 2 + c) * 32 + q] = fz; L += lw[w] * fz; }
        float* mp = MLP + ((size_t)((((b * 4 + h) * 2 + c) * 9 + pidx) * 32 + q)) * 2; mp[0] = Mx; mp[1] = L;
    }
    __syncthreads();
#pragma unroll
    for (int c = 0; c < 2; ++c) {
#pragma unroll
        for (int eb = 0; eb < 4; ++eb)
#pragma unroll
            for (int r = 0; r < 16; ++r) { const int q = crow(r, hi); OX[(wid * 32 + q) * 128 + eb * 32 + r32] = o[c][eb][r] * FAC[(wid * 2 + c) * 32 + q]; }
        __syncthreads();
        { const int idx = tid * 8, q = idx >> 7, e = idx & 127; f32x4 s0 = {0.f, 0.f, 0.f, 0.f}, s1 = {0.f, 0.f, 0.f, 0.f};
#pragma unroll
          for (int w = 0; w < 8; ++w) { s0 += *(const LAS f32x4*)(OX + (w * 32 + q) * 128 + e); s1 += *(const LAS f32x4*)(OX + (w * 32 + q) * 128 + e + 4); }
          float* dst = OPART + ((size_t)((((b * 4 + h) * 2 + c) * 9 + pidx) * 32 + q)) * 128 + e; *(f32x4*)dst = s0; *(f32x4*)(dst + 4) = s1; }
        __syncthreads();
    }
}

template <int W> __device__ __forceinline__ void pool_d(const LAS float* U, LAS bf16* Dd, int ch, int tbeg, int t0, bool smp) {
    float s = 0.f;
#pragma unroll
    for (int i = 0; i < W; ++i) s += U[(15 + tbeg - i) * 256 + ch];
#pragma unroll 8
    for (int k = 0; k < 32; ++k) {
        const int tt = tbeg + k; const float cur = U[(15 + tt) * 256 + ch];
        if (k > 0) s += cur - U[(15 + tt - W) * 256 + ch];
        const int pos = smp ? 4096 + tt : t0 + tt; const int cnt = (pos + 1 < W) ? pos + 1 : W;
        const float d = s * __builtin_amdgcn_rcpf((float)cnt) - cur;
        Dd[tt * 264 + ch] = (bf16)(pk2(d, 0.f) & 0xffffu);
    }
}
__device__ __forceinline__ f32x4 bf4_to_f32(v2u w) { f32x4 v; v.x = bf2f(w.x & 0xffff); v.y = bf2f(w.x >> 16); v.z = bf2f(w.y & 0xffff); v.w = bf2f(w.y >> 16); return v; }
__device__ __forceinline__ void poolconv_tile(LAS unsigned char* lds, int tl, int l, const bf16* Zb, bf16* MIX, const float* state_pool, const float* state_conv, const bf16* pwt, const float* pool_scale,
                                              const float* conv_w, float* out_cp, float* out_cs, int tid) {
    const int lane = tid & 63, r32 = lane & 31, hi = lane >> 5, wid = __builtin_amdgcn_readfirstlane(tid >> 6);
    int b, t0, TT, rowbase; bool smp;
    if (tl < 256) { b = tl >> 5; t0 = (tl & 31) * 64; TT = 64; rowbase = b * 2048 + t0; smp = false; }
    else { b = tl - 256; t0 = 0; TT = 32; rowbase = MP + b * 32; smp = true; }
    LAS float* U = (LAS float*)lds;
    LAS bf16* Dd = (LAS bf16*)(lds + 81920);
    {
        f32x4 uv[10];
#pragma unroll
        for (int k = 0; k < 10; ++k) {
            const int idx = tid + 512 * k, i = idx >> 6, c4 = (idx & 63) * 4; f32x4 v = {0.f, 0.f, 0.f, 0.f};
            if (i < 15 + TT) {
                if (i < 15 && smp) v = *(const f32x4*)(state_pool + (size_t)((l * 8 + b) * 15 + i) * 256 + c4);
                else if (i >= 15 || t0 - 15 + i >= 0) v = bf4_to_f32(*(const v2u*)(Zb + (size_t)(rowbase + i - 15) * 1024 + c4));
            }
            uv[k] = v;
        }
#pragma unroll
        for (int k = 0; k < 10; ++k) { const int idx = tid + 512 * k, i = idx >> 6, c4 = (idx & 63) * 4; if (i < 15 + TT) *(LAS f32x4*)(U + i * 256 + c4) = uv[k]; }
    }
    __syncthreads();
    {
        const int ch = tid & 255, th = tid >> 8, gi = __builtin_amdgcn_readfirstlane(ch >> 6);
        if (th * 32 < TT) {
            if (gi == 0) pool_d<2>(U, Dd, ch, th * 32, t0, smp); else if (gi == 1) pool_d<4>(U, Dd, ch, th * 32, t0, smp);
            else if (gi == 2) pool_d<8>(U, Dd, ch, th * 32, t0, smp); else pool_d<16>(U, Dd, ch, th * 32, t0, smp);
        }
    }
    __syncthreads();
    {
        const int gi = wid >> 1, th = wid & 1;
        if (th * 32 < TT) {
            f32x16 acc0, acc1;
#pragma unroll
            for (int r = 0; r < 16; ++r) { acc0[r] = 0.f; acc1[r] = 0.f; }
#pragma unroll
            for (int ks = 0; ks < 4; ++ks) {
                const bf16x8 a = *(const LAS bf16x8*)(Dd + (th * 32 + r32) * 264 + gi * 64 + ks * 16 + hi * 8);
                const bf16x8 b0 = *(const bf16x8*)(pwt + (size_t)((l * 4 + gi) * 64 + r32) * 64 + ks * 16 + hi * 8);
                const bf16x8 b1 = *(const bf16x8*)(pwt + (size_t)((l * 4 + gi) * 64 + 32 + r32) * 64 + ks * 16 + hi * 8);
                acc0 = mfma32(a, b0, acc0); acc1 = mfma32(a, b1, acc1);
            }
            const float sc0 = pool_scale[l * 256 + gi * 64 + r32], sc1 = pool_scale[l * 256 + gi * 64 + 32 + r32];
#pragma unroll
            for (int r = 0; r < 16; ++r) { const int tok = th * 32 + crow(r, hi); bf16* mp = MIX + (size_t)(rowbase + tok) * 1024 + 512 + gi * 64 + r32;
                mp[0] = (bf16)(pk2(acc0[r] * sc0, 0.f) & 0xffffu); mp[32] = (bf16)(pk2(acc1[r] * sc1, 0.f) & 0xffffu); }
        }
    }
    if (wid * 8 < TT) {
        const int cq = lane, tc = wid * 8;
        v2u hraw[10], graw[10], braw[8]; f32x4 hst[2];
        hst[0] = (f32x4){0.f, 0.f, 0.f, 0.f}; hst[1] = hst[0];
#pragma unroll
        for (int i = 0; i < 10; ++i) {
            const int ts = tc - 2 + i; hraw[i] = (v2u){0u, 0u}; graw[i] = (v2u){0u, 0u};
            if (ts >= 0 || (!smp && t0 + ts >= 0)) { const bf16* zr = Zb + (size_t)(rowbase + ts) * 1024 + 4 * cq; hraw[i] = *(const v2u*)(zr + 256); graw[i] = *(const v2u*)(zr + 768); }
        }
#pragma unroll
        for (int i = 0; i < 8; ++i) braw[i] = *(const v2u*)(Zb + (size_t)(rowbase + tc + i) * 1024 + 512 + 4 * cq);
        if (smp && tc == 0) { hst[0] = *(const f32x4*)(state_conv + (size_t)((l * 8 + b) * 2 + 0) * 256 + 4 * cq); hst[1] = *(const f32x4*)(state_conv + (size_t)((l * 8 + b) * 2 + 1) * 256 + 4 * cq); }
        const f32x4 cw0 = *(const f32x4*)(conv_w + l * 768 + 4 * cq), cw1 = *(const f32x4*)(conv_w + l * 768 + 256 + 4 * cq), cw2 = *(const f32x4*)(conv_w + l * 768 + 512 + 4 * cq);
        f32x4 cm2 = bf4_to_f32(graw[0]) * bf4_to_f32(hraw[0]), cm1 = bf4_to_f32(graw[1]) * bf4_to_f32(hraw[1]);
        if (smp && tc == 0) { cm2 = hst[0]; cm1 = hst[1]; }
#pragma unroll
        for (int i = 0; i < 8; ++i) {
            const int tt = tc + i;
            const f32x4 cv = bf4_to_f32(graw[i + 2]) * bf4_to_f32(hraw[i + 2]);
            const f32x4 y = bf4_to_f32(braw[i]) * (cw0 * cm2 + cw1 * cm1 + cw2 * cv);
            v2u w; w.x = pk2(y.x, y.y); w.y = pk2(y.z, y.w);
            *(v2u*)(MIX + (size_t)(rowbase + tt) * 1024 + 768 + 4 * cq) = w;
            if (smp) { if (tt >= 30) *(f32x4*)(out_cs + (size_t)((l * 8 + b) * 2 + tt - 30) * 256 + 4 * cq) = cv; }
            else if (t0 + tt >= 2046) *(f32x4*)(out_cp + (size_t)((l * 8 + b) * 2 + t0 + tt - 2046) * 256 + 4 * cq) = cv;
            cm2 = cm1; cm1 = cv;
        }
    }
    __syncthreads();
}

__device__ __forceinline__ void combine_phase(int l, const bf16* Ob_, const float* OPART_, const float* MLP_, bf16* MIX_, int gw, int NGW, int lane) {
    const float lam_init = (l == 0) ? 0.2f : 0.35550934f;
    float lam;
    { const float a = KIN(12)[l * 64 + lane] * KIN(13)[l * 64 + lane], c = KIN(14)[l * 64 + lane] * KIN(15)[l * 64 + lane];
      lam = __expf(wave_sum(a)) - __expf(wave_sum(c)) + lam_init; }
    const float g0 = KIN(16)[l * 128 + 2 * lane], g1 = KIN(16)[l * 128 + 2 * lane + 1];
    for (int base = gw * 8; base < MP * 4; base += NGW * 8) {
        float a0[8], a1[8];
        {
            unsigned w1[8], w2[8];
#pragma unroll
            for (int j = 0; j < 8; ++j) { const int wt = base + j, row = wt >> 2, h = wt & 3;
                w1[j] = *(const unsigned*)(Ob_ + (size_t)row * 1024 + h * 128 + 2 * lane); w2[j] = *(const unsigned*)(Ob_ + (size_t)row * 1024 + 512 + h * 128 + 2 * lane); }
#pragma unroll
            for (int j = 0; j < 8; ++j) { a0[j] = bf2f(w1[j] & 0xffff) - lam * bf2f(w2[j] & 0xffff); a1[j] = bf2f(w1[j] >> 16) - lam * bf2f(w2[j] >> 16); }
        }
        float ss[8];
#pragma unroll
        for (int j = 0; j < 8; ++j) ss[j] = a0[j] * a0[j] + a1[j] * a1[j];
#pragma unroll
        for (int j = 0; j < 8; ++j) ss[j] += swz_xor<1>(ss[j]);
#pragma unroll
        for (int j = 0; j < 8; ++j) ss[j] += swz_xor<2>(ss[j]);
#pragma unroll
        for (int j = 0; j < 8; ++j) ss[j] += swz_xor<4>(ss[j]);
#pragma unroll
        for (int j = 0; j < 8; ++j) ss[j] += swz_xor<8>(ss[j]);
#pragma unroll
        for (int j = 0; j < 8; ++j) ss[j] += swz_xor<16>(ss[j]);
#pragma unroll
        for (int j = 0; j < 8; ++j) { const int wt = base + j, row = wt >> 2, h = wt & 3;
            const float tot = xhalf_sum(ss[j]);
            const float r = (1.0f / sqrtf(tot * (1.0f / 128.0f) + EPS)) * (1.0f - lam_init);
            *(unsigned*)(MIX_ + (size_t)row * 1024 + h * 128 + 2 * lane) = pk2(a0[j] * r * g0, a1[j] * r * g1); }
    }
    for (int wt = MP * 4 + gw; wt < M * 4; wt += NGW) {
        const int row = wt >> 2, h = wt & 3, rs = row - MP, b = rs >> 5, q = rs & 31; float oc[2][2];
#pragma unroll
        for (int c = 0; c < 2; ++c) {
            const size_t pb = (size_t)(((b * 4 + h) * 2 + c) * 9);
            float mw[8], lw[8]; f32x2 ov[8]; float Mx = -1e30f;
#pragma unroll
            for (int pi = 0; pi < 8; ++pi) { const f32x2 ml = *(const f32x2*)(MLP_ + ((pb + pi) * 32 + q) * 2); mw[pi] = ml.x; lw[pi] = ml.y; ov[pi] = *(const f32x2*)(OPART_ + ((pb + pi) * 32 + q) * 128 + 2 * lane); }
#pragma unroll
            for (int pi = 0; pi < 8; ++pi) Mx = fmaxf(Mx, mw[pi]);
            float L = 0.f, s0 = 0.f, s1 = 0.f;
#pragma unroll
            for (int pi = 0; pi < 8; ++pi) { const float fz = __builtin_amdgcn_exp2f(mw[pi] - Mx); L += lw[pi] * fz; s0 += ov[pi].x * fz; s1 += ov[pi].y * fz; }
            const float il = 1.0f / L; oc[c][0] = s0 * il; oc[c][1] = s1 * il;
        }
        const float a0 = oc[0][0] - lam * oc[1][0], a1 = oc[0][1] - lam * oc[1][1];
        const float tot = wave_sum(a0 * a0 + a1 * a1);
        const float r = (1.0f / sqrtf(tot * (1.0f / 128.0f) + EPS)) * (1.0f - lam_init);
        *(unsigned*)(MIX_ + (size_t)row * 1024 + h * 128 + 2 * lane) = pk2(a0 * r * g0, a1 * r * g1);
    }
}

#ifndef PROBE_SLOW_ATTN
#define PROBE_SLOW_ATTN 0
#endif
#if PROBE_SLOW_ATTN
__device__ __forceinline__ void slow_attn_phase(int l, const bf16* Qb_, float* outp, const float* cache_k, const float* cache_v, bf16* MIX_, int gw, int NGW, int lane) {
    const float lam_init = (l == 0) ? 0.2f : 0.35550934f;
    float lam;
    { const float a = KIN(12)[l * 64 + lane] * KIN(13)[l * 64 + lane], c = KIN(14)[l * 64 + lane] * KIN(15)[l * 64 + lane];
      lam = __expf(wave_sum(a)) - __expf(wave_sum(c)) + lam_init; }
    const float g0 = KIN(16)[l * 128 + 2 * lane], g1 = KIN(16)[l * 128 + 2 * lane + 1];
    for (int wt = gw; wt < M * 4; wt += NGW) {
        const int row = wt >> 2, h = wt & 3;
        const float *K0, *V0, *K1, *V1; int n0, n1;
        if (row < MP) { const int b = row >> 11, t = row & 2047; K0 = outp + OFF_KP + ((size_t)l * MP + (size_t)b * 2048) * 512 + h * 128; V0 = outp + OFF_VP + ((size_t)l * MP + (size_t)b * 2048) * 512 + h * 128; n0 = ((t >> 6) + 1) * 64; K1 = K0; V1 = V0; n1 = 0; }
        else { const int rs = row - MP, b = rs >> 5; K0 = cache_k + ((size_t)(l * 8 + b) * 4096) * 512 + h * 128; V0 = cache_v + ((size_t)(l * 8 + b) * 4096) * 512 + h * 128; n0 = 4096;
               K1 = outp + OFF_KS + ((size_t)(l * 8 + b) * 32) * 512 + h * 128; V1 = outp + OFF_VS + ((size_t)(l * 8 + b) * 32) * 512 + h * 128; n1 = 32; }
        float oc[2][2];
#pragma unroll 1
        for (int c = 0; c < 2; ++c) {
            float q[64];
#pragma unroll
            for (int d = 0; d < 64; ++d) q[d] = bf2f(Qb_[(size_t)row * 512 + h * 128 + c * 64 + d]);
            float mx = -1e30f;
            for (int seg = 0; seg < 2; ++seg) { const float* Kp = seg ? K1 : K0; const int n = seg ? n1 : n0;
                for (int j0 = 0; j0 < n; j0 += 64) { const int j = j0 + lane; float s = -1e30f;
                    if (j < n) { const float* kr = Kp + (size_t)j * 512 + c * 64; s = 0.f;
#pragma unroll
                        for (int d = 0; d < 64; ++d) s += q[d] * kr[d]; }
                    mx = fmaxf(mx, s); } }
            mx = fmaxf(mx, swz_xor<1>(mx)); mx = fmaxf(mx, swz_xor<2>(mx)); mx = fmaxf(mx, swz_xor<4>(mx)); mx = fmaxf(mx, swz_xor<8>(mx)); mx = fmaxf(mx, swz_xor<16>(mx)); mx = xhalf_max(mx);
            float L = 0.f, o0 = 0.f, o1 = 0.f;
            for (int seg = 0; seg < 2; ++seg) { const float* Kp = seg ? K1 : K0; const float* Vp = seg ? V1 : V0; const int n = seg ? n1 : n0;
                for (int j0 = 0; j0 < n; j0 += 64) { const int j = j0 + lane; float pj = 0.f;
                    if (j < n) { const float* kr = Kp + (size_t)j * 512 + c * 64; float s = 0.f;
#pragma unroll
                        for (int d = 0; d < 64; ++d) s += q[d] * kr[d];
                        pj = __builtin_amdgcn_exp2f(s - mx); }
                    L += pj;
                    const int nn = (n - j0 < 64) ? n - j0 : 64;
                    for (int jj = 0; jj < nn; ++jj) { const float pb = __builtin_bit_cast(float, __builtin_amdgcn_readlane(__builtin_bit_cast(int, pj), jj));
                        const f32x2 vv = *(const f32x2*)(Vp + (size_t)(j0 + jj) * 512 + 2 * lane); o0 += pb * vv.x; o1 += pb * vv.y; } } }
            L = wave_sum(L);
            oc[c][0] = o0 / L; oc[c][1] = o1 / L;
        }
        const float a0 = oc[0][0] - lam * oc[1][0], a1 = oc[0][1] - lam * oc[1][1];
        const float ss = wave_sum(a0 * a0 + a1 * a1);
        const float r = (1.0f / sqrtf(ss * (1.0f / 128.0f) + EPS)) * (1.0f - lam_init);
        *(unsigned*)(MIX_ + (size_t)row * 1024 + h * 128 + 2 * lane) = pk2(a0 * r * g0, a1 * r * g1);
    }
}
#endif

#ifndef PROBE_SLOW_PC
#define PROBE_SLOW_PC 0
#endif
#if PROBE_SLOW_PC
__device__ __forceinline__ float zval(const bf16* Zb_, const float* st, int l, int b, bool smp, int rowbase, int t, int col, int hist) {
    if (t >= 0) return bf2f(Zb_[(size_t)(rowbase + t) * 1024 + col]);
    if (!smp) return 0.f;
    return st[(size_t)((l * 8 + b) * hist + (hist + t)) * 256 + (col & 255)];
}
__device__ __forceinline__ void slow_pc_phase(int l, const bf16* Zb_, bf16* MIX_, int gw, int NGW, int lane) {
    const float* sp = KIN(4); const float* scv = KIN(5); const float* pw = KIN(17); const float* psc = KIN(18); const float* cw = KIN(19);
    for (int wt = gw; wt < M * 4; wt += NGW) {
        const int row = wt >> 2, g = wt & 3; const bool smp = row >= MP;
        int b, t, rowbase; if (smp) { const int rs = row - MP; b = rs >> 5; t = rs & 31; rowbase = MP + b * 32; } else { b = row >> 11; t = row & 2047; rowbase = b * 2048; }
        const int w = 2 << g, ch = g * 64 + lane;
        float s = 0.f;
        for (int i = 0; i < w; ++i) { const int tt = t - i; s += zval(Zb_, sp, l, b, smp, rowbase, tt, ch, 15); }
        const int pos = smp ? 4096 + t : t; const int cnt = (pos + 1 < w) ? pos + 1 : w;
        const float d = s / (float)cnt - zval(Zb_, sp, l, b, smp, rowbase, t, ch, 15);
        float mine = 0.f;
        for (int e = 0; e < 64; ++e) { const float v = wave_sum(d * pw[(size_t)((l * 4 + g) * 64 + lane) * 64 + e]); if (e == lane) mine = v; }
        MIX_[(size_t)row * 1024 + 512 + ch] = (bf16)(pk2(mine * psc[l * 256 + ch], 0.f) & 0xffffu);
        float cvv[3];
#pragma unroll
        for (int k = 0; k < 3; ++k) { const int tt = t - 2 + k;
            if (tt >= 0) cvv[k] = bf2f(Zb_[(size_t)(rowbase + tt) * 1024 + 768 + ch]) * bf2f(Zb_[(size_t)(rowbase + tt) * 1024 + 256 + ch]);
            else cvv[k] = smp ? scv[(size_t)((l * 8 + b) * 2 + (2 + tt)) * 256 + ch] : 0.f; }
        const float bgv = bf2f(Zb_[(size_t)row * 1024 + 512 + ch]);
        const float y = bgv * (cw[l * 768 + ch] * cvv[0] + cw[l * 768 + 256 + ch] * cvv[1] + cw[l * 768 + 512 + ch] * cvv[2]);
        MIX_[(size_t)row * 1024 + 768 + ch] = (bf16)(pk2(y, 0.f) & 0xffffu);
    }
}
#endif

#define XB_TMO      128
#define XB_XCNT(j)  (256  + 64 * (j))
#define XB_XSUB(j)  (1280 + 64 * (j))
#define XB_XGEN(j)  (2304 + 64 * (j))
#define XB_TOP      3328
#define XB_TOPGEN   3392
#define XCD_BAR_WORDS 3456
#define XB_SPIN_CAP (1u << 18)
__device__ __forceinline__ unsigned xb_ld(unsigned* p)              { return __hip_atomic_load(p, __ATOMIC_RELAXED, __HIP_MEMORY_SCOPE_AGENT); }
__device__ __forceinline__ unsigned xb_add(unsigned* p, unsigned v) { return __hip_atomic_fetch_add(p, v, __ATOMIC_RELAXED, __HIP_MEMORY_SCOPE_AGENT); }
__device__ __forceinline__ unsigned xb_xcc_id() { return (unsigned)__builtin_amdgcn_s_getreg((3 << 11) | 20) & 0xFu; }
#define XB_SPIN(cond, bar) do { unsigned _sp = 0; while (cond) { __builtin_amdgcn_s_sleep(1); \
    if ((++_sp & 255u) == 0u) { if (xb_ld(&(bar)[XB_TMO])) break; if (_sp > XB_SPIN_CAP) { atomicAdd(&(bar)[XB_TMO], 1u); break; } } } } while (0)
__device__ __forceinline__ void xcd_barrier_complete(unsigned* bar, unsigned x, unsigned& nloc, unsigned& nx) {
    const unsigned G = gridDim.x * gridDim.y * gridDim.z;
    unsigned sum, cnt, mine, sp = 0u;
    for (;;) {
        sum = 0u; cnt = 0u; mine = 0u;
#pragma unroll
        for (unsigned j = 0; j < 16; ++j) { const unsigned c = xb_ld(&bar[XB_XCNT(j)]); sum += c; cnt += (c > 0u) ? 1u : 0u; mine = (j == x) ? c : mine; }
        if (sum == G) break;
        __builtin_amdgcn_s_sleep(1);
        if ((++sp & 255u) == 0u) { if (xb_ld(&bar[XB_TMO])) break; if (sp > XB_SPIN_CAP) { atomicAdd(&bar[XB_TMO], 1u); break; } }
    }
    nloc = mine > 0u ? mine : 1u; nx = cnt > 0u ? cnt : 1u;
}
__device__ __forceinline__ void xcd_barrier(unsigned* bar, unsigned x, volatile LAS unsigned* st) {
    asm volatile("s_waitcnt vmcnt(0)" ::: "memory");
    __syncthreads();
    if (threadIdx.x == 0) {
        __builtin_amdgcn_s_waitcnt(0);
        unsigned nloc = st[0], nx = st[1];
        if (nloc == 0u) { xcd_barrier_complete(bar, x, nloc, nx); st[0] = nloc; st[1] = nx; }
        const unsigned old = xb_add(&bar[XB_XSUB(x)], 1u);
        const unsigned gen = old / nloc;
        if (old + 1u == (gen + 1u) * nloc) {
            __builtin_amdgcn_fence(__ATOMIC_RELEASE, "agent");
            asm volatile("s_waitcnt vmcnt(0)" ::: "memory");
            const unsigned og = xb_add(&bar[XB_TOP], 1u);
            const unsigned tg = og / nx;
            if (og + 1u == (tg + 1u) * nx) xb_add(&bar[XB_TOPGEN], 1u);
            else XB_SPIN(xb_ld(&bar[XB_TOPGEN]) == tg, bar);
            __builtin_amdgcn_fence(__ATOMIC_ACQUIRE, "agent");
            xb_add(&bar[XB_XGEN(x)], 1u);
            asm volatile("s_waitcnt vmcnt(0)" ::: "memory");
        } else {
            XB_SPIN(xb_ld(&bar[XB_XGEN(x)]) == gen, bar);
            __builtin_amdgcn_fence(__ATOMIC_ACQUIRE, "agent");
            asm volatile("s_waitcnt vmcnt(0)" ::: "memory");
        }
    }
    __syncthreads();
}
#define CG_SYNC() do { asm volatile("s_waitcnt vmcnt(0) lgkmcnt(0)" ::: "memory"); grid.sync(); asm volatile("" ::: "memory"); } while (0)
#define GRID_SYNC() xcd_barrier((unsigned*)KWS() + 4096, xcc, (volatile LAS unsigned*)(lds + LDS_BYTES - 64))
__global__ void __launch_bounds__(NWAVES * 64, 2) mega_fwd(Params p) {
    extern __shared__ __attribute__((aligned(16))) unsigned char lds_raw[];
    LAS unsigned char* lds = (LAS unsigned char*)lds_raw;
    cg::grid_group grid = cg::this_grid();
    const int tid = threadIdx.x, lane = tid & 63, wave = __builtin_amdgcn_readfirstlane(tid >> 6);
    const int G = gridDim.x; const int bx = blockIdx.x; const int vcu0 = (G % 8 == 0) ? (bx % 8) * (G / 8) + bx / 8 : bx;
    const int NGW = G * NWAVES;
#define X ((bf16*)(ws + WS_X))
#define H ((bf16*)(ws + WS_H))
#define MIX ((bf16*)(ws + WS_MIX))
#define ACT ((bf16*)(ws + WS_ACT))
#define Qb ((bf16*)(ws + WS_QB))
#define Kb ((bf16*)(ws + WS_KB))
#define Vb ((bf16*)(ws + WS_VB))
#define Zb ((bf16*)(ws + WS_ZB))
#define Ob ((bf16*)(ws + WS_OB))
#define OPART ((float*)(ws + WS_OPART))
#define MLP ((float*)(ws + WS_ML))
#define pwt ((const bf16*)(ws + WS_POOLWT))
    if (tid < 16) ((LAS unsigned*)(lds + LDS_BYTES - 64))[tid] = 0u;
    const unsigned xcc = xb_xcc_id();
    if (tid == 0) (void)xb_add((unsigned*)KWS() + 4096 + XB_XCNT(xcc), 1u);
    __syncthreads();
    { const int gw = vcu0 * NWAVES + wave; prologue(lds, gw, NGW, wave, lane);
      norm_rows<false>(KIN(0), KIN(1), KIN(6), (bf16*)(KWS() + WS_H), nullptr, gw, NGW, lane); }
    CG_SYNC();
#define FRESH_IDS() int tid = threadIdx.x; asm volatile("" : "+v"(tid)); const int lane = tid & 63, wave = __builtin_amdgcn_readfirstlane(tid >> 6); int vcu = vcu0; asm volatile("" : "+s"(vcu)); const int gw = vcu * NWAVES + wave; (void)lane; (void)gw; (void)wave
#define CNT(nid, idx) ((unsigned*)(ws + CTL_CNT) + (size_t)((nid) * 80 + (idx)) * 64)
#pragma unroll 1
    for (int step = 0; step < 4; ++step) {
        const int l = step >> 1, f = step & 1;
        const bool first = (step == 0);
        { FRESH_IDS(); unsigned char* const ws = KWS(); unsigned char* const wl = ws + WS_W + (size_t)l * WL;
          pg8::Gemm g{H, (const bf16*)(wl + (f ? W_GU2 : W_GU1)), M, 2 * FF, D}; pg8::StaticOrder S; S.init(M, 2 * FF, G, bx);
          pg8::EpiSwiGLU E{ACT, FF};
          pg8::gemm_phase<pg8::EpiSwiGLU, pg8::StaticOrder, true, true>(lds, g, S, E); }
        GRID_SYNC();
        { FRESH_IDS(); unsigned char* const ws = KWS(); unsigned char* const wl = ws + WS_W + (size_t)l * WL;
          const bool last = (step == 3);
          const float* const gn = last ? KIN(25) : (f ? KIN(6) + (l + 1) * D : KIN(10) + l * D);
          const int nid = step * 2;
          float* const yo = KOUT() + OFF_Y;
          pg8::Gemm g{ACT, (const bf16*)(wl + (f ? W_D2 : W_D1)), MP, D, FF}; pg8::StaticOrder S; S.init(MP, D, G, bx);
          if (first) skinny_part1<false, FF>(lds, ACT + (size_t)MP * FF, (const bf16*)(wl + W_D1), KIN(1), X + (size_t)MP * D, 0.5f, (unsigned*)(ws + WS_SLOTS), CNT(nid, 64), vcu, tid);
          else skinny_part1<true, FF>(lds, ACT + (size_t)MP * FF, (const bf16*)(wl + (f ? W_D2 : W_D1)), X + (size_t)MP * D, last ? nullptr : X + (size_t)MP * D, 0.5f, (unsigned*)(ws + WS_SLOTS), CNT(nid, 64), vcu, tid);
          { pg8::Unit u0; const int pm0 = S.next(0, u0) ? u0.pm : 0;
            if (first) { pg8::EpiResidNorm<false> E{KIN(0), X, 0.5f, H, yo, gn, (unsigned*)(ws + WS_SLOTP), CNT(nid, pm0)};
                         pg8::gemm_phase<pg8::EpiResidNorm<false>, pg8::StaticOrder, false, true>(lds, g, S, E); }
            else { pg8::EpiResidNorm<true> E{X, last ? nullptr : X, 0.5f, last ? nullptr : H, yo, gn, (unsigned*)(ws + WS_SLOTP), CNT(nid, pm0)};
                   pg8::gemm_phase<pg8::EpiResidNorm<true>, pg8::StaticOrder, false, true>(lds, g, S, E); } }
          skinny_part2(lds, last ? nullptr : H + (size_t)MP * D, yo + (size_t)MP * D, gn, (unsigned*)(ws + WS_SLOTS), CNT(nid, 64), vcu, tid); }
        if (step == 3) break;
        GRID_SYNC();
        if (f == 0) {
            { FRESH_IDS(); unsigned char* const ws = KWS(); unsigned char* const wl = ws + WS_W + (size_t)l * WL;
              pg8::Gemm g{H, (const bf16*)(wl + W_IN), M, DIN, D}; pg8::StaticOrder S; S.init(M, DIN, G, bx);
              pg8::EpiWin E{ws, KOUT(), l, C2};
              pg8::gemm_phase<pg8::EpiWin, pg8::StaticOrder, true, true>(lds, g, S, E); }
            GRID_SYNC();
#pragma unroll 1
            for (int slot = 0; slot < 2; ++slot) {
              if (((slot ^ vcu0) & 1) == 0) {
                FRESH_IDS(); unsigned char* const ws = KWS();
                for (int i = 0; i < 4; ++i) {
                  const int L = i * G + vcu; if (L >= 1024) break;
                  const int bh = (L & 255) >> 1, sI = L & 1, ii = L >> 8;
                  const int qb = sI == 0 ? (ii == 0 ? 7 : ii == 1 ? 0 : ii == 2 ? 4 : 3) : (ii == 0 ? 6 : ii == 1 ? 1 : ii == 2 ? 5 : 2);
                  const int b = bh >> 4, vh = bh & 15, hh = vh >> 2, c = (vh >> 1) & 1, hf = vh & 1;
                  attn_body::attn_unit<8>(b, qb, (const attn_body::bf16*)(Qb + (hh * 2 + c) * 64), (const attn_body::bf16*)(Kb + (hh * 2 + c) * 64), (const attn_body::bf16*)(Vb + hh * 128 + hf * 64),
                                          (attn_body::bf16*)(Ob + c * 512 + hh * 128 + hf * 64), (char*)lds_raw);
                }
              } else {
                FRESH_IDS(); unsigned char* const ws = KWS(); float* const outp = KOUT();
                for (int pc = vcu; pc < 256; pc += G)
                  sample_piece(lds, pc, l, Qb, KIN(2), KIN(3), outp + OFF_KS, outp + OFF_VS, OPART, MLP, tid);
              }
              __syncthreads();
            }
            { FRESH_IDS(); unsigned char* const ws = KWS(); float* const outp = KOUT();
              for (int tl = vcu; tl < 264; tl += G)
                poolconv_tile(lds, tl, l, Zb, MIX, KIN(4), KIN(5), pwt, KIN(18), KIN(19), outp + OFF_CP, outp + OFF_CS, tid); }
            GRID_SYNC();
            { FRESH_IDS(); unsigned char* const ws = KWS();
              combine_phase(l, Ob, OPART, MLP, MIX, gw, NGW, lane); }
            GRID_SYNC();
            { FRESH_IDS(); unsigned char* const ws = KWS(); unsigned char* const wl = ws + WS_W + (size_t)l * WL;
              const float* const gn = KIN(21) + l * D; const int nid = step * 2 + 1;
              pg8::Gemm g{MIX, (const bf16*)(wl + W_OUT), MP, D, D}; pg8::StaticOrder S; S.init(MP, D, G, bx);
              skinny_part1<true, D>(lds, MIX + (size_t)MP * D, (const bf16*)(wl + W_OUT), X + (size_t)MP * D, X + (size_t)MP * D, 1.0f, (unsigned*)(ws + WS_SLOTS), CNT(nid, 64), vcu, tid);
              { pg8::Unit u0; const int pm0 = S.next(0, u0) ? u0.pm : 0;
                pg8::EpiResidNorm<true> E{X, X, 1.0f, H, nullptr, gn, (unsigned*)(ws + WS_SLOTP), CNT(nid, pm0)};
                pg8::gemm_phase<pg8::EpiResidNorm<true>, pg8::StaticOrder, false, true>(lds, g, S, E); }
              skinny_part2(lds, H + (size_t)MP * D, nullptr, gn, (unsigned*)(ws + WS_SLOTS), CNT(nid, 64), vcu, tid); }
            GRID_SYNC();
        }
    }
}

extern "C" void kernel_launch(void* const* d_in, const int* in_sizes, int n_in, void* d_out, int out_size, void* d_ws, size_t ws_size, hipStream_t stream) {
    static int grid = 0;
    if (grid == 0) {
        if (n_in != 26 || (size_t)out_size != OUT_TOTAL || ws_size < WS_END) { fprintf(stderr, "kernel_launch: unexpected problem shape: n_in %d out %d ws %zu\n", n_in, out_size, ws_size); grid = -1; return; }
        int dev = 0, cus = 0, per_cu = 0;
        if (hipGetDevice(&dev) != hipSuccess || hipDeviceGetAttribute(&cus, hipDeviceAttributeMultiprocessorCount, dev) != hipSuccess) { grid = -1; return; }
        if (hipFuncSetAttribute((const void*)mega_fwd, hipFuncAttributeMaxDynamicSharedMemorySize, LDS_BYTES) != hipSuccess) { fprintf(stderr, "kernel_launch: hipFuncSetAttribute failed\n"); grid = -1; return; }
        if (hipOccupancyMaxActiveBlocksPerMultiprocessor(&per_cu, (const void*)mega_fwd, NWAVES * 64, LDS_BYTES) != hipSuccess || per_cu < 1) { fprintf(stderr, "kernel_launch: occupancy query says %d\n", per_cu); per_cu = 1; }
        (void)hipGetLastError();
        grid = cus * per_cu;
    }
    if (grid < 0) return;
    if (hipMemsetAsync(d_ws, 0, CTL_BYTES, stream) != hipSuccess) { fprintf(stderr, "kernel_launch: memset failed\n"); return; }
    Params p{};
    for (int i = 0; i < 26; ++i) p.in[i] = (const float*)d_in[i];
    p.out = (float*)d_out; p.ws = (unsigned char*)d_ws;
    void* args[] = {&p};
    const hipError_t e = hipLaunchCooperativeKernel((const void*)mega_fwd, dim3(grid), dim3(NWAVES * 64), args, LDS_BYTES, stream);
    if (e != hipSuccess) fprintf(stderr, "kernel_launch: cooperative launch failed: %s (grid %d)\n", hipGetErrorString(e), grid);
}
```

```cpp
#include <hip/hip_runtime.h>
#include <hip/hip_cooperative_groups.h>
#include <cstdio>
#include <cstdint>
namespace pg8 {
#define PG8_LAS __attribute__((address_space(3)))
typedef unsigned short bf16_t;
typedef short bf16x8 __attribute__((ext_vector_type(8)));
typedef float f32x4 __attribute__((ext_vector_type(4)));
typedef unsigned u32x4 __attribute__((ext_vector_type(4)));
constexpr int BM = 256, BK = 64, HALF = 128, HTB = HALF * BK * 2  , STAGE_BYTES = 8 * HTB, NXCD = 8, WGM = 8;

__host__ __device__ __forceinline__ int lds_byte(int r, int c) { const int st = (r >> 4) * 2 + (c >> 5), rr = r & 15, cc = c & 31, ob = rr * 64 + cc * 2; return st * 1024 + (ob ^ (((ob >> 9) & 1) << 5)); }
__host__ __device__ __forceinline__ void stage_rc(int b, int& R, int& C) { const int st = b / 1024, sb = b % 1024, swz = sb ^ (((sb >> 9) & 1) << 5); R = (st >> 1) * 16 + swz / 64; C = (st & 1) * 32 + (swz % 64) / 2; }
__host__ __device__ __forceinline__ int perm32(int rho) { const int n = rho >> 4, i = rho & 15; return 8 * (i >> 2) + 4 * n + (i & 3); }

struct Unit { int pm, pn; };
struct Gemm { const bf16_t* A; const bf16_t* Bt; int M, N, K; };

struct StaticOrder {
    int nM, nN, nwg, G, c;
    __host__ __device__ __forceinline__ void init(int M, int N, int G_, int c_) { nM = M / BM; nN = N / BM; nwg = nM * nN; G = G_; c = c_; }
    __host__ __device__ __forceinline__ bool next(int i, Unit& u) const {
        const long L = (long)i * G + c; if (L >= nwg) return false;
        int wgid = (int)L; { const int q = nwg / NXCD, r = nwg % NXCD, xcd = wgid % NXCD, off = wgid / NXCD; wgid = (xcd < r ? xcd * (q + 1) : r * (q + 1) + (xcd - r) * q) + off; }
        const int nig = WGM * nN, gid = wgid / nig, fm = gid * WGM, gsz = (nM - fm) < WGM ? (nM - fm) : WGM;
        u.pm = fm + ((wgid % nig) % gsz); u.pn = (wgid % nig) / gsz; return true;
    }
    __device__ __forceinline__ void a_ready(const Unit&) const {}
    __device__ __forceinline__ void done(const Unit&) const {}
};

__device__ __forceinline__ unsigned cvt_pk_bf16(float lo, float hi) { unsigned r; asm volatile("v_cvt_pk_bf16_f32 %0, %1, %2" : "=v"(r) : "v"(lo), "v"(hi)); return r; }
typedef float f32x2 __attribute__((ext_vector_type(2)));
typedef unsigned u32x2 __attribute__((ext_vector_type(2)));
constexpr size_t WOFF_ROPE = (size_t)1 << 20, WOFF_QB = (size_t)215 << 20, WOFF_KB = (size_t)232 << 20, WOFF_VB = (size_t)249 << 20, WOFF_ZB = (size_t)266 << 20;
constexpr size_t OOFF_KP = 17039360, OOFF_VP = 33816576, OOFF_PP = 50593792, OOFF_KS = 50663424, OOFF_VS = 50925568, OOFF_PS = 51187712;
__device__ __forceinline__ float silu_mul(float g, float u) { const float e = __builtin_amdgcn_exp2f(-1.4426950408889634f * g); return g * u * __builtin_amdgcn_rcpf(1.0f + e); }
struct EpiSwiGLU {
    static constexpr bool PERM = true, AFTER_DRAIN = false;
    bf16_t* O; int ldc;
    __device__ __forceinline__ void operator()(const f32x4 (&acc)[2][2][4][2], const Unit& u, int wr, int wc, int fr, int fq) const {
        const int row0 = u.pm * BM + wr * 64 + fr; const int col0 = u.pn * 128 + wc * 32 + 8 * fq;
#pragma unroll
        for (int ai = 0; ai < 2; ++ai)
#pragma unroll
            for (int m = 0; m < 4; ++m) {
                bf16_t* p = O + (size_t)(row0 + ai * HALF + m * 16) * ldc + col0;
                const f32x4 g0 = acc[ai][0][m][0], g1 = acc[ai][0][m][1], u0 = acc[ai][1][m][0], u1 = acc[ai][1][m][1];
                u32x4 w;
                w.x = cvt_pk_bf16(silu_mul(g0[0], u0[0]), silu_mul(g0[1], u0[1])); w.y = cvt_pk_bf16(silu_mul(g0[2], u0[2]), silu_mul(g0[3], u0[3]));
                w.z = cvt_pk_bf16(silu_mul(g1[0], u1[0]), silu_mul(g1[1], u1[1])); w.w = cvt_pk_bf16(silu_mul(g1[2], u1[2]), silu_mul(g1[3], u1[3]));
                *(u32x4*)p = w;
                asm volatile("" ::: "memory");
            }
    }
};
struct EpiResid {
    static constexpr bool PERM = false, AFTER_DRAIN = false;
    const float* baseP; const float* baseS; float* out; float scale;
    __device__ __forceinline__ void operator()(const f32x4 (&acc)[2][2][4][2], const Unit& u, int wr, int wc, int fr, int fq) const {
        const int col0 = u.pn * BM + wc * 32 + 4 * fq;
#pragma unroll
        for (int ai = 0; ai < 2; ++ai)
#pragma unroll
            for (int m = 0; m < 4; ++m) {
                const int row = u.pm * BM + ai * HALF + wr * 64 + m * 16 + fr;
                const float* bp = (row < 16384) ? baseP + (size_t)row * 1024 : baseS + (size_t)(row - 16384) * 1024;
                float* op = out + (size_t)row * 1024;
#pragma unroll
                for (int bj = 0; bj < 2; ++bj)
#pragma unroll
                    for (int n = 0; n < 2; ++n) { const int c = col0 + bj * HALF + n * 16; const f32x4 b = *(const f32x4*)(bp + c); *(f32x4*)(op + c) = b + acc[ai][bj][m][n] * scale; }
                asm volatile("" ::: "memory");
            }
    }
};
constexpr float RMS_EPS = 1e-6f;
__device__ __forceinline__ float rstd_of(float ss) { return 1.0f / sqrtf(ss * (1.0f / 1024.0f) + RMS_EPS); }

#define PG8_RLX_AGENT __ATOMIC_RELAXED, __HIP_MEMORY_SCOPE_AGENT
template <bool BASE16> struct EpiResidNorm {
    static constexpr bool PERM = true, AFTER_DRAIN = true;
    const void* baseP; bf16_t* out; float scale; bf16_t* hb; float* yout; const float* gain; unsigned* slots; unsigned* cnt;
    __device__ __forceinline__ void fused(f32x4 (&acc)[2][2][4][2], const Unit& u, int wr, int wc, int fr, int fq, PG8_LAS unsigned char* lds, int wid, int lane) const {
        PG8_LAS float* P = (PG8_LAS float*)lds;
        PG8_LAS float* S = (PG8_LAS float*)(lds + 4096);
        const int col0 = u.pn * BM + wc * 32 + 8 * fq;
        if (BASE16) {
            u32x4 braw[2][4][2];
#pragma unroll
            for (int ai = 0; ai < 2; ++ai)
#pragma unroll
                for (int m = 0; m < 4; ++m) { const size_t ro = (size_t)(u.pm * BM + ai * HALF + wr * 64 + m * 16 + fr) * 1024;
#pragma unroll
                    for (int bj = 0; bj < 2; ++bj) braw[ai][m][bj] = *(const u32x4*)((const bf16_t*)baseP + ro + col0 + bj * HALF); }
#pragma unroll
            for (int ai = 0; ai < 2; ++ai)
#pragma unroll
                for (int m = 0; m < 4; ++m)
#pragma unroll
                    for (int bj = 0; bj < 2; ++bj) { const u32x4 bw = braw[ai][m][bj]; f32x4 b0, b1;
                        b0[0] = __builtin_bit_cast(float, bw.x << 16); b0[1] = __builtin_bit_cast(float, bw.x & 0xffff0000u); b0[2] = __builtin_bit_cast(float, bw.y << 16); b0[3] = __builtin_bit_cast(float, bw.y & 0xffff0000u);
                        b1[0] = __builtin_bit_cast(float, bw.z << 16); b1[1] = __builtin_bit_cast(float, bw.z & 0xffff0000u); b1[2] = __builtin_bit_cast(float, bw.w << 16); b1[3] = __builtin_bit_cast(float, bw.w & 0xffff0000u);
                        acc[ai][bj][m][0] = b0 + acc[ai][bj][m][0] * scale; acc[ai][bj][m][1] = b1 + acc[ai][bj][m][1] * scale; }
        }
#pragma unroll
        for (int ai = 0; ai < 2; ++ai)
#pragma unroll
            for (int m = 0; m < 4; ++m) {
                const int rl = ai * HALF + wr * 64 + m * 16 + fr; const size_t ro = (size_t)(u.pm * BM + rl) * 1024;
                float ss = 0.f;
#pragma unroll
                for (int bj = 0; bj < 2; ++bj) { const int c = col0 + bj * HALF; f32x4 v0, v1;
                    if (BASE16) { v0 = acc[ai][bj][m][0]; v1 = acc[ai][bj][m][1]; }
                    else { v0 = *(const f32x4*)((const float*)baseP + ro + c) + acc[ai][bj][m][0] * scale; v1 = *(const f32x4*)((const float*)baseP + ro + c + 4) + acc[ai][bj][m][1] * scale; acc[ai][bj][m][0] = v0; acc[ai][bj][m][1] = v1; }
                    if (out) { u32x4 w; w.x = cvt_pk_bf16(v0[0], v0[1]); w.y = cvt_pk_bf16(v0[2], v0[3]); w.z = cvt_pk_bf16(v1[0], v1[1]); w.w = cvt_pk_bf16(v1[2], v1[3]); *(u32x4*)(out + ro + c) = w; }
                    ss += ((v0[0] * v0[0] + v0[1] * v0[1]) + (v0[2] * v0[2] + v0[3] * v0[3])) + ((v1[0] * v1[0] + v1[1] * v1[1]) + (v1[2] * v1[2] + v1[3] * v1[3])); }
                ss += __builtin_bit_cast(float, __builtin_amdgcn_ds_swizzle(__builtin_bit_cast(int, ss), (16 << 10) | 0x1f));
                { float a = ss, b2 = ss; asm volatile("s_nop 1\n\tv_permlane32_swap_b32 %0, %1\n\ts_nop 1" : "+v"(a), "+v"(b2)); ss = a + b2; }
                if (fq == 0) P[rl * 4 + wc] = ss;
                if (!BASE16 && (m & 1)) asm volatile("" ::: "memory");
            }
        asm volatile("s_waitcnt lgkmcnt(0)\n\ts_barrier" ::: "memory");
        const int t = wid * 64 + lane;
        if (t < 256) { const float s = (P[t * 4] + P[t * 4 + 1]) + (P[t * 4 + 2] + P[t * 4 + 3]);
            __hip_atomic_store(slots + (size_t)(u.pm * BM + t) * 4 + u.pn, __builtin_bit_cast(unsigned, s), PG8_RLX_AGENT); }
        asm volatile("s_waitcnt vmcnt(0)" ::: "memory");
        if (wid < 4 && lane == 0) __hip_atomic_fetch_add(cnt, 1u, PG8_RLX_AGENT);
        if (wid == 0) {
            unsigned spins = 0;
            while ((unsigned)__builtin_amdgcn_readfirstlane(__hip_atomic_load(cnt, PG8_RLX_AGENT)) < 16u) { __builtin_amdgcn_s_sleep(2); if (++spins > (1u << 22)) break; }
            __builtin_amdgcn_fence(__ATOMIC_ACQUIRE, "agent");
        }
        asm volatile("s_waitcnt vmcnt(0) lgkmcnt(0)\n\ts_barrier" ::: "memory");
        if (t < 256) { const unsigned* sl = slots + (size_t)(u.pm * BM + t) * 4; float tot = 0.f;
#pragma unroll
            for (int k = 0; k < 4; ++k) tot += __builtin_bit_cast(float, __hip_atomic_load(sl + k, PG8_RLX_AGENT));
            S[t] = rstd_of(tot); }
        asm volatile("s_waitcnt lgkmcnt(0)\n\ts_barrier" ::: "memory");
        f32x4 g4[2][2];
#pragma unroll
        for (int bj = 0; bj < 2; ++bj)
#pragma unroll
            for (int n = 0; n < 2; ++n) g4[bj][n] = *(const f32x4*)(gain + col0 + bj * HALF + n * 4);
#pragma unroll
        for (int ai = 0; ai < 2; ++ai)
#pragma unroll
            for (int m = 0; m < 4; ++m) {
                const int rl = ai * HALF + wr * 64 + m * 16 + fr; const size_t ro = (size_t)(u.pm * BM + rl) * 1024; const float r = S[rl];
#pragma unroll
                for (int bj = 0; bj < 2; ++bj) { const int c = col0 + bj * HALF; const f32x4 y0 = acc[ai][bj][m][0] * r * g4[bj][0], y1 = acc[ai][bj][m][1] * r * g4[bj][1];
                    if (hb) { u32x4 w; w.x = cvt_pk_bf16(y0[0], y0[1]); w.y = cvt_pk_bf16(y0[2], y0[3]); w.z = cvt_pk_bf16(y1[0], y1[1]); w.w = cvt_pk_bf16(y1[2], y1[3]); *(u32x4*)(hb + ro + c) = w; }
                    else { *(f32x4*)(yout + ro + c) = y0; *(f32x4*)(yout + ro + c + 4) = y1; } }
            }
        asm volatile("s_waitcnt lgkmcnt(0)\n\ts_barrier" ::: "memory");
    }
};

struct EpiWin {
    static constexpr bool PERM = false, AFTER_DRAIN = false;
    unsigned char* ws; float* outp; int l; float qscale;
    __device__ __forceinline__ void operator()(const f32x4 (&acc)[2][2][4][2], const Unit& u, int wr, int wc, int fr, int fq) const {
        const int pn = u.pn;
        float invrev[2][4];
#pragma unroll
        for (int n = 0; n < 2; ++n)
#pragma unroll
            for (int j = 0; j < 4; ++j) invrev[n][j] = exp2f(-(float)(8 * fq + 4 * n + j) * (13.287712379549449f / 32.0f)) * 0.15915494309189535f;
        bf16_t* const Qb = (bf16_t*)(ws + WOFF_QB); bf16_t* const Kb = (bf16_t*)(ws + WOFF_KB); bf16_t* const Vb = (bf16_t*)(ws + WOFF_VB); bf16_t* const Zb = (bf16_t*)(ws + WOFF_ZB);
        float* const kP = outp + OOFF_KP + (size_t)l * 16384 * 512; float* const vP = outp + OOFF_VP + (size_t)l * 16384 * 512;
        float* const kS = outp + OOFF_KS + (size_t)l * 256 * 512; float* const vS = outp + OOFF_VS + (size_t)l * 256 * 512;
        float* const poolP = outp + OOFF_PP + (size_t)l * 8 * 15 * 256; float* const poolS = outp + OOFF_PS + (size_t)l * 8 * 15 * 256;
        const int c0 = 64 * wc + 8 * fq;
#pragma unroll
        for (int ai = 0; ai < 2; ++ai)
#pragma unroll
            for (int m = 0; m < 4; ++m) {
                const int row = u.pm * BM + ai * HALF + wr * 64 + m * 16 + fr;
                const bool smp = row >= 16384; const int rs = row - 16384;
                f32x4 v[2][2];
                if (pn < 4) {
                    const float posf = (float)(smp ? 4096 + (rs & 31) : (row & 2047));
#pragma unroll
                    for (int n = 0; n < 2; ++n) { f32x4 cs, sn;
#pragma unroll
                        for (int j = 0; j < 4; ++j) { const float rev = posf * invrev[n][j]; const float fr_ = rev - __builtin_rintf(rev); cs[j] = __builtin_amdgcn_cosf(fr_); sn[j] = __builtin_amdgcn_sinf(fr_); }
                        const f32x4 lo = acc[ai][0][m][n], hi = acc[ai][1][m][n];
                        v[0][n] = lo * cs - hi * sn; v[1][n] = hi * cs + lo * sn; }
                } else {
#pragma unroll
                    for (int bj = 0; bj < 2; ++bj)
#pragma unroll
                        for (int n = 0; n < 2; ++n) v[bj][n] = acc[ai][bj][m][n];
                }
#pragma unroll
                for (int bj = 0; bj < 2; ++bj) {
                    const int lc = c0 + 32 * bj; const f32x4 x0 = v[bj][0], x1 = v[bj][1];
                    if (pn < 2) {
                        bf16_t* q = Qb + (size_t)row * 512 + 256 * pn + lc;
                        u32x4 w; w.x = cvt_pk_bf16(x0[0] * qscale, x0[1] * qscale); w.y = cvt_pk_bf16(x0[2] * qscale, x0[3] * qscale); w.z = cvt_pk_bf16(x1[0] * qscale, x1[1] * qscale); w.w = cvt_pk_bf16(x1[2] * qscale, x1[3] * qscale);
                        *(u32x4*)q = w;
                    } else {
                        u32x4 w; w.x = cvt_pk_bf16(x0[0], x0[1]); w.y = cvt_pk_bf16(x0[2], x0[3]); w.z = cvt_pk_bf16(x1[0], x1[1]); w.w = cvt_pk_bf16(x1[2], x1[3]);
                        if (pn < 4) { const int col = 256 * (pn - 2) + lc; float* ko = smp ? kS + (size_t)rs * 512 + col : kP + (size_t)row * 512 + col;
                            *(f32x4*)ko = x0; *(f32x4*)(ko + 4) = x1; *(u32x4*)(Kb + (size_t)row * 512 + col) = w; }
                        else if (pn < 6) { const int col = 256 * (pn - 4) + lc; float* vo = smp ? vS + (size_t)rs * 512 + col : vP + (size_t)row * 512 + col;
                            *(f32x4*)vo = x0; *(f32x4*)(vo + 4) = x1; *(u32x4*)(Vb + (size_t)row * 512 + col) = w; }
                        else { *(u32x4*)(Zb + (size_t)row * 1024 + 256 * (pn - 6) + lc) = w;
                            if (pn == 6) {
                                if (smp) { const int b = rs >> 5, t = rs & 31; if (t >= 17) { float* po = poolS + (size_t)(b * 15 + t - 17) * 256 + lc; *(f32x4*)po = x0; *(f32x4*)(po + 4) = x1; } }
                                else { const int b = row >> 11, t = row & 2047; if (t >= 2033) { float* po = poolP + (size_t)(b * 15 + t - 2033) * 256 + lc; *(f32x4*)po = x0; *(f32x4*)(po + 4) = x1; } }
                            } }
                    }
                }
                asm volatile("" ::: "memory");
            }
    }
};
template <class Epi, class Sched, bool ALIGN_EPI = false, bool SP2 = false>
__device__ __forceinline__ void gemm_phase(PG8_LAS unsigned char* lds, const Gemm g, const Sched& S, const Epi& E) {
    int tid_l = threadIdx.x; asm volatile("" : "+v"(tid_l)); const int tid = tid_l, wid = __builtin_amdgcn_readfirstlane(tid >> 6), lane = tid & 63, wr = wid >> 2, wc = wid & 3, fr = lane & 15, fq = lane >> 4;
    const int K = g.K, nt = K / BK;
    unsigned voffA[2], voffB[2];
#pragma unroll
    for (int i = 0; i < 2; ++i) { int R, C; stage_rc(tid * 16 + i * 8192, R, C); const int Rb = Epi::PERM ? ((R & ~31) + perm32(R & 31)) : R;
        voffA[i] = (unsigned)(R * K + C) * 2u; voffB[i] = (unsigned)(Rb * K + C) * 2u; }
    const size_t kstep = (size_t)(BK * 2);
    const size_t hstep = (size_t)HALF * K * 2;
    const size_t tstep = 2 * hstep;
    const unsigned ldsw = (unsigned)wid * 1024u;
    const int aoff = lds_byte(wr * 64 + fr, fq * 8), boff = lds_byte(wc * 32 + fr, fq * 8);
#define PG8_SA(b, h) (((b) * 2 + (h)) * HTB)
#define PG8_SB(b, h) ((4 + (b) * 2 + (h)) * HTB)
#define PG8_STAGE(bufoff, gbase, voff) do { _Pragma("unroll") for (int _i = 0; _i < 2; ++_i) \
        __builtin_amdgcn_global_load_lds((const unsigned*)((const char*)(gbase) + (voff)[_i]), (PG8_LAS unsigned*)(lds + (bufoff) + ldsw + _i * 8192), 16, 0, 0); } while (0)
#define PG8_LDA(dst, b, h) do { _Pragma("unroll") for (int m = 0; m < 4; ++m) _Pragma("unroll") for (int k = 0; k < 2; ++k) dst[m][k] = *(const PG8_LAS bf16x8*)(lds + PG8_SA(b, h) + aoff + m * 2048 + k * 1024); } while (0)
#define PG8_LDB(dst, b, h) do { _Pragma("unroll") for (int n = 0; n < 2; ++n) _Pragma("unroll") for (int k = 0; k < 2; ++k) dst[n][k] = *(const PG8_LAS bf16x8*)(lds + PG8_SB(b, h) + boff + n * 2048 + k * 1024); } while (0)
#define PG8_MMA(ai, bj, At, Bt) do { __builtin_amdgcn_s_setprio(1); _Pragma("unroll") for (int m = 0; m < 4; ++m) _Pragma("unroll") for (int n = 0; n < 2; ++n) _Pragma("unroll") for (int k = 0; k < 2; ++k) \
        acc[ai][bj][m][n] = __builtin_amdgcn_mfma_f32_16x16x32_bf16(Bt[n][k], At[m][k], acc[ai][bj][m][n], 0, 0, 0); __builtin_amdgcn_s_setprio(0); } while (0)
#define PG8_WAIT_V(n) asm volatile("s_waitcnt vmcnt(" #n ")" ::: "memory")
#define PG8_WAIT_L(n) asm volatile("s_waitcnt lgkmcnt(" #n ")" ::: "memory")
#define PG8_BAR __builtin_amdgcn_s_barrier()
#define PG8_SCHED __builtin_amdgcn_sched_barrier(0)
    Unit cur, nxt; int ui = 0;
    if (!S.next(0, cur)) return;
    f32x4 acc[2][2][4][2];
#pragma unroll
    for (int a = 0; a < 2; ++a)
#pragma unroll
        for (int b = 0; b < 2; ++b)
#pragma unroll
            for (int m = 0; m < 4; ++m)
#pragma unroll
                for (int n = 0; n < 2; ++n) acc[a][b][m][n] = (f32x4){0.f, 0.f, 0.f, 0.f};
    bf16x8 At[4][2], B0[2][2], B1[2][2];
    const char* cA = (const char*)g.A + (size_t)cur.pm * tstep; const char* cB = (const char*)g.Bt + (size_t)cur.pn * tstep;
    S.a_ready(cur);
    if constexpr (SP2) {
        PG8_STAGE(PG8_SB(0, 0), cB, voffB); PG8_STAGE(PG8_SB(0, 1), cB + hstep, voffB); PG8_STAGE(PG8_SA(0, 0), cA, voffA); PG8_STAGE(PG8_SA(0, 1), cA + hstep, voffA);
        if (wr == 1) PG8_BAR;
        PG8_WAIT_V(2); PG8_BAR;
        PG8_STAGE(PG8_SB(1, 0), cB + kstep, voffB); PG8_STAGE(PG8_SA(1, 0), cA + kstep, voffA); PG8_STAGE(PG8_SB(1, 1), cB + hstep + kstep, voffB);
        PG8_WAIT_V(6); PG8_BAR;
    } else {
        PG8_STAGE(PG8_SB(0, 0), cB, voffB); PG8_STAGE(PG8_SA(0, 0), cA, voffA); PG8_STAGE(PG8_SB(0, 1), cB + hstep, voffB); PG8_STAGE(PG8_SA(0, 1), cA + hstep, voffA);
        if (wr == 1) PG8_BAR;
        PG8_WAIT_V(4); PG8_BAR;
        PG8_STAGE(PG8_SB(1, 0), cB + kstep, voffB); PG8_STAGE(PG8_SA(1, 0), cA + kstep, voffA); PG8_STAGE(PG8_SB(1, 1), cB + hstep + kstep, voffB);
        PG8_WAIT_V(6); PG8_BAR;
    }
    for (;;) {
        const bool has_next = S.next(ui + 1, nxt);
        const char* nA = has_next ? (const char*)g.A + (size_t)nxt.pm * tstep : cA; const char* nB = has_next ? (const char*)g.Bt + (size_t)nxt.pn * tstep : cB;
        for (int t = 0; t < nt; t += 2) {
            const bool last = (t == nt - 2);
            const char* a1 = cA + (size_t)(t + 1) * kstep;
            const char* a2 = last ? nA : cA + (size_t)(t + 2) * kstep; const char* b2 = last ? nB : cB + (size_t)(t + 2) * kstep;
            const char* a3 = a2 + kstep; const char* b3 = b2 + kstep;
            if (last && has_next) S.a_ready(nxt);
            if constexpr (SP2) {
            PG8_LDB(B0, 0, 0); PG8_LDB(B1, 0, 1); PG8_SCHED; PG8_LDA(At, 0, 0); PG8_STAGE(PG8_SA(1, 1), a1 + hstep, voffA);
            PG8_WAIT_V(8); PG8_WAIT_L(0); PG8_BAR; PG8_MMA(0, 0, At, B0); PG8_MMA(0, 1, At, B1); PG8_BAR; PG8_SCHED;
            PG8_LDA(At, 0, 1); PG8_STAGE(PG8_SB(0, 0), b2, voffB); PG8_STAGE(PG8_SB(0, 1), b2 + hstep, voffB); PG8_STAGE(PG8_SA(0, 0), a2, voffA);
            PG8_WAIT_V(8); PG8_WAIT_L(0); PG8_BAR; PG8_MMA(1, 0, At, B0); PG8_MMA(1, 1, At, B1); PG8_BAR; PG8_SCHED;
            PG8_LDB(B0, 1, 0); PG8_LDB(B1, 1, 1); PG8_SCHED; PG8_LDA(At, 1, 0); PG8_STAGE(PG8_SA(0, 1), a2 + hstep, voffA);
            PG8_WAIT_V(8); PG8_WAIT_L(0); PG8_BAR; PG8_MMA(0, 0, At, B0); PG8_MMA(0, 1, At, B1); PG8_BAR; PG8_SCHED;
            PG8_LDA(At, 1, 1); PG8_STAGE(PG8_SB(1, 0), b3, voffB); PG8_STAGE(PG8_SB(1, 1), b3 + hstep, voffB); PG8_STAGE(PG8_SA(1, 0), a3, voffA);
            PG8_WAIT_V(8); PG8_WAIT_L(0); PG8_BAR; PG8_MMA(1, 0, At, B0); PG8_MMA(1, 1, At, B1); PG8_BAR; PG8_SCHED;
            } else {
            PG8_LDB(B0, 0, 0); PG8_SCHED; PG8_LDA(At, 0, 0); PG8_STAGE(PG8_SA(1, 1), a1 + hstep, voffA);
            PG8_WAIT_L(8); PG8_BAR; PG8_WAIT_L(0); PG8_MMA(0, 0, At, B0); PG8_BAR; PG8_SCHED;
            PG8_LDB(B1, 0, 1); PG8_STAGE(PG8_SB(0, 0), b2, voffB);
            PG8_BAR; PG8_WAIT_L(0); PG8_MMA(0, 1, At, B1); PG8_BAR;
            PG8_LDA(At, 0, 1); PG8_STAGE(PG8_SA(0, 0), a2, voffA);
            PG8_BAR; PG8_WAIT_L(0); PG8_MMA(1, 0, At, B0); PG8_BAR; PG8_SCHED;
            PG8_STAGE(PG8_SB(0, 1), b2 + hstep, voffB);
            PG8_WAIT_V(6); PG8_BAR; PG8_MMA(1, 1, At, B1); PG8_BAR;
            PG8_LDB(B0, 1, 0); PG8_SCHED; PG8_LDA(At, 1, 0); PG8_STAGE(PG8_SA(0, 1), a2 + hstep, voffA);
            PG8_WAIT_L(8); PG8_BAR; PG8_WAIT_L(0); PG8_MMA(0, 0, At, B0); PG8_BAR; PG8_SCHED;
            PG8_LDB(B1, 1, 1); PG8_STAGE(PG8_SB(1, 0), b3, voffB);
            PG8_BAR; PG8_WAIT_L(0); PG8_MMA(0, 1, At, B1); PG8_BAR;
            PG8_LDA(At, 1, 1); PG8_STAGE(PG8_SA(1, 0), a3, voffA);
            PG8_BAR; PG8_WAIT_L(0); PG8_MMA(1, 0, At, B0); PG8_BAR; PG8_SCHED;
            PG8_STAGE(PG8_SB(1, 1), b3 + hstep, voffB);
            PG8_WAIT_V(6); PG8_BAR; PG8_MMA(1, 1, At, B1); PG8_BAR;
            }
        }
        if constexpr (ALIGN_EPI) { if (wr == 0) PG8_BAR; }
        if constexpr (!Epi::AFTER_DRAIN) { E(acc, cur, wr, wc, fr, fq); S.done(cur); }
        if (!has_next) break;
#pragma unroll
        for (int a = 0; a < 2; ++a)
#pragma unroll
            for (int b = 0; b < 2; ++b)
#pragma unroll
                for (int m = 0; m < 4; ++m)
#pragma unroll
                    for (int n = 0; n < 2; ++n) acc[a][b][m][n] = (f32x4){0.f, 0.f, 0.f, 0.f};
        cur = nxt; cA = nA; cB = nB; ++ui;
        if constexpr (ALIGN_EPI) { if (wr == 1) PG8_BAR; }
    }
    PG8_WAIT_V(0);
    if constexpr (!ALIGN_EPI) { if (wr == 0) PG8_BAR; }
    PG8_BAR;
    if constexpr (Epi::AFTER_DRAIN) { E.fused(acc, cur, wr, wc, fr, fq, lds, wid, lane); S.done(cur); }
#undef PG8_SA
#undef PG8_SB
#undef PG8_STAGE
#undef PG8_LDA
#undef PG8_LDB
#undef PG8_MMA
#undef PG8_WAIT_V
#undef PG8_WAIT_L
#undef PG8_BAR
#undef PG8_SCHED
}
}
#include <hip/hip_bf16.h>
#include <cmath>
namespace attn_body {
using bf16=__hip_bfloat16;
using bf16x8=__attribute__((ext_vector_type(8)))short;
using s16x4=__attribute__((ext_vector_type(4)))short;
using f32x16=__attribute__((ext_vector_type(16)))float;
using u32x4=__attribute__((ext_vector_type(4)))unsigned;
constexpr int BATCH=8,NHEAD=16,SEQ=2048,D=64,PQK=512,PO=1024;
constexpr int NW=8,QBLK=32,QB=QBLK*NW,KVBLK=64,NQB=SEQ/QB;
constexpr int ATTN_UNIT_ROWS=QB;
__device__ __forceinline__ int crow(int r,int hi){return (r&3)+8*(r>>2)+4*hi;}
#define SBAR() __builtin_amdgcn_sched_barrier(0)
__device__ __forceinline__ void cmask(f32x16&p0,f32x16&p1,int jb,int qrel,int hi){
  const float NEG=-INFINITY; (void)hi;
  if(jb>(qrel>>6)){
  #pragma unroll
  for(int r=0;r<16;++r){p0[r]=NEG;p1[r]=NEG;}}
}

constexpr int NSLOT=3, SLOTB=8192;
constexpr int LDS_K=0, LDS_V=NSLOT*SLOTB, LDS_WS=2*NSLOT*SLOTB, LDS_OST=LDS_WS+NW*64*4, LDS_BYTES=LDS_OST+NW*4096;
constexpr float C2=0.125f*1.4426950408889634f;
__device__ __forceinline__ void glds16(const void*gsrc,unsigned lds_dst){unsigned keep;
  asm volatile("s_mov_b32 %0, m0\n\ts_mov_b32 m0, %2\n\ts_nop 0\n\tglobal_load_lds_dwordx4 %1, off\n\ts_mov_b32 m0, %0":"=&s"(keep):"v"(gsrc),"s"(lds_dst):"memory");}
__device__ __forceinline__ float max3f(float a,float b,float c){float r;asm("v_max3_f32 %0, %1, %2, %3":"=v"(r):"v"(a),"v"(b),"v"(c));return r;}
__device__ __forceinline__ float max2f(float a,float b){float r;asm("v_max_f32_e32 %0, %1, %2":"=v"(r):"v"(a),"v"(b));return r;}
__device__ __forceinline__ float fadd_s(float a,float b){float r;asm("v_add_f32_e32 %0, %1, %2":"=v"(r):"v"(a),"v"(b));return r;}
__device__ __forceinline__ float fsub_s(float a,float b){float r;asm("v_sub_f32_e32 %0, %1, %2":"=v"(r):"v"(a),"v"(b));return r;}
typedef float f32x2_t __attribute__((ext_vector_type(2))); typedef __bf16 bf16x2_t __attribute__((ext_vector_type(2)));
__device__ __forceinline__ unsigned cvtpk_s(float lo,float hi){f32x2_t v={lo,hi};bf16x2_t b=__builtin_convertvector(v,bf16x2_t);return __builtin_bit_cast(unsigned,b);}
#define WAIT_BAR(N) asm volatile("s_waitcnt vmcnt(" #N ") lgkmcnt(0)\n\ts_barrier":::"memory")

__device__ __forceinline__ void qkt(f32x16&p0,f32x16&p1,const char*Kslot,const bf16x8*qr,const f32x16&negm,int r32,int hi){
  const char*kb=Kslot+hi*1024+r32*16;
  #pragma unroll
  for(int d0=0;d0<4;++d0){
    const bf16x8 b0=*reinterpret_cast<const bf16x8*>(kb+d0*2048);
    const bf16x8 b1=*reinterpret_cast<const bf16x8*>(kb+d0*2048+512);
    if(d0==0){p0=__builtin_amdgcn_mfma_f32_32x32x16_bf16(b0,qr[0],negm,0,0,0);p1=__builtin_amdgcn_mfma_f32_32x32x16_bf16(b1,qr[0],negm,0,0,0);}
    else{p0=__builtin_amdgcn_mfma_f32_32x32x16_bf16(b0,qr[d0],p0,0,0,0);p1=__builtin_amdgcn_mfma_f32_32x32x16_bf16(b1,qr[d0],p1,0,0,0);}}
}
typedef __attribute__((address_space(3))) const char* lds_cptr;
typedef short v4i16_t __attribute__((ext_vector_type(4)));
__device__ __forceinline__ void kload8(bf16x8*kf,lds_cptr kp){
  kf[0]=*(const __attribute__((address_space(3))) bf16x8*)(kp);      kf[1]=*(const __attribute__((address_space(3))) bf16x8*)(kp+512);
  kf[2]=*(const __attribute__((address_space(3))) bf16x8*)(kp+2048); kf[3]=*(const __attribute__((address_space(3))) bf16x8*)(kp+2560);
  kf[4]=*(const __attribute__((address_space(3))) bf16x8*)(kp+4096); kf[5]=*(const __attribute__((address_space(3))) bf16x8*)(kp+4608);
  kf[6]=*(const __attribute__((address_space(3))) bf16x8*)(kp+6144); kf[7]=*(const __attribute__((address_space(3))) bf16x8*)(kp+6656);
}
__device__ __forceinline__ void kload2(bf16x8*kf,lds_cptr kp,int j){ kf[2*j]=*(const __attribute__((address_space(3))) bf16x8*)(kp+j*2048); kf[2*j+1]=*(const __attribute__((address_space(3))) bf16x8*)(kp+j*2048+512); }
__device__ __forceinline__ s16x4 vtr(lds_cptr p){ return __builtin_bit_cast(s16x4,__builtin_amdgcn_ds_read_tr16_b64_v4i16((__attribute__((address_space(3))) v4i16_t*)p)); }
__device__ __forceinline__ float rowmax(const f32x16&p0,const f32x16&p1){
  float a=max3f(p0[0],p0[1],p1[0]),b=max3f(p0[2],p0[3],p1[1]);a=max3f(a,p1[2],p1[3]);
  #pragma unroll
  for(int r=4;r<16;r+=4){a=max3f(a,p0[r],p0[r+1]);b=max3f(b,p0[r+2],p0[r+3]);a=max3f(a,p1[r],p1[r+1]);b=max3f(b,p1[r+2],p1[r+3]);}
  const float m=max2f(a,b);
  auto rr=__builtin_amdgcn_permlane32_swap(__float_as_uint(m),__float_as_uint(m),false,false);
  return max2f(__uint_as_float(rr[0]),__uint_as_float(rr[1]));
}
__device__ __forceinline__ void pv(f32x16*o,int vb,bf16x8 pa0,bf16x8 pa1,bf16x8 pa2,bf16x8 pa3){
  #pragma unroll
  for(int d0=0;d0<2;++d0){s16x4 lo[4],hi[4];
    #pragma unroll
    for(int ks=0;ks<4;++ks){
      asm volatile("ds_read_b64_tr_b16 %0,%1 offset:%c2":"=&v"(lo[ks]):"v"(vb),"i"(d0*4096+ks*1024):"memory");
      asm volatile("ds_read_b64_tr_b16 %0,%1 offset:%c2":"=&v"(hi[ks]):"v"(vb),"i"(d0*4096+ks*1024+512):"memory");}
    asm volatile("s_waitcnt lgkmcnt(0)":::"memory");SBAR();
    #define PK(k) (bf16x8){lo[k][0],lo[k][1],lo[k][2],lo[k][3],hi[k][0],hi[k][1],hi[k][2],hi[k][3]}
    o[d0]=__builtin_amdgcn_mfma_f32_32x32x16_bf16(pa0,PK(0),o[d0],0,0,0);
    o[d0]=__builtin_amdgcn_mfma_f32_32x32x16_bf16(pa1,PK(1),o[d0],0,0,0);
    o[d0]=__builtin_amdgcn_mfma_f32_32x32x16_bf16(pa2,PK(2),o[d0],0,0,0);
    o[d0]=__builtin_amdgcn_mfma_f32_32x32x16_bf16(pa3,PK(3),o[d0],0,0,0);
    #undef PK
  }
}

#ifndef ATTN_STORE16
#define ATTN_STORE16(p,v) (*(u32x4*)(p)=(v))
#endif
template<int THRL> __device__ __forceinline__ void attn_unit(int b,int qb,const bf16*Q,const bf16*__restrict__ K,const bf16*__restrict__ V,bf16*O,char*shm){
  int tid_l=threadIdx.x; asm volatile("":"+v"(tid_l)); const int tid=tid_l,lane=tid&63,r32=lane&31,hi=lane>>5; const int wid=__builtin_amdgcn_readfirstlane(tid>>6);
  const long rowbase=(long)b*SEQ; const int q0=qb*QB;
  const bf16*Qw=Q+(rowbase+q0+wid*QBLK)*PQK;
  const bf16*Kh=K+rowbase*PQK,*Vh=V+rowbase*PQK;
  const unsigned lds0=(unsigned)(uintptr_t)shm;
  float*wsf=(float*)(shm+LDS_WS)+wid*64;
  const bf16*ksrc=Kh+(long)lane*PQK+wid*8;
  const bf16*vsrc=Vh+(long)(16*(wid&3)+(lane>>2))*PQK+(wid>>2)*32+(lane&3)*8;
  const unsigned kdst=lds0+LDS_K+wid*1024, vdst=lds0+LDS_V+wid*1024;
  #define DMA_K(t,slot) glds16(ksrc+(long)(t)*KVBLK*PQK,(unsigned)__builtin_amdgcn_readfirstlane(kdst+(slot)))
  #define DMA_V(t,slot) glds16(vsrc+(long)(t)*KVBLK*PQK,(unsigned)__builtin_amdgcn_readfirstlane(vdst+(slot)))
  const int vb0=(int)(lds0+LDS_V)+((lane>>4)&1)*32+(lane&3)*8+(4*hi+((lane&15)>>2))*64;
  const char*Kbase=shm+LDS_K; bf16x8 kf[8];
  const lds_cptr shm3=(lds_cptr)shm; const lds_cptr kp0=shm3+LDS_K+hi*1024+r32*16; const lds_cptr vp0=shm3+LDS_V+((lane>>4)&1)*32+(lane&3)*8+(4*hi+((lane&15)>>2))*64;
  const int NT=(q0+QB)/KVBLK;
  DMA_K(0,0);DMA_V(0,0);DMA_K(1,SLOTB);
  bf16x8 qr[4];
  #pragma unroll
  for(int d0=0;d0<4;++d0)qr[d0]=*reinterpret_cast<const bf16x8*>(&Qw[(long)r32*PQK+d0*16+hi*8]);
  float mhat=0.f,l_reg=0.f;f32x16 o[2];o[0]=f32x16{};o[1]=f32x16{};f32x16 negm=f32x16{};asm volatile("":"+v"(negm));
  const int qrel=wid*QBLK+r32;
  #define CMASK(P0,P1,t) do{int jb_=(t)-(NT-4); if(jb_>=0)cmask(P0,P1,jb_,qrel,hi);}while(0)
  bool resc=false;
  #define START(P0,P1) do{ const float rm=rowmax(P0,P1); resc=false; \
    { const float dl=rm; mhat=fadd_s(mhat,dl); \
      _Pragma("unroll") for(int r=0;r<16;++r){P0[r]=fsub_s(P0[r],dl);P1[r]=fsub_s(P1[r],dl);} \
      _Pragma("unroll") for(int r=0;r<16;++r)negm[r]=-mhat; asm volatile("":"+v"(negm)); } \
    _Pragma("unroll") for(int r=0;r<16;++r)P0[r]=__builtin_amdgcn_exp2f(P0[r]); }while(0)
  #define RESC() do{ if(resc){ asm volatile("s_waitcnt lgkmcnt(0)":::"memory"); \
      _Pragma("unroll") for(int d_=0;d_<2;++d_) _Pragma("unroll") for(int r=0;r<16;++r)o[d_][r]*=wsf[crow(r,hi)]; } }while(0)
  f32x16 pA0,pA1,pB0,pB1;
  int sl_prev=0,sl_cur=0,sl_next=SLOTB;
  #define ROT() do{sl_prev=sl_cur;sl_cur=sl_next;sl_next=(sl_next==(NSLOT-1)*SLOTB)?0:sl_next+SLOTB;}while(0)
  DMA_K(2,2*SLOTB);
  WAIT_BAR(3);
  qkt(pA0,pA1,Kbase,qr,negm,r32,hi);asm volatile("s_nop 15\n\ts_nop 7":"+v"(pA0),"+v"(pA1));CMASK(pA0,pA1,0);
  START(pA0,pA1);
  _Pragma("unroll") for(int r=0;r<16;++r)pA1[r]=__builtin_amdgcn_exp2f(pA1[r]);
  WAIT_BAR(0);
  DMA_K(3,0);DMA_V(1,SLOTB);
  ROT();
  kload8(kf,kp0+sl_cur);
  WAIT_BAR(2);
  s16x4 vlo[8],vhi[8]; u32x4 pw0,pw1,pw2,pw3;
  #define PKW(P,B) cvtpk_s(P[B],P[B+1])
  #define PAF(k) __builtin_bit_cast(bf16x8,pw##k)
  #define VFR(i) (bf16x8){vlo[i][0],vlo[i][1],vlo[i][2],vlo[i][3],vhi[i][0],vhi[i][1],vhi[i][2],vhi[i][3]}
  #define PIN(x) asm volatile("":"+v"(x))
  #define MX3(a,b,c) __builtin_fmaxf(__builtin_fmaxf((a),(b)),(c))
  #define GAPA(MF,A0,A1,A2,A3,W0,W1,PW) do{ MF; sacc+=A0; sacc+=A1; sacc+=A2; sacc+=A3; PIN(sacc); W0; W1; PIN(PW); SBAR(); }while(0)
  #define EX(v) __builtin_amdgcn_exp2f(v)
  #define GAPB(MF,X,B) do{ MF; X[B]=EX(X[B]); X[B+1]=EX(X[B+1]); X[B+2]=EX(X[B+2]); X[B+3]=EX(X[B+3]); PIN(X); SBAR(); }while(0)
  #define VRD(i) do{ vlo[i]=vtr(vp_+(((i)>>2)*4096+((i)&3)*1024)); vhi[i]=vtr(vp_+(((i)>>2)*4096+((i)&3)*1024+512)); }while(0)
  #define KRD(G,j) do{ if(G){ kload2(kf,kp0+sl_next,j); SBAR(); } }while(0)
  #define STEP(C0,C1,P0,P1,t,GK,GV,GL) do{ SBAR(); \
    const lds_cptr vp_=vp0+sl_prev; \
    VRD(0); SBAR(); float sacc=(P0[0]+P0[1]); \
    GAPA(C0=__builtin_amdgcn_mfma_f32_32x32x16_bf16(kf[0],qr[0],negm,0,0,0), P0[2],P0[3],P0[4],P0[5],     pw0[0]=PKW(P0,0), pw0[1]=PKW(P0,2), pw0); \
    VRD(4); SBAR(); GAPA(C1=__builtin_amdgcn_mfma_f32_32x32x16_bf16(kf[1],qr[0],negm,0,0,0), P0[6],P0[7],P0[8],P0[9],     pw0[2]=PKW(P0,4), pw0[3]=PKW(P0,6), pw0); \
    VRD(1); SBAR(); GAPA(C0=__builtin_amdgcn_mfma_f32_32x32x16_bf16(kf[2],qr[1],C0,0,0,0),   P0[10],P0[11],P0[12],P0[13], pw1[0]=PKW(P0,8), pw1[1]=PKW(P0,10), pw1); \
    VRD(5); SBAR(); GAPA(C1=__builtin_amdgcn_mfma_f32_32x32x16_bf16(kf[3],qr[1],C1,0,0,0),   P0[14],P0[15],P1[0],P1[1],   pw1[2]=PKW(P0,12),pw1[3]=PKW(P0,14), pw1); \
    VRD(2); SBAR(); GAPA(C0=__builtin_amdgcn_mfma_f32_32x32x16_bf16(kf[4],qr[2],C0,0,0,0),   P1[2],P1[3],P1[4],P1[5],     pw2[0]=PKW(P1,0), pw2[1]=PKW(P1,2), pw2); \
    VRD(6); SBAR(); GAPA(C1=__builtin_amdgcn_mfma_f32_32x32x16_bf16(kf[5],qr[2],C1,0,0,0),   P1[6],P1[7],P1[8],P1[9],     pw2[2]=PKW(P1,4), pw2[3]=PKW(P1,6), pw2); \
    VRD(3); SBAR(); GAPA(C0=__builtin_amdgcn_mfma_f32_32x32x16_bf16(kf[6],qr[3],C0,0,0,0),   P1[10],P1[11],P1[12],P1[13], pw3[0]=PKW(P1,8), pw3[1]=PKW(P1,10), pw3); \
    VRD(7); SBAR(); GAPA(C1=__builtin_amdgcn_mfma_f32_32x32x16_bf16(kf[7],qr[3],C1,0,0,0),   P1[14],P1[15],0.f,0.f,       pw3[2]=PKW(P1,12),pw3[3]=PKW(P1,14), pw3); \
    l_reg+=sacc; \
    if(GK){DMA_K((t)+3,sl_cur);} if(GV){DMA_V((t)+1,sl_next);} \
    CMASK(C0,C1,t); \
    { float a=MX3(C0[0],C0[1],C1[0]),b=MX3(C0[2],C0[3],C1[1]); a=MX3(a,C1[2],C1[3]); \
      _Pragma("unroll") for(int r=4;r<16;r+=4){a=MX3(a,C0[r],C0[r+1]);b=MX3(b,C0[r+2],C0[r+3]);a=MX3(a,C1[r],C1[r+1]);b=MX3(b,C1[r+2],C1[r+3]);} \
      float rm=__builtin_fmaxf(a,b); { auto rr=__builtin_amdgcn_permlane32_swap(__float_as_uint(rm),__float_as_uint(rm),false,false); rm=__builtin_fmaxf(__uint_as_float(rr[0]),__uint_as_float(rr[1])); } \
      resc=false; \
      if(__builtin_expect(__any(rm>(float)THRL),0)){ const float dl=__builtin_fmaxf(rm,0.f); mhat+=dl; \
        _Pragma("unroll") for(int r=0;r<16;++r){C0[r]-=dl;C1[r]-=dl;} \
        _Pragma("unroll") for(int r=0;r<16;++r)negm[r]=-mhat; asm volatile("":"+v"(negm)); \
        const float f=__builtin_amdgcn_exp2f(-dl); l_reg*=f; if(hi==0)wsf[r32]=f; resc=true; } } \
    SBAR(); \
    GAPB(o[0]=__builtin_amdgcn_mfma_f32_32x32x16_bf16(PAF(0),VFR(0),o[0],0,0,0), C0,0); \
    GAPB(o[1]=__builtin_amdgcn_mfma_f32_32x32x16_bf16(PAF(0),VFR(4),o[1],0,0,0), C0,4); \
    KRD(GL,0); GAPB(o[0]=__builtin_amdgcn_mfma_f32_32x32x16_bf16(PAF(1),VFR(1),o[0],0,0,0), C0,8); \
    KRD(GL,1); GAPB(o[1]=__builtin_amdgcn_mfma_f32_32x32x16_bf16(PAF(1),VFR(5),o[1],0,0,0), C0,12); \
    KRD(GL,2); GAPB(o[0]=__builtin_amdgcn_mfma_f32_32x32x16_bf16(PAF(2),VFR(2),o[0],0,0,0), C1,0); \
    KRD(GL,3); GAPB(o[1]=__builtin_amdgcn_mfma_f32_32x32x16_bf16(PAF(2),VFR(6),o[1],0,0,0), C1,4); \
    GAPB(o[0]=__builtin_amdgcn_mfma_f32_32x32x16_bf16(PAF(3),VFR(3),o[0],0,0,0), C1,8); \
    GAPB(o[1]=__builtin_amdgcn_mfma_f32_32x32x16_bf16(PAF(3),VFR(7),o[1],0,0,0), C1,12); \
    }while(0)
  int t=1;
  #undef CMASK
  #define CMASK(P0,P1,t) do{}while(0)
  for(;t+5<NT;t+=2){
    STEP(pB0,pB1,pA0,pA1,t,true,true,true);     WAIT_BAR(2); RESC(); ROT();
    STEP(pA0,pA1,pB0,pB1,t+1,true,true,true);   WAIT_BAR(2); RESC(); ROT();
  }
  #undef CMASK
  #define CMASK(P0,P1,t) do{int jb_=(t)-(NT-4); if(jb_>=0)cmask(P0,P1,jb_,qrel,hi);}while(0)
  #define ENDW(tt) do{ if((tt)+3<NT){WAIT_BAR(2);} else if((tt)+2<NT){WAIT_BAR(1);} else {WAIT_BAR(0);} }while(0)
  for(;t+1<NT;t+=2){
    STEP(pB0,pB1,pA0,pA1,t,(t+3<NT),(t+1<NT),(t+1<NT));       ENDW(t);   RESC(); ROT();
    STEP(pA0,pA1,pB0,pB1,t+1,(t+4<NT),(t+2<NT),(t+2<NT));     ENDW(t+1); RESC(); ROT();
  }
  STEP(pB0,pB1,pA0,pA1,NT-1,false,false,false); RESC();
  { float sacc=pB0[0]+pB0[1]; _Pragma("unroll") for(int r=2;r<16;++r)sacc+=pB0[r]; _Pragma("unroll") for(int r=0;r<16;++r)sacc+=pB1[r]; l_reg+=sacc;
    pw0=(u32x4){PKW(pB0,0),PKW(pB0,2),PKW(pB0,4),PKW(pB0,6)};pw1=(u32x4){PKW(pB0,8),PKW(pB0,10),PKW(pB0,12),PKW(pB0,14)};pw2=(u32x4){PKW(pB1,0),PKW(pB1,2),PKW(pB1,4),PKW(pB1,6)};pw3=(u32x4){PKW(pB1,8),PKW(pB1,10),PKW(pB1,12),PKW(pB1,14)};
    SBAR(); pv(o,vb0+sl_cur,PAF(0),PAF(1),PAF(2),PAF(3)); }
  #undef PKW
  #undef PAF
  #undef VFR
  #undef PIN
  #undef MX3
  #undef GAPA
  #undef GAPB
  #undef EX
  #undef VRD
  #undef KRD
  #undef STEP
  #undef ENDW
  {auto rr=__builtin_amdgcn_permlane32_swap(__float_as_uint(l_reg),__float_as_uint(l_reg),false,false);l_reg=__uint_as_float(rr[0])+__uint_as_float(rr[1]);}
  if(hi==0)wsf[32+r32]=l_reg;asm volatile("s_waitcnt lgkmcnt(0)":::"memory");
  float rli[16];
  #pragma unroll
  for(int r=0;r<16;++r)rli[r]=__builtin_amdgcn_rcpf(wsf[32+crow(r,hi)]);
  bf16*Ow=O+(rowbase+q0+wid*QBLK)*PO;
  { bf16*stg=(bf16*)(shm+LDS_OST)+wid*2048;
    #pragma unroll
    for(int r=0;r<16;++r){const int orow=crow(r,hi);
      #pragma unroll
      for(int d0=0;d0<2;++d0)stg[orow*64+d0*32+r32]=__float2bfloat16(o[d0][r]*rli[r]);}
    asm volatile("s_waitcnt lgkmcnt(0)":::"memory");
    #pragma unroll
    for(int i=0;i<4;++i){const int row=i*8+(lane>>3),ch=lane&7; const u32x4 v=*(const u32x4*)(stg+row*64+ch*8); ATTN_STORE16(Ow+(long)row*PO+ch*8,v);} }
  asm volatile("s_waitcnt lgkmcnt(0)\n\ts_barrier":::"memory");
  #undef DMA_K
  #undef DMA_V
  #undef CMASK
  #undef START
  #undef RESC
  #undef ROT
}
#undef SBAR
#undef WAIT_BAR
}
namespace cg = cooperative_groups;
#define LAS __attribute__((address_space(3)))
typedef unsigned short bf16;
typedef unsigned v4u __attribute__((ext_vector_type(4)));
typedef unsigned v2u __attribute__((ext_vector_type(2)));
typedef float f32x4 __attribute__((ext_vector_type(4)));
typedef float f32x2 __attribute__((ext_vector_type(2)));
typedef float f32x16 __attribute__((ext_vector_type(16)));
typedef short bf16x8 __attribute__((ext_vector_type(8)));

constexpr int NWAVES = 8;
constexpr int D = 1024, MP = 16384, MS = 256, M = MP + MS, FF = 2816, DIN = 2560;
constexpr float EPS = 1e-6f;
constexpr float C2 = 0.125f * 1.4426950408889634f;
constexpr size_t OFF_Y = 0, OFF_KP = 17039360, OFF_VP = 33816576, OFF_PP = 50593792, OFF_CP = 50655232, OFF_KS = 50663424, OFF_VS = 50925568, OFF_PS = 51187712, OFF_CS = 51249152, OUT_TOTAL = 51257344;
constexpr size_t MiB = 1u << 20;
constexpr size_t WS_ROPE = 1 * MiB, WS_POOLWT = 2 * MiB, WS_W = 4 * MiB, WL = 40 * MiB;
constexpr size_t W_GU1 = 0, W_D1 = 11 * MiB, W_IN = 16 * MiB + MiB / 2, W_OUT = 21 * MiB + MiB / 2, W_GU2 = 23 * MiB + MiB / 2, W_D2 = 34 * MiB + MiB / 2;
constexpr size_t WS_X = 84 * MiB, WS_H = 149 * MiB, WS_MIX = 182 * MiB, WS_ACT = 215 * MiB;
constexpr size_t WS_QB = 215 * MiB, WS_KB = 232 * MiB, WS_VB = 249 * MiB, WS_ZB = 266 * MiB;
constexpr size_t WS_OB = 305 * MiB, WS_OPART = 338 * MiB, WS_ML = 347 * MiB, WS_END = 352 * MiB;
static_assert(WS_ROPE == pg8::WOFF_ROPE && WS_QB == pg8::WOFF_QB && WS_KB == pg8::WOFF_KB && WS_VB == pg8::WOFF_VB && WS_ZB == pg8::WOFF_ZB && OFF_KP == pg8::OOFF_KP && OFF_VP == pg8::OOFF_VP && OFF_PP == pg8::OOFF_PP && OFF_KS == pg8::OOFF_KS && OFF_VS == pg8::OOFF_VS && OFF_PS == pg8::OOFF_PS, "offsets");
static_assert(WS_ACT + (size_t)M * FF * 2 <= WS_OB && WS_ZB + (size_t)M * 1024 * 2 <= WS_OB && WS_X + (size_t)M * D * 4 <= WS_H && WS_H + (size_t)M * D * 2 <= WS_MIX && WS_MIX + (size_t)M * D * 2 <= WS_ACT, "ws map");
static_assert(WS_OB + (size_t)M * 1024 * 2 <= WS_OPART && WS_OPART + (size_t)32 * 2 * 9 * 32 * 128 * 4 <= WS_ML && WS_ML + (size_t)32 * 2 * 9 * 32 * 2 * 4 <= WS_END, "ws map 2");
constexpr int LDS_BYTES = 147456;
constexpr size_t CTL_BYTES = 262144, CTL_CNT = 65536;
constexpr size_t WS_SLOTP = 350 * MiB, WS_SLOTS = 351 * MiB;

__device__ __forceinline__ unsigned pk2(float lo, float hi) { f32x2 v = {lo, hi}; typedef __bf16 b2 __attribute__((ext_vector_type(2))); b2 b = __builtin_convertvector(v, b2); return __builtin_bit_cast(unsigned, b); }
__device__ __forceinline__ float bf2f(unsigned short b) { return __builtin_bit_cast(float, (unsigned)b << 16); }
__device__ __forceinline__ bf16x8 pack8(f32x4 a, f32x4 b) { v4u w; w.x = pk2(a.x, a.y); w.y = pk2(a.z, a.w); w.z = pk2(b.x, b.y); w.w = pk2(b.z, b.w); return __builtin_bit_cast(bf16x8, w); }
__device__ __forceinline__ int crow(int r, int hi) { return (r & 3) + 8 * (r >> 2) + 4 * hi; }
__device__ __forceinline__ void xhalf_pair(float m, float& a, float& b) { a = m; b = m; asm volatile("s_nop 1\n\tv_permlane32_swap_b32 %0, %1\n\ts_nop 1" : "+v"(a), "+v"(b)); }
__device__ __forceinline__ float xhalf_max(float m) { float a, b; xhalf_pair(m, a, b); return fmaxf(a, b); }
__device__ __forceinline__ float xhalf_sum(float m) { float a, b; xhalf_pair(m, a, b); return a + b; }
template <int O> __device__ __forceinline__ float swz_xor(float v) { return __builtin_bit_cast(float, __builtin_amdgcn_ds_swizzle(__builtin_bit_cast(int, v), (O << 10) | 0x1f)); }
__device__ __forceinline__ float wave_sum(float v) {
    v += swz_xor<1>(v); v += swz_xor<2>(v); v += swz_xor<4>(v); v += swz_xor<8>(v); v += swz_xor<16>(v);
    return xhalf_sum(v);
}
#define LDS_WAIT() asm volatile("s_waitcnt lgkmcnt(0)" ::: "memory")

struct Params { const float* in[26]; float* out; unsigned char* ws; };
typedef const __attribute__((address_space(4))) unsigned char* karg_ptr;
__device__ __forceinline__ karg_ptr kargs() { karg_ptr k = (karg_ptr)__builtin_amdgcn_kernarg_segment_ptr(); asm volatile("" : "+s"(k)); return k; }
__device__ __forceinline__ const float* KIN(int i) { return *(const float* const __attribute__((address_space(4)))*)(kargs() + 8 * i); }
__device__ __forceinline__ float* KOUT() { return *(float* const __attribute__((address_space(4)))*)(kargs() + 8 * 26); }
__device__ __forceinline__ unsigned char* KWS() { return *(unsigned char* const __attribute__((address_space(4)))*)(kargs() + 8 * 27); }

template <int MODE> __device__ __forceinline__ int wmap(int nl, int row_off) {
    if (MODE == 0) return row_off + nl;
    if (MODE == 1) return (nl >> 7) * 256 + (nl & 127) + row_off;
    const int u = nl >> 8, lc = nl & 255, hc = lc >> 6, bjx = (lc >> 5) & 1, fqx = (lc >> 3) & 3, n = (lc >> 2) & 1, j = lc & 3;
    return u * 256 + 128 * bjx + 32 * hc + 16 * n + 4 * fqx + j;
}
template <int MODE> __device__ __forceinline__ void transpose_item(const float* W, int K, int N, bf16* WT, int row_off, LAS float* scr, int item, int lane) {
    const int nblk = N / 32, kb = item / nblk, nb = item % nblk, k0 = 64 * kb, n0 = 32 * nb;
#pragma unroll 8
    for (int i = 0; i < 32; ++i) { const int kk = 2 * i + (lane >> 5); scr[kk * 33 + (lane & 31)] = W[(size_t)(k0 + kk) * N + n0 + (lane & 31)]; }
    LDS_WAIT(); asm volatile("" ::: "memory");
    const int c = lane & 7;
#pragma unroll
    for (int j = 0; j < 4; ++j) { const int n = (lane >> 3) + 8 * j; const LAS float* s = scr + (8 * c) * 33 + n;
        v4u o; o.x = pk2(s[0 * 33], s[1 * 33]); o.y = pk2(s[2 * 33], s[3 * 33]); o.z = pk2(s[4 * 33], s[5 * 33]); o.w = pk2(s[6 * 33], s[7 * 33]);
        *(v4u*)(WT + (size_t)wmap<MODE>(n0 + n, row_off) * K + k0 + 8 * c) = o; }
    LDS_WAIT(); asm volatile("" ::: "memory");
}
__device__ __forceinline__ void prologue(LAS unsigned char* lds, int gw, int NGW, int wave, int lane) {
    LAS float* scr = (LAS float*)(lds + wave * 16384);
    constexpr int I_F = 16 * 88, I_IN = 16 * 80, I_OUT = 16 * 32, I_L = 6 * I_F + I_IN + I_OUT;
    for (int it = gw; it < 2 * I_L; it += NGW) {
        const int l = it / I_L; int r = it % I_L;
        unsigned char* wl = KWS() + WS_W + (size_t)l * WL;
        if (r < I_F) { transpose_item<1>(KIN(7) + (size_t)l * D * FF, D, FF, (bf16*)(wl + W_GU1), 0, scr, r, lane); continue; } r -= I_F;
        if (r < I_F) { transpose_item<1>(KIN(8) + (size_t)l * D * FF, D, FF, (bf16*)(wl + W_GU1), 128, scr, r, lane); continue; } r -= I_F;
        if (r < I_F) { transpose_item<0>(KIN(9) + (size_t)l * D * FF, FF, D, (bf16*)(wl + W_D1), 0, scr, r, lane); continue; } r -= I_F;
        if (r < I_IN) { transpose_item<2>(KIN(11) + (size_t)l * D * DIN, D, DIN, (bf16*)(wl + W_IN), 0, scr, r, lane); continue; } r -= I_IN;
        if (r < I_OUT) { transpose_item<0>(KIN(20) + (size_t)l * D * D, D, D, (bf16*)(wl + W_OUT), 0, scr, r, lane); continue; } r -= I_OUT;
        if (r < I_F) { transpose_item<1>(KIN(22) + (size_t)l * D * FF, D, FF, (bf16*)(wl + W_GU2), 0, scr, r, lane); continue; } r -= I_F;
        if (r < I_F) { transpose_item<1>(KIN(23) + (size_t)l * D * FF, D, FF, (bf16*)(wl + W_GU2), 128, scr, r, lane); continue; } r -= I_F;
        transpose_item<0>(KIN(24) + (size_t)l * D * FF, FF, D, (bf16*)(wl + W_D2), 0, scr, r, lane);
    }
    float* rope = (float*)(KWS() + WS_ROPE);
    for (int i = gw * 64 + lane; i < 2080 * 32; i += NGW * 64) {
        const int pr = i >> 5, d = i & 31; const int pos = pr < 2048 ? pr : 4096 + (pr - 2048);
        const float inv = exp2f(-(float)d * (13.287712379549449f / 32.0f));
        const float ang = (float)pos * inv;
        const double rev = (double)ang * 0.15915494309189535; const float fr = (float)(rev - __builtin_rint(rev));
        rope[pr * 64 + d] = __builtin_amdgcn_cosf(fr); rope[pr * 64 + 32 + d] = __builtin_amdgcn_sinf(fr);
    }
    bf16* pwt_ = (bf16*)(KWS() + WS_POOLWT);
    for (int i = gw * 64 + lane; i < 2 * 4 * 64 * 64; i += NGW * 64) {
        const int c = i & 63, e = (i >> 6) & 63, lg = i >> 12;
        pwt_[i] = (bf16)(pk2(KIN(17)[(size_t)lg * 4096 + c * 64 + e], 0.f) & 0xffffu);
    }
}
template <bool FINAL> __device__ __forceinline__ void norm_rows(const float* srcP, const float* srcS, const float* g, bf16* H, float* outf, int gw, int NGW, int lane) {
    const f32x4* g4 = (const f32x4*)g + lane;
    f32x4 gv[4];
#pragma unroll
    for (int j = 0; j < 4; ++j) gv[j] = g4[64 * j];
    for (int m = gw; m < M; m += NGW) {
        const float* xr = (m < MP) ? srcP + (size_t)m * D : srcS + (size_t)(m - MP) * D;
        const f32x4* x4 = (const f32x4*)xr + lane;
        f32x4 v[4]; float s = 0.f;
#pragma unroll
        for (int j = 0; j < 4; ++j) { v[j] = x4[64 * j]; s += (v[j].x * v[j].x + v[j].y * v[j].y) + (v[j].z * v[j].z + v[j].w * v[j].w); }
        const float rstd = 1.0f / sqrtf(wave_sum(s) * (1.0f / D) + EPS);
        if (FINAL) {
            f32x4* o4 = (f32x4*)(outf + (size_t)m * D) + lane;
#pragma unroll
            for (int j = 0; j < 4; ++j) o4[64 * j] = v[j] * rstd * gv[j];
        } else {
            v2u* o2 = (v2u*)(H + (size_t)m * D) + lane;
#pragma unroll
            for (int j = 0; j < 4; ++j) { const f32x4 y = v[j] * rstd * gv[j]; v2u w; w.x = pk2(y.x, y.y); w.y = pk2(y.z, y.w); o2[64 * j] = w; }
        }
    }
}
__device__ __forceinline__ f32x16 mfma32(bf16x8 a, bf16x8 b, f32x16 c) { return __builtin_amdgcn_mfma_f32_32x32x16_bf16(a, b, c, 0, 0, 0); }


template <bool BASE16, int K> __device__ __forceinline__ void skinny_part1(LAS unsigned char* lds, const bf16* A, const bf16* Bt, const void* base, bf16* out, float scale,
                                            unsigned* slots, unsigned* cnt8, int tile, int tid) {
    const int lane = tid & 63, r32 = lane & 31, hi = lane >> 5, wid = __builtin_amdgcn_readfirstlane(tid >> 6);
    LAS float* R = (LAS float*)lds;
    LAS float* PARK = (LAS float*)(lds + 131072);
    const int rt = tile >> 5, ct = tile & 31, kw = K >> 3, k0 = wid * kw;
    const int e = tid * 2, row = e >> 5, col = e & 31;
    const size_t o = (size_t)(rt * 32 + row) * 1024 + ct * 32 + col;
    f32x2 bv; if (BASE16) { const unsigned bw = *(const unsigned*)((const bf16*)base + o); bv.x = bf2f(bw & 0xffff); bv.y = bf2f(bw >> 16); } else bv = *(const f32x2*)((const float*)base + o);
    const bf16* ap = A + (size_t)(rt * 32 + r32) * K + wid * 16 + hi * 8; const bf16* bp = Bt + (size_t)(ct * 32 + r32) * K + wid * 16 + hi * 8; (void)k0;
    f32x16 acc;
#pragma unroll
    for (int r = 0; r < 16; ++r) acc[r] = 0.f;
    constexpr int NST = K / 128, UB = (NST % 11 == 0) ? 11 : 8;
#pragma unroll 1
    for (int s0 = 0; s0 < NST; s0 += UB) { bf16x8 av[UB], bw[UB];
#pragma unroll
        for (int j = 0; j < UB; ++j) { av[j] = *(const bf16x8*)(ap + (s0 + j) * 128); bw[j] = *(const bf16x8*)(bp + (s0 + j) * 128); }
#pragma unroll
        for (int j = 0; j < UB; ++j) acc = mfma32(av[j], bw[j], acc); }
    __syncthreads();
#pragma unroll
    for (int r = 0; r < 16; ++r) R[(wid * 32 + crow(r, hi)) * 32 + r32] = acc[r];
    __syncthreads();
    f32x2 s = {0.f, 0.f};
#pragma unroll
    for (int w = 0; w < 8; ++w) s += *(const LAS f32x2*)(R + (w * 32 + row) * 32 + col);
    const f32x2 v = bv + s * scale;
    float ss = v.x * v.x + v.y * v.y; ss += swz_xor<1>(ss); ss += swz_xor<2>(ss); ss += swz_xor<4>(ss); ss += swz_xor<8>(ss);
    if ((tid & 15) == 0) __hip_atomic_store(slots + (size_t)(rt * 32 + row) * 32 + ct, __builtin_bit_cast(unsigned, ss), __ATOMIC_RELAXED, __HIP_MEMORY_SCOPE_AGENT);
    *(LAS f32x2*)(PARK + tid * 2) = v;
    asm volatile("s_waitcnt vmcnt(0)" ::: "memory");
    __syncthreads();
    if (tid == 0) __hip_atomic_fetch_add(cnt8 + 64 * rt, 1u, __ATOMIC_RELAXED, __HIP_MEMORY_SCOPE_AGENT);
    if (out) *(unsigned*)(out + o) = pk2(v.x, v.y);
    __syncthreads();
}
__device__ __forceinline__ void skinny_part2(LAS unsigned char* lds, bf16* hb, float* yout, const float* gain, unsigned* slots, unsigned* cnt8, int tile, int tid) {
    LAS float* PARK = (LAS float*)(lds + 131072);
    const int rt = tile >> 5, ct = tile & 31, e = tid * 2, row = e >> 5, col = e & 31;
    const size_t o = (size_t)(rt * 32 + row) * 1024 + ct * 32 + col;
    if (tid == 0) {
        unsigned spins = 0;
        while (__hip_atomic_load(cnt8 + 64 * rt, __ATOMIC_RELAXED, __HIP_MEMORY_SCOPE_AGENT) < 32u) { __builtin_amdgcn_s_sleep(2); if (++spins > (1u << 22)) break; }
        __builtin_amdgcn_fence(__ATOMIC_ACQUIRE, "agent");
        asm volatile("s_waitcnt vmcnt(0)" ::: "memory");
    }
    __syncthreads();
    const unsigned* sl = slots + (size_t)(rt * 32 + row) * 32 + (tid & 15) * 2;
    float tot = __builtin_bit_cast(float, __hip_atomic_load(sl, __ATOMIC_RELAXED, __HIP_MEMORY_SCOPE_AGENT)) + __builtin_bit_cast(float, __hip_atomic_load(sl + 1, __ATOMIC_RELAXED, __HIP_MEMORY_SCOPE_AGENT));
    tot += swz_xor<1>(tot); tot += swz_xor<2>(tot); tot += swz_xor<4>(tot); tot += swz_xor<8>(tot);
    const float r = 1.0f / sqrtf(tot * (1.0f / 1024.0f) + EPS);
    const f32x2 v = *(const LAS f32x2*)(PARK + tid * 2);
    const f32x2 gv = *(const f32x2*)(gain + ct * 32 + col); const f32x2 y = v * r * gv;
    if (hb) *(unsigned*)(hb + o) = pk2(y.x, y.y); else *(f32x2*)(yout + o) = y;
    __syncthreads();
}

__device__ __forceinline__ void sample_piece(LAS unsigned char* lds, int pc, int l, const bf16* Qb, const float* cache_k, const float* cache_v, const float* knew, const float* vnew, float* OPART, float* MLP, int tid) {
    const int lane = tid & 63, r32 = lane & 31, hi = lane >> 5, wid = __builtin_amdgcn_readfirstlane(tid >> 6);
    const int b = pc >> 5, h = (pc >> 3) & 3, s = pc & 7;
    const bf16* qrow = Qb + (size_t)(MP + b * 32 + r32) * 512 + h * 128 + hi * 8;
    LAS float* ML = (LAS float*)lds;
    LAS float* FAC = (LAS float*)(lds + 4096);
    LAS float* OX = (LAS float*)(lds + 8192);
    const bool extra = (s == 7) && (wid == 7);
    const size_t off = ((size_t)((l * 8 + b) * 4096 + (s * 8 + wid) * 64)) * 512 + h * 128;
    const size_t offx = ((size_t)(l * 8 + b) * 32) * 512 + h * 128;
    const float* Kt = cache_k + off; const float* Vt = cache_v + off; const float* Kx = knew + offx; const float* Vx = vnew + offx;
    float mrow[2], lrow[2]; bf16x8 pw[2][6];
#pragma unroll
    for (int c = 0; c < 2; ++c) {
        bf16x8 qf[4];
#pragma unroll
        for (int d0 = 0; d0 < 4; ++d0) qf[d0] = *(const bf16x8*)(qrow + c * 64 + d0 * 16);
        f32x16 sc[3];
#pragma unroll
        for (int kvb = 0; kvb < 3; ++kvb) {
            if (kvb < 2 || extra) {
                f32x16 a;
#pragma unroll
                for (int r = 0; r < 16; ++r) a[r] = 0.f;
                const float* kp = (kvb < 2 ? Kt + (size_t)(kvb * 32 + r32) * 512 : Kx + (size_t)r32 * 512) + c * 64 + hi * 8;
#pragma unroll
                for (int d0 = 0; d0 < 4; ++d0) { const f32x4 x0 = *(const f32x4*)(kp + d0 * 16), x1 = *(const f32x4*)(kp + d0 * 16 + 4); a = mfma32(pack8(x0, x1), qf[d0], a); }
                sc[kvb] = a;
            } else {
#pragma unroll
                for (int r = 0; r < 16; ++r) sc[kvb][r] = -1e30f;
            }
        }
        float mx = -1e30f;
#pragma unroll
        for (int r = 0; r < 16; ++r) mx = fmaxf(mx, fmaxf(fmaxf(sc[0][r], sc[1][r]), sc[2][r]));
        mx = xhalf_max(mx);
        float sum = 0.f;
#pragma unroll
        for (int kvb = 0; kvb < 3; ++kvb)
#pragma unroll
            for (int r = 0; r < 16; ++r) { const float pv = __builtin_amdgcn_exp2f(sc[kvb][r] - mx); sc[kvb][r] = pv; sum += pv; }
        sum = xhalf_sum(sum);
        mrow[c] = mx; lrow[c] = sum;
#pragma unroll
        for (int kvb = 0; kvb < 3; ++kvb)
#pragma unroll
            for (int hf = 0; hf < 2; ++hf) { v4u w; w.x = pk2(sc[kvb][8 * hf + 0], sc[kvb][8 * hf + 1]); w.y = pk2(sc[kvb][8 * hf + 2], sc[kvb][8 * hf + 3]);
                w.z = pk2(sc[kvb][8 * hf + 4], sc[kvb][8 * hf + 5]); w.w = pk2(sc[kvb][8 * hf + 6], sc[kvb][8 * hf + 7]); pw[c][2 * kvb + hf] = __builtin_bit_cast(bf16x8, w); }
    }
    asm volatile("" ::: "memory");
    f32x16 o[2][4];
#pragma unroll
    for (int c = 0; c < 2; ++c)
#pragma unroll
        for (int eb = 0; eb < 4; ++eb)
#pragma unroll
            for (int r = 0; r < 16; ++r) o[c][eb][r] = 0.f;
#pragma unroll
    for (int ks = 0; ks < 6; ++ks) {
        if (ks < 4 || extra) {
#pragma unroll
            for (int eb = 0; eb < 4; ++eb) {
                const float* vp = (ks < 4 ? Vt + (size_t)(ks * 16 + 4 * hi) * 512 : Vx + (size_t)((ks - 4) * 16 + 4 * hi) * 512) + eb * 32 + r32;
                f32x4 x0, x1;
                x0.x = vp[0 * 512]; x0.y = vp[1 * 512]; x0.z = vp[2 * 512]; x0.w = vp[3 * 512];
                x1.x = vp[8 * 512]; x1.y = vp[9 * 512]; x1.z = vp[10 * 512]; x1.w = vp[11 * 512];
                const bf16x8 vf = pack8(x0, x1);
                o[0][eb] = mfma32(pw[0][ks], vf, o[0][eb]); o[1][eb] = mfma32(pw[1][ks], vf, o[1][eb]);
            }
        }
    }
    if (hi == 0) {
#pragma unroll
        for (int c = 0; c < 2; ++c) { ML[((wid * 2 + c) * 32 + r32) * 2 + 0] = mrow[c]; ML[((wid * 2 + c) * 32 + r32) * 2 + 1] = lrow[c]; }
    }
    __syncthreads();
    const int pidx = s;
    if (tid < 64) {
        const int c = tid >> 5, q = tid & 31; float mw[8], lw[8]; float Mx = -1e30f;
#pragma unroll
        for (int w = 0; w < 8; ++w) { mw[w] = ML[((w * 2 + c) * 32 + q) * 2 + 0]; lw[w] = ML[((w * 2 + c) * 32 + q) * 2 + 1]; Mx = fmaxf(Mx, mw[w]); }
        float L = 0.f;
#pragma unroll
        for (int w = 0; w < 8; ++w) { const float fz = __builtin_amdgcn_exp2f(mw[w] - Mx); FAC[(w * 2 + c) * 32 + q] = fz; L += lw[w] * fz; }
        float* mp = MLP + ((size_t)((((b * 4 + h) * 2 + c) * 9 + pidx) * 32 + q)) * 2; mp[0] = Mx; mp[1] = L;
    }
    __syncthreads();
#pragma unroll
    for (int c = 0; c < 2; ++c) {
#pragma unroll
        for (int eb = 0; eb < 4; ++eb)
#pragma unroll
            for (int r = 0; r < 16; ++r) { const int q = crow(r, hi); OX[(wid * 32 + q) * 128 + eb * 32 + r32] = o[c][eb][r] * FAC[(wid * 2 + c) * 32 + q]; }
        __syncthreads();
        { const int idx = tid * 8, q = idx >> 7, e = idx & 127; f32x4 s0 = {0.f, 0.f, 0.f, 0.f}, s1 = {0.f, 0.f, 0.f, 0.f};
#pragma unroll
          for (int w = 0; w < 8; ++w) { s0 += *(const LAS f32x4*)(OX + (w * 32 + q) * 128 + e); s1 += *(const LAS f32x4*)(OX + (w * 32 + q) * 128 + e + 4); }
          float* dst = OPART + ((size_t)((((b * 4 + h) * 2 + c) * 9 + pidx) * 32 + q)) * 128 + e; *(f32x4*)dst = s0; *(f32x4*)(dst + 4) = s1; }
        __syncthreads();
    }
}

template <int W> __device__ __forceinline__ void pool_d(const LAS float* U, LAS bf16* Dd, int ch, int tbeg, int t0, bool smp) {
    float s = 0.f;
#pragma unroll
    for (int i = 0; i < W; ++i) s += U[(15 + tbeg - i) * 256 + ch];
#pragma unroll 8
    for (int k = 0; k < 32; ++k) {
        const int tt = tbeg + k; const float cur = U[(15 + tt) * 256 + ch];
        if (k > 0) s += cur - U[(15 + tt - W) * 256 + ch];
        const int pos = smp ? 4096 + tt : t0 + tt; const int cnt = (pos + 1 < W) ? pos + 1 : W;
        const float d = s * __builtin_amdgcn_rcpf((float)cnt) - cur;
        Dd[tt * 264 + ch] = (bf16)(pk2(d, 0.f) & 0xffffu);
    }
}
__device__ __forceinline__ f32x4 bf4_to_f32(v2u w) { f32x4 v; v.x = bf2f(w.x & 0xffff); v.y = bf2f(w.x >> 16); v.z = bf2f(w.y & 0xffff); v.w = bf2f(w.y >> 16); return v; }
__device__ __forceinline__ void poolconv_tile(LAS unsigned char* lds, int tl, int l, const bf16* Zb, bf16* MIX, const float* state_pool, const float* state_conv, const bf16* pwt, const float* pool_scale,
                                              const float* conv_w, float* out_cp, float* out_cs, int tid) {
    const int lane = tid & 63, r32 = lane & 31, hi = lane >> 5, wid = __builtin_amdgcn_readfirstlane(tid >> 6);
    int b, t0, TT, rowbase; bool smp;
    if (tl < 256) { b = tl >> 5; t0 = (tl & 31) * 64; TT = 64; rowbase = b * 2048 + t0; smp = false; }
    else { b = tl - 256; t0 = 0; TT = 32; rowbase = MP + b * 32; smp = true; }
    LAS float* U = (LAS float*)lds;
    LAS bf16* Dd = (LAS bf16*)(lds + 81920);
    {
        f32x4 uv[10];
#pragma unroll
        for (int k = 0; k < 10; ++k) {
            const int idx = tid + 512 * k, i = idx >> 6, c4 = (idx & 63) * 4; f32x4 v = {0.f, 0.f, 0.f, 0.f};
            if (i < 15 + TT) {
                if (i < 15 && smp) v = *(const f32x4*)(state_pool + (size_t)((l * 8 + b) * 15 + i) * 256 + c4);
                else if (i >= 15 || t0 - 15 + i >= 0) v = bf4_to_f32(*(const v2u*)(Zb + (size_t)(rowbase + i - 15) * 1024 + c4));
            }
            uv[k] = v;
        }
#pragma unroll
        for (int k = 0; k < 10; ++k) { const int idx = tid + 512 * k, i = idx >> 6, c4 = (idx & 63) * 4; if (i < 15 + TT) *(LAS f32x4*)(U + i * 256 + c4) = uv[k]; }
    }
    __syncthreads();
    {
        const int ch = tid & 255, th = tid >> 8, gi = __builtin_amdgcn_readfirstlane(ch >> 6);
        if (th * 32 < TT) {
            if (gi == 0) pool_d<2>(U, Dd, ch, th * 32, t0, smp); else if (gi == 1) pool_d<4>(U, Dd, ch, th * 32, t0, smp);
            else if (gi == 2) pool_d<8>(U, Dd, ch, th * 32, t0, smp); else pool_d<16>(U, Dd, ch, th * 32, t0, smp);
        }
    }
    __syncthreads();
    {
        const int gi = wid >> 1, th = wid & 1;
        if (th * 32 < TT) {
            f32x16 acc0, acc1;
#pragma unroll
            for (int r = 0; r < 16; ++r) { acc0[r] = 0.f; acc1[r] = 0.f; }
#pragma unroll
            for (int ks = 0; ks < 4; ++ks) {
                const bf16x8 a = *(const LAS bf16x8*)(Dd + (th * 32 + r32) * 264 + gi * 64 + ks * 16 + hi * 8);
                const bf16x8 b0 = *(const bf16x8*)(pwt + (size_t)((l * 4 + gi) * 64 + r32) * 64 + ks * 16 + hi * 8);
                const bf16x8 b1 = *(const bf16x8*)(pwt + (size_t)((l * 4 + gi) * 64 + 32 + r32) * 64 + ks * 16 + hi * 8);
                acc0 = mfma32(a, b0, acc0); acc1 = mfma32(a, b1, acc1);
            }
            const float sc0 = pool_scale[l * 256 + gi * 64 + r32], sc1 = pool_scale[l * 256 + gi * 64 + 32 + r32];
#pragma unroll
            for (int r = 0; r < 16; ++r) { const int tok = th * 32 + crow(r, hi); bf16* mp = MIX + (size_t)(rowbase + tok) * 1024 + 512 + gi * 64 + r32;
                mp[0] = (bf16)(pk2(acc0[r] * sc0, 0.f) & 0xffffu); mp[32] = (bf16)(pk2(acc1[r] * sc1, 0.f) & 0xffffu); }
        }
    }
    if (wid * 8 < TT) {
        const int cq = lane, tc = wid * 8;
        v2u hraw[10], graw[10], braw[8]; f32x4 hst[2];
        hst[0] = (f32x4){0.f, 0.f, 0.f, 0.f}; hst[1] = hst[0];
#pragma unroll
        for (int i = 0; i < 10; ++i) {
            const int ts = tc - 2 + i; hraw[i] = (v2u){0u, 0u}; graw[i] = (v2u){0u, 0u};
            if (ts >= 0 || (!smp && t0 + ts >= 0)) { const bf16* zr = Zb + (size_t)(rowbase + ts) * 1024 + 4 * cq; hraw[i] = *(const v2u*)(zr + 256); graw[i] = *(const v2u*)(zr + 768); }
        }
#pragma unroll
        for (int i = 0; i < 8; ++i) braw[i] = *(const v2u*)(Zb + (size_t)(rowbase + tc + i) * 1024 + 512 + 4 * cq);
        if (smp && tc == 0) { hst[0] = *(const f32x4*)(state_conv + (size_t)((l * 8 + b) * 2 + 0) * 256 + 4 * cq); hst[1] = *(const f32x4*)(state_conv + (size_t)((l * 8 + b) * 2 + 1) * 256 + 4 * cq); }
        const f32x4 cw0 = *(const f32x4*)(conv_w + l * 768 + 4 * cq), cw1 = *(const f32x4*)(conv_w + l * 768 + 256 + 4 * cq), cw2 = *(const f32x4*)(conv_w + l * 768 + 512 + 4 * cq);
        f32x4 cm2 = bf4_to_f32(graw[0]) * bf4_to_f32(hraw[0]), cm1 = bf4_to_f32(graw[1]) * bf4_to_f32(hraw[1]);
        if (smp && tc == 0) { cm2 = hst[0]; cm1 = hst[1]; }
#pragma unroll
        for (int i = 0; i < 8; ++i) {
            const int tt = tc + i;
            const f32x4 cv = bf4_to_f32(graw[i + 2]) * bf4_to_f32(hraw[i + 2]);
            const f32x4 y = bf4_to_f32(braw[i]) * (cw0 * cm2 + cw1 * cm1 + cw2 * cv);
            v2u w; w.x = pk2(y.x, y.y); w.y = pk2(y.z, y.w);
            *(v2u*)(MIX + (size_t)(rowbase + tt) * 1024 + 768 + 4 * cq) = w;
            if (smp) { if (tt >= 30) *(f32x4*)(out_cs + (size_t)((l * 8 + b) * 2 + tt - 30) * 256 + 4 * cq) = cv; }
            else if (t0 + tt >= 2046) *(f32x4*)(out_cp + (size_t)((l * 8 + b) * 2 + t0 + tt - 2046) * 256 + 4 * cq) = cv;
            cm2 = cm1; cm1 = cv;
        }
    }
    __syncthreads();
}

__device__ __forceinline__ void combine_phase(int l, const bf16* Ob_, const float* OPART_, const float* MLP_, bf16* MIX_, int gw, int NGW, int lane) {
    const float lam_init = (l == 0) ? 0.2f : 0.35550934f;
    float lam;
    { const float a = KIN(12)[l * 64 + lane] * KIN(13)[l * 64 + lane], c = KIN(14)[l * 64 + lane] * KIN(15)[l * 64 + lane];
      lam = __expf(wave_sum(a)) - __expf(wave_sum(c)) + lam_init; }
    const float g0 = KIN(16)[l * 128 + 2 * lane], g1 = KIN(16)[l * 128 + 2 * lane + 1];
    for (int base = gw * 8; base < MP * 4; base += NGW * 8) {
        float a0[8], a1[8];
        {
            unsigned w1[8], w2[8];
#pragma unroll
            for (int j = 0; j < 8; ++j) { const int wt = base + j, row = wt >> 2, h = wt & 3;
                w1[j] = *(const unsigned*)(Ob_ + (size_t)row * 1024 + h * 128 + 2 * lane); w2[j] = *(const unsigned*)(Ob_ + (size_t)row * 1024 + 512 + h * 128 + 2 * lane); }
#pragma unroll
            for (int j = 0; j < 8; ++j) { a0[j] = bf2f(w1[j] & 0xffff) - lam * bf2f(w2[j] & 0xffff); a1[j] = bf2f(w1[j] >> 16) - lam * bf2f(w2[j] >> 16); }
        }
        float ss[8];
#pragma unroll
        for (int j = 0; j < 8; ++j) ss[j] = a0[j] * a0[j] + a1[j] * a1[j];
#pragma unroll
        for (int j = 0; j < 8; ++j) ss[j] += swz_xor<1>(ss[j]);
#pragma unroll
        for (int j = 0; j < 8; ++j) ss[j] += swz_xor<2>(ss[j]);
#pragma unroll
        for (int j = 0; j < 8; ++j) ss[j] += swz_xor<4>(ss[j]);
#pragma unroll
        for (int j = 0; j < 8; ++j) ss[j] += swz_xor<8>(ss[j]);
#pragma unroll
        for (int j = 0; j < 8; ++j) ss[j] += swz_xor<16>(ss[j]);
#pragma unroll
        for (int j = 0; j < 8; ++j) { const int wt = base + j, row = wt >> 2, h = wt & 3;
            const float tot = xhalf_sum(ss[j]);
            const float r = (1.0f / sqrtf(tot * (1.0f / 128.0f) + EPS)) * (1.0f - lam_init);
            *(unsigned*)(MIX_ + (size_t)row * 1024 + h * 128 + 2 * lane) = pk2(a0[j] * r * g0, a1[j] * r * g1); }
    }
    for (int wt = MP * 4 + gw; wt < M * 4; wt += NGW) {
        const int row = wt >> 2, h = wt & 3, rs = row - MP, b = rs >> 5, q = rs & 31; float oc[2][2];
#pragma unroll
        for (int c = 0; c < 2; ++c) {
            const size_t pb = (size_t)(((b * 4 + h) * 2 + c) * 9);
            float mw[8], lw[8]; f32x2 ov[8]; float Mx = -1e30f;
#pragma unroll
            for (int pi = 0; pi < 8; ++pi) { const f32x2 ml = *(const f32x2*)(MLP_ + ((pb + pi) * 32 + q) * 2); mw[pi] = ml.x; lw[pi] = ml.y; ov[pi] = *(const f32x2*)(OPART_ + ((pb + pi) * 32 + q) * 128 + 2 * lane); }
#pragma unroll
            for (int pi = 0; pi < 8; ++pi) Mx = fmaxf(Mx, mw[pi]);
            float L = 0.f, s0 = 0.f, s1 = 0.f;
#pragma unroll
            for (int pi = 0; pi < 8; ++pi) { const float fz = __builtin_amdgcn_exp2f(mw[pi] - Mx); L += lw[pi] * fz; s0 += ov[pi].x * fz; s1 += ov[pi].y * fz; }
            const float il = 1.0f / L; oc[c][0] = s0 * il; oc[c][1] = s1 * il;
        }
        const float a0 = oc[0][0] - lam * oc[1][0], a1 = oc[0][1] - lam * oc[1][1];
        const float tot = wave_sum(a0 * a0 + a1 * a1);
        const float r = (1.0f / sqrtf(tot * (1.0f / 128.0f) + EPS)) * (1.0f - lam_init);
        *(unsigned*)(MIX_ + (size_t)row * 1024 + h * 128 + 2 * lane) = pk2(a0 * r * g0, a1 * r * g1);
    }
}

#ifndef PROBE_SLOW_ATTN
#define PROBE_SLOW_ATTN 0
#endif
#if PROBE_SLOW_ATTN
__device__ __forceinline__ void slow_attn_phase(int l, const bf16* Qb_, float* outp, const float* cache_k, const float* cache_v, bf16* MIX_, int gw, int NGW, int lane) {
    const float lam_init = (l == 0) ? 0.2f : 0.35550934f;
    float lam;
    { const float a = KIN(12)[l * 64 + lane] * KIN(13)[l * 64 + lane], c = KIN(14)[l * 64 + lane] * KIN(15)[l * 64 + lane];
      lam = __expf(wave_sum(a)) - __expf(wave_sum(c)) + lam_init; }
    const float g0 = KIN(16)[l * 128 + 2 * lane], g1 = KIN(16)[l * 128 + 2 * lane + 1];
    for (int wt = gw; wt < M * 4; wt += NGW) {
        const int row = wt >> 2, h = wt & 3;
        const float *K0, *V0, *K1, *V1; int n0, n1;
        if (row < MP) { const int b = row >> 11, t = row & 2047; K0 = outp + OFF_KP + ((size_t)l * MP + (size_t)b * 2048) * 512 + h * 128; V0 = outp + OFF_VP + ((size_t)l * MP + (size_t)b * 2048) * 512 + h * 128; n0 = ((t >> 6) + 1) * 64; K1 = K0; V1 = V0; n1 = 0; }
        else { const int rs = row - MP, b = rs >> 5; K0 = cache_k + ((size_t)(l * 8 + b) * 4096) * 512 + h * 128; V0 = cache_v + ((size_t)(l * 8 + b) * 4096) * 512 + h * 128; n0 = 4096;
               K1 = outp + OFF_KS + ((size_t)(l * 8 + b) * 32) * 512 + h * 128; V1 = outp + OFF_VS + ((size_t)(l * 8 + b) * 32) * 512 + h * 128; n1 = 32; }
        float oc[2][2];
#pragma unroll 1
        for (int c = 0; c < 2; ++c) {
            float q[64];
#pragma unroll
            for (int d = 0; d < 64; ++d) q[d] = bf2f(Qb_[(size_t)row * 512 + h * 128 + c * 64 + d]);
            float mx = -1e30f;
            for (int seg = 0; seg < 2; ++seg) { const float* Kp = seg ? K1 : K0; const int n = seg ? n1 : n0;
                for (int j0 = 0; j0 < n; j0 += 64) { const int j = j0 + lane; float s = -1e30f;
                    if (j < n) { const float* kr = Kp + (size_t)j * 512 + c * 64; s = 0.f;
#pragma unroll
                        for (int d = 0; d < 64; ++d) s += q[d] * kr[d]; }
                    mx = fmaxf(mx, s); } }
            mx = fmaxf(mx, swz_xor<1>(mx)); mx = fmaxf(mx, swz_xor<2>(mx)); mx = fmaxf(mx, swz_xor<4>(mx)); mx = fmaxf(mx, swz_xor<8>(mx)); mx = fmaxf(mx, swz_xor<16>(mx)); mx = xhalf_max(mx);
            float L = 0.f, o0 = 0.f, o1 = 0.f;
            for (int seg = 0; seg < 2; ++seg) { const float* Kp = seg ? K1 : K0; const float* Vp = seg ? V1 : V0; const int n = seg ? n1 : n0;
                for (int j0 = 0; j0 < n; j0 += 64) { const int j = j0 + lane; float pj = 0.f;
                    if (j < n) { const float* kr = Kp + (size_t)j * 512 + c * 64; float s = 0.f;
#pragma unroll
                        for (int d = 0; d < 64; ++d) s += q[d] * kr[d];
                        pj = __builtin_amdgcn_exp2f(s - mx); }
                    L += pj;
                    const int nn = (n - j0 < 64) ? n - j0 : 64;
                    for (int jj = 0; jj < nn; ++jj) { const float pb = __builtin_bit_cast(float, __builtin_amdgcn_readlane(__builtin_bit_cast(int, pj), jj));
                        const f32x2 vv = *(const f32x2*)(Vp + (size_t)(j0 + jj) * 512 + 2 * lane); o0 += pb * vv.x; o1 += pb * vv.y; } } }
            L = wave_sum(L);
            oc[c][0] = o0 / L; oc[c][1] = o1 / L;
        }
        const float a0 = oc[0][0] - lam * oc[1][0], a1 = oc[0][1] - lam * oc[1][1];
        const float ss = wave_sum(a0 * a0 + a1 * a1);
        const float r = (1.0f / sqrtf(ss * (1.0f / 128.0f) + EPS)) * (1.0f - lam_init);
        *(unsigned*)(MIX_ + (size_t)row * 1024 + h * 128 + 2 * lane) = pk2(a0 * r * g0, a1 * r * g1);
    }
}
#endif

#ifndef PROBE_SLOW_PC
#define PROBE_SLOW_PC 0
#endif
#if PROBE_SLOW_PC
__device__ __forceinline__ float zval(const bf16* Zb_, const float* st, int l, int b, bool smp, int rowbase, int t, int col, int hist) {
    if (t >= 0) return bf2f(Zb_[(size_t)(rowbase + t) * 1024 + col]);
    if (!smp) return 0.f;
    return st[(size_t)((l * 8 + b) * hist + (hist + t)) * 256 + (col & 255)];
}
__device__ __forceinline__ void slow_pc_phase(int l, const bf16* Zb_, bf16* MIX_, int gw, int NGW, int lane) {
    const float* sp = KIN(4); const float* scv = KIN(5); const float* pw = KIN(17); const float* psc = KIN(18); const float* cw = KIN(19);
    for (int wt = gw; wt < M * 4; wt += NGW) {
        const int row = wt >> 2, g = wt & 3; const bool smp = row >= MP;
        int b, t, rowbase; if (smp) { const int rs = row - MP; b = rs >> 5; t = rs & 31; rowbase = MP + b * 32; } else { b = row >> 11; t = row & 2047; rowbase = b * 2048; }
        const int w = 2 << g, ch = g * 64 + lane;
        float s = 0.f;
        for (int i = 0; i < w; ++i) { const int tt = t - i; s += zval(Zb_, sp, l, b, smp, rowbase, tt, ch, 15); }
        const int pos = smp ? 4096 + t : t; const int cnt = (pos + 1 < w) ? pos + 1 : w;
        const float d = s / (float)cnt - zval(Zb_, sp, l, b, smp, rowbase, t, ch, 15);
        float mine = 0.f;
        for (int e = 0; e < 64; ++e) { const float v = wave_sum(d * pw[(size_t)((l * 4 + g) * 64 + lane) * 64 + e]); if (e == lane) mine = v; }
        MIX_[(size_t)row * 1024 + 512 + ch] = (bf16)(pk2(mine * psc[l * 256 + ch], 0.f) & 0xffffu);
        float cvv[3];
#pragma unroll
        for (int k = 0; k < 3; ++k) { const int tt = t - 2 + k;
            if (tt >= 0) cvv[k] = bf2f(Zb_[(size_t)(rowbase + tt) * 1024 + 768 + ch]) * bf2f(Zb_[(size_t)(rowbase + tt) * 1024 + 256 + ch]);
            else cvv[k] = smp ? scv[(size_t)((l * 8 + b) * 2 + (2 + tt)) * 256 + ch] : 0.f; }
        const float bgv = bf2f(Zb_[(size_t)row * 1024 + 512 + ch]);
        const float y = bgv * (cw[l * 768 + ch] * cvv[0] + cw[l * 768 + 256 + ch] * cvv[1] + cw[l * 768 + 512 + ch] * cvv[2]);
        MIX_[(size_t)row * 1024 + 768 + ch] = (bf16)(pk2(y, 0.f) & 0xffffu);
    }
}
#endif

#define XB_TMO      128
#define XB_XCNT(j)  (256  + 64 * (j))
#define XB_XSUB(j)  (1280 + 64 * (j))
#define XB_XGEN(j)  (2304 + 64 * (j))
#define XB_TOP      3328
#define XB_TOPGEN   3392
#define XCD_BAR_WORDS 3456
#define XB_SPIN_CAP (1u << 18)
__device__ __forceinline__ unsigned xb_ld(unsigned* p)              { return __hip_atomic_load(p, __ATOMIC_RELAXED, __HIP_MEMORY_SCOPE_AGENT); }
__device__ __forceinline__ unsigned xb_add(unsigned* p, unsigned v) { return __hip_atomic_fetch_add(p, v, __ATOMIC_RELAXED, __HIP_MEMORY_SCOPE_AGENT); }
__device__ __forceinline__ unsigned xb_xcc_id() { return (unsigned)__builtin_amdgcn_s_getreg((3 << 11) | 20) & 0xFu; }
#define XB_SPIN(cond, bar) do { unsigned _sp = 0; while (cond) { __builtin_amdgcn_s_sleep(1); \
    if ((++_sp & 255u) == 0u) { if (xb_ld(&(bar)[XB_TMO])) break; if (_sp > XB_SPIN_CAP) { atomicAdd(&(bar)[XB_TMO], 1u); break; } } } } while (0)
__device__ __forceinline__ void xcd_barrier_complete(unsigned* bar, unsigned x, unsigned& nloc, unsigned& nx) {
    const unsigned G = gridDim.x * gridDim.y * gridDim.z;
    unsigned sum, cnt, mine, sp = 0u;
    for (;;) {
        sum = 0u; cnt = 0u; mine = 0u;
#pragma unroll
        for (unsigned j = 0; j < 16; ++j) { const unsigned c = xb_ld(&bar[XB_XCNT(j)]); sum += c; cnt += (c > 0u) ? 1u : 0u; mine = (j == x) ? c : mine; }
        if (sum == G) break;
        __builtin_amdgcn_s_sleep(1);
        if ((++sp & 255u) == 0u) { if (xb_ld(&bar[XB_TMO])) break; if (sp > XB_SPIN_CAP) { atomicAdd(&bar[XB_TMO], 1u); break; } }
    }
    nloc = mine > 0u ? mine : 1u; nx = cnt > 0u ? cnt : 1u;
}
__device__ __forceinline__ void xcd_barrier(unsigned* bar, unsigned x, volatile LAS unsigned* st) {
    asm volatile("s_waitcnt vmcnt(0)" ::: "memory");
    __syncthreads();
    if (threadIdx.x == 0) {
        __builtin_amdgcn_s_waitcnt(0);
        unsigned nloc = st[0], nx = st[1];
        if (nloc == 0u) { xcd_barrier_complete(bar, x, nloc, nx); st[0] = nloc; st[1] = nx; }
        const unsigned old = xb_add(&bar[XB_XSUB(x)], 1u);
        const unsigned gen = old / nloc;
        if (old + 1u == (gen + 1u) * nloc) {
            __builtin_amdgcn_fence(__ATOMIC_RELEASE, "agent");
            asm volatile("s_waitcnt vmcnt(0)" ::: "memory");
            const unsigned og = xb_add(&bar[XB_TOP], 1u);
            const unsigned tg = og / nx;
            if (og + 1u == (tg + 1u) * nx) xb_add(&bar[XB_TOPGEN], 1u);
            else XB_SPIN(xb_ld(&bar[XB_TOPGEN]) == tg, bar);
            __builtin_amdgcn_fence(__ATOMIC_ACQUIRE, "agent");
            xb_add(&bar[XB_XGEN(x)], 1u);
            asm volatile("s_waitcnt vmcnt(0)" ::: "memory");
        } else {
            XB_SPIN(xb_ld(&bar[XB_XGEN(x)]) == gen, bar);
            __builtin_amdgcn_fence(__ATOMIC_ACQUIRE, "agent");
            asm volatile("s_waitcnt vmcnt(0)" ::: "memory");
        }
    }
    __syncthreads();
}
#define CG_SYNC() do { asm volatile("s_waitcnt vmcnt(0) lgkmcnt(0)" ::: "memory"); grid.sync(); asm volatile("" ::: "memory"); } while (0)
#define GRID_SYNC() xcd_barrier((unsigned*)KWS() + 4096, xcc, (volatile LAS unsigned*)(lds + LDS_BYTES - 64))
__global__ void __launch_bounds__(NWAVES * 64, 2) mega_fwd(Params p) {
    extern __shared__ __attribute__((aligned(16))) unsigned char lds_raw[];
    LAS unsigned char* lds = (LAS unsigned char*)lds_raw;
    cg::grid_group grid = cg::this_grid();
    const int tid = threadIdx.x, lane = tid & 63, wave = __builtin_amdgcn_readfirstlane(tid >> 6);
    const int G = gridDim.x; const int bx = blockIdx.x; const int vcu0 = (G % 8 == 0) ? (bx % 8) * (G / 8) + bx / 8 : bx;
    const int NGW = G * NWAVES;
#define X ((bf16*)(ws + WS_X))
#define H ((bf16*)(ws + WS_H))
#define MIX ((bf16*)(ws + WS_MIX))
#define ACT ((bf16*)(ws + WS_ACT))
#define Qb ((bf16*)(ws + WS_QB))
#define Kb ((bf16*)(ws + WS_KB))
#define Vb ((bf16*)(ws + WS_VB))
#define Zb ((bf16*)(ws + WS_ZB))
#define Ob ((bf16*)(ws + WS_OB))
#define OPART ((float*)(ws + WS_OPART))
#define MLP ((float*)(ws + WS_ML))
#define pwt ((const bf16*)(ws + WS_POOLWT))
    if (tid < 16) ((LAS unsigned*)(lds + LDS_BYTES - 64))[tid] = 0u;
    const unsigned xcc = xb_xcc_id();
    if (tid == 0) (void)xb_add((unsigned*)KWS() + 4096 + XB_XCNT(xcc), 1u);
    __syncthreads();
    { const int gw = vcu0 * NWAVES + wave; prologue(lds, gw, NGW, wave, lane);
      norm_rows<false>(KIN(0), KIN(1), KIN(6), (bf16*)(KWS() + WS_H), nullptr, gw, NGW, lane); }
    CG_SYNC();
#define FRESH_IDS() int tid = threadIdx.x; asm volatile("" : "+v"(tid)); const int lane = tid & 63, wave = __builtin_amdgcn_readfirstlane(tid >> 6); int vcu = vcu0; asm volatile("" : "+s"(vcu)); const int gw = vcu * NWAVES + wave; (void)lane; (void)gw; (void)wave
#define CNT(nid, idx) ((unsigned*)(ws + CTL_CNT) + (size_t)((nid) * 80 + (idx)) * 64)
#pragma unroll 1
    for (int step = 0; step < 4; ++step) {
        const int l = step >> 1, f = step & 1;
        const bool first = (step == 0);
        { FRESH_IDS(); unsigned char* const ws = KWS(); unsigned char* const wl = ws + WS_W + (size_t)l * WL;
          pg8::Gemm g{H, (const bf16*)(wl + (f ? W_GU2 : W_GU1)), M, 2 * FF, D}; pg8::StaticOrder S; S.init(M, 2 * FF, G, bx);
          pg8::EpiSwiGLU E{ACT, FF};
          pg8::gemm_phase<pg8::EpiSwiGLU, pg8::StaticOrder, true, true>(lds, g, S, E); }
        GRID_SYNC();
        { FRESH_IDS(); unsigned char* const ws = KWS(); unsigned char* const wl = ws + WS_W + (size_t)l * WL;
          const bool last = (step == 3);
          const float* const gn = last ? KIN(25) : (f ? KIN(6) + (l + 1) * D : KIN(10) + l * D);
          const int nid = step * 2;
          float* const yo = KOUT() + OFF_Y;
          pg8::Gemm g{ACT, (const bf16*)(wl + (f ? W_D2 : W_D1)), MP, D, FF}; pg8::StaticOrder S; S.init(MP, D, G, bx);
          if (first) skinny_part1<false, FF>(lds, ACT + (size_t)MP * FF, (const bf16*)(wl + W_D1), KIN(1), X + (size_t)MP * D, 0.5f, (unsigned*)(ws + WS_SLOTS), CNT(nid, 64), vcu, tid);
          else skinny_part1<true, FF>(lds, ACT + (size_t)MP * FF, (const bf16*)(wl + (f ? W_D2 : W_D1)), X + (size_t)MP * D, last ? nullptr : X + (size_t)MP * D, 0.5f, (unsigned*)(ws + WS_SLOTS), CNT(nid, 64), vcu, tid);
          { pg8::Unit u0; const int pm0 = S.next(0, u0) ? u0.pm : 0;
            if (first) { pg8::EpiResidNorm<false> E{KIN(0), X, 0.5f, H, yo, gn, (unsigned*)(ws + WS_SLOTP), CNT(nid, pm0)};
                         pg8::gemm_phase<pg8::EpiResidNorm<false>, pg8::StaticOrder, false, true>(lds, g, S, E); }
            else { pg8::EpiResidNorm<true> E{X, last ? nullptr : X, 0.5f, last ? nullptr : H, yo, gn, (unsigned*)(ws + WS_SLOTP), CNT(nid, pm0)};
                   pg8::gemm_phase<pg8::EpiResidNorm<true>, pg8::StaticOrder, false, true>(lds, g, S, E); } }
          skinny_part2(lds, last ? nullptr : H + (size_t)MP * D, yo + (size_t)MP * D, gn, (unsigned*)(ws + WS_SLOTS), CNT(nid, 64), vcu, tid); }
        if (step == 3) break;
        GRID_SYNC();
        if (f == 0) {
            { FRESH_IDS(); unsigned char* const ws = KWS(); unsigned char* const wl = ws + WS_W + (size_t)l * WL;
              pg8::Gemm g{H, (const bf16*)(wl + W_IN), M, DIN, D}; pg8::StaticOrder S; S.init(M, DIN, G, bx);
              pg8::EpiWin E{ws, KOUT(), l, C2};
              pg8::gemm_phase<pg8::EpiWin, pg8::StaticOrder, true, true>(lds, g, S, E); }
            GRID_SYNC();
#pragma unroll 1
            for (int slot = 0; slot < 2; ++slot) {
              if (((slot ^ vcu0) & 1) == 0) {
                FRESH_IDS(); unsigned char* const ws = KWS();
                for (int i = 0; i < 4; ++i) {
                  const int L = i * G + vcu; if (L >= 1024) break;
                  const int bh = (L & 255) >> 1, sI = L & 1, ii = L >> 8;
                  const int qb = sI == 0 ? (ii == 0 ? 7 : ii == 1 ? 0 : ii == 2 ? 4 : 3) : (ii == 0 ? 6 : ii == 1 ? 1 : ii == 2 ? 5 : 2);
                  const int b = bh >> 4, vh = bh & 15, hh = vh >> 2, c = (vh >> 1) & 1, hf = vh & 1;
                  attn_body::attn_unit<8>(b, qb, (const attn_body::bf16*)(Qb + (hh * 2 + c) * 64), (const attn_body::bf16*)(Kb + (hh * 2 + c) * 64), (const attn_body::bf16*)(Vb + hh * 128 + hf * 64),
                                          (attn_body::bf16*)(Ob + c * 512 + hh * 128 + hf * 64), (char*)lds_raw);
                }
              } else {
                FRESH_IDS(); unsigned char* const ws = KWS(); float* const outp = KOUT();
                for (int pc = vcu; pc < 256; pc += G)
                  sample_piece(lds, pc, l, Qb, KIN(2), KIN(3), outp + OFF_KS, outp + OFF_VS, OPART, MLP, tid);
              }
              __syncthreads();
            }
            { FRESH_IDS(); unsigned char* const ws = KWS(); float* const outp = KOUT();
              for (int tl = vcu; tl < 264; tl += G)
                poolconv_tile(lds, tl, l, Zb, MIX, KIN(4), KIN(5), pwt, KIN(18), KIN(19), outp + OFF_CP, outp + OFF_CS, tid); }
            GRID_SYNC();
            { FRESH_IDS(); unsigned char* const ws = KWS();
              combine_phase(l, Ob, OPART, MLP, MIX, gw, NGW, lane); }
            GRID_SYNC();
            { FRESH_IDS(); unsigned char* const ws = KWS(); unsigned char* const wl = ws + WS_W + (size_t)l * WL;
              const float* const gn = KIN(21) + l * D; const int nid = step * 2 + 1;
              pg8::Gemm g{MIX, (const bf16*)(wl + W_OUT), MP, D, D}; pg8::StaticOrder S; S.init(MP, D, G, bx);
              skinny_part1<true, D>(lds, MIX + (size_t)MP * D, (const bf16*)(wl + W_OUT), X + (size_t)MP * D, X + (size_t)MP * D, 1.0f, (unsigned*)(ws + WS_SLOTS), CNT(nid, 64), vcu, tid);
              { pg8::Unit u0; const int pm0 = S.next(0, u0) ? u0.pm : 0;
                pg8::EpiResidNorm<true> E{X, X, 1.0f, H, nullptr, gn, (unsigned*)(ws + WS_SLOTP), CNT(nid, pm0)};
                pg8::gemm_phase<pg8::EpiResidNorm<true>, pg8::StaticOrder, false, true>(lds, g, S, E); }
              skinny_part2(lds, H + (size_t)MP * D, nullptr, gn, (unsigned*)(ws + WS_SLOTS), CNT(nid, 64), vcu, tid); }
            GRID_SYNC();
        }
    }
}

extern "C" void kernel_launch(void* const* d_in, const int* in_sizes, int n_in, void* d_out, int out_size, void* d_ws, size_t ws_size, hipStream_t stream) {
    static int grid = 0;
    if (grid == 0) {
        if (n_in != 26 || (size_t)out_size != OUT_TOTAL || ws_size < WS_END) { fprintf(stderr, "kernel_launch: unexpected problem shape: n_in %d out %d ws %zu\n", n_in, out_size, ws_size); grid = -1; return; }
        int dev = 0, cus = 0, per_cu = 0;
        if (hipGetDevice(&dev) != hipSuccess || hipDeviceGetAttribute(&cus, hipDeviceAttributeMultiprocessorCount, dev) != hipSuccess) { grid = -1; return; }
        if (hipFuncSetAttribute((const void*)mega_fwd, hipFuncAttributeMaxDynamicSharedMemorySize, LDS_BYTES) != hipSuccess) { fprintf(stderr, "kernel_launch: hipFuncSetAttribute failed\n"); grid = -1; return; }
        if (hipOccupancyMaxActiveBlocksPerMultiprocessor(&per_cu, (const void*)mega_fwd, NWAVES * 64, LDS_BYTES) != hipSuccess || per_cu < 1) { fprintf(stderr, "kernel_launch: occupancy query says %d\n", per_cu); per_cu = 1; }
        (void)hipGetLastError();
        grid = cus * per_cu;
    }
    if (grid < 0) return;
    if (hipMemsetAsync(d_ws, 0, CTL_BYTES, stream) != hipSuccess) { fprintf(stderr, "kernel_launch: memset failed\n"); return; }
    Params p{};
    for (int i = 0; i < 26; ++i) p.in[i] = (const float*)d_in[i];
    p.out = (float*)d_out; p.ws = (unsigned char*)d_ws;
    void* args[] = {&p};
    const hipError_t e = hipLaunchCooperativeKernel((const void*)mega_fwd, dim3(grid), dim3(NWAVES * 64), args, LDS_BYTES, stream);
    if (e != hipSuccess) fprintf(stderr, "kernel_launch: cooperative launch failed: %s (grid %d)\n", hipGetErrorString(e), grid);
}
```

```cpp
#include <hip/hip_runtime.h>
#include <hip/hip_cooperative_groups.h>
#include <cstdio>
#include <cstdint>
namespace pg8 {
#define PG8_LAS __attribute__((address_space(3)))
typedef unsigned short bf16_t;
typedef short bf16x8 __attribute__((ext_vector_type(8)));
typedef float f32x4 __attribute__((ext_vector_type(4)));
typedef unsigned u32x4 __attribute__((ext_vector_type(4)));
constexpr int BM = 256, BK = 64, HALF = 128, HTB = HALF * BK * 2  , STAGE_BYTES = 8 * HTB, NXCD = 8, WGM = 8;

__host__ __device__ __forceinline__ int lds_byte(int r, int c) { const int st = (r >> 4) * 2 + (c >> 5), rr = r & 15, cc = c & 31, ob = rr * 64 + cc * 2; return st * 1024 + (ob ^ (((ob >> 9) & 1) << 5)); }
__host__ __device__ __forceinline__ void stage_rc(int b, int& R, int& C) { const int st = b / 1024, sb = b % 1024, swz = sb ^ (((sb >> 9) & 1) << 5); R = (st >> 1) * 16 + swz / 64; C = (st & 1) * 32 + (swz % 64) / 2; }
__host__ __device__ __forceinline__ int perm32(int rho) { const int n = rho >> 4, i = rho & 15; return 8 * (i >> 2) + 4 * n + (i & 3); }

struct Unit { int pm, pn; };
struct Gemm { const bf16_t* A; const bf16_t* Bt; int M, N, K; };

struct StaticOrder {
    int nM, nN, nwg, G, c;
    __host__ __device__ __forceinline__ void init(int M, int N, int G_, int c_) { nM = M / BM; nN = N / BM; nwg = nM * nN; G = G_; c = c_; }
    __host__ __device__ __forceinline__ bool next(int i, Unit& u) const {
        const long L = (long)i * G + c; if (L >= nwg) return false;
        int wgid = (int)L; { const int q = nwg / NXCD, r = nwg % NXCD, xcd = wgid % NXCD, off = wgid / NXCD; wgid = (xcd < r ? xcd * (q + 1) : r * (q + 1) + (xcd - r) * q) + off; }
        const int nig = WGM * nN, gid = wgid / nig, fm = gid * WGM, gsz = (nM - fm) < WGM ? (nM - fm) : WGM;
        u.pm = fm + ((wgid % nig) % gsz); u.pn = (wgid % nig) / gsz; return true;
    }
    __device__ __forceinline__ void a_ready(const Unit&) const {}
    __device__ __forceinline__ void done(const Unit&) const {}
};

__device__ __forceinline__ unsigned cvt_pk_bf16(float lo, float hi) { unsigned r; asm volatile("v_cvt_pk_bf16_f32 %0, %1, %2" : "=v"(r) : "v"(lo), "v"(hi)); return r; }
typedef float f32x2 __attribute__((ext_vector_type(2)));
typedef unsigned u32x2 __attribute__((ext_vector_type(2)));
constexpr size_t WOFF_ROPE = (size_t)1 << 20, WOFF_QB = (size_t)215 << 20, WOFF_KB = (size_t)232 << 20, WOFF_VB = (size_t)249 << 20, WOFF_ZB = (size_t)266 << 20;
constexpr size_t OOFF_KP = 17039360, OOFF_VP = 33816576, OOFF_PP = 50593792, OOFF_KS = 50663424, OOFF_VS = 50925568, OOFF_PS = 51187712;
__device__ __forceinline__ float silu_mul(float g, float u) { const float e = __builtin_amdgcn_exp2f(-1.4426950408889634f * g); return g * u * __builtin_amdgcn_rcpf(1.0f + e); }
struct EpiSwiGLU {
    static constexpr bool PERM = true, AFTER_DRAIN = false;
    bf16_t* O; int ldc;
    __device__ __forceinline__ void operator()(const f32x4 (&acc)[2][2][4][2], const Unit& u, int wr, int wc, int fr, int fq) const {
        const int row0 = u.pm * BM + wr * 64 + fr; const int col0 = u.pn * 128 + wc * 32 + 8 * fq;
#pragma unroll
        for (int ai = 0; ai < 2; ++ai)
#pragma unroll
            for (int m = 0; m < 4; ++m) {
                bf16_t* p = O + (size_t)(row0 + ai * HALF + m * 16) * ldc + col0;
                const f32x4 g0 = acc[ai][0][m][0], g1 = acc[ai][0][m][1], u0 = acc[ai][1][m][0], u1 = acc[ai][1][m][1];
                u32x4 w;
                w.x = cvt_pk_bf16(silu_mul(g0[0], u0[0]), silu_mul(g0[1], u0[1])); w.y = cvt_pk_bf16(silu_mul(g0[2], u0[2]), silu_mul(g0[3], u0[3]));
                w.z = cvt_pk_bf16(silu_mul(g1[0], u1[0]), silu_mul(g1[1], u1[1])); w.w = cvt_pk_bf16(silu_mul(g1[2], u1[2]), silu_mul(g1[3], u1[3]));
                *(u32x4*)p = w;
                asm volatile("" ::: "memory");
            }
    }
};
struct EpiResid {
    static constexpr bool PERM = false, AFTER_DRAIN = false;
    const float* baseP; const float* baseS; float* out; float scale;
    __device__ __forceinline__ void operator()(const f32x4 (&acc)[2][2][4][2], const Unit& u, int wr, int wc, int fr, int fq) const {
        const int col0 = u.pn * BM + wc * 32 + 4 * fq;
#pragma unroll
        for (int ai = 0; ai < 2; ++ai)
#pragma unroll
            for (int m = 0; m < 4; ++m) {
                const int row = u.pm * BM + ai * HALF + wr * 64 + m * 16 + fr;
                const float* bp = (row < 16384) ? baseP + (size_t)row * 1024 : baseS + (size_t)(row - 16384) * 1024;
                float* op = out + (size_t)row * 1024;
#pragma unroll
                for (int bj = 0; bj < 2; ++bj)
#pragma unroll
                    for (int n = 0; n < 2; ++n) { const int c = col0 + bj * HALF + n * 16; const f32x4 b = *(const f32x4*)(bp + c); *(f32x4*)(op + c) = b + acc[ai][bj][m][n] * scale; }
                asm volatile("" ::: "memory");
            }
    }
};
constexpr float RMS_EPS = 1e-6f;
__device__ __forceinline__ float rstd_of(float ss) { return 1.0f / sqrtf(ss * (1.0f / 1024.0f) + RMS_EPS); }

#define PG8_RLX_AGENT __ATOMIC_RELAXED, __HIP_MEMORY_SCOPE_AGENT
template <bool BASE16> struct EpiResidNorm {
    static constexpr bool PERM = true, AFTER_DRAIN = true;
    const void* baseP; bf16_t* out; float scale; bf16_t* hb; float* yout; const float* gain; unsigned* slots; unsigned* cnt;
    __device__ __forceinline__ void fused(f32x4 (&acc)[2][2][4][2], const Unit& u, int wr, int wc, int fr, int fq, PG8_LAS unsigned char* lds, int wid, int lane) const {
        PG8_LAS float* P = (PG8_LAS float*)lds;
        PG8_LAS float* S = (PG8_LAS float*)(lds + 4096);
        const int col0 = u.pn * BM + wc * 32 + 8 * fq;
        if (BASE16) {
            u32x4 braw[2][4][2];
#pragma unroll
            for (int ai = 0; ai < 2; ++ai)
#pragma unroll
                for (int m = 0; m < 4; ++m) { const size_t ro = (size_t)(u.pm * BM + ai * HALF + wr * 64 + m * 16 + fr) * 1024;
#pragma unroll
                    for (int bj = 0; bj < 2; ++bj) braw[ai][m][bj] = *(const u32x4*)((const bf16_t*)baseP + ro + col0 + bj * HALF); }
#pragma unroll
            for (int ai = 0; ai < 2; ++ai)
#pragma unroll
                for (int m = 0; m < 4; ++m)
#pragma unroll
                    for (int bj = 0; bj < 2; ++bj) { const u32x4 bw = braw[ai][m][bj]; f32x4 b0, b1;
                        b0[0] = __builtin_bit_cast(float, bw.x << 16); b0[1] = __builtin_bit_cast(float, bw.x & 0xffff0000u); b0[2] = __builtin_bit_cast(float, bw.y << 16); b0[3] = __builtin_bit_cast(float, bw.y & 0xffff0000u);
                        b1[0] = __builtin_bit_cast(float, bw.z << 16); b1[1] = __builtin_bit_cast(float, bw.z & 0xffff0000u); b1[2] = __builtin_bit_cast(float, bw.w << 16); b1[3] = __builtin_bit_cast(float, bw.w & 0xffff0000u);
                        acc[ai][bj][m][0] = b0 + acc[ai][bj][m][0] * scale; acc[ai][bj][m][1] = b1 + acc[ai][bj][m][1] * scale; }
        }
#pragma unroll
        for (int ai = 0; ai < 2; ++ai)
#pragma unroll
            for (int m = 0; m < 4; ++m) {
                const int rl = ai * HALF + wr * 64 + m * 16 + fr; const size_t ro = (size_t)(u.pm * BM + rl) * 1024;
                float ss = 0.f;
#pragma unroll
                for (int bj = 0; bj < 2; ++bj) { const int c = col0 + bj * HALF; f32x4 v0, v1;
                    if (BASE16) { v0 = acc[ai][bj][m][0]; v1 = acc[ai][bj][m][1]; }
                    else { v0 = *(const f32x4*)((const float*)baseP + ro + c) + acc[ai][bj][m][0] * scale; v1 = *(const f32x4*)((const float*)baseP + ro + c + 4) + acc[ai][bj][m][1] * scale; acc[ai][bj][m][0] = v0; acc[ai][bj][m][1] = v1; }
                    if (out) { u32x4 w; w.x = cvt_pk_bf16(v0[0], v0[1]); w.y = cvt_pk_bf16(v0[2], v0[3]); w.z = cvt_pk_bf16(v1[0], v1[1]); w.w = cvt_pk_bf16(v1[2], v1[3]); *(u32x4*)(out + ro + c) = w; }
                    ss += ((v0[0] * v0[0] + v0[1] * v0[1]) + (v0[2] * v0[2] + v0[3] * v0[3])) + ((v1[0] * v1[0] + v1[1] * v1[1]) + (v1[2] * v1[2] + v1[3] * v1[3])); }
                ss += __builtin_bit_cast(float, __builtin_amdgcn_ds_swizzle(__builtin_bit_cast(int, ss), (16 << 10) | 0x1f));
                { float a = ss, b2 = ss; asm volatile("s_nop 1\n\tv_permlane32_swap_b32 %0, %1\n\ts_nop 1" : "+v"(a), "+v"(b2)); ss = a + b2; }
                if (fq == 0) P[rl * 4 + wc] = ss;
                if (!BASE16 && (m & 1)) asm volatile("" ::: "memory");
            }
        asm volatile("s_waitcnt lgkmcnt(0)\n\ts_barrier" ::: "memory");
        const int t = wid * 64 + lane;
        if (t < 256) { const float s = (P[t * 4] + P[t * 4 + 1]) + (P[t * 4 + 2] + P[t * 4 + 3]);
            __hip_atomic_store(slots + (size_t)(u.pm * BM + t) * 4 + u.pn, __builtin_bit_cast(unsigned, s), PG8_RLX_AGENT); }
        asm volatile("s_waitcnt vmcnt(0)" ::: "memory");
        if (wid < 4 && lane == 0) __hip_atomic_fetch_add(cnt, 1u, PG8_RLX_AGENT);
        if (wid == 0) {
            unsigned spins = 0;
            while ((unsigned)__builtin_amdgcn_readfirstlane(__hip_atomic_load(cnt, PG8_RLX_AGENT)) < 16u) { __builtin_amdgcn_s_sleep(2); if (++spins > (1u << 22)) break; }
            __builtin_amdgcn_fence(__ATOMIC_ACQUIRE, "agent");
        }
        asm volatile("s_waitcnt vmcnt(0) lgkmcnt(0)\n\ts_barrier" ::: "memory");
        if (t < 256) { const unsigned* sl = slots + (size_t)(u.pm * BM + t) * 4; float tot = 0.f;
#pragma unroll
            for (int k = 0; k < 4; ++k) tot += __builtin_bit_cast(float, __hip_atomic_load(sl + k, PG8_RLX_AGENT));
            S[t] = rstd_of(tot); }
        asm volatile("s_waitcnt lgkmcnt(0)\n\ts_barrier" ::: "memory");
        f32x4 g4[2][2];
#pragma unroll
        for (int bj = 0; bj < 2; ++bj)
#pragma unroll
            for (int n = 0; n < 2; ++n) g4[bj][n] = *(const f32x4*)(gain + col0 + bj * HALF + n * 4);
#pragma unroll
        for (int ai = 0; ai < 2; ++ai)
#pragma unroll
            for (int m = 0; m < 4; ++m) {
                const int rl = ai * HALF + wr * 64 + m * 16 + fr; const size_t ro = (size_t)(u.pm * BM + rl) * 1024; const float r = S[rl];
#pragma unroll
                for (int bj = 0; bj < 2; ++bj) { const int c = col0 + bj * HALF; const f32x4 y0 = acc[ai][bj][m][0] * r * g4[bj][0], y1 = acc[ai][bj][m][1] * r * g4[bj][1];
                    if (hb) { u32x4 w; w.x = cvt_pk_bf16(y0[0], y0[1]); w.y = cvt_pk_bf16(y0[2], y0[3]); w.z = cvt_pk_bf16(y1[0], y1[1]); w.w = cvt_pk_bf16(y1[2], y1[3]); *(u32x4*)(hb + ro + c) = w; }
                    else { *(f32x4*)(yout + ro + c) = y0; *(f32x4*)(yout + ro + c + 4) = y1; } }
            }
        asm volatile("s_waitcnt lgkmcnt(0)\n\ts_barrier" ::: "memory");
    }
};

struct EpiWin {
    static constexpr bool PERM = false, AFTER_DRAIN = false;
    unsigned char* ws; float* outp; int l; float qscale;
    __device__ __forceinline__ void operator()(const f32x4 (&acc)[2][2][4][2], const Unit& u, int wr, int wc, int fr, int fq) const {
        const int pn = u.pn;
        float invrev[2][4];
#pragma unroll
        for (int n = 0; n < 2; ++n)
#pragma unroll
            for (int j = 0; j < 4; ++j) invrev[n][j] = exp2f(-(float)(8 * fq + 4 * n + j) * (13.287712379549449f / 32.0f)) * 0.15915494309189535f;
        bf16_t* const Qb = (bf16_t*)(ws + WOFF_QB); bf16_t* const Kb = (bf16_t*)(ws + WOFF_KB); bf16_t* const Vb = (bf16_t*)(ws + WOFF_VB); bf16_t* const Zb = (bf16_t*)(ws + WOFF_ZB);
        float* const kP = outp + OOFF_KP + (size_t)l * 16384 * 512; float* const vP = outp + OOFF_VP + (size_t)l * 16384 * 512;
        float* const kS = outp + OOFF_KS + (size_t)l * 256 * 512; float* const vS = outp + OOFF_VS + (size_t)l * 256 * 512;
        float* const poolP = outp + OOFF_PP + (size_t)l * 8 * 15 * 256; float* const poolS = outp + OOFF_PS + (size_t)l * 8 * 15 * 256;
        const int c0 = 64 * wc + 8 * fq;
#pragma unroll
        for (int ai = 0; ai < 2; ++ai)
#pragma unroll
            for (int m = 0; m < 4; ++m) {
                const int row = u.pm * BM + ai * HALF + wr * 64 + m * 16 + fr;
                const bool smp = row >= 16384; const int rs = row - 16384;
                f32x4 v[2][2];
                if (pn < 4) {
                    const float posf = (float)(smp ? 4096 + (rs & 31) : (row & 2047));
#pragma unroll
                    for (int n = 0; n < 2; ++n) { f32x4 cs, sn;
#pragma unroll
                        for (int j = 0; j < 4; ++j) { const float rev = posf * invrev[n][j]; const float fr_ = rev - __builtin_rintf(rev); cs[j] = __builtin_amdgcn_cosf(fr_); sn[j] = __builtin_amdgcn_sinf(fr_); }
                        const f32x4 lo = acc[ai][0][m][n], hi = acc[ai][1][m][n];
                        v[0][n] = lo * cs - hi * sn; v[1][n] = hi * cs + lo * sn; }
                } else {
#pragma unroll
                    for (int bj = 0; bj < 2; ++bj)
#pragma unroll
                        for (int n = 0; n < 2; ++n) v[bj][n] = acc[ai][bj][m][n];
                }
#pragma unroll
                for (int bj = 0; bj < 2; ++bj) {
                    const int lc = c0 + 32 * bj; const f32x4 x0 = v[bj][0], x1 = v[bj][1];
                    if (pn < 2) {
                        bf16_t* q = Qb + (size_t)row * 512 + 256 * pn + lc;
                        u32x4 w; w.x = cvt_pk_bf16(x0[0] * qscale, x0[1] * qscale); w.y = cvt_pk_bf16(x0[2] * qscale, x0[3] * qscale); w.z = cvt_pk_bf16(x1[0] * qscale, x1[1] * qscale); w.w = cvt_pk_bf16(x1[2] * qscale, x1[3] * qscale);
                        *(u32x4*)q = w;
                    } else {
                        u32x4 w; w.x = cvt_pk_bf16(x0[0], x0[1]); w.y = cvt_pk_bf16(x0[2], x0[3]); w.z = cvt_pk_bf16(x1[0], x1[1]); w.w = cvt_pk_bf16(x1[2], x1[3]);
                        if (pn < 4) { const int col = 256 * (pn - 2) + lc; float* ko = smp ? kS + (size_t)rs * 512 + col : kP + (size_t)row * 512 + col;
                            *(f32x4*)ko = x0; *(f32x4*)(ko + 4) = x1; *(u32x4*)(Kb + (size_t)row * 512 + col) = w; }
                        else if (pn < 6) { const int col = 256 * (pn - 4) + lc; float* vo = smp ? vS + (size_t)rs * 512 + col : vP + (size_t)row * 512 + col;
                            *(f32x4*)vo = x0; *(f32x4*)(vo + 4) = x1; *(u32x4*)(Vb + (size_t)row * 512 + col) = w; }
                        else { *(u32x4*)(Zb + (size_t)row * 1024 + 256 * (pn - 6) + lc) = w;
                            if (pn == 6) {
                                if (smp) { const int b = rs >> 5, t = rs & 31; if (t >= 17) { float* po = poolS + (size_t)(b * 15 + t - 17) * 256 + lc; *(f32x4*)po = x0; *(f32x4*)(po + 4) = x1; } }
                                else { const int b = row >> 11, t = row & 2047; if (t >= 2033) { float* po = poolP + (size_t)(b * 15 + t - 2033) * 256 + lc; *(f32x4*)po = x0; *(f32x4*)(po + 4) = x1; } }
                            } }
                    }
                }
                asm volatile("" ::: "memory");
            }
    }
};
template <class Epi, class Sched, bool ALIGN_EPI = false, bool SP2 = false>
__device__ __forceinline__ void gemm_phase(PG8_LAS unsigned char* lds, const Gemm g, const Sched& S, const Epi& E) {
    int tid_l = threadIdx.x; asm volatile("" : "+v"(tid_l)); const int tid = tid_l, wid = __builtin_amdgcn_readfirstlane(tid >> 6), lane = tid & 63, wr = wid >> 2, wc = wid & 3, fr = lane & 15, fq = lane >> 4;
    const int K = g.K, nt = K / BK;
    unsigned voffA[2], voffB[2];
#pragma unroll
    for (int i = 0; i < 2; ++i) { int R, C; stage_rc(tid * 16 + i * 8192, R, C); const int Rb = Epi::PERM ? ((R & ~31) + perm32(R & 31)) : R;
        voffA[i] = (unsigned)(R * K + C) * 2u; voffB[i] = (unsigned)(Rb * K + C) * 2u; }
    const size_t kstep = (size_t)(BK * 2);
    const size_t hstep = (size_t)HALF * K * 2;
    const size_t tstep = 2 * hstep;
    const unsigned ldsw = (unsigned)wid * 1024u;
    const int aoff = lds_byte(wr * 64 + fr, fq * 8), boff = lds_byte(wc * 32 + fr, fq * 8);
#define PG8_SA(b, h) (((b) * 2 + (h)) * HTB)
#define PG8_SB(b, h) ((4 + (b) * 2 + (h)) * HTB)
#define PG8_STAGE(bufoff, gbase, voff) do { _Pragma("unroll") for (int _i = 0; _i < 2; ++_i) \
        __builtin_amdgcn_global_load_lds((const unsigned*)((const char*)(gbase) + (voff)[_i]), (PG8_LAS unsigned*)(lds + (bufoff) + ldsw + _i * 8192), 16, 0, 0); } while (0)
#define PG8_LDA(dst, b, h) do { _Pragma("unroll") for (int m = 0; m < 4; ++m) _Pragma("unroll") for (int k = 0; k < 2; ++k) dst[m][k] = *(const PG8_LAS bf16x8*)(lds + PG8_SA(b, h) + aoff + m * 2048 + k * 1024); } while (0)
#define PG8_LDB(dst, b, h) do { _Pragma("unroll") for (int n = 0; n < 2; ++n) _Pragma("unroll") for (int k = 0; k < 2; ++k) dst[n][k] = *(const PG8_LAS bf16x8*)(lds + PG8_SB(b, h) + boff + n * 2048 + k * 1024); } while (0)
#define PG8_MMA(ai, bj, At, Bt) do { __builtin_amdgcn_s_setprio(1); _Pragma("unroll") for (int m = 0; m < 4; ++m) _Pragma("unroll") for (int n = 0; n < 2; ++n) _Pragma("unroll") for (int k = 0; k < 2; ++k) \
        acc[ai][bj][m][n] = __builtin_amdgcn_mfma_f32_16x16x32_bf16(Bt[n][k], At[m][k], acc[ai][bj][m][n], 0, 0, 0); __builtin_amdgcn_s_setprio(0); } while (0)
#define PG8_WAIT_V(n) asm volatile("s_waitcnt vmcnt(" #n ")" ::: "memory")
#define PG8_WAIT_L(n) asm volatile("s_waitcnt lgkmcnt(" #n ")" ::: "memory")
#define PG8_BAR __builtin_amdgcn_s_barrier()
#define PG8_SCHED __builtin_amdgcn_sched_barrier(0)
    Unit cur, nxt; int ui = 0;
    if (!S.next(0, cur)) return;
    f32x4 acc[2][2][4][2];
#pragma unroll
    for (int a = 0; a < 2; ++a)
#pragma unroll
        for (int b = 0; b < 2; ++b)
#pragma unroll
            for (int m = 0; m < 4; ++m)
#pragma unroll
                for (int n = 0; n < 2; ++n) acc[a][b][m][n] = (f32x4){0.f, 0.f, 0.f, 0.f};
    bf16x8 At[4][2], B0[2][2], B1[2][2];
    const char* cA = (const char*)g.A + (size_t)cur.pm * tstep; const char* cB = (const char*)g.Bt + (size_t)cur.pn * tstep;
    S.a_ready(cur);
    if constexpr (SP2) {
        PG8_STAGE(PG8_SB(0, 0), cB, voffB); PG8_STAGE(PG8_SB(0, 1), cB + hstep, voffB); PG8_STAGE(PG8_SA(0, 0), cA, voffA); PG8_STAGE(PG8_SA(0, 1), cA + hstep, voffA);
        if (wr == 1) PG8_BAR;
        PG8_WAIT_V(2); PG8_BAR;
        PG8_STAGE(PG8_SB(1, 0), cB + kstep, voffB); PG8_STAGE(PG8_SA(1, 0), cA + kstep, voffA); PG8_STAGE(PG8_SB(1, 1), cB + hstep + kstep, voffB);
        PG8_WAIT_V(6); PG8_BAR;
    } else {
        PG8_STAGE(PG8_SB(0, 0), cB, voffB); PG8_STAGE(PG8_SA(0, 0), cA, voffA); PG8_STAGE(PG8_SB(0, 1), cB + hstep, voffB); PG8_STAGE(PG8_SA(0, 1), cA + hstep, voffA);
        if (wr == 1) PG8_BAR;
        PG8_WAIT_V(4); PG8_BAR;
        PG8_STAGE(PG8_SB(1, 0), cB + kstep, voffB); PG8_STAGE(PG8_SA(1, 0), cA + kstep, voffA); PG8_STAGE(PG8_SB(1, 1), cB + hstep + kstep, voffB);
        PG8_WAIT_V(6); PG8_BAR;
    }
    for (;;) {
        const bool has_next = S.next(ui + 1, nxt);
        const char* nA = has_next ? (const char*)g.A + (size_t)nxt.pm * tstep : cA; const char* nB = has_next ? (const char*)g.Bt + (size_t)nxt.pn * tstep : cB;
        for (int t = 0; t < nt; t += 2) {
            const bool last = (t == nt - 2);
            const char* a1 = cA + (size_t)(t + 1) * kstep;
            const char* a2 = last ? nA : cA + (size_t)(t + 2) * kstep; const char* b2 = last ? nB : cB + (size_t)(t + 2) * kstep;
            const char* a3 = a2 + kstep; const char* b3 = b2 + kstep;
            if (last && has_next) S.a_ready(nxt);
            if constexpr (SP2) {
            PG8_LDB(B0, 0, 0); PG8_LDB(B1, 0, 1); PG8_SCHED; PG8_LDA(At, 0, 0); PG8_STAGE(PG8_SA(1, 1), a1 + hstep, voffA);
            PG8_WAIT_V(8); PG8_WAIT_L(0); PG8_BAR; PG8_MMA(0, 0, At, B0); PG8_MMA(0, 1, At, B1); PG8_BAR; PG8_SCHED;
            PG8_LDA(At, 0, 1); PG8_STAGE(PG8_SB(0, 0), b2, voffB); PG8_STAGE(PG8_SB(0, 1), b2 + hstep, voffB); PG8_STAGE(PG8_SA(0, 0), a2, voffA);
            PG8_WAIT_V(8); PG8_WAIT_L(0); PG8_BAR; PG8_MMA(1, 0, At, B0); PG8_MMA(1, 1, At, B1); PG8_BAR; PG8_SCHED;
            PG8_LDB(B0, 1, 0); PG8_LDB(B1, 1, 1); PG8_SCHED; PG8_LDA(At, 1, 0); PG8_STAGE(PG8_SA(0, 1), a2 + hstep, voffA);
            PG8_WAIT_V(8); PG8_WAIT_L(0); PG8_BAR; PG8_MMA(0, 0, At, B0); PG8_MMA(0, 1, At, B1); PG8_BAR; PG8_SCHED;
            PG8_LDA(At, 1, 1); PG8_STAGE(PG8_SB(1, 0), b3, voffB); PG8_STAGE(PG8_SB(1, 1), b3 + hstep, voffB); PG8_STAGE(PG8_SA(1, 0), a3, voffA);
            PG8_WAIT_V(8); PG8_WAIT_L(0); PG8_BAR; PG8_MMA(1, 0, At, B0); PG8_MMA(1, 1, At, B1); PG8_BAR; PG8_SCHED;
            } else {
            PG8_LDB(B0, 0, 0); PG8_SCHED; PG8_LDA(At, 0, 0); PG8_STAGE(PG8_SA(1, 1), a1 + hstep, voffA);
            PG8_WAIT_L(8); PG8_BAR; PG8_WAIT_L(0); PG8_MMA(0, 0, At, B0); PG8_BAR; PG8_SCHED;
            PG8_LDB(B1, 0, 1); PG8_STAGE(PG8_SB(0, 0), b2, voffB);
            PG8_BAR; PG8_WAIT_L(0); PG8_MMA(0, 1, At, B1); PG8_BAR;
            PG8_LDA(At, 0, 1); PG8_STAGE(PG8_SA(0, 0), a2, voffA);
            PG8_BAR; PG8_WAIT_L(0); PG8_MMA(1, 0, At, B0); PG8_BAR; PG8_SCHED;
            PG8_STAGE(PG8_SB(0, 1), b2 + hstep, voffB);
            PG8_WAIT_V(6); PG8_BAR; PG8_MMA(1, 1, At, B1); PG8_BAR;
            PG8_LDB(B0, 1, 0); PG8_SCHED; PG8_LDA(At, 1, 0); PG8_STAGE(PG8_SA(0, 1), a2 + hstep, voffA);
            PG8_WAIT_L(8); PG8_BAR; PG8_WAIT_L(0); PG8_MMA(0, 0, At, B0); PG8_BAR; PG8_SCHED;
            PG8_LDB(B1, 1, 1); PG8_STAGE(PG8_SB(1, 0), b3, voffB);
            PG8_BAR; PG8_WAIT_L(0); PG8_MMA(0, 1, At, B1); PG8_BAR;
            PG8_LDA(At, 1, 1); PG8_STAGE(PG8_SA(1, 0), a3, voffA);
            PG8_BAR; PG8_WAIT_L(0); PG8_MMA(1, 0, At, B0); PG8_BAR; PG8_SCHED;
            PG8_STAGE(PG8_SB(1, 1), b3 + hstep, voffB);
            PG8_WAIT_V(6); PG8_BAR; PG8_MMA(1, 1, At, B1); PG8_BAR;
            }
        }
        if constexpr (ALIGN_EPI) { if (wr == 0) PG8_BAR; }
        if constexpr (!Epi::AFTER_DRAIN) { E(acc, cur, wr, wc, fr, fq); S.done(cur); }
        if (!has_next) break;
#pragma unroll
        for (int a = 0; a < 2; ++a)
#pragma unroll
            for (int b = 0; b < 2; ++b)
#pragma unroll
                for (int m = 0; m < 4; ++m)
#pragma unroll
                    for (int n = 0; n < 2; ++n) acc[a][b][m][n] = (f32x4){0.f, 0.f, 0.f, 0.f};
        cur = nxt; cA = nA; cB = nB; ++ui;
        if constexpr (ALIGN_EPI) { if (wr == 1) PG8_BAR; }
    }
    PG8_WAIT_V(0);
    if constexpr (!ALIGN_EPI) { if (wr == 0) PG8_BAR; }
    PG8_BAR;
    if constexpr (Epi::AFTER_DRAIN) { E.fused(acc, cur, wr, wc, fr, fq, lds, wid, lane); S.done(cur); }
#undef PG8_SA
#undef PG8_SB
#undef PG8_STAGE
#undef PG8_LDA
#undef PG8_LDB
#undef PG8_MMA
#undef PG8_WAIT_V
#undef PG8_WAIT_L
#undef PG8_BAR
#undef PG8_SCHED
}
}
#include <hip/hip_bf16.h>
#include <cmath>
namespace attn_body {
using bf16=__hip_bfloat16;
using bf16x8=__attribute__((ext_vector_type(8)))short;
using s16x4=__attribute__((ext_vector_type(4)))short;
using f32x16=__attribute__((ext_vector_type(16)))float;
using u32x4=__attribute__((ext_vector_type(4)))unsigned;
constexpr int BATCH=8,NHEAD=16,SEQ=2048,D=64,PQK=512,PO=1024;
constexpr int NW=8,QBLK=32,QB=QBLK*NW,KVBLK=64,NQB=SEQ/QB;
constexpr int ATTN_UNIT_ROWS=QB;
__device__ __forceinline__ int crow(int r,int hi){return (r&3)+8*(r>>2)+4*hi;}
#define SBAR() __builtin_amdgcn_sched_barrier(0)
__device__ __forceinline__ void cmask(f32x16&p0,f32x16&p1,int jb,int qrel,int hi){
  const float NEG=-INFINITY; (void)hi;
  if(jb>(qrel>>6)){
  #pragma unroll
  for(int r=0;r<16;++r){p0[r]=NEG;p1[r]=NEG;}}
}

constexpr int NSLOT=3, SLOTB=8192;
constexpr int LDS_K=0, LDS_V=NSLOT*SLOTB, LDS_WS=2*NSLOT*SLOTB, LDS_OST=LDS_WS+NW*64*4, LDS_BYTES=LDS_OST+NW*4096;
constexpr float C2=0.125f*1.4426950408889634f;
__device__ __forceinline__ void glds16(const void*gsrc,unsigned lds_dst){unsigned keep;
  asm volatile("s_mov_b32 %0, m0\n\ts_mov_b32 m0, %2\n\ts_nop 0\n\tglobal_load_lds_dwordx4 %1, off\n\ts_mov_b32 m0, %0":"=&s"(keep):"v"(gsrc),"s"(lds_dst):"memory");}
__device__ __forceinline__ float max3f(float a,float b,float c){float r;asm("v_max3_f32 %0, %1, %2, %3":"=v"(r):"v"(a),"v"(b),"v"(c));return r;}
__device__ __forceinline__ float max2f(float a,float b){float r;asm("v_max_f32_e32 %0, %1, %2":"=v"(r):"v"(a),"v"(b));return r;}
__device__ __forceinline__ float fadd_s(float a,float b){float r;asm("v_add_f32_e32 %0, %1, %2":"=v"(r):"v"(a),"v"(b));return r;}
__device__ __forceinline__ float fsub_s(float a,float b){float r;asm("v_sub_f32_e32 %0, %1, %2":"=v"(r):"v"(a),"v"(b));return r;}
typedef float f32x2_t __attribute__((ext_vector_type(2))); typedef __bf16 bf16x2_t __attribute__((ext_vector_type(2)));
__device__ __forceinline__ unsigned cvtpk_s(float lo,float hi){f32x2_t v={lo,hi};bf16x2_t b=__builtin_convertvector(v,bf16x2_t);return __builtin_bit_cast(unsigned,b);}
#define WAIT_BAR(N) asm volatile("s_waitcnt vmcnt(" #N ") lgkmcnt(0)\n\ts_barrier":::"memory")

__device__ __forceinline__ void qkt(f32x16&p0,f32x16&p1,const char*Kslot,const bf16x8*qr,const f32x16&negm,int r32,int hi){
  const char*kb=Kslot+hi*1024+r32*16;
  #pragma unroll
  for(int d0=0;d0<4;++d0){
    const bf16x8 b0=*reinterpret_cast<const bf16x8*>(kb+d0*2048);
    const bf16x8 b1=*reinterpret_cast<const bf16x8*>(kb+d0*2048+512);
    if(d0==0){p0=__builtin_amdgcn_mfma_f32_32x32x16_bf16(b0,qr[0],negm,0,0,0);p1=__builtin_amdgcn_mfma_f32_32x32x16_bf16(b1,qr[0],negm,0,0,0);}
    else{p0=__builtin_amdgcn_mfma_f32_32x32x16_bf16(b0,qr[d0],p0,0,0,0);p1=__builtin_amdgcn_mfma_f32_32x32x16_bf16(b1,qr[d0],p1,0,0,0);}}
}
typedef __attribute__((address_space(3))) const char* lds_cptr;
typedef short v4i16_t __attribute__((ext_vector_type(4)));
__device__ __forceinline__ void kload8(bf16x8*kf,lds_cptr kp){
  kf[0]=*(const __attribute__((address_space(3))) bf16x8*)(kp);      kf[1]=*(const __attribute__((address_space(3))) bf16x8*)(kp+512);
  kf[2]=*(const __attribute__((address_space(3))) bf16x8*)(kp+2048); kf[3]=*(const __attribute__((address_space(3))) bf16x8*)(kp+2560);
  kf[4]=*(const __attribute__((address_space(3))) bf16x8*)(kp+4096); kf[5]=*(const __attribute__((address_space(3))) bf16x8*)(kp+4608);
  kf[6]=*(const __attribute__((address_space(3))) bf16x8*)(kp+6144); kf[7]=*(const __attribute__((address_space(3))) bf16x8*)(kp+6656);
}
__device__ __forceinline__ void kload2(bf16x8*kf,lds_cptr kp,int j){ kf[2*j]=*(const __attribute__((address_space(3))) bf16x8*)(kp+j*2048); kf[2*j+1]=*(const __attribute__((address_space(3))) bf16x8*)(kp+j*2048+512); }
__device__ __forceinline__ s16x4 vtr(lds_cptr p){ return __builtin_bit_cast(s16x4,__builtin_amdgcn_ds_read_tr16_b64_v4i16((__attribute__((address_space(3))) v4i16_t*)p)); }
__device__ __forceinline__ float rowmax(const f32x16&p0,const f32x16&p1){
  float a=max3f(p0[0],p0[1],p1[0]),b=max3f(p0[2],p0[3],p1[1]);a=max3f(a,p1[2],p1[3]);
  #pragma unroll
  for(int r=4;r<16;r+=4){a=max3f(a,p0[r],p0[r+1]);b=max3f(b,p0[r+2],p0[r+3]);a=max3f(a,p1[r],p1[r+1]);b=max3f(b,p1[r+2],p1[r+3]);}
  const float m=max2f(a,b);
  auto rr=__builtin_amdgcn_permlane32_swap(__float_as_uint(m),__float_as_uint(m),false,false);
  return max2f(__uint_as_float(rr[0]),__uint_as_float(rr[1]));
}
__device__ __forceinline__ void pv(f32x16*o,int vb,bf16x8 pa0,bf16x8 pa1,bf16x8 pa2,bf16x8 pa3){
  #pragma unroll
  for(int d0=0;d0<2;++d0){s16x4 lo[4],hi[4];
    #pragma unroll
    for(int ks=0;ks<4;++ks){
      asm volatile("ds_read_b64_tr_b16 %0,%1 offset:%c2":"=&v"(lo[ks]):"v"(vb),"i"(d0*4096+ks*1024):"memory");
      asm volatile("ds_read_b64_tr_b16 %0,%1 offset:%c2":"=&v"(hi[ks]):"v"(vb),"i"(d0*4096+ks*1024+512):"memory");}
    asm volatile("s_waitcnt lgkmcnt(0)":::"memory");SBAR();
    #define PK(k) (bf16x8){lo[k][0],lo[k][1],lo[k][2],lo[k][3],hi[k][0],hi[k][1],hi[k][2],hi[k][3]}
    o[d0]=__builtin_amdgcn_mfma_f32_32x32x16_bf16(pa0,PK(0),o[d0],0,0,0);
    o[d0]=__builtin_amdgcn_mfma_f32_32x32x16_bf16(pa1,PK(1),o[d0],0,0,0);
    o[d0]=__builtin_amdgcn_mfma_f32_32x32x16_bf16(pa2,PK(2),o[d0],0,0,0);
    o[d0]=__builtin_amdgcn_mfma_f32_32x32x16_bf16(pa3,PK(3),o[d0],0,0,0);
    #undef PK
  }
}

#ifndef ATTN_STORE16
#define ATTN_STORE16(p,v) (*(u32x4*)(p)=(v))
#endif
template<int THRL> __device__ __forceinline__ void attn_unit(int b,int qb,const bf16*Q,const bf16*__restrict__ K,const bf16*__restrict__ V,bf16*O,char*shm){
  int tid_l=threadIdx.x; asm volatile("":"+v"(tid_l)); const int tid=tid_l,lane=tid&63,r32=lane&31,hi=lane>>5; const int wid=__builtin_amdgcn_readfirstlane(tid>>6);
  const long rowbase=(long)b*SEQ; const int q0=qb*QB;
  const bf16*Qw=Q+(rowbase+q0+wid*QBLK)*PQK;
  const bf16*Kh=K+rowbase*PQK,*Vh=V+rowbase*PQK;
  const unsigned lds0=(unsigned)(uintptr_t)shm;
  float*wsf=(float*)(shm+LDS_WS)+wid*64;
  const bf16*ksrc=Kh+(long)lane*PQK+wid*8;
  const bf16*vsrc=Vh+(long)(16*(wid&3)+(lane>>2))*PQK+(wid>>2)*32+(lane&3)*8;
  const unsigned kdst=lds0+LDS_K+wid*1024, vdst=lds0+LDS_V+wid*1024;
  #define DMA_K(t,slot) glds16(ksrc+(long)(t)*KVBLK*PQK,(unsigned)__builtin_amdgcn_readfirstlane(kdst+(slot)))
  #define DMA_V(t,slot) glds16(vsrc+(long)(t)*KVBLK*PQK,(unsigned)__builtin_amdgcn_readfirstlane(vdst+(slot)))
  const int vb0=(int)(lds0+LDS_V)+((lane>>4)&1)*32+(lane&3)*8+(4*hi+((lane&15)>>2))*64;
  const char*Kbase=shm+LDS_K; bf16x8 kf[8];
  const lds_cptr shm3=(lds_cptr)shm; const lds_cptr kp0=shm3+LDS_K+hi*1024+r32*16; const lds_cptr vp0=shm3+LDS_V+((lane>>4)&1)*32+(lane&3)*8+(4*hi+((lane&15)>>2))*64;
  const int NT=(q0+QB)/KVBLK;
  DMA_K(0,0);DMA_V(0,0);DMA_K(1,SLOTB);
  bf16x8 qr[4];
  #pragma unroll
  for(int d0=0;d0<4;++d0)qr[d0]=*reinterpret_cast<const bf16x8*>(&Qw[(long)r32*PQK+d0*16+hi*8]);
  float mhat=0.f,l_reg=0.f;f32x16 o[2];o[0]=f32x16{};o[1]=f32x16{};f32x16 negm=f32x16{};asm volatile("":"+v"(negm));
  const int qrel=wid*QBLK+r32;
  #define CMASK(P0,P1,t) do{int jb_=(t)-(NT-4); if(jb_>=0)cmask(P0,P1,jb_,qrel,hi);}while(0)
  bool resc=false;
  #define START(P0,P1) do{ const float rm=rowmax(P0,P1); resc=false; \
    { const float dl=rm; mhat=fadd_s(mhat,dl); \
      _Pragma("unroll") for(int r=0;r<16;++r){P0[r]=fsub_s(P0[r],dl);P1[r]=fsub_s(P1[r],dl);} \
      _Pragma("unroll") for(int r=0;r<16;++r)negm[r]=-mhat; asm volatile("":"+v"(negm)); } \
    _Pragma("unroll") for(int r=0;r<16;++r)P0[r]=__builtin_amdgcn_exp2f(P0[r]); }while(0)
  #define RESC() do{ if(resc){ asm volatile("s_waitcnt lgkmcnt(0)":::"memory"); \
      _Pragma("unroll") for(int d_=0;d_<2;++d_) _Pragma("unroll") for(int r=0;r<16;++r)o[d_][r]*=wsf[crow(r,hi)]; } }while(0)
  f32x16 pA0,pA1,pB0,pB1;
  int sl_prev=0,sl_cur=0,sl_next=SLOTB;
  #define ROT() do{sl_prev=sl_cur;sl_cur=sl_next;sl_next=(sl_next==(NSLOT-1)*SLOTB)?0:sl_next+SLOTB;}while(0)
  DMA_K(2,2*SLOTB);
  WAIT_BAR(3);
  qkt(pA0,pA1,Kbase,qr,negm,r32,hi);asm volatile("s_nop 15\n\ts_nop 7":"+v"(pA0),"+v"(pA1));CMASK(pA0,pA1,0);
  START(pA0,pA1);
  _Pragma("unroll") for(int r=0;r<16;++r)pA1[r]=__builtin_amdgcn_exp2f(pA1[r]);
  WAIT_BAR(0);
  DMA_K(3,0);DMA_V(1,SLOTB);
  ROT();
  kload8(kf,kp0+sl_cur);
  WAIT_BAR(2);
  s16x4 vlo[8],vhi[8]; u32x4 pw0,pw1,pw2,pw3;
  #define PKW(P,B) cvtpk_s(P[B],P[B+1])
  #define PAF(k) __builtin_bit_cast(bf16x8,pw##k)
  #define VFR(i) (bf16x8){vlo[i][0],vlo[i][1],vlo[i][2],vlo[i][3],vhi[i][0],vhi[i][1],vhi[i][2],vhi[i][3]}
  #define PIN(x) asm volatile("":"+v"(x))
  #define MX3(a,b,c) __builtin_fmaxf(__builtin_fmaxf((a),(b)),(c))
  #define GAPA(MF,A0,A1,A2,A3,W0,W1,PW) do{ MF; sacc+=A0; sacc+=A1; sacc+=A2; sacc+=A3; PIN(sacc); W0; W1; PIN(PW); SBAR(); }while(0)
  #define EX(v) __builtin_amdgcn_exp2f(v)
  #define GAPB(MF,X,B) do{ MF; X[B]=EX(X[B]); X[B+1]=EX(X[B+1]); X[B+2]=EX(X[B+2]); X[B+3]=EX(X[B+3]); PIN(X); SBAR(); }while(0)
  #define VRD(i) do{ vlo[i]=vtr(vp_+(((i)>>2)*4096+((i)&3)*1024)); vhi[i]=vtr(vp_+(((i)>>2)*4096+((i)&3)*1024+512)); }while(0)
  #define KRD(G,j) do{ if(G){ kload2(kf,kp0+sl_next,j); SBAR(); } }while(0)
  #define STEP(C0,C1,P0,P1,t,GK,GV,GL) do{ SBAR(); \
    const lds_cptr vp_=vp0+sl_prev; \
    VRD(0); SBAR(); float sacc=(P0[0]+P0[1]); \
    GAPA(C0=__builtin_amdgcn_mfma_f32_32x32x16_bf16(kf[0],qr[0],negm,0,0,0), P0[2],P0[3],P0[4],P0[5],     pw0[0]=PKW(P0,0), pw0[1]=PKW(P0,2), pw0); \
    VRD(4); SBAR(); GAPA(C1=__builtin_amdgcn_mfma_f32_32x32x16_bf16(kf[1],qr[0],negm,0,0,0), P0[6],P0[7],P0[8],P0[9],     pw0[2]=PKW(P0,4), pw0[3]=PKW(P0,6), pw0); \
    VRD(1); SBAR(); GAPA(C0=__builtin_amdgcn_mfma_f32_32x32x16_bf16(kf[2],qr[1],C0,0,0,0),   P0[10],P0[11],P0[12],P0[13], pw1[0]=PKW(P0,8), pw1[1]=PKW(P0,10), pw1); \
    VRD(5); SBAR(); GAPA(C1=__builtin_amdgcn_mfma_f32_32x32x16_bf16(kf[3],qr[1],C1,0,0,0),   P0[14],P0[15],P1[0],P1[1],   pw1[2]=PKW(P0,12),pw1[3]=PKW(P0,14), pw1); \
    VRD(2); SBAR(); GAPA(C0=__builtin_amdgcn_mfma_f32_32x32x16_bf16(kf[4],qr[2],C0,0,0,0),   P1[2],P1[3],P1[4],P1[5],     pw2[0]=PKW(P1,0), pw2[1]=PKW(P1,2), pw2); \
    VRD(6); SBAR(); GAPA(C1=__builtin_amdgcn_mfma_f32_32x32x16_bf16(kf[5],qr[2],C1,0,0,0),   P1[6],P1[7],P1[8],P1[9],     pw2[2]=PKW(P1,4), pw2[3]=PKW(P1,6), pw2); \
    VRD(3); SBAR(); GAPA(C0=__builtin_amdgcn_mfma_f32_32x32x16_bf16(kf[6],qr[3],C0,0,0,0),   P1[10],P1[11],P1[12],P1[13], pw3[0]=PKW(P1,8), pw3[1]=PKW(P1,10), pw3); \
    VRD(7); SBAR(); GAPA(C1=__builtin_amdgcn_mfma_f32_32x32x16_bf16(kf[7],qr[3],C1,0,0,0),   P1[14],P1[15],0.f,0.f,       pw3[2]=PKW(P1,12),pw3[3]=PKW(P1,14), pw3); \
    l_reg+=sacc; \
    if(GK){DMA_K((t)+3,sl_cur);} if(GV){DMA_V((t)+1,sl_next);} \
    CMASK(C0,C1,t); \
    { float a=MX3(C0[0],C0[1],C1[0]),b=MX3(C0[2],C0[3],C1[1]); a=MX3(a,C1[2],C1[3]); \
      _Pragma("unroll") for(int r=4;r<16;r+=4){a=MX3(a,C0[r],C0[r+1]);b=MX3(b,C0[r+2],C0[r+3]);a=MX3(a,C1[r],C1[r+1]);b=MX3(b,C1[r+2],C1[r+3]);} \
      float rm=__builtin_fmaxf(a,b); { auto rr=__builtin_amdgcn_permlane32_swap(__float_as_uint(rm),__float_as_uint(rm),false,false); rm=__builtin_fmaxf(__uint_as_float(rr[0]),__uint_as_float(rr[1])); } \
      resc=false; \
      if(__builtin_expect(__any(rm>(float)THRL),0)){ const float dl=__builtin_fmaxf(rm,0.f); mhat+=dl; \
        _Pragma("unroll") for(int r=0;r<16;++r){C0[r]-=dl;C1[r]-=dl;} \
        _Pragma("unroll") for(int r=0;r<16;++r)negm[r]=-mhat; asm volatile("":"+v"(negm)); \
        const float f=__builtin_amdgcn_exp2f(-dl); l_reg*=f; if(hi==0)wsf[r32]=f; resc=true; } } \
    SBAR(); \
    GAPB(o[0]=__builtin_amdgcn_mfma_f32_32x32x16_bf16(PAF(0),VFR(0),o[0],0,0,0), C0,0); \
    GAPB(o[1]=__builtin_amdgcn_mfma_f32_32x32x16_bf16(PAF(0),VFR(4),o[1],0,0,0), C0,4); \
    KRD(GL,0); GAPB(o[0]=__builtin_amdgcn_mfma_f32_32x32x16_bf16(PAF(1),VFR(1),o[0],0,0,0), C0,8); \
    KRD(GL,1); GAPB(o[1]=__builtin_amdgcn_mfma_f32_32x32x16_bf16(PAF(1),VFR(5),o[1],0,0,0), C0,12); \
    KRD(GL,2); GAPB(o[0]=__builtin_amdgcn_mfma_f32_32x32x16_bf16(PAF(2),VFR(2),o[0],0,0,0), C1,0); \
    KRD(GL,3); GAPB(o[1]=__builtin_amdgcn_mfma_f32_32x32x16_bf16(PAF(2),VFR(6),o[1],0,0,0), C1,4); \
    GAPB(o[0]=__builtin_amdgcn_mfma_f32_32x32x16_bf16(PAF(3),VFR(3),o[0],0,0,0), C1,8); \
    GAPB(o[1]=__builtin_amdgcn_mfma_f32_32x32x16_bf16(PAF(3),VFR(7),o[1],0,0,0), C1,12); \
    }while(0)
  int t=1;
  #undef CMASK
  #define CMASK(P0,P1,t) do{}while(0)
  for(;t+5<NT;t+=2){
    STEP(pB0,pB1,pA0,pA1,t,true,true,true);     WAIT_BAR(2); RESC(); ROT();
    STEP(pA0,pA1,pB0,pB1,t+1,true,true,true);   WAIT_BAR(2); RESC(); ROT();
  }
  #undef CMASK
  #define CMASK(P0,P1,t) do{int jb_=(t)-(NT-4); if(jb_>=0)cmask(P0,P1,jb_,qrel,hi);}while(0)
  #define ENDW(tt) do{ if((tt)+3<NT){WAIT_BAR(2);} else if((tt)+2<NT){WAIT_BAR(1);} else {WAIT_BAR(0);} }while(0)
  for(;t+1<NT;t+=2){
    STEP(pB0,pB1,pA0,pA1,t,(t+3<NT),(t+1<NT),(t+1<NT));       ENDW(t);   RESC(); ROT();
    STEP(pA0,pA1,pB0,pB1,t+1,(t+4<NT),(t+2<NT),(t+2<NT));     ENDW(t+1); RESC(); ROT();
  }
  STEP(pB0,pB1,pA0,pA1,NT-1,false,false,false); RESC();
  { float sacc=pB0[0]+pB0[1]; _Pragma("unroll") for(int r=2;r<16;++r)sacc+=pB0[r]; _Pragma("unroll") for(int r=0;r<16;++r)sacc+=pB1[r]; l_reg+=sacc;
    pw0=(u32x4){PKW(pB0,0),PKW(pB0,2),PKW(pB0,4),PKW(pB0,6)};pw1=(u32x4){PKW(pB0,8),PKW(pB0,10),PKW(pB0,12),PKW(pB0,14)};pw2=(u32x4){PKW(pB1,0),PKW(pB1,2),PKW(pB1,4),PKW(pB1,6)};pw3=(u32x4){PKW(pB1,8),PKW(pB1,10),PKW(pB1,12),PKW(pB1,14)};
    SBAR(); pv(o,vb0+sl_cur,PAF(0),PAF(1),PAF(2),PAF(3)); }
  #undef PKW
  #undef PAF
  #undef VFR
  #undef PIN
  #undef MX3
  #undef GAPA
  #undef GAPB
  #undef EX
  #undef VRD
  #undef KRD
  #undef STEP
  #undef ENDW
  {auto rr=__builtin_amdgcn_permlane32_swap(__float_as_uint(l_reg),__float_as_uint(l_reg),false,false);l_reg=__uint_as_float(rr[0])+__uint_as_float(rr[1]);}
  if(hi==0)wsf[32+r32]=l_reg;asm volatile("s_waitcnt lgkmcnt(0)":::"memory");
  float rli[16];
  #pragma unroll
  for(int r=0;r<16;++r)rli[r]=__builtin_amdgcn_rcpf(wsf[32+crow(r,hi)]);
  bf16*Ow=O+(rowbase+q0+wid*QBLK)*PO;
  { bf16*stg=(bf16*)(shm+LDS_OST)+wid*2048;
    #pragma unroll
    for(int r=0;r<16;++r){const int orow=crow(r,hi);
      #pragma unroll
      for(int d0=0;d0<2;++d0)stg[orow*64+d0*32+r32]=__float2bfloat16(o[d0][r]*rli[r]);}
    asm volatile("s_waitcnt lgkmcnt(0)":::"memory");
    #pragma unroll
    for(int i=0;i<4;++i){const int row=i*8+(lane>>3),ch=lane&7; const u32x4 v=*(const u32x4*)(stg+row*64+ch*8); ATTN_STORE16(Ow+(long)row*PO+ch*8,v);} }
  asm volatile("s_waitcnt lgkmcnt(0)\n\ts_barrier":::"memory");
  #undef DMA_K
  #undef DMA_V
  #undef CMASK
  #undef START
  #undef RESC
  #undef ROT
}
#undef SBAR
#undef WAIT_BAR
}
namespace cg = cooperative_groups;
#define LAS __attribute__((address_space(3)))
typedef unsigned short bf16;
typedef unsigned v4u __attribute__((ext_vector_type(4)));
typedef unsigned v2u __attribute__((ext_vector_type(2)));
typedef float f32x4 __attribute__((ext_vector_type(4)));
typedef float f32x2 __attribute__((ext_vector_type(2)));
typedef float f32x16 __attribute__((ext_vector_type(16)));
typedef short bf16x8 __attribute__((ext_vector_type(8)));

constexpr int NWAVES = 8;
constexpr int D = 1024, MP = 16384, MS = 256, M = MP + MS, FF = 2816, DIN = 2560;
constexpr float EPS = 1e-6f;
constexpr float C2 = 0.125f * 1.4426950408889634f;
constexpr size_t OFF_Y = 0, OFF_KP = 17039360, OFF_VP = 33816576, OFF_PP = 50593792, OFF_CP = 50655232, OFF_KS = 50663424, OFF_VS = 50925568, OFF_PS = 51187712, OFF_CS = 51249152, OUT_TOTAL = 51257344;
constexpr size_t MiB = 1u << 20;
constexpr size_t WS_ROPE = 1 * MiB, WS_POOLWT = 2 * MiB, WS_W = 4 * MiB, WL = 40 * MiB;
constexpr size_t W_GU1 = 0, W_D1 = 11 * MiB, W_IN = 16 * MiB + MiB / 2, W_OUT = 21 * MiB + MiB / 2, W_GU2 = 23 * MiB + MiB / 2, W_D2 = 34 * MiB + MiB / 2;
constexpr size_t WS_X = 84 * MiB, WS_H = 149 * MiB, WS_MIX = 182 * MiB, WS_ACT = 215 * MiB;
constexpr size_t WS_QB = 215 * MiB, WS_KB = 232 * MiB, WS_VB = 249 * MiB, WS_ZB = 266 * MiB;
constexpr size_t WS_OB = 305 * MiB, WS_OPART = 338 * MiB, WS_ML = 347 * MiB, WS_END = 352 * MiB;
static_assert(WS_ROPE == pg8::WOFF_ROPE && WS_QB == pg8::WOFF_QB && WS_KB == pg8::WOFF_KB && WS_VB == pg8::WOFF_VB && WS_ZB == pg8::WOFF_ZB && OFF_KP == pg8::OOFF_KP && OFF_VP == pg8::OOFF_VP && OFF_PP == pg8::OOFF_PP && OFF_KS == pg8::OOFF_KS && OFF_VS == pg8::OOFF_VS && OFF_PS == pg8::OOFF_PS, "offsets");
static_assert(WS_ACT + (size_t)M * FF * 2 <= WS_OB && WS_ZB + (size_t)M * 1024 * 2 <= WS_OB && WS_X + (size_t)M * D * 4 <= WS_H && WS_H + (size_t)M * D * 2 <= WS_MIX && WS_MIX + (size_t)M * D * 2 <= WS_ACT, "ws map");
static_assert(WS_OB + (size_t)M * 1024 * 2 <= WS_OPART && WS_OPART + (size_t)32 * 2 * 9 * 32 * 128 * 4 <= WS_ML && WS_ML + (size_t)32 * 2 * 9 * 32 * 2 * 4 <= WS_END, "ws map 2");
constexpr int LDS_BYTES = 147456;
constexpr size_t CTL_BYTES = 262144, CTL_CNT = 65536;
constexpr size_t WS_SLOTP = 350 * MiB, WS_SLOTS = 351 * MiB;

__device__ __forceinline__ unsigned pk2(float lo, float hi) { f32x2 v = {lo, hi}; typedef __bf16 b2 __attribute__((ext_vector_type(2))); b2 b = __builtin_convertvector(v, b2); return __builtin_bit_cast(unsigned, b); }
__device__ __forceinline__ float bf2f(unsigned short b) { return __builtin_bit_cast(float, (unsigned)b << 16); }
__device__ __forceinline__ bf16x8 pack8(f32x4 a, f32x4 b) { v4u w; w.x = pk2(a.x, a.y); w.y = pk2(a.z, a.w); w.z = pk2(b.x, b.y); w.w = pk2(b.z, b.w); return __builtin_bit_cast(bf16x8, w); }
__device__ __forceinline__ int crow(int r, int hi) { return (r & 3) + 8 * (r >> 2) + 4 * hi; }
__device__ __forceinline__ void xhalf_pair(float m, float& a, float& b) { a = m; b = m; asm volatile("s_nop 1\n\tv_permlane32_swap_b32 %0, %1\n\ts_nop 1" : "+v"(a), "+v"(b)); }
__device__ __forceinline__ float xhalf_max(float m) { float a, b; xhalf_pair(m, a, b); return fmaxf(a, b); }
__device__ __forceinline__ float xhalf_sum(float m) { float a, b; xhalf_pair(m, a, b); return a + b; }
template <int O> __device__ __forceinline__ float swz_xor(float v) { return __builtin_bit_cast(float, __builtin_amdgcn_ds_swizzle(__builtin_bit_cast(int, v), (O << 10) | 0x1f)); }
__device__ __forceinline__ float wave_sum(float v) {
    v += swz_xor<1>(v); v += swz_xor<2>(v); v += swz_xor<4>(v); v += swz_xor<8>(v); v += swz_xor<16>(v);
    return xhalf_sum(v);
}
#define LDS_WAIT() asm volatile("s_waitcnt lgkmcnt(0)" ::: "memory")

struct Params { const float* in[26]; float* out; unsigned char* ws; };
typedef const __attribute__((address_space(4))) unsigned char* karg_ptr;
__device__ __forceinline__ karg_ptr kargs() { karg_ptr k = (karg_ptr)__builtin_amdgcn_kernarg_segment_ptr(); asm volatile("" : "+s"(k)); return k; }
__device__ __forceinline__ const float* KIN(int i) { return *(const float* const __attribute__((address_space(4)))*)(kargs() + 8 * i); }
__device__ __forceinline__ float* KOUT() { return *(float* const __attribute__((address_space(4)))*)(kargs() + 8 * 26); }
__device__ __forceinline__ unsigned char* KWS() { return *(unsigned char* const __attribute__((address_space(4)))*)(kargs() + 8 * 27); }

template <int MODE> __device__ __forceinline__ int wmap(int nl, int row_off) {
    if (MODE == 0) return row_off + nl;
    if (MODE == 1) return (nl >> 7) * 256 + (nl & 127) + row_off;
    const int u = nl >> 8, lc = nl & 255, hc = lc >> 6, bjx = (lc >> 5) & 1, fqx = (lc >> 3) & 3, n = (lc >> 2) & 1, j = lc & 3;
    return u * 256 + 128 * bjx + 32 * hc + 16 * n + 4 * fqx + j;
}
template <int MODE> __device__ __forceinline__ void transpose_item(const float* W, int K, int N, bf16* WT, int row_off, LAS float* scr, int item, int lane) {
    const int nblk = N / 32, kb = item / nblk, nb = item % nblk, k0 = 64 * kb, n0 = 32 * nb;
#pragma unroll 8
    for (int i = 0; i < 32; ++i) { const int kk = 2 * i + (lane >> 5); scr[kk * 33 + (lane & 31)] = W[(size_t)(k0 + kk) * N + n0 + (lane & 31)]; }
    LDS_WAIT(); asm volatile("" ::: "memory");
    const int c = lane & 7;
#pragma unroll
    for (int j = 0; j < 4; ++j) { const int n = (lane >> 3) + 8 * j; const LAS float* s = scr + (8 * c) * 33 + n;
        v4u o; o.x = pk2(s[0 * 33], s[1 * 33]); o.y = pk2(s[2 * 33], s[3 * 33]); o.z = pk2(s[4 * 33], s[5 * 33]); o.w = pk2(s[6 * 33], s[7 * 33]);
        *(v4u*)(WT + (size_t)wmap<MODE>(n0 + n, row_off) * K + k0 + 8 * c) = o; }
    LDS_WAIT(); asm volatile("" ::: "memory");
}
__device__ __forceinline__ void prologue(LAS unsigned char* lds, int gw, int NGW, int wave, int lane) {
    LAS float* scr = (LAS float*)(lds + wave * 16384);
    constexpr int I_F = 16 * 88, I_IN = 16 * 80, I_OUT = 16 * 32, I_L = 6 * I_F + I_IN + I_OUT;
    for (int it = gw; it < 2 * I_L; it += NGW) {
        const int l = it / I_L; int r = it % I_L;
        unsigned char* wl = KWS() + WS_W + (size_t)l * WL;
        if (r < I_F) { transpose_item<1>(KIN(7) + (size_t)l * D * FF, D, FF, (bf16*)(wl + W_GU1), 0, scr, r, lane); continue; } r -= I_F;
        if (r < I_F) { transpose_item<1>(KIN(8) + (size_t)l * D * FF, D, FF, (bf16*)(wl + W_GU1), 128, scr, r, lane); continue; } r -= I_F;
        if (r < I_F) { transpose_item<0>(KIN(9) + (size_t)l * D * FF, FF, D, (bf16*)(wl + W_D1), 0, scr, r, lane); continue; } r -= I_F;
        if (r < I_IN) { transpose_item<2>(KIN(11) + (size_t)l * D * DIN, D, DIN, (bf16*)(wl + W_IN), 0, scr, r, lane); continue; } r -= I_IN;
        if (r < I_OUT) { transpose_item<0>(KIN(20) + (size_t)l * D * D, D, D, (bf16*)(wl + W_OUT), 0, scr, r, lane); continue; } r -= I_OUT;
        if (r < I_F) { transpose_item<1>(KIN(22) + (size_t)l * D * FF, D, FF, (bf16*)(wl + W_GU2), 0, scr, r, lane); continue; } r -= I_F;
        if (r < I_F) { transpose_item<1>(KIN(23) + (size_t)l * D * FF, D, FF, (bf16*)(wl + W_GU2), 128, scr, r, lane); continue; } r -= I_F;
        transpose_item<0>(KIN(24) + (size_t)l * D * FF, FF, D, (bf16*)(wl + W_D2), 0, scr, r, lane);
    }
    float* rope = (float*)(KWS() + WS_ROPE);
    for (int i = gw * 64 + lane; i < 2080 * 32; i += NGW * 64) {
        const int pr = i >> 5, d = i & 31; const int pos = pr < 2048 ? pr : 4096 + (pr - 2048);
        const float inv = exp2f(-(float)d * (13.287712379549449f / 32.0f));
        const float ang = (float)pos * inv;
        const double rev = (double)ang * 0.15915494309189535; const float fr = (float)(rev - __builtin_rint(rev));
        rope[pr * 64 + d] = __builtin_amdgcn_cosf(fr); rope[pr * 64 + 32 + d] = __builtin_amdgcn_sinf(fr);
    }
    bf16* pwt_ = (bf16*)(KWS() + WS_POOLWT);
    for (int i = gw * 64 + lane; i < 2 * 4 * 64 * 64; i += NGW * 64) {
        const int c = i & 63, e = (i >> 6) & 63, lg = i >> 12;
        pwt_[i] = (bf16)(pk2(KIN(17)[(size_t)lg * 4096 + c * 64 + e], 0.f) & 0xffffu);
    }
}
template <bool FINAL> __device__ __forceinline__ void norm_rows(const float* srcP, const float* srcS, const float* g, bf16* H, float* outf, int gw, int NGW, int lane) {
    const f32x4* g4 = (const f32x4*)g + lane;
    f32x4 gv[4];
#pragma unroll
    for (int j = 0; j < 4; ++j) gv[j] = g4[64 * j];
    for (int m = gw; m < M; m += NGW) {
        const float* xr = (m < MP) ? srcP + (size_t)m * D : srcS + (size_t)(m - MP) * D;
        const f32x4* x4 = (const f32x4*)xr + lane;
        f32x4 v[4]; float s = 0.f;
#pragma unroll
        for (int j = 0; j < 4; ++j) { v[j] = x4[64 * j]; s += (v[j].x * v[j].x + v[j].y * v[j].y) + (v[j].z * v[j].z + v[j].w * v[j].w); }
        const float rstd = 1.0f / sqrtf(wave_sum(s) * (1.0f / D) + EPS);
        if (FINAL) {
            f32x4* o4 = (f32x4*)(outf + (size_t)m * D) + lane;
#pragma unroll
            for (int j = 0; j < 4; ++j) o4[64 * j] = v[j] * rstd * gv[j];
        } else {
            v2u* o2 = (v2u*)(H + (size_t)m * D) + lane;
#pragma unroll
            for (int j = 0; j < 4; ++j) { const f32x4 y = v[j] * rstd * gv[j]; v2u w; w.x = pk2(y.x, y.y); w.y = pk2(y.z, y.w); o2[64 * j] = w; }
        }
    }
}
__device__ __forceinline__ f32x16 mfma32(bf16x8 a, bf16x8 b, f32x16 c) { return __builtin_amdgcn_mfma_f32_32x32x16_bf16(a, b, c, 0, 0, 0); }


template <bool BASE16, int K> __device__ __forceinline__ void skinny_part1(LAS unsigned char* lds, const bf16* A, const bf16* Bt, const void* base, bf16* out, float scale,
                                            unsigned* slots, unsigned* cnt8, int tile, int tid) {
    const int lane = tid & 63, r32 = lane & 31, hi = lane >> 5, wid = __builtin_amdgcn_readfirstlane(tid >> 6);
    LAS float* R = (LAS float*)lds;
    LAS float* PARK = (LAS float*)(lds + 131072);
    const int rt = tile >> 5, ct = tile & 31, kw = K >> 3, k0 = wid * kw;
    const int e = tid * 2, row = e >> 5, col = e & 31;
    const size_t o = (size_t)(rt * 32 + row) * 1024 + ct * 32 + col;
    f32x2 bv; if (BASE16) { const unsigned bw = *(const unsigned*)((const bf16*)base + o); bv.x = bf2f(bw & 0xffff); bv.y = bf2f(bw >> 16); } else bv = *(const f32x2*)((const float*)base + o);
    const bf16* ap = A + (size_t)(rt * 32 + r32) * K + wid * 16 + hi * 8; const bf16* bp = Bt + (size_t)(ct * 32 + r32) * K + wid * 16 + hi * 8; (void)k0;
    f32x16 acc;
#pragma unroll
    for (int r = 0; r < 16; ++r) acc[r] = 0.f;
    constexpr int NST = K / 128, UB = (NST % 11 == 0) ? 11 : 8;
#pragma unroll 1
    for (int s0 = 0; s0 < NST; s0 += UB) { bf16x8 av[UB], bw[UB];
#pragma unroll
        for (int j = 0; j < UB; ++j) { av[j] = *(const bf16x8*)(ap + (s0 + j) * 128); bw[j] = *(const bf16x8*)(bp + (s0 + j) * 128); }
#pragma unroll
        for (int j = 0; j < UB; ++j) acc = mfma32(av[j], bw[j], acc); }
    __syncthreads();
#pragma unroll
    for (int r = 0; r < 16; ++r) R[(wid * 32 + crow(r, hi)) * 32 + r32] = acc[r];
    __syncthreads();
    f32x2 s = {0.f, 0.f};
#pragma unroll
    for (int w = 0; w < 8; ++w) s += *(const LAS f32x2*)(R + (w * 32 + row) * 32 + col);
    const f32x2 v = bv + s * scale;
    float ss = v.x * v.x + v.y * v.y; ss += swz_xor<1>(ss); ss += swz_xor<2>(ss); ss += swz_xor<4>(ss); ss += swz_xor<8>(ss);
    if ((tid & 15) == 0) __hip_atomic_store(slots + (size_t)(rt * 32 + row) * 32 + ct, __builtin_bit_cast(unsigned, ss), __ATOMIC_RELAXED, __HIP_MEMORY_SCOPE_AGENT);
    *(LAS f32x2*)(PARK + tid * 2) = v;
    asm volatile("s_waitcnt vmcnt(0)" ::: "memory");
    __syncthreads();
    if (tid == 0) __hip_atomic_fetch_add(cnt8 + 64 * rt, 1u, __ATOMIC_RELAXED, __HIP_MEMORY_SCOPE_AGENT);
    if (out) *(unsigned*)(out + o) = pk2(v.x, v.y);
    __syncthreads();
}
__device__ __forceinline__ void skinny_part2(LAS unsigned char* lds, bf16* hb, float* yout, const float* gain, unsigned* slots, unsigned* cnt8, int tile, int tid) {
    LAS float* PARK = (LAS float*)(lds + 131072);
    const int rt = tile >> 5, ct = tile & 31, e = tid * 2, row = e >> 5, col = e & 31;
    const size_t o = (size_t)(rt * 32 + row) * 1024 + ct * 32 + col;
    if (tid == 0) {
        unsigned spins = 0;
        while (__hip_atomic_load(cnt8 + 64 * rt, __ATOMIC_RELAXED, __HIP_MEMORY_SCOPE_AGENT) < 32u) { __builtin_amdgcn_s_sleep(2); if (++spins > (1u << 22)) break; }
        __builtin_amdgcn_fence(__ATOMIC_ACQUIRE, "agent");
        asm volatile("s_waitcnt vmcnt(0)" ::: "memory");
    }
    __syncthreads();
    const unsigned* sl = slots + (size_t)(rt * 32 + row) * 32 + (tid & 15) * 2;
    float tot = __builtin_bit_cast(float, __hip_atomic_load(sl, __ATOMIC_RELAXED, __HIP_MEMORY_SCOPE_AGENT)) + __builtin_bit_cast(float, __hip_atomic_load(sl + 1, __ATOMIC_RELAXED, __HIP_MEMORY_SCOPE_AGENT));
    tot += swz_xor<1>(tot); tot += swz_xor<2>(tot); tot += swz_xor<4>(tot); tot += swz_xor<8>(tot);
    const float r = 1.0f / sqrtf(tot * (1.0f / 1024.0f) + EPS);
    const f32x2 v = *(const LAS f32x2*)(PARK + tid * 2);
    const f32x2 gv = *(const f32x2*)(gain + ct * 32 + col); const f32x2 y = v * r * gv;
    if (hb) *(unsigned*)(hb + o) = pk2(y.x, y.y); else *(f32x2*)(yout + o) = y;
    __syncthreads();
}

__device__ __forceinline__ void sample_piece(LAS unsigned char* lds, int pc, int l, const bf16* Qb, const float* cache_k, const float* cache_v, const float* knew, const float* vnew, float* OPART, float* MLP, int tid) {
    const int lane = tid & 63, r32 = lane & 31, hi = lane >> 5, wid = __builtin_amdgcn_readfirstlane(tid >> 6);
    const int b = pc >> 5, h = (pc >> 3) & 3, s = pc & 7;
    const bf16* qrow = Qb + (size_t)(MP + b * 32 + r32) * 512 + h * 128 + hi * 8;
    LAS float* ML = (LAS float*)lds;
    LAS float* FAC = (LAS float*)(lds + 4096);
    LAS float* OX = (LAS float*)(lds + 8192);
    const bool extra = (s == 7) && (wid == 7);
    const size_t off = ((size_t)((l * 8 + b) * 4096 + (s * 8 + wid) * 64)) * 512 + h * 128;
    const size_t offx = ((size_t)(l * 8 + b) * 32) * 512 + h * 128;
    const float* Kt = cache_k + off; const float* Vt = cache_v + off; const float* Kx = knew + offx; const float* Vx = vnew + offx;
    float mrow[2], lrow[2]; bf16x8 pw[2][6];
#pragma unroll
    for (int c = 0; c < 2; ++c) {
        bf16x8 qf[4];
#pragma unroll
        for (int d0 = 0; d0 < 4; ++d0) qf[d0] = *(const bf16x8*)(qrow + c * 64 + d0 * 16);
        f32x16 sc[3];
        {
            LAS bf16* KS = (LAS bf16*)(lds + 8192) + wid * (64 * 72);
            f32x4 kr[16];
#pragma unroll
            for (int i = 0; i < 16; ++i) kr[i] = *(const f32x4*)(Kt + (size_t)(4 * i + (lane >> 4)) * 512 + c * 64 + 4 * (lane & 15));
#pragma unroll
            for (int i = 0; i < 16; ++i) { v2u w; w.x = pk2(kr[i].x, kr[i].y); w.y = pk2(kr[i].z, kr[i].w); *(LAS v2u*)(KS + (4 * i + (lane >> 4)) * 72 + 4 * (lane & 15)) = w; }
            LDS_WAIT();
#pragma unroll
            for (int kvb = 0; kvb < 2; ++kvb) {
                f32x16 a;
#pragma unroll
                for (int r = 0; r < 16; ++r) a[r] = 0.f;
#pragma unroll
                for (int d0 = 0; d0 < 4; ++d0) { const bf16x8 kf = *(const LAS bf16x8*)(KS + (kvb * 32 + r32) * 72 + d0 * 16 + hi * 8); a = mfma32(kf, qf[d0], a); }
                sc[kvb] = a;
            }
            LDS_WAIT();
        }
        if (extra) {
            f32x16 a;
#pragma unroll
            for (int r = 0; r < 16; ++r) a[r] = 0.f;
            const float* kp = Kx + (size_t)r32 * 512 + c * 64 + hi * 8;
#pragma unroll
            for (int d0 = 0; d0 < 4; ++d0) { const f32x4 x0 = *(const f32x4*)(kp + d0 * 16), x1 = *(const f32x4*)(kp + d0 * 16 + 4); a = mfma32(pack8(x0, x1), qf[d0], a); }
            sc[2] = a;
        } else {
#pragma unroll
            for (int r = 0; r < 16; ++r) sc[2][r] = -1e30f;
        }
        float mx = -1e30f;
#pragma unroll
        for (int r = 0; r < 16; ++r) mx = fmaxf(mx, fmaxf(fmaxf(sc[0][r], sc[1][r]), sc[2][r]));
        mx = xhalf_max(mx);
        float sum = 0.f;
#pragma unroll
        for (int kvb = 0; kvb < 3; ++kvb)
#pragma unroll
            for (int r = 0; r < 16; ++r) { const float pv = __builtin_amdgcn_exp2f(sc[kvb][r] - mx); sc[kvb][r] = pv; sum += pv; }
        sum = xhalf_sum(sum);
        mrow[c] = mx; lrow[c] = sum;
#pragma unroll
        for (int kvb = 0; kvb < 3; ++kvb)
#pragma unroll
            for (int hf = 0; hf < 2; ++hf) { v4u w; w.x = pk2(sc[kvb][8 * hf + 0], sc[kvb][8 * hf + 1]); w.y = pk2(sc[kvb][8 * hf + 2], sc[kvb][8 * hf + 3]);
                w.z = pk2(sc[kvb][8 * hf + 4], sc[kvb][8 * hf + 5]); w.w = pk2(sc[kvb][8 * hf + 6], sc[kvb][8 * hf + 7]); pw[c][2 * kvb + hf] = __builtin_bit_cast(bf16x8, w); }
    }
    asm volatile("" ::: "memory");
    f32x16 o[2][4];
#pragma unroll
    for (int c = 0; c < 2; ++c)
#pragma unroll
        for (int eb = 0; eb < 4; ++eb)
#pragma unroll
            for (int r = 0; r < 16; ++r) o[c][eb][r] = 0.f;
#pragma unroll
    for (int ks = 0; ks < 6; ++ks) {
        if (ks < 4 || extra) {
#pragma unroll
            for (int eb = 0; eb < 4; ++eb) {
                const float* vp = (ks < 4 ? Vt + (size_t)(ks * 16 + 4 * hi) * 512 : Vx + (size_t)((ks - 4) * 16 + 4 * hi) * 512) + eb * 32 + r32;
                f32x4 x0, x1;
                x0.x = vp[0 * 512]; x0.y = vp[1 * 512]; x0.z = vp[2 * 512]; x0.w = vp[3 * 512];
                x1.x = vp[8 * 512]; x1.y = vp[9 * 512]; x1.z = vp[10 * 512]; x1.w = vp[11 * 512];
                const bf16x8 vf = pack8(x0, x1);
                o[0][eb] = mfma32(pw[0][ks], vf, o[0][eb]); o[1][eb] = mfma32(pw[1][ks], vf, o[1][eb]);
            }
        }
    }
    if (hi == 0) {
#pragma unroll
        for (int c = 0; c < 2; ++c) { ML[((wid * 2 + c) * 32 + r32) * 2 + 0] = mrow[c]; ML[((wid * 2 + c) * 32 + r32) * 2 + 1] = lrow[c]; }
    }
    __syncthreads();
    const int pidx = s;
    if (tid < 64) {
        const int c = tid >> 5, q = tid & 31; float mw[8], lw[8]; float Mx = -1e30f;
#pragma unroll
        for (int w = 0; w < 8; ++w) { mw[w] = ML[((w * 2 + c) * 32 + q) * 2 + 0]; lw[w] = ML[((w * 2 + c) * 32 + q) * 2 + 1]; Mx = fmaxf(Mx, mw[w]); }
        float L = 0.f;
#pragma unroll
        for (int w = 0; w < 8; ++w) { const float fz = __builtin_amdgcn_exp2f(mw[w] - Mx); FAC[(w * 2 + c) * 32 + q] = fz; L += lw[w] * fz; }
        float* mp = MLP + ((size_t)((((b * 4 + h) * 2 + c) * 9 + pidx) * 32 + q)) * 2; mp[0] = Mx; mp[1] = L;
    }
    __syncthreads();
#pragma unroll
    for (int c = 0; c < 2; ++c) {
#pragma unroll
        for (int eb = 0; eb < 4; ++eb)
#pragma unroll
            for (int r = 0; r < 16; ++r) { const int q = crow(r, hi); OX[(wid * 32 + q) * 128 + eb * 32 + r32] = o[c][eb][r] * FAC[(wid * 2 + c) * 32 + q]; }
        __syncthreads();
        { const int idx = tid * 8, q = idx >> 7, e = idx & 127; f32x4 s0 = {0.f, 0.f, 0.f, 0.f}, s1 = {0.f, 0.f, 0.f, 0.f};
#pragma unroll
          for (int w = 0; w < 8; ++w) { s0 += *(const LAS f32x4*)(OX + (w * 32 + q) * 128 + e); s1 += *(const LAS f32x4*)(OX + (w * 32 + q) * 128 + e + 4); }
          float* dst = OPART + ((size_t)((((b * 4 + h) * 2 + c) * 9 + pidx) * 32 + q)) * 128 + e; *(f32x4*)dst = s0; *(f32x4*)(dst + 4) = s1; }
        __syncthreads();
    }
}

template <int W> __device__ __forceinline__ void pool_d(const LAS float* U, LAS bf16* Dd, int ch, int tbeg, int t0, bool smp) {
    float s = 0.f;
#pragma unroll
    for (int i = 0; i < W; ++i) s += U[(15 + tbeg - i) * 256 + ch];
#pragma unroll 8
    for (int k = 0; k < 32; ++k) {
        const int tt = tbeg + k; const float cur = U[(15 + tt) * 256 + ch];
        if (k > 0) s += cur - U[(15 + tt - W) * 256 + ch];
        const int pos = smp ? 4096 + tt : t0 + tt; const int cnt = (pos + 1 < W) ? pos + 1 : W;
        const float d = s * __builtin_amdgcn_rcpf((float)cnt) - cur;
        Dd[tt * 264 + ch] = (bf16)(pk2(d, 0.f) & 0xffffu);
    }
}
__device__ __forceinline__ f32x4 bf4_to_f32(v2u w) { f32x4 v; v.x = bf2f(w.x & 0xffff); v.y = bf2f(w.x >> 16); v.z = bf2f(w.y & 0xffff); v.w = bf2f(w.y >> 16); return v; }
__device__ __forceinline__ void poolconv_tile(LAS unsigned char* lds, int tl, int l, const bf16* Zb, bf16* MIX, const float* state_pool, const float* state_conv, const bf16* pwt, const float* pool_scale,
                                              const float* conv_w, float* out_cp, float* out_cs, int tid) {
    const int lane = tid & 63, r32 = lane & 31, hi = lane >> 5, wid = __builtin_amdgcn_readfirstlane(tid >> 6);
    int b, t0, TT, rowbase; bool smp;
    if (tl < 256) { b = tl >> 5; t0 = (tl & 31) * 64; TT = 64; rowbase = b * 2048 + t0; smp = false; }
    else { b = tl - 256; t0 = 0; TT = 32; rowbase = MP + b * 32; smp = true; }
    LAS float* U = (LAS float*)lds;
    LAS bf16* Dd = (LAS bf16*)(lds + 81920);
    {
        f32x4 uv[10];
#pragma unroll
        for (int k = 0; k < 10; ++k) {
            const int idx = tid + 512 * k, i = idx >> 6, c4 = (idx & 63) * 4; f32x4 v = {0.f, 0.f, 0.f, 0.f};
            if (i < 15 + TT) {
                if (i < 15 && smp) v = *(const f32x4*)(state_pool + (size_t)((l * 8 + b) * 15 + i) * 256 + c4);
                else if (i >= 15 || t0 - 15 + i >= 0) v = bf4_to_f32(*(const v2u*)(Zb + (size_t)(rowbase + i - 15) * 1024 + c4));
            }
            uv[k] = v;
        }
#pragma unroll
        for (int k = 0; k < 10; ++k) { const int idx = tid + 512 * k, i = idx >> 6, c4 = (idx & 63) * 4; if (i < 15 + TT) *(LAS f32x4*)(U + i * 256 + c4) = uv[k]; }
    }
    __syncthreads();
    {
        const int ch = tid & 255, th = tid >> 8, gi = __builtin_amdgcn_readfirstlane(ch >> 6);
        if (th * 32 < TT) {
            if (gi == 0) pool_d<2>(U, Dd, ch, th * 32, t0, smp); else if (gi == 1) pool_d<4>(U, Dd, ch, th * 32, t0, smp);
            else if (gi == 2) pool_d<8>(U, Dd, ch, th * 32, t0, smp); else pool_d<16>(U, Dd, ch, th * 32, t0, smp);
        }
    }
    __syncthreads();
    {
        const int gi = wid >> 1, th = wid & 1;
        if (th * 32 < TT) {
            f32x16 acc0, acc1;
#pragma unroll
            for (int r = 0; r < 16; ++r) { acc0[r] = 0.f; acc1[r] = 0.f; }
#pragma unroll
            for (int ks = 0; ks < 4; ++ks) {
                const bf16x8 a = *(const LAS bf16x8*)(Dd + (th * 32 + r32) * 264 + gi * 64 + ks * 16 + hi * 8);
                const bf16x8 b0 = *(const bf16x8*)(pwt + (size_t)((l * 4 + gi) * 64 + r32) * 64 + ks * 16 + hi * 8);
                const bf16x8 b1 = *(const bf16x8*)(pwt + (size_t)((l * 4 + gi) * 64 + 32 + r32) * 64 + ks * 16 + hi * 8);
                acc0 = mfma32(a, b0, acc0); acc1 = mfma32(a, b1, acc1);
            }
            const float sc0 = pool_scale[l * 256 + gi * 64 + r32], sc1 = pool_scale[l * 256 + gi * 64 + 32 + r32];
#pragma unroll
            for (int r = 0; r < 16; ++r) { const int tok = th * 32 + crow(r, hi); bf16* mp = MIX + (size_t)(rowbase + tok) * 1024 + 512 + gi * 64 + r32;
                mp[0] = (bf16)(pk2(acc0[r] * sc0, 0.f) & 0xffffu); mp[32] = (bf16)(pk2(acc1[r] * sc1, 0.f) & 0xffffu); }
        }
    }
    if (wid * 8 < TT) {
        const int cq = lane, tc = wid * 8;
        v2u hraw[10], graw[10], braw[8]; f32x4 hst[2];
        hst[0] = (f32x4){0.f, 0.f, 0.f, 0.f}; hst[1] = hst[0];
#pragma unroll
        for (int i = 0; i < 10; ++i) {
            const int ts = tc - 2 + i; hraw[i] = (v2u){0u, 0u}; graw[i] = (v2u){0u, 0u};
            if (ts >= 0 || (!smp && t0 + ts >= 0)) { const bf16* zr = Zb + (size_t)(rowbase + ts) * 1024 + 4 * cq; hraw[i] = *(const v2u*)(zr + 256); graw[i] = *(const v2u*)(zr + 768); }
        }
#pragma unroll
        for (int i = 0; i < 8; ++i) braw[i] = *(const v2u*)(Zb + (size_t)(rowbase + tc + i) * 1024 + 512 + 4 * cq);
        if (smp && tc == 0) { hst[0] = *(const f32x4*)(state_conv + (size_t)((l * 8 + b) * 2 + 0) * 256 + 4 * cq); hst[1] = *(const f32x4*)(state_conv + (size_t)((l * 8 + b) * 2 + 1) * 256 + 4 * cq); }
        const f32x4 cw0 = *(const f32x4*)(conv_w + l * 768 + 4 * cq), cw1 = *(const f32x4*)(conv_w + l * 768 + 256 + 4 * cq), cw2 = *(const f32x4*)(conv_w + l * 768 + 512 + 4 * cq);
        f32x4 cm2 = bf4_to_f32(graw[0]) * bf4_to_f32(hraw[0]), cm1 = bf4_to_f32(graw[1]) * bf4_to_f32(hraw[1]);
        if (smp && tc == 0) { cm2 = hst[0]; cm1 = hst[1]; }
#pragma unroll
        for (int i = 0; i < 8; ++i) {
            const int tt = tc + i;
            const f32x4 cv = bf4_to_f32(graw[i + 2]) * bf4_to_f32(hraw[i + 2]);
            const f32x4 y = bf4_to_f32(braw[i]) * (cw0 * cm2 + cw1 * cm1 + cw2 * cv);
            v2u w; w.x = pk2(y.x, y.y); w.y = pk2(y.z, y.w);
            *(v2u*)(MIX + (size_t)(rowbase + tt) * 1024 + 768 + 4 * cq) = w;
            if (smp) { if (tt >= 30) *(f32x4*)(out_cs + (size_t)((l * 8 + b) * 2 + tt - 30) * 256 + 4 * cq) = cv; }
            else if (t0 + tt >= 2046) *(f32x4*)(out_cp + (size_t)((l * 8 + b) * 2 + t0 + tt - 2046) * 256 + 4 * cq) = cv;
            cm2 = cm1; cm1 = cv;
        }
    }
    __syncthreads();
}

__device__ __forceinline__ void combine_phase(int l, const bf16* Ob_, const float* OPART_, const float* MLP_, bf16* MIX_, int gw, int NGW, int lane) {
    const float lam_init = (l == 0) ? 0.2f : 0.35550934f;
    float lam;
    { const float a = KIN(12)[l * 64 + lane] * KIN(13)[l * 64 + lane], c = KIN(14)[l * 64 + lane] * KIN(15)[l * 64 + lane];
      lam = __expf(wave_sum(a)) - __expf(wave_sum(c)) + lam_init; }
    const float g0 = KIN(16)[l * 128 + 2 * lane], g1 = KIN(16)[l * 128 + 2 * lane + 1];
    for (int base = gw * 8; base < MP * 4; base += NGW * 8) {
        float a0[8], a1[8];
        {
            unsigned w1[8], w2[8];
#pragma unroll
            for (int j = 0; j < 8; ++j) { const int wt = base + j, row = wt >> 2, h = wt & 3;
                w1[j] = *(const unsigned*)(Ob_ + (size_t)row * 1024 + h * 128 + 2 * lane); w2[j] = *(const unsigned*)(Ob_ + (size_t)row * 1024 + 512 + h * 128 + 2 * lane); }
#pragma unroll
            for (int j = 0; j < 8; ++j) { a0[j] = bf2f(w1[j] & 0xffff) - lam * bf2f(w2[j] & 0xffff); a1[j] = bf2f(w1[j] >> 16) - lam * bf2f(w2[j] >> 16); }
        }
        float ss[8];
#pragma unroll
        for (int j = 0; j < 8; ++j) ss[j] = a0[j] * a0[j] + a1[j] * a1[j];
#pragma unroll
        for (int j = 0; j < 8; ++j) ss[j] += swz_xor<1>(ss[j]);
#pragma unroll
        for (int j = 0; j < 8; ++j) ss[j] += swz_xor<2>(ss[j]);
#pragma unroll
        for (int j = 0; j < 8; ++j) ss[j] += swz_xor<4>(ss[j]);
#pragma unroll
        for (int j = 0; j < 8; ++j) ss[j] += swz_xor<8>(ss[j]);
#pragma unroll
        for (int j = 0; j < 8; ++j) ss[j] += swz_xor<16>(ss[j]);
#pragma unroll
        for (int j = 0; j < 8; ++j) { const int wt = base + j, row = wt >> 2, h = wt & 3;
            const float tot = xhalf_sum(ss[j]);
            const float r = (1.0f / sqrtf(tot * (1.0f / 128.0f) + EPS)) * (1.0f - lam_init);
            *(unsigned*)(MIX_ + (size_t)row * 1024 + h * 128 + 2 * lane) = pk2(a0[j] * r * g0, a1[j] * r * g1); }
    }
    for (int wt = MP * 4 + gw; wt < M * 4; wt += NGW) {
        const int row = wt >> 2, h = wt & 3, rs = row - MP, b = rs >> 5, q = rs & 31; float oc[2][2];
#pragma unroll
        for (int c = 0; c < 2; ++c) {
            const size_t pb = (size_t)(((b * 4 + h) * 2 + c) * 9);
            float mw[8], lw[8]; f32x2 ov[8]; float Mx = -1e30f;
#pragma unroll
            for (int pi = 0; pi < 8; ++pi) { const f32x2 ml = *(const f32x2*)(MLP_ + ((pb + pi) * 32 + q) * 2); mw[pi] = ml.x; lw[pi] = ml.y; ov[pi] = *(const f32x2*)(OPART_ + ((pb + pi) * 32 + q) * 128 + 2 * lane); }
#pragma unroll
            for (int pi = 0; pi < 8; ++pi) Mx = fmaxf(Mx, mw[pi]);
            float L = 0.f, s0 = 0.f, s1 = 0.f;
#pragma unroll
            for (int pi = 0; pi < 8; ++pi) { const float fz = __builtin_amdgcn_exp2f(mw[pi] - Mx); L += lw[pi] * fz; s0 += ov[pi].x * fz; s1 += ov[pi].y * fz; }
            const float il = 1.0f / L; oc[c][0] = s0 * il; oc[c][1] = s1 * il;
        }
        const float a0 = oc[0][0] - lam * oc[1][0], a1 = oc[0][1] - lam * oc[1][1];
        const float tot = wave_sum(a0 * a0 + a1 * a1);
        const float r = (1.0f / sqrtf(tot * (1.0f / 128.0f) + EPS)) * (1.0f - lam_init);
        *(unsigned*)(MIX_ + (size_t)row * 1024 + h * 128 + 2 * lane) = pk2(a0 * r * g0, a1 * r * g1);
    }
}

#ifndef PROBE_SLOW_ATTN
#define PROBE_SLOW_ATTN 0
#endif
#if PROBE_SLOW_ATTN
__device__ __forceinline__ void slow_attn_phase(int l, const bf16* Qb_, float* outp, const float* cache_k, const float* cache_v, bf16* MIX_, int gw, int NGW, int lane) {
    const float lam_init = (l == 0) ? 0.2f : 0.35550934f;
    float lam;
    { const float a = KIN(12)[l * 64 + lane] * KIN(13)[l * 64 + lane], c = KIN(14)[l * 64 + lane] * KIN(15)[l * 64 + lane];
      lam = __expf(wave_sum(a)) - __expf(wave_sum(c)) + lam_init; }
    const float g0 = KIN(16)[l * 128 + 2 * lane], g1 = KIN(16)[l * 128 + 2 * lane + 1];
    for (int wt = gw; wt < M * 4; wt += NGW) {
        const int row = wt >> 2, h = wt & 3;
        const float *K0, *V0, *K1, *V1; int n0, n1;
        if (row < MP) { const int b = row >> 11, t = row & 2047; K0 = outp + OFF_KP + ((size_t)l * MP + (size_t)b * 2048) * 512 + h * 128; V0 = outp + OFF_VP + ((size_t)l * MP + (size_t)b * 2048) * 512 + h * 128; n0 = ((t >> 6) + 1) * 64; K1 = K0; V1 = V0; n1 = 0; }
        else { const int rs = row - MP, b = rs >> 5; K0 = cache_k + ((size_t)(l * 8 + b) * 4096) * 512 + h * 128; V0 = cache_v + ((size_t)(l * 8 + b) * 4096) * 512 + h * 128; n0 = 4096;
               K1 = outp + OFF_KS + ((size_t)(l * 8 + b) * 32) * 512 + h * 128; V1 = outp + OFF_VS + ((size_t)(l * 8 + b) * 32) * 512 + h * 128; n1 = 32; }
        float oc[2][2];
#pragma unroll 1
        for (int c = 0; c < 2; ++c) {
            float q[64];
#pragma unroll
            for (int d = 0; d < 64; ++d) q[d] = bf2f(Qb_[(size_t)row * 512 + h * 128 + c * 64 + d]);
            float mx = -1e30f;
            for (int seg = 0; seg < 2; ++seg) { const float* Kp = seg ? K1 : K0; const int n = seg ? n1 : n0;
                for (int j0 = 0; j0 < n; j0 += 64) { const int j = j0 + lane; float s = -1e30f;
                    if (j < n) { const float* kr = Kp + (size_t)j * 512 + c * 64; s = 0.f;
#pragma unroll
                        for (int d = 0; d < 64; ++d) s += q[d] * kr[d]; }
                    mx = fmaxf(mx, s); } }
            mx = fmaxf(mx, swz_xor<1>(mx)); mx = fmaxf(mx, swz_xor<2>(mx)); mx = fmaxf(mx, swz_xor<4>(mx)); mx = fmaxf(mx, swz_xor<8>(mx)); mx = fmaxf(mx, swz_xor<16>(mx)); mx = xhalf_max(mx);
            float L = 0.f, o0 = 0.f, o1 = 0.f;
            for (int seg = 0; seg < 2; ++seg) { const float* Kp = seg ? K1 : K0; const float* Vp = seg ? V1 : V0; const int n = seg ? n1 : n0;
                for (int j0 = 0; j0 < n; j0 += 64) { const int j = j0 + lane; float pj = 0.f;
                    if (j < n) { const float* kr = Kp + (size_t)j * 512 + c * 64; float s = 0.f;
#pragma unroll
                        for (int d = 0; d < 64; ++d) s += q[d] * kr[d];
                        pj = __builtin_amdgcn_exp2f(s - mx); }
                    L += pj;
                    const int nn = (n - j0 < 64) ? n - j0 : 64;
                    for (int jj = 0; jj < nn; ++jj) { const float pb = __builtin_bit_cast(float, __builtin_amdgcn_readlane(__builtin_bit_cast(int, pj), jj));
                        const f32x2 vv = *(const f32x2*)(Vp + (size_t)(j0 + jj) * 512 + 2 * lane); o0 += pb * vv.x; o1 += pb * vv.y; } } }
            L = wave_sum(L);
            oc[c][0] = o0 / L; oc[c][1] = o1 / L;
        }
        const float a0 = oc[0][0] - lam * oc[1][0], a1 = oc[0][1] - lam * oc[1][1];
        const float ss = wave_sum(a0 * a0 + a1 * a1);
        const float r = (1.0f / sqrtf(ss * (1.0f / 128.0f) + EPS)) * (1.0f - lam_init);
        *(unsigned*)(MIX_ + (size_t)row * 1024 + h * 128 + 2 * lane) = pk2(a0 * r * g0, a1 * r * g1);
    }
}
#endif

#ifndef PROBE_SLOW_PC
#define PROBE_SLOW_PC 0
#endif
#if PROBE_SLOW_PC
__device__ __forceinline__ float zval(const bf16* Zb_, const float* st, int l, int b, bool smp, int rowbase, int t, int col, int hist) {
    if (t >= 0) return bf2f(Zb_[(size_t)(rowbase + t) * 1024 + col]);
    if (!smp) return 0.f;
    return st[(size_t)((l * 8 + b) * hist + (hist + t)) * 256 + (col & 255)];
}
__device__ __forceinline__ void slow_pc_phase(int l, const bf16* Zb_, bf16* MIX_, int gw, int NGW, int lane) {
    const float* sp = KIN(4); const float* scv = KIN(5); const float* pw = KIN(17); const float* psc = KIN(18); const float* cw = KIN(19);
    for (int wt = gw; wt < M * 4; wt += NGW) {
        const int row = wt >> 2, g = wt & 3; const bool smp = row >= MP;
        int b, t, rowbase; if (smp) { const int rs = row - MP; b = rs >> 5; t = rs & 31; rowbase = MP + b * 32; } else { b = row >> 11; t = row & 2047; rowbase = b * 2048; }
        const int w = 2 << g, ch = g * 64 + lane;
        float s = 0.f;
        for (int i = 0; i < w; ++i) { const int tt = t - i; s += zval(Zb_, sp, l, b, smp, rowbase, tt, ch, 15); }
        const int pos = smp ? 4096 + t : t; const int cnt = (pos + 1 < w) ? pos + 1 : w;
        const float d = s / (float)cnt - zval(Zb_, sp, l, b, smp, rowbase, t, ch, 15);
        float mine = 0.f;
        for (int e = 0; e < 64; ++e) { const float v = wave_sum(d * pw[(size_t)((l * 4 + g) * 64 + lane) * 64 + e]); if (e == lane) mine = v; }
        MIX_[(size_t)row * 1024 + 512 + ch] = (bf16)(pk2(mine * psc[l * 256 + ch], 0.f) & 0xffffu);
        float cvv[3];
#pragma unroll
        for (int k = 0; k < 3; ++k) { const int tt = t - 2 + k;
            if (tt >= 0) cvv[k] = bf2f(Zb_[(size_t)(rowbase + tt) * 1024 + 768 + ch]) * bf2f(Zb_[(size_t)(rowbase + tt) * 1024 + 256 + ch]);
            else cvv[k] = smp ? scv[(size_t)((l * 8 + b) * 2 + (2 + tt)) * 256 + ch] : 0.f; }
        const float bgv = bf2f(Zb_[(size_t)row * 1024 + 512 + ch]);
        const float y = bgv * (cw[l * 768 + ch] * cvv[0] + cw[l * 768 + 256 + ch] * cvv[1] + cw[l * 768 + 512 + ch] * cvv[2]);
        MIX_[(size_t)row * 1024 + 768 + ch] = (bf16)(pk2(y, 0.f) & 0xffffu);
    }
}
#endif

#define XB_TMO      128
#define XB_XCNT(j)  (256  + 64 * (j))
#define XB_XSUB(j)  (1280 + 64 * (j))
#define XB_XGEN(j)  (2304 + 64 * (j))
#define XB_TOP      3328
#define XB_TOPGEN   3392
#define XCD_BAR_WORDS 3456
#define XB_SPIN_CAP (1u << 18)
__device__ __forceinline__ unsigned xb_ld(unsigned* p)              { return __hip_atomic_load(p, __ATOMIC_RELAXED, __HIP_MEMORY_SCOPE_AGENT); }
__device__ __forceinline__ unsigned xb_add(unsigned* p, unsigned v) { return __hip_atomic_fetch_add(p, v, __ATOMIC_RELAXED, __HIP_MEMORY_SCOPE_AGENT); }
__device__ __forceinline__ unsigned xb_xcc_id() { return (unsigned)__builtin_amdgcn_s_getreg((3 << 11) | 20) & 0xFu; }
#define XB_SPIN(cond, bar) do { unsigned _sp = 0; while (cond) { __builtin_amdgcn_s_sleep(1); \
    if ((++_sp & 255u) == 0u) { if (xb_ld(&(bar)[XB_TMO])) break; if (_sp > XB_SPIN_CAP) { atomicAdd(&(bar)[XB_TMO], 1u); break; } } } } while (0)
__device__ __forceinline__ void xcd_barrier_complete(unsigned* bar, unsigned x, unsigned& nloc, unsigned& nx) {
    const unsigned G = gridDim.x * gridDim.y * gridDim.z;
    unsigned sum, cnt, mine, sp = 0u;
    for (;;) {
        sum = 0u; cnt = 0u; mine = 0u;
#pragma unroll
        for (unsigned j = 0; j < 16; ++j) { const unsigned c = xb_ld(&bar[XB_XCNT(j)]); sum += c; cnt += (c > 0u) ? 1u : 0u; mine = (j == x) ? c : mine; }
        if (sum == G) break;
        __builtin_amdgcn_s_sleep(1);
        if ((++sp & 255u) == 0u) { if (xb_ld(&bar[XB_TMO])) break; if (sp > XB_SPIN_CAP) { atomicAdd(&bar[XB_TMO], 1u); break; } }
    }
    nloc = mine > 0u ? mine : 1u; nx = cnt > 0u ? cnt : 1u;
}
__device__ __forceinline__ void xcd_barrier(unsigned* bar, unsigned x, volatile LAS unsigned* st) {
    asm volatile("s_waitcnt vmcnt(0)" ::: "memory");
    __syncthreads();
    if (threadIdx.x == 0) {
        __builtin_amdgcn_s_waitcnt(0);
        unsigned nloc = st[0], nx = st[1];
        if (nloc == 0u) { xcd_barrier_complete(bar, x, nloc, nx); st[0] = nloc; st[1] = nx; }
        const unsigned old = xb_add(&bar[XB_XSUB(x)], 1u);
        const unsigned gen = old / nloc;
        if (old + 1u == (gen + 1u) * nloc) {
            __builtin_amdgcn_fence(__ATOMIC_RELEASE, "agent");
            asm volatile("s_waitcnt vmcnt(0)" ::: "memory");
            const unsigned og = xb_add(&bar[XB_TOP], 1u);
            const unsigned tg = og / nx;
            if (og + 1u == (tg + 1u) * nx) xb_add(&bar[XB_TOPGEN], 1u);
            else XB_SPIN(xb_ld(&bar[XB_TOPGEN]) == tg, bar);
            __builtin_amdgcn_fence(__ATOMIC_ACQUIRE, "agent");
            xb_add(&bar[XB_XGEN(x)], 1u);
            asm volatile("s_waitcnt vmcnt(0)" ::: "memory");
        } else {
            XB_SPIN(xb_ld(&bar[XB_XGEN(x)]) == gen, bar);
            __builtin_amdgcn_fence(__ATOMIC_ACQUIRE, "agent");
            asm volatile("s_waitcnt vmcnt(0)" ::: "memory");
        }
    }
    __syncthreads();
}
#define CG_SYNC() do { asm volatile("s_waitcnt vmcnt(0) lgkmcnt(0)" ::: "memory"); grid.sync(); asm volatile("" ::: "memory"); } while (0)
#define GRID_SYNC() xcd_barrier((unsigned*)KWS() + 4096, xcc, (volatile LAS unsigned*)(lds + LDS_BYTES - 64))
__global__ void __launch_bounds__(NWAVES * 64, 2) mega_fwd(Params p) {
    extern __shared__ __attribute__((aligned(16))) unsigned char lds_raw[];
    LAS unsigned char* lds = (LAS unsigned char*)lds_raw;
    cg::grid_group grid = cg::this_grid();
    const int tid = threadIdx.x, lane = tid & 63, wave = __builtin_amdgcn_readfirstlane(tid >> 6);
    const int G = gridDim.x; const int bx = blockIdx.x; const int vcu0 = (G % 8 == 0) ? (bx % 8) * (G / 8) + bx / 8 : bx;
    const int NGW = G * NWAVES;
#define X ((bf16*)(ws + WS_X))
#define H ((bf16*)(ws + WS_H))
#define MIX ((bf16*)(ws + WS_MIX))
#define ACT ((bf16*)(ws + WS_ACT))
#define Qb ((bf16*)(ws + WS_QB))
#define Kb ((bf16*)(ws + WS_KB))
#define Vb ((bf16*)(ws + WS_VB))
#define Zb ((bf16*)(ws + WS_ZB))
#define Ob ((bf16*)(ws + WS_OB))
#define OPART ((float*)(ws + WS_OPART))
#define MLP ((float*)(ws + WS_ML))
#define pwt ((const bf16*)(ws + WS_POOLWT))
    if (tid < 16) ((LAS unsigned*)(lds + LDS_BYTES - 64))[tid] = 0u;
    const unsigned xcc = xb_xcc_id();
    if (tid == 0) (void)xb_add((unsigned*)KWS() + 4096 + XB_XCNT(xcc), 1u);
    __syncthreads();
    { const int gw = vcu0 * NWAVES + wave; prologue(lds, gw, NGW, wave, lane);
      norm_rows<false>(KIN(0), KIN(1), KIN(6), (bf16*)(KWS() + WS_H), nullptr, gw, NGW, lane); }
    CG_SYNC();
#define FRESH_IDS() int tid = threadIdx.x; asm volatile("" : "+v"(tid)); const int lane = tid & 63, wave = __builtin_amdgcn_readfirstlane(tid >> 6); int vcu = vcu0; asm volatile("" : "+s"(vcu)); const int gw = vcu * NWAVES + wave; (void)lane; (void)gw; (void)wave
#define CNT(nid, idx) ((unsigned*)(ws + CTL_CNT) + (size_t)((nid) * 80 + (idx)) * 64)
#pragma unroll 1
    for (int step = 0; step < 4; ++step) {
        const int l = step >> 1, f = step & 1;
        const bool first = (step == 0);
        { FRESH_IDS(); unsigned char* const ws = KWS(); unsigned char* const wl = ws + WS_W + (size_t)l * WL;
          pg8::Gemm g{H, (const bf16*)(wl + (f ? W_GU2 : W_GU1)), M, 2 * FF, D}; pg8::StaticOrder S; S.init(M, 2 * FF, G, bx);
          pg8::EpiSwiGLU E{ACT, FF};
          pg8::gemm_phase<pg8::EpiSwiGLU, pg8::StaticOrder, true, true>(lds, g, S, E); }
        GRID_SYNC();
        { FRESH_IDS(); unsigned char* const ws = KWS(); unsigned char* const wl = ws + WS_W + (size_t)l * WL;
          const bool last = (step == 3);
          const float* const gn = last ? KIN(25) : (f ? KIN(6) + (l + 1) * D : KIN(10) + l * D);
          const int nid = step * 2;
          float* const yo = KOUT() + OFF_Y;
          pg8::Gemm g{ACT, (const bf16*)(wl + (f ? W_D2 : W_D1)), MP, D, FF}; pg8::StaticOrder S; S.init(MP, D, G, bx);
          if (first) skinny_part1<false, FF>(lds, ACT + (size_t)MP * FF, (const bf16*)(wl + W_D1), KIN(1), X + (size_t)MP * D, 0.5f, (unsigned*)(ws + WS_SLOTS), CNT(nid, 64), vcu, tid);
          else skinny_part1<true, FF>(lds, ACT + (size_t)MP * FF, (const bf16*)(wl + (f ? W_D2 : W_D1)), X + (size_t)MP * D, last ? nullptr : X + (size_t)MP * D, 0.5f, (unsigned*)(ws + WS_SLOTS), CNT(nid, 64), vcu, tid);
          { pg8::Unit u0; const int pm0 = S.next(0, u0) ? u0.pm : 0;
            if (first) { pg8::EpiResidNorm<false> E{KIN(0), X, 0.5f, H, yo, gn, (unsigned*)(ws + WS_SLOTP), CNT(nid, pm0)};
                         pg8::gemm_phase<pg8::EpiResidNorm<false>, pg8::StaticOrder, false, true>(lds, g, S, E); }
            else { pg8::EpiResidNorm<true> E{X, last ? nullptr : X, 0.5f, last ? nullptr : H, yo, gn, (unsigned*)(ws + WS_SLOTP), CNT(nid, pm0)};
                   pg8::gemm_phase<pg8::EpiResidNorm<true>, pg8::StaticOrder, false, true>(lds, g, S, E); } }
          skinny_part2(lds, last ? nullptr : H + (size_t)MP * D, yo + (size_t)MP * D, gn, (unsigned*)(ws + WS_SLOTS), CNT(nid, 64), vcu, tid); }
        if (step == 3) break;
        GRID_SYNC();
        if (f == 0) {
            { FRESH_IDS(); unsigned char* const ws = KWS(); unsigned char* const wl = ws + WS_W + (size_t)l * WL;
              pg8::Gemm g{H, (const bf16*)(wl + W_IN), M, DIN, D}; pg8::StaticOrder S; S.init(M, DIN, G, bx);
              pg8::EpiWin E{ws, KOUT(), l, C2};
              pg8::gemm_phase<pg8::EpiWin, pg8::StaticOrder, true, true>(lds, g, S, E); }
            GRID_SYNC();
#pragma unroll 1
            for (int slot = 0; slot < 2; ++slot) {
              if (((slot ^ vcu0) & 1) == 0) {
                FRESH_IDS(); unsigned char* const ws = KWS();
                for (int i = 0; i < 4; ++i) {
                  const int L = i * G + vcu; if (L >= 1024) break;
                  const int bh = (L & 255) >> 1, sI = L & 1, ii = L >> 8;
                  const int qb = sI == 0 ? (ii == 0 ? 7 : ii == 1 ? 0 : ii == 2 ? 4 : 3) : (ii == 0 ? 6 : ii == 1 ? 1 : ii == 2 ? 5 : 2);
                  const int b = bh >> 4, vh = bh & 15, hh = vh >> 2, c = (vh >> 1) & 1, hf = vh & 1;
                  attn_body::attn_unit<8>(b, qb, (const attn_body::bf16*)(Qb + (hh * 2 + c) * 64), (const attn_body::bf16*)(Kb + (hh * 2 + c) * 64), (const attn_body::bf16*)(Vb + hh * 128 + hf * 64),
                                          (attn_body::bf16*)(Ob + c * 512 + hh * 128 + hf * 64), (char*)lds_raw);
                }
              } else {
                FRESH_IDS(); unsigned char* const ws = KWS(); float* const outp = KOUT();
                for (int pc = vcu; pc < 256; pc += G)
                  sample_piece(lds, pc, l, Qb, KIN(2), KIN(3), outp + OFF_KS, outp + OFF_VS, OPART, MLP, tid);
              }
              __syncthreads();
            }
            { FRESH_IDS(); unsigned char* const ws = KWS(); float* const outp = KOUT();
              for (int tl = vcu; tl < 264; tl += G)
                poolconv_tile(lds, tl, l, Zb, MIX, KIN(4), KIN(5), pwt, KIN(18), KIN(19), outp + OFF_CP, outp + OFF_CS, tid); }
            GRID_SYNC();
            { FRESH_IDS(); unsigned char* const ws = KWS();
              combine_phase(l, Ob, OPART, MLP, MIX, gw, NGW, lane); }
            GRID_SYNC();
            { FRESH_IDS(); unsigned char* const ws = KWS(); unsigned char* const wl = ws + WS_W + (size_t)l * WL;
              const float* const gn = KIN(21) + l * D; const int nid = step * 2 + 1;
              pg8::Gemm g{MIX, (const bf16*)(wl + W_OUT), MP, D, D}; pg8::StaticOrder S; S.init(MP, D, G, bx);
              skinny_part1<true, D>(lds, MIX + (size_t)MP * D, (const bf16*)(wl + W_OUT), X + (size_t)MP * D, X + (size_t)MP * D, 1.0f, (unsigned*)(ws + WS_SLOTS), CNT(nid, 64), vcu, tid);
              { pg8::Unit u0; const int pm0 = S.next(0, u0) ? u0.pm : 0;
                pg8::EpiResidNorm<true> E{X, X, 1.0f, H, nullptr, gn, (unsigned*)(ws + WS_SLOTP), CNT(nid, pm0)};
                pg8::gemm_phase<pg8::EpiResidNorm<true>, pg8::StaticOrder, false, true>(lds, g, S, E); }
              skinny_part2(lds, H + (size_t)MP * D, nullptr, gn, (unsigned*)(ws + WS_SLOTS), CNT(nid, 64), vcu, tid); }
            GRID_SYNC();
        }
    }
}

extern "C" void kernel_launch(void* const* d_in, const int* in_sizes, int n_in, void* d_out, int out_size, void* d_ws, size_t ws_size, hipStream_t stream) {
    static int grid = 0;
    if (grid == 0) {
        if (n_in != 26 || (size_t)out_size != OUT_TOTAL || ws_size < WS_END) { fprintf(stderr, "kernel_launch: unexpected problem shape: n_in %d out %d ws %zu\n", n_in, out_size, ws_size); grid = -1; return; }
        int dev = 0, cus = 0, per_cu = 0;
        if (hipGetDevice(&dev) != hipSuccess || hipDeviceGetAttribute(&cus, hipDeviceAttributeMultiprocessorCount, dev) != hipSuccess) { grid = -1; return; }
        if (hipFuncSetAttribute((const void*)mega_fwd, hipFuncAttributeMaxDynamicSharedMemorySize, LDS_BYTES) != hipSuccess) { fprintf(stderr, "kernel_launch: hipFuncSetAttribute failed\n"); grid = -1; return; }
        if (hipOccupancyMaxActiveBlocksPerMultiprocessor(&per_cu, (const void*)mega_fwd, NWAVES * 64, LDS_BYTES) != hipSuccess || per_cu < 1) { fprintf(stderr, "kernel_launch: occupancy query says %d\n", per_cu); per_cu = 1; }
        (void)hipGetLastError();
        grid = cus * per_cu;
    }
    if (grid < 0) return;
    if (hipMemsetAsync(d_ws, 0, CTL_BYTES, stream) != hipSuccess) { fprintf(stderr, "kernel_launch: memset failed\n"); return; }
    Params p{};
    for (int i = 0; i < 26; ++i) p.in[i] = (const float*)d_in[i];
    p.out = (float*)d_out; p.ws = (unsigned char*)d_ws;
    void* args[] = {&p};
    const hipError_t e = hipLaunchCooperativeKernel((const void*)mega_fwd, dim3(grid), dim3(NWAVES * 64), args, LDS_BYTES, stream);
    if (e != hipSuccess) fprintf(stderr, "kernel_launch: cooperative launch failed: %s (grid %d)\n", hipGetErrorString(e), grid);
}
```

```cpp
#include <hip/hip_runtime.h>
#include <hip/hip_cooperative_groups.h>
#include <cstdio>
#include <cstdint>
namespace pg8 {
#define PG8_LAS __attribute__((address_space(3)))
typedef unsigned short bf16_t;
typedef short bf16x8 __attribute__((ext_vector_type(8)));
typedef float f32x4 __attribute__((ext_vector_type(4)));
typedef unsigned u32x4 __attribute__((ext_vector_type(4)));
constexpr int BM = 256, BK = 64, HALF = 128, HTB = HALF * BK * 2  , STAGE_BYTES = 8 * HTB, NXCD = 8, WGM = 8;

__host__ __device__ __forceinline__ int lds_byte(int r, int c) { const int st = (r >> 4) * 2 + (c >> 5), rr = r & 15, cc = c & 31, ob = rr * 64 + cc * 2; return st * 1024 + (ob ^ (((ob >> 9) & 1) << 5)); }
__host__ __device__ __forceinline__ void stage_rc(int b, int& R, int& C) { const int st = b / 1024, sb = b % 1024, swz = sb ^ (((sb >> 9) & 1) << 5); R = (st >> 1) * 16 + swz / 64; C = (st & 1) * 32 + (swz % 64) / 2; }
__host__ __device__ __forceinline__ int perm32(int rho) { const int n = rho >> 4, i = rho & 15; return 8 * (i >> 2) + 4 * n + (i & 3); }

struct Unit { int pm, pn; };
struct Gemm { const bf16_t* A; const bf16_t* Bt; int M, N, K; };

struct StaticOrder {
    int nM, nN, nwg, G, c;
    __host__ __device__ __forceinline__ void init(int M, int N, int G_, int c_) { nM = M / BM; nN = N / BM; nwg = nM * nN; G = G_; c = c_; }
    __host__ __device__ __forceinline__ bool next(int i, Unit& u) const {
        const long L = (long)i * G + c; if (L >= nwg) return false;
        int wgid = (int)L; { const int q = nwg / NXCD, r = nwg % NXCD, xcd = wgid % NXCD, off = wgid / NXCD; wgid = (xcd < r ? xcd * (q + 1) : r * (q + 1) + (xcd - r) * q) + off; }
        const int nig = WGM * nN, gid = wgid / nig, fm = gid * WGM, gsz = (nM - fm) < WGM ? (nM - fm) : WGM;
        u.pm = fm + ((wgid % nig) % gsz); u.pn = (wgid % nig) / gsz; return true;
    }
    __device__ __forceinline__ void a_ready(const Unit&) const {}
    __device__ __forceinline__ void done(const Unit&) const {}
};

__device__ __forceinline__ unsigned cvt_pk_bf16(float lo, float hi) { unsigned r; asm volatile("v_cvt_pk_bf16_f32 %0, %1, %2" : "=v"(r) : "v"(lo), "v"(hi)); return r; }
typedef float f32x2 __attribute__((ext_vector_type(2)));
typedef unsigned u32x2 __attribute__((ext_vector_type(2)));
constexpr size_t WOFF_ROPE = (size_t)1 << 20, WOFF_QB = (size_t)215 << 20, WOFF_KB = (size_t)232 << 20, WOFF_VB = (size_t)249 << 20, WOFF_ZB = (size_t)266 << 20;
constexpr size_t OOFF_KP = 17039360, OOFF_VP = 33816576, OOFF_PP = 50593792, OOFF_KS = 50663424, OOFF_VS = 50925568, OOFF_PS = 51187712;
__device__ __forceinline__ float silu_mul(float g, float u) { const float e = __builtin_amdgcn_exp2f(-1.4426950408889634f * g); return g * u * __builtin_amdgcn_rcpf(1.0f + e); }
struct EpiSwiGLU {
    static constexpr bool PERM = true, AFTER_DRAIN = false;
    bf16_t* O; int ldc;
    __device__ __forceinline__ void operator()(const f32x4 (&acc)[2][2][4][2], const Unit& u, int wr, int wc, int fr, int fq) const {
        const int row0 = u.pm * BM + wr * 64 + fr; const int col0 = u.pn * 128 + wc * 32 + 8 * fq;
#pragma unroll
        for (int ai = 0; ai < 2; ++ai)
#pragma unroll
            for (int m = 0; m < 4; ++m) {
                bf16_t* p = O + (size_t)(row0 + ai * HALF + m * 16) * ldc + col0;
                const f32x4 g0 = acc[ai][0][m][0], g1 = acc[ai][0][m][1], u0 = acc[ai][1][m][0], u1 = acc[ai][1][m][1];
                u32x4 w;
                w.x = cvt_pk_bf16(silu_mul(g0[0], u0[0]), silu_mul(g0[1], u0[1])); w.y = cvt_pk_bf16(silu_mul(g0[2], u0[2]), silu_mul(g0[3], u0[3]));
                w.z = cvt_pk_bf16(silu_mul(g1[0], u1[0]), silu_mul(g1[1], u1[1])); w.w = cvt_pk_bf16(silu_mul(g1[2], u1[2]), silu_mul(g1[3], u1[3]));
                *(u32x4*)p = w;
                asm volatile("" ::: "memory");
            }
    }
};
struct EpiResid {
    static constexpr bool PERM = false, AFTER_DRAIN = false;
    const float* baseP; const float* baseS; float* out; float scale;
    __device__ __forceinline__ void operator()(const f32x4 (&acc)[2][2][4][2], const Unit& u, int wr, int wc, int fr, int fq) const {
        const int col0 = u.pn * BM + wc * 32 + 4 * fq;
#pragma unroll
        for (int ai = 0; ai < 2; ++ai)
#pragma unroll
            for (int m = 0; m < 4; ++m) {
                const int row = u.pm * BM + ai * HALF + wr * 64 + m * 16 + fr;
                const float* bp = (row < 16384) ? baseP + (size_t)row * 1024 : baseS + (size_t)(row - 16384) * 1024;
                float* op = out + (size_t)row * 1024;
#pragma unroll
                for (int bj = 0; bj < 2; ++bj)
#pragma unroll
                    for (int n = 0; n < 2; ++n) { const int c = col0 + bj * HALF + n * 16; const f32x4 b = *(const f32x4*)(bp + c); *(f32x4*)(op + c) = b + acc[ai][bj][m][n] * scale; }
                asm volatile("" ::: "memory");
            }
    }
};
constexpr float RMS_EPS = 1e-6f;
__device__ __forceinline__ float rstd_of(float ss) { return 1.0f / sqrtf(ss * (1.0f / 1024.0f) + RMS_EPS); }

#define PG8_RLX_AGENT __ATOMIC_RELAXED, __HIP_MEMORY_SCOPE_AGENT
template <bool BASE16> struct EpiResidNorm {
    static constexpr bool PERM = true, AFTER_DRAIN = true;
    const void* baseP; bf16_t* out; float scale; bf16_t* hb; float* yout; const float* gain; unsigned* slots; unsigned* cnt;
    __device__ __forceinline__ void fused(f32x4 (&acc)[2][2][4][2], const Unit& u, int wr, int wc, int fr, int fq, PG8_LAS unsigned char* lds, int wid, int lane) const {
        PG8_LAS float* P = (PG8_LAS float*)lds;
        PG8_LAS float* S = (PG8_LAS float*)(lds + 4096);
        const int col0 = u.pn * BM + wc * 32 + 8 * fq;
        if (BASE16) {
            u32x4 braw[2][4][2];
#pragma unroll
            for (int ai = 0; ai < 2; ++ai)
#pragma unroll
                for (int m = 0; m < 4; ++m) { const size_t ro = (size_t)(u.pm * BM + ai * HALF + wr * 64 + m * 16 + fr) * 1024;
#pragma unroll
                    for (int bj = 0; bj < 2; ++bj) braw[ai][m][bj] = *(const u32x4*)((const bf16_t*)baseP + ro + col0 + bj * HALF); }
#pragma unroll
            for (int ai = 0; ai < 2; ++ai)
#pragma unroll
                for (int m = 0; m < 4; ++m)
#pragma unroll
                    for (int bj = 0; bj < 2; ++bj) { const u32x4 bw = braw[ai][m][bj]; f32x4 b0, b1;
                        b0[0] = __builtin_bit_cast(float, bw.x << 16); b0[1] = __builtin_bit_cast(float, bw.x & 0xffff0000u); b0[2] = __builtin_bit_cast(float, bw.y << 16); b0[3] = __builtin_bit_cast(float, bw.y & 0xffff0000u);
                        b1[0] = __builtin_bit_cast(float, bw.z << 16); b1[1] = __builtin_bit_cast(float, bw.z & 0xffff0000u); b1[2] = __builtin_bit_cast(float, bw.w << 16); b1[3] = __builtin_bit_cast(float, bw.w & 0xffff0000u);
                        acc[ai][bj][m][0] = b0 + acc[ai][bj][m][0] * scale; acc[ai][bj][m][1] = b1 + acc[ai][bj][m][1] * scale; }
        }
#pragma unroll
        for (int ai = 0; ai < 2; ++ai)
#pragma unroll
            for (int m = 0; m < 4; ++m) {
                const int rl = ai * HALF + wr * 64 + m * 16 + fr; const size_t ro = (size_t)(u.pm * BM + rl) * 1024;
                float ss = 0.f;
#pragma unroll
                for (int bj = 0; bj < 2; ++bj) { const int c = col0 + bj * HALF; f32x4 v0, v1;
                    if (BASE16) { v0 = acc[ai][bj][m][0]; v1 = acc[ai][bj][m][1]; }
                    else { v0 = *(const f32x4*)((const float*)baseP + ro + c) + acc[ai][bj][m][0] * scale; v1 = *(const f32x4*)((const float*)baseP + ro + c + 4) + acc[ai][bj][m][1] * scale; acc[ai][bj][m][0] = v0; acc[ai][bj][m][1] = v1; }
                    if (out) { u32x4 w; w.x = cvt_pk_bf16(v0[0], v0[1]); w.y = cvt_pk_bf16(v0[2], v0[3]); w.z = cvt_pk_bf16(v1[0], v1[1]); w.w = cvt_pk_bf16(v1[2], v1[3]); *(u32x4*)(out + ro + c) = w; }
                    ss += ((v0[0] * v0[0] + v0[1] * v0[1]) + (v0[2] * v0[2] + v0[3] * v0[3])) + ((v1[0] * v1[0] + v1[1] * v1[1]) + (v1[2] * v1[2] + v1[3] * v1[3])); }
                ss += __builtin_bit_cast(float, __builtin_amdgcn_ds_swizzle(__builtin_bit_cast(int, ss), (16 << 10) | 0x1f));
                { float a = ss, b2 = ss; asm volatile("s_nop 1\n\tv_permlane32_swap_b32 %0, %1\n\ts_nop 1" : "+v"(a), "+v"(b2)); ss = a + b2; }
                if (fq == 0) P[rl * 4 + wc] = ss;
                if (!BASE16 && (m & 1)) asm volatile("" ::: "memory");
            }
        asm volatile("s_waitcnt lgkmcnt(0)\n\ts_barrier" ::: "memory");
        const int t = wid * 64 + lane;
        if (t < 256) { const float s = (P[t * 4] + P[t * 4 + 1]) + (P[t * 4 + 2] + P[t * 4 + 3]);
            __hip_atomic_store(slots + (size_t)(u.pm * BM + t) * 4 + u.pn, __builtin_bit_cast(unsigned, s), PG8_RLX_AGENT); }
        asm volatile("s_waitcnt vmcnt(0)" ::: "memory");
        if (wid < 4 && lane == 0) __hip_atomic_fetch_add(cnt, 1u, PG8_RLX_AGENT);
        if (wid == 0) {
            unsigned spins = 0;
            while ((unsigned)__builtin_amdgcn_readfirstlane(__hip_atomic_load(cnt, PG8_RLX_AGENT)) < 16u) { __builtin_amdgcn_s_sleep(2); if (++spins > (1u << 22)) break; }
            __builtin_amdgcn_fence(__ATOMIC_ACQUIRE, "agent");
        }
        asm volatile("s_waitcnt vmcnt(0) lgkmcnt(0)\n\ts_barrier" ::: "memory");
        if (t < 256) { const unsigned* sl = slots + (size_t)(u.pm * BM + t) * 4; float tot = 0.f;
#pragma unroll
            for (int k = 0; k < 4; ++k) tot += __builtin_bit_cast(float, __hip_atomic_load(sl + k, PG8_RLX_AGENT));
            S[t] = rstd_of(tot); }
        asm volatile("s_waitcnt lgkmcnt(0)\n\ts_barrier" ::: "memory");
        f32x4 g4[2][2];
#pragma unroll
        for (int bj = 0; bj < 2; ++bj)
#pragma unroll
            for (int n = 0; n < 2; ++n) g4[bj][n] = *(const f32x4*)(gain + col0 + bj * HALF + n * 4);
#pragma unroll
        for (int ai = 0; ai < 2; ++ai)
#pragma unroll
            for (int m = 0; m < 4; ++m) {
                const int rl = ai * HALF + wr * 64 + m * 16 + fr; const size_t ro = (size_t)(u.pm * BM + rl) * 1024; const float r = S[rl];
#pragma unroll
                for (int bj = 0; bj < 2; ++bj) { const int c = col0 + bj * HALF; const f32x4 y0 = acc[ai][bj][m][0] * r * g4[bj][0], y1 = acc[ai][bj][m][1] * r * g4[bj][1];
                    if (hb) { u32x4 w; w.x = cvt_pk_bf16(y0[0], y0[1]); w.y = cvt_pk_bf16(y0[2], y0[3]); w.z = cvt_pk_bf16(y1[0], y1[1]); w.w = cvt_pk_bf16(y1[2], y1[3]); *(u32x4*)(hb + ro + c) = w; }
                    else { __builtin_nontemporal_store(y0, (f32x4*)(yout + ro + c)); __builtin_nontemporal_store(y1, (f32x4*)(yout + ro + c + 4)); } }
            }
        asm volatile("s_waitcnt lgkmcnt(0)\n\ts_barrier" ::: "memory");
    }
};

struct EpiWin {
    static constexpr bool PERM = false, AFTER_DRAIN = false;
    unsigned char* ws; float* outp; int l; float qscale;
    __device__ __forceinline__ void operator()(const f32x4 (&acc)[2][2][4][2], const Unit& u, int wr, int wc, int fr, int fq) const {
        const int pn = u.pn;
        float invrev[2][4];
#pragma unroll
        for (int n = 0; n < 2; ++n)
#pragma unroll
            for (int j = 0; j < 4; ++j) invrev[n][j] = exp2f(-(float)(8 * fq + 4 * n + j) * (13.287712379549449f / 32.0f)) * 0.15915494309189535f;
        bf16_t* const Qb = (bf16_t*)(ws + WOFF_QB); bf16_t* const Kb = (bf16_t*)(ws + WOFF_KB); bf16_t* const Vb = (bf16_t*)(ws + WOFF_VB); bf16_t* const Zb = (bf16_t*)(ws + WOFF_ZB);
        float* const kP = outp + OOFF_KP + (size_t)l * 16384 * 512; float* const vP = outp + OOFF_VP + (size_t)l * 16384 * 512;
        float* const kS = outp + OOFF_KS + (size_t)l * 256 * 512; float* const vS = outp + OOFF_VS + (size_t)l * 256 * 512;
        float* const poolP = outp + OOFF_PP + (size_t)l * 8 * 15 * 256; float* const poolS = outp + OOFF_PS + (size_t)l * 8 * 15 * 256;
        const int c0 = 64 * wc + 8 * fq;
#pragma unroll
        for (int ai = 0; ai < 2; ++ai)
#pragma unroll
            for (int m = 0; m < 4; ++m) {
                const int row = u.pm * BM + ai * HALF + wr * 64 + m * 16 + fr;
                const bool smp = row >= 16384; const int rs = row - 16384;
                f32x4 v[2][2];
                if (pn < 4) {
                    const float posf = (float)(smp ? 4096 + (rs & 31) : (row & 2047));
#pragma unroll
                    for (int n = 0; n < 2; ++n) { f32x4 cs, sn;
#pragma unroll
                        for (int j = 0; j < 4; ++j) { const float rev = posf * invrev[n][j]; const float fr_ = rev - __builtin_rintf(rev); cs[j] = __builtin_amdgcn_cosf(fr_); sn[j] = __builtin_amdgcn_sinf(fr_); }
                        const f32x4 lo = acc[ai][0][m][n], hi = acc[ai][1][m][n];
                        v[0][n] = lo * cs - hi * sn; v[1][n] = hi * cs + lo * sn; }
                } else {
#pragma unroll
                    for (int bj = 0; bj < 2; ++bj)
#pragma unroll
                        for (int n = 0; n < 2; ++n) v[bj][n] = acc[ai][bj][m][n];
                }
#pragma unroll
                for (int bj = 0; bj < 2; ++bj) {
                    const int lc = c0 + 32 * bj; const f32x4 x0 = v[bj][0], x1 = v[bj][1];
                    if (pn < 2) {
                        bf16_t* q = Qb + (size_t)row * 512 + 256 * pn + lc;
                        u32x4 w; w.x = cvt_pk_bf16(x0[0] * qscale, x0[1] * qscale); w.y = cvt_pk_bf16(x0[2] * qscale, x0[3] * qscale); w.z = cvt_pk_bf16(x1[0] * qscale, x1[1] * qscale); w.w = cvt_pk_bf16(x1[2] * qscale, x1[3] * qscale);
                        *(u32x4*)q = w;
                    } else {
                        u32x4 w; w.x = cvt_pk_bf16(x0[0], x0[1]); w.y = cvt_pk_bf16(x0[2], x0[3]); w.z = cvt_pk_bf16(x1[0], x1[1]); w.w = cvt_pk_bf16(x1[2], x1[3]);
                        if (pn < 4) { const int col = 256 * (pn - 2) + lc; float* ko = smp ? kS + (size_t)rs * 512 + col : kP + (size_t)row * 512 + col;
                            if (smp) { *(f32x4*)ko = x0; *(f32x4*)(ko + 4) = x1; } else { __builtin_nontemporal_store(x0, (f32x4*)ko); __builtin_nontemporal_store(x1, (f32x4*)(ko + 4)); }
                            *(u32x4*)(Kb + (size_t)row * 512 + col) = w; }
                        else if (pn < 6) { const int col = 256 * (pn - 4) + lc; float* vo = smp ? vS + (size_t)rs * 512 + col : vP + (size_t)row * 512 + col;
                            if (smp) { *(f32x4*)vo = x0; *(f32x4*)(vo + 4) = x1; } else { __builtin_nontemporal_store(x0, (f32x4*)vo); __builtin_nontemporal_store(x1, (f32x4*)(vo + 4)); }
                            *(u32x4*)(Vb + (size_t)row * 512 + col) = w; }
                        else { *(u32x4*)(Zb + (size_t)row * 1024 + 256 * (pn - 6) + lc) = w;
                            if (pn == 6) {
                                if (smp) { const int b = rs >> 5, t = rs & 31; if (t >= 17) { float* po = poolS + (size_t)(b * 15 + t - 17) * 256 + lc; *(f32x4*)po = x0; *(f32x4*)(po + 4) = x1; } }
                                else { const int b = row >> 11, t = row & 2047; if (t >= 2033) { float* po = poolP + (size_t)(b * 15 + t - 2033) * 256 + lc; *(f32x4*)po = x0; *(f32x4*)(po + 4) = x1; } }
                            } }
                    }
                }
                asm volatile("" ::: "memory");
            }
    }
};
template <class Epi, class Sched, bool ALIGN_EPI = false, bool SP2 = false>
__device__ __forceinline__ void gemm_phase(PG8_LAS unsigned char* lds, const Gemm g, const Sched& S, const Epi& E) {
    int tid_l = threadIdx.x; asm volatile("" : "+v"(tid_l)); const int tid = tid_l, wid = __builtin_amdgcn_readfirstlane(tid >> 6), lane = tid & 63, wr = wid >> 2, wc = wid & 3, fr = lane & 15, fq = lane >> 4;
    const int K = g.K, nt = K / BK;
    unsigned voffA[2], voffB[2];
#pragma unroll
    for (int i = 0; i < 2; ++i) { int R, C; stage_rc(tid * 16 + i * 8192, R, C); const int Rb = Epi::PERM ? ((R & ~31) + perm32(R & 31)) : R;
        voffA[i] = (unsigned)(R * K + C) * 2u; voffB[i] = (unsigned)(Rb * K + C) * 2u; }
    const size_t kstep = (size_t)(BK * 2);
    const size_t hstep = (size_t)HALF * K * 2;
    const size_t tstep = 2 * hstep;
    const unsigned ldsw = (unsigned)wid * 1024u;
    const int aoff = lds_byte(wr * 64 + fr, fq * 8), boff = lds_byte(wc * 32 + fr, fq * 8);
#define PG8_SA(b, h) (((b) * 2 + (h)) * HTB)
#define PG8_SB(b, h) ((4 + (b) * 2 + (h)) * HTB)
#define PG8_STAGE(bufoff, gbase, voff) do { _Pragma("unroll") for (int _i = 0; _i < 2; ++_i) \
        __builtin_amdgcn_global_load_lds((const unsigned*)((const char*)(gbase) + (voff)[_i]), (PG8_LAS unsigned*)(lds + (bufoff) + ldsw + _i * 8192), 16, 0, 0); } while (0)
#define PG8_LDA(dst, b, h) do { _Pragma("unroll") for (int m = 0; m < 4; ++m) _Pragma("unroll") for (int k = 0; k < 2; ++k) dst[m][k] = *(const PG8_LAS bf16x8*)(lds + PG8_SA(b, h) + aoff + m * 2048 + k * 1024); } while (0)
#define PG8_LDB(dst, b, h) do { _Pragma("unroll") for (int n = 0; n < 2; ++n) _Pragma("unroll") for (int k = 0; k < 2; ++k) dst[n][k] = *(const PG8_LAS bf16x8*)(lds + PG8_SB(b, h) + boff + n * 2048 + k * 1024); } while (0)
#define PG8_MMA(ai, bj, At, Bt) do { __builtin_amdgcn_s_setprio(1); _Pragma("unroll") for (int m = 0; m < 4; ++m) _Pragma("unroll") for (int n = 0; n < 2; ++n) _Pragma("unroll") for (int k = 0; k < 2; ++k) \
        acc[ai][bj][m][n] = __builtin_amdgcn_mfma_f32_16x16x32_bf16(Bt[n][k], At[m][k], acc[ai][bj][m][n], 0, 0, 0); __builtin_amdgcn_s_setprio(0); } while (0)
#define PG8_WAIT_V(n) asm volatile("s_waitcnt vmcnt(" #n ")" ::: "memory")
#define PG8_WAIT_L(n) asm volatile("s_waitcnt lgkmcnt(" #n ")" ::: "memory")
#define PG8_BAR __builtin_amdgcn_s_barrier()
#define PG8_SCHED __builtin_amdgcn_sched_barrier(0)
    Unit cur, nxt; int ui = 0;
    if (!S.next(0, cur)) return;
    f32x4 acc[2][2][4][2];
#pragma unroll
    for (int a = 0; a < 2; ++a)
#pragma unroll
        for (int b = 0; b < 2; ++b)
#pragma unroll
            for (int m = 0; m < 4; ++m)
#pragma unroll
                for (int n = 0; n < 2; ++n) acc[a][b][m][n] = (f32x4){0.f, 0.f, 0.f, 0.f};
    bf16x8 At[4][2], B0[2][2], B1[2][2];
    const char* cA = (const char*)g.A + (size_t)cur.pm * tstep; const char* cB = (const char*)g.Bt + (size_t)cur.pn * tstep;
    S.a_ready(cur);
    if constexpr (SP2) {
        PG8_STAGE(PG8_SB(0, 0), cB, voffB); PG8_STAGE(PG8_SB(0, 1), cB + hstep, voffB); PG8_STAGE(PG8_SA(0, 0), cA, voffA); PG8_STAGE(PG8_SA(0, 1), cA + hstep, voffA);
        if (wr == 1) PG8_BAR;
        PG8_WAIT_V(2); PG8_BAR;
        PG8_STAGE(PG8_SB(1, 0), cB + kstep, voffB); PG8_STAGE(PG8_SA(1, 0), cA + kstep, voffA); PG8_STAGE(PG8_SB(1, 1), cB + hstep + kstep, voffB);
        PG8_WAIT_V(6); PG8_BAR;
    } else {
        PG8_STAGE(PG8_SB(0, 0), cB, voffB); PG8_STAGE(PG8_SA(0, 0), cA, voffA); PG8_STAGE(PG8_SB(0, 1), cB + hstep, voffB); PG8_STAGE(PG8_SA(0, 1), cA + hstep, voffA);
        if (wr == 1) PG8_BAR;
        PG8_WAIT_V(4); PG8_BAR;
        PG8_STAGE(PG8_SB(1, 0), cB + kstep, voffB); PG8_STAGE(PG8_SA(1, 0), cA + kstep, voffA); PG8_STAGE(PG8_SB(1, 1), cB + hstep + kstep, voffB);
        PG8_WAIT_V(6); PG8_BAR;
    }
    for (;;) {
        const bool has_next = S.next(ui + 1, nxt);
        const char* nA = has_next ? (const char*)g.A + (size_t)nxt.pm * tstep : cA; const char* nB = has_next ? (const char*)g.Bt + (size_t)nxt.pn * tstep : cB;
        for (int t = 0; t < nt; t += 2) {
            const bool last = (t == nt - 2);
            const char* a1 = cA + (size_t)(t + 1) * kstep;
            const char* a2 = last ? nA : cA + (size_t)(t + 2) * kstep; const char* b2 = last ? nB : cB + (size_t)(t + 2) * kstep;
            const char* a3 = a2 + kstep; const char* b3 = b2 + kstep;
            if (last && has_next) S.a_ready(nxt);
            if constexpr (SP2) {
            PG8_LDB(B0, 0, 0); PG8_LDB(B1, 0, 1); PG8_SCHED; PG8_LDA(At, 0, 0); PG8_STAGE(PG8_SA(1, 1), a1 + hstep, voffA);
            PG8_WAIT_V(8); PG8_WAIT_L(0); PG8_BAR; PG8_MMA(0, 0, At, B0); PG8_MMA(0, 1, At, B1); PG8_BAR; PG8_SCHED;
            PG8_LDA(At, 0, 1); PG8_STAGE(PG8_SB(0, 0), b2, voffB); PG8_STAGE(PG8_SB(0, 1), b2 + hstep, voffB); PG8_STAGE(PG8_SA(0, 0), a2, voffA);
            PG8_WAIT_V(8); PG8_WAIT_L(0); PG8_BAR; PG8_MMA(1, 0, At, B0); PG8_MMA(1, 1, At, B1); PG8_BAR; PG8_SCHED;
            PG8_LDB(B0, 1, 0); PG8_LDB(B1, 1, 1); PG8_SCHED; PG8_LDA(At, 1, 0); PG8_STAGE(PG8_SA(0, 1), a2 + hstep, voffA);
            PG8_WAIT_V(8); PG8_WAIT_L(0); PG8_BAR; PG8_MMA(0, 0, At, B0); PG8_MMA(0, 1, At, B1); PG8_BAR; PG8_SCHED;
            PG8_LDA(At, 1, 1); PG8_STAGE(PG8_SB(1, 0), b3, voffB); PG8_STAGE(PG8_SB(1, 1), b3 + hstep, voffB); PG8_STAGE(PG8_SA(1, 0), a3, voffA);
            PG8_WAIT_V(8); PG8_WAIT_L(0); PG8_BAR; PG8_MMA(1, 0, At, B0); PG8_MMA(1, 1, At, B1); PG8_BAR; PG8_SCHED;
            } else {
            PG8_LDB(B0, 0, 0); PG8_SCHED; PG8_LDA(At, 0, 0); PG8_STAGE(PG8_SA(1, 1), a1 + hstep, voffA);
            PG8_WAIT_L(8); PG8_BAR; PG8_WAIT_L(0); PG8_MMA(0, 0, At, B0); PG8_BAR; PG8_SCHED;
            PG8_LDB(B1, 0, 1); PG8_STAGE(PG8_SB(0, 0), b2, voffB);
            PG8_BAR; PG8_WAIT_L(0); PG8_MMA(0, 1, At, B1); PG8_BAR;
            PG8_LDA(At, 0, 1); PG8_STAGE(PG8_SA(0, 0), a2, voffA);
            PG8_BAR; PG8_WAIT_L(0); PG8_MMA(1, 0, At, B0); PG8_BAR; PG8_SCHED;
            PG8_STAGE(PG8_SB(0, 1), b2 + hstep, voffB);
            PG8_WAIT_V(6); PG8_BAR; PG8_MMA(1, 1, At, B1); PG8_BAR;
            PG8_LDB(B0, 1, 0); PG8_SCHED; PG8_LDA(At, 1, 0); PG8_STAGE(PG8_SA(0, 1), a2 + hstep, voffA);
            PG8_WAIT_L(8); PG8_BAR; PG8_WAIT_L(0); PG8_MMA(0, 0, At, B0); PG8_BAR; PG8_SCHED;
            PG8_LDB(B1, 1, 1); PG8_STAGE(PG8_SB(1, 0), b3, voffB);
            PG8_BAR; PG8_WAIT_L(0); PG8_MMA(0, 1, At, B1); PG8_BAR;
            PG8_LDA(At, 1, 1); PG8_STAGE(PG8_SA(1, 0), a3, voffA);
            PG8_BAR; PG8_WAIT_L(0); PG8_MMA(1, 0, At, B0); PG8_BAR; PG8_SCHED;
            PG8_STAGE(PG8_SB(1, 1), b3 + hstep, voffB);
            PG8_WAIT_V(6); PG8_BAR; PG8_MMA(1, 1, At, B1); PG8_BAR;
            }
        }
        if constexpr (ALIGN_EPI) { if (wr == 0) PG8_BAR; }
        if constexpr (!Epi::AFTER_DRAIN) { E(acc, cur, wr, wc, fr, fq); S.done(cur); }
        if (!has_next) break;
#pragma unroll
        for (int a = 0; a < 2; ++a)
#pragma unroll
            for (int b = 0; b < 2; ++b)
#pragma unroll
                for (int m = 0; m < 4; ++m)
#pragma unroll
                    for (int n = 0; n < 2; ++n) acc[a][b][m][n] = (f32x4){0.f, 0.f, 0.f, 0.f};
        cur = nxt; cA = nA; cB = nB; ++ui;
        if constexpr (ALIGN_EPI) { if (wr == 1) PG8_BAR; }
    }
    PG8_WAIT_V(0);
    if constexpr (!ALIGN_EPI) { if (wr == 0) PG8_BAR; }
    PG8_BAR;
    if constexpr (Epi::AFTER_DRAIN) { E.fused(acc, cur, wr, wc, fr, fq, lds, wid, lane); S.done(cur); }
#undef PG8_SA
#undef PG8_SB
#undef PG8_STAGE
#undef PG8_LDA
#undef PG8_LDB
#undef PG8_MMA
#undef PG8_WAIT_V
#undef PG8_WAIT_L
#undef PG8_BAR
#undef PG8_SCHED
}
}
#include <hip/hip_bf16.h>
#include <cmath>
namespace attn_body {
using bf16=__hip_bfloat16;
using bf16x8=__attribute__((ext_vector_type(8)))short;
using s16x4=__attribute__((ext_vector_type(4)))short;
using f32x16=__attribute__((ext_vector_type(16)))float;
using u32x4=__attribute__((ext_vector_type(4)))unsigned;
constexpr int BATCH=8,NHEAD=16,SEQ=2048,D=64,PQK=512,PO=1024;
constexpr int NW=8,QBLK=32,QB=QBLK*NW,KVBLK=64,NQB=SEQ/QB;
constexpr int ATTN_UNIT_ROWS=QB;
__device__ __forceinline__ int crow(int r,int hi){return (r&3)+8*(r>>2)+4*hi;}
#define SBAR() __builtin_amdgcn_sched_barrier(0)
__device__ __forceinline__ void cmask(f32x16&p0,f32x16&p1,int jb,int qrel,int hi){
  const float NEG=-INFINITY; (void)hi;
  if(jb>(qrel>>6)){
  #pragma unroll
  for(int r=0;r<16;++r){p0[r]=NEG;p1[r]=NEG;}}
}

constexpr int NSLOT=3, SLOTB=8192;
constexpr int LDS_K=0, LDS_V=NSLOT*SLOTB, LDS_WS=2*NSLOT*SLOTB, LDS_OST=LDS_WS+NW*64*4, LDS_BYTES=LDS_OST+NW*4096;
constexpr float C2=0.125f*1.4426950408889634f;
__device__ __forceinline__ void glds16(const void*gsrc,unsigned lds_dst){unsigned keep;
  asm volatile("s_mov_b32 %0, m0\n\ts_mov_b32 m0, %2\n\ts_nop 0\n\tglobal_load_lds_dwordx4 %1, off\n\ts_mov_b32 m0, %0":"=&s"(keep):"v"(gsrc),"s"(lds_dst):"memory");}
__device__ __forceinline__ float max3f(float a,float b,float c){float r;asm("v_max3_f32 %0, %1, %2, %3":"=v"(r):"v"(a),"v"(b),"v"(c));return r;}
__device__ __forceinline__ float max2f(float a,float b){float r;asm("v_max_f32_e32 %0, %1, %2":"=v"(r):"v"(a),"v"(b));return r;}
__device__ __forceinline__ float fadd_s(float a,float b){float r;asm("v_add_f32_e32 %0, %1, %2":"=v"(r):"v"(a),"v"(b));return r;}
__device__ __forceinline__ float fsub_s(float a,float b){float r;asm("v_sub_f32_e32 %0, %1, %2":"=v"(r):"v"(a),"v"(b));return r;}
typedef float f32x2_t __attribute__((ext_vector_type(2))); typedef __bf16 bf16x2_t __attribute__((ext_vector_type(2)));
__device__ __forceinline__ unsigned cvtpk_s(float lo,float hi){f32x2_t v={lo,hi};bf16x2_t b=__builtin_convertvector(v,bf16x2_t);return __builtin_bit_cast(unsigned,b);}
#define WAIT_BAR(N) asm volatile("s_waitcnt vmcnt(" #N ") lgkmcnt(0)\n\ts_barrier":::"memory")

__device__ __forceinline__ void qkt(f32x16&p0,f32x16&p1,const char*Kslot,const bf16x8*qr,const f32x16&negm,int r32,int hi){
  const char*kb=Kslot+hi*1024+r32*16;
  #pragma unroll
  for(int d0=0;d0<4;++d0){
    const bf16x8 b0=*reinterpret_cast<const bf16x8*>(kb+d0*2048);
    const bf16x8 b1=*reinterpret_cast<const bf16x8*>(kb+d0*2048+512);
    if(d0==0){p0=__builtin_amdgcn_mfma_f32_32x32x16_bf16(b0,qr[0],negm,0,0,0);p1=__builtin_amdgcn_mfma_f32_32x32x16_bf16(b1,qr[0],negm,0,0,0);}
    else{p0=__builtin_amdgcn_mfma_f32_32x32x16_bf16(b0,qr[d0],p0,0,0,0);p1=__builtin_amdgcn_mfma_f32_32x32x16_bf16(b1,qr[d0],p1,0,0,0);}}
}
typedef __attribute__((address_space(3))) const char* lds_cptr;
typedef short v4i16_t __attribute__((ext_vector_type(4)));
__device__ __forceinline__ void kload8(bf16x8*kf,lds_cptr kp){
  kf[0]=*(const __attribute__((address_space(3))) bf16x8*)(kp);      kf[1]=*(const __attribute__((address_space(3))) bf16x8*)(kp+512);
  kf[2]=*(const __attribute__((address_space(3))) bf16x8*)(kp+2048); kf[3]=*(const __attribute__((address_space(3))) bf16x8*)(kp+2560);
  kf[4]=*(const __attribute__((address_space(3))) bf16x8*)(kp+4096); kf[5]=*(const __attribute__((address_space(3))) bf16x8*)(kp+4608);
  kf[6]=*(const __attribute__((address_space(3))) bf16x8*)(kp+6144); kf[7]=*(const __attribute__((address_space(3))) bf16x8*)(kp+6656);
}
__device__ __forceinline__ void kload2(bf16x8*kf,lds_cptr kp,int j){ kf[2*j]=*(const __attribute__((address_space(3))) bf16x8*)(kp+j*2048); kf[2*j+1]=*(const __attribute__((address_space(3))) bf16x8*)(kp+j*2048+512); }
__device__ __forceinline__ s16x4 vtr(lds_cptr p){ return __builtin_bit_cast(s16x4,__builtin_amdgcn_ds_read_tr16_b64_v4i16((__attribute__((address_space(3))) v4i16_t*)p)); }
__device__ __forceinline__ float rowmax(const f32x16&p0,const f32x16&p1){
  float a=max3f(p0[0],p0[1],p1[0]),b=max3f(p0[2],p0[3],p1[1]);a=max3f(a,p1[2],p1[3]);
  #pragma unroll
  for(int r=4;r<16;r+=4){a=max3f(a,p0[r],p0[r+1]);b=max3f(b,p0[r+2],p0[r+3]);a=max3f(a,p1[r],p1[r+1]);b=max3f(b,p1[r+2],p1[r+3]);}
  const float m=max2f(a,b);
  auto rr=__builtin_amdgcn_permlane32_swap(__float_as_uint(m),__float_as_uint(m),false,false);
  return max2f(__uint_as_float(rr[0]),__uint_as_float(rr[1]));
}
__device__ __forceinline__ void pv(f32x16*o,int vb,bf16x8 pa0,bf16x8 pa1,bf16x8 pa2,bf16x8 pa3){
  #pragma unroll
  for(int d0=0;d0<2;++d0){s16x4 lo[4],hi[4];
    #pragma unroll
    for(int ks=0;ks<4;++ks){
      asm volatile("ds_read_b64_tr_b16 %0,%1 offset:%c2":"=&v"(lo[ks]):"v"(vb),"i"(d0*4096+ks*1024):"memory");
      asm volatile("ds_read_b64_tr_b16 %0,%1 offset:%c2":"=&v"(hi[ks]):"v"(vb),"i"(d0*4096+ks*1024+512):"memory");}
    asm volatile("s_waitcnt lgkmcnt(0)":::"memory");SBAR();
    #define PK(k) (bf16x8){lo[k][0],lo[k][1],lo[k][2],lo[k][3],hi[k][0],hi[k][1],hi[k][2],hi[k][3]}
    o[d0]=__builtin_amdgcn_mfma_f32_32x32x16_bf16(pa0,PK(0),o[d0],0,0,0);
    o[d0]=__builtin_amdgcn_mfma_f32_32x32x16_bf16(pa1,PK(1),o[d0],0,0,0);
    o[d0]=__builtin_amdgcn_mfma_f32_32x32x16_bf16(pa2,PK(2),o[d0],0,0,0);
    o[d0]=__builtin_amdgcn_mfma_f32_32x32x16_bf16(pa3,PK(3),o[d0],0,0,0);
    #undef PK
  }
}

#ifndef ATTN_STORE16
#define ATTN_STORE16(p,v) (*(u32x4*)(p)=(v))
#endif
template<int THRL> __device__ __forceinline__ void attn_unit(int b,int qb,const bf16*Q,const bf16*__restrict__ K,const bf16*__restrict__ V,bf16*O,char*shm){
  int tid_l=threadIdx.x; asm volatile("":"+v"(tid_l)); const int tid=tid_l,lane=tid&63,r32=lane&31,hi=lane>>5; const int wid=__builtin_amdgcn_readfirstlane(tid>>6);
  const long rowbase=(long)b*SEQ; const int q0=qb*QB;
  const bf16*Qw=Q+(rowbase+q0+wid*QBLK)*PQK;
  const bf16*Kh=K+rowbase*PQK,*Vh=V+rowbase*PQK;
  const unsigned lds0=(unsigned)(uintptr_t)shm;
  float*wsf=(float*)(shm+LDS_WS)+wid*64;
  const bf16*ksrc=Kh+(long)lane*PQK+wid*8;
  const bf16*vsrc=Vh+(long)(16*(wid&3)+(lane>>2))*PQK+(wid>>2)*32+(lane&3)*8;
  const unsigned kdst=lds0+LDS_K+wid*1024, vdst=lds0+LDS_V+wid*1024;
  #define DMA_K(t,slot) glds16(ksrc+(long)(t)*KVBLK*PQK,(unsigned)__builtin_amdgcn_readfirstlane(kdst+(slot)))
  #define DMA_V(t,slot) glds16(vsrc+(long)(t)*KVBLK*PQK,(unsigned)__builtin_amdgcn_readfirstlane(vdst+(slot)))
  const int vb0=(int)(lds0+LDS_V)+((lane>>4)&1)*32+(lane&3)*8+(4*hi+((lane&15)>>2))*64;
  const char*Kbase=shm+LDS_K; bf16x8 kf[8];
  const lds_cptr shm3=(lds_cptr)shm; const lds_cptr kp0=shm3+LDS_K+hi*1024+r32*16; const lds_cptr vp0=shm3+LDS_V+((lane>>4)&1)*32+(lane&3)*8+(4*hi+((lane&15)>>2))*64;
  const int NT=(q0+QB)/KVBLK;
  DMA_K(0,0);DMA_V(0,0);DMA_K(1,SLOTB);
  bf16x8 qr[4];
  #pragma unroll
  for(int d0=0;d0<4;++d0)qr[d0]=*reinterpret_cast<const bf16x8*>(&Qw[(long)r32*PQK+d0*16+hi*8]);
  float mhat=0.f,l_reg=0.f;f32x16 o[2];o[0]=f32x16{};o[1]=f32x16{};f32x16 negm=f32x16{};asm volatile("":"+v"(negm));
  const int qrel=wid*QBLK+r32;
  #define CMASK(P0,P1,t) do{int jb_=(t)-(NT-4); if(jb_>=0)cmask(P0,P1,jb_,qrel,hi);}while(0)
  bool resc=false;
  #define START(P0,P1) do{ const float rm=rowmax(P0,P1); resc=false; \
    { const float dl=rm; mhat=fadd_s(mhat,dl); \
      _Pragma("unroll") for(int r=0;r<16;++r){P0[r]=fsub_s(P0[r],dl);P1[r]=fsub_s(P1[r],dl);} \
      _Pragma("unroll") for(int r=0;r<16;++r)negm[r]=-mhat; asm volatile("":"+v"(negm)); } \
    _Pragma("unroll") for(int r=0;r<16;++r)P0[r]=__builtin_amdgcn_exp2f(P0[r]); }while(0)
  #define RESC() do{ if(resc){ asm volatile("s_waitcnt lgkmcnt(0)":::"memory"); \
      _Pragma("unroll") for(int d_=0;d_<2;++d_) _Pragma("unroll") for(int r=0;r<16;++r)o[d_][r]*=wsf[crow(r,hi)]; } }while(0)
  f32x16 pA0,pA1,pB0,pB1;
  int sl_prev=0,sl_cur=0,sl_next=SLOTB;
  #define ROT() do{sl_prev=sl_cur;sl_cur=sl_next;sl_next=(sl_next==(NSLOT-1)*SLOTB)?0:sl_next+SLOTB;}while(0)
  DMA_K(2,2*SLOTB);
  WAIT_BAR(3);
  qkt(pA0,pA1,Kbase,qr,negm,r32,hi);asm volatile("s_nop 15\n\ts_nop 7":"+v"(pA0),"+v"(pA1));CMASK(pA0,pA1,0);
  START(pA0,pA1);
  _Pragma("unroll") for(int r=0;r<16;++r)pA1[r]=__builtin_amdgcn_exp2f(pA1[r]);
  WAIT_BAR(0);
  DMA_K(3,0);DMA_V(1,SLOTB);
  ROT();
  kload8(kf,kp0+sl_cur);
  WAIT_BAR(2);
  s16x4 vlo[8],vhi[8]; u32x4 pw0,pw1,pw2,pw3;
  #define PKW(P,B) cvtpk_s(P[B],P[B+1])
  #define PAF(k) __builtin_bit_cast(bf16x8,pw##k)
  #define VFR(i) (bf16x8){vlo[i][0],vlo[i][1],vlo[i][2],vlo[i][3],vhi[i][0],vhi[i][1],vhi[i][2],vhi[i][3]}
  #define PIN(x) asm volatile("":"+v"(x))
  #define MX3(a,b,c) __builtin_fmaxf(__builtin_fmaxf((a),(b)),(c))
  #define GAPA(MF,A0,A1,A2,A3,W0,W1,PW) do{ MF; sacc+=A0; sacc+=A1; sacc+=A2; sacc+=A3; PIN(sacc); W0; W1; PIN(PW); SBAR(); }while(0)
  #define EX(v) __builtin_amdgcn_exp2f(v)
  #define GAPB(MF,X,B) do{ MF; X[B]=EX(X[B]); X[B+1]=EX(X[B+1]); X[B+2]=EX(X[B+2]); X[B+3]=EX(X[B+3]); PIN(X); SBAR(); }while(0)
  #define VRD(i) do{ vlo[i]=vtr(vp_+(((i)>>2)*4096+((i)&3)*1024)); vhi[i]=vtr(vp_+(((i)>>2)*4096+((i)&3)*1024+512)); }while(0)
  #define KRD(G,j) do{ if(G){ kload2(kf,kp0+sl_next,j); SBAR(); } }while(0)
  #define STEP(C0,C1,P0,P1,t,GK,GV,GL) do{ SBAR(); \
    const lds_cptr vp_=vp0+sl_prev; \
    VRD(0); SBAR(); float sacc=(P0[0]+P0[1]); \
    GAPA(C0=__builtin_amdgcn_mfma_f32_32x32x16_bf16(kf[0],qr[0],negm,0,0,0), P0[2],P0[3],P0[4],P0[5],     pw0[0]=PKW(P0,0), pw0[1]=PKW(P0,2), pw0); \
    VRD(4); SBAR(); GAPA(C1=__builtin_amdgcn_mfma_f32_32x32x16_bf16(kf[1],qr[0],negm,0,0,0), P0[6],P0[7],P0[8],P0[9],     pw0[2]=PKW(P0,4), pw0[3]=PKW(P0,6), pw0); \
    VRD(1); SBAR(); GAPA(C0=__builtin_amdgcn_mfma_f32_32x32x16_bf16(kf[2],qr[1],C0,0,0,0),   P0[10],P0[11],P0[12],P0[13], pw1[0]=PKW(P0,8), pw1[1]=PKW(P0,10), pw1); \
    VRD(5); SBAR(); GAPA(C1=__builtin_amdgcn_mfma_f32_32x32x16_bf16(kf[3],qr[1],C1,0,0,0),   P0[14],P0[15],P1[0],P1[1],   pw1[2]=PKW(P0,12),pw1[3]=PKW(P0,14), pw1); \
    VRD(2); SBAR(); GAPA(C0=__builtin_amdgcn_mfma_f32_32x32x16_bf16(kf[4],qr[2],C0,0,0,0),   P1[2],P1[3],P1[4],P1[5],     pw2[0]=PKW(P1,0), pw2[1]=PKW(P1,2), pw2); \
    VRD(6); SBAR(); GAPA(C1=__builtin_amdgcn_mfma_f32_32x32x16_bf16(kf[5],qr[2],C1,0,0,0),   P1[6],P1[7],P1[8],P1[9],     pw2[2]=PKW(P1,4), pw2[3]=PKW(P1,6), pw2); \
    VRD(3); SBAR(); GAPA(C0=__builtin_amdgcn_mfma_f32_32x32x16_bf16(kf[6],qr[3],C0,0,0,0),   P1[10],P1[11],P1[12],P1[13], pw3[0]=PKW(P1,8), pw3[1]=PKW(P1,10), pw3); \
    VRD(7); SBAR(); GAPA(C1=__builtin_amdgcn_mfma_f32_32x32x16_bf16(kf[7],qr[3],C1,0,0,0),   P1[14],P1[15],0.f,0.f,       pw3[2]=PKW(P1,12),pw3[3]=PKW(P1,14), pw3); \
    l_reg+=sacc; \
    if(GK){DMA_K((t)+3,sl_cur);} if(GV){DMA_V((t)+1,sl_next);} \
    CMASK(C0,C1,t); \
    { float a=MX3(C0[0],C0[1],C1[0]),b=MX3(C0[2],C0[3],C1[1]); a=MX3(a,C1[2],C1[3]); \
      _Pragma("unroll") for(int r=4;r<16;r+=4){a=MX3(a,C0[r],C0[r+1]);b=MX3(b,C0[r+2],C0[r+3]);a=MX3(a,C1[r],C1[r+1]);b=MX3(b,C1[r+2],C1[r+3]);} \
      float rm=__builtin_fmaxf(a,b); { auto rr=__builtin_amdgcn_permlane32_swap(__float_as_uint(rm),__float_as_uint(rm),false,false); rm=__builtin_fmaxf(__uint_as_float(rr[0]),__uint_as_float(rr[1])); } \
      resc=false; \
      if(__builtin_expect(__any(rm>(float)THRL),0)){ const float dl=__builtin_fmaxf(rm,0.f); mhat+=dl; \
        _Pragma("unroll") for(int r=0;r<16;++r){C0[r]-=dl;C1[r]-=dl;} \
        _Pragma("unroll") for(int r=0;r<16;++r)negm[r]=-mhat; asm volatile("":"+v"(negm)); \
        const float f=__builtin_amdgcn_exp2f(-dl); l_reg*=f; if(hi==0)wsf[r32]=f; resc=true; } } \
    SBAR(); \
    GAPB(o[0]=__builtin_amdgcn_mfma_f32_32x32x16_bf16(PAF(0),VFR(0),o[0],0,0,0), C0,0); \
    GAPB(o[1]=__builtin_amdgcn_mfma_f32_32x32x16_bf16(PAF(0),VFR(4),o[1],0,0,0), C0,4); \
    KRD(GL,0); GAPB(o[0]=__builtin_amdgcn_mfma_f32_32x32x16_bf16(PAF(1),VFR(1),o[0],0,0,0), C0,8); \
    KRD(GL,1); GAPB(o[1]=__builtin_amdgcn_mfma_f32_32x32x16_bf16(PAF(1),VFR(5),o[1],0,0,0), C0,12); \
    KRD(GL,2); GAPB(o[0]=__builtin_amdgcn_mfma_f32_32x32x16_bf16(PAF(2),VFR(2),o[0],0,0,0), C1,0); \
    KRD(GL,3); GAPB(o[1]=__builtin_amdgcn_mfma_f32_32x32x16_bf16(PAF(2),VFR(6),o[1],0,0,0), C1,4); \
    GAPB(o[0]=__builtin_amdgcn_mfma_f32_32x32x16_bf16(PAF(3),VFR(3),o[0],0,0,0), C1,8); \
    GAPB(o[1]=__builtin_amdgcn_mfma_f32_32x32x16_bf16(PAF(3),VFR(7),o[1],0,0,0), C1,12); \
    }while(0)
  int t=1;
  #undef CMASK
  #define CMASK(P0,P1,t) do{}while(0)
  for(;t+5<NT;t+=2){
    STEP(pB0,pB1,pA0,pA1,t,true,true,true);     WAIT_BAR(2); RESC(); ROT();
    STEP(pA0,pA1,pB0,pB1,t+1,true,true,true);   WAIT_BAR(2); RESC(); ROT();
  }
  #undef CMASK
  #define CMASK(P0,P1,t) do{int jb_=(t)-(NT-4); if(jb_>=0)cmask(P0,P1,jb_,qrel,hi);}while(0)
  #define ENDW(tt) do{ if((tt)+3<NT){WAIT_BAR(2);} else if((tt)+2<NT){WAIT_BAR(1);} else {WAIT_BAR(0);} }while(0)
  for(;t+1<NT;t+=2){
    STEP(pB0,pB1,pA0,pA1,t,(t+3<NT),(t+1<NT),(t+1<NT));       ENDW(t);   RESC(); ROT();
    STEP(pA0,pA1,pB0,pB1,t+1,(t+4<NT),(t+2<NT),(t+2<NT));     ENDW(t+1); RESC(); ROT();
  }
  STEP(pB0,pB1,pA0,pA1,NT-1,false,false,false); RESC();
  { float sacc=pB0[0]+pB0[1]; _Pragma("unroll") for(int r=2;r<16;++r)sacc+=pB0[r]; _Pragma("unroll") for(int r=0;r<16;++r)sacc+=pB1[r]; l_reg+=sacc;
    pw0=(u32x4){PKW(pB0,0),PKW(pB0,2),PKW(pB0,4),PKW(pB0,6)};pw1=(u32x4){PKW(pB0,8),PKW(pB0,10),PKW(pB0,12),PKW(pB0,14)};pw2=(u32x4){PKW(pB1,0),PKW(pB1,2),PKW(pB1,4),PKW(pB1,6)};pw3=(u32x4){PKW(pB1,8),PKW(pB1,10),PKW(pB1,12),PKW(pB1,14)};
    SBAR(); pv(o,vb0+sl_cur,PAF(0),PAF(1),PAF(2),PAF(3)); }
  #undef PKW
  #undef PAF
  #undef VFR
  #undef PIN
  #undef MX3
  #undef GAPA
  #undef GAPB
  #undef EX
  #undef VRD
  #undef KRD
  #undef STEP
  #undef ENDW
  {auto rr=__builtin_amdgcn_permlane32_swap(__float_as_uint(l_reg),__float_as_uint(l_reg),false,false);l_reg=__uint_as_float(rr[0])+__uint_as_float(rr[1]);}
  if(hi==0)wsf[32+r32]=l_reg;asm volatile("s_waitcnt lgkmcnt(0)":::"memory");
  float rli[16];
  #pragma unroll
  for(int r=0;r<16;++r)rli[r]=__builtin_amdgcn_rcpf(wsf[32+crow(r,hi)]);
  bf16*Ow=O+(rowbase+q0+wid*QBLK)*PO;
  { bf16*stg=(bf16*)(shm+LDS_OST)+wid*2048;
    #pragma unroll
    for(int r=0;r<16;++r){const int orow=crow(r,hi);
      #pragma unroll
      for(int d0=0;d0<2;++d0)stg[orow*64+d0*32+r32]=__float2bfloat16(o[d0][r]*rli[r]);}
    asm volatile("s_waitcnt lgkmcnt(0)":::"memory");
    #pragma unroll
    for(int i=0;i<4;++i){const int row=i*8+(lane>>3),ch=lane&7; const u32x4 v=*(const u32x4*)(stg+row*64+ch*8); ATTN_STORE16(Ow+(long)row*PO+ch*8,v);} }
  asm volatile("s_waitcnt lgkmcnt(0)\n\ts_barrier":::"memory");
  #undef DMA_K
  #undef DMA_V
  #undef CMASK
  #undef START
  #undef RESC
  #undef ROT
}
#undef SBAR
#undef WAIT_BAR
}
namespace cg = cooperative_groups;
#define LAS __attribute__((address_space(3)))
typedef unsigned short bf16;
typedef unsigned v4u __attribute__((ext_vector_type(4)));
typedef unsigned v2u __attribute__((ext_vector_type(2)));
typedef float f32x4 __attribute__((ext_vector_type(4)));
typedef float f32x2 __attribute__((ext_vector_type(2)));
typedef float f32x16 __attribute__((ext_vector_type(16)));
typedef short bf16x8 __attribute__((ext_vector_type(8)));

constexpr int NWAVES = 8;
constexpr int D = 1024, MP = 16384, MS = 256, M = MP + MS, FF = 2816, DIN = 2560;
constexpr float EPS = 1e-6f;
constexpr float C2 = 0.125f * 1.4426950408889634f;
constexpr size_t OFF_Y = 0, OFF_KP = 17039360, OFF_VP = 33816576, OFF_PP = 50593792, OFF_CP = 50655232, OFF_KS = 50663424, OFF_VS = 50925568, OFF_PS = 51187712, OFF_CS = 51249152, OUT_TOTAL = 51257344;
constexpr size_t MiB = 1u << 20;
constexpr size_t WS_ROPE = 1 * MiB, WS_POOLWT = 2 * MiB, WS_W = 4 * MiB, WL = 40 * MiB;
constexpr size_t W_GU1 = 0, W_D1 = 11 * MiB, W_IN = 16 * MiB + MiB / 2, W_OUT = 21 * MiB + MiB / 2, W_GU2 = 23 * MiB + MiB / 2, W_D2 = 34 * MiB + MiB / 2;
constexpr size_t WS_X = 84 * MiB, WS_H = 149 * MiB, WS_MIX = 182 * MiB, WS_ACT = 215 * MiB;
constexpr size_t WS_QB = 215 * MiB, WS_KB = 232 * MiB, WS_VB = 249 * MiB, WS_ZB = 266 * MiB;
constexpr size_t WS_OB = 305 * MiB, WS_OPART = 338 * MiB, WS_ML = 347 * MiB, WS_END = 352 * MiB;
static_assert(WS_ROPE == pg8::WOFF_ROPE && WS_QB == pg8::WOFF_QB && WS_KB == pg8::WOFF_KB && WS_VB == pg8::WOFF_VB && WS_ZB == pg8::WOFF_ZB && OFF_KP == pg8::OOFF_KP && OFF_VP == pg8::OOFF_VP && OFF_PP == pg8::OOFF_PP && OFF_KS == pg8::OOFF_KS && OFF_VS == pg8::OOFF_VS && OFF_PS == pg8::OOFF_PS, "offsets");
static_assert(WS_ACT + (size_t)M * FF * 2 <= WS_OB && WS_ZB + (size_t)M * 1024 * 2 <= WS_OB && WS_X + (size_t)M * D * 4 <= WS_H && WS_H + (size_t)M * D * 2 <= WS_MIX && WS_MIX + (size_t)M * D * 2 <= WS_ACT, "ws map");
static_assert(WS_OB + (size_t)M * 1024 * 2 <= WS_OPART && WS_OPART + (size_t)32 * 2 * 9 * 32 * 128 * 4 <= WS_ML && WS_ML + (size_t)32 * 2 * 9 * 32 * 2 * 4 <= WS_END, "ws map 2");
constexpr int LDS_BYTES = 147456;
constexpr size_t CTL_BYTES = 262144, CTL_CNT = 65536;
constexpr size_t WS_SLOTP = 350 * MiB, WS_SLOTS = 351 * MiB;

__device__ __forceinline__ unsigned pk2(float lo, float hi) { f32x2 v = {lo, hi}; typedef __bf16 b2 __attribute__((ext_vector_type(2))); b2 b = __builtin_convertvector(v, b2); return __builtin_bit_cast(unsigned, b); }
__device__ __forceinline__ float bf2f(unsigned short b) { return __builtin_bit_cast(float, (unsigned)b << 16); }
__device__ __forceinline__ bf16x8 pack8(f32x4 a, f32x4 b) { v4u w; w.x = pk2(a.x, a.y); w.y = pk2(a.z, a.w); w.z = pk2(b.x, b.y); w.w = pk2(b.z, b.w); return __builtin_bit_cast(bf16x8, w); }
__device__ __forceinline__ int crow(int r, int hi) { return (r & 3) + 8 * (r >> 2) + 4 * hi; }
__device__ __forceinline__ void xhalf_pair(float m, float& a, float& b) { a = m; b = m; asm volatile("s_nop 1\n\tv_permlane32_swap_b32 %0, %1\n\ts_nop 1" : "+v"(a), "+v"(b)); }
__device__ __forceinline__ float xhalf_max(float m) { float a, b; xhalf_pair(m, a, b); return fmaxf(a, b); }
__device__ __forceinline__ float xhalf_sum(float m) { float a, b; xhalf_pair(m, a, b); return a + b; }
template <int O> __device__ __forceinline__ float swz_xor(float v) { return __builtin_bit_cast(float, __builtin_amdgcn_ds_swizzle(__builtin_bit_cast(int, v), (O << 10) | 0x1f)); }
__device__ __forceinline__ float wave_sum(float v) {
    v += swz_xor<1>(v); v += swz_xor<2>(v); v += swz_xor<4>(v); v += swz_xor<8>(v); v += swz_xor<16>(v);
    return xhalf_sum(v);
}
#define LDS_WAIT() asm volatile("s_waitcnt lgkmcnt(0)" ::: "memory")

struct Params { const float* in[26]; float* out; unsigned char* ws; };
typedef const __attribute__((address_space(4))) unsigned char* karg_ptr;
__device__ __forceinline__ karg_ptr kargs() { karg_ptr k = (karg_ptr)__builtin_amdgcn_kernarg_segment_ptr(); asm volatile("" : "+s"(k)); return k; }
__device__ __forceinline__ const float* KIN(int i) { return *(const float* const __attribute__((address_space(4)))*)(kargs() + 8 * i); }
__device__ __forceinline__ float* KOUT() { return *(float* const __attribute__((address_space(4)))*)(kargs() + 8 * 26); }
__device__ __forceinline__ unsigned char* KWS() { return *(unsigned char* const __attribute__((address_space(4)))*)(kargs() + 8 * 27); }

template <int MODE> __device__ __forceinline__ int wmap(int nl, int row_off) {
    if (MODE == 0) return row_off + nl;
    if (MODE == 1) return (nl >> 7) * 256 + (nl & 127) + row_off;
    const int u = nl >> 8, lc = nl & 255, hc = lc >> 6, bjx = (lc >> 5) & 1, fqx = (lc >> 3) & 3, n = (lc >> 2) & 1, j = lc & 3;
    return u * 256 + 128 * bjx + 32 * hc + 16 * n + 4 * fqx + j;
}
template <int MODE> __device__ __forceinline__ void transpose_item(const float* W, int K, int N, bf16* WT, int row_off, LAS float* scr, int item, int lane) {
    const int nblk = N / 32, kb = item / nblk, nb = item % nblk, k0 = 64 * kb, n0 = 32 * nb;
#pragma unroll 8
    for (int i = 0; i < 32; ++i) { const int kk = 2 * i + (lane >> 5); scr[kk * 33 + (lane & 31)] = __builtin_nontemporal_load(W + (size_t)(k0 + kk) * N + n0 + (lane & 31)); }
    LDS_WAIT(); asm volatile("" ::: "memory");
    const int c = lane & 7;
#pragma unroll
    for (int j = 0; j < 4; ++j) { const int n = (lane >> 3) + 8 * j; const LAS float* s = scr + (8 * c) * 33 + n;
        v4u o; o.x = pk2(s[0 * 33], s[1 * 33]); o.y = pk2(s[2 * 33], s[3 * 33]); o.z = pk2(s[4 * 33], s[5 * 33]); o.w = pk2(s[6 * 33], s[7 * 33]);
        *(v4u*)(WT + (size_t)wmap<MODE>(n0 + n, row_off) * K + k0 + 8 * c) = o; }
    LDS_WAIT(); asm volatile("" ::: "memory");
}
__device__ __forceinline__ void prologue(LAS unsigned char* lds, int gw, int NGW, int wave, int lane) {
    LAS float* scr = (LAS float*)(lds + wave * 16384);
    constexpr int I_F = 16 * 88, I_IN = 16 * 80, I_OUT = 16 * 32, I_L = 6 * I_F + I_IN + I_OUT;
    for (int it = gw; it < 2 * I_L; it += NGW) {
        const int l = it / I_L; int r = it % I_L;
        unsigned char* wl = KWS() + WS_W + (size_t)l * WL;
        if (r < I_F) { transpose_item<1>(KIN(7) + (size_t)l * D * FF, D, FF, (bf16*)(wl + W_GU1), 0, scr, r, lane); continue; } r -= I_F;
        if (r < I_F) { transpose_item<1>(KIN(8) + (size_t)l * D * FF, D, FF, (bf16*)(wl + W_GU1), 128, scr, r, lane); continue; } r -= I_F;
        if (r < I_F) { transpose_item<0>(KIN(9) + (size_t)l * D * FF, FF, D, (bf16*)(wl + W_D1), 0, scr, r, lane); continue; } r -= I_F;
        if (r < I_IN) { transpose_item<2>(KIN(11) + (size_t)l * D * DIN, D, DIN, (bf16*)(wl + W_IN), 0, scr, r, lane); continue; } r -= I_IN;
        if (r < I_OUT) { transpose_item<0>(KIN(20) + (size_t)l * D * D, D, D, (bf16*)(wl + W_OUT), 0, scr, r, lane); continue; } r -= I_OUT;
        if (r < I_F) { transpose_item<1>(KIN(22) + (size_t)l * D * FF, D, FF, (bf16*)(wl + W_GU2), 0, scr, r, lane); continue; } r -= I_F;
        if (r < I_F) { transpose_item<1>(KIN(23) + (size_t)l * D * FF, D, FF, (bf16*)(wl + W_GU2), 128, scr, r, lane); continue; } r -= I_F;
        transpose_item<0>(KIN(24) + (size_t)l * D * FF, FF, D, (bf16*)(wl + W_D2), 0, scr, r, lane);
    }
    float* rope = (float*)(KWS() + WS_ROPE);
    for (int i = gw * 64 + lane; i < 2080 * 32; i += NGW * 64) {
        const int pr = i >> 5, d = i & 31; const int pos = pr < 2048 ? pr : 4096 + (pr - 2048);
        const float inv = exp2f(-(float)d * (13.287712379549449f / 32.0f));
        const float ang = (float)pos * inv;
        const double rev = (double)ang * 0.15915494309189535; const float fr = (float)(rev - __builtin_rint(rev));
        rope[pr * 64 + d] = __builtin_amdgcn_cosf(fr); rope[pr * 64 + 32 + d] = __builtin_amdgcn_sinf(fr);
    }
    bf16* pwt_ = (bf16*)(KWS() + WS_POOLWT);
    for (int i = gw * 64 + lane; i < 2 * 4 * 64 * 64; i += NGW * 64) {
        const int c = i & 63, e = (i >> 6) & 63, lg = i >> 12;
        pwt_[i] = (bf16)(pk2(KIN(17)[(size_t)lg * 4096 + c * 64 + e], 0.f) & 0xffffu);
    }
}
template <bool FINAL> __device__ __forceinline__ void norm_rows(const float* srcP, const float* srcS, const float* g, bf16* H, float* outf, int gw, int NGW, int lane) {
    const f32x4* g4 = (const f32x4*)g + lane;
    f32x4 gv[4];
#pragma unroll
    for (int j = 0; j < 4; ++j) gv[j] = g4[64 * j];
    for (int m = gw; m < M; m += NGW) {
        const float* xr = (m < MP) ? srcP + (size_t)m * D : srcS + (size_t)(m - MP) * D;
        const f32x4* x4 = (const f32x4*)xr + lane;
        f32x4 v[4]; float s = 0.f;
#pragma unroll
        for (int j = 0; j < 4; ++j) { v[j] = x4[64 * j]; s += (v[j].x * v[j].x + v[j].y * v[j].y) + (v[j].z * v[j].z + v[j].w * v[j].w); }
        const float rstd = 1.0f / sqrtf(wave_sum(s) * (1.0f / D) + EPS);
        if (FINAL) {
            f32x4* o4 = (f32x4*)(outf + (size_t)m * D) + lane;
#pragma unroll
            for (int j = 0; j < 4; ++j) o4[64 * j] = v[j] * rstd * gv[j];
        } else {
            v2u* o2 = (v2u*)(H + (size_t)m * D) + lane;
#pragma unroll
            for (int j = 0; j < 4; ++j) { const f32x4 y = v[j] * rstd * gv[j]; v2u w; w.x = pk2(y.x, y.y); w.y = pk2(y.z, y.w); o2[64 * j] = w; }
        }
    }
}
__device__ __forceinline__ f32x16 mfma32(bf16x8 a, bf16x8 b, f32x16 c) { return __builtin_amdgcn_mfma_f32_32x32x16_bf16(a, b, c, 0, 0, 0); }


template <bool BASE16, int K> __device__ __forceinline__ void skinny_part1(LAS unsigned char* lds, const bf16* A, const bf16* Bt, const void* base, bf16* out, float scale,
                                            unsigned* slots, unsigned* cnt8, int tile, int tid) {
    const int lane = tid & 63, r32 = lane & 31, hi = lane >> 5, wid = __builtin_amdgcn_readfirstlane(tid >> 6);
    LAS float* R = (LAS float*)lds;
    LAS float* PARK = (LAS float*)(lds + 131072);
    const int rt = tile >> 5, ct = tile & 31, kw = K >> 3, k0 = wid * kw;
    const int e = tid * 2, row = e >> 5, col = e & 31;
    const size_t o = (size_t)(rt * 32 + row) * 1024 + ct * 32 + col;
    f32x2 bv; if (BASE16) { const unsigned bw = *(const unsigned*)((const bf16*)base + o); bv.x = bf2f(bw & 0xffff); bv.y = bf2f(bw >> 16); } else bv = *(const f32x2*)((const float*)base + o);
    const bf16* ap = A + (size_t)(rt * 32 + r32) * K + wid * 16 + hi * 8; const bf16* bp = Bt + (size_t)(ct * 32 + r32) * K + wid * 16 + hi * 8; (void)k0;
    f32x16 acc;
#pragma unroll
    for (int r = 0; r < 16; ++r) acc[r] = 0.f;
    constexpr int NST = K / 128, UB = (NST % 11 == 0) ? 11 : 8;
#pragma unroll 1
    for (int s0 = 0; s0 < NST; s0 += UB) { bf16x8 av[UB], bw[UB];
#pragma unroll
        for (int j = 0; j < UB; ++j) { av[j] = *(const bf16x8*)(ap + (s0 + j) * 128); bw[j] = *(const bf16x8*)(bp + (s0 + j) * 128); }
#pragma unroll
        for (int j = 0; j < UB; ++j) acc = mfma32(av[j], bw[j], acc); }
    __syncthreads();
#pragma unroll
    for (int r = 0; r < 16; ++r) R[(wid * 32 + crow(r, hi)) * 32 + r32] = acc[r];
    __syncthreads();
    f32x2 s = {0.f, 0.f};
#pragma unroll
    for (int w = 0; w < 8; ++w) s += *(const LAS f32x2*)(R + (w * 32 + row) * 32 + col);
    const f32x2 v = bv + s * scale;
    float ss = v.x * v.x + v.y * v.y; ss += swz_xor<1>(ss); ss += swz_xor<2>(ss); ss += swz_xor<4>(ss); ss += swz_xor<8>(ss);
    if ((tid & 15) == 0) __hip_atomic_store(slots + (size_t)(rt * 32 + row) * 32 + ct, __builtin_bit_cast(unsigned, ss), __ATOMIC_RELAXED, __HIP_MEMORY_SCOPE_AGENT);
    *(LAS f32x2*)(PARK + tid * 2) = v;
    asm volatile("s_waitcnt vmcnt(0)" ::: "memory");
    __syncthreads();
    if (tid == 0) __hip_atomic_fetch_add(cnt8 + 64 * rt, 1u, __ATOMIC_RELAXED, __HIP_MEMORY_SCOPE_AGENT);
    if (out) *(unsigned*)(out + o) = pk2(v.x, v.y);
    __syncthreads();
}
__device__ __forceinline__ void skinny_part2(LAS unsigned char* lds, bf16* hb, float* yout, const float* gain, unsigned* slots, unsigned* cnt8, int tile, int tid) {
    LAS float* PARK = (LAS float*)(lds + 131072);
    const int rt = tile >> 5, ct = tile & 31, e = tid * 2, row = e >> 5, col = e & 31;
    const size_t o = (size_t)(rt * 32 + row) * 1024 + ct * 32 + col;
    if (tid == 0) {
        unsigned spins = 0;
        while (__hip_atomic_load(cnt8 + 64 * rt, __ATOMIC_RELAXED, __HIP_MEMORY_SCOPE_AGENT) < 32u) { __builtin_amdgcn_s_sleep(2); if (++spins > (1u << 22)) break; }
        __builtin_amdgcn_fence(__ATOMIC_ACQUIRE, "agent");
        asm volatile("s_waitcnt vmcnt(0)" ::: "memory");
    }
    __syncthreads();
    const unsigned* sl = slots + (size_t)(rt * 32 + row) * 32 + (tid & 15) * 2;
    float tot = __builtin_bit_cast(float, __hip_atomic_load(sl, __ATOMIC_RELAXED, __HIP_MEMORY_SCOPE_AGENT)) + __builtin_bit_cast(float, __hip_atomic_load(sl + 1, __ATOMIC_RELAXED, __HIP_MEMORY_SCOPE_AGENT));
    tot += swz_xor<1>(tot); tot += swz_xor<2>(tot); tot += swz_xor<4>(tot); tot += swz_xor<8>(tot);
    const float r = 1.0f / sqrtf(tot * (1.0f / 1024.0f) + EPS);
    const f32x2 v = *(const LAS f32x2*)(PARK + tid * 2);
    const f32x2 gv = *(const f32x2*)(gain + ct * 32 + col); const f32x2 y = v * r * gv;
    if (hb) *(unsigned*)(hb + o) = pk2(y.x, y.y); else *(f32x2*)(yout + o) = y;
    __syncthreads();
}

__device__ __forceinline__ void sample_piece(LAS unsigned char* lds, int pc, int l, const bf16* Qb, const float* cache_k, const float* cache_v, const float* knew, const float* vnew, float* OPART, float* MLP, int tid) {
    const int lane = tid & 63, r32 = lane & 31, hi = lane >> 5, wid = __builtin_amdgcn_readfirstlane(tid >> 6);
    const int b = pc >> 5, h = (pc >> 3) & 3, s = pc & 7;
    const bf16* qrow = Qb + (size_t)(MP + b * 32 + r32) * 512 + h * 128 + hi * 8;
    LAS float* ML = (LAS float*)lds;
    LAS float* FAC = (LAS float*)(lds + 4096);
    LAS float* OX = (LAS float*)(lds + 8192);
    const bool extra = (s == 7) && (wid == 7);
    const size_t off = ((size_t)((l * 8 + b) * 4096 + (s * 8 + wid) * 64)) * 512 + h * 128;
    const size_t offx = ((size_t)(l * 8 + b) * 32) * 512 + h * 128;
    const float* Kt = cache_k + off; const float* Vt = cache_v + off; const float* Kx = knew + offx; const float* Vx = vnew + offx;
    float mrow[2], lrow[2]; bf16x8 pw[2][6];
#pragma unroll
    for (int c = 0; c < 2; ++c) {
        bf16x8 qf[4];
#pragma unroll
        for (int d0 = 0; d0 < 4; ++d0) qf[d0] = *(const bf16x8*)(qrow + c * 64 + d0 * 16);
        f32x16 sc[3];
        {
            LAS bf16* KS = (LAS bf16*)(lds + 8192) + wid * (64 * 72);
            f32x4 kr[16];
#pragma unroll
            for (int i = 0; i < 16; ++i) kr[i] = __builtin_nontemporal_load((const f32x4*)(Kt + (size_t)(4 * i + (lane >> 4)) * 512 + c * 64 + 4 * (lane & 15)));
#pragma unroll
            for (int i = 0; i < 16; ++i) { v2u w; w.x = pk2(kr[i].x, kr[i].y); w.y = pk2(kr[i].z, kr[i].w); *(LAS v2u*)(KS + (4 * i + (lane >> 4)) * 72 + 4 * (lane & 15)) = w; }
            LDS_WAIT();
#pragma unroll
            for (int kvb = 0; kvb < 2; ++kvb) {
                f32x16 a;
#pragma unroll
                for (int r = 0; r < 16; ++r) a[r] = 0.f;
#pragma unroll
                for (int d0 = 0; d0 < 4; ++d0) { const bf16x8 kf = *(const LAS bf16x8*)(KS + (kvb * 32 + r32) * 72 + d0 * 16 + hi * 8); a = mfma32(kf, qf[d0], a); }
                sc[kvb] = a;
            }
            LDS_WAIT();
        }
        if (extra) {
            f32x16 a;
#pragma unroll
            for (int r = 0; r < 16; ++r) a[r] = 0.f;
            const float* kp = Kx + (size_t)r32 * 512 + c * 64 + hi * 8;
#pragma unroll
            for (int d0 = 0; d0 < 4; ++d0) { const f32x4 x0 = *(const f32x4*)(kp + d0 * 16), x1 = *(const f32x4*)(kp + d0 * 16 + 4); a = mfma32(pack8(x0, x1), qf[d0], a); }
            sc[2] = a;
        } else {
#pragma unroll
            for (int r = 0; r < 16; ++r) sc[2][r] = -1e30f;
        }
        float mx = -1e30f;
#pragma unroll
        for (int r = 0; r < 16; ++r) mx = fmaxf(mx, fmaxf(fmaxf(sc[0][r], sc[1][r]), sc[2][r]));
        mx = xhalf_max(mx);
        float sum = 0.f;
#pragma unroll
        for (int kvb = 0; kvb < 3; ++kvb)
#pragma unroll
            for (int r = 0; r < 16; ++r) { const float pv = __builtin_amdgcn_exp2f(sc[kvb][r] - mx); sc[kvb][r] = pv; sum += pv; }
        sum = xhalf_sum(sum);
        mrow[c] = mx; lrow[c] = sum;
#pragma unroll
        for (int kvb = 0; kvb < 3; ++kvb)
#pragma unroll
            for (int hf = 0; hf < 2; ++hf) { v4u w; w.x = pk2(sc[kvb][8 * hf + 0], sc[kvb][8 * hf + 1]); w.y = pk2(sc[kvb][8 * hf + 2], sc[kvb][8 * hf + 3]);
                w.z = pk2(sc[kvb][8 * hf + 4], sc[kvb][8 * hf + 5]); w.w = pk2(sc[kvb][8 * hf + 6], sc[kvb][8 * hf + 7]); pw[c][2 * kvb + hf] = __builtin_bit_cast(bf16x8, w); }
    }
    asm volatile("" ::: "memory");
    f32x16 o[2][4];
#pragma unroll
    for (int c = 0; c < 2; ++c)
#pragma unroll
        for (int eb = 0; eb < 4; ++eb)
#pragma unroll
            for (int r = 0; r < 16; ++r) o[c][eb][r] = 0.f;
#pragma unroll
    for (int ks = 0; ks < 6; ++ks) {
        if (ks < 4 || extra) {
#pragma unroll
            for (int eb = 0; eb < 4; ++eb) {
                const float* vp = (ks < 4 ? Vt + (size_t)(ks * 16 + 4 * hi) * 512 : Vx + (size_t)((ks - 4) * 16 + 4 * hi) * 512) + eb * 32 + r32;
                f32x4 x0, x1;
                x0.x = __builtin_nontemporal_load(vp + 0 * 512); x0.y = __builtin_nontemporal_load(vp + 1 * 512); x0.z = __builtin_nontemporal_load(vp + 2 * 512); x0.w = __builtin_nontemporal_load(vp + 3 * 512);
                x1.x = __builtin_nontemporal_load(vp + 8 * 512); x1.y = __builtin_nontemporal_load(vp + 9 * 512); x1.z = __builtin_nontemporal_load(vp + 10 * 512); x1.w = __builtin_nontemporal_load(vp + 11 * 512);
                const bf16x8 vf = pack8(x0, x1);
                o[0][eb] = mfma32(pw[0][ks], vf, o[0][eb]); o[1][eb] = mfma32(pw[1][ks], vf, o[1][eb]);
            }
        }
    }
    if (hi == 0) {
#pragma unroll
        for (int c = 0; c < 2; ++c) { ML[((wid * 2 + c) * 32 + r32) * 2 + 0] = mrow[c]; ML[((wid * 2 + c) * 32 + r32) * 2 + 1] = lrow[c]; }
    }
    __syncthreads();
    const int pidx = s;
    if (tid < 64) {
        const int c = tid >> 5, q = tid & 31; float mw[8], lw[8]; float Mx = -1e30f;
#pragma unroll
        for (int w = 0; w < 8; ++w) { mw[w] = ML[((w * 2 + c) * 32 + q) * 2 + 0]; lw[w] = ML[((w * 2 + c) * 32 + q) * 2 + 1]; Mx = fmaxf(Mx, mw[w]); }
        float L = 0.f;
#pragma unroll
        for (int w = 0; w < 8; ++w) { const float fz = __builtin_amdgcn_exp2f(mw[w] - Mx); FAC[(w * 2 + c) * 32 + q] = fz; L += lw[w] * fz; }
        float* mp = MLP + ((size_t)((((b * 4 + h) * 2 + c) * 9 + pidx) * 32 + q)) * 2; mp[0] = Mx; mp[1] = L;
    }
    __syncthreads();
#pragma unroll
    for (int c = 0; c < 2; ++c) {
#pragma unroll
        for (int eb = 0; eb < 4; ++eb)
#pragma unroll
            for (int r = 0; r < 16; ++r) { const int q = crow(r, hi); OX[(wid * 32 + q) * 128 + eb * 32 + r32] = o[c][eb][r] * FAC[(wid * 2 + c) * 32 + q]; }
        __syncthreads();
        { const int idx = tid * 8, q = idx >> 7, e = idx & 127; f32x4 s0 = {0.f, 0.f, 0.f, 0.f}, s1 = {0.f, 0.f, 0.f, 0.f};
#pragma unroll
          for (int w = 0; w < 8; ++w) { s0 += *(const LAS f32x4*)(OX + (w * 32 + q) * 128 + e); s1 += *(const LAS f32x4*)(OX + (w * 32 + q) * 128 + e + 4); }
          float* dst = OPART + ((size_t)((((b * 4 + h) * 2 + c) * 9 + pidx) * 32 + q)) * 128 + e; *(f32x4*)dst = s0; *(f32x4*)(dst + 4) = s1; }
        __syncthreads();
    }
}

template <int W> __device__ __forceinline__ void pool_d(const LAS float* U, LAS bf16* Dd, int ch, int tbeg, int t0, bool smp) {
    float s = 0.f;
#pragma unroll
    for (int i = 0; i < W; ++i) s += U[(15 + tbeg - i) * 256 + ch];
#pragma unroll 8
    for (int k = 0; k < 32; ++k) {
        const int tt = tbeg + k; const float cur = U[(15 + tt) * 256 + ch];
        if (k > 0) s += cur - U[(15 + tt - W) * 256 + ch];
        const int pos = smp ? 4096 + tt : t0 + tt; const int cnt = (pos + 1 < W) ? pos + 1 : W;
        const float d = s * __builtin_amdgcn_rcpf((float)cnt) - cur;
        Dd[tt * 264 + ch] = (bf16)(pk2(d, 0.f) & 0xffffu);
    }
}
__device__ __forceinline__ f32x4 bf4_to_f32(v2u w) { f32x4 v; v.x = bf2f(w.x & 0xffff); v.y = bf2f(w.x >> 16); v.z = bf2f(w.y & 0xffff); v.w = bf2f(w.y >> 16); return v; }
__device__ __forceinline__ void poolconv_tile(LAS unsigned char* lds, int tl, int l, const bf16* Zb, bf16* MIX, const float* state_pool, const float* state_conv, const bf16* pwt, const float* pool_scale,
                                              const float* conv_w, float* out_cp, float* out_cs, int tid) {
    const int lane = tid & 63, r32 = lane & 31, hi = lane >> 5, wid = __builtin_amdgcn_readfirstlane(tid >> 6);
    int b, t0, TT, rowbase; bool smp;
    if (tl < 256) { b = tl >> 5; t0 = (tl & 31) * 64; TT = 64; rowbase = b * 2048 + t0; smp = false; }
    else { b = tl - 256; t0 = 0; TT = 32; rowbase = MP + b * 32; smp = true; }
    LAS float* U = (LAS float*)lds;
    LAS bf16* Dd = (LAS bf16*)(lds + 81920);
    {
        f32x4 uv[10];
#pragma unroll
        for (int k = 0; k < 10; ++k) {
            const int idx = tid + 512 * k, i = idx >> 6, c4 = (idx & 63) * 4; f32x4 v = {0.f, 0.f, 0.f, 0.f};
            if (i < 15 + TT) {
                if (i < 15 && smp) v = *(const f32x4*)(state_pool + (size_t)((l * 8 + b) * 15 + i) * 256 + c4);
                else if (i >= 15 || t0 - 15 + i >= 0) v = bf4_to_f32(*(const v2u*)(Zb + (size_t)(rowbase + i - 15) * 1024 + c4));
            }
            uv[k] = v;
        }
#pragma unroll
        for (int k = 0; k < 10; ++k) { const int idx = tid + 512 * k, i = idx >> 6, c4 = (idx & 63) * 4; if (i < 15 + TT) *(LAS f32x4*)(U + i * 256 + c4) = uv[k]; }
    }
    __syncthreads();
    {
        const int ch = tid & 255, th = tid >> 8, gi = __builtin_amdgcn_readfirstlane(ch >> 6);
        if (th * 32 < TT) {
            if (gi == 0) pool_d<2>(U, Dd, ch, th * 32, t0, smp); else if (gi == 1) pool_d<4>(U, Dd, ch, th * 32, t0, smp);
            else if (gi == 2) pool_d<8>(U, Dd, ch, th * 32, t0, smp); else pool_d<16>(U, Dd, ch, th * 32, t0, smp);
        }
    }
    __syncthreads();
    {
        const int gi = wid >> 1, th = wid & 1;
        if (th * 32 < TT) {
            f32x16 acc0, acc1;
#pragma unroll
            for (int r = 0; r < 16; ++r) { acc0[r] = 0.f; acc1[r] = 0.f; }
#pragma unroll
            for (int ks = 0; ks < 4; ++ks) {
                const bf16x8 a = *(const LAS bf16x8*)(Dd + (th * 32 + r32) * 264 + gi * 64 + ks * 16 + hi * 8);
                const bf16x8 b0 = *(const bf16x8*)(pwt + (size_t)((l * 4 + gi) * 64 + r32) * 64 + ks * 16 + hi * 8);
                const bf16x8 b1 = *(const bf16x8*)(pwt + (size_t)((l * 4 + gi) * 64 + 32 + r32) * 64 + ks * 16 + hi * 8);
                acc0 = mfma32(a, b0, acc0); acc1 = mfma32(a, b1, acc1);
            }
            const float sc0 = pool_scale[l * 256 + gi * 64 + r32], sc1 = pool_scale[l * 256 + gi * 64 + 32 + r32];
#pragma unroll
            for (int r = 0; r < 16; ++r) { const int tok = th * 32 + crow(r, hi); bf16* mp = MIX + (size_t)(rowbase + tok) * 1024 + 512 + gi * 64 + r32;
                mp[0] = (bf16)(pk2(acc0[r] * sc0, 0.f) & 0xffffu); mp[32] = (bf16)(pk2(acc1[r] * sc1, 0.f) & 0xffffu); }
        }
    }
    if (wid * 8 < TT) {
        const int cq = lane, tc = wid * 8;
        v2u hraw[10], graw[10], braw[8]; f32x4 hst[2];
        hst[0] = (f32x4){0.f, 0.f, 0.f, 0.f}; hst[1] = hst[0];
#pragma unroll
        for (int i = 0; i < 10; ++i) {
            const int ts = tc - 2 + i; hraw[i] = (v2u){0u, 0u}; graw[i] = (v2u){0u, 0u};
            if (ts >= 0 || (!smp && t0 + ts >= 0)) { const bf16* zr = Zb + (size_t)(rowbase + ts) * 1024 + 4 * cq; hraw[i] = *(const v2u*)(zr + 256); graw[i] = *(const v2u*)(zr + 768); }
        }
#pragma unroll
        for (int i = 0; i < 8; ++i) braw[i] = *(const v2u*)(Zb + (size_t)(rowbase + tc + i) * 1024 + 512 + 4 * cq);
        if (smp && tc == 0) { hst[0] = *(const f32x4*)(state_conv + (size_t)((l * 8 + b) * 2 + 0) * 256 + 4 * cq); hst[1] = *(const f32x4*)(state_conv + (size_t)((l * 8 + b) * 2 + 1) * 256 + 4 * cq); }
        const f32x4 cw0 = *(const f32x4*)(conv_w + l * 768 + 4 * cq), cw1 = *(const f32x4*)(conv_w + l * 768 + 256 + 4 * cq), cw2 = *(const f32x4*)(conv_w + l * 768 + 512 + 4 * cq);
        f32x4 cm2 = bf4_to_f32(graw[0]) * bf4_to_f32(hraw[0]), cm1 = bf4_to_f32(graw[1]) * bf4_to_f32(hraw[1]);
        if (smp && tc == 0) { cm2 = hst[0]; cm1 = hst[1]; }
#pragma unroll
        for (int i = 0; i < 8; ++i) {
            const int tt = tc + i;
            const f32x4 cv = bf4_to_f32(graw[i + 2]) * bf4_to_f32(hraw[i + 2]);
            const f32x4 y = bf4_to_f32(braw[i]) * (cw0 * cm2 + cw1 * cm1 + cw2 * cv);
            v2u w; w.x = pk2(y.x, y.y); w.y = pk2(y.z, y.w);
            *(v2u*)(MIX + (size_t)(rowbase + tt) * 1024 + 768 + 4 * cq) = w;
            if (smp) { if (tt >= 30) *(f32x4*)(out_cs + (size_t)((l * 8 + b) * 2 + tt - 30) * 256 + 4 * cq) = cv; }
            else if (t0 + tt >= 2046) *(f32x4*)(out_cp + (size_t)((l * 8 + b) * 2 + t0 + tt - 2046) * 256 + 4 * cq) = cv;
            cm2 = cm1; cm1 = cv;
        }
    }
    __syncthreads();
}

__device__ __forceinline__ void combine_phase(int l, const bf16* Ob_, const float* OPART_, const float* MLP_, bf16* MIX_, int gw, int NGW, int lane) {
    const float lam_init = (l == 0) ? 0.2f : 0.35550934f;
    float lam;
    { const float a = KIN(12)[l * 64 + lane] * KIN(13)[l * 64 + lane], c = KIN(14)[l * 64 + lane] * KIN(15)[l * 64 + lane];
      lam = __expf(wave_sum(a)) - __expf(wave_sum(c)) + lam_init; }
    const float g0 = KIN(16)[l * 128 + 2 * lane], g1 = KIN(16)[l * 128 + 2 * lane + 1];
    for (int base = gw * 8; base < MP * 4; base += NGW * 8) {
        float a0[8], a1[8];
        {
            unsigned w1[8], w2[8];
#pragma unroll
            for (int j = 0; j < 8; ++j) { const int wt = base + j, row = wt >> 2, h = wt & 3;
                w1[j] = *(const unsigned*)(Ob_ + (size_t)row * 1024 + h * 128 + 2 * lane); w2[j] = *(const unsigned*)(Ob_ + (size_t)row * 1024 + 512 + h * 128 + 2 * lane); }
#pragma unroll
            for (int j = 0; j < 8; ++j) { a0[j] = bf2f(w1[j] & 0xffff) - lam * bf2f(w2[j] & 0xffff); a1[j] = bf2f(w1[j] >> 16) - lam * bf2f(w2[j] >> 16); }
        }
        float ss[8];
#pragma unroll
        for (int j = 0; j < 8; ++j) ss[j] = a0[j] * a0[j] + a1[j] * a1[j];
#pragma unroll
        for (int j = 0; j < 8; ++j) ss[j] += swz_xor<1>(ss[j]);
#pragma unroll
        for (int j = 0; j < 8; ++j) ss[j] += swz_xor<2>(ss[j]);
#pragma unroll
        for (int j = 0; j < 8; ++j) ss[j] += swz_xor<4>(ss[j]);
#pragma unroll
        for (int j = 0; j < 8; ++j) ss[j] += swz_xor<8>(ss[j]);
#pragma unroll
        for (int j = 0; j < 8; ++j) ss[j] += swz_xor<16>(ss[j]);
#pragma unroll
        for (int j = 0; j < 8; ++j) { const int wt = base + j, row = wt >> 2, h = wt & 3;
            const float tot = xhalf_sum(ss[j]);
            const float r = (1.0f / sqrtf(tot * (1.0f / 128.0f) + EPS)) * (1.0f - lam_init);
            *(unsigned*)(MIX_ + (size_t)row * 1024 + h * 128 + 2 * lane) = pk2(a0[j] * r * g0, a1[j] * r * g1); }
    }
    for (int wt = MP * 4 + gw; wt < M * 4; wt += NGW) {
        const int row = wt >> 2, h = wt & 3, rs = row - MP, b = rs >> 5, q = rs & 31; float oc[2][2];
#pragma unroll
        for (int c = 0; c < 2; ++c) {
            const size_t pb = (size_t)(((b * 4 + h) * 2 + c) * 9);
            float mw[8], lw[8]; f32x2 ov[8]; float Mx = -1e30f;
#pragma unroll
            for (int pi = 0; pi < 8; ++pi) { const f32x2 ml = *(const f32x2*)(MLP_ + ((pb + pi) * 32 + q) * 2); mw[pi] = ml.x; lw[pi] = ml.y; ov[pi] = *(const f32x2*)(OPART_ + ((pb + pi) * 32 + q) * 128 + 2 * lane); }
#pragma unroll
            for (int pi = 0; pi < 8; ++pi) Mx = fmaxf(Mx, mw[pi]);
            float L = 0.f, s0 = 0.f, s1 = 0.f;
#pragma unroll
            for (int pi = 0; pi < 8; ++pi) { const float fz = __builtin_amdgcn_exp2f(mw[pi] - Mx); L += lw[pi] * fz; s0 += ov[pi].x * fz; s1 += ov[pi].y * fz; }
            const float il = 1.0f / L; oc[c][0] = s0 * il; oc[c][1] = s1 * il;
        }
        const float a0 = oc[0][0] - lam * oc[1][0], a1 = oc[0][1] - lam * oc[1][1];
        const float tot = wave_sum(a0 * a0 + a1 * a1);
        const float r = (1.0f / sqrtf(tot * (1.0f / 128.0f) + EPS)) * (1.0f - lam_init);
        *(unsigned*)(MIX_ + (size_t)row * 1024 + h * 128 + 2 * lane) = pk2(a0 * r * g0, a1 * r * g1);
    }
}

#ifndef PROBE_SLOW_ATTN
#define PROBE_SLOW_ATTN 0
#endif
#if PROBE_SLOW_ATTN
__device__ __forceinline__ void slow_attn_phase(int l, const bf16* Qb_, float* outp, const float* cache_k, const float* cache_v, bf16* MIX_, int gw, int NGW, int lane) {
    const float lam_init = (l == 0) ? 0.2f : 0.35550934f;
    float lam;
    { const float a = KIN(12)[l * 64 + lane] * KIN(13)[l * 64 + lane], c = KIN(14)[l * 64 + lane] * KIN(15)[l * 64 + lane];
      lam = __expf(wave_sum(a)) - __expf(wave_sum(c)) + lam_init; }
    const float g0 = KIN(16)[l * 128 + 2 * lane], g1 = KIN(16)[l * 128 + 2 * lane + 1];
    for (int wt = gw; wt < M * 4; wt += NGW) {
        const int row = wt >> 2, h = wt & 3;
        const float *K0, *V0, *K1, *V1; int n0, n1;
        if (row < MP) { const int b = row >> 11, t = row & 2047; K0 = outp + OFF_KP + ((size_t)l * MP + (size_t)b * 2048) * 512 + h * 128; V0 = outp + OFF_VP + ((size_t)l * MP + (size_t)b * 2048) * 512 + h * 128; n0 = ((t >> 6) + 1) * 64; K1 = K0; V1 = V0; n1 = 0; }
        else { const int rs = row - MP, b = rs >> 5; K0 = cache_k + ((size_t)(l * 8 + b) * 4096) * 512 + h * 128; V0 = cache_v + ((size_t)(l * 8 + b) * 4096) * 512 + h * 128; n0 = 4096;
               K1 = outp + OFF_KS + ((size_t)(l * 8 + b) * 32) * 512 + h * 128; V1 = outp + OFF_VS + ((size_t)(l * 8 + b) * 32) * 512 + h * 128; n1 = 32; }
        float oc[2][2];
#pragma unroll 1
        for (int c = 0; c < 2; ++c) {
            float q[64];
#pragma unroll
            for (int d = 0; d < 64; ++d) q[d] = bf2f(Qb_[(size_t)row * 512 + h * 128 + c * 64 + d]);
            float mx = -1e30f;
            for (int seg = 0; seg < 2; ++seg) { const float* Kp = seg ? K1 : K0; const int n = seg ? n1 : n0;
                for (int j0 = 0; j0 < n; j0 += 64) { const int j = j0 + lane; float s = -1e30f;
                    if (j < n) { const float* kr = Kp + (size_t)j * 512 + c * 64; s = 0.f;
#pragma unroll
                        for (int d = 0; d < 64; ++d) s += q[d] * kr[d]; }
                    mx = fmaxf(mx, s); } }
            mx = fmaxf(mx, swz_xor<1>(mx)); mx = fmaxf(mx, swz_xor<2>(mx)); mx = fmaxf(mx, swz_xor<4>(mx)); mx = fmaxf(mx, swz_xor<8>(mx)); mx = fmaxf(mx, swz_xor<16>(mx)); mx = xhalf_max(mx);
            float L = 0.f, o0 = 0.f, o1 = 0.f;
            for (int seg = 0; seg < 2; ++seg) { const float* Kp = seg ? K1 : K0; const float* Vp = seg ? V1 : V0; const int n = seg ? n1 : n0;
                for (int j0 = 0; j0 < n; j0 += 64) { const int j = j0 + lane; float pj = 0.f;
                    if (j < n) { const float* kr = Kp + (size_t)j * 512 + c * 64; float s = 0.f;
#pragma unroll
                        for (int d = 0; d < 64; ++d) s += q[d] * kr[d];
                        pj = __builtin_amdgcn_exp2f(s - mx); }
                    L += pj;
                    const int nn = (n - j0 < 64) ? n - j0 : 64;
                    for (int jj = 0; jj < nn; ++jj) { const float pb = __builtin_bit_cast(float, __builtin_amdgcn_readlane(__builtin_bit_cast(int, pj), jj));
                        const f32x2 vv = *(const f32x2*)(Vp + (size_t)(j0 + jj) * 512 + 2 * lane); o0 += pb * vv.x; o1 += pb * vv.y; } } }
            L = wave_sum(L);
            oc[c][0] = o0 / L; oc[c][1] = o1 / L;
        }
        const float a0 = oc[0][0] - lam * oc[1][0], a1 = oc[0][1] - lam * oc[1][1];
        const float ss = wave_sum(a0 * a0 + a1 * a1);
        const float r = (1.0f / sqrtf(ss * (1.0f / 128.0f) + EPS)) * (1.0f - lam_init);
        *(unsigned*)(MIX_ + (size_t)row * 1024 + h * 128 + 2 * lane) = pk2(a0 * r * g0, a1 * r * g1);
    }
}
#endif

#ifndef PROBE_SLOW_PC
#define PROBE_SLOW_PC 0
#endif
#if PROBE_SLOW_PC
__device__ __forceinline__ float zval(const bf16* Zb_, const float* st, int l, int b, bool smp, int rowbase, int t, int col, int hist) {
    if (t >= 0) return bf2f(Zb_[(size_t)(rowbase + t) * 1024 + col]);
    if (!smp) return 0.f;
    return st[(size_t)((l * 8 + b) * hist + (hist + t)) * 256 + (col & 255)];
}
__device__ __forceinline__ void slow_pc_phase(int l, const bf16* Zb_, bf16* MIX_, int gw, int NGW, int lane) {
    const float* sp = KIN(4); const float* scv = KIN(5); const float* pw = KIN(17); const float* psc = KIN(18); const float* cw = KIN(19);
    for (int wt = gw; wt < M * 4; wt += NGW) {
        const int row = wt >> 2, g = wt & 3; const bool smp = row >= MP;
        int b, t, rowbase; if (smp) { const int rs = row - MP; b = rs >> 5; t = rs & 31; rowbase = MP + b * 32; } else { b = row >> 11; t = row & 2047; rowbase = b * 2048; }
        const int w = 2 << g, ch = g * 64 + lane;
        float s = 0.f;
        for (int i = 0; i < w; ++i) { const int tt = t - i; s += zval(Zb_, sp, l, b, smp, rowbase, tt, ch, 15); }
        const int pos = smp ? 4096 + t : t; const int cnt = (pos + 1 < w) ? pos + 1 : w;
        const float d = s / (float)cnt - zval(Zb_, sp, l, b, smp, rowbase, t, ch, 15);
        float mine = 0.f;
        for (int e = 0; e < 64; ++e) { const float v = wave_sum(d * pw[(size_t)((l * 4 + g) * 64 + lane) * 64 + e]); if (e == lane) mine = v; }
        MIX_[(size_t)row * 1024 + 512 + ch] = (bf16)(pk2(mine * psc[l * 256 + ch], 0.f) & 0xffffu);
        float cvv[3];
#pragma unroll
        for (int k = 0; k < 3; ++k) { const int tt = t - 2 + k;
            if (tt >= 0) cvv[k] = bf2f(Zb_[(size_t)(rowbase + tt) * 1024 + 768 + ch]) * bf2f(Zb_[(size_t)(rowbase + tt) * 1024 + 256 + ch]);
            else cvv[k] = smp ? scv[(size_t)((l * 8 + b) * 2 + (2 + tt)) * 256 + ch] : 0.f; }
        const float bgv = bf2f(Zb_[(size_t)row * 1024 + 512 + ch]);
        const float y = bgv * (cw[l * 768 + ch] * cvv[0] + cw[l * 768 + 256 + ch] * cvv[1] + cw[l * 768 + 512 + ch] * cvv[2]);
        MIX_[(size_t)row * 1024 + 768 + ch] = (bf16)(pk2(y, 0.f) & 0xffffu);
    }
}
#endif

#define XB_TMO      128
#define XB_XCNT(j)  (256  + 64 * (j))
#define XB_XSUB(j)  (1280 + 64 * (j))
#define XB_XGEN(j)  (2304 + 64 * (j))
#define XB_TOP      3328
#define XB_TOPGEN   3392
#define XCD_BAR_WORDS 3456
#define XB_SPIN_CAP (1u << 18)
__device__ __forceinline__ unsigned xb_ld(unsigned* p)              { return __hip_atomic_load(p, __ATOMIC_RELAXED, __HIP_MEMORY_SCOPE_AGENT); }
__device__ __forceinline__ unsigned xb_add(unsigned* p, unsigned v) { return __hip_atomic_fetch_add(p, v, __ATOMIC_RELAXED, __HIP_MEMORY_SCOPE_AGENT); }
__device__ __forceinline__ unsigned xb_xcc_id() { return (unsigned)__builtin_amdgcn_s_getreg((3 << 11) | 20) & 0xFu; }
#define XB_SPIN(cond, bar) do { unsigned _sp = 0; while (cond) { __builtin_amdgcn_s_sleep(1); \
    if ((++_sp & 255u) == 0u) { if (xb_ld(&(bar)[XB_TMO])) break; if (_sp > XB_SPIN_CAP) { atomicAdd(&(bar)[XB_TMO], 1u); break; } } } } while (0)
__device__ __forceinline__ void xcd_barrier_complete(unsigned* bar, unsigned x, unsigned& nloc, unsigned& nx) {
    const unsigned G = gridDim.x * gridDim.y * gridDim.z;
    unsigned sum, cnt, mine, sp = 0u;
    for (;;) {
        sum = 0u; cnt = 0u; mine = 0u;
#pragma unroll
        for (unsigned j = 0; j < 16; ++j) { const unsigned c = xb_ld(&bar[XB_XCNT(j)]); sum += c; cnt += (c > 0u) ? 1u : 0u; mine = (j == x) ? c : mine; }
        if (sum == G) break;
        __builtin_amdgcn_s_sleep(1);
        if ((++sp & 255u) == 0u) { if (xb_ld(&bar[XB_TMO])) break; if (sp > XB_SPIN_CAP) { atomicAdd(&bar[XB_TMO], 1u); break; } }
    }
    nloc = mine > 0u ? mine : 1u; nx = cnt > 0u ? cnt : 1u;
}
__device__ __forceinline__ void xcd_barrier(unsigned* bar, unsigned x, volatile LAS unsigned* st) {
    asm volatile("s_waitcnt vmcnt(0)" ::: "memory");
    __syncthreads();
    if (threadIdx.x == 0) {
        __builtin_amdgcn_s_waitcnt(0);
        unsigned nloc = st[0], nx = st[1];
        if (nloc == 0u) { xcd_barrier_complete(bar, x, nloc, nx); st[0] = nloc; st[1] = nx; }
        const unsigned old = xb_add(&bar[XB_XSUB(x)], 1u);
        const unsigned gen = old / nloc;
        if (old + 1u == (gen + 1u) * nloc) {
            __builtin_amdgcn_fence(__ATOMIC_RELEASE, "agent");
            asm volatile("s_waitcnt vmcnt(0)" ::: "memory");
            const unsigned og = xb_add(&bar[XB_TOP], 1u);
            const unsigned tg = og / nx;
            if (og + 1u == (tg + 1u) * nx) xb_add(&bar[XB_TOPGEN], 1u);
            else XB_SPIN(xb_ld(&bar[XB_TOPGEN]) == tg, bar);
            __builtin_amdgcn_fence(__ATOMIC_ACQUIRE, "agent");
            xb_add(&bar[XB_XGEN(x)], 1u);
            asm volatile("s_waitcnt vmcnt(0)" ::: "memory");
        } else {
            XB_SPIN(xb_ld(&bar[XB_XGEN(x)]) == gen, bar);
            __builtin_amdgcn_fence(__ATOMIC_ACQUIRE, "agent");
            asm volatile("s_waitcnt vmcnt(0)" ::: "memory");
        }
    }
    __syncthreads();
}
#define CG_SYNC() do { asm volatile("s_waitcnt vmcnt(0) lgkmcnt(0)" ::: "memory"); grid.sync(); asm volatile("" ::: "memory"); } while (0)
#define GRID_SYNC() xcd_barrier((unsigned*)KWS() + 4096, xcc, (volatile LAS unsigned*)(lds + LDS_BYTES - 64))
__global__ void __launch_bounds__(NWAVES * 64, 2) mega_fwd(Params p) {
    extern __shared__ __attribute__((aligned(16))) unsigned char lds_raw[];
    LAS unsigned char* lds = (LAS unsigned char*)lds_raw;
    cg::grid_group grid = cg::this_grid();
    const int tid = threadIdx.x, lane = tid & 63, wave = __builtin_amdgcn_readfirstlane(tid >> 6);
    const int G = gridDim.x; const int bx = blockIdx.x; const int vcu0 = (G % 8 == 0) ? (bx % 8) * (G / 8) + bx / 8 : bx;
    const int NGW = G * NWAVES;
#define X ((bf16*)(ws + WS_X))
#define H ((bf16*)(ws + WS_H))
#define MIX ((bf16*)(ws + WS_MIX))
#define ACT ((bf16*)(ws + WS_ACT))
#define Qb ((bf16*)(ws + WS_QB))
#define Kb ((bf16*)(ws + WS_KB))
#define Vb ((bf16*)(ws + WS_VB))
#define Zb ((bf16*)(ws + WS_ZB))
#define Ob ((bf16*)(ws + WS_OB))
#define OPART ((float*)(ws + WS_OPART))
#define MLP ((float*)(ws + WS_ML))
#define pwt ((const bf16*)(ws + WS_POOLWT))
    if (tid < 16) ((LAS unsigned*)(lds + LDS_BYTES - 64))[tid] = 0u;
    const unsigned xcc = xb_xcc_id();
    if (tid == 0) (void)xb_add((unsigned*)KWS() + 4096 + XB_XCNT(xcc), 1u);
    __syncthreads();
    { const int gw = vcu0 * NWAVES + wave; prologue(lds, gw, NGW, wave, lane);
      norm_rows<false>(KIN(0), KIN(1), KIN(6), (bf16*)(KWS() + WS_H), nullptr, gw, NGW, lane); }
    CG_SYNC();
#define FRESH_IDS() int tid = threadIdx.x; asm volatile("" : "+v"(tid)); const int lane = tid & 63, wave = __builtin_amdgcn_readfirstlane(tid >> 6); int vcu = vcu0; asm volatile("" : "+s"(vcu)); const int gw = vcu * NWAVES + wave; (void)lane; (void)gw; (void)wave
#define CNT(nid, idx) ((unsigned*)(ws + CTL_CNT) + (size_t)((nid) * 80 + (idx)) * 64)
#pragma unroll 1
    for (int step = 0; step < 4; ++step) {
        const int l = step >> 1, f = step & 1;
        const bool first = (step == 0);
        { FRESH_IDS(); unsigned char* const ws = KWS(); unsigned char* const wl = ws + WS_W + (size_t)l * WL;
          pg8::Gemm g{H, (const bf16*)(wl + (f ? W_GU2 : W_GU1)), M, 2 * FF, D}; pg8::StaticOrder S; S.init(M, 2 * FF, G, bx);
          pg8::EpiSwiGLU E{ACT, FF};
          pg8::gemm_phase<pg8::EpiSwiGLU, pg8::StaticOrder, true, true>(lds, g, S, E); }
        GRID_SYNC();
        { FRESH_IDS(); unsigned char* const ws = KWS(); unsigned char* const wl = ws + WS_W + (size_t)l * WL;
          const bool last = (step == 3);
          const float* const gn = last ? KIN(25) : (f ? KIN(6) + (l + 1) * D : KIN(10) + l * D);
          const int nid = step * 2;
          float* const yo = KOUT() + OFF_Y;
          pg8::Gemm g{ACT, (const bf16*)(wl + (f ? W_D2 : W_D1)), MP, D, FF}; pg8::StaticOrder S; S.init(MP, D, G, bx);
          if (first) skinny_part1<false, FF>(lds, ACT + (size_t)MP * FF, (const bf16*)(wl + W_D1), KIN(1), X + (size_t)MP * D, 0.5f, (unsigned*)(ws + WS_SLOTS), CNT(nid, 64), vcu, tid);
          else skinny_part1<true, FF>(lds, ACT + (size_t)MP * FF, (const bf16*)(wl + (f ? W_D2 : W_D1)), X + (size_t)MP * D, last ? nullptr : X + (size_t)MP * D, 0.5f, (unsigned*)(ws + WS_SLOTS), CNT(nid, 64), vcu, tid);
          { pg8::Unit u0; const int pm0 = S.next(0, u0) ? u0.pm : 0;
            if (first) { pg8::EpiResidNorm<false> E{KIN(0), X, 0.5f, H, yo, gn, (unsigned*)(ws + WS_SLOTP), CNT(nid, pm0)};
                         pg8::gemm_phase<pg8::EpiResidNorm<false>, pg8::StaticOrder, false, true>(lds, g, S, E); }
            else { pg8::EpiResidNorm<true> E{X, last ? nullptr : X, 0.5f, last ? nullptr : H, yo, gn, (unsigned*)(ws + WS_SLOTP), CNT(nid, pm0)};
                   pg8::gemm_phase<pg8::EpiResidNorm<true>, pg8::StaticOrder, false, true>(lds, g, S, E); } }
          skinny_part2(lds, last ? nullptr : H + (size_t)MP * D, yo + (size_t)MP * D, gn, (unsigned*)(ws + WS_SLOTS), CNT(nid, 64), vcu, tid); }
        if (step == 3) break;
        GRID_SYNC();
        if (f == 0) {
            { FRESH_IDS(); unsigned char* const ws = KWS(); unsigned char* const wl = ws + WS_W + (size_t)l * WL;
              pg8::Gemm g{H, (const bf16*)(wl + W_IN), M, DIN, D}; pg8::StaticOrder S; S.init(M, DIN, G, bx);
              pg8::EpiWin E{ws, KOUT(), l, C2};
              pg8::gemm_phase<pg8::EpiWin, pg8::StaticOrder, true, true>(lds, g, S, E); }
            GRID_SYNC();
#pragma unroll 1
            for (int slot = 0; slot < 2; ++slot) {
              if (((slot ^ vcu0) & 1) == 0) {
                FRESH_IDS(); unsigned char* const ws = KWS();
                for (int i = 0; i < 4; ++i) {
                  const int L = i * G + vcu; if (L >= 1024) break;
                  const int bh = (L & 255) >> 1, sI = L & 1, ii = L >> 8;
                  const int qb = sI == 0 ? (ii == 0 ? 7 : ii == 1 ? 0 : ii == 2 ? 4 : 3) : (ii == 0 ? 6 : ii == 1 ? 1 : ii == 2 ? 5 : 2);
                  const int b = bh >> 4, vh = bh & 15, hh = vh >> 2, c = (vh >> 1) & 1, hf = vh & 1;
                  attn_body::attn_unit<8>(b, qb, (const attn_body::bf16*)(Qb + (hh * 2 + c) * 64), (const attn_body::bf16*)(Kb + (hh * 2 + c) * 64), (const attn_body::bf16*)(Vb + hh * 128 + hf * 64),
                                          (attn_body::bf16*)(Ob + c * 512 + hh * 128 + hf * 64), (char*)lds_raw);
                }
              } else {
                FRESH_IDS(); unsigned char* const ws = KWS(); float* const outp = KOUT();
                for (int pc = vcu; pc < 256; pc += G)
                  sample_piece(lds, pc, l, Qb, KIN(2), KIN(3), outp + OFF_KS, outp + OFF_VS, OPART, MLP, tid);
              }
              __syncthreads();
            }
            { FRESH_IDS(); unsigned char* const ws = KWS(); float* const outp = KOUT();
              for (int tl = vcu; tl < 264; tl += G)
                poolconv_tile(lds, tl, l, Zb, MIX, KIN(4), KIN(5), pwt, KIN(18), KIN(19), outp + OFF_CP, outp + OFF_CS, tid); }
            GRID_SYNC();
            { FRESH_IDS(); unsigned char* const ws = KWS();
              combine_phase(l, Ob, OPART, MLP, MIX, gw, NGW, lane); }
            GRID_SYNC();
            { FRESH_IDS(); unsigned char* const ws = KWS(); unsigned char* const wl = ws + WS_W + (size_t)l * WL;
              const float* const gn = KIN(21) + l * D; const int nid = step * 2 + 1;
              pg8::Gemm g{MIX, (const bf16*)(wl + W_OUT), MP, D, D}; pg8::StaticOrder S; S.init(MP, D, G, bx);
              skinny_part1<true, D>(lds, MIX + (size_t)MP * D, (const bf16*)(wl + W_OUT), X + (size_t)MP * D, X + (size_t)MP * D, 1.0f, (unsigned*)(ws + WS_SLOTS), CNT(nid, 64), vcu, tid);
              { pg8::Unit u0; const int pm0 = S.next(0, u0) ? u0.pm : 0;
                pg8::EpiResidNorm<true> E{X, X, 1.0f, H, nullptr, gn, (unsigned*)(ws + WS_SLOTP), CNT(nid, pm0)};
                pg8::gemm_phase<pg8::EpiResidNorm<true>, pg8::StaticOrder, false, true>(lds, g, S, E); }
              skinny_part2(lds, H + (size_t)MP * D, nullptr, gn, (unsigned*)(ws + WS_SLOTS), CNT(nid, 64), vcu, tid); }
            GRID_SYNC();
        }
    }
}

extern "C" void kernel_launch(void* const* d_in, const int* in_sizes, int n_in, void* d_out, int out_size, void* d_ws, size_t ws_size, hipStream_t stream) {
    static int grid = 0;
    if (grid == 0) {
        if (n_in != 26 || (size_t)out_size != OUT_TOTAL || ws_size < WS_END) { fprintf(stderr, "kernel_launch: unexpected problem shape: n_in %d out %d ws %zu\n", n_in, out_size, ws_size); grid = -1; return; }
        int dev = 0, cus = 0, per_cu = 0;
        if (hipGetDevice(&dev) != hipSuccess || hipDeviceGetAttribute(&cus, hipDeviceAttributeMultiprocessorCount, dev) != hipSuccess) { grid = -1; return; }
        if (hipFuncSetAttribute((const void*)mega_fwd, hipFuncAttributeMaxDynamicSharedMemorySize, LDS_BYTES) != hipSuccess) { fprintf(stderr, "kernel_launch: hipFuncSetAttribute failed\n"); grid = -1; return; }
        if (hipOccupancyMaxActiveBlocksPerMultiprocessor(&per_cu, (const void*)mega_fwd, NWAVES * 64, LDS_BYTES) != hipSuccess || per_cu < 1) { fprintf(stderr, "kernel_launch: occupancy query says %d\n", per_cu); per_cu = 1; }
        (void)hipGetLastError();
        grid = cus * per_cu;
    }
    if (grid < 0) return;
    if (hipMemsetAsync(d_ws, 0, CTL_BYTES, stream) != hipSuccess) { fprintf(stderr, "kernel_launch: memset failed\n"); return; }
    Params p{};
    for (int i = 0; i < 26; ++i) p.in[i] = (const float*)d_in[i];
    p.out = (float*)d_out; p.ws = (unsigned char*)d_ws;
    void* args[] = {&p};
    const hipError_t e = hipLaunchCooperativeKernel((const void*)mega_fwd, dim3(grid), dim3(NWAVES * 64), args, LDS_BYTES, stream);
    if (e != hipSuccess) fprintf(stderr, "kernel_launch: cooperative launch failed: %s (grid %d)\n", hipGetErrorString(e), grid);
}
```

```cpp
#include <hip/hip_runtime.h>
#include <hip/hip_cooperative_groups.h>
#include <cstdio>
#include <cstdint>
namespace pg8 {
#define PG8_LAS __attribute__((address_space(3)))
typedef unsigned short bf16_t;
typedef short bf16x8 __attribute__((ext_vector_type(8)));
typedef float f32x4 __attribute__((ext_vector_type(4)));
typedef unsigned u32x4 __attribute__((ext_vector_type(4)));
constexpr int BM = 256, BK = 64, HALF = 128, HTB = HALF * BK * 2  , STAGE_BYTES = 8 * HTB, NXCD = 8, WGM = 8;

__host__ __device__ __forceinline__ int lds_byte(int r, int c) { const int st = (r >> 4) * 2 + (c >> 5), rr = r & 15, cc = c & 31, ob = rr * 64 + cc * 2; return st * 1024 + (ob ^ (((ob >> 9) & 1) << 5)); }
__host__ __device__ __forceinline__ void stage_rc(int b, int& R, int& C) { const int st = b / 1024, sb = b % 1024, swz = sb ^ (((sb >> 9) & 1) << 5); R = (st >> 1) * 16 + swz / 64; C = (st & 1) * 32 + (swz % 64) / 2; }
__host__ __device__ __forceinline__ int perm32(int rho) { const int n = rho >> 4, i = rho & 15; return 8 * (i >> 2) + 4 * n + (i & 3); }

struct Unit { int pm, pn; };
struct Gemm { const bf16_t* A; const bf16_t* Bt; int M, N, K; };

struct StaticOrder {
    int nM, nN, nwg, G, c;
    __host__ __device__ __forceinline__ void init(int M, int N, int G_, int c_) { nM = M / BM; nN = N / BM; nwg = nM * nN; G = G_; c = c_; }
    __host__ __device__ __forceinline__ bool next(int i, Unit& u) const {
        const long L = (long)i * G + c; if (L >= nwg) return false;
        int wgid = (int)L; { const int q = nwg / NXCD, r = nwg % NXCD, xcd = wgid % NXCD, off = wgid / NXCD; wgid = (xcd < r ? xcd * (q + 1) : r * (q + 1) + (xcd - r) * q) + off; }
        const int nig = WGM * nN, gid = wgid / nig, fm = gid * WGM, gsz = (nM - fm) < WGM ? (nM - fm) : WGM;
        u.pm = fm + ((wgid % nig) % gsz); u.pn = (wgid % nig) / gsz; return true;
    }
    __device__ __forceinline__ void a_ready(const Unit&) const {}
    __device__ __forceinline__ void done(const Unit&) const {}
};

__device__ __forceinline__ unsigned cvt_pk_bf16(float lo, float hi) { unsigned r; asm volatile("v_cvt_pk_bf16_f32 %0, %1, %2" : "=v"(r) : "v"(lo), "v"(hi)); return r; }
typedef float f32x2 __attribute__((ext_vector_type(2)));
typedef unsigned u32x2 __attribute__((ext_vector_type(2)));
constexpr size_t WOFF_ROPE = (size_t)1 << 20, WOFF_QB = (size_t)215 << 20, WOFF_KB = (size_t)232 << 20, WOFF_VB = (size_t)249 << 20, WOFF_ZB = (size_t)266 << 20;
constexpr size_t OOFF_KP = 17039360, OOFF_VP = 33816576, OOFF_PP = 50593792, OOFF_KS = 50663424, OOFF_VS = 50925568, OOFF_PS = 51187712;
__device__ __forceinline__ float silu_mul(float g, float u) { const float e = __builtin_amdgcn_exp2f(-1.4426950408889634f * g); return g * u * __builtin_amdgcn_rcpf(1.0f + e); }
struct EpiSwiGLU {
    static constexpr bool PERM = true, AFTER_DRAIN = false;
    bf16_t* O; int ldc;
    __device__ __forceinline__ void operator()(const f32x4 (&acc)[2][2][4][2], const Unit& u, int wr, int wc, int fr, int fq) const {
        const int row0 = u.pm * BM + wr * 64 + fr; const int col0 = u.pn * 128 + wc * 32 + 8 * fq;
#pragma unroll
        for (int ai = 0; ai < 2; ++ai)
#pragma unroll
            for (int m = 0; m < 4; ++m) {
                bf16_t* p = O + (size_t)(row0 + ai * HALF + m * 16) * ldc + col0;
                const f32x4 g0 = acc[ai][0][m][0], g1 = acc[ai][0][m][1], u0 = acc[ai][1][m][0], u1 = acc[ai][1][m][1];
                u32x4 w;
                w.x = cvt_pk_bf16(silu_mul(g0[0], u0[0]), silu_mul(g0[1], u0[1])); w.y = cvt_pk_bf16(silu_mul(g0[2], u0[2]), silu_mul(g0[3], u0[3]));
                w.z = cvt_pk_bf16(silu_mul(g1[0], u1[0]), silu_mul(g1[1], u1[1])); w.w = cvt_pk_bf16(silu_mul(g1[2], u1[2]), silu_mul(g1[3], u1[3]));
                *(u32x4*)p = w;
                asm volatile("" ::: "memory");
            }
    }
};
struct EpiResid {
    static constexpr bool PERM = false, AFTER_DRAIN = false;
    const float* baseP; const float* baseS; float* out; float scale;
    __device__ __forceinline__ void operator()(const f32x4 (&acc)[2][2][4][2], const Unit& u, int wr, int wc, int fr, int fq) const {
        const int col0 = u.pn * BM + wc * 32 + 4 * fq;
#pragma unroll
        for (int ai = 0; ai < 2; ++ai)
#pragma unroll
            for (int m = 0; m < 4; ++m) {
                const int row = u.pm * BM + ai * HALF + wr * 64 + m * 16 + fr;
                const float* bp = (row < 16384) ? baseP + (size_t)row * 1024 : baseS + (size_t)(row - 16384) * 1024;
                float* op = out + (size_t)row * 1024;
#pragma unroll
                for (int bj = 0; bj < 2; ++bj)
#pragma unroll
                    for (int n = 0; n < 2; ++n) { const int c = col0 + bj * HALF + n * 16; const f32x4 b = *(const f32x4*)(bp + c); *(f32x4*)(op + c) = b + acc[ai][bj][m][n] * scale; }
                asm volatile("" ::: "memory");
            }
    }
};
constexpr float RMS_EPS = 1e-6f;
__device__ __forceinline__ float rstd_of(float ss) { return 1.0f / sqrtf(ss * (1.0f / 1024.0f) + RMS_EPS); }

#define PG8_RLX_AGENT __ATOMIC_RELAXED, __HIP_MEMORY_SCOPE_AGENT
template <bool BASE16> struct EpiResidNorm {
    static constexpr bool PERM = true, AFTER_DRAIN = true;
    const void* baseP; bf16_t* out; float scale; bf16_t* hb; float* yout; const float* gain; unsigned* slots; unsigned* cnt;
    __device__ __forceinline__ void fused(f32x4 (&acc)[2][2][4][2], const Unit& u, int wr, int wc, int fr, int fq, PG8_LAS unsigned char* lds, int wid, int lane) const {
        PG8_LAS float* P = (PG8_LAS float*)lds;
        PG8_LAS float* S = (PG8_LAS float*)(lds + 4096);
        const int col0 = u.pn * BM + wc * 32 + 8 * fq;
        if (BASE16) {
            u32x4 braw[2][4][2];
#pragma unroll
            for (int ai = 0; ai < 2; ++ai)
#pragma unroll
                for (int m = 0; m < 4; ++m) { const size_t ro = (size_t)(u.pm * BM + ai * HALF + wr * 64 + m * 16 + fr) * 1024;
#pragma unroll
                    for (int bj = 0; bj < 2; ++bj) braw[ai][m][bj] = *(const u32x4*)((const bf16_t*)baseP + ro + col0 + bj * HALF); }
#pragma unroll
            for (int ai = 0; ai < 2; ++ai)
#pragma unroll
                for (int m = 0; m < 4; ++m)
#pragma unroll
                    for (int bj = 0; bj < 2; ++bj) { const u32x4 bw = braw[ai][m][bj]; f32x4 b0, b1;
                        b0[0] = __builtin_bit_cast(float, bw.x << 16); b0[1] = __builtin_bit_cast(float, bw.x & 0xffff0000u); b0[2] = __builtin_bit_cast(float, bw.y << 16); b0[3] = __builtin_bit_cast(float, bw.y & 0xffff0000u);
                        b1[0] = __builtin_bit_cast(float, bw.z << 16); b1[1] = __builtin_bit_cast(float, bw.z & 0xffff0000u); b1[2] = __builtin_bit_cast(float, bw.w << 16); b1[3] = __builtin_bit_cast(float, bw.w & 0xffff0000u);
                        acc[ai][bj][m][0] = b0 + acc[ai][bj][m][0] * scale; acc[ai][bj][m][1] = b1 + acc[ai][bj][m][1] * scale; }
        }
#pragma unroll
        for (int ai = 0; ai < 2; ++ai)
#pragma unroll
            for (int m = 0; m < 4; ++m) {
                const int rl = ai * HALF + wr * 64 + m * 16 + fr; const size_t ro = (size_t)(u.pm * BM + rl) * 1024;
                float ss = 0.f;
#pragma unroll
                for (int bj = 0; bj < 2; ++bj) { const int c = col0 + bj * HALF; f32x4 v0, v1;
                    if (BASE16) { v0 = acc[ai][bj][m][0]; v1 = acc[ai][bj][m][1]; }
                    else { v0 = *(const f32x4*)((const float*)baseP + ro + c) + acc[ai][bj][m][0] * scale; v1 = *(const f32x4*)((const float*)baseP + ro + c + 4) + acc[ai][bj][m][1] * scale; acc[ai][bj][m][0] = v0; acc[ai][bj][m][1] = v1; }
                    if (out) { u32x4 w; w.x = cvt_pk_bf16(v0[0], v0[1]); w.y = cvt_pk_bf16(v0[2], v0[3]); w.z = cvt_pk_bf16(v1[0], v1[1]); w.w = cvt_pk_bf16(v1[2], v1[3]); *(u32x4*)(out + ro + c) = w; }
                    ss += ((v0[0] * v0[0] + v0[1] * v0[1]) + (v0[2] * v0[2] + v0[3] * v0[3])) + ((v1[0] * v1[0] + v1[1] * v1[1]) + (v1[2] * v1[2] + v1[3] * v1[3])); }
                ss += __builtin_bit_cast(float, __builtin_amdgcn_ds_swizzle(__builtin_bit_cast(int, ss), (16 << 10) | 0x1f));
                { float a = ss, b2 = ss; asm volatile("s_nop 1\n\tv_permlane32_swap_b32 %0, %1\n\ts_nop 1" : "+v"(a), "+v"(b2)); ss = a + b2; }
                if (fq == 0) P[rl * 4 + wc] = ss;
                if (!BASE16 && (m & 1)) asm volatile("" ::: "memory");
            }
        asm volatile("s_waitcnt lgkmcnt(0)\n\ts_barrier" ::: "memory");
        const int t = wid * 64 + lane;
        if (t < 256) { const float s = (P[t * 4] + P[t * 4 + 1]) + (P[t * 4 + 2] + P[t * 4 + 3]);
            __hip_atomic_store(slots + (size_t)(u.pm * BM + t) * 4 + u.pn, __builtin_bit_cast(unsigned, s), PG8_RLX_AGENT); }
        asm volatile("s_waitcnt vmcnt(0)" ::: "memory");
        if (wid < 4 && lane == 0) __hip_atomic_fetch_add(cnt, 1u, PG8_RLX_AGENT);
        if (wid == 0) {
            unsigned spins = 0;
            while ((unsigned)__builtin_amdgcn_readfirstlane(__hip_atomic_load(cnt, PG8_RLX_AGENT)) < 16u) { __builtin_amdgcn_s_sleep(2); if (++spins > (1u << 22)) break; }
            __builtin_amdgcn_fence(__ATOMIC_ACQUIRE, "agent");
        }
        asm volatile("s_waitcnt vmcnt(0) lgkmcnt(0)\n\ts_barrier" ::: "memory");
        if (t < 256) { const unsigned* sl = slots + (size_t)(u.pm * BM + t) * 4; float tot = 0.f;
#pragma unroll
            for (int k = 0; k < 4; ++k) tot += __builtin_bit_cast(float, __hip_atomic_load(sl + k, PG8_RLX_AGENT));
            S[t] = rstd_of(tot); }
        asm volatile("s_waitcnt lgkmcnt(0)\n\ts_barrier" ::: "memory");
        f32x4 g4[2][2];
#pragma unroll
        for (int bj = 0; bj < 2; ++bj)
#pragma unroll
            for (int n = 0; n < 2; ++n) g4[bj][n] = *(const f32x4*)(gain + col0 + bj * HALF + n * 4);
#pragma unroll
        for (int ai = 0; ai < 2; ++ai)
#pragma unroll
            for (int m = 0; m < 4; ++m) {
                const int rl = ai * HALF + wr * 64 + m * 16 + fr; const size_t ro = (size_t)(u.pm * BM + rl) * 1024; const float r = S[rl];
#pragma unroll
                for (int bj = 0; bj < 2; ++bj) { const int c = col0 + bj * HALF; const f32x4 y0 = acc[ai][bj][m][0] * r * g4[bj][0], y1 = acc[ai][bj][m][1] * r * g4[bj][1];
                    if (hb) { u32x4 w; w.x = cvt_pk_bf16(y0[0], y0[1]); w.y = cvt_pk_bf16(y0[2], y0[3]); w.z = cvt_pk_bf16(y1[0], y1[1]); w.w = cvt_pk_bf16(y1[2], y1[3]); *(u32x4*)(hb + ro + c) = w; }
                    else { __builtin_nontemporal_store(y0, (f32x4*)(yout + ro + c)); __builtin_nontemporal_store(y1, (f32x4*)(yout + ro + c + 4)); } }
            }
        asm volatile("s_waitcnt lgkmcnt(0)\n\ts_barrier" ::: "memory");
    }
};

struct EpiWin {
    static constexpr bool PERM = false, AFTER_DRAIN = false;
    unsigned char* ws; float* outp; int l; float qscale;
    __device__ __forceinline__ void operator()(const f32x4 (&acc)[2][2][4][2], const Unit& u, int wr, int wc, int fr, int fq) const {
        const int pn = u.pn;
        float invrev[2][4];
#pragma unroll
        for (int n = 0; n < 2; ++n)
#pragma unroll
            for (int j = 0; j < 4; ++j) invrev[n][j] = exp2f(-(float)(8 * fq + 4 * n + j) * (13.287712379549449f / 32.0f)) * 0.15915494309189535f;
        bf16_t* const Qb = (bf16_t*)(ws + WOFF_QB); bf16_t* const Kb = (bf16_t*)(ws + WOFF_KB); bf16_t* const Vb = (bf16_t*)(ws + WOFF_VB); bf16_t* const Zb = (bf16_t*)(ws + WOFF_ZB);
        float* const kP = outp + OOFF_KP + (size_t)l * 16384 * 512; float* const vP = outp + OOFF_VP + (size_t)l * 16384 * 512;
        float* const kS = outp + OOFF_KS + (size_t)l * 256 * 512; float* const vS = outp + OOFF_VS + (size_t)l * 256 * 512;
        float* const poolP = outp + OOFF_PP + (size_t)l * 8 * 15 * 256; float* const poolS = outp + OOFF_PS + (size_t)l * 8 * 15 * 256;
        const int c0 = 64 * wc + 8 * fq;
#pragma unroll
        for (int ai = 0; ai < 2; ++ai)
#pragma unroll
            for (int m = 0; m < 4; ++m) {
                const int row = u.pm * BM + ai * HALF + wr * 64 + m * 16 + fr;
                const bool smp = row >= 16384; const int rs = row - 16384;
                f32x4 v[2][2];
                if (pn < 4) {
                    const float posf = (float)(smp ? 4096 + (rs & 31) : (row & 2047));
#pragma unroll
                    for (int n = 0; n < 2; ++n) { f32x4 cs, sn;
#pragma unroll
                        for (int j = 0; j < 4; ++j) { const float rev = posf * invrev[n][j]; const float fr_ = rev - __builtin_rintf(rev); cs[j] = __builtin_amdgcn_cosf(fr_); sn[j] = __builtin_amdgcn_sinf(fr_); }
                        const f32x4 lo = acc[ai][0][m][n], hi = acc[ai][1][m][n];
                        v[0][n] = lo * cs - hi * sn; v[1][n] = hi * cs + lo * sn; }
                } else {
#pragma unroll
                    for (int bj = 0; bj < 2; ++bj)
#pragma unroll
                        for (int n = 0; n < 2; ++n) v[bj][n] = acc[ai][bj][m][n];
                }
#pragma unroll
                for (int bj = 0; bj < 2; ++bj) {
                    const int lc = c0 + 32 * bj; const f32x4 x0 = v[bj][0], x1 = v[bj][1];
                    if (pn < 2) {
                        bf16_t* q = Qb + (size_t)row * 512 + 256 * pn + lc;
                        u32x4 w; w.x = cvt_pk_bf16(x0[0] * qscale, x0[1] * qscale); w.y = cvt_pk_bf16(x0[2] * qscale, x0[3] * qscale); w.z = cvt_pk_bf16(x1[0] * qscale, x1[1] * qscale); w.w = cvt_pk_bf16(x1[2] * qscale, x1[3] * qscale);
                        *(u32x4*)q = w;
                    } else {
                        u32x4 w; w.x = cvt_pk_bf16(x0[0], x0[1]); w.y = cvt_pk_bf16(x0[2], x0[3]); w.z = cvt_pk_bf16(x1[0], x1[1]); w.w = cvt_pk_bf16(x1[2], x1[3]);
                        if (pn < 4) { const int col = 256 * (pn - 2) + lc; float* ko = smp ? kS + (size_t)rs * 512 + col : kP + (size_t)row * 512 + col;
                            if (smp) { *(f32x4*)ko = x0; *(f32x4*)(ko + 4) = x1; } else { __builtin_nontemporal_store(x0, (f32x4*)ko); __builtin_nontemporal_store(x1, (f32x4*)(ko + 4)); }
                            *(u32x4*)(Kb + (size_t)row * 512 + col) = w; }
                        else if (pn < 6) { const int col = 256 * (pn - 4) + lc; float* vo = smp ? vS + (size_t)rs * 512 + col : vP + (size_t)row * 512 + col;
                            if (smp) { *(f32x4*)vo = x0; *(f32x4*)(vo + 4) = x1; } else { __builtin_nontemporal_store(x0, (f32x4*)vo); __builtin_nontemporal_store(x1, (f32x4*)(vo + 4)); }
                            *(u32x4*)(Vb + (size_t)row * 512 + col) = w; }
                        else { *(u32x4*)(Zb + (size_t)row * 1024 + 256 * (pn - 6) + lc) = w;
                            if (pn == 6) {
                                if (smp) { const int b = rs >> 5, t = rs & 31; if (t >= 17) { float* po = poolS + (size_t)(b * 15 + t - 17) * 256 + lc; *(f32x4*)po = x0; *(f32x4*)(po + 4) = x1; } }
                                else { const int b = row >> 11, t = row & 2047; if (t >= 2033) { float* po = poolP + (size_t)(b * 15 + t - 2033) * 256 + lc; *(f32x4*)po = x0; *(f32x4*)(po + 4) = x1; } }
                            } }
                    }
                }
                asm volatile("" ::: "memory");
            }
    }
};
template <class Epi, class Sched, bool ALIGN_EPI = false, bool SP2 = false>
__device__ __forceinline__ void gemm_phase(PG8_LAS unsigned char* lds, const Gemm g, const Sched& S, const Epi& E) {
    int tid_l = threadIdx.x; asm volatile("" : "+v"(tid_l)); const int tid = tid_l, wid = __builtin_amdgcn_readfirstlane(tid >> 6), lane = tid & 63, wr = wid >> 2, wc = wid & 3, fr = lane & 15, fq = lane >> 4;
    const int K = g.K, nt = K / BK;
    unsigned voffA[2], voffB[2];
#pragma unroll
    for (int i = 0; i < 2; ++i) { int R, C; stage_rc(tid * 16 + i * 8192, R, C); const int Rb = Epi::PERM ? ((R & ~31) + perm32(R & 31)) : R;
        voffA[i] = (unsigned)(R * K + C) * 2u; voffB[i] = (unsigned)(Rb * K + C) * 2u; }
    const size_t kstep = (size_t)(BK * 2);
    const size_t hstep = (size_t)HALF * K * 2;
    const size_t tstep = 2 * hstep;
    const unsigned ldsw = (unsigned)wid * 1024u;
    const int aoff = lds_byte(wr * 64 + fr, fq * 8), boff = lds_byte(wc * 32 + fr, fq * 8);
#define PG8_SA(b, h) (((b) * 2 + (h)) * HTB)
#define PG8_SB(b, h) ((4 + (b) * 2 + (h)) * HTB)
#define PG8_STAGE(bufoff, gbase, voff) do { _Pragma("unroll") for (int _i = 0; _i < 2; ++_i) \
        __builtin_amdgcn_global_load_lds((const unsigned*)((const char*)(gbase) + (voff)[_i]), (PG8_LAS unsigned*)(lds + (bufoff) + ldsw + _i * 8192), 16, 0, 0); } while (0)
#define PG8_LDA(dst, b, h) do { _Pragma("unroll") for (int m = 0; m < 4; ++m) _Pragma("unroll") for (int k = 0; k < 2; ++k) dst[m][k] = *(const PG8_LAS bf16x8*)(lds + PG8_SA(b, h) + aoff + m * 2048 + k * 1024); } while (0)
#define PG8_LDB(dst, b, h) do { _Pragma("unroll") for (int n = 0; n < 2; ++n) _Pragma("unroll") for (int k = 0; k < 2; ++k) dst[n][k] = *(const PG8_LAS bf16x8*)(lds + PG8_SB(b, h) + boff + n * 2048 + k * 1024); } while (0)
#define PG8_MMA(ai, bj, At, Bt) do { __builtin_amdgcn_s_setprio(1); _Pragma("unroll") for (int m = 0; m < 4; ++m) _Pragma("unroll") for (int n = 0; n < 2; ++n) _Pragma("unroll") for (int k = 0; k < 2; ++k) \
        acc[ai][bj][m][n] = __builtin_amdgcn_mfma_f32_16x16x32_bf16(Bt[n][k], At[m][k], acc[ai][bj][m][n], 0, 0, 0); __builtin_amdgcn_s_setprio(0); } while (0)
#define PG8_WAIT_V(n) asm volatile("s_waitcnt vmcnt(" #n ")" ::: "memory")
#define PG8_WAIT_L(n) asm volatile("s_waitcnt lgkmcnt(" #n ")" ::: "memory")
#define PG8_BAR __builtin_amdgcn_s_barrier()
#define PG8_SCHED __builtin_amdgcn_sched_barrier(0)
    Unit cur, nxt; int ui = 0;
    if (!S.next(0, cur)) return;
    f32x4 acc[2][2][4][2];
#pragma unroll
    for (int a = 0; a < 2; ++a)
#pragma unroll
        for (int b = 0; b < 2; ++b)
#pragma unroll
            for (int m = 0; m < 4; ++m)
#pragma unroll
                for (int n = 0; n < 2; ++n) acc[a][b][m][n] = (f32x4){0.f, 0.f, 0.f, 0.f};
    bf16x8 At[4][2], B0[2][2], B1[2][2];
    const char* cA = (const char*)g.A + (size_t)cur.pm * tstep; const char* cB = (const char*)g.Bt + (size_t)cur.pn * tstep;
    S.a_ready(cur);
    if constexpr (SP2) {
        PG8_STAGE(PG8_SB(0, 0), cB, voffB); PG8_STAGE(PG8_SB(0, 1), cB + hstep, voffB); PG8_STAGE(PG8_SA(0, 0), cA, voffA); PG8_STAGE(PG8_SA(0, 1), cA + hstep, voffA);
        if (wr == 1) PG8_BAR;
        PG8_WAIT_V(2); PG8_BAR;
        PG8_STAGE(PG8_SB(1, 0), cB + kstep, voffB); PG8_STAGE(PG8_SA(1, 0), cA + kstep, voffA); PG8_STAGE(PG8_SB(1, 1), cB + hstep + kstep, voffB);
        PG8_WAIT_V(6); PG8_BAR;
    } else {
        PG8_STAGE(PG8_SB(0, 0), cB, voffB); PG8_STAGE(PG8_SA(0, 0), cA, voffA); PG8_STAGE(PG8_SB(0, 1), cB + hstep, voffB); PG8_STAGE(PG8_SA(0, 1), cA + hstep, voffA);
        if (wr == 1) PG8_BAR;
        PG8_WAIT_V(4); PG8_BAR;
        PG8_STAGE(PG8_SB(1, 0), cB + kstep, voffB); PG8_STAGE(PG8_SA(1, 0), cA + kstep, voffA); PG8_STAGE(PG8_SB(1, 1), cB + hstep + kstep, voffB);
        PG8_WAIT_V(6); PG8_BAR;
    }
    for (;;) {
        const bool has_next = S.next(ui + 1, nxt);
        const char* nA = has_next ? (const char*)g.A + (size_t)nxt.pm * tstep : cA; const char* nB = has_next ? (const char*)g.Bt + (size_t)nxt.pn * tstep : cB;
        for (int t = 0; t < nt; t += 2) {
            const bool last = (t == nt - 2);
            const char* a1 = cA + (size_t)(t + 1) * kstep;
            const char* a2 = last ? nA : cA + (size_t)(t + 2) * kstep; const char* b2 = last ? nB : cB + (size_t)(t + 2) * kstep;
            const char* a3 = a2 + kstep; const char* b3 = b2 + kstep;
            if (last && has_next) S.a_ready(nxt);
            if constexpr (SP2) {
            PG8_LDB(B0, 0, 0); PG8_LDB(B1, 0, 1); PG8_SCHED; PG8_LDA(At, 0, 0); PG8_STAGE(PG8_SA(1, 1), a1 + hstep, voffA);
            PG8_WAIT_V(8); PG8_WAIT_L(0); PG8_BAR; PG8_MMA(0, 0, At, B0); PG8_MMA(0, 1, At, B1); PG8_BAR; PG8_SCHED;
            PG8_LDA(At, 0, 1); PG8_STAGE(PG8_SB(0, 0), b2, voffB); PG8_STAGE(PG8_SB(0, 1), b2 + hstep, voffB); PG8_STAGE(PG8_SA(0, 0), a2, voffA);
            PG8_WAIT_V(8); PG8_WAIT_L(0); PG8_BAR; PG8_MMA(1, 0, At, B0); PG8_MMA(1, 1, At, B1); PG8_BAR; PG8_SCHED;
            PG8_LDB(B0, 1, 0); PG8_LDB(B1, 1, 1); PG8_SCHED; PG8_LDA(At, 1, 0); PG8_STAGE(PG8_SA(0, 1), a2 + hstep, voffA);
            PG8_WAIT_V(8); PG8_WAIT_L(0); PG8_BAR; PG8_MMA(0, 0, At, B0); PG8_MMA(0, 1, At, B1); PG8_BAR; PG8_SCHED;
            PG8_LDA(At, 1, 1); PG8_STAGE(PG8_SB(1, 0), b3, voffB); PG8_STAGE(PG8_SB(1, 1), b3 + hstep, voffB); PG8_STAGE(PG8_SA(1, 0), a3, voffA);
            PG8_WAIT_V(8); PG8_WAIT_L(0); PG8_BAR; PG8_MMA(1, 0, At, B0); PG8_MMA(1, 1, At, B1); PG8_BAR; PG8_SCHED;
            } else {
            PG8_LDB(B0, 0, 0); PG8_SCHED; PG8_LDA(At, 0, 0); PG8_STAGE(PG8_SA(1, 1), a1 + hstep, voffA);
            PG8_WAIT_L(8); PG8_BAR; PG8_WAIT_L(0); PG8_MMA(0, 0, At, B0); PG8_BAR; PG8_SCHED;
            PG8_LDB(B1, 0, 1); PG8_STAGE(PG8_SB(0, 0), b2, voffB);
            PG8_BAR; PG8_WAIT_L(0); PG8_MMA(0, 1, At, B1); PG8_BAR;
            PG8_LDA(At, 0, 1); PG8_STAGE(PG8_SA(0, 0), a2, voffA);
            PG8_BAR; PG8_WAIT_L(0); PG8_MMA(1, 0, At, B0); PG8_BAR; PG8_SCHED;
            PG8_STAGE(PG8_SB(0, 1), b2 + hstep, voffB);
            PG8_WAIT_V(6); PG8_BAR; PG8_MMA(1, 1, At, B1); PG8_BAR;
            PG8_LDB(B0, 1, 0); PG8_SCHED; PG8_LDA(At, 1, 0); PG8_STAGE(PG8_SA(0, 1), a2 + hstep, voffA);
            PG8_WAIT_L(8); PG8_BAR; PG8_WAIT_L(0); PG8_MMA(0, 0, At, B0); PG8_BAR; PG8_SCHED;
            PG8_LDB(B1, 1, 1); PG8_STAGE(PG8_SB(1, 0), b3, voffB);
            PG8_BAR; PG8_WAIT_L(0); PG8_MMA(0, 1, At, B1); PG8_BAR;
            PG8_LDA(At, 1, 1); PG8_STAGE(PG8_SA(1, 0), a3, voffA);
            PG8_BAR; PG8_WAIT_L(0); PG8_MMA(1, 0, At, B0); PG8_BAR; PG8_SCHED;
            PG8_STAGE(PG8_SB(1, 1), b3 + hstep, voffB);
            PG8_WAIT_V(6); PG8_BAR; PG8_MMA(1, 1, At, B1); PG8_BAR;
            }
        }
        if constexpr (ALIGN_EPI) { if (wr == 0) PG8_BAR; }
        if constexpr (!Epi::AFTER_DRAIN) { E(acc, cur, wr, wc, fr, fq); S.done(cur); }
        if (!has_next) break;
#pragma unroll
        for (int a = 0; a < 2; ++a)
#pragma unroll
            for (int b = 0; b < 2; ++b)
#pragma unroll
                for (int m = 0; m < 4; ++m)
#pragma unroll
                    for (int n = 0; n < 2; ++n) acc[a][b][m][n] = (f32x4){0.f, 0.f, 0.f, 0.f};
        cur = nxt; cA = nA; cB = nB; ++ui;
        if constexpr (ALIGN_EPI) { if (wr == 1) PG8_BAR; }
    }
    PG8_WAIT_V(0);
    if constexpr (!ALIGN_EPI) { if (wr == 0) PG8_BAR; }
    PG8_BAR;
    if constexpr (Epi::AFTER_DRAIN) { E.fused(acc, cur, wr, wc, fr, fq, lds, wid, lane); S.done(cur); }
#undef PG8_SA
#undef PG8_SB
#undef PG8_STAGE
#undef PG8_LDA
#undef PG8_LDB
#undef PG8_MMA
#undef PG8_WAIT_V
#undef PG8_WAIT_L
#undef PG8_BAR
#undef PG8_SCHED
}
}
#include <hip/hip_bf16.h>
#include <cmath>
namespace attn_body {
using bf16=__hip_bfloat16;
using bf16x8=__attribute__((ext_vector_type(8)))short;
using s16x4=__attribute__((ext_vector_type(4)))short;
using f32x16=__attribute__((ext_vector_type(16)))float;
using u32x4=__attribute__((ext_vector_type(4)))unsigned;
constexpr int BATCH=8,NHEAD=16,SEQ=2048,D=64,PQK=512,PO=1024;
constexpr int NW=8,QBLK=32,QB=QBLK*NW,KVBLK=64,NQB=SEQ/QB;
constexpr int ATTN_UNIT_ROWS=QB;
__device__ __forceinline__ int crow(int r,int hi){return (r&3)+8*(r>>2)+4*hi;}
#define SBAR() __builtin_amdgcn_sched_barrier(0)
__device__ __forceinline__ void cmask(f32x16&p0,f32x16&p1,int jb,int qrel,int hi){
  const float NEG=-INFINITY; (void)hi;
  if(jb>(qrel>>6)){
  #pragma unroll
  for(int r=0;r<16;++r){p0[r]=NEG;p1[r]=NEG;}}
}

constexpr int NSLOT=3, SLOTB=8192;
constexpr int LDS_K=0, LDS_V=NSLOT*SLOTB, LDS_WS=2*NSLOT*SLOTB, LDS_OST=LDS_WS+NW*64*4, LDS_BYTES=LDS_OST+NW*4096;
constexpr float C2=0.125f*1.4426950408889634f;
__device__ __forceinline__ void glds16(const void*gsrc,unsigned lds_dst){unsigned keep;
  asm volatile("s_mov_b32 %0, m0\n\ts_mov_b32 m0, %2\n\ts_nop 0\n\tglobal_load_lds_dwordx4 %1, off\n\ts_mov_b32 m0, %0":"=&s"(keep):"v"(gsrc),"s"(lds_dst):"memory");}
__device__ __forceinline__ float max3f(float a,float b,float c){float r;asm("v_max3_f32 %0, %1, %2, %3":"=v"(r):"v"(a),"v"(b),"v"(c));return r;}
__device__ __forceinline__ float max2f(float a,float b){float r;asm("v_max_f32_e32 %0, %1, %2":"=v"(r):"v"(a),"v"(b));return r;}
__device__ __forceinline__ float fadd_s(float a,float b){float r;asm("v_add_f32_e32 %0, %1, %2":"=v"(r):"v"(a),"v"(b));return r;}
__device__ __forceinline__ float fsub_s(float a,float b){float r;asm("v_sub_f32_e32 %0, %1, %2":"=v"(r):"v"(a),"v"(b));return r;}
typedef float f32x2_t __attribute__((ext_vector_type(2))); typedef __bf16 bf16x2_t __attribute__((ext_vector_type(2)));
__device__ __forceinline__ unsigned cvtpk_s(float lo,float hi){f32x2_t v={lo,hi};bf16x2_t b=__builtin_convertvector(v,bf16x2_t);return __builtin_bit_cast(unsigned,b);}
#define WAIT_BAR(N) asm volatile("s_waitcnt vmcnt(" #N ") lgkmcnt(0)\n\ts_barrier":::"memory")

__device__ __forceinline__ void qkt(f32x16&p0,f32x16&p1,const char*Kslot,const bf16x8*qr,const f32x16&negm,int r32,int hi){
  const char*kb=Kslot+hi*1024+r32*16;
  #pragma unroll
  for(int d0=0;d0<4;++d0){
    const bf16x8 b0=*reinterpret_cast<const bf16x8*>(kb+d0*2048);
    const bf16x8 b1=*reinterpret_cast<const bf16x8*>(kb+d0*2048+512);
    if(d0==0){p0=__builtin_amdgcn_mfma_f32_32x32x16_bf16(b0,qr[0],negm,0,0,0);p1=__builtin_amdgcn_mfma_f32_32x32x16_bf16(b1,qr[0],negm,0,0,0);}
    else{p0=__builtin_amdgcn_mfma_f32_32x32x16_bf16(b0,qr[d0],p0,0,0,0);p1=__builtin_amdgcn_mfma_f32_32x32x16_bf16(b1,qr[d0],p1,0,0,0);}}
}
typedef __attribute__((address_space(3))) const char* lds_cptr;
typedef short v4i16_t __attribute__((ext_vector_type(4)));
__device__ __forceinline__ void kload8(bf16x8*kf,lds_cptr kp){
  kf[0]=*(const __attribute__((address_space(3))) bf16x8*)(kp);      kf[1]=*(const __attribute__((address_space(3))) bf16x8*)(kp+512);
  kf[2]=*(const __attribute__((address_space(3))) bf16x8*)(kp+2048); kf[3]=*(const __attribute__((address_space(3))) bf16x8*)(kp+2560);
  kf[4]=*(const __attribute__((address_space(3))) bf16x8*)(kp+4096); kf[5]=*(const __attribute__((address_space(3))) bf16x8*)(kp+4608);
  kf[6]=*(const __attribute__((address_space(3))) bf16x8*)(kp+6144); kf[7]=*(const __attribute__((address_space(3))) bf16x8*)(kp+6656);
}
__device__ __forceinline__ void kload2(bf16x8*kf,lds_cptr kp,int j){ kf[2*j]=*(const __attribute__((address_space(3))) bf16x8*)(kp+j*2048); kf[2*j+1]=*(const __attribute__((address_space(3))) bf16x8*)(kp+j*2048+512); }
__device__ __forceinline__ s16x4 vtr(lds_cptr p){ return __builtin_bit_cast(s16x4,__builtin_amdgcn_ds_read_tr16_b64_v4i16((__attribute__((address_space(3))) v4i16_t*)p)); }
__device__ __forceinline__ float rowmax(const f32x16&p0,const f32x16&p1){
  float a=max3f(p0[0],p0[1],p1[0]),b=max3f(p0[2],p0[3],p1[1]);a=max3f(a,p1[2],p1[3]);
  #pragma unroll
  for(int r=4;r<16;r+=4){a=max3f(a,p0[r],p0[r+1]);b=max3f(b,p0[r+2],p0[r+3]);a=max3f(a,p1[r],p1[r+1]);b=max3f(b,p1[r+2],p1[r+3]);}
  const float m=max2f(a,b);
  auto rr=__builtin_amdgcn_permlane32_swap(__float_as_uint(m),__float_as_uint(m),false,false);
  return max2f(__uint_as_float(rr[0]),__uint_as_float(rr[1]));
}
__device__ __forceinline__ void pv(f32x16*o,int vb,bf16x8 pa0,bf16x8 pa1,bf16x8 pa2,bf16x8 pa3){
  #pragma unroll
  for(int d0=0;d0<2;++d0){s16x4 lo[4],hi[4];
    #pragma unroll
    for(int ks=0;ks<4;++ks){
      asm volatile("ds_read_b64_tr_b16 %0,%1 offset:%c2":"=&v"(lo[ks]):"v"(vb),"i"(d0*4096+ks*1024):"memory");
      asm volatile("ds_read_b64_tr_b16 %0,%1 offset:%c2":"=&v"(hi[ks]):"v"(vb),"i"(d0*4096+ks*1024+512):"memory");}
    asm volatile("s_waitcnt lgkmcnt(0)":::"memory");SBAR();
    #define PK(k) (bf16x8){lo[k][0],lo[k][1],lo[k][2],lo[k][3],hi[k][0],hi[k][1],hi[k][2],hi[k][3]}
    o[d0]=__builtin_amdgcn_mfma_f32_32x32x16_bf16(pa0,PK(0),o[d0],0,0,0);
    o[d0]=__builtin_amdgcn_mfma_f32_32x32x16_bf16(pa1,PK(1),o[d0],0,0,0);
    o[d0]=__builtin_amdgcn_mfma_f32_32x32x16_bf16(pa2,PK(2),o[d0],0,0,0);
    o[d0]=__builtin_amdgcn_mfma_f32_32x32x16_bf16(pa3,PK(3),o[d0],0,0,0);
    #undef PK
  }
}

#ifndef ATTN_STORE16
#define ATTN_STORE16(p,v) (*(u32x4*)(p)=(v))
#endif
template<int THRL> __device__ __forceinline__ void attn_unit(int b,int qb,const bf16*Q,const bf16*__restrict__ K,const bf16*__restrict__ V,bf16*O,char*shm){
  int tid_l=threadIdx.x; asm volatile("":"+v"(tid_l)); const int tid=tid_l,lane=tid&63,r32=lane&31,hi=lane>>5; const int wid=__builtin_amdgcn_readfirstlane(tid>>6);
  const long rowbase=(long)b*SEQ; const int q0=qb*QB;
  const bf16*Qw=Q+(rowbase+q0+wid*QBLK)*PQK;
  const bf16*Kh=K+rowbase*PQK,*Vh=V+rowbase*PQK;
  const unsigned lds0=(unsigned)(uintptr_t)shm;
  float*wsf=(float*)(shm+LDS_WS)+wid*64;
  const bf16*ksrc=Kh+(long)lane*PQK+wid*8;
  const bf16*vsrc=Vh+(long)(16*(wid&3)+(lane>>2))*PQK+(wid>>2)*32+(lane&3)*8;
  const unsigned kdst=lds0+LDS_K+wid*1024, vdst=lds0+LDS_V+wid*1024;
  #define DMA_K(t,slot) glds16(ksrc+(long)(t)*KVBLK*PQK,(unsigned)__builtin_amdgcn_readfirstlane(kdst+(slot)))
  #define DMA_V(t,slot) glds16(vsrc+(long)(t)*KVBLK*PQK,(unsigned)__builtin_amdgcn_readfirstlane(vdst+(slot)))
  const int vb0=(int)(lds0+LDS_V)+((lane>>4)&1)*32+(lane&3)*8+(4*hi+((lane&15)>>2))*64;
  const char*Kbase=shm+LDS_K; bf16x8 kf[8];
  const lds_cptr shm3=(lds_cptr)shm; const lds_cptr kp0=shm3+LDS_K+hi*1024+r32*16; const lds_cptr vp0=shm3+LDS_V+((lane>>4)&1)*32+(lane&3)*8+(4*hi+((lane&15)>>2))*64;
  const int NT=(q0+QB)/KVBLK;
  DMA_K(0,0);DMA_V(0,0);DMA_K(1,SLOTB);
  bf16x8 qr[4];
  #pragma unroll
  for(int d0=0;d0<4;++d0)qr[d0]=*reinterpret_cast<const bf16x8*>(&Qw[(long)r32*PQK+d0*16+hi*8]);
  float mhat=0.f,l_reg=0.f;f32x16 o[2];o[0]=f32x16{};o[1]=f32x16{};f32x16 negm=f32x16{};asm volatile("":"+v"(negm));
  const int qrel=wid*QBLK+r32;
  #define CMASK(P0,P1,t) do{int jb_=(t)-(NT-4); if(jb_>=0)cmask(P0,P1,jb_,qrel,hi);}while(0)
  bool resc=false;
  #define START(P0,P1) do{ const float rm=rowmax(P0,P1); resc=false; \
    { const float dl=rm; mhat=fadd_s(mhat,dl); \
      _Pragma("unroll") for(int r=0;r<16;++r){P0[r]=fsub_s(P0[r],dl);P1[r]=fsub_s(P1[r],dl);} \
      _Pragma("unroll") for(int r=0;r<16;++r)negm[r]=-mhat; asm volatile("":"+v"(negm)); } \
    _Pragma("unroll") for(int r=0;r<16;++r)P0[r]=__builtin_amdgcn_exp2f(P0[r]); }while(0)
  #define RESC() do{ if(resc){ asm volatile("s_waitcnt lgkmcnt(0)":::"memory"); \
      _Pragma("unroll") for(int d_=0;d_<2;++d_) _Pragma("unroll") for(int r=0;r<16;++r)o[d_][r]*=wsf[crow(r,hi)]; } }while(0)
  f32x16 pA0,pA1,pB0,pB1;
  int sl_prev=0,sl_cur=0,sl_next=SLOTB;
  #define ROT() do{sl_prev=sl_cur;sl_cur=sl_next;sl_next=(sl_next==(NSLOT-1)*SLOTB)?0:sl_next+SLOTB;}while(0)
  DMA_K(2,2*SLOTB);
  WAIT_BAR(3);
  qkt(pA0,pA1,Kbase,qr,negm,r32,hi);asm volatile("s_nop 15\n\ts_nop 7":"+v"(pA0),"+v"(pA1));CMASK(pA0,pA1,0);
  START(pA0,pA1);
  _Pragma("unroll") for(int r=0;r<16;++r)pA1[r]=__builtin_amdgcn_exp2f(pA1[r]);
  WAIT_BAR(0);
  DMA_K(3,0);DMA_V(1,SLOTB);
  ROT();
  kload8(kf,kp0+sl_cur);
  WAIT_BAR(2);
  s16x4 vlo[8],vhi[8]; u32x4 pw0,pw1,pw2,pw3;
  #define PKW(P,B) cvtpk_s(P[B],P[B+1])
  #define PAF(k) __builtin_bit_cast(bf16x8,pw##k)
  #define VFR(i) (bf16x8){vlo[i][0],vlo[i][1],vlo[i][2],vlo[i][3],vhi[i][0],vhi[i][1],vhi[i][2],vhi[i][3]}
  #define PIN(x) asm volatile("":"+v"(x))
  #define MX3(a,b,c) __builtin_fmaxf(__builtin_fmaxf((a),(b)),(c))
  #define GAPA(MF,A0,A1,A2,A3,W0,W1,PW) do{ MF; sacc+=A0; sacc+=A1; sacc+=A2; sacc+=A3; PIN(sacc); W0; W1; PIN(PW); SBAR(); }while(0)
  #define EX(v) __builtin_amdgcn_exp2f(v)
  #define GAPB(MF,X,B) do{ MF; X[B]=EX(X[B]); X[B+1]=EX(X[B+1]); X[B+2]=EX(X[B+2]); X[B+3]=EX(X[B+3]); PIN(X); SBAR(); }while(0)
  #define VRD(i) do{ vlo[i]=vtr(vp_+(((i)>>2)*4096+((i)&3)*1024)); vhi[i]=vtr(vp_+(((i)>>2)*4096+((i)&3)*1024+512)); }while(0)
  #define KRD(G,j) do{ if(G){ kload2(kf,kp0+sl_next,j); SBAR(); } }while(0)
  #define STEP(C0,C1,P0,P1,t,GK,GV,GL) do{ SBAR(); \
    const lds_cptr vp_=vp0+sl_prev; \
    VRD(0); SBAR(); float sacc=(P0[0]+P0[1]); \
    GAPA(C0=__builtin_amdgcn_mfma_f32_32x32x16_bf16(kf[0],qr[0],negm,0,0,0), P0[2],P0[3],P0[4],P0[5],     pw0[0]=PKW(P0,0), pw0[1]=PKW(P0,2), pw0); \
    VRD(4); SBAR(); GAPA(C1=__builtin_amdgcn_mfma_f32_32x32x16_bf16(kf[1],qr[0],negm,0,0,0), P0[6],P0[7],P0[8],P0[9],     pw0[2]=PKW(P0,4), pw0[3]=PKW(P0,6), pw0); \
    VRD(1); SBAR(); GAPA(C0=__builtin_amdgcn_mfma_f32_32x32x16_bf16(kf[2],qr[1],C0,0,0,0),   P0[10],P0[11],P0[12],P0[13], pw1[0]=PKW(P0,8), pw1[1]=PKW(P0,10), pw1); \
    VRD(5); SBAR(); GAPA(C1=__builtin_amdgcn_mfma_f32_32x32x16_bf16(kf[3],qr[1],C1,0,0,0),   P0[14],P0[15],P1[0],P1[1],   pw1[2]=PKW(P0,12),pw1[3]=PKW(P0,14), pw1); \
    VRD(2); SBAR(); GAPA(C0=__builtin_amdgcn_mfma_f32_32x32x16_bf16(kf[4],qr[2],C0,0,0,0),   P1[2],P1[3],P1[4],P1[5],     pw2[0]=PKW(P1,0), pw2[1]=PKW(P1,2), pw2); \
    VRD(6); SBAR(); GAPA(C1=__builtin_amdgcn_mfma_f32_32x32x16_bf16(kf[5],qr[2],C1,0,0,0),   P1[6],P1[7],P1[8],P1[9],     pw2[2]=PKW(P1,4), pw2[3]=PKW(P1,6), pw2); \
    VRD(3); SBAR(); GAPA(C0=__builtin_amdgcn_mfma_f32_32x32x16_bf16(kf[6],qr[3],C0,0,0,0),   P1[10],P1[11],P1[12],P1[13], pw3[0]=PKW(P1,8), pw3[1]=PKW(P1,10), pw3); \
    VRD(7); SBAR(); GAPA(C1=__builtin_amdgcn_mfma_f32_32x32x16_bf16(kf[7],qr[3],C1,0,0,0),   P1[14],P1[15],0.f,0.f,       pw3[2]=PKW(P1,12),pw3[3]=PKW(P1,14), pw3); \
    l_reg+=sacc; \
    if(GK){DMA_K((t)+3,sl_cur);} if(GV){DMA_V((t)+1,sl_next);} \
    CMASK(C0,C1,t); \
    { float a=MX3(C0[0],C0[1],C1[0]),b=MX3(C0[2],C0[3],C1[1]); a=MX3(a,C1[2],C1[3]); \
      _Pragma("unroll") for(int r=4;r<16;r+=4){a=MX3(a,C0[r],C0[r+1]);b=MX3(b,C0[r+2],C0[r+3]);a=MX3(a,C1[r],C1[r+1]);b=MX3(b,C1[r+2],C1[r+3]);} \
      float rm=__builtin_fmaxf(a,b); { auto rr=__builtin_amdgcn_permlane32_swap(__float_as_uint(rm),__float_as_uint(rm),false,false); rm=__builtin_fmaxf(__uint_as_float(rr[0]),__uint_as_float(rr[1])); } \
      resc=false; \
      if(__builtin_expect(__any(rm>(float)THRL),0)){ const float dl=__builtin_fmaxf(rm,0.f); mhat+=dl; \
        _Pragma("unroll") for(int r=0;r<16;++r){C0[r]-=dl;C1[r]-=dl;} \
        _Pragma("unroll") for(int r=0;r<16;++r)negm[r]=-mhat; asm volatile("":"+v"(negm)); \
        const float f=__builtin_amdgcn_exp2f(-dl); l_reg*=f; if(hi==0)wsf[r32]=f; resc=true; } } \
    SBAR(); \
    GAPB(o[0]=__builtin_amdgcn_mfma_f32_32x32x16_bf16(PAF(0),VFR(0),o[0],0,0,0), C0,0); \
    GAPB(o[1]=__builtin_amdgcn_mfma_f32_32x32x16_bf16(PAF(0),VFR(4),o[1],0,0,0), C0,4); \
    KRD(GL,0); GAPB(o[0]=__builtin_amdgcn_mfma_f32_32x32x16_bf16(PAF(1),VFR(1),o[0],0,0,0), C0,8); \
    KRD(GL,1); GAPB(o[1]=__builtin_amdgcn_mfma_f32_32x32x16_bf16(PAF(1),VFR(5),o[1],0,0,0), C0,12); \
    KRD(GL,2); GAPB(o[0]=__builtin_amdgcn_mfma_f32_32x32x16_bf16(PAF(2),VFR(2),o[0],0,0,0), C1,0); \
    KRD(GL,3); GAPB(o[1]=__builtin_amdgcn_mfma_f32_32x32x16_bf16(PAF(2),VFR(6),o[1],0,0,0), C1,4); \
    GAPB(o[0]=__builtin_amdgcn_mfma_f32_32x32x16_bf16(PAF(3),VFR(3),o[0],0,0,0), C1,8); \
    GAPB(o[1]=__builtin_amdgcn_mfma_f32_32x32x16_bf16(PAF(3),VFR(7),o[1],0,0,0), C1,12); \
    }while(0)
  int t=1;
  #undef CMASK
  #define CMASK(P0,P1,t) do{}while(0)
  for(;t+5<NT;t+=2){
    STEP(pB0,pB1,pA0,pA1,t,true,true,true);     WAIT_BAR(2); RESC(); ROT();
    STEP(pA0,pA1,pB0,pB1,t+1,true,true,true);   WAIT_BAR(2); RESC(); ROT();
  }
  #undef CMASK
  #define CMASK(P0,P1,t) do{int jb_=(t)-(NT-4); if(jb_>=0)cmask(P0,P1,jb_,qrel,hi);}while(0)
  #define ENDW(tt) do{ if((tt)+3<NT){WAIT_BAR(2);} else if((tt)+2<NT){WAIT_BAR(1);} else {WAIT_BAR(0);} }while(0)
  for(;t+1<NT;t+=2){
    STEP(pB0,pB1,pA0,pA1,t,(t+3<NT),(t+1<NT),(t+1<NT));       ENDW(t);   RESC(); ROT();
    STEP(pA0,pA1,pB0,pB1,t+1,(t+4<NT),(t+2<NT),(t+2<NT));     ENDW(t+1); RESC(); ROT();
  }
  STEP(pB0,pB1,pA0,pA1,NT-1,false,false,false); RESC();
  { float sacc=pB0[0]+pB0[1]; _Pragma("unroll") for(int r=2;r<16;++r)sacc+=pB0[r]; _Pragma("unroll") for(int r=0;r<16;++r)sacc+=pB1[r]; l_reg+=sacc;
    pw0=(u32x4){PKW(pB0,0),PKW(pB0,2),PKW(pB0,4),PKW(pB0,6)};pw1=(u32x4){PKW(pB0,8),PKW(pB0,10),PKW(pB0,12),PKW(pB0,14)};pw2=(u32x4){PKW(pB1,0),PKW(pB1,2),PKW(pB1,4),PKW(pB1,6)};pw3=(u32x4){PKW(pB1,8),PKW(pB1,10),PKW(pB1,12),PKW(pB1,14)};
    SBAR(); pv(o,vb0+sl_cur,PAF(0),PAF(1),PAF(2),PAF(3)); }
  #undef PKW
  #undef PAF
  #undef VFR
  #undef PIN
  #undef MX3
  #undef GAPA
  #undef GAPB
  #undef EX
  #undef VRD
  #undef KRD
  #undef STEP
  #undef ENDW
  {auto rr=__builtin_amdgcn_permlane32_swap(__float_as_uint(l_reg),__float_as_uint(l_reg),false,false);l_reg=__uint_as_float(rr[0])+__uint_as_float(rr[1]);}
  if(hi==0)wsf[32+r32]=l_reg;asm volatile("s_waitcnt lgkmcnt(0)":::"memory");
  float rli[16];
  #pragma unroll
  for(int r=0;r<16;++r)rli[r]=__builtin_amdgcn_rcpf(wsf[32+crow(r,hi)]);
  bf16*Ow=O+(rowbase+q0+wid*QBLK)*PO;
  { bf16*stg=(bf16*)(shm+LDS_OST)+wid*2048;
    #pragma unroll
    for(int r=0;r<16;++r){const int orow=crow(r,hi);
      #pragma unroll
      for(int d0=0;d0<2;++d0)stg[orow*64+d0*32+r32]=__float2bfloat16(o[d0][r]*rli[r]);}
    asm volatile("s_waitcnt lgkmcnt(0)":::"memory");
    #pragma unroll
    for(int i=0;i<4;++i){const int row=i*8+(lane>>3),ch=lane&7; const u32x4 v=*(const u32x4*)(stg+row*64+ch*8); ATTN_STORE16(Ow+(long)row*PO+ch*8,v);} }
  asm volatile("s_waitcnt lgkmcnt(0)\n\ts_barrier":::"memory");
  #undef DMA_K
  #undef DMA_V
  #undef CMASK
  #undef START
  #undef RESC
  #undef ROT
}
#undef SBAR
#undef WAIT_BAR
}
namespace cg = cooperative_groups;
#define LAS __attribute__((address_space(3)))
typedef unsigned short bf16;
typedef unsigned v4u __attribute__((ext_vector_type(4)));
typedef unsigned v2u __attribute__((ext_vector_type(2)));
typedef float f32x4 __attribute__((ext_vector_type(4)));
typedef float f32x2 __attribute__((ext_vector_type(2)));
typedef float f32x16 __attribute__((ext_vector_type(16)));
typedef short bf16x8 __attribute__((ext_vector_type(8)));

constexpr int NWAVES = 8;
constexpr int D = 1024, MP = 16384, MS = 256, M = MP + MS, FF = 2816, DIN = 2560;
constexpr float EPS = 1e-6f;
constexpr float C2 = 0.125f * 1.4426950408889634f;
constexpr size_t OFF_Y = 0, OFF_KP = 17039360, OFF_VP = 33816576, OFF_PP = 50593792, OFF_CP = 50655232, OFF_KS = 50663424, OFF_VS = 50925568, OFF_PS = 51187712, OFF_CS = 51249152, OUT_TOTAL = 51257344;
constexpr size_t MiB = 1u << 20;
constexpr size_t WS_ROPE = 1 * MiB, WS_POOLWT = 2 * MiB, WS_W = 4 * MiB, WL = 40 * MiB;
constexpr size_t W_GU1 = 0, W_D1 = 11 * MiB, W_IN = 16 * MiB + MiB / 2, W_OUT = 21 * MiB + MiB / 2, W_GU2 = 23 * MiB + MiB / 2, W_D2 = 34 * MiB + MiB / 2;
constexpr size_t WS_X = 84 * MiB, WS_H = 149 * MiB, WS_MIX = 182 * MiB, WS_ACT = 215 * MiB;
constexpr size_t WS_QB = 215 * MiB, WS_KB = 232 * MiB, WS_VB = 249 * MiB, WS_ZB = 266 * MiB;
constexpr size_t WS_OB = 305 * MiB, WS_OPART = 338 * MiB, WS_ML = 347 * MiB, WS_END = 352 * MiB;
static_assert(WS_ROPE == pg8::WOFF_ROPE && WS_QB == pg8::WOFF_QB && WS_KB == pg8::WOFF_KB && WS_VB == pg8::WOFF_VB && WS_ZB == pg8::WOFF_ZB && OFF_KP == pg8::OOFF_KP && OFF_VP == pg8::OOFF_VP && OFF_PP == pg8::OOFF_PP && OFF_KS == pg8::OOFF_KS && OFF_VS == pg8::OOFF_VS && OFF_PS == pg8::OOFF_PS, "offsets");
static_assert(WS_ACT + (size_t)M * FF * 2 <= WS_OB && WS_ZB + (size_t)M * 1024 * 2 <= WS_OB && WS_X + (size_t)M * D * 4 <= WS_H && WS_H + (size_t)M * D * 2 <= WS_MIX && WS_MIX + (size_t)M * D * 2 <= WS_ACT, "ws map");
static_assert(WS_OB + (size_t)M * 1024 * 2 <= WS_OPART && WS_OPART + (size_t)32 * 2 * 9 * 32 * 128 * 4 <= WS_ML && WS_ML + (size_t)32 * 2 * 9 * 32 * 2 * 4 <= WS_END, "ws map 2");
constexpr int LDS_BYTES = 147456;
constexpr size_t CTL_BYTES = 262144, CTL_CNT = 65536;
constexpr size_t WS_SLOTP = 350 * MiB, WS_SLOTS = 351 * MiB;

__device__ __forceinline__ unsigned pk2(float lo, float hi) { f32x2 v = {lo, hi}; typedef __bf16 b2 __attribute__((ext_vector_type(2))); b2 b = __builtin_convertvector(v, b2); return __builtin_bit_cast(unsigned, b); }
__device__ __forceinline__ float bf2f(unsigned short b) { return __builtin_bit_cast(float, (unsigned)b << 16); }
__device__ __forceinline__ bf16x8 pack8(f32x4 a, f32x4 b) { v4u w; w.x = pk2(a.x, a.y); w.y = pk2(a.z, a.w); w.z = pk2(b.x, b.y); w.w = pk2(b.z, b.w); return __builtin_bit_cast(bf16x8, w); }
__device__ __forceinline__ int crow(int r, int hi) { return (r & 3) + 8 * (r >> 2) + 4 * hi; }
__device__ __forceinline__ void xhalf_pair(float m, float& a, float& b) { a = m; b = m; asm volatile("s_nop 1\n\tv_permlane32_swap_b32 %0, %1\n\ts_nop 1" : "+v"(a), "+v"(b)); }
__device__ __forceinline__ float xhalf_max(float m) { float a, b; xhalf_pair(m, a, b); return fmaxf(a, b); }
__device__ __forceinline__ float xhalf_sum(float m) { float a, b; xhalf_pair(m, a, b); return a + b; }
template <int O> __device__ __forceinline__ float swz_xor(float v) { return __builtin_bit_cast(float, __builtin_amdgcn_ds_swizzle(__builtin_bit_cast(int, v), (O << 10) | 0x1f)); }
__device__ __forceinline__ float wave_sum(float v) {
    v += swz_xor<1>(v); v += swz_xor<2>(v); v += swz_xor<4>(v); v += swz_xor<8>(v); v += swz_xor<16>(v);
    return xhalf_sum(v);
}
#define LDS_WAIT() asm volatile("s_waitcnt lgkmcnt(0)" ::: "memory")

struct Params { const float* in[26]; float* out; unsigned char* ws; };
typedef const __attribute__((address_space(4))) unsigned char* karg_ptr;
__device__ __forceinline__ karg_ptr kargs() { karg_ptr k = (karg_ptr)__builtin_amdgcn_kernarg_segment_ptr(); asm volatile("" : "+s"(k)); return k; }
__device__ __forceinline__ const float* KIN(int i) { return *(const float* const __attribute__((address_space(4)))*)(kargs() + 8 * i); }
__device__ __forceinline__ float* KOUT() { return *(float* const __attribute__((address_space(4)))*)(kargs() + 8 * 26); }
__device__ __forceinline__ unsigned char* KWS() { return *(unsigned char* const __attribute__((address_space(4)))*)(kargs() + 8 * 27); }

template <int MODE> __device__ __forceinline__ int wmap(int nl, int row_off) {
    if (MODE == 0) return row_off + nl;
    if (MODE == 1) return (nl >> 7) * 256 + (nl & 127) + row_off;
    const int u = nl >> 8, lc = nl & 255, hc = lc >> 6, bjx = (lc >> 5) & 1, fqx = (lc >> 3) & 3, n = (lc >> 2) & 1, j = lc & 3;
    return u * 256 + 128 * bjx + 32 * hc + 16 * n + 4 * fqx + j;
}
template <int MODE> __device__ __forceinline__ void transpose_item(const float* W, int K, int N, bf16* WT, int row_off, LAS float* scr, int item, int lane) {
    const int nblk = N / 32, kb = item / nblk, nb = item % nblk, k0 = 64 * kb, n0 = 32 * nb;
#pragma unroll 8
    for (int i = 0; i < 32; ++i) { const int kk = 2 * i + (lane >> 5); scr[kk * 33 + (lane & 31)] = __builtin_nontemporal_load(W + (size_t)(k0 + kk) * N + n0 + (lane & 31)); }
    LDS_WAIT(); asm volatile("" ::: "memory");
    const int c = lane & 7;
#pragma unroll
    for (int j = 0; j < 4; ++j) { const int n = (lane >> 3) + 8 * j; const LAS float* s = scr + (8 * c) * 33 + n;
        v4u o; o.x = pk2(s[0 * 33], s[1 * 33]); o.y = pk2(s[2 * 33], s[3 * 33]); o.z = pk2(s[4 * 33], s[5 * 33]); o.w = pk2(s[6 * 33], s[7 * 33]);
        *(v4u*)(WT + (size_t)wmap<MODE>(n0 + n, row_off) * K + k0 + 8 * c) = o; }
    LDS_WAIT(); asm volatile("" ::: "memory");
}
__device__ __forceinline__ void prologue(LAS unsigned char* lds, int gw, int NGW, int wave, int lane) {
    LAS float* scr = (LAS float*)(lds + wave * 16384);
    constexpr int I_F = 16 * 88, I_IN = 16 * 80, I_OUT = 16 * 32, I_L = 6 * I_F + I_IN + I_OUT;
    for (int it = gw; it < 2 * I_L; it += NGW) {
        const int l = it / I_L; int r = it % I_L;
        unsigned char* wl = KWS() + WS_W + (size_t)l * WL;
        if (r < I_F) { transpose_item<1>(KIN(7) + (size_t)l * D * FF, D, FF, (bf16*)(wl + W_GU1), 0, scr, r, lane); continue; } r -= I_F;
        if (r < I_F) { transpose_item<1>(KIN(8) + (size_t)l * D * FF, D, FF, (bf16*)(wl + W_GU1), 128, scr, r, lane); continue; } r -= I_F;
        if (r < I_F) { transpose_item<0>(KIN(9) + (size_t)l * D * FF, FF, D, (bf16*)(wl + W_D1), 0, scr, r, lane); continue; } r -= I_F;
        if (r < I_IN) { transpose_item<2>(KIN(11) + (size_t)l * D * DIN, D, DIN, (bf16*)(wl + W_IN), 0, scr, r, lane); continue; } r -= I_IN;
        if (r < I_OUT) { transpose_item<0>(KIN(20) + (size_t)l * D * D, D, D, (bf16*)(wl + W_OUT), 0, scr, r, lane); continue; } r -= I_OUT;
        if (r < I_F) { transpose_item<1>(KIN(22) + (size_t)l * D * FF, D, FF, (bf16*)(wl + W_GU2), 0, scr, r, lane); continue; } r -= I_F;
        if (r < I_F) { transpose_item<1>(KIN(23) + (size_t)l * D * FF, D, FF, (bf16*)(wl + W_GU2), 128, scr, r, lane); continue; } r -= I_F;
        transpose_item<0>(KIN(24) + (size_t)l * D * FF, FF, D, (bf16*)(wl + W_D2), 0, scr, r, lane);
    }
    float* rope = (float*)(KWS() + WS_ROPE);
    for (int i = gw * 64 + lane; i < 2080 * 32; i += NGW * 64) {
        const int pr = i >> 5, d = i & 31; const int pos = pr < 2048 ? pr : 4096 + (pr - 2048);
        const float inv = exp2f(-(float)d * (13.287712379549449f / 32.0f));
        const float ang = (float)pos * inv;
        const double rev = (double)ang * 0.15915494309189535; const float fr = (float)(rev - __builtin_rint(rev));
        rope[pr * 64 + d] = __builtin_amdgcn_cosf(fr); rope[pr * 64 + 32 + d] = __builtin_amdgcn_sinf(fr);
    }
    bf16* pwt_ = (bf16*)(KWS() + WS_POOLWT);
    for (int i = gw * 64 + lane; i < 2 * 4 * 64 * 64; i += NGW * 64) {
        const int c = i & 63, e = (i >> 6) & 63, lg = i >> 12;
        pwt_[i] = (bf16)(pk2(KIN(17)[(size_t)lg * 4096 + c * 64 + e], 0.f) & 0xffffu);
    }
}
template <bool FINAL> __device__ __forceinline__ void norm_rows(const float* srcP, const float* srcS, const float* g, bf16* H, float* outf, int gw, int NGW, int lane) {
    const f32x4* g4 = (const f32x4*)g + lane;
    f32x4 gv[4];
#pragma unroll
    for (int j = 0; j < 4; ++j) gv[j] = g4[64 * j];
    for (int m = gw; m < M; m += NGW) {
        const float* xr = (m < MP) ? srcP + (size_t)m * D : srcS + (size_t)(m - MP) * D;
        const f32x4* x4 = (const f32x4*)xr + lane;
        f32x4 v[4]; float s = 0.f;
#pragma unroll
        for (int j = 0; j < 4; ++j) { v[j] = x4[64 * j]; s += (v[j].x * v[j].x + v[j].y * v[j].y) + (v[j].z * v[j].z + v[j].w * v[j].w); }
        const float rstd = 1.0f / sqrtf(wave_sum(s) * (1.0f / D) + EPS);
        if (FINAL) {
            f32x4* o4 = (f32x4*)(outf + (size_t)m * D) + lane;
#pragma unroll
            for (int j = 0; j < 4; ++j) o4[64 * j] = v[j] * rstd * gv[j];
        } else {
            v2u* o2 = (v2u*)(H + (size_t)m * D) + lane;
#pragma unroll
            for (int j = 0; j < 4; ++j) { const f32x4 y = v[j] * rstd * gv[j]; v2u w; w.x = pk2(y.x, y.y); w.y = pk2(y.z, y.w); o2[64 * j] = w; }
        }
    }
}
__device__ __forceinline__ f32x16 mfma32(bf16x8 a, bf16x8 b, f32x16 c) { return __builtin_amdgcn_mfma_f32_32x32x16_bf16(a, b, c, 0, 0, 0); }


template <bool BASE16, int K> __device__ __forceinline__ void skinny_part1(LAS unsigned char* lds, const bf16* A, const bf16* Bt, const void* base, bf16* out, float scale,
                                            unsigned* slots, unsigned* cnt8, int tile, int tid) {
    const int lane = tid & 63, r32 = lane & 31, hi = lane >> 5, wid = __builtin_amdgcn_readfirstlane(tid >> 6);
    LAS float* R = (LAS float*)lds;
    LAS float* PARK = (LAS float*)(lds + 131072);
    const int rt = tile >> 5, ct = tile & 31, kw = K >> 3, k0 = wid * kw;
    const int e = tid * 2, row = e >> 5, col = e & 31;
    const size_t o = (size_t)(rt * 32 + row) * 1024 + ct * 32 + col;
    f32x2 bv; if (BASE16) { const unsigned bw = *(const unsigned*)((const bf16*)base + o); bv.x = bf2f(bw & 0xffff); bv.y = bf2f(bw >> 16); } else bv = *(const f32x2*)((const float*)base + o);
    const bf16* ap = A + (size_t)(rt * 32 + r32) * K + wid * 16 + hi * 8; const bf16* bp = Bt + (size_t)(ct * 32 + r32) * K + wid * 16 + hi * 8; (void)k0;
    f32x16 acc;
#pragma unroll
    for (int r = 0; r < 16; ++r) acc[r] = 0.f;
    constexpr int NST = K / 128, UB = (NST % 11 == 0) ? 11 : 8;
#pragma unroll 1
    for (int s0 = 0; s0 < NST; s0 += UB) { bf16x8 av[UB], bw[UB];
#pragma unroll
        for (int j = 0; j < UB; ++j) { av[j] = *(const bf16x8*)(ap + (s0 + j) * 128); bw[j] = *(const bf16x8*)(bp + (s0 + j) * 128); }
#pragma unroll
        for (int j = 0; j < UB; ++j) acc = mfma32(av[j], bw[j], acc); }
    __syncthreads();
#pragma unroll
    for (int r = 0; r < 16; ++r) R[(wid * 32 + crow(r, hi)) * 32 + r32] = acc[r];
    __syncthreads();
    f32x2 s = {0.f, 0.f};
#pragma unroll
    for (int w = 0; w < 8; ++w) s += *(const LAS f32x2*)(R + (w * 32 + row) * 32 + col);
    const f32x2 v = bv + s * scale;
    float ss = v.x * v.x + v.y * v.y; ss += swz_xor<1>(ss); ss += swz_xor<2>(ss); ss += swz_xor<4>(ss); ss += swz_xor<8>(ss);
    if ((tid & 15) == 0) __hip_atomic_store(slots + (size_t)(rt * 32 + row) * 32 + ct, __builtin_bit_cast(unsigned, ss), __ATOMIC_RELAXED, __HIP_MEMORY_SCOPE_AGENT);
    *(LAS f32x2*)(PARK + tid * 2) = v;
    asm volatile("s_waitcnt vmcnt(0)" ::: "memory");
    __syncthreads();
    if (tid == 0) __hip_atomic_fetch_add(cnt8 + 64 * rt, 1u, __ATOMIC_RELAXED, __HIP_MEMORY_SCOPE_AGENT);
    if (out) *(unsigned*)(out + o) = pk2(v.x, v.y);
    __syncthreads();
}
__device__ __forceinline__ void skinny_part2(LAS unsigned char* lds, bf16* hb, float* yout, const float* gain, unsigned* slots, unsigned* cnt8, int tile, int tid) {
    LAS float* PARK = (LAS float*)(lds + 131072);
    const int rt = tile >> 5, ct = tile & 31, e = tid * 2, row = e >> 5, col = e & 31;
    const size_t o = (size_t)(rt * 32 + row) * 1024 + ct * 32 + col;
    if (tid == 0) {
        unsigned spins = 0;
        while (__hip_atomic_load(cnt8 + 64 * rt, __ATOMIC_RELAXED, __HIP_MEMORY_SCOPE_AGENT) < 32u) { __builtin_amdgcn_s_sleep(2); if (++spins > (1u << 22)) break; }
        __builtin_amdgcn_fence(__ATOMIC_ACQUIRE, "agent");
        asm volatile("s_waitcnt vmcnt(0)" ::: "memory");
    }
    __syncthreads();
    const unsigned* sl = slots + (size_t)(rt * 32 + row) * 32 + (tid & 15) * 2;
    float tot = __builtin_bit_cast(float, __hip_atomic_load(sl, __ATOMIC_RELAXED, __HIP_MEMORY_SCOPE_AGENT)) + __builtin_bit_cast(float, __hip_atomic_load(sl + 1, __ATOMIC_RELAXED, __HIP_MEMORY_SCOPE_AGENT));
    tot += swz_xor<1>(tot); tot += swz_xor<2>(tot); tot += swz_xor<4>(tot); tot += swz_xor<8>(tot);
    const float r = 1.0f / sqrtf(tot * (1.0f / 1024.0f) + EPS);
    const f32x2 v = *(const LAS f32x2*)(PARK + tid * 2);
    const f32x2 gv = *(const f32x2*)(gain + ct * 32 + col); const f32x2 y = v * r * gv;
    if (hb) *(unsigned*)(hb + o) = pk2(y.x, y.y); else *(f32x2*)(yout + o) = y;
    __syncthreads();
}

__device__ __forceinline__ void sample_piece(LAS unsigned char* lds, int pc, int l, const bf16* Qb, const float* cache_k, const float* cache_v, const float* knew, const float* vnew, float* OPART, float* MLP, int tid) {
    const int lane = tid & 63, r32 = lane & 31, hi = lane >> 5, wid = __builtin_amdgcn_readfirstlane(tid >> 6);
    const int b = pc >> 5, h = (pc >> 3) & 3, s = pc & 7;
    const bf16* qrow = Qb + (size_t)(MP + b * 32 + r32) * 512 + h * 128 + hi * 8;
    LAS float* ML = (LAS float*)lds;
    LAS float* FAC = (LAS float*)(lds + 4096);
    LAS float* OX = (LAS float*)(lds + 8192);
    const bool extra = (s == 7) && (wid == 7);
    const size_t off = ((size_t)((l * 8 + b) * 4096 + (s * 8 + wid) * 64)) * 512 + h * 128;
    const size_t offx = ((size_t)(l * 8 + b) * 32) * 512 + h * 128;
    const float* Kt = cache_k + off; const float* Vt = cache_v + off; const float* Kx = knew + offx; const float* Vx = vnew + offx;
    float mrow[2], lrow[2]; bf16x8 pw[2][6];
#pragma unroll
    for (int c = 0; c < 2; ++c) {
        bf16x8 qf[4];
#pragma unroll
        for (int d0 = 0; d0 < 4; ++d0) qf[d0] = *(const bf16x8*)(qrow + c * 64 + d0 * 16);
        f32x16 sc[3];
        {
            LAS bf16* KS = (LAS bf16*)(lds + 8192 + wid * 16384);
            const float* kptr = Kt + (size_t)(lane >> 4) * 512 + c * 64 + 4 * (lane & 15);
#pragma unroll 1
            for (int hb = 0; hb < 2; ++hb) {
                f32x4 kr[8];
#pragma unroll
                for (int i = 0; i < 8; ++i) kr[i] = __builtin_nontemporal_load((const f32x4*)(kptr + (size_t)i * 2048));
#pragma unroll
                for (int i = 0; i < 8; ++i) { v2u w; w.x = pk2(kr[i].x, kr[i].y); w.y = pk2(kr[i].z, kr[i].w); *(LAS v2u*)(KS + (hb * 32 + 4 * i + (lane >> 4)) * 72 + 4 * (lane & 15)) = w; }
                kptr += 32 * 512;
            }
            LDS_WAIT();
#pragma unroll
            for (int kvb = 0; kvb < 2; ++kvb) {
                f32x16 a;
#pragma unroll
                for (int r = 0; r < 16; ++r) a[r] = 0.f;
#pragma unroll
                for (int d0 = 0; d0 < 4; ++d0) { const bf16x8 kf = *(const LAS bf16x8*)(KS + (kvb * 32 + r32) * 72 + d0 * 16 + hi * 8); a = mfma32(kf, qf[d0], a); }
                sc[kvb] = a;
            }
            LDS_WAIT();
        }
        if (extra) {
            f32x16 a;
#pragma unroll
            for (int r = 0; r < 16; ++r) a[r] = 0.f;
            const float* kp = Kx + (size_t)r32 * 512 + c * 64 + hi * 8;
#pragma unroll
            for (int d0 = 0; d0 < 4; ++d0) { const f32x4 x0 = *(const f32x4*)(kp + d0 * 16), x1 = *(const f32x4*)(kp + d0 * 16 + 4); a = mfma32(pack8(x0, x1), qf[d0], a); }
            sc[2] = a;
        } else {
#pragma unroll
            for (int r = 0; r < 16; ++r) sc[2][r] = -1e30f;
        }
        float mx = -1e30f;
#pragma unroll
        for (int r = 0; r < 16; ++r) mx = fmaxf(mx, fmaxf(fmaxf(sc[0][r], sc[1][r]), sc[2][r]));
        mx = xhalf_max(mx);
        float sum = 0.f;
#pragma unroll
        for (int kvb = 0; kvb < 3; ++kvb)
#pragma unroll
            for (int r = 0; r < 16; ++r) { const float pv = __builtin_amdgcn_exp2f(sc[kvb][r] - mx); sc[kvb][r] = pv; sum += pv; }
        sum = xhalf_sum(sum);
        mrow[c] = mx; lrow[c] = sum;
#pragma unroll
        for (int kvb = 0; kvb < 3; ++kvb)
#pragma unroll
            for (int hf = 0; hf < 2; ++hf) { v4u w; w.x = pk2(sc[kvb][8 * hf + 0], sc[kvb][8 * hf + 1]); w.y = pk2(sc[kvb][8 * hf + 2], sc[kvb][8 * hf + 3]);
                w.z = pk2(sc[kvb][8 * hf + 4], sc[kvb][8 * hf + 5]); w.w = pk2(sc[kvb][8 * hf + 6], sc[kvb][8 * hf + 7]); pw[c][2 * kvb + hf] = __builtin_bit_cast(bf16x8, w); }
    }
    asm volatile("" ::: "memory");
    LAS unsigned char* VT = lds + 8192 + wid * 16384;
    LDS_WAIT();
    {
        const float* vptr = Vt + (size_t)(lane >> 5) * 512 + 4 * (lane & 31);
#pragma unroll 1
        for (int hb = 0; hb < 4; ++hb) {
            f32x4 vr[8];
#pragma unroll
            for (int i = 0; i < 8; ++i) vr[i] = __builtin_nontemporal_load((const f32x4*)(vptr + (size_t)i * 1024));
#pragma unroll
            for (int i = 0; i < 8; ++i) { const unsigned row = hb * 16 + 2 * i + (lane >> 5), ch = (lane & 31) >> 1;
                v2u w; w.x = pk2(vr[i].x, vr[i].y); w.y = pk2(vr[i].z, vr[i].w);
                *(LAS v2u*)(VT + 256u * row + 16u * (ch ^ (((row & 3) << 2) | ((row >> 2) & 3))) + 8u * (lane & 1)) = w; }
            vptr += 16 * 512;
        }
    }
    LDS_WAIT();
    f32x16 o[2][4];
#pragma unroll
    for (int c = 0; c < 2; ++c)
#pragma unroll
        for (int eb = 0; eb < 4; ++eb)
#pragma unroll
            for (int r = 0; r < 16; ++r) o[c][eb][r] = 0.f;
    {
        const unsigned q4 = (lane & 15) >> 2, p4 = lane & 3, l2 = 2 * ((lane >> 4) & 1) + (p4 >> 1);
        const unsigned a0 = (unsigned)(uintptr_t)VT + 256u * (4 * hi + q4) + 8u * (p4 & 1);
        unsigned ab[2][4];
#pragma unroll
        for (int t = 0; t < 2; ++t)
#pragma unroll
            for (int eb = 0; eb < 4; ++eb) ab[t][eb] = a0 + 2048u * t + 16u * (l2 ^ ((2 * t + hi) & 3)) + 64u * ((unsigned)eb ^ q4);
#pragma unroll
        for (int ks = 0; ks < 4; ++ks) {
#pragma unroll
            for (int eb = 0; eb < 4; ++eb) {
                v2u lo, hi2;
                asm volatile("ds_read_b64_tr_b16 %0, %2 offset:%c4\n\tds_read_b64_tr_b16 %1, %3 offset:%c4\n\ts_waitcnt lgkmcnt(0)" : "=&v"(lo), "=&v"(hi2) : "v"(ab[0][eb]), "v"(ab[1][eb]), "i"(ks * 4096) : "memory");
                v4u w; w.x = lo.x; w.y = lo.y; w.z = hi2.x; w.w = hi2.y;
                const bf16x8 vf = __builtin_bit_cast(bf16x8, w);
                o[0][eb] = mfma32(pw[0][ks], vf, o[0][eb]); o[1][eb] = mfma32(pw[1][ks], vf, o[1][eb]);
            }
        }
    }
    if (extra) {
#pragma unroll
        for (int ks = 4; ks < 6; ++ks) {
#pragma unroll
            for (int eb = 0; eb < 4; ++eb) {
                const float* vp = Vx + (size_t)((ks - 4) * 16 + 4 * hi) * 512 + eb * 32 + r32;
                f32x4 x0, x1;
                x0.x = vp[0 * 512]; x0.y = vp[1 * 512]; x0.z = vp[2 * 512]; x0.w = vp[3 * 512];
                x1.x = vp[8 * 512]; x1.y = vp[9 * 512]; x1.z = vp[10 * 512]; x1.w = vp[11 * 512];
                const bf16x8 vf = pack8(x0, x1);
                o[0][eb] = mfma32(pw[0][ks], vf, o[0][eb]); o[1][eb] = mfma32(pw[1][ks], vf, o[1][eb]);
            }
        }
    }
    if (hi == 0) {
#pragma unroll
        for (int c = 0; c < 2; ++c) { ML[((wid * 2 + c) * 32 + r32) * 2 + 0] = mrow[c]; ML[((wid * 2 + c) * 32 + r32) * 2 + 1] = lrow[c]; }
    }
    __syncthreads();
    const int pidx = s;
    if (tid < 64) {
        const int c = tid >> 5, q = tid & 31; float mw[8], lw[8]; float Mx = -1e30f;
#pragma unroll
        for (int w = 0; w < 8; ++w) { mw[w] = ML[((w * 2 + c) * 32 + q) * 2 + 0]; lw[w] = ML[((w * 2 + c) * 32 + q) * 2 + 1]; Mx = fmaxf(Mx, mw[w]); }
        float L = 0.f;
#pragma unroll
        for (int w = 0; w < 8; ++w) { const float fz = __builtin_amdgcn_exp2f(mw[w] - Mx); FAC[(w * 2 + c) * 32 + q] = fz; L += lw[w] * fz; }
        float* mp = MLP + ((size_t)((((b * 4 + h) * 2 + c) * 9 + pidx) * 32 + q)) * 2; mp[0] = Mx; mp[1] = L;
    }
    __syncthreads();
#pragma unroll
    for (int c = 0; c < 2; ++c) {
#pragma unroll
        for (int eb = 0; eb < 4; ++eb)
#pragma unroll
            for (int r = 0; r < 16; ++r) { const int q = crow(r, hi); OX[(wid * 32 + q) * 128 + eb * 32 + r32] = o[c][eb][r] * FAC[(wid * 2 + c) * 32 + q]; }
        __syncthreads();
        { const int idx = tid * 8, q = idx >> 7, e = idx & 127; f32x4 s0 = {0.f, 0.f, 0.f, 0.f}, s1 = {0.f, 0.f, 0.f, 0.f};
#pragma unroll
          for (int w = 0; w < 8; ++w) { s0 += *(const LAS f32x4*)(OX + (w * 32 + q) * 128 + e); s1 += *(const LAS f32x4*)(OX + (w * 32 + q) * 128 + e + 4); }
          float* dst = OPART + ((size_t)((((b * 4 + h) * 2 + c) * 9 + pidx) * 32 + q)) * 128 + e; *(f32x4*)dst = s0; *(f32x4*)(dst + 4) = s1; }
        __syncthreads();
    }
}

template <int W> __device__ __forceinline__ void pool_d(const LAS float* U, LAS bf16* Dd, int ch, int tbeg, int t0, bool smp) {
    float s = 0.f;
#pragma unroll
    for (int i = 0; i < W; ++i) s += U[(15 + tbeg - i) * 256 + ch];
#pragma unroll 8
    for (int k = 0; k < 32; ++k) {
        const int tt = tbeg + k; const float cur = U[(15 + tt) * 256 + ch];
        if (k > 0) s += cur - U[(15 + tt - W) * 256 + ch];
        const int pos = smp ? 4096 + tt : t0 + tt; const int cnt = (pos + 1 < W) ? pos + 1 : W;
        const float d = s * __builtin_amdgcn_rcpf((float)cnt) - cur;
        Dd[tt * 264 + ch] = (bf16)(pk2(d, 0.f) & 0xffffu);
    }
}
__device__ __forceinline__ f32x4 bf4_to_f32(v2u w) { f32x4 v; v.x = bf2f(w.x & 0xffff); v.y = bf2f(w.x >> 16); v.z = bf2f(w.y & 0xffff); v.w = bf2f(w.y >> 16); return v; }
__device__ __forceinline__ void poolconv_tile(LAS unsigned char* lds, int tl, int l, const bf16* Zb, bf16* MIX, const float* state_pool, const float* state_conv, const bf16* pwt, const float* pool_scale,
                                              const float* conv_w, float* out_cp, float* out_cs, int tid) {
    const int lane = tid & 63, r32 = lane & 31, hi = lane >> 5, wid = __builtin_amdgcn_readfirstlane(tid >> 6);
    int b, t0, TT, rowbase; bool smp;
    if (tl < 256) { b = tl >> 5; t0 = (tl & 31) * 64; TT = 64; rowbase = b * 2048 + t0; smp = false; }
    else { b = tl - 256; t0 = 0; TT = 32; rowbase = MP + b * 32; smp = true; }
    LAS float* U = (LAS float*)lds;
    LAS bf16* Dd = (LAS bf16*)(lds + 81920);
    {
        f32x4 uv[10];
#pragma unroll
        for (int k = 0; k < 10; ++k) {
            const int idx = tid + 512 * k, i = idx >> 6, c4 = (idx & 63) * 4; f32x4 v = {0.f, 0.f, 0.f, 0.f};
            if (i < 15 + TT) {
                if (i < 15 && smp) v = *(const f32x4*)(state_pool + (size_t)((l * 8 + b) * 15 + i) * 256 + c4);
                else if (i >= 15 || t0 - 15 + i >= 0) v = bf4_to_f32(*(const v2u*)(Zb + (size_t)(rowbase + i - 15) * 1024 + c4));
            }
            uv[k] = v;
        }
#pragma unroll
        for (int k = 0; k < 10; ++k) { const int idx = tid + 512 * k, i = idx >> 6, c4 = (idx & 63) * 4; if (i < 15 + TT) *(LAS f32x4*)(U + i * 256 + c4) = uv[k]; }
    }
    __syncthreads();
    {
        const int ch = tid & 255, th = tid >> 8, gi = __builtin_amdgcn_readfirstlane(ch >> 6);
        if (th * 32 < TT) {
            if (gi == 0) pool_d<2>(U, Dd, ch, th * 32, t0, smp); else if (gi == 1) pool_d<4>(U, Dd, ch, th * 32, t0, smp);
            else if (gi == 2) pool_d<8>(U, Dd, ch, th * 32, t0, smp); else pool_d<16>(U, Dd, ch, th * 32, t0, smp);
        }
    }
    __syncthreads();
    {
        const int gi = wid >> 1, th = wid & 1;
        if (th * 32 < TT) {
            f32x16 acc0, acc1;
#pragma unroll
            for (int r = 0; r < 16; ++r) { acc0[r] = 0.f; acc1[r] = 0.f; }
#pragma unroll
            for (int ks = 0; ks < 4; ++ks) {
                const bf16x8 a = *(const LAS bf16x8*)(Dd + (th * 32 + r32) * 264 + gi * 64 + ks * 16 + hi * 8);
                const bf16x8 b0 = *(const bf16x8*)(pwt + (size_t)((l * 4 + gi) * 64 + r32) * 64 + ks * 16 + hi * 8);
                const bf16x8 b1 = *(const bf16x8*)(pwt + (size_t)((l * 4 + gi) * 64 + 32 + r32) * 64 + ks * 16 + hi * 8);
                acc0 = mfma32(a, b0, acc0); acc1 = mfma32(a, b1, acc1);
            }
            const float sc0 = pool_scale[l * 256 + gi * 64 + r32], sc1 = pool_scale[l * 256 + gi * 64 + 32 + r32];
#pragma unroll
            for (int r = 0; r < 16; ++r) { const int tok = th * 32 + crow(r, hi); bf16* mp = MIX + (size_t)(rowbase + tok) * 1024 + 512 + gi * 64 + r32;
                mp[0] = (bf16)(pk2(acc0[r] * sc0, 0.f) & 0xffffu); mp[32] = (bf16)(pk2(acc1[r] * sc1, 0.f) & 0xffffu); }
        }
    }
    if (wid * 8 < TT) {
        const int cq = lane, tc = wid * 8;
        v2u hraw[10], graw[10], braw[8]; f32x4 hst[2];
        hst[0] = (f32x4){0.f, 0.f, 0.f, 0.f}; hst[1] = hst[0];
#pragma unroll
        for (int i = 0; i < 10; ++i) {
            const int ts = tc - 2 + i; hraw[i] = (v2u){0u, 0u}; graw[i] = (v2u){0u, 0u};
            if (ts >= 0 || (!smp && t0 + ts >= 0)) { const bf16* zr = Zb + (size_t)(rowbase + ts) * 1024 + 4 * cq; hraw[i] = *(const v2u*)(zr + 256); graw[i] = *(const v2u*)(zr + 768); }
        }
#pragma unroll
        for (int i = 0; i < 8; ++i) braw[i] = *(const v2u*)(Zb + (size_t)(rowbase + tc + i) * 1024 + 512 + 4 * cq);
        if (smp && tc == 0) { hst[0] = *(const f32x4*)(state_conv + (size_t)((l * 8 + b) * 2 + 0) * 256 + 4 * cq); hst[1] = *(const f32x4*)(state_conv + (size_t)((l * 8 + b) * 2 + 1) * 256 + 4 * cq); }
        const f32x4 cw0 = *(const f32x4*)(conv_w + l * 768 + 4 * cq), cw1 = *(const f32x4*)(conv_w + l * 768 + 256 + 4 * cq), cw2 = *(const f32x4*)(conv_w + l * 768 + 512 + 4 * cq);
        f32x4 cm2 = bf4_to_f32(graw[0]) * bf4_to_f32(hraw[0]), cm1 = bf4_to_f32(graw[1]) * bf4_to_f32(hraw[1]);
        if (smp && tc == 0) { cm2 = hst[0]; cm1 = hst[1]; }
#pragma unroll
        for (int i = 0; i < 8; ++i) {
            const int tt = tc + i;
            const f32x4 cv = bf4_to_f32(graw[i + 2]) * bf4_to_f32(hraw[i + 2]);
            const f32x4 y = bf4_to_f32(braw[i]) * (cw0 * cm2 + cw1 * cm1 + cw2 * cv);
            v2u w; w.x = pk2(y.x, y.y); w.y = pk2(y.z, y.w);
            *(v2u*)(MIX + (size_t)(rowbase + tt) * 1024 + 768 + 4 * cq) = w;
            if (smp) { if (tt >= 30) *(f32x4*)(out_cs + (size_t)((l * 8 + b) * 2 + tt - 30) * 256 + 4 * cq) = cv; }
            else if (t0 + tt >= 2046) *(f32x4*)(out_cp + (size_t)((l * 8 + b) * 2 + t0 + tt - 2046) * 256 + 4 * cq) = cv;
            cm2 = cm1; cm1 = cv;
        }
    }
    __syncthreads();
}

__device__ __forceinline__ void combine_phase(int l, const bf16* Ob_, const float* OPART_, const float* MLP_, bf16* MIX_, int gw, int NGW, int lane) {
    const float lam_init = (l == 0) ? 0.2f : 0.35550934f;
    float lam;
    { const float a = KIN(12)[l * 64 + lane] * KIN(13)[l * 64 + lane], c = KIN(14)[l * 64 + lane] * KIN(15)[l * 64 + lane];
      lam = __expf(wave_sum(a)) - __expf(wave_sum(c)) + lam_init; }
    const float g0 = KIN(16)[l * 128 + 2 * lane], g1 = KIN(16)[l * 128 + 2 * lane + 1];
    for (int base = gw * 8; base < MP * 4; base += NGW * 8) {
        float a0[8], a1[8];
        {
            unsigned w1[8], w2[8];
#pragma unroll
            for (int j = 0; j < 8; ++j) { const int wt = base + j, row = wt >> 2, h = wt & 3;
                w1[j] = *(const unsigned*)(Ob_ + (size_t)row * 1024 + h * 128 + 2 * lane); w2[j] = *(const unsigned*)(Ob_ + (size_t)row * 1024 + 512 + h * 128 + 2 * lane); }
#pragma unroll
            for (int j = 0; j < 8; ++j) { a0[j] = bf2f(w1[j] & 0xffff) - lam * bf2f(w2[j] & 0xffff); a1[j] = bf2f(w1[j] >> 16) - lam * bf2f(w2[j] >> 16); }
        }
        float ss[8];
#pragma unroll
        for (int j = 0; j < 8; ++j) ss[j] = a0[j] * a0[j] + a1[j] * a1[j];
#pragma unroll
        for (int j = 0; j < 8; ++j) ss[j] += swz_xor<1>(ss[j]);
#pragma unroll
        for (int j = 0; j < 8; ++j) ss[j] += swz_xor<2>(ss[j]);
#pragma unroll
        for (int j = 0; j < 8; ++j) ss[j] += swz_xor<4>(ss[j]);
#pragma unroll
        for (int j = 0; j < 8; ++j) ss[j] += swz_xor<8>(ss[j]);
#pragma unroll
        for (int j = 0; j < 8; ++j) ss[j] += swz_xor<16>(ss[j]);
#pragma unroll
        for (int j = 0; j < 8; ++j) { const int wt = base + j, row = wt >> 2, h = wt & 3;
            const float tot = xhalf_sum(ss[j]);
            const float r = (1.0f / sqrtf(tot * (1.0f / 128.0f) + EPS)) * (1.0f - lam_init);
            *(unsigned*)(MIX_ + (size_t)row * 1024 + h * 128 + 2 * lane) = pk2(a0[j] * r * g0, a1[j] * r * g1); }
    }
    for (int wt = MP * 4 + gw; wt < M * 4; wt += NGW) {
        const int row = wt >> 2, h = wt & 3, rs = row - MP, b = rs >> 5, q = rs & 31; float oc[2][2];
#pragma unroll
        for (int c = 0; c < 2; ++c) {
            const size_t pb = (size_t)(((b * 4 + h) * 2 + c) * 9);
            float mw[8], lw[8]; f32x2 ov[8]; float Mx = -1e30f;
#pragma unroll
            for (int pi = 0; pi < 8; ++pi) { const f32x2 ml = *(const f32x2*)(MLP_ + ((pb + pi) * 32 + q) * 2); mw[pi] = ml.x; lw[pi] = ml.y; ov[pi] = *(const f32x2*)(OPART_ + ((pb + pi) * 32 + q) * 128 + 2 * lane); }
#pragma unroll
            for (int pi = 0; pi < 8; ++pi) Mx = fmaxf(Mx, mw[pi]);
            float L = 0.f, s0 = 0.f, s1 = 0.f;
#pragma unroll
            for (int pi = 0; pi < 8; ++pi) { const float fz = __builtin_amdgcn_exp2f(mw[pi] - Mx); L += lw[pi] * fz; s0 += ov[pi].x * fz; s1 += ov[pi].y * fz; }
            const float il = 1.0f / L; oc[c][0] = s0 * il; oc[c][1] = s1 * il;
        }
        const float a0 = oc[0][0] - lam * oc[1][0], a1 = oc[0][1] - lam * oc[1][1];
        const float tot = wave_sum(a0 * a0 + a1 * a1);
        const float r = (1.0f / sqrtf(tot * (1.0f / 128.0f) + EPS)) * (1.0f - lam_init);
        *(unsigned*)(MIX_ + (size_t)row * 1024 + h * 128 + 2 * lane) = pk2(a0 * r * g0, a1 * r * g1);
    }
}

#ifndef PROBE_SLOW_ATTN
#define PROBE_SLOW_ATTN 0
#endif
#if PROBE_SLOW_ATTN
__device__ __forceinline__ void slow_attn_phase(int l, const bf16* Qb_, float* outp, const float* cache_k, const float* cache_v, bf16* MIX_, int gw, int NGW, int lane) {
    const float lam_init = (l == 0) ? 0.2f : 0.35550934f;
    float lam;
    { const float a = KIN(12)[l * 64 + lane] * KIN(13)[l * 64 + lane], c = KIN(14)[l * 64 + lane] * KIN(15)[l * 64 + lane];
      lam = __expf(wave_sum(a)) - __expf(wave_sum(c)) + lam_init; }
    const float g0 = KIN(16)[l * 128 + 2 * lane], g1 = KIN(16)[l * 128 + 2 * lane + 1];
    for (int wt = gw; wt < M * 4; wt += NGW) {
        const int row = wt >> 2, h = wt & 3;
        const float *K0, *V0, *K1, *V1; int n0, n1;
        if (row < MP) { const int b = row >> 11, t = row & 2047; K0 = outp + OFF_KP + ((size_t)l * MP + (size_t)b * 2048) * 512 + h * 128; V0 = outp + OFF_VP + ((size_t)l * MP + (size_t)b * 2048) * 512 + h * 128; n0 = ((t >> 6) + 1) * 64; K1 = K0; V1 = V0; n1 = 0; }
        else { const int rs = row - MP, b = rs >> 5; K0 = cache_k + ((size_t)(l * 8 + b) * 4096) * 512 + h * 128; V0 = cache_v + ((size_t)(l * 8 + b) * 4096) * 512 + h * 128; n0 = 4096;
               K1 = outp + OFF_KS + ((size_t)(l * 8 + b) * 32) * 512 + h * 128; V1 = outp + OFF_VS + ((size_t)(l * 8 + b) * 32) * 512 + h * 128; n1 = 32; }
        float oc[2][2];
#pragma unroll 1
        for (int c = 0; c < 2; ++c) {
            float q[64];
#pragma unroll
            for (int d = 0; d < 64; ++d) q[d] = bf2f(Qb_[(size_t)row * 512 + h * 128 + c * 64 + d]);
            float mx = -1e30f;
            for (int seg = 0; seg < 2; ++seg) { const float* Kp = seg ? K1 : K0; const int n = seg ? n1 : n0;
                for (int j0 = 0; j0 < n; j0 += 64) { const int j = j0 + lane; float s = -1e30f;
                    if (j < n) { const float* kr = Kp + (size_t)j * 512 + c * 64; s = 0.f;
#pragma unroll
                        for (int d = 0; d < 64; ++d) s += q[d] * kr[d]; }
                    mx = fmaxf(mx, s); } }
            mx = fmaxf(mx, swz_xor<1>(mx)); mx = fmaxf(mx, swz_xor<2>(mx)); mx = fmaxf(mx, swz_xor<4>(mx)); mx = fmaxf(mx, swz_xor<8>(mx)); mx = fmaxf(mx, swz_xor<16>(mx)); mx = xhalf_max(mx);
            float L = 0.f, o0 = 0.f, o1 = 0.f;
            for (int seg = 0; seg < 2; ++seg) { const float* Kp = seg ? K1 : K0; const float* Vp = seg ? V1 : V0; const int n = seg ? n1 : n0;
                for (int j0 = 0; j0 < n; j0 += 64) { const int j = j0 + lane; float pj = 0.f;
                    if (j < n) { const float* kr = Kp + (size_t)j * 512 + c * 64; float s = 0.f;
#pragma unroll
                        for (int d = 0; d < 64; ++d) s += q[d] * kr[d];
                        pj = __builtin_amdgcn_exp2f(s - mx); }
                    L += pj;
                    const int nn = (n - j0 < 64) ? n - j0 : 64;
                    for (int jj = 0; jj < nn; ++jj) { const float pb = __builtin_bit_cast(float, __builtin_amdgcn_readlane(__builtin_bit_cast(int, pj), jj));
                        const f32x2 vv = *(const f32x2*)(Vp + (size_t)(j0 + jj) * 512 + 2 * lane); o0 += pb * vv.x; o1 += pb * vv.y; } } }
            L = wave_sum(L);
            oc[c][0] = o0 / L; oc[c][1] = o1 / L;
        }
        const float a0 = oc[0][0] - lam * oc[1][0], a1 = oc[0][1] - lam * oc[1][1];
        const float ss = wave_sum(a0 * a0 + a1 * a1);
        const float r = (1.0f / sqrtf(ss * (1.0f / 128.0f) + EPS)) * (1.0f - lam_init);
        *(unsigned*)(MIX_ + (size_t)row * 1024 + h * 128 + 2 * lane) = pk2(a0 * r * g0, a1 * r * g1);
    }
}
#endif

#ifndef PROBE_SLOW_PC
#define PROBE_SLOW_PC 0
#endif
#if PROBE_SLOW_PC
__device__ __forceinline__ float zval(const bf16* Zb_, const float* st, int l, int b, bool smp, int rowbase, int t, int col, int hist) {
    if (t >= 0) return bf2f(Zb_[(size_t)(rowbase + t) * 1024 + col]);
    if (!smp) return 0.f;
    return st[(size_t)((l * 8 + b) * hist + (hist + t)) * 256 + (col & 255)];
}
__device__ __forceinline__ void slow_pc_phase(int l, const bf16* Zb_, bf16* MIX_, int gw, int NGW, int lane) {
    const float* sp = KIN(4); const float* scv = KIN(5); const float* pw = KIN(17); const float* psc = KIN(18); const float* cw = KIN(19);
    for (int wt = gw; wt < M * 4; wt += NGW) {
        const int row = wt >> 2, g = wt & 3; const bool smp = row >= MP;
        int b, t, rowbase; if (smp) { const int rs = row - MP; b = rs >> 5; t = rs & 31; rowbase = MP + b * 32; } else { b = row >> 11; t = row & 2047; rowbase = b * 2048; }
        const int w = 2 << g, ch = g * 64 + lane;
        float s = 0.f;
        for (int i = 0; i < w; ++i) { const int tt = t - i; s += zval(Zb_, sp, l, b, smp, rowbase, tt, ch, 15); }
        const int pos = smp ? 4096 + t : t; const int cnt = (pos + 1 < w) ? pos + 1 : w;
        const float d = s / (float)cnt - zval(Zb_, sp, l, b, smp, rowbase, t, ch, 15);
        float mine = 0.f;
        for (int e = 0; e < 64; ++e) { const float v = wave_sum(d * pw[(size_t)((l * 4 + g) * 64 + lane) * 64 + e]); if (e == lane) mine = v; }
        MIX_[(size_t)row * 1024 + 512 + ch] = (bf16)(pk2(mine * psc[l * 256 + ch], 0.f) & 0xffffu);
        float cvv[3];
#pragma unroll
        for (int k = 0; k < 3; ++k) { const int tt = t - 2 + k;
            if (tt >= 0) cvv[k] = bf2f(Zb_[(size_t)(rowbase + tt) * 1024 + 768 + ch]) * bf2f(Zb_[(size_t)(rowbase + tt) * 1024 + 256 + ch]);
            else cvv[k] = smp ? scv[(size_t)((l * 8 + b) * 2 + (2 + tt)) * 256 + ch] : 0.f; }
        const float bgv = bf2f(Zb_[(size_t)row * 1024 + 512 + ch]);
        const float y = bgv * (cw[l * 768 + ch] * cvv[0] + cw[l * 768 + 256 + ch] * cvv[1] + cw[l * 768 + 512 + ch] * cvv[2]);
        MIX_[(size_t)row * 1024 + 768 + ch] = (bf16)(pk2(y, 0.f) & 0xffffu);
    }
}
#endif

#define XB_TMO      128
#define XB_XCNT(j)  (256  + 64 * (j))
#define XB_XSUB(j)  (1280 + 64 * (j))
#define XB_XGEN(j)  (2304 + 64 * (j))
#define XB_TOP      3328
#define XB_TOPGEN   3392
#define XCD_BAR_WORDS 3456
#define XB_SPIN_CAP (1u << 18)
__device__ __forceinline__ unsigned xb_ld(unsigned* p)              { return __hip_atomic_load(p, __ATOMIC_RELAXED, __HIP_MEMORY_SCOPE_AGENT); }
__device__ __forceinline__ unsigned xb_add(unsigned* p, unsigned v) { return __hip_atomic_fetch_add(p, v, __ATOMIC_RELAXED, __HIP_MEMORY_SCOPE_AGENT); }
__device__ __forceinline__ unsigned xb_xcc_id() { return (unsigned)__builtin_amdgcn_s_getreg((3 << 11) | 20) & 0xFu; }
#define XB_SPIN(cond, bar) do { unsigned _sp = 0; while (cond) { __builtin_amdgcn_s_sleep(1); \
    if ((++_sp & 255u) == 0u) { if (xb_ld(&(bar)[XB_TMO])) break; if (_sp > XB_SPIN_CAP) { atomicAdd(&(bar)[XB_TMO], 1u); break; } } } } while (0)
__device__ __forceinline__ void xcd_barrier_complete(unsigned* bar, unsigned x, unsigned& nloc, unsigned& nx) {
    const unsigned G = gridDim.x * gridDim.y * gridDim.z;
    unsigned sum, cnt, mine, sp = 0u;
    for (;;) {
        sum = 0u; cnt = 0u; mine = 0u;
#pragma unroll
        for (unsigned j = 0; j < 16; ++j) { const unsigned c = xb_ld(&bar[XB_XCNT(j)]); sum += c; cnt += (c > 0u) ? 1u : 0u; mine = (j == x) ? c : mine; }
        if (sum == G) break;
        __builtin_amdgcn_s_sleep(1);
        if ((++sp & 255u) == 0u) { if (xb_ld(&bar[XB_TMO])) break; if (sp > XB_SPIN_CAP) { atomicAdd(&bar[XB_TMO], 1u); break; } }
    }
    nloc = mine > 0u ? mine : 1u; nx = cnt > 0u ? cnt : 1u;
}
__device__ __forceinline__ void xcd_barrier(unsigned* bar, unsigned x, volatile LAS unsigned* st) {
    asm volatile("s_waitcnt vmcnt(0)" ::: "memory");
    __syncthreads();
    if (threadIdx.x == 0) {
        __builtin_amdgcn_s_waitcnt(0);
        unsigned nloc = st[0], nx = st[1];
        if (nloc == 0u) { xcd_barrier_complete(bar, x, nloc, nx); st[0] = nloc; st[1] = nx; }
        const unsigned old = xb_add(&bar[XB_XSUB(x)], 1u);
        const unsigned gen = old / nloc;
        if (old + 1u == (gen + 1u) * nloc) {
            __builtin_amdgcn_fence(__ATOMIC_RELEASE, "agent");
            asm volatile("s_waitcnt vmcnt(0)" ::: "memory");
            const unsigned og = xb_add(&bar[XB_TOP], 1u);
            const unsigned tg = og / nx;
            if (og + 1u == (tg + 1u) * nx) xb_add(&bar[XB_TOPGEN], 1u);
            else XB_SPIN(xb_ld(&bar[XB_TOPGEN]) == tg, bar);
            __builtin_amdgcn_fence(__ATOMIC_ACQUIRE, "agent");
            xb_add(&bar[XB_XGEN(x)], 1u);
            asm volatile("s_waitcnt vmcnt(0)" ::: "memory");
        } else {
            XB_SPIN(xb_ld(&bar[XB_XGEN(x)]) == gen, bar);
            __builtin_amdgcn_fence(__ATOMIC_ACQUIRE, "agent");
            asm volatile("s_waitcnt vmcnt(0)" ::: "memory");
        }
    }
    __syncthreads();
}
#define CG_SYNC() do { asm volatile("s_waitcnt vmcnt(0) lgkmcnt(0)" ::: "memory"); grid.sync(); asm volatile("" ::: "memory"); } while (0)
#define GRID_SYNC() xcd_barrier((unsigned*)KWS() + 4096, xcc, (volatile LAS unsigned*)(lds + LDS_BYTES - 64))
__global__ void __launch_bounds__(NWAVES * 64, 2) mega_fwd(Params p) {
    extern __shared__ __attribute__((aligned(16))) unsigned char lds_raw[];
    LAS unsigned char* lds = (LAS unsigned char*)lds_raw;
    cg::grid_group grid = cg::this_grid();
    const int tid = threadIdx.x, lane = tid & 63, wave = __builtin_amdgcn_readfirstlane(tid >> 6);
    const int G = gridDim.x; const int bx = blockIdx.x; const int vcu0 = (G % 8 == 0) ? (bx % 8) * (G / 8) + bx / 8 : bx;
    const int NGW = G * NWAVES;
#define X ((bf16*)(ws + WS_X))
#define H ((bf16*)(ws + WS_H))
#define MIX ((bf16*)(ws + WS_MIX))
#define ACT ((bf16*)(ws + WS_ACT))
#define Qb ((bf16*)(ws + WS_QB))
#define Kb ((bf16*)(ws + WS_KB))
#define Vb ((bf16*)(ws + WS_VB))
#define Zb ((bf16*)(ws + WS_ZB))
#define Ob ((bf16*)(ws + WS_OB))
#define OPART ((float*)(ws + WS_OPART))
#define MLP ((float*)(ws + WS_ML))
#define pwt ((const bf16*)(ws + WS_POOLWT))
    if (tid < 16) ((LAS unsigned*)(lds + LDS_BYTES - 64))[tid] = 0u;
    const unsigned xcc = xb_xcc_id();
    if (tid == 0) (void)xb_add((unsigned*)KWS() + 4096 + XB_XCNT(xcc), 1u);
    __syncthreads();
    { const int gw = vcu0 * NWAVES + wave; prologue(lds, gw, NGW, wave, lane);
      norm_rows<false>(KIN(0), KIN(1), KIN(6), (bf16*)(KWS() + WS_H), nullptr, gw, NGW, lane); }
    CG_SYNC();
#define FRESH_IDS() int tid = threadIdx.x; asm volatile("" : "+v"(tid)); const int lane = tid & 63, wave = __builtin_amdgcn_readfirstlane(tid >> 6); int vcu = vcu0; asm volatile("" : "+s"(vcu)); const int gw = vcu * NWAVES + wave; (void)lane; (void)gw; (void)wave
#define CNT(nid, idx) ((unsigned*)(ws + CTL_CNT) + (size_t)((nid) * 80 + (idx)) * 64)
#pragma unroll 1
    for (int step = 0; step < 4; ++step) {
        const int l = step >> 1, f = step & 1;
        const bool first = (step == 0);
        { FRESH_IDS(); unsigned char* const ws = KWS(); unsigned char* const wl = ws + WS_W + (size_t)l * WL;
          pg8::Gemm g{H, (const bf16*)(wl + (f ? W_GU2 : W_GU1)), M, 2 * FF, D}; pg8::StaticOrder S; S.init(M, 2 * FF, G, bx);
          pg8::EpiSwiGLU E{ACT, FF};
          pg8::gemm_phase<pg8::EpiSwiGLU, pg8::StaticOrder, true, true>(lds, g, S, E); }
        GRID_SYNC();
        { FRESH_IDS(); unsigned char* const ws = KWS(); unsigned char* const wl = ws + WS_W + (size_t)l * WL;
          const bool last = (step == 3);
          const float* const gn = last ? KIN(25) : (f ? KIN(6) + (l + 1) * D : KIN(10) + l * D);
          const int nid = step * 2;
          float* const yo = KOUT() + OFF_Y;
          pg8::Gemm g{ACT, (const bf16*)(wl + (f ? W_D2 : W_D1)), MP, D, FF}; pg8::StaticOrder S; S.init(MP, D, G, bx);
          if (first) skinny_part1<false, FF>(lds, ACT + (size_t)MP * FF, (const bf16*)(wl + W_D1), KIN(1), X + (size_t)MP * D, 0.5f, (unsigned*)(ws + WS_SLOTS), CNT(nid, 64), vcu, tid);
          else skinny_part1<true, FF>(lds, ACT + (size_t)MP * FF, (const bf16*)(wl + (f ? W_D2 : W_D1)), X + (size_t)MP * D, last ? nullptr : X + (size_t)MP * D, 0.5f, (unsigned*)(ws + WS_SLOTS), CNT(nid, 64), vcu, tid);
          { pg8::Unit u0; const int pm0 = S.next(0, u0) ? u0.pm : 0;
            if (first) { pg8::EpiResidNorm<false> E{KIN(0), X, 0.5f, H, yo, gn, (unsigned*)(ws + WS_SLOTP), CNT(nid, pm0)};
                         pg8::gemm_phase<pg8::EpiResidNorm<false>, pg8::StaticOrder, false, true>(lds, g, S, E); }
            else { pg8::EpiResidNorm<true> E{X, last ? nullptr : X, 0.5f, last ? nullptr : H, yo, gn, (unsigned*)(ws + WS_SLOTP), CNT(nid, pm0)};
                   pg8::gemm_phase<pg8::EpiResidNorm<true>, pg8::StaticOrder, false, true>(lds, g, S, E); } }
          skinny_part2(lds, last ? nullptr : H + (size_t)MP * D, yo + (size_t)MP * D, gn, (unsigned*)(ws + WS_SLOTS), CNT(nid, 64), vcu, tid); }
        if (step == 3) break;
        GRID_SYNC();
        if (f == 0) {
            { FRESH_IDS(); unsigned char* const ws = KWS(); unsigned char* const wl = ws + WS_W + (size_t)l * WL;
              pg8::Gemm g{H, (const bf16*)(wl + W_IN), M, DIN, D}; pg8::StaticOrder S; S.init(M, DIN, G, bx);
              pg8::EpiWin E{ws, KOUT(), l, C2};
              pg8::gemm_phase<pg8::EpiWin, pg8::StaticOrder, true, true>(lds, g, S, E); }
            GRID_SYNC();
#pragma unroll 1
            for (int slot = 0; slot < 2; ++slot) {
              if (((slot ^ vcu0) & 1) == 0) {
                FRESH_IDS(); unsigned char* const ws = KWS();
                for (int i = 0; i < 4; ++i) {
                  const int L = i * G + vcu; if (L >= 1024) break;
                  const int bh = (L & 255) >> 1, sI = L & 1, ii = L >> 8;
                  const int qb = sI == 0 ? (ii == 0 ? 7 : ii == 1 ? 0 : ii == 2 ? 4 : 3) : (ii == 0 ? 6 : ii == 1 ? 1 : ii == 2 ? 5 : 2);
                  const int b = bh >> 4, vh = bh & 15, hh = vh >> 2, c = (vh >> 1) & 1, hf = vh & 1;
                  attn_body::attn_unit<8>(b, qb, (const attn_body::bf16*)(Qb + (hh * 2 + c) * 64), (const attn_body::bf16*)(Kb + (hh * 2 + c) * 64), (const attn_body::bf16*)(Vb + hh * 128 + hf * 64),
                                          (attn_body::bf16*)(Ob + c * 512 + hh * 128 + hf * 64), (char*)lds_raw);
                }
              } else {
                FRESH_IDS(); unsigned char* const ws = KWS(); float* const outp = KOUT();
                for (int pc = vcu; pc < 256; pc += G)
                  sample_piece(lds, pc, l, Qb, KIN(2), KIN(3), outp + OFF_KS, outp + OFF_VS, OPART, MLP, tid);
              }
              __syncthreads();
            }
            { FRESH_IDS(); unsigned char* const ws = KWS(); float* const outp = KOUT();
              for (int tl = vcu; tl < 264; tl += G)
                poolconv_tile(lds, tl, l, Zb, MIX, KIN(4), KIN(5), pwt, KIN(18), KIN(19), outp + OFF_CP, outp + OFF_CS, tid); }
            GRID_SYNC();
            { FRESH_IDS(); unsigned char* const ws = KWS();
              combine_phase(l, Ob, OPART, MLP, MIX, gw, NGW, lane); }
            GRID_SYNC();
            { FRESH_IDS(); unsigned char* const ws = KWS(); unsigned char* const wl = ws + WS_W + (size_t)l * WL;
              const float* const gn = KIN(21) + l * D; const int nid = step * 2 + 1;
              pg8::Gemm g{MIX, (const bf16*)(wl + W_OUT), MP, D, D}; pg8::StaticOrder S; S.init(MP, D, G, bx);
              skinny_part1<true, D>(lds, MIX + (size_t)MP * D, (const bf16*)(wl + W_OUT), X + (size_t)MP * D, X + (size_t)MP * D, 1.0f, (unsigned*)(ws + WS_SLOTS), CNT(nid, 64), vcu, tid);
              { pg8::Unit u0; const int pm0 = S.next(0, u0) ? u0.pm : 0;
                pg8::EpiResidNorm<true> E{X, X, 1.0f, H, nullptr, gn, (unsigned*)(ws + WS_SLOTP), CNT(nid, pm0)};
                pg8::gemm_phase<pg8::EpiResidNorm<true>, pg8::StaticOrder, false, true>(lds, g, S, E); }
              skinny_part2(lds, H + (size_t)MP * D, nullptr, gn, (unsigned*)(ws + WS_SLOTS), CNT(nid, 64), vcu, tid); }
            GRID_SYNC();
        }
    }
}

extern "C" void kernel_launch(void* const* d_in, const int* in_sizes, int n_in, void* d_out, int out_size, void* d_ws, size_t ws_size, hipStream_t stream) {
    static int grid = 0;
    if (grid == 0) {
        if (n_in != 26 || (size_t)out_size != OUT_TOTAL || ws_size < WS_END) { fprintf(stderr, "kernel_launch: unexpected problem shape: n_in %d out %d ws %zu\n", n_in, out_size, ws_size); grid = -1; return; }
        int dev = 0, cus = 0, per_cu = 0;
        if (hipGetDevice(&dev) != hipSuccess || hipDeviceGetAttribute(&cus, hipDeviceAttributeMultiprocessorCount, dev) != hipSuccess) { grid = -1; return; }
        if (hipFuncSetAttribute((const void*)mega_fwd, hipFuncAttributeMaxDynamicSharedMemorySize, LDS_BYTES) != hipSuccess) { fprintf(stderr, "kernel_launch: hipFuncSetAttribute failed\n"); grid = -1; return; }
        if (hipOccupancyMaxActiveBlocksPerMultiprocessor(&per_cu, (const void*)mega_fwd, NWAVES * 64, LDS_BYTES) != hipSuccess || per_cu < 1) { fprintf(stderr, "kernel_launch: occupancy query says %d\n", per_cu); per_cu = 1; }
        (void)hipGetLastError();
        grid = cus * per_cu;
    }
    if (grid < 0) return;
    if (hipMemsetAsync(d_ws, 0, CTL_BYTES, stream) != hipSuccess) { fprintf(stderr, "kernel_launch: memset failed\n"); return; }
    Params p{};
    for (int i = 0; i < 26; ++i) p.in[i] = (const float*)d_in[i];
    p.out = (float*)d_out; p.ws = (unsigned char*)d_ws;
    void* args[] = {&p};
    const hipError_t e = hipLaunchCooperativeKernel((const void*)mega_fwd, dim3(grid), dim3(NWAVES * 64), args, LDS_BYTES, stream);
    if (e != hipSuccess) fprintf(stderr, "kernel_launch: cooperative launch failed: %s (grid %d)\n", hipGetErrorString(e), grid);
}
```

```cpp
#include <hip/hip_runtime.h>
#include <hip/hip_cooperative_groups.h>
#include <cstdio>
#include <cstdint>
namespace pg8 {
#define PG8_LAS __attribute__((address_space(3)))
typedef unsigned short bf16_t;
typedef short bf16x8 __attribute__((ext_vector_type(8)));
typedef float f32x4 __attribute__((ext_vector_type(4)));
typedef unsigned u32x4 __attribute__((ext_vector_type(4)));
constexpr int BM = 256, BK = 64, HALF = 128, HTB = HALF * BK * 2  , STAGE_BYTES = 8 * HTB, NXCD = 8, WGM = 8;

__host__ __device__ __forceinline__ int lds_byte(int r, int c) { const int st = (r >> 4) * 2 + (c >> 5), rr = r & 15, cc = c & 31, ob = rr * 64 + cc * 2; return st * 1024 + (ob ^ (((ob >> 9) & 1) << 5)); }
__host__ __device__ __forceinline__ void stage_rc(int b, int& R, int& C) { const int st = b / 1024, sb = b % 1024, swz = sb ^ (((sb >> 9) & 1) << 5); R = (st >> 1) * 16 + swz / 64; C = (st & 1) * 32 + (swz % 64) / 2; }
__host__ __device__ __forceinline__ int perm32(int rho) { const int n = rho >> 4, i = rho & 15; return 8 * (i >> 2) + 4 * n + (i & 3); }

struct Unit { int pm, pn; };
struct Gemm { const bf16_t* A; const bf16_t* Bt; int M, N, K; };

struct StaticOrder {
    int nM, nN, nwg, G, c;
    __host__ __device__ __forceinline__ void init(int M, int N, int G_, int c_) { nM = M / BM; nN = N / BM; nwg = nM * nN; G = G_; c = c_; }
    __host__ __device__ __forceinline__ bool next(int i, Unit& u) const {
        const long L = (long)i * G + c; if (L >= nwg) return false;
        int wgid = (int)L; { const int q = nwg / NXCD, r = nwg % NXCD, xcd = wgid % NXCD, off = wgid / NXCD; wgid = (xcd < r ? xcd * (q + 1) : r * (q + 1) + (xcd - r) * q) + off; }
        const int nig = WGM * nN, gid = wgid / nig, fm = gid * WGM, gsz = (nM - fm) < WGM ? (nM - fm) : WGM;
        u.pm = fm + ((wgid % nig) % gsz); u.pn = (wgid % nig) / gsz; return true;
    }
    __device__ __forceinline__ void a_ready(const Unit&) const {}
    __device__ __forceinline__ void done(const Unit&) const {}
};

__device__ __forceinline__ unsigned cvt_pk_bf16(float lo, float hi) { unsigned r; asm volatile("v_cvt_pk_bf16_f32 %0, %1, %2" : "=v"(r) : "v"(lo), "v"(hi)); return r; }
typedef float f32x2 __attribute__((ext_vector_type(2)));
typedef unsigned u32x2 __attribute__((ext_vector_type(2)));
constexpr size_t WOFF_ROPE = (size_t)1 << 20, WOFF_QB = (size_t)215 << 20, WOFF_KB = (size_t)232 << 20, WOFF_VB = (size_t)249 << 20, WOFF_ZB = (size_t)266 << 20;
constexpr size_t OOFF_KP = 17039360, OOFF_VP = 33816576, OOFF_PP = 50593792, OOFF_KS = 50663424, OOFF_VS = 50925568, OOFF_PS = 51187712;
__device__ __forceinline__ float silu_mul(float g, float u) { const float e = __builtin_amdgcn_exp2f(-1.4426950408889634f * g); return g * u * __builtin_amdgcn_rcpf(1.0f + e); }
struct EpiSwiGLU {
    static constexpr bool PERM = true, AFTER_DRAIN = false;
    bf16_t* O; int ldc;
    __device__ __forceinline__ void operator()(const f32x4 (&acc)[2][2][4][2], const Unit& u, int wr, int wc, int fr, int fq) const {
        const int row0 = u.pm * BM + wr * 64 + fr; const int col0 = u.pn * 128 + wc * 32 + 8 * fq;
#pragma unroll
        for (int ai = 0; ai < 2; ++ai)
#pragma unroll
            for (int m = 0; m < 4; ++m) {
                bf16_t* p = O + (size_t)(row0 + ai * HALF + m * 16) * ldc + col0;
                const f32x4 g0 = acc[ai][0][m][0], g1 = acc[ai][0][m][1], u0 = acc[ai][1][m][0], u1 = acc[ai][1][m][1];
                u32x4 w;
                w.x = cvt_pk_bf16(silu_mul(g0[0], u0[0]), silu_mul(g0[1], u0[1])); w.y = cvt_pk_bf16(silu_mul(g0[2], u0[2]), silu_mul(g0[3], u0[3]));
                w.z = cvt_pk_bf16(silu_mul(g1[0], u1[0]), silu_mul(g1[1], u1[1])); w.w = cvt_pk_bf16(silu_mul(g1[2], u1[2]), silu_mul(g1[3], u1[3]));
                *(u32x4*)p = w;
                asm volatile("" ::: "memory");
            }
    }
};
struct EpiResid {
    static constexpr bool PERM = false, AFTER_DRAIN = false;
    const float* baseP; const float* baseS; float* out; float scale;
    __device__ __forceinline__ void operator()(const f32x4 (&acc)[2][2][4][2], const Unit& u, int wr, int wc, int fr, int fq) const {
        const int col0 = u.pn * BM + wc * 32 + 4 * fq;
#pragma unroll
        for (int ai = 0; ai < 2; ++ai)
#pragma unroll
            for (int m = 0; m < 4; ++m) {
                const int row = u.pm * BM + ai * HALF + wr * 64 + m * 16 + fr;
                const float* bp = (row < 16384) ? baseP + (size_t)row * 1024 : baseS + (size_t)(row - 16384) * 1024;
                float* op = out + (size_t)row * 1024;
#pragma unroll
                for (int bj = 0; bj < 2; ++bj)
#pragma unroll
                    for (int n = 0; n < 2; ++n) { const int c = col0 + bj * HALF + n * 16; const f32x4 b = *(const f32x4*)(bp + c); *(f32x4*)(op + c) = b + acc[ai][bj][m][n] * scale; }
                asm volatile("" ::: "memory");
            }
    }
};
constexpr float RMS_EPS = 1e-6f;
__device__ __forceinline__ float rstd_of(float ss) { return 1.0f / sqrtf(ss * (1.0f / 1024.0f) + RMS_EPS); }

#define PG8_RLX_AGENT __ATOMIC_RELAXED, __HIP_MEMORY_SCOPE_AGENT
template <bool BASE16> struct EpiResidNorm {
    static constexpr bool PERM = true, AFTER_DRAIN = true;
    const void* baseP; bf16_t* out; float scale; bf16_t* hb; float* yout; const float* gain; unsigned* slots; unsigned* cnt;
    __device__ __forceinline__ void fused(f32x4 (&acc)[2][2][4][2], const Unit& u, int wr, int wc, int fr, int fq, PG8_LAS unsigned char* lds, int wid, int lane) const {
        PG8_LAS float* P = (PG8_LAS float*)lds;
        PG8_LAS float* S = (PG8_LAS float*)(lds + 4096);
        const int col0 = u.pn * BM + wc * 32 + 8 * fq;
        if (BASE16) {
            u32x4 braw[2][4][2];
#pragma unroll
            for (int ai = 0; ai < 2; ++ai)
#pragma unroll
                for (int m = 0; m < 4; ++m) { const size_t ro = (size_t)(u.pm * BM + ai * HALF + wr * 64 + m * 16 + fr) * 1024;
#pragma unroll
                    for (int bj = 0; bj < 2; ++bj) braw[ai][m][bj] = *(const u32x4*)((const bf16_t*)baseP + ro + col0 + bj * HALF); }
#pragma unroll
            for (int ai = 0; ai < 2; ++ai)
#pragma unroll
                for (int m = 0; m < 4; ++m)
#pragma unroll
                    for (int bj = 0; bj < 2; ++bj) { const u32x4 bw = braw[ai][m][bj]; f32x4 b0, b1;
                        b0[0] = __builtin_bit_cast(float, bw.x << 16); b0[1] = __builtin_bit_cast(float, bw.x & 0xffff0000u); b0[2] = __builtin_bit_cast(float, bw.y << 16); b0[3] = __builtin_bit_cast(float, bw.y & 0xffff0000u);
                        b1[0] = __builtin_bit_cast(float, bw.z << 16); b1[1] = __builtin_bit_cast(float, bw.z & 0xffff0000u); b1[2] = __builtin_bit_cast(float, bw.w << 16); b1[3] = __builtin_bit_cast(float, bw.w & 0xffff0000u);
                        acc[ai][bj][m][0] = b0 + acc[ai][bj][m][0] * scale; acc[ai][bj][m][1] = b1 + acc[ai][bj][m][1] * scale; }
        }
#pragma unroll
        for (int ai = 0; ai < 2; ++ai)
#pragma unroll
            for (int m = 0; m < 4; ++m) {
                const int rl = ai * HALF + wr * 64 + m * 16 + fr; const size_t ro = (size_t)(u.pm * BM + rl) * 1024;
                float ss = 0.f;
#pragma unroll
                for (int bj = 0; bj < 2; ++bj) { const int c = col0 + bj * HALF; f32x4 v0, v1;
                    if (BASE16) { v0 = acc[ai][bj][m][0]; v1 = acc[ai][bj][m][1]; }
                    else { v0 = *(const f32x4*)((const float*)baseP + ro + c) + acc[ai][bj][m][0] * scale; v1 = *(const f32x4*)((const float*)baseP + ro + c + 4) + acc[ai][bj][m][1] * scale; acc[ai][bj][m][0] = v0; acc[ai][bj][m][1] = v1; }
                    if (out) { u32x4 w; w.x = cvt_pk_bf16(v0[0], v0[1]); w.y = cvt_pk_bf16(v0[2], v0[3]); w.z = cvt_pk_bf16(v1[0], v1[1]); w.w = cvt_pk_bf16(v1[2], v1[3]); *(u32x4*)(out + ro + c) = w; }
                    ss += ((v0[0] * v0[0] + v0[1] * v0[1]) + (v0[2] * v0[2] + v0[3] * v0[3])) + ((v1[0] * v1[0] + v1[1] * v1[1]) + (v1[2] * v1[2] + v1[3] * v1[3])); }
                ss += __builtin_bit_cast(float, __builtin_amdgcn_ds_swizzle(__builtin_bit_cast(int, ss), (16 << 10) | 0x1f));
                { float a = ss, b2 = ss; asm volatile("s_nop 1\n\tv_permlane32_swap_b32 %0, %1\n\ts_nop 1" : "+v"(a), "+v"(b2)); ss = a + b2; }
                if (fq == 0) P[rl * 4 + wc] = ss;
                if (!BASE16 && (m & 1)) asm volatile("" ::: "memory");
            }
        asm volatile("s_waitcnt lgkmcnt(0)\n\ts_barrier" ::: "memory");
        const int t = wid * 64 + lane;
        if (t < 256) { const float s = (P[t * 4] + P[t * 4 + 1]) + (P[t * 4 + 2] + P[t * 4 + 3]);
            __hip_atomic_store(slots + (size_t)(u.pm * BM + t) * 4 + u.pn, __builtin_bit_cast(unsigned, s), PG8_RLX_AGENT); }
        asm volatile("s_waitcnt vmcnt(0)" ::: "memory");
        if (wid < 4 && lane == 0) __hip_atomic_fetch_add(cnt, 1u, PG8_RLX_AGENT);
        if (wid == 0) {
            unsigned spins = 0;
            while ((unsigned)__builtin_amdgcn_readfirstlane(__hip_atomic_load(cnt, PG8_RLX_AGENT)) < 16u) { __builtin_amdgcn_s_sleep(2); if (++spins > (1u << 22)) break; }
            __builtin_amdgcn_fence(__ATOMIC_ACQUIRE, "agent");
        }
        asm volatile("s_waitcnt vmcnt(0) lgkmcnt(0)\n\ts_barrier" ::: "memory");
        if (t < 256) { const unsigned* sl = slots + (size_t)(u.pm * BM + t) * 4; float tot = 0.f;
#pragma unroll
            for (int k = 0; k < 4; ++k) tot += __builtin_bit_cast(float, __hip_atomic_load(sl + k, PG8_RLX_AGENT));
            S[t] = rstd_of(tot); }
        asm volatile("s_waitcnt lgkmcnt(0)\n\ts_barrier" ::: "memory");
        f32x4 g4[2][2];
#pragma unroll
        for (int bj = 0; bj < 2; ++bj)
#pragma unroll
            for (int n = 0; n < 2; ++n) g4[bj][n] = *(const f32x4*)(gain + col0 + bj * HALF + n * 4);
#pragma unroll
        for (int ai = 0; ai < 2; ++ai)
#pragma unroll
            for (int m = 0; m < 4; ++m) {
                const int rl = ai * HALF + wr * 64 + m * 16 + fr; const size_t ro = (size_t)(u.pm * BM + rl) * 1024; const float r = S[rl];
#pragma unroll
                for (int bj = 0; bj < 2; ++bj) { const int c = col0 + bj * HALF; const f32x4 y0 = acc[ai][bj][m][0] * r * g4[bj][0], y1 = acc[ai][bj][m][1] * r * g4[bj][1];
                    if (hb) { u32x4 w; w.x = cvt_pk_bf16(y0[0], y0[1]); w.y = cvt_pk_bf16(y0[2], y0[3]); w.z = cvt_pk_bf16(y1[0], y1[1]); w.w = cvt_pk_bf16(y1[2], y1[3]); *(u32x4*)(hb + ro + c) = w; }
                    else { __builtin_nontemporal_store(y0, (f32x4*)(yout + ro + c)); __builtin_nontemporal_store(y1, (f32x4*)(yout + ro + c + 4)); } }
            }
        asm volatile("s_waitcnt lgkmcnt(0)\n\ts_barrier" ::: "memory");
    }
};

struct EpiWin {
    static constexpr bool PERM = false, AFTER_DRAIN = false;
    unsigned char* ws; float* outp; int l; float qscale;
    __device__ __forceinline__ void operator()(const f32x4 (&acc)[2][2][4][2], const Unit& u, int wr, int wc, int fr, int fq) const {
        const int pn = u.pn;
        float invrev[2][4];
#pragma unroll
        for (int n = 0; n < 2; ++n)
#pragma unroll
            for (int j = 0; j < 4; ++j) invrev[n][j] = exp2f(-(float)(8 * fq + 4 * n + j) * (13.287712379549449f / 32.0f)) * 0.15915494309189535f;
        bf16_t* const Qb = (bf16_t*)(ws + WOFF_QB); bf16_t* const Kb = (bf16_t*)(ws + WOFF_KB); bf16_t* const Vb = (bf16_t*)(ws + WOFF_VB); bf16_t* const Zb = (bf16_t*)(ws + WOFF_ZB);
        float* const kP = outp + OOFF_KP + (size_t)l * 16384 * 512; float* const vP = outp + OOFF_VP + (size_t)l * 16384 * 512;
        float* const kS = outp + OOFF_KS + (size_t)l * 256 * 512; float* const vS = outp + OOFF_VS + (size_t)l * 256 * 512;
        float* const poolP = outp + OOFF_PP + (size_t)l * 8 * 15 * 256; float* const poolS = outp + OOFF_PS + (size_t)l * 8 * 15 * 256;
        const int c0 = 64 * wc + 8 * fq;
#pragma unroll
        for (int ai = 0; ai < 2; ++ai)
#pragma unroll
            for (int m = 0; m < 4; ++m) {
                const int row = u.pm * BM + ai * HALF + wr * 64 + m * 16 + fr;
                const bool smp = row >= 16384; const int rs = row - 16384;
                f32x4 v[2][2];
                if (pn < 4) {
                    const float posf = (float)(smp ? 4096 + (rs & 31) : (row & 2047));
#pragma unroll
                    for (int n = 0; n < 2; ++n) { f32x4 cs, sn;
#pragma unroll
                        for (int j = 0; j < 4; ++j) { const float rev = posf * invrev[n][j]; const float fr_ = rev - __builtin_rintf(rev); cs[j] = __builtin_amdgcn_cosf(fr_); sn[j] = __builtin_amdgcn_sinf(fr_); }
                        const f32x4 lo = acc[ai][0][m][n], hi = acc[ai][1][m][n];
                        v[0][n] = lo * cs - hi * sn; v[1][n] = hi * cs + lo * sn; }
                } else {
#pragma unroll
                    for (int bj = 0; bj < 2; ++bj)
#pragma unroll
                        for (int n = 0; n < 2; ++n) v[bj][n] = acc[ai][bj][m][n];
                }
#pragma unroll
                for (int bj = 0; bj < 2; ++bj) {
                    const int lc = c0 + 32 * bj; const f32x4 x0 = v[bj][0], x1 = v[bj][1];
                    if (pn < 2) {
                        bf16_t* q = Qb + (size_t)row * 512 + 256 * pn + lc;
                        u32x4 w; w.x = cvt_pk_bf16(x0[0] * qscale, x0[1] * qscale); w.y = cvt_pk_bf16(x0[2] * qscale, x0[3] * qscale); w.z = cvt_pk_bf16(x1[0] * qscale, x1[1] * qscale); w.w = cvt_pk_bf16(x1[2] * qscale, x1[3] * qscale);
                        *(u32x4*)q = w;
                    } else {
                        u32x4 w; w.x = cvt_pk_bf16(x0[0], x0[1]); w.y = cvt_pk_bf16(x0[2], x0[3]); w.z = cvt_pk_bf16(x1[0], x1[1]); w.w = cvt_pk_bf16(x1[2], x1[3]);
                        if (pn < 4) { const int col = 256 * (pn - 2) + lc; float* ko = smp ? kS + (size_t)rs * 512 + col : kP + (size_t)row * 512 + col;
                            if (smp) { *(f32x4*)ko = x0; *(f32x4*)(ko + 4) = x1; } else { __builtin_nontemporal_store(x0, (f32x4*)ko); __builtin_nontemporal_store(x1, (f32x4*)(ko + 4)); }
                            *(u32x4*)(Kb + (size_t)row * 512 + col) = w; }
                        else if (pn < 6) { const int col = 256 * (pn - 4) + lc; float* vo = smp ? vS + (size_t)rs * 512 + col : vP + (size_t)row * 512 + col;
                            if (smp) { *(f32x4*)vo = x0; *(f32x4*)(vo + 4) = x1; } else { __builtin_nontemporal_store(x0, (f32x4*)vo); __builtin_nontemporal_store(x1, (f32x4*)(vo + 4)); }
                            *(u32x4*)(Vb + (size_t)row * 512 + col) = w; }
                        else { *(u32x4*)(Zb + (size_t)row * 1024 + 256 * (pn - 6) + lc) = w;
                            if (pn == 6) {
                                if (smp) { const int b = rs >> 5, t = rs & 31; if (t >= 17) { float* po = poolS + (size_t)(b * 15 + t - 17) * 256 + lc; *(f32x4*)po = x0; *(f32x4*)(po + 4) = x1; } }
                                else { const int b = row >> 11, t = row & 2047; if (t >= 2033) { float* po = poolP + (size_t)(b * 15 + t - 2033) * 256 + lc; *(f32x4*)po = x0; *(f32x4*)(po + 4) = x1; } }
                            } }
                    }
                }
                asm volatile("" ::: "memory");
            }
    }
};
template <class Epi, class Sched, bool ALIGN_EPI = false, bool SP2 = false>
__device__ __forceinline__ void gemm_phase(PG8_LAS unsigned char* lds, const Gemm g, const Sched& S, const Epi& E) {
    int tid_l = threadIdx.x; asm volatile("" : "+v"(tid_l)); const int tid = tid_l, wid = __builtin_amdgcn_readfirstlane(tid >> 6), lane = tid & 63, wr = wid >> 2, wc = wid & 3, fr = lane & 15, fq = lane >> 4;
    const int K = g.K, nt = K / BK;
    unsigned voffA[2], voffB[2];
#pragma unroll
    for (int i = 0; i < 2; ++i) { int R, C; stage_rc(tid * 16 + i * 8192, R, C); const int Rb = Epi::PERM ? ((R & ~31) + perm32(R & 31)) : R;
        voffA[i] = (unsigned)(R * K + C) * 2u; voffB[i] = (unsigned)(Rb * K + C) * 2u; }
    const size_t kstep = (size_t)(BK * 2);
    const size_t hstep = (size_t)HALF * K * 2;
    const size_t tstep = 2 * hstep;
    const unsigned ldsw = (unsigned)wid * 1024u;
    const int aoff = lds_byte(wr * 64 + fr, fq * 8), boff = lds_byte(wc * 32 + fr, fq * 8);
#define PG8_SA(b, h) (((b) * 2 + (h)) * HTB)
#define PG8_SB(b, h) ((4 + (b) * 2 + (h)) * HTB)
#define PG8_STAGE(bufoff, gbase, voff) do { _Pragma("unroll") for (int _i = 0; _i < 2; ++_i) \
        __builtin_amdgcn_global_load_lds((const unsigned*)((const char*)(gbase) + (voff)[_i]), (PG8_LAS unsigned*)(lds + (bufoff) + ldsw + _i * 8192), 16, 0, 0); } while (0)
#define PG8_LDA(dst, b, h) do { _Pragma("unroll") for (int m = 0; m < 4; ++m) _Pragma("unroll") for (int k = 0; k < 2; ++k) dst[m][k] = *(const PG8_LAS bf16x8*)(lds + PG8_SA(b, h) + aoff + m * 2048 + k * 1024); } while (0)
#define PG8_LDB(dst, b, h) do { _Pragma("unroll") for (int n = 0; n < 2; ++n) _Pragma("unroll") for (int k = 0; k < 2; ++k) dst[n][k] = *(const PG8_LAS bf16x8*)(lds + PG8_SB(b, h) + boff + n * 2048 + k * 1024); } while (0)
#define PG8_MMA(ai, bj, At, Bt) do { __builtin_amdgcn_s_setprio(1); _Pragma("unroll") for (int m = 0; m < 4; ++m) _Pragma("unroll") for (int n = 0; n < 2; ++n) _Pragma("unroll") for (int k = 0; k < 2; ++k) \
        acc[ai][bj][m][n] = __builtin_amdgcn_mfma_f32_16x16x32_bf16(Bt[n][k], At[m][k], acc[ai][bj][m][n], 0, 0, 0); __builtin_amdgcn_s_setprio(0); } while (0)
#define PG8_WAIT_V(n) asm volatile("s_waitcnt vmcnt(" #n ")" ::: "memory")
#define PG8_WAIT_L(n) asm volatile("s_waitcnt lgkmcnt(" #n ")" ::: "memory")
#define PG8_BAR __builtin_amdgcn_s_barrier()
#define PG8_SCHED __builtin_amdgcn_sched_barrier(0)
    Unit cur, nxt; int ui = 0;
    if (!S.next(0, cur)) return;
    f32x4 acc[2][2][4][2];
#pragma unroll
    for (int a = 0; a < 2; ++a)
#pragma unroll
        for (int b = 0; b < 2; ++b)
#pragma unroll
            for (int m = 0; m < 4; ++m)
#pragma unroll
                for (int n = 0; n < 2; ++n) acc[a][b][m][n] = (f32x4){0.f, 0.f, 0.f, 0.f};
    bf16x8 At[4][2], B0[2][2], B1[2][2];
    const char* cA = (const char*)g.A + (size_t)cur.pm * tstep; const char* cB = (const char*)g.Bt + (size_t)cur.pn * tstep;
    S.a_ready(cur);
    if constexpr (SP2) {
        PG8_STAGE(PG8_SB(0, 0), cB, voffB); PG8_STAGE(PG8_SB(0, 1), cB + hstep, voffB); PG8_STAGE(PG8_SA(0, 0), cA, voffA); PG8_STAGE(PG8_SA(0, 1), cA + hstep, voffA);
        if (wr == 1) PG8_BAR;
        PG8_WAIT_V(2); PG8_BAR;
        PG8_STAGE(PG8_SB(1, 0), cB + kstep, voffB); PG8_STAGE(PG8_SA(1, 0), cA + kstep, voffA); PG8_STAGE(PG8_SB(1, 1), cB + hstep + kstep, voffB);
        PG8_WAIT_V(6); PG8_BAR;
    } else {
        PG8_STAGE(PG8_SB(0, 0), cB, voffB); PG8_STAGE(PG8_SA(0, 0), cA, voffA); PG8_STAGE(PG8_SB(0, 1), cB + hstep, voffB); PG8_STAGE(PG8_SA(0, 1), cA + hstep, voffA);
        if (wr == 1) PG8_BAR;
        PG8_WAIT_V(4); PG8_BAR;
        PG8_STAGE(PG8_SB(1, 0), cB + kstep, voffB); PG8_STAGE(PG8_SA(1, 0), cA + kstep, voffA); PG8_STAGE(PG8_SB(1, 1), cB + hstep + kstep, voffB);
        PG8_WAIT_V(6); PG8_BAR;
    }
    for (;;) {
        const bool has_next = S.next(ui + 1, nxt);
        const char* nA = has_next ? (const char*)g.A + (size_t)nxt.pm * tstep : cA; const char* nB = has_next ? (const char*)g.Bt + (size_t)nxt.pn * tstep : cB;
        for (int t = 0; t < nt; t += 2) {
            const bool last = (t == nt - 2);
            const char* a1 = cA + (size_t)(t + 1) * kstep;
            const char* a2 = last ? nA : cA + (size_t)(t + 2) * kstep; const char* b2 = last ? nB : cB + (size_t)(t + 2) * kstep;
            const char* a3 = a2 + kstep; const char* b3 = b2 + kstep;
            if (last && has_next) S.a_ready(nxt);
            if constexpr (SP2) {
            PG8_LDB(B0, 0, 0); PG8_LDB(B1, 0, 1); PG8_SCHED; PG8_LDA(At, 0, 0); PG8_STAGE(PG8_SA(1, 1), a1 + hstep, voffA);
            PG8_WAIT_V(8); PG8_WAIT_L(0); PG8_BAR; PG8_MMA(0, 0, At, B0); PG8_MMA(0, 1, At, B1); PG8_BAR; PG8_SCHED;
            PG8_LDA(At, 0, 1); PG8_STAGE(PG8_SB(0, 0), b2, voffB); PG8_STAGE(PG8_SB(0, 1), b2 + hstep, voffB); PG8_STAGE(PG8_SA(0, 0), a2, voffA);
            PG8_WAIT_V(8); PG8_WAIT_L(0); PG8_BAR; PG8_MMA(1, 0, At, B0); PG8_MMA(1, 1, At, B1); PG8_BAR; PG8_SCHED;
            PG8_LDB(B0, 1, 0); PG8_LDB(B1, 1, 1); PG8_SCHED; PG8_LDA(At, 1, 0); PG8_STAGE(PG8_SA(0, 1), a2 + hstep, voffA);
            PG8_WAIT_V(8); PG8_WAIT_L(0); PG8_BAR; PG8_MMA(0, 0, At, B0); PG8_MMA(0, 1, At, B1); PG8_BAR; PG8_SCHED;
            PG8_LDA(At, 1, 1); PG8_STAGE(PG8_SB(1, 0), b3, voffB); PG8_STAGE(PG8_SB(1, 1), b3 + hstep, voffB); PG8_STAGE(PG8_SA(1, 0), a3, voffA);
            PG8_WAIT_V(8); PG8_WAIT_L(0); PG8_BAR; PG8_MMA(1, 0, At, B0); PG8_MMA(1, 1, At, B1); PG8_BAR; PG8_SCHED;
            } else {
            PG8_LDB(B0, 0, 0); PG8_SCHED; PG8_LDA(At, 0, 0); PG8_STAGE(PG8_SA(1, 1), a1 + hstep, voffA);
            PG8_WAIT_L(8); PG8_BAR; PG8_WAIT_L(0); PG8_MMA(0, 0, At, B0); PG8_BAR; PG8_SCHED;
            PG8_LDB(B1, 0, 1); PG8_STAGE(PG8_SB(0, 0), b2, voffB);
            PG8_BAR; PG8_WAIT_L(0); PG8_MMA(0, 1, At, B1); PG8_BAR;
            PG8_LDA(At, 0, 1); PG8_STAGE(PG8_SA(0, 0), a2, voffA);
            PG8_BAR; PG8_WAIT_L(0); PG8_MMA(1, 0, At, B0); PG8_BAR; PG8_SCHED;
            PG8_STAGE(PG8_SB(0, 1), b2 + hstep, voffB);
            PG8_WAIT_V(6); PG8_BAR; PG8_MMA(1, 1, At, B1); PG8_BAR;
            PG8_LDB(B0, 1, 0); PG8_SCHED; PG8_LDA(At, 1, 0); PG8_STAGE(PG8_SA(0, 1), a2 + hstep, voffA);
            PG8_WAIT_L(8); PG8_BAR; PG8_WAIT_L(0); PG8_MMA(0, 0, At, B0); PG8_BAR; PG8_SCHED;
            PG8_LDB(B1, 1, 1); PG8_STAGE(PG8_SB(1, 0), b3, voffB);
            PG8_BAR; PG8_WAIT_L(0); PG8_MMA(0, 1, At, B1); PG8_BAR;
            PG8_LDA(At, 1, 1); PG8_STAGE(PG8_SA(1, 0), a3, voffA);
            PG8_BAR; PG8_WAIT_L(0); PG8_MMA(1, 0, At, B0); PG8_BAR; PG8_SCHED;
            PG8_STAGE(PG8_SB(1, 1), b3 + hstep, voffB);
            PG8_WAIT_V(6); PG8_BAR; PG8_MMA(1, 1, At, B1); PG8_BAR;
            }
        }
        if constexpr (ALIGN_EPI) { if (wr == 0) PG8_BAR; }
        if constexpr (!Epi::AFTER_DRAIN) { E(acc, cur, wr, wc, fr, fq); S.done(cur); }
        if (!has_next) break;
#pragma unroll
        for (int a = 0; a < 2; ++a)
#pragma unroll
            for (int b = 0; b < 2; ++b)
#pragma unroll
                for (int m = 0; m < 4; ++m)
#pragma unroll
                    for (int n = 0; n < 2; ++n) acc[a][b][m][n] = (f32x4){0.f, 0.f, 0.f, 0.f};
        cur = nxt; cA = nA; cB = nB; ++ui;
        if constexpr (ALIGN_EPI) { if (wr == 1) PG8_BAR; }
    }
    PG8_WAIT_V(0);
    if constexpr (!ALIGN_EPI) { if (wr == 0) PG8_BAR; }
    PG8_BAR;
    if constexpr (Epi::AFTER_DRAIN) { E.fused(acc, cur, wr, wc, fr, fq, lds, wid, lane); S.done(cur); }
#undef PG8_SA
#undef PG8_SB
#undef PG8_STAGE
#undef PG8_LDA
#undef PG8_LDB
#undef PG8_MMA
#undef PG8_WAIT_V
#undef PG8_WAIT_L
#undef PG8_BAR
#undef PG8_SCHED
}
}
#include <hip/hip_bf16.h>
#include <cmath>
namespace attn_body {
using bf16=__hip_bfloat16;
using bf16x8=__attribute__((ext_vector_type(8)))short;
using s16x4=__attribute__((ext_vector_type(4)))short;
using f32x16=__attribute__((ext_vector_type(16)))float;
using u32x4=__attribute__((ext_vector_type(4)))unsigned;
constexpr int BATCH=8,NHEAD=16,SEQ=2048,D=64,PQK=512,PO=1024;
constexpr int NW=8,QBLK=32,QB=QBLK*NW,KVBLK=64,NQB=SEQ/QB;
constexpr int ATTN_UNIT_ROWS=QB;
__device__ __forceinline__ int crow(int r,int hi){return (r&3)+8*(r>>2)+4*hi;}
#define SBAR() __builtin_amdgcn_sched_barrier(0)
__device__ __forceinline__ void cmask(f32x16&p0,f32x16&p1,int jb,int qrel,int hi){
  const float NEG=-INFINITY; (void)hi;
  if(jb>(qrel>>6)){
  #pragma unroll
  for(int r=0;r<16;++r){p0[r]=NEG;p1[r]=NEG;}}
}

constexpr int NSLOT=3, SLOTB=8192;
constexpr int LDS_K=0, LDS_V=NSLOT*SLOTB, LDS_WS=2*NSLOT*SLOTB, LDS_OST=LDS_WS+NW*64*4, LDS_BYTES=LDS_OST+NW*4096;
constexpr float C2=0.125f*1.4426950408889634f;
__device__ __forceinline__ void glds16(const void*gsrc,unsigned lds_dst){unsigned keep;
  asm volatile("s_mov_b32 %0, m0\n\ts_mov_b32 m0, %2\n\ts_nop 0\n\tglobal_load_lds_dwordx4 %1, off\n\ts_mov_b32 m0, %0":"=&s"(keep):"v"(gsrc),"s"(lds_dst):"memory");}
__device__ __forceinline__ float max3f(float a,float b,float c){float r;asm("v_max3_f32 %0, %1, %2, %3":"=v"(r):"v"(a),"v"(b),"v"(c));return r;}
__device__ __forceinline__ float max2f(float a,float b){float r;asm("v_max_f32_e32 %0, %1, %2":"=v"(r):"v"(a),"v"(b));return r;}
__device__ __forceinline__ float fadd_s(float a,float b){float r;asm("v_add_f32_e32 %0, %1, %2":"=v"(r):"v"(a),"v"(b));return r;}
__device__ __forceinline__ float fsub_s(float a,float b){float r;asm("v_sub_f32_e32 %0, %1, %2":"=v"(r):"v"(a),"v"(b));return r;}
typedef float f32x2_t __attribute__((ext_vector_type(2))); typedef __bf16 bf16x2_t __attribute__((ext_vector_type(2)));
__device__ __forceinline__ unsigned cvtpk_s(float lo,float hi){f32x2_t v={lo,hi};bf16x2_t b=__builtin_convertvector(v,bf16x2_t);return __builtin_bit_cast(unsigned,b);}
#define WAIT_BAR(N) asm volatile("s_waitcnt vmcnt(" #N ") lgkmcnt(0)\n\ts_barrier":::"memory")

__device__ __forceinline__ void qkt(f32x16&p0,f32x16&p1,const char*Kslot,const bf16x8*qr,const f32x16&negm,int r32,int hi){
  const char*kb=Kslot+hi*1024+r32*16;
  #pragma unroll
  for(int d0=0;d0<4;++d0){
    const bf16x8 b0=*reinterpret_cast<const bf16x8*>(kb+d0*2048);
    const bf16x8 b1=*reinterpret_cast<const bf16x8*>(kb+d0*2048+512);
    if(d0==0){p0=__builtin_amdgcn_mfma_f32_32x32x16_bf16(b0,qr[0],negm,0,0,0);p1=__builtin_amdgcn_mfma_f32_32x32x16_bf16(b1,qr[0],negm,0,0,0);}
    else{p0=__builtin_amdgcn_mfma_f32_32x32x16_bf16(b0,qr[d0],p0,0,0,0);p1=__builtin_amdgcn_mfma_f32_32x32x16_bf16(b1,qr[d0],p1,0,0,0);}}
}
typedef __attribute__((address_space(3))) const char* lds_cptr;
typedef short v4i16_t __attribute__((ext_vector_type(4)));
__device__ __forceinline__ void kload8(bf16x8*kf,lds_cptr kp){
  kf[0]=*(const __attribute__((address_space(3))) bf16x8*)(kp);      kf[1]=*(const __attribute__((address_space(3))) bf16x8*)(kp+512);
  kf[2]=*(const __attribute__((address_space(3))) bf16x8*)(kp+2048); kf[3]=*(const __attribute__((address_space(3))) bf16x8*)(kp+2560);
  kf[4]=*(const __attribute__((address_space(3))) bf16x8*)(kp+4096); kf[5]=*(const __attribute__((address_space(3))) bf16x8*)(kp+4608);
  kf[6]=*(const __attribute__((address_space(3))) bf16x8*)(kp+6144); kf[7]=*(const __attribute__((address_space(3))) bf16x8*)(kp+6656);
}
__device__ __forceinline__ void kload2(bf16x8*kf,lds_cptr kp,int j){ kf[2*j]=*(const __attribute__((address_space(3))) bf16x8*)(kp+j*2048); kf[2*j+1]=*(const __attribute__((address_space(3))) bf16x8*)(kp+j*2048+512); }
__device__ __forceinline__ s16x4 vtr(lds_cptr p){ return __builtin_bit_cast(s16x4,__builtin_amdgcn_ds_read_tr16_b64_v4i16((__attribute__((address_space(3))) v4i16_t*)p)); }
__device__ __forceinline__ float rowmax(const f32x16&p0,const f32x16&p1){
  float a=max3f(p0[0],p0[1],p1[0]),b=max3f(p0[2],p0[3],p1[1]);a=max3f(a,p1[2],p1[3]);
  #pragma unroll
  for(int r=4;r<16;r+=4){a=max3f(a,p0[r],p0[r+1]);b=max3f(b,p0[r+2],p0[r+3]);a=max3f(a,p1[r],p1[r+1]);b=max3f(b,p1[r+2],p1[r+3]);}
  const float m=max2f(a,b);
  auto rr=__builtin_amdgcn_permlane32_swap(__float_as_uint(m),__float_as_uint(m),false,false);
  return max2f(__uint_as_float(rr[0]),__uint_as_float(rr[1]));
}
__device__ __forceinline__ void pv(f32x16*o,int vb,bf16x8 pa0,bf16x8 pa1,bf16x8 pa2,bf16x8 pa3){
  #pragma unroll
  for(int d0=0;d0<2;++d0){s16x4 lo[4],hi[4];
    #pragma unroll
    for(int ks=0;ks<4;++ks){
      asm volatile("ds_read_b64_tr_b16 %0,%1 offset:%c2":"=&v"(lo[ks]):"v"(vb),"i"(d0*4096+ks*1024):"memory");
      asm volatile("ds_read_b64_tr_b16 %0,%1 offset:%c2":"=&v"(hi[ks]):"v"(vb),"i"(d0*4096+ks*1024+512):"memory");}
    asm volatile("s_waitcnt lgkmcnt(0)":::"memory");SBAR();
    #define PK(k) (bf16x8){lo[k][0],lo[k][1],lo[k][2],lo[k][3],hi[k][0],hi[k][1],hi[k][2],hi[k][3]}
    o[d0]=__builtin_amdgcn_mfma_f32_32x32x16_bf16(pa0,PK(0),o[d0],0,0,0);
    o[d0]=__builtin_amdgcn_mfma_f32_32x32x16_bf16(pa1,PK(1),o[d0],0,0,0);
    o[d0]=__builtin_amdgcn_mfma_f32_32x32x16_bf16(pa2,PK(2),o[d0],0,0,0);
    o[d0]=__builtin_amdgcn_mfma_f32_32x32x16_bf16(pa3,PK(3),o[d0],0,0,0);
    #undef PK
  }
}

#ifndef ATTN_STORE16
#define ATTN_STORE16(p,v) (*(u32x4*)(p)=(v))
#endif
template<int THRL> __device__ __forceinline__ void attn_unit(int b,int qb,int qb_next,bool pre,bf16x8 (&qr)[4],const bf16*Q,const bf16*__restrict__ K,const bf16*__restrict__ V,bf16*O,char*shm){
  int tid_l=threadIdx.x; asm volatile("":"+v"(tid_l)); const int tid=tid_l,lane=tid&63,r32=lane&31,hi=lane>>5; const int wid=__builtin_amdgcn_readfirstlane(tid>>6);
  const long rowbase=(long)b*SEQ; const int q0=qb*QB;
  const bf16*Qw=Q+(rowbase+q0+wid*QBLK)*PQK;
  const bf16*Kh=K+rowbase*PQK,*Vh=V+rowbase*PQK;
  const unsigned lds0=(unsigned)(uintptr_t)shm;
  float*wsf=(float*)(shm+LDS_WS)+wid*64;
  const bf16*ksrc=Kh+(long)lane*PQK+wid*8;
  const bf16*vsrc=Vh+(long)(16*(wid&3)+(lane>>2))*PQK+(wid>>2)*32+(lane&3)*8;
  const unsigned kdst=lds0+LDS_K+wid*1024, vdst=lds0+LDS_V+wid*1024;
  #define DMA_K(t,slot) glds16(ksrc+(long)(t)*KVBLK*PQK,(unsigned)__builtin_amdgcn_readfirstlane(kdst+(slot)))
  #define DMA_V(t,slot) glds16(vsrc+(long)(t)*KVBLK*PQK,(unsigned)__builtin_amdgcn_readfirstlane(vdst+(slot)))
  const int vb0=(int)(lds0+LDS_V)+((lane>>4)&1)*32+(lane&3)*8+(4*hi+((lane&15)>>2))*64;
  const char*Kbase=shm+LDS_K; bf16x8 kf[8];
  const lds_cptr shm3=(lds_cptr)shm; const lds_cptr kp0=shm3+LDS_K+hi*1024+r32*16; const lds_cptr vp0=shm3+LDS_V+((lane>>4)&1)*32+(lane&3)*8+(4*hi+((lane&15)>>2))*64;
  const int NT=(q0+QB)/KVBLK;
  if(!pre){DMA_K(0,0);} DMA_V(0,0); if(!pre){DMA_K(1,SLOTB);}
  #pragma unroll
  for(int d0=0;d0<4;++d0){ if(!pre) qr[d0]=*reinterpret_cast<const bf16x8*>(&Qw[(long)r32*PQK+d0*16+hi*8]); }
  float mhat=0.f,l_reg=0.f;f32x16 o[2];o[0]=f32x16{};o[1]=f32x16{};f32x16 negm=f32x16{};asm volatile("":"+v"(negm));
  const int qrel=wid*QBLK+r32;
  #define CMASK(P0,P1,t) do{int jb_=(t)-(NT-4); if(jb_>=0)cmask(P0,P1,jb_,qrel,hi);}while(0)
  bool resc=false;
  #define START(P0,P1) do{ const float rm=rowmax(P0,P1); resc=false; \
    { const float dl=rm; mhat=fadd_s(mhat,dl); \
      _Pragma("unroll") for(int r=0;r<16;++r){P0[r]=fsub_s(P0[r],dl);P1[r]=fsub_s(P1[r],dl);} \
      _Pragma("unroll") for(int r=0;r<16;++r)negm[r]=-mhat; asm volatile("":"+v"(negm)); } \
    _Pragma("unroll") for(int r=0;r<16;++r)P0[r]=__builtin_amdgcn_exp2f(P0[r]); }while(0)
  #define RESC() do{ if(resc){ asm volatile("s_waitcnt lgkmcnt(0)":::"memory"); \
      _Pragma("unroll") for(int d_=0;d_<2;++d_) _Pragma("unroll") for(int r=0;r<16;++r)o[d_][r]*=wsf[crow(r,hi)]; } }while(0)
  f32x16 pA0,pA1,pB0,pB1;
  int sl_prev=0,sl_cur=0,sl_next=SLOTB;
  #define ROT() do{sl_prev=sl_cur;sl_cur=sl_next;sl_next=(sl_next==(NSLOT-1)*SLOTB)?0:sl_next+SLOTB;}while(0)
  if(!pre){DMA_K(2,2*SLOTB);}
  WAIT_BAR(3);
  qkt(pA0,pA1,Kbase,qr,negm,r32,hi);asm volatile("s_nop 15\n\ts_nop 7":"+v"(pA0),"+v"(pA1));CMASK(pA0,pA1,0);
  START(pA0,pA1);
  _Pragma("unroll") for(int r=0;r<16;++r)pA1[r]=__builtin_amdgcn_exp2f(pA1[r]);
  WAIT_BAR(0);
  DMA_K(3,0);DMA_V(1,SLOTB);
  ROT();
  kload8(kf,kp0+sl_cur);
  WAIT_BAR(2);
  s16x4 vlo[8],vhi[8]; u32x4 pw0,pw1,pw2,pw3;
  #define PKW(P,B) cvtpk_s(P[B],P[B+1])
  #define PAF(k) __builtin_bit_cast(bf16x8,pw##k)
  #define VFR(i) (bf16x8){vlo[i][0],vlo[i][1],vlo[i][2],vlo[i][3],vhi[i][0],vhi[i][1],vhi[i][2],vhi[i][3]}
  #define PIN(x) asm volatile("":"+v"(x))
  #define MX3(a,b,c) __builtin_fmaxf(__builtin_fmaxf((a),(b)),(c))
  #define GAPA(MF,A0,A1,A2,A3,W0,W1,PW) do{ MF; sacc+=A0; sacc+=A1; sacc+=A2; sacc+=A3; PIN(sacc); W0; W1; PIN(PW); SBAR(); }while(0)
  #define EX(v) __builtin_amdgcn_exp2f(v)
  #define GAPB(MF,X,B) do{ MF; X[B]=EX(X[B]); X[B+1]=EX(X[B+1]); X[B+2]=EX(X[B+2]); X[B+3]=EX(X[B+3]); PIN(X); SBAR(); }while(0)
  #define VRD(i) do{ vlo[i]=vtr(vp_+(((i)>>2)*4096+((i)&3)*1024)); vhi[i]=vtr(vp_+(((i)>>2)*4096+((i)&3)*1024+512)); }while(0)
  #define KRD(G,j) do{ if(G){ kload2(kf,kp0+sl_next,j); SBAR(); } }while(0)
  #define STEP(C0,C1,P0,P1,t,GK,GV,GL) do{ SBAR(); \
    const lds_cptr vp_=vp0+sl_prev; \
    VRD(0); SBAR(); float sacc=(P0[0]+P0[1]); \
    GAPA(C0=__builtin_amdgcn_mfma_f32_32x32x16_bf16(kf[0],qr[0],negm,0,0,0), P0[2],P0[3],P0[4],P0[5],     pw0[0]=PKW(P0,0), pw0[1]=PKW(P0,2), pw0); \
    VRD(4); SBAR(); GAPA(C1=__builtin_amdgcn_mfma_f32_32x32x16_bf16(kf[1],qr[0],negm,0,0,0), P0[6],P0[7],P0[8],P0[9],     pw0[2]=PKW(P0,4), pw0[3]=PKW(P0,6), pw0); \
    VRD(1); SBAR(); GAPA(C0=__builtin_amdgcn_mfma_f32_32x32x16_bf16(kf[2],qr[1],C0,0,0,0),   P0[10],P0[11],P0[12],P0[13], pw1[0]=PKW(P0,8), pw1[1]=PKW(P0,10), pw1); \
    VRD(5); SBAR(); GAPA(C1=__builtin_amdgcn_mfma_f32_32x32x16_bf16(kf[3],qr[1],C1,0,0,0),   P0[14],P0[15],P1[0],P1[1],   pw1[2]=PKW(P0,12),pw1[3]=PKW(P0,14), pw1); \
    VRD(2); SBAR(); GAPA(C0=__builtin_amdgcn_mfma_f32_32x32x16_bf16(kf[4],qr[2],C0,0,0,0),   P1[2],P1[3],P1[4],P1[5],     pw2[0]=PKW(P1,0), pw2[1]=PKW(P1,2), pw2); \
    VRD(6); SBAR(); GAPA(C1=__builtin_amdgcn_mfma_f32_32x32x16_bf16(kf[5],qr[2],C1,0,0,0),   P1[6],P1[7],P1[8],P1[9],     pw2[2]=PKW(P1,4), pw2[3]=PKW(P1,6), pw2); \
    VRD(3); SBAR(); GAPA(C0=__builtin_amdgcn_mfma_f32_32x32x16_bf16(kf[6],qr[3],C0,0,0,0),   P1[10],P1[11],P1[12],P1[13], pw3[0]=PKW(P1,8), pw3[1]=PKW(P1,10), pw3); \
    VRD(7); SBAR(); GAPA(C1=__builtin_amdgcn_mfma_f32_32x32x16_bf16(kf[7],qr[3],C1,0,0,0),   P1[14],P1[15],0.f,0.f,       pw3[2]=PKW(P1,12),pw3[3]=PKW(P1,14), pw3); \
    l_reg+=sacc; \
    if(GK){DMA_K((t)+3,sl_cur);} if(GV){DMA_V((t)+1,sl_next);} \
    CMASK(C0,C1,t); \
    { float a=MX3(C0[0],C0[1],C1[0]),b=MX3(C0[2],C0[3],C1[1]); a=MX3(a,C1[2],C1[3]); \
      _Pragma("unroll") for(int r=4;r<16;r+=4){a=MX3(a,C0[r],C0[r+1]);b=MX3(b,C0[r+2],C0[r+3]);a=MX3(a,C1[r],C1[r+1]);b=MX3(b,C1[r+2],C1[r+3]);} \
      float rm=__builtin_fmaxf(a,b); { auto rr=__builtin_amdgcn_permlane32_swap(__float_as_uint(rm),__float_as_uint(rm),false,false); rm=__builtin_fmaxf(__uint_as_float(rr[0]),__uint_as_float(rr[1])); } \
      resc=false; \
      if(__builtin_expect(__any(rm>(float)THRL),0)){ const float dl=__builtin_fmaxf(rm,0.f); mhat+=dl; \
        _Pragma("unroll") for(int r=0;r<16;++r){C0[r]-=dl;C1[r]-=dl;} \
        _Pragma("unroll") for(int r=0;r<16;++r)negm[r]=-mhat; asm volatile("":"+v"(negm)); \
        const float f=__builtin_amdgcn_exp2f(-dl); l_reg*=f; if(hi==0)wsf[r32]=f; resc=true; } } \
    SBAR(); \
    GAPB(o[0]=__builtin_amdgcn_mfma_f32_32x32x16_bf16(PAF(0),VFR(0),o[0],0,0,0), C0,0); \
    GAPB(o[1]=__builtin_amdgcn_mfma_f32_32x32x16_bf16(PAF(0),VFR(4),o[1],0,0,0), C0,4); \
    KRD(GL,0); GAPB(o[0]=__builtin_amdgcn_mfma_f32_32x32x16_bf16(PAF(1),VFR(1),o[0],0,0,0), C0,8); \
    KRD(GL,1); GAPB(o[1]=__builtin_amdgcn_mfma_f32_32x32x16_bf16(PAF(1),VFR(5),o[1],0,0,0), C0,12); \
    KRD(GL,2); GAPB(o[0]=__builtin_amdgcn_mfma_f32_32x32x16_bf16(PAF(2),VFR(2),o[0],0,0,0), C1,0); \
    KRD(GL,3); GAPB(o[1]=__builtin_amdgcn_mfma_f32_32x32x16_bf16(PAF(2),VFR(6),o[1],0,0,0), C1,4); \
    GAPB(o[0]=__builtin_amdgcn_mfma_f32_32x32x16_bf16(PAF(3),VFR(3),o[0],0,0,0), C1,8); \
    GAPB(o[1]=__builtin_amdgcn_mfma_f32_32x32x16_bf16(PAF(3),VFR(7),o[1],0,0,0), C1,12); \
    }while(0)
  int t=1;
  #undef CMASK
  #define CMASK(P0,P1,t) do{}while(0)
  for(;t+5<NT;t+=2){
    STEP(pB0,pB1,pA0,pA1,t,true,true,true);     WAIT_BAR(2); RESC(); ROT();
    STEP(pA0,pA1,pB0,pB1,t+1,true,true,true);   WAIT_BAR(2); RESC(); ROT();
  }
  #undef CMASK
  #define CMASK(P0,P1,t) do{int jb_=(t)-(NT-4); if(jb_>=0)cmask(P0,P1,jb_,qrel,hi);}while(0)
  #define ENDW(tt) do{ if((tt)+3<NT){WAIT_BAR(2);} else if((tt)+2<NT){WAIT_BAR(1);} else {WAIT_BAR(0);} }while(0)
  for(;t+1<NT;t+=2){
    STEP(pB0,pB1,pA0,pA1,t,(t+3<NT),(t+1<NT),(t+1<NT));       ENDW(t);   RESC(); ROT();
    STEP(pA0,pA1,pB0,pB1,t+1,(t+4<NT),(t+2<NT),(t+2<NT));     ENDW(t+1); RESC(); ROT();
  }
  STEP(pB0,pB1,pA0,pA1,NT-1,false,false,false); RESC();
  if(qb_next>=0){ DMA_K(0,0); DMA_K(1,SLOTB); DMA_K(2,2*SLOTB);
    const bf16*Qn=Q+(rowbase+(long)qb_next*QB+wid*QBLK)*PQK;
    _Pragma("unroll") for(int d0=0;d0<4;++d0)qr[d0]=*reinterpret_cast<const bf16x8*>(&Qn[(long)r32*PQK+d0*16+hi*8]); }
  { float sacc=pB0[0]+pB0[1]; _Pragma("unroll") for(int r=2;r<16;++r)sacc+=pB0[r]; _Pragma("unroll") for(int r=0;r<16;++r)sacc+=pB1[r]; l_reg+=sacc;
    pw0=(u32x4){PKW(pB0,0),PKW(pB0,2),PKW(pB0,4),PKW(pB0,6)};pw1=(u32x4){PKW(pB0,8),PKW(pB0,10),PKW(pB0,12),PKW(pB0,14)};pw2=(u32x4){PKW(pB1,0),PKW(pB1,2),PKW(pB1,4),PKW(pB1,6)};pw3=(u32x4){PKW(pB1,8),PKW(pB1,10),PKW(pB1,12),PKW(pB1,14)};
    SBAR(); pv(o,vb0+sl_cur,PAF(0),PAF(1),PAF(2),PAF(3)); }
  #undef PKW
  #undef PAF
  #undef VFR
  #undef PIN
  #undef MX3
  #undef GAPA
  #undef GAPB
  #undef EX
  #undef VRD
  #undef KRD
  #undef STEP
  #undef ENDW
  {auto rr=__builtin_amdgcn_permlane32_swap(__float_as_uint(l_reg),__float_as_uint(l_reg),false,false);l_reg=__uint_as_float(rr[0])+__uint_as_float(rr[1]);}
  if(hi==0)wsf[32+r32]=l_reg;asm volatile("s_waitcnt lgkmcnt(0)":::"memory");
  float rli[16];
  #pragma unroll
  for(int r=0;r<16;++r)rli[r]=__builtin_amdgcn_rcpf(wsf[32+crow(r,hi)]);
  bf16*Ow=O+(rowbase+q0+wid*QBLK)*PO;
  { bf16*stg=(bf16*)(shm+LDS_OST)+wid*2048;
    #pragma unroll
    for(int r=0;r<16;++r){const int orow=crow(r,hi);
      #pragma unroll
      for(int d0=0;d0<2;++d0)stg[orow*64+d0*32+r32]=__float2bfloat16(o[d0][r]*rli[r]);}
    asm volatile("s_waitcnt lgkmcnt(0)":::"memory");
    #pragma unroll
    for(int i=0;i<4;++i){const int row=i*8+(lane>>3),ch=lane&7; const u32x4 v=*(const u32x4*)(stg+row*64+ch*8); ATTN_STORE16(Ow+(long)row*PO+ch*8,v);} }
  asm volatile("s_waitcnt lgkmcnt(0)\n\ts_barrier":::"memory");
  #undef DMA_K
  #undef DMA_V
  #undef CMASK
  #undef START
  #undef RESC
  #undef ROT
}
#undef SBAR
#undef WAIT_BAR
}
namespace cg = cooperative_groups;
#define LAS __attribute__((address_space(3)))
typedef unsigned short bf16;
typedef unsigned v4u __attribute__((ext_vector_type(4)));
typedef unsigned v2u __attribute__((ext_vector_type(2)));
typedef float f32x4 __attribute__((ext_vector_type(4)));
typedef float f32x2 __attribute__((ext_vector_type(2)));
typedef float f32x16 __attribute__((ext_vector_type(16)));
typedef short bf16x8 __attribute__((ext_vector_type(8)));

constexpr int NWAVES = 8;
constexpr int D = 1024, MP = 16384, MS = 256, M = MP + MS, FF = 2816, DIN = 2560;
constexpr float EPS = 1e-6f;
constexpr float C2 = 0.125f * 1.4426950408889634f;
constexpr size_t OFF_Y = 0, OFF_KP = 17039360, OFF_VP = 33816576, OFF_PP = 50593792, OFF_CP = 50655232, OFF_KS = 50663424, OFF_VS = 50925568, OFF_PS = 51187712, OFF_CS = 51249152, OUT_TOTAL = 51257344;
constexpr size_t MiB = 1u << 20;
constexpr size_t WS_ROPE = 1 * MiB, WS_POOLWT = 2 * MiB, WS_W = 4 * MiB, WL = 40 * MiB;
constexpr size_t W_GU1 = 0, W_D1 = 11 * MiB, W_IN = 16 * MiB + MiB / 2, W_OUT = 21 * MiB + MiB / 2, W_GU2 = 23 * MiB + MiB / 2, W_D2 = 34 * MiB + MiB / 2;
constexpr size_t WS_X = 84 * MiB, WS_H = 149 * MiB, WS_MIX = 182 * MiB, WS_ACT = 215 * MiB;
constexpr size_t WS_QB = 215 * MiB, WS_KB = 232 * MiB, WS_VB = 249 * MiB, WS_ZB = 266 * MiB;
constexpr size_t WS_OB = 305 * MiB, WS_OPART = 338 * MiB, WS_ML = 347 * MiB, WS_END = 352 * MiB;
static_assert(WS_ROPE == pg8::WOFF_ROPE && WS_QB == pg8::WOFF_QB && WS_KB == pg8::WOFF_KB && WS_VB == pg8::WOFF_VB && WS_ZB == pg8::WOFF_ZB && OFF_KP == pg8::OOFF_KP && OFF_VP == pg8::OOFF_VP && OFF_PP == pg8::OOFF_PP && OFF_KS == pg8::OOFF_KS && OFF_VS == pg8::OOFF_VS && OFF_PS == pg8::OOFF_PS, "offsets");
static_assert(WS_ACT + (size_t)M * FF * 2 <= WS_OB && WS_ZB + (size_t)M * 1024 * 2 <= WS_OB && WS_X + (size_t)M * D * 4 <= WS_H && WS_H + (size_t)M * D * 2 <= WS_MIX && WS_MIX + (size_t)M * D * 2 <= WS_ACT, "ws map");
static_assert(WS_OB + (size_t)M * 1024 * 2 <= WS_OPART && WS_OPART + (size_t)32 * 2 * 9 * 32 * 128 * 4 <= WS_ML && WS_ML + (size_t)32 * 2 * 9 * 32 * 2 * 4 <= WS_END, "ws map 2");
constexpr int LDS_BYTES = 147456;
constexpr size_t CTL_BYTES = 262144, CTL_CNT = 65536;
constexpr size_t WS_SLOTP = 350 * MiB, WS_SLOTS = 351 * MiB;

__device__ __forceinline__ unsigned pk2(float lo, float hi) { f32x2 v = {lo, hi}; typedef __bf16 b2 __attribute__((ext_vector_type(2))); b2 b = __builtin_convertvector(v, b2); return __builtin_bit_cast(unsigned, b); }
__device__ __forceinline__ float bf2f(unsigned short b) { return __builtin_bit_cast(float, (unsigned)b << 16); }
__device__ __forceinline__ bf16x8 pack8(f32x4 a, f32x4 b) { v4u w; w.x = pk2(a.x, a.y); w.y = pk2(a.z, a.w); w.z = pk2(b.x, b.y); w.w = pk2(b.z, b.w); return __builtin_bit_cast(bf16x8, w); }
__device__ __forceinline__ int crow(int r, int hi) { return (r & 3) + 8 * (r >> 2) + 4 * hi; }
__device__ __forceinline__ void xhalf_pair(float m, float& a, float& b) { a = m; b = m; asm volatile("s_nop 1\n\tv_permlane32_swap_b32 %0, %1\n\ts_nop 1" : "+v"(a), "+v"(b)); }
__device__ __forceinline__ float xhalf_max(float m) { float a, b; xhalf_pair(m, a, b); return fmaxf(a, b); }
__device__ __forceinline__ float xhalf_sum(float m) { float a, b; xhalf_pair(m, a, b); return a + b; }
template <int O> __device__ __forceinline__ float swz_xor(float v) { return __builtin_bit_cast(float, __builtin_amdgcn_ds_swizzle(__builtin_bit_cast(int, v), (O << 10) | 0x1f)); }
__device__ __forceinline__ float wave_sum(float v) {
    v += swz_xor<1>(v); v += swz_xor<2>(v); v += swz_xor<4>(v); v += swz_xor<8>(v); v += swz_xor<16>(v);
    return xhalf_sum(v);
}
#define LDS_WAIT() asm volatile("s_waitcnt lgkmcnt(0)" ::: "memory")

struct Params { const float* in[26]; float* out; unsigned char* ws; };
typedef const __attribute__((address_space(4))) unsigned char* karg_ptr;
__device__ __forceinline__ karg_ptr kargs() { karg_ptr k = (karg_ptr)__builtin_amdgcn_kernarg_segment_ptr(); asm volatile("" : "+s"(k)); return k; }
__device__ __forceinline__ const float* KIN(int i) { return *(const float* const __attribute__((address_space(4)))*)(kargs() + 8 * i); }
__device__ __forceinline__ float* KOUT() { return *(float* const __attribute__((address_space(4)))*)(kargs() + 8 * 26); }
__device__ __forceinline__ unsigned char* KWS() { return *(unsigned char* const __attribute__((address_space(4)))*)(kargs() + 8 * 27); }

template <int MODE> __device__ __forceinline__ int wmap(int nl, int row_off) {
    if (MODE == 0) return row_off + nl;
    if (MODE == 1) return (nl >> 7) * 256 + (nl & 127) + row_off;
    const int u = nl >> 8, lc = nl & 255, hc = lc >> 6, bjx = (lc >> 5) & 1, fqx = (lc >> 3) & 3, n = (lc >> 2) & 1, j = lc & 3;
    return u * 256 + 128 * bjx + 32 * hc + 16 * n + 4 * fqx + j;
}
template <int MODE> __device__ __forceinline__ void transpose_item(const float* W, int K, int N, bf16* WT, int row_off, LAS float* scr, int item, int lane) {
    const int nblk = N / 32, kb = item / nblk, nb = item % nblk, k0 = 64 * kb, n0 = 32 * nb;
#pragma unroll 8
    for (int i = 0; i < 32; ++i) { const int kk = 2 * i + (lane >> 5); scr[kk * 33 + (lane & 31)] = __builtin_nontemporal_load(W + (size_t)(k0 + kk) * N + n0 + (lane & 31)); }
    LDS_WAIT(); asm volatile("" ::: "memory");
    const int c = lane & 7;
#pragma unroll
    for (int j = 0; j < 4; ++j) { const int n = (lane >> 3) + 8 * j; const LAS float* s = scr + (8 * c) * 33 + n;
        v4u o; o.x = pk2(s[0 * 33], s[1 * 33]); o.y = pk2(s[2 * 33], s[3 * 33]); o.z = pk2(s[4 * 33], s[5 * 33]); o.w = pk2(s[6 * 33], s[7 * 33]);
        *(v4u*)(WT + (size_t)wmap<MODE>(n0 + n, row_off) * K + k0 + 8 * c) = o; }
    LDS_WAIT(); asm volatile("" ::: "memory");
}
__device__ __forceinline__ void prologue(LAS unsigned char* lds, int gw, int NGW, int wave, int lane) {
    LAS float* scr = (LAS float*)(lds + wave * 16384);
    constexpr int I_F = 16 * 88, I_IN = 16 * 80, I_OUT = 16 * 32, I_L = 6 * I_F + I_IN + I_OUT;
    for (int it = gw; it < 2 * I_L; it += NGW) {
        const int l = it / I_L; int r = it % I_L;
        unsigned char* wl = KWS() + WS_W + (size_t)l * WL;
        if (r < I_F) { transpose_item<1>(KIN(7) + (size_t)l * D * FF, D, FF, (bf16*)(wl + W_GU1), 0, scr, r, lane); continue; } r -= I_F;
        if (r < I_F) { transpose_item<1>(KIN(8) + (size_t)l * D * FF, D, FF, (bf16*)(wl + W_GU1), 128, scr, r, lane); continue; } r -= I_F;
        if (r < I_F) { transpose_item<0>(KIN(9) + (size_t)l * D * FF, FF, D, (bf16*)(wl + W_D1), 0, scr, r, lane); continue; } r -= I_F;
        if (r < I_IN) { transpose_item<2>(KIN(11) + (size_t)l * D * DIN, D, DIN, (bf16*)(wl + W_IN), 0, scr, r, lane); continue; } r -= I_IN;
        if (r < I_OUT) { transpose_item<0>(KIN(20) + (size_t)l * D * D, D, D, (bf16*)(wl + W_OUT), 0, scr, r, lane); continue; } r -= I_OUT;
        if (r < I_F) { transpose_item<1>(KIN(22) + (size_t)l * D * FF, D, FF, (bf16*)(wl + W_GU2), 0, scr, r, lane); continue; } r -= I_F;
        if (r < I_F) { transpose_item<1>(KIN(23) + (size_t)l * D * FF, D, FF, (bf16*)(wl + W_GU2), 128, scr, r, lane); continue; } r -= I_F;
        transpose_item<0>(KIN(24) + (size_t)l * D * FF, FF, D, (bf16*)(wl + W_D2), 0, scr, r, lane);
    }
    float* rope = (float*)(KWS() + WS_ROPE);
    for (int i = gw * 64 + lane; i < 2080 * 32; i += NGW * 64) {
        const int pr = i >> 5, d = i & 31; const int pos = pr < 2048 ? pr : 4096 + (pr - 2048);
        const float inv = exp2f(-(float)d * (13.287712379549449f / 32.0f));
        const float ang = (float)pos * inv;
        const double rev = (double)ang * 0.15915494309189535; const float fr = (float)(rev - __builtin_rint(rev));
        rope[pr * 64 + d] = __builtin_amdgcn_cosf(fr); rope[pr * 64 + 32 + d] = __builtin_amdgcn_sinf(fr);
    }
    bf16* pwt_ = (bf16*)(KWS() + WS_POOLWT);
    for (int i = gw * 64 + lane; i < 2 * 4 * 64 * 64; i += NGW * 64) {
        const int c = i & 63, e = (i >> 6) & 63, lg = i >> 12;
        pwt_[i] = (bf16)(pk2(KIN(17)[(size_t)lg * 4096 + c * 64 + e], 0.f) & 0xffffu);
    }
}
template <bool FINAL> __device__ __forceinline__ void norm_rows(const float* srcP, const float* srcS, const float* g, bf16* H, float* outf, int gw, int NGW, int lane) {
    const f32x4* g4 = (const f32x4*)g + lane;
    f32x4 gv[4];
#pragma unroll
    for (int j = 0; j < 4; ++j) gv[j] = g4[64 * j];
    for (int m = gw; m < M; m += NGW) {
        const float* xr = (m < MP) ? srcP + (size_t)m * D : srcS + (size_t)(m - MP) * D;
        const f32x4* x4 = (const f32x4*)xr + lane;
        f32x4 v[4]; float s = 0.f;
#pragma unroll
        for (int j = 0; j < 4; ++j) { v[j] = x4[64 * j]; s += (v[j].x * v[j].x + v[j].y * v[j].y) + (v[j].z * v[j].z + v[j].w * v[j].w); }
        const float rstd = 1.0f / sqrtf(wave_sum(s) * (1.0f / D) + EPS);
        if (FINAL) {
            f32x4* o4 = (f32x4*)(outf + (size_t)m * D) + lane;
#pragma unroll
            for (int j = 0; j < 4; ++j) o4[64 * j] = v[j] * rstd * gv[j];
        } else {
            v2u* o2 = (v2u*)(H + (size_t)m * D) + lane;
#pragma unroll
            for (int j = 0; j < 4; ++j) { const f32x4 y = v[j] * rstd * gv[j]; v2u w; w.x = pk2(y.x, y.y); w.y = pk2(y.z, y.w); o2[64 * j] = w; }
        }
    }
}
__device__ __forceinline__ f32x16 mfma32(bf16x8 a, bf16x8 b, f32x16 c) { return __builtin_amdgcn_mfma_f32_32x32x16_bf16(a, b, c, 0, 0, 0); }


template <bool BASE16, int K> __device__ __forceinline__ void skinny_part1(LAS unsigned char* lds, const bf16* A, const bf16* Bt, const void* base, bf16* out, float scale,
                                            unsigned* slots, unsigned* cnt8, int tile, int tid) {
    const int lane = tid & 63, r32 = lane & 31, hi = lane >> 5, wid = __builtin_amdgcn_readfirstlane(tid >> 6);
    LAS float* R = (LAS float*)lds;
    LAS float* PARK = (LAS float*)(lds + 131072);
    const int rt = tile >> 5, ct = tile & 31, kw = K >> 3, k0 = wid * kw;
    const int e = tid * 2, row = e >> 5, col = e & 31;
    const size_t o = (size_t)(rt * 32 + row) * 1024 + ct * 32 + col;
    f32x2 bv; if (BASE16) { const unsigned bw = *(const unsigned*)((const bf16*)base + o); bv.x = bf2f(bw & 0xffff); bv.y = bf2f(bw >> 16); } else bv = *(const f32x2*)((const float*)base + o);
    const bf16* ap = A + (size_t)(rt * 32 + r32) * K + wid * 16 + hi * 8; const bf16* bp = Bt + (size_t)(ct * 32 + r32) * K + wid * 16 + hi * 8; (void)k0;
    f32x16 acc;
#pragma unroll
    for (int r = 0; r < 16; ++r) acc[r] = 0.f;
    constexpr int NST = K / 128, UB = (NST % 11 == 0) ? 11 : 8;
#pragma unroll 1
    for (int s0 = 0; s0 < NST; s0 += UB) { bf16x8 av[UB], bw[UB];
#pragma unroll
        for (int j = 0; j < UB; ++j) { av[j] = *(const bf16x8*)(ap + (s0 + j) * 128); bw[j] = *(const bf16x8*)(bp + (s0 + j) * 128); }
#pragma unroll
        for (int j = 0; j < UB; ++j) acc = mfma32(av[j], bw[j], acc); }
    __syncthreads();
#pragma unroll
    for (int r = 0; r < 16; ++r) R[(wid * 32 + crow(r, hi)) * 32 + r32] = acc[r];
    __syncthreads();
    f32x2 s = {0.f, 0.f};
#pragma unroll
    for (int w = 0; w < 8; ++w) s += *(const LAS f32x2*)(R + (w * 32 + row) * 32 + col);
    const f32x2 v = bv + s * scale;
    float ss = v.x * v.x + v.y * v.y; ss += swz_xor<1>(ss); ss += swz_xor<2>(ss); ss += swz_xor<4>(ss); ss += swz_xor<8>(ss);
    if ((tid & 15) == 0) __hip_atomic_store(slots + (size_t)(rt * 32 + row) * 32 + ct, __builtin_bit_cast(unsigned, ss), __ATOMIC_RELAXED, __HIP_MEMORY_SCOPE_AGENT);
    *(LAS f32x2*)(PARK + tid * 2) = v;
    asm volatile("s_waitcnt vmcnt(0)" ::: "memory");
    __syncthreads();
    if (tid == 0) __hip_atomic_fetch_add(cnt8 + 64 * rt, 1u, __ATOMIC_RELAXED, __HIP_MEMORY_SCOPE_AGENT);
    if (out) *(unsigned*)(out + o) = pk2(v.x, v.y);
    __syncthreads();
}
__device__ __forceinline__ void skinny_part2(LAS unsigned char* lds, bf16* hb, float* yout, const float* gain, unsigned* slots, unsigned* cnt8, int tile, int tid) {
    LAS float* PARK = (LAS float*)(lds + 131072);
    const int rt = tile >> 5, ct = tile & 31, e = tid * 2, row = e >> 5, col = e & 31;
    const size_t o = (size_t)(rt * 32 + row) * 1024 + ct * 32 + col;
    if (tid == 0) {
        unsigned spins = 0;
        while (__hip_atomic_load(cnt8 + 64 * rt, __ATOMIC_RELAXED, __HIP_MEMORY_SCOPE_AGENT) < 32u) { __builtin_amdgcn_s_sleep(2); if (++spins > (1u << 22)) break; }
        __builtin_amdgcn_fence(__ATOMIC_ACQUIRE, "agent");
        asm volatile("s_waitcnt vmcnt(0)" ::: "memory");
    }
    __syncthreads();
    const unsigned* sl = slots + (size_t)(rt * 32 + row) * 32 + (tid & 15) * 2;
    float tot = __builtin_bit_cast(float, __hip_atomic_load(sl, __ATOMIC_RELAXED, __HIP_MEMORY_SCOPE_AGENT)) + __builtin_bit_cast(float, __hip_atomic_load(sl + 1, __ATOMIC_RELAXED, __HIP_MEMORY_SCOPE_AGENT));
    tot += swz_xor<1>(tot); tot += swz_xor<2>(tot); tot += swz_xor<4>(tot); tot += swz_xor<8>(tot);
    const float r = 1.0f / sqrtf(tot * (1.0f / 1024.0f) + EPS);
    const f32x2 v = *(const LAS f32x2*)(PARK + tid * 2);
    const f32x2 gv = *(const f32x2*)(gain + ct * 32 + col); const f32x2 y = v * r * gv;
    if (hb) *(unsigned*)(hb + o) = pk2(y.x, y.y); else *(f32x2*)(yout + o) = y;
    __syncthreads();
}

__device__ __forceinline__ void sample_piece(LAS unsigned char* lds, int pc, int l, const bf16* Qb, const float* cache_k, const float* cache_v, const float* knew, const float* vnew, float* OPART, float* MLP, int tid) {
    const int lane = tid & 63, r32 = lane & 31, hi = lane >> 5, wid = __builtin_amdgcn_readfirstlane(tid >> 6);
    const int b = pc >> 5, h = (pc >> 3) & 3, s = pc & 7;
    const bf16* qrow = Qb + (size_t)(MP + b * 32 + r32) * 512 + h * 128 + hi * 8;
    LAS float* ML = (LAS float*)lds;
    LAS float* FAC = (LAS float*)(lds + 4096);
    LAS float* OX = (LAS float*)(lds + 8192);
    const bool extra = (s == 7) && (wid == 7);
    const size_t off = ((size_t)((l * 8 + b) * 4096 + (s * 8 + wid) * 64)) * 512 + h * 128;
    const size_t offx = ((size_t)(l * 8 + b) * 32) * 512 + h * 128;
    const float* Kt = cache_k + off; const float* Vt = cache_v + off; const float* Kx = knew + offx; const float* Vx = vnew + offx;
    float mrow[2], lrow[2]; bf16x8 pw[2][6];
#pragma unroll
    for (int c = 0; c < 2; ++c) {
        bf16x8 qf[4];
#pragma unroll
        for (int d0 = 0; d0 < 4; ++d0) qf[d0] = *(const bf16x8*)(qrow + c * 64 + d0 * 16);
        f32x16 sc[3];
        {
            LAS bf16* KS = (LAS bf16*)(lds + 8192 + wid * 16384);
            const float* kptr = Kt + (size_t)(lane >> 4) * 512 + c * 64 + 4 * (lane & 15);
#pragma unroll 1
            for (int hb = 0; hb < 2; ++hb) {
                f32x4 kr[8];
#pragma unroll
                for (int i = 0; i < 8; ++i) kr[i] = __builtin_nontemporal_load((const f32x4*)(kptr + (size_t)i * 2048));
#pragma unroll
                for (int i = 0; i < 8; ++i) { v2u w; w.x = pk2(kr[i].x, kr[i].y); w.y = pk2(kr[i].z, kr[i].w); *(LAS v2u*)(KS + (hb * 32 + 4 * i + (lane >> 4)) * 72 + 4 * (lane & 15)) = w; }
                kptr += 32 * 512;
            }
            LDS_WAIT();
#pragma unroll
            for (int kvb = 0; kvb < 2; ++kvb) {
                f32x16 a;
#pragma unroll
                for (int r = 0; r < 16; ++r) a[r] = 0.f;
#pragma unroll
                for (int d0 = 0; d0 < 4; ++d0) { const bf16x8 kf = *(const LAS bf16x8*)(KS + (kvb * 32 + r32) * 72 + d0 * 16 + hi * 8); a = mfma32(kf, qf[d0], a); }
                sc[kvb] = a;
            }
            LDS_WAIT();
        }
        if (extra) {
            f32x16 a;
#pragma unroll
            for (int r = 0; r < 16; ++r) a[r] = 0.f;
            const float* kp = Kx + (size_t)r32 * 512 + c * 64 + hi * 8;
#pragma unroll
            for (int d0 = 0; d0 < 4; ++d0) { const f32x4 x0 = *(const f32x4*)(kp + d0 * 16), x1 = *(const f32x4*)(kp + d0 * 16 + 4); a = mfma32(pack8(x0, x1), qf[d0], a); }
            sc[2] = a;
        } else {
#pragma unroll
            for (int r = 0; r < 16; ++r) sc[2][r] = -1e30f;
        }
        float mx = -1e30f;
#pragma unroll
        for (int r = 0; r < 16; ++r) mx = fmaxf(mx, fmaxf(fmaxf(sc[0][r], sc[1][r]), sc[2][r]));
        mx = xhalf_max(mx);
        float sum = 0.f;
#pragma unroll
        for (int kvb = 0; kvb < 3; ++kvb)
#pragma unroll
            for (int r = 0; r < 16; ++r) { const float pv = __builtin_amdgcn_exp2f(sc[kvb][r] - mx); sc[kvb][r] = pv; sum += pv; }
        sum = xhalf_sum(sum);
        mrow[c] = mx; lrow[c] = sum;
#pragma unroll
        for (int kvb = 0; kvb < 3; ++kvb)
#pragma unroll
            for (int hf = 0; hf < 2; ++hf) { v4u w; w.x = pk2(sc[kvb][8 * hf + 0], sc[kvb][8 * hf + 1]); w.y = pk2(sc[kvb][8 * hf + 2], sc[kvb][8 * hf + 3]);
                w.z = pk2(sc[kvb][8 * hf + 4], sc[kvb][8 * hf + 5]); w.w = pk2(sc[kvb][8 * hf + 6], sc[kvb][8 * hf + 7]); pw[c][2 * kvb + hf] = __builtin_bit_cast(bf16x8, w); }
    }
    asm volatile("" ::: "memory");
    LAS unsigned char* VT = lds + 8192 + wid * 16384;
    LDS_WAIT();
    {
        const float* vptr = Vt + (size_t)(lane >> 5) * 512 + 4 * (lane & 31);
#pragma unroll 1
        for (int hb = 0; hb < 4; ++hb) {
            f32x4 vr[8];
#pragma unroll
            for (int i = 0; i < 8; ++i) vr[i] = __builtin_nontemporal_load((const f32x4*)(vptr + (size_t)i * 1024));
#pragma unroll
            for (int i = 0; i < 8; ++i) { const unsigned row = hb * 16 + 2 * i + (lane >> 5), ch = (lane & 31) >> 1;
                v2u w; w.x = pk2(vr[i].x, vr[i].y); w.y = pk2(vr[i].z, vr[i].w);
                *(LAS v2u*)(VT + 256u * row + 16u * (ch ^ (((row & 3) << 2) | ((row >> 2) & 3))) + 8u * (lane & 1)) = w; }
            vptr += 16 * 512;
        }
    }
    LDS_WAIT();
    f32x16 o[2][4];
#pragma unroll
    for (int c = 0; c < 2; ++c)
#pragma unroll
        for (int eb = 0; eb < 4; ++eb)
#pragma unroll
            for (int r = 0; r < 16; ++r) o[c][eb][r] = 0.f;
    {
        const unsigned q4 = (lane & 15) >> 2, p4 = lane & 3, l2 = 2 * ((lane >> 4) & 1) + (p4 >> 1);
        const unsigned a0 = (unsigned)(uintptr_t)VT + 256u * (4 * hi + q4) + 8u * (p4 & 1);
        unsigned ab[2][4];
#pragma unroll
        for (int t = 0; t < 2; ++t)
#pragma unroll
            for (int eb = 0; eb < 4; ++eb) ab[t][eb] = a0 + 2048u * t + 16u * (l2 ^ ((2 * t + hi) & 3)) + 64u * ((unsigned)eb ^ q4);
#pragma unroll
        for (int ks = 0; ks < 4; ++ks) {
#pragma unroll
            for (int eb = 0; eb < 4; ++eb) {
                v2u lo, hi2;
                asm volatile("ds_read_b64_tr_b16 %0, %2 offset:%c4\n\tds_read_b64_tr_b16 %1, %3 offset:%c4\n\ts_waitcnt lgkmcnt(0)" : "=&v"(lo), "=&v"(hi2) : "v"(ab[0][eb]), "v"(ab[1][eb]), "i"(ks * 4096) : "memory");
                v4u w; w.x = lo.x; w.y = lo.y; w.z = hi2.x; w.w = hi2.y;
                const bf16x8 vf = __builtin_bit_cast(bf16x8, w);
                o[0][eb] = mfma32(pw[0][ks], vf, o[0][eb]); o[1][eb] = mfma32(pw[1][ks], vf, o[1][eb]);
            }
        }
    }
    if (extra) {
#pragma unroll
        for (int ks = 4; ks < 6; ++ks) {
#pragma unroll
            for (int eb = 0; eb < 4; ++eb) {
                const float* vp = Vx + (size_t)((ks - 4) * 16 + 4 * hi) * 512 + eb * 32 + r32;
                f32x4 x0, x1;
                x0.x = vp[0 * 512]; x0.y = vp[1 * 512]; x0.z = vp[2 * 512]; x0.w = vp[3 * 512];
                x1.x = vp[8 * 512]; x1.y = vp[9 * 512]; x1.z = vp[10 * 512]; x1.w = vp[11 * 512];
                const bf16x8 vf = pack8(x0, x1);
                o[0][eb] = mfma32(pw[0][ks], vf, o[0][eb]); o[1][eb] = mfma32(pw[1][ks], vf, o[1][eb]);
            }
        }
    }
    if (hi == 0) {
#pragma unroll
        for (int c = 0; c < 2; ++c) { ML[((wid * 2 + c) * 32 + r32) * 2 + 0] = mrow[c]; ML[((wid * 2 + c) * 32 + r32) * 2 + 1] = lrow[c]; }
    }
    __syncthreads();
    const int pidx = s;
    if (tid < 64) {
        const int c = tid >> 5, q = tid & 31; float mw[8], lw[8]; float Mx = -1e30f;
#pragma unroll
        for (int w = 0; w < 8; ++w) { mw[w] = ML[((w * 2 + c) * 32 + q) * 2 + 0]; lw[w] = ML[((w * 2 + c) * 32 + q) * 2 + 1]; Mx = fmaxf(Mx, mw[w]); }
        float L = 0.f;
#pragma unroll
        for (int w = 0; w < 8; ++w) { const float fz = __builtin_amdgcn_exp2f(mw[w] - Mx); FAC[(w * 2 + c) * 32 + q] = fz; L += lw[w] * fz; }
        float* mp = MLP + ((size_t)((((b * 4 + h) * 2 + c) * 9 + pidx) * 32 + q)) * 2; mp[0] = Mx; mp[1] = L;
    }
    __syncthreads();
#pragma unroll
    for (int c = 0; c < 2; ++c) {
#pragma unroll
        for (int eb = 0; eb < 4; ++eb)
#pragma unroll
            for (int r = 0; r < 16; ++r) { const int q = crow(r, hi); OX[(wid * 32 + q) * 128 + eb * 32 + r32] = o[c][eb][r] * FAC[(wid * 2 + c) * 32 + q]; }
        __syncthreads();
        { const int idx = tid * 8, q = idx >> 7, e = idx & 127; f32x4 s0 = {0.f, 0.f, 0.f, 0.f}, s1 = {0.f, 0.f, 0.f, 0.f};
#pragma unroll
          for (int w = 0; w < 8; ++w) { s0 += *(const LAS f32x4*)(OX + (w * 32 + q) * 128 + e); s1 += *(const LAS f32x4*)(OX + (w * 32 + q) * 128 + e + 4); }
          float* dst = OPART + ((size_t)((((b * 4 + h) * 2 + c) * 9 + pidx) * 32 + q)) * 128 + e; *(f32x4*)dst = s0; *(f32x4*)(dst + 4) = s1; }
        __syncthreads();
    }
}

template <int W> __device__ __forceinline__ void pool_d(const LAS float* U, LAS bf16* Dd, int ch, int tbeg, int t0, bool smp) {
    float s = 0.f;
#pragma unroll
    for (int i = 0; i < W; ++i) s += U[(15 + tbeg - i) * 256 + ch];
#pragma unroll 8
    for (int k = 0; k < 32; ++k) {
        const int tt = tbeg + k; const float cur = U[(15 + tt) * 256 + ch];
        if (k > 0) s += cur - U[(15 + tt - W) * 256 + ch];
        const int pos = smp ? 4096 + tt : t0 + tt; const int cnt = (pos + 1 < W) ? pos + 1 : W;
        const float d = s * __builtin_amdgcn_rcpf((float)cnt) - cur;
        Dd[tt * 264 + ch] = (bf16)(pk2(d, 0.f) & 0xffffu);
    }
}
__device__ __forceinline__ f32x4 bf4_to_f32(v2u w) { f32x4 v; v.x = bf2f(w.x & 0xffff); v.y = bf2f(w.x >> 16); v.z = bf2f(w.y & 0xffff); v.w = bf2f(w.y >> 16); return v; }
__device__ __forceinline__ void poolconv_tile(LAS unsigned char* lds, int tl, int l, const bf16* Zb, bf16* MIX, const float* state_pool, const float* state_conv, const bf16* pwt, const float* pool_scale,
                                              const float* conv_w, float* out_cp, float* out_cs, int tid) {
    const int lane = tid & 63, r32 = lane & 31, hi = lane >> 5, wid = __builtin_amdgcn_readfirstlane(tid >> 6);
    int b, t0, TT, rowbase; bool smp;
    if (tl < 256) { b = tl >> 5; t0 = (tl & 31) * 64; TT = 64; rowbase = b * 2048 + t0; smp = false; }
    else { b = tl - 256; t0 = 0; TT = 32; rowbase = MP + b * 32; smp = true; }
    LAS float* U = (LAS float*)lds;
    LAS bf16* Dd = (LAS bf16*)(lds + 81920);
    {
        f32x4 uv[10];
#pragma unroll
        for (int k = 0; k < 10; ++k) {
            const int idx = tid + 512 * k, i = idx >> 6, c4 = (idx & 63) * 4; f32x4 v = {0.f, 0.f, 0.f, 0.f};
            if (i < 15 + TT) {
                if (i < 15 && smp) v = *(const f32x4*)(state_pool + (size_t)((l * 8 + b) * 15 + i) * 256 + c4);
                else if (i >= 15 || t0 - 15 + i >= 0) v = bf4_to_f32(*(const v2u*)(Zb + (size_t)(rowbase + i - 15) * 1024 + c4));
            }
            uv[k] = v;
        }
#pragma unroll
        for (int k = 0; k < 10; ++k) { const int idx = tid + 512 * k, i = idx >> 6, c4 = (idx & 63) * 4; if (i < 15 + TT) *(LAS f32x4*)(U + i * 256 + c4) = uv[k]; }
    }
    __syncthreads();
    {
        const int ch = tid & 255, th = tid >> 8, gi = __builtin_amdgcn_readfirstlane(ch >> 6);
        if (th * 32 < TT) {
            if (gi == 0) pool_d<2>(U, Dd, ch, th * 32, t0, smp); else if (gi == 1) pool_d<4>(U, Dd, ch, th * 32, t0, smp);
            else if (gi == 2) pool_d<8>(U, Dd, ch, th * 32, t0, smp); else pool_d<16>(U, Dd, ch, th * 32, t0, smp);
        }
    }
    __syncthreads();
    {
        const int gi = wid >> 1, th = wid & 1;
        if (th * 32 < TT) {
            f32x16 acc0, acc1;
#pragma unroll
            for (int r = 0; r < 16; ++r) { acc0[r] = 0.f; acc1[r] = 0.f; }
#pragma unroll
            for (int ks = 0; ks < 4; ++ks) {
                const bf16x8 a = *(const LAS bf16x8*)(Dd + (th * 32 + r32) * 264 + gi * 64 + ks * 16 + hi * 8);
                const bf16x8 b0 = *(const bf16x8*)(pwt + (size_t)((l * 4 + gi) * 64 + r32) * 64 + ks * 16 + hi * 8);
                const bf16x8 b1 = *(const bf16x8*)(pwt + (size_t)((l * 4 + gi) * 64 + 32 + r32) * 64 + ks * 16 + hi * 8);
                acc0 = mfma32(a, b0, acc0); acc1 = mfma32(a, b1, acc1);
            }
            const float sc0 = pool_scale[l * 256 + gi * 64 + r32], sc1 = pool_scale[l * 256 + gi * 64 + 32 + r32];
#pragma unroll
            for (int r = 0; r < 16; ++r) { const int tok = th * 32 + crow(r, hi); bf16* mp = MIX + (size_t)(rowbase + tok) * 1024 + 512 + gi * 64 + r32;
                mp[0] = (bf16)(pk2(acc0[r] * sc0, 0.f) & 0xffffu); mp[32] = (bf16)(pk2(acc1[r] * sc1, 0.f) & 0xffffu); }
        }
    }
    if (wid * 8 < TT) {
        const int cq = lane, tc = wid * 8;
        v2u hraw[10], graw[10], braw[8]; f32x4 hst[2];
        hst[0] = (f32x4){0.f, 0.f, 0.f, 0.f}; hst[1] = hst[0];
#pragma unroll
        for (int i = 0; i < 10; ++i) {
            const int ts = tc - 2 + i; hraw[i] = (v2u){0u, 0u}; graw[i] = (v2u){0u, 0u};
            if (ts >= 0 || (!smp && t0 + ts >= 0)) { const bf16* zr = Zb + (size_t)(rowbase + ts) * 1024 + 4 * cq; hraw[i] = *(const v2u*)(zr + 256); graw[i] = *(const v2u*)(zr + 768); }
        }
#pragma unroll
        for (int i = 0; i < 8; ++i) braw[i] = *(const v2u*)(Zb + (size_t)(rowbase + tc + i) * 1024 + 512 + 4 * cq);
        if (smp && tc == 0) { hst[0] = *(const f32x4*)(state_conv + (size_t)((l * 8 + b) * 2 + 0) * 256 + 4 * cq); hst[1] = *(const f32x4*)(state_conv + (size_t)((l * 8 + b) * 2 + 1) * 256 + 4 * cq); }
        const f32x4 cw0 = *(const f32x4*)(conv_w + l * 768 + 4 * cq), cw1 = *(const f32x4*)(conv_w + l * 768 + 256 + 4 * cq), cw2 = *(const f32x4*)(conv_w + l * 768 + 512 + 4 * cq);
        f32x4 cm2 = bf4_to_f32(graw[0]) * bf4_to_f32(hraw[0]), cm1 = bf4_to_f32(graw[1]) * bf4_to_f32(hraw[1]);
        if (smp && tc == 0) { cm2 = hst[0]; cm1 = hst[1]; }
#pragma unroll
        for (int i = 0; i < 8; ++i) {
            const int tt = tc + i;
            const f32x4 cv = bf4_to_f32(graw[i + 2]) * bf4_to_f32(hraw[i + 2]);
            const f32x4 y = bf4_to_f32(braw[i]) * (cw0 * cm2 + cw1 * cm1 + cw2 * cv);
            v2u w; w.x = pk2(y.x, y.y); w.y = pk2(y.z, y.w);
            *(v2u*)(MIX + (size_t)(rowbase + tt) * 1024 + 768 + 4 * cq) = w;
            if (smp) { if (tt >= 30) *(f32x4*)(out_cs + (size_t)((l * 8 + b) * 2 + tt - 30) * 256 + 4 * cq) = cv; }
            else if (t0 + tt >= 2046) *(f32x4*)(out_cp + (size_t)((l * 8 + b) * 2 + t0 + tt - 2046) * 256 + 4 * cq) = cv;
            cm2 = cm1; cm1 = cv;
        }
    }
    __syncthreads();
}

__device__ __forceinline__ void combine_phase(int l, const bf16* Ob_, const float* OPART_, const float* MLP_, bf16* MIX_, int gw, int NGW, int lane) {
    const float lam_init = (l == 0) ? 0.2f : 0.35550934f;
    float lam;
    { const float a = KIN(12)[l * 64 + lane] * KIN(13)[l * 64 + lane], c = KIN(14)[l * 64 + lane] * KIN(15)[l * 64 + lane];
      lam = __expf(wave_sum(a)) - __expf(wave_sum(c)) + lam_init; }
    const float g0 = KIN(16)[l * 128 + 2 * lane], g1 = KIN(16)[l * 128 + 2 * lane + 1];
    for (int base = gw * 8; base < MP * 4; base += NGW * 8) {
        float a0[8], a1[8];
        {
            unsigned w1[8], w2[8];
#pragma unroll
            for (int j = 0; j < 8; ++j) { const int wt = base + j, row = wt >> 2, h = wt & 3;
                w1[j] = *(const unsigned*)(Ob_ + (size_t)row * 1024 + h * 128 + 2 * lane); w2[j] = *(const unsigned*)(Ob_ + (size_t)row * 1024 + 512 + h * 128 + 2 * lane); }
#pragma unroll
            for (int j = 0; j < 8; ++j) { a0[j] = bf2f(w1[j] & 0xffff) - lam * bf2f(w2[j] & 0xffff); a1[j] = bf2f(w1[j] >> 16) - lam * bf2f(w2[j] >> 16); }
        }
        float ss[8];
#pragma unroll
        for (int j = 0; j < 8; ++j) ss[j] = a0[j] * a0[j] + a1[j] * a1[j];
#pragma unroll
        for (int j = 0; j < 8; ++j) ss[j] += swz_xor<1>(ss[j]);
#pragma unroll
        for (int j = 0; j < 8; ++j) ss[j] += swz_xor<2>(ss[j]);
#pragma unroll
        for (int j = 0; j < 8; ++j) ss[j] += swz_xor<4>(ss[j]);
#pragma unroll
        for (int j = 0; j < 8; ++j) ss[j] += swz_xor<8>(ss[j]);
#pragma unroll
        for (int j = 0; j < 8; ++j) ss[j] += swz_xor<16>(ss[j]);
#pragma unroll
        for (int j = 0; j < 8; ++j) { const int wt = base + j, row = wt >> 2, h = wt & 3;
            const float tot = xhalf_sum(ss[j]);
            const float r = (1.0f / sqrtf(tot * (1.0f / 128.0f) + EPS)) * (1.0f - lam_init);
            *(unsigned*)(MIX_ + (size_t)row * 1024 + h * 128 + 2 * lane) = pk2(a0[j] * r * g0, a1[j] * r * g1); }
    }
    for (int wt = MP * 4 + gw; wt < M * 4; wt += NGW) {
        const int row = wt >> 2, h = wt & 3, rs = row - MP, b = rs >> 5, q = rs & 31; float oc[2][2];
#pragma unroll
        for (int c = 0; c < 2; ++c) {
            const size_t pb = (size_t)(((b * 4 + h) * 2 + c) * 9);
            float mw[8], lw[8]; f32x2 ov[8]; float Mx = -1e30f;
#pragma unroll
            for (int pi = 0; pi < 8; ++pi) { const f32x2 ml = *(const f32x2*)(MLP_ + ((pb + pi) * 32 + q) * 2); mw[pi] = ml.x; lw[pi] = ml.y; ov[pi] = *(const f32x2*)(OPART_ + ((pb + pi) * 32 + q) * 128 + 2 * lane); }
#pragma unroll
            for (int pi = 0; pi < 8; ++pi) Mx = fmaxf(Mx, mw[pi]);
            float L = 0.f, s0 = 0.f, s1 = 0.f;
#pragma unroll
            for (int pi = 0; pi < 8; ++pi) { const float fz = __builtin_amdgcn_exp2f(mw[pi] - Mx); L += lw[pi] * fz; s0 += ov[pi].x * fz; s1 += ov[pi].y * fz; }
            const float il = 1.0f / L; oc[c][0] = s0 * il; oc[c][1] = s1 * il;
        }
        const float a0 = oc[0][0] - lam * oc[1][0], a1 = oc[0][1] - lam * oc[1][1];
        const float tot = wave_sum(a0 * a0 + a1 * a1);
        const float r = (1.0f / sqrtf(tot * (1.0f / 128.0f) + EPS)) * (1.0f - lam_init);
        *(unsigned*)(MIX_ + (size_t)row * 1024 + h * 128 + 2 * lane) = pk2(a0 * r * g0, a1 * r * g1);
    }
}

#ifndef PROBE_SLOW_ATTN
#define PROBE_SLOW_ATTN 0
#endif
#if PROBE_SLOW_ATTN
__device__ __forceinline__ void slow_attn_phase(int l, const bf16* Qb_, float* outp, const float* cache_k, const float* cache_v, bf16* MIX_, int gw, int NGW, int lane) {
    const float lam_init = (l == 0) ? 0.2f : 0.35550934f;
    float lam;
    { const float a = KIN(12)[l * 64 + lane] * KIN(13)[l * 64 + lane], c = KIN(14)[l * 64 + lane] * KIN(15)[l * 64 + lane];
      lam = __expf(wave_sum(a)) - __expf(wave_sum(c)) + lam_init; }
    const float g0 = KIN(16)[l * 128 + 2 * lane], g1 = KIN(16)[l * 128 + 2 * lane + 1];
    for (int wt = gw; wt < M * 4; wt += NGW) {
        const int row = wt >> 2, h = wt & 3;
        const float *K0, *V0, *K1, *V1; int n0, n1;
        if (row < MP) { const int b = row >> 11, t = row & 2047; K0 = outp + OFF_KP + ((size_t)l * MP + (size_t)b * 2048) * 512 + h * 128; V0 = outp + OFF_VP + ((size_t)l * MP + (size_t)b * 2048) * 512 + h * 128; n0 = ((t >> 6) + 1) * 64; K1 = K0; V1 = V0; n1 = 0; }
        else { const int rs = row - MP, b = rs >> 5; K0 = cache_k + ((size_t)(l * 8 + b) * 4096) * 512 + h * 128; V0 = cache_v + ((size_t)(l * 8 + b) * 4096) * 512 + h * 128; n0 = 4096;
               K1 = outp + OFF_KS + ((size_t)(l * 8 + b) * 32) * 512 + h * 128; V1 = outp + OFF_VS + ((size_t)(l * 8 + b) * 32) * 512 + h * 128; n1 = 32; }
        float oc[2][2];
#pragma unroll 1
        for (int c = 0; c < 2; ++c) {
            float q[64];
#pragma unroll
            for (int d = 0; d < 64; ++d) q[d] = bf2f(Qb_[(size_t)row * 512 + h * 128 + c * 64 + d]);
            float mx = -1e30f;
            for (int seg = 0; seg < 2; ++seg) { const float* Kp = seg ? K1 : K0; const int n = seg ? n1 : n0;
                for (int j0 = 0; j0 < n; j0 += 64) { const int j = j0 + lane; float s = -1e30f;
                    if (j < n) { const float* kr = Kp + (size_t)j * 512 + c * 64; s = 0.f;
#pragma unroll
                        for (int d = 0; d < 64; ++d) s += q[d] * kr[d]; }
                    mx = fmaxf(mx, s); } }
            mx = fmaxf(mx, swz_xor<1>(mx)); mx = fmaxf(mx, swz_xor<2>(mx)); mx = fmaxf(mx, swz_xor<4>(mx)); mx = fmaxf(mx, swz_xor<8>(mx)); mx = fmaxf(mx, swz_xor<16>(mx)); mx = xhalf_max(mx);
            float L = 0.f, o0 = 0.f, o1 = 0.f;
            for (int seg = 0; seg < 2; ++seg) { const float* Kp = seg ? K1 : K0; const float* Vp = seg ? V1 : V0; const int n = seg ? n1 : n0;
                for (int j0 = 0; j0 < n; j0 += 64) { const int j = j0 + lane; float pj = 0.f;
                    if (j < n) { const float* kr = Kp + (size_t)j * 512 + c * 64; float s = 0.f;
#pragma unroll
                        for (int d = 0; d < 64; ++d) s += q[d] * kr[d];
                        pj = __builtin_amdgcn_exp2f(s - mx); }
                    L += pj;
                    const int nn = (n - j0 < 64) ? n - j0 : 64;
                    for (int jj = 0; jj < nn; ++jj) { const float pb = __builtin_bit_cast(float, __builtin_amdgcn_readlane(__builtin_bit_cast(int, pj), jj));
                        const f32x2 vv = *(const f32x2*)(Vp + (size_t)(j0 + jj) * 512 + 2 * lane); o0 += pb * vv.x; o1 += pb * vv.y; } } }
            L = wave_sum(L);
            oc[c][0] = o0 / L; oc[c][1] = o1 / L;
        }
        const float a0 = oc[0][0] - lam * oc[1][0], a1 = oc[0][1] - lam * oc[1][1];
        const float ss = wave_sum(a0 * a0 + a1 * a1);
        const float r = (1.0f / sqrtf(ss * (1.0f / 128.0f) + EPS)) * (1.0f - lam_init);
        *(unsigned*)(MIX_ + (size_t)row * 1024 + h * 128 + 2 * lane) = pk2(a0 * r * g0, a1 * r * g1);
    }
}
#endif

#ifndef PROBE_SLOW_PC
#define PROBE_SLOW_PC 0
#endif
#if PROBE_SLOW_PC
__device__ __forceinline__ float zval(const bf16* Zb_, const float* st, int l, int b, bool smp, int rowbase, int t, int col, int hist) {
    if (t >= 0) return bf2f(Zb_[(size_t)(rowbase + t) * 1024 + col]);
    if (!smp) return 0.f;
    return st[(size_t)((l * 8 + b) * hist + (hist + t)) * 256 + (col & 255)];
}
__device__ __forceinline__ void slow_pc_phase(int l, const bf16* Zb_, bf16* MIX_, int gw, int NGW, int lane) {
    const float* sp = KIN(4); const float* scv = KIN(5); const float* pw = KIN(17); const float* psc = KIN(18); const float* cw = KIN(19);
    for (int wt = gw; wt < M * 4; wt += NGW) {
        const int row = wt >> 2, g = wt & 3; const bool smp = row >= MP;
        int b, t, rowbase; if (smp) { const int rs = row - MP; b = rs >> 5; t = rs & 31; rowbase = MP + b * 32; } else { b = row >> 11; t = row & 2047; rowbase = b * 2048; }
        const int w = 2 << g, ch = g * 64 + lane;
        float s = 0.f;
        for (int i = 0; i < w; ++i) { const int tt = t - i; s += zval(Zb_, sp, l, b, smp, rowbase, tt, ch, 15); }
        const int pos = smp ? 4096 + t : t; const int cnt = (pos + 1 < w) ? pos + 1 : w;
        const float d = s / (float)cnt - zval(Zb_, sp, l, b, smp, rowbase, t, ch, 15);
        float mine = 0.f;
        for (int e = 0; e < 64; ++e) { const float v = wave_sum(d * pw[(size_t)((l * 4 + g) * 64 + lane) * 64 + e]); if (e == lane) mine = v; }
        MIX_[(size_t)row * 1024 + 512 + ch] = (bf16)(pk2(mine * psc[l * 256 + ch], 0.f) & 0xffffu);
        float cvv[3];
#pragma unroll
        for (int k = 0; k < 3; ++k) { const int tt = t - 2 + k;
            if (tt >= 0) cvv[k] = bf2f(Zb_[(size_t)(rowbase + tt) * 1024 + 768 + ch]) * bf2f(Zb_[(size_t)(rowbase + tt) * 1024 + 256 + ch]);
            else cvv[k] = smp ? scv[(size_t)((l * 8 + b) * 2 + (2 + tt)) * 256 + ch] : 0.f; }
        const float bgv = bf2f(Zb_[(size_t)row * 1024 + 512 + ch]);
        const float y = bgv * (cw[l * 768 + ch] * cvv[0] + cw[l * 768 + 256 + ch] * cvv[1] + cw[l * 768 + 512 + ch] * cvv[2]);
        MIX_[(size_t)row * 1024 + 768 + ch] = (bf16)(pk2(y, 0.f) & 0xffffu);
    }
}
#endif

#define XB_TMO      128
#define XB_XCNT(j)  (256  + 64 * (j))
#define XB_XSUB(j)  (1280 + 64 * (j))
#define XB_XGEN(j)  (2304 + 64 * (j))
#define XB_TOP      3328
#define XB_TOPGEN   3392
#define XCD_BAR_WORDS 3456
#define XB_SPIN_CAP (1u << 18)
__device__ __forceinline__ unsigned xb_ld(unsigned* p)              { return __hip_atomic_load(p, __ATOMIC_RELAXED, __HIP_MEMORY_SCOPE_AGENT); }
__device__ __forceinline__ unsigned xb_add(unsigned* p, unsigned v) { return __hip_atomic_fetch_add(p, v, __ATOMIC_RELAXED, __HIP_MEMORY_SCOPE_AGENT); }
__device__ __forceinline__ unsigned xb_xcc_id() { return (unsigned)__builtin_amdgcn_s_getreg((3 << 11) | 20) & 0xFu; }
#define XB_SPIN(cond, bar) do { unsigned _sp = 0; while (cond) { __builtin_amdgcn_s_sleep(1); \
    if ((++_sp & 255u) == 0u) { if (xb_ld(&(bar)[XB_TMO])) break; if (_sp > XB_SPIN_CAP) { atomicAdd(&(bar)[XB_TMO], 1u); break; } } } } while (0)
__device__ __forceinline__ void xcd_barrier_complete(unsigned* bar, unsigned x, unsigned& nloc, unsigned& nx) {
    const unsigned G = gridDim.x * gridDim.y * gridDim.z;
    unsigned sum, cnt, mine, sp = 0u;
    for (;;) {
        sum = 0u; cnt = 0u; mine = 0u;
#pragma unroll
        for (unsigned j = 0; j < 16; ++j) { const unsigned c = xb_ld(&bar[XB_XCNT(j)]); sum += c; cnt += (c > 0u) ? 1u : 0u; mine = (j == x) ? c : mine; }
        if (sum == G) break;
        __builtin_amdgcn_s_sleep(1);
        if ((++sp & 255u) == 0u) { if (xb_ld(&bar[XB_TMO])) break; if (sp > XB_SPIN_CAP) { atomicAdd(&bar[XB_TMO], 1u); break; } }
    }
    nloc = mine > 0u ? mine : 1u; nx = cnt > 0u ? cnt : 1u;
}
__device__ __forceinline__ void xcd_barrier(unsigned* bar, unsigned x, volatile LAS unsigned* st) {
    asm volatile("s_waitcnt vmcnt(0)" ::: "memory");
    __syncthreads();
    if (threadIdx.x == 0) {
        __builtin_amdgcn_s_waitcnt(0);
        unsigned nloc = st[0], nx = st[1];
        if (nloc == 0u) { xcd_barrier_complete(bar, x, nloc, nx); st[0] = nloc; st[1] = nx; }
        const unsigned old = xb_add(&bar[XB_XSUB(x)], 1u);
        const unsigned gen = old / nloc;
        if (old + 1u == (gen + 1u) * nloc) {
            __builtin_amdgcn_fence(__ATOMIC_RELEASE, "agent");
            asm volatile("s_waitcnt vmcnt(0)" ::: "memory");
            const unsigned og = xb_add(&bar[XB_TOP], 1u);
            const unsigned tg = og / nx;
            if (og + 1u == (tg + 1u) * nx) xb_add(&bar[XB_TOPGEN], 1u);
            else XB_SPIN(xb_ld(&bar[XB_TOPGEN]) == tg, bar);
            __builtin_amdgcn_fence(__ATOMIC_ACQUIRE, "agent");
            xb_add(&bar[XB_XGEN(x)], 1u);
            asm volatile("s_waitcnt vmcnt(0)" ::: "memory");
        } else {
            XB_SPIN(xb_ld(&bar[XB_XGEN(x)]) == gen, bar);
            __builtin_amdgcn_fence(__ATOMIC_ACQUIRE, "agent");
            asm volatile("s_waitcnt vmcnt(0)" ::: "memory");
        }
    }
    __syncthreads();
}
#define CG_SYNC() do { asm volatile("s_waitcnt vmcnt(0) lgkmcnt(0)" ::: "memory"); grid.sync(); asm volatile("" ::: "memory"); } while (0)
#define GRID_SYNC() xcd_barrier((unsigned*)KWS() + 4096, xcc, (volatile LAS unsigned*)(lds + LDS_BYTES - 64))
__global__ void __launch_bounds__(NWAVES * 64, 2) mega_fwd(Params p) {
    extern __shared__ __attribute__((aligned(16))) unsigned char lds_raw[];
    LAS unsigned char* lds = (LAS unsigned char*)lds_raw;
    cg::grid_group grid = cg::this_grid();
    const int tid = threadIdx.x, lane = tid & 63, wave = __builtin_amdgcn_readfirstlane(tid >> 6);
    const int G = gridDim.x; const int bx = blockIdx.x; const int vcu0 = (G % 8 == 0) ? (bx % 8) * (G / 8) + bx / 8 : bx;
    const int NGW = G * NWAVES;
#define X ((bf16*)(ws + WS_X))
#define H ((bf16*)(ws + WS_H))
#define MIX ((bf16*)(ws + WS_MIX))
#define ACT ((bf16*)(ws + WS_ACT))
#define Qb ((bf16*)(ws + WS_QB))
#define Kb ((bf16*)(ws + WS_KB))
#define Vb ((bf16*)(ws + WS_VB))
#define Zb ((bf16*)(ws + WS_ZB))
#define Ob ((bf16*)(ws + WS_OB))
#define OPART ((float*)(ws + WS_OPART))
#define MLP ((float*)(ws + WS_ML))
#define pwt ((const bf16*)(ws + WS_POOLWT))
    if (tid < 16) ((LAS unsigned*)(lds + LDS_BYTES - 64))[tid] = 0u;
    const unsigned xcc = xb_xcc_id();
    if (tid == 0) (void)xb_add((unsigned*)KWS() + 4096 + XB_XCNT(xcc), 1u);
    __syncthreads();
    { const int gw = vcu0 * NWAVES + wave; prologue(lds, gw, NGW, wave, lane);
      norm_rows<false>(KIN(0), KIN(1), KIN(6), (bf16*)(KWS() + WS_H), nullptr, gw, NGW, lane); }
    CG_SYNC();
#define FRESH_IDS() int tid = threadIdx.x; asm volatile("" : "+v"(tid)); const int lane = tid & 63, wave = __builtin_amdgcn_readfirstlane(tid >> 6); int vcu = vcu0; asm volatile("" : "+s"(vcu)); const int gw = vcu * NWAVES + wave; (void)lane; (void)gw; (void)wave
#define CNT(nid, idx) ((unsigned*)(ws + CTL_CNT) + (size_t)((nid) * 80 + (idx)) * 64)
#pragma unroll 1
    for (int step = 0; step < 4; ++step) {
        const int l = step >> 1, f = step & 1;
        const bool first = (step == 0);
        { FRESH_IDS(); unsigned char* const ws = KWS(); unsigned char* const wl = ws + WS_W + (size_t)l * WL;
          pg8::Gemm g{H, (const bf16*)(wl + (f ? W_GU2 : W_GU1)), M, 2 * FF, D}; pg8::StaticOrder S; S.init(M, 2 * FF, G, bx);
          pg8::EpiSwiGLU E{ACT, FF};
          pg8::gemm_phase<pg8::EpiSwiGLU, pg8::StaticOrder, true, true>(lds, g, S, E); }
        GRID_SYNC();
        { FRESH_IDS(); unsigned char* const ws = KWS(); unsigned char* const wl = ws + WS_W + (size_t)l * WL;
          const bool last = (step == 3);
          const float* const gn = last ? KIN(25) : (f ? KIN(6) + (l + 1) * D : KIN(10) + l * D);
          const int nid = step * 2;
          float* const yo = KOUT() + OFF_Y;
          pg8::Gemm g{ACT, (const bf16*)(wl + (f ? W_D2 : W_D1)), MP, D, FF}; pg8::StaticOrder S; S.init(MP, D, G, bx);
          if (first) skinny_part1<false, FF>(lds, ACT + (size_t)MP * FF, (const bf16*)(wl + W_D1), KIN(1), X + (size_t)MP * D, 0.5f, (unsigned*)(ws + WS_SLOTS), CNT(nid, 64), vcu, tid);
          else skinny_part1<true, FF>(lds, ACT + (size_t)MP * FF, (const bf16*)(wl + (f ? W_D2 : W_D1)), X + (size_t)MP * D, last ? nullptr : X + (size_t)MP * D, 0.5f, (unsigned*)(ws + WS_SLOTS), CNT(nid, 64), vcu, tid);
          { pg8::Unit u0; const int pm0 = S.next(0, u0) ? u0.pm : 0;
            if (first) { pg8::EpiResidNorm<false> E{KIN(0), X, 0.5f, H, yo, gn, (unsigned*)(ws + WS_SLOTP), CNT(nid, pm0)};
                         pg8::gemm_phase<pg8::EpiResidNorm<false>, pg8::StaticOrder, false, true>(lds, g, S, E); }
            else { pg8::EpiResidNorm<true> E{X, last ? nullptr : X, 0.5f, last ? nullptr : H, yo, gn, (unsigned*)(ws + WS_SLOTP), CNT(nid, pm0)};
                   pg8::gemm_phase<pg8::EpiResidNorm<true>, pg8::StaticOrder, false, true>(lds, g, S, E); } }
          skinny_part2(lds, last ? nullptr : H + (size_t)MP * D, yo + (size_t)MP * D, gn, (unsigned*)(ws + WS_SLOTS), CNT(nid, 64), vcu, tid); }
        if (step == 3) break;
        GRID_SYNC();
        if (f == 0) {
            { FRESH_IDS(); unsigned char* const ws = KWS(); unsigned char* const wl = ws + WS_W + (size_t)l * WL;
              pg8::Gemm g{H, (const bf16*)(wl + W_IN), M, DIN, D}; pg8::StaticOrder S; S.init(M, DIN, G, bx);
              pg8::EpiWin E{ws, KOUT(), l, C2};
              pg8::gemm_phase<pg8::EpiWin, pg8::StaticOrder, true, true>(lds, g, S, E); }
            GRID_SYNC();
#pragma unroll 1
            for (int slot = 0; slot < 2; ++slot) {
              if (((slot ^ vcu0) & 1) == 0) {
                FRESH_IDS(); unsigned char* const ws = KWS();
                attn_body::bf16x8 qreg[4];
#pragma unroll
                for (int d0 = 0; d0 < 4; ++d0) qreg[d0] = (attn_body::bf16x8){0, 0, 0, 0, 0, 0, 0, 0};
#pragma unroll 1
                for (int i = 0; i < 4; ++i) {
                  const int L = i * G + vcu; if (L >= 1024) break;
                  const int bh = (L & 255) >> 1, sI = L & 1, ii = L >> 8;
                  const int qb = sI == 0 ? (ii == 0 ? 7 : ii == 1 ? 0 : ii == 2 ? 4 : 3) : (ii == 0 ? 6 : ii == 1 ? 1 : ii == 2 ? 5 : 2);
                  const int in_ = ii + 1;
                  const int qbn = (G == 256 && i < 3) ? (sI == 0 ? (in_ == 1 ? 0 : in_ == 2 ? 4 : 3) : (in_ == 1 ? 1 : in_ == 2 ? 5 : 2)) : -1;
                  const bool pre = (G == 256 && i > 0);
                  const int b = bh >> 4, vh = bh & 15, hh = vh >> 2, c = (vh >> 1) & 1, hf = vh & 1;
                  attn_body::attn_unit<8>(b, qb, qbn, pre, qreg, (const attn_body::bf16*)(Qb + (hh * 2 + c) * 64), (const attn_body::bf16*)(Kb + (hh * 2 + c) * 64), (const attn_body::bf16*)(Vb + hh * 128 + hf * 64),
                                          (attn_body::bf16*)(Ob + c * 512 + hh * 128 + hf * 64), (char*)lds_raw);
                }
              } else {
                FRESH_IDS(); unsigned char* const ws = KWS(); float* const outp = KOUT();
                for (int pc = vcu; pc < 256; pc += G)
                  sample_piece(lds, pc, l, Qb, KIN(2), KIN(3), outp + OFF_KS, outp + OFF_VS, OPART, MLP, tid);
              }
              __syncthreads();
            }
            { FRESH_IDS(); unsigned char* const ws = KWS(); float* const outp = KOUT();
              for (int tl = vcu; tl < 264; tl += G)
                poolconv_tile(lds, tl, l, Zb, MIX, KIN(4), KIN(5), pwt, KIN(18), KIN(19), outp + OFF_CP, outp + OFF_CS, tid); }
            GRID_SYNC();
            { FRESH_IDS(); unsigned char* const ws = KWS();
              combine_phase(l, Ob, OPART, MLP, MIX, gw, NGW, lane); }
            GRID_SYNC();
            { FRESH_IDS(); unsigned char* const ws = KWS(); unsigned char* const wl = ws + WS_W + (size_t)l * WL;
              const float* const gn = KIN(21) + l * D; const int nid = step * 2 + 1;
              pg8::Gemm g{MIX, (const bf16*)(wl + W_OUT), MP, D, D}; pg8::StaticOrder S; S.init(MP, D, G, bx);
              skinny_part1<true, D>(lds, MIX + (size_t)MP * D, (const bf16*)(wl + W_OUT), X + (size_t)MP * D, X + (size_t)MP * D, 1.0f, (unsigned*)(ws + WS_SLOTS), CNT(nid, 64), vcu, tid);
              { pg8::Unit u0; const int pm0 = S.next(0, u0) ? u0.pm : 0;
                pg8::EpiResidNorm<true> E{X, X, 1.0f, H, nullptr, gn, (unsigned*)(ws + WS_SLOTP), CNT(nid, pm0)};
                pg8::gemm_phase<pg8::EpiResidNorm<true>, pg8::StaticOrder, false, true>(lds, g, S, E); }
              skinny_part2(lds, H + (size_t)MP * D, nullptr, gn, (unsigned*)(ws + WS_SLOTS), CNT(nid, 64), vcu, tid); }
            GRID_SYNC();
        }
    }
}

extern "C" void kernel_launch(void* const* d_in, const int* in_sizes, int n_in, void* d_out, int out_size, void* d_ws, size_t ws_size, hipStream_t stream) {
    static int grid = 0;
    if (grid == 0) {
        if (n_in != 26 || (size_t)out_size != OUT_TOTAL || ws_size < WS_END) { fprintf(stderr, "kernel_launch: unexpected problem shape: n_in %d out %d ws %zu\n", n_in, out_size, ws_size); grid = -1; return; }
        int dev = 0, cus = 0, per_cu = 0;
        if (hipGetDevice(&dev) != hipSuccess || hipDeviceGetAttribute(&cus, hipDeviceAttributeMultiprocessorCount, dev) != hipSuccess) { grid = -1; return; }
        if (hipFuncSetAttribute((const void*)mega_fwd, hipFuncAttributeMaxDynamicSharedMemorySize, LDS_BYTES) != hipSuccess) { fprintf(stderr, "kernel_launch: hipFuncSetAttribute failed\n"); grid = -1; return; }
        if (hipOccupancyMaxActiveBlocksPerMultiprocessor(&per_cu, (const void*)mega_fwd, NWAVES * 64, LDS_BYTES) != hipSuccess || per_cu < 1) { fprintf(stderr, "kernel_launch: occupancy query says %d\n", per_cu); per_cu = 1; }
        (void)hipGetLastError();
        grid = cus * per_cu;
    }
    if (grid < 0) return;
    if (hipMemsetAsync(d_ws, 0, CTL_BYTES, stream) != hipSuccess) { fprintf(stderr, "kernel_launch: memset failed\n"); return; }
    Params p{};
    for (int i = 0; i < 26; ++i) p.in[i] = (const float*)d_in[i];
    p.out = (float*)d_out; p.ws = (unsigned char*)d_ws;
    void* args[] = {&p};
    const hipError_t e = hipLaunchCooperativeKernel((const void*)mega_fwd, dim3(grid), dim3(NWAVES * 64), args, LDS_BYTES, stream);
    if (e != hipSuccess) fprintf(stderr, "kernel_launch: cooperative launch failed: %s (grid %d)\n", hipGetErrorString(e), grid);
}
```
